# Optimizing an MI355X kernel written in HIP

```python
import math
import jax, jax.numpy as jnp
from jax import lax
import numpy as np

D_MODEL = 1024
BATCH = 16
SEQ = 256
DEPTH = 2
DEC_BATCH = 8
DEC_SEQ = 4096
PAST_LEN = 256

GRID_W = 64
EPS = 1e-6
GATE_FLOOR = 1e-30
GDN_HEADS = 4
GDN_DK = 64
GDN_DV = 64
GDN_CONV = 5
GDN_CHUNK = 64
GDN_QK = GDN_HEADS * GDN_DK
GDN_W = GDN_HEADS * GDN_DV
GDN_CONV_CH = 2 * GDN_QK + GDN_W
HG_HEADS = 4
HG_DK = 64
HG_DV = 64
HG_CHUNK = 64
HG_QK = HG_HEADS * HG_DK
HG_W = HG_HEADS * HG_DV
MLA_HEADS = 4
MLA_Q_RANK = 384
MLA_KV_RANK = 256
MLA_NOPE = 128
MLA_ROPE = 64
MLA_DV = 128
MLA_QK = MLA_NOPE + MLA_ROPE
MLA_W = MLA_HEADS * MLA_DV
ROPE_BASE = 10000.0
Q_BLOCK = 128
MIX_W = GDN_W + HG_W + MLA_W
IN_SIZES = (GDN_QK, GDN_QK, GDN_W, GDN_W, 2 * GDN_HEADS, 2 * GDN_HEADS,
            HG_QK, HG_W, 2 * HG_QK, HG_W,
            MLA_Q_RANK, MLA_KV_RANK, MLA_ROPE)
IN_DIM = sum(IN_SIZES)
D_FF = -(-8 * D_MODEL // (3 * 256)) * 256

kernel_name = 'hybrid_gdn_hgrn2_mla_diffusion_step'

F32 = jnp.float32


def _split(x, sizes):
    out, off = [], 0
    for s in sizes:
        out.append(x[..., off:off + s])
        off += s
    return out


def rmsnorm(x, w):
    xf = x.astype(F32)
    y = xf * lax.rsqrt(jnp.mean(xf * xf, axis=-1, keepdims=True) + EPS)
    return (y * w.astype(F32)).astype(x.dtype)


def l2norm(x):
    return x * lax.rsqrt(jnp.sum(x * x, axis=-1, keepdims=True) + EPS)


def centred_dwconv(x, w):
    k = w.shape[-1]
    return lax.conv_general_dilated(
        x, w.T[:, None, :].astype(x.dtype), window_strides=(1,),
        padding=[(k // 2, k // 2)], dimension_numbers=('NWC', 'WIO', 'NWC'),
        feature_group_count=x.shape[-1])


def axial_rope(n):
    rows = n // GRID_W
    row = jnp.repeat(jnp.arange(rows, dtype=F32), GRID_W)
    col = jnp.tile(jnp.arange(GRID_W, dtype=F32), rows)
    nf = MLA_ROPE // 4
    inv = ROPE_BASE ** (-jnp.arange(nf, dtype=F32) / nf)
    ang = jnp.stack([row[:, None] * inv, col[:, None] * inv], axis=1)
    return jnp.cos(ang), jnp.sin(ang)


def apply_rope(x, cos, sin):
    xs = x.astype(F32).reshape(x.shape[:-1] + (2, 2, MLA_ROPE // 4))
    x1, x2 = xs[..., 0, :], xs[..., 1, :]
    out = jnp.stack([x1 * cos - x2 * sin, x2 * cos + x1 * sin], axis=-2)
    return out.reshape(x.shape).astype(x.dtype)


def _heads_first(t, n_chunks, chunk):
    b, _, h = t.shape[:3]
    t = t.reshape((b, n_chunks, chunk, h) + t.shape[3:])
    return t.transpose((0, 3, 1, 2) + tuple(range(4, t.ndim)))


def gdn_scan(q, k, v, g, beta, s0):
    bsz, t_len, h, dk = q.shape
    dv = v.shape[-1]
    c = GDN_CHUNK
    n = t_len // c
    qb = _heads_first(q * dk ** -0.5, n, c)
    kb = _heads_first(k, n, c)
    vb = _heads_first(v, n, c)
    gc = jnp.cumsum(_heads_first(g, n, c), axis=-1)
    bt = _heads_first(beta, n, c)[..., None]
    idx = jnp.arange(c)
    incl = idx[:, None] >= idx[None, :]
    strict = idx[:, None] > idx[None, :]
    diff = gc[..., :, None] - gc[..., None, :]
    decay = jnp.where(incl, jnp.exp(jnp.where(incl, diff, 0.0)), 0.0)
    k_beta = kb * bt
    m = jnp.where(strict, jnp.einsum('bhnik,bhnjk->bhnij', k_beta, kb) * decay, 0.0)
    a_mat = m + jnp.eye(c, dtype=m.dtype)
    rhs = jnp.concatenate([vb * bt, k_beta * jnp.exp(gc)[..., None]], axis=-1)
    sol = lax.linalg.triangular_solve(a_mat, rhs, left_side=True, lower=True, unit_diagonal=True)
    u, w = sol[..., :dv], sol[..., dv:]
    att = jnp.where(incl, jnp.einsum('bhnik,bhnjk->bhnij', qb, kb) * decay, 0.0)
    q_dec = qb * jnp.exp(gc)[..., None]
    k_tail = kb * jnp.exp(gc[..., -1:] - gc)[..., None]
    g_last = jnp.exp(gc[..., -1])

    def step(s, xs):
        att_i, u_i, w_i, qd_i, kt_i, gl_i = xs
        v_new = u_i - jnp.einsum('bhck,bhkv->bhcv', w_i, s)
        o = jnp.einsum('bhck,bhkv->bhcv', qd_i, s) + jnp.einsum('bhij,bhjv->bhiv', att_i, v_new)
        s = s * gl_i[..., None, None] + jnp.einsum('bhck,bhcv->bhkv', kt_i, v_new)
        return s, o

    xs = tuple(jnp.moveaxis(a, 2, 0) for a in (att, u, w, q_dec, k_tail, g_last))
    s_fin, o = lax.scan(step, s0.astype(F32), xs)
    return o.transpose(1, 0, 3, 2, 4).reshape(bsz, t_len, h, dv), s_fin


def hgrn_scan(q, k, v, logf, s0):
    bsz, t_len, h, _ = q.shape
    dv = v.shape[-1]
    c = HG_CHUNK
    n = t_len // c
    idx = jnp.arange(c)
    causal = (idx[:, None] >= idx[None, :])[:, :, None]

    def step(s, xs):
        qc, kc, vc, lf = xs
        bc = jnp.cumsum(lf, axis=2)
        diff = bc[:, :, :, None, :] - bc[:, :, None, :, :]
        dec = jnp.where(causal, jnp.exp(jnp.where(causal, diff, 0.0)), 0.0)
        att = jnp.einsum('bhtk,bhtsk,bhsk->bhts', qc, dec, kc)
        o = jnp.einsum('bhts,bhsv->bhtv', att, vc) + jnp.einsum('bhtk,bhkv->bhtv', qc * jnp.exp(bc), s)
        bl = bc[:, :, -1, :]
        s = s * jnp.exp(bl)[..., None] + jnp.einsum('bhsk,bhsv->bhkv', kc * jnp.exp(bl[:, :, None, :] - bc), vc)
        return s, o

    xs = tuple(jnp.moveaxis(_heads_first(a, n, c), 2, 0) for a in (q, k, v, logf))
    s_fin, o = lax.scan(step, s0.astype(F32), xs)
    return o.transpose(1, 0, 3, 2, 4).reshape(bsz, t_len, h, dv), s_fin


def _flip(t):
    return jnp.flip(t, axis=1)


def gdn_mixer(q, k, v, z, a, b, conv_w, a_log, dt_bias, norm_w, s_fwd, s_bwd):
    bsz, t_len, _ = q.shape
    qkv = jax.nn.silu(centred_dwconv(jnp.concatenate([q, k, v], axis=-1), conv_w)).astype(F32)
    q, k, v = _split(qkv, (GDN_QK, GDN_QK, GDN_W))
    q = l2norm(q.reshape(bsz, t_len, GDN_HEADS, GDN_DK))
    k = l2norm(k.reshape(bsz, t_len, GDN_HEADS, GDN_DK))
    v = v.reshape(bsz, t_len, GDN_HEADS, GDN_DV)
    a = a.astype(F32).reshape(bsz, t_len, 2, GDN_HEADS)
    b = b.astype(F32).reshape(bsz, t_len, 2, GDN_HEADS)
    g = -jnp.exp(a_log.astype(F32)) * jax.nn.softplus(a + dt_bias.astype(F32))
    beta = jax.nn.sigmoid(b)
    o_f, sf = gdn_scan(q, k, v, g[:, :, 0], beta[:, :, 0], s_fwd)
    o_b, sb = gdn_scan(_flip(q), _flip(k), _flip(v), _flip(g[:, :, 1]), _flip(beta[:, :, 1]), s_bwd)
    o = o_f + _flip(o_b)
    o = rmsnorm(o, norm_w) * jax.nn.silu(z.astype(F32).reshape(bsz, t_len, GDN_HEADS, GDN_DV))
    return o.reshape(bsz, t_len, GDN_W), sf, sb


def hgrn_mixer(q, i, f, g, lb, norm_w, s_fwd, s_bwd):
    bsz, t_len, _ = q.shape
    q = q.astype(F32).reshape(bsz, t_len, HG_HEADS, HG_DK)
    v = i.astype(F32).reshape(bsz, t_len, HG_HEADS, HG_DV)
    f = f.astype(F32).reshape(bsz, t_len, 2, HG_HEADS, HG_DK)
    lb = lb.astype(F32).reshape(HG_HEADS, HG_DK)
    gate = lb + (1.0 - lb) * jax.nn.sigmoid(f)
    logf = jnp.log(jnp.maximum(gate, GATE_FLOOR))
    k = (1.0 - lb) * jax.nn.sigmoid(-f)
    o_f, sf = hgrn_scan(q, k[:, :, 0], v, logf[:, :, 0], s_fwd)
    o_b, sb = hgrn_scan(_flip(q), _flip(k[:, :, 1]), _flip(v), _flip(logf[:, :, 1]), s_bwd)
    o = o_f + _flip(o_b)
    o = rmsnorm(o, norm_w) * jax.nn.sigmoid(g.astype(F32).reshape(bsz, t_len, HG_HEADS, HG_DV))
    return o.reshape(bsz, t_len, HG_W), sf, sb


def mla_keys(c_kv, k_rope, w_ukv):
    bsz, s_len, _ = c_kv.shape
    kv = (c_kv @ w_ukv).reshape(bsz, s_len, MLA_HEADS, MLA_NOPE + MLA_DV)
    k = jnp.concatenate([kv[..., :MLA_NOPE],
                         jnp.broadcast_to(k_rope[:, :, None, :], (bsz, s_len, MLA_HEADS, MLA_ROPE))], axis=-1)
    return k, kv[..., MLA_NOPE:]


def blocked_attention(q, k, v):
    bsz, t_len, h, dq = q.shape
    nb = t_len // Q_BLOCK
    scale = dq ** -0.5
    qb = q.reshape(bsz, nb, Q_BLOCK, h, dq).transpose(1, 0, 2, 3, 4)

    def one_block(qi):
        s = jnp.einsum('bqhd,bshd->bhqs', qi, k, preferred_element_type=F32) * scale
        p = jax.nn.softmax(s, axis=-1)
        return jnp.einsum('bhqs,bshd->bqhd', p.astype(v.dtype), v)

    o = lax.map(one_block, qb)
    return o.transpose(1, 0, 2, 3, 4).reshape(bsz, t_len, h, v.shape[-1])


def trunk_layer(x, cond, p, gdn_s0, hgrn_s0, rope, ctx_ckv, ctx_kr):
    bsz, t_len, _ = x.shape
    mod = (jax.nn.silu(cond) @ p['w_ada'] + p['b_ada'])[:, None, :]
    sh1, sc1, gt1, sh2, sc2, gt2 = jnp.split(mod, 6, axis=-1)
    h = rmsnorm(x, p['g_pre_mix']) * (1.0 + sc1) + sh1
    (gq, gk, gv, gz, ga, gb, hq, hi, hf, hg, mcq, mckv, mkr) = _split(h @ p['w_in'], IN_SIZES)
    o_gdn, gsf, gsb = gdn_mixer(gq, gk, gv, gz, ga, gb, p['gdn_conv_w'], p['gdn_a_log'],
                                p['gdn_dt_bias'], p['gdn_norm_w'], gdn_s0[:, 0], gdn_s0[:, 1])
    o_hg, hsf, hsb = hgrn_mixer(hq, hi, hf, hg, p['hgrn_lb'], p['hgrn_norm_w'],
                                hgrn_s0[:, 0], hgrn_s0[:, 1])
    q = (rmsnorm(mcq, p['mla_q_norm_w']) @ p['mla_w_uq']).reshape(bsz, t_len, MLA_HEADS, MLA_QK)
    c_kv = rmsnorm(mckv, p['mla_kv_norm_w'])
    if rope is None:
        k, v = mla_keys(c_kv, mkr, p['mla_w_ukv'])
    else:
        cos, sin = rope
        q = jnp.concatenate([q[..., :MLA_NOPE],
                             apply_rope(q[..., MLA_NOPE:], cos[:, None], sin[:, None])], axis=-1)
        k_lat, v_lat = mla_keys(c_kv, apply_rope(mkr, cos, sin), p['mla_w_ukv'])
        k_ctx, v_ctx = mla_keys(ctx_ckv, ctx_kr, p['mla_w_ukv'])
        k = jnp.concatenate([k_lat, k_ctx], axis=1)
        v = jnp.concatenate([v_lat, v_ctx], axis=1)
    o_mla = blocked_attention(q, k, v).reshape(bsz, t_len, MLA_W)
    mix = jnp.concatenate([o_gdn.astype(x.dtype), o_hg.astype(x.dtype), o_mla.astype(x.dtype)], axis=-1)
    x = x + gt1 * rmsnorm(mix @ p['w_out'], p['g_post_mix'])
    h = rmsnorm(x, p['g_pre_ffn']) * (1.0 + sc2) + sh2
    ff_a, ff_b = jnp.split(h @ p['w_ffn_in'], 2, axis=-1)
    x = x + gt2 * rmsnorm((jax.nn.silu(ff_a) * ff_b) @ p['w_ffn_out'], p['g_post_ffn'])
    return x, jnp.stack([gsf, gsb], axis=1), jnp.stack([hsf, hsb], axis=1), c_kv, mkr


def setup_inputs(seed: int = 0) -> dict:
    key = jax.random.key(seed)
    ks = jax.random.split(key, 32)

    def nrm(k, shape, s):
        return jax.random.normal(k, shape, F32) * s

    def gain(k, shape):
        return 1.0 + 0.05 * jax.random.normal(k, shape, F32)

    dt = jnp.exp(jax.random.uniform(ks[18], (DEPTH, 2, GDN_HEADS), F32, math.log(1e-3), math.log(1e-1)))
    return {
        'x_prompt': nrm(ks[0], (BATCH, SEQ, D_MODEL), 1.0),
        'x_sample': nrm(ks[1], (DEC_BATCH, DEC_SEQ, D_MODEL), 1.0),
        'cache_mla_ckv': nrm(ks[2], (DEC_BATCH, DEPTH, PAST_LEN, MLA_KV_RANK), 1.0),
        'cache_mla_krope': nrm(ks[3], (DEC_BATCH, DEPTH, PAST_LEN, MLA_ROPE), 1.0),
        'state_gdn': nrm(ks[4], (DEC_BATCH, DEPTH, 2, GDN_HEADS, GDN_DK, GDN_DV), 0.3),
        'state_hgrn': nrm(ks[5], (DEC_BATCH, DEPTH, 2, HG_HEADS, HG_DK, HG_DV), 0.5),
        'c': nrm(ks[6], (DEC_BATCH, D_MODEL), 1.0),
        'c_ctx': nrm(ks[7], (D_MODEL,), 1.0),
        'w_ada': nrm(ks[8], (DEPTH, D_MODEL, 6 * D_MODEL), 0.5 * D_MODEL ** -0.5),
        'b_ada': nrm(ks[9], (DEPTH, 6 * D_MODEL), 0.02),
        'g_pre_mix': gain(ks[10], (DEPTH, D_MODEL)),
        'g_post_mix': gain(ks[11], (DEPTH, D_MODEL)),
        'g_pre_ffn': gain(ks[12], (DEPTH, D_MODEL)),
        'g_post_ffn': gain(ks[13], (DEPTH, D_MODEL)),
        'w_in': nrm(ks[14], (DEPTH, D_MODEL, IN_DIM), D_MODEL ** -0.5),
        'w_out': nrm(ks[15], (DEPTH, MIX_W, D_MODEL), MIX_W ** -0.5),
        'gdn_conv_w': nrm(ks[16], (DEPTH, GDN_CONV_CH, GDN_CONV), GDN_CONV ** -0.5),
        'gdn_a_log': jnp.log(jax.random.uniform(ks[17], (DEPTH, 2, GDN_HEADS), F32, 1.0, 16.0)),
        'gdn_dt_bias': dt + jnp.log(-jnp.expm1(-dt)),
        'gdn_norm_w': gain(ks[19], (DEPTH, GDN_DV)),
        'hgrn_lb': nrm(ks[20], (DEPTH, HG_QK), 1.0),
        'hgrn_norm_w': gain(ks[21], (DEPTH, HG_DV)),
        'mla_q_norm_w': gain(ks[22], (DEPTH, MLA_Q_RANK)),
        'mla_w_uq': nrm(ks[23], (DEPTH, MLA_Q_RANK, MLA_HEADS * MLA_QK), MLA_Q_RANK ** -0.5),
        'mla_kv_norm_w': gain(ks[24], (DEPTH, MLA_KV_RANK)),
        'mla_w_ukv': nrm(ks[25], (DEPTH, MLA_KV_RANK, MLA_HEADS * (MLA_NOPE + MLA_DV)), MLA_KV_RANK ** -0.5),
        'w_ffn_in': nrm(ks[26], (DEPTH, D_MODEL, 2 * D_FF), D_MODEL ** -0.5),
        'w_ffn_out': nrm(ks[27], (DEPTH, D_FF, D_MODEL), D_FF ** -0.5),
    }


def reference(x_prompt, x_sample, cache_mla_ckv, cache_mla_krope, state_gdn, state_hgrn, c, c_ctx,
              w_ada, b_ada, g_pre_mix, g_post_mix, g_pre_ffn, g_post_ffn, w_in, w_out,
              gdn_conv_w, gdn_a_log, gdn_dt_bias, gdn_norm_w, hgrn_lb, hgrn_norm_w,
              mla_q_norm_w, mla_w_uq, mla_kv_norm_w, mla_w_ukv, w_ffn_in, w_ffn_out):
    gamma = jax.nn.softmax(hgrn_lb.astype(F32), axis=0)
    lower_bounds = jnp.cumsum(gamma, axis=0) - gamma[0:1]

    def layer_params(l):
        return {'w_ada': w_ada[l], 'b_ada': b_ada[l], 'g_pre_mix': g_pre_mix[l],
                'g_post_mix': g_post_mix[l], 'g_pre_ffn': g_pre_ffn[l], 'g_post_ffn': g_post_ffn[l],
                'w_in': w_in[l], 'w_out': w_out[l], 'gdn_conv_w': gdn_conv_w[l],
                'gdn_a_log': gdn_a_log[l], 'gdn_dt_bias': gdn_dt_bias[l], 'gdn_norm_w': gdn_norm_w[l],
                'hgrn_lb': lower_bounds[l], 'hgrn_norm_w': hgrn_norm_w[l],
                'mla_q_norm_w': mla_q_norm_w[l], 'mla_w_uq': mla_w_uq[l],
                'mla_kv_norm_w': mla_kv_norm_w[l], 'mla_w_ukv': mla_w_ukv[l],
                'w_ffn_in': w_ffn_in[l], 'w_ffn_out': w_ffn_out[l]}

    bp = x_prompt.shape[0]
    zero_gdn = jnp.zeros((bp, 2, GDN_HEADS, GDN_DK, GDN_DV), F32)
    zero_hg = jnp.zeros((bp, 2, HG_HEADS, HG_DK, HG_DV), F32)
    xp = x_prompt
    ckv_list, kr_list, gdn_list, hg_list = [], [], [], []
    for l in range(DEPTH):
        xp, s_g, s_h, ckv_l, kr_l = trunk_layer(xp, c_ctx[None, :], layer_params(l),
                                                zero_gdn, zero_hg, None, None, None)
        ckv_list.append(ckv_l)
        kr_list.append(kr_l)
        gdn_list.append(s_g)
        hg_list.append(s_h)
    new_mla_ckv = jnp.stack(ckv_list, axis=1).astype(x_prompt.dtype)
    new_mla_krope = jnp.stack(kr_list, axis=1).astype(x_prompt.dtype)
    new_state_gdn = jnp.stack(gdn_list, axis=1).astype(x_prompt.dtype)
    new_state_hgrn = jnp.stack(hg_list, axis=1).astype(x_prompt.dtype)

    rope = axial_rope(x_sample.shape[1])
    xs = x_sample
    for l in range(DEPTH):
        xs, _, _, _, _ = trunk_layer(xs, c, layer_params(l), state_gdn[:, l], state_hgrn[:, l],
                                     rope, cache_mla_ckv[:, l], cache_mla_krope[:, l])

    return (xp, xs, new_mla_ckv, new_mla_krope, new_state_gdn, new_state_hgrn)
```

```cpp
#include <hip/hip_runtime.h>
#include <hip/hip_cooperative_groups.h>
#include <cstdio>
namespace cg = cooperative_groups;

typedef unsigned short u16;
using bf16x8 = __attribute__((ext_vector_type(8))) short;
using f32x4  = __attribute__((ext_vector_type(4))) float;

#define T_CTX 4096
#define T_ALL 36864
#define PW 3072
#define DFF 2816
#define LDS_BYTES 69632
#define NTHR 256

#define P_GQKV 0
#define P_GZ 768
#define P_HQ 1024
#define P_HI 1280
#define P_HF 1536
#define P_HG 2048
#define P_MCQ 2304
#define P_MCKV 2688
#define P_MKR 2944
#define P_GA 3008

struct Params {
  const float *x_prompt, *x_sample, *cache_ckv, *cache_kr, *state_gdn, *state_hgrn, *c, *c_ctx;
  const float *w_ada, *b_ada, *g_pre_mix, *g_post_mix, *g_pre_ffn, *g_post_ffn, *w_in, *w_out;
  const float *gdn_conv_w, *gdn_a_log, *gdn_dt_bias, *gdn_norm_w, *hgrn_lb, *hgrn_norm_w;
  const float *mla_q_norm_w, *mla_w_uq, *mla_kv_norm_w, *mla_w_ukv, *w_ffn_in, *w_ffn_out;
  float* out;
  u16 *WinT, *WuqT, *WukvT, *WoutT, *WfiT, *WfoT;
  float* mod;
  u16 *HQ, *P, *KN, *VTL, *VTC, *CKVC, *KRC, *MIX;
  float* GAB;
  unsigned* counters;
};

#define OUT_CKV   37748736
#define OUT_KR    39845888
#define OUT_SGDN  40370176
#define OUT_SHG   41418752

__device__ __forceinline__ u16 f2bf(float f) {
  unsigned u = __float_as_uint(f);
  u += 0x7fffu + ((u >> 16) & 1u);
  return (u16)(u >> 16);
}
__device__ __forceinline__ float bf2f(u16 h) { return __uint_as_float(((unsigned)h) << 16); }
__device__ __forceinline__ float wave_sum(float v) {
#pragma unroll
  for (int o = 32; o > 0; o >>= 1) v += __shfl_xor(v, o);
  return v;
}
__device__ __forceinline__ float sigmoidf_(float x) { return 1.f / (1.f + __expf(-x)); }
__device__ __forceinline__ float siluf_(float x) { return x / (1.f + __expf(-x)); }
__device__ __forceinline__ int tid_l() { int t = threadIdx.x; asm volatile("" : "+v"(t)); return t; }
__device__ __forceinline__ int tok_mod(int t) { return t < T_CTX ? 0 : 1 + ((t - T_CTX) >> 12); }

__device__ __forceinline__ int map_col(int kind, int j) {
  if (kind == 0) return j;
  if (kind == 1) { if (j < 1024) return j; if (j < 3008) return j + 16; if (j < 3024) return 1024 + (j - 3008); return -1; }
  int blk = j >> 6, w = j & 63;
  return w < 32 ? blk * 32 + w : DFF + blk * 32 + (w - 32);
}

__device__ __forceinline__ void cvt_tile(const float* __restrict__ src, int K, int Nsrc, u16* __restrict__ dst, int kind, int jt, int kt, float* sm) {
  const int tid = tid_l();
  const int j0 = jt * 64, k0 = kt * 64;
  __syncthreads();
  {
    int jj = tid & 63, kk0 = tid >> 6;
    int sc = map_col(kind, j0 + jj);
    for (int kk = kk0; kk < 64; kk += 4)
      sm[kk * 65 + jj] = sc >= 0 ? src[(size_t)(k0 + kk) * Nsrc + sc] : 0.f;
  }
  __syncthreads();
  {
    int kk = tid & 63, jj0 = tid >> 6;
    for (int jj = jj0; jj < 64; jj += 4)
      dst[(size_t)(j0 + jj) * K + k0 + kk] = f2bf(sm[kk * 65 + jj]);
  }
}

__device__ __forceinline__ void mod_item(const Params& p, int item, float* sm) {
  const int l = item / 96, j0 = (item % 96) * 64;
  const int tid = tid_l();
  float* sC = sm;
  float* sR = sm + 9 * 1024;
  __syncthreads();
  for (int i = tid; i < 9 * 1024; i += NTHR) {
    int m = i >> 10, k = i & 1023;
    float v = m == 0 ? p.c_ctx[k] : p.c[(m - 1) * 1024 + k];
    sC[i] = siluf_(v);
  }
  __syncthreads();
  const int col = tid & 63, ks = tid >> 6;
  float acc[9];
#pragma unroll
  for (int m = 0; m < 9; ++m) acc[m] = 0.f;
  const float* wp = p.w_ada + (size_t)l * 1024 * 6144 + j0 + col;
  for (int k = ks * 256; k < ks * 256 + 256; ++k) {
    float w = wp[(size_t)k * 6144];
#pragma unroll
    for (int m = 0; m < 9; ++m) acc[m] += sC[m * 1024 + k] * w;
  }
#pragma unroll
  for (int m = 0; m < 9; ++m) sR[(ks * 9 + m) * 64 + col] = acc[m];
  __syncthreads();
  for (int i = tid; i < 9 * 64; i += NTHR) {
    int m = i >> 6, cc = i & 63;
    float v = sR[(0 * 9 + m) * 64 + cc] + sR[(1 * 9 + m) * 64 + cc] + sR[(2 * 9 + m) * 64 + cc] + sR[(3 * 9 + m) * 64 + cc];
    p.mod[((size_t)l * 9 + m) * 6144 + j0 + cc] = v + p.b_ada[l * 6144 + j0 + cc];
  }
}

__device__ __forceinline__ void phase0(const Params& p, float* sm) {
  const int PER_LAYER = 3272;
  const int total = 2 * PER_LAYER + 192;
  for (int item = blockIdx.x; item < total; item += gridDim.x) {
    if (item < 192) { mod_item(p, item, sm); continue; }
    int it = item - 192;
    int l = it / PER_LAYER, r = it % PER_LAYER;
    if (r < 768) { cvt_tile(p.w_in + (size_t)l * 1024 * 3024, 1024, 3024, p.WinT + (size_t)l * 3072 * 1024, 1, r / 16, r % 16, sm); continue; }
    r -= 768;
    if (r < 72) { cvt_tile(p.mla_w_uq + (size_t)l * 384 * 768, 384, 768, p.WuqT + (size_t)l * 768 * 384, 0, r / 6, r % 6, sm); continue; }
    r -= 72;
    if (r < 64) { cvt_tile(p.mla_w_ukv + (size_t)l * 256 * 1024, 256, 1024, p.WukvT + (size_t)l * 1024 * 256, 0, r / 4, r % 4, sm); continue; }
    r -= 64;
    if (r < 256) { cvt_tile(p.w_out + (size_t)l * 1024 * 1024, 1024, 1024, p.WoutT + (size_t)l * 1024 * 1024, 0, r / 16, r % 16, sm); continue; }
    r -= 256;
    if (r < 1408) { cvt_tile(p.w_ffn_in + (size_t)l * 1024 * 5632, 1024, 5632, p.WfiT + (size_t)l * 5632 * 1024, 2, r / 16, r % 16, sm); continue; }
    r -= 1408;
    cvt_tile(p.w_ffn_out + (size_t)l * 2816 * 1024, 2816, 1024, p.WfoT + (size_t)l * 1024 * 2816, 0, r / 44, r % 44, sm);
  }
}

__device__ __forceinline__ void rowpass_norm(const Params& p, int l, int stage) {
  const int tidl = tid_l();
  const int lane = tidl & 63, w = tidl >> 6;
  const int ln = stage == 0 ? 0 : (stage == 1 ? l : l + 1);
  const int sh_off = stage == 1 ? 3072 : 0;
  const float* gpre = stage == 1 ? p.g_pre_ffn + l * 1024 : p.g_pre_mix + (ln < 2 ? ln : 0) * 1024;
  u16* dst = stage == 1 ? p.MIX : p.HQ;
  for (int t = blockIdx.x * 4 + w; t < T_ALL; t += gridDim.x * 4) {
    const int m = tok_mod(t);
    float x[16];
    float* xo = p.out + (size_t)t * 1024;
    if (stage == 0) {
      const float* xi = t < T_CTX ? p.x_prompt + (size_t)t * 1024 : p.x_sample + (size_t)(t - T_CTX) * 1024;
#pragma unroll
      for (int i = 0; i < 4; ++i) {
        float4 v = *(const float4*)(xi + i * 256 + lane * 4);
        x[i * 4 + 0] = v.x; x[i * 4 + 1] = v.y; x[i * 4 + 2] = v.z; x[i * 4 + 3] = v.w;
      }
    } else {
      const u16* yp = p.HQ + (size_t)t * 1024;
      float y[16]; float ss = 0.f;
#pragma unroll
      for (int i = 0; i < 4; ++i) {
        uint2 v = *(const uint2*)(yp + i * 256 + lane * 4);
        y[i * 4 + 0] = bf2f((u16)(v.x & 0xffff)); y[i * 4 + 1] = bf2f((u16)(v.x >> 16));
        y[i * 4 + 2] = bf2f((u16)(v.y & 0xffff)); y[i * 4 + 3] = bf2f((u16)(v.y >> 16));
      }
#pragma unroll
      for (int i = 0; i < 16; ++i) ss += y[i] * y[i];
      ss = wave_sum(ss);
      const float rstd = rsqrtf(ss * (1.f / 1024.f) + 1e-6f);
      const float* gpost = (stage == 1 ? p.g_post_mix : p.g_post_ffn) + l * 1024;
      const float* gt = p.mod + ((size_t)l * 9 + m) * 6144 + (stage == 1 ? 2048 : 5120);
#pragma unroll
      for (int i = 0; i < 4; ++i) {
        float4 xv = *(const float4*)(xo + i * 256 + lane * 4);
        float4 gp = *(const float4*)(gpost + i * 256 + lane * 4);
        float4 gg = *(const float4*)(gt + i * 256 + lane * 4);
        x[i * 4 + 0] = xv.x + gg.x * y[i * 4 + 0] * rstd * gp.x;
        x[i * 4 + 1] = xv.y + gg.y * y[i * 4 + 1] * rstd * gp.y;
        x[i * 4 + 2] = xv.z + gg.z * y[i * 4 + 2] * rstd * gp.z;
        x[i * 4 + 3] = xv.w + gg.w * y[i * 4 + 3] * rstd * gp.w;
      }
    }
    __threadfence_block();
#pragma unroll
    for (int i = 0; i < 4; ++i)
      *(float4*)(xo + i * 256 + lane * 4) = make_float4(x[i * 4 + 0], x[i * 4 + 1], x[i * 4 + 2], x[i * 4 + 3]);
    if (ln >= 2) continue;
    float ss = 0.f;
#pragma unroll
    for (int i = 0; i < 16; ++i) ss += x[i] * x[i];
    ss = wave_sum(ss);
    const float rstd = rsqrtf(ss * (1.f / 1024.f) + 1e-6f);
    const float* sh = p.mod + ((size_t)ln * 9 + m) * 6144 + sh_off;
    const float* sc = sh + 1024;
    u16* hp = dst + (size_t)t * 1024;
#pragma unroll
    for (int i = 0; i < 4; ++i) {
      float4 gp = *(const float4*)(gpre + i * 256 + lane * 4);
      float4 s1 = *(const float4*)(sh + i * 256 + lane * 4);
      float4 c1 = *(const float4*)(sc + i * 256 + lane * 4);
      float h0 = x[i * 4 + 0] * rstd * gp.x * (1.f + c1.x) + s1.x;
      float h1 = x[i * 4 + 1] * rstd * gp.y * (1.f + c1.y) + s1.y;
      float h2 = x[i * 4 + 2] * rstd * gp.z * (1.f + c1.z) + s1.z;
      float h3 = x[i * 4 + 3] * rstd * gp.w * (1.f + c1.w) + s1.w;
      uint2 o;
      o.x = (unsigned)f2bf(h0) | ((unsigned)f2bf(h1) << 16);
      o.y = (unsigned)f2bf(h2) | ((unsigned)f2bf(h3) << 16);
      *(uint2*)(hp + i * 256 + lane * 4) = o;
    }
  }
}

__device__ __forceinline__ void rowpass_b0(const Params& p, int l) {
  const int tidl = tid_l();
  const int lane = tidl & 63, w = tidl >> 6;
  for (int t = blockIdx.x * 4 + w; t < T_ALL + 2048; t += gridDim.x * 4) {
    if (t >= T_ALL) {
      int r = t - T_ALL, b = r >> 8, s = r & 255;
      const float* ck = p.cache_ckv + (((size_t)b * 2 + l) * 256 + s) * 256;
      const float* kr = p.cache_kr + (((size_t)b * 2 + l) * 256 + s) * 64;
#pragma unroll
      for (int i = 0; i < 4; ++i) p.CKVC[(size_t)r * 256 + lane + 64 * i] = f2bf(ck[lane + 64 * i]);
      p.KRC[(size_t)r * 64 + lane] = f2bf(kr[lane]);
      continue;
    }
    u16* pr = p.P + (size_t)t * PW;
    {
      float v[6]; float ss = 0.f;
#pragma unroll
      for (int i = 0; i < 6; ++i) { v[i] = bf2f(pr[P_MCQ + lane + 64 * i]); ss += v[i] * v[i]; }
      ss = wave_sum(ss);
      float rstd = rsqrtf(ss * (1.f / 384.f) + 1e-6f);
#pragma unroll
      for (int i = 0; i < 6; ++i) pr[P_MCQ + lane + 64 * i] = f2bf(v[i] * rstd * p.mla_q_norm_w[l * 384 + lane + 64 * i]);
    }
    {
      float v[4]; float ss = 0.f;
#pragma unroll
      for (int i = 0; i < 4; ++i) { v[i] = bf2f(pr[P_MCKV + lane + 64 * i]); ss += v[i] * v[i]; }
      ss = wave_sum(ss);
      float rstd = rsqrtf(ss * (1.f / 256.f) + 1e-6f);
#pragma unroll
      for (int i = 0; i < 4; ++i) {
        float c = v[i] * rstd * p.mla_kv_norm_w[l * 256 + lane + 64 * i];
        pr[P_MCKV + lane + 64 * i] = f2bf(c);
        if (t < T_CTX) {
          int b = t >> 8, s = t & 255;
          p.out[OUT_CKV + (((size_t)b * 2 + l) * 256 + s) * 256 + lane + 64 * i] = c;
        }
      }
    }
    {
      float v = bf2f(pr[P_MKR + lane]);
      if (t < T_CTX) {
        int b = t >> 8, s = t & 255;
        p.out[OUT_KR + (((size_t)b * 2 + l) * 256 + s) * 64 + lane] = v;
      } else {
        int pos = (t - T_CTX) & 4095;
        int axis = lane >> 5, half = (lane >> 4) & 1, f = lane & 15;
        float posf = axis == 0 ? (float)(pos >> 6) : (float)(pos & 63);
        float inv = exp2f(-(float)f * (13.287712379549449f / 16.f));
        float ang = posf * inv;
        float sn, cs;
        __sincosf(ang, &sn, &cs);
        float other = __shfl_xor(v, 16);
        float o = half == 0 ? v * cs - other * sn : v * cs + other * sn;
        pr[P_MKR + lane] = f2bf(o);
      }
    }
  }
}

__device__ __forceinline__ void rowpass_c2(const Params& p, int l) {
  const int tidl = tid_l();
  const int lane = tidl & 63, w = tidl >> 6;
  for (int t = blockIdx.x * 4 + w; t < T_ALL; t += gridDim.x * 4) {
    u16* mr = p.MIX + (size_t)t * 1024;
    const u16* pr = p.P + (size_t)t * PW;
    const u16* qr = p.HQ + (size_t)t * 768;
    float og[4], oh[4];
#pragma unroll
    for (int h = 0; h < 4; ++h) {
      og[h] = bf2f(mr[h * 64 + lane]) + bf2f(mr[256 + h * 64 + lane]);
      oh[h] = bf2f(mr[512 + h * 64 + lane]) + bf2f(mr[768 + h * 64 + lane]);
    }
    u16 om[8];
#pragma unroll
    for (int i = 0; i < 8; ++i) { int c = lane + 64 * i; om[i] = qr[(c >> 7) * 192 + (c & 127)]; }
    float zg[4], gg[4];
#pragma unroll
    for (int h = 0; h < 4; ++h) { zg[h] = bf2f(pr[P_GZ + h * 64 + lane]); gg[h] = bf2f(pr[P_HG + h * 64 + lane]); }
    float rg[4], rh[4];
#pragma unroll
    for (int h = 0; h < 4; ++h) {
      rg[h] = rsqrtf(wave_sum(og[h] * og[h]) * (1.f / 64.f) + 1e-6f);
      rh[h] = rsqrtf(wave_sum(oh[h] * oh[h]) * (1.f / 64.f) + 1e-6f);
    }
    __threadfence_block();
    const float wg = p.gdn_norm_w[l * 64 + lane], wh = p.hgrn_norm_w[l * 64 + lane];
#pragma unroll
    for (int h = 0; h < 4; ++h) {
      mr[h * 64 + lane] = f2bf(og[h] * rg[h] * wg * siluf_(zg[h]));
      mr[256 + h * 64 + lane] = f2bf(oh[h] * rh[h] * wh * sigmoidf_(gg[h]));
    }
#pragma unroll
    for (int i = 0; i < 8; ++i) mr[512 + lane + 64 * i] = om[i];
  }
}

__device__ __forceinline__ void gemm128(const u16* __restrict__ A, int lda, const u16* __restrict__ B, int ldb, int K,
                                        u16* lds, f32x4 (&acc)[4][4]) {
  u16* sA = lds;
  u16* sB = lds + 128 * 72;
  const int tid = tid_l(), lane = tid & 63, w = tid >> 6, wm = w >> 1, wn = w & 1;
  const int r16 = lane & 15, g4 = lane >> 4;
#pragma unroll
  for (int i = 0; i < 4; ++i)
#pragma unroll
    for (int j = 0; j < 4; ++j) acc[i][j] = f32x4{0.f, 0.f, 0.f, 0.f};
  const int lrow = tid >> 3, lkc = tid & 7;
  const u16* ap = A + (size_t)lrow * lda + lkc * 8;
  const u16* bp = B + (size_t)lrow * ldb + lkc * 8;
  const size_t sa32 = (size_t)32 * lda, sb32 = (size_t)32 * ldb;
  uint4 ra0 = *(const uint4*)(ap), ra1 = *(const uint4*)(ap + sa32), ra2 = *(const uint4*)(ap + 2 * sa32), ra3 = *(const uint4*)(ap + 3 * sa32);
  uint4 rb0 = *(const uint4*)(bp), rb1 = *(const uint4*)(bp + sb32), rb2 = *(const uint4*)(bp + 2 * sb32), rb3 = *(const uint4*)(bp + 3 * sb32);
  u16* wa = sA + lrow * 72 + lkc * 8;
  u16* wb = sB + lrow * 72 + lkc * 8;
  const u16* fa = sA + (wm * 64 + r16) * 72 + g4 * 8;
  const u16* fb = sB + (wn * 64 + r16) * 72 + g4 * 8;
  for (int k0 = 0; k0 < K; k0 += 64) {
    __syncthreads();
    *(uint4*)(wa) = ra0; *(uint4*)(wa + 32 * 72) = ra1; *(uint4*)(wa + 64 * 72) = ra2; *(uint4*)(wa + 96 * 72) = ra3;
    *(uint4*)(wb) = rb0; *(uint4*)(wb + 32 * 72) = rb1; *(uint4*)(wb + 64 * 72) = rb2; *(uint4*)(wb + 96 * 72) = rb3;
    __syncthreads();
    if (k0 + 64 < K) {
      const u16* a2 = ap + k0 + 64;
      const u16* b2 = bp + k0 + 64;
      ra0 = *(const uint4*)(a2); ra1 = *(const uint4*)(a2 + sa32); ra2 = *(const uint4*)(a2 + 2 * sa32); ra3 = *(const uint4*)(a2 + 3 * sa32);
      rb0 = *(const uint4*)(b2); rb1 = *(const uint4*)(b2 + sb32); rb2 = *(const uint4*)(b2 + 2 * sb32); rb3 = *(const uint4*)(b2 + 3 * sb32);
    }
#pragma unroll
    for (int ks = 0; ks < 2; ++ks) {
      bf16x8 af0 = *(const bf16x8*)(fa + ks * 32), af1 = *(const bf16x8*)(fa + 16 * 72 + ks * 32);
      bf16x8 af2 = *(const bf16x8*)(fa + 32 * 72 + ks * 32), af3 = *(const bf16x8*)(fa + 48 * 72 + ks * 32);
#pragma unroll
      for (int j = 0; j < 4; ++j) {
        bf16x8 bfj = *(const bf16x8*)(fb + j * 16 * 72 + ks * 32);
        acc[0][j] = __builtin_amdgcn_mfma_f32_16x16x32_bf16(af0, bfj, acc[0][j], 0, 0, 0);
        acc[1][j] = __builtin_amdgcn_mfma_f32_16x16x32_bf16(af1, bfj, acc[1][j], 0, 0, 0);
        acc[2][j] = __builtin_amdgcn_mfma_f32_16x16x32_bf16(af2, bfj, acc[2][j], 0, 0, 0);
        acc[3][j] = __builtin_amdgcn_mfma_f32_16x16x32_bf16(af3, bfj, acc[3][j], 0, 0, 0);
      }
    }
  }
}
#define GEMM_RC const int tde = tid_l(); const int rb = ((tde >> 6) >> 1) * 64 + ((tde & 63) >> 4) * 4, cb = ((tde >> 6) & 1) * 64 + (tde & 15);

__device__ __forceinline__ void phase_a(const Params& p, int l, u16* lds) {
  const int ntn = 24, total = 288 * ntn;
  const u16* Bw = p.WinT + (size_t)l * 3072 * 1024;
  for (int item = blockIdx.x; item < total; item += gridDim.x) {
    const int mt = item / ntn, nt = item % ntn;
    const int m0 = mt * 128, n0 = nt * 128;
    f32x4 acc[4][4];
    gemm128(p.HQ + (size_t)m0 * 1024, 1024, Bw + (size_t)n0 * 1024, 1024, 1024, lds, acc);
    { GEMM_RC
#pragma unroll
              for (int mi = 0; mi < 4; ++mi)
#pragma unroll
                for (int ni = 0; ni < 4; ++ni) {
                  const int col = n0 + cb + ni * 16;
#pragma unroll
                  for (int j = 0; j < 4; ++j) {
                    const int row = m0 + rb + mi * 16 + j;
                    p.P[(size_t)row * PW + col] = f2bf(acc[mi][ni][j]);
                    if (col >= P_GA && col < P_GA + 16) p.GAB[(size_t)row * 16 + (col - P_GA)] = acc[mi][ni][j];
                  }
                }
            }
  }
}

__device__ __forceinline__ void phase_b1(const Params& p, int l, u16* lds) {
  const int nq = 288 * 6, nkv = 304 * 8;
  for (int item = blockIdx.x; item < nq + nkv; item += gridDim.x) {
    if (item < nq) {
      const int mt = item / 6, nt = item % 6;
      const int m0 = mt * 128, n0 = nt * 128;
      const float qscale = 0.07216878364870322f * 1.4426950408889634f;
      f32x4 acc[4][4];
    gemm128(p.P + (size_t)m0 * PW + P_MCQ, PW, p.WuqT + (size_t)l * 768 * 384 + (size_t)n0 * 384, 384, 384, lds, acc);
    { GEMM_RC
                const int lane = tde & 63;
                const int cw0 = n0 + cb - (lane & 15);
                const bool ropew = ((cw0 >> 6) % 3) == 2 && m0 >= T_CTX;
                const int f = lane & 15;
                const float inv = exp2f(-(float)f * (13.287712379549449f / 16.f));
#pragma unroll
                for (int mi = 0; mi < 4; ++mi)
#pragma unroll
                  for (int j = 0; j < 4; ++j) {
                    const int row = m0 + rb + mi * 16 + j;
                    float v0 = acc[mi][0][j], v1 = acc[mi][1][j], v2 = acc[mi][2][j], v3 = acc[mi][3][j];
                    if (ropew) {
                      const int pos = (row - T_CTX) & 4095;
                      float s0, c0, s1, c1;
                      __sincosf((float)(pos >> 6) * inv, &s0, &c0);
                      __sincosf((float)(pos & 63) * inv, &s1, &c1);
                      float a0 = v0 * c0 - v1 * s0, a1 = v1 * c0 + v0 * s0;
                      float b0 = v2 * c1 - v3 * s1, b1 = v3 * c1 + v2 * s1;
                      v0 = a0; v1 = a1; v2 = b0; v3 = b1;
                    }
                    u16* qp = p.HQ + (size_t)row * 768 + n0 + cb;
                    qp[0] = f2bf(v0 * qscale); qp[16] = f2bf(v1 * qscale); qp[32] = f2bf(v2 * qscale); qp[48] = f2bf(v3 * qscale);
                  }
              }
    } else {
      const int it = item - nq;
      const int mt = it / 8, nt = it % 8;
      const int m0 = mt * 128, n0 = nt * 128;
      const u16* Ap; int lda;
      if (mt < 288) { Ap = p.P + (size_t)m0 * PW + P_MCKV; lda = PW; }
      else { Ap = p.CKVC + (size_t)(m0 - T_ALL) * 256; lda = 256; }
      f32x4 acc[4][4];
    gemm128(Ap, lda, p.WukvT + (size_t)l * 1024 * 256 + (size_t)n0 * 256, 256, 256, lds, acc);
    { GEMM_RC
#pragma unroll
                for (int mi = 0; mi < 4; ++mi)
#pragma unroll
                  for (int ni = 0; ni < 4; ++ni) {
                    const int col = n0 + cb + ni * 16;
                    const int h = col >> 8, wi = col & 255;
                    const int row0 = m0 + rb + mi * 16;
                    if (wi < 128) {
#pragma unroll
                      for (int j = 0; j < 4; ++j) p.KN[(size_t)(row0 + j) * 512 + h * 128 + wi] = f2bf(acc[mi][ni][j]);
                    } else {
                      const int dv = wi - 128;
                      u16* dst;
                      if (row0 < T_CTX) { int b = row0 >> 8, pos = row0 & 255; dst = p.VTC + ((size_t)(b * 4 + h) * 128 + dv) * 256 + pos; }
                      else if (row0 < T_ALL) { int b = (row0 - T_CTX) >> 12, pos = (row0 - T_CTX) & 4095; dst = p.VTL + ((size_t)(b * 4 + h) * 128 + dv) * 4352 + pos; }
                      else { int b = (row0 - T_ALL) >> 8, pos = 4096 + ((row0 - T_ALL) & 255); dst = p.VTL + ((size_t)(b * 4 + h) * 128 + dv) * 4352 + pos; }
                      uint2 o;
                      o.x = (unsigned)f2bf(acc[mi][ni][0]) | ((unsigned)f2bf(acc[mi][ni][1]) << 16);
                      o.y = (unsigned)f2bf(acc[mi][ni][2]) | ((unsigned)f2bf(acc[mi][ni][3]) << 16);
                      *(uint2*)dst = o;
                    }
                  }
              }
    }
  }
}

__device__ __forceinline__ void phase_gemm_y(const u16* A, int lda, const u16* B, int K, int N, u16* Y, int ldy, u16* lds) {
  const int ntn = N / 128, total = 288 * ntn;
  for (int item = blockIdx.x; item < total; item += gridDim.x) {
    const int mt = item / ntn, nt = item % ntn;
    const int m0 = mt * 128, n0 = nt * 128;
    f32x4 acc[4][4];
    gemm128(A + (size_t)m0 * lda, lda, B + (size_t)n0 * K, K, K, lds, acc);
    { GEMM_RC
#pragma unroll
              for (int mi = 0; mi < 4; ++mi)
#pragma unroll
                for (int ni = 0; ni < 4; ++ni)
#pragma unroll
                  for (int j = 0; j < 4; ++j)
                    Y[(size_t)(m0 + rb + mi * 16 + j) * ldy + n0 + cb + ni * 16] = f2bf(acc[mi][ni][j]);
            }
  }
}

__device__ __forceinline__ void phase_e(const Params& p, int l, u16* lds) {
  const int ntn = 44, total = 288 * ntn;
  const u16* Bw = p.WfiT + (size_t)l * 5632 * 1024;
  for (int item = blockIdx.x; item < total; item += gridDim.x) {
    const int mt = item / ntn, nt = item % ntn;
    const int m0 = mt * 128, n0 = nt * 128;
    f32x4 acc[4][4];
    gemm128(p.MIX + (size_t)m0 * 1024, 1024, Bw + (size_t)n0 * 1024, 1024, 1024, lds, acc);
    { GEMM_RC
              const int r16 = tde & 15;
              const int hc0 = ((n0 + cb - r16) >> 1) + r16;
#pragma unroll
              for (int mi = 0; mi < 4; ++mi)
#pragma unroll
                for (int ni = 0; ni < 2; ++ni)
#pragma unroll
                  for (int j = 0; j < 4; ++j) {
                    float a = acc[mi][ni][j], b = acc[mi][ni + 2][j];
                    p.P[(size_t)(m0 + rb + mi * 16 + j) * DFF + hc0 + ni * 16] = f2bf(siluf_(a) * b);
                  }
            }
  }
}

__device__ __forceinline__ void attn_item(const Params& p, int latent, int b, int h, int qb, unsigned char* smraw) {
  u16* sK = (u16*)smraw;
  u16* sV = sK + 64 * 200;
  u16* sP = sV + 128 * 72;
  const int tid = tid_l(), lane = tid & 63, w = tid >> 6, r16 = lane & 15, g4 = lane >> 4;
  const int nkeys = latent ? 4352 : 256;
  const int krow0 = latent ? T_CTX + b * 4096 : b * 256;
  const int tq0 = krow0 + qb * 128;
  const u16* vt = latent ? p.VTL + (size_t)((b * 4 + h) * 128) * 4352 : p.VTC + (size_t)((b * 4 + h) * 128) * 256;
  u16* sPw = sP + w * 32 * 72;
  bf16x8 q[2][6];
#pragma unroll
  for (int mi = 0; mi < 2; ++mi)
#pragma unroll
    for (int ks = 0; ks < 6; ++ks)
      q[mi][ks] = *(const bf16x8*)(p.HQ + (size_t)(tq0 + w * 32 + mi * 16 + r16) * 768 + h * 192 + ks * 32 + g4 * 8);
  f32x4 o[2][8];
  float mrow[2][4], lrow[2][4];
#pragma unroll
  for (int mi = 0; mi < 2; ++mi) {
#pragma unroll
    for (int nd = 0; nd < 8; ++nd) o[mi][nd] = f32x4{0.f, 0.f, 0.f, 0.f};
#pragma unroll
    for (int r = 0; r < 4; ++r) { mrow[mi][r] = -1e30f; lrow[mi][r] = 0.f; }
  }
  const int lkey = tid >> 2, lpart = tid & 3;
  const int ldv = tid >> 1, lhalf = tid & 1;
  for (int kt = 0; kt < nkeys / 64; ++kt) {
    __syncthreads();
    {
      const int pos = kt * 64 + lkey;
      const bool own = (!latent) || pos < 4096;
      const int row = own ? krow0 + pos : T_ALL + b * 256 + (pos - 4096);
      const u16* srcn = p.KN + (size_t)row * 512 + h * 128 + lpart * 8;
      const u16* srcr = own ? p.P + (size_t)(krow0 + pos) * PW + P_MKR + lpart * 8
                            : p.KRC + (size_t)(b * 256 + pos - 4096) * 64 + lpart * 8;
      u16* dk = sK + lkey * 200 + lpart * 8;
      const uint4 k0 = *(const uint4*)(srcn), k1 = *(const uint4*)(srcn + 32), k2 = *(const uint4*)(srcn + 64), k3 = *(const uint4*)(srcn + 96);
      const uint4 k4 = *(const uint4*)(srcr), k5 = *(const uint4*)(srcr + 32);
      *(uint4*)(dk) = k0; *(uint4*)(dk + 32) = k1; *(uint4*)(dk + 64) = k2; *(uint4*)(dk + 96) = k3;
      *(uint4*)(dk + 128) = k4; *(uint4*)(dk + 160) = k5;
    }
    asm volatile("" ::: "memory");
    {
      const u16* sv = vt + (size_t)ldv * nkeys + kt * 64 + lhalf * 32;
      u16* dvp = sV + ldv * 72 + lhalf * 32;
      const uint4 v0 = *(const uint4*)(sv), v1 = *(const uint4*)(sv + 8), v2 = *(const uint4*)(sv + 16), v3 = *(const uint4*)(sv + 24);
      *(uint4*)(dvp) = v0; *(uint4*)(dvp + 8) = v1; *(uint4*)(dvp + 16) = v2; *(uint4*)(dvp + 24) = v3;
    }
    __syncthreads();
    f32x4 s[2][4];
#pragma unroll
    for (int mi = 0; mi < 2; ++mi)
#pragma unroll
      for (int ni = 0; ni < 4; ++ni) s[mi][ni] = f32x4{0.f, 0.f, 0.f, 0.f};
#pragma unroll
    for (int ks = 0; ks < 6; ++ks)
#pragma unroll
      for (int ni = 0; ni < 4; ++ni) {
        bf16x8 kf = *(const bf16x8*)(sK + (ni * 16 + r16) * 200 + ks * 32 + g4 * 8);
        s[0][ni] = __builtin_amdgcn_mfma_f32_16x16x32_bf16(q[0][ks], kf, s[0][ni], 0, 0, 0);
        s[1][ni] = __builtin_amdgcn_mfma_f32_16x16x32_bf16(q[1][ks], kf, s[1][ni], 0, 0, 0);
      }
#pragma unroll
    for (int mi = 0; mi < 2; ++mi)
#pragma unroll
      for (int r = 0; r < 4; ++r) {
        float mx = fmaxf(fmaxf(s[mi][0][r], s[mi][1][r]), fmaxf(s[mi][2][r], s[mi][3][r]));
        mx = fmaxf(mx, __shfl_xor(mx, 1)); mx = fmaxf(mx, __shfl_xor(mx, 2));
        mx = fmaxf(mx, __shfl_xor(mx, 4)); mx = fmaxf(mx, __shfl_xor(mx, 8));
        const float mnew = fmaxf(mrow[mi][r], mx);
        const float alpha = __builtin_amdgcn_exp2f(mrow[mi][r] - mnew);
        mrow[mi][r] = mnew;
        float ps = 0.f;
#pragma unroll
        for (int ni = 0; ni < 4; ++ni) {
          float pv = __builtin_amdgcn_exp2f(s[mi][ni][r] - mnew);
          ps += pv;
          sPw[(mi * 16 + g4 * 4 + r) * 72 + ni * 16 + r16] = f2bf(pv);
        }
        ps += __shfl_xor(ps, 1); ps += __shfl_xor(ps, 2); ps += __shfl_xor(ps, 4); ps += __shfl_xor(ps, 8);
        lrow[mi][r] = lrow[mi][r] * alpha + ps;
#pragma unroll
        for (int nd = 0; nd < 8; ++nd) o[mi][nd][r] *= alpha;
      }
    __syncthreads();
#pragma unroll
    for (int ks2 = 0; ks2 < 2; ++ks2) {
      bf16x8 pf0 = *(const bf16x8*)(sPw + (0 * 16 + r16) * 72 + ks2 * 32 + g4 * 8);
      bf16x8 pf1 = *(const bf16x8*)(sPw + (1 * 16 + r16) * 72 + ks2 * 32 + g4 * 8);
#pragma unroll
      for (int nd = 0; nd < 8; ++nd) {
        bf16x8 vf = *(const bf16x8*)(sV + (nd * 16 + r16) * 72 + ks2 * 32 + g4 * 8);
        o[0][nd] = __builtin_amdgcn_mfma_f32_16x16x32_bf16(pf0, vf, o[0][nd], 0, 0, 0);
        o[1][nd] = __builtin_amdgcn_mfma_f32_16x16x32_bf16(pf1, vf, o[1][nd], 0, 0, 0);
      }
    }
  }
#pragma unroll
  for (int mi = 0; mi < 2; ++mi)
#pragma unroll
    for (int r = 0; r < 4; ++r) {
      const float inv = 1.f / lrow[mi][r];
      u16* op = p.HQ + (size_t)(tq0 + w * 32 + mi * 16 + g4 * 4 + r) * 768 + h * 192 + r16;
#pragma unroll
      for (int nd = 0; nd < 8; ++nd) op[nd * 16] = f2bf(o[mi][nd][r] * inv);
    }
}

#define MFMA4(a, b, c) __builtin_amdgcn_mfma_f32_16x16x4f32((a), (b), (c), 0, 0, 0)

__device__ __forceinline__ float softplusf_(float x) { return fmaxf(x, 0.f) + log1pf(__expf(-fabsf(x))); }

__device__ __forceinline__ void gdn_chain(const Params& p, int l, int seq, int h, int d, int vs, float* sm) {
  float* sMM = sm;
  float* sK = sMM + 64 * 68;
  float* sW = sK + 64 * 65;
  float* sV = sW + 64 * 65;
  float* sS = sV + 64 * 33;
  float* sGc = sS + 64 * 33;
  float* sBeta = sGc + 64;
  float* sBg = sBeta + 64;
  const int tid = tid_l(), lane = tid & 63, w = tid >> 6, r16 = lane & 15, g4 = lane >> 4;
  const bool latent = seq >= 16;
  const int len = latent ? 4096 : 256;
  const int t0 = latent ? T_CTX + (seq - 16) * 4096 : seq * 256;
  const int nchunks = len >> 6;
  const int c2 = tid % 80, rg = tid / 80;
  const int lc = 2 * c2;
  int gch;
  if (lc < 64) gch = h * 64 + lc; else if (lc < 128) gch = 256 + h * 64 + (lc - 64); else gch = 512 + h * 64 + vs * 32 + (lc - 128);
  float cwa[5], cwb[5];
#pragma unroll
  for (int j = 0; j < 5; ++j) {
    cwa[j] = p.gdn_conv_w[((size_t)l * 768 + gch) * 5 + j];
    cwb[j] = p.gdn_conv_w[((size_t)l * 768 + gch + 1) * 5 + j];
  }
  const float Acoef = -__expf(p.gdn_a_log[l * 8 + d * 4 + h]);
  const float dtb = p.gdn_dt_bias[l * 8 + d * 4 + h];
  f32x4 Sreg[2];
  __syncthreads();
  {
    const float* s0 = latent ? p.state_gdn + ((((size_t)(seq - 16) * 2 + l) * 2 + d) * 4 + h) * 4096 : nullptr;
#pragma unroll
    for (int n = 0; n < 2; ++n)
#pragma unroll
      for (int r = 0; r < 4; ++r) {
        const int kidx = 16 * w + g4 * 4 + r, cc = n * 16 + r16;
        float v = latent ? s0[kidx * 64 + vs * 32 + cc] : 0.f;
        Sreg[n][r] = v;
        sS[kidx * 33 + cc] = v;
      }
  }
  const u16* Pb = p.P + (size_t)t0 * PW;
  for (int n = 0; n < nchunks; ++n) {
    const int tlo = d == 0 ? n * 64 : len - 64 * (n + 1);
    if (tid < 240) {
      const int u0 = rg * 22, u1 = (u0 + 22 < 64) ? u0 + 22 : 64;
      float xa[5], xb[5];
#pragma unroll
      for (int j = 0; j < 4; ++j) {
        const int tau = tlo + u0 - 2 + j;
        unsigned v = (tau >= 0 && tau < len) ? *(const unsigned*)(Pb + (size_t)tau * PW + gch) : 0u;
        xa[j + 1] = bf2f((u16)(v & 0xffff)); xb[j + 1] = bf2f((u16)(v >> 16));
      }
      for (int u = u0; u < u1; ++u) {
#pragma unroll
        for (int j = 0; j < 4; ++j) { xa[j] = xa[j + 1]; xb[j] = xb[j + 1]; }
        const int tau = tlo + u + 2;
        unsigned v = (tau >= 0 && tau < len) ? *(const unsigned*)(Pb + (size_t)tau * PW + gch) : 0u;
        xa[4] = bf2f((u16)(v & 0xffff)); xb[4] = bf2f((u16)(v >> 16));
        float ya = 0.f, yb = 0.f;
#pragma unroll
        for (int j = 0; j < 5; ++j) { ya += cwa[j] * xa[j]; yb += cwb[j] * xb[j]; }
        ya = siluf_(ya); yb = siluf_(yb);
        const int pp = d == 0 ? u : 63 - u;
        if (lc < 64) { sW[pp * 65 + lc] = ya; sW[pp * 65 + lc + 1] = yb; }
        else if (lc < 128) { sK[pp * 65 + lc - 64] = ya; sK[pp * 65 + lc - 63] = yb; }
        else { sV[pp * 33 + lc - 128] = ya; sV[pp * 33 + lc - 127] = yb; }
      }
    }
    if (tid < 64) {
      const int pp = tid, u = d == 0 ? pp : 63 - pp;
      const float* gab = p.GAB + (size_t)(t0 + tlo + u) * 16;
      float g = Acoef * softplusf_(gab[d * 4 + h] + dtb);
      float bt = sigmoidf_(gab[8 + d * 4 + h]);
#pragma unroll
      for (int o = 1; o < 64; o <<= 1) { float tt = __shfl_up(g, o); if (lane >= o) g += tt; }
      sGc[pp] = g; sBeta[pp] = bt; sBg[pp] = bt * __expf(g);
    }
    __syncthreads();
    {
      const int row = tid >> 2, q4 = tid & 3;
      float sq = 0.f, sk = 0.f;
#pragma unroll
      for (int i = 0; i < 16; ++i) { float a = sW[row * 65 + q4 * 16 + i], b = sK[row * 65 + q4 * 16 + i]; sq += a * a; sk += b * b; }
      sq += __shfl_xor(sq, 1); sq += __shfl_xor(sq, 2);
      sk += __shfl_xor(sk, 1); sk += __shfl_xor(sk, 2);
      const float rq = rsqrtf(sq + 1e-6f) * 0.125f, rk = rsqrtf(sk + 1e-6f);
#pragma unroll
      for (int i = 0; i < 16; ++i) { sW[row * 65 + q4 * 16 + i] *= rq; sK[row * 65 + q4 * 16 + i] *= rk; }
    }
    __syncthreads();
    float qa[16], ka[16];
#pragma unroll
    for (int s = 0; s < 16; ++s) { qa[s] = sW[(16 * w + r16) * 65 + 4 * s + g4]; ka[s] = sK[(16 * w + r16) * 65 + 4 * s + g4]; }
#pragma unroll
    for (int nn = 0; nn < 4; ++nn) {
      f32x4 acc = f32x4{0.f, 0.f, 0.f, 0.f};
      if (nn <= w) {
#pragma unroll
        for (int s = 0; s < 16; ++s) acc = MFMA4(ka[s], sK[(16 * nn + r16) * 65 + 4 * s + g4], acc);
      }
#pragma unroll
      for (int r = 0; r < 4; ++r) {
        const int i = 16 * w + g4 * 4 + r, j = 16 * nn + r16;
        sMM[i * 68 + j] = (i > j) ? sBeta[i] * acc[r] * __expf(sGc[i] - sGc[j]) : 0.f;
      }
    }
    __syncthreads();
    if (tid < 96) {
      const int c = tid;
      float* colp = c < 64 ? sW + c : sV + (c - 64);
      const int cst = c < 64 ? 65 : 33;
      for (int ib = 0; ib < 4; ++ib) {
        float a[16];
        const float* mrow = sMM + (16 * ib) * 68;
#pragma unroll
        for (int r = 0; r < 16; ++r) {
          const int i = 16 * ib + r;
          a[r] = (c < 64) ? sK[i * 65 + c] * sBg[i] : sV[i * 33 + (c - 64)] * sBeta[i];
        }
        for (int j4 = 0; j4 < 4 * ib; ++j4) {
          const float x0 = colp[(4 * j4 + 0) * cst], x1 = colp[(4 * j4 + 1) * cst], x2 = colp[(4 * j4 + 2) * cst], x3 = colp[(4 * j4 + 3) * cst];
#pragma unroll
          for (int r = 0; r < 16; ++r) {
            const float4 m = *(const float4*)(mrow + r * 68 + 4 * j4);
            a[r] -= m.x * x0 + m.y * x1 + m.z * x2 + m.w * x3;
          }
        }
#pragma unroll
        for (int r = 1; r < 16; ++r) {
#pragma unroll
          for (int q4 = 0; q4 < (r + 3) / 4; ++q4) {
            const float4 m = *(const float4*)(mrow + r * 68 + 16 * ib + 4 * q4);
            if (q4 * 4 + 0 < r) a[r] -= m.x * a[q4 * 4 + 0];
            if (q4 * 4 + 1 < r) a[r] -= m.y * a[q4 * 4 + 1];
            if (q4 * 4 + 2 < r) a[r] -= m.z * a[q4 * 4 + 2];
            if (q4 * 4 + 3 < r) a[r] -= m.w * a[q4 * 4 + 3];
          }
        }
#pragma unroll
        for (int r = 0; r < 16; ++r) colp[(16 * ib + r) * cst] = a[r];
      }
    }
    __syncthreads();
#pragma unroll
    for (int nn = 0; nn < 4; ++nn) {
      f32x4 acc = f32x4{0.f, 0.f, 0.f, 0.f};
      if (nn <= w) {
#pragma unroll
        for (int s = 0; s < 16; ++s) acc = MFMA4(qa[s], sK[(16 * nn + r16) * 65 + 4 * s + g4], acc);
      }
#pragma unroll
      for (int r = 0; r < 4; ++r) {
        const int i = 16 * w + g4 * 4 + r, j = 16 * nn + r16;
        sMM[i * 68 + j] = (i >= j) ? acc[r] * __expf(sGc[i] - sGc[j]) : 0.f;
      }
    }
    {
      f32x4 acc[2] = {f32x4{0.f, 0.f, 0.f, 0.f}, f32x4{0.f, 0.f, 0.f, 0.f}};
#pragma unroll
      for (int s = 0; s < 16; ++s) {
        const float a = sW[(16 * w + r16) * 65 + 4 * s + g4];
        acc[0] = MFMA4(a, sS[(4 * s + g4) * 33 + r16], acc[0]);
        acc[1] = MFMA4(a, sS[(4 * s + g4) * 33 + 16 + r16], acc[1]);
      }
#pragma unroll
      for (int nn = 0; nn < 2; ++nn)
#pragma unroll
        for (int r = 0; r < 4; ++r) {
          const int i = 16 * w + g4 * 4 + r, cc = nn * 16 + r16;
          sV[i * 33 + cc] = sV[i * 33 + cc] - acc[nn][r];
        }
    }
    __syncthreads();
    {
      f32x4 acc[2] = {f32x4{0.f, 0.f, 0.f, 0.f}, f32x4{0.f, 0.f, 0.f, 0.f}};
      const float eg = __expf(sGc[16 * w + r16]);
#pragma unroll
      for (int s = 0; s < 16; ++s) {
        const float a = qa[s] * eg;
        acc[0] = MFMA4(a, sS[(4 * s + g4) * 33 + r16], acc[0]);
        acc[1] = MFMA4(a, sS[(4 * s + g4) * 33 + 16 + r16], acc[1]);
      }
#pragma unroll
      for (int s = 0; s < 16; ++s) {
        if (s < 4 * (w + 1)) {
          const float a = sMM[(16 * w + r16) * 68 + 4 * s + g4];
          acc[0] = MFMA4(a, sV[(4 * s + g4) * 33 + r16], acc[0]);
          acc[1] = MFMA4(a, sV[(4 * s + g4) * 33 + 16 + r16], acc[1]);
        }
      }
#pragma unroll
      for (int nn = 0; nn < 2; ++nn)
#pragma unroll
        for (int r = 0; r < 4; ++r) {
          const int pp = 16 * w + g4 * 4 + r;
          const int u = d == 0 ? pp : 63 - pp;
          p.MIX[(size_t)(t0 + tlo + u) * 1024 + d * 256 + h * 64 + vs * 32 + nn * 16 + r16] = f2bf(acc[nn][r]);
        }
    }
    __syncthreads();
    {
      const float g63 = sGc[63];
      const float gl = __expf(g63);
#pragma unroll
      for (int nn = 0; nn < 2; ++nn)
#pragma unroll
        for (int r = 0; r < 4; ++r) Sreg[nn][r] *= gl;
#pragma unroll
      for (int s = 0; s < 16; ++s) {
        const int srow = 4 * s + g4;
        const float a = sK[srow * 65 + 16 * w + r16] * __expf(g63 - sGc[srow]);
        Sreg[0] = MFMA4(a, sV[srow * 33 + r16], Sreg[0]);
        Sreg[1] = MFMA4(a, sV[srow * 33 + 16 + r16], Sreg[1]);
      }
    }
    __syncthreads();
#pragma unroll
    for (int nn = 0; nn < 2; ++nn)
#pragma unroll
      for (int r = 0; r < 4; ++r) sS[(16 * w + g4 * 4 + r) * 33 + nn * 16 + r16] = Sreg[nn][r];
    __syncthreads();
  }
  if (!latent) {
    float* so = p.out + OUT_SGDN + ((((size_t)seq * 2 + l) * 2 + d) * 4 + h) * 4096;
#pragma unroll
    for (int nn = 0; nn < 2; ++nn)
#pragma unroll
      for (int r = 0; r < 4; ++r) so[(16 * w + g4 * 4 + r) * 64 + vs * 32 + nn * 16 + r16] = Sreg[nn][r];
  }
}

__device__ __forceinline__ void hgrn_chain(const Params& p, int l, int seq, int h, int d, int vs, float* sm) {
  float* sBC = sm;
  float* sK = sBC + 64 * 65;
  float* sAT = sK + 64 * 65;
  float* sV = sAT + 64 * 68;
  float* sS = sV + 64 * 33;
  float* sTot = sS + 64 * 33;
  const int tid = tid_l(), lane = tid & 63, w = tid >> 6, r16 = lane & 15, g4 = lane >> 4;
  const bool latent = seq >= 16;
  const int len = latent ? 4096 : 256;
  const int t0 = latent ? T_CTX + (seq - 16) * 4096 : seq * 256;
  const int nchunks = len >> 6;
  float lbk;
  {
    const int kch = h * 64 + (tid & 63);
    lbk = (l == 0) ? 0.f : sigmoidf_(p.hgrn_lb[256 + kch] - p.hgrn_lb[kch]);
  }
  f32x4 Sreg[2];
  __syncthreads();
  {
    const float* s0 = latent ? p.state_hgrn + ((((size_t)(seq - 16) * 2 + l) * 2 + d) * 4 + h) * 4096 : nullptr;
#pragma unroll
    for (int n = 0; n < 2; ++n)
#pragma unroll
      for (int r = 0; r < 4; ++r) {
        const int kidx = 16 * w + g4 * 4 + r, cc = n * 16 + r16;
        float v = latent ? s0[kidx * 64 + vs * 32 + cc] : 0.f;
        Sreg[n][r] = v;
        sS[kidx * 33 + cc] = v;
      }
  }
  const u16* Pb = p.P + (size_t)t0 * PW;
  for (int n = 0; n < nchunks; ++n) {
    const int tlo = d == 0 ? n * 64 : len - 64 * (n + 1);
    float cs[16];
    {
      const int k = tid & 63, sg = tid >> 6;
      float run = 0.f;
#pragma unroll
      for (int i = 0; i < 16; ++i) {
        const int pp = 16 * sg + i, u = d == 0 ? pp : 63 - pp;
        const float x = bf2f(Pb[(size_t)(tlo + u) * PW + P_HF + d * 256 + h * 64 + k]);
        const float sg_ = sigmoidf_(x);
        const float gate = lbk + (1.f - lbk) * sg_;
        run += __logf(fmaxf(gate, 1e-30f));
        cs[i] = run;
        sK[pp * 65 + k] = (1.f - lbk) * (1.f - sg_);
      }
      sTot[sg * 64 + k] = run;
    }
#pragma unroll
    for (int i = 0; i < 8; ++i) {
      const int e = tid + i * 256;
      const int pp = e >> 5, cc = e & 31, u = d == 0 ? pp : 63 - pp;
      sV[pp * 33 + cc] = bf2f(Pb[(size_t)(tlo + u) * PW + P_HI + h * 64 + vs * 32 + cc]);
    }
    float qa[16];
    {
      const int pp = 16 * w + r16, u = d == 0 ? pp : 63 - pp;
#pragma unroll
      for (int s = 0; s < 16; ++s) qa[s] = bf2f(Pb[(size_t)(tlo + u) * PW + P_HQ + h * 64 + 4 * s + g4]);
    }
    __syncthreads();
    {
      const int k = tid & 63, sg = tid >> 6;
      float off = 0.f;
      for (int s2 = 0; s2 < sg; ++s2) off += sTot[s2 * 64 + k];
#pragma unroll
      for (int i = 0; i < 16; ++i) sBC[(16 * sg + i) * 65 + k] = cs[i] + off;
    }
    __syncthreads();
    {
      float aq[16], rf[16];
#pragma unroll
      for (int s = 0; s < 16; ++s) {
        const int kk = 4 * s + g4;
        rf[s] = (w == 0) ? 0.f : sBC[(16 * w - 1) * 65 + kk];
        aq[s] = qa[s] * __expf(sBC[(16 * w + r16) * 65 + kk] - rf[s]);
      }
#pragma unroll
      for (int nn = 0; nn < 4; ++nn) {
        f32x4 acc = f32x4{0.f, 0.f, 0.f, 0.f};
        if (nn <= w) {
#pragma unroll
          for (int s = 0; s < 16; ++s) {
            const int kk = 4 * s + g4, sc = 16 * nn + r16;
            const float bv = sK[sc * 65 + kk] * __expf(fminf(rf[s] - sBC[sc * 65 + kk], 80.f));
            acc = MFMA4(aq[s], bv, acc);
          }
        }
#pragma unroll
        for (int r = 0; r < 4; ++r) {
          const int i = 16 * w + g4 * 4 + r, j = 16 * nn + r16;
          sAT[i * 68 + j] = (i >= j) ? acc[r] : 0.f;
        }
      }
    }
    __syncthreads();
    {
      f32x4 acc[2] = {f32x4{0.f, 0.f, 0.f, 0.f}, f32x4{0.f, 0.f, 0.f, 0.f}};
#pragma unroll
      for (int s = 0; s < 16; ++s) {
        const int kk = 4 * s + g4;
        const float a = qa[s] * __expf(sBC[(16 * w + r16) * 65 + kk]);
        acc[0] = MFMA4(a, sS[kk * 33 + r16], acc[0]);
        acc[1] = MFMA4(a, sS[kk * 33 + 16 + r16], acc[1]);
      }
#pragma unroll
      for (int s = 0; s < 16; ++s) {
        if (s < 4 * (w + 1)) {
          const float a = sAT[(16 * w + r16) * 68 + 4 * s + g4];
          acc[0] = MFMA4(a, sV[(4 * s + g4) * 33 + r16], acc[0]);
          acc[1] = MFMA4(a, sV[(4 * s + g4) * 33 + 16 + r16], acc[1]);
        }
      }
#pragma unroll
      for (int nn = 0; nn < 2; ++nn)
#pragma unroll
        for (int r = 0; r < 4; ++r) {
          const int pp = 16 * w + g4 * 4 + r;
          const int u = d == 0 ? pp : 63 - pp;
          p.MIX[(size_t)(t0 + tlo + u) * 1024 + 512 + d * 256 + h * 64 + vs * 32 + nn * 16 + r16] = f2bf(acc[nn][r]);
        }
    }
    __syncthreads();
    {
#pragma unroll
      for (int nn = 0; nn < 2; ++nn)
#pragma unroll
        for (int r = 0; r < 4; ++r) Sreg[nn][r] *= __expf(sBC[63 * 65 + 16 * w + g4 * 4 + r]);
      const int kA = 16 * w + r16;
      const float blA = sBC[63 * 65 + kA];
#pragma unroll
      for (int s = 0; s < 16; ++s) {
        const int srow = 4 * s + g4;
        const float a = sK[srow * 65 + kA] * __expf(blA - sBC[srow * 65 + kA]);
        Sreg[0] = MFMA4(a, sV[srow * 33 + r16], Sreg[0]);
        Sreg[1] = MFMA4(a, sV[srow * 33 + 16 + r16], Sreg[1]);
      }
    }
    __syncthreads();
#pragma unroll
    for (int nn = 0; nn < 2; ++nn)
#pragma unroll
      for (int r = 0; r < 4; ++r) sS[(16 * w + g4 * 4 + r) * 33 + nn * 16 + r16] = Sreg[nn][r];
    __syncthreads();
  }
  if (!latent) {
    float* so = p.out + OUT_SHG + ((((size_t)seq * 2 + l) * 2 + d) * 4 + h) * 4096;
#pragma unroll
    for (int nn = 0; nn < 2; ++nn)
#pragma unroll
      for (int r = 0; r < 4; ++r) so[(16 * w + g4 * 4 + r) * 64 + vs * 32 + nn * 16 + r16] = Sreg[nn][r];
  }
}

__device__ __forceinline__ void phase_c(const Params& p, int l, unsigned char* smraw) {
  __shared__ int s_item;
  const int total = 1920;
  for (;;) {
    __syncthreads();
    if (tid_l() == 0) s_item = (int)atomicAdd(&p.counters[l * 64], 1u);
    __syncthreads();
    const int item = s_item;
    if (item >= total) break;
    int kind, a0, a1, a2, a3;
    if (item < 256 || (item >= 1280 && item < 1792)) {
      const int i2 = item < 256 ? item : item - 1280;
      const int rest = i2 >> 1;
      kind = i2 & 1;
      a3 = rest & 1; a2 = (rest >> 1) & 1; a1 = (rest >> 2) & 3; a0 = (rest >> 4) + (item < 256 ? 16 : 0);
    } else if (item < 1280) {
      const int i2 = item - 256;
      kind = 2; a0 = 1; a1 = i2 >> 7; a2 = (i2 >> 5) & 3; a3 = i2 & 31;
    } else {
      const int i2 = item - 1792;
      kind = 2; a0 = 0; a1 = i2 >> 3; a2 = (i2 >> 1) & 3; a3 = i2 & 1;
    }
    if (kind == 0) gdn_chain(p, l, a0, a1, a2, a3, (float*)smraw);
    else if (kind == 1) hgrn_chain(p, l, a0, a1, a2, a3, (float*)smraw);
    else attn_item(p, a0, a1, a2, a3, smraw);
  }
}

__global__ void __launch_bounds__(NTHR, 2) mega(Params p) {
  __shared__ __attribute__((aligned(16))) unsigned char smem[LDS_BYTES];
  cg::grid_group grid = cg::this_grid();
  phase0(p, (float*)smem);
  grid.sync();
  rowpass_norm(p, 0, 0);
  grid.sync();
  for (int l = 0; l < 2; ++l) {
    phase_a(p, l, (u16*)smem);
    grid.sync();
    rowpass_b0(p, l);
    grid.sync();
    phase_b1(p, l, (u16*)smem);
    grid.sync();
    phase_c(p, l, smem);
    grid.sync();
    rowpass_c2(p, l);
    grid.sync();
    phase_gemm_y(p.MIX, 1024, p.WoutT + (size_t)l * 1024 * 1024, 1024, 1024, p.HQ, 1024, (u16*)smem);
    grid.sync();
    rowpass_norm(p, l, 1);
    grid.sync();
    phase_e(p, l, (u16*)smem);
    grid.sync();
    phase_gemm_y(p.P, DFF, p.WfoT + (size_t)l * 1024 * DFF, DFF, 1024, p.HQ, 1024, (u16*)smem);
    grid.sync();
    rowpass_norm(p, l, 2);
    if (l == 0) grid.sync();
  }
}

extern "C" void kernel_launch(void* const* d_in, const int* in_sizes, int n_in, void* d_out, int out_size, void* d_ws,
                              size_t ws_size, hipStream_t stream) {
  static int grid_blocks = 0;
  if (!grid_blocks) {
    int dev = 0, cus = 0, per_cu = 0;
    hipGetDevice(&dev);
    hipDeviceGetAttribute(&cus, hipDeviceAttributeMultiprocessorCount, dev);
    hipOccupancyMaxActiveBlocksPerMultiprocessor(&per_cu, mega, NTHR, 0);
    if (per_cu > 2) per_cu = 2;
    if (per_cu < 1) per_cu = 1;
    grid_blocks = cus * per_cu;
  }
  Params p{};
  const float* const* in = (const float* const*)d_in;
  p.x_prompt = in[0]; p.x_sample = in[1]; p.cache_ckv = in[2]; p.cache_kr = in[3]; p.state_gdn = in[4]; p.state_hgrn = in[5];
  p.c = in[6]; p.c_ctx = in[7]; p.w_ada = in[8]; p.b_ada = in[9]; p.g_pre_mix = in[10]; p.g_post_mix = in[11];
  p.g_pre_ffn = in[12]; p.g_post_ffn = in[13]; p.w_in = in[14]; p.w_out = in[15]; p.gdn_conv_w = in[16];
  p.gdn_a_log = in[17]; p.gdn_dt_bias = in[18]; p.gdn_norm_w = in[19]; p.hgrn_lb = in[20]; p.hgrn_norm_w = in[21];
  p.mla_q_norm_w = in[22]; p.mla_w_uq = in[23]; p.mla_kv_norm_w = in[24]; p.mla_w_ukv = in[25]; p.w_ffn_in = in[26];
  p.w_ffn_out = in[27];
  p.out = (float*)d_out;
  unsigned char* ws = (unsigned char*)d_ws;
  size_t off = 0;
  auto take = [&](size_t bytes) { unsigned char* r = ws + off; off += (bytes + 255) & ~(size_t)255; return r; };
  p.counters = (unsigned*)take(1024);
  p.WinT = (u16*)take((size_t)2 * 3072 * 1024 * 2);
  p.WuqT = (u16*)take((size_t)2 * 768 * 384 * 2);
  p.WukvT = (u16*)take((size_t)2 * 1024 * 256 * 2);
  p.WoutT = (u16*)take((size_t)2 * 1024 * 1024 * 2);
  p.WfiT = (u16*)take((size_t)2 * 5632 * 1024 * 2);
  p.WfoT = (u16*)take((size_t)2 * 1024 * 2816 * 2);
  p.mod = (float*)take((size_t)2 * 9 * 6144 * 4);
  p.HQ = (u16*)take((size_t)T_ALL * 1024 * 2);
  p.P = (u16*)take((size_t)T_ALL * PW * 2);
  p.KN = (u16*)take((size_t)(T_ALL + 2048) * 512 * 2);
  p.VTL = (u16*)take((size_t)8 * 4 * 128 * 4352 * 2);
  p.VTC = (u16*)take((size_t)16 * 4 * 128 * 256 * 2);
  p.CKVC = (u16*)take((size_t)2048 * 256 * 2);
  p.KRC = (u16*)take((size_t)2048 * 64 * 2);
  p.GAB = (float*)take((size_t)T_ALL * 16 * 4);
  p.MIX = (u16*)take((size_t)T_ALL * 1024 * 2);
  if (off > ws_size) { fprintf(stderr, "workspace too small: need %zu have %zu\n", off, ws_size); return; }
  hipMemsetAsync(p.counters, 0, 1024, stream);
  void* args[] = {&p};
  hipError_t e = hipLaunchCooperativeKernel((void*)mega, dim3(grid_blocks), dim3(NTHR), args, 0, stream);
  if (e != hipSuccess) fprintf(stderr, "cooperative launch failed: %s (grid %d)\n", hipGetErrorString(e), grid_blocks);
}
```

```cpp
#include <hip/hip_runtime.h>
#include <hip/hip_cooperative_groups.h>
#include <cstdio>
namespace cg = cooperative_groups;

typedef unsigned short u16;
using bf16x8 = __attribute__((ext_vector_type(8))) short;
using f32x4  = __attribute__((ext_vector_type(4))) float;

#define T_CTX 4096
#define T_ALL 36864
#define PW 3072
#define DFF 2816
#define LDS_BYTES 73728
#define NTHR 256

#define P_GQKV 0
#define P_GZ 768
#define P_HQ 1024
#define P_HI 1280
#define P_HF 1536
#define P_HG 2048
#define P_MCQ 2304
#define P_MCKV 2688
#define P_MKR 2944
#define P_GA 3008

struct Params {
  const float *x_prompt, *x_sample, *cache_ckv, *cache_kr, *state_gdn, *state_hgrn, *c, *c_ctx;
  const float *w_ada, *b_ada, *g_pre_mix, *g_post_mix, *g_pre_ffn, *g_post_ffn, *w_in, *w_out;
  const float *gdn_conv_w, *gdn_a_log, *gdn_dt_bias, *gdn_norm_w, *hgrn_lb, *hgrn_norm_w;
  const float *mla_q_norm_w, *mla_w_uq, *mla_kv_norm_w, *mla_w_ukv, *w_ffn_in, *w_ffn_out;
  float* out;
  u16 *WinT, *WuqT, *WukvT, *WoutT, *WfiT, *WfoT;
  float* mod;
  u16 *HQ, *P, *KN, *VTL, *VTC, *CKVC, *KRC, *MIX;
  float* GAB;
  unsigned* counters;
};

#define OUT_CKV   37748736
#define OUT_KR    39845888
#define OUT_SGDN  40370176
#define OUT_SHG   41418752

__device__ __forceinline__ u16 f2bf(float f) {
  unsigned u = __float_as_uint(f);
  u += 0x7fffu + ((u >> 16) & 1u);
  return (u16)(u >> 16);
}
__device__ __forceinline__ float bf2f(u16 h) { return __uint_as_float(((unsigned)h) << 16); }
__device__ __forceinline__ float wave_sum(float v) {
#pragma unroll
  for (int o = 32; o > 0; o >>= 1) v += __shfl_xor(v, o);
  return v;
}
__device__ __forceinline__ float sigmoidf_(float x) { return __builtin_amdgcn_rcpf(1.f + __expf(-x)); }
__device__ __forceinline__ float siluf_(float x) { return x * __builtin_amdgcn_rcpf(1.f + __expf(-x)); }
__device__ __forceinline__ int tid_l() { int t = threadIdx.x; asm volatile("" : "+v"(t)); return t; }
__device__ __forceinline__ int tok_mod(int t) { return t < T_CTX ? 0 : 1 + ((t - T_CTX) >> 12); }

__device__ __forceinline__ int map_col(int kind, int j) {
  if (kind == 0) return j;
  if (kind == 1) { if (j < 1024) return j; if (j < 3008) return j + 16; if (j < 3024) return 1024 + (j - 3008); return -1; }
  int blk = j >> 6, w = j & 63;
  return w < 32 ? blk * 32 + w : DFF + blk * 32 + (w - 32);
}

__device__ __forceinline__ void cvt_tile(const float* __restrict__ src, int K, int Nsrc, u16* __restrict__ dst, int kind, int jt, int kt, float* sm) {
  const int tid = tid_l();
  const int j0 = jt * 64, k0 = kt * 64;
  __syncthreads();
  {
    int jj = tid & 63, kk0 = tid >> 6;
    int sc = map_col(kind, j0 + jj);
    for (int kk = kk0; kk < 64; kk += 4)
      sm[kk * 65 + jj] = sc >= 0 ? src[(size_t)(k0 + kk) * Nsrc + sc] : 0.f;
  }
  __syncthreads();
  {
    int kk = tid & 63, jj0 = tid >> 6;
    for (int jj = jj0; jj < 64; jj += 4)
      dst[(size_t)(j0 + jj) * K + k0 + kk] = f2bf(sm[kk * 65 + jj]);
  }
}

__device__ __forceinline__ void mod_item(const Params& p, int item, float* sm) {
  const int l = item / 96, j0 = (item % 96) * 64;
  const int tid = tid_l();
  float* sC = sm;
  float* sR = sm + 9 * 1024;
  __syncthreads();
  for (int i = tid; i < 9 * 1024; i += NTHR) {
    int m = i >> 10, k = i & 1023;
    float v = m == 0 ? p.c_ctx[k] : p.c[(m - 1) * 1024 + k];
    sC[i] = siluf_(v);
  }
  __syncthreads();
  const int col = tid & 63, ks = tid >> 6;
  float acc[9];
#pragma unroll
  for (int m = 0; m < 9; ++m) acc[m] = 0.f;
  const float* wp = p.w_ada + (size_t)l * 1024 * 6144 + j0 + col;
  for (int k = ks * 256; k < ks * 256 + 256; ++k) {
    float w = wp[(size_t)k * 6144];
#pragma unroll
    for (int m = 0; m < 9; ++m) acc[m] += sC[m * 1024 + k] * w;
  }
#pragma unroll
  for (int m = 0; m < 9; ++m) sR[(ks * 9 + m) * 64 + col] = acc[m];
  __syncthreads();
  for (int i = tid; i < 9 * 64; i += NTHR) {
    int m = i >> 6, cc = i & 63;
    float v = sR[(0 * 9 + m) * 64 + cc] + sR[(1 * 9 + m) * 64 + cc] + sR[(2 * 9 + m) * 64 + cc] + sR[(3 * 9 + m) * 64 + cc];
    p.mod[((size_t)l * 9 + m) * 6144 + j0 + cc] = v + p.b_ada[l * 6144 + j0 + cc];
  }
}

__device__ __forceinline__ void phase0(const Params& p, float* sm) {
  const int PER_LAYER = 3272;
  const int total = 2 * PER_LAYER + 192;
  for (int item = blockIdx.x; item < total; item += gridDim.x) {
    if (item < 192) { mod_item(p, item, sm); continue; }
    int it = item - 192;
    int l = it / PER_LAYER, r = it % PER_LAYER;
    if (r < 768) { cvt_tile(p.w_in + (size_t)l * 1024 * 3024, 1024, 3024, p.WinT + (size_t)l * 3072 * 1024, 1, r / 16, r % 16, sm); continue; }
    r -= 768;
    if (r < 72) { cvt_tile(p.mla_w_uq + (size_t)l * 384 * 768, 384, 768, p.WuqT + (size_t)l * 768 * 384, 0, r / 6, r % 6, sm); continue; }
    r -= 72;
    if (r < 64) { cvt_tile(p.mla_w_ukv + (size_t)l * 256 * 1024, 256, 1024, p.WukvT + (size_t)l * 1024 * 256, 0, r / 4, r % 4, sm); continue; }
    r -= 64;
    if (r < 256) { cvt_tile(p.w_out + (size_t)l * 1024 * 1024, 1024, 1024, p.WoutT + (size_t)l * 1024 * 1024, 0, r / 16, r % 16, sm); continue; }
    r -= 256;
    if (r < 1408) { cvt_tile(p.w_ffn_in + (size_t)l * 1024 * 5632, 1024, 5632, p.WfiT + (size_t)l * 5632 * 1024, 2, r / 16, r % 16, sm); continue; }
    r -= 1408;
    cvt_tile(p.w_ffn_out + (size_t)l * 2816 * 1024, 2816, 1024, p.WfoT + (size_t)l * 1024 * 2816, 0, r / 44, r % 44, sm);
  }
}

__device__ __forceinline__ void rowpass_norm(const Params& p, int l, int stage) {
  const int tidl = tid_l();
  const int lane = tidl & 63, w = tidl >> 6;
  const int ln = stage == 0 ? 0 : (stage == 1 ? l : l + 1);
  const int sh_off = stage == 1 ? 3072 : 0;
  const float* gpre = stage == 1 ? p.g_pre_ffn + l * 1024 : p.g_pre_mix + (ln < 2 ? ln : 0) * 1024;
  u16* dst = stage == 1 ? p.MIX : p.HQ;
  for (int t = blockIdx.x * 4 + w; t < T_ALL; t += gridDim.x * 4) {
    const int m = tok_mod(t);
    float x[16];
    float* xo = p.out + (size_t)t * 1024;
    if (stage == 0) {
      const float* xi = t < T_CTX ? p.x_prompt + (size_t)t * 1024 : p.x_sample + (size_t)(t - T_CTX) * 1024;
#pragma unroll
      for (int i = 0; i < 4; ++i) {
        float4 v = *(const float4*)(xi + i * 256 + lane * 4);
        x[i * 4 + 0] = v.x; x[i * 4 + 1] = v.y; x[i * 4 + 2] = v.z; x[i * 4 + 3] = v.w;
      }
    } else {
      const u16* yp = p.HQ + (size_t)t * 1024;
      float y[16]; float ss = 0.f;
#pragma unroll
      for (int i = 0; i < 4; ++i) {
        uint2 v = *(const uint2*)(yp + i * 256 + lane * 4);
        y[i * 4 + 0] = bf2f((u16)(v.x & 0xffff)); y[i * 4 + 1] = bf2f((u16)(v.x >> 16));
        y[i * 4 + 2] = bf2f((u16)(v.y & 0xffff)); y[i * 4 + 3] = bf2f((u16)(v.y >> 16));
      }
#pragma unroll
      for (int i = 0; i < 16; ++i) ss += y[i] * y[i];
      ss = wave_sum(ss);
      const float rstd = rsqrtf(ss * (1.f / 1024.f) + 1e-6f);
      const float* gpost = (stage == 1 ? p.g_post_mix : p.g_post_ffn) + l * 1024;
      const float* gt = p.mod + ((size_t)l * 9 + m) * 6144 + (stage == 1 ? 2048 : 5120);
#pragma unroll
      for (int i = 0; i < 4; ++i) {
        float4 xv = *(const float4*)(xo + i * 256 + lane * 4);
        float4 gp = *(const float4*)(gpost + i * 256 + lane * 4);
        float4 gg = *(const float4*)(gt + i * 256 + lane * 4);
        x[i * 4 + 0] = xv.x + gg.x * y[i * 4 + 0] * rstd * gp.x;
        x[i * 4 + 1] = xv.y + gg.y * y[i * 4 + 1] * rstd * gp.y;
        x[i * 4 + 2] = xv.z + gg.z * y[i * 4 + 2] * rstd * gp.z;
        x[i * 4 + 3] = xv.w + gg.w * y[i * 4 + 3] * rstd * gp.w;
      }
    }
    __threadfence_block();
#pragma unroll
    for (int i = 0; i < 4; ++i)
      *(float4*)(xo + i * 256 + lane * 4) = make_float4(x[i * 4 + 0], x[i * 4 + 1], x[i * 4 + 2], x[i * 4 + 3]);
    if (ln >= 2) continue;
    float ss = 0.f;
#pragma unroll
    for (int i = 0; i < 16; ++i) ss += x[i] * x[i];
    ss = wave_sum(ss);
    const float rstd = rsqrtf(ss * (1.f / 1024.f) + 1e-6f);
    const float* sh = p.mod + ((size_t)ln * 9 + m) * 6144 + sh_off;
    const float* sc = sh + 1024;
    u16* hp = dst + (size_t)t * 1024;
#pragma unroll
    for (int i = 0; i < 4; ++i) {
      float4 gp = *(const float4*)(gpre + i * 256 + lane * 4);
      float4 s1 = *(const float4*)(sh + i * 256 + lane * 4);
      float4 c1 = *(const float4*)(sc + i * 256 + lane * 4);
      float h0 = x[i * 4 + 0] * rstd * gp.x * (1.f + c1.x) + s1.x;
      float h1 = x[i * 4 + 1] * rstd * gp.y * (1.f + c1.y) + s1.y;
      float h2 = x[i * 4 + 2] * rstd * gp.z * (1.f + c1.z) + s1.z;
      float h3 = x[i * 4 + 3] * rstd * gp.w * (1.f + c1.w) + s1.w;
      uint2 o;
      o.x = (unsigned)f2bf(h0) | ((unsigned)f2bf(h1) << 16);
      o.y = (unsigned)f2bf(h2) | ((unsigned)f2bf(h3) << 16);
      *(uint2*)(hp + i * 256 + lane * 4) = o;
    }
  }
}

__device__ __forceinline__ void rowpass_b0(const Params& p, int l) {
  const int tidl = tid_l();
  const int lane = tidl & 63, w = tidl >> 6;
  for (int t = blockIdx.x * 4 + w; t < T_ALL + 2048; t += gridDim.x * 4) {
    if (t >= T_ALL) {
      int r = t - T_ALL, b = r >> 8, s = r & 255;
      const float* ck = p.cache_ckv + (((size_t)b * 2 + l) * 256 + s) * 256;
      const float* kr = p.cache_kr + (((size_t)b * 2 + l) * 256 + s) * 64;
#pragma unroll
      for (int i = 0; i < 4; ++i) p.CKVC[(size_t)r * 256 + lane + 64 * i] = f2bf(ck[lane + 64 * i]);
      p.KRC[(size_t)r * 64 + lane] = f2bf(kr[lane]);
      continue;
    }
    u16* pr = p.P + (size_t)t * PW;
    {
      float v[6]; float ss = 0.f;
#pragma unroll
      for (int i = 0; i < 6; ++i) { v[i] = bf2f(pr[P_MCQ + lane + 64 * i]); ss += v[i] * v[i]; }
      ss = wave_sum(ss);
      float rstd = rsqrtf(ss * (1.f / 384.f) + 1e-6f);
#pragma unroll
      for (int i = 0; i < 6; ++i) pr[P_MCQ + lane + 64 * i] = f2bf(v[i] * rstd * p.mla_q_norm_w[l * 384 + lane + 64 * i]);
    }
    {
      float v[4]; float ss = 0.f;
#pragma unroll
      for (int i = 0; i < 4; ++i) { v[i] = bf2f(pr[P_MCKV + lane + 64 * i]); ss += v[i] * v[i]; }
      ss = wave_sum(ss);
      float rstd = rsqrtf(ss * (1.f / 256.f) + 1e-6f);
#pragma unroll
      for (int i = 0; i < 4; ++i) {
        float c = v[i] * rstd * p.mla_kv_norm_w[l * 256 + lane + 64 * i];
        pr[P_MCKV + lane + 64 * i] = f2bf(c);
        if (t < T_CTX) {
          int b = t >> 8, s = t & 255;
          p.out[OUT_CKV + (((size_t)b * 2 + l) * 256 + s) * 256 + lane + 64 * i] = c;
        }
      }
    }
    {
      float v = bf2f(pr[P_MKR + lane]);
      if (t < T_CTX) {
        int b = t >> 8, s = t & 255;
        p.out[OUT_KR + (((size_t)b * 2 + l) * 256 + s) * 64 + lane] = v;
      } else {
        int pos = (t - T_CTX) & 4095;
        int axis = lane >> 5, half = (lane >> 4) & 1, f = lane & 15;
        float posf = axis == 0 ? (float)(pos >> 6) : (float)(pos & 63);
        float inv = exp2f(-(float)f * (13.287712379549449f / 16.f));
        float ang = posf * inv;
        float sn, cs;
        __sincosf(ang, &sn, &cs);
        float other = __shfl_xor(v, 16);
        float o = half == 0 ? v * cs - other * sn : v * cs + other * sn;
        pr[P_MKR + lane] = f2bf(o);
      }
    }
  }
}

__device__ __forceinline__ void rowpass_c2(const Params& p, int l) {
  const int tidl = tid_l();
  const int lane = tidl & 63, w = tidl >> 6;
  for (int t = blockIdx.x * 4 + w; t < T_ALL; t += gridDim.x * 4) {
    u16* mr = p.MIX + (size_t)t * 1024;
    const u16* pr = p.P + (size_t)t * PW;
    const u16* qr = p.HQ + (size_t)t * 768;
    float og[4], oh[4];
#pragma unroll
    for (int h = 0; h < 4; ++h) {
      og[h] = bf2f(mr[h * 64 + lane]) + bf2f(mr[256 + h * 64 + lane]);
      oh[h] = bf2f(mr[512 + h * 64 + lane]) + bf2f(mr[768 + h * 64 + lane]);
    }
    u16 om[8];
#pragma unroll
    for (int i = 0; i < 8; ++i) { int c = lane + 64 * i; om[i] = qr[(c >> 7) * 192 + (c & 127)]; }
    float zg[4], gg[4];
#pragma unroll
    for (int h = 0; h < 4; ++h) { zg[h] = bf2f(pr[P_GZ + h * 64 + lane]); gg[h] = bf2f(pr[P_HG + h * 64 + lane]); }
    float rg[4], rh[4];
#pragma unroll
    for (int h = 0; h < 4; ++h) {
      rg[h] = rsqrtf(wave_sum(og[h] * og[h]) * (1.f / 64.f) + 1e-6f);
      rh[h] = rsqrtf(wave_sum(oh[h] * oh[h]) * (1.f / 64.f) + 1e-6f);
    }
    __threadfence_block();
    const float wg = p.gdn_norm_w[l * 64 + lane], wh = p.hgrn_norm_w[l * 64 + lane];
#pragma unroll
    for (int h = 0; h < 4; ++h) {
      mr[h * 64 + lane] = f2bf(og[h] * rg[h] * wg * siluf_(zg[h]));
      mr[256 + h * 64 + lane] = f2bf(oh[h] * rh[h] * wh * sigmoidf_(gg[h]));
    }
#pragma unroll
    for (int i = 0; i < 8; ++i) mr[512 + lane + 64 * i] = om[i];
  }
}

__device__ __forceinline__ void gemm128(const u16* __restrict__ A, int lda, const u16* __restrict__ B, int ldb, int K,
                                        u16* lds, f32x4 (&acc)[4][4]) {
  u16* sA = lds;
  u16* sB = lds + 128 * 72;
  const int tid = tid_l(), lane = tid & 63, w = tid >> 6, wm = w >> 1, wn = w & 1;
  const int r16 = lane & 15, g4 = lane >> 4;
#pragma unroll
  for (int i = 0; i < 4; ++i)
#pragma unroll
    for (int j = 0; j < 4; ++j) acc[i][j] = f32x4{0.f, 0.f, 0.f, 0.f};
  const int lrow = tid >> 3, lkc = tid & 7;
  const u16* ap = A + (size_t)lrow * lda + lkc * 8;
  const u16* bp = B + (size_t)lrow * ldb + lkc * 8;
  const size_t sa32 = (size_t)32 * lda, sb32 = (size_t)32 * ldb;
  uint4 ra0 = *(const uint4*)(ap), ra1 = *(const uint4*)(ap + sa32), ra2 = *(const uint4*)(ap + 2 * sa32), ra3 = *(const uint4*)(ap + 3 * sa32);
  uint4 rb0 = *(const uint4*)(bp), rb1 = *(const uint4*)(bp + sb32), rb2 = *(const uint4*)(bp + 2 * sb32), rb3 = *(const uint4*)(bp + 3 * sb32);
  u16* wa = sA + lrow * 72 + lkc * 8;
  u16* wb = sB + lrow * 72 + lkc * 8;
  const u16* fa = sA + (wm * 64 + r16) * 72 + g4 * 8;
  const u16* fb = sB + (wn * 64 + r16) * 72 + g4 * 8;
  for (int k0 = 0; k0 < K; k0 += 64) {
    __syncthreads();
    *(uint4*)(wa) = ra0; *(uint4*)(wa + 32 * 72) = ra1; *(uint4*)(wa + 64 * 72) = ra2; *(uint4*)(wa + 96 * 72) = ra3;
    *(uint4*)(wb) = rb0; *(uint4*)(wb + 32 * 72) = rb1; *(uint4*)(wb + 64 * 72) = rb2; *(uint4*)(wb + 96 * 72) = rb3;
    __syncthreads();
    if (k0 + 64 < K) {
      const u16* a2 = ap + k0 + 64;
      const u16* b2 = bp + k0 + 64;
      ra0 = *(const uint4*)(a2); ra1 = *(const uint4*)(a2 + sa32); ra2 = *(const uint4*)(a2 + 2 * sa32); ra3 = *(const uint4*)(a2 + 3 * sa32);
      rb0 = *(const uint4*)(b2); rb1 = *(const uint4*)(b2 + sb32); rb2 = *(const uint4*)(b2 + 2 * sb32); rb3 = *(const uint4*)(b2 + 3 * sb32);
    }
#pragma unroll
    for (int ks = 0; ks < 2; ++ks) {
      bf16x8 af0 = *(const bf16x8*)(fa + ks * 32), af1 = *(const bf16x8*)(fa + 16 * 72 + ks * 32);
      bf16x8 af2 = *(const bf16x8*)(fa + 32 * 72 + ks * 32), af3 = *(const bf16x8*)(fa + 48 * 72 + ks * 32);
#pragma unroll
      for (int j = 0; j < 4; ++j) {
        bf16x8 bfj = *(const bf16x8*)(fb + j * 16 * 72 + ks * 32);
        acc[0][j] = __builtin_amdgcn_mfma_f32_16x16x32_bf16(af0, bfj, acc[0][j], 0, 0, 0);
        acc[1][j] = __builtin_amdgcn_mfma_f32_16x16x32_bf16(af1, bfj, acc[1][j], 0, 0, 0);
        acc[2][j] = __builtin_amdgcn_mfma_f32_16x16x32_bf16(af2, bfj, acc[2][j], 0, 0, 0);
        acc[3][j] = __builtin_amdgcn_mfma_f32_16x16x32_bf16(af3, bfj, acc[3][j], 0, 0, 0);
      }
    }
  }
}
#define GEMM_RC const int tde = tid_l(); const int rb = ((tde >> 6) >> 1) * 64 + ((tde & 63) >> 4) * 4, cb = ((tde >> 6) & 1) * 64 + (tde & 15);

__device__ __forceinline__ void phase_a(const Params& p, int l, u16* lds) {
  const int ntn = 24, total = 288 * ntn;
  const u16* Bw = p.WinT + (size_t)l * 3072 * 1024;
  for (int item = blockIdx.x; item < total; item += gridDim.x) {
    const int mt = item / ntn, nt = item % ntn;
    const int m0 = mt * 128, n0 = nt * 128;
    f32x4 acc[4][4];
    gemm128(p.HQ + (size_t)m0 * 1024, 1024, Bw + (size_t)n0 * 1024, 1024, 1024, lds, acc);
    { GEMM_RC
#pragma unroll
              for (int mi = 0; mi < 4; ++mi)
#pragma unroll
                for (int ni = 0; ni < 4; ++ni) {
                  const int col = n0 + cb + ni * 16;
#pragma unroll
                  for (int j = 0; j < 4; ++j) {
                    const int row = m0 + rb + mi * 16 + j;
                    p.P[(size_t)row * PW + col] = f2bf(acc[mi][ni][j]);
                    if (col >= P_GA && col < P_GA + 16) p.GAB[(size_t)row * 16 + (col - P_GA)] = acc[mi][ni][j];
                  }
                }
            }
  }
}

__device__ __forceinline__ void phase_b1(const Params& p, int l, u16* lds) {
  const int nq = 288 * 6, nkv = 304 * 8;
  for (int item = blockIdx.x; item < nq + nkv; item += gridDim.x) {
    if (item < nq) {
      const int mt = item / 6, nt = item % 6;
      const int m0 = mt * 128, n0 = nt * 128;
      const float qscale = 0.07216878364870322f * 1.4426950408889634f;
      f32x4 acc[4][4];
    gemm128(p.P + (size_t)m0 * PW + P_MCQ, PW, p.WuqT + (size_t)l * 768 * 384 + (size_t)n0 * 384, 384, 384, lds, acc);
    { GEMM_RC
                const int lane = tde & 63;
                const int cw0 = n0 + cb - (lane & 15);
                const bool ropew = ((cw0 >> 6) % 3) == 2 && m0 >= T_CTX;
                const int f = lane & 15;
                const float inv = exp2f(-(float)f * (13.287712379549449f / 16.f));
#pragma unroll
                for (int mi = 0; mi < 4; ++mi)
#pragma unroll
                  for (int j = 0; j < 4; ++j) {
                    const int row = m0 + rb + mi * 16 + j;
                    float v0 = acc[mi][0][j], v1 = acc[mi][1][j], v2 = acc[mi][2][j], v3 = acc[mi][3][j];
                    if (ropew) {
                      const int pos = (row - T_CTX) & 4095;
                      float s0, c0, s1, c1;
                      __sincosf((float)(pos >> 6) * inv, &s0, &c0);
                      __sincosf((float)(pos & 63) * inv, &s1, &c1);
                      float a0 = v0 * c0 - v1 * s0, a1 = v1 * c0 + v0 * s0;
                      float b0 = v2 * c1 - v3 * s1, b1 = v3 * c1 + v2 * s1;
                      v0 = a0; v1 = a1; v2 = b0; v3 = b1;
                    }
                    u16* qp = p.HQ + (size_t)row * 768 + n0 + cb;
                    qp[0] = f2bf(v0 * qscale); qp[16] = f2bf(v1 * qscale); qp[32] = f2bf(v2 * qscale); qp[48] = f2bf(v3 * qscale);
                  }
              }
    } else {
      const int it = item - nq;
      const int mt = it / 8, nt = it % 8;
      const int m0 = mt * 128, n0 = nt * 128;
      const u16* Ap; int lda;
      if (mt < 288) { Ap = p.P + (size_t)m0 * PW + P_MCKV; lda = PW; }
      else { Ap = p.CKVC + (size_t)(m0 - T_ALL) * 256; lda = 256; }
      f32x4 acc[4][4];
    gemm128(Ap, lda, p.WukvT + (size_t)l * 1024 * 256 + (size_t)n0 * 256, 256, 256, lds, acc);
    { GEMM_RC
#pragma unroll
                for (int mi = 0; mi < 4; ++mi)
#pragma unroll
                  for (int ni = 0; ni < 4; ++ni) {
                    const int col = n0 + cb + ni * 16;
                    const int h = col >> 8, wi = col & 255;
                    const int row0 = m0 + rb + mi * 16;
                    if (wi < 128) {
#pragma unroll
                      for (int j = 0; j < 4; ++j) p.KN[(size_t)(row0 + j) * 512 + h * 128 + wi] = f2bf(acc[mi][ni][j]);
                    } else {
                      const int dv = wi - 128;
                      u16* dst;
                      if (row0 < T_CTX) { int b = row0 >> 8, pos = row0 & 255; dst = p.VTC + ((size_t)(b * 4 + h) * 128 + dv) * 256 + pos; }
                      else if (row0 < T_ALL) { int b = (row0 - T_CTX) >> 12, pos = (row0 - T_CTX) & 4095; dst = p.VTL + ((size_t)(b * 4 + h) * 128 + dv) * 4352 + pos; }
                      else { int b = (row0 - T_ALL) >> 8, pos = 4096 + ((row0 - T_ALL) & 255); dst = p.VTL + ((size_t)(b * 4 + h) * 128 + dv) * 4352 + pos; }
                      uint2 o;
                      o.x = (unsigned)f2bf(acc[mi][ni][0]) | ((unsigned)f2bf(acc[mi][ni][1]) << 16);
                      o.y = (unsigned)f2bf(acc[mi][ni][2]) | ((unsigned)f2bf(acc[mi][ni][3]) << 16);
                      *(uint2*)dst = o;
                    }
                  }
              }
    }
  }
}

__device__ __forceinline__ void phase_gemm_y(const u16* A, int lda, const u16* B, int K, int N, u16* Y, int ldy, u16* lds) {
  const int ntn = N / 128, total = 288 * ntn;
  for (int item = blockIdx.x; item < total; item += gridDim.x) {
    const int mt = item / ntn, nt = item % ntn;
    const int m0 = mt * 128, n0 = nt * 128;
    f32x4 acc[4][4];
    gemm128(A + (size_t)m0 * lda, lda, B + (size_t)n0 * K, K, K, lds, acc);
    { GEMM_RC
#pragma unroll
              for (int mi = 0; mi < 4; ++mi)
#pragma unroll
                for (int ni = 0; ni < 4; ++ni)
#pragma unroll
                  for (int j = 0; j < 4; ++j)
                    Y[(size_t)(m0 + rb + mi * 16 + j) * ldy + n0 + cb + ni * 16] = f2bf(acc[mi][ni][j]);
            }
  }
}

__device__ __forceinline__ void phase_e(const Params& p, int l, u16* lds) {
  const int ntn = 44, total = 288 * ntn;
  const u16* Bw = p.WfiT + (size_t)l * 5632 * 1024;
  for (int item = blockIdx.x; item < total; item += gridDim.x) {
    const int mt = item / ntn, nt = item % ntn;
    const int m0 = mt * 128, n0 = nt * 128;
    f32x4 acc[4][4];
    gemm128(p.MIX + (size_t)m0 * 1024, 1024, Bw + (size_t)n0 * 1024, 1024, 1024, lds, acc);
    { GEMM_RC
              const int r16 = tde & 15;
              const int hc0 = ((n0 + cb - r16) >> 1) + r16;
#pragma unroll
              for (int mi = 0; mi < 4; ++mi)
#pragma unroll
                for (int ni = 0; ni < 2; ++ni)
#pragma unroll
                  for (int j = 0; j < 4; ++j) {
                    float a = acc[mi][ni][j], b = acc[mi][ni + 2][j];
                    p.P[(size_t)(m0 + rb + mi * 16 + j) * DFF + hc0 + ni * 16] = f2bf(siluf_(a) * b);
                  }
            }
  }
}

__device__ __forceinline__ void attn_item(const Params& p, int latent, int b, int h, int qb, unsigned char* smraw, int dummy = 0) {
  u16* sK = (u16*)smraw;
  u16* sV = sK + 64 * 200;
  u16* sP = sV + 128 * 72;
  const int tid = tid_l(), lane = tid & 63, w = tid >> 6, r16 = lane & 15, g4 = lane >> 4;
  const int nkeys = latent ? 4352 : 256;
  const int krow0 = latent ? T_CTX + b * 4096 : b * 256;
  const int tq0 = krow0 + qb * 128;
  const u16* vt = latent ? p.VTL + (size_t)((b * 4 + h) * 128) * 4352 : p.VTC + (size_t)((b * 4 + h) * 128) * 256;
  u16* sPw = sP + w * 32 * 72;
  bf16x8 q[2][6];
#pragma unroll
  for (int mi = 0; mi < 2; ++mi)
#pragma unroll
    for (int ks = 0; ks < 6; ++ks)
      q[mi][ks] = *(const bf16x8*)(p.HQ + (size_t)(tq0 + w * 32 + mi * 16 + r16) * 768 + h * 192 + ks * 32 + g4 * 8);
  f32x4 o[2][8];
  float mrow[2][4], lrow[2][4];
#pragma unroll
  for (int mi = 0; mi < 2; ++mi) {
#pragma unroll
    for (int nd = 0; nd < 8; ++nd) o[mi][nd] = f32x4{0.f, 0.f, 0.f, 0.f};
#pragma unroll
    for (int r = 0; r < 4; ++r) { mrow[mi][r] = -1e30f; lrow[mi][r] = 0.f; }
  }
  const int lkey = tid >> 2, lpart = tid & 3;
  const int ldv = tid >> 1, lhalf = tid & 1;
  for (int kt = 0; kt < nkeys / 64; ++kt) {
    __syncthreads();
    {
      const int pos = kt * 64 + lkey;
      const bool own = (!latent) || pos < 4096;
      const int row = own ? krow0 + pos : T_ALL + b * 256 + (pos - 4096);
      const u16* srcn = p.KN + (size_t)row * 512 + h * 128 + lpart * 8;
      const u16* srcr = own ? p.P + (size_t)(krow0 + pos) * PW + P_MKR + lpart * 8
                            : p.KRC + (size_t)(b * 256 + pos - 4096) * 64 + lpart * 8;
      u16* dk = sK + lkey * 200 + lpart * 8;
      const uint4 k0 = *(const uint4*)(srcn), k1 = *(const uint4*)(srcn + 32), k2 = *(const uint4*)(srcn + 64), k3 = *(const uint4*)(srcn + 96);
      const uint4 k4 = *(const uint4*)(srcr), k5 = *(const uint4*)(srcr + 32);
      *(uint4*)(dk) = k0; *(uint4*)(dk + 32) = k1; *(uint4*)(dk + 64) = k2; *(uint4*)(dk + 96) = k3;
      *(uint4*)(dk + 128) = k4; *(uint4*)(dk + 160) = k5;
    }
    asm volatile("" ::: "memory");
    {
      const u16* sv = vt + (size_t)ldv * nkeys + kt * 64 + lhalf * 32;
      u16* dvp = sV + ldv * 72 + lhalf * 32;
      const uint4 v0 = *(const uint4*)(sv), v1 = *(const uint4*)(sv + 8), v2 = *(const uint4*)(sv + 16), v3 = *(const uint4*)(sv + 24);
      *(uint4*)(dvp) = v0; *(uint4*)(dvp + 8) = v1; *(uint4*)(dvp + 16) = v2; *(uint4*)(dvp + 24) = v3;
    }
    __syncthreads();
    f32x4 s[2][4];
#pragma unroll
    for (int mi = 0; mi < 2; ++mi)
#pragma unroll
      for (int ni = 0; ni < 4; ++ni) s[mi][ni] = f32x4{0.f, 0.f, 0.f, 0.f};
#pragma unroll
    for (int ks = 0; ks < 6; ++ks)
#pragma unroll
      for (int ni = 0; ni < 4; ++ni) {
        bf16x8 kf = *(const bf16x8*)(sK + (ni * 16 + r16) * 200 + ks * 32 + g4 * 8);
        s[0][ni] = __builtin_amdgcn_mfma_f32_16x16x32_bf16(q[0][ks], kf, s[0][ni], 0, 0, 0);
        s[1][ni] = __builtin_amdgcn_mfma_f32_16x16x32_bf16(q[1][ks], kf, s[1][ni], 0, 0, 0);
      }
#pragma unroll
    for (int mi = 0; mi < 2; ++mi)
#pragma unroll
      for (int r = 0; r < 4; ++r) {
        float mx = fmaxf(fmaxf(s[mi][0][r], s[mi][1][r]), fmaxf(s[mi][2][r], s[mi][3][r]));
        mx = fmaxf(mx, __shfl_xor(mx, 1)); mx = fmaxf(mx, __shfl_xor(mx, 2));
        mx = fmaxf(mx, __shfl_xor(mx, 4)); mx = fmaxf(mx, __shfl_xor(mx, 8));
        const float mnew = fmaxf(mrow[mi][r], mx);
        const float alpha = __builtin_amdgcn_exp2f(mrow[mi][r] - mnew);
        mrow[mi][r] = mnew;
        float ps = 0.f;
#pragma unroll
        for (int ni = 0; ni < 4; ++ni) {
          float pv = __builtin_amdgcn_exp2f(s[mi][ni][r] - mnew);
          ps += pv;
          sPw[(mi * 16 + g4 * 4 + r) * 72 + ni * 16 + r16] = f2bf(pv);
        }
        ps += __shfl_xor(ps, 1); ps += __shfl_xor(ps, 2); ps += __shfl_xor(ps, 4); ps += __shfl_xor(ps, 8);
        lrow[mi][r] = lrow[mi][r] * alpha + ps;
#pragma unroll
        for (int nd = 0; nd < 8; ++nd) o[mi][nd][r] *= alpha;
      }
    __syncthreads();
#pragma unroll
    for (int ks2 = 0; ks2 < 2; ++ks2) {
      bf16x8 pf0 = *(const bf16x8*)(sPw + (0 * 16 + r16) * 72 + ks2 * 32 + g4 * 8);
      bf16x8 pf1 = *(const bf16x8*)(sPw + (1 * 16 + r16) * 72 + ks2 * 32 + g4 * 8);
#pragma unroll
      for (int nd = 0; nd < 8; ++nd) {
        bf16x8 vf = *(const bf16x8*)(sV + (nd * 16 + r16) * 72 + ks2 * 32 + g4 * 8);
        o[0][nd] = __builtin_amdgcn_mfma_f32_16x16x32_bf16(pf0, vf, o[0][nd], 0, 0, 0);
        o[1][nd] = __builtin_amdgcn_mfma_f32_16x16x32_bf16(pf1, vf, o[1][nd], 0, 0, 0);
      }
    }
  }
#pragma unroll
  for (int mi = 0; mi < 2; ++mi)
#pragma unroll
    for (int r = 0; r < 4; ++r) {
      const float inv = 1.f / lrow[mi][r];
      u16* op = p.HQ + (size_t)(tq0 + w * 32 + mi * 16 + g4 * 4 + r) * 768 + h * 192 + r16;
      if (dummy) op = p.HQ + (size_t)T_ALL * 768 + (size_t)((tq0 + w * 32 + mi * 16 + g4 * 4 + r) % 9216) * 768 + h * 192 + r16;
#pragma unroll
      for (int nd = 0; nd < 8; ++nd) op[nd * 16] = f2bf(o[mi][nd][r] * inv);
    }
}

__device__ __forceinline__ void gbar(unsigned* ctr, unsigned target) {
  asm volatile("s_waitcnt vmcnt(0)" ::: "memory");
  __syncthreads();
  if (tid_l() == 0) {
    __builtin_amdgcn_fence(__ATOMIC_RELEASE, "agent");
    asm volatile("s_waitcnt vmcnt(0)" ::: "memory");
    __hip_atomic_fetch_add(ctr, 1u, __ATOMIC_RELAXED, __HIP_MEMORY_SCOPE_AGENT);
    while (__hip_atomic_load(ctr, __ATOMIC_RELAXED, __HIP_MEMORY_SCOPE_AGENT) < target) __builtin_amdgcn_s_sleep(2);
    __builtin_amdgcn_fence(__ATOMIC_ACQUIRE, "agent");
    asm volatile("s_waitcnt vmcnt(0)" ::: "memory");
  }
  __syncthreads();
}
#define MFMA4(a, b, c) __builtin_amdgcn_mfma_f32_16x16x4f32((a), (b), (c), 0, 0, 0)

__device__ __forceinline__ float softplusf_(float x) { return fmaxf(x, 0.f) + log1pf(__expf(-fabsf(x))); }

__device__ __forceinline__ void gdn_chain(const Params& p, int l, int seq, int h, int d, int vs, float* sm) {
  float* sMM = sm;
  float* sK = sMM + 64 * 68;
  float* sW = sK + 64 * 65;
  float* sV = sW + 64 * 65;
  float* sS = sV + 64 * 33;
  float* sGc = sS + 64 * 33;
  float* sBeta = sGc + 64;
  float* sBg = sBeta + 64;
  const int tid = tid_l(), lane = tid & 63, w = tid >> 6, r16 = lane & 15, g4 = lane >> 4;
  const bool latent = seq >= 16;
  const int len = latent ? 4096 : 256;
  const int t0 = latent ? T_CTX + (seq - 16) * 4096 : seq * 256;
  const int nchunks = len >> 6;
  const int c2 = tid % 80, rg = tid / 80;
  const int lc = 2 * c2;
  int gch;
  if (lc < 64) gch = h * 64 + lc; else if (lc < 128) gch = 256 + h * 64 + (lc - 64); else gch = 512 + h * 64 + vs * 32 + (lc - 128);
  float cwa[5], cwb[5];
#pragma unroll
  for (int j = 0; j < 5; ++j) {
    cwa[j] = p.gdn_conv_w[((size_t)l * 768 + gch) * 5 + j];
    cwb[j] = p.gdn_conv_w[((size_t)l * 768 + gch + 1) * 5 + j];
  }
  const float Acoef = -__expf(p.gdn_a_log[l * 8 + d * 4 + h]);
  const float dtb = p.gdn_dt_bias[l * 8 + d * 4 + h];
  f32x4 Sreg[2];
  __syncthreads();
  {
    const float* s0 = latent ? p.state_gdn + ((((size_t)(seq - 16) * 2 + l) * 2 + d) * 4 + h) * 4096 : nullptr;
#pragma unroll
    for (int n = 0; n < 2; ++n)
#pragma unroll
      for (int r = 0; r < 4; ++r) {
        const int kidx = 16 * w + g4 * 4 + r, cc = n * 16 + r16;
        float v = latent ? s0[kidx * 64 + vs * 32 + cc] : 0.f;
        Sreg[n][r] = v;
        sS[kidx * 33 + cc] = v;
      }
  }
  const u16* Pb = p.P + (size_t)t0 * PW;
  u16* sRaw = (u16*)sMM;
  u16* sRawV = (u16*)(sBg + 64);
#define GDN_UNIT(i, tl, rr, un, pgo_, plo_) \
    const int e_ = (tl) + (i) * 256; const int rr = e_ / 20, un = e_ % 20; const bool val_ = e_ < 1360; \
    const int pgo_ = rr * PW + (un < 8 ? h * 64 + un * 8 : (un < 16 ? 256 + h * 64 + (un - 8) * 8 : 512 + h * 64 + vs * 32 + (un - 16) * 8)); \
    const int plo_ = un < 16 ? rr * 128 + un * 8 : (int)(sRawV - sRaw) + rr * 32 + (un - 16) * 8;
  uint4 pf[6];
  float pga = 0.f, pgb = 0.f;
  {
    const int tlo = d == 0 ? 0 : len - 64;
#pragma unroll
    for (int i = 0; i < 6; ++i) {
      GDN_UNIT(i, tid, rr, un, pgo_, plo_)
      const int tau = tlo - 2 + rr;
      pf[i] = (val_ && tau >= 0 && tau < len) ? *(const uint4*)(Pb + (ptrdiff_t)(tlo - 2) * PW + pgo_) : make_uint4(0, 0, 0, 0);
    }
    if (tid < 64) {
      const int u = d == 0 ? tid : 63 - tid;
      const float* gab = p.GAB + (size_t)(t0 + tlo + u) * 16;
      pga = gab[d * 4 + h]; pgb = gab[8 + d * 4 + h];
    }
  }
  for (int n = 0; n < nchunks; ++n) {
    const int tlo = d == 0 ? n * 64 : len - 64 * (n + 1);
    const int tl2 = tid_l();
#pragma unroll
    for (int i = 0; i < 6; ++i) {
      GDN_UNIT(i, tl2, rr, un, pgo_, plo_)
      if (val_) *(uint4*)(sRaw + plo_) = pf[i];
    }
    const float ga_cur = pga, gb_cur = pgb;
    __syncthreads();
    if (n + 1 < nchunks) {
      const int tlo2 = d == 0 ? (n + 1) * 64 : len - 64 * (n + 2);
#pragma unroll
      for (int i = 0; i < 6; ++i) {
        GDN_UNIT(i, tl2, rr, un, pgo_, plo_)
        const int tau = tlo2 - 2 + rr;
        pf[i] = (val_ && tau >= 0 && tau < len) ? *(const uint4*)(Pb + (ptrdiff_t)(tlo2 - 2) * PW + pgo_) : make_uint4(0, 0, 0, 0);
      }
      if (tid < 64) {
        const int u = d == 0 ? tid : 63 - tid;
        const float* gab = p.GAB + (size_t)(t0 + tlo2 + u) * 16;
        pga = gab[d * 4 + h]; pgb = gab[8 + d * 4 + h];
      }
    }
    if (tid < 240) {
      const int u0 = rg * 22;
      const u16* rp = lc < 128 ? sRaw + lc : sRawV + (lc - 128);
      const int rst = lc < 128 ? 128 : 32;
      float* dq = lc < 64 ? sW + lc : (lc < 128 ? sK + (lc - 64) : sV + (lc - 128));
      const int dst = lc < 128 ? 65 : 33;
#pragma unroll 1
      for (int hf = 0; hf < 2; ++hf) {
        const int ub = u0 + hf * 11;
        unsigned rv[15];
#pragma unroll
        for (int j = 0; j < 15; ++j) { const int row = ub + j < 67 ? ub + j : 67; rv[j] = *(const unsigned*)(rp + row * rst); }
#pragma unroll
        for (int uu = 0; uu < 11; ++uu) {
          const int u = ub + uu;
          float ya = 0.f, yb = 0.f;
#pragma unroll
          for (int j = 0; j < 5; ++j) {
            ya += cwa[j] * bf2f((u16)(rv[uu + j] & 0xffff));
            yb += cwb[j] * bf2f((u16)(rv[uu + j] >> 16));
          }
          ya = siluf_(ya); yb = siluf_(yb);
          const int pp = d == 0 ? u : 63 - u;
          if (u < 64) { dq[pp * dst] = ya; dq[pp * dst + 1] = yb; }
        }
      }
    }
    if (tid < 64) {
      const int pp = tid;
      float g = Acoef * softplusf_(ga_cur + dtb);
      float bt = sigmoidf_(gb_cur);
#pragma unroll
      for (int o = 1; o < 64; o <<= 1) { float tt = __shfl_up(g, o); if (lane >= o) g += tt; }
      sGc[pp] = g; sBeta[pp] = bt; sBg[pp] = bt * __expf(g);
    }
    __syncthreads();
    {
      const int row = tid >> 2, q4 = tid & 3;
      float sq = 0.f, sk = 0.f;
#pragma unroll
      for (int i = 0; i < 16; ++i) { float a = sW[row * 65 + q4 * 16 + i], b = sK[row * 65 + q4 * 16 + i]; sq += a * a; sk += b * b; }
      sq += __shfl_xor(sq, 1); sq += __shfl_xor(sq, 2);
      sk += __shfl_xor(sk, 1); sk += __shfl_xor(sk, 2);
      const float rq = rsqrtf(sq + 1e-6f) * 0.125f, rk = rsqrtf(sk + 1e-6f);
#pragma unroll
      for (int i = 0; i < 16; ++i) { sW[row * 65 + q4 * 16 + i] *= rq; sK[row * 65 + q4 * 16 + i] *= rk; }
    }
    __syncthreads();
    float qa[16];
#pragma unroll
    for (int s = 0; s < 16; ++s) qa[s] = sW[(16 * w + r16) * 65 + 4 * s + g4];
    const unsigned tcode = w == 0 ? 0x730u : (w == 1 ? 0xA51u : (w == 2 ? 0x062u : 0x0FBu));
    const int tcnt = w < 2 ? 3 : 2;
    f32x4 attacc[3];
#pragma unroll
    for (int t = 0; t < 3; ++t) {
      attacc[t] = f32x4{0.f, 0.f, 0.f, 0.f};
      if (t < tcnt) {
        const int ti = (tcode >> (4 * t)) & 3, tn = (tcode >> (4 * t + 2)) & 3;
        f32x4 accm = f32x4{0.f, 0.f, 0.f, 0.f};
        const float* ak = sK + (16 * ti + r16) * 65 + g4;
        const float* aq = sW + (16 * ti + r16) * 65 + g4;
        const float* bk = sK + (16 * tn + r16) * 65 + g4;
#pragma unroll
        for (int s = 0; s < 16; ++s) {
          const float bv = bk[4 * s];
          accm = MFMA4(ak[4 * s], bv, accm);
          attacc[t] = MFMA4(aq[4 * s], bv, attacc[t]);
        }
#pragma unroll
        for (int r = 0; r < 4; ++r) {
          const int i = 16 * ti + g4 * 4 + r, j = 16 * tn + r16;
          sMM[i * 68 + j] = (i > j) ? sBeta[i] * accm[r] * __expf(sGc[i] - sGc[j]) : 0.f;
        }
      }
    }
    __syncthreads();
    for (int ib = 0; ib < 4; ++ib) {
#pragma unroll
      for (int tt = 0; tt < 2; ++tt) {
        const int ct = w + 4 * tt;
        if (ct < 6) {
          f32x4 acc = f32x4{0.f, 0.f, 0.f, 0.f};
          const float* am = sMM + (16 * ib + r16) * 68 + g4;
          const float* bx = ct < 4 ? sW + g4 * 65 + 16 * ct + r16 : sV + g4 * 33 + 16 * (ct - 4) + r16;
          const int bst = ct < 4 ? 65 : 33;
          for (int s = 0; s < 4 * ib; ++s) acc = MFMA4(am[4 * s], bx[4 * s * bst], acc);
#pragma unroll
          for (int r = 0; r < 4; ++r) {
            const int i = 16 * ib + g4 * 4 + r;
            if (ct < 4) { const int c = 16 * ct + r16; sW[i * 65 + c] = sK[i * 65 + c] * sBg[i] - acc[r]; }
            else { const int c = 16 * (ct - 4) + r16; sV[i * 33 + c] = sV[i * 33 + c] * sBeta[i] - acc[r]; }
          }
        }
      }
      __syncthreads();
      if (tid < 96) {
        const int c = tid;
        float* colp = (c < 64 ? sW + c : sV + (c - 64)) + (16 * ib) * (c < 64 ? 65 : 33);
        const int cst = c < 64 ? 65 : 33;
        const float* md = sMM + (16 * ib) * 68 + 16 * ib;
        float a[16];
#pragma unroll
        for (int r = 0; r < 16; ++r) a[r] = colp[r * cst];
#pragma unroll
        for (int r = 1; r < 16; ++r) {
          if (r == 4 || r == 8 || r == 10 || r == 12 || r == 14) asm volatile("" ::: "memory");
#pragma unroll
          for (int q4 = 0; q4 < (r + 3) / 4; ++q4) {
            const float4 m = *(const float4*)(md + r * 68 + 4 * q4);
            if (q4 * 4 + 0 < r) a[r] -= m.x * a[q4 * 4 + 0];
            if (q4 * 4 + 1 < r) a[r] -= m.y * a[q4 * 4 + 1];
            if (q4 * 4 + 2 < r) a[r] -= m.z * a[q4 * 4 + 2];
            if (q4 * 4 + 3 < r) a[r] -= m.w * a[q4 * 4 + 3];
          }
        }
#pragma unroll
        for (int r = 1; r < 16; ++r) colp[r * cst] = a[r];
      }
      __syncthreads();
    }
#pragma unroll
    for (int t = 0; t < 3; ++t) {
      if (t < tcnt) {
        const int ti = (tcode >> (4 * t)) & 3, tn = (tcode >> (4 * t + 2)) & 3;
#pragma unroll
        for (int r = 0; r < 4; ++r) {
          const int i = 16 * ti + g4 * 4 + r, j = 16 * tn + r16;
          sMM[i * 68 + j] = (i >= j) ? attacc[t][r] * __expf(sGc[i] - sGc[j]) : 0.f;
        }
      }
    }
    {
      f32x4 acc[2] = {f32x4{0.f, 0.f, 0.f, 0.f}, f32x4{0.f, 0.f, 0.f, 0.f}};
#pragma unroll
      for (int s = 0; s < 16; ++s) {
        const float a = sW[(16 * w + r16) * 65 + 4 * s + g4];
        acc[0] = MFMA4(a, sS[(4 * s + g4) * 33 + r16], acc[0]);
        acc[1] = MFMA4(a, sS[(4 * s + g4) * 33 + 16 + r16], acc[1]);
      }
#pragma unroll
      for (int nn = 0; nn < 2; ++nn)
#pragma unroll
        for (int r = 0; r < 4; ++r) {
          const int i = 16 * w + g4 * 4 + r, cc = nn * 16 + r16;
          sV[i * 33 + cc] = sV[i * 33 + cc] - acc[nn][r];
        }
    }
    __syncthreads();
    {
      f32x4 acc[2] = {f32x4{0.f, 0.f, 0.f, 0.f}, f32x4{0.f, 0.f, 0.f, 0.f}};
      const float eg = __expf(sGc[16 * w + r16]);
#pragma unroll
      for (int s = 0; s < 16; ++s) {
        const float a = qa[s] * eg;
        acc[0] = MFMA4(a, sS[(4 * s + g4) * 33 + r16], acc[0]);
        acc[1] = MFMA4(a, sS[(4 * s + g4) * 33 + 16 + r16], acc[1]);
      }
#pragma unroll
      for (int s = 0; s < 16; ++s) {
        if (s < 4 * (w + 1)) {
          const float a = sMM[(16 * w + r16) * 68 + 4 * s + g4];
          acc[0] = MFMA4(a, sV[(4 * s + g4) * 33 + r16], acc[0]);
          acc[1] = MFMA4(a, sV[(4 * s + g4) * 33 + 16 + r16], acc[1]);
        }
      }
#pragma unroll
      for (int nn = 0; nn < 2; ++nn)
#pragma unroll
        for (int r = 0; r < 4; ++r) {
          const int pp = 16 * w + g4 * 4 + r;
          const int u = d == 0 ? pp : 63 - pp;
          p.MIX[(size_t)(t0 + tlo + u) * 1024 + d * 256 + h * 64 + vs * 32 + nn * 16 + r16] = f2bf(acc[nn][r]);
        }
    }
    __syncthreads();
    {
      const float g63 = sGc[63];
      const float gl = __expf(g63);
#pragma unroll
      for (int nn = 0; nn < 2; ++nn)
#pragma unroll
        for (int r = 0; r < 4; ++r) Sreg[nn][r] *= gl;
#pragma unroll
      for (int s = 0; s < 16; ++s) {
        const int srow = 4 * s + g4;
        const float a = sK[srow * 65 + 16 * w + r16] * __expf(g63 - sGc[srow]);
        Sreg[0] = MFMA4(a, sV[srow * 33 + r16], Sreg[0]);
        Sreg[1] = MFMA4(a, sV[srow * 33 + 16 + r16], Sreg[1]);
      }
    }
    __syncthreads();
#pragma unroll
    for (int nn = 0; nn < 2; ++nn)
#pragma unroll
      for (int r = 0; r < 4; ++r) sS[(16 * w + g4 * 4 + r) * 33 + nn * 16 + r16] = Sreg[nn][r];
    __syncthreads();
  }
  if (!latent) {
    float* so = p.out + OUT_SGDN + ((((size_t)seq * 2 + l) * 2 + d) * 4 + h) * 4096;
#pragma unroll
    for (int nn = 0; nn < 2; ++nn)
#pragma unroll
      for (int r = 0; r < 4; ++r) so[(16 * w + g4 * 4 + r) * 64 + vs * 32 + nn * 16 + r16] = Sreg[nn][r];
  }
}

__device__ __forceinline__ void hgrn_chain(const Params& p, int l, int seq, int h, int d, int vs, float* sm) {
  float* sBC = sm;
  float* sK = sBC + 64 * 65;
  float* sAT = sK + 64 * 65;
  float* sV = sAT + 64 * 68;
  float* sS = sV + 64 * 33;
  float* sTot = sS + 64 * 33;
  const int tid = tid_l(), lane = tid & 63, w = tid >> 6, r16 = lane & 15, g4 = lane >> 4;
  const bool latent = seq >= 16;
  const int len = latent ? 4096 : 256;
  const int t0 = latent ? T_CTX + (seq - 16) * 4096 : seq * 256;
  const int nchunks = len >> 6;
  float lbk;
  {
    const int kch = h * 64 + (tid & 63);
    lbk = (l == 0) ? 0.f : sigmoidf_(p.hgrn_lb[256 + kch] - p.hgrn_lb[kch]);
  }
  f32x4 Sreg[2];
  __syncthreads();
  {
    const float* s0 = latent ? p.state_hgrn + ((((size_t)(seq - 16) * 2 + l) * 2 + d) * 4 + h) * 4096 : nullptr;
#pragma unroll
    for (int n = 0; n < 2; ++n)
#pragma unroll
      for (int r = 0; r < 4; ++r) {
        const int kidx = 16 * w + g4 * 4 + r, cc = n * 16 + r16;
        float v = latent ? s0[kidx * 64 + vs * 32 + cc] : 0.f;
        Sreg[n][r] = v;
        sS[kidx * 33 + cc] = v;
      }
  }
  const u16* Pb = p.P + (size_t)t0 * PW;
  float* sLb = sTot + 256;
  if (tid < 64) sLb[tid] = lbk;
  __syncthreads();
  int pgo[5];
#pragma unroll
  for (int i = 0; i < 5; ++i) {
    const int e = tid + i * 256;
    const int u = e / 20, un = e % 20;
    pgo[i] = u * PW + (un < 8 ? P_HF + d * 256 + h * 64 + un * 8 : (un < 12 ? P_HI + h * 64 + vs * 32 + (un - 8) * 8 : P_HQ + h * 64 + (un - 12) * 8));
  }
  uint4 pf[5];
  {
    const int tlo = d == 0 ? 0 : len - 64;
#pragma unroll
    for (int i = 0; i < 5; ++i) pf[i] = *(const uint4*)(Pb + (size_t)tlo * PW + pgo[i]);
  }
  for (int n = 0; n < nchunks; ++n) {
#pragma unroll
    for (int i = 0; i < 5; ++i) {
      const int e = tid + i * 256;
      const int u = e / 20, un = e % 20;
      const int pp = d == 0 ? u : 63 - u;
      const unsigned wv[4] = {pf[i].x, pf[i].y, pf[i].z, pf[i].w};
#pragma unroll
      for (int j = 0; j < 8; ++j) {
        const float x = bf2f((u16)((wv[j >> 1] >> ((j & 1) * 16)) & 0xffff));
        if (un < 8) {
          const int k = un * 8 + j;
          const float lb = sLb[k];
          const float sg_ = sigmoidf_(x);
          const float gate = lb + (1.f - lb) * sg_;
          sBC[pp * 65 + k] = __logf(fmaxf(gate, 1e-30f));
          sK[pp * 65 + k] = (1.f - lb) * (1.f - sg_);
        } else if (un < 12) {
          sV[pp * 33 + (un - 8) * 8 + j] = x;
        } else {
          sAT[pp * 68 + (un - 12) * 8 + j] = x;
        }
      }
    }
    __syncthreads();
    if (n + 1 < nchunks) {
      const int tlo2 = d == 0 ? (n + 1) * 64 : len - 64 * (n + 2);
#pragma unroll
      for (int i = 0; i < 5; ++i) pf[i] = *(const uint4*)(Pb + (size_t)tlo2 * PW + pgo[i]);
    }
    const int tlo = d == 0 ? n * 64 : len - 64 * (n + 1);
    float cs[16];
    {
      const int k = tid & 63, sg = tid >> 6;
      float run = 0.f;
#pragma unroll
      for (int i = 0; i < 16; ++i) { run += sBC[(16 * sg + i) * 65 + k]; cs[i] = run; }
      sTot[sg * 64 + k] = run;
    }
    float qa[16];
#pragma unroll
    for (int s = 0; s < 16; ++s) qa[s] = sAT[(16 * w + r16) * 68 + 4 * s + g4];
    __syncthreads();
    {
      const int k = tid & 63, sg = tid >> 6;
      float off = 0.f;
      for (int s2 = 0; s2 < sg; ++s2) off += sTot[s2 * 64 + k];
#pragma unroll
      for (int i = 0; i < 16; ++i) sBC[(16 * sg + i) * 65 + k] = cs[i] + off;
    }
    __syncthreads();
    {
      float aq[16], rf[16];
#pragma unroll
      for (int s = 0; s < 16; ++s) {
        const int kk = 4 * s + g4;
        rf[s] = (w == 0) ? 0.f : sBC[(16 * w - 1) * 65 + kk];
        aq[s] = qa[s] * __expf(sBC[(16 * w + r16) * 65 + kk] - rf[s]);
      }
#pragma unroll
      for (int nn = 0; nn < 4; ++nn) {
        f32x4 acc = f32x4{0.f, 0.f, 0.f, 0.f};
        if (nn <= w) {
#pragma unroll
          for (int s = 0; s < 16; ++s) {
            const int kk = 4 * s + g4, sc = 16 * nn + r16;
            const float bv = sK[sc * 65 + kk] * __expf(fminf(rf[s] - sBC[sc * 65 + kk], 80.f));
            acc = MFMA4(aq[s], bv, acc);
          }
        }
#pragma unroll
        for (int r = 0; r < 4; ++r) {
          const int i = 16 * w + g4 * 4 + r, j = 16 * nn + r16;
          sAT[i * 68 + j] = (i >= j) ? acc[r] : 0.f;
        }
      }
    }
    __syncthreads();
    {
      f32x4 acc[2] = {f32x4{0.f, 0.f, 0.f, 0.f}, f32x4{0.f, 0.f, 0.f, 0.f}};
#pragma unroll
      for (int s = 0; s < 16; ++s) {
        const int kk = 4 * s + g4;
        const float a = qa[s] * __expf(sBC[(16 * w + r16) * 65 + kk]);
        acc[0] = MFMA4(a, sS[kk * 33 + r16], acc[0]);
        acc[1] = MFMA4(a, sS[kk * 33 + 16 + r16], acc[1]);
      }
#pragma unroll
      for (int s = 0; s < 16; ++s) {
        if (s < 4 * (w + 1)) {
          const float a = sAT[(16 * w + r16) * 68 + 4 * s + g4];
          acc[0] = MFMA4(a, sV[(4 * s + g4) * 33 + r16], acc[0]);
          acc[1] = MFMA4(a, sV[(4 * s + g4) * 33 + 16 + r16], acc[1]);
        }
      }
#pragma unroll
      for (int nn = 0; nn < 2; ++nn)
#pragma unroll
        for (int r = 0; r < 4; ++r) {
          const int pp = 16 * w + g4 * 4 + r;
          const int u = d == 0 ? pp : 63 - pp;
          p.MIX[(size_t)(t0 + tlo + u) * 1024 + 512 + d * 256 + h * 64 + vs * 32 + nn * 16 + r16] = f2bf(acc[nn][r]);
        }
    }
    __syncthreads();
    {
#pragma unroll
      for (int nn = 0; nn < 2; ++nn)
#pragma unroll
        for (int r = 0; r < 4; ++r) Sreg[nn][r] *= __expf(sBC[63 * 65 + 16 * w + g4 * 4 + r]);
      const int kA = 16 * w + r16;
      const float blA = sBC[63 * 65 + kA];
#pragma unroll
      for (int s = 0; s < 16; ++s) {
        const int srow = 4 * s + g4;
        const float a = sK[srow * 65 + kA] * __expf(blA - sBC[srow * 65 + kA]);
        Sreg[0] = MFMA4(a, sV[srow * 33 + r16], Sreg[0]);
        Sreg[1] = MFMA4(a, sV[srow * 33 + 16 + r16], Sreg[1]);
      }
    }
    __syncthreads();
#pragma unroll
    for (int nn = 0; nn < 2; ++nn)
#pragma unroll
      for (int r = 0; r < 4; ++r) sS[(16 * w + g4 * 4 + r) * 33 + nn * 16 + r16] = Sreg[nn][r];
    __syncthreads();
  }
  if (!latent) {
    float* so = p.out + OUT_SHG + ((((size_t)seq * 2 + l) * 2 + d) * 4 + h) * 4096;
#pragma unroll
    for (int nn = 0; nn < 2; ++nn)
#pragma unroll
      for (int r = 0; r < 4; ++r) so[(16 * w + g4 * 4 + r) * 64 + vs * 32 + nn * 16 + r16] = Sreg[nn][r];
  }
}

__device__ __forceinline__ void phase_c(const Params& p, int l, unsigned char* smraw, int mode = 0) {
  __shared__ int s_item;
  const int total = 1920;
  for (;;) {
    __syncthreads();
    if (tid_l() == 0) s_item = (int)atomicAdd(&p.counters[l * 64 + mode * 16], 1u);
    __syncthreads();
    const int item = s_item;
    if (item >= total) break;
    int kind, a0, a1, a2, a3;
    if (item < 256 || (item >= 1280 && item < 1792)) {
      const int i2 = item < 256 ? item : item - 1280;
      const int rest = i2 >> 1;
      kind = i2 & 1;
      a3 = rest & 1; a2 = (rest >> 1) & 1; a1 = (rest >> 2) & 3; a0 = (rest >> 4) + (item < 256 ? 16 : 0);
    } else if (item < 1280) {
      const int i2 = item - 256;
      kind = 2; a0 = 1; a1 = i2 >> 7; a2 = (i2 >> 5) & 3; a3 = i2 & 31;
    } else {
      const int i2 = item - 1792;
      kind = 2; a0 = 0; a1 = i2 >> 3; a2 = (i2 >> 1) & 3; a3 = i2 & 1;
    }
    if (mode == 1 && kind == 2) continue;
    if (mode == 2 && kind != 2) continue;
    if (kind == 0) gdn_chain(p, l, a0, a1, a2, a3, (float*)smraw);
    else if (kind == 1) hgrn_chain(p, l, a0, a1, a2, a3, (float*)smraw);
    else attn_item(p, a0, a1, a2, a3, smraw, mode == 2);
  }
}

__global__ void __launch_bounds__(NTHR, 2) mega(Params p) {
  __shared__ __attribute__((aligned(16))) unsigned char smem[LDS_BYTES];
  cg::grid_group grid = cg::this_grid();
  unsigned* bar = p.counters + 128;
  unsigned nb = 0;
  const unsigned G = gridDim.x;
#define GSYNC() gbar(bar, (++nb) * G)
  phase0(p, (float*)smem);
  grid.sync();
  rowpass_norm(p, 0, 0);
  GSYNC();
  for (int l = 0; l < 2; ++l) {
    phase_a(p, l, (u16*)smem);
    GSYNC();
    rowpass_b0(p, l);
    GSYNC();
    phase_b1(p, l, (u16*)smem);
    GSYNC();
    phase_c(p, l, smem);
    GSYNC();
    rowpass_c2(p, l);
    GSYNC();
    phase_gemm_y(p.MIX, 1024, p.WoutT + (size_t)l * 1024 * 1024, 1024, 1024, p.HQ, 1024, (u16*)smem);
    GSYNC();
    rowpass_norm(p, l, 1);
    GSYNC();
    phase_e(p, l, (u16*)smem);
    GSYNC();
    phase_gemm_y(p.P, DFF, p.WfoT + (size_t)l * 1024 * DFF, DFF, 1024, p.HQ, 1024, (u16*)smem);
    GSYNC();
    rowpass_norm(p, l, 2);
    if (l == 0) GSYNC();
  }
}

extern "C" void kernel_launch(void* const* d_in, const int* in_sizes, int n_in, void* d_out, int out_size, void* d_ws,
                              size_t ws_size, hipStream_t stream) {
  static int grid_blocks = 0;
  if (!grid_blocks) {
    int dev = 0, cus = 0, per_cu = 0;
    hipGetDevice(&dev);
    hipDeviceGetAttribute(&cus, hipDeviceAttributeMultiprocessorCount, dev);
    hipOccupancyMaxActiveBlocksPerMultiprocessor(&per_cu, mega, NTHR, 0);
    if (per_cu > 2) per_cu = 2;
    if (per_cu < 1) per_cu = 1;
    grid_blocks = cus * per_cu;
  }
  Params p{};
  const float* const* in = (const float* const*)d_in;
  p.x_prompt = in[0]; p.x_sample = in[1]; p.cache_ckv = in[2]; p.cache_kr = in[3]; p.state_gdn = in[4]; p.state_hgrn = in[5];
  p.c = in[6]; p.c_ctx = in[7]; p.w_ada = in[8]; p.b_ada = in[9]; p.g_pre_mix = in[10]; p.g_post_mix = in[11];
  p.g_pre_ffn = in[12]; p.g_post_ffn = in[13]; p.w_in = in[14]; p.w_out = in[15]; p.gdn_conv_w = in[16];
  p.gdn_a_log = in[17]; p.gdn_dt_bias = in[18]; p.gdn_norm_w = in[19]; p.hgrn_lb = in[20]; p.hgrn_norm_w = in[21];
  p.mla_q_norm_w = in[22]; p.mla_w_uq = in[23]; p.mla_kv_norm_w = in[24]; p.mla_w_ukv = in[25]; p.w_ffn_in = in[26];
  p.w_ffn_out = in[27];
  p.out = (float*)d_out;
  unsigned char* ws = (unsigned char*)d_ws;
  size_t off = 0;
  auto take = [&](size_t bytes) { unsigned char* r = ws + off; off += (bytes + 255) & ~(size_t)255; return r; };
  p.counters = (unsigned*)take(1024);
  p.WinT = (u16*)take((size_t)2 * 3072 * 1024 * 2);
  p.WuqT = (u16*)take((size_t)2 * 768 * 384 * 2);
  p.WukvT = (u16*)take((size_t)2 * 1024 * 256 * 2);
  p.WoutT = (u16*)take((size_t)2 * 1024 * 1024 * 2);
  p.WfiT = (u16*)take((size_t)2 * 5632 * 1024 * 2);
  p.WfoT = (u16*)take((size_t)2 * 1024 * 2816 * 2);
  p.mod = (float*)take((size_t)2 * 9 * 6144 * 4);
  p.HQ = (u16*)take((size_t)T_ALL * 1024 * 2);
  p.P = (u16*)take((size_t)T_ALL * PW * 2);
  p.KN = (u16*)take((size_t)(T_ALL + 2048) * 512 * 2);
  p.VTL = (u16*)take((size_t)8 * 4 * 128 * 4352 * 2);
  p.VTC = (u16*)take((size_t)16 * 4 * 128 * 256 * 2);
  p.CKVC = (u16*)take((size_t)2048 * 256 * 2);
  p.KRC = (u16*)take((size_t)2048 * 64 * 2);
  p.GAB = (float*)take((size_t)T_ALL * 16 * 4);
  p.MIX = (u16*)take((size_t)T_ALL * 1024 * 2);
  if (off > ws_size) { fprintf(stderr, "workspace too small: need %zu have %zu\n", off, ws_size); return; }
  hipMemsetAsync(p.counters, 0, 1024, stream);
  void* args[] = {&p};
  hipError_t e = hipLaunchCooperativeKernel((void*)mega, dim3(grid_blocks), dim3(NTHR), args, 0, stream);
  if (e != hipSuccess) fprintf(stderr, "cooperative launch failed: %s (grid %d)\n", hipGetErrorString(e), grid_blocks);
}
```

```cpp
#include <hip/hip_runtime.h>
#include <hip/hip_cooperative_groups.h>
#include <cstdio>
namespace cg = cooperative_groups;

typedef unsigned short u16;
using bf16x8 = __attribute__((ext_vector_type(8))) short;
using f32x4  = __attribute__((ext_vector_type(4))) float;

#define T_CTX 4096
#define T_ALL 36864
#define PW 3072
#define DFF 2816
#define LDS_BYTES 73728
#define NTHR 256

#define P_GQKV 0
#define P_GZ 768
#define P_HQ 1024
#define P_HI 1280
#define P_HF 1536
#define P_HG 2048
#define P_MCQ 2304
#define P_MCKV 2688
#define P_MKR 2944
#define P_GA 3008

struct Params {
  const float *x_prompt, *x_sample, *cache_ckv, *cache_kr, *state_gdn, *state_hgrn, *c, *c_ctx;
  const float *w_ada, *b_ada, *g_pre_mix, *g_post_mix, *g_pre_ffn, *g_post_ffn, *w_in, *w_out;
  const float *gdn_conv_w, *gdn_a_log, *gdn_dt_bias, *gdn_norm_w, *hgrn_lb, *hgrn_norm_w;
  const float *mla_q_norm_w, *mla_w_uq, *mla_kv_norm_w, *mla_w_ukv, *w_ffn_in, *w_ffn_out;
  float* out;
  u16 *WinT, *WuqT, *WukvT, *WoutT, *WfiT, *WfoT;
  float* mod;
  u16 *HQ, *P, *KN, *VTL, *VTC, *CKVC, *KRC, *MIX;
  float* GAB;
  unsigned* counters;
  unsigned* xbar;
};

#define OUT_CKV   37748736
#define OUT_KR    39845888
#define OUT_SGDN  40370176
#define OUT_SHG   41418752

__device__ __forceinline__ u16 f2bf(float f) {
  unsigned u = __float_as_uint(f);
  u += 0x7fffu + ((u >> 16) & 1u);
  return (u16)(u >> 16);
}
__device__ __forceinline__ float bf2f(u16 h) { return __uint_as_float(((unsigned)h) << 16); }
__device__ __forceinline__ float wave_sum(float v) {
#pragma unroll
  for (int o = 32; o > 0; o >>= 1) v += __shfl_xor(v, o);
  return v;
}
__device__ __forceinline__ float sigmoidf_(float x) { return __builtin_amdgcn_rcpf(1.f + __expf(-x)); }
__device__ __forceinline__ float siluf_(float x) { return x * __builtin_amdgcn_rcpf(1.f + __expf(-x)); }
__device__ __forceinline__ int tid_l() { int t = threadIdx.x; asm volatile("" : "+v"(t)); return t; }
__device__ __forceinline__ int tok_mod(int t) { return t < T_CTX ? 0 : 1 + ((t - T_CTX) >> 12); }

__device__ __forceinline__ int map_col(int kind, int j) {
  if (kind == 0) return j;
  if (kind == 1) { if (j < 1024) return j; if (j < 3008) return j + 16; if (j < 3024) return 1024 + (j - 3008); return -1; }
  int blk = j >> 6, w = j & 63;
  return w < 32 ? blk * 32 + w : DFF + blk * 32 + (w - 32);
}

__device__ __forceinline__ void cvt_tile(const float* __restrict__ src, int K, int Nsrc, u16* __restrict__ dst, int kind, int jt, int kt, float* sm) {
  const int tid = tid_l();
  const int j0 = jt * 64, k0 = kt * 64;
  __syncthreads();
  {
    int jj = tid & 63, kk0 = tid >> 6;
    int sc = map_col(kind, j0 + jj);
    for (int kk = kk0; kk < 64; kk += 4)
      sm[kk * 65 + jj] = sc >= 0 ? src[(size_t)(k0 + kk) * Nsrc + sc] : 0.f;
  }
  __syncthreads();
  {
    int kk = tid & 63, jj0 = tid >> 6;
    for (int jj = jj0; jj < 64; jj += 4)
      dst[(size_t)(j0 + jj) * K + k0 + kk] = f2bf(sm[kk * 65 + jj]);
  }
}

__device__ __forceinline__ void mod_item(const Params& p, int item, float* sm) {
  const int l = item / 96, j0 = (item % 96) * 64;
  const int tid = tid_l();
  float* sC = sm;
  float* sR = sm + 9 * 1024;
  __syncthreads();
  for (int i = tid; i < 9 * 1024; i += NTHR) {
    int m = i >> 10, k = i & 1023;
    float v = m == 0 ? p.c_ctx[k] : p.c[(m - 1) * 1024 + k];
    sC[i] = siluf_(v);
  }
  __syncthreads();
  const int col = tid & 63, ks = tid >> 6;
  float acc[9];
#pragma unroll
  for (int m = 0; m < 9; ++m) acc[m] = 0.f;
  const float* wp = p.w_ada + (size_t)l * 1024 * 6144 + j0 + col;
  for (int k = ks * 256; k < ks * 256 + 256; ++k) {
    float w = wp[(size_t)k * 6144];
#pragma unroll
    for (int m = 0; m < 9; ++m) acc[m] += sC[m * 1024 + k] * w;
  }
#pragma unroll
  for (int m = 0; m < 9; ++m) sR[(ks * 9 + m) * 64 + col] = acc[m];
  __syncthreads();
  for (int i = tid; i < 9 * 64; i += NTHR) {
    int m = i >> 6, cc = i & 63;
    float v = sR[(0 * 9 + m) * 64 + cc] + sR[(1 * 9 + m) * 64 + cc] + sR[(2 * 9 + m) * 64 + cc] + sR[(3 * 9 + m) * 64 + cc];
    p.mod[((size_t)l * 9 + m) * 6144 + j0 + cc] = v + p.b_ada[l * 6144 + j0 + cc];
  }
}

__device__ __forceinline__ void phase0(const Params& p, float* sm) {
  const int PER_LAYER = 3272;
  const int total = 2 * PER_LAYER + 192;
  for (int item = blockIdx.x; item < total; item += gridDim.x) {
    if (item < 192) { mod_item(p, item, sm); continue; }
    int it = item - 192;
    int l = it / PER_LAYER, r = it % PER_LAYER;
    if (r < 768) { cvt_tile(p.w_in + (size_t)l * 1024 * 3024, 1024, 3024, p.WinT + (size_t)l * 3072 * 1024, 1, r / 16, r % 16, sm); continue; }
    r -= 768;
    if (r < 72) { cvt_tile(p.mla_w_uq + (size_t)l * 384 * 768, 384, 768, p.WuqT + (size_t)l * 768 * 384, 0, r / 6, r % 6, sm); continue; }
    r -= 72;
    if (r < 64) { cvt_tile(p.mla_w_ukv + (size_t)l * 256 * 1024, 256, 1024, p.WukvT + (size_t)l * 1024 * 256, 0, r / 4, r % 4, sm); continue; }
    r -= 64;
    if (r < 256) { cvt_tile(p.w_out + (size_t)l * 1024 * 1024, 1024, 1024, p.WoutT + (size_t)l * 1024 * 1024, 0, r / 16, r % 16, sm); continue; }
    r -= 256;
    if (r < 1408) { cvt_tile(p.w_ffn_in + (size_t)l * 1024 * 5632, 1024, 5632, p.WfiT + (size_t)l * 5632 * 1024, 2, r / 16, r % 16, sm); continue; }
    r -= 1408;
    cvt_tile(p.w_ffn_out + (size_t)l * 2816 * 1024, 2816, 1024, p.WfoT + (size_t)l * 1024 * 2816, 0, r / 44, r % 44, sm);
  }
}

__device__ __forceinline__ void rowpass_norm(const Params& p, int l, int stage) {
  const int tidl = tid_l();
  const int lane = tidl & 63, w = tidl >> 6;
  const int ln = stage == 0 ? 0 : (stage == 1 ? l : l + 1);
  const int sh_off = stage == 1 ? 3072 : 0;
  const float* gpre = stage == 1 ? p.g_pre_ffn + l * 1024 : p.g_pre_mix + (ln < 2 ? ln : 0) * 1024;
  u16* dst = stage == 1 ? p.MIX : p.HQ;
  for (int t = blockIdx.x * 4 + w; t < T_ALL; t += gridDim.x * 4) {
    const int m = tok_mod(t);
    float x[16];
    float* xo = p.out + (size_t)t * 1024;
    if (stage == 0) {
      const float* xi = t < T_CTX ? p.x_prompt + (size_t)t * 1024 : p.x_sample + (size_t)(t - T_CTX) * 1024;
#pragma unroll
      for (int i = 0; i < 4; ++i) {
        float4 v = *(const float4*)(xi + i * 256 + lane * 4);
        x[i * 4 + 0] = v.x; x[i * 4 + 1] = v.y; x[i * 4 + 2] = v.z; x[i * 4 + 3] = v.w;
      }
    } else {
      const u16* yp = p.HQ + (size_t)t * 1024;
      float y[16]; float ss = 0.f;
#pragma unroll
      for (int i = 0; i < 4; ++i) {
        uint2 v = *(const uint2*)(yp + i * 256 + lane * 4);
        y[i * 4 + 0] = bf2f((u16)(v.x & 0xffff)); y[i * 4 + 1] = bf2f((u16)(v.x >> 16));
        y[i * 4 + 2] = bf2f((u16)(v.y & 0xffff)); y[i * 4 + 3] = bf2f((u16)(v.y >> 16));
      }
#pragma unroll
      for (int i = 0; i < 16; ++i) ss += y[i] * y[i];
      ss = wave_sum(ss);
      const float rstd = rsqrtf(ss * (1.f / 1024.f) + 1e-6f);
      const float* gpost = (stage == 1 ? p.g_post_mix : p.g_post_ffn) + l * 1024;
      const float* gt = p.mod + ((size_t)l * 9 + m) * 6144 + (stage == 1 ? 2048 : 5120);
#pragma unroll
      for (int i = 0; i < 4; ++i) {
        float4 xv = *(const float4*)(xo + i * 256 + lane * 4);
        float4 gp = *(const float4*)(gpost + i * 256 + lane * 4);
        float4 gg = *(const float4*)(gt + i * 256 + lane * 4);
        x[i * 4 + 0] = xv.x + gg.x * y[i * 4 + 0] * rstd * gp.x;
        x[i * 4 + 1] = xv.y + gg.y * y[i * 4 + 1] * rstd * gp.y;
        x[i * 4 + 2] = xv.z + gg.z * y[i * 4 + 2] * rstd * gp.z;
        x[i * 4 + 3] = xv.w + gg.w * y[i * 4 + 3] * rstd * gp.w;
      }
    }
    __threadfence_block();
#pragma unroll
    for (int i = 0; i < 4; ++i)
      *(float4*)(xo + i * 256 + lane * 4) = make_float4(x[i * 4 + 0], x[i * 4 + 1], x[i * 4 + 2], x[i * 4 + 3]);
    if (ln >= 2) continue;
    float ss = 0.f;
#pragma unroll
    for (int i = 0; i < 16; ++i) ss += x[i] * x[i];
    ss = wave_sum(ss);
    const float rstd = rsqrtf(ss * (1.f / 1024.f) + 1e-6f);
    const float* sh = p.mod + ((size_t)ln * 9 + m) * 6144 + sh_off;
    const float* sc = sh + 1024;
    u16* hp = dst + (size_t)t * 1024;
#pragma unroll
    for (int i = 0; i < 4; ++i) {
      float4 gp = *(const float4*)(gpre + i * 256 + lane * 4);
      float4 s1 = *(const float4*)(sh + i * 256 + lane * 4);
      float4 c1 = *(const float4*)(sc + i * 256 + lane * 4);
      float h0 = x[i * 4 + 0] * rstd * gp.x * (1.f + c1.x) + s1.x;
      float h1 = x[i * 4 + 1] * rstd * gp.y * (1.f + c1.y) + s1.y;
      float h2 = x[i * 4 + 2] * rstd * gp.z * (1.f + c1.z) + s1.z;
      float h3 = x[i * 4 + 3] * rstd * gp.w * (1.f + c1.w) + s1.w;
      uint2 o;
      o.x = (unsigned)f2bf(h0) | ((unsigned)f2bf(h1) << 16);
      o.y = (unsigned)f2bf(h2) | ((unsigned)f2bf(h3) << 16);
      *(uint2*)(hp + i * 256 + lane * 4) = o;
    }
  }
}

__device__ __forceinline__ void rowpass_b0(const Params& p, int l) {
  const int tidl = tid_l();
  const int lane = tidl & 63, w = tidl >> 6;
  for (int t = blockIdx.x * 4 + w; t < T_ALL + 2048; t += gridDim.x * 4) {
    if (t >= T_ALL) {
      int r = t - T_ALL, b = r >> 8, s = r & 255;
      const float* ck = p.cache_ckv + (((size_t)b * 2 + l) * 256 + s) * 256;
      const float* kr = p.cache_kr + (((size_t)b * 2 + l) * 256 + s) * 64;
#pragma unroll
      for (int i = 0; i < 4; ++i) p.CKVC[(size_t)r * 256 + lane + 64 * i] = f2bf(ck[lane + 64 * i]);
      p.KRC[(size_t)r * 64 + lane] = f2bf(kr[lane]);
      continue;
    }
    u16* pr = p.P + (size_t)t * PW;
    {
      float v[6]; float ss = 0.f;
#pragma unroll
      for (int i = 0; i < 6; ++i) { v[i] = bf2f(pr[P_MCQ + lane + 64 * i]); ss += v[i] * v[i]; }
      ss = wave_sum(ss);
      float rstd = rsqrtf(ss * (1.f / 384.f) + 1e-6f);
#pragma unroll
      for (int i = 0; i < 6; ++i) pr[P_MCQ + lane + 64 * i] = f2bf(v[i] * rstd * p.mla_q_norm_w[l * 384 + lane + 64 * i]);
    }
    {
      float v[4]; float ss = 0.f;
#pragma unroll
      for (int i = 0; i < 4; ++i) { v[i] = bf2f(pr[P_MCKV + lane + 64 * i]); ss += v[i] * v[i]; }
      ss = wave_sum(ss);
      float rstd = rsqrtf(ss * (1.f / 256.f) + 1e-6f);
#pragma unroll
      for (int i = 0; i < 4; ++i) {
        float c = v[i] * rstd * p.mla_kv_norm_w[l * 256 + lane + 64 * i];
        pr[P_MCKV + lane + 64 * i] = f2bf(c);
        if (t < T_CTX) {
          int b = t >> 8, s = t & 255;
          p.out[OUT_CKV + (((size_t)b * 2 + l) * 256 + s) * 256 + lane + 64 * i] = c;
        }
      }
    }
    {
      float v = bf2f(pr[P_MKR + lane]);
      if (t < T_CTX) {
        int b = t >> 8, s = t & 255;
        p.out[OUT_KR + (((size_t)b * 2 + l) * 256 + s) * 64 + lane] = v;
      } else {
        int pos = (t - T_CTX) & 4095;
        int axis = lane >> 5, half = (lane >> 4) & 1, f = lane & 15;
        float posf = axis == 0 ? (float)(pos >> 6) : (float)(pos & 63);
        float inv = exp2f(-(float)f * (13.287712379549449f / 16.f));
        float ang = posf * inv;
        float sn, cs;
        __sincosf(ang, &sn, &cs);
        float other = __shfl_xor(v, 16);
        float o = half == 0 ? v * cs - other * sn : v * cs + other * sn;
        pr[P_MKR + lane] = f2bf(o);
      }
    }
  }
}

__device__ __forceinline__ void rowpass_c2(const Params& p, int l) {
  const int tidl = tid_l();
  const int lane = tidl & 63, w = tidl >> 6;
  for (int t = blockIdx.x * 4 + w; t < T_ALL; t += gridDim.x * 4) {
    u16* mr = p.MIX + (size_t)t * 1024;
    const u16* pr = p.P + (size_t)t * PW;
    const u16* qr = p.HQ + (size_t)t * 768;
    float og[4], oh[4];
#pragma unroll
    for (int h = 0; h < 4; ++h) {
      og[h] = bf2f(mr[h * 64 + lane]) + bf2f(mr[256 + h * 64 + lane]);
      oh[h] = bf2f(mr[512 + h * 64 + lane]) + bf2f(mr[768 + h * 64 + lane]);
    }
    u16 om[8];
#pragma unroll
    for (int i = 0; i < 8; ++i) { int c = lane + 64 * i; om[i] = qr[(c >> 7) * 192 + (c & 127)]; }
    float zg[4], gg[4];
#pragma unroll
    for (int h = 0; h < 4; ++h) { zg[h] = bf2f(pr[P_GZ + h * 64 + lane]); gg[h] = bf2f(pr[P_HG + h * 64 + lane]); }
    float rg[4], rh[4];
#pragma unroll
    for (int h = 0; h < 4; ++h) {
      rg[h] = rsqrtf(wave_sum(og[h] * og[h]) * (1.f / 64.f) + 1e-6f);
      rh[h] = rsqrtf(wave_sum(oh[h] * oh[h]) * (1.f / 64.f) + 1e-6f);
    }
    __threadfence_block();
    const float wg = p.gdn_norm_w[l * 64 + lane], wh = p.hgrn_norm_w[l * 64 + lane];
#pragma unroll
    for (int h = 0; h < 4; ++h) {
      mr[h * 64 + lane] = f2bf(og[h] * rg[h] * wg * siluf_(zg[h]));
      mr[256 + h * 64 + lane] = f2bf(oh[h] * rh[h] * wh * sigmoidf_(gg[h]));
    }
#pragma unroll
    for (int i = 0; i < 8; ++i) mr[512 + lane + 64 * i] = om[i];
  }
}

__device__ __forceinline__ void gemm128(const u16* __restrict__ A, int lda, const u16* __restrict__ B, int ldb, int K,
                                        u16* lds, f32x4 (&acc)[4][4]) {
  const int tid = tid_l(), lane = tid & 63, w = tid >> 6, wm = w >> 1, wn = w & 1;
  const int r16 = lane & 15, g4 = lane >> 4;
#pragma unroll
  for (int i = 0; i < 4; ++i)
#pragma unroll
    for (int j = 0; j < 4; ++j) acc[i][j] = f32x4{0.f, 0.f, 0.f, 0.f};
  const int lrow = tid >> 3, lkc = tid & 7;
  const u16* ap = A + (size_t)lrow * lda + lkc * 8;
  const u16* bp = B + (size_t)lrow * ldb + lkc * 8;
  const size_t sa32 = (size_t)32 * lda, sb32 = (size_t)32 * ldb;
  uint4 ra0 = *(const uint4*)(ap), ra1 = *(const uint4*)(ap + sa32), ra2 = *(const uint4*)(ap + 2 * sa32), ra3 = *(const uint4*)(ap + 3 * sa32);
  uint4 rb0 = *(const uint4*)(bp), rb1 = *(const uint4*)(bp + sb32), rb2 = *(const uint4*)(bp + 2 * sb32), rb3 = *(const uint4*)(bp + 3 * sb32);
  const int woff = lrow * 64 + ((lkc ^ (lrow & 7)) * 8);
  const int sw = r16 & 7;
  const int fa0 = (wm * 64 + r16) * 64 + ((g4 ^ sw) * 8);
  const int fa1 = (wm * 64 + r16) * 64 + (((4 + g4) ^ sw) * 8);
  const int fb0 = 128 * 64 + (wn * 64 + r16) * 64 + ((g4 ^ sw) * 8);
  const int fb1 = 128 * 64 + (wn * 64 + r16) * 64 + (((4 + g4) ^ sw) * 8);
  const int nk = K >> 6;
  __syncthreads();
  {
    u16* wa = lds + woff; u16* wb = lds + 128 * 64 + woff;
    *(uint4*)(wa) = ra0; *(uint4*)(wa + 32 * 64) = ra1; *(uint4*)(wa + 64 * 64) = ra2; *(uint4*)(wa + 96 * 64) = ra3;
    *(uint4*)(wb) = rb0; *(uint4*)(wb + 32 * 64) = rb1; *(uint4*)(wb + 64 * 64) = rb2; *(uint4*)(wb + 96 * 64) = rb3;
  }
  if (nk > 1) {
    const u16* a2 = ap + 64; const u16* b2 = bp + 64;
    ra0 = *(const uint4*)(a2); ra1 = *(const uint4*)(a2 + sa32); ra2 = *(const uint4*)(a2 + 2 * sa32); ra3 = *(const uint4*)(a2 + 3 * sa32);
    rb0 = *(const uint4*)(b2); rb1 = *(const uint4*)(b2 + sb32); rb2 = *(const uint4*)(b2 + 2 * sb32); rb3 = *(const uint4*)(b2 + 3 * sb32);
  }
  __syncthreads();
  for (int kt = 0; kt < nk; ++kt) {
    const u16* cur = lds + (kt & 1) * (256 * 64);
    if (kt + 1 < nk) {
      u16* nxt = lds + ((kt + 1) & 1) * (256 * 64);
      u16* wa = nxt + woff; u16* wb = nxt + 128 * 64 + woff;
      *(uint4*)(wa) = ra0; *(uint4*)(wa + 32 * 64) = ra1; *(uint4*)(wa + 64 * 64) = ra2; *(uint4*)(wa + 96 * 64) = ra3;
      *(uint4*)(wb) = rb0; *(uint4*)(wb + 32 * 64) = rb1; *(uint4*)(wb + 64 * 64) = rb2; *(uint4*)(wb + 96 * 64) = rb3;
      if (kt + 2 < nk) {
        const u16* a2 = ap + (kt + 2) * 64; const u16* b2 = bp + (kt + 2) * 64;
        ra0 = *(const uint4*)(a2); ra1 = *(const uint4*)(a2 + sa32); ra2 = *(const uint4*)(a2 + 2 * sa32); ra3 = *(const uint4*)(a2 + 3 * sa32);
        rb0 = *(const uint4*)(b2); rb1 = *(const uint4*)(b2 + sb32); rb2 = *(const uint4*)(b2 + 2 * sb32); rb3 = *(const uint4*)(b2 + 3 * sb32);
      }
    }
#pragma unroll
    for (int ks = 0; ks < 2; ++ks) {
      const u16* fa = cur + (ks ? fa1 : fa0);
      const u16* fb = cur + (ks ? fb1 : fb0);
      bf16x8 af0 = *(const bf16x8*)(fa), af1 = *(const bf16x8*)(fa + 16 * 64);
      bf16x8 af2 = *(const bf16x8*)(fa + 32 * 64), af3 = *(const bf16x8*)(fa + 48 * 64);
#pragma unroll
      for (int j = 0; j < 4; ++j) {
        bf16x8 bfj = *(const bf16x8*)(fb + j * 16 * 64);
        acc[0][j] = __builtin_amdgcn_mfma_f32_16x16x32_bf16(bfj, af0, acc[0][j], 0, 0, 0);
        acc[1][j] = __builtin_amdgcn_mfma_f32_16x16x32_bf16(bfj, af1, acc[1][j], 0, 0, 0);
        acc[2][j] = __builtin_amdgcn_mfma_f32_16x16x32_bf16(bfj, af2, acc[2][j], 0, 0, 0);
        acc[3][j] = __builtin_amdgcn_mfma_f32_16x16x32_bf16(bfj, af3, acc[3][j], 0, 0, 0);
      }
    }
    __syncthreads();
  }
}
__device__ __forceinline__ uint2 pack4(f32x4 v) {
  uint2 o;
  o.x = (unsigned)f2bf(v[0]) | ((unsigned)f2bf(v[1]) << 16);
  o.y = (unsigned)f2bf(v[2]) | ((unsigned)f2bf(v[3]) << 16);
  return o;
}
#define GEMM_RC const int tde = tid_l(); const int rb = ((tde >> 6) >> 1) * 64 + (tde & 15), cb = ((tde >> 6) & 1) * 64 + ((tde & 63) >> 4) * 4;

__device__ __forceinline__ void phase_a(const Params& p, int l, u16* lds) {
  const int ntn = 24, total = 288 * ntn;
  const u16* Bw = p.WinT + (size_t)l * 3072 * 1024;
  for (int item = blockIdx.x; item < total; item += gridDim.x) {
    const int mt = item / ntn, nt = item % ntn;
    const int m0 = mt * 128, n0 = nt * 128;
    f32x4 acc[4][4];
    gemm128(p.HQ + (size_t)m0 * 1024, 1024, Bw + (size_t)n0 * 1024, 1024, 1024, lds, acc);
    { GEMM_RC
#pragma unroll
      for (int mi = 0; mi < 4; ++mi) {
        const int row = m0 + rb + mi * 16;
#pragma unroll
        for (int ni = 0; ni < 4; ++ni) {
          const int col = n0 + cb + ni * 16;
          *(uint2*)(p.P + (size_t)row * PW + col) = pack4(acc[mi][ni]);
          if (col >= P_GA && col < P_GA + 16)
            *(float4*)(p.GAB + (size_t)row * 16 + (col - P_GA)) = make_float4(acc[mi][ni][0], acc[mi][ni][1], acc[mi][ni][2], acc[mi][ni][3]);
        }
      }
    }
  }
}

__device__ __forceinline__ void phase_b1(const Params& p, int l, u16* lds) {
  const int nq = 288 * 6, nkv = 304 * 8;
  for (int item = blockIdx.x; item < nq + nkv; item += gridDim.x) {
    if (item < nq) {
      const int mt = item / 6, nt = item % 6;
      const int m0 = mt * 128, n0 = nt * 128;
      const float qscale = 0.07216878364870322f * 1.4426950408889634f;
      f32x4 acc[4][4];
      gemm128(p.P + (size_t)m0 * PW + P_MCQ, PW, p.WuqT + (size_t)l * 768 * 384 + (size_t)n0 * 384, 384, 384, lds, acc);
      { GEMM_RC
        const int g4 = (tde & 63) >> 4;
        const int cw0 = n0 + cb - g4 * 4;
        const bool ropew = ((cw0 >> 6) % 3) == 2 && m0 >= T_CTX;
#pragma unroll
        for (int mi = 0; mi < 4; ++mi) {
          const int row = m0 + rb + mi * 16;
          f32x4 v0 = acc[mi][0], v1 = acc[mi][1], v2 = acc[mi][2], v3 = acc[mi][3];
          if (ropew) {
            const int pos = (row - T_CTX) & 4095;
#pragma unroll
            for (int r = 0; r < 4; ++r) {
              const float inv = exp2f(-(float)(g4 * 4 + r) * (13.287712379549449f / 16.f));
              float s0, c0, s1, c1;
              __sincosf((float)(pos >> 6) * inv, &s0, &c0);
              __sincosf((float)(pos & 63) * inv, &s1, &c1);
              const float a0 = v0[r] * c0 - v1[r] * s0, a1 = v1[r] * c0 + v0[r] * s0;
              const float b0 = v2[r] * c1 - v3[r] * s1, b1 = v3[r] * c1 + v2[r] * s1;
              v0[r] = a0; v1[r] = a1; v2[r] = b0; v3[r] = b1;
            }
          }
          u16* qp = p.HQ + (size_t)row * 768 + n0 + cb;
          *(uint2*)(qp) = pack4(v0 * qscale); *(uint2*)(qp + 16) = pack4(v1 * qscale);
          *(uint2*)(qp + 32) = pack4(v2 * qscale); *(uint2*)(qp + 48) = pack4(v3 * qscale);
        }
      }
    } else {
      const int it = item - nq;
      const int mt = it / 8, nt = it % 8;
      const int m0 = mt * 128, n0 = nt * 128;
      const u16* Ap; int lda;
      if (mt < 288) { Ap = p.P + (size_t)m0 * PW + P_MCKV; lda = PW; }
      else { Ap = p.CKVC + (size_t)(m0 - T_ALL) * 256; lda = 256; }
      f32x4 acc[4][4];
      gemm128(Ap, lda, p.WukvT + (size_t)l * 1024 * 256 + (size_t)n0 * 256, 256, 256, lds, acc);
      { GEMM_RC
#pragma unroll
        for (int mi = 0; mi < 4; ++mi) {
          const int row = m0 + rb + mi * 16;
          u16* vb; int vst;
          if (row < T_CTX) { int b = row >> 8, pos = row & 255; vb = p.VTC + (size_t)(b * 4) * 128 * 256 + pos; vst = 256; }
          else if (row < T_ALL) { int b = (row - T_CTX) >> 12, pos = (row - T_CTX) & 4095; vb = p.VTL + (size_t)(b * 4) * 128 * 4352 + pos; vst = 4352; }
          else { int b = (row - T_ALL) >> 8, pos = 4096 + ((row - T_ALL) & 255); vb = p.VTL + (size_t)(b * 4) * 128 * 4352 + pos; vst = 4352; }
#pragma unroll
          for (int ni = 0; ni < 4; ++ni) {
            const int col = n0 + cb + ni * 16;
            const int h = col >> 8, wi = col & 255;
            if (wi < 128) {
              *(uint2*)(p.KN + (size_t)row * 512 + h * 128 + wi) = pack4(acc[mi][ni]);
            } else {
              u16* dst = vb + (size_t)(h * 128 + (wi - 128)) * vst;
#pragma unroll
              for (int r = 0; r < 4; ++r) dst[(size_t)r * vst] = f2bf(acc[mi][ni][r]);
            }
          }
        }
      }
    }
  }
}

__device__ __forceinline__ void phase_gemm_y(const u16* A, int lda, const u16* B, int K, int N, u16* Y, int ldy, u16* lds) {
  const int ntn = N / 128, total = 288 * ntn;
  for (int item = blockIdx.x; item < total; item += gridDim.x) {
    const int mt = item / ntn, nt = item % ntn;
    const int m0 = mt * 128, n0 = nt * 128;
    f32x4 acc[4][4];
    gemm128(A + (size_t)m0 * lda, lda, B + (size_t)n0 * K, K, K, lds, acc);
    { GEMM_RC
#pragma unroll
      for (int mi = 0; mi < 4; ++mi)
#pragma unroll
        for (int ni = 0; ni < 4; ++ni)
          *(uint2*)(Y + (size_t)(m0 + rb + mi * 16) * ldy + n0 + cb + ni * 16) = pack4(acc[mi][ni]);
    }
  }
}

__device__ __forceinline__ void phase_e(const Params& p, int l, u16* lds) {
  const int ntn = 44, total = 288 * ntn;
  const u16* Bw = p.WfiT + (size_t)l * 5632 * 1024;
  for (int item = blockIdx.x; item < total; item += gridDim.x) {
    const int mt = item / ntn, nt = item % ntn;
    const int m0 = mt * 128, n0 = nt * 128;
    f32x4 acc[4][4];
    gemm128(p.MIX + (size_t)m0 * 1024, 1024, Bw + (size_t)n0 * 1024, 1024, 1024, lds, acc);
    { GEMM_RC
      const int g4x4 = ((tde & 63) >> 4) * 4;
      const int hc0 = ((n0 + cb - g4x4) >> 1) + g4x4;
#pragma unroll
      for (int mi = 0; mi < 4; ++mi)
#pragma unroll
        for (int ni = 0; ni < 2; ++ni) {
          f32x4 hv;
#pragma unroll
          for (int r = 0; r < 4; ++r) hv[r] = siluf_(acc[mi][ni][r]) * acc[mi][ni + 2][r];
          *(uint2*)(p.P + (size_t)(m0 + rb + mi * 16) * DFF + hc0 + ni * 16) = pack4(hv);
        }
    }
  }
}

__device__ __forceinline__ void attn_item(const Params& p, int latent, int b, int h, int qb, unsigned char* smraw, int dummy = 0) {
  u16* sK = (u16*)smraw;
  u16* sV = sK + 64 * 200;
  u16* sP = sV + 128 * 72;
  const int tid = tid_l(), lane = tid & 63, w = tid >> 6, r16 = lane & 15, g4 = lane >> 4;
  const int nkeys = latent ? 4352 : 256;
  const int krow0 = latent ? T_CTX + b * 4096 : b * 256;
  const int tq0 = krow0 + qb * 128;
  const u16* vt = latent ? p.VTL + (size_t)((b * 4 + h) * 128) * 4352 : p.VTC + (size_t)((b * 4 + h) * 128) * 256;
  u16* sPw = sP + w * 32 * 72;
  bf16x8 q[2][6];
#pragma unroll
  for (int mi = 0; mi < 2; ++mi)
#pragma unroll
    for (int ks = 0; ks < 6; ++ks)
      q[mi][ks] = *(const bf16x8*)(p.HQ + (size_t)(tq0 + w * 32 + mi * 16 + r16) * 768 + h * 192 + ks * 32 + g4 * 8);
  f32x4 o[2][8];
  float mrow[2][4], lrow[2][4];
#pragma unroll
  for (int mi = 0; mi < 2; ++mi) {
#pragma unroll
    for (int nd = 0; nd < 8; ++nd) o[mi][nd] = f32x4{0.f, 0.f, 0.f, 0.f};
#pragma unroll
    for (int r = 0; r < 4; ++r) { mrow[mi][r] = -1e30f; lrow[mi][r] = 0.f; }
  }
  const int lkey = tid >> 2, lpart = tid & 3;
  const int ldv = tid >> 1, lhalf = tid & 1;
  for (int kt = 0; kt < nkeys / 64; ++kt) {
    __syncthreads();
    {
      const int pos = kt * 64 + lkey;
      const bool own = (!latent) || pos < 4096;
      const int row = own ? krow0 + pos : T_ALL + b * 256 + (pos - 4096);
      const u16* srcn = p.KN + (size_t)row * 512 + h * 128 + lpart * 8;
      const u16* srcr = own ? p.P + (size_t)(krow0 + pos) * PW + P_MKR + lpart * 8
                            : p.KRC + (size_t)(b * 256 + pos - 4096) * 64 + lpart * 8;
      u16* dk = sK + lkey * 200 + lpart * 8;
      const uint4 k0 = *(const uint4*)(srcn), k1 = *(const uint4*)(srcn + 32), k2 = *(const uint4*)(srcn + 64), k3 = *(const uint4*)(srcn + 96);
      const uint4 k4 = *(const uint4*)(srcr), k5 = *(const uint4*)(srcr + 32);
      *(uint4*)(dk) = k0; *(uint4*)(dk + 32) = k1; *(uint4*)(dk + 64) = k2; *(uint4*)(dk + 96) = k3;
      *(uint4*)(dk + 128) = k4; *(uint4*)(dk + 160) = k5;
    }
    asm volatile("" ::: "memory");
    {
      const u16* sv = vt + (size_t)ldv * nkeys + kt * 64 + lhalf * 32;
      u16* dvp = sV + ldv * 72 + lhalf * 32;
      const uint4 v0 = *(const uint4*)(sv), v1 = *(const uint4*)(sv + 8), v2 = *(const uint4*)(sv + 16), v3 = *(const uint4*)(sv + 24);
      *(uint4*)(dvp) = v0; *(uint4*)(dvp + 8) = v1; *(uint4*)(dvp + 16) = v2; *(uint4*)(dvp + 24) = v3;
    }
    __syncthreads();
    f32x4 s[2][4];
#pragma unroll
    for (int mi = 0; mi < 2; ++mi)
#pragma unroll
      for (int ni = 0; ni < 4; ++ni) s[mi][ni] = f32x4{0.f, 0.f, 0.f, 0.f};
#pragma unroll
    for (int ks = 0; ks < 6; ++ks)
#pragma unroll
      for (int ni = 0; ni < 4; ++ni) {
        bf16x8 kf = *(const bf16x8*)(sK + (ni * 16 + r16) * 200 + ks * 32 + g4 * 8);
        s[0][ni] = __builtin_amdgcn_mfma_f32_16x16x32_bf16(q[0][ks], kf, s[0][ni], 0, 0, 0);
        s[1][ni] = __builtin_amdgcn_mfma_f32_16x16x32_bf16(q[1][ks], kf, s[1][ni], 0, 0, 0);
      }
#pragma unroll
    for (int mi = 0; mi < 2; ++mi)
#pragma unroll
      for (int r = 0; r < 4; ++r) {
        float mx = fmaxf(fmaxf(s[mi][0][r], s[mi][1][r]), fmaxf(s[mi][2][r], s[mi][3][r]));
        mx = fmaxf(mx, __shfl_xor(mx, 1)); mx = fmaxf(mx, __shfl_xor(mx, 2));
        mx = fmaxf(mx, __shfl_xor(mx, 4)); mx = fmaxf(mx, __shfl_xor(mx, 8));
        const float mnew = fmaxf(mrow[mi][r], mx);
        const float alpha = __builtin_amdgcn_exp2f(mrow[mi][r] - mnew);
        mrow[mi][r] = mnew;
        float ps = 0.f;
#pragma unroll
        for (int ni = 0; ni < 4; ++ni) {
          float pv = __builtin_amdgcn_exp2f(s[mi][ni][r] - mnew);
          ps += pv;
          sPw[(mi * 16 + g4 * 4 + r) * 72 + ni * 16 + r16] = f2bf(pv);
        }
        ps += __shfl_xor(ps, 1); ps += __shfl_xor(ps, 2); ps += __shfl_xor(ps, 4); ps += __shfl_xor(ps, 8);
        lrow[mi][r] = lrow[mi][r] * alpha + ps;
#pragma unroll
        for (int nd = 0; nd < 8; ++nd) o[mi][nd][r] *= alpha;
      }
    __syncthreads();
#pragma unroll
    for (int ks2 = 0; ks2 < 2; ++ks2) {
      bf16x8 pf0 = *(const bf16x8*)(sPw + (0 * 16 + r16) * 72 + ks2 * 32 + g4 * 8);
      bf16x8 pf1 = *(const bf16x8*)(sPw + (1 * 16 + r16) * 72 + ks2 * 32 + g4 * 8);
#pragma unroll
      for (int nd = 0; nd < 8; ++nd) {
        bf16x8 vf = *(const bf16x8*)(sV + (nd * 16 + r16) * 72 + ks2 * 32 + g4 * 8);
        o[0][nd] = __builtin_amdgcn_mfma_f32_16x16x32_bf16(pf0, vf, o[0][nd], 0, 0, 0);
        o[1][nd] = __builtin_amdgcn_mfma_f32_16x16x32_bf16(pf1, vf, o[1][nd], 0, 0, 0);
      }
    }
  }
#pragma unroll
  for (int mi = 0; mi < 2; ++mi)
#pragma unroll
    for (int r = 0; r < 4; ++r) {
      const float inv = 1.f / lrow[mi][r];
      u16* op = p.HQ + (size_t)(tq0 + w * 32 + mi * 16 + g4 * 4 + r) * 768 + h * 192 + r16;
      if (dummy) op = p.HQ + (size_t)T_ALL * 768 + (size_t)((tq0 + w * 32 + mi * 16 + g4 * 4 + r) % 9216) * 768 + h * 192 + r16;
#pragma unroll
      for (int nd = 0; nd < 8; ++nd) op[nd * 16] = f2bf(o[mi][nd][r] * inv);
    }
}

#define XB_TMO      128
#define XB_XCNT(j)  (256  + 64 * (j))
#define XB_XSUB(j)  (1280 + 64 * (j))
#define XB_XGEN(j)  (2304 + 64 * (j))
#define XB_TOP      3328
#define XB_TOPGEN   3392
#define XCD_BAR_WORDS 3456
#define XB_SPIN_CAP (1u << 23)
#define LAS __attribute__((address_space(3)))

__device__ __forceinline__ unsigned xb_ld(unsigned* p)              { return __hip_atomic_load(p, __ATOMIC_RELAXED, __HIP_MEMORY_SCOPE_AGENT); }
__device__ __forceinline__ unsigned xb_add(unsigned* p, unsigned v) { return __hip_atomic_fetch_add(p, v, __ATOMIC_RELAXED, __HIP_MEMORY_SCOPE_AGENT); }
__device__ __forceinline__ unsigned xb_xcc_id() { return (unsigned)__builtin_amdgcn_s_getreg((3 << 11) | 20) & 0xFu; }
#define XB_SPIN(cond, bar) do { unsigned _sp = 0; while (cond) { __builtin_amdgcn_s_sleep(1); \
    if ((++_sp & 255u) == 0u) { if (xb_ld(&(bar)[XB_TMO])) break; if (_sp > XB_SPIN_CAP) { atomicAdd(&(bar)[XB_TMO], 1u); break; } } } } while (0)

struct XcdBarrier {
    unsigned* bar; unsigned x;
    volatile LAS unsigned* st;
};

__device__ __forceinline__ XcdBarrier xcd_barrier_post(unsigned* bar, volatile LAS unsigned* st) {
    XcdBarrier b; b.bar = bar; b.x = xb_xcc_id(); b.st = st;
    if (threadIdx.x == 0) (void)xb_add(&bar[XB_XCNT(b.x)], 1u);
    return b;
}
__device__ __forceinline__ void xcd_barrier_complete(unsigned* bar, unsigned x, unsigned& nloc, unsigned& nx) {
    const unsigned G = gridDim.x * gridDim.y * gridDim.z;
    unsigned sum, cnt, mine, sp = 0u;
    for (;;) {
        sum = 0u; cnt = 0u; mine = 0u;
#pragma unroll
        for (unsigned j = 0; j < 16; ++j) { const unsigned c = xb_ld(&bar[XB_XCNT(j)]); sum += c; cnt += (c > 0u) ? 1u : 0u; mine = (j == x) ? c : mine; }
        if (sum == G) break;
        __builtin_amdgcn_s_sleep(1);
        if ((++sp & 255u) == 0u) { if (xb_ld(&bar[XB_TMO])) break; if (sp > XB_SPIN_CAP) { atomicAdd(&bar[XB_TMO], 1u); break; } }
    }
    nloc = mine > 0u ? mine : 1u; nx = cnt > 0u ? cnt : 1u;
}

__device__ __forceinline__ void xcd_barrier(const XcdBarrier& b) {
    asm volatile("s_waitcnt vmcnt(0)" ::: "memory");
    __syncthreads();
    if (threadIdx.x == 0) {
        unsigned* bar = b.bar;
        __builtin_amdgcn_s_waitcnt(0);
        unsigned nloc = b.st[0], nx = b.st[1];
        if (nloc == 0u) { xcd_barrier_complete(bar, b.x, nloc, nx); b.st[0] = nloc; b.st[1] = nx; }
        const unsigned old = xb_add(&bar[XB_XSUB(b.x)], 1u);
        const unsigned gen = old / nloc;
        if (old + 1u == (gen + 1u) * nloc) {
            __builtin_amdgcn_fence(__ATOMIC_RELEASE, "agent");
            asm volatile("s_waitcnt vmcnt(0)" ::: "memory");
            const unsigned og = xb_add(&bar[XB_TOP], 1u);
            const unsigned tg = og / nx;
            if (og + 1u == (tg + 1u) * nx) xb_add(&bar[XB_TOPGEN], 1u);
            else XB_SPIN(xb_ld(&bar[XB_TOPGEN]) == tg, bar);
            __builtin_amdgcn_fence(__ATOMIC_ACQUIRE, "agent");
            xb_add(&bar[XB_XGEN(b.x)], 1u);
            asm volatile("s_waitcnt vmcnt(0)" ::: "memory");
        } else {
            XB_SPIN(xb_ld(&bar[XB_XGEN(b.x)]) == gen, bar);
            __builtin_amdgcn_fence(__ATOMIC_ACQUIRE, "agent");
            asm volatile("s_waitcnt vmcnt(0)" ::: "memory");
        }
    }
    __syncthreads();
}


__device__ __forceinline__ void gbar(unsigned* ctr, unsigned target) {
  asm volatile("s_waitcnt vmcnt(0)" ::: "memory");
  __syncthreads();
  if (tid_l() == 0) {
    __builtin_amdgcn_fence(__ATOMIC_RELEASE, "agent");
    asm volatile("s_waitcnt vmcnt(0)" ::: "memory");
    __hip_atomic_fetch_add(ctr, 1u, __ATOMIC_RELAXED, __HIP_MEMORY_SCOPE_AGENT);
    while (__hip_atomic_load(ctr, __ATOMIC_RELAXED, __HIP_MEMORY_SCOPE_AGENT) < target) __builtin_amdgcn_s_sleep(2);
    __builtin_amdgcn_fence(__ATOMIC_ACQUIRE, "agent");
    asm volatile("s_waitcnt vmcnt(0)" ::: "memory");
  }
  __syncthreads();
}
#define MFMA4(a, b, c) __builtin_amdgcn_mfma_f32_16x16x4f32((a), (b), (c), 0, 0, 0)

__device__ __forceinline__ float softplusf_(float x) { return fmaxf(x, 0.f) + log1pf(__expf(-fabsf(x))); }

__device__ __forceinline__ void gdn_chain(const Params& p, int l, int seq, int h, int d, int vs, float* sm) {
  float* sMM = sm;
  float* sK = sMM + 64 * 68;
  float* sW = sK + 64 * 65;
  float* sV = sW + 64 * 65;
  float* sS = sV + 64 * 33;
  float* sGc = sS + 64 * 33;
  float* sBeta = sGc + 64;
  float* sBg = sBeta + 64;
  const int tid = tid_l(), lane = tid & 63, w = tid >> 6, r16 = lane & 15, g4 = lane >> 4;
  const bool latent = seq >= 16;
  const int len = latent ? 4096 : 256;
  const int t0 = latent ? T_CTX + (seq - 16) * 4096 : seq * 256;
  const int nchunks = len >> 6;
  const int c2 = tid % 80, rg = tid / 80;
  const int lc = 2 * c2;
  int gch;
  if (lc < 64) gch = h * 64 + lc; else if (lc < 128) gch = 256 + h * 64 + (lc - 64); else gch = 512 + h * 64 + vs * 32 + (lc - 128);
  float cwa[5], cwb[5];
#pragma unroll
  for (int j = 0; j < 5; ++j) {
    cwa[j] = p.gdn_conv_w[((size_t)l * 768 + gch) * 5 + j];
    cwb[j] = p.gdn_conv_w[((size_t)l * 768 + gch + 1) * 5 + j];
  }
  const float Acoef = -__expf(p.gdn_a_log[l * 8 + d * 4 + h]);
  const float dtb = p.gdn_dt_bias[l * 8 + d * 4 + h];
  f32x4 Sreg[2];
  __syncthreads();
  {
    const float* s0 = latent ? p.state_gdn + ((((size_t)(seq - 16) * 2 + l) * 2 + d) * 4 + h) * 4096 : nullptr;
#pragma unroll
    for (int n = 0; n < 2; ++n)
#pragma unroll
      for (int r = 0; r < 4; ++r) {
        const int kidx = 16 * w + g4 * 4 + r, cc = n * 16 + r16;
        float v = latent ? s0[kidx * 64 + vs * 32 + cc] : 0.f;
        Sreg[n][r] = v;
        sS[kidx * 33 + cc] = v;
      }
  }
  const u16* Pb = p.P + (size_t)t0 * PW;
  u16* sRaw = (u16*)sMM;
  u16* sRawV = (u16*)(sBg + 64);
#define GDN_UNIT(i, tl, rr, un, pgo_, plo_) \
    const int e_ = (tl) + (i) * 256; const int rr = e_ / 20, un = e_ % 20; const bool val_ = e_ < 1360; \
    const int pgo_ = rr * PW + (un < 8 ? h * 64 + un * 8 : (un < 16 ? 256 + h * 64 + (un - 8) * 8 : 512 + h * 64 + vs * 32 + (un - 16) * 8)); \
    const int plo_ = un < 16 ? rr * 128 + un * 8 : (int)(sRawV - sRaw) + rr * 32 + (un - 16) * 8;
  uint4 pf[6];
  float pga = 0.f, pgb = 0.f;
  {
    const int tlo = d == 0 ? 0 : len - 64;
#pragma unroll
    for (int i = 0; i < 6; ++i) {
      GDN_UNIT(i, tid, rr, un, pgo_, plo_)
      const int tau = tlo - 2 + rr;
      pf[i] = (val_ && tau >= 0 && tau < len) ? *(const uint4*)(Pb + (ptrdiff_t)(tlo - 2) * PW + pgo_) : make_uint4(0, 0, 0, 0);
    }
    if (tid < 64) {
      const int u = d == 0 ? tid : 63 - tid;
      const float* gab = p.GAB + (size_t)(t0 + tlo + u) * 16;
      pga = gab[d * 4 + h]; pgb = gab[8 + d * 4 + h];
    }
  }
  for (int n = 0; n < nchunks; ++n) {
    const int tlo = d == 0 ? n * 64 : len - 64 * (n + 1);
    const int tl2 = tid_l();
#pragma unroll
    for (int i = 0; i < 6; ++i) {
      GDN_UNIT(i, tl2, rr, un, pgo_, plo_)
      if (val_) *(uint4*)(sRaw + plo_) = pf[i];
    }
    const float ga_cur = pga, gb_cur = pgb;
    __syncthreads();
    if (n + 1 < nchunks) {
      const int tlo2 = d == 0 ? (n + 1) * 64 : len - 64 * (n + 2);
#pragma unroll
      for (int i = 0; i < 6; ++i) {
        GDN_UNIT(i, tl2, rr, un, pgo_, plo_)
        const int tau = tlo2 - 2 + rr;
        pf[i] = (val_ && tau >= 0 && tau < len) ? *(const uint4*)(Pb + (ptrdiff_t)(tlo2 - 2) * PW + pgo_) : make_uint4(0, 0, 0, 0);
      }
      if (tid < 64) {
        const int u = d == 0 ? tid : 63 - tid;
        const float* gab = p.GAB + (size_t)(t0 + tlo2 + u) * 16;
        pga = gab[d * 4 + h]; pgb = gab[8 + d * 4 + h];
      }
    }
    if (tid < 240) {
      const int u0 = rg * 22;
      const u16* rp = lc < 128 ? sRaw + lc : sRawV + (lc - 128);
      const int rst = lc < 128 ? 128 : 32;
      float* dq = lc < 64 ? sW + lc : (lc < 128 ? sK + (lc - 64) : sV + (lc - 128));
      const int dst = lc < 128 ? 65 : 33;
#pragma unroll 1
      for (int hf = 0; hf < 2; ++hf) {
        const int ub = u0 + hf * 11;
        unsigned rv[15];
#pragma unroll
        for (int j = 0; j < 15; ++j) { const int row = ub + j < 67 ? ub + j : 67; rv[j] = *(const unsigned*)(rp + row * rst); }
#pragma unroll
        for (int uu = 0; uu < 11; ++uu) {
          const int u = ub + uu;
          float ya = 0.f, yb = 0.f;
#pragma unroll
          for (int j = 0; j < 5; ++j) {
            ya += cwa[j] * bf2f((u16)(rv[uu + j] & 0xffff));
            yb += cwb[j] * bf2f((u16)(rv[uu + j] >> 16));
          }
          ya = siluf_(ya); yb = siluf_(yb);
          const int pp = d == 0 ? u : 63 - u;
          if (u < 64) { dq[pp * dst] = ya; dq[pp * dst + 1] = yb; }
        }
      }
    }
    if (tid < 64) {
      const int pp = tid;
      float g = Acoef * softplusf_(ga_cur + dtb);
      float bt = sigmoidf_(gb_cur);
#pragma unroll
      for (int o = 1; o < 64; o <<= 1) { float tt = __shfl_up(g, o); if (lane >= o) g += tt; }
      sGc[pp] = g; sBeta[pp] = bt; sBg[pp] = bt * __expf(g);
    }
    __syncthreads();
    {
      const int row = tid >> 2, q4 = tid & 3;
      float sq = 0.f, sk = 0.f;
#pragma unroll
      for (int i = 0; i < 16; ++i) { float a = sW[row * 65 + q4 * 16 + i], b = sK[row * 65 + q4 * 16 + i]; sq += a * a; sk += b * b; }
      sq += __shfl_xor(sq, 1); sq += __shfl_xor(sq, 2);
      sk += __shfl_xor(sk, 1); sk += __shfl_xor(sk, 2);
      const float rq = rsqrtf(sq + 1e-6f) * 0.125f, rk = rsqrtf(sk + 1e-6f);
#pragma unroll
      for (int i = 0; i < 16; ++i) { sW[row * 65 + q4 * 16 + i] *= rq; sK[row * 65 + q4 * 16 + i] *= rk; }
    }
    __syncthreads();
    float qa[16];
#pragma unroll
    for (int s = 0; s < 16; ++s) qa[s] = sW[(16 * w + r16) * 65 + 4 * s + g4];
    const unsigned tcode = w == 0 ? 0x730u : (w == 1 ? 0xA51u : (w == 2 ? 0x062u : 0x0FBu));
    const int tcnt = w < 2 ? 3 : 2;
    f32x4 attacc[3];
#pragma unroll
    for (int t = 0; t < 3; ++t) {
      attacc[t] = f32x4{0.f, 0.f, 0.f, 0.f};
      if (t < tcnt) {
        const int ti = (tcode >> (4 * t)) & 3, tn = (tcode >> (4 * t + 2)) & 3;
        f32x4 accm = f32x4{0.f, 0.f, 0.f, 0.f};
        const float* ak = sK + (16 * ti + r16) * 65 + g4;
        const float* aq = sW + (16 * ti + r16) * 65 + g4;
        const float* bk = sK + (16 * tn + r16) * 65 + g4;
#pragma unroll
        for (int s = 0; s < 16; ++s) {
          const float bv = bk[4 * s];
          accm = MFMA4(ak[4 * s], bv, accm);
          attacc[t] = MFMA4(aq[4 * s], bv, attacc[t]);
        }
#pragma unroll
        for (int r = 0; r < 4; ++r) {
          const int i = 16 * ti + g4 * 4 + r, j = 16 * tn + r16;
          sMM[i * 68 + j] = (i > j) ? sBeta[i] * accm[r] * __expf(sGc[i] - sGc[j]) : 0.f;
        }
      }
    }
    __syncthreads();
    for (int ib = 0; ib < 4; ++ib) {
#pragma unroll
      for (int tt = 0; tt < 2; ++tt) {
        const int ct = w + 4 * tt;
        if (ct < 6) {
          f32x4 acc = f32x4{0.f, 0.f, 0.f, 0.f};
          const float* am = sMM + (16 * ib + r16) * 68 + g4;
          const float* bx = ct < 4 ? sW + g4 * 65 + 16 * ct + r16 : sV + g4 * 33 + 16 * (ct - 4) + r16;
          const int bst = ct < 4 ? 65 : 33;
          for (int s = 0; s < 4 * ib; ++s) acc = MFMA4(am[4 * s], bx[4 * s * bst], acc);
#pragma unroll
          for (int r = 0; r < 4; ++r) {
            const int i = 16 * ib + g4 * 4 + r;
            if (ct < 4) { const int c = 16 * ct + r16; sW[i * 65 + c] = sK[i * 65 + c] * sBg[i] - acc[r]; }
            else { const int c = 16 * (ct - 4) + r16; sV[i * 33 + c] = sV[i * 33 + c] * sBeta[i] - acc[r]; }
          }
        }
      }
      __syncthreads();
      if (tid < 96) {
        const int c = tid;
        float* colp = (c < 64 ? sW + c : sV + (c - 64)) + (16 * ib) * (c < 64 ? 65 : 33);
        const int cst = c < 64 ? 65 : 33;
        const float* md = sMM + (16 * ib) * 68 + 16 * ib;
        float a[16];
#pragma unroll
        for (int r = 0; r < 16; ++r) a[r] = colp[r * cst];
#pragma unroll
        for (int r = 1; r < 16; ++r) {
          if (r == 4 || r == 8 || r == 10 || r == 12 || r == 14) asm volatile("" ::: "memory");
#pragma unroll
          for (int q4 = 0; q4 < (r + 3) / 4; ++q4) {
            const float4 m = *(const float4*)(md + r * 68 + 4 * q4);
            if (q4 * 4 + 0 < r) a[r] -= m.x * a[q4 * 4 + 0];
            if (q4 * 4 + 1 < r) a[r] -= m.y * a[q4 * 4 + 1];
            if (q4 * 4 + 2 < r) a[r] -= m.z * a[q4 * 4 + 2];
            if (q4 * 4 + 3 < r) a[r] -= m.w * a[q4 * 4 + 3];
          }
        }
#pragma unroll
        for (int r = 1; r < 16; ++r) colp[r * cst] = a[r];
      }
      __syncthreads();
    }
#pragma unroll
    for (int t = 0; t < 3; ++t) {
      if (t < tcnt) {
        const int ti = (tcode >> (4 * t)) & 3, tn = (tcode >> (4 * t + 2)) & 3;
#pragma unroll
        for (int r = 0; r < 4; ++r) {
          const int i = 16 * ti + g4 * 4 + r, j = 16 * tn + r16;
          sMM[i * 68 + j] = (i >= j) ? attacc[t][r] * __expf(sGc[i] - sGc[j]) : 0.f;
        }
      }
    }
    {
      f32x4 acc[2] = {f32x4{0.f, 0.f, 0.f, 0.f}, f32x4{0.f, 0.f, 0.f, 0.f}};
#pragma unroll
      for (int s = 0; s < 16; ++s) {
        const float a = sW[(16 * w + r16) * 65 + 4 * s + g4];
        acc[0] = MFMA4(a, sS[(4 * s + g4) * 33 + r16], acc[0]);
        acc[1] = MFMA4(a, sS[(4 * s + g4) * 33 + 16 + r16], acc[1]);
      }
#pragma unroll
      for (int nn = 0; nn < 2; ++nn)
#pragma unroll
        for (int r = 0; r < 4; ++r) {
          const int i = 16 * w + g4 * 4 + r, cc = nn * 16 + r16;
          sV[i * 33 + cc] = sV[i * 33 + cc] - acc[nn][r];
        }
    }
    __syncthreads();
    {
      f32x4 acc[2] = {f32x4{0.f, 0.f, 0.f, 0.f}, f32x4{0.f, 0.f, 0.f, 0.f}};
      const float eg = __expf(sGc[16 * w + r16]);
#pragma unroll
      for (int s = 0; s < 16; ++s) {
        const float a = qa[s] * eg;
        acc[0] = MFMA4(a, sS[(4 * s + g4) * 33 + r16], acc[0]);
        acc[1] = MFMA4(a, sS[(4 * s + g4) * 33 + 16 + r16], acc[1]);
      }
#pragma unroll
      for (int s = 0; s < 16; ++s) {
        if (s < 4 * (w + 1)) {
          const float a = sMM[(16 * w + r16) * 68 + 4 * s + g4];
          acc[0] = MFMA4(a, sV[(4 * s + g4) * 33 + r16], acc[0]);
          acc[1] = MFMA4(a, sV[(4 * s + g4) * 33 + 16 + r16], acc[1]);
        }
      }
#pragma unroll
      for (int nn = 0; nn < 2; ++nn)
#pragma unroll
        for (int r = 0; r < 4; ++r) {
          const int pp = 16 * w + g4 * 4 + r;
          const int u = d == 0 ? pp : 63 - pp;
          p.MIX[(size_t)(t0 + tlo + u) * 1024 + d * 256 + h * 64 + vs * 32 + nn * 16 + r16] = f2bf(acc[nn][r]);
        }
    }
    __syncthreads();
    {
      const float g63 = sGc[63];
      const float gl = __expf(g63);
#pragma unroll
      for (int nn = 0; nn < 2; ++nn)
#pragma unroll
        for (int r = 0; r < 4; ++r) Sreg[nn][r] *= gl;
#pragma unroll
      for (int s = 0; s < 16; ++s) {
        const int srow = 4 * s + g4;
        const float a = sK[srow * 65 + 16 * w + r16] * __expf(g63 - sGc[srow]);
        Sreg[0] = MFMA4(a, sV[srow * 33 + r16], Sreg[0]);
        Sreg[1] = MFMA4(a, sV[srow * 33 + 16 + r16], Sreg[1]);
      }
    }
    __syncthreads();
#pragma unroll
    for (int nn = 0; nn < 2; ++nn)
#pragma unroll
      for (int r = 0; r < 4; ++r) sS[(16 * w + g4 * 4 + r) * 33 + nn * 16 + r16] = Sreg[nn][r];
    __syncthreads();
  }
  if (!latent) {
    float* so = p.out + OUT_SGDN + ((((size_t)seq * 2 + l) * 2 + d) * 4 + h) * 4096;
#pragma unroll
    for (int nn = 0; nn < 2; ++nn)
#pragma unroll
      for (int r = 0; r < 4; ++r) so[(16 * w + g4 * 4 + r) * 64 + vs * 32 + nn * 16 + r16] = Sreg[nn][r];
  }
}

__device__ __forceinline__ void hgrn_chain(const Params& p, int l, int seq, int h, int d, int vs, float* sm) {
  float* sBC = sm;
  float* sK = sBC + 64 * 65;
  float* sAT = sK + 64 * 65;
  float* sV = sAT + 64 * 68;
  float* sS = sV + 64 * 33;
  float* sTot = sS + 64 * 33;
  const int tid = tid_l(), lane = tid & 63, w = tid >> 6, r16 = lane & 15, g4 = lane >> 4;
  const bool latent = seq >= 16;
  const int len = latent ? 4096 : 256;
  const int t0 = latent ? T_CTX + (seq - 16) * 4096 : seq * 256;
  const int nchunks = len >> 6;
  float lbk;
  {
    const int kch = h * 64 + (tid & 63);
    lbk = (l == 0) ? 0.f : sigmoidf_(p.hgrn_lb[256 + kch] - p.hgrn_lb[kch]);
  }
  f32x4 Sreg[2];
  __syncthreads();
  {
    const float* s0 = latent ? p.state_hgrn + ((((size_t)(seq - 16) * 2 + l) * 2 + d) * 4 + h) * 4096 : nullptr;
#pragma unroll
    for (int n = 0; n < 2; ++n)
#pragma unroll
      for (int r = 0; r < 4; ++r) {
        const int kidx = 16 * w + g4 * 4 + r, cc = n * 16 + r16;
        float v = latent ? s0[kidx * 64 + vs * 32 + cc] : 0.f;
        Sreg[n][r] = v;
        sS[kidx * 33 + cc] = v;
      }
  }
  const u16* Pb = p.P + (size_t)t0 * PW;
  float* sLb = sTot + 256;
  if (tid < 64) sLb[tid] = lbk;
  __syncthreads();
  int pgo[5];
#pragma unroll
  for (int i = 0; i < 5; ++i) {
    const int e = tid + i * 256;
    const int u = e / 20, un = e % 20;
    pgo[i] = u * PW + (un < 8 ? P_HF + d * 256 + h * 64 + un * 8 : (un < 12 ? P_HI + h * 64 + vs * 32 + (un - 8) * 8 : P_HQ + h * 64 + (un - 12) * 8));
  }
  uint4 pf[5];
  {
    const int tlo = d == 0 ? 0 : len - 64;
#pragma unroll
    for (int i = 0; i < 5; ++i) pf[i] = *(const uint4*)(Pb + (size_t)tlo * PW + pgo[i]);
  }
  for (int n = 0; n < nchunks; ++n) {
#pragma unroll
    for (int i = 0; i < 5; ++i) {
      const int e = tid + i * 256;
      const int u = e / 20, un = e % 20;
      const int pp = d == 0 ? u : 63 - u;
      const unsigned wv[4] = {pf[i].x, pf[i].y, pf[i].z, pf[i].w};
#pragma unroll
      for (int j = 0; j < 8; ++j) {
        const float x = bf2f((u16)((wv[j >> 1] >> ((j & 1) * 16)) & 0xffff));
        if (un < 8) {
          const int k = un * 8 + j;
          const float lb = sLb[k];
          const float sg_ = sigmoidf_(x);
          const float gate = lb + (1.f - lb) * sg_;
          sBC[pp * 65 + k] = __logf(fmaxf(gate, 1e-30f));
          sK[pp * 65 + k] = (1.f - lb) * (1.f - sg_);
        } else if (un < 12) {
          sV[pp * 33 + (un - 8) * 8 + j] = x;
        } else {
          sAT[pp * 68 + (un - 12) * 8 + j] = x;
        }
      }
    }
    __syncthreads();
    if (n + 1 < nchunks) {
      const int tlo2 = d == 0 ? (n + 1) * 64 : len - 64 * (n + 2);
#pragma unroll
      for (int i = 0; i < 5; ++i) pf[i] = *(const uint4*)(Pb + (size_t)tlo2 * PW + pgo[i]);
    }
    const int tlo = d == 0 ? n * 64 : len - 64 * (n + 1);
    float cs[16];
    {
      const int k = tid & 63, sg = tid >> 6;
      float run = 0.f;
#pragma unroll
      for (int i = 0; i < 16; ++i) { run += sBC[(16 * sg + i) * 65 + k]; cs[i] = run; }
      sTot[sg * 64 + k] = run;
    }
    float qa[16];
#pragma unroll
    for (int s = 0; s < 16; ++s) qa[s] = sAT[(16 * w + r16) * 68 + 4 * s + g4];
    __syncthreads();
    {
      const int k = tid & 63, sg = tid >> 6;
      float off = 0.f;
      for (int s2 = 0; s2 < sg; ++s2) off += sTot[s2 * 64 + k];
#pragma unroll
      for (int i = 0; i < 16; ++i) sBC[(16 * sg + i) * 65 + k] = cs[i] + off;
    }
    __syncthreads();
    {
      float aq[16], rf[16];
#pragma unroll
      for (int s = 0; s < 16; ++s) {
        const int kk = 4 * s + g4;
        rf[s] = (w == 0) ? 0.f : sBC[(16 * w - 1) * 65 + kk];
        aq[s] = qa[s] * __expf(sBC[(16 * w + r16) * 65 + kk] - rf[s]);
      }
#pragma unroll
      for (int nn = 0; nn < 4; ++nn) {
        f32x4 acc = f32x4{0.f, 0.f, 0.f, 0.f};
        if (nn <= w) {
#pragma unroll
          for (int s = 0; s < 16; ++s) {
            const int kk = 4 * s + g4, sc = 16 * nn + r16;
            const float bv = sK[sc * 65 + kk] * __expf(fminf(rf[s] - sBC[sc * 65 + kk], 80.f));
            acc = MFMA4(aq[s], bv, acc);
          }
        }
#pragma unroll
        for (int r = 0; r < 4; ++r) {
          const int i = 16 * w + g4 * 4 + r, j = 16 * nn + r16;
          sAT[i * 68 + j] = (i >= j) ? acc[r] : 0.f;
        }
      }
    }
    __syncthreads();
    {
      f32x4 acc[2] = {f32x4{0.f, 0.f, 0.f, 0.f}, f32x4{0.f, 0.f, 0.f, 0.f}};
#pragma unroll
      for (int s = 0; s < 16; ++s) {
        const int kk = 4 * s + g4;
        const float a = qa[s] * __expf(sBC[(16 * w + r16) * 65 + kk]);
        acc[0] = MFMA4(a, sS[kk * 33 + r16], acc[0]);
        acc[1] = MFMA4(a, sS[kk * 33 + 16 + r16], acc[1]);
      }
#pragma unroll
      for (int s = 0; s < 16; ++s) {
        if (s < 4 * (w + 1)) {
          const float a = sAT[(16 * w + r16) * 68 + 4 * s + g4];
          acc[0] = MFMA4(a, sV[(4 * s + g4) * 33 + r16], acc[0]);
          acc[1] = MFMA4(a, sV[(4 * s + g4) * 33 + 16 + r16], acc[1]);
        }
      }
#pragma unroll
      for (int nn = 0; nn < 2; ++nn)
#pragma unroll
        for (int r = 0; r < 4; ++r) {
          const int pp = 16 * w + g4 * 4 + r;
          const int u = d == 0 ? pp : 63 - pp;
          p.MIX[(size_t)(t0 + tlo + u) * 1024 + 512 + d * 256 + h * 64 + vs * 32 + nn * 16 + r16] = f2bf(acc[nn][r]);
        }
    }
    __syncthreads();
    {
#pragma unroll
      for (int nn = 0; nn < 2; ++nn)
#pragma unroll
        for (int r = 0; r < 4; ++r) Sreg[nn][r] *= __expf(sBC[63 * 65 + 16 * w + g4 * 4 + r]);
      const int kA = 16 * w + r16;
      const float blA = sBC[63 * 65 + kA];
#pragma unroll
      for (int s = 0; s < 16; ++s) {
        const int srow = 4 * s + g4;
        const float a = sK[srow * 65 + kA] * __expf(blA - sBC[srow * 65 + kA]);
        Sreg[0] = MFMA4(a, sV[srow * 33 + r16], Sreg[0]);
        Sreg[1] = MFMA4(a, sV[srow * 33 + 16 + r16], Sreg[1]);
      }
    }
    __syncthreads();
#pragma unroll
    for (int nn = 0; nn < 2; ++nn)
#pragma unroll
      for (int r = 0; r < 4; ++r) sS[(16 * w + g4 * 4 + r) * 33 + nn * 16 + r16] = Sreg[nn][r];
    __syncthreads();
  }
  if (!latent) {
    float* so = p.out + OUT_SHG + ((((size_t)seq * 2 + l) * 2 + d) * 4 + h) * 4096;
#pragma unroll
    for (int nn = 0; nn < 2; ++nn)
#pragma unroll
      for (int r = 0; r < 4; ++r) so[(16 * w + g4 * 4 + r) * 64 + vs * 32 + nn * 16 + r16] = Sreg[nn][r];
  }
}

__device__ __forceinline__ void phase_c(const Params& p, int l, unsigned char* smraw, int mode = 0) {
  __shared__ int s_item;
  const int total = 1920;
  for (;;) {
    __syncthreads();
    if (tid_l() == 0) s_item = (int)atomicAdd(&p.counters[l * 64 + mode * 16], 1u);
    __syncthreads();
    const int item = s_item;
    if (item >= total) break;
    int kind, a0, a1, a2, a3;
    if (item < 256 || (item >= 1280 && item < 1792)) {
      const int i2 = item < 256 ? item : item - 1280;
      const int rest = i2 >> 1;
      kind = i2 & 1;
      a3 = rest & 1; a2 = (rest >> 1) & 1; a1 = (rest >> 2) & 3; a0 = (rest >> 4) + (item < 256 ? 16 : 0);
    } else if (item < 1280) {
      const int i2 = item - 256;
      kind = 2; a0 = 1; a1 = i2 >> 7; a2 = (i2 >> 5) & 3; a3 = i2 & 31;
    } else {
      const int i2 = item - 1792;
      kind = 2; a0 = 0; a1 = i2 >> 3; a2 = (i2 >> 1) & 3; a3 = i2 & 1;
    }
    if (mode == 1 && kind == 2) continue;
    if (mode == 2 && kind != 2) continue;
    if (kind == 0) gdn_chain(p, l, a0, a1, a2, a3, (float*)smraw);
    else if (kind == 1) hgrn_chain(p, l, a0, a1, a2, a3, (float*)smraw);
    else attn_item(p, a0, a1, a2, a3, smraw, mode == 2);
  }
}

__global__ void __launch_bounds__(NTHR, 2) mega(Params p) {
  __shared__ __attribute__((aligned(16))) unsigned char smem[LDS_BYTES];
  cg::grid_group grid = cg::this_grid();
  __shared__ uint4 xb_words;
  if (threadIdx.x == 0) xb_words = make_uint4(0u, 0u, 0u, 0u);
  __syncthreads();
  {
    XcdBarrier xb0 = xcd_barrier_post(p.xbar, (volatile LAS unsigned*)&xb_words);
    if (threadIdx.x == 0) ((volatile LAS unsigned*)&xb_words)[2] = xb0.x;
  }
#define GSYNC() do { XcdBarrier xb_; xb_.bar = p.xbar; xb_.st = (volatile LAS unsigned*)&xb_words; xb_.x = 0; \
    if (threadIdx.x == 0) xb_.x = ((volatile LAS unsigned*)&xb_words)[2]; xcd_barrier(xb_); } while (0)
  phase0(p, (float*)smem);
  grid.sync();
  rowpass_norm(p, 0, 0);
  GSYNC();
  for (int l = 0; l < 2; ++l) {
    phase_a(p, l, (u16*)smem);
    GSYNC();
    rowpass_b0(p, l);
    GSYNC();
    phase_b1(p, l, (u16*)smem);
    GSYNC();
    phase_c(p, l, smem);
    GSYNC();
    rowpass_c2(p, l);
    GSYNC();
    phase_gemm_y(p.MIX, 1024, p.WoutT + (size_t)l * 1024 * 1024, 1024, 1024, p.HQ, 1024, (u16*)smem);
    GSYNC();
    rowpass_norm(p, l, 1);
    GSYNC();
    phase_e(p, l, (u16*)smem);
    GSYNC();
    phase_gemm_y(p.P, DFF, p.WfoT + (size_t)l * 1024 * DFF, DFF, 1024, p.HQ, 1024, (u16*)smem);
    GSYNC();
    rowpass_norm(p, l, 2);
    if (l == 0) GSYNC();
  }
}

extern "C" void kernel_launch(void* const* d_in, const int* in_sizes, int n_in, void* d_out, int out_size, void* d_ws,
                              size_t ws_size, hipStream_t stream) {
  static int grid_blocks = 0;
  if (!grid_blocks) {
    int dev = 0, cus = 0, per_cu = 0;
    hipGetDevice(&dev);
    hipDeviceGetAttribute(&cus, hipDeviceAttributeMultiprocessorCount, dev);
    hipOccupancyMaxActiveBlocksPerMultiprocessor(&per_cu, mega, NTHR, 0);
    if (per_cu > 2) per_cu = 2;
    if (per_cu < 1) per_cu = 1;
    grid_blocks = cus * per_cu;
  }
  Params p{};
  const float* const* in = (const float* const*)d_in;
  p.x_prompt = in[0]; p.x_sample = in[1]; p.cache_ckv = in[2]; p.cache_kr = in[3]; p.state_gdn = in[4]; p.state_hgrn = in[5];
  p.c = in[6]; p.c_ctx = in[7]; p.w_ada = in[8]; p.b_ada = in[9]; p.g_pre_mix = in[10]; p.g_post_mix = in[11];
  p.g_pre_ffn = in[12]; p.g_post_ffn = in[13]; p.w_in = in[14]; p.w_out = in[15]; p.gdn_conv_w = in[16];
  p.gdn_a_log = in[17]; p.gdn_dt_bias = in[18]; p.gdn_norm_w = in[19]; p.hgrn_lb = in[20]; p.hgrn_norm_w = in[21];
  p.mla_q_norm_w = in[22]; p.mla_w_uq = in[23]; p.mla_kv_norm_w = in[24]; p.mla_w_ukv = in[25]; p.w_ffn_in = in[26];
  p.w_ffn_out = in[27];
  p.out = (float*)d_out;
  unsigned char* ws = (unsigned char*)d_ws;
  size_t off = 0;
  auto take = [&](size_t bytes) { unsigned char* r = ws + off; off += (bytes + 255) & ~(size_t)255; return r; };
  p.counters = (unsigned*)take(1024);
  p.xbar = (unsigned*)take(16384);
  p.WinT = (u16*)take((size_t)2 * 3072 * 1024 * 2);
  p.WuqT = (u16*)take((size_t)2 * 768 * 384 * 2);
  p.WukvT = (u16*)take((size_t)2 * 1024 * 256 * 2);
  p.WoutT = (u16*)take((size_t)2 * 1024 * 1024 * 2);
  p.WfiT = (u16*)take((size_t)2 * 5632 * 1024 * 2);
  p.WfoT = (u16*)take((size_t)2 * 1024 * 2816 * 2);
  p.mod = (float*)take((size_t)2 * 9 * 6144 * 4);
  p.HQ = (u16*)take((size_t)T_ALL * 1024 * 2);
  p.P = (u16*)take((size_t)T_ALL * PW * 2);
  p.KN = (u16*)take((size_t)(T_ALL + 2048) * 512 * 2);
  p.VTL = (u16*)take((size_t)8 * 4 * 128 * 4352 * 2);
  p.VTC = (u16*)take((size_t)16 * 4 * 128 * 256 * 2);
  p.CKVC = (u16*)take((size_t)2048 * 256 * 2);
  p.KRC = (u16*)take((size_t)2048 * 64 * 2);
  p.GAB = (float*)take((size_t)T_ALL * 16 * 4);
  p.MIX = (u16*)take((size_t)T_ALL * 1024 * 2);
  if (off > ws_size) { fprintf(stderr, "workspace too small: need %zu have %zu\n", off, ws_size); return; }
  hipMemsetAsync(p.counters, 0, 1024 + 16384, stream);
  void* args[] = {&p};
  hipError_t e = hipLaunchCooperativeKernel((void*)mega, dim3(grid_blocks), dim3(NTHR), args, 0, stream);
  if (e != hipSuccess) fprintf(stderr, "cooperative launch failed: %s (grid %d)\n", hipGetErrorString(e), grid_blocks);
}
```

```cpp
#include <hip/hip_runtime.h>
#include <hip/hip_cooperative_groups.h>
#include <cstdio>
namespace cg = cooperative_groups;

typedef unsigned short u16;
using bf16x8 = __attribute__((ext_vector_type(8))) short;
using f32x4  = __attribute__((ext_vector_type(4))) float;

#define T_CTX 4096
#define T_ALL 36864
#define PW 3072
#define DFF 2816
#define LDS_BYTES 73728
#define NTHR 256

#define P_GQKV 0
#define P_GZ 768
#define P_HQ 1024
#define P_HI 1280
#define P_HF 1536
#define P_HG 2048
#define P_MCQ 2304
#define P_MCKV 2688
#define P_MKR 2944
#define P_GA 3008

struct Params {
  const float *x_prompt, *x_sample, *cache_ckv, *cache_kr, *state_gdn, *state_hgrn, *c, *c_ctx;
  const float *w_ada, *b_ada, *g_pre_mix, *g_post_mix, *g_pre_ffn, *g_post_ffn, *w_in, *w_out;
  const float *gdn_conv_w, *gdn_a_log, *gdn_dt_bias, *gdn_norm_w, *hgrn_lb, *hgrn_norm_w;
  const float *mla_q_norm_w, *mla_w_uq, *mla_kv_norm_w, *mla_w_ukv, *w_ffn_in, *w_ffn_out;
  float* out;
  u16 *WinT, *WuqT, *WukvT, *WoutT, *WfiT, *WfoT;
  float* mod;
  u16 *HQ, *P, *KN, *VTL, *VTC, *CKVC, *KRC, *MIX;
  float* GAB;
  unsigned* counters;
  unsigned* xbar;
};

#define OUT_CKV   37748736
#define OUT_KR    39845888
#define OUT_SGDN  40370176
#define OUT_SHG   41418752

__device__ __forceinline__ u16 f2bf(float f) {
  unsigned u = __float_as_uint(f);
  u += 0x7fffu + ((u >> 16) & 1u);
  return (u16)(u >> 16);
}
__device__ __forceinline__ float bf2f(u16 h) { return __uint_as_float(((unsigned)h) << 16); }
__device__ __forceinline__ float wave_sum(float v) {
#pragma unroll
  for (int o = 32; o > 0; o >>= 1) v += __shfl_xor(v, o);
  return v;
}
__device__ __forceinline__ float sigmoidf_(float x) { return __builtin_amdgcn_rcpf(1.f + __expf(-x)); }
__device__ __forceinline__ float siluf_(float x) { return x * __builtin_amdgcn_rcpf(1.f + __expf(-x)); }
__device__ __forceinline__ int tid_l() { int t = threadIdx.x; asm volatile("" : "+v"(t)); return t; }
__device__ __forceinline__ int tok_mod(int t) { return t < T_CTX ? 0 : 1 + ((t - T_CTX) >> 12); }

__device__ __forceinline__ int map_col(int kind, int j) {
  if (kind == 0) return j;
  if (kind == 1) { if (j < 1024) return j; if (j < 3008) return j + 16; if (j < 3024) return 1024 + (j - 3008); return -1; }
  int blk = j >> 6, w = j & 63;
  return w < 32 ? blk * 32 + w : DFF + blk * 32 + (w - 32);
}

__device__ __forceinline__ void cvt_tile(const float* __restrict__ src, int K, int Nsrc, u16* __restrict__ dst, int kind, int jt, int kt, float* sm) {
  const int tid = tid_l();
  const int j0 = jt * 64, k0 = kt * 64;
  __syncthreads();
  {
    int jj = tid & 63, kk0 = tid >> 6;
    int sc = map_col(kind, j0 + jj);
    for (int kk = kk0; kk < 64; kk += 4)
      sm[kk * 65 + jj] = sc >= 0 ? src[(size_t)(k0 + kk) * Nsrc + sc] : 0.f;
  }
  __syncthreads();
  {
    int kk = tid & 63, jj0 = tid >> 6;
    for (int jj = jj0; jj < 64; jj += 4)
      dst[(size_t)(j0 + jj) * K + k0 + kk] = f2bf(sm[kk * 65 + jj]);
  }
}

__device__ __forceinline__ void mod_item(const Params& p, int item, float* sm) {
  const int l = item / 96, j0 = (item % 96) * 64;
  const int tid = tid_l();
  float* sC = sm;
  float* sR = sm + 9 * 1024;
  __syncthreads();
  for (int i = tid; i < 9 * 1024; i += NTHR) {
    int m = i >> 10, k = i & 1023;
    float v = m == 0 ? p.c_ctx[k] : p.c[(m - 1) * 1024 + k];
    sC[i] = siluf_(v);
  }
  __syncthreads();
  const int col = tid & 63, ks = tid >> 6;
  float acc[9];
#pragma unroll
  for (int m = 0; m < 9; ++m) acc[m] = 0.f;
  const float* wp = p.w_ada + (size_t)l * 1024 * 6144 + j0 + col;
  for (int k = ks * 256; k < ks * 256 + 256; ++k) {
    float w = wp[(size_t)k * 6144];
#pragma unroll
    for (int m = 0; m < 9; ++m) acc[m] += sC[m * 1024 + k] * w;
  }
#pragma unroll
  for (int m = 0; m < 9; ++m) sR[(ks * 9 + m) * 64 + col] = acc[m];
  __syncthreads();
  for (int i = tid; i < 9 * 64; i += NTHR) {
    int m = i >> 6, cc = i & 63;
    float v = sR[(0 * 9 + m) * 64 + cc] + sR[(1 * 9 + m) * 64 + cc] + sR[(2 * 9 + m) * 64 + cc] + sR[(3 * 9 + m) * 64 + cc];
    p.mod[((size_t)l * 9 + m) * 6144 + j0 + cc] = v + p.b_ada[l * 6144 + j0 + cc];
  }
}

__device__ __forceinline__ void phase0(const Params& p, float* sm) {
  const int PER_LAYER = 3272;
  const int total = 2 * PER_LAYER + 192;
  for (int item = blockIdx.x; item < total; item += gridDim.x) {
    if (item < 192) { mod_item(p, item, sm); continue; }
    int it = item - 192;
    int l = it / PER_LAYER, r = it % PER_LAYER;
    if (r < 768) { cvt_tile(p.w_in + (size_t)l * 1024 * 3024, 1024, 3024, p.WinT + (size_t)l * 3072 * 1024, 1, r / 16, r % 16, sm); continue; }
    r -= 768;
    if (r < 72) { cvt_tile(p.mla_w_uq + (size_t)l * 384 * 768, 384, 768, p.WuqT + (size_t)l * 768 * 384, 0, r / 6, r % 6, sm); continue; }
    r -= 72;
    if (r < 64) { cvt_tile(p.mla_w_ukv + (size_t)l * 256 * 1024, 256, 1024, p.WukvT + (size_t)l * 1024 * 256, 0, r / 4, r % 4, sm); continue; }
    r -= 64;
    if (r < 256) { cvt_tile(p.w_out + (size_t)l * 1024 * 1024, 1024, 1024, p.WoutT + (size_t)l * 1024 * 1024, 0, r / 16, r % 16, sm); continue; }
    r -= 256;
    if (r < 1408) { cvt_tile(p.w_ffn_in + (size_t)l * 1024 * 5632, 1024, 5632, p.WfiT + (size_t)l * 5632 * 1024, 2, r / 16, r % 16, sm); continue; }
    r -= 1408;
    cvt_tile(p.w_ffn_out + (size_t)l * 2816 * 1024, 2816, 1024, p.WfoT + (size_t)l * 1024 * 2816, 0, r / 44, r % 44, sm);
  }
}

__device__ __forceinline__ void rowpass_norm(const Params& p, int l, int stage) {
  const int tidl = tid_l();
  const int lane = tidl & 63, w = tidl >> 6;
  const int ln = stage == 0 ? 0 : (stage == 1 ? l : l + 1);
  const int sh_off = stage == 1 ? 3072 : 0;
  const float* gpre = stage == 1 ? p.g_pre_ffn + l * 1024 : p.g_pre_mix + (ln < 2 ? ln : 0) * 1024;
  u16* dst = stage == 1 ? p.MIX : p.HQ;
  for (int t = blockIdx.x * 4 + w; t < T_ALL; t += gridDim.x * 4) {
    const int m = tok_mod(t);
    float x[16];
    float* xo = p.out + (size_t)t * 1024;
    if (stage == 0) {
      const float* xi = t < T_CTX ? p.x_prompt + (size_t)t * 1024 : p.x_sample + (size_t)(t - T_CTX) * 1024;
#pragma unroll
      for (int i = 0; i < 4; ++i) {
        float4 v = *(const float4*)(xi + i * 256 + lane * 4);
        x[i * 4 + 0] = v.x; x[i * 4 + 1] = v.y; x[i * 4 + 2] = v.z; x[i * 4 + 3] = v.w;
      }
    } else {
      const u16* yp = p.HQ + (size_t)t * 1024;
      float y[16]; float ss = 0.f;
#pragma unroll
      for (int i = 0; i < 4; ++i) {
        uint2 v = *(const uint2*)(yp + i * 256 + lane * 4);
        y[i * 4 + 0] = bf2f((u16)(v.x & 0xffff)); y[i * 4 + 1] = bf2f((u16)(v.x >> 16));
        y[i * 4 + 2] = bf2f((u16)(v.y & 0xffff)); y[i * 4 + 3] = bf2f((u16)(v.y >> 16));
      }
#pragma unroll
      for (int i = 0; i < 16; ++i) ss += y[i] * y[i];
      ss = wave_sum(ss);
      const float rstd = rsqrtf(ss * (1.f / 1024.f) + 1e-6f);
      const float* gpost = (stage == 1 ? p.g_post_mix : p.g_post_ffn) + l * 1024;
      const float* gt = p.mod + ((size_t)l * 9 + m) * 6144 + (stage == 1 ? 2048 : 5120);
#pragma unroll
      for (int i = 0; i < 4; ++i) {
        float4 xv = *(const float4*)(xo + i * 256 + lane * 4);
        float4 gp = *(const float4*)(gpost + i * 256 + lane * 4);
        float4 gg = *(const float4*)(gt + i * 256 + lane * 4);
        x[i * 4 + 0] = xv.x + gg.x * y[i * 4 + 0] * rstd * gp.x;
        x[i * 4 + 1] = xv.y + gg.y * y[i * 4 + 1] * rstd * gp.y;
        x[i * 4 + 2] = xv.z + gg.z * y[i * 4 + 2] * rstd * gp.z;
        x[i * 4 + 3] = xv.w + gg.w * y[i * 4 + 3] * rstd * gp.w;
      }
    }
    __threadfence_block();
#pragma unroll
    for (int i = 0; i < 4; ++i)
      *(float4*)(xo + i * 256 + lane * 4) = make_float4(x[i * 4 + 0], x[i * 4 + 1], x[i * 4 + 2], x[i * 4 + 3]);
    if (ln >= 2) continue;
    float ss = 0.f;
#pragma unroll
    for (int i = 0; i < 16; ++i) ss += x[i] * x[i];
    ss = wave_sum(ss);
    const float rstd = rsqrtf(ss * (1.f / 1024.f) + 1e-6f);
    const float* sh = p.mod + ((size_t)ln * 9 + m) * 6144 + sh_off;
    const float* sc = sh + 1024;
    u16* hp = dst + (size_t)t * 1024;
#pragma unroll
    for (int i = 0; i < 4; ++i) {
      float4 gp = *(const float4*)(gpre + i * 256 + lane * 4);
      float4 s1 = *(const float4*)(sh + i * 256 + lane * 4);
      float4 c1 = *(const float4*)(sc + i * 256 + lane * 4);
      float h0 = x[i * 4 + 0] * rstd * gp.x * (1.f + c1.x) + s1.x;
      float h1 = x[i * 4 + 1] * rstd * gp.y * (1.f + c1.y) + s1.y;
      float h2 = x[i * 4 + 2] * rstd * gp.z * (1.f + c1.z) + s1.z;
      float h3 = x[i * 4 + 3] * rstd * gp.w * (1.f + c1.w) + s1.w;
      uint2 o;
      o.x = (unsigned)f2bf(h0) | ((unsigned)f2bf(h1) << 16);
      o.y = (unsigned)f2bf(h2) | ((unsigned)f2bf(h3) << 16);
      *(uint2*)(hp + i * 256 + lane * 4) = o;
    }
  }
}

__device__ __forceinline__ void rowpass_b0(const Params& p, int l) {
  const int tidl = tid_l();
  const int lane = tidl & 63, w = tidl >> 6;
  for (int t = blockIdx.x * 4 + w; t < T_ALL + 2048; t += gridDim.x * 4) {
    if (t >= T_ALL) {
      int r = t - T_ALL, b = r >> 8, s = r & 255;
      const float* ck = p.cache_ckv + (((size_t)b * 2 + l) * 256 + s) * 256;
      const float* kr = p.cache_kr + (((size_t)b * 2 + l) * 256 + s) * 64;
#pragma unroll
      for (int i = 0; i < 4; ++i) p.CKVC[(size_t)r * 256 + lane + 64 * i] = f2bf(ck[lane + 64 * i]);
      p.KRC[(size_t)r * 64 + lane] = f2bf(kr[lane]);
      continue;
    }
    u16* pr = p.P + (size_t)t * PW;
    {
      float v[6]; float ss = 0.f;
#pragma unroll
      for (int i = 0; i < 6; ++i) { v[i] = bf2f(pr[P_MCQ + lane + 64 * i]); ss += v[i] * v[i]; }
      ss = wave_sum(ss);
      float rstd = rsqrtf(ss * (1.f / 384.f) + 1e-6f);
#pragma unroll
      for (int i = 0; i < 6; ++i) pr[P_MCQ + lane + 64 * i] = f2bf(v[i] * rstd * p.mla_q_norm_w[l * 384 + lane + 64 * i]);
    }
    {
      float v[4]; float ss = 0.f;
#pragma unroll
      for (int i = 0; i < 4; ++i) { v[i] = bf2f(pr[P_MCKV + lane + 64 * i]); ss += v[i] * v[i]; }
      ss = wave_sum(ss);
      float rstd = rsqrtf(ss * (1.f / 256.f) + 1e-6f);
#pragma unroll
      for (int i = 0; i < 4; ++i) {
        float c = v[i] * rstd * p.mla_kv_norm_w[l * 256 + lane + 64 * i];
        pr[P_MCKV + lane + 64 * i] = f2bf(c);
        if (t < T_CTX) {
          int b = t >> 8, s = t & 255;
          p.out[OUT_CKV + (((size_t)b * 2 + l) * 256 + s) * 256 + lane + 64 * i] = c;
        }
      }
    }
    {
      float v = bf2f(pr[P_MKR + lane]);
      if (t < T_CTX) {
        int b = t >> 8, s = t & 255;
        p.out[OUT_KR + (((size_t)b * 2 + l) * 256 + s) * 64 + lane] = v;
      } else {
        int pos = (t - T_CTX) & 4095;
        int axis = lane >> 5, half = (lane >> 4) & 1, f = lane & 15;
        float posf = axis == 0 ? (float)(pos >> 6) : (float)(pos & 63);
        float inv = exp2f(-(float)f * (13.287712379549449f / 16.f));
        float ang = posf * inv;
        float sn, cs;
        __sincosf(ang, &sn, &cs);
        float other = __shfl_xor(v, 16);
        float o = half == 0 ? v * cs - other * sn : v * cs + other * sn;
        pr[P_MKR + lane] = f2bf(o);
      }
    }
  }
}

__device__ __forceinline__ void rowpass_c2(const Params& p, int l) {
  const int tidl = tid_l();
  const int lane = tidl & 63, w = tidl >> 6;
  for (int t = blockIdx.x * 4 + w; t < T_ALL; t += gridDim.x * 4) {
    u16* mr = p.MIX + (size_t)t * 1024;
    const u16* pr = p.P + (size_t)t * PW;
    const u16* qr = p.HQ + (size_t)t * 768;
    float og[4], oh[4];
#pragma unroll
    for (int h = 0; h < 4; ++h) {
      og[h] = bf2f(mr[h * 64 + lane]) + bf2f(mr[256 + h * 64 + lane]);
      oh[h] = bf2f(mr[512 + h * 64 + lane]) + bf2f(mr[768 + h * 64 + lane]);
    }
    u16 om[8];
#pragma unroll
    for (int i = 0; i < 8; ++i) { int c = lane + 64 * i; om[i] = qr[(c >> 7) * 192 + (c & 127)]; }
    float zg[4], gg[4];
#pragma unroll
    for (int h = 0; h < 4; ++h) { zg[h] = bf2f(pr[P_GZ + h * 64 + lane]); gg[h] = bf2f(pr[P_HG + h * 64 + lane]); }
    float rg[4], rh[4];
#pragma unroll
    for (int h = 0; h < 4; ++h) {
      rg[h] = rsqrtf(wave_sum(og[h] * og[h]) * (1.f / 64.f) + 1e-6f);
      rh[h] = rsqrtf(wave_sum(oh[h] * oh[h]) * (1.f / 64.f) + 1e-6f);
    }
    __threadfence_block();
    const float wg = p.gdn_norm_w[l * 64 + lane], wh = p.hgrn_norm_w[l * 64 + lane];
#pragma unroll
    for (int h = 0; h < 4; ++h) {
      mr[h * 64 + lane] = f2bf(og[h] * rg[h] * wg * siluf_(zg[h]));
      mr[256 + h * 64 + lane] = f2bf(oh[h] * rh[h] * wh * sigmoidf_(gg[h]));
    }
#pragma unroll
    for (int i = 0; i < 8; ++i) mr[512 + lane + 64 * i] = om[i];
  }
}

__device__ __forceinline__ void gemm128(const u16* __restrict__ A, int lda, const u16* __restrict__ B, int ldb, int K,
                                        u16* lds, f32x4 (&acc)[4][4]) {
  const int tid = tid_l(), lane = tid & 63, w = tid >> 6, wm = w >> 1, wn = w & 1;
  const int r16 = lane & 15, g4 = lane >> 4;
#pragma unroll
  for (int i = 0; i < 4; ++i)
#pragma unroll
    for (int j = 0; j < 4; ++j) acc[i][j] = f32x4{0.f, 0.f, 0.f, 0.f};
  const int lrow = tid >> 3, lkc = tid & 7;
  const u16* ap = A + (size_t)lrow * lda + lkc * 8;
  const u16* bp = B + (size_t)lrow * ldb + lkc * 8;
  const size_t sa32 = (size_t)32 * lda, sb32 = (size_t)32 * ldb;
  uint4 ra0 = *(const uint4*)(ap), ra1 = *(const uint4*)(ap + sa32), ra2 = *(const uint4*)(ap + 2 * sa32), ra3 = *(const uint4*)(ap + 3 * sa32);
  uint4 rb0 = *(const uint4*)(bp), rb1 = *(const uint4*)(bp + sb32), rb2 = *(const uint4*)(bp + 2 * sb32), rb3 = *(const uint4*)(bp + 3 * sb32);
  const int woff = lrow * 64 + ((lkc ^ (lrow & 7)) * 8);
  const int sw = r16 & 7;
  const int fa0 = (wm * 64 + r16) * 64 + ((g4 ^ sw) * 8);
  const int fa1 = (wm * 64 + r16) * 64 + (((4 + g4) ^ sw) * 8);
  const int fb0 = 128 * 64 + (wn * 64 + r16) * 64 + ((g4 ^ sw) * 8);
  const int fb1 = 128 * 64 + (wn * 64 + r16) * 64 + (((4 + g4) ^ sw) * 8);
  const int nk = K >> 6;
  __syncthreads();
  {
    u16* wa = lds + woff; u16* wb = lds + 128 * 64 + woff;
    *(uint4*)(wa) = ra0; *(uint4*)(wa + 32 * 64) = ra1; *(uint4*)(wa + 64 * 64) = ra2; *(uint4*)(wa + 96 * 64) = ra3;
    *(uint4*)(wb) = rb0; *(uint4*)(wb + 32 * 64) = rb1; *(uint4*)(wb + 64 * 64) = rb2; *(uint4*)(wb + 96 * 64) = rb3;
  }
  if (nk > 1) {
    const u16* a2 = ap + 64; const u16* b2 = bp + 64;
    ra0 = *(const uint4*)(a2); ra1 = *(const uint4*)(a2 + sa32); ra2 = *(const uint4*)(a2 + 2 * sa32); ra3 = *(const uint4*)(a2 + 3 * sa32);
    rb0 = *(const uint4*)(b2); rb1 = *(const uint4*)(b2 + sb32); rb2 = *(const uint4*)(b2 + 2 * sb32); rb3 = *(const uint4*)(b2 + 3 * sb32);
  }
  __syncthreads();
  for (int kt = 0; kt < nk; ++kt) {
    const u16* cur = lds + (kt & 1) * (256 * 64);
    if (kt + 1 < nk) {
      u16* nxt = lds + ((kt + 1) & 1) * (256 * 64);
      u16* wa = nxt + woff; u16* wb = nxt + 128 * 64 + woff;
      *(uint4*)(wa) = ra0; *(uint4*)(wa + 32 * 64) = ra1; *(uint4*)(wa + 64 * 64) = ra2; *(uint4*)(wa + 96 * 64) = ra3;
      *(uint4*)(wb) = rb0; *(uint4*)(wb + 32 * 64) = rb1; *(uint4*)(wb + 64 * 64) = rb2; *(uint4*)(wb + 96 * 64) = rb3;
      if (kt + 2 < nk) {
        const u16* a2 = ap + (kt + 2) * 64; const u16* b2 = bp + (kt + 2) * 64;
        ra0 = *(const uint4*)(a2); ra1 = *(const uint4*)(a2 + sa32); ra2 = *(const uint4*)(a2 + 2 * sa32); ra3 = *(const uint4*)(a2 + 3 * sa32);
        rb0 = *(const uint4*)(b2); rb1 = *(const uint4*)(b2 + sb32); rb2 = *(const uint4*)(b2 + 2 * sb32); rb3 = *(const uint4*)(b2 + 3 * sb32);
      }
    }
#pragma unroll
    for (int ks = 0; ks < 2; ++ks) {
      const u16* fa = cur + (ks ? fa1 : fa0);
      const u16* fb = cur + (ks ? fb1 : fb0);
      bf16x8 af0 = *(const bf16x8*)(fa), af1 = *(const bf16x8*)(fa + 16 * 64);
      bf16x8 af2 = *(const bf16x8*)(fa + 32 * 64), af3 = *(const bf16x8*)(fa + 48 * 64);
#pragma unroll
      for (int j = 0; j < 4; ++j) {
        bf16x8 bfj = *(const bf16x8*)(fb + j * 16 * 64);
        acc[0][j] = __builtin_amdgcn_mfma_f32_16x16x32_bf16(bfj, af0, acc[0][j], 0, 0, 0);
        acc[1][j] = __builtin_amdgcn_mfma_f32_16x16x32_bf16(bfj, af1, acc[1][j], 0, 0, 0);
        acc[2][j] = __builtin_amdgcn_mfma_f32_16x16x32_bf16(bfj, af2, acc[2][j], 0, 0, 0);
        acc[3][j] = __builtin_amdgcn_mfma_f32_16x16x32_bf16(bfj, af3, acc[3][j], 0, 0, 0);
      }
    }
    __syncthreads();
  }
}
__device__ __forceinline__ uint2 pack4(f32x4 v) {
  uint2 o;
  o.x = (unsigned)f2bf(v[0]) | ((unsigned)f2bf(v[1]) << 16);
  o.y = (unsigned)f2bf(v[2]) | ((unsigned)f2bf(v[3]) << 16);
  return o;
}
#define GEMM_RC const int tde = tid_l(); const int rb = ((tde >> 6) >> 1) * 64 + (tde & 15), cb = ((tde >> 6) & 1) * 64 + ((tde & 63) >> 4) * 4;

__device__ __forceinline__ void phase_a(const Params& p, int l, u16* lds) {
  const int ntn = 24, total = 288 * ntn;
  const u16* Bw = p.WinT + (size_t)l * 3072 * 1024;
  for (int item = blockIdx.x; item < total; item += gridDim.x) {
    const int mt = item / ntn, nt = item % ntn;
    const int m0 = mt * 128, n0 = nt * 128;
    f32x4 acc[4][4];
    gemm128(p.HQ + (size_t)m0 * 1024, 1024, Bw + (size_t)n0 * 1024, 1024, 1024, lds, acc);
    { GEMM_RC
#pragma unroll
      for (int mi = 0; mi < 4; ++mi) {
        const int row = m0 + rb + mi * 16;
#pragma unroll
        for (int ni = 0; ni < 4; ++ni) {
          const int col = n0 + cb + ni * 16;
          *(uint2*)(p.P + (size_t)row * PW + col) = pack4(acc[mi][ni]);
          if (col >= P_GA && col < P_GA + 16)
            *(float4*)(p.GAB + (size_t)row * 16 + (col - P_GA)) = make_float4(acc[mi][ni][0], acc[mi][ni][1], acc[mi][ni][2], acc[mi][ni][3]);
        }
      }
    }
  }
}

__device__ __forceinline__ void phase_b1(const Params& p, int l, u16* lds) {
  const int nq = 288 * 6, nkv = 304 * 8;
  for (int item = blockIdx.x; item < nq + nkv; item += gridDim.x) {
    if (item < nq) {
      const int mt = item / 6, nt = item % 6;
      const int m0 = mt * 128, n0 = nt * 128;
      const float qscale = 0.07216878364870322f * 1.4426950408889634f;
      f32x4 acc[4][4];
      gemm128(p.P + (size_t)m0 * PW + P_MCQ, PW, p.WuqT + (size_t)l * 768 * 384 + (size_t)n0 * 384, 384, 384, lds, acc);
      { GEMM_RC
        const int g4 = (tde & 63) >> 4;
        const int cw0 = n0 + cb - g4 * 4;
        const bool ropew = ((cw0 >> 6) % 3) == 2 && m0 >= T_CTX;
#pragma unroll
        for (int mi = 0; mi < 4; ++mi) {
          const int row = m0 + rb + mi * 16;
          f32x4 v0 = acc[mi][0], v1 = acc[mi][1], v2 = acc[mi][2], v3 = acc[mi][3];
          if (ropew) {
            const int pos = (row - T_CTX) & 4095;
#pragma unroll
            for (int r = 0; r < 4; ++r) {
              const float inv = exp2f(-(float)(g4 * 4 + r) * (13.287712379549449f / 16.f));
              float s0, c0, s1, c1;
              __sincosf((float)(pos >> 6) * inv, &s0, &c0);
              __sincosf((float)(pos & 63) * inv, &s1, &c1);
              const float a0 = v0[r] * c0 - v1[r] * s0, a1 = v1[r] * c0 + v0[r] * s0;
              const float b0 = v2[r] * c1 - v3[r] * s1, b1 = v3[r] * c1 + v2[r] * s1;
              v0[r] = a0; v1[r] = a1; v2[r] = b0; v3[r] = b1;
            }
          }
          u16* qp = p.HQ + (size_t)row * 768 + n0 + cb;
          *(uint2*)(qp) = pack4(v0 * qscale); *(uint2*)(qp + 16) = pack4(v1 * qscale);
          *(uint2*)(qp + 32) = pack4(v2 * qscale); *(uint2*)(qp + 48) = pack4(v3 * qscale);
        }
      }
    } else {
      const int it = item - nq;
      const int mt = it / 8, nt = it % 8;
      const int m0 = mt * 128, n0 = nt * 128;
      const u16* Ap; int lda;
      if (mt < 288) { Ap = p.P + (size_t)m0 * PW + P_MCKV; lda = PW; }
      else { Ap = p.CKVC + (size_t)(m0 - T_ALL) * 256; lda = 256; }
      f32x4 acc[4][4];
      gemm128(Ap, lda, p.WukvT + (size_t)l * 1024 * 256 + (size_t)n0 * 256, 256, 256, lds, acc);
      { GEMM_RC
#pragma unroll
        for (int mi = 0; mi < 4; ++mi) {
          const int row = m0 + rb + mi * 16;
          u16* vb; int vst;
          if (row < T_CTX) { int b = row >> 8, pos = row & 255; vb = p.VTC + (size_t)(b * 4) * 128 * 256 + pos; vst = 256; }
          else if (row < T_ALL) { int b = (row - T_CTX) >> 12, pos = (row - T_CTX) & 4095; vb = p.VTL + (size_t)(b * 4) * 128 * 4352 + pos; vst = 4352; }
          else { int b = (row - T_ALL) >> 8, pos = 4096 + ((row - T_ALL) & 255); vb = p.VTL + (size_t)(b * 4) * 128 * 4352 + pos; vst = 4352; }
#pragma unroll
          for (int ni = 0; ni < 4; ++ni) {
            const int col = n0 + cb + ni * 16;
            const int h = col >> 8, wi = col & 255;
            if (wi < 128) {
              *(uint2*)(p.KN + (size_t)row * 512 + h * 128 + wi) = pack4(acc[mi][ni]);
            } else {
              u16* dst = vb + (size_t)(h * 128 + (wi - 128)) * vst;
#pragma unroll
              for (int r = 0; r < 4; ++r) dst[(size_t)r * vst] = f2bf(acc[mi][ni][r]);
            }
          }
        }
      }
    }
  }
}

__device__ __forceinline__ void phase_gemm_y(const u16* A, int lda, const u16* B, int K, int N, u16* Y, int ldy, u16* lds) {
  const int ntn = N / 128, total = 288 * ntn;
  for (int item = blockIdx.x; item < total; item += gridDim.x) {
    const int mt = item / ntn, nt = item % ntn;
    const int m0 = mt * 128, n0 = nt * 128;
    f32x4 acc[4][4];
    gemm128(A + (size_t)m0 * lda, lda, B + (size_t)n0 * K, K, K, lds, acc);
    { GEMM_RC
#pragma unroll
      for (int mi = 0; mi < 4; ++mi)
#pragma unroll
        for (int ni = 0; ni < 4; ++ni)
          *(uint2*)(Y + (size_t)(m0 + rb + mi * 16) * ldy + n0 + cb + ni * 16) = pack4(acc[mi][ni]);
    }
  }
}

__device__ __forceinline__ void phase_e(const Params& p, int l, u16* lds) {
  const int ntn = 44, total = 288 * ntn;
  const u16* Bw = p.WfiT + (size_t)l * 5632 * 1024;
  for (int item = blockIdx.x; item < total; item += gridDim.x) {
    const int mt = item / ntn, nt = item % ntn;
    const int m0 = mt * 128, n0 = nt * 128;
    f32x4 acc[4][4];
    gemm128(p.MIX + (size_t)m0 * 1024, 1024, Bw + (size_t)n0 * 1024, 1024, 1024, lds, acc);
    { GEMM_RC
      const int g4x4 = ((tde & 63) >> 4) * 4;
      const int hc0 = ((n0 + cb - g4x4) >> 1) + g4x4;
#pragma unroll
      for (int mi = 0; mi < 4; ++mi)
#pragma unroll
        for (int ni = 0; ni < 2; ++ni) {
          f32x4 hv;
#pragma unroll
          for (int r = 0; r < 4; ++r) hv[r] = siluf_(acc[mi][ni][r]) * acc[mi][ni + 2][r];
          *(uint2*)(p.P + (size_t)(m0 + rb + mi * 16) * DFF + hc0 + ni * 16) = pack4(hv);
        }
    }
  }
}

#define KST 208
#define VST 80
#define PST 80
__device__ __forceinline__ void attn_item(const Params& p, int latent, int b, int h, int qb, unsigned char* smraw, int dummy = 0) {
  u16* sK = (u16*)smraw;
  u16* sV = sK + 64 * KST;
  u16* sP = sV + 128 * VST;
  const int tid = tid_l(), lane = tid & 63, w = tid >> 6, r16 = lane & 15, g4 = lane >> 4;
  const int nkeys = latent ? 4352 : 256;
  const int krow0 = latent ? T_CTX + b * 4096 : b * 256;
  const int tq0 = krow0 + qb * 128;
  const u16* vt = latent ? p.VTL + (size_t)((b * 4 + h) * 128) * 4352 : p.VTC + (size_t)((b * 4 + h) * 128) * 256;
  u16* sPw = sP + w * 32 * PST;
  bf16x8 q[2][6];
#pragma unroll
  for (int mi = 0; mi < 2; ++mi)
#pragma unroll
    for (int ks = 0; ks < 6; ++ks)
      q[mi][ks] = *(const bf16x8*)(p.HQ + (size_t)(tq0 + w * 32 + mi * 16 + r16) * 768 + h * 192 + ks * 32 + g4 * 8);
  f32x4 o[2][8];
  float mrow[2], lrow[2];
#pragma unroll
  for (int mi = 0; mi < 2; ++mi) {
#pragma unroll
    for (int nd = 0; nd < 8; ++nd) o[mi][nd] = f32x4{0.f, 0.f, 0.f, 0.f};
    mrow[mi] = -1e30f; lrow[mi] = 0.f;
  }
  const int lkey = tid >> 2, lpart = tid & 3;
  const int ldv = tid >> 1, lhalf = tid & 1;
  const int ntile = nkeys >> 6;
  uint4 k0, k1, k2, k3, k4, k5;
  {
    const int pos = lkey;
    const u16* srcn = p.KN + (size_t)(krow0 + pos) * 512 + h * 128 + lpart * 8;
    const u16* srcr = p.P + (size_t)(krow0 + pos) * PW + P_MKR + lpart * 8;
    k0 = *(const uint4*)(srcn); k1 = *(const uint4*)(srcn + 32); k2 = *(const uint4*)(srcn + 64); k3 = *(const uint4*)(srcn + 96);
    k4 = *(const uint4*)(srcr); k5 = *(const uint4*)(srcr + 32);
  }
  for (int kt = 0; kt < ntile; ++kt) {
    __syncthreads();
    {
      u16* dk = sK + lkey * KST + lpart * 8;
      *(uint4*)(dk) = k0; *(uint4*)(dk + 32) = k1; *(uint4*)(dk + 64) = k2; *(uint4*)(dk + 96) = k3;
      *(uint4*)(dk + 128) = k4; *(uint4*)(dk + 160) = k5;
    }
    const u16* sv = vt + (size_t)ldv * nkeys + kt * 64 + lhalf * 32;
    const uint4 v0 = *(const uint4*)(sv), v1 = *(const uint4*)(sv + 8), v2 = *(const uint4*)(sv + 16), v3 = *(const uint4*)(sv + 24);
    __syncthreads();
    f32x4 s[2][4];
#pragma unroll
    for (int mi = 0; mi < 2; ++mi)
#pragma unroll
      for (int ni = 0; ni < 4; ++ni) s[mi][ni] = f32x4{0.f, 0.f, 0.f, 0.f};
#pragma unroll
    for (int ks = 0; ks < 6; ++ks)
#pragma unroll
      for (int ni = 0; ni < 4; ++ni) {
        bf16x8 kf = *(const bf16x8*)(sK + (ni * 16 + r16) * KST + ks * 32 + g4 * 8);
        s[0][ni] = __builtin_amdgcn_mfma_f32_16x16x32_bf16(kf, q[0][ks], s[0][ni], 0, 0, 0);
        s[1][ni] = __builtin_amdgcn_mfma_f32_16x16x32_bf16(kf, q[1][ks], s[1][ni], 0, 0, 0);
      }
#pragma unroll
    for (int mi = 0; mi < 2; ++mi) {
      float mx = -1e30f;
#pragma unroll
      for (int ni = 0; ni < 4; ++ni)
#pragma unroll
        for (int r = 0; r < 4; ++r) mx = fmaxf(mx, s[mi][ni][r]);
      mx = fmaxf(mx, __shfl_xor(mx, 16)); mx = fmaxf(mx, __shfl_xor(mx, 32));
      const float mnew = fmaxf(mrow[mi], mx);
      const float alpha = __builtin_amdgcn_exp2f(mrow[mi] - mnew);
      mrow[mi] = mnew;
      float ps = 0.f;
#pragma unroll
      for (int ni = 0; ni < 4; ++ni) {
        f32x4 pv;
#pragma unroll
        for (int r = 0; r < 4; ++r) { pv[r] = __builtin_amdgcn_exp2f(s[mi][ni][r] - mnew); ps += pv[r]; }
        *(uint2*)(sPw + (mi * 16 + r16) * PST + ni * 16 + g4 * 4) = pack4(pv);
      }
      ps += __shfl_xor(ps, 16); ps += __shfl_xor(ps, 32);
      lrow[mi] = lrow[mi] * alpha + ps;
#pragma unroll
      for (int nd = 0; nd < 8; ++nd) o[mi][nd] *= alpha;
    }
    {
      u16* dvp = sV + ldv * VST + lhalf * 32;
      *(uint4*)(dvp) = v0; *(uint4*)(dvp + 8) = v1; *(uint4*)(dvp + 16) = v2; *(uint4*)(dvp + 24) = v3;
    }
    __syncthreads();
    if (kt + 1 < ntile) {
      const int pos = (kt + 1) * 64 + lkey;
      const bool own = (!latent) || pos < 4096;
      const int row = own ? krow0 + pos : T_ALL + b * 256 + (pos - 4096);
      const u16* srcn = p.KN + (size_t)row * 512 + h * 128 + lpart * 8;
      const u16* srcr = own ? p.P + (size_t)(krow0 + pos) * PW + P_MKR + lpart * 8
                            : p.KRC + (size_t)(b * 256 + pos - 4096) * 64 + lpart * 8;
      k0 = *(const uint4*)(srcn); k1 = *(const uint4*)(srcn + 32); k2 = *(const uint4*)(srcn + 64); k3 = *(const uint4*)(srcn + 96);
      k4 = *(const uint4*)(srcr); k5 = *(const uint4*)(srcr + 32);
    }
#pragma unroll
    for (int ks2 = 0; ks2 < 2; ++ks2) {
      bf16x8 pf0 = *(const bf16x8*)(sPw + (0 * 16 + r16) * PST + ks2 * 32 + g4 * 8);
      bf16x8 pf1 = *(const bf16x8*)(sPw + (1 * 16 + r16) * PST + ks2 * 32 + g4 * 8);
#pragma unroll
      for (int nd = 0; nd < 8; ++nd) {
        bf16x8 vf = *(const bf16x8*)(sV + (nd * 16 + r16) * VST + ks2 * 32 + g4 * 8);
        o[0][nd] = __builtin_amdgcn_mfma_f32_16x16x32_bf16(vf, pf0, o[0][nd], 0, 0, 0);
        o[1][nd] = __builtin_amdgcn_mfma_f32_16x16x32_bf16(vf, pf1, o[1][nd], 0, 0, 0);
      }
    }
  }
#pragma unroll
  for (int mi = 0; mi < 2; ++mi) {
    const float inv = 1.f / lrow[mi];
    const int qrow = tq0 + w * 32 + mi * 16 + r16;
    u16* op = p.HQ + (size_t)qrow * 768 + h * 192 + g4 * 4;
    if (dummy) op = p.HQ + (size_t)T_ALL * 768 + (size_t)(qrow % 9216) * 768 + h * 192 + g4 * 4;
#pragma unroll
    for (int nd = 0; nd < 8; ++nd) *(uint2*)(op + nd * 16) = pack4(o[mi][nd] * inv);
  }
}

#define XB_TMO      128
#define XB_XCNT(j)  (256  + 64 * (j))
#define XB_XSUB(j)  (1280 + 64 * (j))
#define XB_XGEN(j)  (2304 + 64 * (j))
#define XB_TOP      3328
#define XB_TOPGEN   3392
#define XCD_BAR_WORDS 3456
#define XB_SPIN_CAP (1u << 23)
#define LAS __attribute__((address_space(3)))

__device__ __forceinline__ unsigned xb_ld(unsigned* p)              { return __hip_atomic_load(p, __ATOMIC_RELAXED, __HIP_MEMORY_SCOPE_AGENT); }
__device__ __forceinline__ unsigned xb_add(unsigned* p, unsigned v) { return __hip_atomic_fetch_add(p, v, __ATOMIC_RELAXED, __HIP_MEMORY_SCOPE_AGENT); }
__device__ __forceinline__ unsigned xb_xcc_id() { return (unsigned)__builtin_amdgcn_s_getreg((3 << 11) | 20) & 0xFu; }
#define XB_SPIN(cond, bar) do { unsigned _sp = 0; while (cond) { __builtin_amdgcn_s_sleep(1); \
    if ((++_sp & 255u) == 0u) { if (xb_ld(&(bar)[XB_TMO])) break; if (_sp > XB_SPIN_CAP) { atomicAdd(&(bar)[XB_TMO], 1u); break; } } } } while (0)

struct XcdBarrier {
    unsigned* bar; unsigned x;
    volatile LAS unsigned* st;
};

__device__ __forceinline__ XcdBarrier xcd_barrier_post(unsigned* bar, volatile LAS unsigned* st) {
    XcdBarrier b; b.bar = bar; b.x = xb_xcc_id(); b.st = st;
    if (threadIdx.x == 0) (void)xb_add(&bar[XB_XCNT(b.x)], 1u);
    return b;
}
__device__ __forceinline__ void xcd_barrier_complete(unsigned* bar, unsigned x, unsigned& nloc, unsigned& nx) {
    const unsigned G = gridDim.x * gridDim.y * gridDim.z;
    unsigned sum, cnt, mine, sp = 0u;
    for (;;) {
        sum = 0u; cnt = 0u; mine = 0u;
#pragma unroll
        for (unsigned j = 0; j < 16; ++j) { const unsigned c = xb_ld(&bar[XB_XCNT(j)]); sum += c; cnt += (c > 0u) ? 1u : 0u; mine = (j == x) ? c : mine; }
        if (sum == G) break;
        __builtin_amdgcn_s_sleep(1);
        if ((++sp & 255u) == 0u) { if (xb_ld(&bar[XB_TMO])) break; if (sp > XB_SPIN_CAP) { atomicAdd(&bar[XB_TMO], 1u); break; } }
    }
    nloc = mine > 0u ? mine : 1u; nx = cnt > 0u ? cnt : 1u;
}

__device__ __forceinline__ void xcd_barrier(const XcdBarrier& b) {
    asm volatile("s_waitcnt vmcnt(0)" ::: "memory");
    __syncthreads();
    if (threadIdx.x == 0) {
        unsigned* bar = b.bar;
        __builtin_amdgcn_s_waitcnt(0);
        unsigned nloc = b.st[0], nx = b.st[1];
        if (nloc == 0u) { xcd_barrier_complete(bar, b.x, nloc, nx); b.st[0] = nloc; b.st[1] = nx; }
        const unsigned old = xb_add(&bar[XB_XSUB(b.x)], 1u);
        const unsigned gen = old / nloc;
        if (old + 1u == (gen + 1u) * nloc) {
            __builtin_amdgcn_fence(__ATOMIC_RELEASE, "agent");
            asm volatile("s_waitcnt vmcnt(0)" ::: "memory");
            const unsigned og = xb_add(&bar[XB_TOP], 1u);
            const unsigned tg = og / nx;
            if (og + 1u == (tg + 1u) * nx) xb_add(&bar[XB_TOPGEN], 1u);
            else XB_SPIN(xb_ld(&bar[XB_TOPGEN]) == tg, bar);
            __builtin_amdgcn_fence(__ATOMIC_ACQUIRE, "agent");
            xb_add(&bar[XB_XGEN(b.x)], 1u);
            asm volatile("s_waitcnt vmcnt(0)" ::: "memory");
        } else {
            XB_SPIN(xb_ld(&bar[XB_XGEN(b.x)]) == gen, bar);
            __builtin_amdgcn_fence(__ATOMIC_ACQUIRE, "agent");
            asm volatile("s_waitcnt vmcnt(0)" ::: "memory");
        }
    }
    __syncthreads();
}


__device__ __forceinline__ void gbar(unsigned* ctr, unsigned target) {
  asm volatile("s_waitcnt vmcnt(0)" ::: "memory");
  __syncthreads();
  if (tid_l() == 0) {
    __builtin_amdgcn_fence(__ATOMIC_RELEASE, "agent");
    asm volatile("s_waitcnt vmcnt(0)" ::: "memory");
    __hip_atomic_fetch_add(ctr, 1u, __ATOMIC_RELAXED, __HIP_MEMORY_SCOPE_AGENT);
    while (__hip_atomic_load(ctr, __ATOMIC_RELAXED, __HIP_MEMORY_SCOPE_AGENT) < target) __builtin_amdgcn_s_sleep(2);
    __builtin_amdgcn_fence(__ATOMIC_ACQUIRE, "agent");
    asm volatile("s_waitcnt vmcnt(0)" ::: "memory");
  }
  __syncthreads();
}
#define MFMA4(a, b, c) __builtin_amdgcn_mfma_f32_16x16x4f32((a), (b), (c), 0, 0, 0)

__device__ __forceinline__ float softplusf_(float x) { return fmaxf(x, 0.f) + log1pf(__expf(-fabsf(x))); }

__device__ __forceinline__ void gdn_chain(const Params& p, int l, int seq, int h, int d, int vs, float* sm) {
  float* sMM = sm;
  float* sK = sMM + 64 * 68;
  float* sW = sK + 64 * 65;
  float* sV = sW + 64 * 65;
  float* sS = sV + 64 * 33;
  float* sGc = sS + 64 * 33;
  float* sBeta = sGc + 64;
  float* sBg = sBeta + 64;
  const int tid = tid_l(), lane = tid & 63, w = tid >> 6, r16 = lane & 15, g4 = lane >> 4;
  const bool latent = seq >= 16;
  const int len = latent ? 4096 : 256;
  const int t0 = latent ? T_CTX + (seq - 16) * 4096 : seq * 256;
  const int nchunks = len >> 6;
  const int c2 = tid % 80, rg = tid / 80;
  const int lc = 2 * c2;
  int gch;
  if (lc < 64) gch = h * 64 + lc; else if (lc < 128) gch = 256 + h * 64 + (lc - 64); else gch = 512 + h * 64 + vs * 32 + (lc - 128);
  float cwa[5], cwb[5];
#pragma unroll
  for (int j = 0; j < 5; ++j) {
    cwa[j] = p.gdn_conv_w[((size_t)l * 768 + gch) * 5 + j];
    cwb[j] = p.gdn_conv_w[((size_t)l * 768 + gch + 1) * 5 + j];
  }
  const float Acoef = -__expf(p.gdn_a_log[l * 8 + d * 4 + h]);
  const float dtb = p.gdn_dt_bias[l * 8 + d * 4 + h];
  f32x4 Sreg[2];
  __syncthreads();
  {
    const float* s0 = latent ? p.state_gdn + ((((size_t)(seq - 16) * 2 + l) * 2 + d) * 4 + h) * 4096 : nullptr;
#pragma unroll
    for (int n = 0; n < 2; ++n)
#pragma unroll
      for (int r = 0; r < 4; ++r) {
        const int kidx = 16 * w + g4 * 4 + r, cc = n * 16 + r16;
        float v = latent ? s0[kidx * 64 + vs * 32 + cc] : 0.f;
        Sreg[n][r] = v;
        sS[kidx * 33 + cc] = v;
      }
  }
  const u16* Pb = p.P + (size_t)t0 * PW;
  u16* sRaw = (u16*)sMM;
  u16* sRawV = (u16*)(sBg + 64);
#define GDN_UNIT(i, tl, rr, un, pgo_, plo_) \
    const int e_ = (tl) + (i) * 256; const int rr = e_ / 20, un = e_ % 20; const bool val_ = e_ < 1360; \
    const int pgo_ = rr * PW + (un < 8 ? h * 64 + un * 8 : (un < 16 ? 256 + h * 64 + (un - 8) * 8 : 512 + h * 64 + vs * 32 + (un - 16) * 8)); \
    const int plo_ = un < 16 ? rr * 128 + un * 8 : (int)(sRawV - sRaw) + rr * 32 + (un - 16) * 8;
  uint4 pf[6];
  float pga = 0.f, pgb = 0.f;
  {
    const int tlo = d == 0 ? 0 : len - 64;
#pragma unroll
    for (int i = 0; i < 6; ++i) {
      GDN_UNIT(i, tid, rr, un, pgo_, plo_)
      const int tau = tlo - 2 + rr;
      pf[i] = (val_ && tau >= 0 && tau < len) ? *(const uint4*)(Pb + (ptrdiff_t)(tlo - 2) * PW + pgo_) : make_uint4(0, 0, 0, 0);
    }
    if (tid < 64) {
      const int u = d == 0 ? tid : 63 - tid;
      const float* gab = p.GAB + (size_t)(t0 + tlo + u) * 16;
      pga = gab[d * 4 + h]; pgb = gab[8 + d * 4 + h];
    }
  }
  for (int n = 0; n < nchunks; ++n) {
    const int tlo = d == 0 ? n * 64 : len - 64 * (n + 1);
    const int tl2 = tid_l();
#pragma unroll
    for (int i = 0; i < 6; ++i) {
      GDN_UNIT(i, tl2, rr, un, pgo_, plo_)
      if (val_) *(uint4*)(sRaw + plo_) = pf[i];
    }
    const float ga_cur = pga, gb_cur = pgb;
    __syncthreads();
    if (n + 1 < nchunks) {
      const int tlo2 = d == 0 ? (n + 1) * 64 : len - 64 * (n + 2);
#pragma unroll
      for (int i = 0; i < 6; ++i) {
        GDN_UNIT(i, tl2, rr, un, pgo_, plo_)
        const int tau = tlo2 - 2 + rr;
        pf[i] = (val_ && tau >= 0 && tau < len) ? *(const uint4*)(Pb + (ptrdiff_t)(tlo2 - 2) * PW + pgo_) : make_uint4(0, 0, 0, 0);
      }
      if (tid < 64) {
        const int u = d == 0 ? tid : 63 - tid;
        const float* gab = p.GAB + (size_t)(t0 + tlo2 + u) * 16;
        pga = gab[d * 4 + h]; pgb = gab[8 + d * 4 + h];
      }
    }
    if (tid < 240) {
      const int u0 = rg * 22;
      const u16* rp = lc < 128 ? sRaw + lc : sRawV + (lc - 128);
      const int rst = lc < 128 ? 128 : 32;
      float* dq = lc < 64 ? sW + lc : (lc < 128 ? sK + (lc - 64) : sV + (lc - 128));
      const int dst = lc < 128 ? 65 : 33;
#pragma unroll 1
      for (int hf = 0; hf < 2; ++hf) {
        const int ub = u0 + hf * 11;
        unsigned rv[15];
#pragma unroll
        for (int j = 0; j < 15; ++j) { const int row = ub + j < 67 ? ub + j : 67; rv[j] = *(const unsigned*)(rp + row * rst); }
#pragma unroll
        for (int uu = 0; uu < 11; ++uu) {
          const int u = ub + uu;
          float ya = 0.f, yb = 0.f;
#pragma unroll
          for (int j = 0; j < 5; ++j) {
            ya += cwa[j] * bf2f((u16)(rv[uu + j] & 0xffff));
            yb += cwb[j] * bf2f((u16)(rv[uu + j] >> 16));
          }
          ya = siluf_(ya); yb = siluf_(yb);
          const int pp = d == 0 ? u : 63 - u;
          if (u < 64) { dq[pp * dst] = ya; dq[pp * dst + 1] = yb; }
        }
      }
    }
    if (tid < 64) {
      const int pp = tid;
      float g = Acoef * softplusf_(ga_cur + dtb);
      float bt = sigmoidf_(gb_cur);
#pragma unroll
      for (int o = 1; o < 64; o <<= 1) { float tt = __shfl_up(g, o); if (lane >= o) g += tt; }
      sGc[pp] = g; sBeta[pp] = bt; sBg[pp] = bt * __expf(g);
    }
    __syncthreads();
    {
      const int row = tid >> 2, q4 = tid & 3;
      float sq = 0.f, sk = 0.f;
#pragma unroll
      for (int i = 0; i < 16; ++i) { float a = sW[row * 65 + q4 * 16 + i], b = sK[row * 65 + q4 * 16 + i]; sq += a * a; sk += b * b; }
      sq += __shfl_xor(sq, 1); sq += __shfl_xor(sq, 2);
      sk += __shfl_xor(sk, 1); sk += __shfl_xor(sk, 2);
      const float rq = rsqrtf(sq + 1e-6f) * 0.125f, rk = rsqrtf(sk + 1e-6f);
#pragma unroll
      for (int i = 0; i < 16; ++i) { sW[row * 65 + q4 * 16 + i] *= rq; sK[row * 65 + q4 * 16 + i] *= rk; }
    }
    __syncthreads();
    float qa[16];
#pragma unroll
    for (int s = 0; s < 16; ++s) qa[s] = sW[(16 * w + r16) * 65 + 4 * s + g4];
    const unsigned tcode = w == 0 ? 0x730u : (w == 1 ? 0xA51u : (w == 2 ? 0x062u : 0x0FBu));
    const int tcnt = w < 2 ? 3 : 2;
    f32x4 attacc[3];
#pragma unroll
    for (int t = 0; t < 3; ++t) {
      attacc[t] = f32x4{0.f, 0.f, 0.f, 0.f};
      if (t < tcnt) {
        const int ti = (tcode >> (4 * t)) & 3, tn = (tcode >> (4 * t + 2)) & 3;
        f32x4 accm = f32x4{0.f, 0.f, 0.f, 0.f};
        const float* ak = sK + (16 * ti + r16) * 65 + g4;
        const float* aq = sW + (16 * ti + r16) * 65 + g4;
        const float* bk = sK + (16 * tn + r16) * 65 + g4;
#pragma unroll
        for (int s = 0; s < 16; ++s) {
          const float bv = bk[4 * s];
          accm = MFMA4(ak[4 * s], bv, accm);
          attacc[t] = MFMA4(aq[4 * s], bv, attacc[t]);
        }
#pragma unroll
        for (int r = 0; r < 4; ++r) {
          const int i = 16 * ti + g4 * 4 + r, j = 16 * tn + r16;
          sMM[i * 68 + j] = (i > j) ? sBeta[i] * accm[r] * __expf(sGc[i] - sGc[j]) : 0.f;
        }
      }
    }
    __syncthreads();
    if (w == 0) {
      const int bi = tid >> 4, c = tid & 15;
      float* md = sMM + (16 * bi) * 68 + 16 * bi;
      float a[16];
#pragma unroll
      for (int r = 0; r < 16; ++r) a[r] = (r == c) ? 1.f : 0.f;
#pragma unroll
      for (int r = 1; r < 16; ++r) {
#pragma unroll
        for (int q4 = 0; q4 < (r + 3) / 4; ++q4) {
          const float4 m = *(const float4*)(md + r * 68 + 4 * q4);
          if (q4 * 4 + 0 < r) a[r] -= m.x * a[q4 * 4 + 0];
          if (q4 * 4 + 1 < r) a[r] -= m.y * a[q4 * 4 + 1];
          if (q4 * 4 + 2 < r) a[r] -= m.z * a[q4 * 4 + 2];
          if (q4 * 4 + 3 < r) a[r] -= m.w * a[q4 * 4 + 3];
        }
      }
      __builtin_amdgcn_fence(__ATOMIC_SEQ_CST, "wavefront");
#pragma unroll
      for (int r = 0; r < 16; ++r) md[r * 68 + c] = a[r];
    } else {
      for (int t = w - 1; t < 8; t += 3) {
        const int ti = t >> 1, tc = t & 1;
        const float bg = sBg[16 * ti + r16];
        const float* ak = sK + (16 * ti + r16) * 65 + g4;
        const float* bs = sS + g4 * 33 + 16 * tc + r16;
        f32x4 acc = f32x4{0.f, 0.f, 0.f, 0.f};
#pragma unroll
        for (int s = 0; s < 16; ++s) acc = MFMA4(ak[4 * s] * bg, bs[4 * s * 33], acc);
#pragma unroll
        for (int r = 0; r < 4; ++r) {
          const int i = 16 * ti + g4 * 4 + r, cc = 16 * tc + r16;
          sV[i * 33 + cc] = sV[i * 33 + cc] * sBeta[i] - acc[r];
        }
      }
    }
    __syncthreads();
    for (int ib = 0; ib < 4; ++ib) {
      if (w < 2) {
        const int ct = w;
        f32x4 acc = f32x4{0.f, 0.f, 0.f, 0.f};
        const float* am = sMM + (16 * ib + r16) * 68 + g4;
        const float* bx = sV + g4 * 33 + 16 * ct + r16;
        for (int s4 = 0; s4 < ib; ++s4) {
#pragma unroll
          for (int s = 0; s < 4; ++s) acc = MFMA4(am[16 * s4 + 4 * s], bx[(16 * s4 + 4 * s) * 33], acc);
        }
        f32x4 rm;
#pragma unroll
        for (int r = 0; r < 4; ++r) rm[r] = sV[(16 * ib + g4 * 4 + r) * 33 + 16 * ct + r16] - acc[r];
        const float* dd = sMM + (16 * ib + r16) * 68 + 16 * ib + 4 * g4;
        f32x4 xn = f32x4{0.f, 0.f, 0.f, 0.f};
#pragma unroll
        for (int s = 0; s < 4; ++s) xn = MFMA4(dd[s], rm[s], xn);
#pragma unroll
        for (int r = 0; r < 4; ++r) sV[(16 * ib + g4 * 4 + r) * 33 + 16 * ct + r16] = xn[r];
      }
      __syncthreads();
    }
#pragma unroll
    for (int t = 0; t < 3; ++t) {
      if (t < tcnt) {
        const int ti = (tcode >> (4 * t)) & 3, tn = (tcode >> (4 * t + 2)) & 3;
#pragma unroll
        for (int r = 0; r < 4; ++r) {
          const int i = 16 * ti + g4 * 4 + r, j = 16 * tn + r16;
          sMM[i * 68 + j] = (i >= j) ? attacc[t][r] * __expf(sGc[i] - sGc[j]) : 0.f;
        }
      }
    }
    __syncthreads();
    {
      f32x4 acc[2] = {f32x4{0.f, 0.f, 0.f, 0.f}, f32x4{0.f, 0.f, 0.f, 0.f}};
      const float eg = __expf(sGc[16 * w + r16]);
#pragma unroll
      for (int s = 0; s < 16; ++s) {
        const float a = qa[s] * eg;
        acc[0] = MFMA4(a, sS[(4 * s + g4) * 33 + r16], acc[0]);
        acc[1] = MFMA4(a, sS[(4 * s + g4) * 33 + 16 + r16], acc[1]);
      }
#pragma unroll
      for (int s = 0; s < 16; ++s) {
        if (s < 4 * (w + 1)) {
          const float a = sMM[(16 * w + r16) * 68 + 4 * s + g4];
          acc[0] = MFMA4(a, sV[(4 * s + g4) * 33 + r16], acc[0]);
          acc[1] = MFMA4(a, sV[(4 * s + g4) * 33 + 16 + r16], acc[1]);
        }
      }
#pragma unroll
      for (int nn = 0; nn < 2; ++nn)
#pragma unroll
        for (int r = 0; r < 4; ++r) {
          const int pp = 16 * w + g4 * 4 + r;
          const int u = d == 0 ? pp : 63 - pp;
          p.MIX[(size_t)(t0 + tlo + u) * 1024 + d * 256 + h * 64 + vs * 32 + nn * 16 + r16] = f2bf(acc[nn][r]);
        }
    }
    __syncthreads();
    {
      const float g63 = sGc[63];
      const float gl = __expf(g63);
#pragma unroll
      for (int nn = 0; nn < 2; ++nn)
#pragma unroll
        for (int r = 0; r < 4; ++r) Sreg[nn][r] *= gl;
#pragma unroll
      for (int s = 0; s < 16; ++s) {
        const int srow = 4 * s + g4;
        const float a = sK[srow * 65 + 16 * w + r16] * __expf(g63 - sGc[srow]);
        Sreg[0] = MFMA4(a, sV[srow * 33 + r16], Sreg[0]);
        Sreg[1] = MFMA4(a, sV[srow * 33 + 16 + r16], Sreg[1]);
      }
    }
    __syncthreads();
#pragma unroll
    for (int nn = 0; nn < 2; ++nn)
#pragma unroll
      for (int r = 0; r < 4; ++r) sS[(16 * w + g4 * 4 + r) * 33 + nn * 16 + r16] = Sreg[nn][r];
    __syncthreads();
  }
  if (!latent) {
    float* so = p.out + OUT_SGDN + ((((size_t)seq * 2 + l) * 2 + d) * 4 + h) * 4096;
#pragma unroll
    for (int nn = 0; nn < 2; ++nn)
#pragma unroll
      for (int r = 0; r < 4; ++r) so[(16 * w + g4 * 4 + r) * 64 + vs * 32 + nn * 16 + r16] = Sreg[nn][r];
  }
}

__device__ __forceinline__ void hgrn_chain(const Params& p, int l, int seq, int h, int d, int vs, float* sm) {
  float* sBC = sm;
  float* sK = sBC + 64 * 65;
  float* sAT = sK + 64 * 65;
  float* sV = sAT + 64 * 68;
  float* sS = sV + 64 * 33;
  float* sTot = sS + 64 * 33;
  const int tid = tid_l(), lane = tid & 63, w = tid >> 6, r16 = lane & 15, g4 = lane >> 4;
  const bool latent = seq >= 16;
  const int len = latent ? 4096 : 256;
  const int t0 = latent ? T_CTX + (seq - 16) * 4096 : seq * 256;
  const int nchunks = len >> 6;
  float lbk;
  {
    const int kch = h * 64 + (tid & 63);
    lbk = (l == 0) ? 0.f : sigmoidf_(p.hgrn_lb[256 + kch] - p.hgrn_lb[kch]);
  }
  f32x4 Sreg[2];
  __syncthreads();
  {
    const float* s0 = latent ? p.state_hgrn + ((((size_t)(seq - 16) * 2 + l) * 2 + d) * 4 + h) * 4096 : nullptr;
#pragma unroll
    for (int n = 0; n < 2; ++n)
#pragma unroll
      for (int r = 0; r < 4; ++r) {
        const int kidx = 16 * w + g4 * 4 + r, cc = n * 16 + r16;
        float v = latent ? s0[kidx * 64 + vs * 32 + cc] : 0.f;
        Sreg[n][r] = v;
        sS[kidx * 33 + cc] = v;
      }
  }
  const u16* Pb = p.P + (size_t)t0 * PW;
  float* sLb = sTot + 256;
  if (tid < 64) sLb[tid] = lbk;
  __syncthreads();
  int pgo[5];
#pragma unroll
  for (int i = 0; i < 5; ++i) {
    const int e = tid + i * 256;
    const int u = e / 20, un = e % 20;
    pgo[i] = u * PW + (un < 8 ? P_HF + d * 256 + h * 64 + un * 8 : (un < 12 ? P_HI + h * 64 + vs * 32 + (un - 8) * 8 : P_HQ + h * 64 + (un - 12) * 8));
  }
  uint4 pf[5];
  {
    const int tlo = d == 0 ? 0 : len - 64;
#pragma unroll
    for (int i = 0; i < 5; ++i) pf[i] = *(const uint4*)(Pb + (size_t)tlo * PW + pgo[i]);
  }
  for (int n = 0; n < nchunks; ++n) {
#pragma unroll
    for (int i = 0; i < 5; ++i) {
      const int e = tid + i * 256;
      const int u = e / 20, un = e % 20;
      const int pp = d == 0 ? u : 63 - u;
      const unsigned wv[4] = {pf[i].x, pf[i].y, pf[i].z, pf[i].w};
#pragma unroll
      for (int j = 0; j < 8; ++j) {
        const float x = bf2f((u16)((wv[j >> 1] >> ((j & 1) * 16)) & 0xffff));
        if (un < 8) {
          const int k = un * 8 + j;
          const float lb = sLb[k];
          const float sg_ = sigmoidf_(x);
          const float gate = lb + (1.f - lb) * sg_;
          sBC[pp * 65 + k] = __logf(fmaxf(gate, 1e-30f));
          sK[pp * 65 + k] = (1.f - lb) * (1.f - sg_);
        } else if (un < 12) {
          sV[pp * 33 + (un - 8) * 8 + j] = x;
        } else {
          sAT[pp * 68 + (un - 12) * 8 + j] = x;
        }
      }
    }
    __syncthreads();
    if (n + 1 < nchunks) {
      const int tlo2 = d == 0 ? (n + 1) * 64 : len - 64 * (n + 2);
#pragma unroll
      for (int i = 0; i < 5; ++i) pf[i] = *(const uint4*)(Pb + (size_t)tlo2 * PW + pgo[i]);
    }
    const int tlo = d == 0 ? n * 64 : len - 64 * (n + 1);
    float cs[16];
    {
      const int k = tid & 63, sg = tid >> 6;
      float run = 0.f;
#pragma unroll
      for (int i = 0; i < 16; ++i) { run += sBC[(16 * sg + i) * 65 + k]; cs[i] = run; }
      sTot[sg * 64 + k] = run;
    }
    float qa[16];
#pragma unroll
    for (int s = 0; s < 16; ++s) qa[s] = sAT[(16 * w + r16) * 68 + 4 * s + g4];
    __syncthreads();
    {
      const int k = tid & 63, sg = tid >> 6;
      float off = 0.f;
      for (int s2 = 0; s2 < sg; ++s2) off += sTot[s2 * 64 + k];
#pragma unroll
      for (int i = 0; i < 16; ++i) sBC[(16 * sg + i) * 65 + k] = cs[i] + off;
    }
    __syncthreads();
    {
      float aq[16], rf[16];
#pragma unroll
      for (int s = 0; s < 16; ++s) {
        const int kk = 4 * s + g4;
        rf[s] = (w == 0) ? 0.f : sBC[(16 * w - 1) * 65 + kk];
        aq[s] = qa[s] * __expf(sBC[(16 * w + r16) * 65 + kk] - rf[s]);
      }
#pragma unroll
      for (int nn = 0; nn < 4; ++nn) {
        f32x4 acc = f32x4{0.f, 0.f, 0.f, 0.f};
        if (nn <= w) {
#pragma unroll
          for (int s = 0; s < 16; ++s) {
            const int kk = 4 * s + g4, sc = 16 * nn + r16;
            const float bv = sK[sc * 65 + kk] * __expf(fminf(rf[s] - sBC[sc * 65 + kk], 80.f));
            acc = MFMA4(aq[s], bv, acc);
          }
        }
#pragma unroll
        for (int r = 0; r < 4; ++r) {
          const int i = 16 * w + g4 * 4 + r, j = 16 * nn + r16;
          sAT[i * 68 + j] = (i >= j) ? acc[r] : 0.f;
        }
      }
    }
    __syncthreads();
    {
      f32x4 acc[2] = {f32x4{0.f, 0.f, 0.f, 0.f}, f32x4{0.f, 0.f, 0.f, 0.f}};
#pragma unroll
      for (int s = 0; s < 16; ++s) {
        const int kk = 4 * s + g4;
        const float a = qa[s] * __expf(sBC[(16 * w + r16) * 65 + kk]);
        acc[0] = MFMA4(a, sS[kk * 33 + r16], acc[0]);
        acc[1] = MFMA4(a, sS[kk * 33 + 16 + r16], acc[1]);
      }
#pragma unroll
      for (int s = 0; s < 16; ++s) {
        if (s < 4 * (w + 1)) {
          const float a = sAT[(16 * w + r16) * 68 + 4 * s + g4];
          acc[0] = MFMA4(a, sV[(4 * s + g4) * 33 + r16], acc[0]);
          acc[1] = MFMA4(a, sV[(4 * s + g4) * 33 + 16 + r16], acc[1]);
        }
      }
#pragma unroll
      for (int nn = 0; nn < 2; ++nn)
#pragma unroll
        for (int r = 0; r < 4; ++r) {
          const int pp = 16 * w + g4 * 4 + r;
          const int u = d == 0 ? pp : 63 - pp;
          p.MIX[(size_t)(t0 + tlo + u) * 1024 + 512 + d * 256 + h * 64 + vs * 32 + nn * 16 + r16] = f2bf(acc[nn][r]);
        }
    }
    __syncthreads();
    {
#pragma unroll
      for (int nn = 0; nn < 2; ++nn)
#pragma unroll
        for (int r = 0; r < 4; ++r) Sreg[nn][r] *= __expf(sBC[63 * 65 + 16 * w + g4 * 4 + r]);
      const int kA = 16 * w + r16;
      const float blA = sBC[63 * 65 + kA];
#pragma unroll
      for (int s = 0; s < 16; ++s) {
        const int srow = 4 * s + g4;
        const float a = sK[srow * 65 + kA] * __expf(blA - sBC[srow * 65 + kA]);
        Sreg[0] = MFMA4(a, sV[srow * 33 + r16], Sreg[0]);
        Sreg[1] = MFMA4(a, sV[srow * 33 + 16 + r16], Sreg[1]);
      }
    }
    __syncthreads();
#pragma unroll
    for (int nn = 0; nn < 2; ++nn)
#pragma unroll
      for (int r = 0; r < 4; ++r) sS[(16 * w + g4 * 4 + r) * 33 + nn * 16 + r16] = Sreg[nn][r];
    __syncthreads();
  }
  if (!latent) {
    float* so = p.out + OUT_SHG + ((((size_t)seq * 2 + l) * 2 + d) * 4 + h) * 4096;
#pragma unroll
    for (int nn = 0; nn < 2; ++nn)
#pragma unroll
      for (int r = 0; r < 4; ++r) so[(16 * w + g4 * 4 + r) * 64 + vs * 32 + nn * 16 + r16] = Sreg[nn][r];
  }
}

__device__ __forceinline__ void phase_c(const Params& p, int l, unsigned char* smraw, int mode = 0) {
  __shared__ int s_item;
  const int total = 1920;
  for (;;) {
    __syncthreads();
    if (tid_l() == 0) s_item = (int)atomicAdd(&p.counters[l * 64 + mode * 16], 1u);
    __syncthreads();
    const int item = s_item;
    if (item >= total) break;
    int kind, a0, a1, a2, a3;
    if (item < 256 || (item >= 1280 && item < 1792)) {
      const int i2 = item < 256 ? item : item - 1280;
      const int rest = i2 >> 1;
      kind = i2 & 1;
      a3 = rest & 1; a2 = (rest >> 1) & 1; a1 = (rest >> 2) & 3; a0 = (rest >> 4) + (item < 256 ? 16 : 0);
    } else if (item < 1280) {
      const int i2 = item - 256;
      kind = 2; a0 = 1; a1 = i2 >> 7; a2 = (i2 >> 5) & 3; a3 = i2 & 31;
    } else {
      const int i2 = item - 1792;
      kind = 2; a0 = 0; a1 = i2 >> 3; a2 = (i2 >> 1) & 3; a3 = i2 & 1;
    }
    if (mode == 1 && kind == 2) continue;
    if (mode == 2 && kind != 2) continue;
    if (kind == 0) gdn_chain(p, l, a0, a1, a2, a3, (float*)smraw);
    else if (kind == 1) hgrn_chain(p, l, a0, a1, a2, a3, (float*)smraw);
    else attn_item(p, a0, a1, a2, a3, smraw, mode == 2);
  }
}

__global__ void __launch_bounds__(NTHR, 2) mega(Params p) {
  __shared__ __attribute__((aligned(16))) unsigned char smem[LDS_BYTES];
  cg::grid_group grid = cg::this_grid();
  __shared__ uint4 xb_words;
  if (threadIdx.x == 0) xb_words = make_uint4(0u, 0u, 0u, 0u);
  __syncthreads();
  {
    XcdBarrier xb0 = xcd_barrier_post(p.xbar, (volatile LAS unsigned*)&xb_words);
    if (threadIdx.x == 0) ((volatile LAS unsigned*)&xb_words)[2] = xb0.x;
  }
#define GSYNC() do { XcdBarrier xb_; xb_.bar = p.xbar; xb_.st = (volatile LAS unsigned*)&xb_words; xb_.x = 0; \
    if (threadIdx.x == 0) xb_.x = ((volatile LAS unsigned*)&xb_words)[2]; xcd_barrier(xb_); } while (0)
  phase0(p, (float*)smem);
  grid.sync();
  rowpass_norm(p, 0, 0);
  GSYNC();
  for (int l = 0; l < 2; ++l) {
    phase_a(p, l, (u16*)smem);
    GSYNC();
    rowpass_b0(p, l);
    GSYNC();
    phase_b1(p, l, (u16*)smem);
    GSYNC();
    phase_c(p, l, smem);
    GSYNC();
    rowpass_c2(p, l);
    GSYNC();
    phase_gemm_y(p.MIX, 1024, p.WoutT + (size_t)l * 1024 * 1024, 1024, 1024, p.HQ, 1024, (u16*)smem);
    GSYNC();
    rowpass_norm(p, l, 1);
    GSYNC();
    phase_e(p, l, (u16*)smem);
    GSYNC();
    phase_gemm_y(p.P, DFF, p.WfoT + (size_t)l * 1024 * DFF, DFF, 1024, p.HQ, 1024, (u16*)smem);
    GSYNC();
    rowpass_norm(p, l, 2);
    if (l == 0) GSYNC();
  }
}

extern "C" void kernel_launch(void* const* d_in, const int* in_sizes, int n_in, void* d_out, int out_size, void* d_ws,
                              size_t ws_size, hipStream_t stream) {
  static int grid_blocks = 0;
  if (!grid_blocks) {
    int dev = 0, cus = 0, per_cu = 0;
    hipGetDevice(&dev);
    hipDeviceGetAttribute(&cus, hipDeviceAttributeMultiprocessorCount, dev);
    hipOccupancyMaxActiveBlocksPerMultiprocessor(&per_cu, mega, NTHR, 0);
    if (per_cu > 2) per_cu = 2;
    if (per_cu < 1) per_cu = 1;
    grid_blocks = cus * per_cu;
  }
  Params p{};
  const float* const* in = (const float* const*)d_in;
  p.x_prompt = in[0]; p.x_sample = in[1]; p.cache_ckv = in[2]; p.cache_kr = in[3]; p.state_gdn = in[4]; p.state_hgrn = in[5];
  p.c = in[6]; p.c_ctx = in[7]; p.w_ada = in[8]; p.b_ada = in[9]; p.g_pre_mix = in[10]; p.g_post_mix = in[11];
  p.g_pre_ffn = in[12]; p.g_post_ffn = in[13]; p.w_in = in[14]; p.w_out = in[15]; p.gdn_conv_w = in[16];
  p.gdn_a_log = in[17]; p.gdn_dt_bias = in[18]; p.gdn_norm_w = in[19]; p.hgrn_lb = in[20]; p.hgrn_norm_w = in[21];
  p.mla_q_norm_w = in[22]; p.mla_w_uq = in[23]; p.mla_kv_norm_w = in[24]; p.mla_w_ukv = in[25]; p.w_ffn_in = in[26];
  p.w_ffn_out = in[27];
  p.out = (float*)d_out;
  unsigned char* ws = (unsigned char*)d_ws;
  size_t off = 0;
  auto take = [&](size_t bytes) { unsigned char* r = ws + off; off += (bytes + 255) & ~(size_t)255; return r; };
  p.counters = (unsigned*)take(1024);
  p.xbar = (unsigned*)take(16384);
  p.WinT = (u16*)take((size_t)2 * 3072 * 1024 * 2);
  p.WuqT = (u16*)take((size_t)2 * 768 * 384 * 2);
  p.WukvT = (u16*)take((size_t)2 * 1024 * 256 * 2);
  p.WoutT = (u16*)take((size_t)2 * 1024 * 1024 * 2);
  p.WfiT = (u16*)take((size_t)2 * 5632 * 1024 * 2);
  p.WfoT = (u16*)take((size_t)2 * 1024 * 2816 * 2);
  p.mod = (float*)take((size_t)2 * 9 * 6144 * 4);
  p.HQ = (u16*)take((size_t)T_ALL * 1024 * 2);
  p.P = (u16*)take((size_t)T_ALL * PW * 2);
  p.KN = (u16*)take((size_t)(T_ALL + 2048) * 512 * 2);
  p.VTL = (u16*)take((size_t)8 * 4 * 128 * 4352 * 2);
  p.VTC = (u16*)take((size_t)16 * 4 * 128 * 256 * 2);
  p.CKVC = (u16*)take((size_t)2048 * 256 * 2);
  p.KRC = (u16*)take((size_t)2048 * 64 * 2);
  p.GAB = (float*)take((size_t)T_ALL * 16 * 4);
  p.MIX = (u16*)take((size_t)T_ALL * 1024 * 2);
  if (off > ws_size) { fprintf(stderr, "workspace too small: need %zu have %zu\n", off, ws_size); return; }
  hipMemsetAsync(p.counters, 0, 1024 + 16384, stream);
  void* args[] = {&p};
  hipError_t e = hipLaunchCooperativeKernel((void*)mega, dim3(grid_blocks), dim3(NTHR), args, 0, stream);
  if (e != hipSuccess) fprintf(stderr, "cooperative launch failed: %s (grid %d)\n", hipGetErrorString(e), grid_blocks);
}
```

```cpp
#include <hip/hip_runtime.h>
#include <hip/hip_cooperative_groups.h>
#include <cstdio>
namespace cg = cooperative_groups;

typedef unsigned short u16;
using bf16x8 = __attribute__((ext_vector_type(8))) short;
using f32x4  = __attribute__((ext_vector_type(4))) float;

#define T_CTX 4096
#define T_ALL 36864
#define PW 3072
#define DFF 2816
#define LDS_BYTES 73728
#define NTHR 256

#define P_GQKV 0
#define P_GZ 768
#define P_HQ 1024
#define P_HI 1280
#define P_HF 1536
#define P_HG 2048
#define P_MCQ 2304
#define P_MCKV 2688
#define P_MKR 2944
#define P_GA 3008

struct Params {
  const float *x_prompt, *x_sample, *cache_ckv, *cache_kr, *state_gdn, *state_hgrn, *c, *c_ctx;
  const float *w_ada, *b_ada, *g_pre_mix, *g_post_mix, *g_pre_ffn, *g_post_ffn, *w_in, *w_out;
  const float *gdn_conv_w, *gdn_a_log, *gdn_dt_bias, *gdn_norm_w, *hgrn_lb, *hgrn_norm_w;
  const float *mla_q_norm_w, *mla_w_uq, *mla_kv_norm_w, *mla_w_ukv, *w_ffn_in, *w_ffn_out;
  float* out;
  u16 *WinT, *WuqT, *WukvT, *WoutT, *WfiT, *WfoT;
  float* mod;
  u16 *HQ, *P, *KN, *VTL, *VTC, *CKVC, *KRC, *MIX;
  float* GAB;
  unsigned* counters;
  unsigned* xbar;
};

#define OUT_CKV   37748736
#define OUT_KR    39845888
#define OUT_SGDN  40370176
#define OUT_SHG   41418752

__device__ __forceinline__ u16 f2bf(float f) {
  unsigned u = __float_as_uint(f);
  u += 0x7fffu + ((u >> 16) & 1u);
  return (u16)(u >> 16);
}
__device__ __forceinline__ float bf2f(u16 h) { return __uint_as_float(((unsigned)h) << 16); }
__device__ __forceinline__ float wave_sum(float v) {
#pragma unroll
  for (int o = 32; o > 0; o >>= 1) v += __shfl_xor(v, o);
  return v;
}
__device__ __forceinline__ float sigmoidf_(float x) { return __builtin_amdgcn_rcpf(1.f + __expf(-x)); }
__device__ __forceinline__ float siluf_(float x) { return x * __builtin_amdgcn_rcpf(1.f + __expf(-x)); }
__device__ __forceinline__ int tid_l() { int t = threadIdx.x; asm volatile("" : "+v"(t)); return t; }
__device__ __forceinline__ int tok_mod(int t) { return t < T_CTX ? 0 : 1 + ((t - T_CTX) >> 12); }

__device__ __forceinline__ int map_col(int kind, int j) {
  if (kind == 0) return j;
  if (kind == 1) { if (j < 1024) return j; if (j < 3008) return j + 16; if (j < 3024) return 1024 + (j - 3008); return -1; }
  int blk = j >> 6, w = j & 63;
  return w < 32 ? blk * 32 + w : DFF + blk * 32 + (w - 32);
}

__device__ __forceinline__ void cvt_tile(const float* __restrict__ src, int K, int Nsrc, u16* __restrict__ dst, int kind, int jt, int kt, float* sm) {
  const int tid = tid_l();
  const int j0 = jt * 64, k0 = kt * 64;
  __syncthreads();
  {
    int jj = tid & 63, kk0 = tid >> 6;
    int sc = map_col(kind, j0 + jj);
    for (int kk = kk0; kk < 64; kk += 4)
      sm[kk * 65 + jj] = sc >= 0 ? src[(size_t)(k0 + kk) * Nsrc + sc] : 0.f;
  }
  __syncthreads();
  {
    int kk = tid & 63, jj0 = tid >> 6;
    for (int jj = jj0; jj < 64; jj += 4)
      dst[(size_t)(j0 + jj) * K + k0 + kk] = f2bf(sm[kk * 65 + jj]);
  }
}

__device__ __forceinline__ void mod_item(const Params& p, int item, float* sm) {
  const int l = item / 96, j0 = (item % 96) * 64;
  const int tid = tid_l();
  float* sC = sm;
  float* sR = sm + 9 * 1024;
  __syncthreads();
  for (int i = tid; i < 9 * 1024; i += NTHR) {
    int m = i >> 10, k = i & 1023;
    float v = m == 0 ? p.c_ctx[k] : p.c[(m - 1) * 1024 + k];
    sC[i] = siluf_(v);
  }
  __syncthreads();
  const int col = tid & 63, ks = tid >> 6;
  float acc[9];
#pragma unroll
  for (int m = 0; m < 9; ++m) acc[m] = 0.f;
  const float* wp = p.w_ada + (size_t)l * 1024 * 6144 + j0 + col;
  for (int k = ks * 256; k < ks * 256 + 256; ++k) {
    float w = wp[(size_t)k * 6144];
#pragma unroll
    for (int m = 0; m < 9; ++m) acc[m] += sC[m * 1024 + k] * w;
  }
#pragma unroll
  for (int m = 0; m < 9; ++m) sR[(ks * 9 + m) * 64 + col] = acc[m];
  __syncthreads();
  for (int i = tid; i < 9 * 64; i += NTHR) {
    int m = i >> 6, cc = i & 63;
    float v = sR[(0 * 9 + m) * 64 + cc] + sR[(1 * 9 + m) * 64 + cc] + sR[(2 * 9 + m) * 64 + cc] + sR[(3 * 9 + m) * 64 + cc];
    p.mod[((size_t)l * 9 + m) * 6144 + j0 + cc] = v + p.b_ada[l * 6144 + j0 + cc];
  }
}

__device__ __forceinline__ void phase0(const Params& p, float* sm) {
  const int PER_LAYER = 3272;
  const int total = 2 * PER_LAYER + 192;
  for (int item = blockIdx.x; item < total; item += gridDim.x) {
    if (item < 192) { mod_item(p, item, sm); continue; }
    int it = item - 192;
    int l = it / PER_LAYER, r = it % PER_LAYER;
    if (r < 768) { cvt_tile(p.w_in + (size_t)l * 1024 * 3024, 1024, 3024, p.WinT + (size_t)l * 3072 * 1024, 1, r / 16, r % 16, sm); continue; }
    r -= 768;
    if (r < 72) { cvt_tile(p.mla_w_uq + (size_t)l * 384 * 768, 384, 768, p.WuqT + (size_t)l * 768 * 384, 0, r / 6, r % 6, sm); continue; }
    r -= 72;
    if (r < 64) { cvt_tile(p.mla_w_ukv + (size_t)l * 256 * 1024, 256, 1024, p.WukvT + (size_t)l * 1024 * 256, 0, r / 4, r % 4, sm); continue; }
    r -= 64;
    if (r < 256) { cvt_tile(p.w_out + (size_t)l * 1024 * 1024, 1024, 1024, p.WoutT + (size_t)l * 1024 * 1024, 0, r / 16, r % 16, sm); continue; }
    r -= 256;
    if (r < 1408) { cvt_tile(p.w_ffn_in + (size_t)l * 1024 * 5632, 1024, 5632, p.WfiT + (size_t)l * 5632 * 1024, 2, r / 16, r % 16, sm); continue; }
    r -= 1408;
    cvt_tile(p.w_ffn_out + (size_t)l * 2816 * 1024, 2816, 1024, p.WfoT + (size_t)l * 1024 * 2816, 0, r / 44, r % 44, sm);
  }
}

__device__ __forceinline__ void rowpass_norm(const Params& p, int l, int stage) {
  const int tidl = tid_l();
  const int lane = tidl & 63, w = tidl >> 6;
  const int ln = stage == 0 ? 0 : (stage == 1 ? l : l + 1);
  const int sh_off = stage == 1 ? 3072 : 0;
  const float* gpre = stage == 1 ? p.g_pre_ffn + l * 1024 : p.g_pre_mix + (ln < 2 ? ln : 0) * 1024;
  u16* dst = stage == 1 ? p.MIX : p.HQ;
  for (int t = blockIdx.x * 4 + w; t < T_ALL; t += gridDim.x * 4) {
    const int m = tok_mod(t);
    float x[16];
    float* xo = p.out + (size_t)t * 1024;
    if (stage == 0) {
      const float* xi = t < T_CTX ? p.x_prompt + (size_t)t * 1024 : p.x_sample + (size_t)(t - T_CTX) * 1024;
#pragma unroll
      for (int i = 0; i < 4; ++i) {
        float4 v = *(const float4*)(xi + i * 256 + lane * 4);
        x[i * 4 + 0] = v.x; x[i * 4 + 1] = v.y; x[i * 4 + 2] = v.z; x[i * 4 + 3] = v.w;
      }
    } else {
      const u16* yp = p.HQ + (size_t)t * 1024;
      float y[16]; float ss = 0.f;
#pragma unroll
      for (int i = 0; i < 4; ++i) {
        uint2 v = *(const uint2*)(yp + i * 256 + lane * 4);
        y[i * 4 + 0] = bf2f((u16)(v.x & 0xffff)); y[i * 4 + 1] = bf2f((u16)(v.x >> 16));
        y[i * 4 + 2] = bf2f((u16)(v.y & 0xffff)); y[i * 4 + 3] = bf2f((u16)(v.y >> 16));
      }
#pragma unroll
      for (int i = 0; i < 16; ++i) ss += y[i] * y[i];
      ss = wave_sum(ss);
      const float rstd = rsqrtf(ss * (1.f / 1024.f) + 1e-6f);
      const float* gpost = (stage == 1 ? p.g_post_mix : p.g_post_ffn) + l * 1024;
      const float* gt = p.mod + ((size_t)l * 9 + m) * 6144 + (stage == 1 ? 2048 : 5120);
#pragma unroll
      for (int i = 0; i < 4; ++i) {
        float4 xv = *(const float4*)(xo + i * 256 + lane * 4);
        float4 gp = *(const float4*)(gpost + i * 256 + lane * 4);
        float4 gg = *(const float4*)(gt + i * 256 + lane * 4);
        x[i * 4 + 0] = xv.x + gg.x * y[i * 4 + 0] * rstd * gp.x;
        x[i * 4 + 1] = xv.y + gg.y * y[i * 4 + 1] * rstd * gp.y;
        x[i * 4 + 2] = xv.z + gg.z * y[i * 4 + 2] * rstd * gp.z;
        x[i * 4 + 3] = xv.w + gg.w * y[i * 4 + 3] * rstd * gp.w;
      }
    }
    __threadfence_block();
#pragma unroll
    for (int i = 0; i < 4; ++i)
      *(float4*)(xo + i * 256 + lane * 4) = make_float4(x[i * 4 + 0], x[i * 4 + 1], x[i * 4 + 2], x[i * 4 + 3]);
    if (ln >= 2) continue;
    float ss = 0.f;
#pragma unroll
    for (int i = 0; i < 16; ++i) ss += x[i] * x[i];
    ss = wave_sum(ss);
    const float rstd = rsqrtf(ss * (1.f / 1024.f) + 1e-6f);
    const float* sh = p.mod + ((size_t)ln * 9 + m) * 6144 + sh_off;
    const float* sc = sh + 1024;
    u16* hp = dst + (size_t)t * 1024;
#pragma unroll
    for (int i = 0; i < 4; ++i) {
      float4 gp = *(const float4*)(gpre + i * 256 + lane * 4);
      float4 s1 = *(const float4*)(sh + i * 256 + lane * 4);
      float4 c1 = *(const float4*)(sc + i * 256 + lane * 4);
      float h0 = x[i * 4 + 0] * rstd * gp.x * (1.f + c1.x) + s1.x;
      float h1 = x[i * 4 + 1] * rstd * gp.y * (1.f + c1.y) + s1.y;
      float h2 = x[i * 4 + 2] * rstd * gp.z * (1.f + c1.z) + s1.z;
      float h3 = x[i * 4 + 3] * rstd * gp.w * (1.f + c1.w) + s1.w;
      uint2 o;
      o.x = (unsigned)f2bf(h0) | ((unsigned)f2bf(h1) << 16);
      o.y = (unsigned)f2bf(h2) | ((unsigned)f2bf(h3) << 16);
      *(uint2*)(hp + i * 256 + lane * 4) = o;
    }
  }
}

__device__ __forceinline__ void rowpass_b0(const Params& p, int l) {
  const int tidl = tid_l();
  const int lane = tidl & 63, w = tidl >> 6;
  for (int t = blockIdx.x * 4 + w; t < T_ALL + 2048; t += gridDim.x * 4) {
    if (t >= T_ALL) {
      int r = t - T_ALL, b = r >> 8, s = r & 255;
      const float* ck = p.cache_ckv + (((size_t)b * 2 + l) * 256 + s) * 256;
      const float* kr = p.cache_kr + (((size_t)b * 2 + l) * 256 + s) * 64;
#pragma unroll
      for (int i = 0; i < 4; ++i) p.CKVC[(size_t)r * 256 + lane + 64 * i] = f2bf(ck[lane + 64 * i]);
      p.KRC[(size_t)r * 64 + lane] = f2bf(kr[lane]);
      continue;
    }
    u16* pr = p.P + (size_t)t * PW;
    {
      float v[6]; float ss = 0.f;
#pragma unroll
      for (int i = 0; i < 6; ++i) { v[i] = bf2f(pr[P_MCQ + lane + 64 * i]); ss += v[i] * v[i]; }
      ss = wave_sum(ss);
      float rstd = rsqrtf(ss * (1.f / 384.f) + 1e-6f);
#pragma unroll
      for (int i = 0; i < 6; ++i) pr[P_MCQ + lane + 64 * i] = f2bf(v[i] * rstd * p.mla_q_norm_w[l * 384 + lane + 64 * i]);
    }
    {
      float v[4]; float ss = 0.f;
#pragma unroll
      for (int i = 0; i < 4; ++i) { v[i] = bf2f(pr[P_MCKV + lane + 64 * i]); ss += v[i] * v[i]; }
      ss = wave_sum(ss);
      float rstd = rsqrtf(ss * (1.f / 256.f) + 1e-6f);
#pragma unroll
      for (int i = 0; i < 4; ++i) {
        float c = v[i] * rstd * p.mla_kv_norm_w[l * 256 + lane + 64 * i];
        pr[P_MCKV + lane + 64 * i] = f2bf(c);
        if (t < T_CTX) {
          int b = t >> 8, s = t & 255;
          p.out[OUT_CKV + (((size_t)b * 2 + l) * 256 + s) * 256 + lane + 64 * i] = c;
        }
      }
    }
    {
      float v = bf2f(pr[P_MKR + lane]);
      if (t < T_CTX) {
        int b = t >> 8, s = t & 255;
        p.out[OUT_KR + (((size_t)b * 2 + l) * 256 + s) * 64 + lane] = v;
      } else {
        int pos = (t - T_CTX) & 4095;
        int axis = lane >> 5, half = (lane >> 4) & 1, f = lane & 15;
        float posf = axis == 0 ? (float)(pos >> 6) : (float)(pos & 63);
        float inv = exp2f(-(float)f * (13.287712379549449f / 16.f));
        float ang = posf * inv;
        float sn, cs;
        __sincosf(ang, &sn, &cs);
        float other = __shfl_xor(v, 16);
        float o = half == 0 ? v * cs - other * sn : v * cs + other * sn;
        pr[P_MKR + lane] = f2bf(o);
      }
    }
  }
}


#define P_QH 2304
#define P_KH 2560
__device__ __forceinline__ void rowpass_b2(const Params& p, int l) {
  const int tidl = tid_l();
  const int lane = tidl & 63, w = tidl >> 6;
  float cw[6][2][5];
#pragma unroll
  for (int g = 0; g < 6; ++g)
#pragma unroll
    for (int e = 0; e < 2; ++e)
#pragma unroll
      for (int j = 0; j < 5; ++j) cw[g][e][j] = p.gdn_conv_w[((size_t)l * 768 + 128 * g + 2 * lane + e) * 5 + j];
  u16* VH = p.HQ + (size_t)T_ALL * 768;
  for (int t = blockIdx.x * 4 + w; t < T_ALL; t += gridDim.x * 4) {
    const int len = t < T_CTX ? 256 : 4096;
    const int tau = t < T_CTX ? (t & 255) : ((t - T_CTX) & 4095);
    float y[6][2];
#pragma unroll
    for (int g = 0; g < 6; ++g) { y[g][0] = 0.f; y[g][1] = 0.f; }
#pragma unroll
    for (int j = 0; j < 5; ++j) {
      const int tt = tau + j - 2;
      if (tt >= 0 && tt < len) {
        const u16* pr = p.P + (size_t)(t + j - 2) * PW + 2 * lane;
#pragma unroll
        for (int g = 0; g < 6; ++g) {
          const unsigned v = *(const unsigned*)(pr + 128 * g);
          y[g][0] += cw[g][0][j] * bf2f((u16)(v & 0xffff));
          y[g][1] += cw[g][1][j] * bf2f((u16)(v >> 16));
        }
      }
    }
#pragma unroll
    for (int g = 0; g < 6; ++g) { y[g][0] = siluf_(y[g][0]); y[g][1] = siluf_(y[g][1]); }
#pragma unroll
    for (int g = 0; g < 4; ++g) {
      float ss = y[g][0] * y[g][0] + y[g][1] * y[g][1];
      ss += __shfl_xor(ss, 1); ss += __shfl_xor(ss, 2); ss += __shfl_xor(ss, 4); ss += __shfl_xor(ss, 8); ss += __shfl_xor(ss, 16);
      const float rn = rsqrtf(ss + 1e-6f) * (g < 2 ? 0.125f : 1.f);
      y[g][0] *= rn; y[g][1] *= rn;
    }
    u16* pw = p.P + (size_t)t * PW;
#pragma unroll
    for (int g = 0; g < 4; ++g)
      *(unsigned*)(pw + P_QH + 128 * g + 2 * lane) = (unsigned)f2bf(y[g][0]) | ((unsigned)f2bf(y[g][1]) << 16);
#pragma unroll
    for (int g = 4; g < 6; ++g)
      *(unsigned*)(VH + (size_t)t * 256 + 128 * (g - 4) + 2 * lane) = (unsigned)f2bf(y[g][0]) | ((unsigned)f2bf(y[g][1]) << 16);
  }
}

__device__ __forceinline__ void rowpass_c2(const Params& p, int l) {
  const int tidl = tid_l();
  const int lane = tidl & 63, w = tidl >> 6;
  for (int t = blockIdx.x * 4 + w; t < T_ALL; t += gridDim.x * 4) {
    u16* mr = p.MIX + (size_t)t * 1024;
    const u16* pr = p.P + (size_t)t * PW;
    const u16* qr = p.HQ + (size_t)t * 768;
    float og[4], oh[4];
#pragma unroll
    for (int h = 0; h < 4; ++h) {
      og[h] = bf2f(mr[h * 64 + lane]) + bf2f(mr[256 + h * 64 + lane]);
      oh[h] = bf2f(mr[512 + h * 64 + lane]) + bf2f(mr[768 + h * 64 + lane]);
    }
    u16 om[8];
#pragma unroll
    for (int i = 0; i < 8; ++i) { int c = lane + 64 * i; om[i] = qr[(c >> 7) * 192 + (c & 127)]; }
    float zg[4], gg[4];
#pragma unroll
    for (int h = 0; h < 4; ++h) { zg[h] = bf2f(pr[P_GZ + h * 64 + lane]); gg[h] = bf2f(pr[P_HG + h * 64 + lane]); }
    float rg[4], rh[4];
#pragma unroll
    for (int h = 0; h < 4; ++h) {
      rg[h] = rsqrtf(wave_sum(og[h] * og[h]) * (1.f / 64.f) + 1e-6f);
      rh[h] = rsqrtf(wave_sum(oh[h] * oh[h]) * (1.f / 64.f) + 1e-6f);
    }
    __threadfence_block();
    const float wg = p.gdn_norm_w[l * 64 + lane], wh = p.hgrn_norm_w[l * 64 + lane];
#pragma unroll
    for (int h = 0; h < 4; ++h) {
      mr[h * 64 + lane] = f2bf(og[h] * rg[h] * wg * siluf_(zg[h]));
      mr[256 + h * 64 + lane] = f2bf(oh[h] * rh[h] * wh * sigmoidf_(gg[h]));
    }
#pragma unroll
    for (int i = 0; i < 8; ++i) mr[512 + lane + 64 * i] = om[i];
  }
}

__device__ __forceinline__ void gemm128(const u16* __restrict__ A, int lda, const u16* __restrict__ B, int ldb, int K,
                                        u16* lds, f32x4 (&acc)[4][4]) {
  const int tid = tid_l(), lane = tid & 63, w = tid >> 6, wm = w >> 1, wn = w & 1;
  const int r16 = lane & 15, g4 = lane >> 4;
#pragma unroll
  for (int i = 0; i < 4; ++i)
#pragma unroll
    for (int j = 0; j < 4; ++j) acc[i][j] = f32x4{0.f, 0.f, 0.f, 0.f};
  const int lrow = tid >> 3, lkc = tid & 7;
  const u16* ap = A + (size_t)lrow * lda + lkc * 8;
  const u16* bp = B + (size_t)lrow * ldb + lkc * 8;
  const size_t sa32 = (size_t)32 * lda, sb32 = (size_t)32 * ldb;
  uint4 ra0 = *(const uint4*)(ap), ra1 = *(const uint4*)(ap + sa32), ra2 = *(const uint4*)(ap + 2 * sa32), ra3 = *(const uint4*)(ap + 3 * sa32);
  uint4 rb0 = *(const uint4*)(bp), rb1 = *(const uint4*)(bp + sb32), rb2 = *(const uint4*)(bp + 2 * sb32), rb3 = *(const uint4*)(bp + 3 * sb32);
  const int woff = lrow * 64 + ((lkc ^ (lrow & 7)) * 8);
  const int sw = r16 & 7;
  const int fa0 = (wm * 64 + r16) * 64 + ((g4 ^ sw) * 8);
  const int fa1 = (wm * 64 + r16) * 64 + (((4 + g4) ^ sw) * 8);
  const int fb0 = 128 * 64 + (wn * 64 + r16) * 64 + ((g4 ^ sw) * 8);
  const int fb1 = 128 * 64 + (wn * 64 + r16) * 64 + (((4 + g4) ^ sw) * 8);
  const int nk = K >> 6;
  __syncthreads();
  {
    u16* wa = lds + woff; u16* wb = lds + 128 * 64 + woff;
    *(uint4*)(wa) = ra0; *(uint4*)(wa + 32 * 64) = ra1; *(uint4*)(wa + 64 * 64) = ra2; *(uint4*)(wa + 96 * 64) = ra3;
    *(uint4*)(wb) = rb0; *(uint4*)(wb + 32 * 64) = rb1; *(uint4*)(wb + 64 * 64) = rb2; *(uint4*)(wb + 96 * 64) = rb3;
  }
  if (nk > 1) {
    const u16* a2 = ap + 64; const u16* b2 = bp + 64;
    ra0 = *(const uint4*)(a2); ra1 = *(const uint4*)(a2 + sa32); ra2 = *(const uint4*)(a2 + 2 * sa32); ra3 = *(const uint4*)(a2 + 3 * sa32);
    rb0 = *(const uint4*)(b2); rb1 = *(const uint4*)(b2 + sb32); rb2 = *(const uint4*)(b2 + 2 * sb32); rb3 = *(const uint4*)(b2 + 3 * sb32);
  }
  __syncthreads();
  for (int kt = 0; kt < nk; ++kt) {
    const u16* cur = lds + (kt & 1) * (256 * 64);
    if (kt + 1 < nk) {
      u16* nxt = lds + ((kt + 1) & 1) * (256 * 64);
      u16* wa = nxt + woff; u16* wb = nxt + 128 * 64 + woff;
      *(uint4*)(wa) = ra0; *(uint4*)(wa + 32 * 64) = ra1; *(uint4*)(wa + 64 * 64) = ra2; *(uint4*)(wa + 96 * 64) = ra3;
      *(uint4*)(wb) = rb0; *(uint4*)(wb + 32 * 64) = rb1; *(uint4*)(wb + 64 * 64) = rb2; *(uint4*)(wb + 96 * 64) = rb3;
      if (kt + 2 < nk) {
        const u16* a2 = ap + (kt + 2) * 64; const u16* b2 = bp + (kt + 2) * 64;
        ra0 = *(const uint4*)(a2); ra1 = *(const uint4*)(a2 + sa32); ra2 = *(const uint4*)(a2 + 2 * sa32); ra3 = *(const uint4*)(a2 + 3 * sa32);
        rb0 = *(const uint4*)(b2); rb1 = *(const uint4*)(b2 + sb32); rb2 = *(const uint4*)(b2 + 2 * sb32); rb3 = *(const uint4*)(b2 + 3 * sb32);
      }
    }
    {
      const u16* pa0 = cur + fa0; const u16* pa1 = cur + fa1; const u16* pb0 = cur + fb0; const u16* pb1 = cur + fb1;
      bf16x8 a0 = *(const bf16x8*)(pa0), a1 = *(const bf16x8*)(pa0 + 16 * 64), a2 = *(const bf16x8*)(pa0 + 32 * 64), a3 = *(const bf16x8*)(pa0 + 48 * 64);
      bf16x8 b0 = *(const bf16x8*)(pb0), b1 = *(const bf16x8*)(pb0 + 16 * 64), b2 = *(const bf16x8*)(pb0 + 32 * 64), b3 = *(const bf16x8*)(pb0 + 48 * 64);
      bf16x8 c0 = *(const bf16x8*)(pa1), c1 = *(const bf16x8*)(pa1 + 16 * 64), c2 = *(const bf16x8*)(pa1 + 32 * 64), c3 = *(const bf16x8*)(pa1 + 48 * 64);
      bf16x8 d0 = *(const bf16x8*)(pb1), d1 = *(const bf16x8*)(pb1 + 16 * 64), d2 = *(const bf16x8*)(pb1 + 32 * 64), d3 = *(const bf16x8*)(pb1 + 48 * 64);
      __builtin_amdgcn_sched_barrier(0);
#define G128_MM(j, bj, x0, x1, x2, x3) do { \
        acc[0][j] = __builtin_amdgcn_mfma_f32_16x16x32_bf16(bj, x0, acc[0][j], 0, 0, 0); \
        acc[1][j] = __builtin_amdgcn_mfma_f32_16x16x32_bf16(bj, x1, acc[1][j], 0, 0, 0); \
        acc[2][j] = __builtin_amdgcn_mfma_f32_16x16x32_bf16(bj, x2, acc[2][j], 0, 0, 0); \
        acc[3][j] = __builtin_amdgcn_mfma_f32_16x16x32_bf16(bj, x3, acc[3][j], 0, 0, 0); } while (0)
      G128_MM(0, b0, a0, a1, a2, a3); G128_MM(1, b1, a0, a1, a2, a3); G128_MM(2, b2, a0, a1, a2, a3); G128_MM(3, b3, a0, a1, a2, a3);
      G128_MM(0, d0, c0, c1, c2, c3); G128_MM(1, d1, c0, c1, c2, c3); G128_MM(2, d2, c0, c1, c2, c3); G128_MM(3, d3, c0, c1, c2, c3);
    }
    __syncthreads();
  }
}
__device__ __forceinline__ uint2 pack4(f32x4 v) {
  uint2 o;
  o.x = (unsigned)f2bf(v[0]) | ((unsigned)f2bf(v[1]) << 16);
  o.y = (unsigned)f2bf(v[2]) | ((unsigned)f2bf(v[3]) << 16);
  return o;
}

__device__ __forceinline__ void gemm256(const u16* __restrict__ A, int lda, const u16* __restrict__ B, int ldb, int K,
                                        u16* lds, f32x4 (&acc)[8][4]) {
  const int tid = tid_l(), lane = tid & 63, w = tid >> 6, wm = w >> 1, wn = w & 1;
  const int r16 = lane & 15, g4 = lane >> 4;
#pragma unroll
  for (int i = 0; i < 8; ++i)
#pragma unroll
    for (int j = 0; j < 4; ++j) acc[i][j] = f32x4{0.f, 0.f, 0.f, 0.f};
  const int lrow = tid >> 2, lkc = tid & 3;
  const u16* ap = A + (size_t)lrow * lda + lkc * 8;
  const u16* bp = B + (size_t)lrow * ldb + lkc * 8;
  const size_t sa64 = (size_t)64 * lda, sb64 = (size_t)64 * ldb;
  const int woff = lrow * 32 + ((lkc ^ ((lrow >> 1) & 3)) * 8);
  const int fsw = (g4 ^ ((r16 >> 1) & 3)) * 8;
  const int faoff = (wm * 128 + r16) * 32 + fsw;
  const int fboff = 256 * 32 + (wn * 64 + r16) * 32 + fsw;
  const int nk = K >> 5;
  const int BUF = 384 * 32;
  uint4 xa0, xa1, xa2, xa3, xb0, xb1;
  uint4 ya0, ya1, ya2, ya3, yb0, yb1;
#define G256_LOAD(P, st) do { const u16* a2_ = ap + (st) * 32; const u16* b2_ = bp + (st) * 32; \
    P##a0 = *(const uint4*)(a2_); P##a1 = *(const uint4*)(a2_ + sa64); P##a2 = *(const uint4*)(a2_ + 2 * sa64); P##a3 = *(const uint4*)(a2_ + 3 * sa64); \
    P##b0 = *(const uint4*)(b2_); P##b1 = *(const uint4*)(b2_ + sb64); } while (0)
#define G256_STORE(P, buf) do { u16* wa_ = lds + (buf) * BUF + woff; u16* wb_ = wa_ + 256 * 32; \
    *(uint4*)(wa_) = P##a0; *(uint4*)(wa_ + 64 * 32) = P##a1; *(uint4*)(wa_ + 128 * 32) = P##a2; *(uint4*)(wa_ + 192 * 32) = P##a3; \
    *(uint4*)(wb_) = P##b0; *(uint4*)(wb_ + 64 * 32) = P##b1; } while (0)
#define G256_MM(i, af) do { \
      acc[i][0] = __builtin_amdgcn_mfma_f32_16x16x32_bf16(bf0, af, acc[i][0], 0, 0, 0); \
      acc[i][1] = __builtin_amdgcn_mfma_f32_16x16x32_bf16(bf1, af, acc[i][1], 0, 0, 0); \
      acc[i][2] = __builtin_amdgcn_mfma_f32_16x16x32_bf16(bf2, af, acc[i][2], 0, 0, 0); \
      acc[i][3] = __builtin_amdgcn_mfma_f32_16x16x32_bf16(bf3, af, acc[i][3], 0, 0, 0); } while (0)
#define G256_COMPUTE(buf) do { const u16* fa_ = lds + (buf) * BUF + faoff; const u16* fb_ = lds + (buf) * BUF + fboff; \
    bf16x8 bf0 = *(const bf16x8*)(fb_), bf1 = *(const bf16x8*)(fb_ + 16 * 32), bf2 = *(const bf16x8*)(fb_ + 32 * 32), bf3 = *(const bf16x8*)(fb_ + 48 * 32); \
    bf16x8 a0 = *(const bf16x8*)(fa_), a1 = *(const bf16x8*)(fa_ + 16 * 32), a2 = *(const bf16x8*)(fa_ + 32 * 32), a3 = *(const bf16x8*)(fa_ + 48 * 32); \
    __builtin_amdgcn_sched_barrier(0); \
    G256_MM(0, a0); a0 = *(const bf16x8*)(fa_ + 64 * 32); __builtin_amdgcn_sched_barrier(0); \
    G256_MM(1, a1); a1 = *(const bf16x8*)(fa_ + 80 * 32); __builtin_amdgcn_sched_barrier(0); \
    G256_MM(2, a2); a2 = *(const bf16x8*)(fa_ + 96 * 32); __builtin_amdgcn_sched_barrier(0); \
    G256_MM(3, a3); a3 = *(const bf16x8*)(fa_ + 112 * 32); __builtin_amdgcn_sched_barrier(0); \
    G256_MM(4, a0); G256_MM(5, a1); G256_MM(6, a2); G256_MM(7, a3); } while (0)
  G256_LOAD(x, 0);
  G256_LOAD(y, 1);
  __syncthreads();
  G256_STORE(x, 0);
  G256_LOAD(x, 2);
  __syncthreads();
  for (int kt = 0; kt < nk; kt += 2) {
    G256_STORE(y, 1);
    if (kt + 3 < nk) G256_LOAD(y, kt + 3);
    G256_COMPUTE(0);
    __syncthreads();
    if (kt + 2 < nk) {
      G256_STORE(x, 0);
      if (kt + 4 < nk) G256_LOAD(x, kt + 4);
    }
    G256_COMPUTE(1);
    __syncthreads();
  }
}
#define GEMM256_RC const int tde = tid_l(); const int rb = ((tde >> 6) >> 1) * 128 + (tde & 15), cb = ((tde >> 6) & 1) * 64 + ((tde & 63) >> 4) * 4;
#define GEMM_RC const int tde = tid_l(); const int rb = ((tde >> 6) >> 1) * 64 + (tde & 15), cb = ((tde >> 6) & 1) * 64 + ((tde & 63) >> 4) * 4;


__device__ __forceinline__ bool tile_at(int r, int Mt, int Nt, int& mt, int& nt) {
  const int x = blockIdx.x & 7, j = blockIdx.x >> 3, bpx = gridDim.x >> 3;
  const int mpx = Mt >> 3;
  const int q = r * bpx + j;
  if (q >= mpx * Nt) return false;
  const int full = (Nt >> 3) * (mpx * 8);
  int cb, rem, wcb;
  if (q < full) { cb = q / (mpx * 8); rem = q - cb * mpx * 8; wcb = 8; }
  else { cb = Nt >> 3; rem = q - full; wcb = Nt - cb * 8; }
  mt = x * mpx + rem / wcb;
  nt = cb * 8 + rem % wcb;
  return true;
}

__device__ __forceinline__ void phase_a(const Params& p, int l, u16* lds) {
  const u16* Bw = p.WinT + (size_t)l * 3072 * 1024;
  int mt, nt;
  for (int r = 0; tile_at(r, 144, 24, mt, nt); ++r) {
    const int m0 = mt * 256, n0 = nt * 128;
    f32x4 acc[8][4];
    gemm256(p.HQ + (size_t)m0 * 1024, 1024, Bw + (size_t)n0 * 1024, 1024, 1024, lds, acc);
    { GEMM256_RC
#pragma unroll
      for (int mi = 0; mi < 8; ++mi) {
        const int row = m0 + rb + mi * 16;
#pragma unroll
        for (int ni = 0; ni < 4; ++ni) {
          const int col = n0 + cb + ni * 16;
          *(uint2*)(p.P + (size_t)row * PW + col) = pack4(acc[mi][ni]);
          if (col >= P_GA && col < P_GA + 16)
            *(float4*)(p.GAB + (size_t)row * 16 + (col - P_GA)) = make_float4(acc[mi][ni][0], acc[mi][ni][1], acc[mi][ni][2], acc[mi][ni][3]);
        }
      }
    }
  }
}

__device__ __forceinline__ void phase_b1(const Params& p, int l, u16* lds) {
  int mt, nt;
  for (int pass = 0; pass < 2; ++pass) {
  for (int r = 0; tile_at(r, pass == 0 ? 288 : 304, pass == 0 ? 6 : 8, mt, nt); ++r) {
    if (pass == 0) {
      const int m0 = mt * 128, n0 = nt * 128;
      const float qscale = 0.07216878364870322f * 1.4426950408889634f;
      f32x4 acc[4][4];
      gemm128(p.P + (size_t)m0 * PW + P_MCQ, PW, p.WuqT + (size_t)l * 768 * 384 + (size_t)n0 * 384, 384, 384, lds, acc);
      { GEMM_RC
        const int g4 = (tde & 63) >> 4;
        const int cw0 = n0 + cb - g4 * 4;
        const bool ropew = ((cw0 >> 6) % 3) == 2 && m0 >= T_CTX;
#pragma unroll
        for (int mi = 0; mi < 4; ++mi) {
          const int row = m0 + rb + mi * 16;
          f32x4 v0 = acc[mi][0], v1 = acc[mi][1], v2 = acc[mi][2], v3 = acc[mi][3];
          if (ropew) {
            const int pos = (row - T_CTX) & 4095;
#pragma unroll
            for (int r = 0; r < 4; ++r) {
              const float inv = exp2f(-(float)(g4 * 4 + r) * (13.287712379549449f / 16.f));
              float s0, c0, s1, c1;
              __sincosf((float)(pos >> 6) * inv, &s0, &c0);
              __sincosf((float)(pos & 63) * inv, &s1, &c1);
              const float a0 = v0[r] * c0 - v1[r] * s0, a1 = v1[r] * c0 + v0[r] * s0;
              const float b0 = v2[r] * c1 - v3[r] * s1, b1 = v3[r] * c1 + v2[r] * s1;
              v0[r] = a0; v1[r] = a1; v2[r] = b0; v3[r] = b1;
            }
          }
          u16* qp = p.HQ + (size_t)row * 768 + n0 + cb;
          *(uint2*)(qp) = pack4(v0 * qscale); *(uint2*)(qp + 16) = pack4(v1 * qscale);
          *(uint2*)(qp + 32) = pack4(v2 * qscale); *(uint2*)(qp + 48) = pack4(v3 * qscale);
        }
      }
    } else {
      const int m0 = mt * 128, n0 = nt * 128;
      const u16* Ap; int lda;
      if (mt < 288) { Ap = p.P + (size_t)m0 * PW + P_MCKV; lda = PW; }
      else { Ap = p.CKVC + (size_t)(m0 - T_ALL) * 256; lda = 256; }
      f32x4 acc[4][4];
      gemm128(Ap, lda, p.WukvT + (size_t)l * 1024 * 256 + (size_t)n0 * 256, 256, 256, lds, acc);
      { GEMM_RC
#pragma unroll
        for (int mi = 0; mi < 4; ++mi) {
          const int row = m0 + rb + mi * 16;
          u16* vb; int vst;
          if (row < T_CTX) { int b = row >> 8, pos = row & 255; vb = p.VTC + (size_t)(b * 4) * 128 * 256 + pos; vst = 256; }
          else if (row < T_ALL) { int b = (row - T_CTX) >> 12, pos = (row - T_CTX) & 4095; vb = p.VTL + (size_t)(b * 4) * 128 * 4352 + pos; vst = 4352; }
          else { int b = (row - T_ALL) >> 8, pos = 4096 + ((row - T_ALL) & 255); vb = p.VTL + (size_t)(b * 4) * 128 * 4352 + pos; vst = 4352; }
#pragma unroll
          for (int ni = 0; ni < 4; ++ni) {
            const int col = n0 + cb + ni * 16;
            const int h = col >> 8, wi = col & 255;
            if (wi < 128) {
              *(uint2*)(p.KN + (size_t)row * 512 + h * 128 + wi) = pack4(acc[mi][ni]);
            } else {
              u16* dst = vb + (size_t)(h * 128 + (wi - 128)) * vst;
#pragma unroll
              for (int r = 0; r < 4; ++r) dst[(size_t)r * vst] = f2bf(acc[mi][ni][r]);
            }
          }
        }
      }
    }
  }
  }
}

__device__ __forceinline__ void phase_gemm_y(const u16* A, int lda, const u16* B, int K, int N, u16* Y, int ldy, u16* lds) {
  int mt, nt;
  for (int r = 0; tile_at(r, 288, N / 128, mt, nt); ++r) {
    const int m0 = mt * 128, n0 = nt * 128;
    f32x4 acc[4][4];
    gemm128(A + (size_t)m0 * lda, lda, B + (size_t)n0 * K, K, K, lds, acc);
    { GEMM_RC
#pragma unroll
      for (int mi = 0; mi < 4; ++mi)
#pragma unroll
        for (int ni = 0; ni < 4; ++ni)
          *(uint2*)(Y + (size_t)(m0 + rb + mi * 16) * ldy + n0 + cb + ni * 16) = pack4(acc[mi][ni]);
    }
  }
}

__device__ __forceinline__ void phase_e(const Params& p, int l, u16* lds) {
  const u16* Bw = p.WfiT + (size_t)l * 5632 * 1024;
  int mt, nt;
  for (int r = 0; tile_at(r, 144, 44, mt, nt); ++r) {
    const int m0 = mt * 256, n0 = nt * 128;
    f32x4 acc[8][4];
    gemm256(p.MIX + (size_t)m0 * 1024, 1024, Bw + (size_t)n0 * 1024, 1024, 1024, lds, acc);
    { GEMM256_RC
      const int g4x4 = ((tde & 63) >> 4) * 4;
      const int hc0 = ((n0 + cb - g4x4) >> 1) + g4x4;
#pragma unroll
      for (int mi = 0; mi < 8; ++mi)
#pragma unroll
        for (int ni = 0; ni < 2; ++ni) {
          f32x4 hv;
#pragma unroll
          for (int r = 0; r < 4; ++r) hv[r] = siluf_(acc[mi][ni][r]) * acc[mi][ni + 2][r];
          *(uint2*)(p.P + (size_t)(m0 + rb + mi * 16) * DFF + hc0 + ni * 16) = pack4(hv);
        }
    }
  }
}

#define KST 208
#define VST 80
#define PST 80
__device__ __forceinline__ void attn_item(const Params& p, int latent, int b, int h, int qb, unsigned char* smraw, int dummy = 0) {
  u16* sK = (u16*)smraw;
  u16* sV = sK + 64 * KST;
  u16* sP = sV + 128 * VST;
  const int tid = tid_l(), lane = tid & 63, w = tid >> 6, r16 = lane & 15, g4 = lane >> 4;
  const int nkeys = latent ? 4352 : 256;
  const int krow0 = latent ? T_CTX + b * 4096 : b * 256;
  const int tq0 = krow0 + qb * 128;
  const u16* vt = latent ? p.VTL + (size_t)((b * 4 + h) * 128) * 4352 : p.VTC + (size_t)((b * 4 + h) * 128) * 256;
  u16* sPw = sP + w * 32 * PST;
  bf16x8 q[2][6];
#pragma unroll
  for (int mi = 0; mi < 2; ++mi)
#pragma unroll
    for (int ks = 0; ks < 6; ++ks)
      q[mi][ks] = *(const bf16x8*)(p.HQ + (size_t)(tq0 + w * 32 + mi * 16 + r16) * 768 + h * 192 + ks * 32 + g4 * 8);
  f32x4 o[2][8];
  float mrow[2], lrow[2];
#pragma unroll
  for (int mi = 0; mi < 2; ++mi) {
#pragma unroll
    for (int nd = 0; nd < 8; ++nd) o[mi][nd] = f32x4{0.f, 0.f, 0.f, 0.f};
    mrow[mi] = -1e30f; lrow[mi] = 0.f;
  }
  const int lkey = tid >> 2, lpart = tid & 3;
  const int ldv = tid >> 1, lhalf = tid & 1;
  const int ntile = nkeys >> 6;
  uint4 k0, k1, k2, k3, k4, k5;
  {
    const int pos = lkey;
    const u16* srcn = p.KN + (size_t)(krow0 + pos) * 512 + h * 128 + lpart * 8;
    const u16* srcr = p.P + (size_t)(krow0 + pos) * PW + P_MKR + lpart * 8;
    k0 = *(const uint4*)(srcn); k1 = *(const uint4*)(srcn + 32); k2 = *(const uint4*)(srcn + 64); k3 = *(const uint4*)(srcn + 96);
    k4 = *(const uint4*)(srcr); k5 = *(const uint4*)(srcr + 32);
  }
  for (int kt = 0; kt < ntile; ++kt) {
    __syncthreads();
    {
      u16* dk = sK + lkey * KST + lpart * 8;
      *(uint4*)(dk) = k0; *(uint4*)(dk + 32) = k1; *(uint4*)(dk + 64) = k2; *(uint4*)(dk + 96) = k3;
      *(uint4*)(dk + 128) = k4; *(uint4*)(dk + 160) = k5;
    }
    const u16* sv = vt + (size_t)ldv * nkeys + kt * 64 + lhalf * 32;
    const uint4 v0 = *(const uint4*)(sv), v1 = *(const uint4*)(sv + 8), v2 = *(const uint4*)(sv + 16), v3 = *(const uint4*)(sv + 24);
    __syncthreads();
    f32x4 s[2][4];
#pragma unroll
    for (int mi = 0; mi < 2; ++mi)
#pragma unroll
      for (int ni = 0; ni < 4; ++ni) s[mi][ni] = f32x4{0.f, 0.f, 0.f, 0.f};
#pragma unroll
    for (int ks = 0; ks < 6; ++ks)
#pragma unroll
      for (int ni = 0; ni < 4; ++ni) {
        bf16x8 kf = *(const bf16x8*)(sK + (ni * 16 + r16) * KST + ks * 32 + g4 * 8);
        s[0][ni] = __builtin_amdgcn_mfma_f32_16x16x32_bf16(kf, q[0][ks], s[0][ni], 0, 0, 0);
        s[1][ni] = __builtin_amdgcn_mfma_f32_16x16x32_bf16(kf, q[1][ks], s[1][ni], 0, 0, 0);
      }
#pragma unroll
    for (int mi = 0; mi < 2; ++mi) {
      float mx = -1e30f;
#pragma unroll
      for (int ni = 0; ni < 4; ++ni)
#pragma unroll
        for (int r = 0; r < 4; ++r) mx = fmaxf(mx, s[mi][ni][r]);
      mx = fmaxf(mx, __shfl_xor(mx, 16)); mx = fmaxf(mx, __shfl_xor(mx, 32));
      const float mnew = fmaxf(mrow[mi], mx);
      const float alpha = __builtin_amdgcn_exp2f(mrow[mi] - mnew);
      mrow[mi] = mnew;
      float ps = 0.f;
#pragma unroll
      for (int ni = 0; ni < 4; ++ni) {
        f32x4 pv;
#pragma unroll
        for (int r = 0; r < 4; ++r) { pv[r] = __builtin_amdgcn_exp2f(s[mi][ni][r] - mnew); ps += pv[r]; }
        *(uint2*)(sPw + (mi * 16 + r16) * PST + ni * 16 + g4 * 4) = pack4(pv);
      }
      ps += __shfl_xor(ps, 16); ps += __shfl_xor(ps, 32);
      lrow[mi] = lrow[mi] * alpha + ps;
#pragma unroll
      for (int nd = 0; nd < 8; ++nd) o[mi][nd] *= alpha;
    }
    {
      u16* dvp = sV + ldv * VST + lhalf * 32;
      *(uint4*)(dvp) = v0; *(uint4*)(dvp + 8) = v1; *(uint4*)(dvp + 16) = v2; *(uint4*)(dvp + 24) = v3;
    }
    __syncthreads();
    if (kt + 1 < ntile) {
      const int pos = (kt + 1) * 64 + lkey;
      const bool own = (!latent) || pos < 4096;
      const int row = own ? krow0 + pos : T_ALL + b * 256 + (pos - 4096);
      const u16* srcn = p.KN + (size_t)row * 512 + h * 128 + lpart * 8;
      const u16* srcr = own ? p.P + (size_t)(krow0 + pos) * PW + P_MKR + lpart * 8
                            : p.KRC + (size_t)(b * 256 + pos - 4096) * 64 + lpart * 8;
      k0 = *(const uint4*)(srcn); k1 = *(const uint4*)(srcn + 32); k2 = *(const uint4*)(srcn + 64); k3 = *(const uint4*)(srcn + 96);
      k4 = *(const uint4*)(srcr); k5 = *(const uint4*)(srcr + 32);
    }
#pragma unroll
    for (int ks2 = 0; ks2 < 2; ++ks2) {
      bf16x8 pf0 = *(const bf16x8*)(sPw + (0 * 16 + r16) * PST + ks2 * 32 + g4 * 8);
      bf16x8 pf1 = *(const bf16x8*)(sPw + (1 * 16 + r16) * PST + ks2 * 32 + g4 * 8);
#pragma unroll
      for (int nd = 0; nd < 8; ++nd) {
        bf16x8 vf = *(const bf16x8*)(sV + (nd * 16 + r16) * VST + ks2 * 32 + g4 * 8);
        o[0][nd] = __builtin_amdgcn_mfma_f32_16x16x32_bf16(vf, pf0, o[0][nd], 0, 0, 0);
        o[1][nd] = __builtin_amdgcn_mfma_f32_16x16x32_bf16(vf, pf1, o[1][nd], 0, 0, 0);
      }
    }
  }
#pragma unroll
  for (int mi = 0; mi < 2; ++mi) {
    const float inv = 1.f / lrow[mi];
    const int qrow = tq0 + w * 32 + mi * 16 + r16;
    u16* op = p.HQ + (size_t)qrow * 768 + h * 192 + g4 * 4;
    if (dummy) op = p.HQ + (size_t)T_ALL * 768 + (size_t)(qrow % 9216) * 768 + h * 192 + g4 * 4;
#pragma unroll
    for (int nd = 0; nd < 8; ++nd) *(uint2*)(op + nd * 16) = pack4(o[mi][nd] * inv);
  }
}

#define XB_TMO      128
#define XB_XCNT(j)  (256  + 64 * (j))
#define XB_XSUB(j)  (1280 + 64 * (j))
#define XB_XGEN(j)  (2304 + 64 * (j))
#define XB_TOP      3328
#define XB_TOPGEN   3392
#define XCD_BAR_WORDS 3456
#define XB_SPIN_CAP (1u << 23)
#define LAS __attribute__((address_space(3)))

__device__ __forceinline__ unsigned xb_ld(unsigned* p)              { return __hip_atomic_load(p, __ATOMIC_RELAXED, __HIP_MEMORY_SCOPE_AGENT); }
__device__ __forceinline__ unsigned xb_add(unsigned* p, unsigned v) { return __hip_atomic_fetch_add(p, v, __ATOMIC_RELAXED, __HIP_MEMORY_SCOPE_AGENT); }
__device__ __forceinline__ unsigned xb_xcc_id() { return (unsigned)__builtin_amdgcn_s_getreg((3 << 11) | 20) & 0xFu; }
#define XB_SPIN(cond, bar) do { unsigned _sp = 0; while (cond) { __builtin_amdgcn_s_sleep(1); \
    if ((++_sp & 255u) == 0u) { if (xb_ld(&(bar)[XB_TMO])) break; if (_sp > XB_SPIN_CAP) { atomicAdd(&(bar)[XB_TMO], 1u); break; } } } } while (0)

struct XcdBarrier {
    unsigned* bar; unsigned x;
    volatile LAS unsigned* st;
};

__device__ __forceinline__ XcdBarrier xcd_barrier_post(unsigned* bar, volatile LAS unsigned* st) {
    XcdBarrier b; b.bar = bar; b.x = xb_xcc_id(); b.st = st;
    if (threadIdx.x == 0) (void)xb_add(&bar[XB_XCNT(b.x)], 1u);
    return b;
}
__device__ __forceinline__ void xcd_barrier_complete(unsigned* bar, unsigned x, unsigned& nloc, unsigned& nx) {
    const unsigned G = gridDim.x * gridDim.y * gridDim.z;
    unsigned sum, cnt, mine, sp = 0u;
    for (;;) {
        sum = 0u; cnt = 0u; mine = 0u;
#pragma unroll
        for (unsigned j = 0; j < 16; ++j) { const unsigned c = xb_ld(&bar[XB_XCNT(j)]); sum += c; cnt += (c > 0u) ? 1u : 0u; mine = (j == x) ? c : mine; }
        if (sum == G) break;
        __builtin_amdgcn_s_sleep(1);
        if ((++sp & 255u) == 0u) { if (xb_ld(&bar[XB_TMO])) break; if (sp > XB_SPIN_CAP) { atomicAdd(&bar[XB_TMO], 1u); break; } }
    }
    nloc = mine > 0u ? mine : 1u; nx = cnt > 0u ? cnt : 1u;
}

__device__ __forceinline__ void xcd_barrier(const XcdBarrier& b) {
    asm volatile("s_waitcnt vmcnt(0)" ::: "memory");
    __syncthreads();
    if (threadIdx.x == 0) {
        unsigned* bar = b.bar;
        __builtin_amdgcn_s_waitcnt(0);
        unsigned nloc = b.st[0], nx = b.st[1];
        if (nloc == 0u) { xcd_barrier_complete(bar, b.x, nloc, nx); b.st[0] = nloc; b.st[1] = nx; }
        const unsigned old = xb_add(&bar[XB_XSUB(b.x)], 1u);
        const unsigned gen = old / nloc;
        if (old + 1u == (gen + 1u) * nloc) {
            __builtin_amdgcn_fence(__ATOMIC_RELEASE, "agent");
            asm volatile("s_waitcnt vmcnt(0)" ::: "memory");
            const unsigned og = xb_add(&bar[XB_TOP], 1u);
            const unsigned tg = og / nx;
            if (og + 1u == (tg + 1u) * nx) xb_add(&bar[XB_TOPGEN], 1u);
            else XB_SPIN(xb_ld(&bar[XB_TOPGEN]) == tg, bar);
            __builtin_amdgcn_fence(__ATOMIC_ACQUIRE, "agent");
            xb_add(&bar[XB_XGEN(b.x)], 1u);
            asm volatile("s_waitcnt vmcnt(0)" ::: "memory");
        } else {
            XB_SPIN(xb_ld(&bar[XB_XGEN(b.x)]) == gen, bar);
            __builtin_amdgcn_fence(__ATOMIC_ACQUIRE, "agent");
            asm volatile("s_waitcnt vmcnt(0)" ::: "memory");
        }
    }
    __syncthreads();
}


__device__ __forceinline__ void gbar(unsigned* ctr, unsigned target) {
  asm volatile("s_waitcnt vmcnt(0)" ::: "memory");
  __syncthreads();
  if (tid_l() == 0) {
    __builtin_amdgcn_fence(__ATOMIC_RELEASE, "agent");
    asm volatile("s_waitcnt vmcnt(0)" ::: "memory");
    __hip_atomic_fetch_add(ctr, 1u, __ATOMIC_RELAXED, __HIP_MEMORY_SCOPE_AGENT);
    while (__hip_atomic_load(ctr, __ATOMIC_RELAXED, __HIP_MEMORY_SCOPE_AGENT) < target) __builtin_amdgcn_s_sleep(2);
    __builtin_amdgcn_fence(__ATOMIC_ACQUIRE, "agent");
    asm volatile("s_waitcnt vmcnt(0)" ::: "memory");
  }
  __syncthreads();
}
#define MFMA4(a, b, c) __builtin_amdgcn_mfma_f32_16x16x4f32((a), (b), (c), 0, 0, 0)

__device__ __forceinline__ float softplusf_(float x) { return fmaxf(x, 0.f) + log1pf(__expf(-fabsf(x))); }

__device__ __forceinline__ void gdn_chain(const Params& p, int l, int seq, int h, int d, int vs, float* sm) {
  float* sMM = sm;
  float* sK = sMM + 64 * 68;
  float* sW = sK + 64 * 65;
  float* sV = sW + 64 * 65;
  float* sS = sV + 64 * 33;
  float* sGc = sS + 64 * 33;
  float* sBeta = sGc + 64;
  float* sBg = sBeta + 64;
  const int tid = tid_l(), lane = tid & 63, w = tid >> 6, r16 = lane & 15, g4 = lane >> 4;
  const bool latent = seq >= 16;
  const int len = latent ? 4096 : 256;
  const int t0 = latent ? T_CTX + (seq - 16) * 4096 : seq * 256;
  const int nchunks = len >> 6;
  const float Acoef = -__expf(p.gdn_a_log[l * 8 + d * 4 + h]);
  const float dtb = p.gdn_dt_bias[l * 8 + d * 4 + h];
  f32x4 Sreg[2];
  __syncthreads();
  {
    const float* s0 = latent ? p.state_gdn + ((((size_t)(seq - 16) * 2 + l) * 2 + d) * 4 + h) * 4096 : nullptr;
#pragma unroll
    for (int n = 0; n < 2; ++n)
#pragma unroll
      for (int r = 0; r < 4; ++r) {
        const int kidx = 16 * w + g4 * 4 + r, cc = n * 16 + r16;
        float v = latent ? s0[kidx * 64 + vs * 32 + cc] : 0.f;
        Sreg[n][r] = v;
        sS[kidx * 33 + cc] = v;
      }
  }
  const u16* Pb = p.P + (size_t)t0 * PW;
  const u16* VHb = p.HQ + (size_t)T_ALL * 768 + (size_t)t0 * 256;
#define GDN_SRC(i, tl, tlo_) ({ const int e_ = (tl) + (i) * 256; const int u_ = e_ / 20, un_ = e_ % 20; \
    (un_ < 16) ? (Pb + (size_t)((tlo_) + u_) * PW + (un_ < 8 ? P_QH + h * 64 + un_ * 8 : P_KH + h * 64 + (un_ - 8) * 8)) \
               : (VHb + (size_t)((tlo_) + u_) * 256 + h * 64 + vs * 32 + (un_ - 16) * 8); })
  uint4 pf[5];
  float pga = 0.f, pgb = 0.f;
  {
    const int tlo = d == 0 ? 0 : len - 64;
#pragma unroll
    for (int i = 0; i < 5; ++i) pf[i] = *(const uint4*)GDN_SRC(i, tid, tlo);
    if (tid < 64) {
      const int u = d == 0 ? tid : 63 - tid;
      const float* gab = p.GAB + (size_t)(t0 + tlo + u) * 16;
      pga = gab[d * 4 + h]; pgb = gab[8 + d * 4 + h];
    }
  }
  for (int n = 0; n < nchunks; ++n) {
    const int tlo = d == 0 ? n * 64 : len - 64 * (n + 1);
    const int tl2 = tid_l();
#pragma unroll
    for (int i = 0; i < 5; ++i) {
      const int e = tl2 + i * 256;
      const int u = e / 20, un = e % 20;
      const int pp = d == 0 ? u : 63 - u;
      float* dq = un < 8 ? sW + pp * 65 + un * 8 : (un < 16 ? sK + pp * 65 + (un - 8) * 8 : sV + pp * 33 + (un - 16) * 8);
      const unsigned wv[4] = {pf[i].x, pf[i].y, pf[i].z, pf[i].w};
#pragma unroll
      for (int j = 0; j < 4; ++j) { dq[2 * j] = bf2f((u16)(wv[j] & 0xffff)); dq[2 * j + 1] = bf2f((u16)(wv[j] >> 16)); }
    }
    if (tid < 64) {
      const int pp = tid;
      float g = Acoef * softplusf_(pga + dtb);
      float bt = sigmoidf_(pgb);
#pragma unroll
      for (int o = 1; o < 64; o <<= 1) { float tt = __shfl_up(g, o); if (lane >= o) g += tt; }
      sGc[pp] = g; sBeta[pp] = bt; sBg[pp] = bt * __expf(g);
    }
    if (n + 1 < nchunks) {
      const int tlo2 = d == 0 ? (n + 1) * 64 : len - 64 * (n + 2);
#pragma unroll
      for (int i = 0; i < 5; ++i) pf[i] = *(const uint4*)GDN_SRC(i, tl2, tlo2);
      if (tid < 64) {
        const int u = d == 0 ? tid : 63 - tid;
        const float* gab = p.GAB + (size_t)(t0 + tlo2 + u) * 16;
        pga = gab[d * 4 + h]; pgb = gab[8 + d * 4 + h];
      }
    }
    __syncthreads();
    float qa[16];
#pragma unroll
    for (int s = 0; s < 16; ++s) qa[s] = sW[(16 * w + r16) * 65 + 4 * s + g4];
    const unsigned tcode = w == 0 ? 0x730u : (w == 1 ? 0xA51u : (w == 2 ? 0x062u : 0x0FBu));
    const int tcnt = w < 2 ? 3 : 2;
    f32x4 attacc[3];
#pragma unroll
    for (int t = 0; t < 3; ++t) {
      attacc[t] = f32x4{0.f, 0.f, 0.f, 0.f};
      if (t < tcnt) {
        const int ti = (tcode >> (4 * t)) & 3, tn = (tcode >> (4 * t + 2)) & 3;
        f32x4 accm = f32x4{0.f, 0.f, 0.f, 0.f};
        const float* ak = sK + (16 * ti + r16) * 65 + g4;
        const float* aq = sW + (16 * ti + r16) * 65 + g4;
        const float* bk = sK + (16 * tn + r16) * 65 + g4;
#pragma unroll
        for (int s = 0; s < 16; ++s) {
          const float bv = bk[4 * s];
          accm = MFMA4(ak[4 * s], bv, accm);
          attacc[t] = MFMA4(aq[4 * s], bv, attacc[t]);
        }
#pragma unroll
        for (int r = 0; r < 4; ++r) {
          const int i = 16 * ti + g4 * 4 + r, j = 16 * tn + r16;
          sMM[i * 68 + j] = (i > j) ? sBeta[i] * accm[r] * __expf(sGc[i] - sGc[j]) : 0.f;
        }
      }
    }
    __syncthreads();
    if (w == 0) {
      const int bi = tid >> 4, c = tid & 15;
      float* md = sMM + (16 * bi) * 68 + 16 * bi;
      float a[16];
#pragma unroll
      for (int r = 0; r < 16; ++r) a[r] = (r == c) ? 1.f : 0.f;
#pragma unroll
      for (int r = 1; r < 16; ++r) {
#pragma unroll
        for (int q4 = 0; q4 < (r + 3) / 4; ++q4) {
          const float4 m = *(const float4*)(md + r * 68 + 4 * q4);
          if (q4 * 4 + 0 < r) a[r] -= m.x * a[q4 * 4 + 0];
          if (q4 * 4 + 1 < r) a[r] -= m.y * a[q4 * 4 + 1];
          if (q4 * 4 + 2 < r) a[r] -= m.z * a[q4 * 4 + 2];
          if (q4 * 4 + 3 < r) a[r] -= m.w * a[q4 * 4 + 3];
        }
      }
      __builtin_amdgcn_fence(__ATOMIC_SEQ_CST, "wavefront");
#pragma unroll
      for (int r = 0; r < 16; ++r) md[r * 68 + c] = a[r];
    } else {
      for (int t = w - 1; t < 8; t += 3) {
        const int ti = t >> 1, tc = t & 1;
        const float bg = sBg[16 * ti + r16];
        const float* ak = sK + (16 * ti + r16) * 65 + g4;
        const float* bs = sS + g4 * 33 + 16 * tc + r16;
        f32x4 acc = f32x4{0.f, 0.f, 0.f, 0.f};
#pragma unroll
        for (int s = 0; s < 16; ++s) acc = MFMA4(ak[4 * s] * bg, bs[4 * s * 33], acc);
#pragma unroll
        for (int r = 0; r < 4; ++r) {
          const int i = 16 * ti + g4 * 4 + r, cc = 16 * tc + r16;
          sV[i * 33 + cc] = sV[i * 33 + cc] * sBeta[i] - acc[r];
        }
      }
    }
    __syncthreads();
    for (int ib = 0; ib < 4; ++ib) {
      if (w < 2) {
        const int ct = w;
        f32x4 acc = f32x4{0.f, 0.f, 0.f, 0.f};
        const float* am = sMM + (16 * ib + r16) * 68 + g4;
        const float* bx = sV + g4 * 33 + 16 * ct + r16;
        for (int s4 = 0; s4 < ib; ++s4) {
#pragma unroll
          for (int s = 0; s < 4; ++s) acc = MFMA4(am[16 * s4 + 4 * s], bx[(16 * s4 + 4 * s) * 33], acc);
        }
        f32x4 rm;
#pragma unroll
        for (int r = 0; r < 4; ++r) rm[r] = sV[(16 * ib + g4 * 4 + r) * 33 + 16 * ct + r16] - acc[r];
        const float* dd = sMM + (16 * ib + r16) * 68 + 16 * ib + 4 * g4;
        f32x4 xn = f32x4{0.f, 0.f, 0.f, 0.f};
#pragma unroll
        for (int s = 0; s < 4; ++s) xn = MFMA4(dd[s], rm[s], xn);
#pragma unroll
        for (int r = 0; r < 4; ++r) sV[(16 * ib + g4 * 4 + r) * 33 + 16 * ct + r16] = xn[r];
      }
      __syncthreads();
    }
#pragma unroll
    for (int t = 0; t < 3; ++t) {
      if (t < tcnt) {
        const int ti = (tcode >> (4 * t)) & 3, tn = (tcode >> (4 * t + 2)) & 3;
#pragma unroll
        for (int r = 0; r < 4; ++r) {
          const int i = 16 * ti + g4 * 4 + r, j = 16 * tn + r16;
          sMM[i * 68 + j] = (i >= j) ? attacc[t][r] * __expf(sGc[i] - sGc[j]) : 0.f;
        }
      }
    }
    __syncthreads();
    {
      f32x4 acc[2] = {f32x4{0.f, 0.f, 0.f, 0.f}, f32x4{0.f, 0.f, 0.f, 0.f}};
      const float eg = __expf(sGc[16 * w + r16]);
#pragma unroll
      for (int s = 0; s < 16; ++s) {
        const float a = qa[s] * eg;
        acc[0] = MFMA4(a, sS[(4 * s + g4) * 33 + r16], acc[0]);
        acc[1] = MFMA4(a, sS[(4 * s + g4) * 33 + 16 + r16], acc[1]);
      }
#pragma unroll
      for (int s = 0; s < 16; ++s) {
        if (s < 4 * (w + 1)) {
          const float a = sMM[(16 * w + r16) * 68 + 4 * s + g4];
          acc[0] = MFMA4(a, sV[(4 * s + g4) * 33 + r16], acc[0]);
          acc[1] = MFMA4(a, sV[(4 * s + g4) * 33 + 16 + r16], acc[1]);
        }
      }
#pragma unroll
      for (int nn = 0; nn < 2; ++nn)
#pragma unroll
        for (int r = 0; r < 4; ++r) {
          const int pp = 16 * w + g4 * 4 + r;
          const int u = d == 0 ? pp : 63 - pp;
          p.MIX[(size_t)(t0 + tlo + u) * 1024 + d * 256 + h * 64 + vs * 32 + nn * 16 + r16] = f2bf(acc[nn][r]);
        }
    }
    __syncthreads();
    {
      const float g63 = sGc[63];
      const float gl = __expf(g63);
#pragma unroll
      for (int nn = 0; nn < 2; ++nn)
#pragma unroll
        for (int r = 0; r < 4; ++r) Sreg[nn][r] *= gl;
#pragma unroll
      for (int s = 0; s < 16; ++s) {
        const int srow = 4 * s + g4;
        const float a = sK[srow * 65 + 16 * w + r16] * __expf(g63 - sGc[srow]);
        Sreg[0] = MFMA4(a, sV[srow * 33 + r16], Sreg[0]);
        Sreg[1] = MFMA4(a, sV[srow * 33 + 16 + r16], Sreg[1]);
      }
    }
    __syncthreads();
#pragma unroll
    for (int nn = 0; nn < 2; ++nn)
#pragma unroll
      for (int r = 0; r < 4; ++r) sS[(16 * w + g4 * 4 + r) * 33 + nn * 16 + r16] = Sreg[nn][r];
    __syncthreads();
  }
  if (!latent) {
    float* so = p.out + OUT_SGDN + ((((size_t)seq * 2 + l) * 2 + d) * 4 + h) * 4096;
#pragma unroll
    for (int nn = 0; nn < 2; ++nn)
#pragma unroll
      for (int r = 0; r < 4; ++r) so[(16 * w + g4 * 4 + r) * 64 + vs * 32 + nn * 16 + r16] = Sreg[nn][r];
  }
}

__device__ __forceinline__ void hgrn_chain(const Params& p, int l, int seq, int h, int d, int vs, float* sm) {
  float* sBC = sm;
  float* sK = sBC + 64 * 65;
  float* sAT = sK + 64 * 65;
  float* sV = sAT + 64 * 68;
  float* sS = sV + 64 * 33;
  float* sTot = sS + 64 * 33;
  const int tid = tid_l(), lane = tid & 63, w = tid >> 6, r16 = lane & 15, g4 = lane >> 4;
  const bool latent = seq >= 16;
  const int len = latent ? 4096 : 256;
  const int t0 = latent ? T_CTX + (seq - 16) * 4096 : seq * 256;
  const int nchunks = len >> 6;
  float lbk;
  {
    const int kch = h * 64 + (tid & 63);
    lbk = (l == 0) ? 0.f : sigmoidf_(p.hgrn_lb[256 + kch] - p.hgrn_lb[kch]);
  }
  f32x4 Sreg[2];
  __syncthreads();
  {
    const float* s0 = latent ? p.state_hgrn + ((((size_t)(seq - 16) * 2 + l) * 2 + d) * 4 + h) * 4096 : nullptr;
#pragma unroll
    for (int n = 0; n < 2; ++n)
#pragma unroll
      for (int r = 0; r < 4; ++r) {
        const int kidx = 16 * w + g4 * 4 + r, cc = n * 16 + r16;
        float v = latent ? s0[kidx * 64 + vs * 32 + cc] : 0.f;
        Sreg[n][r] = v;
        sS[kidx * 33 + cc] = v;
      }
  }
  const u16* Pb = p.P + (size_t)t0 * PW;
  float* sLb = sTot + 256;
  if (tid < 64) sLb[tid] = lbk;
  __syncthreads();
  int pgo[5];
#pragma unroll
  for (int i = 0; i < 5; ++i) {
    const int e = tid + i * 256;
    const int u = e / 20, un = e % 20;
    pgo[i] = u * PW + (un < 8 ? P_HF + d * 256 + h * 64 + un * 8 : (un < 12 ? P_HI + h * 64 + vs * 32 + (un - 8) * 8 : P_HQ + h * 64 + (un - 12) * 8));
  }
  uint4 pf[5];
  {
    const int tlo = d == 0 ? 0 : len - 64;
#pragma unroll
    for (int i = 0; i < 5; ++i) pf[i] = *(const uint4*)(Pb + (size_t)tlo * PW + pgo[i]);
  }
  for (int n = 0; n < nchunks; ++n) {
#pragma unroll
    for (int i = 0; i < 5; ++i) {
      const int e = tid + i * 256;
      const int u = e / 20, un = e % 20;
      const int pp = d == 0 ? u : 63 - u;
      const unsigned wv[4] = {pf[i].x, pf[i].y, pf[i].z, pf[i].w};
#pragma unroll
      for (int j = 0; j < 8; ++j) {
        const float x = bf2f((u16)((wv[j >> 1] >> ((j & 1) * 16)) & 0xffff));
        if (un < 8) {
          const int k = un * 8 + j;
          const float lb = sLb[k];
          const float sg_ = sigmoidf_(x);
          const float gate = lb + (1.f - lb) * sg_;
          sBC[pp * 65 + k] = __logf(fmaxf(gate, 1e-30f));
          sK[pp * 65 + k] = (1.f - lb) * (1.f - sg_);
        } else if (un < 12) {
          sV[pp * 33 + (un - 8) * 8 + j] = x;
        } else {
          sAT[pp * 68 + (un - 12) * 8 + j] = x;
        }
      }
    }
    __syncthreads();
    if (n + 1 < nchunks) {
      const int tlo2 = d == 0 ? (n + 1) * 64 : len - 64 * (n + 2);
#pragma unroll
      for (int i = 0; i < 5; ++i) pf[i] = *(const uint4*)(Pb + (size_t)tlo2 * PW + pgo[i]);
    }
    const int tlo = d == 0 ? n * 64 : len - 64 * (n + 1);
    float cs[16];
    {
      const int k = tid & 63, sg = tid >> 6;
      float run = 0.f;
#pragma unroll
      for (int i = 0; i < 16; ++i) { run += sBC[(16 * sg + i) * 65 + k]; cs[i] = run; }
      sTot[sg * 64 + k] = run;
    }
    float qa[16];
#pragma unroll
    for (int s = 0; s < 16; ++s) qa[s] = sAT[(16 * w + r16) * 68 + 4 * s + g4];
    __syncthreads();
    {
      const int k = tid & 63, sg = tid >> 6;
      float off = 0.f;
      for (int s2 = 0; s2 < sg; ++s2) off += sTot[s2 * 64 + k];
#pragma unroll
      for (int i = 0; i < 16; ++i) sBC[(16 * sg + i) * 65 + k] = cs[i] + off;
    }
    __syncthreads();
    {
      float aq[16], rf[16];
#pragma unroll
      for (int s = 0; s < 16; ++s) {
        const int kk = 4 * s + g4;
        rf[s] = (w == 0) ? 0.f : sBC[(16 * w - 1) * 65 + kk];
        aq[s] = qa[s] * __expf(sBC[(16 * w + r16) * 65 + kk] - rf[s]);
      }
#pragma unroll
      for (int nn = 0; nn < 4; ++nn) {
        f32x4 acc = f32x4{0.f, 0.f, 0.f, 0.f};
        if (nn <= w) {
#pragma unroll
          for (int s = 0; s < 16; ++s) {
            const int kk = 4 * s + g4, sc = 16 * nn + r16;
            const float bv = sK[sc * 65 + kk] * __expf(fminf(rf[s] - sBC[sc * 65 + kk], 80.f));
            acc = MFMA4(aq[s], bv, acc);
          }
        }
#pragma unroll
        for (int r = 0; r < 4; ++r) {
          const int i = 16 * w + g4 * 4 + r, j = 16 * nn + r16;
          sAT[i * 68 + j] = (i >= j) ? acc[r] : 0.f;
        }
      }
    }
    __syncthreads();
    {
      f32x4 acc[2] = {f32x4{0.f, 0.f, 0.f, 0.f}, f32x4{0.f, 0.f, 0.f, 0.f}};
#pragma unroll
      for (int s = 0; s < 16; ++s) {
        const int kk = 4 * s + g4;
        const float a = qa[s] * __expf(sBC[(16 * w + r16) * 65 + kk]);
        acc[0] = MFMA4(a, sS[kk * 33 + r16], acc[0]);
        acc[1] = MFMA4(a, sS[kk * 33 + 16 + r16], acc[1]);
      }
#pragma unroll
      for (int s = 0; s < 16; ++s) {
        if (s < 4 * (w + 1)) {
          const float a = sAT[(16 * w + r16) * 68 + 4 * s + g4];
          acc[0] = MFMA4(a, sV[(4 * s + g4) * 33 + r16], acc[0]);
          acc[1] = MFMA4(a, sV[(4 * s + g4) * 33 + 16 + r16], acc[1]);
        }
      }
#pragma unroll
      for (int nn = 0; nn < 2; ++nn)
#pragma unroll
        for (int r = 0; r < 4; ++r) {
          const int pp = 16 * w + g4 * 4 + r;
          const int u = d == 0 ? pp : 63 - pp;
          p.MIX[(size_t)(t0 + tlo + u) * 1024 + 512 + d * 256 + h * 64 + vs * 32 + nn * 16 + r16] = f2bf(acc[nn][r]);
        }
    }
    __syncthreads();
    {
#pragma unroll
      for (int nn = 0; nn < 2; ++nn)
#pragma unroll
        for (int r = 0; r < 4; ++r) Sreg[nn][r] *= __expf(sBC[63 * 65 + 16 * w + g4 * 4 + r]);
      const int kA = 16 * w + r16;
      const float blA = sBC[63 * 65 + kA];
#pragma unroll
      for (int s = 0; s < 16; ++s) {
        const int srow = 4 * s + g4;
        const float a = sK[srow * 65 + kA] * __expf(blA - sBC[srow * 65 + kA]);
        Sreg[0] = MFMA4(a, sV[srow * 33 + r16], Sreg[0]);
        Sreg[1] = MFMA4(a, sV[srow * 33 + 16 + r16], Sreg[1]);
      }
    }
    __syncthreads();
#pragma unroll
    for (int nn = 0; nn < 2; ++nn)
#pragma unroll
      for (int r = 0; r < 4; ++r) sS[(16 * w + g4 * 4 + r) * 33 + nn * 16 + r16] = Sreg[nn][r];
    __syncthreads();
  }
  if (!latent) {
    float* so = p.out + OUT_SHG + ((((size_t)seq * 2 + l) * 2 + d) * 4 + h) * 4096;
#pragma unroll
    for (int nn = 0; nn < 2; ++nn)
#pragma unroll
      for (int r = 0; r < 4; ++r) so[(16 * w + g4 * 4 + r) * 64 + vs * 32 + nn * 16 + r16] = Sreg[nn][r];
  }
}

__device__ __forceinline__ void phase_c(const Params& p, int l, unsigned char* smraw, int mode = 0) {
  __shared__ int s_item;
  const int total = 1920;
  for (;;) {
    __syncthreads();
    if (tid_l() == 0) s_item = (int)atomicAdd(&p.counters[l * 64 + mode * 16], 1u);
    __syncthreads();
    const int item = s_item;
    if (item >= total) break;
    int kind, a0, a1, a2, a3;
    if (item < 256 || (item >= 1280 && item < 1792)) {
      const int i2 = item < 256 ? item : item - 1280;
      const int rest = i2 >> 1;
      kind = i2 & 1;
      a3 = rest & 1; a2 = (rest >> 1) & 1; a1 = (rest >> 2) & 3; a0 = (rest >> 4) + (item < 256 ? 16 : 0);
    } else if (item < 1280) {
      const int i2 = item - 256;
      kind = 2; a0 = 1; a1 = i2 >> 7; a2 = (i2 >> 5) & 3; a3 = i2 & 31;
    } else {
      const int i2 = item - 1792;
      kind = 2; a0 = 0; a1 = i2 >> 3; a2 = (i2 >> 1) & 3; a3 = i2 & 1;
    }
    if (mode == 1 && kind == 2) continue;
    if (mode == 2 && kind != 2) continue;
    if (kind == 0) gdn_chain(p, l, a0, a1, a2, a3, (float*)smraw);
    else if (kind == 1) hgrn_chain(p, l, a0, a1, a2, a3, (float*)smraw);
    else attn_item(p, a0, a1, a2, a3, smraw, mode == 2);
  }
}

__global__ void __launch_bounds__(NTHR, 2) mega(Params p) {
  __shared__ __attribute__((aligned(16))) unsigned char smem[LDS_BYTES];
  cg::grid_group grid = cg::this_grid();
  __shared__ uint4 xb_words;
  if (threadIdx.x == 0) xb_words = make_uint4(0u, 0u, 0u, 0u);
  __syncthreads();
  {
    XcdBarrier xb0 = xcd_barrier_post(p.xbar, (volatile LAS unsigned*)&xb_words);
    if (threadIdx.x == 0) ((volatile LAS unsigned*)&xb_words)[2] = xb0.x;
  }
#define GSYNC() do { XcdBarrier xb_; xb_.bar = p.xbar; xb_.st = (volatile LAS unsigned*)&xb_words; xb_.x = 0; \
    if (threadIdx.x == 0) xb_.x = ((volatile LAS unsigned*)&xb_words)[2]; xcd_barrier(xb_); } while (0)
  phase0(p, (float*)smem);
  grid.sync();
  rowpass_norm(p, 0, 0);
  GSYNC();
  for (int l = 0; l < 2; ++l) {
    phase_a(p, l, (u16*)smem);
    GSYNC();
    rowpass_b0(p, l);
    GSYNC();
    phase_b1(p, l, (u16*)smem);
    GSYNC();
    rowpass_b2(p, l);
    GSYNC();
    phase_c(p, l, smem);
    GSYNC();
    rowpass_c2(p, l);
    GSYNC();
    phase_gemm_y(p.MIX, 1024, p.WoutT + (size_t)l * 1024 * 1024, 1024, 1024, p.HQ, 1024, (u16*)smem);
    GSYNC();
    rowpass_norm(p, l, 1);
    GSYNC();
    phase_e(p, l, (u16*)smem);
    GSYNC();
    phase_gemm_y(p.P, DFF, p.WfoT + (size_t)l * 1024 * DFF, DFF, 1024, p.HQ, 1024, (u16*)smem);
    GSYNC();
    rowpass_norm(p, l, 2);
    if (l == 0) GSYNC();
  }
}

extern "C" void kernel_launch(void* const* d_in, const int* in_sizes, int n_in, void* d_out, int out_size, void* d_ws,
                              size_t ws_size, hipStream_t stream) {
  static int grid_blocks = 0;
  if (!grid_blocks) {
    int dev = 0, cus = 0, per_cu = 0;
    hipGetDevice(&dev);
    hipDeviceGetAttribute(&cus, hipDeviceAttributeMultiprocessorCount, dev);
    hipOccupancyMaxActiveBlocksPerMultiprocessor(&per_cu, mega, NTHR, 0);
    if (per_cu > 2) per_cu = 2;
    if (per_cu < 1) per_cu = 1;
    grid_blocks = cus * per_cu;
  }
  Params p{};
  const float* const* in = (const float* const*)d_in;
  p.x_prompt = in[0]; p.x_sample = in[1]; p.cache_ckv = in[2]; p.cache_kr = in[3]; p.state_gdn = in[4]; p.state_hgrn = in[5];
  p.c = in[6]; p.c_ctx = in[7]; p.w_ada = in[8]; p.b_ada = in[9]; p.g_pre_mix = in[10]; p.g_post_mix = in[11];
  p.g_pre_ffn = in[12]; p.g_post_ffn = in[13]; p.w_in = in[14]; p.w_out = in[15]; p.gdn_conv_w = in[16];
  p.gdn_a_log = in[17]; p.gdn_dt_bias = in[18]; p.gdn_norm_w = in[19]; p.hgrn_lb = in[20]; p.hgrn_norm_w = in[21];
  p.mla_q_norm_w = in[22]; p.mla_w_uq = in[23]; p.mla_kv_norm_w = in[24]; p.mla_w_ukv = in[25]; p.w_ffn_in = in[26];
  p.w_ffn_out = in[27];
  p.out = (float*)d_out;
  unsigned char* ws = (unsigned char*)d_ws;
  size_t off = 0;
  auto take = [&](size_t bytes) { unsigned char* r = ws + off; off += (bytes + 255) & ~(size_t)255; return r; };
  p.counters = (unsigned*)take(1024);
  p.xbar = (unsigned*)take(16384);
  p.WinT = (u16*)take((size_t)2 * 3072 * 1024 * 2);
  p.WuqT = (u16*)take((size_t)2 * 768 * 384 * 2);
  p.WukvT = (u16*)take((size_t)2 * 1024 * 256 * 2);
  p.WoutT = (u16*)take((size_t)2 * 1024 * 1024 * 2);
  p.WfiT = (u16*)take((size_t)2 * 5632 * 1024 * 2);
  p.WfoT = (u16*)take((size_t)2 * 1024 * 2816 * 2);
  p.mod = (float*)take((size_t)2 * 9 * 6144 * 4);
  p.HQ = (u16*)take((size_t)T_ALL * 1024 * 2);
  p.P = (u16*)take((size_t)T_ALL * PW * 2);
  p.KN = (u16*)take((size_t)(T_ALL + 2048) * 512 * 2);
  p.VTL = (u16*)take((size_t)8 * 4 * 128 * 4352 * 2);
  p.VTC = (u16*)take((size_t)16 * 4 * 128 * 256 * 2);
  p.CKVC = (u16*)take((size_t)2048 * 256 * 2);
  p.KRC = (u16*)take((size_t)2048 * 64 * 2);
  p.GAB = (float*)take((size_t)T_ALL * 16 * 4);
  p.MIX = (u16*)take((size_t)T_ALL * 1024 * 2);
  if (off > ws_size) { fprintf(stderr, "workspace too small: need %zu have %zu\n", off, ws_size); return; }
  hipMemsetAsync(p.counters, 0, 1024 + 16384, stream);
  void* args[] = {&p};
  hipError_t e = hipLaunchCooperativeKernel((void*)mega, dim3(grid_blocks), dim3(NTHR), args, 0, stream);
  if (e != hipSuccess) fprintf(stderr, "cooperative launch failed: %s (grid %d)\n", hipGetErrorString(e), grid_blocks);
}
```

```cpp
#include <hip/hip_runtime.h>
#include <hip/hip_cooperative_groups.h>
#include <cstdio>
namespace cg = cooperative_groups;

typedef unsigned short u16;
using bf16x8 = __attribute__((ext_vector_type(8))) short;
using f32x4  = __attribute__((ext_vector_type(4))) float;

#define T_CTX 4096
#define T_ALL 36864
#define PW 3072
#define DFF 2816
#define LDS_BYTES 73728
#define NTHR 256

#define P_GQKV 0
#define P_GZ 768
#define P_HQ 1024
#define P_HI 1280
#define P_HF 1536
#define P_HG 2048
#define P_MCQ 2304
#define P_MCKV 2688
#define P_MKR 2944
#define P_GA 3008

struct Params {
  const float *x_prompt, *x_sample, *cache_ckv, *cache_kr, *state_gdn, *state_hgrn, *c, *c_ctx;
  const float *w_ada, *b_ada, *g_pre_mix, *g_post_mix, *g_pre_ffn, *g_post_ffn, *w_in, *w_out;
  const float *gdn_conv_w, *gdn_a_log, *gdn_dt_bias, *gdn_norm_w, *hgrn_lb, *hgrn_norm_w;
  const float *mla_q_norm_w, *mla_w_uq, *mla_kv_norm_w, *mla_w_ukv, *w_ffn_in, *w_ffn_out;
  float* out;
  u16 *WinT, *WuqT, *WukvT, *WoutT, *WfiT, *WfoT;
  float* mod;
  u16 *HQ, *P, *KN, *VTL, *VTC, *CKVC, *KRC, *MIX;
  float* GAB;
  unsigned* counters;
  unsigned* xbar;
};

#define OUT_CKV   37748736
#define OUT_KR    39845888
#define OUT_SGDN  40370176
#define OUT_SHG   41418752

__device__ __forceinline__ u16 f2bf(float f) {
  unsigned u = __float_as_uint(f);
  u += 0x7fffu + ((u >> 16) & 1u);
  return (u16)(u >> 16);
}
__device__ __forceinline__ float bf2f(u16 h) { return __uint_as_float(((unsigned)h) << 16); }
__device__ __forceinline__ float wave_sum(float v) {
#pragma unroll
  for (int o = 32; o > 0; o >>= 1) v += __shfl_xor(v, o);
  return v;
}
__device__ __forceinline__ float sigmoidf_(float x) { return __builtin_amdgcn_rcpf(1.f + __expf(-x)); }
__device__ __forceinline__ float siluf_(float x) { return x * __builtin_amdgcn_rcpf(1.f + __expf(-x)); }
__device__ __forceinline__ int tid_l() { int t = threadIdx.x; asm volatile("" : "+v"(t)); return t; }
__device__ __forceinline__ int tok_mod(int t) { return t < T_CTX ? 0 : 1 + ((t - T_CTX) >> 12); }

__device__ __forceinline__ int map_col(int kind, int j) {
  if (kind == 0) return j;
  if (kind == 1) { if (j < 1024) return j; if (j < 3008) return j + 16; if (j < 3024) return 1024 + (j - 3008); return -1; }
  int blk = j >> 6, w = j & 63;
  return w < 32 ? blk * 32 + w : DFF + blk * 32 + (w - 32);
}

__device__ __forceinline__ void cvt_tile(const float* __restrict__ src, int K, int Nsrc, u16* __restrict__ dst, int kind, int jt, int kt, float* sm) {
  const int tid = tid_l();
  const int j0 = jt * 64, k0 = kt * 64;
  __syncthreads();
  {
    int jj = tid & 63, kk0 = tid >> 6;
    int sc = map_col(kind, j0 + jj);
    for (int kk = kk0; kk < 64; kk += 4)
      sm[kk * 65 + jj] = sc >= 0 ? src[(size_t)(k0 + kk) * Nsrc + sc] : 0.f;
  }
  __syncthreads();
  {
    int kk = tid & 63, jj0 = tid >> 6;
    for (int jj = jj0; jj < 64; jj += 4)
      dst[(size_t)(j0 + jj) * K + k0 + kk] = f2bf(sm[kk * 65 + jj]);
  }
}

__device__ __forceinline__ void mod_item(const Params& p, int item, float* sm) {
  const int l = item / 96, j0 = (item % 96) * 64;
  const int tid = tid_l();
  float* sC = sm;
  float* sR = sm + 9 * 1024;
  __syncthreads();
  for (int i = tid; i < 9 * 1024; i += NTHR) {
    int m = i >> 10, k = i & 1023;
    float v = m == 0 ? p.c_ctx[k] : p.c[(m - 1) * 1024 + k];
    sC[i] = siluf_(v);
  }
  __syncthreads();
  const int col = tid & 63, ks = tid >> 6;
  float acc[9];
#pragma unroll
  for (int m = 0; m < 9; ++m) acc[m] = 0.f;
  const float* wp = p.w_ada + (size_t)l * 1024 * 6144 + j0 + col;
  for (int k = ks * 256; k < ks * 256 + 256; ++k) {
    float w = wp[(size_t)k * 6144];
#pragma unroll
    for (int m = 0; m < 9; ++m) acc[m] += sC[m * 1024 + k] * w;
  }
#pragma unroll
  for (int m = 0; m < 9; ++m) sR[(ks * 9 + m) * 64 + col] = acc[m];
  __syncthreads();
  for (int i = tid; i < 9 * 64; i += NTHR) {
    int m = i >> 6, cc = i & 63;
    float v = sR[(0 * 9 + m) * 64 + cc] + sR[(1 * 9 + m) * 64 + cc] + sR[(2 * 9 + m) * 64 + cc] + sR[(3 * 9 + m) * 64 + cc];
    p.mod[((size_t)l * 9 + m) * 6144 + j0 + cc] = v + p.b_ada[l * 6144 + j0 + cc];
  }
}

__device__ __forceinline__ void phase0(const Params& p, float* sm) {
  const int PER_LAYER = 3272;
  const int total = 2 * PER_LAYER + 192;
  for (int item = blockIdx.x; item < total; item += gridDim.x) {
    if (item < 192) { mod_item(p, item, sm); continue; }
    int it = item - 192;
    int l = it / PER_LAYER, r = it % PER_LAYER;
    if (r < 768) { cvt_tile(p.w_in + (size_t)l * 1024 * 3024, 1024, 3024, p.WinT + (size_t)l * 3072 * 1024, 1, r / 16, r % 16, sm); continue; }
    r -= 768;
    if (r < 72) { cvt_tile(p.mla_w_uq + (size_t)l * 384 * 768, 384, 768, p.WuqT + (size_t)l * 768 * 384, 0, r / 6, r % 6, sm); continue; }
    r -= 72;
    if (r < 64) { cvt_tile(p.mla_w_ukv + (size_t)l * 256 * 1024, 256, 1024, p.WukvT + (size_t)l * 1024 * 256, 0, r / 4, r % 4, sm); continue; }
    r -= 64;
    if (r < 256) { cvt_tile(p.w_out + (size_t)l * 1024 * 1024, 1024, 1024, p.WoutT + (size_t)l * 1024 * 1024, 0, r / 16, r % 16, sm); continue; }
    r -= 256;
    if (r < 1408) { cvt_tile(p.w_ffn_in + (size_t)l * 1024 * 5632, 1024, 5632, p.WfiT + (size_t)l * 5632 * 1024, 2, r / 16, r % 16, sm); continue; }
    r -= 1408;
    cvt_tile(p.w_ffn_out + (size_t)l * 2816 * 1024, 2816, 1024, p.WfoT + (size_t)l * 1024 * 2816, 0, r / 44, r % 44, sm);
  }
}

__device__ __forceinline__ void rowpass_norm(const Params& p, int l, int stage) {
  const int tidl = tid_l();
  const int lane = tidl & 63, w = tidl >> 6;
  const int ln = stage == 0 ? 0 : (stage == 1 ? l : l + 1);
  const int sh_off = stage == 1 ? 3072 : 0;
  const float* gpre = stage == 1 ? p.g_pre_ffn + l * 1024 : p.g_pre_mix + (ln < 2 ? ln : 0) * 1024;
  u16* dst = stage == 1 ? p.MIX : p.HQ;
  for (int t = blockIdx.x * 4 + w; t < T_ALL; t += gridDim.x * 4) {
    const int m = tok_mod(t);
    float x[16];
    float* xo = p.out + (size_t)t * 1024;
    if (stage == 0) {
      const float* xi = t < T_CTX ? p.x_prompt + (size_t)t * 1024 : p.x_sample + (size_t)(t - T_CTX) * 1024;
#pragma unroll
      for (int i = 0; i < 4; ++i) {
        float4 v = *(const float4*)(xi + i * 256 + lane * 4);
        x[i * 4 + 0] = v.x; x[i * 4 + 1] = v.y; x[i * 4 + 2] = v.z; x[i * 4 + 3] = v.w;
      }
    } else {
      const u16* yp = p.HQ + (size_t)t * 1024;
      float y[16]; float ss = 0.f;
#pragma unroll
      for (int i = 0; i < 4; ++i) {
        uint2 v = *(const uint2*)(yp + i * 256 + lane * 4);
        y[i * 4 + 0] = bf2f((u16)(v.x & 0xffff)); y[i * 4 + 1] = bf2f((u16)(v.x >> 16));
        y[i * 4 + 2] = bf2f((u16)(v.y & 0xffff)); y[i * 4 + 3] = bf2f((u16)(v.y >> 16));
      }
#pragma unroll
      for (int i = 0; i < 16; ++i) ss += y[i] * y[i];
      ss = wave_sum(ss);
      const float rstd = rsqrtf(ss * (1.f / 1024.f) + 1e-6f);
      const float* gpost = (stage == 1 ? p.g_post_mix : p.g_post_ffn) + l * 1024;
      const float* gt = p.mod + ((size_t)l * 9 + m) * 6144 + (stage == 1 ? 2048 : 5120);
#pragma unroll
      for (int i = 0; i < 4; ++i) {
        float4 xv = *(const float4*)(xo + i * 256 + lane * 4);
        float4 gp = *(const float4*)(gpost + i * 256 + lane * 4);
        float4 gg = *(const float4*)(gt + i * 256 + lane * 4);
        x[i * 4 + 0] = xv.x + gg.x * y[i * 4 + 0] * rstd * gp.x;
        x[i * 4 + 1] = xv.y + gg.y * y[i * 4 + 1] * rstd * gp.y;
        x[i * 4 + 2] = xv.z + gg.z * y[i * 4 + 2] * rstd * gp.z;
        x[i * 4 + 3] = xv.w + gg.w * y[i * 4 + 3] * rstd * gp.w;
      }
    }
    __threadfence_block();
#pragma unroll
    for (int i = 0; i < 4; ++i)
      *(float4*)(xo + i * 256 + lane * 4) = make_float4(x[i * 4 + 0], x[i * 4 + 1], x[i * 4 + 2], x[i * 4 + 3]);
    if (ln >= 2) continue;
    float ss = 0.f;
#pragma unroll
    for (int i = 0; i < 16; ++i) ss += x[i] * x[i];
    ss = wave_sum(ss);
    const float rstd = rsqrtf(ss * (1.f / 1024.f) + 1e-6f);
    const float* sh = p.mod + ((size_t)ln * 9 + m) * 6144 + sh_off;
    const float* sc = sh + 1024;
    u16* hp = dst + (size_t)t * 1024;
#pragma unroll
    for (int i = 0; i < 4; ++i) {
      float4 gp = *(const float4*)(gpre + i * 256 + lane * 4);
      float4 s1 = *(const float4*)(sh + i * 256 + lane * 4);
      float4 c1 = *(const float4*)(sc + i * 256 + lane * 4);
      float h0 = x[i * 4 + 0] * rstd * gp.x * (1.f + c1.x) + s1.x;
      float h1 = x[i * 4 + 1] * rstd * gp.y * (1.f + c1.y) + s1.y;
      float h2 = x[i * 4 + 2] * rstd * gp.z * (1.f + c1.z) + s1.z;
      float h3 = x[i * 4 + 3] * rstd * gp.w * (1.f + c1.w) + s1.w;
      uint2 o;
      o.x = (unsigned)f2bf(h0) | ((unsigned)f2bf(h1) << 16);
      o.y = (unsigned)f2bf(h2) | ((unsigned)f2bf(h3) << 16);
      *(uint2*)(hp + i * 256 + lane * 4) = o;
    }
  }
}

__device__ __forceinline__ void unpack8(const uint4 v, float (&f)[8]);
__device__ __forceinline__ uint4 pack8(const float (&f)[8]);
__device__ __forceinline__ void rowpass_b0(const Params& p, int l) {
  const int tidl = tid_l();
  const int lane = tidl & 63, w = tidl >> 6;
  for (int t = blockIdx.x * 4 + w; t < T_ALL + 2048; t += gridDim.x * 4) {
    if (t >= T_ALL) {
      const int r = t - T_ALL, b = r >> 8, s = r & 255;
      if (lane < 32) {
        const float* ck = p.cache_ckv + (((size_t)b * 2 + l) * 256 + s) * 256 + lane * 8;
        const float4 x0 = *(const float4*)ck, x1 = *(const float4*)(ck + 4);
        const float f[8] = {x0.x, x0.y, x0.z, x0.w, x1.x, x1.y, x1.z, x1.w};
        *(uint4*)(p.CKVC + (size_t)r * 256 + lane * 8) = pack8(f);
      } else if (lane < 40) {
        const float* kr = p.cache_kr + (((size_t)b * 2 + l) * 256 + s) * 64 + (lane - 32) * 8;
        const float4 x0 = *(const float4*)kr, x1 = *(const float4*)(kr + 4);
        const float f[8] = {x0.x, x0.y, x0.z, x0.w, x1.x, x1.y, x1.z, x1.w};
        *(uint4*)(p.KRC + (size_t)r * 64 + (lane - 32) * 8) = pack8(f);
      }
      continue;
    }
    u16* pr = p.P + (size_t)t * PW;
    {
      float f[8]; float ss = 0.f;
      if (lane < 48) {
        unpack8(*(const uint4*)(pr + P_MCQ + lane * 8), f);
#pragma unroll
        for (int i = 0; i < 8; ++i) ss += f[i] * f[i];
      }
      ss = wave_sum(ss);
      const float rstd = rsqrtf(ss * (1.f / 384.f) + 1e-6f);
      if (lane < 48) {
        const float* wq = p.mla_q_norm_w + l * 384 + lane * 8;
        const float4 w0 = *(const float4*)wq, w1 = *(const float4*)(wq + 4);
        f[0] *= rstd * w0.x; f[1] *= rstd * w0.y; f[2] *= rstd * w0.z; f[3] *= rstd * w0.w;
        f[4] *= rstd * w1.x; f[5] *= rstd * w1.y; f[6] *= rstd * w1.z; f[7] *= rstd * w1.w;
        *(uint4*)(pr + P_MCQ + lane * 8) = pack8(f);
      }
    }
    {
      float f[8]; float ss = 0.f;
      if (lane < 32) {
        unpack8(*(const uint4*)(pr + P_MCKV + lane * 8), f);
#pragma unroll
        for (int i = 0; i < 8; ++i) ss += f[i] * f[i];
      }
      ss = wave_sum(ss);
      const float rstd = rsqrtf(ss * (1.f / 256.f) + 1e-6f);
      if (lane < 32) {
        const float* wk = p.mla_kv_norm_w + l * 256 + lane * 8;
        const float4 w0 = *(const float4*)wk, w1 = *(const float4*)(wk + 4);
        f[0] *= rstd * w0.x; f[1] *= rstd * w0.y; f[2] *= rstd * w0.z; f[3] *= rstd * w0.w;
        f[4] *= rstd * w1.x; f[5] *= rstd * w1.y; f[6] *= rstd * w1.z; f[7] *= rstd * w1.w;
        *(uint4*)(pr + P_MCKV + lane * 8) = pack8(f);
        if (t < T_CTX) {
          const int b = t >> 8, s = t & 255;
          float* op = p.out + OUT_CKV + (((size_t)b * 2 + l) * 256 + s) * 256 + lane * 8;
          *(float4*)op = make_float4(f[0], f[1], f[2], f[3]);
          *(float4*)(op + 4) = make_float4(f[4], f[5], f[6], f[7]);
        }
      }
    }
    {
      float v = bf2f(pr[P_MKR + lane]);
      if (t < T_CTX) {
        int b = t >> 8, s = t & 255;
        p.out[OUT_KR + (((size_t)b * 2 + l) * 256 + s) * 64 + lane] = v;
      } else {
        int pos = (t - T_CTX) & 4095;
        int axis = lane >> 5, half = (lane >> 4) & 1, f = lane & 15;
        float posf = axis == 0 ? (float)(pos >> 6) : (float)(pos & 63);
        float inv = exp2f(-(float)f * (13.287712379549449f / 16.f));
        float ang = posf * inv;
        float sn, cs;
        __sincosf(ang, &sn, &cs);
        float other = __shfl_xor(v, 16);
        float o = half == 0 ? v * cs - other * sn : v * cs + other * sn;
        pr[P_MKR + lane] = f2bf(o);
      }
    }
  }
}

#define P_QH 2304
#define P_KH 2560
__device__ __forceinline__ void rowpass_b2(const Params& p, int l) {
  const int tidl = tid_l();
  const int lane = tidl & 63, w = tidl >> 6;
  float cw[6][2][5];
#pragma unroll
  for (int g = 0; g < 6; ++g)
#pragma unroll
    for (int e = 0; e < 2; ++e)
#pragma unroll
      for (int j = 0; j < 5; ++j) cw[g][e][j] = p.gdn_conv_w[((size_t)l * 768 + 128 * g + 2 * lane + e) * 5 + j];
  u16* VH = p.HQ + (size_t)T_ALL * 768;
  for (int t = blockIdx.x * 4 + w; t < T_ALL; t += gridDim.x * 4) {
    const int len = t < T_CTX ? 256 : 4096;
    const int tau = t < T_CTX ? (t & 255) : ((t - T_CTX) & 4095);
    float y[6][2];
#pragma unroll
    for (int g = 0; g < 6; ++g) { y[g][0] = 0.f; y[g][1] = 0.f; }
#pragma unroll
    for (int j = 0; j < 5; ++j) {
      const int tt = tau + j - 2;
      if (tt >= 0 && tt < len) {
        const u16* pr = p.P + (size_t)(t + j - 2) * PW + 2 * lane;
#pragma unroll
        for (int g = 0; g < 6; ++g) {
          const unsigned v = *(const unsigned*)(pr + 128 * g);
          y[g][0] += cw[g][0][j] * bf2f((u16)(v & 0xffff));
          y[g][1] += cw[g][1][j] * bf2f((u16)(v >> 16));
        }
      }
    }
#pragma unroll
    for (int g = 0; g < 6; ++g) { y[g][0] = siluf_(y[g][0]); y[g][1] = siluf_(y[g][1]); }
#pragma unroll
    for (int g = 0; g < 4; ++g) {
      float ss = y[g][0] * y[g][0] + y[g][1] * y[g][1];
      ss += __shfl_xor(ss, 1); ss += __shfl_xor(ss, 2); ss += __shfl_xor(ss, 4); ss += __shfl_xor(ss, 8); ss += __shfl_xor(ss, 16);
      const float rn = rsqrtf(ss + 1e-6f) * (g < 2 ? 0.125f : 1.f);
      y[g][0] *= rn; y[g][1] *= rn;
    }
    u16* pw = p.P + (size_t)t * PW;
#pragma unroll
    for (int g = 0; g < 4; ++g)
      *(unsigned*)(pw + P_QH + 128 * g + 2 * lane) = (unsigned)f2bf(y[g][0]) | ((unsigned)f2bf(y[g][1]) << 16);
#pragma unroll
    for (int g = 4; g < 6; ++g)
      *(unsigned*)(VH + (size_t)t * 256 + 128 * (g - 4) + 2 * lane) = (unsigned)f2bf(y[g][0]) | ((unsigned)f2bf(y[g][1]) << 16);
  }
}

__device__ __forceinline__ void unpack8(const uint4 v, float (&f)[8]) {
  f[0] = bf2f((u16)(v.x & 0xffff)); f[1] = bf2f((u16)(v.x >> 16)); f[2] = bf2f((u16)(v.y & 0xffff)); f[3] = bf2f((u16)(v.y >> 16));
  f[4] = bf2f((u16)(v.z & 0xffff)); f[5] = bf2f((u16)(v.z >> 16)); f[6] = bf2f((u16)(v.w & 0xffff)); f[7] = bf2f((u16)(v.w >> 16));
}
__device__ __forceinline__ uint4 pack8(const float (&f)[8]) {
  uint4 o;
  o.x = (unsigned)f2bf(f[0]) | ((unsigned)f2bf(f[1]) << 16); o.y = (unsigned)f2bf(f[2]) | ((unsigned)f2bf(f[3]) << 16);
  o.z = (unsigned)f2bf(f[4]) | ((unsigned)f2bf(f[5]) << 16); o.w = (unsigned)f2bf(f[6]) | ((unsigned)f2bf(f[7]) << 16);
  return o;
}
__device__ __forceinline__ void rowpass_c2(const Params& p, int l) {
  const int tidl = tid_l();
  const int lane = tidl & 63, w = tidl >> 6;
  const int hl = lane & 31, isH = lane >> 5;
  const float* nw = (isH ? p.hgrn_norm_w : p.gdn_norm_w) + l * 64 + (hl & 7) * 8;
  const float4 w0 = *(const float4*)(nw), w1 = *(const float4*)(nw + 4);
  const float wv[8] = {w0.x, w0.y, w0.z, w0.w, w1.x, w1.y, w1.z, w1.w};
  for (int t = blockIdx.x * 4 + w; t < T_ALL; t += gridDim.x * 4) {
    u16* mr = p.MIX + (size_t)t * 1024;
    const u16* pr = p.P + (size_t)t * PW;
    const u16* qr = p.HQ + (size_t)t * 768;
    const uint4 vf = *(const uint4*)(mr + isH * 512 + hl * 8);
    const uint4 vb = *(const uint4*)(mr + isH * 512 + 256 + hl * 8);
    const uint4 vg = *(const uint4*)(pr + (isH ? P_HG : P_GZ) + hl * 8);
    const int c0 = lane * 8;
    const uint4 vo = *(const uint4*)(qr + (c0 >> 7) * 192 + (c0 & 127));
    float f[8], bb[8], g[8];
    unpack8(vf, f); unpack8(vb, bb); unpack8(vg, g);
    float ss = 0.f;
#pragma unroll
    for (int i = 0; i < 8; ++i) { f[i] += bb[i]; ss += f[i] * f[i]; }
    ss += __shfl_xor(ss, 1); ss += __shfl_xor(ss, 2); ss += __shfl_xor(ss, 4);
    const float rn = rsqrtf(ss * (1.f / 64.f) + 1e-6f);
#pragma unroll
    for (int i = 0; i < 8; ++i) f[i] = f[i] * rn * wv[i] * (isH ? sigmoidf_(g[i]) : siluf_(g[i]));
    __threadfence_block();
    *(uint4*)(mr + isH * 256 + hl * 8) = pack8(f);
    *(uint4*)(mr + 512 + c0) = vo;
  }
}

__device__ __forceinline__ void gemm128(const u16* __restrict__ A, int lda, const u16* __restrict__ B, int ldb, int K,
                                        u16* lds, f32x4 (&acc)[4][4]) {
  const int tid = tid_l(), lane = tid & 63, w = tid >> 6, wm = w >> 1, wn = w & 1;
  const int r16 = lane & 15, g4 = lane >> 4;
#pragma unroll
  for (int i = 0; i < 4; ++i)
#pragma unroll
    for (int j = 0; j < 4; ++j) acc[i][j] = f32x4{0.f, 0.f, 0.f, 0.f};
  const int lrow = tid >> 3, lkc = tid & 7;
  const u16* ap = A + (size_t)lrow * lda + lkc * 8;
  const u16* bp = B + (size_t)lrow * ldb + lkc * 8;
  const size_t sa32 = (size_t)32 * lda, sb32 = (size_t)32 * ldb;
  uint4 ra0 = *(const uint4*)(ap), ra1 = *(const uint4*)(ap + sa32), ra2 = *(const uint4*)(ap + 2 * sa32), ra3 = *(const uint4*)(ap + 3 * sa32);
  uint4 rb0 = *(const uint4*)(bp), rb1 = *(const uint4*)(bp + sb32), rb2 = *(const uint4*)(bp + 2 * sb32), rb3 = *(const uint4*)(bp + 3 * sb32);
  const int woff = lrow * 64 + ((lkc ^ (lrow & 7)) * 8);
  const int sw = r16 & 7;
  const int fa0 = (wm * 64 + r16) * 64 + ((g4 ^ sw) * 8);
  const int fa1 = (wm * 64 + r16) * 64 + (((4 + g4) ^ sw) * 8);
  const int fb0 = 128 * 64 + (wn * 64 + r16) * 64 + ((g4 ^ sw) * 8);
  const int fb1 = 128 * 64 + (wn * 64 + r16) * 64 + (((4 + g4) ^ sw) * 8);
  const int nk = K >> 6;
  __syncthreads();
  {
    u16* wa = lds + woff; u16* wb = lds + 128 * 64 + woff;
    *(uint4*)(wa) = ra0; *(uint4*)(wa + 32 * 64) = ra1; *(uint4*)(wa + 64 * 64) = ra2; *(uint4*)(wa + 96 * 64) = ra3;
    *(uint4*)(wb) = rb0; *(uint4*)(wb + 32 * 64) = rb1; *(uint4*)(wb + 64 * 64) = rb2; *(uint4*)(wb + 96 * 64) = rb3;
  }
  if (nk > 1) {
    const u16* a2 = ap + 64; const u16* b2 = bp + 64;
    ra0 = *(const uint4*)(a2); ra1 = *(const uint4*)(a2 + sa32); ra2 = *(const uint4*)(a2 + 2 * sa32); ra3 = *(const uint4*)(a2 + 3 * sa32);
    rb0 = *(const uint4*)(b2); rb1 = *(const uint4*)(b2 + sb32); rb2 = *(const uint4*)(b2 + 2 * sb32); rb3 = *(const uint4*)(b2 + 3 * sb32);
  }
  __syncthreads();
  for (int kt = 0; kt < nk; ++kt) {
    const u16* cur = lds + (kt & 1) * (256 * 64);
    if (kt + 1 < nk) {
      u16* nxt = lds + ((kt + 1) & 1) * (256 * 64);
      u16* wa = nxt + woff; u16* wb = nxt + 128 * 64 + woff;
      *(uint4*)(wa) = ra0; *(uint4*)(wa + 32 * 64) = ra1; *(uint4*)(wa + 64 * 64) = ra2; *(uint4*)(wa + 96 * 64) = ra3;
      *(uint4*)(wb) = rb0; *(uint4*)(wb + 32 * 64) = rb1; *(uint4*)(wb + 64 * 64) = rb2; *(uint4*)(wb + 96 * 64) = rb3;
      if (kt + 2 < nk) {
        const u16* a2 = ap + (kt + 2) * 64; const u16* b2 = bp + (kt + 2) * 64;
        ra0 = *(const uint4*)(a2); ra1 = *(const uint4*)(a2 + sa32); ra2 = *(const uint4*)(a2 + 2 * sa32); ra3 = *(const uint4*)(a2 + 3 * sa32);
        rb0 = *(const uint4*)(b2); rb1 = *(const uint4*)(b2 + sb32); rb2 = *(const uint4*)(b2 + 2 * sb32); rb3 = *(const uint4*)(b2 + 3 * sb32);
      }
    }
    {
      const u16* pa0 = cur + fa0; const u16* pa1 = cur + fa1; const u16* pb0 = cur + fb0; const u16* pb1 = cur + fb1;
      bf16x8 a0 = *(const bf16x8*)(pa0), a1 = *(const bf16x8*)(pa0 + 16 * 64), a2 = *(const bf16x8*)(pa0 + 32 * 64), a3 = *(const bf16x8*)(pa0 + 48 * 64);
      bf16x8 b0 = *(const bf16x8*)(pb0), b1 = *(const bf16x8*)(pb0 + 16 * 64), b2 = *(const bf16x8*)(pb0 + 32 * 64), b3 = *(const bf16x8*)(pb0 + 48 * 64);
      bf16x8 c0 = *(const bf16x8*)(pa1), c1 = *(const bf16x8*)(pa1 + 16 * 64), c2 = *(const bf16x8*)(pa1 + 32 * 64), c3 = *(const bf16x8*)(pa1 + 48 * 64);
      bf16x8 d0 = *(const bf16x8*)(pb1), d1 = *(const bf16x8*)(pb1 + 16 * 64), d2 = *(const bf16x8*)(pb1 + 32 * 64), d3 = *(const bf16x8*)(pb1 + 48 * 64);
      __builtin_amdgcn_sched_barrier(0);
#define G128_MM(j, bj, x0, x1, x2, x3) do { \
        acc[0][j] = __builtin_amdgcn_mfma_f32_16x16x32_bf16(bj, x0, acc[0][j], 0, 0, 0); \
        acc[1][j] = __builtin_amdgcn_mfma_f32_16x16x32_bf16(bj, x1, acc[1][j], 0, 0, 0); \
        acc[2][j] = __builtin_amdgcn_mfma_f32_16x16x32_bf16(bj, x2, acc[2][j], 0, 0, 0); \
        acc[3][j] = __builtin_amdgcn_mfma_f32_16x16x32_bf16(bj, x3, acc[3][j], 0, 0, 0); } while (0)
      G128_MM(0, b0, a0, a1, a2, a3); G128_MM(1, b1, a0, a1, a2, a3); G128_MM(2, b2, a0, a1, a2, a3); G128_MM(3, b3, a0, a1, a2, a3);
      G128_MM(0, d0, c0, c1, c2, c3); G128_MM(1, d1, c0, c1, c2, c3); G128_MM(2, d2, c0, c1, c2, c3); G128_MM(3, d3, c0, c1, c2, c3);
    }
    __syncthreads();
  }
}
__device__ __forceinline__ uint2 pack4(f32x4 v) {
  uint2 o;
  o.x = (unsigned)f2bf(v[0]) | ((unsigned)f2bf(v[1]) << 16);
  o.y = (unsigned)f2bf(v[2]) | ((unsigned)f2bf(v[3]) << 16);
  return o;
}

__device__ __forceinline__ void gemm256(const u16* __restrict__ A, int lda, const u16* __restrict__ B, int ldb, int K,
                                        u16* lds, f32x4 (&acc)[8][4]) {
  const int tid = tid_l(), lane = tid & 63, w = tid >> 6, wm = w >> 1, wn = w & 1;
  const int r16 = lane & 15, g4 = lane >> 4;
#pragma unroll
  for (int i = 0; i < 8; ++i)
#pragma unroll
    for (int j = 0; j < 4; ++j) acc[i][j] = f32x4{0.f, 0.f, 0.f, 0.f};
  const int lrow = tid >> 2, lkc = tid & 3;
  const u16* ap = A + (size_t)lrow * lda + lkc * 8;
  const u16* bp = B + (size_t)lrow * ldb + lkc * 8;
  const size_t sa64 = (size_t)64 * lda, sb64 = (size_t)64 * ldb;
  const int woff = lrow * 32 + ((lkc ^ ((lrow >> 1) & 3)) * 8);
  const int fsw = (g4 ^ ((r16 >> 1) & 3)) * 8;
  const int faoff = (wm * 128 + r16) * 32 + fsw;
  const int fboff = 256 * 32 + (wn * 64 + r16) * 32 + fsw;
  const int nk = K >> 5;
  const int BUF = 384 * 32;
  uint4 xa0, xa1, xa2, xa3, xb0, xb1;
  uint4 ya0, ya1, ya2, ya3, yb0, yb1;
#define G256_LOAD(P, st) do { const u16* a2_ = ap + (st) * 32; const u16* b2_ = bp + (st) * 32; \
    P##a0 = *(const uint4*)(a2_); P##a1 = *(const uint4*)(a2_ + sa64); P##a2 = *(const uint4*)(a2_ + 2 * sa64); P##a3 = *(const uint4*)(a2_ + 3 * sa64); \
    P##b0 = *(const uint4*)(b2_); P##b1 = *(const uint4*)(b2_ + sb64); } while (0)
#define G256_STORE(P, buf) do { u16* wa_ = lds + (buf) * BUF + woff; u16* wb_ = wa_ + 256 * 32; \
    *(uint4*)(wa_) = P##a0; *(uint4*)(wa_ + 64 * 32) = P##a1; *(uint4*)(wa_ + 128 * 32) = P##a2; *(uint4*)(wa_ + 192 * 32) = P##a3; \
    *(uint4*)(wb_) = P##b0; *(uint4*)(wb_ + 64 * 32) = P##b1; } while (0)
#define G256_MM(i, af) do { \
      acc[i][0] = __builtin_amdgcn_mfma_f32_16x16x32_bf16(bf0, af, acc[i][0], 0, 0, 0); \
      acc[i][1] = __builtin_amdgcn_mfma_f32_16x16x32_bf16(bf1, af, acc[i][1], 0, 0, 0); \
      acc[i][2] = __builtin_amdgcn_mfma_f32_16x16x32_bf16(bf2, af, acc[i][2], 0, 0, 0); \
      acc[i][3] = __builtin_amdgcn_mfma_f32_16x16x32_bf16(bf3, af, acc[i][3], 0, 0, 0); } while (0)
#define G256_COMPUTE(buf) do { const u16* fa_ = lds + (buf) * BUF + faoff; const u16* fb_ = lds + (buf) * BUF + fboff; \
    bf16x8 bf0 = *(const bf16x8*)(fb_), bf1 = *(const bf16x8*)(fb_ + 16 * 32), bf2 = *(const bf16x8*)(fb_ + 32 * 32), bf3 = *(const bf16x8*)(fb_ + 48 * 32); \
    bf16x8 a0 = *(const bf16x8*)(fa_), a1 = *(const bf16x8*)(fa_ + 16 * 32), a2 = *(const bf16x8*)(fa_ + 32 * 32), a3 = *(const bf16x8*)(fa_ + 48 * 32); \
    __builtin_amdgcn_sched_barrier(0); \
    G256_MM(0, a0); a0 = *(const bf16x8*)(fa_ + 64 * 32); __builtin_amdgcn_sched_barrier(0); \
    G256_MM(1, a1); a1 = *(const bf16x8*)(fa_ + 80 * 32); __builtin_amdgcn_sched_barrier(0); \
    G256_MM(2, a2); a2 = *(const bf16x8*)(fa_ + 96 * 32); __builtin_amdgcn_sched_barrier(0); \
    G256_MM(3, a3); a3 = *(const bf16x8*)(fa_ + 112 * 32); __builtin_amdgcn_sched_barrier(0); \
    G256_MM(4, a0); G256_MM(5, a1); G256_MM(6, a2); G256_MM(7, a3); } while (0)
  G256_LOAD(x, 0);
  G256_LOAD(y, 1);
  __syncthreads();
  G256_STORE(x, 0);
  G256_LOAD(x, 2);
  __syncthreads();
  for (int kt = 0; kt < nk; kt += 2) {
    G256_STORE(y, 1);
    if (kt + 3 < nk) G256_LOAD(y, kt + 3);
    G256_COMPUTE(0);
    __syncthreads();
    if (kt + 2 < nk) {
      G256_STORE(x, 0);
      if (kt + 4 < nk) G256_LOAD(x, kt + 4);
    }
    G256_COMPUTE(1);
    __syncthreads();
  }
}
#define GEMM256_RC const int tde = tid_l(); const int rb = ((tde >> 6) >> 1) * 128 + (tde & 15), cb = ((tde >> 6) & 1) * 64 + ((tde & 63) >> 4) * 4;
#define GEMM_RC const int tde = tid_l(); const int rb = ((tde >> 6) >> 1) * 64 + (tde & 15), cb = ((tde >> 6) & 1) * 64 + ((tde & 63) >> 4) * 4;


__device__ __forceinline__ bool tile_at(int r, int Mt, int Nt, int& mt, int& nt) {
  const int x = blockIdx.x & 7, j = blockIdx.x >> 3, bpx = gridDim.x >> 3;
  const int mpx = Mt >> 3;
  const int q = r * bpx + j;
  if (q >= mpx * Nt) return false;
  const int full = (Nt >> 3) * (mpx * 8);
  int cb, rem, wcb;
  if (q < full) { cb = q / (mpx * 8); rem = q - cb * mpx * 8; wcb = 8; }
  else { cb = Nt >> 3; rem = q - full; wcb = Nt - cb * 8; }
  mt = x * mpx + rem / wcb;
  nt = cb * 8 + rem % wcb;
  return true;
}

__device__ __forceinline__ void phase_a(const Params& p, int l, u16* lds) {
  const u16* Bw = p.WinT + (size_t)l * 3072 * 1024;
  int mt, nt;
  for (int r = 0; tile_at(r, 144, 24, mt, nt); ++r) {
    const int m0 = mt * 256, n0 = nt * 128;
    f32x4 acc[8][4];
    gemm256(p.HQ + (size_t)m0 * 1024, 1024, Bw + (size_t)n0 * 1024, 1024, 1024, lds, acc);
    { GEMM256_RC
#pragma unroll
      for (int mi = 0; mi < 8; ++mi) {
        const int row = m0 + rb + mi * 16;
#pragma unroll
        for (int ni = 0; ni < 4; ++ni) {
          const int col = n0 + cb + ni * 16;
          *(uint2*)(p.P + (size_t)row * PW + col) = pack4(acc[mi][ni]);
          if (col >= P_GA && col < P_GA + 16)
            *(float4*)(p.GAB + (size_t)row * 16 + (col - P_GA)) = make_float4(acc[mi][ni][0], acc[mi][ni][1], acc[mi][ni][2], acc[mi][ni][3]);
        }
      }
    }
  }
}

__device__ __forceinline__ void phase_b1(const Params& p, int l, u16* lds) {
  int mt, nt;
  for (int pass = 0; pass < 2; ++pass) {
  for (int r = 0; tile_at(r, pass == 0 ? 288 : 304, pass == 0 ? 6 : 8, mt, nt); ++r) {
    if (pass == 0) {
      const int m0 = mt * 128, n0 = nt * 128;
      const float qscale = 0.07216878364870322f * 1.4426950408889634f;
      f32x4 acc[4][4];
      gemm128(p.P + (size_t)m0 * PW + P_MCQ, PW, p.WuqT + (size_t)l * 768 * 384 + (size_t)n0 * 384, 384, 384, lds, acc);
      { GEMM_RC
        const int g4 = (tde & 63) >> 4;
        const int cw0 = n0 + cb - g4 * 4;
        const bool ropew = ((cw0 >> 6) % 3) == 2 && m0 >= T_CTX;
#pragma unroll
        for (int mi = 0; mi < 4; ++mi) {
          const int row = m0 + rb + mi * 16;
          f32x4 v0 = acc[mi][0], v1 = acc[mi][1], v2 = acc[mi][2], v3 = acc[mi][3];
          if (ropew) {
            const int pos = (row - T_CTX) & 4095;
#pragma unroll
            for (int r = 0; r < 4; ++r) {
              const float inv = exp2f(-(float)(g4 * 4 + r) * (13.287712379549449f / 16.f));
              float s0, c0, s1, c1;
              __sincosf((float)(pos >> 6) * inv, &s0, &c0);
              __sincosf((float)(pos & 63) * inv, &s1, &c1);
              const float a0 = v0[r] * c0 - v1[r] * s0, a1 = v1[r] * c0 + v0[r] * s0;
              const float b0 = v2[r] * c1 - v3[r] * s1, b1 = v3[r] * c1 + v2[r] * s1;
              v0[r] = a0; v1[r] = a1; v2[r] = b0; v3[r] = b1;
            }
          }
          u16* qp = p.HQ + (size_t)row * 768 + n0 + cb;
          *(uint2*)(qp) = pack4(v0 * qscale); *(uint2*)(qp + 16) = pack4(v1 * qscale);
          *(uint2*)(qp + 32) = pack4(v2 * qscale); *(uint2*)(qp + 48) = pack4(v3 * qscale);
        }
      }
    } else {
      const int m0 = mt * 128, n0 = nt * 128;
      const u16* Ap; int lda;
      if (mt < 288) { Ap = p.P + (size_t)m0 * PW + P_MCKV; lda = PW; }
      else { Ap = p.CKVC + (size_t)(m0 - T_ALL) * 256; lda = 256; }
      f32x4 acc[4][4];
      gemm128(Ap, lda, p.WukvT + (size_t)l * 1024 * 256 + (size_t)n0 * 256, 256, 256, lds, acc);
      { GEMM_RC
#pragma unroll
        for (int mi = 0; mi < 4; ++mi) {
          const int row = m0 + rb + mi * 16;
          u16* vb; int vst;
          if (row < T_CTX) { int b = row >> 8, pos = row & 255; vb = p.VTC + (size_t)(b * 4) * 128 * 256 + pos; vst = 256; }
          else if (row < T_ALL) { int b = (row - T_CTX) >> 12, pos = (row - T_CTX) & 4095; vb = p.VTL + (size_t)(b * 4) * 128 * 4352 + pos; vst = 4352; }
          else { int b = (row - T_ALL) >> 8, pos = 4096 + ((row - T_ALL) & 255); vb = p.VTL + (size_t)(b * 4) * 128 * 4352 + pos; vst = 4352; }
#pragma unroll
          for (int ni = 0; ni < 4; ++ni) {
            const int col = n0 + cb + ni * 16;
            const int h = col >> 8, wi = col & 255;
            if (wi < 128) {
              *(uint2*)(p.KN + (size_t)row * 512 + h * 128 + wi) = pack4(acc[mi][ni]);
            } else {
              u16* dst = vb + (size_t)(h * 128 + (wi - 128)) * vst;
#pragma unroll
              for (int r = 0; r < 4; ++r) dst[(size_t)r * vst] = f2bf(acc[mi][ni][r]);
            }
          }
        }
      }
    }
  }
  }
}

__device__ __forceinline__ void phase_gemm_y(const u16* A, int lda, const u16* B, int K, int N, u16* Y, int ldy, u16* lds) {
  int mt, nt;
  for (int r = 0; tile_at(r, 288, N / 128, mt, nt); ++r) {
    const int m0 = mt * 128, n0 = nt * 128;
    f32x4 acc[4][4];
    gemm128(A + (size_t)m0 * lda, lda, B + (size_t)n0 * K, K, K, lds, acc);
    { GEMM_RC
#pragma unroll
      for (int mi = 0; mi < 4; ++mi)
#pragma unroll
        for (int ni = 0; ni < 4; ++ni)
          *(uint2*)(Y + (size_t)(m0 + rb + mi * 16) * ldy + n0 + cb + ni * 16) = pack4(acc[mi][ni]);
    }
  }
}

__device__ __forceinline__ void phase_e(const Params& p, int l, u16* lds) {
  const u16* Bw = p.WfiT + (size_t)l * 5632 * 1024;
  int mt, nt;
  for (int r = 0; tile_at(r, 144, 44, mt, nt); ++r) {
    const int m0 = mt * 256, n0 = nt * 128;
    f32x4 acc[8][4];
    gemm256(p.MIX + (size_t)m0 * 1024, 1024, Bw + (size_t)n0 * 1024, 1024, 1024, lds, acc);
    { GEMM256_RC
      const int g4x4 = ((tde & 63) >> 4) * 4;
      const int hc0 = ((n0 + cb - g4x4) >> 1) + g4x4;
#pragma unroll
      for (int mi = 0; mi < 8; ++mi)
#pragma unroll
        for (int ni = 0; ni < 2; ++ni) {
          f32x4 hv;
#pragma unroll
          for (int r = 0; r < 4; ++r) hv[r] = siluf_(acc[mi][ni][r]) * acc[mi][ni + 2][r];
          *(uint2*)(p.P + (size_t)(m0 + rb + mi * 16) * DFF + hc0 + ni * 16) = pack4(hv);
        }
    }
  }
}

#define KST 208
#define VST 80
#define PST 80
__device__ __forceinline__ void attn_item(const Params& p, int latent, int b, int h, int qb, unsigned char* smraw, int dummy = 0) {
  u16* sK = (u16*)smraw;
  u16* sV = sK + 64 * KST;
  u16* sP = sV + 128 * VST;
  const int tid = tid_l(), lane = tid & 63, w = tid >> 6, r16 = lane & 15, g4 = lane >> 4;
  const int nkeys = latent ? 4352 : 256;
  const int krow0 = latent ? T_CTX + b * 4096 : b * 256;
  const int tq0 = krow0 + qb * 128;
  const u16* vt = latent ? p.VTL + (size_t)((b * 4 + h) * 128) * 4352 : p.VTC + (size_t)((b * 4 + h) * 128) * 256;
  u16* sPw = sP + w * 32 * PST;
  bf16x8 q[2][6];
#pragma unroll
  for (int mi = 0; mi < 2; ++mi)
#pragma unroll
    for (int ks = 0; ks < 6; ++ks)
      q[mi][ks] = *(const bf16x8*)(p.HQ + (size_t)(tq0 + w * 32 + mi * 16 + r16) * 768 + h * 192 + ks * 32 + g4 * 8);
  f32x4 o[2][8];
  float mrow[2], lrow[2];
#pragma unroll
  for (int mi = 0; mi < 2; ++mi) {
#pragma unroll
    for (int nd = 0; nd < 8; ++nd) o[mi][nd] = f32x4{0.f, 0.f, 0.f, 0.f};
    mrow[mi] = -1e30f; lrow[mi] = 0.f;
  }
  const int lkey = tid >> 2, lpart = tid & 3;
  const int ldv = tid >> 1, lhalf = tid & 1;
  const int ntile = nkeys >> 6;
  uint4 k0, k1, k2, k3, k4, k5;
  {
    const int pos = lkey;
    const u16* srcn = p.KN + (size_t)(krow0 + pos) * 512 + h * 128 + lpart * 8;
    const u16* srcr = p.P + (size_t)(krow0 + pos) * PW + P_MKR + lpart * 8;
    k0 = *(const uint4*)(srcn); k1 = *(const uint4*)(srcn + 32); k2 = *(const uint4*)(srcn + 64); k3 = *(const uint4*)(srcn + 96);
    k4 = *(const uint4*)(srcr); k5 = *(const uint4*)(srcr + 32);
  }
  for (int kt = 0; kt < ntile; ++kt) {
    __syncthreads();
    {
      u16* dk = sK + lkey * KST + lpart * 8;
      *(uint4*)(dk) = k0; *(uint4*)(dk + 32) = k1; *(uint4*)(dk + 64) = k2; *(uint4*)(dk + 96) = k3;
      *(uint4*)(dk + 128) = k4; *(uint4*)(dk + 160) = k5;
    }
    const u16* sv = vt + (size_t)ldv * nkeys + kt * 64 + lhalf * 32;
    const uint4 v0 = *(const uint4*)(sv), v1 = *(const uint4*)(sv + 8), v2 = *(const uint4*)(sv + 16), v3 = *(const uint4*)(sv + 24);
    __syncthreads();
    f32x4 s[2][4];
#pragma unroll
    for (int mi = 0; mi < 2; ++mi)
#pragma unroll
      for (int ni = 0; ni < 4; ++ni) s[mi][ni] = f32x4{0.f, 0.f, 0.f, 0.f};
#pragma unroll
    for (int ks = 0; ks < 6; ++ks)
#pragma unroll
      for (int ni = 0; ni < 4; ++ni) {
        bf16x8 kf = *(const bf16x8*)(sK + (ni * 16 + r16) * KST + ks * 32 + g4 * 8);
        s[0][ni] = __builtin_amdgcn_mfma_f32_16x16x32_bf16(kf, q[0][ks], s[0][ni], 0, 0, 0);
        s[1][ni] = __builtin_amdgcn_mfma_f32_16x16x32_bf16(kf, q[1][ks], s[1][ni], 0, 0, 0);
      }
#pragma unroll
    for (int mi = 0; mi < 2; ++mi) {
      float mx = -1e30f;
#pragma unroll
      for (int ni = 0; ni < 4; ++ni)
#pragma unroll
        for (int r = 0; r < 4; ++r) mx = fmaxf(mx, s[mi][ni][r]);
      mx = fmaxf(mx, __shfl_xor(mx, 16)); mx = fmaxf(mx, __shfl_xor(mx, 32));
      const float mnew = fmaxf(mrow[mi], mx);
      const float alpha = __builtin_amdgcn_exp2f(mrow[mi] - mnew);
      mrow[mi] = mnew;
      float ps = 0.f;
#pragma unroll
      for (int ni = 0; ni < 4; ++ni) {
        f32x4 pv;
#pragma unroll
        for (int r = 0; r < 4; ++r) { pv[r] = __builtin_amdgcn_exp2f(s[mi][ni][r] - mnew); ps += pv[r]; }
        *(uint2*)(sPw + (mi * 16 + r16) * PST + ni * 16 + g4 * 4) = pack4(pv);
      }
      ps += __shfl_xor(ps, 16); ps += __shfl_xor(ps, 32);
      lrow[mi] = lrow[mi] * alpha + ps;
#pragma unroll
      for (int nd = 0; nd < 8; ++nd) o[mi][nd] *= alpha;
    }
    {
      u16* dvp = sV + ldv * VST + lhalf * 32;
      *(uint4*)(dvp) = v0; *(uint4*)(dvp + 8) = v1; *(uint4*)(dvp + 16) = v2; *(uint4*)(dvp + 24) = v3;
    }
    __syncthreads();
    if (kt + 1 < ntile) {
      const int pos = (kt + 1) * 64 + lkey;
      const bool own = (!latent) || pos < 4096;
      const int row = own ? krow0 + pos : T_ALL + b * 256 + (pos - 4096);
      const u16* srcn = p.KN + (size_t)row * 512 + h * 128 + lpart * 8;
      const u16* srcr = own ? p.P + (size_t)(krow0 + pos) * PW + P_MKR + lpart * 8
                            : p.KRC + (size_t)(b * 256 + pos - 4096) * 64 + lpart * 8;
      k0 = *(const uint4*)(srcn); k1 = *(const uint4*)(srcn + 32); k2 = *(const uint4*)(srcn + 64); k3 = *(const uint4*)(srcn + 96);
      k4 = *(const uint4*)(srcr); k5 = *(const uint4*)(srcr + 32);
    }
#pragma unroll
    for (int ks2 = 0; ks2 < 2; ++ks2) {
      bf16x8 pf0 = *(const bf16x8*)(sPw + (0 * 16 + r16) * PST + ks2 * 32 + g4 * 8);
      bf16x8 pf1 = *(const bf16x8*)(sPw + (1 * 16 + r16) * PST + ks2 * 32 + g4 * 8);
#pragma unroll
      for (int nd = 0; nd < 8; ++nd) {
        bf16x8 vf = *(const bf16x8*)(sV + (nd * 16 + r16) * VST + ks2 * 32 + g4 * 8);
        o[0][nd] = __builtin_amdgcn_mfma_f32_16x16x32_bf16(vf, pf0, o[0][nd], 0, 0, 0);
        o[1][nd] = __builtin_amdgcn_mfma_f32_16x16x32_bf16(vf, pf1, o[1][nd], 0, 0, 0);
      }
    }
  }
#pragma unroll
  for (int mi = 0; mi < 2; ++mi) {
    const float inv = 1.f / lrow[mi];
    const int qrow = tq0 + w * 32 + mi * 16 + r16;
    u16* op = p.HQ + (size_t)qrow * 768 + h * 192 + g4 * 4;
    if (dummy) op = p.HQ + (size_t)T_ALL * 768 + (size_t)(qrow % 9216) * 768 + h * 192 + g4 * 4;
#pragma unroll
    for (int nd = 0; nd < 8; ++nd) *(uint2*)(op + nd * 16) = pack4(o[mi][nd] * inv);
  }
}

#define XB_TMO      128
#define XB_XCNT(j)  (256  + 64 * (j))
#define XB_XSUB(j)  (1280 + 64 * (j))
#define XB_XGEN(j)  (2304 + 64 * (j))
#define XB_TOP      3328
#define XB_TOPGEN   3392
#define XCD_BAR_WORDS 3456
#define XB_SPIN_CAP (1u << 23)
#define LAS __attribute__((address_space(3)))

__device__ __forceinline__ unsigned xb_ld(unsigned* p)              { return __hip_atomic_load(p, __ATOMIC_RELAXED, __HIP_MEMORY_SCOPE_AGENT); }
__device__ __forceinline__ unsigned xb_add(unsigned* p, unsigned v) { return __hip_atomic_fetch_add(p, v, __ATOMIC_RELAXED, __HIP_MEMORY_SCOPE_AGENT); }
__device__ __forceinline__ unsigned xb_xcc_id() { return (unsigned)__builtin_amdgcn_s_getreg((3 << 11) | 20) & 0xFu; }
#define XB_SPIN(cond, bar) do { unsigned _sp = 0; while (cond) { __builtin_amdgcn_s_sleep(1); \
    if ((++_sp & 255u) == 0u) { if (xb_ld(&(bar)[XB_TMO])) break; if (_sp > XB_SPIN_CAP) { atomicAdd(&(bar)[XB_TMO], 1u); break; } } } } while (0)

struct XcdBarrier {
    unsigned* bar; unsigned x;
    volatile LAS unsigned* st;
};

__device__ __forceinline__ XcdBarrier xcd_barrier_post(unsigned* bar, volatile LAS unsigned* st) {
    XcdBarrier b; b.bar = bar; b.x = xb_xcc_id(); b.st = st;
    if (threadIdx.x == 0) (void)xb_add(&bar[XB_XCNT(b.x)], 1u);
    return b;
}
__device__ __forceinline__ void xcd_barrier_complete(unsigned* bar, unsigned x, unsigned& nloc, unsigned& nx) {
    const unsigned G = gridDim.x * gridDim.y * gridDim.z;
    unsigned sum, cnt, mine, sp = 0u;
    for (;;) {
        sum = 0u; cnt = 0u; mine = 0u;
#pragma unroll
        for (unsigned j = 0; j < 16; ++j) { const unsigned c = xb_ld(&bar[XB_XCNT(j)]); sum += c; cnt += (c > 0u) ? 1u : 0u; mine = (j == x) ? c : mine; }
        if (sum == G) break;
        __builtin_amdgcn_s_sleep(1);
        if ((++sp & 255u) == 0u) { if (xb_ld(&bar[XB_TMO])) break; if (sp > XB_SPIN_CAP) { atomicAdd(&bar[XB_TMO], 1u); break; } }
    }
    nloc = mine > 0u ? mine : 1u; nx = cnt > 0u ? cnt : 1u;
}

__device__ __forceinline__ void xcd_barrier(const XcdBarrier& b) {
    asm volatile("s_waitcnt vmcnt(0)" ::: "memory");
    __syncthreads();
    if (threadIdx.x == 0) {
        unsigned* bar = b.bar;
        __builtin_amdgcn_s_waitcnt(0);
        unsigned nloc = b.st[0], nx = b.st[1];
        if (nloc == 0u) { xcd_barrier_complete(bar, b.x, nloc, nx); b.st[0] = nloc; b.st[1] = nx; }
        const unsigned old = xb_add(&bar[XB_XSUB(b.x)], 1u);
        const unsigned gen = old / nloc;
        if (old + 1u == (gen + 1u) * nloc) {
            __builtin_amdgcn_fence(__ATOMIC_RELEASE, "agent");
            asm volatile("s_waitcnt vmcnt(0)" ::: "memory");
            const unsigned og = xb_add(&bar[XB_TOP], 1u);
            const unsigned tg = og / nx;
            if (og + 1u == (tg + 1u) * nx) xb_add(&bar[XB_TOPGEN], 1u);
            else XB_SPIN(xb_ld(&bar[XB_TOPGEN]) == tg, bar);
            __builtin_amdgcn_fence(__ATOMIC_ACQUIRE, "agent");
            xb_add(&bar[XB_XGEN(b.x)], 1u);
            asm volatile("s_waitcnt vmcnt(0)" ::: "memory");
        } else {
            XB_SPIN(xb_ld(&bar[XB_XGEN(b.x)]) == gen, bar);
            __builtin_amdgcn_fence(__ATOMIC_ACQUIRE, "agent");
            asm volatile("s_waitcnt vmcnt(0)" ::: "memory");
        }
    }
    __syncthreads();
}


__device__ __forceinline__ void gbar(unsigned* ctr, unsigned target) {
  asm volatile("s_waitcnt vmcnt(0)" ::: "memory");
  __syncthreads();
  if (tid_l() == 0) {
    __builtin_amdgcn_fence(__ATOMIC_RELEASE, "agent");
    asm volatile("s_waitcnt vmcnt(0)" ::: "memory");
    __hip_atomic_fetch_add(ctr, 1u, __ATOMIC_RELAXED, __HIP_MEMORY_SCOPE_AGENT);
    while (__hip_atomic_load(ctr, __ATOMIC_RELAXED, __HIP_MEMORY_SCOPE_AGENT) < target) __builtin_amdgcn_s_sleep(2);
    __builtin_amdgcn_fence(__ATOMIC_ACQUIRE, "agent");
    asm volatile("s_waitcnt vmcnt(0)" ::: "memory");
  }
  __syncthreads();
}
#define MFMA4(a, b, c) __builtin_amdgcn_mfma_f32_16x16x4f32((a), (b), (c), 0, 0, 0)

__device__ __forceinline__ float softplusf_(float x) { return fmaxf(x, 0.f) + log1pf(__expf(-fabsf(x))); }

__device__ __forceinline__ void gdn_chain(const Params& p, int l, int seq, int h, int d, int vs, float* sm) {
  float* sMM = sm;
  float* sK = sMM + 64 * 68;
  float* sW = sK + 64 * 65;
  float* sV = sW + 64 * 65;
  float* sS = sV + 64 * 33;
  float* sGc = sS + 64 * 33;
  float* sBeta = sGc + 64;
  float* sBg = sBeta + 64;
  const int tid = tid_l(), lane = tid & 63, w = tid >> 6, r16 = lane & 15, g4 = lane >> 4;
  const bool latent = seq >= 16;
  const int len = latent ? 4096 : 256;
  const int t0 = latent ? T_CTX + (seq - 16) * 4096 : seq * 256;
  const int nchunks = len >> 6;
  const float Acoef = -__expf(p.gdn_a_log[l * 8 + d * 4 + h]);
  const float dtb = p.gdn_dt_bias[l * 8 + d * 4 + h];
  f32x4 Sreg[2];
  __syncthreads();
  {
    const float* s0 = latent ? p.state_gdn + ((((size_t)(seq - 16) * 2 + l) * 2 + d) * 4 + h) * 4096 : nullptr;
#pragma unroll
    for (int n = 0; n < 2; ++n)
#pragma unroll
      for (int r = 0; r < 4; ++r) {
        const int kidx = 16 * w + g4 * 4 + r, cc = n * 16 + r16;
        float v = latent ? s0[kidx * 64 + vs * 32 + cc] : 0.f;
        Sreg[n][r] = v;
        sS[kidx * 33 + cc] = v;
      }
  }
  const u16* Pb = p.P + (size_t)t0 * PW;
  const u16* VHb = p.HQ + (size_t)T_ALL * 768 + (size_t)t0 * 256;
#define GDN_SRC(i, tl, tlo_) ({ const int e_ = (tl) + (i) * 256; const int u_ = e_ / 20, un_ = e_ % 20; \
    (un_ < 16) ? (Pb + (size_t)((tlo_) + u_) * PW + (un_ < 8 ? P_QH + h * 64 + un_ * 8 : P_KH + h * 64 + (un_ - 8) * 8)) \
               : (VHb + (size_t)((tlo_) + u_) * 256 + h * 64 + vs * 32 + (un_ - 16) * 8); })
  uint4 pf[5];
  float pga = 0.f, pgb = 0.f;
  {
    const int tlo = d == 0 ? 0 : len - 64;
#pragma unroll
    for (int i = 0; i < 5; ++i) pf[i] = *(const uint4*)GDN_SRC(i, tid, tlo);
    if (tid < 64) {
      const int u = d == 0 ? tid : 63 - tid;
      const float* gab = p.GAB + (size_t)(t0 + tlo + u) * 16;
      pga = gab[d * 4 + h]; pgb = gab[8 + d * 4 + h];
    }
  }
  for (int n = 0; n < nchunks; ++n) {
    const int tlo = d == 0 ? n * 64 : len - 64 * (n + 1);
    const int tl2 = tid_l();
#pragma unroll
    for (int i = 0; i < 5; ++i) {
      const int e = tl2 + i * 256;
      const int u = e / 20, un = e % 20;
      const int pp = d == 0 ? u : 63 - u;
      float* dq = un < 8 ? sW + pp * 65 + un * 8 : (un < 16 ? sK + pp * 65 + (un - 8) * 8 : sV + pp * 33 + (un - 16) * 8);
      const unsigned wv[4] = {pf[i].x, pf[i].y, pf[i].z, pf[i].w};
#pragma unroll
      for (int j = 0; j < 4; ++j) { dq[2 * j] = bf2f((u16)(wv[j] & 0xffff)); dq[2 * j + 1] = bf2f((u16)(wv[j] >> 16)); }
    }
    if (tid < 64) {
      const int pp = tid;
      float g = Acoef * softplusf_(pga + dtb);
      float bt = sigmoidf_(pgb);
#pragma unroll
      for (int o = 1; o < 64; o <<= 1) { float tt = __shfl_up(g, o); if (lane >= o) g += tt; }
      sGc[pp] = g; sBeta[pp] = bt; sBg[pp] = bt * __expf(g);
    }
    if (n + 1 < nchunks) {
      const int tlo2 = d == 0 ? (n + 1) * 64 : len - 64 * (n + 2);
#pragma unroll
      for (int i = 0; i < 5; ++i) pf[i] = *(const uint4*)GDN_SRC(i, tl2, tlo2);
      if (tid < 64) {
        const int u = d == 0 ? tid : 63 - tid;
        const float* gab = p.GAB + (size_t)(t0 + tlo2 + u) * 16;
        pga = gab[d * 4 + h]; pgb = gab[8 + d * 4 + h];
      }
    }
    __syncthreads();
    float qa[16];
#pragma unroll
    for (int s = 0; s < 16; ++s) qa[s] = sW[(16 * w + r16) * 65 + 4 * s + g4];
    const unsigned tcode = w == 0 ? 0x730u : (w == 1 ? 0xA51u : (w == 2 ? 0x062u : 0x0FBu));
    const int tcnt = w < 2 ? 3 : 2;
    f32x4 attacc[3];
#pragma unroll
    for (int t = 0; t < 3; ++t) {
      attacc[t] = f32x4{0.f, 0.f, 0.f, 0.f};
      if (t < tcnt) {
        const int ti = (tcode >> (4 * t)) & 3, tn = (tcode >> (4 * t + 2)) & 3;
        f32x4 accm = f32x4{0.f, 0.f, 0.f, 0.f};
        const float* ak = sK + (16 * ti + r16) * 65 + g4;
        const float* aq = sW + (16 * ti + r16) * 65 + g4;
        const float* bk = sK + (16 * tn + r16) * 65 + g4;
#pragma unroll
        for (int s = 0; s < 16; ++s) {
          const float bv = bk[4 * s];
          accm = MFMA4(ak[4 * s], bv, accm);
          attacc[t] = MFMA4(aq[4 * s], bv, attacc[t]);
        }
#pragma unroll
        for (int r = 0; r < 4; ++r) {
          const int i = 16 * ti + g4 * 4 + r, j = 16 * tn + r16;
          sMM[i * 68 + j] = (i > j) ? sBeta[i] * accm[r] * __expf(sGc[i] - sGc[j]) : 0.f;
        }
      }
    }
    __syncthreads();
    if (w == 0) {
      const int bi = tid >> 4, c = tid & 15;
      float* md = sMM + (16 * bi) * 68 + 16 * bi;
      float a[16];
#pragma unroll
      for (int r = 0; r < 16; ++r) a[r] = (r == c) ? 1.f : 0.f;
#pragma unroll
      for (int r = 1; r < 16; ++r) {
#pragma unroll
        for (int q4 = 0; q4 < (r + 3) / 4; ++q4) {
          const float4 m = *(const float4*)(md + r * 68 + 4 * q4);
          if (q4 * 4 + 0 < r) a[r] -= m.x * a[q4 * 4 + 0];
          if (q4 * 4 + 1 < r) a[r] -= m.y * a[q4 * 4 + 1];
          if (q4 * 4 + 2 < r) a[r] -= m.z * a[q4 * 4 + 2];
          if (q4 * 4 + 3 < r) a[r] -= m.w * a[q4 * 4 + 3];
        }
      }
      __builtin_amdgcn_fence(__ATOMIC_SEQ_CST, "wavefront");
#pragma unroll
      for (int r = 0; r < 16; ++r) md[r * 68 + c] = a[r];
    } else {
      for (int t = w - 1; t < 8; t += 3) {
        const int ti = t >> 1, tc = t & 1;
        const float bg = sBg[16 * ti + r16];
        const float* ak = sK + (16 * ti + r16) * 65 + g4;
        const float* bs = sS + g4 * 33 + 16 * tc + r16;
        f32x4 acc = f32x4{0.f, 0.f, 0.f, 0.f};
#pragma unroll
        for (int s = 0; s < 16; ++s) acc = MFMA4(ak[4 * s] * bg, bs[4 * s * 33], acc);
#pragma unroll
        for (int r = 0; r < 4; ++r) {
          const int i = 16 * ti + g4 * 4 + r, cc = 16 * tc + r16;
          sV[i * 33 + cc] = sV[i * 33 + cc] * sBeta[i] - acc[r];
        }
      }
    }
    __syncthreads();
    for (int ib = 0; ib < 4; ++ib) {
      if (w < 2) {
        const int ct = w;
        f32x4 acc = f32x4{0.f, 0.f, 0.f, 0.f};
        const float* am = sMM + (16 * ib + r16) * 68 + g4;
        const float* bx = sV + g4 * 33 + 16 * ct + r16;
        for (int s4 = 0; s4 < ib; ++s4) {
#pragma unroll
          for (int s = 0; s < 4; ++s) acc = MFMA4(am[16 * s4 + 4 * s], bx[(16 * s4 + 4 * s) * 33], acc);
        }
        f32x4 rm;
#pragma unroll
        for (int r = 0; r < 4; ++r) rm[r] = sV[(16 * ib + g4 * 4 + r) * 33 + 16 * ct + r16] - acc[r];
        const float* dd = sMM + (16 * ib + r16) * 68 + 16 * ib + 4 * g4;
        f32x4 xn = f32x4{0.f, 0.f, 0.f, 0.f};
#pragma unroll
        for (int s = 0; s < 4; ++s) xn = MFMA4(dd[s], rm[s], xn);
#pragma unroll
        for (int r = 0; r < 4; ++r) sV[(16 * ib + g4 * 4 + r) * 33 + 16 * ct + r16] = xn[r];
      }
      __syncthreads();
    }
#pragma unroll
    for (int t = 0; t < 3; ++t) {
      if (t < tcnt) {
        const int ti = (tcode >> (4 * t)) & 3, tn = (tcode >> (4 * t + 2)) & 3;
#pragma unroll
        for (int r = 0; r < 4; ++r) {
          const int i = 16 * ti + g4 * 4 + r, j = 16 * tn + r16;
          sMM[i * 68 + j] = (i >= j) ? attacc[t][r] * __expf(sGc[i] - sGc[j]) : 0.f;
        }
      }
    }
    __syncthreads();
    {
      f32x4 acc[2] = {f32x4{0.f, 0.f, 0.f, 0.f}, f32x4{0.f, 0.f, 0.f, 0.f}};
      const float eg = __expf(sGc[16 * w + r16]);
#pragma unroll
      for (int s = 0; s < 16; ++s) {
        const float a = qa[s] * eg;
        acc[0] = MFMA4(sS[(4 * s + g4) * 33 + r16], a, acc[0]);
        acc[1] = MFMA4(sS[(4 * s + g4) * 33 + 16 + r16], a, acc[1]);
      }
#pragma unroll
      for (int s = 0; s < 16; ++s) {
        if (s < 4 * (w + 1)) {
          const float a = sMM[(16 * w + r16) * 68 + 4 * s + g4];
          acc[0] = MFMA4(sV[(4 * s + g4) * 33 + r16], a, acc[0]);
          acc[1] = MFMA4(sV[(4 * s + g4) * 33 + 16 + r16], a, acc[1]);
        }
      }
      {
        const int pp = 16 * w + r16;
        const int u = d == 0 ? pp : 63 - pp;
        u16* op = p.MIX + (size_t)(t0 + tlo + u) * 1024 + d * 256 + h * 64 + vs * 32 + g4 * 4;
        *(uint2*)(op) = pack4(acc[0]);
        *(uint2*)(op + 16) = pack4(acc[1]);
      }
    }
    __syncthreads();
    {
      const float g63 = sGc[63];
      const float gl = __expf(g63);
#pragma unroll
      for (int nn = 0; nn < 2; ++nn)
#pragma unroll
        for (int r = 0; r < 4; ++r) Sreg[nn][r] *= gl;
#pragma unroll
      for (int s = 0; s < 16; ++s) {
        const int srow = 4 * s + g4;
        const float a = sK[srow * 65 + 16 * w + r16] * __expf(g63 - sGc[srow]);
        Sreg[0] = MFMA4(a, sV[srow * 33 + r16], Sreg[0]);
        Sreg[1] = MFMA4(a, sV[srow * 33 + 16 + r16], Sreg[1]);
      }
    }
    __syncthreads();
#pragma unroll
    for (int nn = 0; nn < 2; ++nn)
#pragma unroll
      for (int r = 0; r < 4; ++r) sS[(16 * w + g4 * 4 + r) * 33 + nn * 16 + r16] = Sreg[nn][r];
    __syncthreads();
  }
  if (!latent) {
    float* so = p.out + OUT_SGDN + ((((size_t)seq * 2 + l) * 2 + d) * 4 + h) * 4096;
#pragma unroll
    for (int nn = 0; nn < 2; ++nn)
#pragma unroll
      for (int r = 0; r < 4; ++r) so[(16 * w + g4 * 4 + r) * 64 + vs * 32 + nn * 16 + r16] = Sreg[nn][r];
  }
}

__device__ __forceinline__ void hgrn_chain(const Params& p, int l, int seq, int h, int d, int vs, float* sm) {
  float* sBC = sm;
  float* sK = sBC + 64 * 65;
  float* sAT = sK + 64 * 65;
  float* sV = sAT + 64 * 68;
  float* sS = sV + 64 * 33;
  float* sTot = sS + 64 * 33;
  const int tid = tid_l(), lane = tid & 63, w = tid >> 6, r16 = lane & 15, g4 = lane >> 4;
  const bool latent = seq >= 16;
  const int len = latent ? 4096 : 256;
  const int t0 = latent ? T_CTX + (seq - 16) * 4096 : seq * 256;
  const int nchunks = len >> 6;
  float lbk;
  {
    const int kch = h * 64 + (tid & 63);
    lbk = (l == 0) ? 0.f : sigmoidf_(p.hgrn_lb[256 + kch] - p.hgrn_lb[kch]);
  }
  f32x4 Sreg[2];
  __syncthreads();
  {
    const float* s0 = latent ? p.state_hgrn + ((((size_t)(seq - 16) * 2 + l) * 2 + d) * 4 + h) * 4096 : nullptr;
#pragma unroll
    for (int n = 0; n < 2; ++n)
#pragma unroll
      for (int r = 0; r < 4; ++r) {
        const int kidx = 16 * w + g4 * 4 + r, cc = n * 16 + r16;
        float v = latent ? s0[kidx * 64 + vs * 32 + cc] : 0.f;
        Sreg[n][r] = v;
        sS[kidx * 33 + cc] = v;
      }
  }
  const u16* Pb = p.P + (size_t)t0 * PW;
  float* sLb = sTot + 256;
  if (tid < 64) sLb[tid] = lbk;
  __syncthreads();
  int pgo[5];
#pragma unroll
  for (int i = 0; i < 5; ++i) {
    const int e = tid + i * 256;
    const int u = e / 20, un = e % 20;
    pgo[i] = u * PW + (un < 8 ? P_HF + d * 256 + h * 64 + un * 8 : (un < 12 ? P_HI + h * 64 + vs * 32 + (un - 8) * 8 : P_HQ + h * 64 + (un - 12) * 8));
  }
  uint4 pf[5];
  {
    const int tlo = d == 0 ? 0 : len - 64;
#pragma unroll
    for (int i = 0; i < 5; ++i) pf[i] = *(const uint4*)(Pb + (size_t)tlo * PW + pgo[i]);
  }
  for (int n = 0; n < nchunks; ++n) {
#pragma unroll
    for (int i = 0; i < 5; ++i) {
      const int e = tid + i * 256;
      const int u = e / 20, un = e % 20;
      const int pp = d == 0 ? u : 63 - u;
      const unsigned wv[4] = {pf[i].x, pf[i].y, pf[i].z, pf[i].w};
#pragma unroll
      for (int j = 0; j < 8; ++j) {
        const float x = bf2f((u16)((wv[j >> 1] >> ((j & 1) * 16)) & 0xffff));
        if (un < 8) {
          const int k = un * 8 + j;
          const float lb = sLb[k];
          const float sg_ = sigmoidf_(x);
          const float gate = lb + (1.f - lb) * sg_;
          sBC[pp * 65 + k] = __logf(fmaxf(gate, 1e-30f));
          sK[pp * 65 + k] = (1.f - lb) * (1.f - sg_);
        } else if (un < 12) {
          sV[pp * 33 + (un - 8) * 8 + j] = x;
        } else {
          sAT[pp * 68 + (un - 12) * 8 + j] = x;
        }
      }
    }
    __syncthreads();
    if (n + 1 < nchunks) {
      const int tlo2 = d == 0 ? (n + 1) * 64 : len - 64 * (n + 2);
#pragma unroll
      for (int i = 0; i < 5; ++i) pf[i] = *(const uint4*)(Pb + (size_t)tlo2 * PW + pgo[i]);
    }
    const int tlo = d == 0 ? n * 64 : len - 64 * (n + 1);
    float cs[16];
    {
      const int k = tid & 63, sg = tid >> 6;
      float run = 0.f;
#pragma unroll
      for (int i = 0; i < 16; ++i) { run += sBC[(16 * sg + i) * 65 + k]; cs[i] = run; }
      sTot[sg * 64 + k] = run;
    }
    float qa[16];
#pragma unroll
    for (int s = 0; s < 16; ++s) qa[s] = sAT[(16 * w + r16) * 68 + 4 * s + g4];
    __syncthreads();
    {
      const int k = tid & 63, sg = tid >> 6;
      float off = 0.f;
      for (int s2 = 0; s2 < sg; ++s2) off += sTot[s2 * 64 + k];
#pragma unroll
      for (int i = 0; i < 16; ++i) sBC[(16 * sg + i) * 65 + k] = cs[i] + off;
    }
    __syncthreads();
    {
      float aq[16], rf[16];
#pragma unroll
      for (int s = 0; s < 16; ++s) {
        const int kk = 4 * s + g4;
        rf[s] = (w == 0) ? 0.f : sBC[(16 * w - 1) * 65 + kk];
        aq[s] = qa[s] * __expf(sBC[(16 * w + r16) * 65 + kk] - rf[s]);
      }
#pragma unroll
      for (int nn = 0; nn < 4; ++nn) {
        f32x4 acc = f32x4{0.f, 0.f, 0.f, 0.f};
        if (nn <= w) {
#pragma unroll
          for (int s = 0; s < 16; ++s) {
            const int kk = 4 * s + g4, sc = 16 * nn + r16;
            const float bv = sK[sc * 65 + kk] * __expf(fminf(rf[s] - sBC[sc * 65 + kk], 80.f));
            acc = MFMA4(aq[s], bv, acc);
          }
        }
#pragma unroll
        for (int r = 0; r < 4; ++r) {
          const int i = 16 * w + g4 * 4 + r, j = 16 * nn + r16;
          sAT[i * 68 + j] = (i >= j) ? acc[r] : 0.f;
        }
      }
    }
    __syncthreads();
    {
      f32x4 acc[2] = {f32x4{0.f, 0.f, 0.f, 0.f}, f32x4{0.f, 0.f, 0.f, 0.f}};
#pragma unroll
      for (int s = 0; s < 16; ++s) {
        const int kk = 4 * s + g4;
        const float a = qa[s] * __expf(sBC[(16 * w + r16) * 65 + kk]);
        acc[0] = MFMA4(sS[kk * 33 + r16], a, acc[0]);
        acc[1] = MFMA4(sS[kk * 33 + 16 + r16], a, acc[1]);
      }
#pragma unroll
      for (int s = 0; s < 16; ++s) {
        if (s < 4 * (w + 1)) {
          const float a = sAT[(16 * w + r16) * 68 + 4 * s + g4];
          acc[0] = MFMA4(sV[(4 * s + g4) * 33 + r16], a, acc[0]);
          acc[1] = MFMA4(sV[(4 * s + g4) * 33 + 16 + r16], a, acc[1]);
        }
      }
      {
        const int pp = 16 * w + r16;
        const int u = d == 0 ? pp : 63 - pp;
        u16* op = p.MIX + (size_t)(t0 + tlo + u) * 1024 + 512 + d * 256 + h * 64 + vs * 32 + g4 * 4;
        *(uint2*)(op) = pack4(acc[0]);
        *(uint2*)(op + 16) = pack4(acc[1]);
      }
    }
    __syncthreads();
    {
#pragma unroll
      for (int nn = 0; nn < 2; ++nn)
#pragma unroll
        for (int r = 0; r < 4; ++r) Sreg[nn][r] *= __expf(sBC[63 * 65 + 16 * w + g4 * 4 + r]);
      const int kA = 16 * w + r16;
      const float blA = sBC[63 * 65 + kA];
#pragma unroll
      for (int s = 0; s < 16; ++s) {
        const int srow = 4 * s + g4;
        const float a = sK[srow * 65 + kA] * __expf(blA - sBC[srow * 65 + kA]);
        Sreg[0] = MFMA4(a, sV[srow * 33 + r16], Sreg[0]);
        Sreg[1] = MFMA4(a, sV[srow * 33 + 16 + r16], Sreg[1]);
      }
    }
    __syncthreads();
#pragma unroll
    for (int nn = 0; nn < 2; ++nn)
#pragma unroll
      for (int r = 0; r < 4; ++r) sS[(16 * w + g4 * 4 + r) * 33 + nn * 16 + r16] = Sreg[nn][r];
    __syncthreads();
  }
  if (!latent) {
    float* so = p.out + OUT_SHG + ((((size_t)seq * 2 + l) * 2 + d) * 4 + h) * 4096;
#pragma unroll
    for (int nn = 0; nn < 2; ++nn)
#pragma unroll
      for (int r = 0; r < 4; ++r) so[(16 * w + g4 * 4 + r) * 64 + vs * 32 + nn * 16 + r16] = Sreg[nn][r];
  }
}

__device__ __forceinline__ void phase_c(const Params& p, int l, unsigned char* smraw, int mode = 0) {
  __shared__ int s_item;
  const int total = 1920;
  for (;;) {
    __syncthreads();
    if (tid_l() == 0) s_item = (int)atomicAdd(&p.counters[l * 64 + mode * 16], 1u);
    __syncthreads();
    const int item = s_item;
    if (item >= total) break;
    int kind, a0, a1, a2, a3;
    if (item < 256 || (item >= 1280 && item < 1792)) {
      const int i2 = item < 256 ? item : item - 1280;
      const int rest = i2 >> 1;
      kind = i2 & 1;
      a3 = rest & 1; a2 = (rest >> 1) & 1; a1 = (rest >> 2) & 3; a0 = (rest >> 4) + (item < 256 ? 16 : 0);
    } else if (item < 1280) {
      const int i2 = item - 256;
      kind = 2; a0 = 1; a1 = i2 >> 7; a2 = (i2 >> 5) & 3; a3 = i2 & 31;
    } else {
      const int i2 = item - 1792;
      kind = 2; a0 = 0; a1 = i2 >> 3; a2 = (i2 >> 1) & 3; a3 = i2 & 1;
    }
    if (mode == 1 && kind == 2) continue;
    if (mode == 2 && kind != 2) continue;
    if (kind == 0) gdn_chain(p, l, a0, a1, a2, a3, (float*)smraw);
    else if (kind == 1) hgrn_chain(p, l, a0, a1, a2, a3, (float*)smraw);
    else attn_item(p, a0, a1, a2, a3, smraw, mode == 2);
  }
}

__global__ void __launch_bounds__(NTHR, 2) mega(Params p) {
  __shared__ __attribute__((aligned(16))) unsigned char smem[LDS_BYTES];
  cg::grid_group grid = cg::this_grid();
  __shared__ uint4 xb_words;
  if (threadIdx.x == 0) xb_words = make_uint4(0u, 0u, 0u, 0u);
  __syncthreads();
  {
    XcdBarrier xb0 = xcd_barrier_post(p.xbar, (volatile LAS unsigned*)&xb_words);
    if (threadIdx.x == 0) ((volatile LAS unsigned*)&xb_words)[2] = xb0.x;
  }
#define GSYNC() do { XcdBarrier xb_; xb_.bar = p.xbar; xb_.st = (volatile LAS unsigned*)&xb_words; xb_.x = 0; \
    if (threadIdx.x == 0) xb_.x = ((volatile LAS unsigned*)&xb_words)[2]; xcd_barrier(xb_); } while (0)
  phase0(p, (float*)smem);
  grid.sync();
  rowpass_norm(p, 0, 0);
  GSYNC();
  for (int l = 0; l < 2; ++l) {
    phase_a(p, l, (u16*)smem);
    GSYNC();
    rowpass_b0(p, l);
    GSYNC();
    phase_b1(p, l, (u16*)smem);
    GSYNC();
    rowpass_b2(p, l);
    GSYNC();
    phase_c(p, l, smem);
    GSYNC();
    rowpass_c2(p, l);
    GSYNC();
    phase_gemm_y(p.MIX, 1024, p.WoutT + (size_t)l * 1024 * 1024, 1024, 1024, p.HQ, 1024, (u16*)smem);
    GSYNC();
    rowpass_norm(p, l, 1);
    GSYNC();
    phase_e(p, l, (u16*)smem);
    GSYNC();
    phase_gemm_y(p.P, DFF, p.WfoT + (size_t)l * 1024 * DFF, DFF, 1024, p.HQ, 1024, (u16*)smem);
    GSYNC();
    rowpass_norm(p, l, 2);
    if (l == 0) GSYNC();
  }
}

extern "C" void kernel_launch(void* const* d_in, const int* in_sizes, int n_in, void* d_out, int out_size, void* d_ws,
                              size_t ws_size, hipStream_t stream) {
  static int grid_blocks = 0;
  if (!grid_blocks) {
    int dev = 0, cus = 0, per_cu = 0;
    hipGetDevice(&dev);
    hipDeviceGetAttribute(&cus, hipDeviceAttributeMultiprocessorCount, dev);
    hipOccupancyMaxActiveBlocksPerMultiprocessor(&per_cu, mega, NTHR, 0);
    if (per_cu > 2) per_cu = 2;
    if (per_cu < 1) per_cu = 1;
    grid_blocks = cus * per_cu;
  }
  Params p{};
  const float* const* in = (const float* const*)d_in;
  p.x_prompt = in[0]; p.x_sample = in[1]; p.cache_ckv = in[2]; p.cache_kr = in[3]; p.state_gdn = in[4]; p.state_hgrn = in[5];
  p.c = in[6]; p.c_ctx = in[7]; p.w_ada = in[8]; p.b_ada = in[9]; p.g_pre_mix = in[10]; p.g_post_mix = in[11];
  p.g_pre_ffn = in[12]; p.g_post_ffn = in[13]; p.w_in = in[14]; p.w_out = in[15]; p.gdn_conv_w = in[16];
  p.gdn_a_log = in[17]; p.gdn_dt_bias = in[18]; p.gdn_norm_w = in[19]; p.hgrn_lb = in[20]; p.hgrn_norm_w = in[21];
  p.mla_q_norm_w = in[22]; p.mla_w_uq = in[23]; p.mla_kv_norm_w = in[24]; p.mla_w_ukv = in[25]; p.w_ffn_in = in[26];
  p.w_ffn_out = in[27];
  p.out = (float*)d_out;
  unsigned char* ws = (unsigned char*)d_ws;
  size_t off = 0;
  auto take = [&](size_t bytes) { unsigned char* r = ws + off; off += (bytes + 255) & ~(size_t)255; return r; };
  p.counters = (unsigned*)take(1024);
  p.xbar = (unsigned*)take(16384);
  p.WinT = (u16*)take((size_t)2 * 3072 * 1024 * 2);
  p.WuqT = (u16*)take((size_t)2 * 768 * 384 * 2);
  p.WukvT = (u16*)take((size_t)2 * 1024 * 256 * 2);
  p.WoutT = (u16*)take((size_t)2 * 1024 * 1024 * 2);
  p.WfiT = (u16*)take((size_t)2 * 5632 * 1024 * 2);
  p.WfoT = (u16*)take((size_t)2 * 1024 * 2816 * 2);
  p.mod = (float*)take((size_t)2 * 9 * 6144 * 4);
  p.HQ = (u16*)take((size_t)T_ALL * 1024 * 2);
  p.P = (u16*)take((size_t)T_ALL * PW * 2);
  p.KN = (u16*)take((size_t)(T_ALL + 2048) * 512 * 2);
  p.VTL = (u16*)take((size_t)8 * 4 * 128 * 4352 * 2);
  p.VTC = (u16*)take((size_t)16 * 4 * 128 * 256 * 2);
  p.CKVC = (u16*)take((size_t)2048 * 256 * 2);
  p.KRC = (u16*)take((size_t)2048 * 64 * 2);
  p.GAB = (float*)take((size_t)T_ALL * 16 * 4);
  p.MIX = (u16*)take((size_t)T_ALL * 1024 * 2);
  if (off > ws_size) { fprintf(stderr, "workspace too small: need %zu have %zu\n", off, ws_size); return; }
  hipMemsetAsync(p.counters, 0, 1024 + 16384, stream);
  void* args[] = {&p};
  hipError_t e = hipLaunchCooperativeKernel((void*)mega, dim3(grid_blocks), dim3(NTHR), args, 0, stream);
  if (e != hipSuccess) fprintf(stderr, "cooperative launch failed: %s (grid %d)\n", hipGetErrorString(e), grid_blocks);
}
```

```cpp
#include <hip/hip_runtime.h>
#include <hip/hip_cooperative_groups.h>
#include <cstdio>
namespace cg = cooperative_groups;

typedef unsigned short u16;
using bf16x8 = __attribute__((ext_vector_type(8))) short;
using f32x4  = __attribute__((ext_vector_type(4))) float;

#define T_CTX 4096
#define T_ALL 36864
#define PW 3072
#define DFF 2816
#define LDS_BYTES 73728
#define NTHR 256

#define P_GQKV 0
#define P_GZ 768
#define P_HQ 1024
#define P_HI 1280
#define P_HF 1536
#define P_HG 2048
#define P_MCQ 2304
#define P_MCKV 2688
#define P_MKR 2944
#define P_GA 3008

struct Params {
  const float *x_prompt, *x_sample, *cache_ckv, *cache_kr, *state_gdn, *state_hgrn, *c, *c_ctx;
  const float *w_ada, *b_ada, *g_pre_mix, *g_post_mix, *g_pre_ffn, *g_post_ffn, *w_in, *w_out;
  const float *gdn_conv_w, *gdn_a_log, *gdn_dt_bias, *gdn_norm_w, *hgrn_lb, *hgrn_norm_w;
  const float *mla_q_norm_w, *mla_w_uq, *mla_kv_norm_w, *mla_w_ukv, *w_ffn_in, *w_ffn_out;
  float* out;
  u16 *WinT, *WuqT, *WukvT, *WoutT, *WfiT, *WfoT;
  float* mod;
  u16 *HQ, *P, *KN, *VTL, *VTC, *CKVC, *KRC, *MIX;
  float* GAB;
  unsigned* counters;
  unsigned* xbar;
};

#define OUT_CKV   37748736
#define OUT_KR    39845888
#define OUT_SGDN  40370176
#define OUT_SHG   41418752

__device__ __forceinline__ u16 f2bf(float f) {
  unsigned u = __float_as_uint(f);
  u += 0x7fffu + ((u >> 16) & 1u);
  return (u16)(u >> 16);
}
__device__ __forceinline__ float bf2f(u16 h) { return __uint_as_float(((unsigned)h) << 16); }
__device__ __forceinline__ float wave_sum(float v) {
#pragma unroll
  for (int o = 32; o > 0; o >>= 1) v += __shfl_xor(v, o);
  return v;
}
__device__ __forceinline__ float sigmoidf_(float x) { return __builtin_amdgcn_rcpf(1.f + __expf(-x)); }
__device__ __forceinline__ float siluf_(float x) { return x * __builtin_amdgcn_rcpf(1.f + __expf(-x)); }
__device__ __forceinline__ int tid_l() { int t = threadIdx.x; asm volatile("" : "+v"(t)); return t; }
__device__ __forceinline__ int tok_mod(int t) { return t < T_CTX ? 0 : 1 + ((t - T_CTX) >> 12); }

__device__ __forceinline__ int map_col(int kind, int j) {
  if (kind == 0) return j;
  if (kind == 1) { if (j < 1024) return j; if (j < 3008) return j + 16; if (j < 3024) return 1024 + (j - 3008); return -1; }
  int blk = j >> 6, w = j & 63;
  return w < 32 ? blk * 32 + w : DFF + blk * 32 + (w - 32);
}

__device__ __forceinline__ void cvt_tile(const float* __restrict__ src, int K, int Nsrc, u16* __restrict__ dst, int kind, int jt, int kt, float* sm) {
  const int tid = tid_l();
  const int j0 = jt * 64, k0 = kt * 64;
  __syncthreads();
  {
    int jj = tid & 63, kk0 = tid >> 6;
    int sc = map_col(kind, j0 + jj);
    for (int kk = kk0; kk < 64; kk += 4)
      sm[kk * 65 + jj] = sc >= 0 ? src[(size_t)(k0 + kk) * Nsrc + sc] : 0.f;
  }
  __syncthreads();
  {
    int kk = tid & 63, jj0 = tid >> 6;
    for (int jj = jj0; jj < 64; jj += 4)
      dst[(size_t)(j0 + jj) * K + k0 + kk] = f2bf(sm[kk * 65 + jj]);
  }
}

__device__ __forceinline__ void mod_item(const Params& p, int item, float* sm) {
  const int l = item / 96, j0 = (item % 96) * 64;
  const int tid = tid_l();
  float* sC = sm;
  float* sR = sm + 9 * 1024;
  __syncthreads();
  for (int i = tid; i < 9 * 1024; i += NTHR) {
    int m = i >> 10, k = i & 1023;
    float v = m == 0 ? p.c_ctx[k] : p.c[(m - 1) * 1024 + k];
    sC[i] = siluf_(v);
  }
  __syncthreads();
  const int col = tid & 63, ks = tid >> 6;
  float acc[9];
#pragma unroll
  for (int m = 0; m < 9; ++m) acc[m] = 0.f;
  const float* wp = p.w_ada + (size_t)l * 1024 * 6144 + j0 + col;
  for (int k = ks * 256; k < ks * 256 + 256; ++k) {
    float w = wp[(size_t)k * 6144];
#pragma unroll
    for (int m = 0; m < 9; ++m) acc[m] += sC[m * 1024 + k] * w;
  }
#pragma unroll
  for (int m = 0; m < 9; ++m) sR[(ks * 9 + m) * 64 + col] = acc[m];
  __syncthreads();
  for (int i = tid; i < 9 * 64; i += NTHR) {
    int m = i >> 6, cc = i & 63;
    float v = sR[(0 * 9 + m) * 64 + cc] + sR[(1 * 9 + m) * 64 + cc] + sR[(2 * 9 + m) * 64 + cc] + sR[(3 * 9 + m) * 64 + cc];
    p.mod[((size_t)l * 9 + m) * 6144 + j0 + cc] = v + p.b_ada[l * 6144 + j0 + cc];
  }
}

__device__ __forceinline__ void phase0(const Params& p, float* sm) {
  const int PER_LAYER = 3272;
  const int total = 2 * PER_LAYER + 192;
  for (int item = blockIdx.x; item < total; item += gridDim.x) {
    if (item < 192) { mod_item(p, item, sm); continue; }
    int it = item - 192;
    int l = it / PER_LAYER, r = it % PER_LAYER;
    if (r < 768) { cvt_tile(p.w_in + (size_t)l * 1024 * 3024, 1024, 3024, p.WinT + (size_t)l * 3072 * 1024, 1, r / 16, r % 16, sm); continue; }
    r -= 768;
    if (r < 72) { cvt_tile(p.mla_w_uq + (size_t)l * 384 * 768, 384, 768, p.WuqT + (size_t)l * 768 * 384, 0, r / 6, r % 6, sm); continue; }
    r -= 72;
    if (r < 64) { cvt_tile(p.mla_w_ukv + (size_t)l * 256 * 1024, 256, 1024, p.WukvT + (size_t)l * 1024 * 256, 0, r / 4, r % 4, sm); continue; }
    r -= 64;
    if (r < 256) { cvt_tile(p.w_out + (size_t)l * 1024 * 1024, 1024, 1024, p.WoutT + (size_t)l * 1024 * 1024, 0, r / 16, r % 16, sm); continue; }
    r -= 256;
    if (r < 1408) { cvt_tile(p.w_ffn_in + (size_t)l * 1024 * 5632, 1024, 5632, p.WfiT + (size_t)l * 5632 * 1024, 2, r / 16, r % 16, sm); continue; }
    r -= 1408;
    cvt_tile(p.w_ffn_out + (size_t)l * 2816 * 1024, 2816, 1024, p.WfoT + (size_t)l * 1024 * 2816, 0, r / 44, r % 44, sm);
  }
}

__device__ __forceinline__ void rowpass_norm(const Params& p, int l, int stage) {
  const int tidl = tid_l();
  const int lane = tidl & 63, w = tidl >> 6;
  const int ln = stage == 0 ? 0 : (stage == 1 ? l : l + 1);
  const int sh_off = stage == 1 ? 3072 : 0;
  const float* gpre = stage == 1 ? p.g_pre_ffn + l * 1024 : p.g_pre_mix + (ln < 2 ? ln : 0) * 1024;
  u16* dst = stage == 1 ? p.MIX : p.HQ;
  for (int t = blockIdx.x * 4 + w; t < T_ALL; t += gridDim.x * 4) {
    const int m = tok_mod(t);
    float x[16];
    float* xo = p.out + (size_t)t * 1024;
    if (stage == 0) {
      const float* xi = t < T_CTX ? p.x_prompt + (size_t)t * 1024 : p.x_sample + (size_t)(t - T_CTX) * 1024;
#pragma unroll
      for (int i = 0; i < 4; ++i) {
        float4 v = *(const float4*)(xi + i * 256 + lane * 4);
        x[i * 4 + 0] = v.x; x[i * 4 + 1] = v.y; x[i * 4 + 2] = v.z; x[i * 4 + 3] = v.w;
      }
    } else {
      const u16* yp = p.HQ + (size_t)t * 1024;
      float y[16]; float ss = 0.f;
#pragma unroll
      for (int i = 0; i < 4; ++i) {
        uint2 v = *(const uint2*)(yp + i * 256 + lane * 4);
        y[i * 4 + 0] = bf2f((u16)(v.x & 0xffff)); y[i * 4 + 1] = bf2f((u16)(v.x >> 16));
        y[i * 4 + 2] = bf2f((u16)(v.y & 0xffff)); y[i * 4 + 3] = bf2f((u16)(v.y >> 16));
      }
#pragma unroll
      for (int i = 0; i < 16; ++i) ss += y[i] * y[i];
      ss = wave_sum(ss);
      const float rstd = rsqrtf(ss * (1.f / 1024.f) + 1e-6f);
      const float* gpost = (stage == 1 ? p.g_post_mix : p.g_post_ffn) + l * 1024;
      const float* gt = p.mod + ((size_t)l * 9 + m) * 6144 + (stage == 1 ? 2048 : 5120);
#pragma unroll
      for (int i = 0; i < 4; ++i) {
        float4 xv = *(const float4*)(xo + i * 256 + lane * 4);
        float4 gp = *(const float4*)(gpost + i * 256 + lane * 4);
        float4 gg = *(const float4*)(gt + i * 256 + lane * 4);
        x[i * 4 + 0] = xv.x + gg.x * y[i * 4 + 0] * rstd * gp.x;
        x[i * 4 + 1] = xv.y + gg.y * y[i * 4 + 1] * rstd * gp.y;
        x[i * 4 + 2] = xv.z + gg.z * y[i * 4 + 2] * rstd * gp.z;
        x[i * 4 + 3] = xv.w + gg.w * y[i * 4 + 3] * rstd * gp.w;
      }
    }
    __threadfence_block();
#pragma unroll
    for (int i = 0; i < 4; ++i)
      *(float4*)(xo + i * 256 + lane * 4) = make_float4(x[i * 4 + 0], x[i * 4 + 1], x[i * 4 + 2], x[i * 4 + 3]);
    if (ln >= 2) continue;
    float ss = 0.f;
#pragma unroll
    for (int i = 0; i < 16; ++i) ss += x[i] * x[i];
    ss = wave_sum(ss);
    const float rstd = rsqrtf(ss * (1.f / 1024.f) + 1e-6f);
    const float* sh = p.mod + ((size_t)ln * 9 + m) * 6144 + sh_off;
    const float* sc = sh + 1024;
    u16* hp = dst + (size_t)t * 1024;
#pragma unroll
    for (int i = 0; i < 4; ++i) {
      float4 gp = *(const float4*)(gpre + i * 256 + lane * 4);
      float4 s1 = *(const float4*)(sh + i * 256 + lane * 4);
      float4 c1 = *(const float4*)(sc + i * 256 + lane * 4);
      float h0 = x[i * 4 + 0] * rstd * gp.x * (1.f + c1.x) + s1.x;
      float h1 = x[i * 4 + 1] * rstd * gp.y * (1.f + c1.y) + s1.y;
      float h2 = x[i * 4 + 2] * rstd * gp.z * (1.f + c1.z) + s1.z;
      float h3 = x[i * 4 + 3] * rstd * gp.w * (1.f + c1.w) + s1.w;
      uint2 o;
      o.x = (unsigned)f2bf(h0) | ((unsigned)f2bf(h1) << 16);
      o.y = (unsigned)f2bf(h2) | ((unsigned)f2bf(h3) << 16);
      *(uint2*)(hp + i * 256 + lane * 4) = o;
    }
  }
}

__device__ __forceinline__ void unpack8(const uint4 v, float (&f)[8]);
__device__ __forceinline__ uint4 pack8(const float (&f)[8]);
__device__ __forceinline__ void rowpass_b0(const Params& p, int l) {
  const int tidl = tid_l();
  const int lane = tidl & 63, w = tidl >> 6;
  for (int t = blockIdx.x * 4 + w; t < T_ALL + 2048; t += gridDim.x * 4) {
    if (t >= T_ALL) {
      const int r = t - T_ALL, b = r >> 8, s = r & 255;
      if (lane < 32) {
        const float* ck = p.cache_ckv + (((size_t)b * 2 + l) * 256 + s) * 256 + lane * 8;
        const float4 x0 = *(const float4*)ck, x1 = *(const float4*)(ck + 4);
        const float f[8] = {x0.x, x0.y, x0.z, x0.w, x1.x, x1.y, x1.z, x1.w};
        *(uint4*)(p.CKVC + (size_t)r * 256 + lane * 8) = pack8(f);
      } else if (lane < 40) {
        const float* kr = p.cache_kr + (((size_t)b * 2 + l) * 256 + s) * 64 + (lane - 32) * 8;
        const float4 x0 = *(const float4*)kr, x1 = *(const float4*)(kr + 4);
        const float f[8] = {x0.x, x0.y, x0.z, x0.w, x1.x, x1.y, x1.z, x1.w};
        *(uint4*)(p.KRC + (size_t)r * 64 + (lane - 32) * 8) = pack8(f);
      }
      continue;
    }
    u16* pr = p.P + (size_t)t * PW;
    {
      float f[8]; float ss = 0.f;
      if (lane < 48) {
        unpack8(*(const uint4*)(pr + P_MCQ + lane * 8), f);
#pragma unroll
        for (int i = 0; i < 8; ++i) ss += f[i] * f[i];
      }
      ss = wave_sum(ss);
      const float rstd = rsqrtf(ss * (1.f / 384.f) + 1e-6f);
      if (lane < 48) {
        const float* wq = p.mla_q_norm_w + l * 384 + lane * 8;
        const float4 w0 = *(const float4*)wq, w1 = *(const float4*)(wq + 4);
        f[0] *= rstd * w0.x; f[1] *= rstd * w0.y; f[2] *= rstd * w0.z; f[3] *= rstd * w0.w;
        f[4] *= rstd * w1.x; f[5] *= rstd * w1.y; f[6] *= rstd * w1.z; f[7] *= rstd * w1.w;
        *(uint4*)(pr + P_MCQ + lane * 8) = pack8(f);
      }
    }
    {
      float f[8]; float ss = 0.f;
      if (lane < 32) {
        unpack8(*(const uint4*)(pr + P_MCKV + lane * 8), f);
#pragma unroll
        for (int i = 0; i < 8; ++i) ss += f[i] * f[i];
      }
      ss = wave_sum(ss);
      const float rstd = rsqrtf(ss * (1.f / 256.f) + 1e-6f);
      if (lane < 32) {
        const float* wk = p.mla_kv_norm_w + l * 256 + lane * 8;
        const float4 w0 = *(const float4*)wk, w1 = *(const float4*)(wk + 4);
        f[0] *= rstd * w0.x; f[1] *= rstd * w0.y; f[2] *= rstd * w0.z; f[3] *= rstd * w0.w;
        f[4] *= rstd * w1.x; f[5] *= rstd * w1.y; f[6] *= rstd * w1.z; f[7] *= rstd * w1.w;
        *(uint4*)(pr + P_MCKV + lane * 8) = pack8(f);
        if (t < T_CTX) {
          const int b = t >> 8, s = t & 255;
          float* op = p.out + OUT_CKV + (((size_t)b * 2 + l) * 256 + s) * 256 + lane * 8;
          *(float4*)op = make_float4(f[0], f[1], f[2], f[3]);
          *(float4*)(op + 4) = make_float4(f[4], f[5], f[6], f[7]);
        }
      }
    }
    {
      float v = bf2f(pr[P_MKR + lane]);
      if (t < T_CTX) {
        int b = t >> 8, s = t & 255;
        p.out[OUT_KR + (((size_t)b * 2 + l) * 256 + s) * 64 + lane] = v;
      } else {
        int pos = (t - T_CTX) & 4095;
        int axis = lane >> 5, half = (lane >> 4) & 1, f = lane & 15;
        float posf = axis == 0 ? (float)(pos >> 6) : (float)(pos & 63);
        float inv = exp2f(-(float)f * (13.287712379549449f / 16.f));
        float ang = posf * inv;
        float sn, cs;
        __sincosf(ang, &sn, &cs);
        float other = __shfl_xor(v, 16);
        float o = half == 0 ? v * cs - other * sn : v * cs + other * sn;
        pr[P_MKR + lane] = f2bf(o);
      }
    }
  }
}

#define P_QH 2304
#define P_KH 2560
__device__ __forceinline__ void rowpass_b2(const Params& p, int l) {
  const int tidl = tid_l();
  const int lane = tidl & 63, w = tidl >> 6;
  float cw[6][2][5];
#pragma unroll
  for (int g = 0; g < 6; ++g)
#pragma unroll
    for (int e = 0; e < 2; ++e)
#pragma unroll
      for (int j = 0; j < 5; ++j) cw[g][e][j] = p.gdn_conv_w[((size_t)l * 768 + 128 * g + 2 * lane + e) * 5 + j];
  u16* VH = p.HQ + (size_t)T_ALL * 768;
  for (int t = blockIdx.x * 4 + w; t < T_ALL; t += gridDim.x * 4) {
    const int len = t < T_CTX ? 256 : 4096;
    const int tau = t < T_CTX ? (t & 255) : ((t - T_CTX) & 4095);
    float y[6][2];
#pragma unroll
    for (int g = 0; g < 6; ++g) { y[g][0] = 0.f; y[g][1] = 0.f; }
#pragma unroll
    for (int j = 0; j < 5; ++j) {
      const int tt = tau + j - 2;
      if (tt >= 0 && tt < len) {
        const u16* pr = p.P + (size_t)(t + j - 2) * PW + 2 * lane;
#pragma unroll
        for (int g = 0; g < 6; ++g) {
          const unsigned v = *(const unsigned*)(pr + 128 * g);
          y[g][0] += cw[g][0][j] * bf2f((u16)(v & 0xffff));
          y[g][1] += cw[g][1][j] * bf2f((u16)(v >> 16));
        }
      }
    }
#pragma unroll
    for (int g = 0; g < 6; ++g) { y[g][0] = siluf_(y[g][0]); y[g][1] = siluf_(y[g][1]); }
#pragma unroll
    for (int g = 0; g < 4; ++g) {
      float ss = y[g][0] * y[g][0] + y[g][1] * y[g][1];
      ss += __shfl_xor(ss, 1); ss += __shfl_xor(ss, 2); ss += __shfl_xor(ss, 4); ss += __shfl_xor(ss, 8); ss += __shfl_xor(ss, 16);
      const float rn = rsqrtf(ss + 1e-6f) * (g < 2 ? 0.125f : 1.f);
      y[g][0] *= rn; y[g][1] *= rn;
    }
    u16* pw = p.P + (size_t)t * PW;
#pragma unroll
    for (int g = 0; g < 4; ++g)
      *(unsigned*)(pw + P_QH + 128 * g + 2 * lane) = (unsigned)f2bf(y[g][0]) | ((unsigned)f2bf(y[g][1]) << 16);
#pragma unroll
    for (int g = 4; g < 6; ++g)
      *(unsigned*)(VH + (size_t)t * 256 + 128 * (g - 4) + 2 * lane) = (unsigned)f2bf(y[g][0]) | ((unsigned)f2bf(y[g][1]) << 16);
  }
}

__device__ __forceinline__ void unpack8(const uint4 v, float (&f)[8]) {
  f[0] = bf2f((u16)(v.x & 0xffff)); f[1] = bf2f((u16)(v.x >> 16)); f[2] = bf2f((u16)(v.y & 0xffff)); f[3] = bf2f((u16)(v.y >> 16));
  f[4] = bf2f((u16)(v.z & 0xffff)); f[5] = bf2f((u16)(v.z >> 16)); f[6] = bf2f((u16)(v.w & 0xffff)); f[7] = bf2f((u16)(v.w >> 16));
}
__device__ __forceinline__ uint4 pack8(const float (&f)[8]) {
  uint4 o;
  o.x = (unsigned)f2bf(f[0]) | ((unsigned)f2bf(f[1]) << 16); o.y = (unsigned)f2bf(f[2]) | ((unsigned)f2bf(f[3]) << 16);
  o.z = (unsigned)f2bf(f[4]) | ((unsigned)f2bf(f[5]) << 16); o.w = (unsigned)f2bf(f[6]) | ((unsigned)f2bf(f[7]) << 16);
  return o;
}
__device__ __forceinline__ void rowpass_c2(const Params& p, int l) {
  const int tidl = tid_l();
  const int lane = tidl & 63, w = tidl >> 6;
  const int hl = lane & 31, isH = lane >> 5;
  const float* nw = (isH ? p.hgrn_norm_w : p.gdn_norm_w) + l * 64 + (hl & 7) * 8;
  const float4 w0 = *(const float4*)(nw), w1 = *(const float4*)(nw + 4);
  const float wv[8] = {w0.x, w0.y, w0.z, w0.w, w1.x, w1.y, w1.z, w1.w};
  for (int t = blockIdx.x * 4 + w; t < T_ALL; t += gridDim.x * 4) {
    u16* mr = p.MIX + (size_t)t * 1024;
    const u16* pr = p.P + (size_t)t * PW;
    const u16* qr = p.HQ + (size_t)t * 768;
    const uint4 vf = *(const uint4*)(mr + isH * 512 + hl * 8);
    const uint4 vb = *(const uint4*)(mr + isH * 512 + 256 + hl * 8);
    const uint4 vg = *(const uint4*)(pr + (isH ? P_HG : P_GZ) + hl * 8);
    const int c0 = lane * 8;
    const uint4 vo = *(const uint4*)(qr + (c0 >> 7) * 192 + (c0 & 127));
    float f[8], bb[8], g[8];
    unpack8(vf, f); unpack8(vb, bb); unpack8(vg, g);
    float ss = 0.f;
#pragma unroll
    for (int i = 0; i < 8; ++i) { f[i] += bb[i]; ss += f[i] * f[i]; }
    ss += __shfl_xor(ss, 1); ss += __shfl_xor(ss, 2); ss += __shfl_xor(ss, 4);
    const float rn = rsqrtf(ss * (1.f / 64.f) + 1e-6f);
#pragma unroll
    for (int i = 0; i < 8; ++i) f[i] = f[i] * rn * wv[i] * (isH ? sigmoidf_(g[i]) : siluf_(g[i]));
    __threadfence_block();
    *(uint4*)(mr + isH * 256 + hl * 8) = pack8(f);
    *(uint4*)(mr + 512 + c0) = vo;
  }
}

__device__ __forceinline__ void gemm128(const u16* __restrict__ A, int lda, const u16* __restrict__ B, int ldb, int K,
                                        u16* lds, f32x4 (&acc)[4][4]) {
  const int tid = tid_l(), lane = tid & 63, w = tid >> 6, wm = w >> 1, wn = w & 1;
  const int r16 = lane & 15, g4 = lane >> 4;
#pragma unroll
  for (int i = 0; i < 4; ++i)
#pragma unroll
    for (int j = 0; j < 4; ++j) acc[i][j] = f32x4{0.f, 0.f, 0.f, 0.f};
  const int lrow = tid >> 3, lkc = tid & 7;
  const u16* ap = A + (size_t)lrow * lda + lkc * 8;
  const u16* bp = B + (size_t)lrow * ldb + lkc * 8;
  const size_t sa32 = (size_t)32 * lda, sb32 = (size_t)32 * ldb;
  uint4 ra0 = *(const uint4*)(ap), ra1 = *(const uint4*)(ap + sa32), ra2 = *(const uint4*)(ap + 2 * sa32), ra3 = *(const uint4*)(ap + 3 * sa32);
  uint4 rb0 = *(const uint4*)(bp), rb1 = *(const uint4*)(bp + sb32), rb2 = *(const uint4*)(bp + 2 * sb32), rb3 = *(const uint4*)(bp + 3 * sb32);
  const int woff = lrow * 64 + ((lkc ^ (lrow & 7)) * 8);
  const int sw = r16 & 7;
  const int fa0 = (wm * 64 + r16) * 64 + ((g4 ^ sw) * 8);
  const int fa1 = (wm * 64 + r16) * 64 + (((4 + g4) ^ sw) * 8);
  const int fb0 = 128 * 64 + (wn * 64 + r16) * 64 + ((g4 ^ sw) * 8);
  const int fb1 = 128 * 64 + (wn * 64 + r16) * 64 + (((4 + g4) ^ sw) * 8);
  const int nk = K >> 6;
  __syncthreads();
  {
    u16* wa = lds + woff; u16* wb = lds + 128 * 64 + woff;
    *(uint4*)(wa) = ra0; *(uint4*)(wa + 32 * 64) = ra1; *(uint4*)(wa + 64 * 64) = ra2; *(uint4*)(wa + 96 * 64) = ra3;
    *(uint4*)(wb) = rb0; *(uint4*)(wb + 32 * 64) = rb1; *(uint4*)(wb + 64 * 64) = rb2; *(uint4*)(wb + 96 * 64) = rb3;
  }
  if (nk > 1) {
    const u16* a2 = ap + 64; const u16* b2 = bp + 64;
    ra0 = *(const uint4*)(a2); ra1 = *(const uint4*)(a2 + sa32); ra2 = *(const uint4*)(a2 + 2 * sa32); ra3 = *(const uint4*)(a2 + 3 * sa32);
    rb0 = *(const uint4*)(b2); rb1 = *(const uint4*)(b2 + sb32); rb2 = *(const uint4*)(b2 + 2 * sb32); rb3 = *(const uint4*)(b2 + 3 * sb32);
  }
  __syncthreads();
  for (int kt = 0; kt < nk; ++kt) {
    const u16* cur = lds + (kt & 1) * (256 * 64);
    if (kt + 1 < nk) {
      u16* nxt = lds + ((kt + 1) & 1) * (256 * 64);
      u16* wa = nxt + woff; u16* wb = nxt + 128 * 64 + woff;
      *(uint4*)(wa) = ra0; *(uint4*)(wa + 32 * 64) = ra1; *(uint4*)(wa + 64 * 64) = ra2; *(uint4*)(wa + 96 * 64) = ra3;
      *(uint4*)(wb) = rb0; *(uint4*)(wb + 32 * 64) = rb1; *(uint4*)(wb + 64 * 64) = rb2; *(uint4*)(wb + 96 * 64) = rb3;
      if (kt + 2 < nk) {
        const u16* a2 = ap + (kt + 2) * 64; const u16* b2 = bp + (kt + 2) * 64;
        ra0 = *(const uint4*)(a2); ra1 = *(const uint4*)(a2 + sa32); ra2 = *(const uint4*)(a2 + 2 * sa32); ra3 = *(const uint4*)(a2 + 3 * sa32);
        rb0 = *(const uint4*)(b2); rb1 = *(const uint4*)(b2 + sb32); rb2 = *(const uint4*)(b2 + 2 * sb32); rb3 = *(const uint4*)(b2 + 3 * sb32);
      }
    }
    {
      const u16* pa0 = cur + fa0; const u16* pa1 = cur + fa1; const u16* pb0 = cur + fb0; const u16* pb1 = cur + fb1;
      bf16x8 a0 = *(const bf16x8*)(pa0), a1 = *(const bf16x8*)(pa0 + 16 * 64), a2 = *(const bf16x8*)(pa0 + 32 * 64), a3 = *(const bf16x8*)(pa0 + 48 * 64);
      bf16x8 b0 = *(const bf16x8*)(pb0), b1 = *(const bf16x8*)(pb0 + 16 * 64), b2 = *(const bf16x8*)(pb0 + 32 * 64), b3 = *(const bf16x8*)(pb0 + 48 * 64);
      bf16x8 c0 = *(const bf16x8*)(pa1), c1 = *(const bf16x8*)(pa1 + 16 * 64), c2 = *(const bf16x8*)(pa1 + 32 * 64), c3 = *(const bf16x8*)(pa1 + 48 * 64);
      bf16x8 d0 = *(const bf16x8*)(pb1), d1 = *(const bf16x8*)(pb1 + 16 * 64), d2 = *(const bf16x8*)(pb1 + 32 * 64), d3 = *(const bf16x8*)(pb1 + 48 * 64);
      __builtin_amdgcn_sched_barrier(0);
#define G128_MM(j, bj, x0, x1, x2, x3) do { \
        acc[0][j] = __builtin_amdgcn_mfma_f32_16x16x32_bf16(bj, x0, acc[0][j], 0, 0, 0); \
        acc[1][j] = __builtin_amdgcn_mfma_f32_16x16x32_bf16(bj, x1, acc[1][j], 0, 0, 0); \
        acc[2][j] = __builtin_amdgcn_mfma_f32_16x16x32_bf16(bj, x2, acc[2][j], 0, 0, 0); \
        acc[3][j] = __builtin_amdgcn_mfma_f32_16x16x32_bf16(bj, x3, acc[3][j], 0, 0, 0); } while (0)
      G128_MM(0, b0, a0, a1, a2, a3); G128_MM(1, b1, a0, a1, a2, a3); G128_MM(2, b2, a0, a1, a2, a3); G128_MM(3, b3, a0, a1, a2, a3);
      G128_MM(0, d0, c0, c1, c2, c3); G128_MM(1, d1, c0, c1, c2, c3); G128_MM(2, d2, c0, c1, c2, c3); G128_MM(3, d3, c0, c1, c2, c3);
    }
    __syncthreads();
  }
}
__device__ __forceinline__ uint2 pack4(f32x4 v) {
  uint2 o;
  o.x = (unsigned)f2bf(v[0]) | ((unsigned)f2bf(v[1]) << 16);
  o.y = (unsigned)f2bf(v[2]) | ((unsigned)f2bf(v[3]) << 16);
  return o;
}

__device__ __forceinline__ void gemm256(const u16* __restrict__ A, int lda, const u16* __restrict__ B, int ldb, int K,
                                        u16* lds, f32x4 (&acc)[8][4]) {
  const int tid = tid_l(), lane = tid & 63, w = tid >> 6, wm = w >> 1, wn = w & 1;
  const int r16 = lane & 15, g4 = lane >> 4;
#pragma unroll
  for (int i = 0; i < 8; ++i)
#pragma unroll
    for (int j = 0; j < 4; ++j) acc[i][j] = f32x4{0.f, 0.f, 0.f, 0.f};
  const int lrow = tid >> 2, lkc = tid & 3;
  const u16* ap = A + (size_t)lrow * lda + lkc * 8;
  const u16* bp = B + (size_t)lrow * ldb + lkc * 8;
  const size_t sa64 = (size_t)64 * lda, sb64 = (size_t)64 * ldb;
  const int woff = lrow * 32 + ((lkc ^ ((lrow >> 1) & 3)) * 8);
  const int fsw = (g4 ^ ((r16 >> 1) & 3)) * 8;
  const int faoff = (wm * 128 + r16) * 32 + fsw;
  const int fboff = 256 * 32 + (wn * 64 + r16) * 32 + fsw;
  const int nk = K >> 5;
  const int BUF = 384 * 32;
  uint4 xa0, xa1, xa2, xa3, xb0, xb1;
  uint4 ya0, ya1, ya2, ya3, yb0, yb1;
#define G256_LOAD(P, st) do { const u16* a2_ = ap + (st) * 32; const u16* b2_ = bp + (st) * 32; \
    P##a0 = *(const uint4*)(a2_); P##a1 = *(const uint4*)(a2_ + sa64); P##a2 = *(const uint4*)(a2_ + 2 * sa64); P##a3 = *(const uint4*)(a2_ + 3 * sa64); \
    P##b0 = *(const uint4*)(b2_); P##b1 = *(const uint4*)(b2_ + sb64); } while (0)
#define G256_STORE(P, buf) do { u16* wa_ = lds + (buf) * BUF + woff; u16* wb_ = wa_ + 256 * 32; \
    *(uint4*)(wa_) = P##a0; *(uint4*)(wa_ + 64 * 32) = P##a1; *(uint4*)(wa_ + 128 * 32) = P##a2; *(uint4*)(wa_ + 192 * 32) = P##a3; \
    *(uint4*)(wb_) = P##b0; *(uint4*)(wb_ + 64 * 32) = P##b1; } while (0)
#define G256_MM(i, af) do { \
      acc[i][0] = __builtin_amdgcn_mfma_f32_16x16x32_bf16(bf0, af, acc[i][0], 0, 0, 0); \
      acc[i][1] = __builtin_amdgcn_mfma_f32_16x16x32_bf16(bf1, af, acc[i][1], 0, 0, 0); \
      acc[i][2] = __builtin_amdgcn_mfma_f32_16x16x32_bf16(bf2, af, acc[i][2], 0, 0, 0); \
      acc[i][3] = __builtin_amdgcn_mfma_f32_16x16x32_bf16(bf3, af, acc[i][3], 0, 0, 0); } while (0)
#define G256_COMPUTE(buf) do { const u16* fa_ = lds + (buf) * BUF + faoff; const u16* fb_ = lds + (buf) * BUF + fboff; \
    bf16x8 bf0 = *(const bf16x8*)(fb_), bf1 = *(const bf16x8*)(fb_ + 16 * 32), bf2 = *(const bf16x8*)(fb_ + 32 * 32), bf3 = *(const bf16x8*)(fb_ + 48 * 32); \
    bf16x8 a0 = *(const bf16x8*)(fa_), a1 = *(const bf16x8*)(fa_ + 16 * 32), a2 = *(const bf16x8*)(fa_ + 32 * 32), a3 = *(const bf16x8*)(fa_ + 48 * 32); \
    __builtin_amdgcn_sched_barrier(0); __builtin_amdgcn_s_setprio(1); \
    G256_MM(0, a0); a0 = *(const bf16x8*)(fa_ + 64 * 32); __builtin_amdgcn_sched_barrier(0); \
    G256_MM(1, a1); a1 = *(const bf16x8*)(fa_ + 80 * 32); __builtin_amdgcn_sched_barrier(0); \
    G256_MM(2, a2); a2 = *(const bf16x8*)(fa_ + 96 * 32); __builtin_amdgcn_sched_barrier(0); \
    G256_MM(3, a3); a3 = *(const bf16x8*)(fa_ + 112 * 32); __builtin_amdgcn_sched_barrier(0); \
    G256_MM(4, a0); G256_MM(5, a1); G256_MM(6, a2); G256_MM(7, a3); __builtin_amdgcn_s_setprio(0); } while (0)
  G256_LOAD(x, 0);
  G256_LOAD(y, 1);
  __syncthreads();
  G256_STORE(x, 0);
  G256_LOAD(x, 2);
  __syncthreads();
  for (int kt = 0; kt < nk; kt += 2) {
    G256_STORE(y, 1);
    if (kt + 3 < nk) G256_LOAD(y, kt + 3);
    G256_COMPUTE(0);
    __syncthreads();
    if (kt + 2 < nk) {
      G256_STORE(x, 0);
      if (kt + 4 < nk) G256_LOAD(x, kt + 4);
    }
    G256_COMPUTE(1);
    __syncthreads();
  }
}
#define GEMM256_RC const int tde = tid_l(); const int rb = ((tde >> 6) >> 1) * 128 + (tde & 15), cb = ((tde >> 6) & 1) * 64 + ((tde & 63) >> 4) * 4;
#define GEMM_RC const int tde = tid_l(); const int rb = ((tde >> 6) >> 1) * 64 + (tde & 15), cb = ((tde >> 6) & 1) * 64 + ((tde & 63) >> 4) * 4;


__device__ __forceinline__ bool tile_at(int r, int Mt, int Nt, int& mt, int& nt) {
  const int x = blockIdx.x & 7, j = blockIdx.x >> 3, bpx = gridDim.x >> 3;
  const int mpx = Mt >> 3;
  const int q = r * bpx + j;
  if (q >= mpx * Nt) return false;
  const int full = (Nt >> 3) * (mpx * 8);
  int cb, rem, wcb;
  if (q < full) { cb = q / (mpx * 8); rem = q - cb * mpx * 8; wcb = 8; }
  else { cb = Nt >> 3; rem = q - full; wcb = Nt - cb * 8; }
  mt = x * mpx + rem / wcb;
  nt = cb * 8 + rem % wcb;
  return true;
}

__device__ __forceinline__ void phase_a(const Params& p, int l, u16* lds) {
  const u16* Bw = p.WinT + (size_t)l * 3072 * 1024;
  int mt, nt;
  for (int r = 0; tile_at(r, 144, 24, mt, nt); ++r) {
    const int m0 = mt * 256, n0 = nt * 128;
    f32x4 acc[8][4];
    gemm256(p.HQ + (size_t)m0 * 1024, 1024, Bw + (size_t)n0 * 1024, 1024, 1024, lds, acc);
    { GEMM256_RC
#pragma unroll
      for (int mi = 0; mi < 8; ++mi) {
        const int row = m0 + rb + mi * 16;
#pragma unroll
        for (int ni = 0; ni < 4; ++ni) {
          const int col = n0 + cb + ni * 16;
          *(uint2*)(p.P + (size_t)row * PW + col) = pack4(acc[mi][ni]);
          if (col >= P_GA && col < P_GA + 16)
            *(float4*)(p.GAB + (size_t)row * 16 + (col - P_GA)) = make_float4(acc[mi][ni][0], acc[mi][ni][1], acc[mi][ni][2], acc[mi][ni][3]);
        }
      }
    }
  }
}

__device__ __forceinline__ void phase_b1(const Params& p, int l, u16* lds) {
  int mt, nt;
  for (int pass = 0; pass < 2; ++pass) {
  for (int r = 0; tile_at(r, pass == 0 ? 288 : 304, pass == 0 ? 6 : 8, mt, nt); ++r) {
    if (pass == 0) {
      const int m0 = mt * 128, n0 = nt * 128;
      const float qscale = 0.07216878364870322f * 1.4426950408889634f;
      f32x4 acc[4][4];
      gemm128(p.P + (size_t)m0 * PW + P_MCQ, PW, p.WuqT + (size_t)l * 768 * 384 + (size_t)n0 * 384, 384, 384, lds, acc);
      { GEMM_RC
        const int g4 = (tde & 63) >> 4;
        const int cw0 = n0 + cb - g4 * 4;
        const bool ropew = ((cw0 >> 6) % 3) == 2 && m0 >= T_CTX;
#pragma unroll
        for (int mi = 0; mi < 4; ++mi) {
          const int row = m0 + rb + mi * 16;
          f32x4 v0 = acc[mi][0], v1 = acc[mi][1], v2 = acc[mi][2], v3 = acc[mi][3];
          if (ropew) {
            const int pos = (row - T_CTX) & 4095;
#pragma unroll
            for (int r = 0; r < 4; ++r) {
              const float inv = exp2f(-(float)(g4 * 4 + r) * (13.287712379549449f / 16.f));
              float s0, c0, s1, c1;
              __sincosf((float)(pos >> 6) * inv, &s0, &c0);
              __sincosf((float)(pos & 63) * inv, &s1, &c1);
              const float a0 = v0[r] * c0 - v1[r] * s0, a1 = v1[r] * c0 + v0[r] * s0;
              const float b0 = v2[r] * c1 - v3[r] * s1, b1 = v3[r] * c1 + v2[r] * s1;
              v0[r] = a0; v1[r] = a1; v2[r] = b0; v3[r] = b1;
            }
          }
          u16* qp = p.HQ + (size_t)row * 768 + n0 + cb;
          *(uint2*)(qp) = pack4(v0 * qscale); *(uint2*)(qp + 16) = pack4(v1 * qscale);
          *(uint2*)(qp + 32) = pack4(v2 * qscale); *(uint2*)(qp + 48) = pack4(v3 * qscale);
        }
      }
    } else {
      const int m0 = mt * 128, n0 = nt * 128;
      const u16* Ap; int lda;
      if (mt < 288) { Ap = p.P + (size_t)m0 * PW + P_MCKV; lda = PW; }
      else { Ap = p.CKVC + (size_t)(m0 - T_ALL) * 256; lda = 256; }
      f32x4 acc[4][4];
      gemm128(Ap, lda, p.WukvT + (size_t)l * 1024 * 256 + (size_t)n0 * 256, 256, 256, lds, acc);
      { GEMM_RC
#pragma unroll
        for (int mi = 0; mi < 4; ++mi) {
          const int row = m0 + rb + mi * 16;
          u16* vb; int vst;
          if (row < T_CTX) { int b = row >> 8, pos = row & 255; vb = p.VTC + (size_t)(b * 4) * 128 * 256 + pos; vst = 256; }
          else if (row < T_ALL) { int b = (row - T_CTX) >> 12, pos = (row - T_CTX) & 4095; vb = p.VTL + (size_t)(b * 4) * 128 * 4352 + pos; vst = 4352; }
          else { int b = (row - T_ALL) >> 8, pos = 4096 + ((row - T_ALL) & 255); vb = p.VTL + (size_t)(b * 4) * 128 * 4352 + pos; vst = 4352; }
#pragma unroll
          for (int ni = 0; ni < 4; ++ni) {
            const int col = n0 + cb + ni * 16;
            const int h = col >> 8, wi = col & 255;
            if (wi < 128) {
              *(uint2*)(p.KN + (size_t)row * 512 + h * 128 + wi) = pack4(acc[mi][ni]);
            } else {
              u16* dst = vb + (size_t)(h * 128 + (wi - 128)) * vst;
#pragma unroll
              for (int r = 0; r < 4; ++r) dst[(size_t)r * vst] = f2bf(acc[mi][ni][r]);
            }
          }
        }
      }
    }
  }
  }
}

__device__ __forceinline__ void phase_gemm_y(const u16* A, int lda, const u16* B, int K, int N, u16* Y, int ldy, u16* lds) {
  int mt, nt;
  for (int r = 0; tile_at(r, 288, N / 128, mt, nt); ++r) {
    const int m0 = mt * 128, n0 = nt * 128;
    f32x4 acc[4][4];
    gemm128(A + (size_t)m0 * lda, lda, B + (size_t)n0 * K, K, K, lds, acc);
    { GEMM_RC
#pragma unroll
      for (int mi = 0; mi < 4; ++mi)
#pragma unroll
        for (int ni = 0; ni < 4; ++ni)
          *(uint2*)(Y + (size_t)(m0 + rb + mi * 16) * ldy + n0 + cb + ni * 16) = pack4(acc[mi][ni]);
    }
  }
}

__device__ __forceinline__ void phase_e(const Params& p, int l, u16* lds) {
  const u16* Bw = p.WfiT + (size_t)l * 5632 * 1024;
  int mt, nt;
  for (int r = 0; tile_at(r, 144, 44, mt, nt); ++r) {
    const int m0 = mt * 256, n0 = nt * 128;
    f32x4 acc[8][4];
    gemm256(p.MIX + (size_t)m0 * 1024, 1024, Bw + (size_t)n0 * 1024, 1024, 1024, lds, acc);
    { GEMM256_RC
      const int g4x4 = ((tde & 63) >> 4) * 4;
      const int hc0 = ((n0 + cb - g4x4) >> 1) + g4x4;
#pragma unroll
      for (int mi = 0; mi < 8; ++mi)
#pragma unroll
        for (int ni = 0; ni < 2; ++ni) {
          f32x4 hv;
#pragma unroll
          for (int r = 0; r < 4; ++r) hv[r] = siluf_(acc[mi][ni][r]) * acc[mi][ni + 2][r];
          *(uint2*)(p.P + (size_t)(m0 + rb + mi * 16) * DFF + hc0 + ni * 16) = pack4(hv);
        }
    }
  }
}

#define KST 208
#define VST 80
#define PST 80
__device__ __forceinline__ void attn_item(const Params& p, int latent, int b, int h, int qb, unsigned char* smraw, int dummy = 0) {
  u16* sK = (u16*)smraw;
  u16* sV = sK + 64 * KST;
  u16* sP = sV + 128 * VST;
  const int tid = tid_l(), lane = tid & 63, w = tid >> 6, r16 = lane & 15, g4 = lane >> 4;
  const int nkeys = latent ? 4352 : 256;
  const int krow0 = latent ? T_CTX + b * 4096 : b * 256;
  const int tq0 = krow0 + qb * 128;
  const u16* vt = latent ? p.VTL + (size_t)((b * 4 + h) * 128) * 4352 : p.VTC + (size_t)((b * 4 + h) * 128) * 256;
  u16* sPw = sP + w * 32 * PST;
  bf16x8 q[2][6];
#pragma unroll
  for (int mi = 0; mi < 2; ++mi)
#pragma unroll
    for (int ks = 0; ks < 6; ++ks)
      q[mi][ks] = *(const bf16x8*)(p.HQ + (size_t)(tq0 + w * 32 + mi * 16 + r16) * 768 + h * 192 + ks * 32 + g4 * 8);
  f32x4 o[2][8];
  float mrow[2], lrow[2];
#pragma unroll
  for (int mi = 0; mi < 2; ++mi) {
#pragma unroll
    for (int nd = 0; nd < 8; ++nd) o[mi][nd] = f32x4{0.f, 0.f, 0.f, 0.f};
    mrow[mi] = -1e30f; lrow[mi] = 0.f;
  }
  const int lkey = tid >> 2, lpart = tid & 3;
  const int ldv = tid >> 1, lhalf = tid & 1;
  const int ntile = nkeys >> 6;
  uint4 k0, k1, k2, k3, k4, k5;
  {
    const int pos = lkey;
    const u16* srcn = p.KN + (size_t)(krow0 + pos) * 512 + h * 128 + lpart * 8;
    const u16* srcr = p.P + (size_t)(krow0 + pos) * PW + P_MKR + lpart * 8;
    k0 = *(const uint4*)(srcn); k1 = *(const uint4*)(srcn + 32); k2 = *(const uint4*)(srcn + 64); k3 = *(const uint4*)(srcn + 96);
    k4 = *(const uint4*)(srcr); k5 = *(const uint4*)(srcr + 32);
  }
  for (int kt = 0; kt < ntile; ++kt) {
    __syncthreads();
    {
      u16* dk = sK + lkey * KST + lpart * 8;
      *(uint4*)(dk) = k0; *(uint4*)(dk + 32) = k1; *(uint4*)(dk + 64) = k2; *(uint4*)(dk + 96) = k3;
      *(uint4*)(dk + 128) = k4; *(uint4*)(dk + 160) = k5;
    }
    const u16* sv = vt + (size_t)ldv * nkeys + kt * 64 + lhalf * 32;
    const uint4 v0 = *(const uint4*)(sv), v1 = *(const uint4*)(sv + 8), v2 = *(const uint4*)(sv + 16), v3 = *(const uint4*)(sv + 24);
    __syncthreads();
    f32x4 s[2][4];
#pragma unroll
    for (int mi = 0; mi < 2; ++mi)
#pragma unroll
      for (int ni = 0; ni < 4; ++ni) s[mi][ni] = f32x4{0.f, 0.f, 0.f, 0.f};
#pragma unroll
    for (int ks = 0; ks < 6; ++ks)
#pragma unroll
      for (int ni = 0; ni < 4; ++ni) {
        bf16x8 kf = *(const bf16x8*)(sK + (ni * 16 + r16) * KST + ks * 32 + g4 * 8);
        s[0][ni] = __builtin_amdgcn_mfma_f32_16x16x32_bf16(kf, q[0][ks], s[0][ni], 0, 0, 0);
        s[1][ni] = __builtin_amdgcn_mfma_f32_16x16x32_bf16(kf, q[1][ks], s[1][ni], 0, 0, 0);
      }
#pragma unroll
    for (int mi = 0; mi < 2; ++mi) {
      float mx = -1e30f;
#pragma unroll
      for (int ni = 0; ni < 4; ++ni)
#pragma unroll
        for (int r = 0; r < 4; ++r) mx = fmaxf(mx, s[mi][ni][r]);
      mx = fmaxf(mx, __shfl_xor(mx, 16)); mx = fmaxf(mx, __shfl_xor(mx, 32));
      const float mnew = fmaxf(mrow[mi], mx);
      const float alpha = __builtin_amdgcn_exp2f(mrow[mi] - mnew);
      mrow[mi] = mnew;
      float ps = 0.f;
#pragma unroll
      for (int ni = 0; ni < 4; ++ni) {
        f32x4 pv;
#pragma unroll
        for (int r = 0; r < 4; ++r) { pv[r] = __builtin_amdgcn_exp2f(s[mi][ni][r] - mnew); ps += pv[r]; }
        *(uint2*)(sPw + (mi * 16 + r16) * PST + ni * 16 + g4 * 4) = pack4(pv);
      }
      ps += __shfl_xor(ps, 16); ps += __shfl_xor(ps, 32);
      lrow[mi] = lrow[mi] * alpha + ps;
#pragma unroll
      for (int nd = 0; nd < 8; ++nd) o[mi][nd] *= alpha;
    }
    {
      u16* dvp = sV + ldv * VST + lhalf * 32;
      *(uint4*)(dvp) = v0; *(uint4*)(dvp + 8) = v1; *(uint4*)(dvp + 16) = v2; *(uint4*)(dvp + 24) = v3;
    }
    __syncthreads();
    if (kt + 1 < ntile) {
      const int pos = (kt + 1) * 64 + lkey;
      const bool own = (!latent) || pos < 4096;
      const int row = own ? krow0 + pos : T_ALL + b * 256 + (pos - 4096);
      const u16* srcn = p.KN + (size_t)row * 512 + h * 128 + lpart * 8;
      const u16* srcr = own ? p.P + (size_t)(krow0 + pos) * PW + P_MKR + lpart * 8
                            : p.KRC + (size_t)(b * 256 + pos - 4096) * 64 + lpart * 8;
      k0 = *(const uint4*)(srcn); k1 = *(const uint4*)(srcn + 32); k2 = *(const uint4*)(srcn + 64); k3 = *(const uint4*)(srcn + 96);
      k4 = *(const uint4*)(srcr); k5 = *(const uint4*)(srcr + 32);
    }
#pragma unroll
    for (int ks2 = 0; ks2 < 2; ++ks2) {
      bf16x8 pf0 = *(const bf16x8*)(sPw + (0 * 16 + r16) * PST + ks2 * 32 + g4 * 8);
      bf16x8 pf1 = *(const bf16x8*)(sPw + (1 * 16 + r16) * PST + ks2 * 32 + g4 * 8);
#pragma unroll
      for (int nd = 0; nd < 8; ++nd) {
        bf16x8 vf = *(const bf16x8*)(sV + (nd * 16 + r16) * VST + ks2 * 32 + g4 * 8);
        o[0][nd] = __builtin_amdgcn_mfma_f32_16x16x32_bf16(vf, pf0, o[0][nd], 0, 0, 0);
        o[1][nd] = __builtin_amdgcn_mfma_f32_16x16x32_bf16(vf, pf1, o[1][nd], 0, 0, 0);
      }
    }
  }
#pragma unroll
  for (int mi = 0; mi < 2; ++mi) {
    const float inv = 1.f / lrow[mi];
    const int qrow = tq0 + w * 32 + mi * 16 + r16;
    u16* op = p.HQ + (size_t)qrow * 768 + h * 192 + g4 * 4;
    if (dummy) op = p.HQ + (size_t)T_ALL * 768 + (size_t)(qrow % 9216) * 768 + h * 192 + g4 * 4;
#pragma unroll
    for (int nd = 0; nd < 8; ++nd) *(uint2*)(op + nd * 16) = pack4(o[mi][nd] * inv);
  }
}

#define XB_TMO      128
#define XB_XCNT(j)  (256  + 64 * (j))
#define XB_XSUB(j)  (1280 + 64 * (j))
#define XB_XGEN(j)  (2304 + 64 * (j))
#define XB_TOP      3328
#define XB_TOPGEN   3392
#define XCD_BAR_WORDS 3456
#define XB_SPIN_CAP (1u << 23)
#define LAS __attribute__((address_space(3)))

__device__ __forceinline__ unsigned xb_ld(unsigned* p)              { return __hip_atomic_load(p, __ATOMIC_RELAXED, __HIP_MEMORY_SCOPE_AGENT); }
__device__ __forceinline__ unsigned xb_add(unsigned* p, unsigned v) { return __hip_atomic_fetch_add(p, v, __ATOMIC_RELAXED, __HIP_MEMORY_SCOPE_AGENT); }
__device__ __forceinline__ unsigned xb_xcc_id() { return (unsigned)__builtin_amdgcn_s_getreg((3 << 11) | 20) & 0xFu; }
#define XB_SPIN(cond, bar) do { unsigned _sp = 0; while (cond) { __builtin_amdgcn_s_sleep(1); \
    if ((++_sp & 255u) == 0u) { if (xb_ld(&(bar)[XB_TMO])) break; if (_sp > XB_SPIN_CAP) { atomicAdd(&(bar)[XB_TMO], 1u); break; } } } } while (0)

struct XcdBarrier {
    unsigned* bar; unsigned x;
    volatile LAS unsigned* st;
};

__device__ __forceinline__ XcdBarrier xcd_barrier_post(unsigned* bar, volatile LAS unsigned* st) {
    XcdBarrier b; b.bar = bar; b.x = xb_xcc_id(); b.st = st;
    if (threadIdx.x == 0) (void)xb_add(&bar[XB_XCNT(b.x)], 1u);
    return b;
}
__device__ __forceinline__ void xcd_barrier_complete(unsigned* bar, unsigned x, unsigned& nloc, unsigned& nx) {
    const unsigned G = gridDim.x * gridDim.y * gridDim.z;
    unsigned sum, cnt, mine, sp = 0u;
    for (;;) {
        sum = 0u; cnt = 0u; mine = 0u;
#pragma unroll
        for (unsigned j = 0; j < 16; ++j) { const unsigned c = xb_ld(&bar[XB_XCNT(j)]); sum += c; cnt += (c > 0u) ? 1u : 0u; mine = (j == x) ? c : mine; }
        if (sum == G) break;
        __builtin_amdgcn_s_sleep(1);
        if ((++sp & 255u) == 0u) { if (xb_ld(&bar[XB_TMO])) break; if (sp > XB_SPIN_CAP) { atomicAdd(&bar[XB_TMO], 1u); break; } }
    }
    nloc = mine > 0u ? mine : 1u; nx = cnt > 0u ? cnt : 1u;
}

__device__ __forceinline__ void xcd_barrier(const XcdBarrier& b) {
    asm volatile("s_waitcnt vmcnt(0)" ::: "memory");
    __syncthreads();
    if (threadIdx.x == 0) {
        unsigned* bar = b.bar;
        __builtin_amdgcn_s_waitcnt(0);
        unsigned nloc = b.st[0], nx = b.st[1];
        if (nloc == 0u) { xcd_barrier_complete(bar, b.x, nloc, nx); b.st[0] = nloc; b.st[1] = nx; }
        const unsigned old = xb_add(&bar[XB_XSUB(b.x)], 1u);
        const unsigned gen = old / nloc;
        if (old + 1u == (gen + 1u) * nloc) {
            __builtin_amdgcn_fence(__ATOMIC_RELEASE, "agent");
            asm volatile("s_waitcnt vmcnt(0)" ::: "memory");
            const unsigned og = xb_add(&bar[XB_TOP], 1u);
            const unsigned tg = og / nx;
            if (og + 1u == (tg + 1u) * nx) xb_add(&bar[XB_TOPGEN], 1u);
            else XB_SPIN(xb_ld(&bar[XB_TOPGEN]) == tg, bar);
            __builtin_amdgcn_fence(__ATOMIC_ACQUIRE, "agent");
            xb_add(&bar[XB_XGEN(b.x)], 1u);
            asm volatile("s_waitcnt vmcnt(0)" ::: "memory");
        } else {
            XB_SPIN(xb_ld(&bar[XB_XGEN(b.x)]) == gen, bar);
            __builtin_amdgcn_fence(__ATOMIC_ACQUIRE, "agent");
            asm volatile("s_waitcnt vmcnt(0)" ::: "memory");
        }
    }
    __syncthreads();
}


__device__ __forceinline__ void gbar(unsigned* ctr, unsigned target) {
  asm volatile("s_waitcnt vmcnt(0)" ::: "memory");
  __syncthreads();
  if (tid_l() == 0) {
    __builtin_amdgcn_fence(__ATOMIC_RELEASE, "agent");
    asm volatile("s_waitcnt vmcnt(0)" ::: "memory");
    __hip_atomic_fetch_add(ctr, 1u, __ATOMIC_RELAXED, __HIP_MEMORY_SCOPE_AGENT);
    while (__hip_atomic_load(ctr, __ATOMIC_RELAXED, __HIP_MEMORY_SCOPE_AGENT) < target) __builtin_amdgcn_s_sleep(2);
    __builtin_amdgcn_fence(__ATOMIC_ACQUIRE, "agent");
    asm volatile("s_waitcnt vmcnt(0)" ::: "memory");
  }
  __syncthreads();
}
#define MFMA4(a, b, c) __builtin_amdgcn_mfma_f32_16x16x4f32((a), (b), (c), 0, 0, 0)

__device__ __forceinline__ float softplusf_(float x) { return fmaxf(x, 0.f) + log1pf(__expf(-fabsf(x))); }

__device__ __forceinline__ void gdn_chain(const Params& p, int l, int seq, int h, int d, int vs, float* sm) {
  float* sMM = sm;
  float* sK = sMM + 64 * 68;
  float* sW = sK + 64 * 65;
  float* sV = sW + 64 * 65;
  float* sS = sV + 64 * 33;
  float* sGc = sS + 64 * 33;
  float* sBeta = sGc + 64;
  float* sBg = sBeta + 64;
  const int tid = tid_l(), lane = tid & 63, w = tid >> 6, r16 = lane & 15, g4 = lane >> 4;
  const bool latent = seq >= 16;
  const int len = latent ? 4096 : 256;
  const int t0 = latent ? T_CTX + (seq - 16) * 4096 : seq * 256;
  const int nchunks = len >> 6;
  const float Acoef = -__expf(p.gdn_a_log[l * 8 + d * 4 + h]);
  const float dtb = p.gdn_dt_bias[l * 8 + d * 4 + h];
  f32x4 Sreg[2];
  __syncthreads();
  {
    const float* s0 = latent ? p.state_gdn + ((((size_t)(seq - 16) * 2 + l) * 2 + d) * 4 + h) * 4096 : nullptr;
#pragma unroll
    for (int n = 0; n < 2; ++n)
#pragma unroll
      for (int r = 0; r < 4; ++r) {
        const int kidx = 16 * w + g4 * 4 + r, cc = n * 16 + r16;
        float v = latent ? s0[kidx * 64 + vs * 32 + cc] : 0.f;
        Sreg[n][r] = v;
        sS[kidx * 33 + cc] = v;
      }
  }
  const u16* Pb = p.P + (size_t)t0 * PW;
  const u16* VHb = p.HQ + (size_t)T_ALL * 768 + (size_t)t0 * 256;
#define GDN_SRC(i, tl, tlo_) ({ const int e_ = (tl) + (i) * 256; const int u_ = e_ / 20, un_ = e_ % 20; \
    (un_ < 16) ? (Pb + (size_t)((tlo_) + u_) * PW + (un_ < 8 ? P_QH + h * 64 + un_ * 8 : P_KH + h * 64 + (un_ - 8) * 8)) \
               : (VHb + (size_t)((tlo_) + u_) * 256 + h * 64 + vs * 32 + (un_ - 16) * 8); })
  uint4 pf[5];
  float pga = 0.f, pgb = 0.f;
  {
    const int tlo = d == 0 ? 0 : len - 64;
#pragma unroll
    for (int i = 0; i < 5; ++i) pf[i] = *(const uint4*)GDN_SRC(i, tid, tlo);
    if (tid < 64) {
      const int u = d == 0 ? tid : 63 - tid;
      const float* gab = p.GAB + (size_t)(t0 + tlo + u) * 16;
      pga = gab[d * 4 + h]; pgb = gab[8 + d * 4 + h];
    }
  }
  for (int n = 0; n < nchunks; ++n) {
    const int tlo = d == 0 ? n * 64 : len - 64 * (n + 1);
    const int tl2 = tid_l();
#pragma unroll
    for (int i = 0; i < 5; ++i) {
      const int e = tl2 + i * 256;
      const int u = e / 20, un = e % 20;
      const int pp = d == 0 ? u : 63 - u;
      float* dq = un < 8 ? sW + pp * 65 + un * 8 : (un < 16 ? sK + pp * 65 + (un - 8) * 8 : sV + pp * 33 + (un - 16) * 8);
      const unsigned wv[4] = {pf[i].x, pf[i].y, pf[i].z, pf[i].w};
#pragma unroll
      for (int j = 0; j < 4; ++j) { dq[2 * j] = bf2f((u16)(wv[j] & 0xffff)); dq[2 * j + 1] = bf2f((u16)(wv[j] >> 16)); }
    }
    if (tid < 64) {
      const int pp = tid;
      float g = Acoef * softplusf_(pga + dtb);
      float bt = sigmoidf_(pgb);
#pragma unroll
      for (int o = 1; o < 64; o <<= 1) { float tt = __shfl_up(g, o); if (lane >= o) g += tt; }
      sGc[pp] = g; sBeta[pp] = bt; sBg[pp] = bt * __expf(g);
    }
    if (n + 1 < nchunks) {
      const int tlo2 = d == 0 ? (n + 1) * 64 : len - 64 * (n + 2);
#pragma unroll
      for (int i = 0; i < 5; ++i) pf[i] = *(const uint4*)GDN_SRC(i, tl2, tlo2);
      if (tid < 64) {
        const int u = d == 0 ? tid : 63 - tid;
        const float* gab = p.GAB + (size_t)(t0 + tlo2 + u) * 16;
        pga = gab[d * 4 + h]; pgb = gab[8 + d * 4 + h];
      }
    }
    __syncthreads();
    float qa[16];
#pragma unroll
    for (int s = 0; s < 16; ++s) qa[s] = sW[(16 * w + r16) * 65 + 4 * s + g4];
    const unsigned tcode = w == 0 ? 0x730u : (w == 1 ? 0xA51u : (w == 2 ? 0x062u : 0x0FBu));
    const int tcnt = w < 2 ? 3 : 2;
    f32x4 attacc[3];
#pragma unroll
    for (int t = 0; t < 3; ++t) {
      attacc[t] = f32x4{0.f, 0.f, 0.f, 0.f};
      if (t < tcnt) {
        const int ti = (tcode >> (4 * t)) & 3, tn = (tcode >> (4 * t + 2)) & 3;
        f32x4 accm = f32x4{0.f, 0.f, 0.f, 0.f};
        const float* ak = sK + (16 * ti + r16) * 65 + g4;
        const float* aq = sW + (16 * ti + r16) * 65 + g4;
        const float* bk = sK + (16 * tn + r16) * 65 + g4;
#pragma unroll
        for (int s = 0; s < 16; ++s) {
          const float bv = bk[4 * s];
          accm = MFMA4(ak[4 * s], bv, accm);
          attacc[t] = MFMA4(aq[4 * s], bv, attacc[t]);
        }
#pragma unroll
        for (int r = 0; r < 4; ++r) {
          const int i = 16 * ti + g4 * 4 + r, j = 16 * tn + r16;
          sMM[i * 68 + j] = (i > j) ? sBeta[i] * accm[r] * __expf(sGc[i] - sGc[j]) : 0.f;
        }
      }
    }
    __syncthreads();
    if (w == 0) {
      const int bi = tid >> 4, c = tid & 15;
      float* md = sMM + (16 * bi) * 68 + 16 * bi;
      float a[16];
#pragma unroll
      for (int r = 0; r < 16; ++r) a[r] = (r == c) ? 1.f : 0.f;
#pragma unroll
      for (int r = 1; r < 16; ++r) {
#pragma unroll
        for (int q4 = 0; q4 < (r + 3) / 4; ++q4) {
          const float4 m = *(const float4*)(md + r * 68 + 4 * q4);
          if (q4 * 4 + 0 < r) a[r] -= m.x * a[q4 * 4 + 0];
          if (q4 * 4 + 1 < r) a[r] -= m.y * a[q4 * 4 + 1];
          if (q4 * 4 + 2 < r) a[r] -= m.z * a[q4 * 4 + 2];
          if (q4 * 4 + 3 < r) a[r] -= m.w * a[q4 * 4 + 3];
        }
      }
      __builtin_amdgcn_fence(__ATOMIC_SEQ_CST, "wavefront");
#pragma unroll
      for (int r = 0; r < 16; ++r) md[r * 68 + c] = a[r];
    } else {
      for (int t = w - 1; t < 8; t += 3) {
        const int ti = t >> 1, tc = t & 1;
        const float bg = sBg[16 * ti + r16];
        const float* ak = sK + (16 * ti + r16) * 65 + g4;
        const float* bs = sS + g4 * 33 + 16 * tc + r16;
        f32x4 acc = f32x4{0.f, 0.f, 0.f, 0.f};
#pragma unroll
        for (int s = 0; s < 16; ++s) acc = MFMA4(ak[4 * s] * bg, bs[4 * s * 33], acc);
#pragma unroll
        for (int r = 0; r < 4; ++r) {
          const int i = 16 * ti + g4 * 4 + r, cc = 16 * tc + r16;
          sV[i * 33 + cc] = sV[i * 33 + cc] * sBeta[i] - acc[r];
        }
      }
    }
    __syncthreads();
    for (int ib = 0; ib < 4; ++ib) {
      if (w < 2) {
        const int ct = w;
        f32x4 acc = f32x4{0.f, 0.f, 0.f, 0.f};
        const float* am = sMM + (16 * ib + r16) * 68 + g4;
        const float* bx = sV + g4 * 33 + 16 * ct + r16;
        for (int s4 = 0; s4 < ib; ++s4) {
#pragma unroll
          for (int s = 0; s < 4; ++s) acc = MFMA4(am[16 * s4 + 4 * s], bx[(16 * s4 + 4 * s) * 33], acc);
        }
        f32x4 rm;
#pragma unroll
        for (int r = 0; r < 4; ++r) rm[r] = sV[(16 * ib + g4 * 4 + r) * 33 + 16 * ct + r16] - acc[r];
        const float* dd = sMM + (16 * ib + r16) * 68 + 16 * ib + 4 * g4;
        f32x4 xn = f32x4{0.f, 0.f, 0.f, 0.f};
#pragma unroll
        for (int s = 0; s < 4; ++s) xn = MFMA4(dd[s], rm[s], xn);
#pragma unroll
        for (int r = 0; r < 4; ++r) sV[(16 * ib + g4 * 4 + r) * 33 + 16 * ct + r16] = xn[r];
      }
      __syncthreads();
    }
#pragma unroll
    for (int t = 0; t < 3; ++t) {
      if (t < tcnt) {
        const int ti = (tcode >> (4 * t)) & 3, tn = (tcode >> (4 * t + 2)) & 3;
#pragma unroll
        for (int r = 0; r < 4; ++r) {
          const int i = 16 * ti + g4 * 4 + r, j = 16 * tn + r16;
          sMM[i * 68 + j] = (i >= j) ? attacc[t][r] * __expf(sGc[i] - sGc[j]) : 0.f;
        }
      }
    }
    __syncthreads();
    {
      f32x4 acc[2] = {f32x4{0.f, 0.f, 0.f, 0.f}, f32x4{0.f, 0.f, 0.f, 0.f}};
      const float eg = __expf(sGc[16 * w + r16]);
#pragma unroll
      for (int s = 0; s < 16; ++s) {
        const float a = qa[s] * eg;
        acc[0] = MFMA4(sS[(4 * s + g4) * 33 + r16], a, acc[0]);
        acc[1] = MFMA4(sS[(4 * s + g4) * 33 + 16 + r16], a, acc[1]);
      }
#pragma unroll
      for (int s = 0; s < 16; ++s) {
        if (s < 4 * (w + 1)) {
          const float a = sMM[(16 * w + r16) * 68 + 4 * s + g4];
          acc[0] = MFMA4(sV[(4 * s + g4) * 33 + r16], a, acc[0]);
          acc[1] = MFMA4(sV[(4 * s + g4) * 33 + 16 + r16], a, acc[1]);
        }
      }
      {
        const int pp = 16 * w + r16;
        const int u = d == 0 ? pp : 63 - pp;
        u16* op = p.MIX + (size_t)(t0 + tlo + u) * 1024 + d * 256 + h * 64 + vs * 32 + g4 * 4;
        *(uint2*)(op) = pack4(acc[0]);
        *(uint2*)(op + 16) = pack4(acc[1]);
      }
    }
    __syncthreads();
    {
      const float g63 = sGc[63];
      const float gl = __expf(g63);
#pragma unroll
      for (int nn = 0; nn < 2; ++nn)
#pragma unroll
        for (int r = 0; r < 4; ++r) Sreg[nn][r] *= gl;
#pragma unroll
      for (int s = 0; s < 16; ++s) {
        const int srow = 4 * s + g4;
        const float a = sK[srow * 65 + 16 * w + r16] * __expf(g63 - sGc[srow]);
        Sreg[0] = MFMA4(a, sV[srow * 33 + r16], Sreg[0]);
        Sreg[1] = MFMA4(a, sV[srow * 33 + 16 + r16], Sreg[1]);
      }
    }
    __syncthreads();
#pragma unroll
    for (int nn = 0; nn < 2; ++nn)
#pragma unroll
      for (int r = 0; r < 4; ++r) sS[(16 * w + g4 * 4 + r) * 33 + nn * 16 + r16] = Sreg[nn][r];
    __syncthreads();
  }
  if (!latent) {
    float* so = p.out + OUT_SGDN + ((((size_t)seq * 2 + l) * 2 + d) * 4 + h) * 4096;
#pragma unroll
    for (int nn = 0; nn < 2; ++nn)
#pragma unroll
      for (int r = 0; r < 4; ++r) so[(16 * w + g4 * 4 + r) * 64 + vs * 32 + nn * 16 + r16] = Sreg[nn][r];
  }
}

__device__ __forceinline__ void hgrn_chain(const Params& p, int l, int seq, int h, int d, int vs, float* sm) {
  float* sBC = sm;
  float* sK = sBC + 64 * 65;
  float* sAT = sK + 64 * 65;
  float* sV = sAT + 64 * 68;
  float* sS = sV + 64 * 33;
  float* sTot = sS + 64 * 33;
  const int tid = tid_l(), lane = tid & 63, w = tid >> 6, r16 = lane & 15, g4 = lane >> 4;
  const bool latent = seq >= 16;
  const int len = latent ? 4096 : 256;
  const int t0 = latent ? T_CTX + (seq - 16) * 4096 : seq * 256;
  const int nchunks = len >> 6;
  float lbk;
  {
    const int kch = h * 64 + (tid & 63);
    lbk = (l == 0) ? 0.f : sigmoidf_(p.hgrn_lb[256 + kch] - p.hgrn_lb[kch]);
  }
  f32x4 Sreg[2];
  __syncthreads();
  {
    const float* s0 = latent ? p.state_hgrn + ((((size_t)(seq - 16) * 2 + l) * 2 + d) * 4 + h) * 4096 : nullptr;
#pragma unroll
    for (int n = 0; n < 2; ++n)
#pragma unroll
      for (int r = 0; r < 4; ++r) {
        const int kidx = 16 * w + g4 * 4 + r, cc = n * 16 + r16;
        float v = latent ? s0[kidx * 64 + vs * 32 + cc] : 0.f;
        Sreg[n][r] = v;
        sS[kidx * 33 + cc] = v;
      }
  }
  const u16* Pb = p.P + (size_t)t0 * PW;
  float* sLb = sTot + 256;
  if (tid < 64) sLb[tid] = lbk;
  __syncthreads();
  int pgo[5];
#pragma unroll
  for (int i = 0; i < 5; ++i) {
    const int e = tid + i * 256;
    const int u = e / 20, un = e % 20;
    pgo[i] = u * PW + (un < 8 ? P_HF + d * 256 + h * 64 + un * 8 : (un < 12 ? P_HI + h * 64 + vs * 32 + (un - 8) * 8 : P_HQ + h * 64 + (un - 12) * 8));
  }
  uint4 pf[5];
  {
    const int tlo = d == 0 ? 0 : len - 64;
#pragma unroll
    for (int i = 0; i < 5; ++i) pf[i] = *(const uint4*)(Pb + (size_t)tlo * PW + pgo[i]);
  }
  for (int n = 0; n < nchunks; ++n) {
#pragma unroll
    for (int i = 0; i < 5; ++i) {
      const int e = tid + i * 256;
      const int u = e / 20, un = e % 20;
      const int pp = d == 0 ? u : 63 - u;
      const unsigned wv[4] = {pf[i].x, pf[i].y, pf[i].z, pf[i].w};
#pragma unroll
      for (int j = 0; j < 8; ++j) {
        const float x = bf2f((u16)((wv[j >> 1] >> ((j & 1) * 16)) & 0xffff));
        if (un < 8) {
          const int k = un * 8 + j;
          const float lb = sLb[k];
          const float sg_ = sigmoidf_(x);
          const float gate = lb + (1.f - lb) * sg_;
          sBC[pp * 65 + k] = __logf(fmaxf(gate, 1e-30f));
          sK[pp * 65 + k] = (1.f - lb) * (1.f - sg_);
        } else if (un < 12) {
          sV[pp * 33 + (un - 8) * 8 + j] = x;
        } else {
          sAT[pp * 68 + (un - 12) * 8 + j] = x;
        }
      }
    }
    __syncthreads();
    if (n + 1 < nchunks) {
      const int tlo2 = d == 0 ? (n + 1) * 64 : len - 64 * (n + 2);
#pragma unroll
      for (int i = 0; i < 5; ++i) pf[i] = *(const uint4*)(Pb + (size_t)tlo2 * PW + pgo[i]);
    }
    const int tlo = d == 0 ? n * 64 : len - 64 * (n + 1);
    float cs[16];
    {
      const int k = tid & 63, sg = tid >> 6;
      float run = 0.f;
#pragma unroll
      for (int i = 0; i < 16; ++i) { run += sBC[(16 * sg + i) * 65 + k]; cs[i] = run; }
      sTot[sg * 64 + k] = run;
    }
    float qa[16];
#pragma unroll
    for (int s = 0; s < 16; ++s) qa[s] = sAT[(16 * w + r16) * 68 + 4 * s + g4];
    __syncthreads();
    {
      const int k = tid & 63, sg = tid >> 6;
      float off = 0.f;
      for (int s2 = 0; s2 < sg; ++s2) off += sTot[s2 * 64 + k];
#pragma unroll
      for (int i = 0; i < 16; ++i) sBC[(16 * sg + i) * 65 + k] = cs[i] + off;
    }
    __syncthreads();
    {
      float aq[16], rf[16];
#pragma unroll
      for (int s = 0; s < 16; ++s) {
        const int kk = 4 * s + g4;
        rf[s] = (w == 0) ? 0.f : sBC[(16 * w - 1) * 65 + kk];
        aq[s] = qa[s] * __expf(sBC[(16 * w + r16) * 65 + kk] - rf[s]);
      }
#pragma unroll
      for (int nn = 0; nn < 4; ++nn) {
        f32x4 acc = f32x4{0.f, 0.f, 0.f, 0.f};
        if (nn <= w) {
#pragma unroll
          for (int s = 0; s < 16; ++s) {
            const int kk = 4 * s + g4, sc = 16 * nn + r16;
            const float bv = sK[sc * 65 + kk] * __expf(fminf(rf[s] - sBC[sc * 65 + kk], 80.f));
            acc = MFMA4(aq[s], bv, acc);
          }
        }
#pragma unroll
        for (int r = 0; r < 4; ++r) {
          const int i = 16 * w + g4 * 4 + r, j = 16 * nn + r16;
          sAT[i * 68 + j] = (i >= j) ? acc[r] : 0.f;
        }
      }
    }
    __syncthreads();
    {
      f32x4 acc[2] = {f32x4{0.f, 0.f, 0.f, 0.f}, f32x4{0.f, 0.f, 0.f, 0.f}};
#pragma unroll
      for (int s = 0; s < 16; ++s) {
        const int kk = 4 * s + g4;
        const float a = qa[s] * __expf(sBC[(16 * w + r16) * 65 + kk]);
        acc[0] = MFMA4(sS[kk * 33 + r16], a, acc[0]);
        acc[1] = MFMA4(sS[kk * 33 + 16 + r16], a, acc[1]);
      }
#pragma unroll
      for (int s = 0; s < 16; ++s) {
        if (s < 4 * (w + 1)) {
          const float a = sAT[(16 * w + r16) * 68 + 4 * s + g4];
          acc[0] = MFMA4(sV[(4 * s + g4) * 33 + r16], a, acc[0]);
          acc[1] = MFMA4(sV[(4 * s + g4) * 33 + 16 + r16], a, acc[1]);
        }
      }
      {
        const int pp = 16 * w + r16;
        const int u = d == 0 ? pp : 63 - pp;
        u16* op = p.MIX + (size_t)(t0 + tlo + u) * 1024 + 512 + d * 256 + h * 64 + vs * 32 + g4 * 4;
        *(uint2*)(op) = pack4(acc[0]);
        *(uint2*)(op + 16) = pack4(acc[1]);
      }
    }
    __syncthreads();
    {
#pragma unroll
      for (int nn = 0; nn < 2; ++nn)
#pragma unroll
        for (int r = 0; r < 4; ++r) Sreg[nn][r] *= __expf(sBC[63 * 65 + 16 * w + g4 * 4 + r]);
      const int kA = 16 * w + r16;
      const float blA = sBC[63 * 65 + kA];
#pragma unroll
      for (int s = 0; s < 16; ++s) {
        const int srow = 4 * s + g4;
        const float a = sK[srow * 65 + kA] * __expf(blA - sBC[srow * 65 + kA]);
        Sreg[0] = MFMA4(a, sV[srow * 33 + r16], Sreg[0]);
        Sreg[1] = MFMA4(a, sV[srow * 33 + 16 + r16], Sreg[1]);
      }
    }
    __syncthreads();
#pragma unroll
    for (int nn = 0; nn < 2; ++nn)
#pragma unroll
      for (int r = 0; r < 4; ++r) sS[(16 * w + g4 * 4 + r) * 33 + nn * 16 + r16] = Sreg[nn][r];
    __syncthreads();
  }
  if (!latent) {
    float* so = p.out + OUT_SHG + ((((size_t)seq * 2 + l) * 2 + d) * 4 + h) * 4096;
#pragma unroll
    for (int nn = 0; nn < 2; ++nn)
#pragma unroll
      for (int r = 0; r < 4; ++r) so[(16 * w + g4 * 4 + r) * 64 + vs * 32 + nn * 16 + r16] = Sreg[nn][r];
  }
}

__device__ __forceinline__ void phase_c(const Params& p, int l, unsigned char* smraw, int mode = 0) {
  __shared__ int s_item;
  const int total = 1920;
  for (;;) {
    __syncthreads();
    if (tid_l() == 0) s_item = (int)atomicAdd(&p.counters[l * 64 + mode * 16], 1u);
    __syncthreads();
    const int item = s_item;
    if (item >= total) break;
    int kind, a0, a1, a2, a3;
    if (item < 256 || (item >= 1280 && item < 1792)) {
      const int i2 = item < 256 ? item : item - 1280;
      const int rest = i2 >> 1;
      kind = i2 & 1;
      a3 = rest & 1; a2 = (rest >> 1) & 1; a1 = (rest >> 2) & 3; a0 = (rest >> 4) + (item < 256 ? 16 : 0);
    } else if (item < 1280) {
      const int i2 = item - 256;
      kind = 2; a0 = 1; a1 = i2 >> 7; a2 = (i2 >> 5) & 3; a3 = i2 & 31;
    } else {
      const int i2 = item - 1792;
      kind = 2; a0 = 0; a1 = i2 >> 3; a2 = (i2 >> 1) & 3; a3 = i2 & 1;
    }
    if (mode == 1 && kind == 2) continue;
    if (mode == 2 && kind != 2) continue;
    if (kind != 2) __builtin_amdgcn_s_setprio(3);
    if (kind == 0) gdn_chain(p, l, a0, a1, a2, a3, (float*)smraw);
    else if (kind == 1) hgrn_chain(p, l, a0, a1, a2, a3, (float*)smraw);
    if (kind != 2) __builtin_amdgcn_s_setprio(0);
    else attn_item(p, a0, a1, a2, a3, smraw, mode == 2);
  }
}

__global__ void __launch_bounds__(NTHR, 2) mega(Params p) {
  __shared__ __attribute__((aligned(16))) unsigned char smem[LDS_BYTES];
  cg::grid_group grid = cg::this_grid();
  __shared__ uint4 xb_words;
  if (threadIdx.x == 0) xb_words = make_uint4(0u, 0u, 0u, 0u);
  __syncthreads();
  {
    XcdBarrier xb0 = xcd_barrier_post(p.xbar, (volatile LAS unsigned*)&xb_words);
    if (threadIdx.x == 0) ((volatile LAS unsigned*)&xb_words)[2] = xb0.x;
  }
#define GSYNC() do { XcdBarrier xb_; xb_.bar = p.xbar; xb_.st = (volatile LAS unsigned*)&xb_words; xb_.x = 0; \
    if (threadIdx.x == 0) xb_.x = ((volatile LAS unsigned*)&xb_words)[2]; xcd_barrier(xb_); } while (0)
  phase0(p, (float*)smem);
  grid.sync();
  rowpass_norm(p, 0, 0);
  GSYNC();
  for (int l = 0; l < 2; ++l) {
    phase_a(p, l, (u16*)smem);
    GSYNC();
    rowpass_b0(p, l);
    GSYNC();
    phase_b1(p, l, (u16*)smem);
    GSYNC();
    rowpass_b2(p, l);
    GSYNC();
    phase_c(p, l, smem);
    GSYNC();
    rowpass_c2(p, l);
    GSYNC();
    phase_gemm_y(p.MIX, 1024, p.WoutT + (size_t)l * 1024 * 1024, 1024, 1024, p.HQ, 1024, (u16*)smem);
    GSYNC();
    rowpass_norm(p, l, 1);
    GSYNC();
    phase_e(p, l, (u16*)smem);
    GSYNC();
    phase_gemm_y(p.P, DFF, p.WfoT + (size_t)l * 1024 * DFF, DFF, 1024, p.HQ, 1024, (u16*)smem);
    GSYNC();
    rowpass_norm(p, l, 2);
    if (l == 0) GSYNC();
  }
}

extern "C" void kernel_launch(void* const* d_in, const int* in_sizes, int n_in, void* d_out, int out_size, void* d_ws,
                              size_t ws_size, hipStream_t stream) {
  static int grid_blocks = 0;
  if (!grid_blocks) {
    int dev = 0, cus = 0, per_cu = 0;
    hipGetDevice(&dev);
    hipDeviceGetAttribute(&cus, hipDeviceAttributeMultiprocessorCount, dev);
    hipOccupancyMaxActiveBlocksPerMultiprocessor(&per_cu, mega, NTHR, 0);
    if (per_cu > 2) per_cu = 2;
    if (per_cu < 1) per_cu = 1;
    grid_blocks = cus * per_cu;
  }
  Params p{};
  const float* const* in = (const float* const*)d_in;
  p.x_prompt = in[0]; p.x_sample = in[1]; p.cache_ckv = in[2]; p.cache_kr = in[3]; p.state_gdn = in[4]; p.state_hgrn = in[5];
  p.c = in[6]; p.c_ctx = in[7]; p.w_ada = in[8]; p.b_ada = in[9]; p.g_pre_mix = in[10]; p.g_post_mix = in[11];
  p.g_pre_ffn = in[12]; p.g_post_ffn = in[13]; p.w_in = in[14]; p.w_out = in[15]; p.gdn_conv_w = in[16];
  p.gdn_a_log = in[17]; p.gdn_dt_bias = in[18]; p.gdn_norm_w = in[19]; p.hgrn_lb = in[20]; p.hgrn_norm_w = in[21];
  p.mla_q_norm_w = in[22]; p.mla_w_uq = in[23]; p.mla_kv_norm_w = in[24]; p.mla_w_ukv = in[25]; p.w_ffn_in = in[26];
  p.w_ffn_out = in[27];
  p.out = (float*)d_out;
  unsigned char* ws = (unsigned char*)d_ws;
  size_t off = 0;
  auto take = [&](size_t bytes) { unsigned char* r = ws + off; off += (bytes + 255) & ~(size_t)255; return r; };
  p.counters = (unsigned*)take(1024);
  p.xbar = (unsigned*)take(16384);
  p.WinT = (u16*)take((size_t)2 * 3072 * 1024 * 2);
  p.WuqT = (u16*)take((size_t)2 * 768 * 384 * 2);
  p.WukvT = (u16*)take((size_t)2 * 1024 * 256 * 2);
  p.WoutT = (u16*)take((size_t)2 * 1024 * 1024 * 2);
  p.WfiT = (u16*)take((size_t)2 * 5632 * 1024 * 2);
  p.WfoT = (u16*)take((size_t)2 * 1024 * 2816 * 2);
  p.mod = (float*)take((size_t)2 * 9 * 6144 * 4);
  p.HQ = (u16*)take((size_t)T_ALL * 1024 * 2);
  p.P = (u16*)take((size_t)T_ALL * PW * 2);
  p.KN = (u16*)take((size_t)(T_ALL + 2048) * 512 * 2);
  p.VTL = (u16*)take((size_t)8 * 4 * 128 * 4352 * 2);
  p.VTC = (u16*)take((size_t)16 * 4 * 128 * 256 * 2);
  p.CKVC = (u16*)take((size_t)2048 * 256 * 2);
  p.KRC = (u16*)take((size_t)2048 * 64 * 2);
  p.GAB = (float*)take((size_t)T_ALL * 16 * 4);
  p.MIX = (u16*)take((size_t)T_ALL * 1024 * 2);
  if (off > ws_size) { fprintf(stderr, "workspace too small: need %zu have %zu\n", off, ws_size); return; }
  hipMemsetAsync(p.counters, 0, 1024 + 16384, stream);
  void* args[] = {&p};
  hipError_t e = hipLaunchCooperativeKernel((void*)mega, dim3(grid_blocks), dim3(NTHR), args, 0, stream);
  if (e != hipSuccess) fprintf(stderr, "cooperative launch failed: %s (grid %d)\n", hipGetErrorString(e), grid_blocks);
}
```

```cpp
#include <hip/hip_runtime.h>
#include <hip/hip_cooperative_groups.h>
#include <cstdio>
namespace cg = cooperative_groups;

typedef unsigned short u16;
using bf16x8 = __attribute__((ext_vector_type(8))) short;
using f32x4  = __attribute__((ext_vector_type(4))) float;

#define T_CTX 4096
#define T_ALL 36864
#define PW 3072
#define DFF 2816
#define LDS_BYTES 73728
#define NTHR 256

#define P_GQKV 0
#define P_GZ 768
#define P_HQ 1024
#define P_HI 1280
#define P_HF 1536
#define P_HG 2048
#define P_MCQ 2304
#define P_MCKV 2688
#define P_MKR 2944
#define P_GA 3008

struct Params {
  const float *x_prompt, *x_sample, *cache_ckv, *cache_kr, *state_gdn, *state_hgrn, *c, *c_ctx;
  const float *w_ada, *b_ada, *g_pre_mix, *g_post_mix, *g_pre_ffn, *g_post_ffn, *w_in, *w_out;
  const float *gdn_conv_w, *gdn_a_log, *gdn_dt_bias, *gdn_norm_w, *hgrn_lb, *hgrn_norm_w;
  const float *mla_q_norm_w, *mla_w_uq, *mla_kv_norm_w, *mla_w_ukv, *w_ffn_in, *w_ffn_out;
  float* out;
  u16 *WinT, *WuqT, *WukvT, *WoutT, *WfiT, *WfoT;
  float* mod;
  u16 *HQ, *P, *KN, *VTL, *VTC, *CKVC, *KRC, *MIX;
  float* GAB;
  unsigned* counters;
  unsigned* xbar;
};

#define OUT_CKV   37748736
#define OUT_KR    39845888
#define OUT_SGDN  40370176
#define OUT_SHG   41418752

__device__ __forceinline__ u16 f2bf(float f) {
  unsigned u = __float_as_uint(f);
  u += 0x7fffu + ((u >> 16) & 1u);
  return (u16)(u >> 16);
}
__device__ __forceinline__ float bf2f(u16 h) { return __uint_as_float(((unsigned)h) << 16); }
__device__ __forceinline__ float wave_sum(float v) {
#pragma unroll
  for (int o = 32; o > 0; o >>= 1) v += __shfl_xor(v, o);
  return v;
}
__device__ __forceinline__ float sigmoidf_(float x) { return __builtin_amdgcn_rcpf(1.f + __expf(-x)); }
__device__ __forceinline__ float siluf_(float x) { return x * __builtin_amdgcn_rcpf(1.f + __expf(-x)); }
__device__ __forceinline__ int tid_l() { int t = threadIdx.x; asm volatile("" : "+v"(t)); return t; }
__device__ __forceinline__ int tok_mod(int t) { return t < T_CTX ? 0 : 1 + ((t - T_CTX) >> 12); }

__device__ __forceinline__ int map_col(int kind, int j) {
  if (kind == 0) return j;
  if (kind == 1) { if (j < 1024) return j; if (j < 3008) return j + 16; if (j < 3024) return 1024 + (j - 3008); return -1; }
  int blk = j >> 6, w = j & 63;
  return w < 32 ? blk * 32 + w : DFF + blk * 32 + (w - 32);
}

__device__ __forceinline__ void cvt_tile(const float* __restrict__ src, int K, int Nsrc, u16* __restrict__ dst, int kind, int jt, int kt, float* sm) {
  const int tid = tid_l();
  const int j0 = jt * 64, k0 = kt * 64;
  __syncthreads();
  {
    int jj = tid & 63, kk0 = tid >> 6;
    int sc = map_col(kind, j0 + jj);
    for (int kk = kk0; kk < 64; kk += 4)
      sm[kk * 65 + jj] = sc >= 0 ? src[(size_t)(k0 + kk) * Nsrc + sc] : 0.f;
  }
  __syncthreads();
  {
    const int kq = tid & 15, jj0 = tid >> 4;
#pragma unroll
    for (int jj = jj0; jj < 64; jj += 16) {
      uint2 o;
      o.x = (unsigned)f2bf(sm[(4 * kq + 0) * 65 + jj]) | ((unsigned)f2bf(sm[(4 * kq + 1) * 65 + jj]) << 16);
      o.y = (unsigned)f2bf(sm[(4 * kq + 2) * 65 + jj]) | ((unsigned)f2bf(sm[(4 * kq + 3) * 65 + jj]) << 16);
      *(uint2*)(dst + (size_t)(j0 + jj) * K + k0 + 4 * kq) = o;
    }
  }
}

__device__ __forceinline__ void mod_item(const Params& p, int item, float* sm) {
  const int l = item / 96, j0 = (item % 96) * 64;
  const int tid = tid_l();
  float* sC = sm;
  float* sR = sm + 9 * 1024;
  __syncthreads();
  for (int i = tid; i < 9 * 1024; i += NTHR) {
    int m = i >> 10, k = i & 1023;
    float v = m == 0 ? p.c_ctx[k] : p.c[(m - 1) * 1024 + k];
    sC[i] = siluf_(v);
  }
  __syncthreads();
  const int col = tid & 63, ks = tid >> 6;
  float acc[9];
#pragma unroll
  for (int m = 0; m < 9; ++m) acc[m] = 0.f;
  const float* wp = p.w_ada + (size_t)l * 1024 * 6144 + j0 + col;
  for (int k = ks * 256; k < ks * 256 + 256; k += 8) {
    float wv[8];
#pragma unroll
    for (int u = 0; u < 8; ++u) wv[u] = wp[(size_t)(k + u) * 6144];
#pragma unroll
    for (int u = 0; u < 8; ++u)
#pragma unroll
      for (int m = 0; m < 9; ++m) acc[m] += sC[m * 1024 + k + u] * wv[u];
  }
#pragma unroll
  for (int m = 0; m < 9; ++m) sR[(ks * 9 + m) * 64 + col] = acc[m];
  __syncthreads();
  for (int i = tid; i < 9 * 64; i += NTHR) {
    int m = i >> 6, cc = i & 63;
    float v = sR[(0 * 9 + m) * 64 + cc] + sR[(1 * 9 + m) * 64 + cc] + sR[(2 * 9 + m) * 64 + cc] + sR[(3 * 9 + m) * 64 + cc];
    p.mod[((size_t)l * 9 + m) * 6144 + j0 + cc] = v + p.b_ada[l * 6144 + j0 + cc];
  }
}

__device__ __forceinline__ void phase0(const Params& p, float* sm) {
  const int PER_LAYER = 3272;
  const int total = 2 * PER_LAYER + 192;
  for (int item = blockIdx.x; item < total; item += gridDim.x) {
    if (item < 192) { mod_item(p, item, sm); continue; }
    int it = item - 192;
    int l = it / PER_LAYER, r = it % PER_LAYER;
    if (r < 768) { cvt_tile(p.w_in + (size_t)l * 1024 * 3024, 1024, 3024, p.WinT + (size_t)l * 3072 * 1024, 1, r / 16, r % 16, sm); continue; }
    r -= 768;
    if (r < 72) { cvt_tile(p.mla_w_uq + (size_t)l * 384 * 768, 384, 768, p.WuqT + (size_t)l * 768 * 384, 0, r / 6, r % 6, sm); continue; }
    r -= 72;
    if (r < 64) { cvt_tile(p.mla_w_ukv + (size_t)l * 256 * 1024, 256, 1024, p.WukvT + (size_t)l * 1024 * 256, 0, r / 4, r % 4, sm); continue; }
    r -= 64;
    if (r < 256) { cvt_tile(p.w_out + (size_t)l * 1024 * 1024, 1024, 1024, p.WoutT + (size_t)l * 1024 * 1024, 0, r / 16, r % 16, sm); continue; }
    r -= 256;
    if (r < 1408) { cvt_tile(p.w_ffn_in + (size_t)l * 1024 * 5632, 1024, 5632, p.WfiT + (size_t)l * 5632 * 1024, 2, r / 16, r % 16, sm); continue; }
    r -= 1408;
    cvt_tile(p.w_ffn_out + (size_t)l * 2816 * 1024, 2816, 1024, p.WfoT + (size_t)l * 1024 * 2816, 0, r / 44, r % 44, sm);
  }
}

__device__ __forceinline__ void rowpass_norm(const Params& p, int l, int stage) {
  const int tidl = tid_l();
  const int lane = tidl & 63, w = tidl >> 6;
  const int ln = stage == 0 ? 0 : (stage == 1 ? l : l + 1);
  const int sh_off = stage == 1 ? 3072 : 0;
  const float* gpre = stage == 1 ? p.g_pre_ffn + l * 1024 : p.g_pre_mix + (ln < 2 ? ln : 0) * 1024;
  u16* dst = stage == 1 ? p.MIX : p.HQ;
  for (int t = blockIdx.x * 4 + w; t < T_ALL; t += gridDim.x * 4) {
    const int m = tok_mod(t);
    float x[16];
    float* xo = p.out + (size_t)t * 1024;
    if (stage == 0) {
      const float* xi = t < T_CTX ? p.x_prompt + (size_t)t * 1024 : p.x_sample + (size_t)(t - T_CTX) * 1024;
#pragma unroll
      for (int i = 0; i < 4; ++i) {
        float4 v = *(const float4*)(xi + i * 256 + lane * 4);
        x[i * 4 + 0] = v.x; x[i * 4 + 1] = v.y; x[i * 4 + 2] = v.z; x[i * 4 + 3] = v.w;
      }
    } else {
      const u16* yp = p.HQ + (size_t)t * 1024;
      float y[16]; float ss = 0.f;
#pragma unroll
      for (int i = 0; i < 4; ++i) {
        uint2 v = *(const uint2*)(yp + i * 256 + lane * 4);
        y[i * 4 + 0] = bf2f((u16)(v.x & 0xffff)); y[i * 4 + 1] = bf2f((u16)(v.x >> 16));
        y[i * 4 + 2] = bf2f((u16)(v.y & 0xffff)); y[i * 4 + 3] = bf2f((u16)(v.y >> 16));
      }
#pragma unroll
      for (int i = 0; i < 16; ++i) ss += y[i] * y[i];
      ss = wave_sum(ss);
      const float rstd = rsqrtf(ss * (1.f / 1024.f) + 1e-6f);
      const float* gpost = (stage == 1 ? p.g_post_mix : p.g_post_ffn) + l * 1024;
      const float* gt = p.mod + ((size_t)l * 9 + m) * 6144 + (stage == 1 ? 2048 : 5120);
#pragma unroll
      for (int i = 0; i < 4; ++i) {
        float4 xv = *(const float4*)(xo + i * 256 + lane * 4);
        float4 gp = *(const float4*)(gpost + i * 256 + lane * 4);
        float4 gg = *(const float4*)(gt + i * 256 + lane * 4);
        x[i * 4 + 0] = xv.x + gg.x * y[i * 4 + 0] * rstd * gp.x;
        x[i * 4 + 1] = xv.y + gg.y * y[i * 4 + 1] * rstd * gp.y;
        x[i * 4 + 2] = xv.z + gg.z * y[i * 4 + 2] * rstd * gp.z;
        x[i * 4 + 3] = xv.w + gg.w * y[i * 4 + 3] * rstd * gp.w;
      }
    }
    __threadfence_block();
#pragma unroll
    for (int i = 0; i < 4; ++i)
      *(float4*)(xo + i * 256 + lane * 4) = make_float4(x[i * 4 + 0], x[i * 4 + 1], x[i * 4 + 2], x[i * 4 + 3]);
    if (ln >= 2) continue;
    float ss = 0.f;
#pragma unroll
    for (int i = 0; i < 16; ++i) ss += x[i] * x[i];
    ss = wave_sum(ss);
    const float rstd = rsqrtf(ss * (1.f / 1024.f) + 1e-6f);
    const float* sh = p.mod + ((size_t)ln * 9 + m) * 6144 + sh_off;
    const float* sc = sh + 1024;
    u16* hp = dst + (size_t)t * 1024;
#pragma unroll
    for (int i = 0; i < 4; ++i) {
      float4 gp = *(const float4*)(gpre + i * 256 + lane * 4);
      float4 s1 = *(const float4*)(sh + i * 256 + lane * 4);
      float4 c1 = *(const float4*)(sc + i * 256 + lane * 4);
      float h0 = x[i * 4 + 0] * rstd * gp.x * (1.f + c1.x) + s1.x;
      float h1 = x[i * 4 + 1] * rstd * gp.y * (1.f + c1.y) + s1.y;
      float h2 = x[i * 4 + 2] * rstd * gp.z * (1.f + c1.z) + s1.z;
      float h3 = x[i * 4 + 3] * rstd * gp.w * (1.f + c1.w) + s1.w;
      uint2 o;
      o.x = (unsigned)f2bf(h0) | ((unsigned)f2bf(h1) << 16);
      o.y = (unsigned)f2bf(h2) | ((unsigned)f2bf(h3) << 16);
      *(uint2*)(hp + i * 256 + lane * 4) = o;
    }
  }
}

__device__ __forceinline__ void unpack8(const uint4 v, float (&f)[8]);
__device__ __forceinline__ uint4 pack8(const float (&f)[8]);
__device__ __forceinline__ void rowpass_b0(const Params& p, int l) {
  const int tidl = tid_l();
  const int lane = tidl & 63, w = tidl >> 6;
  for (int t = blockIdx.x * 4 + w; t < T_ALL + 2048; t += gridDim.x * 4) {
    if (t >= T_ALL) {
      const int r = t - T_ALL, b = r >> 8, s = r & 255;
      if (lane < 32) {
        const float* ck = p.cache_ckv + (((size_t)b * 2 + l) * 256 + s) * 256 + lane * 8;
        const float4 x0 = *(const float4*)ck, x1 = *(const float4*)(ck + 4);
        const float f[8] = {x0.x, x0.y, x0.z, x0.w, x1.x, x1.y, x1.z, x1.w};
        *(uint4*)(p.CKVC + (size_t)r * 256 + lane * 8) = pack8(f);
      } else if (lane < 40) {
        const float* kr = p.cache_kr + (((size_t)b * 2 + l) * 256 + s) * 64 + (lane - 32) * 8;
        const float4 x0 = *(const float4*)kr, x1 = *(const float4*)(kr + 4);
        const float f[8] = {x0.x, x0.y, x0.z, x0.w, x1.x, x1.y, x1.z, x1.w};
        *(uint4*)(p.KRC + (size_t)r * 64 + (lane - 32) * 8) = pack8(f);
      }
      continue;
    }
    u16* pr = p.P + (size_t)t * PW;
    {
      float f[8]; float ss = 0.f;
      if (lane < 48) {
        unpack8(*(const uint4*)(pr + P_MCQ + lane * 8), f);
#pragma unroll
        for (int i = 0; i < 8; ++i) ss += f[i] * f[i];
      }
      ss = wave_sum(ss);
      const float rstd = rsqrtf(ss * (1.f / 384.f) + 1e-6f);
      if (lane < 48) {
        const float* wq = p.mla_q_norm_w + l * 384 + lane * 8;
        const float4 w0 = *(const float4*)wq, w1 = *(const float4*)(wq + 4);
        f[0] *= rstd * w0.x; f[1] *= rstd * w0.y; f[2] *= rstd * w0.z; f[3] *= rstd * w0.w;
        f[4] *= rstd * w1.x; f[5] *= rstd * w1.y; f[6] *= rstd * w1.z; f[7] *= rstd * w1.w;
        *(uint4*)(pr + P_MCQ + lane * 8) = pack8(f);
      }
    }
    {
      float f[8]; float ss = 0.f;
      if (lane < 32) {
        unpack8(*(const uint4*)(pr + P_MCKV + lane * 8), f);
#pragma unroll
        for (int i = 0; i < 8; ++i) ss += f[i] * f[i];
      }
      ss = wave_sum(ss);
      const float rstd = rsqrtf(ss * (1.f / 256.f) + 1e-6f);
      if (lane < 32) {
        const float* wk = p.mla_kv_norm_w + l * 256 + lane * 8;
        const float4 w0 = *(const float4*)wk, w1 = *(const float4*)(wk + 4);
        f[0] *= rstd * w0.x; f[1] *= rstd * w0.y; f[2] *= rstd * w0.z; f[3] *= rstd * w0.w;
        f[4] *= rstd * w1.x; f[5] *= rstd * w1.y; f[6] *= rstd * w1.z; f[7] *= rstd * w1.w;
        *(uint4*)(pr + P_MCKV + lane * 8) = pack8(f);
        if (t < T_CTX) {
          const int b = t >> 8, s = t & 255;
          float* op = p.out + OUT_CKV + (((size_t)b * 2 + l) * 256 + s) * 256 + lane * 8;
          *(float4*)op = make_float4(f[0], f[1], f[2], f[3]);
          *(float4*)(op + 4) = make_float4(f[4], f[5], f[6], f[7]);
        }
      }
    }
    {
      float v = bf2f(pr[P_MKR + lane]);
      if (t < T_CTX) {
        int b = t >> 8, s = t & 255;
        p.out[OUT_KR + (((size_t)b * 2 + l) * 256 + s) * 64 + lane] = v;
      } else {
        int pos = (t - T_CTX) & 4095;
        int axis = lane >> 5, half = (lane >> 4) & 1, f = lane & 15;
        float posf = axis == 0 ? (float)(pos >> 6) : (float)(pos & 63);
        float inv = exp2f(-(float)f * (13.287712379549449f / 16.f));
        float ang = posf * inv;
        float sn, cs;
        __sincosf(ang, &sn, &cs);
        float other = __shfl_xor(v, 16);
        float o = half == 0 ? v * cs - other * sn : v * cs + other * sn;
        pr[P_MKR + lane] = f2bf(o);
      }
    }
  }
}

#define P_QH 2304
#define P_KH 2560
__device__ __forceinline__ void rowpass_b2(const Params& p, int l) {
  const int tidl = tid_l();
  const int lane = tidl & 63, w = tidl >> 6;
  float cw[8][5], cv[8][5];
#pragma unroll
  for (int e = 0; e < 8; ++e)
#pragma unroll
    for (int j = 0; j < 5; ++j) {
      cw[e][j] = p.gdn_conv_w[((size_t)l * 768 + 8 * lane + e) * 5 + j];
      cv[e][j] = p.gdn_conv_w[((size_t)l * 768 + 512 + 8 * (lane & 31) + e) * 5 + j];
    }
  u16* VH = p.HQ + (size_t)T_ALL * 768;
  for (int t = blockIdx.x * 4 + w; t < T_ALL; t += gridDim.x * 4) {
    const int len = t < T_CTX ? 256 : 4096;
    const int tau = t < T_CTX ? (t & 255) : ((t - T_CTX) & 4095);
    float y[8], yv[8];
#pragma unroll
    for (int e = 0; e < 8; ++e) { y[e] = 0.f; yv[e] = 0.f; }
#pragma unroll
    for (int j = 0; j < 5; ++j) {
      const int tt = tau + j - 2;
      if (tt >= 0 && tt < len) {
        const u16* pr = p.P + (size_t)(t + j - 2) * PW;
        float f[8];
        unpack8(*(const uint4*)(pr + 8 * lane), f);
#pragma unroll
        for (int e = 0; e < 8; ++e) y[e] += cw[e][j] * f[e];
        if (lane < 32) {
          unpack8(*(const uint4*)(pr + 512 + 8 * lane), f);
#pragma unroll
          for (int e = 0; e < 8; ++e) yv[e] += cv[e][j] * f[e];
        }
      }
    }
    float ss = 0.f;
#pragma unroll
    for (int e = 0; e < 8; ++e) { y[e] = siluf_(y[e]); yv[e] = siluf_(yv[e]); ss += y[e] * y[e]; }
    ss += __shfl_xor(ss, 1); ss += __shfl_xor(ss, 2); ss += __shfl_xor(ss, 4);
    const float rn = rsqrtf(ss + 1e-6f) * (lane < 32 ? 0.125f : 1.f);
#pragma unroll
    for (int e = 0; e < 8; ++e) y[e] *= rn;
    *(uint4*)(p.P + (size_t)t * PW + P_QH + 8 * lane) = pack8(y);
    if (lane < 32) *(uint4*)(VH + (size_t)t * 256 + 8 * lane) = pack8(yv);
  }
}

__device__ __forceinline__ void unpack8(const uint4 v, float (&f)[8]) {
  f[0] = bf2f((u16)(v.x & 0xffff)); f[1] = bf2f((u16)(v.x >> 16)); f[2] = bf2f((u16)(v.y & 0xffff)); f[3] = bf2f((u16)(v.y >> 16));
  f[4] = bf2f((u16)(v.z & 0xffff)); f[5] = bf2f((u16)(v.z >> 16)); f[6] = bf2f((u16)(v.w & 0xffff)); f[7] = bf2f((u16)(v.w >> 16));
}
__device__ __forceinline__ uint4 pack8(const float (&f)[8]) {
  uint4 o;
  o.x = (unsigned)f2bf(f[0]) | ((unsigned)f2bf(f[1]) << 16); o.y = (unsigned)f2bf(f[2]) | ((unsigned)f2bf(f[3]) << 16);
  o.z = (unsigned)f2bf(f[4]) | ((unsigned)f2bf(f[5]) << 16); o.w = (unsigned)f2bf(f[6]) | ((unsigned)f2bf(f[7]) << 16);
  return o;
}
__device__ __forceinline__ void rowpass_c2(const Params& p, int l) {
  const int tidl = tid_l();
  const int lane = tidl & 63, w = tidl >> 6;
  const int hl = lane & 31, isH = lane >> 5;
  const float* nw = (isH ? p.hgrn_norm_w : p.gdn_norm_w) + l * 64 + (hl & 7) * 8;
  const float4 w0 = *(const float4*)(nw), w1 = *(const float4*)(nw + 4);
  const float wv[8] = {w0.x, w0.y, w0.z, w0.w, w1.x, w1.y, w1.z, w1.w};
  for (int t = blockIdx.x * 4 + w; t < T_ALL; t += gridDim.x * 4) {
    u16* mr = p.MIX + (size_t)t * 1024;
    const u16* pr = p.P + (size_t)t * PW;
    const u16* qr = p.HQ + (size_t)t * 768;
    const uint4 vf = *(const uint4*)(mr + isH * 512 + hl * 8);
    const uint4 vb = *(const uint4*)(mr + isH * 512 + 256 + hl * 8);
    const uint4 vg = *(const uint4*)(pr + (isH ? P_HG : P_GZ) + hl * 8);
    const int c0 = lane * 8;
    const uint4 vo = *(const uint4*)(qr + (c0 >> 7) * 192 + (c0 & 127));
    float f[8], bb[8], g[8];
    unpack8(vf, f); unpack8(vb, bb); unpack8(vg, g);
    float ss = 0.f;
#pragma unroll
    for (int i = 0; i < 8; ++i) { f[i] += bb[i]; ss += f[i] * f[i]; }
    ss += __shfl_xor(ss, 1); ss += __shfl_xor(ss, 2); ss += __shfl_xor(ss, 4);
    const float rn = rsqrtf(ss * (1.f / 64.f) + 1e-6f);
#pragma unroll
    for (int i = 0; i < 8; ++i) f[i] = f[i] * rn * wv[i] * (isH ? sigmoidf_(g[i]) : siluf_(g[i]));
    __threadfence_block();
    *(uint4*)(mr + isH * 256 + hl * 8) = pack8(f);
    *(uint4*)(mr + 512 + c0) = vo;
  }
}

__device__ __forceinline__ void gemm128(const u16* __restrict__ A, int lda, const u16* __restrict__ B, int ldb, int K,
                                        u16* lds, f32x4 (&acc)[4][4]) {
  const int tid = tid_l(), lane = tid & 63, w = tid >> 6, wm = w >> 1, wn = w & 1;
  const int r16 = lane & 15, g4 = lane >> 4;
#pragma unroll
  for (int i = 0; i < 4; ++i)
#pragma unroll
    for (int j = 0; j < 4; ++j) acc[i][j] = f32x4{0.f, 0.f, 0.f, 0.f};
  const int lrow = tid >> 3, lkc = tid & 7;
  const u16* ap = A + (size_t)lrow * lda + lkc * 8;
  const u16* bp = B + (size_t)lrow * ldb + lkc * 8;
  const size_t sa32 = (size_t)32 * lda, sb32 = (size_t)32 * ldb;
  uint4 ra0 = *(const uint4*)(ap), ra1 = *(const uint4*)(ap + sa32), ra2 = *(const uint4*)(ap + 2 * sa32), ra3 = *(const uint4*)(ap + 3 * sa32);
  uint4 rb0 = *(const uint4*)(bp), rb1 = *(const uint4*)(bp + sb32), rb2 = *(const uint4*)(bp + 2 * sb32), rb3 = *(const uint4*)(bp + 3 * sb32);
  const int woff = lrow * 64 + ((lkc ^ (lrow & 7)) * 8);
  const int sw = r16 & 7;
  const int fa0 = (wm * 64 + r16) * 64 + ((g4 ^ sw) * 8);
  const int fa1 = (wm * 64 + r16) * 64 + (((4 + g4) ^ sw) * 8);
  const int fb0 = 128 * 64 + (wn * 64 + r16) * 64 + ((g4 ^ sw) * 8);
  const int fb1 = 128 * 64 + (wn * 64 + r16) * 64 + (((4 + g4) ^ sw) * 8);
  const int nk = K >> 6;
  __syncthreads();
  {
    u16* wa = lds + woff; u16* wb = lds + 128 * 64 + woff;
    *(uint4*)(wa) = ra0; *(uint4*)(wa + 32 * 64) = ra1; *(uint4*)(wa + 64 * 64) = ra2; *(uint4*)(wa + 96 * 64) = ra3;
    *(uint4*)(wb) = rb0; *(uint4*)(wb + 32 * 64) = rb1; *(uint4*)(wb + 64 * 64) = rb2; *(uint4*)(wb + 96 * 64) = rb3;
  }
  if (nk > 1) {
    const u16* a2 = ap + 64; const u16* b2 = bp + 64;
    ra0 = *(const uint4*)(a2); ra1 = *(const uint4*)(a2 + sa32); ra2 = *(const uint4*)(a2 + 2 * sa32); ra3 = *(const uint4*)(a2 + 3 * sa32);
    rb0 = *(const uint4*)(b2); rb1 = *(const uint4*)(b2 + sb32); rb2 = *(const uint4*)(b2 + 2 * sb32); rb3 = *(const uint4*)(b2 + 3 * sb32);
  }
  __syncthreads();
  for (int kt = 0; kt < nk; ++kt) {
    const u16* cur = lds + (kt & 1) * (256 * 64);
    if (kt + 1 < nk) {
      u16* nxt = lds + ((kt + 1) & 1) * (256 * 64);
      u16* wa = nxt + woff; u16* wb = nxt + 128 * 64 + woff;
      *(uint4*)(wa) = ra0; *(uint4*)(wa + 32 * 64) = ra1; *(uint4*)(wa + 64 * 64) = ra2; *(uint4*)(wa + 96 * 64) = ra3;
      *(uint4*)(wb) = rb0; *(uint4*)(wb + 32 * 64) = rb1; *(uint4*)(wb + 64 * 64) = rb2; *(uint4*)(wb + 96 * 64) = rb3;
      if (kt + 2 < nk) {
        const u16* a2 = ap + (kt + 2) * 64; const u16* b2 = bp + (kt + 2) * 64;
        ra0 = *(const uint4*)(a2); ra1 = *(const uint4*)(a2 + sa32); ra2 = *(const uint4*)(a2 + 2 * sa32); ra3 = *(const uint4*)(a2 + 3 * sa32);
        rb0 = *(const uint4*)(b2); rb1 = *(const uint4*)(b2 + sb32); rb2 = *(const uint4*)(b2 + 2 * sb32); rb3 = *(const uint4*)(b2 + 3 * sb32);
      }
    }
    {
      const u16* pa0 = cur + fa0; const u16* pa1 = cur + fa1; const u16* pb0 = cur + fb0; const u16* pb1 = cur + fb1;
      bf16x8 a0 = *(const bf16x8*)(pa0), a1 = *(const bf16x8*)(pa0 + 16 * 64), a2 = *(const bf16x8*)(pa0 + 32 * 64), a3 = *(const bf16x8*)(pa0 + 48 * 64);
      bf16x8 b0 = *(const bf16x8*)(pb0), b1 = *(const bf16x8*)(pb0 + 16 * 64), b2 = *(const bf16x8*)(pb0 + 32 * 64), b3 = *(const bf16x8*)(pb0 + 48 * 64);
      bf16x8 c0 = *(const bf16x8*)(pa1), c1 = *(const bf16x8*)(pa1 + 16 * 64), c2 = *(const bf16x8*)(pa1 + 32 * 64), c3 = *(const bf16x8*)(pa1 + 48 * 64);
      bf16x8 d0 = *(const bf16x8*)(pb1), d1 = *(const bf16x8*)(pb1 + 16 * 64), d2 = *(const bf16x8*)(pb1 + 32 * 64), d3 = *(const bf16x8*)(pb1 + 48 * 64);
      __builtin_amdgcn_sched_barrier(0);
#define G128_MM(j, bj, x0, x1, x2, x3) do { \
        acc[0][j] = __builtin_amdgcn_mfma_f32_16x16x32_bf16(bj, x0, acc[0][j], 0, 0, 0); \
        acc[1][j] = __builtin_amdgcn_mfma_f32_16x16x32_bf16(bj, x1, acc[1][j], 0, 0, 0); \
        acc[2][j] = __builtin_amdgcn_mfma_f32_16x16x32_bf16(bj, x2, acc[2][j], 0, 0, 0); \
        acc[3][j] = __builtin_amdgcn_mfma_f32_16x16x32_bf16(bj, x3, acc[3][j], 0, 0, 0); } while (0)
      G128_MM(0, b0, a0, a1, a2, a3); G128_MM(1, b1, a0, a1, a2, a3); G128_MM(2, b2, a0, a1, a2, a3); G128_MM(3, b3, a0, a1, a2, a3);
      G128_MM(0, d0, c0, c1, c2, c3); G128_MM(1, d1, c0, c1, c2, c3); G128_MM(2, d2, c0, c1, c2, c3); G128_MM(3, d3, c0, c1, c2, c3);
    }
    __syncthreads();
  }
}
__device__ __forceinline__ uint2 pack4(f32x4 v) {
  uint2 o;
  o.x = (unsigned)f2bf(v[0]) | ((unsigned)f2bf(v[1]) << 16);
  o.y = (unsigned)f2bf(v[2]) | ((unsigned)f2bf(v[3]) << 16);
  return o;
}

__device__ __forceinline__ void gemm256(const u16* __restrict__ A, int lda, const u16* __restrict__ B, int ldb, int K,
                                        u16* lds, f32x4 (&acc)[8][4]) {
  const int tid = tid_l(), lane = tid & 63, w = tid >> 6, wm = w >> 1, wn = w & 1;
  const int r16 = lane & 15, g4 = lane >> 4;
#pragma unroll
  for (int i = 0; i < 8; ++i)
#pragma unroll
    for (int j = 0; j < 4; ++j) acc[i][j] = f32x4{0.f, 0.f, 0.f, 0.f};
  const int lrow = tid >> 2, lkc = tid & 3;
  const u16* ap = A + (size_t)lrow * lda + lkc * 8;
  const u16* bp = B + (size_t)lrow * ldb + lkc * 8;
  const size_t sa64 = (size_t)64 * lda, sb64 = (size_t)64 * ldb;
  const int woff = lrow * 32 + ((lkc ^ ((lrow >> 1) & 3)) * 8);
  const int fsw = (g4 ^ ((r16 >> 1) & 3)) * 8;
  const int faoff = (wm * 128 + r16) * 32 + fsw;
  const int fboff = 256 * 32 + (wn * 64 + r16) * 32 + fsw;
  const int nk = K >> 5;
  const int BUF = 384 * 32;
  uint4 xa0, xa1, xa2, xa3, xb0, xb1;
  uint4 ya0, ya1, ya2, ya3, yb0, yb1;
#define G256_LOAD(P, st) do { const u16* a2_ = ap + (st) * 32; const u16* b2_ = bp + (st) * 32; \
    P##a0 = *(const uint4*)(a2_); P##a1 = *(const uint4*)(a2_ + sa64); P##a2 = *(const uint4*)(a2_ + 2 * sa64); P##a3 = *(const uint4*)(a2_ + 3 * sa64); \
    P##b0 = *(const uint4*)(b2_); P##b1 = *(const uint4*)(b2_ + sb64); } while (0)
#define G256_STORE(P, buf) do { u16* wa_ = lds + (buf) * BUF + woff; u16* wb_ = wa_ + 256 * 32; \
    *(uint4*)(wa_) = P##a0; *(uint4*)(wa_ + 64 * 32) = P##a1; *(uint4*)(wa_ + 128 * 32) = P##a2; *(uint4*)(wa_ + 192 * 32) = P##a3; \
    *(uint4*)(wb_) = P##b0; *(uint4*)(wb_ + 64 * 32) = P##b1; } while (0)
#define G256_MM(i, af) do { \
      acc[i][0] = __builtin_amdgcn_mfma_f32_16x16x32_bf16(bf0, af, acc[i][0], 0, 0, 0); \
      acc[i][1] = __builtin_amdgcn_mfma_f32_16x16x32_bf16(bf1, af, acc[i][1], 0, 0, 0); \
      acc[i][2] = __builtin_amdgcn_mfma_f32_16x16x32_bf16(bf2, af, acc[i][2], 0, 0, 0); \
      acc[i][3] = __builtin_amdgcn_mfma_f32_16x16x32_bf16(bf3, af, acc[i][3], 0, 0, 0); } while (0)
#define G256_COMPUTE(buf) do { const u16* fa_ = lds + (buf) * BUF + faoff; const u16* fb_ = lds + (buf) * BUF + fboff; \
    bf16x8 bf0 = *(const bf16x8*)(fb_), bf1 = *(const bf16x8*)(fb_ + 16 * 32), bf2 = *(const bf16x8*)(fb_ + 32 * 32), bf3 = *(const bf16x8*)(fb_ + 48 * 32); \
    bf16x8 a0 = *(const bf16x8*)(fa_), a1 = *(const bf16x8*)(fa_ + 16 * 32), a2 = *(const bf16x8*)(fa_ + 32 * 32), a3 = *(const bf16x8*)(fa_ + 48 * 32); \
    __builtin_amdgcn_sched_barrier(0); __builtin_amdgcn_s_setprio(1); \
    G256_MM(0, a0); a0 = *(const bf16x8*)(fa_ + 64 * 32); __builtin_amdgcn_sched_barrier(0); \
    G256_MM(1, a1); a1 = *(const bf16x8*)(fa_ + 80 * 32); __builtin_amdgcn_sched_barrier(0); \
    G256_MM(2, a2); a2 = *(const bf16x8*)(fa_ + 96 * 32); __builtin_amdgcn_sched_barrier(0); \
    G256_MM(3, a3); a3 = *(const bf16x8*)(fa_ + 112 * 32); __builtin_amdgcn_sched_barrier(0); \
    G256_MM(4, a0); G256_MM(5, a1); G256_MM(6, a2); G256_MM(7, a3); __builtin_amdgcn_s_setprio(0); } while (0)
  G256_LOAD(x, 0);
  G256_LOAD(y, 1);
  __syncthreads();
  G256_STORE(x, 0);
  G256_LOAD(x, 2);
  __syncthreads();
  for (int kt = 0; kt < nk; kt += 2) {
    G256_STORE(y, 1);
    if (kt + 3 < nk) G256_LOAD(y, kt + 3);
    G256_COMPUTE(0);
    __syncthreads();
    if (kt + 2 < nk) {
      G256_STORE(x, 0);
      if (kt + 4 < nk) G256_LOAD(x, kt + 4);
    }
    G256_COMPUTE(1);
    __syncthreads();
  }
}
#define GEMM256_RC const int tde = tid_l(); const int rb = ((tde >> 6) >> 1) * 128 + (tde & 15), cb = ((tde >> 6) & 1) * 64 + ((tde & 63) >> 4) * 4;
#define GEMM_RC const int tde = tid_l(); const int rb = ((tde >> 6) >> 1) * 64 + (tde & 15), cb = ((tde >> 6) & 1) * 64 + ((tde & 63) >> 4) * 4;


__device__ __forceinline__ bool tile_at(int r, int Mt, int Nt, int& mt, int& nt) {
  const int x = blockIdx.x & 7, j = blockIdx.x >> 3, bpx = gridDim.x >> 3;
  const int mpx = Mt >> 3;
  const int q = r * bpx + j;
  if (q >= mpx * Nt) return false;
  const int full = (Nt >> 3) * (mpx * 8);
  int cb, rem, wcb;
  if (q < full) { cb = q / (mpx * 8); rem = q - cb * mpx * 8; wcb = 8; }
  else { cb = Nt >> 3; rem = q - full; wcb = Nt - cb * 8; }
  mt = x * mpx + rem / wcb;
  nt = cb * 8 + rem % wcb;
  return true;
}

__device__ __forceinline__ void phase_a(const Params& p, int l, u16* lds) {
  const u16* Bw = p.WinT + (size_t)l * 3072 * 1024;
  int mt, nt;
  for (int r = 0; tile_at(r, 144, 24, mt, nt); ++r) {
    const int m0 = mt * 256, n0 = nt * 128;
    f32x4 acc[8][4];
    gemm256(p.HQ + (size_t)m0 * 1024, 1024, Bw + (size_t)n0 * 1024, 1024, 1024, lds, acc);
    { GEMM256_RC
#pragma unroll
      for (int mi = 0; mi < 8; ++mi) {
        const int row = m0 + rb + mi * 16;
#pragma unroll
        for (int ni = 0; ni < 4; ++ni) {
          const int col = n0 + cb + ni * 16;
          *(uint2*)(p.P + (size_t)row * PW + col) = pack4(acc[mi][ni]);
          if (col >= P_GA && col < P_GA + 16)
            *(float4*)(p.GAB + (size_t)row * 16 + (col - P_GA)) = make_float4(acc[mi][ni][0], acc[mi][ni][1], acc[mi][ni][2], acc[mi][ni][3]);
        }
      }
    }
  }
}

__device__ __forceinline__ void phase_b1(const Params& p, int l, u16* lds) {
  int mt, nt;
  for (int pass = 0; pass < 2; ++pass) {
  for (int r = 0; tile_at(r, pass == 0 ? 288 : 304, pass == 0 ? 6 : 8, mt, nt); ++r) {
    if (pass == 0) {
      const int m0 = mt * 128, n0 = nt * 128;
      const float qscale = 0.07216878364870322f * 1.4426950408889634f;
      f32x4 acc[4][4];
      gemm128(p.P + (size_t)m0 * PW + P_MCQ, PW, p.WuqT + (size_t)l * 768 * 384 + (size_t)n0 * 384, 384, 384, lds, acc);
      { GEMM_RC
        const int g4 = (tde & 63) >> 4;
        const int cw0 = n0 + cb - g4 * 4;
        const bool ropew = ((cw0 >> 6) % 3) == 2 && m0 >= T_CTX;
#pragma unroll
        for (int mi = 0; mi < 4; ++mi) {
          const int row = m0 + rb + mi * 16;
          f32x4 v0 = acc[mi][0], v1 = acc[mi][1], v2 = acc[mi][2], v3 = acc[mi][3];
          if (ropew) {
            const int pos = (row - T_CTX) & 4095;
#pragma unroll
            for (int r = 0; r < 4; ++r) {
              const float inv = exp2f(-(float)(g4 * 4 + r) * (13.287712379549449f / 16.f));
              float s0, c0, s1, c1;
              __sincosf((float)(pos >> 6) * inv, &s0, &c0);
              __sincosf((float)(pos & 63) * inv, &s1, &c1);
              const float a0 = v0[r] * c0 - v1[r] * s0, a1 = v1[r] * c0 + v0[r] * s0;
              const float b0 = v2[r] * c1 - v3[r] * s1, b1 = v3[r] * c1 + v2[r] * s1;
              v0[r] = a0; v1[r] = a1; v2[r] = b0; v3[r] = b1;
            }
          }
          u16* qp = p.HQ + (size_t)row * 768 + n0 + cb;
          *(uint2*)(qp) = pack4(v0 * qscale); *(uint2*)(qp + 16) = pack4(v1 * qscale);
          *(uint2*)(qp + 32) = pack4(v2 * qscale); *(uint2*)(qp + 48) = pack4(v3 * qscale);
        }
      }
    } else {
      const int m0 = mt * 128, n0 = nt * 128;
      const u16* Ap; int lda;
      if (mt < 288) { Ap = p.P + (size_t)m0 * PW + P_MCKV; lda = PW; }
      else { Ap = p.CKVC + (size_t)(m0 - T_ALL) * 256; lda = 256; }
      f32x4 acc[4][4];
      gemm128(Ap, lda, p.WukvT + (size_t)l * 1024 * 256 + (size_t)n0 * 256, 256, 256, lds, acc);
      { GEMM_RC
#pragma unroll
        for (int mi = 0; mi < 4; ++mi) {
          const int row = m0 + rb + mi * 16;
          u16* vb; int vst;
          if (row < T_CTX) { int b = row >> 8, pos = row & 255; vb = p.VTC + (size_t)(b * 4) * 128 * 256 + pos; vst = 256; }
          else if (row < T_ALL) { int b = (row - T_CTX) >> 12, pos = (row - T_CTX) & 4095; vb = p.VTL + (size_t)(b * 4) * 128 * 4352 + pos; vst = 4352; }
          else { int b = (row - T_ALL) >> 8, pos = 4096 + ((row - T_ALL) & 255); vb = p.VTL + (size_t)(b * 4) * 128 * 4352 + pos; vst = 4352; }
#pragma unroll
          for (int ni = 0; ni < 4; ++ni) {
            const int col = n0 + cb + ni * 16;
            const int h = col >> 8, wi = col & 255;
            if (wi < 128) {
              *(uint2*)(p.KN + (size_t)row * 512 + h * 128 + wi) = pack4(acc[mi][ni]);
            } else {
              u16* dst = vb + (size_t)(h * 128 + (wi - 128)) * vst;
#pragma unroll
              for (int r = 0; r < 4; ++r) dst[(size_t)r * vst] = f2bf(acc[mi][ni][r]);
            }
          }
        }
      }
    }
  }
  }
}

__device__ __forceinline__ void phase_gemm_y(const u16* A, int lda, const u16* B, int K, int N, u16* Y, int ldy, u16* lds) {
  int mt, nt;
  for (int r = 0; tile_at(r, 288, N / 128, mt, nt); ++r) {
    const int m0 = mt * 128, n0 = nt * 128;
    f32x4 acc[4][4];
    gemm128(A + (size_t)m0 * lda, lda, B + (size_t)n0 * K, K, K, lds, acc);
    { GEMM_RC
#pragma unroll
      for (int mi = 0; mi < 4; ++mi)
#pragma unroll
        for (int ni = 0; ni < 4; ++ni)
          *(uint2*)(Y + (size_t)(m0 + rb + mi * 16) * ldy + n0 + cb + ni * 16) = pack4(acc[mi][ni]);
    }
  }
}

__device__ __forceinline__ void phase_e(const Params& p, int l, u16* lds) {
  const u16* Bw = p.WfiT + (size_t)l * 5632 * 1024;
  int mt, nt;
  for (int r = 0; tile_at(r, 144, 44, mt, nt); ++r) {
    const int m0 = mt * 256, n0 = nt * 128;
    f32x4 acc[8][4];
    gemm256(p.MIX + (size_t)m0 * 1024, 1024, Bw + (size_t)n0 * 1024, 1024, 1024, lds, acc);
    { GEMM256_RC
      const int g4x4 = ((tde & 63) >> 4) * 4;
      const int hc0 = ((n0 + cb - g4x4) >> 1) + g4x4;
#pragma unroll
      for (int mi = 0; mi < 8; ++mi)
#pragma unroll
        for (int ni = 0; ni < 2; ++ni) {
          f32x4 hv;
#pragma unroll
          for (int r = 0; r < 4; ++r) hv[r] = siluf_(acc[mi][ni][r]) * acc[mi][ni + 2][r];
          *(uint2*)(p.P + (size_t)(m0 + rb + mi * 16) * DFF + hc0 + ni * 16) = pack4(hv);
        }
    }
  }
}

#define KST 208
#define VST 80
#define PST 80
__device__ __forceinline__ void attn_item(const Params& p, int latent, int b, int h, int qb, unsigned char* smraw, int dummy = 0) {
  u16* sK = (u16*)smraw;
  u16* sV = sK + 64 * KST;
  u16* sP = sV + 128 * VST;
  const int tid = tid_l(), lane = tid & 63, w = tid >> 6, r16 = lane & 15, g4 = lane >> 4;
  const int nkeys = latent ? 4352 : 256;
  const int krow0 = latent ? T_CTX + b * 4096 : b * 256;
  const int tq0 = krow0 + qb * 128;
  const u16* vt = latent ? p.VTL + (size_t)((b * 4 + h) * 128) * 4352 : p.VTC + (size_t)((b * 4 + h) * 128) * 256;
  u16* sPw = sP + w * 32 * PST;
  bf16x8 q[2][6];
#pragma unroll
  for (int mi = 0; mi < 2; ++mi)
#pragma unroll
    for (int ks = 0; ks < 6; ++ks)
      q[mi][ks] = *(const bf16x8*)(p.HQ + (size_t)(tq0 + w * 32 + mi * 16 + r16) * 768 + h * 192 + ks * 32 + g4 * 8);
  f32x4 o[2][8];
  float mrow[2], lrow[2];
#pragma unroll
  for (int mi = 0; mi < 2; ++mi) {
#pragma unroll
    for (int nd = 0; nd < 8; ++nd) o[mi][nd] = f32x4{0.f, 0.f, 0.f, 0.f};
    mrow[mi] = -1e30f; lrow[mi] = 0.f;
  }
  const int lkey = tid >> 2, lpart = tid & 3;
  const int ldv = tid >> 1, lhalf = tid & 1;
  const int ntile = nkeys >> 6;
  uint4 k0, k1, k2, k3, k4, k5;
  {
    const int pos = lkey;
    const u16* srcn = p.KN + (size_t)(krow0 + pos) * 512 + h * 128 + lpart * 8;
    const u16* srcr = p.P + (size_t)(krow0 + pos) * PW + P_MKR + lpart * 8;
    k0 = *(const uint4*)(srcn); k1 = *(const uint4*)(srcn + 32); k2 = *(const uint4*)(srcn + 64); k3 = *(const uint4*)(srcn + 96);
    k4 = *(const uint4*)(srcr); k5 = *(const uint4*)(srcr + 32);
  }
  for (int kt = 0; kt < ntile; ++kt) {
    __syncthreads();
    {
      u16* dk = sK + lkey * KST + lpart * 8;
      *(uint4*)(dk) = k0; *(uint4*)(dk + 32) = k1; *(uint4*)(dk + 64) = k2; *(uint4*)(dk + 96) = k3;
      *(uint4*)(dk + 128) = k4; *(uint4*)(dk + 160) = k5;
    }
    const u16* sv = vt + (size_t)ldv * nkeys + kt * 64 + lhalf * 32;
    const uint4 v0 = *(const uint4*)(sv), v1 = *(const uint4*)(sv + 8), v2 = *(const uint4*)(sv + 16), v3 = *(const uint4*)(sv + 24);
    __syncthreads();
    f32x4 s[2][4];
#pragma unroll
    for (int mi = 0; mi < 2; ++mi)
#pragma unroll
      for (int ni = 0; ni < 4; ++ni) s[mi][ni] = f32x4{0.f, 0.f, 0.f, 0.f};
#pragma unroll
    for (int ks = 0; ks < 6; ++ks)
#pragma unroll
      for (int ni = 0; ni < 4; ++ni) {
        bf16x8 kf = *(const bf16x8*)(sK + (ni * 16 + r16) * KST + ks * 32 + g4 * 8);
        s[0][ni] = __builtin_amdgcn_mfma_f32_16x16x32_bf16(kf, q[0][ks], s[0][ni], 0, 0, 0);
        s[1][ni] = __builtin_amdgcn_mfma_f32_16x16x32_bf16(kf, q[1][ks], s[1][ni], 0, 0, 0);
      }
#pragma unroll
    for (int mi = 0; mi < 2; ++mi) {
      float mx = -1e30f;
#pragma unroll
      for (int ni = 0; ni < 4; ++ni)
#pragma unroll
        for (int r = 0; r < 4; ++r) mx = fmaxf(mx, s[mi][ni][r]);
      mx = fmaxf(mx, __shfl_xor(mx, 16)); mx = fmaxf(mx, __shfl_xor(mx, 32));
      const float mnew = fmaxf(mrow[mi], mx);
      const float alpha = __builtin_amdgcn_exp2f(mrow[mi] - mnew);
      mrow[mi] = mnew;
      float ps = 0.f;
#pragma unroll
      for (int ni = 0; ni < 4; ++ni) {
        f32x4 pv;
#pragma unroll
        for (int r = 0; r < 4; ++r) { pv[r] = __builtin_amdgcn_exp2f(s[mi][ni][r] - mnew); ps += pv[r]; }
        *(uint2*)(sPw + (mi * 16 + r16) * PST + ni * 16 + g4 * 4) = pack4(pv);
      }
      ps += __shfl_xor(ps, 16); ps += __shfl_xor(ps, 32);
      lrow[mi] = lrow[mi] * alpha + ps;
#pragma unroll
      for (int nd = 0; nd < 8; ++nd) o[mi][nd] *= alpha;
    }
    {
      u16* dvp = sV + ldv * VST + lhalf * 32;
      *(uint4*)(dvp) = v0; *(uint4*)(dvp + 8) = v1; *(uint4*)(dvp + 16) = v2; *(uint4*)(dvp + 24) = v3;
    }
    __syncthreads();
    if (kt + 1 < ntile) {
      const int pos = (kt + 1) * 64 + lkey;
      const bool own = (!latent) || pos < 4096;
      const int row = own ? krow0 + pos : T_ALL + b * 256 + (pos - 4096);
      const u16* srcn = p.KN + (size_t)row * 512 + h * 128 + lpart * 8;
      const u16* srcr = own ? p.P + (size_t)(krow0 + pos) * PW + P_MKR + lpart * 8
                            : p.KRC + (size_t)(b * 256 + pos - 4096) * 64 + lpart * 8;
      k0 = *(const uint4*)(srcn); k1 = *(const uint4*)(srcn + 32); k2 = *(const uint4*)(srcn + 64); k3 = *(const uint4*)(srcn + 96);
      k4 = *(const uint4*)(srcr); k5 = *(const uint4*)(srcr + 32);
    }
#pragma unroll
    for (int ks2 = 0; ks2 < 2; ++ks2) {
      bf16x8 pf0 = *(const bf16x8*)(sPw + (0 * 16 + r16) * PST + ks2 * 32 + g4 * 8);
      bf16x8 pf1 = *(const bf16x8*)(sPw + (1 * 16 + r16) * PST + ks2 * 32 + g4 * 8);
#pragma unroll
      for (int nd = 0; nd < 8; ++nd) {
        bf16x8 vf = *(const bf16x8*)(sV + (nd * 16 + r16) * VST + ks2 * 32 + g4 * 8);
        o[0][nd] = __builtin_amdgcn_mfma_f32_16x16x32_bf16(vf, pf0, o[0][nd], 0, 0, 0);
        o[1][nd] = __builtin_amdgcn_mfma_f32_16x16x32_bf16(vf, pf1, o[1][nd], 0, 0, 0);
      }
    }
  }
#pragma unroll
  for (int mi = 0; mi < 2; ++mi) {
    const float inv = 1.f / lrow[mi];
    const int qrow = tq0 + w * 32 + mi * 16 + r16;
    u16* op = p.HQ + (size_t)qrow * 768 + h * 192 + g4 * 4;
    if (dummy) op = p.HQ + (size_t)T_ALL * 768 + (size_t)(qrow % 9216) * 768 + h * 192 + g4 * 4;
#pragma unroll
    for (int nd = 0; nd < 8; ++nd) *(uint2*)(op + nd * 16) = pack4(o[mi][nd] * inv);
  }
}

#define XB_TMO      128
#define XB_XCNT(j)  (256  + 64 * (j))
#define XB_XSUB(j)  (1280 + 64 * (j))
#define XB_XGEN(j)  (2304 + 64 * (j))
#define XB_TOP      3328
#define XB_TOPGEN   3392
#define XCD_BAR_WORDS 3456
#define XB_SPIN_CAP (1u << 23)
#define LAS __attribute__((address_space(3)))

__device__ __forceinline__ unsigned xb_ld(unsigned* p)              { return __hip_atomic_load(p, __ATOMIC_RELAXED, __HIP_MEMORY_SCOPE_AGENT); }
__device__ __forceinline__ unsigned xb_add(unsigned* p, unsigned v) { return __hip_atomic_fetch_add(p, v, __ATOMIC_RELAXED, __HIP_MEMORY_SCOPE_AGENT); }
__device__ __forceinline__ unsigned xb_xcc_id() { return (unsigned)__builtin_amdgcn_s_getreg((3 << 11) | 20) & 0xFu; }
#define XB_SPIN(cond, bar) do { unsigned _sp = 0; while (cond) { __builtin_amdgcn_s_sleep(1); \
    if ((++_sp & 255u) == 0u) { if (xb_ld(&(bar)[XB_TMO])) break; if (_sp > XB_SPIN_CAP) { atomicAdd(&(bar)[XB_TMO], 1u); break; } } } } while (0)

struct XcdBarrier {
    unsigned* bar; unsigned x;
    volatile LAS unsigned* st;
};

__device__ __forceinline__ XcdBarrier xcd_barrier_post(unsigned* bar, volatile LAS unsigned* st) {
    XcdBarrier b; b.bar = bar; b.x = xb_xcc_id(); b.st = st;
    if (threadIdx.x == 0) (void)xb_add(&bar[XB_XCNT(b.x)], 1u);
    return b;
}
__device__ __forceinline__ void xcd_barrier_complete(unsigned* bar, unsigned x, unsigned& nloc, unsigned& nx) {
    const unsigned G = gridDim.x * gridDim.y * gridDim.z;
    unsigned sum, cnt, mine, sp = 0u;
    for (;;) {
        sum = 0u; cnt = 0u; mine = 0u;
#pragma unroll
        for (unsigned j = 0; j < 16; ++j) { const unsigned c = xb_ld(&bar[XB_XCNT(j)]); sum += c; cnt += (c > 0u) ? 1u : 0u; mine = (j == x) ? c : mine; }
        if (sum == G) break;
        __builtin_amdgcn_s_sleep(1);
        if ((++sp & 255u) == 0u) { if (xb_ld(&bar[XB_TMO])) break; if (sp > XB_SPIN_CAP) { atomicAdd(&bar[XB_TMO], 1u); break; } }
    }
    nloc = mine > 0u ? mine : 1u; nx = cnt > 0u ? cnt : 1u;
}

__device__ __forceinline__ void xcd_barrier(const XcdBarrier& b) {
    asm volatile("s_waitcnt vmcnt(0)" ::: "memory");
    __syncthreads();
    if (threadIdx.x == 0) {
        unsigned* bar = b.bar;
        __builtin_amdgcn_s_waitcnt(0);
        unsigned nloc = b.st[0], nx = b.st[1];
        if (nloc == 0u) { xcd_barrier_complete(bar, b.x, nloc, nx); b.st[0] = nloc; b.st[1] = nx; }
        const unsigned old = xb_add(&bar[XB_XSUB(b.x)], 1u);
        const unsigned gen = old / nloc;
        if (old + 1u == (gen + 1u) * nloc) {
            __builtin_amdgcn_fence(__ATOMIC_RELEASE, "agent");
            asm volatile("s_waitcnt vmcnt(0)" ::: "memory");
            const unsigned og = xb_add(&bar[XB_TOP], 1u);
            const unsigned tg = og / nx;
            if (og + 1u == (tg + 1u) * nx) xb_add(&bar[XB_TOPGEN], 1u);
            else XB_SPIN(xb_ld(&bar[XB_TOPGEN]) == tg, bar);
            __builtin_amdgcn_fence(__ATOMIC_ACQUIRE, "agent");
            xb_add(&bar[XB_XGEN(b.x)], 1u);
            asm volatile("s_waitcnt vmcnt(0)" ::: "memory");
        } else {
            XB_SPIN(xb_ld(&bar[XB_XGEN(b.x)]) == gen, bar);
            __builtin_amdgcn_fence(__ATOMIC_ACQUIRE, "agent");
            asm volatile("s_waitcnt vmcnt(0)" ::: "memory");
        }
    }
    __syncthreads();
}


__device__ __forceinline__ void gbar(unsigned* ctr, unsigned target) {
  asm volatile("s_waitcnt vmcnt(0)" ::: "memory");
  __syncthreads();
  if (tid_l() == 0) {
    __builtin_amdgcn_fence(__ATOMIC_RELEASE, "agent");
    asm volatile("s_waitcnt vmcnt(0)" ::: "memory");
    __hip_atomic_fetch_add(ctr, 1u, __ATOMIC_RELAXED, __HIP_MEMORY_SCOPE_AGENT);
    while (__hip_atomic_load(ctr, __ATOMIC_RELAXED, __HIP_MEMORY_SCOPE_AGENT) < target) __builtin_amdgcn_s_sleep(2);
    __builtin_amdgcn_fence(__ATOMIC_ACQUIRE, "agent");
    asm volatile("s_waitcnt vmcnt(0)" ::: "memory");
  }
  __syncthreads();
}
#define MFMA4(a, b, c) __builtin_amdgcn_mfma_f32_16x16x4f32((a), (b), (c), 0, 0, 0)

__device__ __forceinline__ float softplusf_(float x) { return fmaxf(x, 0.f) + log1pf(__expf(-fabsf(x))); }

__device__ __forceinline__ void gdn_chain(const Params& p, int l, int seq, int h, int d, int vs, float* sm) {
  float* sMM = sm;
  float* sK = sMM + 64 * 68;
  float* sW = sK + 64 * 65;
  float* sV = sW + 64 * 65;
  float* sS = sV + 64 * 33;
  float* sGc = sS + 64 * 33;
  float* sBeta = sGc + 64;
  float* sBg = sBeta + 64;
  const int tid = tid_l(), lane = tid & 63, w = tid >> 6, r16 = lane & 15, g4 = lane >> 4;
  const bool latent = seq >= 16;
  const int len = latent ? 4096 : 256;
  const int t0 = latent ? T_CTX + (seq - 16) * 4096 : seq * 256;
  const int nchunks = len >> 6;
  const float Acoef = -__expf(p.gdn_a_log[l * 8 + d * 4 + h]);
  const float dtb = p.gdn_dt_bias[l * 8 + d * 4 + h];
  f32x4 Sreg[2];
  __syncthreads();
  {
    const float* s0 = latent ? p.state_gdn + ((((size_t)(seq - 16) * 2 + l) * 2 + d) * 4 + h) * 4096 : nullptr;
#pragma unroll
    for (int n = 0; n < 2; ++n)
#pragma unroll
      for (int r = 0; r < 4; ++r) {
        const int kidx = 16 * w + g4 * 4 + r, cc = n * 16 + r16;
        float v = latent ? s0[kidx * 64 + vs * 32 + cc] : 0.f;
        Sreg[n][r] = v;
        sS[kidx * 33 + cc] = v;
      }
  }
  const u16* Pb = p.P + (size_t)t0 * PW;
  const u16* VHb = p.HQ + (size_t)T_ALL * 768 + (size_t)t0 * 256;
#define GDN_SRC(i, tl, tlo_) ({ const int e_ = (tl) + (i) * 256; const int u_ = e_ / 20, un_ = e_ % 20; \
    (un_ < 16) ? (Pb + (size_t)((tlo_) + u_) * PW + (un_ < 8 ? P_QH + h * 64 + un_ * 8 : P_KH + h * 64 + (un_ - 8) * 8)) \
               : (VHb + (size_t)((tlo_) + u_) * 256 + h * 64 + vs * 32 + (un_ - 16) * 8); })
  uint4 pf[5];
  float pga = 0.f, pgb = 0.f;
  {
    const int tlo = d == 0 ? 0 : len - 64;
#pragma unroll
    for (int i = 0; i < 5; ++i) pf[i] = *(const uint4*)GDN_SRC(i, tid, tlo);
    if (tid < 64) {
      const int u = d == 0 ? tid : 63 - tid;
      const float* gab = p.GAB + (size_t)(t0 + tlo + u) * 16;
      pga = gab[d * 4 + h]; pgb = gab[8 + d * 4 + h];
    }
  }
  for (int n = 0; n < nchunks; ++n) {
    const int tlo = d == 0 ? n * 64 : len - 64 * (n + 1);
    const int tl2 = tid_l();
#pragma unroll
    for (int i = 0; i < 5; ++i) {
      const int e = tl2 + i * 256;
      const int u = e / 20, un = e % 20;
      const int pp = d == 0 ? u : 63 - u;
      float* dq = un < 8 ? sW + pp * 65 + un * 8 : (un < 16 ? sK + pp * 65 + (un - 8) * 8 : sV + pp * 33 + (un - 16) * 8);
      const unsigned wv[4] = {pf[i].x, pf[i].y, pf[i].z, pf[i].w};
#pragma unroll
      for (int j = 0; j < 4; ++j) { dq[2 * j] = bf2f((u16)(wv[j] & 0xffff)); dq[2 * j + 1] = bf2f((u16)(wv[j] >> 16)); }
    }
    if (tid < 64) {
      const int pp = tid;
      float g = Acoef * softplusf_(pga + dtb);
      float bt = sigmoidf_(pgb);
#pragma unroll
      for (int o = 1; o < 64; o <<= 1) { float tt = __shfl_up(g, o); if (lane >= o) g += tt; }
      sGc[pp] = g; sBeta[pp] = bt; sBg[pp] = bt * __expf(g);
    }
    if (n + 1 < nchunks) {
      const int tlo2 = d == 0 ? (n + 1) * 64 : len - 64 * (n + 2);
#pragma unroll
      for (int i = 0; i < 5; ++i) pf[i] = *(const uint4*)GDN_SRC(i, tl2, tlo2);
      if (tid < 64) {
        const int u = d == 0 ? tid : 63 - tid;
        const float* gab = p.GAB + (size_t)(t0 + tlo2 + u) * 16;
        pga = gab[d * 4 + h]; pgb = gab[8 + d * 4 + h];
      }
    }
    __syncthreads();
    float qa[16];
#pragma unroll
    for (int s = 0; s < 16; ++s) qa[s] = sW[(16 * w + r16) * 65 + 4 * s + g4];
    const unsigned tcode = w == 0 ? 0x730u : (w == 1 ? 0xA51u : (w == 2 ? 0x062u : 0x0FBu));
    const int tcnt = w < 2 ? 3 : 2;
    f32x4 attacc[3];
#pragma unroll
    for (int t = 0; t < 3; ++t) {
      attacc[t] = f32x4{0.f, 0.f, 0.f, 0.f};
      if (t < tcnt) {
        const int ti = (tcode >> (4 * t)) & 3, tn = (tcode >> (4 * t + 2)) & 3;
        f32x4 accm = f32x4{0.f, 0.f, 0.f, 0.f};
        const float* ak = sK + (16 * ti + r16) * 65 + g4;
        const float* aq = sW + (16 * ti + r16) * 65 + g4;
        const float* bk = sK + (16 * tn + r16) * 65 + g4;
#pragma unroll
        for (int s = 0; s < 16; ++s) {
          const float bv = bk[4 * s];
          accm = MFMA4(ak[4 * s], bv, accm);
          attacc[t] = MFMA4(aq[4 * s], bv, attacc[t]);
        }
#pragma unroll
        for (int r = 0; r < 4; ++r) {
          const int i = 16 * ti + g4 * 4 + r, j = 16 * tn + r16;
          sMM[i * 68 + j] = (i > j) ? sBeta[i] * accm[r] * __expf(sGc[i] - sGc[j]) : 0.f;
        }
      }
    }
    __syncthreads();
    if (w == 0) {
      const int bi = tid >> 4, c = tid & 15;
      float* md = sMM + (16 * bi) * 68 + 16 * bi;
      float a[16];
#pragma unroll
      for (int r = 0; r < 16; ++r) a[r] = (r == c) ? 1.f : 0.f;
#pragma unroll
      for (int r = 1; r < 16; ++r) {
#pragma unroll
        for (int q4 = 0; q4 < (r + 3) / 4; ++q4) {
          const float4 m = *(const float4*)(md + r * 68 + 4 * q4);
          if (q4 * 4 + 0 < r) a[r] -= m.x * a[q4 * 4 + 0];
          if (q4 * 4 + 1 < r) a[r] -= m.y * a[q4 * 4 + 1];
          if (q4 * 4 + 2 < r) a[r] -= m.z * a[q4 * 4 + 2];
          if (q4 * 4 + 3 < r) a[r] -= m.w * a[q4 * 4 + 3];
        }
      }
      __builtin_amdgcn_fence(__ATOMIC_SEQ_CST, "wavefront");
#pragma unroll
      for (int r = 0; r < 16; ++r) md[r * 68 + c] = a[r];
    } else {
      for (int t = w - 1; t < 8; t += 3) {
        const int ti = t >> 1, tc = t & 1;
        const float bg = sBg[16 * ti + r16];
        const float* ak = sK + (16 * ti + r16) * 65 + g4;
        const float* bs = sS + g4 * 33 + 16 * tc + r16;
        f32x4 acc = f32x4{0.f, 0.f, 0.f, 0.f};
#pragma unroll
        for (int s = 0; s < 16; ++s) acc = MFMA4(ak[4 * s] * bg, bs[4 * s * 33], acc);
#pragma unroll
        for (int r = 0; r < 4; ++r) {
          const int i = 16 * ti + g4 * 4 + r, cc = 16 * tc + r16;
          sV[i * 33 + cc] = sV[i * 33 + cc] * sBeta[i] - acc[r];
        }
      }
    }
    __syncthreads();
    for (int ib = 0; ib < 4; ++ib) {
      if (w < 2) {
        const int ct = w;
        f32x4 acc = f32x4{0.f, 0.f, 0.f, 0.f};
        const float* am = sMM + (16 * ib + r16) * 68 + g4;
        const float* bx = sV + g4 * 33 + 16 * ct + r16;
        for (int s4 = 0; s4 < ib; ++s4) {
#pragma unroll
          for (int s = 0; s < 4; ++s) acc = MFMA4(am[16 * s4 + 4 * s], bx[(16 * s4 + 4 * s) * 33], acc);
        }
        f32x4 rm;
#pragma unroll
        for (int r = 0; r < 4; ++r) rm[r] = sV[(16 * ib + g4 * 4 + r) * 33 + 16 * ct + r16] - acc[r];
        const float* dd = sMM + (16 * ib + r16) * 68 + 16 * ib + 4 * g4;
        f32x4 xn = f32x4{0.f, 0.f, 0.f, 0.f};
#pragma unroll
        for (int s = 0; s < 4; ++s) xn = MFMA4(dd[s], rm[s], xn);
#pragma unroll
        for (int r = 0; r < 4; ++r) sV[(16 * ib + g4 * 4 + r) * 33 + 16 * ct + r16] = xn[r];
      }
      __syncthreads();
    }
#pragma unroll
    for (int t = 0; t < 3; ++t) {
      if (t < tcnt) {
        const int ti = (tcode >> (4 * t)) & 3, tn = (tcode >> (4 * t + 2)) & 3;
#pragma unroll
        for (int r = 0; r < 4; ++r) {
          const int i = 16 * ti + g4 * 4 + r, j = 16 * tn + r16;
          sMM[i * 68 + j] = (i >= j) ? attacc[t][r] * __expf(sGc[i] - sGc[j]) : 0.f;
        }
      }
    }
    __syncthreads();
    {
      f32x4 acc[2] = {f32x4{0.f, 0.f, 0.f, 0.f}, f32x4{0.f, 0.f, 0.f, 0.f}};
      const float eg = __expf(sGc[16 * w + r16]);
#pragma unroll
      for (int s = 0; s < 16; ++s) {
        const float a = qa[s] * eg;
        acc[0] = MFMA4(sS[(4 * s + g4) * 33 + r16], a, acc[0]);
        acc[1] = MFMA4(sS[(4 * s + g4) * 33 + 16 + r16], a, acc[1]);
      }
#pragma unroll
      for (int s = 0; s < 16; ++s) {
        if (s < 4 * (w + 1)) {
          const float a = sMM[(16 * w + r16) * 68 + 4 * s + g4];
          acc[0] = MFMA4(sV[(4 * s + g4) * 33 + r16], a, acc[0]);
          acc[1] = MFMA4(sV[(4 * s + g4) * 33 + 16 + r16], a, acc[1]);
        }
      }
      {
        const int pp = 16 * w + r16;
        const int u = d == 0 ? pp : 63 - pp;
        u16* op = p.MIX + (size_t)(t0 + tlo + u) * 1024 + d * 256 + h * 64 + vs * 32 + g4 * 4;
        *(uint2*)(op) = pack4(acc[0]);
        *(uint2*)(op + 16) = pack4(acc[1]);
      }
    }
    __syncthreads();
    {
      const float g63 = sGc[63];
      const float gl = __expf(g63);
#pragma unroll
      for (int nn = 0; nn < 2; ++nn)
#pragma unroll
        for (int r = 0; r < 4; ++r) Sreg[nn][r] *= gl;
#pragma unroll
      for (int s = 0; s < 16; ++s) {
        const int srow = 4 * s + g4;
        const float a = sK[srow * 65 + 16 * w + r16] * __expf(g63 - sGc[srow]);
        Sreg[0] = MFMA4(a, sV[srow * 33 + r16], Sreg[0]);
        Sreg[1] = MFMA4(a, sV[srow * 33 + 16 + r16], Sreg[1]);
      }
    }
    __syncthreads();
#pragma unroll
    for (int nn = 0; nn < 2; ++nn)
#pragma unroll
      for (int r = 0; r < 4; ++r) sS[(16 * w + g4 * 4 + r) * 33 + nn * 16 + r16] = Sreg[nn][r];
    __syncthreads();
  }
  if (!latent) {
    float* so = p.out + OUT_SGDN + ((((size_t)seq * 2 + l) * 2 + d) * 4 + h) * 4096;
#pragma unroll
    for (int nn = 0; nn < 2; ++nn)
#pragma unroll
      for (int r = 0; r < 4; ++r) so[(16 * w + g4 * 4 + r) * 64 + vs * 32 + nn * 16 + r16] = Sreg[nn][r];
  }
}

__device__ __forceinline__ void hgrn_chain(const Params& p, int l, int seq, int h, int d, int vs, float* sm) {
  float* sBC = sm;
  float* sK = sBC + 64 * 65;
  float* sAT = sK + 64 * 65;
  float* sV = sAT + 64 * 68;
  float* sS = sV + 64 * 33;
  float* sTot = sS + 64 * 33;
  const int tid = tid_l(), lane = tid & 63, w = tid >> 6, r16 = lane & 15, g4 = lane >> 4;
  const bool latent = seq >= 16;
  const int len = latent ? 4096 : 256;
  const int t0 = latent ? T_CTX + (seq - 16) * 4096 : seq * 256;
  const int nchunks = len >> 6;
  float lbk;
  {
    const int kch = h * 64 + (tid & 63);
    lbk = (l == 0) ? 0.f : sigmoidf_(p.hgrn_lb[256 + kch] - p.hgrn_lb[kch]);
  }
  f32x4 Sreg[2];
  __syncthreads();
  {
    const float* s0 = latent ? p.state_hgrn + ((((size_t)(seq - 16) * 2 + l) * 2 + d) * 4 + h) * 4096 : nullptr;
#pragma unroll
    for (int n = 0; n < 2; ++n)
#pragma unroll
      for (int r = 0; r < 4; ++r) {
        const int kidx = 16 * w + g4 * 4 + r, cc = n * 16 + r16;
        float v = latent ? s0[kidx * 64 + vs * 32 + cc] : 0.f;
        Sreg[n][r] = v;
        sS[kidx * 33 + cc] = v;
      }
  }
  const u16* Pb = p.P + (size_t)t0 * PW;
  float* sLb = sTot + 256;
  if (tid < 64) sLb[tid] = lbk;
  __syncthreads();
  int pgo[5];
#pragma unroll
  for (int i = 0; i < 5; ++i) {
    const int e = tid + i * 256;
    const int u = e / 20, un = e % 20;
    pgo[i] = u * PW + (un < 8 ? P_HF + d * 256 + h * 64 + un * 8 : (un < 12 ? P_HI + h * 64 + vs * 32 + (un - 8) * 8 : P_HQ + h * 64 + (un - 12) * 8));
  }
  uint4 pf[5];
  {
    const int tlo = d == 0 ? 0 : len - 64;
#pragma unroll
    for (int i = 0; i < 5; ++i) pf[i] = *(const uint4*)(Pb + (size_t)tlo * PW + pgo[i]);
  }
  for (int n = 0; n < nchunks; ++n) {
#pragma unroll
    for (int i = 0; i < 5; ++i) {
      const int e = tid + i * 256;
      const int u = e / 20, un = e % 20;
      const int pp = d == 0 ? u : 63 - u;
      const unsigned wv[4] = {pf[i].x, pf[i].y, pf[i].z, pf[i].w};
#pragma unroll
      for (int j = 0; j < 8; ++j) {
        const float x = bf2f((u16)((wv[j >> 1] >> ((j & 1) * 16)) & 0xffff));
        if (un < 8) {
          const int k = un * 8 + j;
          const float lb = sLb[k];
          const float sg_ = sigmoidf_(x);
          const float gate = lb + (1.f - lb) * sg_;
          sBC[pp * 65 + k] = __logf(fmaxf(gate, 1e-30f));
          sK[pp * 65 + k] = (1.f - lb) * (1.f - sg_);
        } else if (un < 12) {
          sV[pp * 33 + (un - 8) * 8 + j] = x;
        } else {
          sAT[pp * 68 + (un - 12) * 8 + j] = x;
        }
      }
    }
    __syncthreads();
    if (n + 1 < nchunks) {
      const int tlo2 = d == 0 ? (n + 1) * 64 : len - 64 * (n + 2);
#pragma unroll
      for (int i = 0; i < 5; ++i) pf[i] = *(const uint4*)(Pb + (size_t)tlo2 * PW + pgo[i]);
    }
    const int tlo = d == 0 ? n * 64 : len - 64 * (n + 1);
    float cs[16];
    {
      const int k = tid & 63, sg = tid >> 6;
      float run = 0.f;
#pragma unroll
      for (int i = 0; i < 16; ++i) { run += sBC[(16 * sg + i) * 65 + k]; cs[i] = run; }
      sTot[sg * 64 + k] = run;
    }
    float qa[16];
#pragma unroll
    for (int s = 0; s < 16; ++s) qa[s] = sAT[(16 * w + r16) * 68 + 4 * s + g4];
    __syncthreads();
    {
      const int k = tid & 63, sg = tid >> 6;
      float off = 0.f;
      for (int s2 = 0; s2 < sg; ++s2) off += sTot[s2 * 64 + k];
#pragma unroll
      for (int i = 0; i < 16; ++i) sBC[(16 * sg + i) * 65 + k] = cs[i] + off;
    }
    __syncthreads();
    {
      float aq[16], rf[16];
#pragma unroll
      for (int s = 0; s < 16; ++s) {
        const int kk = 4 * s + g4;
        rf[s] = (w == 0) ? 0.f : sBC[(16 * w - 1) * 65 + kk];
        aq[s] = qa[s] * __expf(sBC[(16 * w + r16) * 65 + kk] - rf[s]);
      }
#pragma unroll
      for (int nn = 0; nn < 4; ++nn) {
        f32x4 acc = f32x4{0.f, 0.f, 0.f, 0.f};
        if (nn <= w) {
#pragma unroll
          for (int s = 0; s < 16; ++s) {
            const int kk = 4 * s + g4, sc = 16 * nn + r16;
            const float bv = sK[sc * 65 + kk] * __expf(fminf(rf[s] - sBC[sc * 65 + kk], 80.f));
            acc = MFMA4(aq[s], bv, acc);
          }
        }
#pragma unroll
        for (int r = 0; r < 4; ++r) {
          const int i = 16 * w + g4 * 4 + r, j = 16 * nn + r16;
          sAT[i * 68 + j] = (i >= j) ? acc[r] : 0.f;
        }
      }
    }
    __syncthreads();
    {
      f32x4 acc[2] = {f32x4{0.f, 0.f, 0.f, 0.f}, f32x4{0.f, 0.f, 0.f, 0.f}};
#pragma unroll
      for (int s = 0; s < 16; ++s) {
        const int kk = 4 * s + g4;
        const float a = qa[s] * __expf(sBC[(16 * w + r16) * 65 + kk]);
        acc[0] = MFMA4(sS[kk * 33 + r16], a, acc[0]);
        acc[1] = MFMA4(sS[kk * 33 + 16 + r16], a, acc[1]);
      }
#pragma unroll
      for (int s = 0; s < 16; ++s) {
        if (s < 4 * (w + 1)) {
          const float a = sAT[(16 * w + r16) * 68 + 4 * s + g4];
          acc[0] = MFMA4(sV[(4 * s + g4) * 33 + r16], a, acc[0]);
          acc[1] = MFMA4(sV[(4 * s + g4) * 33 + 16 + r16], a, acc[1]);
        }
      }
      {
        const int pp = 16 * w + r16;
        const int u = d == 0 ? pp : 63 - pp;
        u16* op = p.MIX + (size_t)(t0 + tlo + u) * 1024 + 512 + d * 256 + h * 64 + vs * 32 + g4 * 4;
        *(uint2*)(op) = pack4(acc[0]);
        *(uint2*)(op + 16) = pack4(acc[1]);
      }
    }
    __syncthreads();
    {
#pragma unroll
      for (int nn = 0; nn < 2; ++nn)
#pragma unroll
        for (int r = 0; r < 4; ++r) Sreg[nn][r] *= __expf(sBC[63 * 65 + 16 * w + g4 * 4 + r]);
      const int kA = 16 * w + r16;
      const float blA = sBC[63 * 65 + kA];
#pragma unroll
      for (int s = 0; s < 16; ++s) {
        const int srow = 4 * s + g4;
        const float a = sK[srow * 65 + kA] * __expf(blA - sBC[srow * 65 + kA]);
        Sreg[0] = MFMA4(a, sV[srow * 33 + r16], Sreg[0]);
        Sreg[1] = MFMA4(a, sV[srow * 33 + 16 + r16], Sreg[1]);
      }
    }
    __syncthreads();
#pragma unroll
    for (int nn = 0; nn < 2; ++nn)
#pragma unroll
      for (int r = 0; r < 4; ++r) sS[(16 * w + g4 * 4 + r) * 33 + nn * 16 + r16] = Sreg[nn][r];
    __syncthreads();
  }
  if (!latent) {
    float* so = p.out + OUT_SHG + ((((size_t)seq * 2 + l) * 2 + d) * 4 + h) * 4096;
#pragma unroll
    for (int nn = 0; nn < 2; ++nn)
#pragma unroll
      for (int r = 0; r < 4; ++r) so[(16 * w + g4 * 4 + r) * 64 + vs * 32 + nn * 16 + r16] = Sreg[nn][r];
  }
}

__device__ __forceinline__ void phase_c(const Params& p, int l, unsigned char* smraw, int mode = 0) {
  __shared__ int s_item;
  const int total = 1920;
  for (;;) {
    __syncthreads();
    if (tid_l() == 0) s_item = (int)atomicAdd(&p.counters[l * 64 + mode * 16], 1u);
    __syncthreads();
    const int item = s_item;
    if (item >= total) break;
    int kind, a0, a1, a2, a3;
    if (item < 256 || (item >= 1280 && item < 1792)) {
      const int i2 = item < 256 ? item : item - 1280;
      const int rest = i2 >> 1;
      kind = i2 & 1;
      a3 = rest & 1; a2 = (rest >> 1) & 1; a1 = (rest >> 2) & 3; a0 = (rest >> 4) + (item < 256 ? 16 : 0);
    } else if (item < 1280) {
      const int i2 = item - 256;
      kind = 2; a0 = 1; a1 = i2 >> 7; a2 = (i2 >> 5) & 3; a3 = i2 & 31;
    } else {
      const int i2 = item - 1792;
      kind = 2; a0 = 0; a1 = i2 >> 3; a2 = (i2 >> 1) & 3; a3 = i2 & 1;
    }
    if (mode == 1 && kind == 2) continue;
    if (mode == 2 && kind != 2) continue;
    if (kind != 2) __builtin_amdgcn_s_setprio(3);
    if (kind == 0) gdn_chain(p, l, a0, a1, a2, a3, (float*)smraw);
    else if (kind == 1) hgrn_chain(p, l, a0, a1, a2, a3, (float*)smraw);
    if (kind != 2) __builtin_amdgcn_s_setprio(0);
    else attn_item(p, a0, a1, a2, a3, smraw, mode == 2);
  }
}

__global__ void __launch_bounds__(NTHR, 2) mega(Params p) {
  __shared__ __attribute__((aligned(16))) unsigned char smem[LDS_BYTES];
  cg::grid_group grid = cg::this_grid();
  __shared__ uint4 xb_words;
  if (threadIdx.x == 0) xb_words = make_uint4(0u, 0u, 0u, 0u);
  __syncthreads();
  {
    XcdBarrier xb0 = xcd_barrier_post(p.xbar, (volatile LAS unsigned*)&xb_words);
    if (threadIdx.x == 0) ((volatile LAS unsigned*)&xb_words)[2] = xb0.x;
  }
#define GSYNC() do { XcdBarrier xb_; xb_.bar = p.xbar; xb_.st = (volatile LAS unsigned*)&xb_words; xb_.x = 0; \
    if (threadIdx.x == 0) xb_.x = ((volatile LAS unsigned*)&xb_words)[2]; xcd_barrier(xb_); } while (0)
  phase0(p, (float*)smem);
  grid.sync();
  rowpass_norm(p, 0, 0);
  GSYNC();
  for (int l = 0; l < 2; ++l) {
    phase_a(p, l, (u16*)smem);
    GSYNC();
    rowpass_b0(p, l);
    GSYNC();
    phase_b1(p, l, (u16*)smem);
    GSYNC();
    rowpass_b2(p, l);
    GSYNC();
    phase_c(p, l, smem);
    GSYNC();
    rowpass_c2(p, l);
    GSYNC();
    phase_gemm_y(p.MIX, 1024, p.WoutT + (size_t)l * 1024 * 1024, 1024, 1024, p.HQ, 1024, (u16*)smem);
    GSYNC();
    rowpass_norm(p, l, 1);
    GSYNC();
    phase_e(p, l, (u16*)smem);
    GSYNC();
    phase_gemm_y(p.P, DFF, p.WfoT + (size_t)l * 1024 * DFF, DFF, 1024, p.HQ, 1024, (u16*)smem);
    GSYNC();
    rowpass_norm(p, l, 2);
    if (l == 0) GSYNC();
  }
}

extern "C" void kernel_launch(void* const* d_in, const int* in_sizes, int n_in, void* d_out, int out_size, void* d_ws,
                              size_t ws_size, hipStream_t stream) {
  static int grid_blocks = 0;
  if (!grid_blocks) {
    int dev = 0, cus = 0, per_cu = 0;
    hipGetDevice(&dev);
    hipDeviceGetAttribute(&cus, hipDeviceAttributeMultiprocessorCount, dev);
    hipOccupancyMaxActiveBlocksPerMultiprocessor(&per_cu, mega, NTHR, 0);
    if (per_cu > 2) per_cu = 2;
    if (per_cu < 1) per_cu = 1;
    grid_blocks = cus * per_cu;
  }
  Params p{};
  const float* const* in = (const float* const*)d_in;
  p.x_prompt = in[0]; p.x_sample = in[1]; p.cache_ckv = in[2]; p.cache_kr = in[3]; p.state_gdn = in[4]; p.state_hgrn = in[5];
  p.c = in[6]; p.c_ctx = in[7]; p.w_ada = in[8]; p.b_ada = in[9]; p.g_pre_mix = in[10]; p.g_post_mix = in[11];
  p.g_pre_ffn = in[12]; p.g_post_ffn = in[13]; p.w_in = in[14]; p.w_out = in[15]; p.gdn_conv_w = in[16];
  p.gdn_a_log = in[17]; p.gdn_dt_bias = in[18]; p.gdn_norm_w = in[19]; p.hgrn_lb = in[20]; p.hgrn_norm_w = in[21];
  p.mla_q_norm_w = in[22]; p.mla_w_uq = in[23]; p.mla_kv_norm_w = in[24]; p.mla_w_ukv = in[25]; p.w_ffn_in = in[26];
  p.w_ffn_out = in[27];
  p.out = (float*)d_out;
  unsigned char* ws = (unsigned char*)d_ws;
  size_t off = 0;
  auto take = [&](size_t bytes) { unsigned char* r = ws + off; off += (bytes + 255) & ~(size_t)255; return r; };
  p.counters = (unsigned*)take(1024);
  p.xbar = (unsigned*)take(16384);
  p.WinT = (u16*)take((size_t)2 * 3072 * 1024 * 2);
  p.WuqT = (u16*)take((size_t)2 * 768 * 384 * 2);
  p.WukvT = (u16*)take((size_t)2 * 1024 * 256 * 2);
  p.WoutT = (u16*)take((size_t)2 * 1024 * 1024 * 2);
  p.WfiT = (u16*)take((size_t)2 * 5632 * 1024 * 2);
  p.WfoT = (u16*)take((size_t)2 * 1024 * 2816 * 2);
  p.mod = (float*)take((size_t)2 * 9 * 6144 * 4);
  p.HQ = (u16*)take((size_t)T_ALL * 1024 * 2);
  p.P = (u16*)take((size_t)T_ALL * PW * 2);
  p.KN = (u16*)take((size_t)(T_ALL + 2048) * 512 * 2);
  p.VTL = (u16*)take((size_t)8 * 4 * 128 * 4352 * 2);
  p.VTC = (u16*)take((size_t)16 * 4 * 128 * 256 * 2);
  p.CKVC = (u16*)take((size_t)2048 * 256 * 2);
  p.KRC = (u16*)take((size_t)2048 * 64 * 2);
  p.GAB = (float*)take((size_t)T_ALL * 16 * 4);
  p.MIX = (u16*)take((size_t)T_ALL * 1024 * 2);
  if (off > ws_size) { fprintf(stderr, "workspace too small: need %zu have %zu\n", off, ws_size); return; }
  hipMemsetAsync(p.counters, 0, 1024 + 16384, stream);
  void* args[] = {&p};
  hipError_t e = hipLaunchCooperativeKernel((void*)mega, dim3(grid_blocks), dim3(NTHR), args, 0, stream);
  if (e != hipSuccess) fprintf(stderr, "cooperative launch failed: %s (grid %d)\n", hipGetErrorString(e), grid_blocks);
}
```

```cpp
#include <hip/hip_runtime.h>
#include <hip/hip_cooperative_groups.h>
#include <cstdio>
namespace cg = cooperative_groups;

typedef unsigned short u16;
using bf16x8 = __attribute__((ext_vector_type(8))) short;
using f32x4  = __attribute__((ext_vector_type(4))) float;

#define T_CTX 4096
#define T_ALL 36864
#define PW 3072
#define DFF 2816
#define LDS_BYTES 73728
#define NTHR 256

#define P_GQKV 0
#define P_GZ 768
#define P_HQ 1024
#define P_HI 1280
#define P_HF 1536
#define P_HG 2048
#define P_MCQ 2304
#define P_MCKV 2688
#define P_MKR 2944
#define P_GA 3008

struct Params {
  const float *x_prompt, *x_sample, *cache_ckv, *cache_kr, *state_gdn, *state_hgrn, *c, *c_ctx;
  const float *w_ada, *b_ada, *g_pre_mix, *g_post_mix, *g_pre_ffn, *g_post_ffn, *w_in, *w_out;
  const float *gdn_conv_w, *gdn_a_log, *gdn_dt_bias, *gdn_norm_w, *hgrn_lb, *hgrn_norm_w;
  const float *mla_q_norm_w, *mla_w_uq, *mla_kv_norm_w, *mla_w_ukv, *w_ffn_in, *w_ffn_out;
  float* out;
  u16 *WinT, *WuqT, *WukvT, *WoutT, *WfiT, *WfoT;
  float* mod;
  u16 *HQ, *P, *KN, *VTL, *VTC, *CKVC, *KRC, *MIX;
  float* GAB;
  unsigned* counters;
  unsigned* xbar;
};

#define OUT_CKV   37748736
#define OUT_KR    39845888
#define OUT_SGDN  40370176
#define OUT_SHG   41418752

__device__ __forceinline__ u16 f2bf(float f) {
  unsigned u = __float_as_uint(f);
  u += 0x7fffu + ((u >> 16) & 1u);
  return (u16)(u >> 16);
}
__device__ __forceinline__ float bf2f(u16 h) { return __uint_as_float(((unsigned)h) << 16); }
__device__ __forceinline__ float wave_sum(float v) {
#pragma unroll
  for (int o = 32; o > 0; o >>= 1) v += __shfl_xor(v, o);
  return v;
}
__device__ __forceinline__ float sigmoidf_(float x) { return __builtin_amdgcn_rcpf(1.f + __expf(-x)); }
__device__ __forceinline__ float siluf_(float x) { return x * __builtin_amdgcn_rcpf(1.f + __expf(-x)); }
__device__ __forceinline__ int tid_l() { int t = threadIdx.x; asm volatile("" : "+v"(t)); return t; }
__device__ __forceinline__ int tok_mod(int t) { return t < T_CTX ? 0 : 1 + ((t - T_CTX) >> 12); }

__device__ __forceinline__ int map_col(int kind, int j) {
  if (kind == 0) return j;
  if (kind == 1) { if (j < 1024) return j; if (j < 3008) return j + 16; if (j < 3024) return 1024 + (j - 3008); return -1; }
  int blk = j >> 6, w = j & 63;
  return w < 32 ? blk * 32 + w : DFF + blk * 32 + (w - 32);
}

__device__ __forceinline__ void cvt_tile(const float* __restrict__ src, int K, int Nsrc, u16* __restrict__ dst, int kind, int jt, int kt, float* sm) {
  const int tid = tid_l();
  const int j0 = jt * 64, k0 = kt * 64;
  __syncthreads();
  {
    int jj = tid & 63, kk0 = tid >> 6;
    int sc = map_col(kind, j0 + jj);
    for (int kk = kk0; kk < 64; kk += 4)
      sm[kk * 65 + jj] = sc >= 0 ? src[(size_t)(k0 + kk) * Nsrc + sc] : 0.f;
  }
  __syncthreads();
  {
    const int kq = tid & 15, jj0 = tid >> 4;
#pragma unroll
    for (int jj = jj0; jj < 64; jj += 16) {
      uint2 o;
      o.x = (unsigned)f2bf(sm[(4 * kq + 0) * 65 + jj]) | ((unsigned)f2bf(sm[(4 * kq + 1) * 65 + jj]) << 16);
      o.y = (unsigned)f2bf(sm[(4 * kq + 2) * 65 + jj]) | ((unsigned)f2bf(sm[(4 * kq + 3) * 65 + jj]) << 16);
      *(uint2*)(dst + (size_t)(j0 + jj) * K + k0 + 4 * kq) = o;
    }
  }
}

__device__ __forceinline__ void mod_item(const Params& p, int item, float* sm) {
  const int l = item / 96, j0 = (item % 96) * 64;
  const int tid = tid_l();
  float* sC = sm;
  float* sR = sm + 9 * 1024;
  __syncthreads();
  for (int i = tid; i < 9 * 1024; i += NTHR) {
    int m = i >> 10, k = i & 1023;
    float v = m == 0 ? p.c_ctx[k] : p.c[(m - 1) * 1024 + k];
    sC[i] = siluf_(v);
  }
  __syncthreads();
  const int col = tid & 63, ks = tid >> 6;
  float acc[9];
#pragma unroll
  for (int m = 0; m < 9; ++m) acc[m] = 0.f;
  const float* wp = p.w_ada + (size_t)l * 1024 * 6144 + j0 + col;
  for (int k = ks * 256; k < ks * 256 + 256; k += 8) {
    float wv[8];
#pragma unroll
    for (int u = 0; u < 8; ++u) wv[u] = wp[(size_t)(k + u) * 6144];
#pragma unroll
    for (int u = 0; u < 8; ++u)
#pragma unroll
      for (int m = 0; m < 9; ++m) acc[m] += sC[m * 1024 + k + u] * wv[u];
  }
#pragma unroll
  for (int m = 0; m < 9; ++m) sR[(ks * 9 + m) * 64 + col] = acc[m];
  __syncthreads();
  for (int i = tid; i < 9 * 64; i += NTHR) {
    int m = i >> 6, cc = i & 63;
    float v = sR[(0 * 9 + m) * 64 + cc] + sR[(1 * 9 + m) * 64 + cc] + sR[(2 * 9 + m) * 64 + cc] + sR[(3 * 9 + m) * 64 + cc];
    p.mod[((size_t)l * 9 + m) * 6144 + j0 + cc] = v + p.b_ada[l * 6144 + j0 + cc];
  }
}

__device__ __forceinline__ void phase0(const Params& p, float* sm) {
  const int PER_LAYER = 3272;
  const int total = 2 * PER_LAYER + 192;
  for (int item = blockIdx.x; item < total; item += gridDim.x) {
    if (item < 192) { mod_item(p, item, sm); continue; }
    int it = item - 192;
    int l = it / PER_LAYER, r = it % PER_LAYER;
    if (r < 768) { cvt_tile(p.w_in + (size_t)l * 1024 * 3024, 1024, 3024, p.WinT + (size_t)l * 3072 * 1024, 1, r / 16, r % 16, sm); continue; }
    r -= 768;
    if (r < 72) { cvt_tile(p.mla_w_uq + (size_t)l * 384 * 768, 384, 768, p.WuqT + (size_t)l * 768 * 384, 0, r / 6, r % 6, sm); continue; }
    r -= 72;
    if (r < 64) { cvt_tile(p.mla_w_ukv + (size_t)l * 256 * 1024, 256, 1024, p.WukvT + (size_t)l * 1024 * 256, 0, r / 4, r % 4, sm); continue; }
    r -= 64;
    if (r < 256) { cvt_tile(p.w_out + (size_t)l * 1024 * 1024, 1024, 1024, p.WoutT + (size_t)l * 1024 * 1024, 0, r / 16, r % 16, sm); continue; }
    r -= 256;
    if (r < 1408) { cvt_tile(p.w_ffn_in + (size_t)l * 1024 * 5632, 1024, 5632, p.WfiT + (size_t)l * 5632 * 1024, 2, r / 16, r % 16, sm); continue; }
    r -= 1408;
    cvt_tile(p.w_ffn_out + (size_t)l * 2816 * 1024, 2816, 1024, p.WfoT + (size_t)l * 1024 * 2816, 0, r / 44, r % 44, sm);
  }
}

__device__ __forceinline__ void rowpass_norm(const Params& p, int l, int stage) {
  const int tidl = tid_l();
  const int lane = tidl & 63, w = tidl >> 6;
  const int ln = stage == 0 ? 0 : (stage == 1 ? l : l + 1);
  const int sh_off = stage == 1 ? 3072 : 0;
  const float* gpre = stage == 1 ? p.g_pre_ffn + l * 1024 : p.g_pre_mix + (ln < 2 ? ln : 0) * 1024;
  u16* dst = stage == 1 ? p.MIX : p.HQ;
  for (int t = blockIdx.x * 4 + w; t < T_ALL; t += gridDim.x * 4) {
    const int m = tok_mod(t);
    float x[16];
    float* xo = p.out + (size_t)t * 1024;
    if (stage == 0) {
      const float* xi = t < T_CTX ? p.x_prompt + (size_t)t * 1024 : p.x_sample + (size_t)(t - T_CTX) * 1024;
#pragma unroll
      for (int i = 0; i < 4; ++i) {
        float4 v = *(const float4*)(xi + i * 256 + lane * 4);
        x[i * 4 + 0] = v.x; x[i * 4 + 1] = v.y; x[i * 4 + 2] = v.z; x[i * 4 + 3] = v.w;
      }
    } else {
      const u16* yp = p.HQ + (size_t)t * 1024;
      float y[16]; float ss = 0.f;
#pragma unroll
      for (int i = 0; i < 4; ++i) {
        uint2 v = *(const uint2*)(yp + i * 256 + lane * 4);
        y[i * 4 + 0] = bf2f((u16)(v.x & 0xffff)); y[i * 4 + 1] = bf2f((u16)(v.x >> 16));
        y[i * 4 + 2] = bf2f((u16)(v.y & 0xffff)); y[i * 4 + 3] = bf2f((u16)(v.y >> 16));
      }
#pragma unroll
      for (int i = 0; i < 16; ++i) ss += y[i] * y[i];
      ss = wave_sum(ss);
      const float rstd = rsqrtf(ss * (1.f / 1024.f) + 1e-6f);
      const float* gpost = (stage == 1 ? p.g_post_mix : p.g_post_ffn) + l * 1024;
      const float* gt = p.mod + ((size_t)l * 9 + m) * 6144 + (stage == 1 ? 2048 : 5120);
#pragma unroll
      for (int i = 0; i < 4; ++i) {
        float4 xv = *(const float4*)(xo + i * 256 + lane * 4);
        float4 gp = *(const float4*)(gpost + i * 256 + lane * 4);
        float4 gg = *(const float4*)(gt + i * 256 + lane * 4);
        x[i * 4 + 0] = xv.x + gg.x * y[i * 4 + 0] * rstd * gp.x;
        x[i * 4 + 1] = xv.y + gg.y * y[i * 4 + 1] * rstd * gp.y;
        x[i * 4 + 2] = xv.z + gg.z * y[i * 4 + 2] * rstd * gp.z;
        x[i * 4 + 3] = xv.w + gg.w * y[i * 4 + 3] * rstd * gp.w;
      }
    }
    __threadfence_block();
#pragma unroll
    for (int i = 0; i < 4; ++i)
      *(float4*)(xo + i * 256 + lane * 4) = make_float4(x[i * 4 + 0], x[i * 4 + 1], x[i * 4 + 2], x[i * 4 + 3]);
    if (ln >= 2) continue;
    float ss = 0.f;
#pragma unroll
    for (int i = 0; i < 16; ++i) ss += x[i] * x[i];
    ss = wave_sum(ss);
    const float rstd = rsqrtf(ss * (1.f / 1024.f) + 1e-6f);
    const float* sh = p.mod + ((size_t)ln * 9 + m) * 6144 + sh_off;
    const float* sc = sh + 1024;
    u16* hp = dst + (size_t)t * 1024;
#pragma unroll
    for (int i = 0; i < 4; ++i) {
      float4 gp = *(const float4*)(gpre + i * 256 + lane * 4);
      float4 s1 = *(const float4*)(sh + i * 256 + lane * 4);
      float4 c1 = *(const float4*)(sc + i * 256 + lane * 4);
      float h0 = x[i * 4 + 0] * rstd * gp.x * (1.f + c1.x) + s1.x;
      float h1 = x[i * 4 + 1] * rstd * gp.y * (1.f + c1.y) + s1.y;
      float h2 = x[i * 4 + 2] * rstd * gp.z * (1.f + c1.z) + s1.z;
      float h3 = x[i * 4 + 3] * rstd * gp.w * (1.f + c1.w) + s1.w;
      uint2 o;
      o.x = (unsigned)f2bf(h0) | ((unsigned)f2bf(h1) << 16);
      o.y = (unsigned)f2bf(h2) | ((unsigned)f2bf(h3) << 16);
      *(uint2*)(hp + i * 256 + lane * 4) = o;
    }
  }
}

__device__ __forceinline__ void unpack8(const uint4 v, float (&f)[8]);
__device__ __forceinline__ uint4 pack8(const float (&f)[8]);
__device__ __forceinline__ void rowpass_b0(const Params& p, int l) {
  const int tidl = tid_l();
  const int lane = tidl & 63, w = tidl >> 6;
  for (int t = blockIdx.x * 4 + w; t < T_ALL + 2048; t += gridDim.x * 4) {
    if (t >= T_ALL) {
      const int r = t - T_ALL, b = r >> 8, s = r & 255;
      if (lane < 32) {
        const float* ck = p.cache_ckv + (((size_t)b * 2 + l) * 256 + s) * 256 + lane * 8;
        const float4 x0 = *(const float4*)ck, x1 = *(const float4*)(ck + 4);
        const float f[8] = {x0.x, x0.y, x0.z, x0.w, x1.x, x1.y, x1.z, x1.w};
        *(uint4*)(p.CKVC + (size_t)r * 256 + lane * 8) = pack8(f);
      } else if (lane < 40) {
        const float* kr = p.cache_kr + (((size_t)b * 2 + l) * 256 + s) * 64 + (lane - 32) * 8;
        const float4 x0 = *(const float4*)kr, x1 = *(const float4*)(kr + 4);
        const float f[8] = {x0.x, x0.y, x0.z, x0.w, x1.x, x1.y, x1.z, x1.w};
        *(uint4*)(p.KRC + (size_t)r * 64 + (lane - 32) * 8) = pack8(f);
      }
      continue;
    }
    u16* pr = p.P + (size_t)t * PW;
    {
      float f[8]; float ss = 0.f;
      if (lane < 48) {
        unpack8(*(const uint4*)(pr + P_MCQ + lane * 8), f);
#pragma unroll
        for (int i = 0; i < 8; ++i) ss += f[i] * f[i];
      }
      ss = wave_sum(ss);
      const float rstd = rsqrtf(ss * (1.f / 384.f) + 1e-6f);
      if (lane < 48) {
        const float* wq = p.mla_q_norm_w + l * 384 + lane * 8;
        const float4 w0 = *(const float4*)wq, w1 = *(const float4*)(wq + 4);
        f[0] *= rstd * w0.x; f[1] *= rstd * w0.y; f[2] *= rstd * w0.z; f[3] *= rstd * w0.w;
        f[4] *= rstd * w1.x; f[5] *= rstd * w1.y; f[6] *= rstd * w1.z; f[7] *= rstd * w1.w;
        *(uint4*)(pr + P_MCQ + lane * 8) = pack8(f);
      }
    }
    {
      float f[8]; float ss = 0.f;
      if (lane < 32) {
        unpack8(*(const uint4*)(pr + P_MCKV + lane * 8), f);
#pragma unroll
        for (int i = 0; i < 8; ++i) ss += f[i] * f[i];
      }
      ss = wave_sum(ss);
      const float rstd = rsqrtf(ss * (1.f / 256.f) + 1e-6f);
      if (lane < 32) {
        const float* wk = p.mla_kv_norm_w + l * 256 + lane * 8;
        const float4 w0 = *(const float4*)wk, w1 = *(const float4*)(wk + 4);
        f[0] *= rstd * w0.x; f[1] *= rstd * w0.y; f[2] *= rstd * w0.z; f[3] *= rstd * w0.w;
        f[4] *= rstd * w1.x; f[5] *= rstd * w1.y; f[6] *= rstd * w1.z; f[7] *= rstd * w1.w;
        *(uint4*)(pr + P_MCKV + lane * 8) = pack8(f);
        if (t < T_CTX) {
          const int b = t >> 8, s = t & 255;
          float* op = p.out + OUT_CKV + (((size_t)b * 2 + l) * 256 + s) * 256 + lane * 8;
          *(float4*)op = make_float4(f[0], f[1], f[2], f[3]);
          *(float4*)(op + 4) = make_float4(f[4], f[5], f[6], f[7]);
        }
      }
    }
    {
      float v = bf2f(pr[P_MKR + lane]);
      if (t < T_CTX) {
        int b = t >> 8, s = t & 255;
        p.out[OUT_KR + (((size_t)b * 2 + l) * 256 + s) * 64 + lane] = v;
      } else {
        int pos = (t - T_CTX) & 4095;
        int axis = lane >> 5, half = (lane >> 4) & 1, f = lane & 15;
        float posf = axis == 0 ? (float)(pos >> 6) : (float)(pos & 63);
        float inv = exp2f(-(float)f * (13.287712379549449f / 16.f));
        float ang = posf * inv;
        float sn, cs;
        __sincosf(ang, &sn, &cs);
        float other = __shfl_xor(v, 16);
        float o = half == 0 ? v * cs - other * sn : v * cs + other * sn;
        pr[P_MKR + lane] = f2bf(o);
      }
    }
  }
}

#define P_QH 2304
#define P_KH 2560
__device__ __forceinline__ void rowpass_b2(const Params& p, int l) {
  const int tidl = tid_l();
  const int lane = tidl & 63, w = tidl >> 6;
  float cw[8][5], cv[8][5];
#pragma unroll
  for (int e = 0; e < 8; ++e)
#pragma unroll
    for (int j = 0; j < 5; ++j) {
      cw[e][j] = p.gdn_conv_w[((size_t)l * 768 + 8 * lane + e) * 5 + j];
      cv[e][j] = p.gdn_conv_w[((size_t)l * 768 + 512 + 8 * (lane & 31) + e) * 5 + j];
    }
  u16* VH = p.HQ + (size_t)T_ALL * 768;
  for (int t = blockIdx.x * 4 + w; t < T_ALL; t += gridDim.x * 4) {
    const int len = t < T_CTX ? 256 : 4096;
    const int tau = t < T_CTX ? (t & 255) : ((t - T_CTX) & 4095);
    float y[8], yv[8];
#pragma unroll
    for (int e = 0; e < 8; ++e) { y[e] = 0.f; yv[e] = 0.f; }
#pragma unroll
    for (int j = 0; j < 5; ++j) {
      const int tt = tau + j - 2;
      if (tt >= 0 && tt < len) {
        const u16* pr = p.P + (size_t)(t + j - 2) * PW;
        float f[8];
        unpack8(*(const uint4*)(pr + 8 * lane), f);
#pragma unroll
        for (int e = 0; e < 8; ++e) y[e] += cw[e][j] * f[e];
        if (lane < 32) {
          unpack8(*(const uint4*)(pr + 512 + 8 * lane), f);
#pragma unroll
          for (int e = 0; e < 8; ++e) yv[e] += cv[e][j] * f[e];
        }
      }
    }
    float ss = 0.f;
#pragma unroll
    for (int e = 0; e < 8; ++e) { y[e] = siluf_(y[e]); yv[e] = siluf_(yv[e]); ss += y[e] * y[e]; }
    ss += __shfl_xor(ss, 1); ss += __shfl_xor(ss, 2); ss += __shfl_xor(ss, 4);
    const float rn = rsqrtf(ss + 1e-6f) * (lane < 32 ? 0.125f : 1.f);
#pragma unroll
    for (int e = 0; e < 8; ++e) y[e] *= rn;
    *(uint4*)(p.P + (size_t)t * PW + P_QH + 8 * lane) = pack8(y);
    if (lane < 32) *(uint4*)(VH + (size_t)t * 256 + 8 * lane) = pack8(yv);
  }
}

__device__ __forceinline__ void unpack8(const uint4 v, float (&f)[8]) {
  f[0] = bf2f((u16)(v.x & 0xffff)); f[1] = bf2f((u16)(v.x >> 16)); f[2] = bf2f((u16)(v.y & 0xffff)); f[3] = bf2f((u16)(v.y >> 16));
  f[4] = bf2f((u16)(v.z & 0xffff)); f[5] = bf2f((u16)(v.z >> 16)); f[6] = bf2f((u16)(v.w & 0xffff)); f[7] = bf2f((u16)(v.w >> 16));
}
__device__ __forceinline__ uint4 pack8(const float (&f)[8]) {
  uint4 o;
  o.x = (unsigned)f2bf(f[0]) | ((unsigned)f2bf(f[1]) << 16); o.y = (unsigned)f2bf(f[2]) | ((unsigned)f2bf(f[3]) << 16);
  o.z = (unsigned)f2bf(f[4]) | ((unsigned)f2bf(f[5]) << 16); o.w = (unsigned)f2bf(f[6]) | ((unsigned)f2bf(f[7]) << 16);
  return o;
}
__device__ __forceinline__ void rowpass_c2(const Params& p, int l) {
  const int tidl = tid_l();
  const int lane = tidl & 63, w = tidl >> 6;
  const int hl = lane & 31, isH = lane >> 5;
  const float* nw = (isH ? p.hgrn_norm_w : p.gdn_norm_w) + l * 64 + (hl & 7) * 8;
  const float4 w0 = *(const float4*)(nw), w1 = *(const float4*)(nw + 4);
  const float wv[8] = {w0.x, w0.y, w0.z, w0.w, w1.x, w1.y, w1.z, w1.w};
  for (int t = blockIdx.x * 4 + w; t < T_ALL; t += gridDim.x * 4) {
    u16* mr = p.MIX + (size_t)t * 1024;
    const u16* pr = p.P + (size_t)t * PW;
    const u16* qr = p.HQ + (size_t)t * 768;
    const uint4 vf = *(const uint4*)(mr + isH * 512 + hl * 8);
    const uint4 vb = *(const uint4*)(mr + isH * 512 + 256 + hl * 8);
    const uint4 vg = *(const uint4*)(pr + (isH ? P_HG : P_GZ) + hl * 8);
    const int c0 = lane * 8;
    const uint4 vo = *(const uint4*)(qr + (c0 >> 7) * 192 + (c0 & 127));
    float f[8], bb[8], g[8];
    unpack8(vf, f); unpack8(vb, bb); unpack8(vg, g);
    float ss = 0.f;
#pragma unroll
    for (int i = 0; i < 8; ++i) { f[i] += bb[i]; ss += f[i] * f[i]; }
    ss += __shfl_xor(ss, 1); ss += __shfl_xor(ss, 2); ss += __shfl_xor(ss, 4);
    const float rn = rsqrtf(ss * (1.f / 64.f) + 1e-6f);
#pragma unroll
    for (int i = 0; i < 8; ++i) f[i] = f[i] * rn * wv[i] * (isH ? sigmoidf_(g[i]) : siluf_(g[i]));
    __threadfence_block();
    *(uint4*)(mr + isH * 256 + hl * 8) = pack8(f);
    *(uint4*)(mr + 512 + c0) = vo;
  }
}

__device__ __forceinline__ void gemm128(const u16* __restrict__ A, int lda, const u16* __restrict__ B, int ldb, int K,
                                        u16* lds, f32x4 (&acc)[4][4]) {
  const int tid = tid_l(), lane = tid & 63, w = tid >> 6, wm = w >> 1, wn = w & 1;
  const int r16 = lane & 15, g4 = lane >> 4;
#pragma unroll
  for (int i = 0; i < 4; ++i)
#pragma unroll
    for (int j = 0; j < 4; ++j) acc[i][j] = f32x4{0.f, 0.f, 0.f, 0.f};
  const int lrow = tid >> 3, lkc = tid & 7;
  const u16* ap = A + (size_t)lrow * lda + lkc * 8;
  const u16* bp = B + (size_t)lrow * ldb + lkc * 8;
  const size_t sa32 = (size_t)32 * lda, sb32 = (size_t)32 * ldb;
  uint4 ra0 = *(const uint4*)(ap), ra1 = *(const uint4*)(ap + sa32), ra2 = *(const uint4*)(ap + 2 * sa32), ra3 = *(const uint4*)(ap + 3 * sa32);
  uint4 rb0 = *(const uint4*)(bp), rb1 = *(const uint4*)(bp + sb32), rb2 = *(const uint4*)(bp + 2 * sb32), rb3 = *(const uint4*)(bp + 3 * sb32);
  const int woff = lrow * 64 + ((lkc ^ (lrow & 7)) * 8);
  const int sw = r16 & 7;
  const int fa0 = (wm * 64 + r16) * 64 + ((g4 ^ sw) * 8);
  const int fa1 = (wm * 64 + r16) * 64 + (((4 + g4) ^ sw) * 8);
  const int fb0 = 128 * 64 + (wn * 64 + r16) * 64 + ((g4 ^ sw) * 8);
  const int fb1 = 128 * 64 + (wn * 64 + r16) * 64 + (((4 + g4) ^ sw) * 8);
  const int nk = K >> 6;
  __syncthreads();
  {
    u16* wa = lds + woff; u16* wb = lds + 128 * 64 + woff;
    *(uint4*)(wa) = ra0; *(uint4*)(wa + 32 * 64) = ra1; *(uint4*)(wa + 64 * 64) = ra2; *(uint4*)(wa + 96 * 64) = ra3;
    *(uint4*)(wb) = rb0; *(uint4*)(wb + 32 * 64) = rb1; *(uint4*)(wb + 64 * 64) = rb2; *(uint4*)(wb + 96 * 64) = rb3;
  }
  if (nk > 1) {
    const u16* a2 = ap + 64; const u16* b2 = bp + 64;
    ra0 = *(const uint4*)(a2); ra1 = *(const uint4*)(a2 + sa32); ra2 = *(const uint4*)(a2 + 2 * sa32); ra3 = *(const uint4*)(a2 + 3 * sa32);
    rb0 = *(const uint4*)(b2); rb1 = *(const uint4*)(b2 + sb32); rb2 = *(const uint4*)(b2 + 2 * sb32); rb3 = *(const uint4*)(b2 + 3 * sb32);
  }
  __syncthreads();
  for (int kt = 0; kt < nk; ++kt) {
    const u16* cur = lds + (kt & 1) * (256 * 64);
    if (kt + 1 < nk) {
      u16* nxt = lds + ((kt + 1) & 1) * (256 * 64);
      u16* wa = nxt + woff; u16* wb = nxt + 128 * 64 + woff;
      *(uint4*)(wa) = ra0; *(uint4*)(wa + 32 * 64) = ra1; *(uint4*)(wa + 64 * 64) = ra2; *(uint4*)(wa + 96 * 64) = ra3;
      *(uint4*)(wb) = rb0; *(uint4*)(wb + 32 * 64) = rb1; *(uint4*)(wb + 64 * 64) = rb2; *(uint4*)(wb + 96 * 64) = rb3;
      if (kt + 2 < nk) {
        const u16* a2 = ap + (kt + 2) * 64; const u16* b2 = bp + (kt + 2) * 64;
        ra0 = *(const uint4*)(a2); ra1 = *(const uint4*)(a2 + sa32); ra2 = *(const uint4*)(a2 + 2 * sa32); ra3 = *(const uint4*)(a2 + 3 * sa32);
        rb0 = *(const uint4*)(b2); rb1 = *(const uint4*)(b2 + sb32); rb2 = *(const uint4*)(b2 + 2 * sb32); rb3 = *(const uint4*)(b2 + 3 * sb32);
      }
    }
    {
      const u16* pa0 = cur + fa0; const u16* pa1 = cur + fa1; const u16* pb0 = cur + fb0; const u16* pb1 = cur + fb1;
      bf16x8 a0 = *(const bf16x8*)(pa0), a1 = *(const bf16x8*)(pa0 + 16 * 64), a2 = *(const bf16x8*)(pa0 + 32 * 64), a3 = *(const bf16x8*)(pa0 + 48 * 64);
      bf16x8 b0 = *(const bf16x8*)(pb0), b1 = *(const bf16x8*)(pb0 + 16 * 64), b2 = *(const bf16x8*)(pb0 + 32 * 64), b3 = *(const bf16x8*)(pb0 + 48 * 64);
      bf16x8 c0 = *(const bf16x8*)(pa1), c1 = *(const bf16x8*)(pa1 + 16 * 64), c2 = *(const bf16x8*)(pa1 + 32 * 64), c3 = *(const bf16x8*)(pa1 + 48 * 64);
      bf16x8 d0 = *(const bf16x8*)(pb1), d1 = *(const bf16x8*)(pb1 + 16 * 64), d2 = *(const bf16x8*)(pb1 + 32 * 64), d3 = *(const bf16x8*)(pb1 + 48 * 64);
      __builtin_amdgcn_sched_barrier(0);
#define G128_MM(j, bj, x0, x1, x2, x3) do { \
        acc[0][j] = __builtin_amdgcn_mfma_f32_16x16x32_bf16(bj, x0, acc[0][j], 0, 0, 0); \
        acc[1][j] = __builtin_amdgcn_mfma_f32_16x16x32_bf16(bj, x1, acc[1][j], 0, 0, 0); \
        acc[2][j] = __builtin_amdgcn_mfma_f32_16x16x32_bf16(bj, x2, acc[2][j], 0, 0, 0); \
        acc[3][j] = __builtin_amdgcn_mfma_f32_16x16x32_bf16(bj, x3, acc[3][j], 0, 0, 0); } while (0)
      __builtin_amdgcn_s_setprio(1);
      G128_MM(0, b0, a0, a1, a2, a3); G128_MM(1, b1, a0, a1, a2, a3); G128_MM(2, b2, a0, a1, a2, a3); G128_MM(3, b3, a0, a1, a2, a3);
      G128_MM(0, d0, c0, c1, c2, c3); G128_MM(1, d1, c0, c1, c2, c3); G128_MM(2, d2, c0, c1, c2, c3); G128_MM(3, d3, c0, c1, c2, c3);
      __builtin_amdgcn_s_setprio(0);
    }
    __syncthreads();
  }
}
__device__ __forceinline__ uint2 pack4(f32x4 v) {
  uint2 o;
  o.x = (unsigned)f2bf(v[0]) | ((unsigned)f2bf(v[1]) << 16);
  o.y = (unsigned)f2bf(v[2]) | ((unsigned)f2bf(v[3]) << 16);
  return o;
}

__device__ __forceinline__ void gemm256(const u16* __restrict__ A, int lda, const u16* __restrict__ B, int ldb, int K,
                                        u16* lds, f32x4 (&acc)[8][4]) {
  const int tid = tid_l(), lane = tid & 63, w = tid >> 6, wm = w >> 1, wn = w & 1;
  const int r16 = lane & 15, g4 = lane >> 4;
#pragma unroll
  for (int i = 0; i < 8; ++i)
#pragma unroll
    for (int j = 0; j < 4; ++j) acc[i][j] = f32x4{0.f, 0.f, 0.f, 0.f};
  const int lrow = tid >> 2, lkc = tid & 3;
  const u16* ap = A + (size_t)lrow * lda + lkc * 8;
  const u16* bp = B + (size_t)lrow * ldb + lkc * 8;
  const size_t sa64 = (size_t)64 * lda, sb64 = (size_t)64 * ldb;
  const int woff = lrow * 32 + ((lkc ^ ((lrow >> 1) & 3)) * 8);
  const int fsw = (g4 ^ ((r16 >> 1) & 3)) * 8;
  const int faoff = (wm * 128 + r16) * 32 + fsw;
  const int fboff = 256 * 32 + (wn * 64 + r16) * 32 + fsw;
  const int nk = K >> 5;
  const int BUF = 384 * 32;
  uint4 xa0, xa1, xa2, xa3, xb0, xb1;
  uint4 ya0, ya1, ya2, ya3, yb0, yb1;
#define G256_LOAD(P, st) do { const u16* a2_ = ap + (st) * 32; const u16* b2_ = bp + (st) * 32; \
    P##a0 = *(const uint4*)(a2_); P##a1 = *(const uint4*)(a2_ + sa64); P##a2 = *(const uint4*)(a2_ + 2 * sa64); P##a3 = *(const uint4*)(a2_ + 3 * sa64); \
    P##b0 = *(const uint4*)(b2_); P##b1 = *(const uint4*)(b2_ + sb64); } while (0)
#define G256_STORE(P, buf) do { u16* wa_ = lds + (buf) * BUF + woff; u16* wb_ = wa_ + 256 * 32; \
    *(uint4*)(wa_) = P##a0; *(uint4*)(wa_ + 64 * 32) = P##a1; *(uint4*)(wa_ + 128 * 32) = P##a2; *(uint4*)(wa_ + 192 * 32) = P##a3; \
    *(uint4*)(wb_) = P##b0; *(uint4*)(wb_ + 64 * 32) = P##b1; } while (0)
#define G256_MM(i, af) do { \
      acc[i][0] = __builtin_amdgcn_mfma_f32_16x16x32_bf16(bf0, af, acc[i][0], 0, 0, 0); \
      acc[i][1] = __builtin_amdgcn_mfma_f32_16x16x32_bf16(bf1, af, acc[i][1], 0, 0, 0); \
      acc[i][2] = __builtin_amdgcn_mfma_f32_16x16x32_bf16(bf2, af, acc[i][2], 0, 0, 0); \
      acc[i][3] = __builtin_amdgcn_mfma_f32_16x16x32_bf16(bf3, af, acc[i][3], 0, 0, 0); } while (0)
#define G256_COMPUTE(buf) do { const u16* fa_ = lds + (buf) * BUF + faoff; const u16* fb_ = lds + (buf) * BUF + fboff; \
    bf16x8 bf0 = *(const bf16x8*)(fb_), bf1 = *(const bf16x8*)(fb_ + 16 * 32), bf2 = *(const bf16x8*)(fb_ + 32 * 32), bf3 = *(const bf16x8*)(fb_ + 48 * 32); \
    bf16x8 a0 = *(const bf16x8*)(fa_), a1 = *(const bf16x8*)(fa_ + 16 * 32), a2 = *(const bf16x8*)(fa_ + 32 * 32), a3 = *(const bf16x8*)(fa_ + 48 * 32); \
    __builtin_amdgcn_sched_barrier(0); __builtin_amdgcn_s_setprio(1); \
    G256_MM(0, a0); a0 = *(const bf16x8*)(fa_ + 64 * 32); __builtin_amdgcn_sched_barrier(0); \
    G256_MM(1, a1); a1 = *(const bf16x8*)(fa_ + 80 * 32); __builtin_amdgcn_sched_barrier(0); \
    G256_MM(2, a2); a2 = *(const bf16x8*)(fa_ + 96 * 32); __builtin_amdgcn_sched_barrier(0); \
    G256_MM(3, a3); a3 = *(const bf16x8*)(fa_ + 112 * 32); __builtin_amdgcn_sched_barrier(0); \
    G256_MM(4, a0); G256_MM(5, a1); G256_MM(6, a2); G256_MM(7, a3); __builtin_amdgcn_s_setprio(0); } while (0)
  G256_LOAD(x, 0);
  G256_LOAD(y, 1);
  __syncthreads();
  G256_STORE(x, 0);
  G256_LOAD(x, 2);
  __syncthreads();
  for (int kt = 0; kt < nk; kt += 2) {
    G256_STORE(y, 1);
    if (kt + 3 < nk) G256_LOAD(y, kt + 3);
    G256_COMPUTE(0);
    __syncthreads();
    if (kt + 2 < nk) {
      G256_STORE(x, 0);
      if (kt + 4 < nk) G256_LOAD(x, kt + 4);
    }
    G256_COMPUTE(1);
    __syncthreads();
  }
}
#define GEMM256_RC const int tde = tid_l(); const int rb = ((tde >> 6) >> 1) * 128 + (tde & 15), cb = ((tde >> 6) & 1) * 64 + ((tde & 63) >> 4) * 4;
#define GEMM_RC const int tde = tid_l(); const int rb = ((tde >> 6) >> 1) * 64 + (tde & 15), cb = ((tde >> 6) & 1) * 64 + ((tde & 63) >> 4) * 4;


__device__ __forceinline__ bool tile_at(int r, int Mt, int Nt, int& mt, int& nt) {
  const int x = blockIdx.x & 7, j = blockIdx.x >> 3, bpx = gridDim.x >> 3;
  const int mpx = Mt >> 3;
  const int q = r * bpx + j;
  if (q >= mpx * Nt) return false;
  const int full = (Nt >> 3) * (mpx * 8);
  int cb, rem, wcb;
  if (q < full) { cb = q / (mpx * 8); rem = q - cb * mpx * 8; wcb = 8; }
  else { cb = Nt >> 3; rem = q - full; wcb = Nt - cb * 8; }
  mt = x * mpx + rem / wcb;
  nt = cb * 8 + rem % wcb;
  return true;
}

__device__ __forceinline__ void phase_a(const Params& p, int l, u16* lds) {
  const u16* Bw = p.WinT + (size_t)l * 3072 * 1024;
  int mt, nt;
  for (int r = 0; tile_at(r, 144, 24, mt, nt); ++r) {
    const int m0 = mt * 256, n0 = nt * 128;
    f32x4 acc[8][4];
    gemm256(p.HQ + (size_t)m0 * 1024, 1024, Bw + (size_t)n0 * 1024, 1024, 1024, lds, acc);
    { GEMM256_RC
#pragma unroll
      for (int mi = 0; mi < 8; ++mi) {
        const int row = m0 + rb + mi * 16;
#pragma unroll
        for (int ni = 0; ni < 4; ++ni) {
          const int col = n0 + cb + ni * 16;
          *(uint2*)(p.P + (size_t)row * PW + col) = pack4(acc[mi][ni]);
          if (col >= P_GA && col < P_GA + 16)
            *(float4*)(p.GAB + (size_t)row * 16 + (col - P_GA)) = make_float4(acc[mi][ni][0], acc[mi][ni][1], acc[mi][ni][2], acc[mi][ni][3]);
        }
      }
    }
  }
}

__device__ __forceinline__ void phase_b1(const Params& p, int l, u16* lds) {
  int mt, nt;
  for (int pass = 0; pass < 2; ++pass) {
  for (int r = 0; tile_at(r, pass == 0 ? 288 : 304, pass == 0 ? 6 : 8, mt, nt); ++r) {
    if (pass == 0) {
      const int m0 = mt * 128, n0 = nt * 128;
      const float qscale = 0.07216878364870322f * 1.4426950408889634f;
      f32x4 acc[4][4];
      gemm128(p.P + (size_t)m0 * PW + P_MCQ, PW, p.WuqT + (size_t)l * 768 * 384 + (size_t)n0 * 384, 384, 384, lds, acc);
      { GEMM_RC
        const int g4 = (tde & 63) >> 4;
        const int cw0 = n0 + cb - g4 * 4;
        const bool ropew = ((cw0 >> 6) % 3) == 2 && m0 >= T_CTX;
#pragma unroll
        for (int mi = 0; mi < 4; ++mi) {
          const int row = m0 + rb + mi * 16;
          f32x4 v0 = acc[mi][0], v1 = acc[mi][1], v2 = acc[mi][2], v3 = acc[mi][3];
          if (ropew) {
            const int pos = (row - T_CTX) & 4095;
#pragma unroll
            for (int r = 0; r < 4; ++r) {
              const float inv = exp2f(-(float)(g4 * 4 + r) * (13.287712379549449f / 16.f));
              float s0, c0, s1, c1;
              __sincosf((float)(pos >> 6) * inv, &s0, &c0);
              __sincosf((float)(pos & 63) * inv, &s1, &c1);
              const float a0 = v0[r] * c0 - v1[r] * s0, a1 = v1[r] * c0 + v0[r] * s0;
              const float b0 = v2[r] * c1 - v3[r] * s1, b1 = v3[r] * c1 + v2[r] * s1;
              v0[r] = a0; v1[r] = a1; v2[r] = b0; v3[r] = b1;
            }
          }
          u16* qp = p.HQ + (size_t)row * 768 + n0 + cb;
          *(uint2*)(qp) = pack4(v0 * qscale); *(uint2*)(qp + 16) = pack4(v1 * qscale);
          *(uint2*)(qp + 32) = pack4(v2 * qscale); *(uint2*)(qp + 48) = pack4(v3 * qscale);
        }
      }
    } else {
      const int m0 = mt * 128, n0 = nt * 128;
      const u16* Ap; int lda;
      if (mt < 288) { Ap = p.P + (size_t)m0 * PW + P_MCKV; lda = PW; }
      else { Ap = p.CKVC + (size_t)(m0 - T_ALL) * 256; lda = 256; }
      f32x4 acc[4][4];
      gemm128(Ap, lda, p.WukvT + (size_t)l * 1024 * 256 + (size_t)n0 * 256, 256, 256, lds, acc);
      { GEMM_RC
#pragma unroll
        for (int mi = 0; mi < 4; ++mi) {
          const int row = m0 + rb + mi * 16;
          u16* vb; int vst;
          if (row < T_CTX) { int b = row >> 8, pos = row & 255; vb = p.VTC + (size_t)(b * 4) * 128 * 256 + pos; vst = 256; }
          else if (row < T_ALL) { int b = (row - T_CTX) >> 12, pos = (row - T_CTX) & 4095; vb = p.VTL + (size_t)(b * 4) * 128 * 4352 + pos; vst = 4352; }
          else { int b = (row - T_ALL) >> 8, pos = 4096 + ((row - T_ALL) & 255); vb = p.VTL + (size_t)(b * 4) * 128 * 4352 + pos; vst = 4352; }
#pragma unroll
          for (int ni = 0; ni < 4; ++ni) {
            const int col = n0 + cb + ni * 16;
            const int h = col >> 8, wi = col & 255;
            if (wi < 128) {
              *(uint2*)(p.KN + (size_t)row * 512 + h * 128 + wi) = pack4(acc[mi][ni]);
            } else {
              u16* dst = vb + (size_t)(h * 128 + (wi - 128)) * vst;
#pragma unroll
              for (int r = 0; r < 4; ++r) dst[(size_t)r * vst] = f2bf(acc[mi][ni][r]);
            }
          }
        }
      }
    }
  }
  }
}

__device__ __forceinline__ void phase_gemm_y(const u16* A, int lda, const u16* B, int K, int N, u16* Y, int ldy, u16* lds) {
  int mt, nt;
  for (int r = 0; tile_at(r, 288, N / 128, mt, nt); ++r) {
    const int m0 = mt * 128, n0 = nt * 128;
    f32x4 acc[4][4];
    gemm128(A + (size_t)m0 * lda, lda, B + (size_t)n0 * K, K, K, lds, acc);
    { GEMM_RC
#pragma unroll
      for (int mi = 0; mi < 4; ++mi)
#pragma unroll
        for (int ni = 0; ni < 4; ++ni)
          *(uint2*)(Y + (size_t)(m0 + rb + mi * 16) * ldy + n0 + cb + ni * 16) = pack4(acc[mi][ni]);
    }
  }
}

__device__ __forceinline__ void phase_e(const Params& p, int l, u16* lds) {
  const u16* Bw = p.WfiT + (size_t)l * 5632 * 1024;
  int mt, nt;
  for (int r = 0; tile_at(r, 144, 44, mt, nt); ++r) {
    const int m0 = mt * 256, n0 = nt * 128;
    f32x4 acc[8][4];
    gemm256(p.MIX + (size_t)m0 * 1024, 1024, Bw + (size_t)n0 * 1024, 1024, 1024, lds, acc);
    { GEMM256_RC
      const int g4x4 = ((tde & 63) >> 4) * 4;
      const int hc0 = ((n0 + cb - g4x4) >> 1) + g4x4;
#pragma unroll
      for (int mi = 0; mi < 8; ++mi)
#pragma unroll
        for (int ni = 0; ni < 2; ++ni) {
          f32x4 hv;
#pragma unroll
          for (int r = 0; r < 4; ++r) hv[r] = siluf_(acc[mi][ni][r]) * acc[mi][ni + 2][r];
          *(uint2*)(p.P + (size_t)(m0 + rb + mi * 16) * DFF + hc0 + ni * 16) = pack4(hv);
        }
    }
  }
}

#define KST 208
#define VST 80
#define PST 80
__device__ __forceinline__ void attn_item(const Params& p, int latent, int b, int h, int qb, unsigned char* smraw, int dummy = 0) {
  u16* sK = (u16*)smraw;
  u16* sV = sK + 64 * KST;
  u16* sP = sV + 128 * VST;
  const int tid = tid_l(), lane = tid & 63, w = tid >> 6, r16 = lane & 15, g4 = lane >> 4;
  const int nkeys = latent ? 4352 : 256;
  const int krow0 = latent ? T_CTX + b * 4096 : b * 256;
  const int tq0 = krow0 + qb * 128;
  const u16* vt = latent ? p.VTL + (size_t)((b * 4 + h) * 128) * 4352 : p.VTC + (size_t)((b * 4 + h) * 128) * 256;
  u16* sPw = sP + w * 32 * PST;
  bf16x8 q[2][6];
#pragma unroll
  for (int mi = 0; mi < 2; ++mi)
#pragma unroll
    for (int ks = 0; ks < 6; ++ks)
      q[mi][ks] = *(const bf16x8*)(p.HQ + (size_t)(tq0 + w * 32 + mi * 16 + r16) * 768 + h * 192 + ks * 32 + g4 * 8);
  f32x4 o[2][8];
  float mrow[2], lrow[2];
#pragma unroll
  for (int mi = 0; mi < 2; ++mi) {
#pragma unroll
    for (int nd = 0; nd < 8; ++nd) o[mi][nd] = f32x4{0.f, 0.f, 0.f, 0.f};
    mrow[mi] = -1e30f; lrow[mi] = 0.f;
  }
  const int lkey = tid >> 2, lpart = tid & 3;
  const int ldv = tid >> 1, lhalf = tid & 1;
  const int ntile = nkeys >> 6;
  uint4 k0, k1, k2, k3, k4, k5;
  {
    const int pos = lkey;
    const u16* srcn = p.KN + (size_t)(krow0 + pos) * 512 + h * 128 + lpart * 8;
    const u16* srcr = p.P + (size_t)(krow0 + pos) * PW + P_MKR + lpart * 8;
    k0 = *(const uint4*)(srcn); k1 = *(const uint4*)(srcn + 32); k2 = *(const uint4*)(srcn + 64); k3 = *(const uint4*)(srcn + 96);
    k4 = *(const uint4*)(srcr); k5 = *(const uint4*)(srcr + 32);
  }
  for (int kt = 0; kt < ntile; ++kt) {
    __syncthreads();
    {
      u16* dk = sK + lkey * KST + lpart * 8;
      *(uint4*)(dk) = k0; *(uint4*)(dk + 32) = k1; *(uint4*)(dk + 64) = k2; *(uint4*)(dk + 96) = k3;
      *(uint4*)(dk + 128) = k4; *(uint4*)(dk + 160) = k5;
    }
    const u16* sv = vt + (size_t)ldv * nkeys + kt * 64 + lhalf * 32;
    const uint4 v0 = *(const uint4*)(sv), v1 = *(const uint4*)(sv + 8), v2 = *(const uint4*)(sv + 16), v3 = *(const uint4*)(sv + 24);
    __syncthreads();
    f32x4 s[2][4];
#pragma unroll
    for (int mi = 0; mi < 2; ++mi)
#pragma unroll
      for (int ni = 0; ni < 4; ++ni) s[mi][ni] = f32x4{0.f, 0.f, 0.f, 0.f};
#pragma unroll
    for (int ks = 0; ks < 6; ++ks)
#pragma unroll
      for (int ni = 0; ni < 4; ++ni) {
        bf16x8 kf = *(const bf16x8*)(sK + (ni * 16 + r16) * KST + ks * 32 + g4 * 8);
        s[0][ni] = __builtin_amdgcn_mfma_f32_16x16x32_bf16(kf, q[0][ks], s[0][ni], 0, 0, 0);
        s[1][ni] = __builtin_amdgcn_mfma_f32_16x16x32_bf16(kf, q[1][ks], s[1][ni], 0, 0, 0);
      }
#pragma unroll
    for (int mi = 0; mi < 2; ++mi) {
      float mx = -1e30f;
#pragma unroll
      for (int ni = 0; ni < 4; ++ni)
#pragma unroll
        for (int r = 0; r < 4; ++r) mx = fmaxf(mx, s[mi][ni][r]);
      mx = fmaxf(mx, __shfl_xor(mx, 16)); mx = fmaxf(mx, __shfl_xor(mx, 32));
      const float mnew = fmaxf(mrow[mi], mx);
      const float alpha = __builtin_amdgcn_exp2f(mrow[mi] - mnew);
      mrow[mi] = mnew;
      float ps = 0.f;
#pragma unroll
      for (int ni = 0; ni < 4; ++ni) {
        f32x4 pv;
#pragma unroll
        for (int r = 0; r < 4; ++r) { pv[r] = __builtin_amdgcn_exp2f(s[mi][ni][r] - mnew); ps += pv[r]; }
        *(uint2*)(sPw + (mi * 16 + r16) * PST + ni * 16 + g4 * 4) = pack4(pv);
      }
      ps += __shfl_xor(ps, 16); ps += __shfl_xor(ps, 32);
      lrow[mi] = lrow[mi] * alpha + ps;
#pragma unroll
      for (int nd = 0; nd < 8; ++nd) o[mi][nd] *= alpha;
    }
    {
      u16* dvp = sV + ldv * VST + lhalf * 32;
      *(uint4*)(dvp) = v0; *(uint4*)(dvp + 8) = v1; *(uint4*)(dvp + 16) = v2; *(uint4*)(dvp + 24) = v3;
    }
    __syncthreads();
    if (kt + 1 < ntile) {
      const int pos = (kt + 1) * 64 + lkey;
      const bool own = (!latent) || pos < 4096;
      const int row = own ? krow0 + pos : T_ALL + b * 256 + (pos - 4096);
      const u16* srcn = p.KN + (size_t)row * 512 + h * 128 + lpart * 8;
      const u16* srcr = own ? p.P + (size_t)(krow0 + pos) * PW + P_MKR + lpart * 8
                            : p.KRC + (size_t)(b * 256 + pos - 4096) * 64 + lpart * 8;
      k0 = *(const uint4*)(srcn); k1 = *(const uint4*)(srcn + 32); k2 = *(const uint4*)(srcn + 64); k3 = *(const uint4*)(srcn + 96);
      k4 = *(const uint4*)(srcr); k5 = *(const uint4*)(srcr + 32);
    }
#pragma unroll
    for (int ks2 = 0; ks2 < 2; ++ks2) {
      bf16x8 pf0 = *(const bf16x8*)(sPw + (0 * 16 + r16) * PST + ks2 * 32 + g4 * 8);
      bf16x8 pf1 = *(const bf16x8*)(sPw + (1 * 16 + r16) * PST + ks2 * 32 + g4 * 8);
#pragma unroll
      for (int nd = 0; nd < 8; ++nd) {
        bf16x8 vf = *(const bf16x8*)(sV + (nd * 16 + r16) * VST + ks2 * 32 + g4 * 8);
        o[0][nd] = __builtin_amdgcn_mfma_f32_16x16x32_bf16(vf, pf0, o[0][nd], 0, 0, 0);
        o[1][nd] = __builtin_amdgcn_mfma_f32_16x16x32_bf16(vf, pf1, o[1][nd], 0, 0, 0);
      }
    }
  }
#pragma unroll
  for (int mi = 0; mi < 2; ++mi) {
    const float inv = 1.f / lrow[mi];
    const int qrow = tq0 + w * 32 + mi * 16 + r16;
    u16* op = p.HQ + (size_t)qrow * 768 + h * 192 + g4 * 4;
    if (dummy) op = p.HQ + (size_t)T_ALL * 768 + (size_t)(qrow % 9216) * 768 + h * 192 + g4 * 4;
#pragma unroll
    for (int nd = 0; nd < 8; ++nd) *(uint2*)(op + nd * 16) = pack4(o[mi][nd] * inv);
  }
}

#define XB_TMO      128
#define XB_XCNT(j)  (256  + 64 * (j))
#define XB_XSUB(j)  (1280 + 64 * (j))
#define XB_XGEN(j)  (2304 + 64 * (j))
#define XB_TOP      3328
#define XB_TOPGEN   3392
#define XCD_BAR_WORDS 3456
#define XB_SPIN_CAP (1u << 23)
#define LAS __attribute__((address_space(3)))

__device__ __forceinline__ unsigned xb_ld(unsigned* p)              { return __hip_atomic_load(p, __ATOMIC_RELAXED, __HIP_MEMORY_SCOPE_AGENT); }
__device__ __forceinline__ unsigned xb_add(unsigned* p, unsigned v) { return __hip_atomic_fetch_add(p, v, __ATOMIC_RELAXED, __HIP_MEMORY_SCOPE_AGENT); }
__device__ __forceinline__ unsigned xb_xcc_id() { return (unsigned)__builtin_amdgcn_s_getreg((3 << 11) | 20) & 0xFu; }
#define XB_SPIN(cond, bar) do { unsigned _sp = 0; while (cond) { __builtin_amdgcn_s_sleep(1); \
    if ((++_sp & 255u) == 0u) { if (xb_ld(&(bar)[XB_TMO])) break; if (_sp > XB_SPIN_CAP) { atomicAdd(&(bar)[XB_TMO], 1u); break; } } } } while (0)

struct XcdBarrier {
    unsigned* bar; unsigned x;
    volatile LAS unsigned* st;
};

__device__ __forceinline__ XcdBarrier xcd_barrier_post(unsigned* bar, volatile LAS unsigned* st) {
    XcdBarrier b; b.bar = bar; b.x = xb_xcc_id(); b.st = st;
    if (threadIdx.x == 0) (void)xb_add(&bar[XB_XCNT(b.x)], 1u);
    return b;
}
__device__ __forceinline__ void xcd_barrier_complete(unsigned* bar, unsigned x, unsigned& nloc, unsigned& nx) {
    const unsigned G = gridDim.x * gridDim.y * gridDim.z;
    unsigned sum, cnt, mine, sp = 0u;
    for (;;) {
        sum = 0u; cnt = 0u; mine = 0u;
#pragma unroll
        for (unsigned j = 0; j < 16; ++j) { const unsigned c = xb_ld(&bar[XB_XCNT(j)]); sum += c; cnt += (c > 0u) ? 1u : 0u; mine = (j == x) ? c : mine; }
        if (sum == G) break;
        __builtin_amdgcn_s_sleep(1);
        if ((++sp & 255u) == 0u) { if (xb_ld(&bar[XB_TMO])) break; if (sp > XB_SPIN_CAP) { atomicAdd(&bar[XB_TMO], 1u); break; } }
    }
    nloc = mine > 0u ? mine : 1u; nx = cnt > 0u ? cnt : 1u;
}

__device__ __forceinline__ void xcd_barrier(const XcdBarrier& b) {
    asm volatile("s_waitcnt vmcnt(0)" ::: "memory");
    __syncthreads();
    if (threadIdx.x == 0) {
        unsigned* bar = b.bar;
        __builtin_amdgcn_s_waitcnt(0);
        unsigned nloc = b.st[0], nx = b.st[1];
        if (nloc == 0u) { xcd_barrier_complete(bar, b.x, nloc, nx); b.st[0] = nloc; b.st[1] = nx; }
        const unsigned old = xb_add(&bar[XB_XSUB(b.x)], 1u);
        const unsigned gen = old / nloc;
        if (old + 1u == (gen + 1u) * nloc) {
            __builtin_amdgcn_fence(__ATOMIC_RELEASE, "agent");
            asm volatile("s_waitcnt vmcnt(0)" ::: "memory");
            const unsigned og = xb_add(&bar[XB_TOP], 1u);
            const unsigned tg = og / nx;
            if (og + 1u == (tg + 1u) * nx) xb_add(&bar[XB_TOPGEN], 1u);
            else XB_SPIN(xb_ld(&bar[XB_TOPGEN]) == tg, bar);
            __builtin_amdgcn_fence(__ATOMIC_ACQUIRE, "agent");
            xb_add(&bar[XB_XGEN(b.x)], 1u);
            asm volatile("s_waitcnt vmcnt(0)" ::: "memory");
        } else {
            XB_SPIN(xb_ld(&bar[XB_XGEN(b.x)]) == gen, bar);
            __builtin_amdgcn_fence(__ATOMIC_ACQUIRE, "agent");
            asm volatile("s_waitcnt vmcnt(0)" ::: "memory");
        }
    }
    __syncthreads();
}


__device__ __forceinline__ void gbar(unsigned* ctr, unsigned target) {
  asm volatile("s_waitcnt vmcnt(0)" ::: "memory");
  __syncthreads();
  if (tid_l() == 0) {
    __builtin_amdgcn_fence(__ATOMIC_RELEASE, "agent");
    asm volatile("s_waitcnt vmcnt(0)" ::: "memory");
    __hip_atomic_fetch_add(ctr, 1u, __ATOMIC_RELAXED, __HIP_MEMORY_SCOPE_AGENT);
    while (__hip_atomic_load(ctr, __ATOMIC_RELAXED, __HIP_MEMORY_SCOPE_AGENT) < target) __builtin_amdgcn_s_sleep(2);
    __builtin_amdgcn_fence(__ATOMIC_ACQUIRE, "agent");
    asm volatile("s_waitcnt vmcnt(0)" ::: "memory");
  }
  __syncthreads();
}
#define MFMA4(a, b, c) __builtin_amdgcn_mfma_f32_16x16x4f32((a), (b), (c), 0, 0, 0)

__device__ __forceinline__ float softplusf_(float x) { return fmaxf(x, 0.f) + log1pf(__expf(-fabsf(x))); }

__device__ __forceinline__ void gdn_chain(const Params& p, int l, int seq, int h, int d, int vs, float* sm) {
  float* sMM = sm;
  float* sK = sMM + 64 * 68;
  float* sW = sK + 64 * 65;
  float* sV = sW + 64 * 65;
  float* sS = sV + 64 * 33;
  float* sGc = sS + 64 * 33;
  float* sBeta = sGc + 64;
  float* sBg = sBeta + 64;
  const int tid = tid_l(), lane = tid & 63, w = tid >> 6, r16 = lane & 15, g4 = lane >> 4;
  const bool latent = seq >= 16;
  const int len = latent ? 4096 : 256;
  const int t0 = latent ? T_CTX + (seq - 16) * 4096 : seq * 256;
  const int nchunks = len >> 6;
  const float Acoef = -__expf(p.gdn_a_log[l * 8 + d * 4 + h]);
  const float dtb = p.gdn_dt_bias[l * 8 + d * 4 + h];
  f32x4 Sreg[2];
  __syncthreads();
  {
    const float* s0 = latent ? p.state_gdn + ((((size_t)(seq - 16) * 2 + l) * 2 + d) * 4 + h) * 4096 : nullptr;
#pragma unroll
    for (int n = 0; n < 2; ++n)
#pragma unroll
      for (int r = 0; r < 4; ++r) {
        const int kidx = 16 * w + g4 * 4 + r, cc = n * 16 + r16;
        float v = latent ? s0[kidx * 64 + vs * 32 + cc] : 0.f;
        Sreg[n][r] = v;
        sS[kidx * 33 + cc] = v;
      }
  }
  const u16* Pb = p.P + (size_t)t0 * PW;
  const u16* VHb = p.HQ + (size_t)T_ALL * 768 + (size_t)t0 * 256;
#define GDN_SRC(i, tl, tlo_) ({ const int e_ = (tl) + (i) * 256; const int u_ = e_ / 20, un_ = e_ % 20; \
    (un_ < 16) ? (Pb + (size_t)((tlo_) + u_) * PW + (un_ < 8 ? P_QH + h * 64 + un_ * 8 : P_KH + h * 64 + (un_ - 8) * 8)) \
               : (VHb + (size_t)((tlo_) + u_) * 256 + h * 64 + vs * 32 + (un_ - 16) * 8); })
  uint4 pf[5];
  float pga = 0.f, pgb = 0.f;
  {
    const int tlo = d == 0 ? 0 : len - 64;
#pragma unroll
    for (int i = 0; i < 5; ++i) pf[i] = *(const uint4*)GDN_SRC(i, tid, tlo);
    if (tid < 64) {
      const int u = d == 0 ? tid : 63 - tid;
      const float* gab = p.GAB + (size_t)(t0 + tlo + u) * 16;
      pga = gab[d * 4 + h]; pgb = gab[8 + d * 4 + h];
    }
  }
  for (int n = 0; n < nchunks; ++n) {
    const int tlo = d == 0 ? n * 64 : len - 64 * (n + 1);
    const int tl2 = tid_l();
#pragma unroll
    for (int i = 0; i < 5; ++i) {
      const int e = tl2 + i * 256;
      const int u = e / 20, un = e % 20;
      const int pp = d == 0 ? u : 63 - u;
      float* dq = un < 8 ? sW + pp * 65 + un * 8 : (un < 16 ? sK + pp * 65 + (un - 8) * 8 : sV + pp * 33 + (un - 16) * 8);
      const unsigned wv[4] = {pf[i].x, pf[i].y, pf[i].z, pf[i].w};
#pragma unroll
      for (int j = 0; j < 4; ++j) { dq[2 * j] = bf2f((u16)(wv[j] & 0xffff)); dq[2 * j + 1] = bf2f((u16)(wv[j] >> 16)); }
    }
    if (tid < 64) {
      const int pp = tid;
      float g = Acoef * softplusf_(pga + dtb);
      float bt = sigmoidf_(pgb);
#pragma unroll
      for (int o = 1; o < 64; o <<= 1) { float tt = __shfl_up(g, o); if (lane >= o) g += tt; }
      sGc[pp] = g; sBeta[pp] = bt; sBg[pp] = bt * __expf(g);
    }
    if (n + 1 < nchunks) {
      const int tlo2 = d == 0 ? (n + 1) * 64 : len - 64 * (n + 2);
#pragma unroll
      for (int i = 0; i < 5; ++i) pf[i] = *(const uint4*)GDN_SRC(i, tl2, tlo2);
      if (tid < 64) {
        const int u = d == 0 ? tid : 63 - tid;
        const float* gab = p.GAB + (size_t)(t0 + tlo2 + u) * 16;
        pga = gab[d * 4 + h]; pgb = gab[8 + d * 4 + h];
      }
    }
    __syncthreads();
    float qa[16];
#pragma unroll
    for (int s = 0; s < 16; ++s) qa[s] = sW[(16 * w + r16) * 65 + 4 * s + g4];
    const unsigned tcode = w == 0 ? 0x730u : (w == 1 ? 0xA51u : (w == 2 ? 0x062u : 0x0FBu));
    const int tcnt = w < 2 ? 3 : 2;
    f32x4 attacc[3];
#pragma unroll
    for (int t = 0; t < 3; ++t) {
      attacc[t] = f32x4{0.f, 0.f, 0.f, 0.f};
      if (t < tcnt) {
        const int ti = (tcode >> (4 * t)) & 3, tn = (tcode >> (4 * t + 2)) & 3;
        f32x4 accm = f32x4{0.f, 0.f, 0.f, 0.f};
        const float* ak = sK + (16 * ti + r16) * 65 + g4;
        const float* aq = sW + (16 * ti + r16) * 65 + g4;
        const float* bk = sK + (16 * tn + r16) * 65 + g4;
#pragma unroll
        for (int s = 0; s < 16; ++s) {
          const float bv = bk[4 * s];
          accm = MFMA4(ak[4 * s], bv, accm);
          attacc[t] = MFMA4(aq[4 * s], bv, attacc[t]);
        }
#pragma unroll
        for (int r = 0; r < 4; ++r) {
          const int i = 16 * ti + g4 * 4 + r, j = 16 * tn + r16;
          sMM[i * 68 + j] = (i > j) ? sBeta[i] * accm[r] * __expf(sGc[i] - sGc[j]) : 0.f;
        }
      }
    }
    __syncthreads();
    if (w == 0) {
      const int bi = tid >> 4, c = tid & 15;
      float* md = sMM + (16 * bi) * 68 + 16 * bi;
      float a[16];
#pragma unroll
      for (int r = 0; r < 16; ++r) a[r] = (r == c) ? 1.f : 0.f;
#pragma unroll
      for (int r = 1; r < 16; ++r) {
#pragma unroll
        for (int q4 = 0; q4 < (r + 3) / 4; ++q4) {
          const float4 m = *(const float4*)(md + r * 68 + 4 * q4);
          if (q4 * 4 + 0 < r) a[r] -= m.x * a[q4 * 4 + 0];
          if (q4 * 4 + 1 < r) a[r] -= m.y * a[q4 * 4 + 1];
          if (q4 * 4 + 2 < r) a[r] -= m.z * a[q4 * 4 + 2];
          if (q4 * 4 + 3 < r) a[r] -= m.w * a[q4 * 4 + 3];
        }
      }
      __builtin_amdgcn_fence(__ATOMIC_SEQ_CST, "wavefront");
#pragma unroll
      for (int r = 0; r < 16; ++r) md[r * 68 + c] = a[r];
    } else {
      for (int t = w - 1; t < 8; t += 3) {
        const int ti = t >> 1, tc = t & 1;
        const float bg = sBg[16 * ti + r16];
        const float* ak = sK + (16 * ti + r16) * 65 + g4;
        const float* bs = sS + g4 * 33 + 16 * tc + r16;
        f32x4 acc = f32x4{0.f, 0.f, 0.f, 0.f};
#pragma unroll
        for (int s = 0; s < 16; ++s) acc = MFMA4(ak[4 * s] * bg, bs[4 * s * 33], acc);
#pragma unroll
        for (int r = 0; r < 4; ++r) {
          const int i = 16 * ti + g4 * 4 + r, cc = 16 * tc + r16;
          sV[i * 33 + cc] = sV[i * 33 + cc] * sBeta[i] - acc[r];
        }
      }
    }
    __syncthreads();
    for (int ib = 0; ib < 4; ++ib) {
      if (w < 2) {
        const int ct = w;
        f32x4 acc = f32x4{0.f, 0.f, 0.f, 0.f};
        const float* am = sMM + (16 * ib + r16) * 68 + g4;
        const float* bx = sV + g4 * 33 + 16 * ct + r16;
        for (int s4 = 0; s4 < ib; ++s4) {
#pragma unroll
          for (int s = 0; s < 4; ++s) acc = MFMA4(am[16 * s4 + 4 * s], bx[(16 * s4 + 4 * s) * 33], acc);
        }
        f32x4 rm;
#pragma unroll
        for (int r = 0; r < 4; ++r) rm[r] = sV[(16 * ib + g4 * 4 + r) * 33 + 16 * ct + r16] - acc[r];
        const float* dd = sMM + (16 * ib + r16) * 68 + 16 * ib + 4 * g4;
        f32x4 xn = f32x4{0.f, 0.f, 0.f, 0.f};
#pragma unroll
        for (int s = 0; s < 4; ++s) xn = MFMA4(dd[s], rm[s], xn);
#pragma unroll
        for (int r = 0; r < 4; ++r) sV[(16 * ib + g4 * 4 + r) * 33 + 16 * ct + r16] = xn[r];
      }
      __syncthreads();
    }
#pragma unroll
    for (int t = 0; t < 3; ++t) {
      if (t < tcnt) {
        const int ti = (tcode >> (4 * t)) & 3, tn = (tcode >> (4 * t + 2)) & 3;
#pragma unroll
        for (int r = 0; r < 4; ++r) {
          const int i = 16 * ti + g4 * 4 + r, j = 16 * tn + r16;
          sMM[i * 68 + j] = (i >= j) ? attacc[t][r] * __expf(sGc[i] - sGc[j]) : 0.f;
        }
      }
    }
    __syncthreads();
    {
      f32x4 acc[2] = {f32x4{0.f, 0.f, 0.f, 0.f}, f32x4{0.f, 0.f, 0.f, 0.f}};
      const float eg = __expf(sGc[16 * w + r16]);
#pragma unroll
      for (int s = 0; s < 16; ++s) {
        const float a = qa[s] * eg;
        acc[0] = MFMA4(sS[(4 * s + g4) * 33 + r16], a, acc[0]);
        acc[1] = MFMA4(sS[(4 * s + g4) * 33 + 16 + r16], a, acc[1]);
      }
#pragma unroll
      for (int s = 0; s < 16; ++s) {
        if (s < 4 * (w + 1)) {
          const float a = sMM[(16 * w + r16) * 68 + 4 * s + g4];
          acc[0] = MFMA4(sV[(4 * s + g4) * 33 + r16], a, acc[0]);
          acc[1] = MFMA4(sV[(4 * s + g4) * 33 + 16 + r16], a, acc[1]);
        }
      }
      {
        const int pp = 16 * w + r16;
        const int u = d == 0 ? pp : 63 - pp;
        u16* op = p.MIX + (size_t)(t0 + tlo + u) * 1024 + d * 256 + h * 64 + vs * 32 + g4 * 4;
        *(uint2*)(op) = pack4(acc[0]);
        *(uint2*)(op + 16) = pack4(acc[1]);
      }
    }
    __syncthreads();
    {
      const float g63 = sGc[63];
      const float gl = __expf(g63);
#pragma unroll
      for (int nn = 0; nn < 2; ++nn)
#pragma unroll
        for (int r = 0; r < 4; ++r) Sreg[nn][r] *= gl;
#pragma unroll
      for (int s = 0; s < 16; ++s) {
        const int srow = 4 * s + g4;
        const float a = sK[srow * 65 + 16 * w + r16] * __expf(g63 - sGc[srow]);
        Sreg[0] = MFMA4(a, sV[srow * 33 + r16], Sreg[0]);
        Sreg[1] = MFMA4(a, sV[srow * 33 + 16 + r16], Sreg[1]);
      }
    }
    __syncthreads();
#pragma unroll
    for (int nn = 0; nn < 2; ++nn)
#pragma unroll
      for (int r = 0; r < 4; ++r) sS[(16 * w + g4 * 4 + r) * 33 + nn * 16 + r16] = Sreg[nn][r];
    __syncthreads();
  }
  if (!latent) {
    float* so = p.out + OUT_SGDN + ((((size_t)seq * 2 + l) * 2 + d) * 4 + h) * 4096;
#pragma unroll
    for (int nn = 0; nn < 2; ++nn)
#pragma unroll
      for (int r = 0; r < 4; ++r) so[(16 * w + g4 * 4 + r) * 64 + vs * 32 + nn * 16 + r16] = Sreg[nn][r];
  }
}

__device__ __forceinline__ void hgrn_chain(const Params& p, int l, int seq, int h, int d, int vs, float* sm) {
  float* sBC = sm;
  float* sK = sBC + 64 * 65;
  float* sAT = sK + 64 * 65;
  float* sV = sAT + 64 * 68;
  float* sS = sV + 64 * 33;
  float* sTot = sS + 64 * 33;
  const int tid = tid_l(), lane = tid & 63, w = tid >> 6, r16 = lane & 15, g4 = lane >> 4;
  const bool latent = seq >= 16;
  const int len = latent ? 4096 : 256;
  const int t0 = latent ? T_CTX + (seq - 16) * 4096 : seq * 256;
  const int nchunks = len >> 6;
  float lbk;
  {
    const int kch = h * 64 + (tid & 63);
    lbk = (l == 0) ? 0.f : sigmoidf_(p.hgrn_lb[256 + kch] - p.hgrn_lb[kch]);
  }
  f32x4 Sreg[2];
  __syncthreads();
  {
    const float* s0 = latent ? p.state_hgrn + ((((size_t)(seq - 16) * 2 + l) * 2 + d) * 4 + h) * 4096 : nullptr;
#pragma unroll
    for (int n = 0; n < 2; ++n)
#pragma unroll
      for (int r = 0; r < 4; ++r) {
        const int kidx = 16 * w + g4 * 4 + r, cc = n * 16 + r16;
        float v = latent ? s0[kidx * 64 + vs * 32 + cc] : 0.f;
        Sreg[n][r] = v;
        sS[kidx * 33 + cc] = v;
      }
  }
  const u16* Pb = p.P + (size_t)t0 * PW;
  float* sLb = sTot + 256;
  if (tid < 64) sLb[tid] = lbk;
  __syncthreads();
  int pgo[5];
#pragma unroll
  for (int i = 0; i < 5; ++i) {
    const int e = tid + i * 256;
    const int u = e / 20, un = e % 20;
    pgo[i] = u * PW + (un < 8 ? P_HF + d * 256 + h * 64 + un * 8 : (un < 12 ? P_HI + h * 64 + vs * 32 + (un - 8) * 8 : P_HQ + h * 64 + (un - 12) * 8));
  }
  uint4 pf[5];
  {
    const int tlo = d == 0 ? 0 : len - 64;
#pragma unroll
    for (int i = 0; i < 5; ++i) pf[i] = *(const uint4*)(Pb + (size_t)tlo * PW + pgo[i]);
  }
  for (int n = 0; n < nchunks; ++n) {
#pragma unroll
    for (int i = 0; i < 5; ++i) {
      const int e = tid + i * 256;
      const int u = e / 20, un = e % 20;
      const int pp = d == 0 ? u : 63 - u;
      const unsigned wv[4] = {pf[i].x, pf[i].y, pf[i].z, pf[i].w};
#pragma unroll
      for (int j = 0; j < 8; ++j) {
        const float x = bf2f((u16)((wv[j >> 1] >> ((j & 1) * 16)) & 0xffff));
        if (un < 8) {
          const int k = un * 8 + j;
          const float lb = sLb[k];
          const float sg_ = sigmoidf_(x);
          const float gate = lb + (1.f - lb) * sg_;
          sBC[pp * 65 + k] = __logf(fmaxf(gate, 1e-30f));
          sK[pp * 65 + k] = (1.f - lb) * (1.f - sg_);
        } else if (un < 12) {
          sV[pp * 33 + (un - 8) * 8 + j] = x;
        } else {
          sAT[pp * 68 + (un - 12) * 8 + j] = x;
        }
      }
    }
    __syncthreads();
    if (n + 1 < nchunks) {
      const int tlo2 = d == 0 ? (n + 1) * 64 : len - 64 * (n + 2);
#pragma unroll
      for (int i = 0; i < 5; ++i) pf[i] = *(const uint4*)(Pb + (size_t)tlo2 * PW + pgo[i]);
    }
    const int tlo = d == 0 ? n * 64 : len - 64 * (n + 1);
    float cs[16];
    {
      const int k = tid & 63, sg = tid >> 6;
      float run = 0.f;
#pragma unroll
      for (int i = 0; i < 16; ++i) { run += sBC[(16 * sg + i) * 65 + k]; cs[i] = run; }
      sTot[sg * 64 + k] = run;
    }
    float qa[16];
#pragma unroll
    for (int s = 0; s < 16; ++s) qa[s] = sAT[(16 * w + r16) * 68 + 4 * s + g4];
    __syncthreads();
    {
      const int k = tid & 63, sg = tid >> 6;
      float off = 0.f;
      for (int s2 = 0; s2 < sg; ++s2) off += sTot[s2 * 64 + k];
#pragma unroll
      for (int i = 0; i < 16; ++i) sBC[(16 * sg + i) * 65 + k] = cs[i] + off;
    }
    __syncthreads();
    {
      float aq[16], rf[16];
#pragma unroll
      for (int s = 0; s < 16; ++s) {
        const int kk = 4 * s + g4;
        rf[s] = (w == 0) ? 0.f : sBC[(16 * w - 1) * 65 + kk];
        aq[s] = qa[s] * __expf(sBC[(16 * w + r16) * 65 + kk] - rf[s]);
      }
#pragma unroll
      for (int nn = 0; nn < 4; ++nn) {
        f32x4 acc = f32x4{0.f, 0.f, 0.f, 0.f};
        if (nn <= w) {
#pragma unroll
          for (int s = 0; s < 16; ++s) {
            const int kk = 4 * s + g4, sc = 16 * nn + r16;
            const float bv = sK[sc * 65 + kk] * __expf(fminf(rf[s] - sBC[sc * 65 + kk], 80.f));
            acc = MFMA4(aq[s], bv, acc);
          }
        }
#pragma unroll
        for (int r = 0; r < 4; ++r) {
          const int i = 16 * w + g4 * 4 + r, j = 16 * nn + r16;
          sAT[i * 68 + j] = (i >= j) ? acc[r] : 0.f;
        }
      }
    }
    __syncthreads();
    {
      f32x4 acc[2] = {f32x4{0.f, 0.f, 0.f, 0.f}, f32x4{0.f, 0.f, 0.f, 0.f}};
#pragma unroll
      for (int s = 0; s < 16; ++s) {
        const int kk = 4 * s + g4;
        const float a = qa[s] * __expf(sBC[(16 * w + r16) * 65 + kk]);
        acc[0] = MFMA4(sS[kk * 33 + r16], a, acc[0]);
        acc[1] = MFMA4(sS[kk * 33 + 16 + r16], a, acc[1]);
      }
#pragma unroll
      for (int s = 0; s < 16; ++s) {
        if (s < 4 * (w + 1)) {
          const float a = sAT[(16 * w + r16) * 68 + 4 * s + g4];
          acc[0] = MFMA4(sV[(4 * s + g4) * 33 + r16], a, acc[0]);
          acc[1] = MFMA4(sV[(4 * s + g4) * 33 + 16 + r16], a, acc[1]);
        }
      }
      {
        const int pp = 16 * w + r16;
        const int u = d == 0 ? pp : 63 - pp;
        u16* op = p.MIX + (size_t)(t0 + tlo + u) * 1024 + 512 + d * 256 + h * 64 + vs * 32 + g4 * 4;
        *(uint2*)(op) = pack4(acc[0]);
        *(uint2*)(op + 16) = pack4(acc[1]);
      }
    }
    __syncthreads();
    {
#pragma unroll
      for (int nn = 0; nn < 2; ++nn)
#pragma unroll
        for (int r = 0; r < 4; ++r) Sreg[nn][r] *= __expf(sBC[63 * 65 + 16 * w + g4 * 4 + r]);
      const int kA = 16 * w + r16;
      const float blA = sBC[63 * 65 + kA];
#pragma unroll
      for (int s = 0; s < 16; ++s) {
        const int srow = 4 * s + g4;
        const float a = sK[srow * 65 + kA] * __expf(blA - sBC[srow * 65 + kA]);
        Sreg[0] = MFMA4(a, sV[srow * 33 + r16], Sreg[0]);
        Sreg[1] = MFMA4(a, sV[srow * 33 + 16 + r16], Sreg[1]);
      }
    }
    __syncthreads();
#pragma unroll
    for (int nn = 0; nn < 2; ++nn)
#pragma unroll
      for (int r = 0; r < 4; ++r) sS[(16 * w + g4 * 4 + r) * 33 + nn * 16 + r16] = Sreg[nn][r];
    __syncthreads();
  }
  if (!latent) {
    float* so = p.out + OUT_SHG + ((((size_t)seq * 2 + l) * 2 + d) * 4 + h) * 4096;
#pragma unroll
    for (int nn = 0; nn < 2; ++nn)
#pragma unroll
      for (int r = 0; r < 4; ++r) so[(16 * w + g4 * 4 + r) * 64 + vs * 32 + nn * 16 + r16] = Sreg[nn][r];
  }
}

__device__ __forceinline__ void phase_c(const Params& p, int l, unsigned char* smraw, int mode = 0) {
  __shared__ int s_item;
  const int total = 1920;
  for (;;) {
    __syncthreads();
    if (tid_l() == 0) s_item = (int)atomicAdd(&p.counters[l * 64 + mode * 16], 1u);
    __syncthreads();
    const int item = s_item;
    if (item >= total) break;
    int kind, a0, a1, a2, a3;
    if (item < 256 || (item >= 1280 && item < 1792)) {
      const int i2 = item < 256 ? item : item - 1280;
      const int rest = i2 >> 1;
      kind = i2 & 1;
      a3 = rest & 1; a2 = (rest >> 1) & 1; a1 = (rest >> 2) & 3; a0 = (rest >> 4) + (item < 256 ? 16 : 0);
    } else if (item < 1280) {
      const int i2 = item - 256;
      kind = 2; a0 = 1; a1 = i2 >> 7; a2 = (i2 >> 5) & 3; a3 = i2 & 31;
    } else {
      const int i2 = item - 1792;
      kind = 2; a0 = 0; a1 = i2 >> 3; a2 = (i2 >> 1) & 3; a3 = i2 & 1;
    }
    if (mode == 1 && kind == 2) continue;
    if (mode == 2 && kind != 2) continue;
    if (kind != 2) __builtin_amdgcn_s_setprio(3);
    if (kind == 0) gdn_chain(p, l, a0, a1, a2, a3, (float*)smraw);
    else if (kind == 1) hgrn_chain(p, l, a0, a1, a2, a3, (float*)smraw);
    if (kind != 2) __builtin_amdgcn_s_setprio(0);
    else attn_item(p, a0, a1, a2, a3, smraw, mode == 2);
  }
}

__global__ void __launch_bounds__(NTHR, 2) mega(Params p) {
  __shared__ __attribute__((aligned(16))) unsigned char smem[LDS_BYTES];
  cg::grid_group grid = cg::this_grid();
  __shared__ uint4 xb_words;
  if (threadIdx.x == 0) xb_words = make_uint4(0u, 0u, 0u, 0u);
  __syncthreads();
  {
    XcdBarrier xb0 = xcd_barrier_post(p.xbar, (volatile LAS unsigned*)&xb_words);
    if (threadIdx.x == 0) ((volatile LAS unsigned*)&xb_words)[2] = xb0.x;
  }
#define GSYNC() do { XcdBarrier xb_; xb_.bar = p.xbar; xb_.st = (volatile LAS unsigned*)&xb_words; xb_.x = 0; \
    if (threadIdx.x == 0) xb_.x = ((volatile LAS unsigned*)&xb_words)[2]; xcd_barrier(xb_); } while (0)
  phase0(p, (float*)smem);
  if (p.out == nullptr) grid.sync();
  GSYNC();
  rowpass_norm(p, 0, 0);
  GSYNC();
  for (int l = 0; l < 2; ++l) {
    phase_a(p, l, (u16*)smem);
    GSYNC();
    rowpass_b0(p, l);
    GSYNC();
    phase_b1(p, l, (u16*)smem);
    GSYNC();
    rowpass_b2(p, l);
    GSYNC();
    phase_c(p, l, smem);
    GSYNC();
    rowpass_c2(p, l);
    GSYNC();
    phase_gemm_y(p.MIX, 1024, p.WoutT + (size_t)l * 1024 * 1024, 1024, 1024, p.HQ, 1024, (u16*)smem);
    GSYNC();
    rowpass_norm(p, l, 1);
    GSYNC();
    phase_e(p, l, (u16*)smem);
    GSYNC();
    phase_gemm_y(p.P, DFF, p.WfoT + (size_t)l * 1024 * DFF, DFF, 1024, p.HQ, 1024, (u16*)smem);
    GSYNC();
    rowpass_norm(p, l, 2);
    if (l == 0) GSYNC();
  }
}

extern "C" void kernel_launch(void* const* d_in, const int* in_sizes, int n_in, void* d_out, int out_size, void* d_ws,
                              size_t ws_size, hipStream_t stream) {
  static int grid_blocks = 0;
  if (!grid_blocks) {
    int dev = 0, cus = 0, per_cu = 0;
    hipGetDevice(&dev);
    hipDeviceGetAttribute(&cus, hipDeviceAttributeMultiprocessorCount, dev);
    hipOccupancyMaxActiveBlocksPerMultiprocessor(&per_cu, mega, NTHR, 0);
    if (per_cu > 2) per_cu = 2;
    if (per_cu < 1) per_cu = 1;
    grid_blocks = cus * per_cu;
  }
  Params p{};
  const float* const* in = (const float* const*)d_in;
  p.x_prompt = in[0]; p.x_sample = in[1]; p.cache_ckv = in[2]; p.cache_kr = in[3]; p.state_gdn = in[4]; p.state_hgrn = in[5];
  p.c = in[6]; p.c_ctx = in[7]; p.w_ada = in[8]; p.b_ada = in[9]; p.g_pre_mix = in[10]; p.g_post_mix = in[11];
  p.g_pre_ffn = in[12]; p.g_post_ffn = in[13]; p.w_in = in[14]; p.w_out = in[15]; p.gdn_conv_w = in[16];
  p.gdn_a_log = in[17]; p.gdn_dt_bias = in[18]; p.gdn_norm_w = in[19]; p.hgrn_lb = in[20]; p.hgrn_norm_w = in[21];
  p.mla_q_norm_w = in[22]; p.mla_w_uq = in[23]; p.mla_kv_norm_w = in[24]; p.mla_w_ukv = in[25]; p.w_ffn_in = in[26];
  p.w_ffn_out = in[27];
  p.out = (float*)d_out;
  unsigned char* ws = (unsigned char*)d_ws;
  size_t off = 0;
  auto take = [&](size_t bytes) { unsigned char* r = ws + off; off += (bytes + 255) & ~(size_t)255; return r; };
  p.counters = (unsigned*)take(1024);
  p.xbar = (unsigned*)take(16384);
  p.WinT = (u16*)take((size_t)2 * 3072 * 1024 * 2);
  p.WuqT = (u16*)take((size_t)2 * 768 * 384 * 2);
  p.WukvT = (u16*)take((size_t)2 * 1024 * 256 * 2);
  p.WoutT = (u16*)take((size_t)2 * 1024 * 1024 * 2);
  p.WfiT = (u16*)take((size_t)2 * 5632 * 1024 * 2);
  p.WfoT = (u16*)take((size_t)2 * 1024 * 2816 * 2);
  p.mod = (float*)take((size_t)2 * 9 * 6144 * 4);
  p.HQ = (u16*)take((size_t)T_ALL * 1024 * 2);
  p.P = (u16*)take((size_t)T_ALL * PW * 2);
  p.KN = (u16*)take((size_t)(T_ALL + 2048) * 512 * 2);
  p.VTL = (u16*)take((size_t)8 * 4 * 128 * 4352 * 2);
  p.VTC = (u16*)take((size_t)16 * 4 * 128 * 256 * 2);
  p.CKVC = (u16*)take((size_t)2048 * 256 * 2);
  p.KRC = (u16*)take((size_t)2048 * 64 * 2);
  p.GAB = (float*)take((size_t)T_ALL * 16 * 4);
  p.MIX = (u16*)take((size_t)T_ALL * 1024 * 2);
  if (off > ws_size) { fprintf(stderr, "workspace too small: need %zu have %zu\n", off, ws_size); return; }
  hipMemsetAsync(p.counters, 0, 1024 + 16384, stream);
  void* args[] = {&p};
  hipError_t e = hipLaunchCooperativeKernel((void*)mega, dim3(grid_blocks), dim3(NTHR), args, 0, stream);
  if (e != hipSuccess) fprintf(stderr, "cooperative launch failed: %s (grid %d)\n", hipGetErrorString(e), grid_blocks);
}
```

```cpp
#include <hip/hip_runtime.h>
#include <hip/hip_cooperative_groups.h>
#include <cstdio>
namespace cg = cooperative_groups;

typedef unsigned short u16;
using bf16x8 = __attribute__((ext_vector_type(8))) short;
using f32x4  = __attribute__((ext_vector_type(4))) float;

#define T_CTX 4096
#define T_ALL 36864
#define PW 3072
#define DFF 2816
#define LDS_BYTES 73728
#define NTHR 256

#define P_GQKV 0
#define P_GZ 768
#define P_HQ 1024
#define P_HI 1280
#define P_HF 1536
#define P_HG 2048
#define P_MCQ 2304
#define P_MCKV 2688
#define P_MKR 2944
#define P_GA 3008

struct Params {
  const float *x_prompt, *x_sample, *cache_ckv, *cache_kr, *state_gdn, *state_hgrn, *c, *c_ctx;
  const float *w_ada, *b_ada, *g_pre_mix, *g_post_mix, *g_pre_ffn, *g_post_ffn, *w_in, *w_out;
  const float *gdn_conv_w, *gdn_a_log, *gdn_dt_bias, *gdn_norm_w, *hgrn_lb, *hgrn_norm_w;
  const float *mla_q_norm_w, *mla_w_uq, *mla_kv_norm_w, *mla_w_ukv, *w_ffn_in, *w_ffn_out;
  float* out;
  u16 *WinT, *WuqT, *WukvT, *WoutT, *WfiT, *WfoT;
  float* mod;
  u16 *HQ, *P, *KN, *VTL, *VTC, *CKVC, *KRC, *MIX;
  float* GAB;
  unsigned* counters;
  unsigned* xbar;
};

#define OUT_CKV   37748736
#define OUT_KR    39845888
#define OUT_SGDN  40370176
#define OUT_SHG   41418752

__device__ __forceinline__ u16 f2bf(float f) {
  unsigned u = __float_as_uint(f);
  u += 0x7fffu + ((u >> 16) & 1u);
  return (u16)(u >> 16);
}
__device__ __forceinline__ float bf2f(u16 h) { return __uint_as_float(((unsigned)h) << 16); }
__device__ __forceinline__ float wave_sum(float v) {
#pragma unroll
  for (int o = 32; o > 0; o >>= 1) v += __shfl_xor(v, o);
  return v;
}
__device__ __forceinline__ float sigmoidf_(float x) { return __builtin_amdgcn_rcpf(1.f + __expf(-x)); }
__device__ __forceinline__ float siluf_(float x) { return x * __builtin_amdgcn_rcpf(1.f + __expf(-x)); }
__device__ __forceinline__ int tid_l() { int t = threadIdx.x; asm volatile("" : "+v"(t)); return t; }
__device__ __forceinline__ int tok_mod(int t) { return t < T_CTX ? 0 : 1 + ((t - T_CTX) >> 12); }

__device__ __forceinline__ int map_col(int kind, int j) {
  if (kind == 0) return j;
  if (kind == 1) { if (j < 1024) return j; if (j < 3008) return j + 16; if (j < 3024) return 1024 + (j - 3008); return -1; }
  int blk = j >> 6, w = j & 63;
  return w < 32 ? blk * 32 + w : DFF + blk * 32 + (w - 32);
}

__device__ __forceinline__ void cvt_tile(const float* __restrict__ src, int K, int Nsrc, u16* __restrict__ dst, int kind, int jt, int kt, float* sm) {
  const int tid = tid_l();
  const int j0 = jt * 64, k0 = kt * 64;
  __syncthreads();
  {
    int jj = tid & 63, kk0 = tid >> 6;
    int sc = map_col(kind, j0 + jj);
    for (int kk = kk0; kk < 64; kk += 4)
      sm[kk * 65 + jj] = sc >= 0 ? src[(size_t)(k0 + kk) * Nsrc + sc] : 0.f;
  }
  __syncthreads();
  {
    const int kq = tid & 15, jj0 = tid >> 4;
#pragma unroll
    for (int jj = jj0; jj < 64; jj += 16) {
      uint2 o;
      o.x = (unsigned)f2bf(sm[(4 * kq + 0) * 65 + jj]) | ((unsigned)f2bf(sm[(4 * kq + 1) * 65 + jj]) << 16);
      o.y = (unsigned)f2bf(sm[(4 * kq + 2) * 65 + jj]) | ((unsigned)f2bf(sm[(4 * kq + 3) * 65 + jj]) << 16);
      *(uint2*)(dst + (size_t)(j0 + jj) * K + k0 + 4 * kq) = o;
    }
  }
}

__device__ __forceinline__ void mod_item(const Params& p, int item, float* sm) {
  const int l = item / 96, j0 = (item % 96) * 64;
  const int tid = tid_l();
  float* sC = sm;
  float* sR = sm + 9 * 1024;
  __syncthreads();
  for (int i = tid; i < 9 * 1024; i += NTHR) {
    int m = i >> 10, k = i & 1023;
    float v = m == 0 ? p.c_ctx[k] : p.c[(m - 1) * 1024 + k];
    sC[i] = siluf_(v);
  }
  __syncthreads();
  const int col = tid & 63, ks = tid >> 6;
  float acc[9];
#pragma unroll
  for (int m = 0; m < 9; ++m) acc[m] = 0.f;
  const float* wp = p.w_ada + (size_t)l * 1024 * 6144 + j0 + col;
  for (int k = ks * 256; k < ks * 256 + 256; k += 8) {
    float wv[8];
#pragma unroll
    for (int u = 0; u < 8; ++u) wv[u] = wp[(size_t)(k + u) * 6144];
#pragma unroll
    for (int u = 0; u < 8; ++u)
#pragma unroll
      for (int m = 0; m < 9; ++m) acc[m] += sC[m * 1024 + k + u] * wv[u];
  }
#pragma unroll
  for (int m = 0; m < 9; ++m) sR[(ks * 9 + m) * 64 + col] = acc[m];
  __syncthreads();
  for (int i = tid; i < 9 * 64; i += NTHR) {
    int m = i >> 6, cc = i & 63;
    float v = sR[(0 * 9 + m) * 64 + cc] + sR[(1 * 9 + m) * 64 + cc] + sR[(2 * 9 + m) * 64 + cc] + sR[(3 * 9 + m) * 64 + cc];
    p.mod[((size_t)l * 9 + m) * 6144 + j0 + cc] = v + p.b_ada[l * 6144 + j0 + cc];
  }
}

__device__ __forceinline__ void phase0(const Params& p, float* sm) {
  const int PER_LAYER = 3272;
  const int total = 2 * PER_LAYER + 192;
  for (int item = blockIdx.x; item < total; item += gridDim.x) {
    if (item < 192) { mod_item(p, item, sm); continue; }
    int it = item - 192;
    int l = it / PER_LAYER, r = it % PER_LAYER;
    if (r < 768) { cvt_tile(p.w_in + (size_t)l * 1024 * 3024, 1024, 3024, p.WinT + (size_t)l * 3072 * 1024, 1, r / 16, r % 16, sm); continue; }
    r -= 768;
    if (r < 72) { cvt_tile(p.mla_w_uq + (size_t)l * 384 * 768, 384, 768, p.WuqT + (size_t)l * 768 * 384, 0, r / 6, r % 6, sm); continue; }
    r -= 72;
    if (r < 64) { cvt_tile(p.mla_w_ukv + (size_t)l * 256 * 1024, 256, 1024, p.WukvT + (size_t)l * 1024 * 256, 0, r / 4, r % 4, sm); continue; }
    r -= 64;
    if (r < 256) { cvt_tile(p.w_out + (size_t)l * 1024 * 1024, 1024, 1024, p.WoutT + (size_t)l * 1024 * 1024, 0, r / 16, r % 16, sm); continue; }
    r -= 256;
    if (r < 1408) { cvt_tile(p.w_ffn_in + (size_t)l * 1024 * 5632, 1024, 5632, p.WfiT + (size_t)l * 5632 * 1024, 2, r / 16, r % 16, sm); continue; }
    r -= 1408;
    cvt_tile(p.w_ffn_out + (size_t)l * 2816 * 1024, 2816, 1024, p.WfoT + (size_t)l * 1024 * 2816, 0, r / 44, r % 44, sm);
  }
}

__device__ __forceinline__ void rowpass_norm(const Params& p, int l, int stage) {
  const int tidl = tid_l();
  const int lane = tidl & 63, w = tidl >> 6;
  const int ln = stage == 0 ? 0 : (stage == 1 ? l : l + 1);
  const int sh_off = stage == 1 ? 3072 : 0;
  const float* gpre = stage == 1 ? p.g_pre_ffn + l * 1024 : p.g_pre_mix + (ln < 2 ? ln : 0) * 1024;
  u16* dst = stage == 1 ? p.MIX : p.HQ;
  for (int t = blockIdx.x * 4 + w; t < T_ALL; t += gridDim.x * 4) {
    const int m = tok_mod(t);
    float x[16];
    float* xo = p.out + (size_t)t * 1024;
    if (stage == 0) {
      const float* xi = t < T_CTX ? p.x_prompt + (size_t)t * 1024 : p.x_sample + (size_t)(t - T_CTX) * 1024;
#pragma unroll
      for (int i = 0; i < 4; ++i) {
        float4 v = *(const float4*)(xi + i * 256 + lane * 4);
        x[i * 4 + 0] = v.x; x[i * 4 + 1] = v.y; x[i * 4 + 2] = v.z; x[i * 4 + 3] = v.w;
      }
    } else {
      const u16* yp = p.HQ + (size_t)t * 1024;
      float y[16]; float ss = 0.f;
#pragma unroll
      for (int i = 0; i < 4; ++i) {
        uint2 v = *(const uint2*)(yp + i * 256 + lane * 4);
        y[i * 4 + 0] = bf2f((u16)(v.x & 0xffff)); y[i * 4 + 1] = bf2f((u16)(v.x >> 16));
        y[i * 4 + 2] = bf2f((u16)(v.y & 0xffff)); y[i * 4 + 3] = bf2f((u16)(v.y >> 16));
      }
#pragma unroll
      for (int i = 0; i < 16; ++i) ss += y[i] * y[i];
      ss = wave_sum(ss);
      const float rstd = rsqrtf(ss * (1.f / 1024.f) + 1e-6f);
      const float* gpost = (stage == 1 ? p.g_post_mix : p.g_post_ffn) + l * 1024;
      const float* gt = p.mod + ((size_t)l * 9 + m) * 6144 + (stage == 1 ? 2048 : 5120);
#pragma unroll
      for (int i = 0; i < 4; ++i) {
        float4 xv = *(const float4*)(xo + i * 256 + lane * 4);
        float4 gp = *(const float4*)(gpost + i * 256 + lane * 4);
        float4 gg = *(const float4*)(gt + i * 256 + lane * 4);
        x[i * 4 + 0] = xv.x + gg.x * y[i * 4 + 0] * rstd * gp.x;
        x[i * 4 + 1] = xv.y + gg.y * y[i * 4 + 1] * rstd * gp.y;
        x[i * 4 + 2] = xv.z + gg.z * y[i * 4 + 2] * rstd * gp.z;
        x[i * 4 + 3] = xv.w + gg.w * y[i * 4 + 3] * rstd * gp.w;
      }
    }
    __threadfence_block();
#pragma unroll
    for (int i = 0; i < 4; ++i)
      *(float4*)(xo + i * 256 + lane * 4) = make_float4(x[i * 4 + 0], x[i * 4 + 1], x[i * 4 + 2], x[i * 4 + 3]);
    if (ln >= 2) continue;
    float ss = 0.f;
#pragma unroll
    for (int i = 0; i < 16; ++i) ss += x[i] * x[i];
    ss = wave_sum(ss);
    const float rstd = rsqrtf(ss * (1.f / 1024.f) + 1e-6f);
    const float* sh = p.mod + ((size_t)ln * 9 + m) * 6144 + sh_off;
    const float* sc = sh + 1024;
    u16* hp = dst + (size_t)t * 1024;
#pragma unroll
    for (int i = 0; i < 4; ++i) {
      float4 gp = *(const float4*)(gpre + i * 256 + lane * 4);
      float4 s1 = *(const float4*)(sh + i * 256 + lane * 4);
      float4 c1 = *(const float4*)(sc + i * 256 + lane * 4);
      float h0 = x[i * 4 + 0] * rstd * gp.x * (1.f + c1.x) + s1.x;
      float h1 = x[i * 4 + 1] * rstd * gp.y * (1.f + c1.y) + s1.y;
      float h2 = x[i * 4 + 2] * rstd * gp.z * (1.f + c1.z) + s1.z;
      float h3 = x[i * 4 + 3] * rstd * gp.w * (1.f + c1.w) + s1.w;
      uint2 o;
      o.x = (unsigned)f2bf(h0) | ((unsigned)f2bf(h1) << 16);
      o.y = (unsigned)f2bf(h2) | ((unsigned)f2bf(h3) << 16);
      *(uint2*)(hp + i * 256 + lane * 4) = o;
    }
  }
}

__device__ __forceinline__ void unpack8(const uint4 v, float (&f)[8]);
__device__ __forceinline__ uint4 pack8(const float (&f)[8]);
__device__ __forceinline__ void rowpass_b0(const Params& p, int l) {
  const int tidl = tid_l();
  const int lane = tidl & 63, w = tidl >> 6;
  for (int t = blockIdx.x * 4 + w; t < T_ALL + 2048; t += gridDim.x * 4) {
    if (t >= T_ALL) {
      const int r = t - T_ALL, b = r >> 8, s = r & 255;
      if (lane < 32) {
        const float* ck = p.cache_ckv + (((size_t)b * 2 + l) * 256 + s) * 256 + lane * 8;
        const float4 x0 = *(const float4*)ck, x1 = *(const float4*)(ck + 4);
        const float f[8] = {x0.x, x0.y, x0.z, x0.w, x1.x, x1.y, x1.z, x1.w};
        *(uint4*)(p.CKVC + (size_t)r * 256 + lane * 8) = pack8(f);
      } else if (lane < 40) {
        const float* kr = p.cache_kr + (((size_t)b * 2 + l) * 256 + s) * 64 + (lane - 32) * 8;
        const float4 x0 = *(const float4*)kr, x1 = *(const float4*)(kr + 4);
        const float f[8] = {x0.x, x0.y, x0.z, x0.w, x1.x, x1.y, x1.z, x1.w};
        *(uint4*)(p.KRC + (size_t)r * 64 + (lane - 32) * 8) = pack8(f);
      }
      continue;
    }
    u16* pr = p.P + (size_t)t * PW;
    {
      float f[8]; float ss = 0.f;
      if (lane < 48) {
        unpack8(*(const uint4*)(pr + P_MCQ + lane * 8), f);
#pragma unroll
        for (int i = 0; i < 8; ++i) ss += f[i] * f[i];
      }
      ss = wave_sum(ss);
      const float rstd = rsqrtf(ss * (1.f / 384.f) + 1e-6f);
      if (lane < 48) {
        const float* wq = p.mla_q_norm_w + l * 384 + lane * 8;
        const float4 w0 = *(const float4*)wq, w1 = *(const float4*)(wq + 4);
        f[0] *= rstd * w0.x; f[1] *= rstd * w0.y; f[2] *= rstd * w0.z; f[3] *= rstd * w0.w;
        f[4] *= rstd * w1.x; f[5] *= rstd * w1.y; f[6] *= rstd * w1.z; f[7] *= rstd * w1.w;
        *(uint4*)(pr + P_MCQ + lane * 8) = pack8(f);
      }
    }
    {
      float f[8]; float ss = 0.f;
      if (lane < 32) {
        unpack8(*(const uint4*)(pr + P_MCKV + lane * 8), f);
#pragma unroll
        for (int i = 0; i < 8; ++i) ss += f[i] * f[i];
      }
      ss = wave_sum(ss);
      const float rstd = rsqrtf(ss * (1.f / 256.f) + 1e-6f);
      if (lane < 32) {
        const float* wk = p.mla_kv_norm_w + l * 256 + lane * 8;
        const float4 w0 = *(const float4*)wk, w1 = *(const float4*)(wk + 4);
        f[0] *= rstd * w0.x; f[1] *= rstd * w0.y; f[2] *= rstd * w0.z; f[3] *= rstd * w0.w;
        f[4] *= rstd * w1.x; f[5] *= rstd * w1.y; f[6] *= rstd * w1.z; f[7] *= rstd * w1.w;
        *(uint4*)(pr + P_MCKV + lane * 8) = pack8(f);
        if (t < T_CTX) {
          const int b = t >> 8, s = t & 255;
          float* op = p.out + OUT_CKV + (((size_t)b * 2 + l) * 256 + s) * 256 + lane * 8;
          *(float4*)op = make_float4(f[0], f[1], f[2], f[3]);
          *(float4*)(op + 4) = make_float4(f[4], f[5], f[6], f[7]);
        }
      }
    }
    {
      float v = bf2f(pr[P_MKR + lane]);
      if (t < T_CTX) {
        int b = t >> 8, s = t & 255;
        p.out[OUT_KR + (((size_t)b * 2 + l) * 256 + s) * 64 + lane] = v;
      } else {
        int pos = (t - T_CTX) & 4095;
        int axis = lane >> 5, half = (lane >> 4) & 1, f = lane & 15;
        float posf = axis == 0 ? (float)(pos >> 6) : (float)(pos & 63);
        float inv = exp2f(-(float)f * (13.287712379549449f / 16.f));
        float ang = posf * inv;
        float sn, cs;
        __sincosf(ang, &sn, &cs);
        float other = __shfl_xor(v, 16);
        float o = half == 0 ? v * cs - other * sn : v * cs + other * sn;
        pr[P_MKR + lane] = f2bf(o);
      }
    }
  }
}

#define P_QH 2304
#define P_KH 2560
__device__ __forceinline__ void rowpass_b2(const Params& p, int l) {
  const int tidl = tid_l();
  const int lane = tidl & 63, w = tidl >> 6;
  float cw[8][5], cv[8][5];
#pragma unroll
  for (int e = 0; e < 8; ++e)
#pragma unroll
    for (int j = 0; j < 5; ++j) {
      cw[e][j] = p.gdn_conv_w[((size_t)l * 768 + 8 * lane + e) * 5 + j];
      cv[e][j] = p.gdn_conv_w[((size_t)l * 768 + 512 + 8 * (lane & 31) + e) * 5 + j];
    }
  u16* VH = p.HQ + (size_t)T_ALL * 768;
  for (int t = blockIdx.x * 4 + w; t < T_ALL; t += gridDim.x * 4) {
    const int len = t < T_CTX ? 256 : 4096;
    const int tau = t < T_CTX ? (t & 255) : ((t - T_CTX) & 4095);
    float y[8], yv[8];
#pragma unroll
    for (int e = 0; e < 8; ++e) { y[e] = 0.f; yv[e] = 0.f; }
#pragma unroll
    for (int j = 0; j < 5; ++j) {
      const int tt = tau + j - 2;
      if (tt >= 0 && tt < len) {
        const u16* pr = p.P + (size_t)(t + j - 2) * PW;
        float f[8];
        unpack8(*(const uint4*)(pr + 8 * lane), f);
#pragma unroll
        for (int e = 0; e < 8; ++e) y[e] += cw[e][j] * f[e];
        if (lane < 32) {
          unpack8(*(const uint4*)(pr + 512 + 8 * lane), f);
#pragma unroll
          for (int e = 0; e < 8; ++e) yv[e] += cv[e][j] * f[e];
        }
      }
    }
    float ss = 0.f;
#pragma unroll
    for (int e = 0; e < 8; ++e) { y[e] = siluf_(y[e]); yv[e] = siluf_(yv[e]); ss += y[e] * y[e]; }
    ss += __shfl_xor(ss, 1); ss += __shfl_xor(ss, 2); ss += __shfl_xor(ss, 4);
    const float rn = rsqrtf(ss + 1e-6f) * (lane < 32 ? 0.125f : 1.f);
#pragma unroll
    for (int e = 0; e < 8; ++e) y[e] *= rn;
    *(uint4*)(p.P + (size_t)t * PW + P_QH + 8 * lane) = pack8(y);
    if (lane < 32) *(uint4*)(VH + (size_t)t * 256 + 8 * lane) = pack8(yv);
  }
}

__device__ __forceinline__ void unpack8(const uint4 v, float (&f)[8]) {
  f[0] = bf2f((u16)(v.x & 0xffff)); f[1] = bf2f((u16)(v.x >> 16)); f[2] = bf2f((u16)(v.y & 0xffff)); f[3] = bf2f((u16)(v.y >> 16));
  f[4] = bf2f((u16)(v.z & 0xffff)); f[5] = bf2f((u16)(v.z >> 16)); f[6] = bf2f((u16)(v.w & 0xffff)); f[7] = bf2f((u16)(v.w >> 16));
}
__device__ __forceinline__ uint4 pack8(const float (&f)[8]) {
  uint4 o;
  o.x = (unsigned)f2bf(f[0]) | ((unsigned)f2bf(f[1]) << 16); o.y = (unsigned)f2bf(f[2]) | ((unsigned)f2bf(f[3]) << 16);
  o.z = (unsigned)f2bf(f[4]) | ((unsigned)f2bf(f[5]) << 16); o.w = (unsigned)f2bf(f[6]) | ((unsigned)f2bf(f[7]) << 16);
  return o;
}
__device__ __forceinline__ void rowpass_c2(const Params& p, int l) {
  const int tidl = tid_l();
  const int lane = tidl & 63, w = tidl >> 6;
  const int hl = lane & 31, isH = lane >> 5;
  const float* nw = (isH ? p.hgrn_norm_w : p.gdn_norm_w) + l * 64 + (hl & 7) * 8;
  const float4 w0 = *(const float4*)(nw), w1 = *(const float4*)(nw + 4);
  const float wv[8] = {w0.x, w0.y, w0.z, w0.w, w1.x, w1.y, w1.z, w1.w};
  for (int t = blockIdx.x * 4 + w; t < T_ALL; t += gridDim.x * 4) {
    u16* mr = p.MIX + (size_t)t * 1024;
    const u16* pr = p.P + (size_t)t * PW;
    const u16* qr = p.HQ + (size_t)t * 768;
    const uint4 vf = *(const uint4*)(mr + isH * 512 + hl * 8);
    const uint4 vb = *(const uint4*)(mr + isH * 512 + 256 + hl * 8);
    const uint4 vg = *(const uint4*)(pr + (isH ? P_HG : P_GZ) + hl * 8);
    const int c0 = lane * 8;
    const uint4 vo = *(const uint4*)(qr + (c0 >> 7) * 192 + (c0 & 127));
    float f[8], bb[8], g[8];
    unpack8(vf, f); unpack8(vb, bb); unpack8(vg, g);
    float ss = 0.f;
#pragma unroll
    for (int i = 0; i < 8; ++i) { f[i] += bb[i]; ss += f[i] * f[i]; }
    ss += __shfl_xor(ss, 1); ss += __shfl_xor(ss, 2); ss += __shfl_xor(ss, 4);
    const float rn = rsqrtf(ss * (1.f / 64.f) + 1e-6f);
#pragma unroll
    for (int i = 0; i < 8; ++i) f[i] = f[i] * rn * wv[i] * (isH ? sigmoidf_(g[i]) : siluf_(g[i]));
    __threadfence_block();
    *(uint4*)(mr + isH * 256 + hl * 8) = pack8(f);
    *(uint4*)(mr + 512 + c0) = vo;
  }
}

__device__ __forceinline__ void gemm128(const u16* __restrict__ A, int lda, const u16* __restrict__ B, int ldb, int K,
                                        u16* lds, f32x4 (&acc)[4][4]) {
  const int tid = tid_l(), lane = tid & 63, w = tid >> 6, wm = w >> 1, wn = w & 1;
  const int r16 = lane & 15, g4 = lane >> 4;
#pragma unroll
  for (int i = 0; i < 4; ++i)
#pragma unroll
    for (int j = 0; j < 4; ++j) acc[i][j] = f32x4{0.f, 0.f, 0.f, 0.f};
  const int lrow = tid >> 3, lkc = tid & 7;
  const u16* ap = A + (size_t)lrow * lda + lkc * 8;
  const u16* bp = B + (size_t)lrow * ldb + lkc * 8;
  const size_t sa32 = (size_t)32 * lda, sb32 = (size_t)32 * ldb;
  uint4 ra0 = *(const uint4*)(ap), ra1 = *(const uint4*)(ap + sa32), ra2 = *(const uint4*)(ap + 2 * sa32), ra3 = *(const uint4*)(ap + 3 * sa32);
  uint4 rb0 = *(const uint4*)(bp), rb1 = *(const uint4*)(bp + sb32), rb2 = *(const uint4*)(bp + 2 * sb32), rb3 = *(const uint4*)(bp + 3 * sb32);
  const int woff = lrow * 64 + ((lkc ^ (lrow & 7)) * 8);
  const int sw = r16 & 7;
  const int fa0 = (wm * 64 + r16) * 64 + ((g4 ^ sw) * 8);
  const int fa1 = (wm * 64 + r16) * 64 + (((4 + g4) ^ sw) * 8);
  const int fb0 = 128 * 64 + (wn * 64 + r16) * 64 + ((g4 ^ sw) * 8);
  const int fb1 = 128 * 64 + (wn * 64 + r16) * 64 + (((4 + g4) ^ sw) * 8);
  const int nk = K >> 6;
  __syncthreads();
  {
    u16* wa = lds + woff; u16* wb = lds + 128 * 64 + woff;
    *(uint4*)(wa) = ra0; *(uint4*)(wa + 32 * 64) = ra1; *(uint4*)(wa + 64 * 64) = ra2; *(uint4*)(wa + 96 * 64) = ra3;
    *(uint4*)(wb) = rb0; *(uint4*)(wb + 32 * 64) = rb1; *(uint4*)(wb + 64 * 64) = rb2; *(uint4*)(wb + 96 * 64) = rb3;
  }
  if (nk > 1) {
    const u16* a2 = ap + 64; const u16* b2 = bp + 64;
    ra0 = *(const uint4*)(a2); ra1 = *(const uint4*)(a2 + sa32); ra2 = *(const uint4*)(a2 + 2 * sa32); ra3 = *(const uint4*)(a2 + 3 * sa32);
    rb0 = *(const uint4*)(b2); rb1 = *(const uint4*)(b2 + sb32); rb2 = *(const uint4*)(b2 + 2 * sb32); rb3 = *(const uint4*)(b2 + 3 * sb32);
  }
  __syncthreads();
  for (int kt = 0; kt < nk; ++kt) {
    const u16* cur = lds + (kt & 1) * (256 * 64);
    if (kt + 1 < nk) {
      u16* nxt = lds + ((kt + 1) & 1) * (256 * 64);
      u16* wa = nxt + woff; u16* wb = nxt + 128 * 64 + woff;
      *(uint4*)(wa) = ra0; *(uint4*)(wa + 32 * 64) = ra1; *(uint4*)(wa + 64 * 64) = ra2; *(uint4*)(wa + 96 * 64) = ra3;
      *(uint4*)(wb) = rb0; *(uint4*)(wb + 32 * 64) = rb1; *(uint4*)(wb + 64 * 64) = rb2; *(uint4*)(wb + 96 * 64) = rb3;
      if (kt + 2 < nk) {
        const u16* a2 = ap + (kt + 2) * 64; const u16* b2 = bp + (kt + 2) * 64;
        ra0 = *(const uint4*)(a2); ra1 = *(const uint4*)(a2 + sa32); ra2 = *(const uint4*)(a2 + 2 * sa32); ra3 = *(const uint4*)(a2 + 3 * sa32);
        rb0 = *(const uint4*)(b2); rb1 = *(const uint4*)(b2 + sb32); rb2 = *(const uint4*)(b2 + 2 * sb32); rb3 = *(const uint4*)(b2 + 3 * sb32);
      }
    }
    {
      const u16* pa0 = cur + fa0; const u16* pa1 = cur + fa1; const u16* pb0 = cur + fb0; const u16* pb1 = cur + fb1;
      bf16x8 a0 = *(const bf16x8*)(pa0), a1 = *(const bf16x8*)(pa0 + 16 * 64), a2 = *(const bf16x8*)(pa0 + 32 * 64), a3 = *(const bf16x8*)(pa0 + 48 * 64);
      bf16x8 b0 = *(const bf16x8*)(pb0), b1 = *(const bf16x8*)(pb0 + 16 * 64), b2 = *(const bf16x8*)(pb0 + 32 * 64), b3 = *(const bf16x8*)(pb0 + 48 * 64);
      bf16x8 c0 = *(const bf16x8*)(pa1), c1 = *(const bf16x8*)(pa1 + 16 * 64), c2 = *(const bf16x8*)(pa1 + 32 * 64), c3 = *(const bf16x8*)(pa1 + 48 * 64);
      bf16x8 d0 = *(const bf16x8*)(pb1), d1 = *(const bf16x8*)(pb1 + 16 * 64), d2 = *(const bf16x8*)(pb1 + 32 * 64), d3 = *(const bf16x8*)(pb1 + 48 * 64);
      __builtin_amdgcn_sched_barrier(0);
#define G128_MM(j, bj, x0, x1, x2, x3) do { \
        acc[0][j] = __builtin_amdgcn_mfma_f32_16x16x32_bf16(bj, x0, acc[0][j], 0, 0, 0); \
        acc[1][j] = __builtin_amdgcn_mfma_f32_16x16x32_bf16(bj, x1, acc[1][j], 0, 0, 0); \
        acc[2][j] = __builtin_amdgcn_mfma_f32_16x16x32_bf16(bj, x2, acc[2][j], 0, 0, 0); \
        acc[3][j] = __builtin_amdgcn_mfma_f32_16x16x32_bf16(bj, x3, acc[3][j], 0, 0, 0); } while (0)
      __builtin_amdgcn_s_setprio(1);
      G128_MM(0, b0, a0, a1, a2, a3); G128_MM(1, b1, a0, a1, a2, a3); G128_MM(2, b2, a0, a1, a2, a3); G128_MM(3, b3, a0, a1, a2, a3);
      G128_MM(0, d0, c0, c1, c2, c3); G128_MM(1, d1, c0, c1, c2, c3); G128_MM(2, d2, c0, c1, c2, c3); G128_MM(3, d3, c0, c1, c2, c3);
      __builtin_amdgcn_s_setprio(0);
    }
    __syncthreads();
  }
}
__device__ __forceinline__ uint2 pack4(f32x4 v) {
  uint2 o;
  o.x = (unsigned)f2bf(v[0]) | ((unsigned)f2bf(v[1]) << 16);
  o.y = (unsigned)f2bf(v[2]) | ((unsigned)f2bf(v[3]) << 16);
  return o;
}

__device__ __forceinline__ void gemm256(const u16* __restrict__ A, int lda, const u16* __restrict__ B, int ldb, int K,
                                        u16* lds, f32x4 (&acc)[8][4]) {
  const int tid = tid_l(), lane = tid & 63, w = tid >> 6, wm = w >> 1, wn = w & 1;
  const int r16 = lane & 15, g4 = lane >> 4;
#pragma unroll
  for (int i = 0; i < 8; ++i)
#pragma unroll
    for (int j = 0; j < 4; ++j) acc[i][j] = f32x4{0.f, 0.f, 0.f, 0.f};
  const int lrow = tid >> 2, lkc = tid & 3;
  const u16* ap = A + (size_t)lrow * lda + lkc * 8;
  const u16* bp = B + (size_t)lrow * ldb + lkc * 8;
  const size_t sa64 = (size_t)64 * lda, sb64 = (size_t)64 * ldb;
  const int woff = lrow * 32 + ((lkc ^ ((lrow >> 1) & 3)) * 8);
  const int fsw = (g4 ^ ((r16 >> 1) & 3)) * 8;
  const int faoff = (wm * 128 + r16) * 32 + fsw;
  const int fboff = 256 * 32 + (wn * 64 + r16) * 32 + fsw;
  const int nk = K >> 5;
  const int BUF = 384 * 32;
  uint4 xa0, xa1, xa2, xa3, xb0, xb1;
  uint4 ya0, ya1, ya2, ya3, yb0, yb1;
#define G256_LOAD(P, st) do { const u16* a2_ = ap + (st) * 32; const u16* b2_ = bp + (st) * 32; \
    P##a0 = *(const uint4*)(a2_); P##a1 = *(const uint4*)(a2_ + sa64); P##a2 = *(const uint4*)(a2_ + 2 * sa64); P##a3 = *(const uint4*)(a2_ + 3 * sa64); \
    P##b0 = *(const uint4*)(b2_); P##b1 = *(const uint4*)(b2_ + sb64); } while (0)
#define G256_STORE(P, buf) do { u16* wa_ = lds + (buf) * BUF + woff; u16* wb_ = wa_ + 256 * 32; \
    *(uint4*)(wa_) = P##a0; *(uint4*)(wa_ + 64 * 32) = P##a1; *(uint4*)(wa_ + 128 * 32) = P##a2; *(uint4*)(wa_ + 192 * 32) = P##a3; \
    *(uint4*)(wb_) = P##b0; *(uint4*)(wb_ + 64 * 32) = P##b1; } while (0)
#define G256_MM(i, af) do { \
      acc[i][0] = __builtin_amdgcn_mfma_f32_16x16x32_bf16(bf0, af, acc[i][0], 0, 0, 0); \
      acc[i][1] = __builtin_amdgcn_mfma_f32_16x16x32_bf16(bf1, af, acc[i][1], 0, 0, 0); \
      acc[i][2] = __builtin_amdgcn_mfma_f32_16x16x32_bf16(bf2, af, acc[i][2], 0, 0, 0); \
      acc[i][3] = __builtin_amdgcn_mfma_f32_16x16x32_bf16(bf3, af, acc[i][3], 0, 0, 0); } while (0)
#define G256_COMPUTE(buf) do { const u16* fa_ = lds + (buf) * BUF + faoff; const u16* fb_ = lds + (buf) * BUF + fboff; \
    bf16x8 bf0 = *(const bf16x8*)(fb_), bf1 = *(const bf16x8*)(fb_ + 16 * 32), bf2 = *(const bf16x8*)(fb_ + 32 * 32), bf3 = *(const bf16x8*)(fb_ + 48 * 32); \
    bf16x8 a0 = *(const bf16x8*)(fa_), a1 = *(const bf16x8*)(fa_ + 16 * 32), a2 = *(const bf16x8*)(fa_ + 32 * 32), a3 = *(const bf16x8*)(fa_ + 48 * 32); \
    __builtin_amdgcn_sched_barrier(0); __builtin_amdgcn_s_setprio(1); \
    G256_MM(0, a0); a0 = *(const bf16x8*)(fa_ + 64 * 32); __builtin_amdgcn_sched_barrier(0); \
    G256_MM(1, a1); a1 = *(const bf16x8*)(fa_ + 80 * 32); __builtin_amdgcn_sched_barrier(0); \
    G256_MM(2, a2); a2 = *(const bf16x8*)(fa_ + 96 * 32); __builtin_amdgcn_sched_barrier(0); \
    G256_MM(3, a3); a3 = *(const bf16x8*)(fa_ + 112 * 32); __builtin_amdgcn_sched_barrier(0); \
    G256_MM(4, a0); G256_MM(5, a1); G256_MM(6, a2); G256_MM(7, a3); __builtin_amdgcn_s_setprio(0); } while (0)
  G256_LOAD(x, 0);
  G256_LOAD(y, 1);
  __syncthreads();
  G256_STORE(x, 0);
  G256_LOAD(x, 2);
  __syncthreads();
  for (int kt = 0; kt < nk; kt += 2) {
    G256_STORE(y, 1);
    if (kt + 3 < nk) G256_LOAD(y, kt + 3);
    G256_COMPUTE(0);
    __syncthreads();
    if (kt + 2 < nk) {
      G256_STORE(x, 0);
      if (kt + 4 < nk) G256_LOAD(x, kt + 4);
    }
    G256_COMPUTE(1);
    __syncthreads();
  }
}
#define GEMM256_RC const int tde = tid_l(); const int rb = ((tde >> 6) >> 1) * 128 + (tde & 15), cb = ((tde >> 6) & 1) * 64 + ((tde & 63) >> 4) * 4;
#define GEMM_RC const int tde = tid_l(); const int rb = ((tde >> 6) >> 1) * 64 + (tde & 15), cb = ((tde >> 6) & 1) * 64 + ((tde & 63) >> 4) * 4;


__device__ __forceinline__ bool tile_at(int r, int Mt, int Nt, int& mt, int& nt) {
  const int x = blockIdx.x & 7, j = blockIdx.x >> 3, bpx = gridDim.x >> 3;
  const int mpx = Mt >> 3;
  const int q = r * bpx + j;
  if (q >= mpx * Nt) return false;
  const int full = (Nt >> 3) * (mpx * 8);
  int cb, rem, wcb;
  if (q < full) { cb = q / (mpx * 8); rem = q - cb * mpx * 8; wcb = 8; }
  else { cb = Nt >> 3; rem = q - full; wcb = Nt - cb * 8; }
  mt = x * mpx + rem / wcb;
  nt = cb * 8 + rem % wcb;
  return true;
}

__device__ __forceinline__ void phase_a(const Params& p, int l, u16* lds) {
  const u16* Bw = p.WinT + (size_t)l * 3072 * 1024;
  int mt, nt;
  for (int r = 0; tile_at(r, 144, 24, mt, nt); ++r) {
    const int m0 = mt * 256, n0 = nt * 128;
    f32x4 acc[8][4];
    gemm256(p.HQ + (size_t)m0 * 1024, 1024, Bw + (size_t)n0 * 1024, 1024, 1024, lds, acc);
    { GEMM256_RC
#pragma unroll
      for (int mi = 0; mi < 8; ++mi) {
        const int row = m0 + rb + mi * 16;
#pragma unroll
        for (int ni = 0; ni < 4; ++ni) {
          const int col = n0 + cb + ni * 16;
          *(uint2*)(p.P + (size_t)row * PW + col) = pack4(acc[mi][ni]);
          if (col >= P_GA && col < P_GA + 16)
            *(float4*)(p.GAB + (size_t)row * 16 + (col - P_GA)) = make_float4(acc[mi][ni][0], acc[mi][ni][1], acc[mi][ni][2], acc[mi][ni][3]);
        }
      }
    }
  }
}

__device__ __forceinline__ void phase_b1(const Params& p, int l, u16* lds) {
  int mt, nt;
  for (int pass = 0; pass < 2; ++pass) {
  for (int r = 0; tile_at(r, pass == 0 ? 288 : 304, pass == 0 ? 6 : 8, mt, nt); ++r) {
    if (pass == 0) {
      const int m0 = mt * 128, n0 = nt * 128;
      const float qscale = 0.07216878364870322f * 1.4426950408889634f;
      f32x4 acc[4][4];
      gemm128(p.P + (size_t)m0 * PW + P_MCQ, PW, p.WuqT + (size_t)l * 768 * 384 + (size_t)n0 * 384, 384, 384, lds, acc);
      { GEMM_RC
        const int g4 = (tde & 63) >> 4;
        const int cw0 = n0 + cb - g4 * 4;
        const bool ropew = ((cw0 >> 6) % 3) == 2 && m0 >= T_CTX;
#pragma unroll
        for (int mi = 0; mi < 4; ++mi) {
          const int row = m0 + rb + mi * 16;
          f32x4 v0 = acc[mi][0], v1 = acc[mi][1], v2 = acc[mi][2], v3 = acc[mi][3];
          if (ropew) {
            const int pos = (row - T_CTX) & 4095;
#pragma unroll
            for (int r = 0; r < 4; ++r) {
              const float inv = exp2f(-(float)(g4 * 4 + r) * (13.287712379549449f / 16.f));
              float s0, c0, s1, c1;
              __sincosf((float)(pos >> 6) * inv, &s0, &c0);
              __sincosf((float)(pos & 63) * inv, &s1, &c1);
              const float a0 = v0[r] * c0 - v1[r] * s0, a1 = v1[r] * c0 + v0[r] * s0;
              const float b0 = v2[r] * c1 - v3[r] * s1, b1 = v3[r] * c1 + v2[r] * s1;
              v0[r] = a0; v1[r] = a1; v2[r] = b0; v3[r] = b1;
            }
          }
          u16* qp = p.HQ + (size_t)row * 768 + n0 + cb;
          *(uint2*)(qp) = pack4(v0 * qscale); *(uint2*)(qp + 16) = pack4(v1 * qscale);
          *(uint2*)(qp + 32) = pack4(v2 * qscale); *(uint2*)(qp + 48) = pack4(v3 * qscale);
        }
      }
    } else {
      const int m0 = mt * 128, n0 = nt * 128;
      const u16* Ap; int lda;
      if (mt < 288) { Ap = p.P + (size_t)m0 * PW + P_MCKV; lda = PW; }
      else { Ap = p.CKVC + (size_t)(m0 - T_ALL) * 256; lda = 256; }
      f32x4 acc[4][4];
      gemm128(Ap, lda, p.WukvT + (size_t)l * 1024 * 256 + (size_t)n0 * 256, 256, 256, lds, acc);
      { GEMM_RC
#pragma unroll
        for (int mi = 0; mi < 4; ++mi) {
          const int row = m0 + rb + mi * 16;
          u16* vb; int vst;
          if (row < T_CTX) { int b = row >> 8, pos = row & 255; vb = p.VTC + (size_t)(b * 4) * 128 * 256 + pos; vst = 256; }
          else if (row < T_ALL) { int b = (row - T_CTX) >> 12, pos = (row - T_CTX) & 4095; vb = p.VTL + (size_t)(b * 4) * 128 * 4352 + pos; vst = 4352; }
          else { int b = (row - T_ALL) >> 8, pos = 4096 + ((row - T_ALL) & 255); vb = p.VTL + (size_t)(b * 4) * 128 * 4352 + pos; vst = 4352; }
#pragma unroll
          for (int ni = 0; ni < 4; ++ni) {
            const int col = n0 + cb + ni * 16;
            const int h = col >> 8, wi = col & 255;
            if (wi < 128) {
              *(uint2*)(p.KN + (size_t)row * 512 + h * 128 + wi) = pack4(acc[mi][ni]);
            } else {
              u16* dst = vb + (size_t)(h * 128 + (wi - 128)) * vst;
#pragma unroll
              for (int r = 0; r < 4; ++r) dst[(size_t)r * vst] = f2bf(acc[mi][ni][r]);
            }
          }
        }
      }
    }
  }
  }
}

__device__ __forceinline__ void phase_gemm_y(const u16* A, int lda, const u16* B, int K, int N, u16* Y, int ldy, u16* lds) {
  int mt, nt;
  for (int r = 0; tile_at(r, 288, N / 128, mt, nt); ++r) {
    const int m0 = mt * 128, n0 = nt * 128;
    f32x4 acc[4][4];
    gemm128(A + (size_t)m0 * lda, lda, B + (size_t)n0 * K, K, K, lds, acc);
    { GEMM_RC
#pragma unroll
      for (int mi = 0; mi < 4; ++mi)
#pragma unroll
        for (int ni = 0; ni < 4; ++ni)
          *(uint2*)(Y + (size_t)(m0 + rb + mi * 16) * ldy + n0 + cb + ni * 16) = pack4(acc[mi][ni]);
    }
  }
}

__device__ __forceinline__ void phase_e(const Params& p, int l, u16* lds) {
  const u16* Bw = p.WfiT + (size_t)l * 5632 * 1024;
  int mt, nt;
  for (int r = 0; tile_at(r, 144, 44, mt, nt); ++r) {
    const int m0 = mt * 256, n0 = nt * 128;
    f32x4 acc[8][4];
    gemm256(p.MIX + (size_t)m0 * 1024, 1024, Bw + (size_t)n0 * 1024, 1024, 1024, lds, acc);
    { GEMM256_RC
      const int g4x4 = ((tde & 63) >> 4) * 4;
      const int hc0 = ((n0 + cb - g4x4) >> 1) + g4x4;
#pragma unroll
      for (int mi = 0; mi < 8; ++mi)
#pragma unroll
        for (int ni = 0; ni < 2; ++ni) {
          f32x4 hv;
#pragma unroll
          for (int r = 0; r < 4; ++r) hv[r] = siluf_(acc[mi][ni][r]) * acc[mi][ni + 2][r];
          *(uint2*)(p.P + (size_t)(m0 + rb + mi * 16) * DFF + hc0 + ni * 16) = pack4(hv);
        }
    }
  }
}

#define KST 208
#define VST 80
#define PST 80
__device__ __forceinline__ void attn_item(const Params& p, int latent, int b, int h, int qb, unsigned char* smraw, int dummy = 0) {
  u16* sK = (u16*)smraw;
  u16* sV = sK + 64 * KST;
  u16* sP = sV + 128 * VST;
  const int tid = tid_l(), lane = tid & 63, w = tid >> 6, r16 = lane & 15, g4 = lane >> 4;
  const int nkeys = latent ? 4352 : 256;
  const int krow0 = latent ? T_CTX + b * 4096 : b * 256;
  const int tq0 = krow0 + qb * 128;
  const u16* vt = latent ? p.VTL + (size_t)((b * 4 + h) * 128) * 4352 : p.VTC + (size_t)((b * 4 + h) * 128) * 256;
  u16* sPw = sP + w * 32 * PST;
  bf16x8 q[2][6];
#pragma unroll
  for (int mi = 0; mi < 2; ++mi)
#pragma unroll
    for (int ks = 0; ks < 6; ++ks)
      q[mi][ks] = *(const bf16x8*)(p.HQ + (size_t)(tq0 + w * 32 + mi * 16 + r16) * 768 + h * 192 + ks * 32 + g4 * 8);
  f32x4 o[2][8];
  float mrow[2], lrow[2];
#pragma unroll
  for (int mi = 0; mi < 2; ++mi) {
#pragma unroll
    for (int nd = 0; nd < 8; ++nd) o[mi][nd] = f32x4{0.f, 0.f, 0.f, 0.f};
    mrow[mi] = -1e30f; lrow[mi] = 0.f;
  }
  const int lkey = tid >> 2, lpart = tid & 3;
  const int ldv = tid >> 1, lhalf = tid & 1;
  const int ntile = nkeys >> 6;
  uint4 k0, k1, k2, k3, k4, k5;
  {
    const int pos = lkey;
    const u16* srcn = p.KN + (size_t)(krow0 + pos) * 512 + h * 128 + lpart * 8;
    const u16* srcr = p.P + (size_t)(krow0 + pos) * PW + P_MKR + lpart * 8;
    k0 = *(const uint4*)(srcn); k1 = *(const uint4*)(srcn + 32); k2 = *(const uint4*)(srcn + 64); k3 = *(const uint4*)(srcn + 96);
    k4 = *(const uint4*)(srcr); k5 = *(const uint4*)(srcr + 32);
  }
  for (int kt = 0; kt < ntile; ++kt) {
    __syncthreads();
    {
      u16* dk = sK + lkey * KST + lpart * 8;
      *(uint4*)(dk) = k0; *(uint4*)(dk + 32) = k1; *(uint4*)(dk + 64) = k2; *(uint4*)(dk + 96) = k3;
      *(uint4*)(dk + 128) = k4; *(uint4*)(dk + 160) = k5;
    }
    const u16* sv = vt + (size_t)ldv * nkeys + kt * 64 + lhalf * 32;
    const uint4 v0 = *(const uint4*)(sv), v1 = *(const uint4*)(sv + 8), v2 = *(const uint4*)(sv + 16), v3 = *(const uint4*)(sv + 24);
    __syncthreads();
    f32x4 s[2][4];
#pragma unroll
    for (int mi = 0; mi < 2; ++mi)
#pragma unroll
      for (int ni = 0; ni < 4; ++ni) s[mi][ni] = f32x4{0.f, 0.f, 0.f, 0.f};
#pragma unroll
    for (int ks = 0; ks < 6; ++ks)
#pragma unroll
      for (int ni = 0; ni < 4; ++ni) {
        bf16x8 kf = *(const bf16x8*)(sK + (ni * 16 + r16) * KST + ks * 32 + g4 * 8);
        s[0][ni] = __builtin_amdgcn_mfma_f32_16x16x32_bf16(kf, q[0][ks], s[0][ni], 0, 0, 0);
        s[1][ni] = __builtin_amdgcn_mfma_f32_16x16x32_bf16(kf, q[1][ks], s[1][ni], 0, 0, 0);
      }
#pragma unroll
    for (int mi = 0; mi < 2; ++mi) {
      float mx = -1e30f;
#pragma unroll
      for (int ni = 0; ni < 4; ++ni)
#pragma unroll
        for (int r = 0; r < 4; ++r) mx = fmaxf(mx, s[mi][ni][r]);
      mx = fmaxf(mx, __shfl_xor(mx, 16)); mx = fmaxf(mx, __shfl_xor(mx, 32));
      const float mnew = fmaxf(mrow[mi], mx);
      const float alpha = __builtin_amdgcn_exp2f(mrow[mi] - mnew);
      mrow[mi] = mnew;
      float ps = 0.f;
#pragma unroll
      for (int ni = 0; ni < 4; ++ni) {
        f32x4 pv;
#pragma unroll
        for (int r = 0; r < 4; ++r) { pv[r] = __builtin_amdgcn_exp2f(s[mi][ni][r] - mnew); ps += pv[r]; }
        *(uint2*)(sPw + (mi * 16 + r16) * PST + ni * 16 + g4 * 4) = pack4(pv);
      }
      ps += __shfl_xor(ps, 16); ps += __shfl_xor(ps, 32);
      lrow[mi] = lrow[mi] * alpha + ps;
#pragma unroll
      for (int nd = 0; nd < 8; ++nd) o[mi][nd] *= alpha;
    }
    {
      u16* dvp = sV + ldv * VST + lhalf * 32;
      *(uint4*)(dvp) = v0; *(uint4*)(dvp + 8) = v1; *(uint4*)(dvp + 16) = v2; *(uint4*)(dvp + 24) = v3;
    }
    __syncthreads();
    if (kt + 1 < ntile) {
      const int pos = (kt + 1) * 64 + lkey;
      const bool own = (!latent) || pos < 4096;
      const int row = own ? krow0 + pos : T_ALL + b * 256 + (pos - 4096);
      const u16* srcn = p.KN + (size_t)row * 512 + h * 128 + lpart * 8;
      const u16* srcr = own ? p.P + (size_t)(krow0 + pos) * PW + P_MKR + lpart * 8
                            : p.KRC + (size_t)(b * 256 + pos - 4096) * 64 + lpart * 8;
      k0 = *(const uint4*)(srcn); k1 = *(const uint4*)(srcn + 32); k2 = *(const uint4*)(srcn + 64); k3 = *(const uint4*)(srcn + 96);
      k4 = *(const uint4*)(srcr); k5 = *(const uint4*)(srcr + 32);
    }
#pragma unroll
    for (int ks2 = 0; ks2 < 2; ++ks2) {
      bf16x8 pf0 = *(const bf16x8*)(sPw + (0 * 16 + r16) * PST + ks2 * 32 + g4 * 8);
      bf16x8 pf1 = *(const bf16x8*)(sPw + (1 * 16 + r16) * PST + ks2 * 32 + g4 * 8);
#pragma unroll
      for (int nd = 0; nd < 8; ++nd) {
        bf16x8 vf = *(const bf16x8*)(sV + (nd * 16 + r16) * VST + ks2 * 32 + g4 * 8);
        o[0][nd] = __builtin_amdgcn_mfma_f32_16x16x32_bf16(vf, pf0, o[0][nd], 0, 0, 0);
        o[1][nd] = __builtin_amdgcn_mfma_f32_16x16x32_bf16(vf, pf1, o[1][nd], 0, 0, 0);
      }
    }
  }
#pragma unroll
  for (int mi = 0; mi < 2; ++mi) {
    const float inv = 1.f / lrow[mi];
    const int qrow = tq0 + w * 32 + mi * 16 + r16;
    u16* op = p.HQ + (size_t)qrow * 768 + h * 192 + g4 * 4;
    if (dummy) op = p.HQ + (size_t)T_ALL * 768 + (size_t)(qrow % 9216) * 768 + h * 192 + g4 * 4;
#pragma unroll
    for (int nd = 0; nd < 8; ++nd) *(uint2*)(op + nd * 16) = pack4(o[mi][nd] * inv);
  }
}

#define XB_TMO      128
#define XB_XCNT(j)  (256  + 64 * (j))
#define XB_XSUB(j)  (1280 + 64 * (j))
#define XB_XGEN(j)  (2304 + 64 * (j))
#define XB_TOP      3328
#define XB_TOPGEN   3392
#define XCD_BAR_WORDS 3456
#define XB_SPIN_CAP (1u << 23)
#define LAS __attribute__((address_space(3)))

__device__ __forceinline__ unsigned xb_ld(unsigned* p)              { return __hip_atomic_load(p, __ATOMIC_RELAXED, __HIP_MEMORY_SCOPE_AGENT); }
__device__ __forceinline__ unsigned xb_add(unsigned* p, unsigned v) { return __hip_atomic_fetch_add(p, v, __ATOMIC_RELAXED, __HIP_MEMORY_SCOPE_AGENT); }
__device__ __forceinline__ unsigned xb_xcc_id() { return (unsigned)__builtin_amdgcn_s_getreg((3 << 11) | 20) & 0xFu; }
#define XB_SPIN(cond, bar) do { unsigned _sp = 0; while (cond) { __builtin_amdgcn_s_sleep(1); \
    if ((++_sp & 255u) == 0u) { if (xb_ld(&(bar)[XB_TMO])) break; if (_sp > XB_SPIN_CAP) { atomicAdd(&(bar)[XB_TMO], 1u); break; } } } } while (0)

struct XcdBarrier {
    unsigned* bar; unsigned x;
    volatile LAS unsigned* st;
};

__device__ __forceinline__ XcdBarrier xcd_barrier_post(unsigned* bar, volatile LAS unsigned* st) {
    XcdBarrier b; b.bar = bar; b.x = xb_xcc_id(); b.st = st;
    if (threadIdx.x == 0) (void)xb_add(&bar[XB_XCNT(b.x)], 1u);
    return b;
}
__device__ __forceinline__ void xcd_barrier_complete(unsigned* bar, unsigned x, unsigned& nloc, unsigned& nx) {
    const unsigned G = gridDim.x * gridDim.y * gridDim.z;
    unsigned sum, cnt, mine, sp = 0u;
    for (;;) {
        sum = 0u; cnt = 0u; mine = 0u;
#pragma unroll
        for (unsigned j = 0; j < 16; ++j) { const unsigned c = xb_ld(&bar[XB_XCNT(j)]); sum += c; cnt += (c > 0u) ? 1u : 0u; mine = (j == x) ? c : mine; }
        if (sum == G) break;
        __builtin_amdgcn_s_sleep(1);
        if ((++sp & 255u) == 0u) { if (xb_ld(&bar[XB_TMO])) break; if (sp > XB_SPIN_CAP) { atomicAdd(&bar[XB_TMO], 1u); break; } }
    }
    nloc = mine > 0u ? mine : 1u; nx = cnt > 0u ? cnt : 1u;
}

__device__ __forceinline__ void xcd_barrier(const XcdBarrier& b) {
    asm volatile("s_waitcnt vmcnt(0)" ::: "memory");
    __syncthreads();
    if (threadIdx.x == 0) {
        unsigned* bar = b.bar;
        __builtin_amdgcn_s_waitcnt(0);
        unsigned nloc = b.st[0], nx = b.st[1];
        if (nloc == 0u) { xcd_barrier_complete(bar, b.x, nloc, nx); b.st[0] = nloc; b.st[1] = nx; }
        const unsigned old = xb_add(&bar[XB_XSUB(b.x)], 1u);
        const unsigned gen = old / nloc;
        if (old + 1u == (gen + 1u) * nloc) {
            __builtin_amdgcn_fence(__ATOMIC_RELEASE, "agent");
            asm volatile("s_waitcnt vmcnt(0)" ::: "memory");
            const unsigned og = xb_add(&bar[XB_TOP], 1u);
            const unsigned tg = og / nx;
            if (og + 1u == (tg + 1u) * nx) xb_add(&bar[XB_TOPGEN], 1u);
            else XB_SPIN(xb_ld(&bar[XB_TOPGEN]) == tg, bar);
            __builtin_amdgcn_fence(__ATOMIC_ACQUIRE, "agent");
            xb_add(&bar[XB_XGEN(b.x)], 1u);
            asm volatile("s_waitcnt vmcnt(0)" ::: "memory");
        } else {
            XB_SPIN(xb_ld(&bar[XB_XGEN(b.x)]) == gen, bar);
            __builtin_amdgcn_fence(__ATOMIC_ACQUIRE, "agent");
            asm volatile("s_waitcnt vmcnt(0)" ::: "memory");
        }
    }
    __syncthreads();
}


__device__ __forceinline__ void gbar(unsigned* ctr, unsigned target) {
  asm volatile("s_waitcnt vmcnt(0)" ::: "memory");
  __syncthreads();
  if (tid_l() == 0) {
    __builtin_amdgcn_fence(__ATOMIC_RELEASE, "agent");
    asm volatile("s_waitcnt vmcnt(0)" ::: "memory");
    __hip_atomic_fetch_add(ctr, 1u, __ATOMIC_RELAXED, __HIP_MEMORY_SCOPE_AGENT);
    while (__hip_atomic_load(ctr, __ATOMIC_RELAXED, __HIP_MEMORY_SCOPE_AGENT) < target) __builtin_amdgcn_s_sleep(2);
    __builtin_amdgcn_fence(__ATOMIC_ACQUIRE, "agent");
    asm volatile("s_waitcnt vmcnt(0)" ::: "memory");
  }
  __syncthreads();
}
#define MFMA4(a, b, c) __builtin_amdgcn_mfma_f32_16x16x4f32((a), (b), (c), 0, 0, 0)

__device__ __forceinline__ float softplusf_(float x) { return fmaxf(x, 0.f) + log1pf(__expf(-fabsf(x))); }

__device__ __forceinline__ void gdn_chain(const Params& p, int l, int seq, int h, int d, int vs, float* sm) {
  float* sMM = sm;
  float* sK = sMM + 64 * 68;
  float* sW = sK + 64 * 65;
  float* sV = sW + 64 * 65;
  float* sS = sV + 64 * 33;
  float* sGc = sS + 64 * 33;
  float* sBeta = sGc + 64;
  float* sBg = sBeta + 64;
  const int tid = tid_l(), lane = tid & 63, w = tid >> 6, r16 = lane & 15, g4 = lane >> 4;
  const bool latent = seq >= 16;
  const int len = latent ? 4096 : 256;
  const int t0 = latent ? T_CTX + (seq - 16) * 4096 : seq * 256;
  const int nchunks = len >> 6;
  const float Acoef = -__expf(p.gdn_a_log[l * 8 + d * 4 + h]);
  const float dtb = p.gdn_dt_bias[l * 8 + d * 4 + h];
  f32x4 Sreg[2];
  __syncthreads();
  {
    const float* s0 = latent ? p.state_gdn + ((((size_t)(seq - 16) * 2 + l) * 2 + d) * 4 + h) * 4096 : nullptr;
#pragma unroll
    for (int n = 0; n < 2; ++n)
#pragma unroll
      for (int r = 0; r < 4; ++r) {
        const int kidx = 16 * w + g4 * 4 + r, cc = n * 16 + r16;
        float v = latent ? s0[kidx * 64 + vs * 32 + cc] : 0.f;
        Sreg[n][r] = v;
        sS[kidx * 33 + cc] = v;
      }
  }
  const u16* Pb = p.P + (size_t)t0 * PW;
  const u16* VHb = p.HQ + (size_t)T_ALL * 768 + (size_t)t0 * 256;
#define GDN_SRC(i, tl, tlo_) ({ const int e_ = (tl) + (i) * 256; const int u_ = e_ / 20, un_ = e_ % 20; \
    (un_ < 16) ? (Pb + (size_t)((tlo_) + u_) * PW + (un_ < 8 ? P_QH + h * 64 + un_ * 8 : P_KH + h * 64 + (un_ - 8) * 8)) \
               : (VHb + (size_t)((tlo_) + u_) * 256 + h * 64 + vs * 32 + (un_ - 16) * 8); })
  uint4 pf[5];
  float pga = 0.f, pgb = 0.f;
  {
    const int tlo = d == 0 ? 0 : len - 64;
#pragma unroll
    for (int i = 0; i < 5; ++i) pf[i] = *(const uint4*)GDN_SRC(i, tid, tlo);
    if (tid < 64) {
      const int u = d == 0 ? tid : 63 - tid;
      const float* gab = p.GAB + (size_t)(t0 + tlo + u) * 16;
      pga = gab[d * 4 + h]; pgb = gab[8 + d * 4 + h];
    }
  }
  for (int n = 0; n < nchunks; ++n) {
    const int tlo = d == 0 ? n * 64 : len - 64 * (n + 1);
    const int tl2 = tid_l();
#pragma unroll
    for (int i = 0; i < 5; ++i) {
      const int e = tl2 + i * 256;
      const int u = e / 20, un = e % 20;
      const int pp = d == 0 ? u : 63 - u;
      float* dq = un < 8 ? sW + pp * 65 + un * 8 : (un < 16 ? sK + pp * 65 + (un - 8) * 8 : sV + pp * 33 + (un - 16) * 8);
      const unsigned wv[4] = {pf[i].x, pf[i].y, pf[i].z, pf[i].w};
#pragma unroll
      for (int j = 0; j < 4; ++j) { dq[2 * j] = bf2f((u16)(wv[j] & 0xffff)); dq[2 * j + 1] = bf2f((u16)(wv[j] >> 16)); }
    }
    if (tid < 64) {
      const int pp = tid;
      float g = Acoef * softplusf_(pga + dtb);
      float bt = sigmoidf_(pgb);
#pragma unroll
      for (int o = 1; o < 64; o <<= 1) { float tt = __shfl_up(g, o); if (lane >= o) g += tt; }
      sGc[pp] = g; sBeta[pp] = bt; sBg[pp] = bt * __expf(g);
    }
    if (n + 1 < nchunks) {
      const int tlo2 = d == 0 ? (n + 1) * 64 : len - 64 * (n + 2);
#pragma unroll
      for (int i = 0; i < 5; ++i) pf[i] = *(const uint4*)GDN_SRC(i, tl2, tlo2);
      if (tid < 64) {
        const int u = d == 0 ? tid : 63 - tid;
        const float* gab = p.GAB + (size_t)(t0 + tlo2 + u) * 16;
        pga = gab[d * 4 + h]; pgb = gab[8 + d * 4 + h];
      }
    }
    __syncthreads();
    float qa[16];
#pragma unroll
    for (int s = 0; s < 16; ++s) qa[s] = sW[(16 * w + r16) * 65 + 4 * s + g4];
    const unsigned tcode = w == 0 ? 0x730u : (w == 1 ? 0xA51u : (w == 2 ? 0x062u : 0x0FBu));
    const int tcnt = w < 2 ? 3 : 2;
    f32x4 attacc[3];
#pragma unroll
    for (int t = 0; t < 3; ++t) {
      attacc[t] = f32x4{0.f, 0.f, 0.f, 0.f};
      if (t < tcnt) {
        const int ti = (tcode >> (4 * t)) & 3, tn = (tcode >> (4 * t + 2)) & 3;
        f32x4 accm = f32x4{0.f, 0.f, 0.f, 0.f};
        const float* ak = sK + (16 * ti + r16) * 65 + g4;
        const float* aq = sW + (16 * ti + r16) * 65 + g4;
        const float* bk = sK + (16 * tn + r16) * 65 + g4;
#pragma unroll
        for (int s = 0; s < 16; ++s) {
          const float bv = bk[4 * s];
          accm = MFMA4(ak[4 * s], bv, accm);
          attacc[t] = MFMA4(aq[4 * s], bv, attacc[t]);
        }
#pragma unroll
        for (int r = 0; r < 4; ++r) {
          const int i = 16 * ti + g4 * 4 + r, j = 16 * tn + r16;
          sMM[i * 68 + j] = (i > j) ? sBeta[i] * accm[r] * __expf(sGc[i] - sGc[j]) : 0.f;
        }
      }
    }
    __syncthreads();
    if (w == 0) {
      const int bi = tid >> 4, c = tid & 15;
      float* md = sMM + (16 * bi) * 68 + 16 * bi;
      float a[16];
#pragma unroll
      for (int r = 0; r < 16; ++r) a[r] = (r == c) ? 1.f : 0.f;
#pragma unroll
      for (int r = 1; r < 16; ++r) {
#pragma unroll
        for (int q4 = 0; q4 < (r + 3) / 4; ++q4) {
          const float4 m = *(const float4*)(md + r * 68 + 4 * q4);
          if (q4 * 4 + 0 < r) a[r] -= m.x * a[q4 * 4 + 0];
          if (q4 * 4 + 1 < r) a[r] -= m.y * a[q4 * 4 + 1];
          if (q4 * 4 + 2 < r) a[r] -= m.z * a[q4 * 4 + 2];
          if (q4 * 4 + 3 < r) a[r] -= m.w * a[q4 * 4 + 3];
        }
      }
      __builtin_amdgcn_fence(__ATOMIC_SEQ_CST, "wavefront");
#pragma unroll
      for (int r = 0; r < 16; ++r) md[r * 68 + c] = a[r];
    } else {
      for (int t = w - 1; t < 8; t += 3) {
        const int ti = t >> 1, tc = t & 1;
        const float bg = sBg[16 * ti + r16];
        const float* ak = sK + (16 * ti + r16) * 65 + g4;
        const float* bs = sS + g4 * 33 + 16 * tc + r16;
        f32x4 acc = f32x4{0.f, 0.f, 0.f, 0.f};
#pragma unroll
        for (int s = 0; s < 16; ++s) acc = MFMA4(ak[4 * s] * bg, bs[4 * s * 33], acc);
#pragma unroll
        for (int r = 0; r < 4; ++r) {
          const int i = 16 * ti + g4 * 4 + r, cc = 16 * tc + r16;
          sV[i * 33 + cc] = sV[i * 33 + cc] * sBeta[i] - acc[r];
        }
      }
    }
    __syncthreads();
    for (int ib = 0; ib < 4; ++ib) {
      if (w < 2) {
        const int ct = w;
        f32x4 acc = f32x4{0.f, 0.f, 0.f, 0.f};
        const float* am = sMM + (16 * ib + r16) * 68 + g4;
        const float* bx = sV + g4 * 33 + 16 * ct + r16;
        for (int s4 = 0; s4 < ib; ++s4) {
#pragma unroll
          for (int s = 0; s < 4; ++s) acc = MFMA4(am[16 * s4 + 4 * s], bx[(16 * s4 + 4 * s) * 33], acc);
        }
        f32x4 rm;
#pragma unroll
        for (int r = 0; r < 4; ++r) rm[r] = sV[(16 * ib + g4 * 4 + r) * 33 + 16 * ct + r16] - acc[r];
        const float* dd = sMM + (16 * ib + r16) * 68 + 16 * ib + 4 * g4;
        f32x4 xn = f32x4{0.f, 0.f, 0.f, 0.f};
#pragma unroll
        for (int s = 0; s < 4; ++s) xn = MFMA4(dd[s], rm[s], xn);
#pragma unroll
        for (int r = 0; r < 4; ++r) sV[(16 * ib + g4 * 4 + r) * 33 + 16 * ct + r16] = xn[r];
      }
      __syncthreads();
    }
#pragma unroll
    for (int t = 0; t < 3; ++t) {
      if (t < tcnt) {
        const int ti = (tcode >> (4 * t)) & 3, tn = (tcode >> (4 * t + 2)) & 3;
#pragma unroll
        for (int r = 0; r < 4; ++r) {
          const int i = 16 * ti + g4 * 4 + r, j = 16 * tn + r16;
          sMM[i * 68 + j] = (i >= j) ? attacc[t][r] * __expf(sGc[i] - sGc[j]) : 0.f;
        }
      }
    }
    __syncthreads();
    {
      f32x4 acc[2] = {f32x4{0.f, 0.f, 0.f, 0.f}, f32x4{0.f, 0.f, 0.f, 0.f}};
      const float eg = __expf(sGc[16 * w + r16]);
#pragma unroll
      for (int s = 0; s < 16; ++s) {
        const float a = qa[s] * eg;
        acc[0] = MFMA4(sS[(4 * s + g4) * 33 + r16], a, acc[0]);
        acc[1] = MFMA4(sS[(4 * s + g4) * 33 + 16 + r16], a, acc[1]);
      }
#pragma unroll
      for (int s = 0; s < 16; ++s) {
        if (s < 4 * (w + 1)) {
          const float a = sMM[(16 * w + r16) * 68 + 4 * s + g4];
          acc[0] = MFMA4(sV[(4 * s + g4) * 33 + r16], a, acc[0]);
          acc[1] = MFMA4(sV[(4 * s + g4) * 33 + 16 + r16], a, acc[1]);
        }
      }
      {
        const int pp = 16 * w + r16;
        const int u = d == 0 ? pp : 63 - pp;
        u16* op = p.MIX + (size_t)(t0 + tlo + u) * 1024 + d * 256 + h * 64 + vs * 32 + g4 * 4;
        *(uint2*)(op) = pack4(acc[0]);
        *(uint2*)(op + 16) = pack4(acc[1]);
      }
    }
    __syncthreads();
    {
      const float g63 = sGc[63];
      const float gl = __expf(g63);
#pragma unroll
      for (int nn = 0; nn < 2; ++nn)
#pragma unroll
        for (int r = 0; r < 4; ++r) Sreg[nn][r] *= gl;
#pragma unroll
      for (int s = 0; s < 16; ++s) {
        const int srow = 4 * s + g4;
        const float a = sK[srow * 65 + 16 * w + r16] * __expf(g63 - sGc[srow]);
        Sreg[0] = MFMA4(a, sV[srow * 33 + r16], Sreg[0]);
        Sreg[1] = MFMA4(a, sV[srow * 33 + 16 + r16], Sreg[1]);
      }
    }
    __syncthreads();
#pragma unroll
    for (int nn = 0; nn < 2; ++nn)
#pragma unroll
      for (int r = 0; r < 4; ++r) sS[(16 * w + g4 * 4 + r) * 33 + nn * 16 + r16] = Sreg[nn][r];
    __syncthreads();
  }
  if (!latent) {
    float* so = p.out + OUT_SGDN + ((((size_t)seq * 2 + l) * 2 + d) * 4 + h) * 4096;
#pragma unroll
    for (int nn = 0; nn < 2; ++nn)
#pragma unroll
      for (int r = 0; r < 4; ++r) so[(16 * w + g4 * 4 + r) * 64 + vs * 32 + nn * 16 + r16] = Sreg[nn][r];
  }
}

__device__ __forceinline__ void hgrn_chain(const Params& p, int l, int seq, int h, int d, int vs, float* sm) {
  float* sBC = sm;
  float* sK = sBC + 64 * 65;
  float* sAT = sK + 64 * 65;
  float* sV = sAT + 64 * 68;
  float* sS = sV + 64 * 33;
  float* sTot = sS + 64 * 33;
  const int tid = tid_l(), lane = tid & 63, w = tid >> 6, r16 = lane & 15, g4 = lane >> 4;
  const bool latent = seq >= 16;
  const int len = latent ? 4096 : 256;
  const int t0 = latent ? T_CTX + (seq - 16) * 4096 : seq * 256;
  const int nchunks = len >> 6;
  float lbk;
  {
    const int kch = h * 64 + (tid & 63);
    lbk = (l == 0) ? 0.f : sigmoidf_(p.hgrn_lb[256 + kch] - p.hgrn_lb[kch]);
  }
  f32x4 Sreg[2];
  __syncthreads();
  {
    const float* s0 = latent ? p.state_hgrn + ((((size_t)(seq - 16) * 2 + l) * 2 + d) * 4 + h) * 4096 : nullptr;
#pragma unroll
    for (int n = 0; n < 2; ++n)
#pragma unroll
      for (int r = 0; r < 4; ++r) {
        const int kidx = 16 * w + g4 * 4 + r, cc = n * 16 + r16;
        float v = latent ? s0[kidx * 64 + vs * 32 + cc] : 0.f;
        Sreg[n][r] = v;
        sS[kidx * 33 + cc] = v;
      }
  }
  const u16* Pb = p.P + (size_t)t0 * PW;
  float* sLb = sTot + 256;
  if (tid < 64) sLb[tid] = lbk;
  __syncthreads();
  int pgo[5];
#pragma unroll
  for (int i = 0; i < 5; ++i) {
    const int e = tid + i * 256;
    const int u = e / 20, un = e % 20;
    pgo[i] = u * PW + (un < 8 ? P_HF + d * 256 + h * 64 + un * 8 : (un < 12 ? P_HI + h * 64 + vs * 32 + (un - 8) * 8 : P_HQ + h * 64 + (un - 12) * 8));
  }
  uint4 pf[5];
  {
    const int tlo = d == 0 ? 0 : len - 64;
#pragma unroll
    for (int i = 0; i < 5; ++i) pf[i] = *(const uint4*)(Pb + (size_t)tlo * PW + pgo[i]);
  }
  for (int n = 0; n < nchunks; ++n) {
#pragma unroll
    for (int i = 0; i < 5; ++i) {
      const int e = tid + i * 256;
      const int u = e / 20, un = e % 20;
      const int pp = d == 0 ? u : 63 - u;
      const unsigned wv[4] = {pf[i].x, pf[i].y, pf[i].z, pf[i].w};
#pragma unroll
      for (int j = 0; j < 8; ++j) {
        const float x = bf2f((u16)((wv[j >> 1] >> ((j & 1) * 16)) & 0xffff));
        if (un < 8) {
          const int k = un * 8 + j;
          const float lb = sLb[k];
          const float sg_ = sigmoidf_(x);
          const float gate = lb + (1.f - lb) * sg_;
          sBC[pp * 65 + k] = __logf(fmaxf(gate, 1e-30f));
          sK[pp * 65 + k] = (1.f - lb) * (1.f - sg_);
        } else if (un < 12) {
          sV[pp * 33 + (un - 8) * 8 + j] = x;
        } else {
          sAT[pp * 68 + (un - 12) * 8 + j] = x;
        }
      }
    }
    __syncthreads();
    if (n + 1 < nchunks) {
      const int tlo2 = d == 0 ? (n + 1) * 64 : len - 64 * (n + 2);
#pragma unroll
      for (int i = 0; i < 5; ++i) pf[i] = *(const uint4*)(Pb + (size_t)tlo2 * PW + pgo[i]);
    }
    const int tlo = d == 0 ? n * 64 : len - 64 * (n + 1);
    float cs[16];
    {
      const int k = tid & 63, sg = tid >> 6;
      float run = 0.f;
#pragma unroll
      for (int i = 0; i < 16; ++i) { run += sBC[(16 * sg + i) * 65 + k]; cs[i] = run; }
      sTot[sg * 64 + k] = run;
    }
    float qa[16];
#pragma unroll
    for (int s = 0; s < 16; ++s) qa[s] = sAT[(16 * w + r16) * 68 + 4 * s + g4];
    __syncthreads();
    {
      const int k = tid & 63, sg = tid >> 6;
      float off = 0.f;
      for (int s2 = 0; s2 < sg; ++s2) off += sTot[s2 * 64 + k];
#pragma unroll
      for (int i = 0; i < 16; ++i) sBC[(16 * sg + i) * 65 + k] = cs[i] + off;
    }
    __syncthreads();
    {
      float aq[16], rf[16];
#pragma unroll
      for (int s = 0; s < 16; ++s) {
        const int kk = 4 * s + g4;
        rf[s] = (w == 0) ? 0.f : sBC[(16 * w - 1) * 65 + kk];
        aq[s] = qa[s] * __expf(sBC[(16 * w + r16) * 65 + kk] - rf[s]);
      }
#pragma unroll
      for (int nn = 0; nn < 4; ++nn) {
        f32x4 acc = f32x4{0.f, 0.f, 0.f, 0.f};
        if (nn <= w) {
#pragma unroll
          for (int s = 0; s < 16; ++s) {
            const int kk = 4 * s + g4, sc = 16 * nn + r16;
            const float bv = sK[sc * 65 + kk] * __expf(fminf(rf[s] - sBC[sc * 65 + kk], 80.f));
            acc = MFMA4(aq[s], bv, acc);
          }
        }
#pragma unroll
        for (int r = 0; r < 4; ++r) {
          const int i = 16 * w + g4 * 4 + r, j = 16 * nn + r16;
          sAT[i * 68 + j] = (i >= j) ? acc[r] : 0.f;
        }
      }
    }
    __syncthreads();
    {
      f32x4 acc[2] = {f32x4{0.f, 0.f, 0.f, 0.f}, f32x4{0.f, 0.f, 0.f, 0.f}};
#pragma unroll
      for (int s = 0; s < 16; ++s) {
        const int kk = 4 * s + g4;
        const float a = qa[s] * __expf(sBC[(16 * w + r16) * 65 + kk]);
        acc[0] = MFMA4(sS[kk * 33 + r16], a, acc[0]);
        acc[1] = MFMA4(sS[kk * 33 + 16 + r16], a, acc[1]);
      }
#pragma unroll
      for (int s = 0; s < 16; ++s) {
        if (s < 4 * (w + 1)) {
          const float a = sAT[(16 * w + r16) * 68 + 4 * s + g4];
          acc[0] = MFMA4(sV[(4 * s + g4) * 33 + r16], a, acc[0]);
          acc[1] = MFMA4(sV[(4 * s + g4) * 33 + 16 + r16], a, acc[1]);
        }
      }
      {
        const int pp = 16 * w + r16;
        const int u = d == 0 ? pp : 63 - pp;
        u16* op = p.MIX + (size_t)(t0 + tlo + u) * 1024 + 512 + d * 256 + h * 64 + vs * 32 + g4 * 4;
        *(uint2*)(op) = pack4(acc[0]);
        *(uint2*)(op + 16) = pack4(acc[1]);
      }
    }
    __syncthreads();
    {
#pragma unroll
      for (int nn = 0; nn < 2; ++nn)
#pragma unroll
        for (int r = 0; r < 4; ++r) Sreg[nn][r] *= __expf(sBC[63 * 65 + 16 * w + g4 * 4 + r]);
      const int kA = 16 * w + r16;
      const float blA = sBC[63 * 65 + kA];
#pragma unroll
      for (int s = 0; s < 16; ++s) {
        const int srow = 4 * s + g4;
        const float a = sK[srow * 65 + kA] * __expf(blA - sBC[srow * 65 + kA]);
        Sreg[0] = MFMA4(a, sV[srow * 33 + r16], Sreg[0]);
        Sreg[1] = MFMA4(a, sV[srow * 33 + 16 + r16], Sreg[1]);
      }
    }
    __syncthreads();
#pragma unroll
    for (int nn = 0; nn < 2; ++nn)
#pragma unroll
      for (int r = 0; r < 4; ++r) sS[(16 * w + g4 * 4 + r) * 33 + nn * 16 + r16] = Sreg[nn][r];
    __syncthreads();
  }
  if (!latent) {
    float* so = p.out + OUT_SHG + ((((size_t)seq * 2 + l) * 2 + d) * 4 + h) * 4096;
#pragma unroll
    for (int nn = 0; nn < 2; ++nn)
#pragma unroll
      for (int r = 0; r < 4; ++r) so[(16 * w + g4 * 4 + r) * 64 + vs * 32 + nn * 16 + r16] = Sreg[nn][r];
  }
}

__device__ __forceinline__ void phase_c(const Params& p, int l, unsigned char* smraw, int mode = 0) {
  __shared__ int s_item;
  const int total = 1920;
  const bool paired = (gridDim.x == 512);
  const int jx = blockIdx.x >> 3;
  int my_static = -1;
  if (paired && (jx & 31) < 16) my_static = (blockIdx.x & 7) * 32 + (jx >> 5) * 16 + (jx & 15);
  for (;;) {
    __syncthreads();
    if (tid_l() == 0) {
      if (my_static >= 0) s_item = my_static;
      else s_item = (paired ? 256 : 0) + (int)atomicAdd(&p.counters[l * 64 + mode * 16], 1u);
    }
    __syncthreads();
    my_static = -1;
    const int item = s_item;
    if (item >= total) break;
    int kind, a0, a1, a2, a3;
    if (item < 256 || (item >= 1280 && item < 1792)) {
      const int i2 = item < 256 ? item : item - 1280;
      const int rest = i2 >> 1;
      kind = i2 & 1;
      a3 = rest & 1; a2 = (rest >> 1) & 1; a1 = (rest >> 2) & 3; a0 = (rest >> 4) + (item < 256 ? 16 : 0);
    } else if (item < 1280) {
      const int i2 = item - 256;
      kind = 2; a0 = 1; a1 = i2 >> 7; a2 = (i2 >> 5) & 3; a3 = i2 & 31;
    } else {
      const int i2 = item - 1792;
      kind = 2; a0 = 0; a1 = i2 >> 3; a2 = (i2 >> 1) & 3; a3 = i2 & 1;
    }
    if (mode == 1 && kind == 2) continue;
    if (mode == 2 && kind != 2) continue;
    if (kind != 2) __builtin_amdgcn_s_setprio(3);
    if (kind == 0) gdn_chain(p, l, a0, a1, a2, a3, (float*)smraw);
    else if (kind == 1) hgrn_chain(p, l, a0, a1, a2, a3, (float*)smraw);
    if (kind != 2) __builtin_amdgcn_s_setprio(0);
    else attn_item(p, a0, a1, a2, a3, smraw, mode == 2);
  }
}

__global__ void __launch_bounds__(NTHR, 2) mega(Params p) {
  __shared__ __attribute__((aligned(16))) unsigned char smem[LDS_BYTES];
  cg::grid_group grid = cg::this_grid();
  __shared__ uint4 xb_words;
  if (threadIdx.x == 0) xb_words = make_uint4(0u, 0u, 0u, 0u);
  __syncthreads();
  {
    XcdBarrier xb0 = xcd_barrier_post(p.xbar, (volatile LAS unsigned*)&xb_words);
    if (threadIdx.x == 0) ((volatile LAS unsigned*)&xb_words)[2] = xb0.x;
  }
#define GSYNC() do { XcdBarrier xb_; xb_.bar = p.xbar; xb_.st = (volatile LAS unsigned*)&xb_words; xb_.x = 0; \
    if (threadIdx.x == 0) xb_.x = ((volatile LAS unsigned*)&xb_words)[2]; xcd_barrier(xb_); } while (0)
  phase0(p, (float*)smem);
  if (p.out == nullptr) grid.sync();
  GSYNC();
  rowpass_norm(p, 0, 0);
  GSYNC();
  for (int l = 0; l < 2; ++l) {
    phase_a(p, l, (u16*)smem);
    GSYNC();
    rowpass_b0(p, l);
    GSYNC();
    phase_b1(p, l, (u16*)smem);
    GSYNC();
    rowpass_b2(p, l);
    GSYNC();
    phase_c(p, l, smem);
    GSYNC();
    rowpass_c2(p, l);
    GSYNC();
    phase_gemm_y(p.MIX, 1024, p.WoutT + (size_t)l * 1024 * 1024, 1024, 1024, p.HQ, 1024, (u16*)smem);
    GSYNC();
    rowpass_norm(p, l, 1);
    GSYNC();
    phase_e(p, l, (u16*)smem);
    GSYNC();
    phase_gemm_y(p.P, DFF, p.WfoT + (size_t)l * 1024 * DFF, DFF, 1024, p.HQ, 1024, (u16*)smem);
    GSYNC();
    rowpass_norm(p, l, 2);
    if (l == 0) GSYNC();
  }
}

extern "C" void kernel_launch(void* const* d_in, const int* in_sizes, int n_in, void* d_out, int out_size, void* d_ws,
                              size_t ws_size, hipStream_t stream) {
  static int grid_blocks = 0;
  if (!grid_blocks) {
    int dev = 0, cus = 0, per_cu = 0;
    hipGetDevice(&dev);
    hipDeviceGetAttribute(&cus, hipDeviceAttributeMultiprocessorCount, dev);
    hipOccupancyMaxActiveBlocksPerMultiprocessor(&per_cu, mega, NTHR, 0);
    if (per_cu > 2) per_cu = 2;
    if (per_cu < 1) per_cu = 1;
    grid_blocks = cus * per_cu;
  }
  Params p{};
  const float* const* in = (const float* const*)d_in;
  p.x_prompt = in[0]; p.x_sample = in[1]; p.cache_ckv = in[2]; p.cache_kr = in[3]; p.state_gdn = in[4]; p.state_hgrn = in[5];
  p.c = in[6]; p.c_ctx = in[7]; p.w_ada = in[8]; p.b_ada = in[9]; p.g_pre_mix = in[10]; p.g_post_mix = in[11];
  p.g_pre_ffn = in[12]; p.g_post_ffn = in[13]; p.w_in = in[14]; p.w_out = in[15]; p.gdn_conv_w = in[16];
  p.gdn_a_log = in[17]; p.gdn_dt_bias = in[18]; p.gdn_norm_w = in[19]; p.hgrn_lb = in[20]; p.hgrn_norm_w = in[21];
  p.mla_q_norm_w = in[22]; p.mla_w_uq = in[23]; p.mla_kv_norm_w = in[24]; p.mla_w_ukv = in[25]; p.w_ffn_in = in[26];
  p.w_ffn_out = in[27];
  p.out = (float*)d_out;
  unsigned char* ws = (unsigned char*)d_ws;
  size_t off = 0;
  auto take = [&](size_t bytes) { unsigned char* r = ws + off; off += (bytes + 255) & ~(size_t)255; return r; };
  p.counters = (unsigned*)take(1024);
  p.xbar = (unsigned*)take(16384);
  p.WinT = (u16*)take((size_t)2 * 3072 * 1024 * 2);
  p.WuqT = (u16*)take((size_t)2 * 768 * 384 * 2);
  p.WukvT = (u16*)take((size_t)2 * 1024 * 256 * 2);
  p.WoutT = (u16*)take((size_t)2 * 1024 * 1024 * 2);
  p.WfiT = (u16*)take((size_t)2 * 5632 * 1024 * 2);
  p.WfoT = (u16*)take((size_t)2 * 1024 * 2816 * 2);
  p.mod = (float*)take((size_t)2 * 9 * 6144 * 4);
  p.HQ = (u16*)take((size_t)T_ALL * 1024 * 2);
  p.P = (u16*)take((size_t)T_ALL * PW * 2);
  p.KN = (u16*)take((size_t)(T_ALL + 2048) * 512 * 2);
  p.VTL = (u16*)take((size_t)8 * 4 * 128 * 4352 * 2);
  p.VTC = (u16*)take((size_t)16 * 4 * 128 * 256 * 2);
  p.CKVC = (u16*)take((size_t)2048 * 256 * 2);
  p.KRC = (u16*)take((size_t)2048 * 64 * 2);
  p.GAB = (float*)take((size_t)T_ALL * 16 * 4);
  p.MIX = (u16*)take((size_t)T_ALL * 1024 * 2);
  if (off > ws_size) { fprintf(stderr, "workspace too small: need %zu have %zu\n", off, ws_size); return; }
  hipMemsetAsync(p.counters, 0, 1024 + 16384, stream);
  void* args[] = {&p};
  hipError_t e = hipLaunchCooperativeKernel((void*)mega, dim3(grid_blocks), dim3(NTHR), args, 0, stream);
  if (e != hipSuccess) fprintf(stderr, "cooperative launch failed: %s (grid %d)\n", hipGetErrorString(e), grid_blocks);
}
```

```cpp
#include <hip/hip_runtime.h>
#include <hip/hip_cooperative_groups.h>
#include <cstdio>
namespace cg = cooperative_groups;

typedef unsigned short u16;
using bf16x8 = __attribute__((ext_vector_type(8))) short;
using f32x4  = __attribute__((ext_vector_type(4))) float;

#define T_CTX 4096
#define T_ALL 36864
#define PW 3072
#define DFF 2816
#define LDS_BYTES 73728
#define NTHR 256

#define P_GQKV 0
#define P_GZ 768
#define P_HQ 1024
#define P_HI 1280
#define P_HF 1536
#define P_HG 2048
#define P_MCQ 2304
#define P_MCKV 2688
#define P_MKR 2944
#define P_GA 3008

struct Params {
  const float *x_prompt, *x_sample, *cache_ckv, *cache_kr, *state_gdn, *state_hgrn, *c, *c_ctx;
  const float *w_ada, *b_ada, *g_pre_mix, *g_post_mix, *g_pre_ffn, *g_post_ffn, *w_in, *w_out;
  const float *gdn_conv_w, *gdn_a_log, *gdn_dt_bias, *gdn_norm_w, *hgrn_lb, *hgrn_norm_w;
  const float *mla_q_norm_w, *mla_w_uq, *mla_kv_norm_w, *mla_w_ukv, *w_ffn_in, *w_ffn_out;
  float* out;
  u16 *WinT, *WuqT, *WukvT, *WoutT, *WfiT, *WfoT;
  float* mod;
  u16 *HQ, *P, *KN, *VTL, *VTC, *CKVC, *KRC, *MIX;
  float* GAB;
  unsigned* counters;
  unsigned* xbar;
};

#define OUT_CKV   37748736
#define OUT_KR    39845888
#define OUT_SGDN  40370176
#define OUT_SHG   41418752

__device__ __forceinline__ u16 f2bf(float f) {
  unsigned u = __float_as_uint(f);
  u += 0x7fffu + ((u >> 16) & 1u);
  return (u16)(u >> 16);
}
__device__ __forceinline__ float bf2f(u16 h) { return __uint_as_float(((unsigned)h) << 16); }
__device__ __forceinline__ float wave_sum(float v) {
#pragma unroll
  for (int o = 32; o > 0; o >>= 1) v += __shfl_xor(v, o);
  return v;
}
__device__ __forceinline__ float sigmoidf_(float x) { return __builtin_amdgcn_rcpf(1.f + __expf(-x)); }
__device__ __forceinline__ float siluf_(float x) { return x * __builtin_amdgcn_rcpf(1.f + __expf(-x)); }
__device__ __forceinline__ int tid_l() { int t = threadIdx.x; asm volatile("" : "+v"(t)); return t; }
__device__ __forceinline__ int tok_mod(int t) { return t < T_CTX ? 0 : 1 + ((t - T_CTX) >> 12); }

__device__ __forceinline__ int map_col(int kind, int j) {
  if (kind == 0) return j;
  if (kind == 1) { if (j < 1024) return j; if (j < 3008) return j + 16; if (j < 3024) return 1024 + (j - 3008); return -1; }
  int blk = j >> 6, w = j & 63;
  return w < 32 ? blk * 32 + w : DFF + blk * 32 + (w - 32);
}

__device__ __forceinline__ void cvt_tile(const float* __restrict__ src, int K, int Nsrc, u16* __restrict__ dst, int kind, int jt, int kt, float* sm) {
  const int tid = tid_l();
  const int j0 = jt * 64, k0 = kt * 64;
  __syncthreads();
  {
    int jj = tid & 63, kk0 = tid >> 6;
    int sc = map_col(kind, j0 + jj);
    for (int kk = kk0; kk < 64; kk += 4)
      sm[kk * 65 + jj] = sc >= 0 ? src[(size_t)(k0 + kk) * Nsrc + sc] : 0.f;
  }
  __syncthreads();
  {
    const int kq = tid & 15, jj0 = tid >> 4;
#pragma unroll
    for (int jj = jj0; jj < 64; jj += 16) {
      uint2 o;
      o.x = (unsigned)f2bf(sm[(4 * kq + 0) * 65 + jj]) | ((unsigned)f2bf(sm[(4 * kq + 1) * 65 + jj]) << 16);
      o.y = (unsigned)f2bf(sm[(4 * kq + 2) * 65 + jj]) | ((unsigned)f2bf(sm[(4 * kq + 3) * 65 + jj]) << 16);
      *(uint2*)(dst + (size_t)(j0 + jj) * K + k0 + 4 * kq) = o;
    }
  }
}

__device__ __forceinline__ void mod_item(const Params& p, int item, float* sm) {
  const int l = item / 96, j0 = (item % 96) * 64;
  const int tid = tid_l();
  float* sC = sm;
  float* sR = sm + 9 * 1024;
  __syncthreads();
  for (int i = tid; i < 9 * 1024; i += NTHR) {
    int m = i >> 10, k = i & 1023;
    float v = m == 0 ? p.c_ctx[k] : p.c[(m - 1) * 1024 + k];
    sC[i] = siluf_(v);
  }
  __syncthreads();
  const int col = tid & 63, ks = tid >> 6;
  float acc[9];
#pragma unroll
  for (int m = 0; m < 9; ++m) acc[m] = 0.f;
  const float* wp = p.w_ada + (size_t)l * 1024 * 6144 + j0 + col;
  for (int k = ks * 256; k < ks * 256 + 256; k += 8) {
    float wv[8];
#pragma unroll
    for (int u = 0; u < 8; ++u) wv[u] = wp[(size_t)(k + u) * 6144];
#pragma unroll
    for (int u = 0; u < 8; ++u)
#pragma unroll
      for (int m = 0; m < 9; ++m) acc[m] += sC[m * 1024 + k + u] * wv[u];
  }
#pragma unroll
  for (int m = 0; m < 9; ++m) sR[(ks * 9 + m) * 64 + col] = acc[m];
  __syncthreads();
  for (int i = tid; i < 9 * 64; i += NTHR) {
    int m = i >> 6, cc = i & 63;
    float v = sR[(0 * 9 + m) * 64 + cc] + sR[(1 * 9 + m) * 64 + cc] + sR[(2 * 9 + m) * 64 + cc] + sR[(3 * 9 + m) * 64 + cc];
    p.mod[((size_t)l * 9 + m) * 6144 + j0 + cc] = v + p.b_ada[l * 6144 + j0 + cc];
  }
}

__device__ __forceinline__ void phase0(const Params& p, float* sm) {
  const int PER_LAYER = 3272;
  const int total = 2 * PER_LAYER + 192;
  for (int item = blockIdx.x; item < total; item += gridDim.x) {
    if (item < 192) { mod_item(p, item, sm); continue; }
    int it = item - 192;
    int l = it / PER_LAYER, r = it % PER_LAYER;
    if (r < 768) { cvt_tile(p.w_in + (size_t)l * 1024 * 3024, 1024, 3024, p.WinT + (size_t)l * 3072 * 1024, 1, r / 16, r % 16, sm); continue; }
    r -= 768;
    if (r < 72) { cvt_tile(p.mla_w_uq + (size_t)l * 384 * 768, 384, 768, p.WuqT + (size_t)l * 768 * 384, 0, r / 6, r % 6, sm); continue; }
    r -= 72;
    if (r < 64) { cvt_tile(p.mla_w_ukv + (size_t)l * 256 * 1024, 256, 1024, p.WukvT + (size_t)l * 1024 * 256, 0, r / 4, r % 4, sm); continue; }
    r -= 64;
    if (r < 256) { cvt_tile(p.w_out + (size_t)l * 1024 * 1024, 1024, 1024, p.WoutT + (size_t)l * 1024 * 1024, 0, r / 16, r % 16, sm); continue; }
    r -= 256;
    if (r < 1408) { cvt_tile(p.w_ffn_in + (size_t)l * 1024 * 5632, 1024, 5632, p.WfiT + (size_t)l * 5632 * 1024, 2, r / 16, r % 16, sm); continue; }
    r -= 1408;
    cvt_tile(p.w_ffn_out + (size_t)l * 2816 * 1024, 2816, 1024, p.WfoT + (size_t)l * 1024 * 2816, 0, r / 44, r % 44, sm);
  }
}

__device__ __forceinline__ void rowpass_norm(const Params& p, int l, int stage) {
  const int tidl = tid_l();
  const int lane = tidl & 63, w = tidl >> 6;
  const int ln = stage == 0 ? 0 : (stage == 1 ? l : l + 1);
  const int sh_off = stage == 1 ? 3072 : 0;
  const float* gpre = stage == 1 ? p.g_pre_ffn + l * 1024 : p.g_pre_mix + (ln < 2 ? ln : 0) * 1024;
  u16* dst = stage == 1 ? p.MIX : p.HQ;
  for (int t = blockIdx.x * 4 + w; t < T_ALL; t += gridDim.x * 4) {
    const int m = tok_mod(t);
    float x[16];
    float* xo = p.out + (size_t)t * 1024;
    if (stage == 0) {
      const float* xi = t < T_CTX ? p.x_prompt + (size_t)t * 1024 : p.x_sample + (size_t)(t - T_CTX) * 1024;
#pragma unroll
      for (int i = 0; i < 4; ++i) {
        float4 v = *(const float4*)(xi + i * 256 + lane * 4);
        x[i * 4 + 0] = v.x; x[i * 4 + 1] = v.y; x[i * 4 + 2] = v.z; x[i * 4 + 3] = v.w;
      }
    } else {
      const u16* yp = p.HQ + (size_t)t * 1024;
      float y[16]; float ss = 0.f;
#pragma unroll
      for (int i = 0; i < 4; ++i) {
        uint2 v = *(const uint2*)(yp + i * 256 + lane * 4);
        y[i * 4 + 0] = bf2f((u16)(v.x & 0xffff)); y[i * 4 + 1] = bf2f((u16)(v.x >> 16));
        y[i * 4 + 2] = bf2f((u16)(v.y & 0xffff)); y[i * 4 + 3] = bf2f((u16)(v.y >> 16));
      }
#pragma unroll
      for (int i = 0; i < 16; ++i) ss += y[i] * y[i];
      ss = wave_sum(ss);
      const float rstd = rsqrtf(ss * (1.f / 1024.f) + 1e-6f);
      const float* gpost = (stage == 1 ? p.g_post_mix : p.g_post_ffn) + l * 1024;
      const float* gt = p.mod + ((size_t)l * 9 + m) * 6144 + (stage == 1 ? 2048 : 5120);
#pragma unroll
      for (int i = 0; i < 4; ++i) {
        float4 xv = *(const float4*)(xo + i * 256 + lane * 4);
        float4 gp = *(const float4*)(gpost + i * 256 + lane * 4);
        float4 gg = *(const float4*)(gt + i * 256 + lane * 4);
        x[i * 4 + 0] = xv.x + gg.x * y[i * 4 + 0] * rstd * gp.x;
        x[i * 4 + 1] = xv.y + gg.y * y[i * 4 + 1] * rstd * gp.y;
        x[i * 4 + 2] = xv.z + gg.z * y[i * 4 + 2] * rstd * gp.z;
        x[i * 4 + 3] = xv.w + gg.w * y[i * 4 + 3] * rstd * gp.w;
      }
    }
    __threadfence_block();
#pragma unroll
    for (int i = 0; i < 4; ++i)
      *(float4*)(xo + i * 256 + lane * 4) = make_float4(x[i * 4 + 0], x[i * 4 + 1], x[i * 4 + 2], x[i * 4 + 3]);
    if (ln >= 2) continue;
    float ss = 0.f;
#pragma unroll
    for (int i = 0; i < 16; ++i) ss += x[i] * x[i];
    ss = wave_sum(ss);
    const float rstd = rsqrtf(ss * (1.f / 1024.f) + 1e-6f);
    const float* sh = p.mod + ((size_t)ln * 9 + m) * 6144 + sh_off;
    const float* sc = sh + 1024;
    u16* hp = dst + (size_t)t * 1024;
#pragma unroll
    for (int i = 0; i < 4; ++i) {
      float4 gp = *(const float4*)(gpre + i * 256 + lane * 4);
      float4 s1 = *(const float4*)(sh + i * 256 + lane * 4);
      float4 c1 = *(const float4*)(sc + i * 256 + lane * 4);
      float h0 = x[i * 4 + 0] * rstd * gp.x * (1.f + c1.x) + s1.x;
      float h1 = x[i * 4 + 1] * rstd * gp.y * (1.f + c1.y) + s1.y;
      float h2 = x[i * 4 + 2] * rstd * gp.z * (1.f + c1.z) + s1.z;
      float h3 = x[i * 4 + 3] * rstd * gp.w * (1.f + c1.w) + s1.w;
      uint2 o;
      o.x = (unsigned)f2bf(h0) | ((unsigned)f2bf(h1) << 16);
      o.y = (unsigned)f2bf(h2) | ((unsigned)f2bf(h3) << 16);
      *(uint2*)(hp + i * 256 + lane * 4) = o;
    }
  }
}

__device__ __forceinline__ void unpack8(const uint4 v, float (&f)[8]);
__device__ __forceinline__ uint4 pack8(const float (&f)[8]);
__device__ __forceinline__ void rowpass_b0(const Params& p, int l) {
  const int tidl = tid_l();
  const int lane = tidl & 63, w = tidl >> 6;
  for (int t = blockIdx.x * 4 + w; t < T_ALL + 2048; t += gridDim.x * 4) {
    if (t >= T_ALL) {
      const int r = t - T_ALL, b = r >> 8, s = r & 255;
      if (lane < 32) {
        const float* ck = p.cache_ckv + (((size_t)b * 2 + l) * 256 + s) * 256 + lane * 8;
        const float4 x0 = *(const float4*)ck, x1 = *(const float4*)(ck + 4);
        const float f[8] = {x0.x, x0.y, x0.z, x0.w, x1.x, x1.y, x1.z, x1.w};
        *(uint4*)(p.CKVC + (size_t)r * 256 + lane * 8) = pack8(f);
      } else if (lane < 40) {
        const float* kr = p.cache_kr + (((size_t)b * 2 + l) * 256 + s) * 64 + (lane - 32) * 8;
        const float4 x0 = *(const float4*)kr, x1 = *(const float4*)(kr + 4);
        const float f[8] = {x0.x, x0.y, x0.z, x0.w, x1.x, x1.y, x1.z, x1.w};
        *(uint4*)(p.KRC + (size_t)r * 64 + (lane - 32) * 8) = pack8(f);
      }
      continue;
    }
    u16* pr = p.P + (size_t)t * PW;
    {
      float f[8]; float ss = 0.f;
      if (lane < 48) {
        unpack8(*(const uint4*)(pr + P_MCQ + lane * 8), f);
#pragma unroll
        for (int i = 0; i < 8; ++i) ss += f[i] * f[i];
      }
      ss = wave_sum(ss);
      const float rstd = rsqrtf(ss * (1.f / 384.f) + 1e-6f);
      if (lane < 48) {
        const float* wq = p.mla_q_norm_w + l * 384 + lane * 8;
        const float4 w0 = *(const float4*)wq, w1 = *(const float4*)(wq + 4);
        f[0] *= rstd * w0.x; f[1] *= rstd * w0.y; f[2] *= rstd * w0.z; f[3] *= rstd * w0.w;
        f[4] *= rstd * w1.x; f[5] *= rstd * w1.y; f[6] *= rstd * w1.z; f[7] *= rstd * w1.w;
        *(uint4*)(pr + P_MCQ + lane * 8) = pack8(f);
      }
    }
    {
      float f[8]; float ss = 0.f;
      if (lane < 32) {
        unpack8(*(const uint4*)(pr + P_MCKV + lane * 8), f);
#pragma unroll
        for (int i = 0; i < 8; ++i) ss += f[i] * f[i];
      }
      ss = wave_sum(ss);
      const float rstd = rsqrtf(ss * (1.f / 256.f) + 1e-6f);
      if (lane < 32) {
        const float* wk = p.mla_kv_norm_w + l * 256 + lane * 8;
        const float4 w0 = *(const float4*)wk, w1 = *(const float4*)(wk + 4);
        f[0] *= rstd * w0.x; f[1] *= rstd * w0.y; f[2] *= rstd * w0.z; f[3] *= rstd * w0.w;
        f[4] *= rstd * w1.x; f[5] *= rstd * w1.y; f[6] *= rstd * w1.z; f[7] *= rstd * w1.w;
        *(uint4*)(pr + P_MCKV + lane * 8) = pack8(f);
        if (t < T_CTX) {
          const int b = t >> 8, s = t & 255;
          float* op = p.out + OUT_CKV + (((size_t)b * 2 + l) * 256 + s) * 256 + lane * 8;
          *(float4*)op = make_float4(f[0], f[1], f[2], f[3]);
          *(float4*)(op + 4) = make_float4(f[4], f[5], f[6], f[7]);
        }
      }
    }
    {
      float v = bf2f(pr[P_MKR + lane]);
      if (t < T_CTX) {
        int b = t >> 8, s = t & 255;
        p.out[OUT_KR + (((size_t)b * 2 + l) * 256 + s) * 64 + lane] = v;
      } else {
        int pos = (t - T_CTX) & 4095;
        int axis = lane >> 5, half = (lane >> 4) & 1, f = lane & 15;
        float posf = axis == 0 ? (float)(pos >> 6) : (float)(pos & 63);
        float inv = exp2f(-(float)f * (13.287712379549449f / 16.f));
        float ang = posf * inv;
        float sn, cs;
        __sincosf(ang, &sn, &cs);
        float other = __shfl_xor(v, 16);
        float o = half == 0 ? v * cs - other * sn : v * cs + other * sn;
        pr[P_MKR + lane] = f2bf(o);
      }
    }
  }
}

#define P_QH 2304
#define P_KH 2560
__device__ __forceinline__ void rowpass_b2(const Params& p, int l) {
  const int tidl = tid_l();
  const int lane = tidl & 63, w = tidl >> 6;
  float cw[8][5], cv[8][5];
#pragma unroll
  for (int e = 0; e < 8; ++e)
#pragma unroll
    for (int j = 0; j < 5; ++j) {
      cw[e][j] = p.gdn_conv_w[((size_t)l * 768 + 8 * lane + e) * 5 + j];
      cv[e][j] = p.gdn_conv_w[((size_t)l * 768 + 512 + 8 * (lane & 31) + e) * 5 + j];
    }
  u16* VH = p.HQ + (size_t)T_ALL * 768;
  for (int t = blockIdx.x * 4 + w; t < T_ALL; t += gridDim.x * 4) {
    const int len = t < T_CTX ? 256 : 4096;
    const int tau = t < T_CTX ? (t & 255) : ((t - T_CTX) & 4095);
    float y[8], yv[8];
#pragma unroll
    for (int e = 0; e < 8; ++e) { y[e] = 0.f; yv[e] = 0.f; }
#pragma unroll
    for (int j = 0; j < 5; ++j) {
      const int tt = tau + j - 2;
      if (tt >= 0 && tt < len) {
        const u16* pr = p.P + (size_t)(t + j - 2) * PW;
        float f[8];
        unpack8(*(const uint4*)(pr + 8 * lane), f);
#pragma unroll
        for (int e = 0; e < 8; ++e) y[e] += cw[e][j] * f[e];
        if (lane < 32) {
          unpack8(*(const uint4*)(pr + 512 + 8 * lane), f);
#pragma unroll
          for (int e = 0; e < 8; ++e) yv[e] += cv[e][j] * f[e];
        }
      }
    }
    float ss = 0.f;
#pragma unroll
    for (int e = 0; e < 8; ++e) { y[e] = siluf_(y[e]); yv[e] = siluf_(yv[e]); ss += y[e] * y[e]; }
    ss += __shfl_xor(ss, 1); ss += __shfl_xor(ss, 2); ss += __shfl_xor(ss, 4);
    const float rn = rsqrtf(ss + 1e-6f) * (lane < 32 ? 0.125f : 1.f);
#pragma unroll
    for (int e = 0; e < 8; ++e) y[e] *= rn;
    *(uint4*)(p.P + (size_t)t * PW + P_QH + 8 * lane) = pack8(y);
    if (lane < 32) *(uint4*)(VH + (size_t)t * 256 + 8 * lane) = pack8(yv);
  }
}

__device__ __forceinline__ void unpack8(const uint4 v, float (&f)[8]) {
  f[0] = bf2f((u16)(v.x & 0xffff)); f[1] = bf2f((u16)(v.x >> 16)); f[2] = bf2f((u16)(v.y & 0xffff)); f[3] = bf2f((u16)(v.y >> 16));
  f[4] = bf2f((u16)(v.z & 0xffff)); f[5] = bf2f((u16)(v.z >> 16)); f[6] = bf2f((u16)(v.w & 0xffff)); f[7] = bf2f((u16)(v.w >> 16));
}
__device__ __forceinline__ uint4 pack8(const float (&f)[8]) {
  uint4 o;
  o.x = (unsigned)f2bf(f[0]) | ((unsigned)f2bf(f[1]) << 16); o.y = (unsigned)f2bf(f[2]) | ((unsigned)f2bf(f[3]) << 16);
  o.z = (unsigned)f2bf(f[4]) | ((unsigned)f2bf(f[5]) << 16); o.w = (unsigned)f2bf(f[6]) | ((unsigned)f2bf(f[7]) << 16);
  return o;
}
__device__ __forceinline__ void rowpass_c2(const Params& p, int l) {
  const int tidl = tid_l();
  const int lane = tidl & 63, w = tidl >> 6;
  const int hl = lane & 31, isH = lane >> 5;
  const float* nw = (isH ? p.hgrn_norm_w : p.gdn_norm_w) + l * 64 + (hl & 7) * 8;
  const float4 w0 = *(const float4*)(nw), w1 = *(const float4*)(nw + 4);
  const float wv[8] = {w0.x, w0.y, w0.z, w0.w, w1.x, w1.y, w1.z, w1.w};
  for (int t = blockIdx.x * 4 + w; t < T_ALL; t += gridDim.x * 4) {
    u16* mr = p.MIX + (size_t)t * 1024;
    const u16* pr = p.P + (size_t)t * PW;
    const u16* qr = p.HQ + (size_t)t * 768;
    const uint4 vf = *(const uint4*)(mr + isH * 512 + hl * 8);
    const uint4 vb = *(const uint4*)(mr + isH * 512 + 256 + hl * 8);
    const uint4 vg = *(const uint4*)(pr + (isH ? P_HG : P_GZ) + hl * 8);
    const int c0 = lane * 8;
    const uint4 vo = *(const uint4*)(qr + (c0 >> 7) * 192 + (c0 & 127));
    float f[8], bb[8], g[8];
    unpack8(vf, f); unpack8(vb, bb); unpack8(vg, g);
    float ss = 0.f;
#pragma unroll
    for (int i = 0; i < 8; ++i) { f[i] += bb[i]; ss += f[i] * f[i]; }
    ss += __shfl_xor(ss, 1); ss += __shfl_xor(ss, 2); ss += __shfl_xor(ss, 4);
    const float rn = rsqrtf(ss * (1.f / 64.f) + 1e-6f);
#pragma unroll
    for (int i = 0; i < 8; ++i) f[i] = f[i] * rn * wv[i] * (isH ? sigmoidf_(g[i]) : siluf_(g[i]));
    __threadfence_block();
    *(uint4*)(mr + isH * 256 + hl * 8) = pack8(f);
    *(uint4*)(mr + 512 + c0) = vo;
  }
}

__device__ __forceinline__ void gemm128(const u16* __restrict__ A, int lda, const u16* __restrict__ B, int ldb, int K,
                                        u16* lds, f32x4 (&acc)[4][4]) {
  const int tid = tid_l(), lane = tid & 63, w = tid >> 6, wm = w >> 1, wn = w & 1;
  const int r16 = lane & 15, g4 = lane >> 4;
#pragma unroll
  for (int i = 0; i < 4; ++i)
#pragma unroll
    for (int j = 0; j < 4; ++j) acc[i][j] = f32x4{0.f, 0.f, 0.f, 0.f};
  const int lrow = tid >> 3, lkc = tid & 7;
  const u16* ap = A + (size_t)lrow * lda + lkc * 8;
  const u16* bp = B + (size_t)lrow * ldb + lkc * 8;
  const size_t sa32 = (size_t)32 * lda, sb32 = (size_t)32 * ldb;
  uint4 ra0 = *(const uint4*)(ap), ra1 = *(const uint4*)(ap + sa32), ra2 = *(const uint4*)(ap + 2 * sa32), ra3 = *(const uint4*)(ap + 3 * sa32);
  uint4 rb0 = *(const uint4*)(bp), rb1 = *(const uint4*)(bp + sb32), rb2 = *(const uint4*)(bp + 2 * sb32), rb3 = *(const uint4*)(bp + 3 * sb32);
  const int woff = lrow * 64 + ((lkc ^ (lrow & 7)) * 8);
  const int sw = r16 & 7;
  const int fa0 = (wm * 64 + r16) * 64 + ((g4 ^ sw) * 8);
  const int fa1 = (wm * 64 + r16) * 64 + (((4 + g4) ^ sw) * 8);
  const int fb0 = 128 * 64 + (wn * 64 + r16) * 64 + ((g4 ^ sw) * 8);
  const int fb1 = 128 * 64 + (wn * 64 + r16) * 64 + (((4 + g4) ^ sw) * 8);
  const int nk = K >> 6;
  __syncthreads();
  {
    u16* wa = lds + woff; u16* wb = lds + 128 * 64 + woff;
    *(uint4*)(wa) = ra0; *(uint4*)(wa + 32 * 64) = ra1; *(uint4*)(wa + 64 * 64) = ra2; *(uint4*)(wa + 96 * 64) = ra3;
    *(uint4*)(wb) = rb0; *(uint4*)(wb + 32 * 64) = rb1; *(uint4*)(wb + 64 * 64) = rb2; *(uint4*)(wb + 96 * 64) = rb3;
  }
  if (nk > 1) {
    const u16* a2 = ap + 64; const u16* b2 = bp + 64;
    ra0 = *(const uint4*)(a2); ra1 = *(const uint4*)(a2 + sa32); ra2 = *(const uint4*)(a2 + 2 * sa32); ra3 = *(const uint4*)(a2 + 3 * sa32);
    rb0 = *(const uint4*)(b2); rb1 = *(const uint4*)(b2 + sb32); rb2 = *(const uint4*)(b2 + 2 * sb32); rb3 = *(const uint4*)(b2 + 3 * sb32);
  }
  __syncthreads();
  for (int kt = 0; kt < nk; ++kt) {
    const u16* cur = lds + (kt & 1) * (256 * 64);
    if (kt + 1 < nk) {
      u16* nxt = lds + ((kt + 1) & 1) * (256 * 64);
      u16* wa = nxt + woff; u16* wb = nxt + 128 * 64 + woff;
      *(uint4*)(wa) = ra0; *(uint4*)(wa + 32 * 64) = ra1; *(uint4*)(wa + 64 * 64) = ra2; *(uint4*)(wa + 96 * 64) = ra3;
      *(uint4*)(wb) = rb0; *(uint4*)(wb + 32 * 64) = rb1; *(uint4*)(wb + 64 * 64) = rb2; *(uint4*)(wb + 96 * 64) = rb3;
      if (kt + 2 < nk) {
        const u16* a2 = ap + (kt + 2) * 64; const u16* b2 = bp + (kt + 2) * 64;
        ra0 = *(const uint4*)(a2); ra1 = *(const uint4*)(a2 + sa32); ra2 = *(const uint4*)(a2 + 2 * sa32); ra3 = *(const uint4*)(a2 + 3 * sa32);
        rb0 = *(const uint4*)(b2); rb1 = *(const uint4*)(b2 + sb32); rb2 = *(const uint4*)(b2 + 2 * sb32); rb3 = *(const uint4*)(b2 + 3 * sb32);
      }
    }
    {
      const u16* pa0 = cur + fa0; const u16* pa1 = cur + fa1; const u16* pb0 = cur + fb0; const u16* pb1 = cur + fb1;
      bf16x8 a0 = *(const bf16x8*)(pa0), a1 = *(const bf16x8*)(pa0 + 16 * 64), a2 = *(const bf16x8*)(pa0 + 32 * 64), a3 = *(const bf16x8*)(pa0 + 48 * 64);
      bf16x8 b0 = *(const bf16x8*)(pb0), b1 = *(const bf16x8*)(pb0 + 16 * 64), b2 = *(const bf16x8*)(pb0 + 32 * 64), b3 = *(const bf16x8*)(pb0 + 48 * 64);
      bf16x8 c0 = *(const bf16x8*)(pa1), c1 = *(const bf16x8*)(pa1 + 16 * 64), c2 = *(const bf16x8*)(pa1 + 32 * 64), c3 = *(const bf16x8*)(pa1 + 48 * 64);
      bf16x8 d0 = *(const bf16x8*)(pb1), d1 = *(const bf16x8*)(pb1 + 16 * 64), d2 = *(const bf16x8*)(pb1 + 32 * 64), d3 = *(const bf16x8*)(pb1 + 48 * 64);
      __builtin_amdgcn_sched_barrier(0);
#define G128_MM(j, bj, x0, x1, x2, x3) do { \
        acc[0][j] = __builtin_amdgcn_mfma_f32_16x16x32_bf16(bj, x0, acc[0][j], 0, 0, 0); \
        acc[1][j] = __builtin_amdgcn_mfma_f32_16x16x32_bf16(bj, x1, acc[1][j], 0, 0, 0); \
        acc[2][j] = __builtin_amdgcn_mfma_f32_16x16x32_bf16(bj, x2, acc[2][j], 0, 0, 0); \
        acc[3][j] = __builtin_amdgcn_mfma_f32_16x16x32_bf16(bj, x3, acc[3][j], 0, 0, 0); } while (0)
      __builtin_amdgcn_s_setprio(1);
      G128_MM(0, b0, a0, a1, a2, a3); G128_MM(1, b1, a0, a1, a2, a3); G128_MM(2, b2, a0, a1, a2, a3); G128_MM(3, b3, a0, a1, a2, a3);
      G128_MM(0, d0, c0, c1, c2, c3); G128_MM(1, d1, c0, c1, c2, c3); G128_MM(2, d2, c0, c1, c2, c3); G128_MM(3, d3, c0, c1, c2, c3);
      __builtin_amdgcn_s_setprio(0);
    }
    __syncthreads();
  }
}
__device__ __forceinline__ uint2 pack4(f32x4 v) {
  uint2 o;
  o.x = (unsigned)f2bf(v[0]) | ((unsigned)f2bf(v[1]) << 16);
  o.y = (unsigned)f2bf(v[2]) | ((unsigned)f2bf(v[3]) << 16);
  return o;
}

__device__ __forceinline__ void gemm256(const u16* __restrict__ A, int lda, const u16* __restrict__ B, int ldb, int K,
                                        u16* lds, f32x4 (&acc)[8][4]) {
  const int tid = tid_l(), lane = tid & 63, w = tid >> 6, wm = w >> 1, wn = w & 1;
  const int r16 = lane & 15, g4 = lane >> 4;
#pragma unroll
  for (int i = 0; i < 8; ++i)
#pragma unroll
    for (int j = 0; j < 4; ++j) acc[i][j] = f32x4{0.f, 0.f, 0.f, 0.f};
  const int lrow = tid >> 2, lkc = tid & 3;
  const u16* ap = A + (size_t)lrow * lda + lkc * 8;
  const u16* bp = B + (size_t)lrow * ldb + lkc * 8;
  const size_t sa64 = (size_t)64 * lda, sb64 = (size_t)64 * ldb;
  const int woff = lrow * 32 + ((lkc ^ ((lrow >> 1) & 3)) * 8);
  const int fsw = (g4 ^ ((r16 >> 1) & 3)) * 8;
  const int faoff = (wm * 128 + r16) * 32 + fsw;
  const int fboff = 256 * 32 + (wn * 64 + r16) * 32 + fsw;
  const int nk = K >> 5;
  const int BUF = 384 * 32;
  uint4 xa0, xa1, xa2, xa3, xb0, xb1;
  uint4 ya0, ya1, ya2, ya3, yb0, yb1;
#define G256_LOAD(P, st) do { const u16* a2_ = ap + (st) * 32; const u16* b2_ = bp + (st) * 32; \
    P##a0 = *(const uint4*)(a2_); P##a1 = *(const uint4*)(a2_ + sa64); P##a2 = *(const uint4*)(a2_ + 2 * sa64); P##a3 = *(const uint4*)(a2_ + 3 * sa64); \
    P##b0 = *(const uint4*)(b2_); P##b1 = *(const uint4*)(b2_ + sb64); } while (0)
#define G256_STORE(P, buf) do { u16* wa_ = lds + (buf) * BUF + woff; u16* wb_ = wa_ + 256 * 32; \
    *(uint4*)(wa_) = P##a0; *(uint4*)(wa_ + 64 * 32) = P##a1; *(uint4*)(wa_ + 128 * 32) = P##a2; *(uint4*)(wa_ + 192 * 32) = P##a3; \
    *(uint4*)(wb_) = P##b0; *(uint4*)(wb_ + 64 * 32) = P##b1; } while (0)
#define G256_MM(i, af) do { \
      acc[i][0] = __builtin_amdgcn_mfma_f32_16x16x32_bf16(bf0, af, acc[i][0], 0, 0, 0); \
      acc[i][1] = __builtin_amdgcn_mfma_f32_16x16x32_bf16(bf1, af, acc[i][1], 0, 0, 0); \
      acc[i][2] = __builtin_amdgcn_mfma_f32_16x16x32_bf16(bf2, af, acc[i][2], 0, 0, 0); \
      acc[i][3] = __builtin_amdgcn_mfma_f32_16x16x32_bf16(bf3, af, acc[i][3], 0, 0, 0); } while (0)
#define G256_COMPUTE(buf) do { const u16* fa_ = lds + (buf) * BUF + faoff; const u16* fb_ = lds + (buf) * BUF + fboff; \
    bf16x8 bf0 = *(const bf16x8*)(fb_), bf1 = *(const bf16x8*)(fb_ + 16 * 32), bf2 = *(const bf16x8*)(fb_ + 32 * 32), bf3 = *(const bf16x8*)(fb_ + 48 * 32); \
    bf16x8 a0 = *(const bf16x8*)(fa_), a1 = *(const bf16x8*)(fa_ + 16 * 32), a2 = *(const bf16x8*)(fa_ + 32 * 32), a3 = *(const bf16x8*)(fa_ + 48 * 32); \
    __builtin_amdgcn_sched_barrier(0); __builtin_amdgcn_s_setprio(1); \
    G256_MM(0, a0); a0 = *(const bf16x8*)(fa_ + 64 * 32); __builtin_amdgcn_sched_barrier(0); \
    G256_MM(1, a1); a1 = *(const bf16x8*)(fa_ + 80 * 32); __builtin_amdgcn_sched_barrier(0); \
    G256_MM(2, a2); a2 = *(const bf16x8*)(fa_ + 96 * 32); __builtin_amdgcn_sched_barrier(0); \
    G256_MM(3, a3); a3 = *(const bf16x8*)(fa_ + 112 * 32); __builtin_amdgcn_sched_barrier(0); \
    G256_MM(4, a0); G256_MM(5, a1); G256_MM(6, a2); G256_MM(7, a3); __builtin_amdgcn_s_setprio(0); } while (0)
  G256_LOAD(x, 0);
  G256_LOAD(y, 1);
  __syncthreads();
  G256_STORE(x, 0);
  G256_LOAD(x, 2);
  __syncthreads();
  for (int kt = 0; kt < nk; kt += 2) {
    G256_STORE(y, 1);
    if (kt + 3 < nk) G256_LOAD(y, kt + 3);
    G256_COMPUTE(0);
    __syncthreads();
    if (kt + 2 < nk) {
      G256_STORE(x, 0);
      if (kt + 4 < nk) G256_LOAD(x, kt + 4);
    }
    G256_COMPUTE(1);
    __syncthreads();
  }
}

__device__ __forceinline__ void gemm192(const u16* __restrict__ A, int lda, const u16* __restrict__ B, int ldb, int K,
                                        u16* lds, f32x4 (&acc)[6][4]) {
  const int tid = tid_l(), lane = tid & 63, w = tid >> 6, wm = w >> 1, wn = w & 1;
  const int r16 = lane & 15, g4 = lane >> 4;
#pragma unroll
  for (int i = 0; i < 6; ++i)
#pragma unroll
    for (int j = 0; j < 4; ++j) acc[i][j] = f32x4{0.f, 0.f, 0.f, 0.f};
  const int lrow = tid >> 2, lkc = tid & 3;
  const u16* ap = A + (size_t)lrow * lda + lkc * 8;
  const u16* bp = B + (size_t)lrow * ldb + lkc * 8;
  const size_t sa64 = (size_t)64 * lda, sb64 = (size_t)64 * ldb;
  const int woff = lrow * 32 + ((lkc ^ ((lrow >> 1) & 3)) * 8);
  const int fsw = (g4 ^ ((r16 >> 1) & 3)) * 8;
  const int faoff = (wm * 96 + r16) * 32 + fsw;
  const int fboff = 192 * 32 + (wn * 64 + r16) * 32 + fsw;
  const int nk = K >> 5;
  const int BUF = 320 * 32;
  uint4 xa0, xa1, xa2, xb0, xb1;
  uint4 ya0, ya1, ya2, yb0, yb1;
#define G192_LOAD(P, st) do { const u16* a2_ = ap + (st) * 32; const u16* b2_ = bp + (st) * 32; \
    P##a0 = *(const uint4*)(a2_); P##a1 = *(const uint4*)(a2_ + sa64); P##a2 = *(const uint4*)(a2_ + 2 * sa64); \
    P##b0 = *(const uint4*)(b2_); P##b1 = *(const uint4*)(b2_ + sb64); } while (0)
#define G192_STORE(P, buf) do { u16* wa_ = lds + (buf) * BUF + woff; u16* wb_ = wa_ + 192 * 32; \
    *(uint4*)(wa_) = P##a0; *(uint4*)(wa_ + 64 * 32) = P##a1; *(uint4*)(wa_ + 128 * 32) = P##a2; \
    *(uint4*)(wb_) = P##b0; *(uint4*)(wb_ + 64 * 32) = P##b1; } while (0)
#define G192_COMPUTE(buf) do { const u16* fa_ = lds + (buf) * BUF + faoff; const u16* fb_ = lds + (buf) * BUF + fboff; \
    bf16x8 bf0 = *(const bf16x8*)(fb_), bf1 = *(const bf16x8*)(fb_ + 16 * 32), bf2 = *(const bf16x8*)(fb_ + 32 * 32), bf3 = *(const bf16x8*)(fb_ + 48 * 32); \
    bf16x8 a0 = *(const bf16x8*)(fa_), a1 = *(const bf16x8*)(fa_ + 16 * 32), a2 = *(const bf16x8*)(fa_ + 32 * 32), a3 = *(const bf16x8*)(fa_ + 48 * 32); \
    __builtin_amdgcn_sched_barrier(0); __builtin_amdgcn_s_setprio(1); \
    G256_MM(0, a0); a0 = *(const bf16x8*)(fa_ + 64 * 32); __builtin_amdgcn_sched_barrier(0); \
    G256_MM(1, a1); a1 = *(const bf16x8*)(fa_ + 80 * 32); __builtin_amdgcn_sched_barrier(0); \
    G256_MM(2, a2); G256_MM(3, a3); G256_MM(4, a0); G256_MM(5, a1); __builtin_amdgcn_s_setprio(0); } while (0)
  G192_LOAD(x, 0);
  G192_LOAD(y, 1);
  __syncthreads();
  G192_STORE(x, 0);
  G192_LOAD(x, 2);
  __syncthreads();
  for (int kt = 0; kt < nk; kt += 2) {
    G192_STORE(y, 1);
    if (kt + 3 < nk) G192_LOAD(y, kt + 3);
    G192_COMPUTE(0);
    __syncthreads();
    if (kt + 2 < nk) {
      G192_STORE(x, 0);
      if (kt + 4 < nk) G192_LOAD(x, kt + 4);
    }
    G192_COMPUTE(1);
    __syncthreads();
  }
}
#define GEMM256_RC const int tde = tid_l(); const int rb = ((tde >> 6) >> 1) * 128 + (tde & 15), cb = ((tde >> 6) & 1) * 64 + ((tde & 63) >> 4) * 4;
#define GEMM_RC const int tde = tid_l(); const int rb = ((tde >> 6) >> 1) * 64 + (tde & 15), cb = ((tde >> 6) & 1) * 64 + ((tde & 63) >> 4) * 4;


__device__ __forceinline__ bool tile_at(int r, int Mt, int Nt, int& mt, int& nt) {
  const int x = blockIdx.x & 7, j = blockIdx.x >> 3, bpx = gridDim.x >> 3;
  const int mpx = Mt >> 3;
  const int q = r * bpx + j;
  if (q >= mpx * Nt) return false;
  const int full = (Nt >> 3) * (mpx * 8);
  int cb, rem, wcb;
  if (q < full) { cb = q / (mpx * 8); rem = q - cb * mpx * 8; wcb = 8; }
  else { cb = Nt >> 3; rem = q - full; wcb = Nt - cb * 8; }
  mt = x * mpx + rem / wcb;
  nt = cb * 8 + rem % wcb;
  return true;
}

__device__ __forceinline__ void phase_a(const Params& p, int l, u16* lds) {
  const u16* Bw = p.WinT + (size_t)l * 3072 * 1024;
  int mt, nt;
  for (int r = 0; tile_at(r, 144, 24, mt, nt); ++r) {
    const int m0 = mt * 256, n0 = nt * 128;
    f32x4 acc[8][4];
    gemm256(p.HQ + (size_t)m0 * 1024, 1024, Bw + (size_t)n0 * 1024, 1024, 1024, lds, acc);
    { GEMM256_RC
#pragma unroll
      for (int mi = 0; mi < 8; ++mi) {
        const int row = m0 + rb + mi * 16;
#pragma unroll
        for (int ni = 0; ni < 4; ++ni) {
          const int col = n0 + cb + ni * 16;
          *(uint2*)(p.P + (size_t)row * PW + col) = pack4(acc[mi][ni]);
          if (col >= P_GA && col < P_GA + 16)
            *(float4*)(p.GAB + (size_t)row * 16 + (col - P_GA)) = make_float4(acc[mi][ni][0], acc[mi][ni][1], acc[mi][ni][2], acc[mi][ni][3]);
        }
      }
    }
  }
}

__device__ __forceinline__ void phase_b1(const Params& p, int l, u16* lds) {
  int mt, nt;
  for (int pass = 0; pass < 2; ++pass) {
  for (int r = 0; tile_at(r, pass == 0 ? 288 : 304, pass == 0 ? 6 : 8, mt, nt); ++r) {
    if (pass == 0) {
      const int m0 = mt * 128, n0 = nt * 128;
      const float qscale = 0.07216878364870322f * 1.4426950408889634f;
      f32x4 acc[4][4];
      gemm128(p.P + (size_t)m0 * PW + P_MCQ, PW, p.WuqT + (size_t)l * 768 * 384 + (size_t)n0 * 384, 384, 384, lds, acc);
      { GEMM_RC
        const int g4 = (tde & 63) >> 4;
        const int cw0 = n0 + cb - g4 * 4;
        const bool ropew = ((cw0 >> 6) % 3) == 2 && m0 >= T_CTX;
#pragma unroll
        for (int mi = 0; mi < 4; ++mi) {
          const int row = m0 + rb + mi * 16;
          f32x4 v0 = acc[mi][0], v1 = acc[mi][1], v2 = acc[mi][2], v3 = acc[mi][3];
          if (ropew) {
            const int pos = (row - T_CTX) & 4095;
#pragma unroll
            for (int r = 0; r < 4; ++r) {
              const float inv = exp2f(-(float)(g4 * 4 + r) * (13.287712379549449f / 16.f));
              float s0, c0, s1, c1;
              __sincosf((float)(pos >> 6) * inv, &s0, &c0);
              __sincosf((float)(pos & 63) * inv, &s1, &c1);
              const float a0 = v0[r] * c0 - v1[r] * s0, a1 = v1[r] * c0 + v0[r] * s0;
              const float b0 = v2[r] * c1 - v3[r] * s1, b1 = v3[r] * c1 + v2[r] * s1;
              v0[r] = a0; v1[r] = a1; v2[r] = b0; v3[r] = b1;
            }
          }
          u16* qp = p.HQ + (size_t)row * 768 + n0 + cb;
          *(uint2*)(qp) = pack4(v0 * qscale); *(uint2*)(qp + 16) = pack4(v1 * qscale);
          *(uint2*)(qp + 32) = pack4(v2 * qscale); *(uint2*)(qp + 48) = pack4(v3 * qscale);
        }
      }
    } else {
      const int m0 = mt * 128, n0 = nt * 128;
      const u16* Ap; int lda;
      if (mt < 288) { Ap = p.P + (size_t)m0 * PW + P_MCKV; lda = PW; }
      else { Ap = p.CKVC + (size_t)(m0 - T_ALL) * 256; lda = 256; }
      f32x4 acc[4][4];
      gemm128(Ap, lda, p.WukvT + (size_t)l * 1024 * 256 + (size_t)n0 * 256, 256, 256, lds, acc);
      { GEMM_RC
#pragma unroll
        for (int mi = 0; mi < 4; ++mi) {
          const int row = m0 + rb + mi * 16;
          u16* vb; int vst;
          if (row < T_CTX) { int b = row >> 8, pos = row & 255; vb = p.VTC + (size_t)(b * 4) * 128 * 256 + pos; vst = 256; }
          else if (row < T_ALL) { int b = (row - T_CTX) >> 12, pos = (row - T_CTX) & 4095; vb = p.VTL + (size_t)(b * 4) * 128 * 4352 + pos; vst = 4352; }
          else { int b = (row - T_ALL) >> 8, pos = 4096 + ((row - T_ALL) & 255); vb = p.VTL + (size_t)(b * 4) * 128 * 4352 + pos; vst = 4352; }
#pragma unroll
          for (int ni = 0; ni < 4; ++ni) {
            const int col = n0 + cb + ni * 16;
            const int h = col >> 8, wi = col & 255;
            if (wi < 128) {
              *(uint2*)(p.KN + (size_t)row * 512 + h * 128 + wi) = pack4(acc[mi][ni]);
            } else {
              u16* dst = vb + (size_t)(h * 128 + (wi - 128)) * vst;
#pragma unroll
              for (int r = 0; r < 4; ++r) dst[(size_t)r * vst] = f2bf(acc[mi][ni][r]);
            }
          }
        }
      }
    }
  }
  }
}

__device__ __forceinline__ void phase_gemm_y(const u16* A, int lda, const u16* B, int K, int N, u16* Y, int ldy, u16* lds) {
  int mt, nt;
  for (int r = 0; tile_at(r, 192, N / 128, mt, nt); ++r) {
    const int m0 = mt * 192, n0 = nt * 128;
    f32x4 acc[6][4];
    gemm192(A + (size_t)m0 * lda, lda, B + (size_t)n0 * K, K, K, lds, acc);
    {
      const int tde = tid_l();
      const int rb = ((tde >> 6) >> 1) * 96 + (tde & 15), cb = ((tde >> 6) & 1) * 64 + ((tde & 63) >> 4) * 4;
#pragma unroll
      for (int mi = 0; mi < 6; ++mi)
#pragma unroll
        for (int ni = 0; ni < 4; ++ni)
          *(uint2*)(Y + (size_t)(m0 + rb + mi * 16) * ldy + n0 + cb + ni * 16) = pack4(acc[mi][ni]);
    }
  }
}

__device__ __forceinline__ void phase_e(const Params& p, int l, u16* lds) {
  const u16* Bw = p.WfiT + (size_t)l * 5632 * 1024;
  int mt, nt;
  for (int r = 0; tile_at(r, 144, 44, mt, nt); ++r) {
    const int m0 = mt * 256, n0 = nt * 128;
    f32x4 acc[8][4];
    gemm256(p.MIX + (size_t)m0 * 1024, 1024, Bw + (size_t)n0 * 1024, 1024, 1024, lds, acc);
    { GEMM256_RC
      const int g4x4 = ((tde & 63) >> 4) * 4;
      const int hc0 = ((n0 + cb - g4x4) >> 1) + g4x4;
#pragma unroll
      for (int mi = 0; mi < 8; ++mi)
#pragma unroll
        for (int ni = 0; ni < 2; ++ni) {
          f32x4 hv;
#pragma unroll
          for (int r = 0; r < 4; ++r) hv[r] = siluf_(acc[mi][ni][r]) * acc[mi][ni + 2][r];
          *(uint2*)(p.P + (size_t)(m0 + rb + mi * 16) * DFF + hc0 + ni * 16) = pack4(hv);
        }
    }
  }
}

#define KST 208
#define VST 80
#define PST 80
__device__ __forceinline__ void attn_item(const Params& p, int latent, int b, int h, int qb, unsigned char* smraw, int dummy = 0) {
  u16* sK = (u16*)smraw;
  u16* sV = sK + 64 * KST;
  u16* sP = sV + 128 * VST;
  const int tid = tid_l(), lane = tid & 63, w = tid >> 6, r16 = lane & 15, g4 = lane >> 4;
  const int nkeys = latent ? 4352 : 256;
  const int krow0 = latent ? T_CTX + b * 4096 : b * 256;
  const int tq0 = krow0 + qb * 128;
  const u16* vt = latent ? p.VTL + (size_t)((b * 4 + h) * 128) * 4352 : p.VTC + (size_t)((b * 4 + h) * 128) * 256;
  u16* sPw = sP + w * 32 * PST;
  bf16x8 q[2][6];
#pragma unroll
  for (int mi = 0; mi < 2; ++mi)
#pragma unroll
    for (int ks = 0; ks < 6; ++ks)
      q[mi][ks] = *(const bf16x8*)(p.HQ + (size_t)(tq0 + w * 32 + mi * 16 + r16) * 768 + h * 192 + ks * 32 + g4 * 8);
  f32x4 o[2][8];
  float mrow[2], lrow[2];
#pragma unroll
  for (int mi = 0; mi < 2; ++mi) {
#pragma unroll
    for (int nd = 0; nd < 8; ++nd) o[mi][nd] = f32x4{0.f, 0.f, 0.f, 0.f};
    mrow[mi] = -1e30f; lrow[mi] = 0.f;
  }
  const int lkey = tid >> 2, lpart = tid & 3;
  const int ldv = tid >> 1, lhalf = tid & 1;
  const int ntile = nkeys >> 6;
  uint4 k0, k1, k2, k3, k4, k5;
  {
    const int pos = lkey;
    const u16* srcn = p.KN + (size_t)(krow0 + pos) * 512 + h * 128 + lpart * 8;
    const u16* srcr = p.P + (size_t)(krow0 + pos) * PW + P_MKR + lpart * 8;
    k0 = *(const uint4*)(srcn); k1 = *(const uint4*)(srcn + 32); k2 = *(const uint4*)(srcn + 64); k3 = *(const uint4*)(srcn + 96);
    k4 = *(const uint4*)(srcr); k5 = *(const uint4*)(srcr + 32);
  }
  for (int kt = 0; kt < ntile; ++kt) {
    __syncthreads();
    {
      u16* dk = sK + lkey * KST + lpart * 8;
      *(uint4*)(dk) = k0; *(uint4*)(dk + 32) = k1; *(uint4*)(dk + 64) = k2; *(uint4*)(dk + 96) = k3;
      *(uint4*)(dk + 128) = k4; *(uint4*)(dk + 160) = k5;
    }
    const u16* sv = vt + (size_t)ldv * nkeys + kt * 64 + lhalf * 32;
    const uint4 v0 = *(const uint4*)(sv), v1 = *(const uint4*)(sv + 8), v2 = *(const uint4*)(sv + 16), v3 = *(const uint4*)(sv + 24);
    __syncthreads();
    f32x4 s[2][4];
#pragma unroll
    for (int mi = 0; mi < 2; ++mi)
#pragma unroll
      for (int ni = 0; ni < 4; ++ni) s[mi][ni] = f32x4{0.f, 0.f, 0.f, 0.f};
#pragma unroll
    for (int ks = 0; ks < 6; ++ks)
#pragma unroll
      for (int ni = 0; ni < 4; ++ni) {
        bf16x8 kf = *(const bf16x8*)(sK + (ni * 16 + r16) * KST + ks * 32 + g4 * 8);
        s[0][ni] = __builtin_amdgcn_mfma_f32_16x16x32_bf16(kf, q[0][ks], s[0][ni], 0, 0, 0);
        s[1][ni] = __builtin_amdgcn_mfma_f32_16x16x32_bf16(kf, q[1][ks], s[1][ni], 0, 0, 0);
      }
#pragma unroll
    for (int mi = 0; mi < 2; ++mi) {
      float mx = -1e30f;
#pragma unroll
      for (int ni = 0; ni < 4; ++ni)
#pragma unroll
        for (int r = 0; r < 4; ++r) mx = fmaxf(mx, s[mi][ni][r]);
      mx = fmaxf(mx, __shfl_xor(mx, 16)); mx = fmaxf(mx, __shfl_xor(mx, 32));
      const float mnew = fmaxf(mrow[mi], mx);
      const float alpha = __builtin_amdgcn_exp2f(mrow[mi] - mnew);
      mrow[mi] = mnew;
      float ps = 0.f;
#pragma unroll
      for (int ni = 0; ni < 4; ++ni) {
        f32x4 pv;
#pragma unroll
        for (int r = 0; r < 4; ++r) { pv[r] = __builtin_amdgcn_exp2f(s[mi][ni][r] - mnew); ps += pv[r]; }
        *(uint2*)(sPw + (mi * 16 + r16) * PST + ni * 16 + g4 * 4) = pack4(pv);
      }
      ps += __shfl_xor(ps, 16); ps += __shfl_xor(ps, 32);
      lrow[mi] = lrow[mi] * alpha + ps;
#pragma unroll
      for (int nd = 0; nd < 8; ++nd) o[mi][nd] *= alpha;
    }
    {
      u16* dvp = sV + ldv * VST + lhalf * 32;
      *(uint4*)(dvp) = v0; *(uint4*)(dvp + 8) = v1; *(uint4*)(dvp + 16) = v2; *(uint4*)(dvp + 24) = v3;
    }
    __syncthreads();
    if (kt + 1 < ntile) {
      const int pos = (kt + 1) * 64 + lkey;
      const bool own = (!latent) || pos < 4096;
      const int row = own ? krow0 + pos : T_ALL + b * 256 + (pos - 4096);
      const u16* srcn = p.KN + (size_t)row * 512 + h * 128 + lpart * 8;
      const u16* srcr = own ? p.P + (size_t)(krow0 + pos) * PW + P_MKR + lpart * 8
                            : p.KRC + (size_t)(b * 256 + pos - 4096) * 64 + lpart * 8;
      k0 = *(const uint4*)(srcn); k1 = *(const uint4*)(srcn + 32); k2 = *(const uint4*)(srcn + 64); k3 = *(const uint4*)(srcn + 96);
      k4 = *(const uint4*)(srcr); k5 = *(const uint4*)(srcr + 32);
    }
#pragma unroll
    for (int ks2 = 0; ks2 < 2; ++ks2) {
      bf16x8 pf0 = *(const bf16x8*)(sPw + (0 * 16 + r16) * PST + ks2 * 32 + g4 * 8);
      bf16x8 pf1 = *(const bf16x8*)(sPw + (1 * 16 + r16) * PST + ks2 * 32 + g4 * 8);
#pragma unroll
      for (int nd = 0; nd < 8; ++nd) {
        bf16x8 vf = *(const bf16x8*)(sV + (nd * 16 + r16) * VST + ks2 * 32 + g4 * 8);
        o[0][nd] = __builtin_amdgcn_mfma_f32_16x16x32_bf16(vf, pf0, o[0][nd], 0, 0, 0);
        o[1][nd] = __builtin_amdgcn_mfma_f32_16x16x32_bf16(vf, pf1, o[1][nd], 0, 0, 0);
      }
    }
  }
#pragma unroll
  for (int mi = 0; mi < 2; ++mi) {
    const float inv = 1.f / lrow[mi];
    const int qrow = tq0 + w * 32 + mi * 16 + r16;
    u16* op = p.HQ + (size_t)qrow * 768 + h * 192 + g4 * 4;
    if (dummy) op = p.HQ + (size_t)T_ALL * 768 + (size_t)(qrow % 9216) * 768 + h * 192 + g4 * 4;
#pragma unroll
    for (int nd = 0; nd < 8; ++nd) *(uint2*)(op + nd * 16) = pack4(o[mi][nd] * inv);
  }
}

#define XB_TMO      128
#define XB_XCNT(j)  (256  + 64 * (j))
#define XB_XSUB(j)  (1280 + 64 * (j))
#define XB_XGEN(j)  (2304 + 64 * (j))
#define XB_TOP      3328
#define XB_TOPGEN   3392
#define XCD_BAR_WORDS 3456
#define XB_SPIN_CAP (1u << 23)
#define LAS __attribute__((address_space(3)))

__device__ __forceinline__ unsigned xb_ld(unsigned* p)              { return __hip_atomic_load(p, __ATOMIC_RELAXED, __HIP_MEMORY_SCOPE_AGENT); }
__device__ __forceinline__ unsigned xb_add(unsigned* p, unsigned v) { return __hip_atomic_fetch_add(p, v, __ATOMIC_RELAXED, __HIP_MEMORY_SCOPE_AGENT); }
__device__ __forceinline__ unsigned xb_xcc_id() { return (unsigned)__builtin_amdgcn_s_getreg((3 << 11) | 20) & 0xFu; }
#define XB_SPIN(cond, bar) do { unsigned _sp = 0; while (cond) { __builtin_amdgcn_s_sleep(1); \
    if ((++_sp & 255u) == 0u) { if (xb_ld(&(bar)[XB_TMO])) break; if (_sp > XB_SPIN_CAP) { atomicAdd(&(bar)[XB_TMO], 1u); break; } } } } while (0)

struct XcdBarrier {
    unsigned* bar; unsigned x;
    volatile LAS unsigned* st;
};

__device__ __forceinline__ XcdBarrier xcd_barrier_post(unsigned* bar, volatile LAS unsigned* st) {
    XcdBarrier b; b.bar = bar; b.x = xb_xcc_id(); b.st = st;
    if (threadIdx.x == 0) (void)xb_add(&bar[XB_XCNT(b.x)], 1u);
    return b;
}
__device__ __forceinline__ void xcd_barrier_complete(unsigned* bar, unsigned x, unsigned& nloc, unsigned& nx) {
    const unsigned G = gridDim.x * gridDim.y * gridDim.z;
    unsigned sum, cnt, mine, sp = 0u;
    for (;;) {
        sum = 0u; cnt = 0u; mine = 0u;
#pragma unroll
        for (unsigned j = 0; j < 16; ++j) { const unsigned c = xb_ld(&bar[XB_XCNT(j)]); sum += c; cnt += (c > 0u) ? 1u : 0u; mine = (j == x) ? c : mine; }
        if (sum == G) break;
        __builtin_amdgcn_s_sleep(1);
        if ((++sp & 255u) == 0u) { if (xb_ld(&bar[XB_TMO])) break; if (sp > XB_SPIN_CAP) { atomicAdd(&bar[XB_TMO], 1u); break; } }
    }
    nloc = mine > 0u ? mine : 1u; nx = cnt > 0u ? cnt : 1u;
}

__device__ __forceinline__ void xcd_barrier(const XcdBarrier& b) {
    asm volatile("s_waitcnt vmcnt(0)" ::: "memory");
    __syncthreads();
    if (threadIdx.x == 0) {
        unsigned* bar = b.bar;
        __builtin_amdgcn_s_waitcnt(0);
        unsigned nloc = b.st[0], nx = b.st[1];
        if (nloc == 0u) { xcd_barrier_complete(bar, b.x, nloc, nx); b.st[0] = nloc; b.st[1] = nx; }
        const unsigned old = xb_add(&bar[XB_XSUB(b.x)], 1u);
        const unsigned gen = old / nloc;
        if (old + 1u == (gen + 1u) * nloc) {
            __builtin_amdgcn_fence(__ATOMIC_RELEASE, "agent");
            asm volatile("s_waitcnt vmcnt(0)" ::: "memory");
            const unsigned og = xb_add(&bar[XB_TOP], 1u);
            const unsigned tg = og / nx;
            if (og + 1u == (tg + 1u) * nx) xb_add(&bar[XB_TOPGEN], 1u);
            else XB_SPIN(xb_ld(&bar[XB_TOPGEN]) == tg, bar);
            __builtin_amdgcn_fence(__ATOMIC_ACQUIRE, "agent");
            xb_add(&bar[XB_XGEN(b.x)], 1u);
            asm volatile("s_waitcnt vmcnt(0)" ::: "memory");
        } else {
            XB_SPIN(xb_ld(&bar[XB_XGEN(b.x)]) == gen, bar);
            __builtin_amdgcn_fence(__ATOMIC_ACQUIRE, "agent");
            asm volatile("s_waitcnt vmcnt(0)" ::: "memory");
        }
    }
    __syncthreads();
}


__device__ __forceinline__ void gbar(unsigned* ctr, unsigned target) {
  asm volatile("s_waitcnt vmcnt(0)" ::: "memory");
  __syncthreads();
  if (tid_l() == 0) {
    __builtin_amdgcn_fence(__ATOMIC_RELEASE, "agent");
    asm volatile("s_waitcnt vmcnt(0)" ::: "memory");
    __hip_atomic_fetch_add(ctr, 1u, __ATOMIC_RELAXED, __HIP_MEMORY_SCOPE_AGENT);
    while (__hip_atomic_load(ctr, __ATOMIC_RELAXED, __HIP_MEMORY_SCOPE_AGENT) < target) __builtin_amdgcn_s_sleep(2);
    __builtin_amdgcn_fence(__ATOMIC_ACQUIRE, "agent");
    asm volatile("s_waitcnt vmcnt(0)" ::: "memory");
  }
  __syncthreads();
}
#define MFMA4(a, b, c) __builtin_amdgcn_mfma_f32_16x16x4f32((a), (b), (c), 0, 0, 0)

__device__ __forceinline__ float softplusf_(float x) { return fmaxf(x, 0.f) + log1pf(__expf(-fabsf(x))); }

__device__ __forceinline__ void gdn_chain(const Params& p, int l, int seq, int h, int d, int vs, float* sm) {
  float* sMM = sm;
  float* sK = sMM + 64 * 68;
  float* sW = sK + 64 * 65;
  float* sV = sW + 64 * 65;
  float* sS = sV + 64 * 33;
  float* sGc = sS + 64 * 33;
  float* sBeta = sGc + 64;
  float* sBg = sBeta + 64;
  const int tid = tid_l(), lane = tid & 63, w = tid >> 6, r16 = lane & 15, g4 = lane >> 4;
  const bool latent = seq >= 16;
  const int len = latent ? 4096 : 256;
  const int t0 = latent ? T_CTX + (seq - 16) * 4096 : seq * 256;
  const int nchunks = len >> 6;
  const float Acoef = -__expf(p.gdn_a_log[l * 8 + d * 4 + h]);
  const float dtb = p.gdn_dt_bias[l * 8 + d * 4 + h];
  f32x4 Sreg[2];
  __syncthreads();
  {
    const float* s0 = latent ? p.state_gdn + ((((size_t)(seq - 16) * 2 + l) * 2 + d) * 4 + h) * 4096 : nullptr;
#pragma unroll
    for (int n = 0; n < 2; ++n)
#pragma unroll
      for (int r = 0; r < 4; ++r) {
        const int kidx = 16 * w + g4 * 4 + r, cc = n * 16 + r16;
        float v = latent ? s0[kidx * 64 + vs * 32 + cc] : 0.f;
        Sreg[n][r] = v;
        sS[kidx * 33 + cc] = v;
      }
  }
  const u16* Pb = p.P + (size_t)t0 * PW;
  const u16* VHb = p.HQ + (size_t)T_ALL * 768 + (size_t)t0 * 256;
#define GDN_SRC(i, tl, tlo_) ({ const int e_ = (tl) + (i) * 256; const int u_ = e_ / 20, un_ = e_ % 20; \
    (un_ < 16) ? (Pb + (size_t)((tlo_) + u_) * PW + (un_ < 8 ? P_QH + h * 64 + un_ * 8 : P_KH + h * 64 + (un_ - 8) * 8)) \
               : (VHb + (size_t)((tlo_) + u_) * 256 + h * 64 + vs * 32 + (un_ - 16) * 8); })
  uint4 pf[5];
  float pga = 0.f, pgb = 0.f;
  {
    const int tlo = d == 0 ? 0 : len - 64;
#pragma unroll
    for (int i = 0; i < 5; ++i) pf[i] = *(const uint4*)GDN_SRC(i, tid, tlo);
    if (tid < 64) {
      const int u = d == 0 ? tid : 63 - tid;
      const float* gab = p.GAB + (size_t)(t0 + tlo + u) * 16;
      pga = gab[d * 4 + h]; pgb = gab[8 + d * 4 + h];
    }
  }
  for (int n = 0; n < nchunks; ++n) {
    const int tlo = d == 0 ? n * 64 : len - 64 * (n + 1);
    const int tl2 = tid_l();
#pragma unroll
    for (int i = 0; i < 5; ++i) {
      const int e = tl2 + i * 256;
      const int u = e / 20, un = e % 20;
      const int pp = d == 0 ? u : 63 - u;
      float* dq = un < 8 ? sW + pp * 65 + un * 8 : (un < 16 ? sK + pp * 65 + (un - 8) * 8 : sV + pp * 33 + (un - 16) * 8);
      const unsigned wv[4] = {pf[i].x, pf[i].y, pf[i].z, pf[i].w};
#pragma unroll
      for (int j = 0; j < 4; ++j) { dq[2 * j] = bf2f((u16)(wv[j] & 0xffff)); dq[2 * j + 1] = bf2f((u16)(wv[j] >> 16)); }
    }
    if (tid < 64) {
      const int pp = tid;
      float g = Acoef * softplusf_(pga + dtb);
      float bt = sigmoidf_(pgb);
#pragma unroll
      for (int o = 1; o < 64; o <<= 1) { float tt = __shfl_up(g, o); if (lane >= o) g += tt; }
      sGc[pp] = g; sBeta[pp] = bt; sBg[pp] = bt * __expf(g);
    }
    if (n + 1 < nchunks) {
      const int tlo2 = d == 0 ? (n + 1) * 64 : len - 64 * (n + 2);
#pragma unroll
      for (int i = 0; i < 5; ++i) pf[i] = *(const uint4*)GDN_SRC(i, tl2, tlo2);
      if (tid < 64) {
        const int u = d == 0 ? tid : 63 - tid;
        const float* gab = p.GAB + (size_t)(t0 + tlo2 + u) * 16;
        pga = gab[d * 4 + h]; pgb = gab[8 + d * 4 + h];
      }
    }
    __syncthreads();
    float qa[16];
#pragma unroll
    for (int s = 0; s < 16; ++s) qa[s] = sW[(16 * w + r16) * 65 + 4 * s + g4];
    const unsigned tcode = w == 0 ? 0x730u : (w == 1 ? 0xA51u : (w == 2 ? 0x062u : 0x0FBu));
    const int tcnt = w < 2 ? 3 : 2;
    f32x4 attacc[3];
#pragma unroll
    for (int t = 0; t < 3; ++t) {
      attacc[t] = f32x4{0.f, 0.f, 0.f, 0.f};
      if (t < tcnt) {
        const int ti = (tcode >> (4 * t)) & 3, tn = (tcode >> (4 * t + 2)) & 3;
        f32x4 accm = f32x4{0.f, 0.f, 0.f, 0.f};
        const float* ak = sK + (16 * ti + r16) * 65 + g4;
        const float* aq = sW + (16 * ti + r16) * 65 + g4;
        const float* bk = sK + (16 * tn + r16) * 65 + g4;
#pragma unroll
        for (int s = 0; s < 16; ++s) {
          const float bv = bk[4 * s];
          accm = MFMA4(ak[4 * s], bv, accm);
          attacc[t] = MFMA4(aq[4 * s], bv, attacc[t]);
        }
#pragma unroll
        for (int r = 0; r < 4; ++r) {
          const int i = 16 * ti + g4 * 4 + r, j = 16 * tn + r16;
          sMM[i * 68 + j] = (i > j) ? sBeta[i] * accm[r] * __expf(sGc[i] - sGc[j]) : 0.f;
        }
      }
    }
    __syncthreads();
    if (w == 0) {
      const int bi = tid >> 4, c = tid & 15;
      float* md = sMM + (16 * bi) * 68 + 16 * bi;
      float a[16];
#pragma unroll
      for (int r = 0; r < 16; ++r) a[r] = (r == c) ? 1.f : 0.f;
#pragma unroll
      for (int r = 1; r < 16; ++r) {
#pragma unroll
        for (int q4 = 0; q4 < (r + 3) / 4; ++q4) {
          const float4 m = *(const float4*)(md + r * 68 + 4 * q4);
          if (q4 * 4 + 0 < r) a[r] -= m.x * a[q4 * 4 + 0];
          if (q4 * 4 + 1 < r) a[r] -= m.y * a[q4 * 4 + 1];
          if (q4 * 4 + 2 < r) a[r] -= m.z * a[q4 * 4 + 2];
          if (q4 * 4 + 3 < r) a[r] -= m.w * a[q4 * 4 + 3];
        }
      }
      __builtin_amdgcn_fence(__ATOMIC_SEQ_CST, "wavefront");
#pragma unroll
      for (int r = 0; r < 16; ++r) md[r * 68 + c] = a[r];
    } else {
      for (int t = w - 1; t < 8; t += 3) {
        const int ti = t >> 1, tc = t & 1;
        const float bg = sBg[16 * ti + r16];
        const float* ak = sK + (16 * ti + r16) * 65 + g4;
        const float* bs = sS + g4 * 33 + 16 * tc + r16;
        f32x4 acc = f32x4{0.f, 0.f, 0.f, 0.f};
#pragma unroll
        for (int s = 0; s < 16; ++s) acc = MFMA4(ak[4 * s] * bg, bs[4 * s * 33], acc);
#pragma unroll
        for (int r = 0; r < 4; ++r) {
          const int i = 16 * ti + g4 * 4 + r, cc = 16 * tc + r16;
          sV[i * 33 + cc] = sV[i * 33 + cc] * sBeta[i] - acc[r];
        }
      }
    }
    __syncthreads();
    for (int ib = 0; ib < 4; ++ib) {
      if (w < 2) {
        const int ct = w;
        f32x4 acc = f32x4{0.f, 0.f, 0.f, 0.f};
        const float* am = sMM + (16 * ib + r16) * 68 + g4;
        const float* bx = sV + g4 * 33 + 16 * ct + r16;
        for (int s4 = 0; s4 < ib; ++s4) {
#pragma unroll
          for (int s = 0; s < 4; ++s) acc = MFMA4(am[16 * s4 + 4 * s], bx[(16 * s4 + 4 * s) * 33], acc);
        }
        f32x4 rm;
#pragma unroll
        for (int r = 0; r < 4; ++r) rm[r] = sV[(16 * ib + g4 * 4 + r) * 33 + 16 * ct + r16] - acc[r];
        const float* dd = sMM + (16 * ib + r16) * 68 + 16 * ib + 4 * g4;
        f32x4 xn = f32x4{0.f, 0.f, 0.f, 0.f};
#pragma unroll
        for (int s = 0; s < 4; ++s) xn = MFMA4(dd[s], rm[s], xn);
#pragma unroll
        for (int r = 0; r < 4; ++r) sV[(16 * ib + g4 * 4 + r) * 33 + 16 * ct + r16] = xn[r];
      }
      __syncthreads();
    }
#pragma unroll
    for (int t = 0; t < 3; ++t) {
      if (t < tcnt) {
        const int ti = (tcode >> (4 * t)) & 3, tn = (tcode >> (4 * t + 2)) & 3;
#pragma unroll
        for (int r = 0; r < 4; ++r) {
          const int i = 16 * ti + g4 * 4 + r, j = 16 * tn + r16;
          sMM[i * 68 + j] = (i >= j) ? attacc[t][r] * __expf(sGc[i] - sGc[j]) : 0.f;
        }
      }
    }
    __syncthreads();
    {
      f32x4 acc[2] = {f32x4{0.f, 0.f, 0.f, 0.f}, f32x4{0.f, 0.f, 0.f, 0.f}};
      const float eg = __expf(sGc[16 * w + r16]);
#pragma unroll
      for (int s = 0; s < 16; ++s) {
        const float a = qa[s] * eg;
        acc[0] = MFMA4(sS[(4 * s + g4) * 33 + r16], a, acc[0]);
        acc[1] = MFMA4(sS[(4 * s + g4) * 33 + 16 + r16], a, acc[1]);
      }
#pragma unroll
      for (int s = 0; s < 16; ++s) {
        if (s < 4 * (w + 1)) {
          const float a = sMM[(16 * w + r16) * 68 + 4 * s + g4];
          acc[0] = MFMA4(sV[(4 * s + g4) * 33 + r16], a, acc[0]);
          acc[1] = MFMA4(sV[(4 * s + g4) * 33 + 16 + r16], a, acc[1]);
        }
      }
      {
        const int pp = 16 * w + r16;
        const int u = d == 0 ? pp : 63 - pp;
        u16* op = p.MIX + (size_t)(t0 + tlo + u) * 1024 + d * 256 + h * 64 + vs * 32 + g4 * 4;
        *(uint2*)(op) = pack4(acc[0]);
        *(uint2*)(op + 16) = pack4(acc[1]);
      }
    }
    __syncthreads();
    {
      const float g63 = sGc[63];
      const float gl = __expf(g63);
#pragma unroll
      for (int nn = 0; nn < 2; ++nn)
#pragma unroll
        for (int r = 0; r < 4; ++r) Sreg[nn][r] *= gl;
#pragma unroll
      for (int s = 0; s < 16; ++s) {
        const int srow = 4 * s + g4;
        const float a = sK[srow * 65 + 16 * w + r16] * __expf(g63 - sGc[srow]);
        Sreg[0] = MFMA4(a, sV[srow * 33 + r16], Sreg[0]);
        Sreg[1] = MFMA4(a, sV[srow * 33 + 16 + r16], Sreg[1]);
      }
    }
    __syncthreads();
#pragma unroll
    for (int nn = 0; nn < 2; ++nn)
#pragma unroll
      for (int r = 0; r < 4; ++r) sS[(16 * w + g4 * 4 + r) * 33 + nn * 16 + r16] = Sreg[nn][r];
    __syncthreads();
  }
  if (!latent) {
    float* so = p.out + OUT_SGDN + ((((size_t)seq * 2 + l) * 2 + d) * 4 + h) * 4096;
#pragma unroll
    for (int nn = 0; nn < 2; ++nn)
#pragma unroll
      for (int r = 0; r < 4; ++r) so[(16 * w + g4 * 4 + r) * 64 + vs * 32 + nn * 16 + r16] = Sreg[nn][r];
  }
}

__device__ __forceinline__ void hgrn_chain(const Params& p, int l, int seq, int h, int d, int vs, float* sm) {
  float* sBC = sm;
  float* sK = sBC + 64 * 65;
  float* sAT = sK + 64 * 65;
  float* sV = sAT + 64 * 68;
  float* sS = sV + 64 * 33;
  float* sTot = sS + 64 * 33;
  const int tid = tid_l(), lane = tid & 63, w = tid >> 6, r16 = lane & 15, g4 = lane >> 4;
  const bool latent = seq >= 16;
  const int len = latent ? 4096 : 256;
  const int t0 = latent ? T_CTX + (seq - 16) * 4096 : seq * 256;
  const int nchunks = len >> 6;
  float lbk;
  {
    const int kch = h * 64 + (tid & 63);
    lbk = (l == 0) ? 0.f : sigmoidf_(p.hgrn_lb[256 + kch] - p.hgrn_lb[kch]);
  }
  f32x4 Sreg[2];
  __syncthreads();
  {
    const float* s0 = latent ? p.state_hgrn + ((((size_t)(seq - 16) * 2 + l) * 2 + d) * 4 + h) * 4096 : nullptr;
#pragma unroll
    for (int n = 0; n < 2; ++n)
#pragma unroll
      for (int r = 0; r < 4; ++r) {
        const int kidx = 16 * w + g4 * 4 + r, cc = n * 16 + r16;
        float v = latent ? s0[kidx * 64 + vs * 32 + cc] : 0.f;
        Sreg[n][r] = v;
        sS[kidx * 33 + cc] = v;
      }
  }
  const u16* Pb = p.P + (size_t)t0 * PW;
  float* sLb = sTot + 256;
  if (tid < 64) sLb[tid] = lbk;
  __syncthreads();
  int pgo[5];
#pragma unroll
  for (int i = 0; i < 5; ++i) {
    const int e = tid + i * 256;
    const int u = e / 20, un = e % 20;
    pgo[i] = u * PW + (un < 8 ? P_HF + d * 256 + h * 64 + un * 8 : (un < 12 ? P_HI + h * 64 + vs * 32 + (un - 8) * 8 : P_HQ + h * 64 + (un - 12) * 8));
  }
  uint4 pf[5];
  {
    const int tlo = d == 0 ? 0 : len - 64;
#pragma unroll
    for (int i = 0; i < 5; ++i) pf[i] = *(const uint4*)(Pb + (size_t)tlo * PW + pgo[i]);
  }
  for (int n = 0; n < nchunks; ++n) {
#pragma unroll
    for (int i = 0; i < 5; ++i) {
      const int e = tid + i * 256;
      const int u = e / 20, un = e % 20;
      const int pp = d == 0 ? u : 63 - u;
      const unsigned wv[4] = {pf[i].x, pf[i].y, pf[i].z, pf[i].w};
#pragma unroll
      for (int j = 0; j < 8; ++j) {
        const float x = bf2f((u16)((wv[j >> 1] >> ((j & 1) * 16)) & 0xffff));
        if (un < 8) {
          const int k = un * 8 + j;
          const float lb = sLb[k];
          const float sg_ = sigmoidf_(x);
          const float gate = lb + (1.f - lb) * sg_;
          sBC[pp * 65 + k] = __logf(fmaxf(gate, 1e-30f));
          sK[pp * 65 + k] = (1.f - lb) * (1.f - sg_);
        } else if (un < 12) {
          sV[pp * 33 + (un - 8) * 8 + j] = x;
        } else {
          sAT[pp * 68 + (un - 12) * 8 + j] = x;
        }
      }
    }
    __syncthreads();
    if (n + 1 < nchunks) {
      const int tlo2 = d == 0 ? (n + 1) * 64 : len - 64 * (n + 2);
#pragma unroll
      for (int i = 0; i < 5; ++i) pf[i] = *(const uint4*)(Pb + (size_t)tlo2 * PW + pgo[i]);
    }
    const int tlo = d == 0 ? n * 64 : len - 64 * (n + 1);
    float cs[16];
    {
      const int k = tid & 63, sg = tid >> 6;
      float run = 0.f;
#pragma unroll
      for (int i = 0; i < 16; ++i) { run += sBC[(16 * sg + i) * 65 + k]; cs[i] = run; }
      sTot[sg * 64 + k] = run;
    }
    float qa[16];
#pragma unroll
    for (int s = 0; s < 16; ++s) qa[s] = sAT[(16 * w + r16) * 68 + 4 * s + g4];
    __syncthreads();
    {
      const int k = tid & 63, sg = tid >> 6;
      float off = 0.f;
      for (int s2 = 0; s2 < sg; ++s2) off += sTot[s2 * 64 + k];
#pragma unroll
      for (int i = 0; i < 16; ++i) sBC[(16 * sg + i) * 65 + k] = cs[i] + off;
    }
    __syncthreads();
    {
      float aq[16], rf[16];
#pragma unroll
      for (int s = 0; s < 16; ++s) {
        const int kk = 4 * s + g4;
        rf[s] = (w == 0) ? 0.f : sBC[(16 * w - 1) * 65 + kk];
        aq[s] = qa[s] * __expf(sBC[(16 * w + r16) * 65 + kk] - rf[s]);
      }
#pragma unroll
      for (int nn = 0; nn < 4; ++nn) {
        f32x4 acc = f32x4{0.f, 0.f, 0.f, 0.f};
        if (nn <= w) {
#pragma unroll
          for (int s = 0; s < 16; ++s) {
            const int kk = 4 * s + g4, sc = 16 * nn + r16;
            const float bv = sK[sc * 65 + kk] * __expf(fminf(rf[s] - sBC[sc * 65 + kk], 80.f));
            acc = MFMA4(aq[s], bv, acc);
          }
        }
#pragma unroll
        for (int r = 0; r < 4; ++r) {
          const int i = 16 * w + g4 * 4 + r, j = 16 * nn + r16;
          sAT[i * 68 + j] = (i >= j) ? acc[r] : 0.f;
        }
      }
    }
    __syncthreads();
    {
      f32x4 acc[2] = {f32x4{0.f, 0.f, 0.f, 0.f}, f32x4{0.f, 0.f, 0.f, 0.f}};
#pragma unroll
      for (int s = 0; s < 16; ++s) {
        const int kk = 4 * s + g4;
        const float a = qa[s] * __expf(sBC[(16 * w + r16) * 65 + kk]);
        acc[0] = MFMA4(sS[kk * 33 + r16], a, acc[0]);
        acc[1] = MFMA4(sS[kk * 33 + 16 + r16], a, acc[1]);
      }
#pragma unroll
      for (int s = 0; s < 16; ++s) {
        if (s < 4 * (w + 1)) {
          const float a = sAT[(16 * w + r16) * 68 + 4 * s + g4];
          acc[0] = MFMA4(sV[(4 * s + g4) * 33 + r16], a, acc[0]);
          acc[1] = MFMA4(sV[(4 * s + g4) * 33 + 16 + r16], a, acc[1]);
        }
      }
      {
        const int pp = 16 * w + r16;
        const int u = d == 0 ? pp : 63 - pp;
        u16* op = p.MIX + (size_t)(t0 + tlo + u) * 1024 + 512 + d * 256 + h * 64 + vs * 32 + g4 * 4;
        *(uint2*)(op) = pack4(acc[0]);
        *(uint2*)(op + 16) = pack4(acc[1]);
      }
    }
    __syncthreads();
    {
#pragma unroll
      for (int nn = 0; nn < 2; ++nn)
#pragma unroll
        for (int r = 0; r < 4; ++r) Sreg[nn][r] *= __expf(sBC[63 * 65 + 16 * w + g4 * 4 + r]);
      const int kA = 16 * w + r16;
      const float blA = sBC[63 * 65 + kA];
#pragma unroll
      for (int s = 0; s < 16; ++s) {
        const int srow = 4 * s + g4;
        const float a = sK[srow * 65 + kA] * __expf(blA - sBC[srow * 65 + kA]);
        Sreg[0] = MFMA4(a, sV[srow * 33 + r16], Sreg[0]);
        Sreg[1] = MFMA4(a, sV[srow * 33 + 16 + r16], Sreg[1]);
      }
    }
    __syncthreads();
#pragma unroll
    for (int nn = 0; nn < 2; ++nn)
#pragma unroll
      for (int r = 0; r < 4; ++r) sS[(16 * w + g4 * 4 + r) * 33 + nn * 16 + r16] = Sreg[nn][r];
    __syncthreads();
  }
  if (!latent) {
    float* so = p.out + OUT_SHG + ((((size_t)seq * 2 + l) * 2 + d) * 4 + h) * 4096;
#pragma unroll
    for (int nn = 0; nn < 2; ++nn)
#pragma unroll
      for (int r = 0; r < 4; ++r) so[(16 * w + g4 * 4 + r) * 64 + vs * 32 + nn * 16 + r16] = Sreg[nn][r];
  }
}

__device__ __forceinline__ void phase_c(const Params& p, int l, unsigned char* smraw, int mode = 0) {
  __shared__ int s_item;
  const int total = 1920;
  const bool paired = (gridDim.x == 512);
  const int jx = blockIdx.x >> 3;
  int my_static = -1;
  if (paired && (jx & 31) < 16) my_static = (blockIdx.x & 7) * 32 + (jx >> 5) * 16 + (jx & 15);
  for (;;) {
    __syncthreads();
    if (tid_l() == 0) {
      if (my_static >= 0) s_item = my_static;
      else s_item = (paired ? 256 : 0) + (int)atomicAdd(&p.counters[l * 64 + mode * 16], 1u);
    }
    __syncthreads();
    my_static = -1;
    const int item = s_item;
    if (item >= total) break;
    int kind, a0, a1, a2, a3;
    if (item < 256 || (item >= 1280 && item < 1792)) {
      const int i2 = item < 256 ? item : item - 1280;
      const int rest = i2 >> 1;
      kind = i2 & 1;
      a3 = rest & 1; a2 = (rest >> 1) & 1; a1 = (rest >> 2) & 3; a0 = (rest >> 4) + (item < 256 ? 16 : 0);
    } else if (item < 1280) {
      const int i2 = item - 256;
      kind = 2; a0 = 1; a1 = i2 >> 7; a2 = (i2 >> 5) & 3; a3 = i2 & 31;
    } else {
      const int i2 = item - 1792;
      kind = 2; a0 = 0; a1 = i2 >> 3; a2 = (i2 >> 1) & 3; a3 = i2 & 1;
    }
    if (mode == 1 && kind == 2) continue;
    if (mode == 2 && kind != 2) continue;
    if (kind != 2) __builtin_amdgcn_s_setprio(3);
    if (kind == 0) gdn_chain(p, l, a0, a1, a2, a3, (float*)smraw);
    else if (kind == 1) hgrn_chain(p, l, a0, a1, a2, a3, (float*)smraw);
    if (kind != 2) __builtin_amdgcn_s_setprio(0);
    else attn_item(p, a0, a1, a2, a3, smraw, mode == 2);
  }
}

__global__ void __launch_bounds__(NTHR, 2) mega(Params p) {
  __shared__ __attribute__((aligned(16))) unsigned char smem[LDS_BYTES];
  cg::grid_group grid = cg::this_grid();
  __shared__ uint4 xb_words;
  if (threadIdx.x == 0) xb_words = make_uint4(0u, 0u, 0u, 0u);
  __syncthreads();
  {
    XcdBarrier xb0 = xcd_barrier_post(p.xbar, (volatile LAS unsigned*)&xb_words);
    if (threadIdx.x == 0) ((volatile LAS unsigned*)&xb_words)[2] = xb0.x;
  }
#define GSYNC() do { XcdBarrier xb_; xb_.bar = p.xbar; xb_.st = (volatile LAS unsigned*)&xb_words; xb_.x = 0; \
    if (threadIdx.x == 0) xb_.x = ((volatile LAS unsigned*)&xb_words)[2]; xcd_barrier(xb_); } while (0)
  phase0(p, (float*)smem);
  if (p.out == nullptr) grid.sync();
  GSYNC();
  rowpass_norm(p, 0, 0);
  GSYNC();
  for (int l = 0; l < 2; ++l) {
    phase_a(p, l, (u16*)smem);
    GSYNC();
    rowpass_b0(p, l);
    GSYNC();
    phase_b1(p, l, (u16*)smem);
    GSYNC();
    rowpass_b2(p, l);
    GSYNC();
    phase_c(p, l, smem);
    GSYNC();
    rowpass_c2(p, l);
    GSYNC();
    phase_gemm_y(p.MIX, 1024, p.WoutT + (size_t)l * 1024 * 1024, 1024, 1024, p.HQ, 1024, (u16*)smem);
    GSYNC();
    rowpass_norm(p, l, 1);
    GSYNC();
    phase_e(p, l, (u16*)smem);
    GSYNC();
    phase_gemm_y(p.P, DFF, p.WfoT + (size_t)l * 1024 * DFF, DFF, 1024, p.HQ, 1024, (u16*)smem);
    GSYNC();
    rowpass_norm(p, l, 2);
    if (l == 0) GSYNC();
  }
}

extern "C" void kernel_launch(void* const* d_in, const int* in_sizes, int n_in, void* d_out, int out_size, void* d_ws,
                              size_t ws_size, hipStream_t stream) {
  static int grid_blocks = 0;
  if (!grid_blocks) {
    int dev = 0, cus = 0, per_cu = 0;
    hipGetDevice(&dev);
    hipDeviceGetAttribute(&cus, hipDeviceAttributeMultiprocessorCount, dev);
    hipOccupancyMaxActiveBlocksPerMultiprocessor(&per_cu, mega, NTHR, 0);
    if (per_cu > 2) per_cu = 2;
    if (per_cu < 1) per_cu = 1;
    grid_blocks = cus * per_cu;
  }
  Params p{};
  const float* const* in = (const float* const*)d_in;
  p.x_prompt = in[0]; p.x_sample = in[1]; p.cache_ckv = in[2]; p.cache_kr = in[3]; p.state_gdn = in[4]; p.state_hgrn = in[5];
  p.c = in[6]; p.c_ctx = in[7]; p.w_ada = in[8]; p.b_ada = in[9]; p.g_pre_mix = in[10]; p.g_post_mix = in[11];
  p.g_pre_ffn = in[12]; p.g_post_ffn = in[13]; p.w_in = in[14]; p.w_out = in[15]; p.gdn_conv_w = in[16];
  p.gdn_a_log = in[17]; p.gdn_dt_bias = in[18]; p.gdn_norm_w = in[19]; p.hgrn_lb = in[20]; p.hgrn_norm_w = in[21];
  p.mla_q_norm_w = in[22]; p.mla_w_uq = in[23]; p.mla_kv_norm_w = in[24]; p.mla_w_ukv = in[25]; p.w_ffn_in = in[26];
  p.w_ffn_out = in[27];
  p.out = (float*)d_out;
  unsigned char* ws = (unsigned char*)d_ws;
  size_t off = 0;
  auto take = [&](size_t bytes) { unsigned char* r = ws + off; off += (bytes + 255) & ~(size_t)255; return r; };
  p.counters = (unsigned*)take(1024);
  p.xbar = (unsigned*)take(16384);
  p.WinT = (u16*)take((size_t)2 * 3072 * 1024 * 2);
  p.WuqT = (u16*)take((size_t)2 * 768 * 384 * 2);
  p.WukvT = (u16*)take((size_t)2 * 1024 * 256 * 2);
  p.WoutT = (u16*)take((size_t)2 * 1024 * 1024 * 2);
  p.WfiT = (u16*)take((size_t)2 * 5632 * 1024 * 2);
  p.WfoT = (u16*)take((size_t)2 * 1024 * 2816 * 2);
  p.mod = (float*)take((size_t)2 * 9 * 6144 * 4);
  p.HQ = (u16*)take((size_t)T_ALL * 1024 * 2);
  p.P = (u16*)take((size_t)T_ALL * PW * 2);
  p.KN = (u16*)take((size_t)(T_ALL + 2048) * 512 * 2);
  p.VTL = (u16*)take((size_t)8 * 4 * 128 * 4352 * 2);
  p.VTC = (u16*)take((size_t)16 * 4 * 128 * 256 * 2);
  p.CKVC = (u16*)take((size_t)2048 * 256 * 2);
  p.KRC = (u16*)take((size_t)2048 * 64 * 2);
  p.GAB = (float*)take((size_t)T_ALL * 16 * 4);
  p.MIX = (u16*)take((size_t)T_ALL * 1024 * 2);
  if (off > ws_size) { fprintf(stderr, "workspace too small: need %zu have %zu\n", off, ws_size); return; }
  hipMemsetAsync(p.counters, 0, 1024 + 16384, stream);
  void* args[] = {&p};
  hipError_t e = hipLaunchCooperativeKernel((void*)mega, dim3(grid_blocks), dim3(NTHR), args, 0, stream);
  if (e != hipSuccess) fprintf(stderr, "cooperative launch failed: %s (grid %d)\n", hipGetErrorString(e), grid_blocks);
}
```

```cpp
#include <hip/hip_runtime.h>
#include <hip/hip_cooperative_groups.h>
#include <cstdio>
namespace cg = cooperative_groups;

typedef unsigned short u16;
using bf16x8 = __attribute__((ext_vector_type(8))) short;
using f32x4  = __attribute__((ext_vector_type(4))) float;

#define T_CTX 4096
#define T_ALL 36864
#define PW 3072
#define DFF 2816
#define LDS_BYTES 73728
#define NTHR 256

#define P_GQKV 0
#define P_GZ 768
#define P_HQ 1024
#define P_HI 1280
#define P_HF 1536
#define P_HG 2048
#define P_MCQ 2304
#define P_MCKV 2688
#define P_MKR 2944
#define P_GA 3008

struct Params {
  const float *x_prompt, *x_sample, *cache_ckv, *cache_kr, *state_gdn, *state_hgrn, *c, *c_ctx;
  const float *w_ada, *b_ada, *g_pre_mix, *g_post_mix, *g_pre_ffn, *g_post_ffn, *w_in, *w_out;
  const float *gdn_conv_w, *gdn_a_log, *gdn_dt_bias, *gdn_norm_w, *hgrn_lb, *hgrn_norm_w;
  const float *mla_q_norm_w, *mla_w_uq, *mla_kv_norm_w, *mla_w_ukv, *w_ffn_in, *w_ffn_out;
  float* out;
  u16 *WinT, *WuqT, *WukvT, *WoutT, *WfiT, *WfoT;
  float* mod;
  u16 *HQ, *P, *KN, *VTL, *VTC, *CKVC, *KRC, *MIX;
  float* GAB;
  unsigned* counters;
  unsigned* xbar;
};

#define OUT_CKV   37748736
#define OUT_KR    39845888
#define OUT_SGDN  40370176
#define OUT_SHG   41418752

__device__ __forceinline__ u16 f2bf(float f) {
  unsigned u = __float_as_uint(f);
  u += 0x7fffu + ((u >> 16) & 1u);
  return (u16)(u >> 16);
}
__device__ __forceinline__ float bf2f(u16 h) { return __uint_as_float(((unsigned)h) << 16); }
__device__ __forceinline__ float wave_sum(float v) {
#pragma unroll
  for (int o = 32; o > 0; o >>= 1) v += __shfl_xor(v, o);
  return v;
}
__device__ __forceinline__ float sigmoidf_(float x) { return __builtin_amdgcn_rcpf(1.f + __expf(-x)); }
__device__ __forceinline__ float siluf_(float x) { return x * __builtin_amdgcn_rcpf(1.f + __expf(-x)); }
__device__ __forceinline__ int tid_l() { int t = threadIdx.x; asm volatile("" : "+v"(t)); return t; }
__device__ __forceinline__ int tok_mod(int t) { return t < T_CTX ? 0 : 1 + ((t - T_CTX) >> 12); }

__device__ __forceinline__ int map_col(int kind, int j) {
  if (kind == 0) return j;
  if (kind == 1) { if (j < 1024) return j; if (j < 3008) return j + 16; if (j < 3024) return 1024 + (j - 3008); return -1; }
  int blk = j >> 6, w = j & 63;
  return w < 32 ? blk * 32 + w : DFF + blk * 32 + (w - 32);
}

__device__ __forceinline__ void cvt_tile(const float* __restrict__ src, int K, int Nsrc, u16* __restrict__ dst, int kind, int jt, int kt, float* sm) {
  const int tid = tid_l();
  const int j0 = jt * 64, k0 = kt * 64;
  __syncthreads();
  {
    int jj = tid & 63, kk0 = tid >> 6;
    int sc = map_col(kind, j0 + jj);
    for (int kk = kk0; kk < 64; kk += 4)
      sm[kk * 65 + jj] = sc >= 0 ? src[(size_t)(k0 + kk) * Nsrc + sc] : 0.f;
  }
  __syncthreads();
  {
    const int kq = tid & 15, jj0 = tid >> 4;
#pragma unroll
    for (int jj = jj0; jj < 64; jj += 16) {
      uint2 o;
      o.x = (unsigned)f2bf(sm[(4 * kq + 0) * 65 + jj]) | ((unsigned)f2bf(sm[(4 * kq + 1) * 65 + jj]) << 16);
      o.y = (unsigned)f2bf(sm[(4 * kq + 2) * 65 + jj]) | ((unsigned)f2bf(sm[(4 * kq + 3) * 65 + jj]) << 16);
      *(uint2*)(dst + (size_t)(j0 + jj) * K + k0 + 4 * kq) = o;
    }
  }
}

__device__ __forceinline__ void mod_item(const Params& p, int item, float* sm) {
  const int l = item / 96, j0 = (item % 96) * 64;
  const int tid = tid_l();
  float* sC = sm;
  float* sR = sm + 9 * 1024;
  __syncthreads();
  for (int i = tid; i < 9 * 1024; i += NTHR) {
    int m = i >> 10, k = i & 1023;
    float v = m == 0 ? p.c_ctx[k] : p.c[(m - 1) * 1024 + k];
    sC[i] = siluf_(v);
  }
  __syncthreads();
  const int col = tid & 63, ks = tid >> 6;
  float acc[9];
#pragma unroll
  for (int m = 0; m < 9; ++m) acc[m] = 0.f;
  const float* wp = p.w_ada + (size_t)l * 1024 * 6144 + j0 + col;
  for (int k = ks * 256; k < ks * 256 + 256; k += 8) {
    float wv[8];
#pragma unroll
    for (int u = 0; u < 8; ++u) wv[u] = wp[(size_t)(k + u) * 6144];
#pragma unroll
    for (int u = 0; u < 8; ++u)
#pragma unroll
      for (int m = 0; m < 9; ++m) acc[m] += sC[m * 1024 + k + u] * wv[u];
  }
#pragma unroll
  for (int m = 0; m < 9; ++m) sR[(ks * 9 + m) * 64 + col] = acc[m];
  __syncthreads();
  for (int i = tid; i < 9 * 64; i += NTHR) {
    int m = i >> 6, cc = i & 63;
    float v = sR[(0 * 9 + m) * 64 + cc] + sR[(1 * 9 + m) * 64 + cc] + sR[(2 * 9 + m) * 64 + cc] + sR[(3 * 9 + m) * 64 + cc];
    p.mod[((size_t)l * 9 + m) * 6144 + j0 + cc] = v + p.b_ada[l * 6144 + j0 + cc];
  }
}

__device__ __forceinline__ void phase0(const Params& p, float* sm) {
  const int PER_LAYER = 3272;
  const int total = 2 * PER_LAYER + 192;
  for (int item = blockIdx.x; item < total; item += gridDim.x) {
    if (item < 192) { mod_item(p, item, sm); continue; }
    int it = item - 192;
    int l = it / PER_LAYER, r = it % PER_LAYER;
    if (r < 768) { cvt_tile(p.w_in + (size_t)l * 1024 * 3024, 1024, 3024, p.WinT + (size_t)l * 3072 * 1024, 1, r / 16, r % 16, sm); continue; }
    r -= 768;
    if (r < 72) { cvt_tile(p.mla_w_uq + (size_t)l * 384 * 768, 384, 768, p.WuqT + (size_t)l * 768 * 384, 0, r / 6, r % 6, sm); continue; }
    r -= 72;
    if (r < 64) { cvt_tile(p.mla_w_ukv + (size_t)l * 256 * 1024, 256, 1024, p.WukvT + (size_t)l * 1024 * 256, 0, r / 4, r % 4, sm); continue; }
    r -= 64;
    if (r < 256) { cvt_tile(p.w_out + (size_t)l * 1024 * 1024, 1024, 1024, p.WoutT + (size_t)l * 1024 * 1024, 0, r / 16, r % 16, sm); continue; }
    r -= 256;
    if (r < 1408) { cvt_tile(p.w_ffn_in + (size_t)l * 1024 * 5632, 1024, 5632, p.WfiT + (size_t)l * 5632 * 1024, 2, r / 16, r % 16, sm); continue; }
    r -= 1408;
    cvt_tile(p.w_ffn_out + (size_t)l * 2816 * 1024, 2816, 1024, p.WfoT + (size_t)l * 1024 * 2816, 0, r / 44, r % 44, sm);
  }
}

__device__ __forceinline__ void rowpass_norm(const Params& p, int l, int stage) {
  const int tidl = tid_l();
  const int lane = tidl & 63, w = tidl >> 6;
  const int ln = stage == 0 ? 0 : (stage == 1 ? l : l + 1);
  const int sh_off = stage == 1 ? 3072 : 0;
  const float* gpre = stage == 1 ? p.g_pre_ffn + l * 1024 : p.g_pre_mix + (ln < 2 ? ln : 0) * 1024;
  u16* dst = stage == 1 ? p.MIX : p.HQ;
  for (int t = blockIdx.x * 4 + w; t < T_ALL; t += gridDim.x * 4) {
    const int m = tok_mod(t);
    float x[16];
    float* xo = p.out + (size_t)t * 1024;
    if (stage == 0) {
      const float* xi = t < T_CTX ? p.x_prompt + (size_t)t * 1024 : p.x_sample + (size_t)(t - T_CTX) * 1024;
#pragma unroll
      for (int i = 0; i < 4; ++i) {
        float4 v = *(const float4*)(xi + i * 256 + lane * 4);
        x[i * 4 + 0] = v.x; x[i * 4 + 1] = v.y; x[i * 4 + 2] = v.z; x[i * 4 + 3] = v.w;
      }
    } else {
      const u16* yp = p.HQ + (size_t)t * 1024;
      float y[16]; float ss = 0.f;
#pragma unroll
      for (int i = 0; i < 4; ++i) {
        uint2 v = *(const uint2*)(yp + i * 256 + lane * 4);
        y[i * 4 + 0] = bf2f((u16)(v.x & 0xffff)); y[i * 4 + 1] = bf2f((u16)(v.x >> 16));
        y[i * 4 + 2] = bf2f((u16)(v.y & 0xffff)); y[i * 4 + 3] = bf2f((u16)(v.y >> 16));
      }
#pragma unroll
      for (int i = 0; i < 16; ++i) ss += y[i] * y[i];
      ss = wave_sum(ss);
      const float rstd = rsqrtf(ss * (1.f / 1024.f) + 1e-6f);
      const float* gpost = (stage == 1 ? p.g_post_mix : p.g_post_ffn) + l * 1024;
      const float* gt = p.mod + ((size_t)l * 9 + m) * 6144 + (stage == 1 ? 2048 : 5120);
#pragma unroll
      for (int i = 0; i < 4; ++i) {
        float4 xv = *(const float4*)(xo + i * 256 + lane * 4);
        float4 gp = *(const float4*)(gpost + i * 256 + lane * 4);
        float4 gg = *(const float4*)(gt + i * 256 + lane * 4);
        x[i * 4 + 0] = xv.x + gg.x * y[i * 4 + 0] * rstd * gp.x;
        x[i * 4 + 1] = xv.y + gg.y * y[i * 4 + 1] * rstd * gp.y;
        x[i * 4 + 2] = xv.z + gg.z * y[i * 4 + 2] * rstd * gp.z;
        x[i * 4 + 3] = xv.w + gg.w * y[i * 4 + 3] * rstd * gp.w;
      }
    }
    __threadfence_block();
#pragma unroll
    for (int i = 0; i < 4; ++i)
      *(float4*)(xo + i * 256 + lane * 4) = make_float4(x[i * 4 + 0], x[i * 4 + 1], x[i * 4 + 2], x[i * 4 + 3]);
    if (ln >= 2) continue;
    float ss = 0.f;
#pragma unroll
    for (int i = 0; i < 16; ++i) ss += x[i] * x[i];
    ss = wave_sum(ss);
    const float rstd = rsqrtf(ss * (1.f / 1024.f) + 1e-6f);
    const float* sh = p.mod + ((size_t)ln * 9 + m) * 6144 + sh_off;
    const float* sc = sh + 1024;
    u16* hp = dst + (size_t)t * 1024;
#pragma unroll
    for (int i = 0; i < 4; ++i) {
      float4 gp = *(const float4*)(gpre + i * 256 + lane * 4);
      float4 s1 = *(const float4*)(sh + i * 256 + lane * 4);
      float4 c1 = *(const float4*)(sc + i * 256 + lane * 4);
      float h0 = x[i * 4 + 0] * rstd * gp.x * (1.f + c1.x) + s1.x;
      float h1 = x[i * 4 + 1] * rstd * gp.y * (1.f + c1.y) + s1.y;
      float h2 = x[i * 4 + 2] * rstd * gp.z * (1.f + c1.z) + s1.z;
      float h3 = x[i * 4 + 3] * rstd * gp.w * (1.f + c1.w) + s1.w;
      uint2 o;
      o.x = (unsigned)f2bf(h0) | ((unsigned)f2bf(h1) << 16);
      o.y = (unsigned)f2bf(h2) | ((unsigned)f2bf(h3) << 16);
      *(uint2*)(hp + i * 256 + lane * 4) = o;
    }
  }
}

__device__ __forceinline__ void unpack8(const uint4 v, float (&f)[8]);
__device__ __forceinline__ uint4 pack8(const float (&f)[8]);
__device__ __forceinline__ void rowpass_b0(const Params& p, int l) {
  const int tidl = tid_l();
  const int lane = tidl & 63, w = tidl >> 6;
  for (int t = blockIdx.x * 4 + w; t < T_ALL + 2048; t += gridDim.x * 4) {
    if (t >= T_ALL) {
      const int r = t - T_ALL, b = r >> 8, s = r & 255;
      if (lane < 32) {
        const float* ck = p.cache_ckv + (((size_t)b * 2 + l) * 256 + s) * 256 + lane * 8;
        const float4 x0 = *(const float4*)ck, x1 = *(const float4*)(ck + 4);
        const float f[8] = {x0.x, x0.y, x0.z, x0.w, x1.x, x1.y, x1.z, x1.w};
        *(uint4*)(p.CKVC + (size_t)r * 256 + lane * 8) = pack8(f);
      } else if (lane < 40) {
        const float* kr = p.cache_kr + (((size_t)b * 2 + l) * 256 + s) * 64 + (lane - 32) * 8;
        const float4 x0 = *(const float4*)kr, x1 = *(const float4*)(kr + 4);
        const float f[8] = {x0.x, x0.y, x0.z, x0.w, x1.x, x1.y, x1.z, x1.w};
        *(uint4*)(p.KRC + (size_t)r * 64 + (lane - 32) * 8) = pack8(f);
      }
      continue;
    }
    u16* pr = p.P + (size_t)t * PW;
    {
      float f[8]; float ss = 0.f;
      if (lane < 48) {
        unpack8(*(const uint4*)(pr + P_MCQ + lane * 8), f);
#pragma unroll
        for (int i = 0; i < 8; ++i) ss += f[i] * f[i];
      }
      ss = wave_sum(ss);
      const float rstd = rsqrtf(ss * (1.f / 384.f) + 1e-6f);
      if (lane < 48) {
        const float* wq = p.mla_q_norm_w + l * 384 + lane * 8;
        const float4 w0 = *(const float4*)wq, w1 = *(const float4*)(wq + 4);
        f[0] *= rstd * w0.x; f[1] *= rstd * w0.y; f[2] *= rstd * w0.z; f[3] *= rstd * w0.w;
        f[4] *= rstd * w1.x; f[5] *= rstd * w1.y; f[6] *= rstd * w1.z; f[7] *= rstd * w1.w;
        *(uint4*)(pr + P_MCQ + lane * 8) = pack8(f);
      }
    }
    {
      float f[8]; float ss = 0.f;
      if (lane < 32) {
        unpack8(*(const uint4*)(pr + P_MCKV + lane * 8), f);
#pragma unroll
        for (int i = 0; i < 8; ++i) ss += f[i] * f[i];
      }
      ss = wave_sum(ss);
      const float rstd = rsqrtf(ss * (1.f / 256.f) + 1e-6f);
      if (lane < 32) {
        const float* wk = p.mla_kv_norm_w + l * 256 + lane * 8;
        const float4 w0 = *(const float4*)wk, w1 = *(const float4*)(wk + 4);
        f[0] *= rstd * w0.x; f[1] *= rstd * w0.y; f[2] *= rstd * w0.z; f[3] *= rstd * w0.w;
        f[4] *= rstd * w1.x; f[5] *= rstd * w1.y; f[6] *= rstd * w1.z; f[7] *= rstd * w1.w;
        *(uint4*)(pr + P_MCKV + lane * 8) = pack8(f);
        if (t < T_CTX) {
          const int b = t >> 8, s = t & 255;
          float* op = p.out + OUT_CKV + (((size_t)b * 2 + l) * 256 + s) * 256 + lane * 8;
          *(float4*)op = make_float4(f[0], f[1], f[2], f[3]);
          *(float4*)(op + 4) = make_float4(f[4], f[5], f[6], f[7]);
        }
      }
    }
    {
      float v = bf2f(pr[P_MKR + lane]);
      if (t < T_CTX) {
        int b = t >> 8, s = t & 255;
        p.out[OUT_KR + (((size_t)b * 2 + l) * 256 + s) * 64 + lane] = v;
      } else {
        int pos = (t - T_CTX) & 4095;
        int axis = lane >> 5, half = (lane >> 4) & 1, f = lane & 15;
        float posf = axis == 0 ? (float)(pos >> 6) : (float)(pos & 63);
        float inv = exp2f(-(float)f * (13.287712379549449f / 16.f));
        float ang = posf * inv;
        float sn, cs;
        __sincosf(ang, &sn, &cs);
        float other = __shfl_xor(v, 16);
        float o = half == 0 ? v * cs - other * sn : v * cs + other * sn;
        pr[P_MKR + lane] = f2bf(o);
      }
    }
  }
}

#define P_QH 2304
#define P_KH 2560
__device__ __forceinline__ void rowpass_b2(const Params& p, int l) {
  const int tidl = tid_l();
  const int lane = tidl & 63, w = tidl >> 6;
  float cw[8][5], cv[8][5];
#pragma unroll
  for (int e = 0; e < 8; ++e)
#pragma unroll
    for (int j = 0; j < 5; ++j) {
      cw[e][j] = p.gdn_conv_w[((size_t)l * 768 + 8 * lane + e) * 5 + j];
      cv[e][j] = p.gdn_conv_w[((size_t)l * 768 + 512 + 8 * (lane & 31) + e) * 5 + j];
    }
  u16* VH = p.HQ + (size_t)T_ALL * 768;
  for (int t = blockIdx.x * 4 + w; t < T_ALL; t += gridDim.x * 4) {
    const int len = t < T_CTX ? 256 : 4096;
    const int tau = t < T_CTX ? (t & 255) : ((t - T_CTX) & 4095);
    float y[8], yv[8];
#pragma unroll
    for (int e = 0; e < 8; ++e) { y[e] = 0.f; yv[e] = 0.f; }
#pragma unroll
    for (int j = 0; j < 5; ++j) {
      const int tt = tau + j - 2;
      if (tt >= 0 && tt < len) {
        const u16* pr = p.P + (size_t)(t + j - 2) * PW;
        float f[8];
        unpack8(*(const uint4*)(pr + 8 * lane), f);
#pragma unroll
        for (int e = 0; e < 8; ++e) y[e] += cw[e][j] * f[e];
        if (lane < 32) {
          unpack8(*(const uint4*)(pr + 512 + 8 * lane), f);
#pragma unroll
          for (int e = 0; e < 8; ++e) yv[e] += cv[e][j] * f[e];
        }
      }
    }
    float ss = 0.f;
#pragma unroll
    for (int e = 0; e < 8; ++e) { y[e] = siluf_(y[e]); yv[e] = siluf_(yv[e]); ss += y[e] * y[e]; }
    ss += __shfl_xor(ss, 1); ss += __shfl_xor(ss, 2); ss += __shfl_xor(ss, 4);
    const float rn = rsqrtf(ss + 1e-6f) * (lane < 32 ? 0.125f : 1.f);
#pragma unroll
    for (int e = 0; e < 8; ++e) y[e] *= rn;
    *(uint4*)(p.P + (size_t)t * PW + P_QH + 8 * lane) = pack8(y);
    if (lane < 32) *(uint4*)(VH + (size_t)t * 256 + 8 * lane) = pack8(yv);
  }
}

__device__ __forceinline__ void unpack8(const uint4 v, float (&f)[8]) {
  f[0] = bf2f((u16)(v.x & 0xffff)); f[1] = bf2f((u16)(v.x >> 16)); f[2] = bf2f((u16)(v.y & 0xffff)); f[3] = bf2f((u16)(v.y >> 16));
  f[4] = bf2f((u16)(v.z & 0xffff)); f[5] = bf2f((u16)(v.z >> 16)); f[6] = bf2f((u16)(v.w & 0xffff)); f[7] = bf2f((u16)(v.w >> 16));
}
__device__ __forceinline__ uint4 pack8(const float (&f)[8]) {
  uint4 o;
  o.x = (unsigned)f2bf(f[0]) | ((unsigned)f2bf(f[1]) << 16); o.y = (unsigned)f2bf(f[2]) | ((unsigned)f2bf(f[3]) << 16);
  o.z = (unsigned)f2bf(f[4]) | ((unsigned)f2bf(f[5]) << 16); o.w = (unsigned)f2bf(f[6]) | ((unsigned)f2bf(f[7]) << 16);
  return o;
}
__device__ __forceinline__ void rowpass_c2(const Params& p, int l) {
  const int tidl = tid_l();
  const int lane = tidl & 63, w = tidl >> 6;
  const int hl = lane & 31, isH = lane >> 5;
  const float* nw = (isH ? p.hgrn_norm_w : p.gdn_norm_w) + l * 64 + (hl & 7) * 8;
  const float4 w0 = *(const float4*)(nw), w1 = *(const float4*)(nw + 4);
  const float wv[8] = {w0.x, w0.y, w0.z, w0.w, w1.x, w1.y, w1.z, w1.w};
  for (int t = blockIdx.x * 4 + w; t < T_ALL; t += gridDim.x * 4) {
    u16* mr = p.MIX + (size_t)t * 1024;
    const u16* pr = p.P + (size_t)t * PW;
    const u16* qr = p.HQ + (size_t)t * 768;
    const uint4 vf = *(const uint4*)(mr + isH * 512 + hl * 8);
    const uint4 vb = *(const uint4*)(mr + isH * 512 + 256 + hl * 8);
    const uint4 vg = *(const uint4*)(pr + (isH ? P_HG : P_GZ) + hl * 8);
    const int c0 = lane * 8;
    const uint4 vo = *(const uint4*)(qr + (c0 >> 7) * 192 + (c0 & 127));
    float f[8], bb[8], g[8];
    unpack8(vf, f); unpack8(vb, bb); unpack8(vg, g);
    float ss = 0.f;
#pragma unroll
    for (int i = 0; i < 8; ++i) { f[i] += bb[i]; ss += f[i] * f[i]; }
    ss += __shfl_xor(ss, 1); ss += __shfl_xor(ss, 2); ss += __shfl_xor(ss, 4);
    const float rn = rsqrtf(ss * (1.f / 64.f) + 1e-6f);
#pragma unroll
    for (int i = 0; i < 8; ++i) f[i] = f[i] * rn * wv[i] * (isH ? sigmoidf_(g[i]) : siluf_(g[i]));
    __threadfence_block();
    *(uint4*)(mr + isH * 256 + hl * 8) = pack8(f);
    *(uint4*)(mr + 512 + c0) = vo;
  }
}

__device__ __forceinline__ void gemm128(const u16* __restrict__ A, int lda, const u16* __restrict__ B, int ldb, int K,
                                        u16* lds, f32x4 (&acc)[4][4]) {
  const int tid = tid_l(), lane = tid & 63, w = tid >> 6, wm = w >> 1, wn = w & 1;
  const int r16 = lane & 15, g4 = lane >> 4;
#pragma unroll
  for (int i = 0; i < 4; ++i)
#pragma unroll
    for (int j = 0; j < 4; ++j) acc[i][j] = f32x4{0.f, 0.f, 0.f, 0.f};
  const int lrow = tid >> 3, lkc = tid & 7;
  const u16* ap = A + (size_t)lrow * lda + lkc * 8;
  const u16* bp = B + (size_t)lrow * ldb + lkc * 8;
  const size_t sa32 = (size_t)32 * lda, sb32 = (size_t)32 * ldb;
  uint4 ra0 = *(const uint4*)(ap), ra1 = *(const uint4*)(ap + sa32), ra2 = *(const uint4*)(ap + 2 * sa32), ra3 = *(const uint4*)(ap + 3 * sa32);
  uint4 rb0 = *(const uint4*)(bp), rb1 = *(const uint4*)(bp + sb32), rb2 = *(const uint4*)(bp + 2 * sb32), rb3 = *(const uint4*)(bp + 3 * sb32);
  const int woff = lrow * 64 + ((lkc ^ (lrow & 7)) * 8);
  const int sw = r16 & 7;
  const int fa0 = (wm * 64 + r16) * 64 + ((g4 ^ sw) * 8);
  const int fa1 = (wm * 64 + r16) * 64 + (((4 + g4) ^ sw) * 8);
  const int fb0 = 128 * 64 + (wn * 64 + r16) * 64 + ((g4 ^ sw) * 8);
  const int fb1 = 128 * 64 + (wn * 64 + r16) * 64 + (((4 + g4) ^ sw) * 8);
  const int nk = K >> 6;
  __syncthreads();
  {
    u16* wa = lds + woff; u16* wb = lds + 128 * 64 + woff;
    *(uint4*)(wa) = ra0; *(uint4*)(wa + 32 * 64) = ra1; *(uint4*)(wa + 64 * 64) = ra2; *(uint4*)(wa + 96 * 64) = ra3;
    *(uint4*)(wb) = rb0; *(uint4*)(wb + 32 * 64) = rb1; *(uint4*)(wb + 64 * 64) = rb2; *(uint4*)(wb + 96 * 64) = rb3;
  }
  if (nk > 1) {
    const u16* a2 = ap + 64; const u16* b2 = bp + 64;
    ra0 = *(const uint4*)(a2); ra1 = *(const uint4*)(a2 + sa32); ra2 = *(const uint4*)(a2 + 2 * sa32); ra3 = *(const uint4*)(a2 + 3 * sa32);
    rb0 = *(const uint4*)(b2); rb1 = *(const uint4*)(b2 + sb32); rb2 = *(const uint4*)(b2 + 2 * sb32); rb3 = *(const uint4*)(b2 + 3 * sb32);
  }
  __syncthreads();
  for (int kt = 0; kt < nk; ++kt) {
    const u16* cur = lds + (kt & 1) * (256 * 64);
    if (kt + 1 < nk) {
      u16* nxt = lds + ((kt + 1) & 1) * (256 * 64);
      u16* wa = nxt + woff; u16* wb = nxt + 128 * 64 + woff;
      *(uint4*)(wa) = ra0; *(uint4*)(wa + 32 * 64) = ra1; *(uint4*)(wa + 64 * 64) = ra2; *(uint4*)(wa + 96 * 64) = ra3;
      *(uint4*)(wb) = rb0; *(uint4*)(wb + 32 * 64) = rb1; *(uint4*)(wb + 64 * 64) = rb2; *(uint4*)(wb + 96 * 64) = rb3;
      if (kt + 2 < nk) {
        const u16* a2 = ap + (kt + 2) * 64; const u16* b2 = bp + (kt + 2) * 64;
        ra0 = *(const uint4*)(a2); ra1 = *(const uint4*)(a2 + sa32); ra2 = *(const uint4*)(a2 + 2 * sa32); ra3 = *(const uint4*)(a2 + 3 * sa32);
        rb0 = *(const uint4*)(b2); rb1 = *(const uint4*)(b2 + sb32); rb2 = *(const uint4*)(b2 + 2 * sb32); rb3 = *(const uint4*)(b2 + 3 * sb32);
      }
    }
    {
      const u16* pa0 = cur + fa0; const u16* pa1 = cur + fa1; const u16* pb0 = cur + fb0; const u16* pb1 = cur + fb1;
      bf16x8 a0 = *(const bf16x8*)(pa0), a1 = *(const bf16x8*)(pa0 + 16 * 64), a2 = *(const bf16x8*)(pa0 + 32 * 64), a3 = *(const bf16x8*)(pa0 + 48 * 64);
      bf16x8 b0 = *(const bf16x8*)(pb0), b1 = *(const bf16x8*)(pb0 + 16 * 64), b2 = *(const bf16x8*)(pb0 + 32 * 64), b3 = *(const bf16x8*)(pb0 + 48 * 64);
      bf16x8 c0 = *(const bf16x8*)(pa1), c1 = *(const bf16x8*)(pa1 + 16 * 64), c2 = *(const bf16x8*)(pa1 + 32 * 64), c3 = *(const bf16x8*)(pa1 + 48 * 64);
      bf16x8 d0 = *(const bf16x8*)(pb1), d1 = *(const bf16x8*)(pb1 + 16 * 64), d2 = *(const bf16x8*)(pb1 + 32 * 64), d3 = *(const bf16x8*)(pb1 + 48 * 64);
      __builtin_amdgcn_sched_barrier(0);
#define G128_MM(j, bj, x0, x1, x2, x3) do { \
        acc[0][j] = __builtin_amdgcn_mfma_f32_16x16x32_bf16(bj, x0, acc[0][j], 0, 0, 0); \
        acc[1][j] = __builtin_amdgcn_mfma_f32_16x16x32_bf16(bj, x1, acc[1][j], 0, 0, 0); \
        acc[2][j] = __builtin_amdgcn_mfma_f32_16x16x32_bf16(bj, x2, acc[2][j], 0, 0, 0); \
        acc[3][j] = __builtin_amdgcn_mfma_f32_16x16x32_bf16(bj, x3, acc[3][j], 0, 0, 0); } while (0)
      __builtin_amdgcn_s_setprio(1);
      G128_MM(0, b0, a0, a1, a2, a3); G128_MM(1, b1, a0, a1, a2, a3); G128_MM(2, b2, a0, a1, a2, a3); G128_MM(3, b3, a0, a1, a2, a3);
      G128_MM(0, d0, c0, c1, c2, c3); G128_MM(1, d1, c0, c1, c2, c3); G128_MM(2, d2, c0, c1, c2, c3); G128_MM(3, d3, c0, c1, c2, c3);
      __builtin_amdgcn_s_setprio(0);
    }
    __syncthreads();
  }
}
__device__ __forceinline__ uint2 pack4(f32x4 v) {
  uint2 o;
  o.x = (unsigned)f2bf(v[0]) | ((unsigned)f2bf(v[1]) << 16);
  o.y = (unsigned)f2bf(v[2]) | ((unsigned)f2bf(v[3]) << 16);
  return o;
}

__device__ __forceinline__ void gemm256(const u16* __restrict__ A, int lda, const u16* __restrict__ B, int ldb, int K,
                                        u16* lds, f32x4 (&acc)[8][4]) {
  const int tid = tid_l(), lane = tid & 63, w = tid >> 6, wm = w >> 1, wn = w & 1;
  const int r16 = lane & 15, g4 = lane >> 4;
#pragma unroll
  for (int i = 0; i < 8; ++i)
#pragma unroll
    for (int j = 0; j < 4; ++j) acc[i][j] = f32x4{0.f, 0.f, 0.f, 0.f};
  const int lrow = tid >> 2, lkc = tid & 3;
  const u16* ap = A + (size_t)lrow * lda + lkc * 8;
  const u16* bp = B + (size_t)lrow * ldb + lkc * 8;
  const size_t sa64 = (size_t)64 * lda, sb64 = (size_t)64 * ldb;
  const int woff = lrow * 32 + ((lkc ^ ((lrow >> 1) & 3)) * 8);
  const int fsw = (g4 ^ ((r16 >> 1) & 3)) * 8;
  const int faoff = (wm * 128 + r16) * 32 + fsw;
  const int fboff = 256 * 32 + (wn * 64 + r16) * 32 + fsw;
  const int nk = K >> 5;
  const int BUF = 384 * 32;
  uint4 xa0, xa1, xa2, xa3, xb0, xb1;
  uint4 ya0, ya1, ya2, ya3, yb0, yb1;
#define G256_LOAD(P, st) do { const u16* a2_ = ap + (st) * 32; const u16* b2_ = bp + (st) * 32; \
    P##a0 = *(const uint4*)(a2_); P##a1 = *(const uint4*)(a2_ + sa64); P##a2 = *(const uint4*)(a2_ + 2 * sa64); P##a3 = *(const uint4*)(a2_ + 3 * sa64); \
    P##b0 = *(const uint4*)(b2_); P##b1 = *(const uint4*)(b2_ + sb64); } while (0)
#define G256_STORE(P, buf) do { u16* wa_ = lds + (buf) * BUF + woff; u16* wb_ = wa_ + 256 * 32; \
    *(uint4*)(wa_) = P##a0; *(uint4*)(wa_ + 64 * 32) = P##a1; *(uint4*)(wa_ + 128 * 32) = P##a2; *(uint4*)(wa_ + 192 * 32) = P##a3; \
    *(uint4*)(wb_) = P##b0; *(uint4*)(wb_ + 64 * 32) = P##b1; } while (0)
#define G256_MM(i, af) do { \
      acc[i][0] = __builtin_amdgcn_mfma_f32_16x16x32_bf16(bf0, af, acc[i][0], 0, 0, 0); \
      acc[i][1] = __builtin_amdgcn_mfma_f32_16x16x32_bf16(bf1, af, acc[i][1], 0, 0, 0); \
      acc[i][2] = __builtin_amdgcn_mfma_f32_16x16x32_bf16(bf2, af, acc[i][2], 0, 0, 0); \
      acc[i][3] = __builtin_amdgcn_mfma_f32_16x16x32_bf16(bf3, af, acc[i][3], 0, 0, 0); } while (0)
#define G256_COMPUTE(buf) do { const u16* fa_ = lds + (buf) * BUF + faoff; const u16* fb_ = lds + (buf) * BUF + fboff; \
    bf16x8 bf0 = *(const bf16x8*)(fb_), bf1 = *(const bf16x8*)(fb_ + 16 * 32), bf2 = *(const bf16x8*)(fb_ + 32 * 32), bf3 = *(const bf16x8*)(fb_ + 48 * 32); \
    bf16x8 a0 = *(const bf16x8*)(fa_), a1 = *(const bf16x8*)(fa_ + 16 * 32), a2 = *(const bf16x8*)(fa_ + 32 * 32), a3 = *(const bf16x8*)(fa_ + 48 * 32); \
    __builtin_amdgcn_sched_barrier(0); __builtin_amdgcn_s_setprio(1); \
    G256_MM(0, a0); a0 = *(const bf16x8*)(fa_ + 64 * 32); __builtin_amdgcn_sched_barrier(0); \
    G256_MM(1, a1); a1 = *(const bf16x8*)(fa_ + 80 * 32); __builtin_amdgcn_sched_barrier(0); \
    G256_MM(2, a2); a2 = *(const bf16x8*)(fa_ + 96 * 32); __builtin_amdgcn_sched_barrier(0); \
    G256_MM(3, a3); a3 = *(const bf16x8*)(fa_ + 112 * 32); __builtin_amdgcn_sched_barrier(0); \
    G256_MM(4, a0); G256_MM(5, a1); G256_MM(6, a2); G256_MM(7, a3); __builtin_amdgcn_s_setprio(0); } while (0)
  bf16x8 bf0, bf1, bf2, bf3, a0, a1, a2, a3;
#define G3_PRELOAD(buf) do { const u16* fa_ = lds + (buf) * BUF + faoff; const u16* fb_ = lds + (buf) * BUF + fboff; \
    bf0 = *(const bf16x8*)(fb_); bf1 = *(const bf16x8*)(fb_ + 16 * 32); bf2 = *(const bf16x8*)(fb_ + 32 * 32); bf3 = *(const bf16x8*)(fb_ + 48 * 32); \
    a0 = *(const bf16x8*)(fa_); a1 = *(const bf16x8*)(fa_ + 16 * 32); a2 = *(const bf16x8*)(fa_ + 32 * 32); a3 = *(const bf16x8*)(fa_ + 48 * 32); } while (0)
#define G3_COMPUTE(buf) do { const u16* fa_ = lds + (buf) * BUF + faoff; \
    __builtin_amdgcn_sched_barrier(0); __builtin_amdgcn_s_setprio(1); \
    G256_MM(0, a0); a0 = *(const bf16x8*)(fa_ + 64 * 32); __builtin_amdgcn_sched_barrier(0); \
    G256_MM(1, a1); a1 = *(const bf16x8*)(fa_ + 80 * 32); __builtin_amdgcn_sched_barrier(0); \
    G256_MM(2, a2); a2 = *(const bf16x8*)(fa_ + 96 * 32); __builtin_amdgcn_sched_barrier(0); \
    G256_MM(3, a3); a3 = *(const bf16x8*)(fa_ + 112 * 32); __builtin_amdgcn_sched_barrier(0); \
    G256_MM(4, a0); G256_MM(5, a1); G256_MM(6, a2); G256_MM(7, a3); __builtin_amdgcn_s_setprio(0); \
    __builtin_amdgcn_sched_barrier(0); } while (0)
#define G3_STAGE(i, SET) do { \
    if (kt + (i) + 2 < nk) G256_STORE(SET, ((i) + 2) % 3); \
    if (kt + (i) + 4 < nk) G256_LOAD(SET, kt + (i) + 4); \
    if (kt + (i) < nk) G3_COMPUTE((i) % 3); \
    if (kt + (i) + 1 < nk) G3_PRELOAD(((i) + 1) % 3); \
    __syncthreads(); } while (0)
  G256_LOAD(x, 0);
  G256_LOAD(y, 1);
  __syncthreads();
  G256_STORE(x, 0);
  G256_LOAD(x, 2);
  G256_STORE(y, 1);
  G256_LOAD(y, 3);
  __syncthreads();
  G3_PRELOAD(0);
  for (int kt = 0; kt < nk; kt += 6) {
    G3_STAGE(0, x); G3_STAGE(1, y); G3_STAGE(2, x); G3_STAGE(3, y); G3_STAGE(4, x); G3_STAGE(5, y);
  }
}

__device__ __forceinline__ void gemm192(const u16* __restrict__ A, int lda, const u16* __restrict__ B, int ldb, int K,
                                        u16* lds, f32x4 (&acc)[6][4]) {
  const int tid = tid_l(), lane = tid & 63, w = tid >> 6, wm = w >> 1, wn = w & 1;
  const int r16 = lane & 15, g4 = lane >> 4;
#pragma unroll
  for (int i = 0; i < 6; ++i)
#pragma unroll
    for (int j = 0; j < 4; ++j) acc[i][j] = f32x4{0.f, 0.f, 0.f, 0.f};
  const int lrow = tid >> 2, lkc = tid & 3;
  const u16* ap = A + (size_t)lrow * lda + lkc * 8;
  const u16* bp = B + (size_t)lrow * ldb + lkc * 8;
  const size_t sa64 = (size_t)64 * lda, sb64 = (size_t)64 * ldb;
  const int woff = lrow * 32 + ((lkc ^ ((lrow >> 1) & 3)) * 8);
  const int fsw = (g4 ^ ((r16 >> 1) & 3)) * 8;
  const int faoff = (wm * 96 + r16) * 32 + fsw;
  const int fboff = 192 * 32 + (wn * 64 + r16) * 32 + fsw;
  const int nk = K >> 5;
  const int BUF = 320 * 32;
  uint4 xa0, xa1, xa2, xb0, xb1;
  uint4 ya0, ya1, ya2, yb0, yb1;
#define G192_LOAD(P, st) do { const u16* a2_ = ap + (st) * 32; const u16* b2_ = bp + (st) * 32; \
    P##a0 = *(const uint4*)(a2_); P##a1 = *(const uint4*)(a2_ + sa64); P##a2 = *(const uint4*)(a2_ + 2 * sa64); \
    P##b0 = *(const uint4*)(b2_); P##b1 = *(const uint4*)(b2_ + sb64); } while (0)
#define G192_STORE(P, buf) do { u16* wa_ = lds + (buf) * BUF + woff; u16* wb_ = wa_ + 192 * 32; \
    *(uint4*)(wa_) = P##a0; *(uint4*)(wa_ + 64 * 32) = P##a1; *(uint4*)(wa_ + 128 * 32) = P##a2; \
    *(uint4*)(wb_) = P##b0; *(uint4*)(wb_ + 64 * 32) = P##b1; } while (0)
#define G192_COMPUTE(buf) do { const u16* fa_ = lds + (buf) * BUF + faoff; const u16* fb_ = lds + (buf) * BUF + fboff; \
    bf16x8 bf0 = *(const bf16x8*)(fb_), bf1 = *(const bf16x8*)(fb_ + 16 * 32), bf2 = *(const bf16x8*)(fb_ + 32 * 32), bf3 = *(const bf16x8*)(fb_ + 48 * 32); \
    bf16x8 a0 = *(const bf16x8*)(fa_), a1 = *(const bf16x8*)(fa_ + 16 * 32), a2 = *(const bf16x8*)(fa_ + 32 * 32), a3 = *(const bf16x8*)(fa_ + 48 * 32); \
    __builtin_amdgcn_sched_barrier(0); __builtin_amdgcn_s_setprio(1); \
    G256_MM(0, a0); a0 = *(const bf16x8*)(fa_ + 64 * 32); __builtin_amdgcn_sched_barrier(0); \
    G256_MM(1, a1); a1 = *(const bf16x8*)(fa_ + 80 * 32); __builtin_amdgcn_sched_barrier(0); \
    G256_MM(2, a2); G256_MM(3, a3); G256_MM(4, a0); G256_MM(5, a1); __builtin_amdgcn_s_setprio(0); } while (0)
  G192_LOAD(x, 0);
  G192_LOAD(y, 1);
  __syncthreads();
  G192_STORE(x, 0);
  G192_LOAD(x, 2);
  __syncthreads();
  for (int kt = 0; kt < nk; kt += 2) {
    G192_STORE(y, 1);
    if (kt + 3 < nk) G192_LOAD(y, kt + 3);
    G192_COMPUTE(0);
    __syncthreads();
    if (kt + 2 < nk) {
      G192_STORE(x, 0);
      if (kt + 4 < nk) G192_LOAD(x, kt + 4);
    }
    G192_COMPUTE(1);
    __syncthreads();
  }
}
#define GEMM256_RC const int tde = tid_l(); const int rb = ((tde >> 6) >> 1) * 128 + (tde & 15), cb = ((tde >> 6) & 1) * 64 + ((tde & 63) >> 4) * 4;
#define GEMM_RC const int tde = tid_l(); const int rb = ((tde >> 6) >> 1) * 64 + (tde & 15), cb = ((tde >> 6) & 1) * 64 + ((tde & 63) >> 4) * 4;


__device__ __forceinline__ bool tile_at(int r, int Mt, int Nt, int& mt, int& nt) {
  const int x = blockIdx.x & 7, j = blockIdx.x >> 3, bpx = gridDim.x >> 3;
  const int mpx = Mt >> 3;
  const int q = r * bpx + j;
  if (q >= mpx * Nt) return false;
  const int full = (Nt >> 3) * (mpx * 8);
  int cb, rem, wcb;
  if (q < full) { cb = q / (mpx * 8); rem = q - cb * mpx * 8; wcb = 8; }
  else { cb = Nt >> 3; rem = q - full; wcb = Nt - cb * 8; }
  mt = x * mpx + rem / wcb;
  nt = cb * 8 + rem % wcb;
  return true;
}

__device__ __forceinline__ void phase_a(const Params& p, int l, u16* lds) {
  const u16* Bw = p.WinT + (size_t)l * 3072 * 1024;
  int mt, nt;
  for (int r = 0; tile_at(r, 144, 24, mt, nt); ++r) {
    const int m0 = mt * 256, n0 = nt * 128;
    f32x4 acc[8][4];
    gemm256(p.HQ + (size_t)m0 * 1024, 1024, Bw + (size_t)n0 * 1024, 1024, 1024, lds, acc);
    { GEMM256_RC
#pragma unroll
      for (int mi = 0; mi < 8; ++mi) {
        const int row = m0 + rb + mi * 16;
#pragma unroll
        for (int ni = 0; ni < 4; ++ni) {
          const int col = n0 + cb + ni * 16;
          *(uint2*)(p.P + (size_t)row * PW + col) = pack4(acc[mi][ni]);
          if (col >= P_GA && col < P_GA + 16)
            *(float4*)(p.GAB + (size_t)row * 16 + (col - P_GA)) = make_float4(acc[mi][ni][0], acc[mi][ni][1], acc[mi][ni][2], acc[mi][ni][3]);
        }
      }
    }
  }
}

__device__ __forceinline__ void phase_b1(const Params& p, int l, u16* lds) {
  int mt, nt;
  for (int pass = 0; pass < 2; ++pass) {
  for (int r = 0; tile_at(r, pass == 0 ? 288 : 304, pass == 0 ? 6 : 8, mt, nt); ++r) {
    if (pass == 0) {
      const int m0 = mt * 128, n0 = nt * 128;
      const float qscale = 0.07216878364870322f * 1.4426950408889634f;
      f32x4 acc[4][4];
      gemm128(p.P + (size_t)m0 * PW + P_MCQ, PW, p.WuqT + (size_t)l * 768 * 384 + (size_t)n0 * 384, 384, 384, lds, acc);
      { GEMM_RC
        const int g4 = (tde & 63) >> 4;
        const int cw0 = n0 + cb - g4 * 4;
        const bool ropew = ((cw0 >> 6) % 3) == 2 && m0 >= T_CTX;
#pragma unroll
        for (int mi = 0; mi < 4; ++mi) {
          const int row = m0 + rb + mi * 16;
          f32x4 v0 = acc[mi][0], v1 = acc[mi][1], v2 = acc[mi][2], v3 = acc[mi][3];
          if (ropew) {
            const int pos = (row - T_CTX) & 4095;
#pragma unroll
            for (int r = 0; r < 4; ++r) {
              const float inv = exp2f(-(float)(g4 * 4 + r) * (13.287712379549449f / 16.f));
              float s0, c0, s1, c1;
              __sincosf((float)(pos >> 6) * inv, &s0, &c0);
              __sincosf((float)(pos & 63) * inv, &s1, &c1);
              const float a0 = v0[r] * c0 - v1[r] * s0, a1 = v1[r] * c0 + v0[r] * s0;
              const float b0 = v2[r] * c1 - v3[r] * s1, b1 = v3[r] * c1 + v2[r] * s1;
              v0[r] = a0; v1[r] = a1; v2[r] = b0; v3[r] = b1;
            }
          }
          u16* qp = p.HQ + (size_t)row * 768 + n0 + cb;
          *(uint2*)(qp) = pack4(v0 * qscale); *(uint2*)(qp + 16) = pack4(v1 * qscale);
          *(uint2*)(qp + 32) = pack4(v2 * qscale); *(uint2*)(qp + 48) = pack4(v3 * qscale);
        }
      }
    } else {
      const int m0 = mt * 128, n0 = nt * 128;
      const u16* Ap; int lda;
      if (mt < 288) { Ap = p.P + (size_t)m0 * PW + P_MCKV; lda = PW; }
      else { Ap = p.CKVC + (size_t)(m0 - T_ALL) * 256; lda = 256; }
      f32x4 acc[4][4];
      gemm128(Ap, lda, p.WukvT + (size_t)l * 1024 * 256 + (size_t)n0 * 256, 256, 256, lds, acc);
      { GEMM_RC
#pragma unroll
        for (int mi = 0; mi < 4; ++mi) {
          const int row = m0 + rb + mi * 16;
          u16* vb; int vst;
          if (row < T_CTX) { int b = row >> 8, pos = row & 255; vb = p.VTC + (size_t)(b * 4) * 128 * 256 + pos; vst = 256; }
          else if (row < T_ALL) { int b = (row - T_CTX) >> 12, pos = (row - T_CTX) & 4095; vb = p.VTL + (size_t)(b * 4) * 128 * 4352 + pos; vst = 4352; }
          else { int b = (row - T_ALL) >> 8, pos = 4096 + ((row - T_ALL) & 255); vb = p.VTL + (size_t)(b * 4) * 128 * 4352 + pos; vst = 4352; }
#pragma unroll
          for (int ni = 0; ni < 4; ++ni) {
            const int col = n0 + cb + ni * 16;
            const int h = col >> 8, wi = col & 255;
            if (wi < 128) {
              *(uint2*)(p.KN + (size_t)row * 512 + h * 128 + wi) = pack4(acc[mi][ni]);
            } else {
              u16* dst = vb + (size_t)(h * 128 + (wi - 128)) * vst;
#pragma unroll
              for (int r = 0; r < 4; ++r) dst[(size_t)r * vst] = f2bf(acc[mi][ni][r]);
            }
          }
        }
      }
    }
  }
  }
}

__device__ __forceinline__ void phase_gemm_y(const u16* A, int lda, const u16* B, int K, int N, u16* Y, int ldy, u16* lds) {
  int mt, nt;
  for (int r = 0; tile_at(r, 192, N / 128, mt, nt); ++r) {
    const int m0 = mt * 192, n0 = nt * 128;
    f32x4 acc[6][4];
    gemm192(A + (size_t)m0 * lda, lda, B + (size_t)n0 * K, K, K, lds, acc);
    {
      const int tde = tid_l();
      const int rb = ((tde >> 6) >> 1) * 96 + (tde & 15), cb = ((tde >> 6) & 1) * 64 + ((tde & 63) >> 4) * 4;
#pragma unroll
      for (int mi = 0; mi < 6; ++mi)
#pragma unroll
        for (int ni = 0; ni < 4; ++ni)
          *(uint2*)(Y + (size_t)(m0 + rb + mi * 16) * ldy + n0 + cb + ni * 16) = pack4(acc[mi][ni]);
    }
  }
}

__device__ __forceinline__ void phase_e(const Params& p, int l, u16* lds) {
  const u16* Bw = p.WfiT + (size_t)l * 5632 * 1024;
  int mt, nt;
  for (int r = 0; tile_at(r, 144, 44, mt, nt); ++r) {
    const int m0 = mt * 256, n0 = nt * 128;
    f32x4 acc[8][4];
    gemm256(p.MIX + (size_t)m0 * 1024, 1024, Bw + (size_t)n0 * 1024, 1024, 1024, lds, acc);
    { GEMM256_RC
      const int g4x4 = ((tde & 63) >> 4) * 4;
      const int hc0 = ((n0 + cb - g4x4) >> 1) + g4x4;
#pragma unroll
      for (int mi = 0; mi < 8; ++mi)
#pragma unroll
        for (int ni = 0; ni < 2; ++ni) {
          f32x4 hv;
#pragma unroll
          for (int r = 0; r < 4; ++r) hv[r] = siluf_(acc[mi][ni][r]) * acc[mi][ni + 2][r];
          *(uint2*)(p.P + (size_t)(m0 + rb + mi * 16) * DFF + hc0 + ni * 16) = pack4(hv);
        }
    }
  }
}

#define KST 208
#define VST 80
#define PST 80
__device__ __forceinline__ void attn_item(const Params& p, int latent, int b, int h, int qb, unsigned char* smraw, int dummy = 0) {
  u16* sK = (u16*)smraw;
  u16* sV = sK + 64 * KST;
  u16* sP = sV + 128 * VST;
  const int tid = tid_l(), lane = tid & 63, w = tid >> 6, r16 = lane & 15, g4 = lane >> 4;
  const int nkeys = latent ? 4352 : 256;
  const int krow0 = latent ? T_CTX + b * 4096 : b * 256;
  const int tq0 = krow0 + qb * 128;
  const u16* vt = latent ? p.VTL + (size_t)((b * 4 + h) * 128) * 4352 : p.VTC + (size_t)((b * 4 + h) * 128) * 256;
  u16* sPw = sP + w * 32 * PST;
  bf16x8 q[2][6];
#pragma unroll
  for (int mi = 0; mi < 2; ++mi)
#pragma unroll
    for (int ks = 0; ks < 6; ++ks)
      q[mi][ks] = *(const bf16x8*)(p.HQ + (size_t)(tq0 + w * 32 + mi * 16 + r16) * 768 + h * 192 + ks * 32 + g4 * 8);
  f32x4 o[2][8];
  float mrow[2], lrow[2];
#pragma unroll
  for (int mi = 0; mi < 2; ++mi) {
#pragma unroll
    for (int nd = 0; nd < 8; ++nd) o[mi][nd] = f32x4{0.f, 0.f, 0.f, 0.f};
    mrow[mi] = -1e30f; lrow[mi] = 0.f;
  }
  const int lkey = tid >> 2, lpart = tid & 3;
  const int ldv = tid >> 1, lhalf = tid & 1;
  const int ntile = nkeys >> 6;
  uint4 k0, k1, k2, k3, k4, k5;
  {
    const int pos = lkey;
    const u16* srcn = p.KN + (size_t)(krow0 + pos) * 512 + h * 128 + lpart * 8;
    const u16* srcr = p.P + (size_t)(krow0 + pos) * PW + P_MKR + lpart * 8;
    k0 = *(const uint4*)(srcn); k1 = *(const uint4*)(srcn + 32); k2 = *(const uint4*)(srcn + 64); k3 = *(const uint4*)(srcn + 96);
    k4 = *(const uint4*)(srcr); k5 = *(const uint4*)(srcr + 32);
  }
  for (int kt = 0; kt < ntile; ++kt) {
    __syncthreads();
    {
      u16* dk = sK + lkey * KST + lpart * 8;
      *(uint4*)(dk) = k0; *(uint4*)(dk + 32) = k1; *(uint4*)(dk + 64) = k2; *(uint4*)(dk + 96) = k3;
      *(uint4*)(dk + 128) = k4; *(uint4*)(dk + 160) = k5;
    }
    const u16* sv = vt + (size_t)ldv * nkeys + kt * 64 + lhalf * 32;
    const uint4 v0 = *(const uint4*)(sv), v1 = *(const uint4*)(sv + 8), v2 = *(const uint4*)(sv + 16), v3 = *(const uint4*)(sv + 24);
    __syncthreads();
    f32x4 s[2][4];
#pragma unroll
    for (int mi = 0; mi < 2; ++mi)
#pragma unroll
      for (int ni = 0; ni < 4; ++ni) s[mi][ni] = f32x4{0.f, 0.f, 0.f, 0.f};
#pragma unroll
    for (int ks = 0; ks < 6; ++ks)
#pragma unroll
      for (int ni = 0; ni < 4; ++ni) {
        bf16x8 kf = *(const bf16x8*)(sK + (ni * 16 + r16) * KST + ks * 32 + g4 * 8);
        s[0][ni] = __builtin_amdgcn_mfma_f32_16x16x32_bf16(kf, q[0][ks], s[0][ni], 0, 0, 0);
        s[1][ni] = __builtin_amdgcn_mfma_f32_16x16x32_bf16(kf, q[1][ks], s[1][ni], 0, 0, 0);
      }
#pragma unroll
    for (int mi = 0; mi < 2; ++mi) {
      float mx = -1e30f;
#pragma unroll
      for (int ni = 0; ni < 4; ++ni)
#pragma unroll
        for (int r = 0; r < 4; ++r) mx = fmaxf(mx, s[mi][ni][r]);
      mx = fmaxf(mx, __shfl_xor(mx, 16)); mx = fmaxf(mx, __shfl_xor(mx, 32));
      const float mnew = fmaxf(mrow[mi], mx);
      const float alpha = __builtin_amdgcn_exp2f(mrow[mi] - mnew);
      mrow[mi] = mnew;
      float ps = 0.f;
#pragma unroll
      for (int ni = 0; ni < 4; ++ni) {
        f32x4 pv;
#pragma unroll
        for (int r = 0; r < 4; ++r) { pv[r] = __builtin_amdgcn_exp2f(s[mi][ni][r] - mnew); ps += pv[r]; }
        *(uint2*)(sPw + (mi * 16 + r16) * PST + ni * 16 + g4 * 4) = pack4(pv);
      }
      ps += __shfl_xor(ps, 16); ps += __shfl_xor(ps, 32);
      lrow[mi] = lrow[mi] * alpha + ps;
#pragma unroll
      for (int nd = 0; nd < 8; ++nd) o[mi][nd] *= alpha;
    }
    {
      u16* dvp = sV + ldv * VST + lhalf * 32;
      *(uint4*)(dvp) = v0; *(uint4*)(dvp + 8) = v1; *(uint4*)(dvp + 16) = v2; *(uint4*)(dvp + 24) = v3;
    }
    __syncthreads();
    if (kt + 1 < ntile) {
      const int pos = (kt + 1) * 64 + lkey;
      const bool own = (!latent) || pos < 4096;
      const int row = own ? krow0 + pos : T_ALL + b * 256 + (pos - 4096);
      const u16* srcn = p.KN + (size_t)row * 512 + h * 128 + lpart * 8;
      const u16* srcr = own ? p.P + (size_t)(krow0 + pos) * PW + P_MKR + lpart * 8
                            : p.KRC + (size_t)(b * 256 + pos - 4096) * 64 + lpart * 8;
      k0 = *(const uint4*)(srcn); k1 = *(const uint4*)(srcn + 32); k2 = *(const uint4*)(srcn + 64); k3 = *(const uint4*)(srcn + 96);
      k4 = *(const uint4*)(srcr); k5 = *(const uint4*)(srcr + 32);
    }
#pragma unroll
    for (int ks2 = 0; ks2 < 2; ++ks2) {
      bf16x8 pf0 = *(const bf16x8*)(sPw + (0 * 16 + r16) * PST + ks2 * 32 + g4 * 8);
      bf16x8 pf1 = *(const bf16x8*)(sPw + (1 * 16 + r16) * PST + ks2 * 32 + g4 * 8);
#pragma unroll
      for (int nd = 0; nd < 8; ++nd) {
        bf16x8 vf = *(const bf16x8*)(sV + (nd * 16 + r16) * VST + ks2 * 32 + g4 * 8);
        o[0][nd] = __builtin_amdgcn_mfma_f32_16x16x32_bf16(vf, pf0, o[0][nd], 0, 0, 0);
        o[1][nd] = __builtin_amdgcn_mfma_f32_16x16x32_bf16(vf, pf1, o[1][nd], 0, 0, 0);
      }
    }
  }
#pragma unroll
  for (int mi = 0; mi < 2; ++mi) {
    const float inv = 1.f / lrow[mi];
    const int qrow = tq0 + w * 32 + mi * 16 + r16;
    u16* op = p.HQ + (size_t)qrow * 768 + h * 192 + g4 * 4;
    if (dummy) op = p.HQ + (size_t)T_ALL * 768 + (size_t)(qrow % 9216) * 768 + h * 192 + g4 * 4;
#pragma unroll
    for (int nd = 0; nd < 8; ++nd) *(uint2*)(op + nd * 16) = pack4(o[mi][nd] * inv);
  }
}

#define XB_TMO      128
#define XB_XCNT(j)  (256  + 64 * (j))
#define XB_XSUB(j)  (1280 + 64 * (j))
#define XB_XGEN(j)  (2304 + 64 * (j))
#define XB_TOP      3328
#define XB_TOPGEN   3392
#define XCD_BAR_WORDS 3456
#define XB_SPIN_CAP (1u << 23)
#define LAS __attribute__((address_space(3)))

__device__ __forceinline__ unsigned xb_ld(unsigned* p)              { return __hip_atomic_load(p, __ATOMIC_RELAXED, __HIP_MEMORY_SCOPE_AGENT); }
__device__ __forceinline__ unsigned xb_add(unsigned* p, unsigned v) { return __hip_atomic_fetch_add(p, v, __ATOMIC_RELAXED, __HIP_MEMORY_SCOPE_AGENT); }
__device__ __forceinline__ unsigned xb_xcc_id() { return (unsigned)__builtin_amdgcn_s_getreg((3 << 11) | 20) & 0xFu; }
#define XB_SPIN(cond, bar) do { unsigned _sp = 0; while (cond) { __builtin_amdgcn_s_sleep(1); \
    if ((++_sp & 255u) == 0u) { if (xb_ld(&(bar)[XB_TMO])) break; if (_sp > XB_SPIN_CAP) { atomicAdd(&(bar)[XB_TMO], 1u); break; } } } } while (0)

struct XcdBarrier {
    unsigned* bar; unsigned x;
    volatile LAS unsigned* st;
};

__device__ __forceinline__ XcdBarrier xcd_barrier_post(unsigned* bar, volatile LAS unsigned* st) {
    XcdBarrier b; b.bar = bar; b.x = xb_xcc_id(); b.st = st;
    if (threadIdx.x == 0) (void)xb_add(&bar[XB_XCNT(b.x)], 1u);
    return b;
}
__device__ __forceinline__ void xcd_barrier_complete(unsigned* bar, unsigned x, unsigned& nloc, unsigned& nx) {
    const unsigned G = gridDim.x * gridDim.y * gridDim.z;
    unsigned sum, cnt, mine, sp = 0u;
    for (;;) {
        sum = 0u; cnt = 0u; mine = 0u;
#pragma unroll
        for (unsigned j = 0; j < 16; ++j) { const unsigned c = xb_ld(&bar[XB_XCNT(j)]); sum += c; cnt += (c > 0u) ? 1u : 0u; mine = (j == x) ? c : mine; }
        if (sum == G) break;
        __builtin_amdgcn_s_sleep(1);
        if ((++sp & 255u) == 0u) { if (xb_ld(&bar[XB_TMO])) break; if (sp > XB_SPIN_CAP) { atomicAdd(&bar[XB_TMO], 1u); break; } }
    }
    nloc = mine > 0u ? mine : 1u; nx = cnt > 0u ? cnt : 1u;
}

__device__ __forceinline__ void xcd_barrier(const XcdBarrier& b) {
    asm volatile("s_waitcnt vmcnt(0)" ::: "memory");
    __syncthreads();
    if (threadIdx.x == 0) {
        unsigned* bar = b.bar;
        __builtin_amdgcn_s_waitcnt(0);
        unsigned nloc = b.st[0], nx = b.st[1];
        if (nloc == 0u) { xcd_barrier_complete(bar, b.x, nloc, nx); b.st[0] = nloc; b.st[1] = nx; }
        const unsigned old = xb_add(&bar[XB_XSUB(b.x)], 1u);
        const unsigned gen = old / nloc;
        if (old + 1u == (gen + 1u) * nloc) {
            __builtin_amdgcn_fence(__ATOMIC_RELEASE, "agent");
            asm volatile("s_waitcnt vmcnt(0)" ::: "memory");
            const unsigned og = xb_add(&bar[XB_TOP], 1u);
            const unsigned tg = og / nx;
            if (og + 1u == (tg + 1u) * nx) xb_add(&bar[XB_TOPGEN], 1u);
            else XB_SPIN(xb_ld(&bar[XB_TOPGEN]) == tg, bar);
            __builtin_amdgcn_fence(__ATOMIC_ACQUIRE, "agent");
            xb_add(&bar[XB_XGEN(b.x)], 1u);
            asm volatile("s_waitcnt vmcnt(0)" ::: "memory");
        } else {
            XB_SPIN(xb_ld(&bar[XB_XGEN(b.x)]) == gen, bar);
            __builtin_amdgcn_fence(__ATOMIC_ACQUIRE, "agent");
            asm volatile("s_waitcnt vmcnt(0)" ::: "memory");
        }
    }
    __syncthreads();
}


__device__ __forceinline__ void gbar(unsigned* ctr, unsigned target) {
  asm volatile("s_waitcnt vmcnt(0)" ::: "memory");
  __syncthreads();
  if (tid_l() == 0) {
    __builtin_amdgcn_fence(__ATOMIC_RELEASE, "agent");
    asm volatile("s_waitcnt vmcnt(0)" ::: "memory");
    __hip_atomic_fetch_add(ctr, 1u, __ATOMIC_RELAXED, __HIP_MEMORY_SCOPE_AGENT);
    while (__hip_atomic_load(ctr, __ATOMIC_RELAXED, __HIP_MEMORY_SCOPE_AGENT) < target) __builtin_amdgcn_s_sleep(2);
    __builtin_amdgcn_fence(__ATOMIC_ACQUIRE, "agent");
    asm volatile("s_waitcnt vmcnt(0)" ::: "memory");
  }
  __syncthreads();
}
#define MFMA4(a, b, c) __builtin_amdgcn_mfma_f32_16x16x4f32((a), (b), (c), 0, 0, 0)

__device__ __forceinline__ float softplusf_(float x) { return fmaxf(x, 0.f) + log1pf(__expf(-fabsf(x))); }

__device__ __forceinline__ void gdn_chain(const Params& p, int l, int seq, int h, int d, int vs, float* sm) {
  float* sMM = sm;
  float* sK = sMM + 64 * 68;
  float* sW = sK + 64 * 65;
  float* sV = sW + 64 * 65;
  float* sS = sV + 64 * 33;
  float* sGc = sS + 64 * 33;
  float* sBeta = sGc + 64;
  float* sBg = sBeta + 64;
  const int tid = tid_l(), lane = tid & 63, w = tid >> 6, r16 = lane & 15, g4 = lane >> 4;
  const bool latent = seq >= 16;
  const int len = latent ? 4096 : 256;
  const int t0 = latent ? T_CTX + (seq - 16) * 4096 : seq * 256;
  const int nchunks = len >> 6;
  const float Acoef = -__expf(p.gdn_a_log[l * 8 + d * 4 + h]);
  const float dtb = p.gdn_dt_bias[l * 8 + d * 4 + h];
  f32x4 Sreg[2];
  __syncthreads();
  {
    const float* s0 = latent ? p.state_gdn + ((((size_t)(seq - 16) * 2 + l) * 2 + d) * 4 + h) * 4096 : nullptr;
#pragma unroll
    for (int n = 0; n < 2; ++n)
#pragma unroll
      for (int r = 0; r < 4; ++r) {
        const int kidx = 16 * w + g4 * 4 + r, cc = n * 16 + r16;
        float v = latent ? s0[kidx * 64 + vs * 32 + cc] : 0.f;
        Sreg[n][r] = v;
        sS[kidx * 33 + cc] = v;
      }
  }
  const u16* Pb = p.P + (size_t)t0 * PW;
  const u16* VHb = p.HQ + (size_t)T_ALL * 768 + (size_t)t0 * 256;
#define GDN_SRC(i, tl, tlo_) ({ const int e_ = (tl) + (i) * 256; const int u_ = e_ / 20, un_ = e_ % 20; \
    (un_ < 16) ? (Pb + (size_t)((tlo_) + u_) * PW + (un_ < 8 ? P_QH + h * 64 + un_ * 8 : P_KH + h * 64 + (un_ - 8) * 8)) \
               : (VHb + (size_t)((tlo_) + u_) * 256 + h * 64 + vs * 32 + (un_ - 16) * 8); })
  uint4 pf[5];
  float pga = 0.f, pgb = 0.f;
  {
    const int tlo = d == 0 ? 0 : len - 64;
#pragma unroll
    for (int i = 0; i < 5; ++i) pf[i] = *(const uint4*)GDN_SRC(i, tid, tlo);
    if (tid < 64) {
      const int u = d == 0 ? tid : 63 - tid;
      const float* gab = p.GAB + (size_t)(t0 + tlo + u) * 16;
      pga = gab[d * 4 + h]; pgb = gab[8 + d * 4 + h];
    }
  }
  for (int n = 0; n < nchunks; ++n) {
    const int tlo = d == 0 ? n * 64 : len - 64 * (n + 1);
    const int tl2 = tid_l();
#pragma unroll
    for (int i = 0; i < 5; ++i) {
      const int e = tl2 + i * 256;
      const int u = e / 20, un = e % 20;
      const int pp = d == 0 ? u : 63 - u;
      float* dq = un < 8 ? sW + pp * 65 + un * 8 : (un < 16 ? sK + pp * 65 + (un - 8) * 8 : sV + pp * 33 + (un - 16) * 8);
      const unsigned wv[4] = {pf[i].x, pf[i].y, pf[i].z, pf[i].w};
#pragma unroll
      for (int j = 0; j < 4; ++j) { dq[2 * j] = bf2f((u16)(wv[j] & 0xffff)); dq[2 * j + 1] = bf2f((u16)(wv[j] >> 16)); }
    }
    if (tid < 64) {
      const int pp = tid;
      float g = Acoef * softplusf_(pga + dtb);
      float bt = sigmoidf_(pgb);
#pragma unroll
      for (int o = 1; o < 64; o <<= 1) { float tt = __shfl_up(g, o); if (lane >= o) g += tt; }
      sGc[pp] = g; sBeta[pp] = bt; sBg[pp] = bt * __expf(g);
    }
    if (n + 1 < nchunks) {
      const int tlo2 = d == 0 ? (n + 1) * 64 : len - 64 * (n + 2);
#pragma unroll
      for (int i = 0; i < 5; ++i) pf[i] = *(const uint4*)GDN_SRC(i, tl2, tlo2);
      if (tid < 64) {
        const int u = d == 0 ? tid : 63 - tid;
        const float* gab = p.GAB + (size_t)(t0 + tlo2 + u) * 16;
        pga = gab[d * 4 + h]; pgb = gab[8 + d * 4 + h];
      }
    }
    __syncthreads();
    float qa[16];
#pragma unroll
    for (int s = 0; s < 16; ++s) qa[s] = sW[(16 * w + r16) * 65 + 4 * s + g4];
    const unsigned tcode = w == 0 ? 0x730u : (w == 1 ? 0xA51u : (w == 2 ? 0x062u : 0x0FBu));
    const int tcnt = w < 2 ? 3 : 2;
    f32x4 attacc[3];
#pragma unroll
    for (int t = 0; t < 3; ++t) {
      attacc[t] = f32x4{0.f, 0.f, 0.f, 0.f};
      if (t < tcnt) {
        const int ti = (tcode >> (4 * t)) & 3, tn = (tcode >> (4 * t + 2)) & 3;
        f32x4 accm = f32x4{0.f, 0.f, 0.f, 0.f};
        const float* ak = sK + (16 * ti + r16) * 65 + g4;
        const float* aq = sW + (16 * ti + r16) * 65 + g4;
        const float* bk = sK + (16 * tn + r16) * 65 + g4;
#pragma unroll
        for (int s = 0; s < 16; ++s) {
          const float bv = bk[4 * s];
          accm = MFMA4(ak[4 * s], bv, accm);
          attacc[t] = MFMA4(aq[4 * s], bv, attacc[t]);
        }
#pragma unroll
        for (int r = 0; r < 4; ++r) {
          const int i = 16 * ti + g4 * 4 + r, j = 16 * tn + r16;
          sMM[i * 68 + j] = (i > j) ? sBeta[i] * accm[r] * __expf(sGc[i] - sGc[j]) : 0.f;
        }
      }
    }
    __syncthreads();
    if (w == 0) {
      const int bi = tid >> 4, c = tid & 15;
      float* md = sMM + (16 * bi) * 68 + 16 * bi;
      float a[16];
#pragma unroll
      for (int r = 0; r < 16; ++r) a[r] = (r == c) ? 1.f : 0.f;
#pragma unroll
      for (int r = 1; r < 16; ++r) {
#pragma unroll
        for (int q4 = 0; q4 < (r + 3) / 4; ++q4) {
          const float4 m = *(const float4*)(md + r * 68 + 4 * q4);
          if (q4 * 4 + 0 < r) a[r] -= m.x * a[q4 * 4 + 0];
          if (q4 * 4 + 1 < r) a[r] -= m.y * a[q4 * 4 + 1];
          if (q4 * 4 + 2 < r) a[r] -= m.z * a[q4 * 4 + 2];
          if (q4 * 4 + 3 < r) a[r] -= m.w * a[q4 * 4 + 3];
        }
      }
      __builtin_amdgcn_fence(__ATOMIC_SEQ_CST, "wavefront");
#pragma unroll
      for (int r = 0; r < 16; ++r) md[r * 68 + c] = a[r];
    } else {
      for (int t = w - 1; t < 8; t += 3) {
        const int ti = t >> 1, tc = t & 1;
        const float bg = sBg[16 * ti + r16];
        const float* ak = sK + (16 * ti + r16) * 65 + g4;
        const float* bs = sS + g4 * 33 + 16 * tc + r16;
        f32x4 acc = f32x4{0.f, 0.f, 0.f, 0.f};
#pragma unroll
        for (int s = 0; s < 16; ++s) acc = MFMA4(ak[4 * s] * bg, bs[4 * s * 33], acc);
#pragma unroll
        for (int r = 0; r < 4; ++r) {
          const int i = 16 * ti + g4 * 4 + r, cc = 16 * tc + r16;
          sV[i * 33 + cc] = sV[i * 33 + cc] * sBeta[i] - acc[r];
        }
      }
    }
    __syncthreads();
    for (int ib = 0; ib < 4; ++ib) {
      if (w < 2) {
        const int ct = w;
        f32x4 acc = f32x4{0.f, 0.f, 0.f, 0.f};
        const float* am = sMM + (16 * ib + r16) * 68 + g4;
        const float* bx = sV + g4 * 33 + 16 * ct + r16;
        for (int s4 = 0; s4 < ib; ++s4) {
#pragma unroll
          for (int s = 0; s < 4; ++s) acc = MFMA4(am[16 * s4 + 4 * s], bx[(16 * s4 + 4 * s) * 33], acc);
        }
        f32x4 rm;
#pragma unroll
        for (int r = 0; r < 4; ++r) rm[r] = sV[(16 * ib + g4 * 4 + r) * 33 + 16 * ct + r16] - acc[r];
        const float* dd = sMM + (16 * ib + r16) * 68 + 16 * ib + 4 * g4;
        f32x4 xn = f32x4{0.f, 0.f, 0.f, 0.f};
#pragma unroll
        for (int s = 0; s < 4; ++s) xn = MFMA4(dd[s], rm[s], xn);
#pragma unroll
        for (int r = 0; r < 4; ++r) sV[(16 * ib + g4 * 4 + r) * 33 + 16 * ct + r16] = xn[r];
      }
      __syncthreads();
    }
#pragma unroll
    for (int t = 0; t < 3; ++t) {
      if (t < tcnt) {
        const int ti = (tcode >> (4 * t)) & 3, tn = (tcode >> (4 * t + 2)) & 3;
#pragma unroll
        for (int r = 0; r < 4; ++r) {
          const int i = 16 * ti + g4 * 4 + r, j = 16 * tn + r16;
          sMM[i * 68 + j] = (i >= j) ? attacc[t][r] * __expf(sGc[i] - sGc[j]) : 0.f;
        }
      }
    }
    __syncthreads();
    {
      f32x4 acc[2] = {f32x4{0.f, 0.f, 0.f, 0.f}, f32x4{0.f, 0.f, 0.f, 0.f}};
      const float eg = __expf(sGc[16 * w + r16]);
#pragma unroll
      for (int s = 0; s < 16; ++s) {
        const float a = qa[s] * eg;
        acc[0] = MFMA4(sS[(4 * s + g4) * 33 + r16], a, acc[0]);
        acc[1] = MFMA4(sS[(4 * s + g4) * 33 + 16 + r16], a, acc[1]);
      }
#pragma unroll
      for (int s = 0; s < 16; ++s) {
        if (s < 4 * (w + 1)) {
          const float a = sMM[(16 * w + r16) * 68 + 4 * s + g4];
          acc[0] = MFMA4(sV[(4 * s + g4) * 33 + r16], a, acc[0]);
          acc[1] = MFMA4(sV[(4 * s + g4) * 33 + 16 + r16], a, acc[1]);
        }
      }
      {
        const int pp = 16 * w + r16;
        const int u = d == 0 ? pp : 63 - pp;
        u16* op = p.MIX + (size_t)(t0 + tlo + u) * 1024 + d * 256 + h * 64 + vs * 32 + g4 * 4;
        *(uint2*)(op) = pack4(acc[0]);
        *(uint2*)(op + 16) = pack4(acc[1]);
      }
    }
    __syncthreads();
    {
      const float g63 = sGc[63];
      const float gl = __expf(g63);
#pragma unroll
      for (int nn = 0; nn < 2; ++nn)
#pragma unroll
        for (int r = 0; r < 4; ++r) Sreg[nn][r] *= gl;
#pragma unroll
      for (int s = 0; s < 16; ++s) {
        const int srow = 4 * s + g4;
        const float a = sK[srow * 65 + 16 * w + r16] * __expf(g63 - sGc[srow]);
        Sreg[0] = MFMA4(a, sV[srow * 33 + r16], Sreg[0]);
        Sreg[1] = MFMA4(a, sV[srow * 33 + 16 + r16], Sreg[1]);
      }
    }
    __syncthreads();
#pragma unroll
    for (int nn = 0; nn < 2; ++nn)
#pragma unroll
      for (int r = 0; r < 4; ++r) sS[(16 * w + g4 * 4 + r) * 33 + nn * 16 + r16] = Sreg[nn][r];
    __syncthreads();
  }
  if (!latent) {
    float* so = p.out + OUT_SGDN + ((((size_t)seq * 2 + l) * 2 + d) * 4 + h) * 4096;
#pragma unroll
    for (int nn = 0; nn < 2; ++nn)
#pragma unroll
      for (int r = 0; r < 4; ++r) so[(16 * w + g4 * 4 + r) * 64 + vs * 32 + nn * 16 + r16] = Sreg[nn][r];
  }
}

__device__ __forceinline__ void hgrn_chain(const Params& p, int l, int seq, int h, int d, int vs, float* sm) {
  float* sBC = sm;
  float* sK = sBC + 64 * 65;
  float* sAT = sK + 64 * 65;
  float* sV = sAT + 64 * 68;
  float* sS = sV + 64 * 33;
  float* sTot = sS + 64 * 33;
  const int tid = tid_l(), lane = tid & 63, w = tid >> 6, r16 = lane & 15, g4 = lane >> 4;
  const bool latent = seq >= 16;
  const int len = latent ? 4096 : 256;
  const int t0 = latent ? T_CTX + (seq - 16) * 4096 : seq * 256;
  const int nchunks = len >> 6;
  float lbk;
  {
    const int kch = h * 64 + (tid & 63);
    lbk = (l == 0) ? 0.f : sigmoidf_(p.hgrn_lb[256 + kch] - p.hgrn_lb[kch]);
  }
  f32x4 Sreg[2];
  __syncthreads();
  {
    const float* s0 = latent ? p.state_hgrn + ((((size_t)(seq - 16) * 2 + l) * 2 + d) * 4 + h) * 4096 : nullptr;
#pragma unroll
    for (int n = 0; n < 2; ++n)
#pragma unroll
      for (int r = 0; r < 4; ++r) {
        const int kidx = 16 * w + g4 * 4 + r, cc = n * 16 + r16;
        float v = latent ? s0[kidx * 64 + vs * 32 + cc] : 0.f;
        Sreg[n][r] = v;
        sS[kidx * 33 + cc] = v;
      }
  }
  const u16* Pb = p.P + (size_t)t0 * PW;
  float* sLb = sTot + 256;
  if (tid < 64) sLb[tid] = lbk;
  __syncthreads();
  int pgo[5];
#pragma unroll
  for (int i = 0; i < 5; ++i) {
    const int e = tid + i * 256;
    const int u = e / 20, un = e % 20;
    pgo[i] = u * PW + (un < 8 ? P_HF + d * 256 + h * 64 + un * 8 : (un < 12 ? P_HI + h * 64 + vs * 32 + (un - 8) * 8 : P_HQ + h * 64 + (un - 12) * 8));
  }
  uint4 pf[5];
  {
    const int tlo = d == 0 ? 0 : len - 64;
#pragma unroll
    for (int i = 0; i < 5; ++i) pf[i] = *(const uint4*)(Pb + (size_t)tlo * PW + pgo[i]);
  }
  for (int n = 0; n < nchunks; ++n) {
#pragma unroll
    for (int i = 0; i < 5; ++i) {
      const int e = tid + i * 256;
      const int u = e / 20, un = e % 20;
      const int pp = d == 0 ? u : 63 - u;
      const unsigned wv[4] = {pf[i].x, pf[i].y, pf[i].z, pf[i].w};
#pragma unroll
      for (int j = 0; j < 8; ++j) {
        const float x = bf2f((u16)((wv[j >> 1] >> ((j & 1) * 16)) & 0xffff));
        if (un < 8) {
          const int k = un * 8 + j;
          const float lb = sLb[k];
          const float sg_ = sigmoidf_(x);
          const float gate = lb + (1.f - lb) * sg_;
          sBC[pp * 65 + k] = __logf(fmaxf(gate, 1e-30f));
          sK[pp * 65 + k] = (1.f - lb) * (1.f - sg_);
        } else if (un < 12) {
          sV[pp * 33 + (un - 8) * 8 + j] = x;
        } else {
          sAT[pp * 68 + (un - 12) * 8 + j] = x;
        }
      }
    }
    __syncthreads();
    if (n + 1 < nchunks) {
      const int tlo2 = d == 0 ? (n + 1) * 64 : len - 64 * (n + 2);
#pragma unroll
      for (int i = 0; i < 5; ++i) pf[i] = *(const uint4*)(Pb + (size_t)tlo2 * PW + pgo[i]);
    }
    const int tlo = d == 0 ? n * 64 : len - 64 * (n + 1);
    float cs[16];
    {
      const int k = tid & 63, sg = tid >> 6;
      float run = 0.f;
#pragma unroll
      for (int i = 0; i < 16; ++i) { run += sBC[(16 * sg + i) * 65 + k]; cs[i] = run; }
      sTot[sg * 64 + k] = run;
    }
    float qa[16];
#pragma unroll
    for (int s = 0; s < 16; ++s) qa[s] = sAT[(16 * w + r16) * 68 + 4 * s + g4];
    __syncthreads();
    {
      const int k = tid & 63, sg = tid >> 6;
      float off = 0.f;
      for (int s2 = 0; s2 < sg; ++s2) off += sTot[s2 * 64 + k];
#pragma unroll
      for (int i = 0; i < 16; ++i) sBC[(16 * sg + i) * 65 + k] = cs[i] + off;
    }
    __syncthreads();
    {
      float aq[16], rf[16];
#pragma unroll
      for (int s = 0; s < 16; ++s) {
        const int kk = 4 * s + g4;
        rf[s] = (w == 0) ? 0.f : sBC[(16 * w - 1) * 65 + kk];
        aq[s] = qa[s] * __expf(sBC[(16 * w + r16) * 65 + kk] - rf[s]);
      }
#pragma unroll
      for (int nn = 0; nn < 4; ++nn) {
        f32x4 acc = f32x4{0.f, 0.f, 0.f, 0.f};
        if (nn <= w) {
#pragma unroll
          for (int s = 0; s < 16; ++s) {
            const int kk = 4 * s + g4, sc = 16 * nn + r16;
            const float bv = sK[sc * 65 + kk] * __expf(fminf(rf[s] - sBC[sc * 65 + kk], 80.f));
            acc = MFMA4(aq[s], bv, acc);
          }
        }
#pragma unroll
        for (int r = 0; r < 4; ++r) {
          const int i = 16 * w + g4 * 4 + r, j = 16 * nn + r16;
          sAT[i * 68 + j] = (i >= j) ? acc[r] : 0.f;
        }
      }
    }
    __syncthreads();
    {
      f32x4 acc[2] = {f32x4{0.f, 0.f, 0.f, 0.f}, f32x4{0.f, 0.f, 0.f, 0.f}};
#pragma unroll
      for (int s = 0; s < 16; ++s) {
        const int kk = 4 * s + g4;
        const float a = qa[s] * __expf(sBC[(16 * w + r16) * 65 + kk]);
        acc[0] = MFMA4(sS[kk * 33 + r16], a, acc[0]);
        acc[1] = MFMA4(sS[kk * 33 + 16 + r16], a, acc[1]);
      }
#pragma unroll
      for (int s = 0; s < 16; ++s) {
        if (s < 4 * (w + 1)) {
          const float a = sAT[(16 * w + r16) * 68 + 4 * s + g4];
          acc[0] = MFMA4(sV[(4 * s + g4) * 33 + r16], a, acc[0]);
          acc[1] = MFMA4(sV[(4 * s + g4) * 33 + 16 + r16], a, acc[1]);
        }
      }
      {
        const int pp = 16 * w + r16;
        const int u = d == 0 ? pp : 63 - pp;
        u16* op = p.MIX + (size_t)(t0 + tlo + u) * 1024 + 512 + d * 256 + h * 64 + vs * 32 + g4 * 4;
        *(uint2*)(op) = pack4(acc[0]);
        *(uint2*)(op + 16) = pack4(acc[1]);
      }
    }
    __syncthreads();
    {
#pragma unroll
      for (int nn = 0; nn < 2; ++nn)
#pragma unroll
        for (int r = 0; r < 4; ++r) Sreg[nn][r] *= __expf(sBC[63 * 65 + 16 * w + g4 * 4 + r]);
      const int kA = 16 * w + r16;
      const float blA = sBC[63 * 65 + kA];
#pragma unroll
      for (int s = 0; s < 16; ++s) {
        const int srow = 4 * s + g4;
        const float a = sK[srow * 65 + kA] * __expf(blA - sBC[srow * 65 + kA]);
        Sreg[0] = MFMA4(a, sV[srow * 33 + r16], Sreg[0]);
        Sreg[1] = MFMA4(a, sV[srow * 33 + 16 + r16], Sreg[1]);
      }
    }
    __syncthreads();
#pragma unroll
    for (int nn = 0; nn < 2; ++nn)
#pragma unroll
      for (int r = 0; r < 4; ++r) sS[(16 * w + g4 * 4 + r) * 33 + nn * 16 + r16] = Sreg[nn][r];
    __syncthreads();
  }
  if (!latent) {
    float* so = p.out + OUT_SHG + ((((size_t)seq * 2 + l) * 2 + d) * 4 + h) * 4096;
#pragma unroll
    for (int nn = 0; nn < 2; ++nn)
#pragma unroll
      for (int r = 0; r < 4; ++r) so[(16 * w + g4 * 4 + r) * 64 + vs * 32 + nn * 16 + r16] = Sreg[nn][r];
  }
}

__device__ __forceinline__ void phase_c(const Params& p, int l, unsigned char* smraw, int mode = 0) {
  __shared__ int s_item;
  const int total = 1920;
  const bool paired = (gridDim.x == 512);
  const int jx = blockIdx.x >> 3;
  int my_static = -1;
  if (paired && (jx & 31) < 16) my_static = (blockIdx.x & 7) * 32 + (jx >> 5) * 16 + (jx & 15);
  for (;;) {
    __syncthreads();
    if (tid_l() == 0) {
      if (my_static >= 0) s_item = my_static;
      else s_item = (paired ? 256 : 0) + (int)atomicAdd(&p.counters[l * 64 + mode * 16], 1u);
    }
    __syncthreads();
    my_static = -1;
    const int item = s_item;
    if (item >= total) break;
    int kind, a0, a1, a2, a3;
    if (item < 256 || (item >= 1280 && item < 1792)) {
      const int i2 = item < 256 ? item : item - 1280;
      const int rest = i2 >> 1;
      kind = i2 & 1;
      a3 = rest & 1; a2 = (rest >> 1) & 1; a1 = (rest >> 2) & 3; a0 = (rest >> 4) + (item < 256 ? 16 : 0);
    } else if (item < 1280) {
      const int i2 = item - 256;
      kind = 2; a0 = 1; a1 = i2 >> 7; a2 = (i2 >> 5) & 3; a3 = i2 & 31;
    } else {
      const int i2 = item - 1792;
      kind = 2; a0 = 0; a1 = i2 >> 3; a2 = (i2 >> 1) & 3; a3 = i2 & 1;
    }
    if (mode == 1 && kind == 2) continue;
    if (mode == 2 && kind != 2) continue;
    if (kind != 2) __builtin_amdgcn_s_setprio(3);
    if (kind == 0) gdn_chain(p, l, a0, a1, a2, a3, (float*)smraw);
    else if (kind == 1) hgrn_chain(p, l, a0, a1, a2, a3, (float*)smraw);
    if (kind != 2) __builtin_amdgcn_s_setprio(0);
    else attn_item(p, a0, a1, a2, a3, smraw, mode == 2);
  }
}

__global__ void __launch_bounds__(NTHR, 2) mega(Params p) {
  __shared__ __attribute__((aligned(16))) unsigned char smem[LDS_BYTES];
  cg::grid_group grid = cg::this_grid();
  __shared__ uint4 xb_words;
  if (threadIdx.x == 0) xb_words = make_uint4(0u, 0u, 0u, 0u);
  __syncthreads();
  {
    XcdBarrier xb0 = xcd_barrier_post(p.xbar, (volatile LAS unsigned*)&xb_words);
    if (threadIdx.x == 0) ((volatile LAS unsigned*)&xb_words)[2] = xb0.x;
  }
#define GSYNC() do { XcdBarrier xb_; xb_.bar = p.xbar; xb_.st = (volatile LAS unsigned*)&xb_words; xb_.x = 0; \
    if (threadIdx.x == 0) xb_.x = ((volatile LAS unsigned*)&xb_words)[2]; xcd_barrier(xb_); } while (0)
  phase0(p, (float*)smem);
  if (p.out == nullptr) grid.sync();
  GSYNC();
  rowpass_norm(p, 0, 0);
  GSYNC();
  for (int l = 0; l < 2; ++l) {
    phase_a(p, l, (u16*)smem);
    GSYNC();
    rowpass_b0(p, l);
    GSYNC();
    phase_b1(p, l, (u16*)smem);
    GSYNC();
    rowpass_b2(p, l);
    GSYNC();
    phase_c(p, l, smem);
    GSYNC();
    rowpass_c2(p, l);
    GSYNC();
    phase_gemm_y(p.MIX, 1024, p.WoutT + (size_t)l * 1024 * 1024, 1024, 1024, p.HQ, 1024, (u16*)smem);
    GSYNC();
    rowpass_norm(p, l, 1);
    GSYNC();
    phase_e(p, l, (u16*)smem);
    GSYNC();
    phase_gemm_y(p.P, DFF, p.WfoT + (size_t)l * 1024 * DFF, DFF, 1024, p.HQ, 1024, (u16*)smem);
    GSYNC();
    rowpass_norm(p, l, 2);
    if (l == 0) GSYNC();
  }
}

extern "C" void kernel_launch(void* const* d_in, const int* in_sizes, int n_in, void* d_out, int out_size, void* d_ws,
                              size_t ws_size, hipStream_t stream) {
  static int grid_blocks = 0;
  if (!grid_blocks) {
    int dev = 0, cus = 0, per_cu = 0;
    hipGetDevice(&dev);
    hipDeviceGetAttribute(&cus, hipDeviceAttributeMultiprocessorCount, dev);
    hipOccupancyMaxActiveBlocksPerMultiprocessor(&per_cu, mega, NTHR, 0);
    if (per_cu > 2) per_cu = 2;
    if (per_cu < 1) per_cu = 1;
    grid_blocks = cus * per_cu;
  }
  Params p{};
  const float* const* in = (const float* const*)d_in;
  p.x_prompt = in[0]; p.x_sample = in[1]; p.cache_ckv = in[2]; p.cache_kr = in[3]; p.state_gdn = in[4]; p.state_hgrn = in[5];
  p.c = in[6]; p.c_ctx = in[7]; p.w_ada = in[8]; p.b_ada = in[9]; p.g_pre_mix = in[10]; p.g_post_mix = in[11];
  p.g_pre_ffn = in[12]; p.g_post_ffn = in[13]; p.w_in = in[14]; p.w_out = in[15]; p.gdn_conv_w = in[16];
  p.gdn_a_log = in[17]; p.gdn_dt_bias = in[18]; p.gdn_norm_w = in[19]; p.hgrn_lb = in[20]; p.hgrn_norm_w = in[21];
  p.mla_q_norm_w = in[22]; p.mla_w_uq = in[23]; p.mla_kv_norm_w = in[24]; p.mla_w_ukv = in[25]; p.w_ffn_in = in[26];
  p.w_ffn_out = in[27];
  p.out = (float*)d_out;
  unsigned char* ws = (unsigned char*)d_ws;
  size_t off = 0;
  auto take = [&](size_t bytes) { unsigned char* r = ws + off; off += (bytes + 255) & ~(size_t)255; return r; };
  p.counters = (unsigned*)take(1024);
  p.xbar = (unsigned*)take(16384);
  p.WinT = (u16*)take((size_t)2 * 3072 * 1024 * 2);
  p.WuqT = (u16*)take((size_t)2 * 768 * 384 * 2);
  p.WukvT = (u16*)take((size_t)2 * 1024 * 256 * 2);
  p.WoutT = (u16*)take((size_t)2 * 1024 * 1024 * 2);
  p.WfiT = (u16*)take((size_t)2 * 5632 * 1024 * 2);
  p.WfoT = (u16*)take((size_t)2 * 1024 * 2816 * 2);
  p.mod = (float*)take((size_t)2 * 9 * 6144 * 4);
  p.HQ = (u16*)take((size_t)T_ALL * 1024 * 2);
  p.P = (u16*)take((size_t)T_ALL * PW * 2);
  p.KN = (u16*)take((size_t)(T_ALL + 2048) * 512 * 2);
  p.VTL = (u16*)take((size_t)8 * 4 * 128 * 4352 * 2);
  p.VTC = (u16*)take((size_t)16 * 4 * 128 * 256 * 2);
  p.CKVC = (u16*)take((size_t)2048 * 256 * 2);
  p.KRC = (u16*)take((size_t)2048 * 64 * 2);
  p.GAB = (float*)take((size_t)T_ALL * 16 * 4);
  p.MIX = (u16*)take((size_t)T_ALL * 1024 * 2);
  if (off > ws_size) { fprintf(stderr, "workspace too small: need %zu have %zu\n", off, ws_size); return; }
  hipMemsetAsync(p.counters, 0, 1024 + 16384, stream);
  void* args[] = {&p};
  hipError_t e = hipLaunchCooperativeKernel((void*)mega, dim3(grid_blocks), dim3(NTHR), args, 0, stream);
  if (e != hipSuccess) fprintf(stderr, "cooperative launch failed: %s (grid %d)\n", hipGetErrorString(e), grid_blocks);
}
```

```cpp
#include <hip/hip_runtime.h>
#include <hip/hip_cooperative_groups.h>
#include <cstdio>
namespace cg = cooperative_groups;

typedef unsigned short u16;
using bf16x8 = __attribute__((ext_vector_type(8))) short;
using f32x4  = __attribute__((ext_vector_type(4))) float;

#define T_CTX 4096
#define T_ALL 36864
#define PW 3072
#define DFF 2816
#define LDS_BYTES 73728
#define NTHR 256

#define P_GQKV 0
#define P_GZ 768
#define P_HQ 1024
#define P_HI 1280
#define P_HF 1536
#define P_HG 2048
#define P_MCQ 2304
#define P_MCKV 2688
#define P_MKR 2944
#define P_GA 3008

struct Params {
  const float *x_prompt, *x_sample, *cache_ckv, *cache_kr, *state_gdn, *state_hgrn, *c, *c_ctx;
  const float *w_ada, *b_ada, *g_pre_mix, *g_post_mix, *g_pre_ffn, *g_post_ffn, *w_in, *w_out;
  const float *gdn_conv_w, *gdn_a_log, *gdn_dt_bias, *gdn_norm_w, *hgrn_lb, *hgrn_norm_w;
  const float *mla_q_norm_w, *mla_w_uq, *mla_kv_norm_w, *mla_w_ukv, *w_ffn_in, *w_ffn_out;
  float* out;
  u16 *WinT, *WuqT, *WukvT, *WoutT, *WfiT, *WfoT;
  float* mod;
  u16 *HQ, *P, *KN, *VTL, *VTC, *CKVC, *KRC, *MIX;
  float* GAB;
  unsigned* counters;
  unsigned* xbar;
};

#define OUT_CKV   37748736
#define OUT_KR    39845888
#define OUT_SGDN  40370176
#define OUT_SHG   41418752

__device__ __forceinline__ u16 f2bf(float f) {
  unsigned u = __float_as_uint(f);
  u += 0x7fffu + ((u >> 16) & 1u);
  return (u16)(u >> 16);
}
__device__ __forceinline__ float bf2f(u16 h) { return __uint_as_float(((unsigned)h) << 16); }
__device__ __forceinline__ float wave_sum(float v) {
#pragma unroll
  for (int o = 32; o > 0; o >>= 1) v += __shfl_xor(v, o);
  return v;
}
__device__ __forceinline__ float sigmoidf_(float x) { return __builtin_amdgcn_rcpf(1.f + __expf(-x)); }
__device__ __forceinline__ float siluf_(float x) { return x * __builtin_amdgcn_rcpf(1.f + __expf(-x)); }
__device__ __forceinline__ int tid_l() { int t = threadIdx.x; asm volatile("" : "+v"(t)); return t; }
__device__ __forceinline__ int tok_mod(int t) { return t < T_CTX ? 0 : 1 + ((t - T_CTX) >> 12); }

__device__ __forceinline__ int map_col(int kind, int j) {
  if (kind == 0) return j;
  if (kind == 1) { if (j < 1024) return j; if (j < 3008) return j + 16; if (j < 3024) return 1024 + (j - 3008); return -1; }
  int blk = j >> 6, w = j & 63;
  return w < 32 ? blk * 32 + w : DFF + blk * 32 + (w - 32);
}

__device__ __forceinline__ void cvt_tile(const float* __restrict__ src, int K, int Nsrc, u16* __restrict__ dst, int kind, int jt, int kt, float* sm) {
  const int tid = tid_l();
  const int j0 = jt * 64, k0 = kt * 64;
  __syncthreads();
  {
    int jj = tid & 63, kk0 = tid >> 6;
    int sc = map_col(kind, j0 + jj);
    for (int kk = kk0; kk < 64; kk += 4)
      sm[kk * 65 + jj] = sc >= 0 ? src[(size_t)(k0 + kk) * Nsrc + sc] : 0.f;
  }
  __syncthreads();
  {
    const int kq = tid & 15, jj0 = tid >> 4;
#pragma unroll
    for (int jj = jj0; jj < 64; jj += 16) {
      uint2 o;
      o.x = (unsigned)f2bf(sm[(4 * kq + 0) * 65 + jj]) | ((unsigned)f2bf(sm[(4 * kq + 1) * 65 + jj]) << 16);
      o.y = (unsigned)f2bf(sm[(4 * kq + 2) * 65 + jj]) | ((unsigned)f2bf(sm[(4 * kq + 3) * 65 + jj]) << 16);
      *(uint2*)(dst + (size_t)(j0 + jj) * K + k0 + 4 * kq) = o;
    }
  }
}

__device__ __forceinline__ void mod_item(const Params& p, int item, float* sm) {
  const int l = item / 96, j0 = (item % 96) * 64;
  const int tid = tid_l();
  float* sC = sm;
  float* sR = sm + 9 * 1024;
  __syncthreads();
  for (int i = tid; i < 9 * 1024; i += NTHR) {
    int m = i >> 10, k = i & 1023;
    float v = m == 0 ? p.c_ctx[k] : p.c[(m - 1) * 1024 + k];
    sC[i] = siluf_(v);
  }
  __syncthreads();
  const int col = tid & 63, ks = tid >> 6;
  float acc[9];
#pragma unroll
  for (int m = 0; m < 9; ++m) acc[m] = 0.f;
  const float* wp = p.w_ada + (size_t)l * 1024 * 6144 + j0 + col;
  for (int k = ks * 256; k < ks * 256 + 256; k += 8) {
    float wv[8];
#pragma unroll
    for (int u = 0; u < 8; ++u) wv[u] = wp[(size_t)(k + u) * 6144];
#pragma unroll
    for (int u = 0; u < 8; ++u)
#pragma unroll
      for (int m = 0; m < 9; ++m) acc[m] += sC[m * 1024 + k + u] * wv[u];
  }
#pragma unroll
  for (int m = 0; m < 9; ++m) sR[(ks * 9 + m) * 64 + col] = acc[m];
  __syncthreads();
  for (int i = tid; i < 9 * 64; i += NTHR) {
    int m = i >> 6, cc = i & 63;
    float v = sR[(0 * 9 + m) * 64 + cc] + sR[(1 * 9 + m) * 64 + cc] + sR[(2 * 9 + m) * 64 + cc] + sR[(3 * 9 + m) * 64 + cc];
    p.mod[((size_t)l * 9 + m) * 6144 + j0 + cc] = v + p.b_ada[l * 6144 + j0 + cc];
  }
}

__device__ __forceinline__ void phase0(const Params& p, float* sm) {
  const int PER_LAYER = 3272;
  const int total = 2 * PER_LAYER + 192;
  for (int item = blockIdx.x; item < total; item += gridDim.x) {
    if (item < 192) { mod_item(p, item, sm); continue; }
    int it = item - 192;
    int l = it / PER_LAYER, r = it % PER_LAYER;
    if (r < 768) { cvt_tile(p.w_in + (size_t)l * 1024 * 3024, 1024, 3024, p.WinT + (size_t)l * 3072 * 1024, 1, r / 16, r % 16, sm); continue; }
    r -= 768;
    if (r < 72) { cvt_tile(p.mla_w_uq + (size_t)l * 384 * 768, 384, 768, p.WuqT + (size_t)l * 768 * 384, 0, r / 6, r % 6, sm); continue; }
    r -= 72;
    if (r < 64) { cvt_tile(p.mla_w_ukv + (size_t)l * 256 * 1024, 256, 1024, p.WukvT + (size_t)l * 1024 * 256, 0, r / 4, r % 4, sm); continue; }
    r -= 64;
    if (r < 256) { cvt_tile(p.w_out + (size_t)l * 1024 * 1024, 1024, 1024, p.WoutT + (size_t)l * 1024 * 1024, 0, r / 16, r % 16, sm); continue; }
    r -= 256;
    if (r < 1408) { cvt_tile(p.w_ffn_in + (size_t)l * 1024 * 5632, 1024, 5632, p.WfiT + (size_t)l * 5632 * 1024, 2, r / 16, r % 16, sm); continue; }
    r -= 1408;
    cvt_tile(p.w_ffn_out + (size_t)l * 2816 * 1024, 2816, 1024, p.WfoT + (size_t)l * 1024 * 2816, 0, r / 44, r % 44, sm);
  }
}

__device__ __forceinline__ void rowpass_norm(const Params& p, int l, int stage) {
  const int tidl = tid_l();
  const int lane = tidl & 63, w = tidl >> 6;
  const int ln = stage == 0 ? 0 : (stage == 1 ? l : l + 1);
  const int sh_off = stage == 1 ? 3072 : 0;
  const float* gpre = stage == 1 ? p.g_pre_ffn + l * 1024 : p.g_pre_mix + (ln < 2 ? ln : 0) * 1024;
  u16* dst = stage == 1 ? p.MIX : p.HQ;
  for (int t = blockIdx.x * 4 + w; t < T_ALL; t += gridDim.x * 4) {
    const int m = tok_mod(t);
    float x[16];
    float* xo = p.out + (size_t)t * 1024;
    if (stage == 0) {
      const float* xi = t < T_CTX ? p.x_prompt + (size_t)t * 1024 : p.x_sample + (size_t)(t - T_CTX) * 1024;
#pragma unroll
      for (int i = 0; i < 4; ++i) {
        float4 v = *(const float4*)(xi + i * 256 + lane * 4);
        x[i * 4 + 0] = v.x; x[i * 4 + 1] = v.y; x[i * 4 + 2] = v.z; x[i * 4 + 3] = v.w;
      }
    } else {
      const u16* yp = p.HQ + (size_t)t * 1024;
      float y[16]; float ss = 0.f;
#pragma unroll
      for (int i = 0; i < 4; ++i) {
        uint2 v = *(const uint2*)(yp + i * 256 + lane * 4);
        y[i * 4 + 0] = bf2f((u16)(v.x & 0xffff)); y[i * 4 + 1] = bf2f((u16)(v.x >> 16));
        y[i * 4 + 2] = bf2f((u16)(v.y & 0xffff)); y[i * 4 + 3] = bf2f((u16)(v.y >> 16));
      }
#pragma unroll
      for (int i = 0; i < 16; ++i) ss += y[i] * y[i];
      ss = wave_sum(ss);
      const float rstd = rsqrtf(ss * (1.f / 1024.f) + 1e-6f);
      const float* gpost = (stage == 1 ? p.g_post_mix : p.g_post_ffn) + l * 1024;
      const float* gt = p.mod + ((size_t)l * 9 + m) * 6144 + (stage == 1 ? 2048 : 5120);
#pragma unroll
      for (int i = 0; i < 4; ++i) {
        float4 xv = *(const float4*)(xo + i * 256 + lane * 4);
        float4 gp = *(const float4*)(gpost + i * 256 + lane * 4);
        float4 gg = *(const float4*)(gt + i * 256 + lane * 4);
        x[i * 4 + 0] = xv.x + gg.x * y[i * 4 + 0] * rstd * gp.x;
        x[i * 4 + 1] = xv.y + gg.y * y[i * 4 + 1] * rstd * gp.y;
        x[i * 4 + 2] = xv.z + gg.z * y[i * 4 + 2] * rstd * gp.z;
        x[i * 4 + 3] = xv.w + gg.w * y[i * 4 + 3] * rstd * gp.w;
      }
    }
    __threadfence_block();
#pragma unroll
    for (int i = 0; i < 4; ++i)
      *(float4*)(xo + i * 256 + lane * 4) = make_float4(x[i * 4 + 0], x[i * 4 + 1], x[i * 4 + 2], x[i * 4 + 3]);
    if (ln >= 2) continue;
    float ss = 0.f;
#pragma unroll
    for (int i = 0; i < 16; ++i) ss += x[i] * x[i];
    ss = wave_sum(ss);
    const float rstd = rsqrtf(ss * (1.f / 1024.f) + 1e-6f);
    const float* sh = p.mod + ((size_t)ln * 9 + m) * 6144 + sh_off;
    const float* sc = sh + 1024;
    u16* hp = dst + (size_t)t * 1024;
#pragma unroll
    for (int i = 0; i < 4; ++i) {
      float4 gp = *(const float4*)(gpre + i * 256 + lane * 4);
      float4 s1 = *(const float4*)(sh + i * 256 + lane * 4);
      float4 c1 = *(const float4*)(sc + i * 256 + lane * 4);
      float h0 = x[i * 4 + 0] * rstd * gp.x * (1.f + c1.x) + s1.x;
      float h1 = x[i * 4 + 1] * rstd * gp.y * (1.f + c1.y) + s1.y;
      float h2 = x[i * 4 + 2] * rstd * gp.z * (1.f + c1.z) + s1.z;
      float h3 = x[i * 4 + 3] * rstd * gp.w * (1.f + c1.w) + s1.w;
      uint2 o;
      o.x = (unsigned)f2bf(h0) | ((unsigned)f2bf(h1) << 16);
      o.y = (unsigned)f2bf(h2) | ((unsigned)f2bf(h3) << 16);
      *(uint2*)(hp + i * 256 + lane * 4) = o;
    }
  }
}

__device__ __forceinline__ void unpack8(const uint4 v, float (&f)[8]);
__device__ __forceinline__ uint4 pack8(const float (&f)[8]);
__device__ __forceinline__ void rowpass_b0(const Params& p, int l) {
  const int tidl = tid_l();
  const int lane = tidl & 63, w = tidl >> 6;
  for (int t = blockIdx.x * 4 + w; t < T_ALL + 2048; t += gridDim.x * 4) {
    if (t >= T_ALL) {
      const int r = t - T_ALL, b = r >> 8, s = r & 255;
      if (lane < 32) {
        const float* ck = p.cache_ckv + (((size_t)b * 2 + l) * 256 + s) * 256 + lane * 8;
        const float4 x0 = *(const float4*)ck, x1 = *(const float4*)(ck + 4);
        const float f[8] = {x0.x, x0.y, x0.z, x0.w, x1.x, x1.y, x1.z, x1.w};
        *(uint4*)(p.CKVC + (size_t)r * 256 + lane * 8) = pack8(f);
      } else if (lane < 40) {
        const float* kr = p.cache_kr + (((size_t)b * 2 + l) * 256 + s) * 64 + (lane - 32) * 8;
        const float4 x0 = *(const float4*)kr, x1 = *(const float4*)(kr + 4);
        const float f[8] = {x0.x, x0.y, x0.z, x0.w, x1.x, x1.y, x1.z, x1.w};
        *(uint4*)(p.KRC + (size_t)r * 64 + (lane - 32) * 8) = pack8(f);
      }
      continue;
    }
    u16* pr = p.P + (size_t)t * PW;
    {
      float f[8]; float ss = 0.f;
      if (lane < 48) {
        unpack8(*(const uint4*)(pr + P_MCQ + lane * 8), f);
#pragma unroll
        for (int i = 0; i < 8; ++i) ss += f[i] * f[i];
      }
      ss = wave_sum(ss);
      const float rstd = rsqrtf(ss * (1.f / 384.f) + 1e-6f);
      if (lane < 48) {
        const float* wq = p.mla_q_norm_w + l * 384 + lane * 8;
        const float4 w0 = *(const float4*)wq, w1 = *(const float4*)(wq + 4);
        f[0] *= rstd * w0.x; f[1] *= rstd * w0.y; f[2] *= rstd * w0.z; f[3] *= rstd * w0.w;
        f[4] *= rstd * w1.x; f[5] *= rstd * w1.y; f[6] *= rstd * w1.z; f[7] *= rstd * w1.w;
        *(uint4*)(pr + P_MCQ + lane * 8) = pack8(f);
      }
    }
    {
      float f[8]; float ss = 0.f;
      if (lane < 32) {
        unpack8(*(const uint4*)(pr + P_MCKV + lane * 8), f);
#pragma unroll
        for (int i = 0; i < 8; ++i) ss += f[i] * f[i];
      }
      ss = wave_sum(ss);
      const float rstd = rsqrtf(ss * (1.f / 256.f) + 1e-6f);
      if (lane < 32) {
        const float* wk = p.mla_kv_norm_w + l * 256 + lane * 8;
        const float4 w0 = *(const float4*)wk, w1 = *(const float4*)(wk + 4);
        f[0] *= rstd * w0.x; f[1] *= rstd * w0.y; f[2] *= rstd * w0.z; f[3] *= rstd * w0.w;
        f[4] *= rstd * w1.x; f[5] *= rstd * w1.y; f[6] *= rstd * w1.z; f[7] *= rstd * w1.w;
        *(uint4*)(pr + P_MCKV + lane * 8) = pack8(f);
        if (t < T_CTX) {
          const int b = t >> 8, s = t & 255;
          float* op = p.out + OUT_CKV + (((size_t)b * 2 + l) * 256 + s) * 256 + lane * 8;
          *(float4*)op = make_float4(f[0], f[1], f[2], f[3]);
          *(float4*)(op + 4) = make_float4(f[4], f[5], f[6], f[7]);
        }
      }
    }
    {
      float v = bf2f(pr[P_MKR + lane]);
      if (t < T_CTX) {
        int b = t >> 8, s = t & 255;
        p.out[OUT_KR + (((size_t)b * 2 + l) * 256 + s) * 64 + lane] = v;
      } else {
        int pos = (t - T_CTX) & 4095;
        int axis = lane >> 5, half = (lane >> 4) & 1, f = lane & 15;
        float posf = axis == 0 ? (float)(pos >> 6) : (float)(pos & 63);
        float inv = exp2f(-(float)f * (13.287712379549449f / 16.f));
        float ang = posf * inv;
        float sn, cs;
        __sincosf(ang, &sn, &cs);
        float other = __shfl_xor(v, 16);
        float o = half == 0 ? v * cs - other * sn : v * cs + other * sn;
        pr[P_MKR + lane] = f2bf(o);
      }
    }
  }
}

#define P_QH 2304
#define P_KH 2560
__device__ __forceinline__ void rowpass_b2(const Params& p, int l) {
  const int tidl = tid_l();
  const int lane = tidl & 63, w = tidl >> 6;
  float cw[8][5], cv[8][5];
#pragma unroll
  for (int e = 0; e < 8; ++e)
#pragma unroll
    for (int j = 0; j < 5; ++j) {
      cw[e][j] = p.gdn_conv_w[((size_t)l * 768 + 8 * lane + e) * 5 + j];
      cv[e][j] = p.gdn_conv_w[((size_t)l * 768 + 512 + 8 * (lane & 31) + e) * 5 + j];
    }
  u16* VH = p.HQ + (size_t)T_ALL * 768;
  for (int t = blockIdx.x * 4 + w; t < T_ALL; t += gridDim.x * 4) {
    const int len = t < T_CTX ? 256 : 4096;
    const int tau = t < T_CTX ? (t & 255) : ((t - T_CTX) & 4095);
    float y[8], yv[8];
#pragma unroll
    for (int e = 0; e < 8; ++e) { y[e] = 0.f; yv[e] = 0.f; }
#pragma unroll
    for (int j = 0; j < 5; ++j) {
      const int tt = tau + j - 2;
      if (tt >= 0 && tt < len) {
        const u16* pr = p.P + (size_t)(t + j - 2) * PW;
        float f[8];
        unpack8(*(const uint4*)(pr + 8 * lane), f);
#pragma unroll
        for (int e = 0; e < 8; ++e) y[e] += cw[e][j] * f[e];
        if (lane < 32) {
          unpack8(*(const uint4*)(pr + 512 + 8 * lane), f);
#pragma unroll
          for (int e = 0; e < 8; ++e) yv[e] += cv[e][j] * f[e];
        }
      }
    }
    float ss = 0.f;
#pragma unroll
    for (int e = 0; e < 8; ++e) { y[e] = siluf_(y[e]); yv[e] = siluf_(yv[e]); ss += y[e] * y[e]; }
    ss += __shfl_xor(ss, 1); ss += __shfl_xor(ss, 2); ss += __shfl_xor(ss, 4);
    const float rn = rsqrtf(ss + 1e-6f) * (lane < 32 ? 0.125f : 1.f);
#pragma unroll
    for (int e = 0; e < 8; ++e) y[e] *= rn;
    *(uint4*)(p.P + (size_t)t * PW + P_QH + 8 * lane) = pack8(y);
    if (lane < 32) *(uint4*)(VH + (size_t)t * 256 + 8 * lane) = pack8(yv);
  }
}

__device__ __forceinline__ void unpack8(const uint4 v, float (&f)[8]) {
  f[0] = bf2f((u16)(v.x & 0xffff)); f[1] = bf2f((u16)(v.x >> 16)); f[2] = bf2f((u16)(v.y & 0xffff)); f[3] = bf2f((u16)(v.y >> 16));
  f[4] = bf2f((u16)(v.z & 0xffff)); f[5] = bf2f((u16)(v.z >> 16)); f[6] = bf2f((u16)(v.w & 0xffff)); f[7] = bf2f((u16)(v.w >> 16));
}
__device__ __forceinline__ uint4 pack8(const float (&f)[8]) {
  uint4 o;
  o.x = (unsigned)f2bf(f[0]) | ((unsigned)f2bf(f[1]) << 16); o.y = (unsigned)f2bf(f[2]) | ((unsigned)f2bf(f[3]) << 16);
  o.z = (unsigned)f2bf(f[4]) | ((unsigned)f2bf(f[5]) << 16); o.w = (unsigned)f2bf(f[6]) | ((unsigned)f2bf(f[7]) << 16);
  return o;
}
__device__ __forceinline__ void rowpass_c2(const Params& p, int l) {
  const int tidl = tid_l();
  const int lane = tidl & 63, w = tidl >> 6;
  const int hl = lane & 31, isH = lane >> 5;
  const float* nw = (isH ? p.hgrn_norm_w : p.gdn_norm_w) + l * 64 + (hl & 7) * 8;
  const float4 w0 = *(const float4*)(nw), w1 = *(const float4*)(nw + 4);
  const float wv[8] = {w0.x, w0.y, w0.z, w0.w, w1.x, w1.y, w1.z, w1.w};
  for (int t = blockIdx.x * 4 + w; t < T_ALL; t += gridDim.x * 4) {
    u16* mr = p.MIX + (size_t)t * 1024;
    const u16* pr = p.P + (size_t)t * PW;
    const u16* qr = p.HQ + (size_t)t * 768;
    const uint4 vf = *(const uint4*)(mr + isH * 512 + hl * 8);
    const uint4 vb = *(const uint4*)(mr + isH * 512 + 256 + hl * 8);
    const uint4 vg = *(const uint4*)(pr + (isH ? P_HG : P_GZ) + hl * 8);
    const int c0 = lane * 8;
    const uint4 vo = *(const uint4*)(qr + (c0 >> 7) * 192 + (c0 & 127));
    float f[8], bb[8], g[8];
    unpack8(vf, f); unpack8(vb, bb); unpack8(vg, g);
    float ss = 0.f;
#pragma unroll
    for (int i = 0; i < 8; ++i) { f[i] += bb[i]; ss += f[i] * f[i]; }
    ss += __shfl_xor(ss, 1); ss += __shfl_xor(ss, 2); ss += __shfl_xor(ss, 4);
    const float rn = rsqrtf(ss * (1.f / 64.f) + 1e-6f);
#pragma unroll
    for (int i = 0; i < 8; ++i) f[i] = f[i] * rn * wv[i] * (isH ? sigmoidf_(g[i]) : siluf_(g[i]));
    __threadfence_block();
    *(uint4*)(mr + isH * 256 + hl * 8) = pack8(f);
    *(uint4*)(mr + 512 + c0) = vo;
  }
}

__device__ __forceinline__ void gemm128(const u16* __restrict__ A, int lda, const u16* __restrict__ B, int ldb, int K,
                                        u16* lds, f32x4 (&acc)[4][4]) {
  const int tid = tid_l(), lane = tid & 63, w = tid >> 6, wm = w >> 1, wn = w & 1;
  const int r16 = lane & 15, g4 = lane >> 4;
#pragma unroll
  for (int i = 0; i < 4; ++i)
#pragma unroll
    for (int j = 0; j < 4; ++j) acc[i][j] = f32x4{0.f, 0.f, 0.f, 0.f};
  const int lrow = tid >> 3, lkc = tid & 7;
  const u16* ap = A + (size_t)lrow * lda + lkc * 8;
  const u16* bp = B + (size_t)lrow * ldb + lkc * 8;
  const size_t sa32 = (size_t)32 * lda, sb32 = (size_t)32 * ldb;
  uint4 ra0 = *(const uint4*)(ap), ra1 = *(const uint4*)(ap + sa32), ra2 = *(const uint4*)(ap + 2 * sa32), ra3 = *(const uint4*)(ap + 3 * sa32);
  uint4 rb0 = *(const uint4*)(bp), rb1 = *(const uint4*)(bp + sb32), rb2 = *(const uint4*)(bp + 2 * sb32), rb3 = *(const uint4*)(bp + 3 * sb32);
  const int woff = lrow * 64 + ((lkc ^ (lrow & 7)) * 8);
  const int sw = r16 & 7;
  const int fa0 = (wm * 64 + r16) * 64 + ((g4 ^ sw) * 8);
  const int fa1 = (wm * 64 + r16) * 64 + (((4 + g4) ^ sw) * 8);
  const int fb0 = 128 * 64 + (wn * 64 + r16) * 64 + ((g4 ^ sw) * 8);
  const int fb1 = 128 * 64 + (wn * 64 + r16) * 64 + (((4 + g4) ^ sw) * 8);
  const int nk = K >> 6;
  __syncthreads();
  {
    u16* wa = lds + woff; u16* wb = lds + 128 * 64 + woff;
    *(uint4*)(wa) = ra0; *(uint4*)(wa + 32 * 64) = ra1; *(uint4*)(wa + 64 * 64) = ra2; *(uint4*)(wa + 96 * 64) = ra3;
    *(uint4*)(wb) = rb0; *(uint4*)(wb + 32 * 64) = rb1; *(uint4*)(wb + 64 * 64) = rb2; *(uint4*)(wb + 96 * 64) = rb3;
  }
  if (nk > 1) {
    const u16* a2 = ap + 64; const u16* b2 = bp + 64;
    ra0 = *(const uint4*)(a2); ra1 = *(const uint4*)(a2 + sa32); ra2 = *(const uint4*)(a2 + 2 * sa32); ra3 = *(const uint4*)(a2 + 3 * sa32);
    rb0 = *(const uint4*)(b2); rb1 = *(const uint4*)(b2 + sb32); rb2 = *(const uint4*)(b2 + 2 * sb32); rb3 = *(const uint4*)(b2 + 3 * sb32);
  }
  __syncthreads();
  for (int kt = 0; kt < nk; ++kt) {
    const u16* cur = lds + (kt & 1) * (256 * 64);
    if (kt + 1 < nk) {
      u16* nxt = lds + ((kt + 1) & 1) * (256 * 64);
      u16* wa = nxt + woff; u16* wb = nxt + 128 * 64 + woff;
      *(uint4*)(wa) = ra0; *(uint4*)(wa + 32 * 64) = ra1; *(uint4*)(wa + 64 * 64) = ra2; *(uint4*)(wa + 96 * 64) = ra3;
      *(uint4*)(wb) = rb0; *(uint4*)(wb + 32 * 64) = rb1; *(uint4*)(wb + 64 * 64) = rb2; *(uint4*)(wb + 96 * 64) = rb3;
      if (kt + 2 < nk) {
        const u16* a2 = ap + (kt + 2) * 64; const u16* b2 = bp + (kt + 2) * 64;
        ra0 = *(const uint4*)(a2); ra1 = *(const uint4*)(a2 + sa32); ra2 = *(const uint4*)(a2 + 2 * sa32); ra3 = *(const uint4*)(a2 + 3 * sa32);
        rb0 = *(const uint4*)(b2); rb1 = *(const uint4*)(b2 + sb32); rb2 = *(const uint4*)(b2 + 2 * sb32); rb3 = *(const uint4*)(b2 + 3 * sb32);
      }
    }
    {
      const u16* pa0 = cur + fa0; const u16* pa1 = cur + fa1; const u16* pb0 = cur + fb0; const u16* pb1 = cur + fb1;
      bf16x8 a0 = *(const bf16x8*)(pa0), a1 = *(const bf16x8*)(pa0 + 16 * 64), a2 = *(const bf16x8*)(pa0 + 32 * 64), a3 = *(const bf16x8*)(pa0 + 48 * 64);
      bf16x8 b0 = *(const bf16x8*)(pb0), b1 = *(const bf16x8*)(pb0 + 16 * 64), b2 = *(const bf16x8*)(pb0 + 32 * 64), b3 = *(const bf16x8*)(pb0 + 48 * 64);
      bf16x8 c0 = *(const bf16x8*)(pa1), c1 = *(const bf16x8*)(pa1 + 16 * 64), c2 = *(const bf16x8*)(pa1 + 32 * 64), c3 = *(const bf16x8*)(pa1 + 48 * 64);
      bf16x8 d0 = *(const bf16x8*)(pb1), d1 = *(const bf16x8*)(pb1 + 16 * 64), d2 = *(const bf16x8*)(pb1 + 32 * 64), d3 = *(const bf16x8*)(pb1 + 48 * 64);
      __builtin_amdgcn_sched_barrier(0);
#define G128_MM(j, bj, x0, x1, x2, x3) do { \
        acc[0][j] = __builtin_amdgcn_mfma_f32_16x16x32_bf16(bj, x0, acc[0][j], 0, 0, 0); \
        acc[1][j] = __builtin_amdgcn_mfma_f32_16x16x32_bf16(bj, x1, acc[1][j], 0, 0, 0); \
        acc[2][j] = __builtin_amdgcn_mfma_f32_16x16x32_bf16(bj, x2, acc[2][j], 0, 0, 0); \
        acc[3][j] = __builtin_amdgcn_mfma_f32_16x16x32_bf16(bj, x3, acc[3][j], 0, 0, 0); } while (0)
      __builtin_amdgcn_s_setprio(1);
      G128_MM(0, b0, a0, a1, a2, a3); G128_MM(1, b1, a0, a1, a2, a3); G128_MM(2, b2, a0, a1, a2, a3); G128_MM(3, b3, a0, a1, a2, a3);
      G128_MM(0, d0, c0, c1, c2, c3); G128_MM(1, d1, c0, c1, c2, c3); G128_MM(2, d2, c0, c1, c2, c3); G128_MM(3, d3, c0, c1, c2, c3);
      __builtin_amdgcn_s_setprio(0);
    }
    __syncthreads();
  }
}
__device__ __forceinline__ uint2 pack4(f32x4 v) {
  uint2 o;
  o.x = (unsigned)f2bf(v[0]) | ((unsigned)f2bf(v[1]) << 16);
  o.y = (unsigned)f2bf(v[2]) | ((unsigned)f2bf(v[3]) << 16);
  return o;
}

__device__ __forceinline__ void gemm256(const u16* __restrict__ A, int lda, const u16* __restrict__ B, int ldb, int K,
                                        u16* lds, f32x4 (&acc)[8][4]) {
  const int tid = tid_l(), lane = tid & 63, w = tid >> 6, wm = w >> 1, wn = w & 1;
  const int r16 = lane & 15, g4 = lane >> 4;
#pragma unroll
  for (int i = 0; i < 8; ++i)
#pragma unroll
    for (int j = 0; j < 4; ++j) acc[i][j] = f32x4{0.f, 0.f, 0.f, 0.f};
  const int lrow = tid >> 2, lkc = tid & 3;
  const u16* ap = A + (size_t)lrow * lda + lkc * 8;
  const u16* bp = B + (size_t)lrow * ldb + lkc * 8;
  const size_t sa64 = (size_t)64 * lda, sb64 = (size_t)64 * ldb;
  const int woff = lrow * 32 + ((lkc ^ ((lrow >> 1) & 3)) * 8);
  const int fsw = (g4 ^ ((r16 >> 1) & 3)) * 8;
  const int faoff = (wm * 128 + r16) * 32 + fsw;
  const int fboff = 256 * 32 + (wn * 64 + r16) * 32 + fsw;
  const int nk = K >> 5;
  const int BUF = 384 * 32;
  uint4 xa0, xa1, xa2, xa3, xb0, xb1;
  uint4 ya0, ya1, ya2, ya3, yb0, yb1;
#define G256_LOAD(P, st) do { const u16* a2_ = ap + (st) * 32; const u16* b2_ = bp + (st) * 32; \
    P##a0 = *(const uint4*)(a2_); P##a1 = *(const uint4*)(a2_ + sa64); P##a2 = *(const uint4*)(a2_ + 2 * sa64); P##a3 = *(const uint4*)(a2_ + 3 * sa64); \
    P##b0 = *(const uint4*)(b2_); P##b1 = *(const uint4*)(b2_ + sb64); } while (0)
#define G256_STORE(P, buf) do { u16* wa_ = lds + (buf) * BUF + woff; u16* wb_ = wa_ + 256 * 32; \
    *(uint4*)(wa_) = P##a0; *(uint4*)(wa_ + 64 * 32) = P##a1; *(uint4*)(wa_ + 128 * 32) = P##a2; *(uint4*)(wa_ + 192 * 32) = P##a3; \
    *(uint4*)(wb_) = P##b0; *(uint4*)(wb_ + 64 * 32) = P##b1; } while (0)
#define G256_MM(i, af) do { \
      acc[i][0] = __builtin_amdgcn_mfma_f32_16x16x32_bf16(bf0, af, acc[i][0], 0, 0, 0); \
      acc[i][1] = __builtin_amdgcn_mfma_f32_16x16x32_bf16(bf1, af, acc[i][1], 0, 0, 0); \
      acc[i][2] = __builtin_amdgcn_mfma_f32_16x16x32_bf16(bf2, af, acc[i][2], 0, 0, 0); \
      acc[i][3] = __builtin_amdgcn_mfma_f32_16x16x32_bf16(bf3, af, acc[i][3], 0, 0, 0); } while (0)
#define G256_COMPUTE(buf) do { const u16* fa_ = lds + (buf) * BUF + faoff; const u16* fb_ = lds + (buf) * BUF + fboff; \
    bf16x8 bf0 = *(const bf16x8*)(fb_), bf1 = *(const bf16x8*)(fb_ + 16 * 32), bf2 = *(const bf16x8*)(fb_ + 32 * 32), bf3 = *(const bf16x8*)(fb_ + 48 * 32); \
    bf16x8 a0 = *(const bf16x8*)(fa_), a1 = *(const bf16x8*)(fa_ + 16 * 32), a2 = *(const bf16x8*)(fa_ + 32 * 32), a3 = *(const bf16x8*)(fa_ + 48 * 32); \
    __builtin_amdgcn_sched_barrier(0); __builtin_amdgcn_s_setprio(1); \
    G256_MM(0, a0); a0 = *(const bf16x8*)(fa_ + 64 * 32); __builtin_amdgcn_sched_barrier(0); \
    G256_MM(1, a1); a1 = *(const bf16x8*)(fa_ + 80 * 32); __builtin_amdgcn_sched_barrier(0); \
    G256_MM(2, a2); a2 = *(const bf16x8*)(fa_ + 96 * 32); __builtin_amdgcn_sched_barrier(0); \
    G256_MM(3, a3); a3 = *(const bf16x8*)(fa_ + 112 * 32); __builtin_amdgcn_sched_barrier(0); \
    G256_MM(4, a0); G256_MM(5, a1); G256_MM(6, a2); G256_MM(7, a3); __builtin_amdgcn_s_setprio(0); } while (0)
  bf16x8 bf0, bf1, bf2, bf3, a0, a1, a2, a3;
#define G3_PRELOAD(buf) do { const u16* fa_ = lds + (buf) * BUF + faoff; const u16* fb_ = lds + (buf) * BUF + fboff; \
    bf0 = *(const bf16x8*)(fb_); bf1 = *(const bf16x8*)(fb_ + 16 * 32); bf2 = *(const bf16x8*)(fb_ + 32 * 32); bf3 = *(const bf16x8*)(fb_ + 48 * 32); \
    a0 = *(const bf16x8*)(fa_); a1 = *(const bf16x8*)(fa_ + 16 * 32); a2 = *(const bf16x8*)(fa_ + 32 * 32); a3 = *(const bf16x8*)(fa_ + 48 * 32); } while (0)
#define G3_COMPUTE(buf) do { const u16* fa_ = lds + (buf) * BUF + faoff; \
    __builtin_amdgcn_sched_barrier(0); __builtin_amdgcn_s_setprio(1); \
    G256_MM(0, a0); a0 = *(const bf16x8*)(fa_ + 64 * 32); __builtin_amdgcn_sched_barrier(0); \
    G256_MM(1, a1); a1 = *(const bf16x8*)(fa_ + 80 * 32); __builtin_amdgcn_sched_barrier(0); \
    G256_MM(2, a2); a2 = *(const bf16x8*)(fa_ + 96 * 32); __builtin_amdgcn_sched_barrier(0); \
    G256_MM(3, a3); a3 = *(const bf16x8*)(fa_ + 112 * 32); __builtin_amdgcn_sched_barrier(0); \
    G256_MM(4, a0); G256_MM(5, a1); G256_MM(6, a2); G256_MM(7, a3); __builtin_amdgcn_s_setprio(0); \
    __builtin_amdgcn_sched_barrier(0); } while (0)
#define G3_STAGE(i, SET) do { \
    if (kt + (i) + 2 < nk) G256_STORE(SET, ((i) + 2) % 3); \
    if (kt + (i) + 4 < nk) G256_LOAD(SET, kt + (i) + 4); \
    if (kt + (i) < nk) G3_COMPUTE((i) % 3); \
    if (kt + (i) + 1 < nk) G3_PRELOAD(((i) + 1) % 3); \
    __syncthreads(); } while (0)
  G256_LOAD(x, 0);
  G256_LOAD(y, 1);
  __syncthreads();
  G256_STORE(x, 0);
  G256_LOAD(x, 2);
  G256_STORE(y, 1);
  G256_LOAD(y, 3);
  __syncthreads();
  G3_PRELOAD(0);
  for (int kt = 0; kt < nk; kt += 6) {
    G3_STAGE(0, x); G3_STAGE(1, y); G3_STAGE(2, x); G3_STAGE(3, y); G3_STAGE(4, x); G3_STAGE(5, y);
  }
}

__device__ __forceinline__ void gemm192(const u16* __restrict__ A, int lda, const u16* __restrict__ B, int ldb, int K,
                                        u16* lds, f32x4 (&acc)[6][4]) {
  const int tid = tid_l(), lane = tid & 63, w = tid >> 6, wm = w >> 1, wn = w & 1;
  const int r16 = lane & 15, g4 = lane >> 4;
#pragma unroll
  for (int i = 0; i < 6; ++i)
#pragma unroll
    for (int j = 0; j < 4; ++j) acc[i][j] = f32x4{0.f, 0.f, 0.f, 0.f};
  const int lrow = tid >> 2, lkc = tid & 3;
  const u16* ap = A + (size_t)lrow * lda + lkc * 8;
  const u16* bp = B + (size_t)lrow * ldb + lkc * 8;
  const size_t sa64 = (size_t)64 * lda, sb64 = (size_t)64 * ldb;
  const int woff = lrow * 32 + ((lkc ^ ((lrow >> 1) & 3)) * 8);
  const int fsw = (g4 ^ ((r16 >> 1) & 3)) * 8;
  const int faoff = (wm * 96 + r16) * 32 + fsw;
  const int fboff = 192 * 32 + (wn * 64 + r16) * 32 + fsw;
  const int nk = K >> 5;
  const int BUF = 320 * 32;
  uint4 xa0, xa1, xa2, xb0, xb1;
  uint4 ya0, ya1, ya2, yb0, yb1;
#define G192_LOAD(P, st) do { const u16* a2_ = ap + (st) * 32; const u16* b2_ = bp + (st) * 32; \
    P##a0 = *(const uint4*)(a2_); P##a1 = *(const uint4*)(a2_ + sa64); P##a2 = *(const uint4*)(a2_ + 2 * sa64); \
    P##b0 = *(const uint4*)(b2_); P##b1 = *(const uint4*)(b2_ + sb64); } while (0)
#define G192_STORE(P, buf) do { u16* wa_ = lds + (buf) * BUF + woff; u16* wb_ = wa_ + 192 * 32; \
    *(uint4*)(wa_) = P##a0; *(uint4*)(wa_ + 64 * 32) = P##a1; *(uint4*)(wa_ + 128 * 32) = P##a2; \
    *(uint4*)(wb_) = P##b0; *(uint4*)(wb_ + 64 * 32) = P##b1; } while (0)
#define G192_COMPUTE(buf) do { const u16* fa_ = lds + (buf) * BUF + faoff; const u16* fb_ = lds + (buf) * BUF + fboff; \
    bf16x8 bf0 = *(const bf16x8*)(fb_), bf1 = *(const bf16x8*)(fb_ + 16 * 32), bf2 = *(const bf16x8*)(fb_ + 32 * 32), bf3 = *(const bf16x8*)(fb_ + 48 * 32); \
    bf16x8 a0 = *(const bf16x8*)(fa_), a1 = *(const bf16x8*)(fa_ + 16 * 32), a2 = *(const bf16x8*)(fa_ + 32 * 32), a3 = *(const bf16x8*)(fa_ + 48 * 32); \
    __builtin_amdgcn_sched_barrier(0); __builtin_amdgcn_s_setprio(1); \
    G256_MM(0, a0); a0 = *(const bf16x8*)(fa_ + 64 * 32); __builtin_amdgcn_sched_barrier(0); \
    G256_MM(1, a1); a1 = *(const bf16x8*)(fa_ + 80 * 32); __builtin_amdgcn_sched_barrier(0); \
    G256_MM(2, a2); G256_MM(3, a3); G256_MM(4, a0); G256_MM(5, a1); __builtin_amdgcn_s_setprio(0); } while (0)
  G192_LOAD(x, 0);
  G192_LOAD(y, 1);
  __syncthreads();
  G192_STORE(x, 0);
  G192_LOAD(x, 2);
  __syncthreads();
  for (int kt = 0; kt < nk; kt += 2) {
    G192_STORE(y, 1);
    if (kt + 3 < nk) G192_LOAD(y, kt + 3);
    G192_COMPUTE(0);
    __syncthreads();
    if (kt + 2 < nk) {
      G192_STORE(x, 0);
      if (kt + 4 < nk) G192_LOAD(x, kt + 4);
    }
    G192_COMPUTE(1);
    __syncthreads();
  }
}
#define GEMM256_RC const int tde = tid_l(); const int rb = ((tde >> 6) >> 1) * 128 + (tde & 15), cb = ((tde >> 6) & 1) * 64 + ((tde & 63) >> 4) * 4;
#define GEMM_RC const int tde = tid_l(); const int rb = ((tde >> 6) >> 1) * 64 + (tde & 15), cb = ((tde >> 6) & 1) * 64 + ((tde & 63) >> 4) * 4;


__device__ __forceinline__ bool tile_at(int r, int Mt, int Nt, int& mt, int& nt) {
  const int x = blockIdx.x & 7, j = blockIdx.x >> 3, bpx = gridDim.x >> 3;
  const int mpx = Mt >> 3;
  const int q = r * bpx + j;
  if (q >= mpx * Nt) return false;
  const int full = (Nt >> 3) * (mpx * 8);
  int cb, rem, wcb;
  if (q < full) { cb = q / (mpx * 8); rem = q - cb * mpx * 8; wcb = 8; }
  else { cb = Nt >> 3; rem = q - full; wcb = Nt - cb * 8; }
  mt = x * mpx + rem / wcb;
  nt = cb * 8 + rem % wcb;
  return true;
}

__device__ __forceinline__ void phase_a(const Params& p, int l, u16* lds) {
  const u16* Bw = p.WinT + (size_t)l * 3072 * 1024;
  int mt, nt;
  for (int r = 0; tile_at(r, 144, 24, mt, nt); ++r) {
    const int m0 = mt * 256, n0 = nt * 128;
    f32x4 acc[8][4];
    gemm256(p.HQ + (size_t)m0 * 1024, 1024, Bw + (size_t)n0 * 1024, 1024, 1024, lds, acc);
    { GEMM256_RC
#pragma unroll
      for (int mi = 0; mi < 8; ++mi) {
        const int row = m0 + rb + mi * 16;
#pragma unroll
        for (int ni = 0; ni < 4; ++ni) {
          const int col = n0 + cb + ni * 16;
          *(uint2*)(p.P + (size_t)row * PW + col) = pack4(acc[mi][ni]);
          if (col >= P_GA && col < P_GA + 16)
            *(float4*)(p.GAB + (size_t)row * 16 + (col - P_GA)) = make_float4(acc[mi][ni][0], acc[mi][ni][1], acc[mi][ni][2], acc[mi][ni][3]);
        }
      }
    }
  }
}

__device__ __forceinline__ void phase_b1(const Params& p, int l, u16* lds) {
  int mt, nt;
  for (int pass = 0; pass < 2; ++pass) {
  for (int r = 0; tile_at(r, pass == 0 ? 288 : 304, pass == 0 ? 6 : 8, mt, nt); ++r) {
    if (pass == 0) {
      const int m0 = mt * 128, n0 = nt * 128;
      const float qscale = 0.07216878364870322f * 1.4426950408889634f;
      f32x4 acc[4][4];
      gemm128(p.P + (size_t)m0 * PW + P_MCQ, PW, p.WuqT + (size_t)l * 768 * 384 + (size_t)n0 * 384, 384, 384, lds, acc);
      { GEMM_RC
        const int g4 = (tde & 63) >> 4;
        const int cw0 = n0 + cb - g4 * 4;
        const bool ropew = ((cw0 >> 6) % 3) == 2 && m0 >= T_CTX;
#pragma unroll
        for (int mi = 0; mi < 4; ++mi) {
          const int row = m0 + rb + mi * 16;
          f32x4 v0 = acc[mi][0], v1 = acc[mi][1], v2 = acc[mi][2], v3 = acc[mi][3];
          if (ropew) {
            const int pos = (row - T_CTX) & 4095;
#pragma unroll
            for (int r = 0; r < 4; ++r) {
              const float inv = exp2f(-(float)(g4 * 4 + r) * (13.287712379549449f / 16.f));
              float s0, c0, s1, c1;
              __sincosf((float)(pos >> 6) * inv, &s0, &c0);
              __sincosf((float)(pos & 63) * inv, &s1, &c1);
              const float a0 = v0[r] * c0 - v1[r] * s0, a1 = v1[r] * c0 + v0[r] * s0;
              const float b0 = v2[r] * c1 - v3[r] * s1, b1 = v3[r] * c1 + v2[r] * s1;
              v0[r] = a0; v1[r] = a1; v2[r] = b0; v3[r] = b1;
            }
          }
          u16* qp = p.HQ + (size_t)row * 768 + n0 + cb;
          *(uint2*)(qp) = pack4(v0 * qscale); *(uint2*)(qp + 16) = pack4(v1 * qscale);
          *(uint2*)(qp + 32) = pack4(v2 * qscale); *(uint2*)(qp + 48) = pack4(v3 * qscale);
        }
      }
    } else {
      const int m0 = mt * 128, n0 = nt * 128;
      const u16* Ap; int lda;
      if (mt < 288) { Ap = p.P + (size_t)m0 * PW + P_MCKV; lda = PW; }
      else { Ap = p.CKVC + (size_t)(m0 - T_ALL) * 256; lda = 256; }
      f32x4 acc[4][4];
      gemm128(Ap, lda, p.WukvT + (size_t)l * 1024 * 256 + (size_t)n0 * 256, 256, 256, lds, acc);
      { GEMM_RC
#pragma unroll
        for (int mi = 0; mi < 4; ++mi) {
          const int row = m0 + rb + mi * 16;
          u16* vb; int vst;
          if (row < T_CTX) { int b = row >> 8, pos = row & 255; vb = p.VTC + (size_t)(b * 4) * 128 * 256 + pos; vst = 256; }
          else if (row < T_ALL) { int b = (row - T_CTX) >> 12, pos = (row - T_CTX) & 4095; vb = p.VTL + (size_t)(b * 4) * 128 * 4352 + pos; vst = 4352; }
          else { int b = (row - T_ALL) >> 8, pos = 4096 + ((row - T_ALL) & 255); vb = p.VTL + (size_t)(b * 4) * 128 * 4352 + pos; vst = 4352; }
#pragma unroll
          for (int ni = 0; ni < 4; ++ni) {
            const int col = n0 + cb + ni * 16;
            const int h = col >> 8, wi = col & 255;
            if (wi < 128) {
              *(uint2*)(p.KN + (size_t)row * 512 + h * 128 + wi) = pack4(acc[mi][ni]);
            } else {
              u16* dst = vb + (size_t)(h * 128 + (wi - 128)) * vst;
#pragma unroll
              for (int r = 0; r < 4; ++r) dst[(size_t)r * vst] = f2bf(acc[mi][ni][r]);
            }
          }
        }
      }
    }
  }
  }
}

__device__ __forceinline__ void phase_gemm_y(const u16* A, int lda, const u16* B, int K, int N, u16* Y, int ldy, u16* lds) {
  int mt, nt;
  for (int r = 0; tile_at(r, 192, N / 128, mt, nt); ++r) {
    const int m0 = mt * 192, n0 = nt * 128;
    f32x4 acc[6][4];
    gemm192(A + (size_t)m0 * lda, lda, B + (size_t)n0 * K, K, K, lds, acc);
    {
      const int tde = tid_l();
      const int rb = ((tde >> 6) >> 1) * 96 + (tde & 15), cb = ((tde >> 6) & 1) * 64 + ((tde & 63) >> 4) * 4;
#pragma unroll
      for (int mi = 0; mi < 6; ++mi)
#pragma unroll
        for (int ni = 0; ni < 4; ++ni)
          *(uint2*)(Y + (size_t)(m0 + rb + mi * 16) * ldy + n0 + cb + ni * 16) = pack4(acc[mi][ni]);
    }
  }
}

__device__ __forceinline__ void phase_e(const Params& p, int l, u16* lds) {
  const u16* Bw = p.WfiT + (size_t)l * 5632 * 1024;
  int mt, nt;
  for (int r = 0; tile_at(r, 144, 44, mt, nt); ++r) {
    const int m0 = mt * 256, n0 = nt * 128;
    f32x4 acc[8][4];
    gemm256(p.MIX + (size_t)m0 * 1024, 1024, Bw + (size_t)n0 * 1024, 1024, 1024, lds, acc);
    { GEMM256_RC
      const int g4x4 = ((tde & 63) >> 4) * 4;
      const int hc0 = ((n0 + cb - g4x4) >> 1) + g4x4;
#pragma unroll
      for (int mi = 0; mi < 8; ++mi)
#pragma unroll
        for (int ni = 0; ni < 2; ++ni) {
          f32x4 hv;
#pragma unroll
          for (int r = 0; r < 4; ++r) hv[r] = siluf_(acc[mi][ni][r]) * acc[mi][ni + 2][r];
          *(uint2*)(p.P + (size_t)(m0 + rb + mi * 16) * DFF + hc0 + ni * 16) = pack4(hv);
        }
    }
  }
}

#define KST 208
#define VST 80
#define PST 80
__device__ __forceinline__ void attn_item(const Params& p, int latent, int b, int h, int qb, unsigned char* smraw, int dummy = 0) {
  u16* sK = (u16*)smraw;
  u16* sV = sK + 64 * KST;
  u16* sP = sV + 128 * VST;
  const int tid = tid_l(), lane = tid & 63, w = tid >> 6, r16 = lane & 15, g4 = lane >> 4;
  const int nkeys = latent ? 4352 : 256;
  const int krow0 = latent ? T_CTX + b * 4096 : b * 256;
  const int tq0 = krow0 + qb * 128;
  const u16* vt = latent ? p.VTL + (size_t)((b * 4 + h) * 128) * 4352 : p.VTC + (size_t)((b * 4 + h) * 128) * 256;
  u16* sPw = sP + w * 32 * PST;
  bf16x8 q[2][6];
#pragma unroll
  for (int mi = 0; mi < 2; ++mi)
#pragma unroll
    for (int ks = 0; ks < 6; ++ks)
      q[mi][ks] = *(const bf16x8*)(p.HQ + (size_t)(tq0 + w * 32 + mi * 16 + r16) * 768 + h * 192 + ks * 32 + g4 * 8);
  f32x4 o[2][8];
  float mrow[2], lrow[2];
#pragma unroll
  for (int mi = 0; mi < 2; ++mi) {
#pragma unroll
    for (int nd = 0; nd < 8; ++nd) o[mi][nd] = f32x4{0.f, 0.f, 0.f, 0.f};
    mrow[mi] = -1e30f; lrow[mi] = 0.f;
  }
  const int lkey = tid >> 2, lpart = tid & 3;
  const int ldv = tid >> 1, lhalf = tid & 1;
  const int ntile = nkeys >> 6;
  uint4 k0, k1, k2, k3, k4, k5;
  {
    const int pos = lkey;
    const u16* srcn = p.KN + (size_t)(krow0 + pos) * 512 + h * 128 + lpart * 8;
    const u16* srcr = p.P + (size_t)(krow0 + pos) * PW + P_MKR + lpart * 8;
    k0 = *(const uint4*)(srcn); k1 = *(const uint4*)(srcn + 32); k2 = *(const uint4*)(srcn + 64); k3 = *(const uint4*)(srcn + 96);
    k4 = *(const uint4*)(srcr); k5 = *(const uint4*)(srcr + 32);
  }
  for (int kt = 0; kt < ntile; ++kt) {
    __syncthreads();
    {
      u16* dk = sK + lkey * KST + lpart * 8;
      *(uint4*)(dk) = k0; *(uint4*)(dk + 32) = k1; *(uint4*)(dk + 64) = k2; *(uint4*)(dk + 96) = k3;
      *(uint4*)(dk + 128) = k4; *(uint4*)(dk + 160) = k5;
    }
    const u16* sv = vt + (size_t)ldv * nkeys + kt * 64 + lhalf * 32;
    const uint4 v0 = *(const uint4*)(sv), v1 = *(const uint4*)(sv + 8), v2 = *(const uint4*)(sv + 16), v3 = *(const uint4*)(sv + 24);
    __syncthreads();
    f32x4 s[2][4];
#pragma unroll
    for (int mi = 0; mi < 2; ++mi)
#pragma unroll
      for (int ni = 0; ni < 4; ++ni) s[mi][ni] = f32x4{0.f, 0.f, 0.f, 0.f};
#pragma unroll
    for (int ks = 0; ks < 6; ++ks)
#pragma unroll
      for (int ni = 0; ni < 4; ++ni) {
        bf16x8 kf = *(const bf16x8*)(sK + (ni * 16 + r16) * KST + ks * 32 + g4 * 8);
        s[0][ni] = __builtin_amdgcn_mfma_f32_16x16x32_bf16(kf, q[0][ks], s[0][ni], 0, 0, 0);
        s[1][ni] = __builtin_amdgcn_mfma_f32_16x16x32_bf16(kf, q[1][ks], s[1][ni], 0, 0, 0);
      }
#pragma unroll
    for (int mi = 0; mi < 2; ++mi) {
      float mx = -1e30f;
#pragma unroll
      for (int ni = 0; ni < 4; ++ni)
#pragma unroll
        for (int r = 0; r < 4; ++r) mx = fmaxf(mx, s[mi][ni][r]);
      mx = fmaxf(mx, __shfl_xor(mx, 16)); mx = fmaxf(mx, __shfl_xor(mx, 32));
      const float mnew = fmaxf(mrow[mi], mx);
      const float alpha = __builtin_amdgcn_exp2f(mrow[mi] - mnew);
      mrow[mi] = mnew;
      float ps = 0.f;
#pragma unroll
      for (int ni = 0; ni < 4; ++ni) {
        f32x4 pv;
#pragma unroll
        for (int r = 0; r < 4; ++r) { pv[r] = __builtin_amdgcn_exp2f(s[mi][ni][r] - mnew); ps += pv[r]; }
        *(uint2*)(sPw + (mi * 16 + r16) * PST + ni * 16 + g4 * 4) = pack4(pv);
      }
      ps += __shfl_xor(ps, 16); ps += __shfl_xor(ps, 32);
      lrow[mi] = lrow[mi] * alpha + ps;
#pragma unroll
      for (int nd = 0; nd < 8; ++nd) o[mi][nd] *= alpha;
    }
    {
      u16* dvp = sV + ldv * VST + lhalf * 32;
      *(uint4*)(dvp) = v0; *(uint4*)(dvp + 8) = v1; *(uint4*)(dvp + 16) = v2; *(uint4*)(dvp + 24) = v3;
    }
    __syncthreads();
    if (kt + 1 < ntile) {
      const int pos = (kt + 1) * 64 + lkey;
      const bool own = (!latent) || pos < 4096;
      const int row = own ? krow0 + pos : T_ALL + b * 256 + (pos - 4096);
      const u16* srcn = p.KN + (size_t)row * 512 + h * 128 + lpart * 8;
      const u16* srcr = own ? p.P + (size_t)(krow0 + pos) * PW + P_MKR + lpart * 8
                            : p.KRC + (size_t)(b * 256 + pos - 4096) * 64 + lpart * 8;
      k0 = *(const uint4*)(srcn); k1 = *(const uint4*)(srcn + 32); k2 = *(const uint4*)(srcn + 64); k3 = *(const uint4*)(srcn + 96);
      k4 = *(const uint4*)(srcr); k5 = *(const uint4*)(srcr + 32);
    }
#pragma unroll
    for (int ks2 = 0; ks2 < 2; ++ks2) {
      bf16x8 pf0 = *(const bf16x8*)(sPw + (0 * 16 + r16) * PST + ks2 * 32 + g4 * 8);
      bf16x8 pf1 = *(const bf16x8*)(sPw + (1 * 16 + r16) * PST + ks2 * 32 + g4 * 8);
#pragma unroll
      for (int nd = 0; nd < 8; ++nd) {
        bf16x8 vf = *(const bf16x8*)(sV + (nd * 16 + r16) * VST + ks2 * 32 + g4 * 8);
        o[0][nd] = __builtin_amdgcn_mfma_f32_16x16x32_bf16(vf, pf0, o[0][nd], 0, 0, 0);
        o[1][nd] = __builtin_amdgcn_mfma_f32_16x16x32_bf16(vf, pf1, o[1][nd], 0, 0, 0);
      }
    }
  }
#pragma unroll
  for (int mi = 0; mi < 2; ++mi) {
    const float inv = 1.f / lrow[mi];
    const int qrow = tq0 + w * 32 + mi * 16 + r16;
    u16* op = p.HQ + (size_t)qrow * 768 + h * 192 + g4 * 4;
    if (dummy) op = p.HQ + (size_t)T_ALL * 768 + (size_t)(qrow % 9216) * 768 + h * 192 + g4 * 4;
#pragma unroll
    for (int nd = 0; nd < 8; ++nd) *(uint2*)(op + nd * 16) = pack4(o[mi][nd] * inv);
  }
}

#define XB_TMO      128
#define XB_XCNT(j)  (256  + 64 * (j))
#define XB_XSUB(j)  (1280 + 64 * (j))
#define XB_XGEN(j)  (2304 + 64 * (j))
#define XB_TOP      3328
#define XB_TOPGEN   3392
#define XCD_BAR_WORDS 3456
#define XB_SPIN_CAP (1u << 23)
#define LAS __attribute__((address_space(3)))

__device__ __forceinline__ unsigned xb_ld(unsigned* p)              { return __hip_atomic_load(p, __ATOMIC_RELAXED, __HIP_MEMORY_SCOPE_AGENT); }
__device__ __forceinline__ unsigned xb_add(unsigned* p, unsigned v) { return __hip_atomic_fetch_add(p, v, __ATOMIC_RELAXED, __HIP_MEMORY_SCOPE_AGENT); }
__device__ __forceinline__ unsigned xb_xcc_id() { return (unsigned)__builtin_amdgcn_s_getreg((3 << 11) | 20) & 0xFu; }
#define XB_SPIN(cond, bar) do { unsigned _sp = 0; while (cond) { __builtin_amdgcn_s_sleep(1); \
    if ((++_sp & 255u) == 0u) { if (xb_ld(&(bar)[XB_TMO])) break; if (_sp > XB_SPIN_CAP) { atomicAdd(&(bar)[XB_TMO], 1u); break; } } } } while (0)

struct XcdBarrier {
    unsigned* bar; unsigned x;
    volatile LAS unsigned* st;
};

__device__ __forceinline__ XcdBarrier xcd_barrier_post(unsigned* bar, volatile LAS unsigned* st) {
    XcdBarrier b; b.bar = bar; b.x = xb_xcc_id(); b.st = st;
    if (threadIdx.x == 0) (void)xb_add(&bar[XB_XCNT(b.x)], 1u);
    return b;
}
__device__ __forceinline__ void xcd_barrier_complete(unsigned* bar, unsigned x, unsigned& nloc, unsigned& nx) {
    const unsigned G = gridDim.x * gridDim.y * gridDim.z;
    unsigned sum, cnt, mine, sp = 0u;
    for (;;) {
        sum = 0u; cnt = 0u; mine = 0u;
#pragma unroll
        for (unsigned j = 0; j < 16; ++j) { const unsigned c = xb_ld(&bar[XB_XCNT(j)]); sum += c; cnt += (c > 0u) ? 1u : 0u; mine = (j == x) ? c : mine; }
        if (sum == G) break;
        __builtin_amdgcn_s_sleep(1);
        if ((++sp & 255u) == 0u) { if (xb_ld(&bar[XB_TMO])) break; if (sp > XB_SPIN_CAP) { atomicAdd(&bar[XB_TMO], 1u); break; } }
    }
    nloc = mine > 0u ? mine : 1u; nx = cnt > 0u ? cnt : 1u;
}

__device__ __forceinline__ void xcd_barrier(const XcdBarrier& b) {
    asm volatile("s_waitcnt vmcnt(0)" ::: "memory");
    __syncthreads();
    if (threadIdx.x == 0) {
        unsigned* bar = b.bar;
        __builtin_amdgcn_s_waitcnt(0);
        unsigned nloc = b.st[0], nx = b.st[1];
        if (nloc == 0u) { xcd_barrier_complete(bar, b.x, nloc, nx); b.st[0] = nloc; b.st[1] = nx; }
        const unsigned old = xb_add(&bar[XB_XSUB(b.x)], 1u);
        const unsigned gen = old / nloc;
        if (old + 1u == (gen + 1u) * nloc) {
            __builtin_amdgcn_fence(__ATOMIC_RELEASE, "agent");
            asm volatile("s_waitcnt vmcnt(0)" ::: "memory");
            const unsigned og = xb_add(&bar[XB_TOP], 1u);
            const unsigned tg = og / nx;
            if (og + 1u == (tg + 1u) * nx) xb_add(&bar[XB_TOPGEN], 1u);
            else XB_SPIN(xb_ld(&bar[XB_TOPGEN]) == tg, bar);
            __builtin_amdgcn_fence(__ATOMIC_ACQUIRE, "agent");
            xb_add(&bar[XB_XGEN(b.x)], 1u);
            asm volatile("s_waitcnt vmcnt(0)" ::: "memory");
        } else {
            XB_SPIN(xb_ld(&bar[XB_XGEN(b.x)]) == gen, bar);
            __builtin_amdgcn_fence(__ATOMIC_ACQUIRE, "agent");
            asm volatile("s_waitcnt vmcnt(0)" ::: "memory");
        }
    }
    __syncthreads();
}


__device__ __forceinline__ void gbar(unsigned* ctr, unsigned target) {
  asm volatile("s_waitcnt vmcnt(0)" ::: "memory");
  __syncthreads();
  if (tid_l() == 0) {
    __builtin_amdgcn_fence(__ATOMIC_RELEASE, "agent");
    asm volatile("s_waitcnt vmcnt(0)" ::: "memory");
    __hip_atomic_fetch_add(ctr, 1u, __ATOMIC_RELAXED, __HIP_MEMORY_SCOPE_AGENT);
    while (__hip_atomic_load(ctr, __ATOMIC_RELAXED, __HIP_MEMORY_SCOPE_AGENT) < target) __builtin_amdgcn_s_sleep(2);
    __builtin_amdgcn_fence(__ATOMIC_ACQUIRE, "agent");
    asm volatile("s_waitcnt vmcnt(0)" ::: "memory");
  }
  __syncthreads();
}
#define MFMA4(a, b, c) __builtin_amdgcn_mfma_f32_16x16x4f32((a), (b), (c), 0, 0, 0)

__device__ __forceinline__ float softplusf_(float x) { return fmaxf(x, 0.f) + log1pf(__expf(-fabsf(x))); }

__device__ __forceinline__ void gdn_chain(const Params& p, int l, int seq, int h, int d, int vs, float* sm) {
  float* sMM = sm;
  float* sK = sMM + 64 * 68;
  float* sW = sK + 64 * 65;
  float* sV = sW + 64 * 65;
  float* sS = sV + 64 * 33;
  float* sGc = sS + 64 * 33;
  float* sBeta = sGc + 64;
  float* sBg = sBeta + 64;
  const int tid = tid_l(), lane = tid & 63, w = tid >> 6, r16 = lane & 15, g4 = lane >> 4;
  const bool latent = seq >= 16;
  const int len = latent ? 4096 : 256;
  const int t0 = latent ? T_CTX + (seq - 16) * 4096 : seq * 256;
  const int nchunks = len >> 6;
  const float Acoef = -__expf(p.gdn_a_log[l * 8 + d * 4 + h]);
  const float dtb = p.gdn_dt_bias[l * 8 + d * 4 + h];
  f32x4 Sreg[2];
  __syncthreads();
  {
    const float* s0 = latent ? p.state_gdn + ((((size_t)(seq - 16) * 2 + l) * 2 + d) * 4 + h) * 4096 : nullptr;
#pragma unroll
    for (int n = 0; n < 2; ++n)
#pragma unroll
      for (int r = 0; r < 4; ++r) {
        const int kidx = 16 * w + g4 * 4 + r, cc = n * 16 + r16;
        float v = latent ? s0[kidx * 64 + vs * 32 + cc] : 0.f;
        Sreg[n][r] = v;
        sS[kidx * 33 + cc] = v;
      }
  }
  const u16* Pb = p.P + (size_t)t0 * PW;
  const u16* VHb = p.HQ + (size_t)T_ALL * 768 + (size_t)t0 * 256;
#define GDN_SRC(i, tl, tlo_) ({ const int e_ = (tl) + (i) * 256; const int u_ = e_ / 20, un_ = e_ % 20; \
    (un_ < 16) ? (Pb + (size_t)((tlo_) + u_) * PW + (un_ < 8 ? P_QH + h * 64 + un_ * 8 : P_KH + h * 64 + (un_ - 8) * 8)) \
               : (VHb + (size_t)((tlo_) + u_) * 256 + h * 64 + vs * 32 + (un_ - 16) * 8); })
  uint4 pf[5];
  float pga = 0.f, pgb = 0.f;
  {
    const int tlo = d == 0 ? 0 : len - 64;
#pragma unroll
    for (int i = 0; i < 5; ++i) pf[i] = *(const uint4*)GDN_SRC(i, tid, tlo);
    if (tid < 64) {
      const int u = d == 0 ? tid : 63 - tid;
      const float* gab = p.GAB + (size_t)(t0 + tlo + u) * 16;
      pga = gab[d * 4 + h]; pgb = gab[8 + d * 4 + h];
    }
  }
  for (int n = 0; n < nchunks; ++n) {
    const int tlo = d == 0 ? n * 64 : len - 64 * (n + 1);
    const int tl2 = tid_l();
#pragma unroll
    for (int i = 0; i < 5; ++i) {
      const int e = tl2 + i * 256;
      const int u = e / 20, un = e % 20;
      const int pp = d == 0 ? u : 63 - u;
      float* dq = un < 8 ? sW + pp * 65 + un * 8 : (un < 16 ? sK + pp * 65 + (un - 8) * 8 : sV + pp * 33 + (un - 16) * 8);
      const unsigned wv[4] = {pf[i].x, pf[i].y, pf[i].z, pf[i].w};
#pragma unroll
      for (int j = 0; j < 4; ++j) { dq[2 * j] = bf2f((u16)(wv[j] & 0xffff)); dq[2 * j + 1] = bf2f((u16)(wv[j] >> 16)); }
    }
    if (tid < 64) {
      const int pp = tid;
      float g = Acoef * softplusf_(pga + dtb);
      float bt = sigmoidf_(pgb);
#pragma unroll
      for (int o = 1; o < 64; o <<= 1) { float tt = __shfl_up(g, o); if (lane >= o) g += tt; }
      sGc[pp] = g; sBeta[pp] = bt; sBg[pp] = bt * __expf(g);
    }
    if (n + 1 < nchunks) {
      const int tlo2 = d == 0 ? (n + 1) * 64 : len - 64 * (n + 2);
#pragma unroll
      for (int i = 0; i < 5; ++i) pf[i] = *(const uint4*)GDN_SRC(i, tl2, tlo2);
      if (tid < 64) {
        const int u = d == 0 ? tid : 63 - tid;
        const float* gab = p.GAB + (size_t)(t0 + tlo2 + u) * 16;
        pga = gab[d * 4 + h]; pgb = gab[8 + d * 4 + h];
      }
    }
    __syncthreads();
    float qa[16];
#pragma unroll
    for (int s = 0; s < 16; ++s) qa[s] = sW[(16 * w + r16) * 65 + 4 * s + g4];
    const unsigned tcode = w == 0 ? 0x730u : (w == 1 ? 0xA51u : (w == 2 ? 0x062u : 0x0FBu));
    const int tcnt = w < 2 ? 3 : 2;
    f32x4 attacc[3];
#pragma unroll
    for (int t = 0; t < 3; ++t) {
      attacc[t] = f32x4{0.f, 0.f, 0.f, 0.f};
      if (t < tcnt) {
        const int ti = (tcode >> (4 * t)) & 3, tn = (tcode >> (4 * t + 2)) & 3;
        f32x4 accm = f32x4{0.f, 0.f, 0.f, 0.f};
        const float* ak = sK + (16 * ti + r16) * 65 + g4;
        const float* aq = sW + (16 * ti + r16) * 65 + g4;
        const float* bk = sK + (16 * tn + r16) * 65 + g4;
#pragma unroll
        for (int s = 0; s < 16; ++s) {
          const float bv = bk[4 * s];
          accm = MFMA4(ak[4 * s], bv, accm);
          attacc[t] = MFMA4(aq[4 * s], bv, attacc[t]);
        }
#pragma unroll
        for (int r = 0; r < 4; ++r) {
          const int i = 16 * ti + g4 * 4 + r, j = 16 * tn + r16;
          sMM[i * 68 + j] = (i > j) ? sBeta[i] * accm[r] * __expf(sGc[i] - sGc[j]) : 0.f;
        }
      }
    }
    __syncthreads();
    if (w == 0) {
      const int bi = tid >> 4, c = tid & 15;
      float* md = sMM + (16 * bi) * 68 + 16 * bi;
      float a[16];
#pragma unroll
      for (int r = 0; r < 16; ++r) a[r] = (r == c) ? 1.f : 0.f;
#pragma unroll
      for (int r = 1; r < 16; ++r) {
#pragma unroll
        for (int q4 = 0; q4 < (r + 3) / 4; ++q4) {
          const float4 m = *(const float4*)(md + r * 68 + 4 * q4);
          if (q4 * 4 + 0 < r) a[r] -= m.x * a[q4 * 4 + 0];
          if (q4 * 4 + 1 < r) a[r] -= m.y * a[q4 * 4 + 1];
          if (q4 * 4 + 2 < r) a[r] -= m.z * a[q4 * 4 + 2];
          if (q4 * 4 + 3 < r) a[r] -= m.w * a[q4 * 4 + 3];
        }
      }
      __builtin_amdgcn_fence(__ATOMIC_SEQ_CST, "wavefront");
#pragma unroll
      for (int r = 0; r < 16; ++r) md[r * 68 + c] = a[r];
    } else {
      for (int t = w - 1; t < 8; t += 3) {
        const int ti = t >> 1, tc = t & 1;
        const float bg = sBg[16 * ti + r16];
        const float* ak = sK + (16 * ti + r16) * 65 + g4;
        const float* bs = sS + g4 * 33 + 16 * tc + r16;
        f32x4 acc = f32x4{0.f, 0.f, 0.f, 0.f};
#pragma unroll
        for (int s = 0; s < 16; ++s) acc = MFMA4(ak[4 * s] * bg, bs[4 * s * 33], acc);
#pragma unroll
        for (int r = 0; r < 4; ++r) {
          const int i = 16 * ti + g4 * 4 + r, cc = 16 * tc + r16;
          sV[i * 33 + cc] = sV[i * 33 + cc] * sBeta[i] - acc[r];
        }
      }
    }
    __syncthreads();
    for (int ib = 0; ib < 4; ++ib) {
      if (w < 2) {
        const int ct = w;
        f32x4 acc = f32x4{0.f, 0.f, 0.f, 0.f};
        const float* am = sMM + (16 * ib + r16) * 68 + g4;
        const float* bx = sV + g4 * 33 + 16 * ct + r16;
        for (int s4 = 0; s4 < ib; ++s4) {
#pragma unroll
          for (int s = 0; s < 4; ++s) acc = MFMA4(am[16 * s4 + 4 * s], bx[(16 * s4 + 4 * s) * 33], acc);
        }
        f32x4 rm;
#pragma unroll
        for (int r = 0; r < 4; ++r) rm[r] = sV[(16 * ib + g4 * 4 + r) * 33 + 16 * ct + r16] - acc[r];
        const float* dd = sMM + (16 * ib + r16) * 68 + 16 * ib + 4 * g4;
        f32x4 xn = f32x4{0.f, 0.f, 0.f, 0.f};
#pragma unroll
        for (int s = 0; s < 4; ++s) xn = MFMA4(dd[s], rm[s], xn);
#pragma unroll
        for (int r = 0; r < 4; ++r) sV[(16 * ib + g4 * 4 + r) * 33 + 16 * ct + r16] = xn[r];
        __builtin_amdgcn_fence(__ATOMIC_SEQ_CST, "wavefront");
      }
    }
    __syncthreads();
#pragma unroll
    for (int t = 0; t < 3; ++t) {
      if (t < tcnt) {
        const int ti = (tcode >> (4 * t)) & 3, tn = (tcode >> (4 * t + 2)) & 3;
#pragma unroll
        for (int r = 0; r < 4; ++r) {
          const int i = 16 * ti + g4 * 4 + r, j = 16 * tn + r16;
          sMM[i * 68 + j] = (i >= j) ? attacc[t][r] * __expf(sGc[i] - sGc[j]) : 0.f;
        }
      }
    }
    __syncthreads();
    {
      f32x4 acc[2] = {f32x4{0.f, 0.f, 0.f, 0.f}, f32x4{0.f, 0.f, 0.f, 0.f}};
      const float eg = __expf(sGc[16 * w + r16]);
#pragma unroll
      for (int s = 0; s < 16; ++s) {
        const float a = qa[s] * eg;
        acc[0] = MFMA4(sS[(4 * s + g4) * 33 + r16], a, acc[0]);
        acc[1] = MFMA4(sS[(4 * s + g4) * 33 + 16 + r16], a, acc[1]);
      }
#pragma unroll
      for (int s = 0; s < 16; ++s) {
        if (s < 4 * (w + 1)) {
          const float a = sMM[(16 * w + r16) * 68 + 4 * s + g4];
          acc[0] = MFMA4(sV[(4 * s + g4) * 33 + r16], a, acc[0]);
          acc[1] = MFMA4(sV[(4 * s + g4) * 33 + 16 + r16], a, acc[1]);
        }
      }
      {
        const int pp = 16 * w + r16;
        const int u = d == 0 ? pp : 63 - pp;
        u16* op = p.MIX + (size_t)(t0 + tlo + u) * 1024 + d * 256 + h * 64 + vs * 32 + g4 * 4;
        *(uint2*)(op) = pack4(acc[0]);
        *(uint2*)(op + 16) = pack4(acc[1]);
      }
    }
    __syncthreads();
    {
      const float g63 = sGc[63];
      const float gl = __expf(g63);
#pragma unroll
      for (int nn = 0; nn < 2; ++nn)
#pragma unroll
        for (int r = 0; r < 4; ++r) Sreg[nn][r] *= gl;
#pragma unroll
      for (int s = 0; s < 16; ++s) {
        const int srow = 4 * s + g4;
        const float a = sK[srow * 65 + 16 * w + r16] * __expf(g63 - sGc[srow]);
        Sreg[0] = MFMA4(a, sV[srow * 33 + r16], Sreg[0]);
        Sreg[1] = MFMA4(a, sV[srow * 33 + 16 + r16], Sreg[1]);
      }
    }
    __syncthreads();
#pragma unroll
    for (int nn = 0; nn < 2; ++nn)
#pragma unroll
      for (int r = 0; r < 4; ++r) sS[(16 * w + g4 * 4 + r) * 33 + nn * 16 + r16] = Sreg[nn][r];
    __syncthreads();
  }
  if (!latent) {
    float* so = p.out + OUT_SGDN + ((((size_t)seq * 2 + l) * 2 + d) * 4 + h) * 4096;
#pragma unroll
    for (int nn = 0; nn < 2; ++nn)
#pragma unroll
      for (int r = 0; r < 4; ++r) so[(16 * w + g4 * 4 + r) * 64 + vs * 32 + nn * 16 + r16] = Sreg[nn][r];
  }
}

__device__ __forceinline__ void hgrn_chain(const Params& p, int l, int seq, int h, int d, int vs, float* sm) {
  float* sBC = sm;
  float* sK = sBC + 64 * 65;
  float* sAT = sK + 64 * 65;
  float* sV = sAT + 64 * 68;
  float* sS = sV + 64 * 33;
  float* sTot = sS + 64 * 33;
  const int tid = tid_l(), lane = tid & 63, w = tid >> 6, r16 = lane & 15, g4 = lane >> 4;
  const bool latent = seq >= 16;
  const int len = latent ? 4096 : 256;
  const int t0 = latent ? T_CTX + (seq - 16) * 4096 : seq * 256;
  const int nchunks = len >> 6;
  float lbk;
  {
    const int kch = h * 64 + (tid & 63);
    lbk = (l == 0) ? 0.f : sigmoidf_(p.hgrn_lb[256 + kch] - p.hgrn_lb[kch]);
  }
  f32x4 Sreg[2];
  __syncthreads();
  {
    const float* s0 = latent ? p.state_hgrn + ((((size_t)(seq - 16) * 2 + l) * 2 + d) * 4 + h) * 4096 : nullptr;
#pragma unroll
    for (int n = 0; n < 2; ++n)
#pragma unroll
      for (int r = 0; r < 4; ++r) {
        const int kidx = 16 * w + g4 * 4 + r, cc = n * 16 + r16;
        float v = latent ? s0[kidx * 64 + vs * 32 + cc] : 0.f;
        Sreg[n][r] = v;
        sS[kidx * 33 + cc] = v;
      }
  }
  const u16* Pb = p.P + (size_t)t0 * PW;
  float* sLb = sTot + 256;
  if (tid < 64) sLb[tid] = lbk;
  __syncthreads();
  int pgo[5];
#pragma unroll
  for (int i = 0; i < 5; ++i) {
    const int e = tid + i * 256;
    const int u = e / 20, un = e % 20;
    pgo[i] = u * PW + (un < 8 ? P_HF + d * 256 + h * 64 + un * 8 : (un < 12 ? P_HI + h * 64 + vs * 32 + (un - 8) * 8 : P_HQ + h * 64 + (un - 12) * 8));
  }
  uint4 pf[5];
  {
    const int tlo = d == 0 ? 0 : len - 64;
#pragma unroll
    for (int i = 0; i < 5; ++i) pf[i] = *(const uint4*)(Pb + (size_t)tlo * PW + pgo[i]);
  }
  for (int n = 0; n < nchunks; ++n) {
#pragma unroll
    for (int i = 0; i < 5; ++i) {
      const int e = tid + i * 256;
      const int u = e / 20, un = e % 20;
      const int pp = d == 0 ? u : 63 - u;
      const unsigned wv[4] = {pf[i].x, pf[i].y, pf[i].z, pf[i].w};
#pragma unroll
      for (int j = 0; j < 8; ++j) {
        const float x = bf2f((u16)((wv[j >> 1] >> ((j & 1) * 16)) & 0xffff));
        if (un < 8) {
          const int k = un * 8 + j;
          const float lb = sLb[k];
          const float sg_ = sigmoidf_(x);
          const float gate = lb + (1.f - lb) * sg_;
          sBC[pp * 65 + k] = __logf(fmaxf(gate, 1e-30f));
          sK[pp * 65 + k] = (1.f - lb) * (1.f - sg_);
        } else if (un < 12) {
          sV[pp * 33 + (un - 8) * 8 + j] = x;
        } else {
          sAT[pp * 68 + (un - 12) * 8 + j] = x;
        }
      }
    }
    __syncthreads();
    if (n + 1 < nchunks) {
      const int tlo2 = d == 0 ? (n + 1) * 64 : len - 64 * (n + 2);
#pragma unroll
      for (int i = 0; i < 5; ++i) pf[i] = *(const uint4*)(Pb + (size_t)tlo2 * PW + pgo[i]);
    }
    const int tlo = d == 0 ? n * 64 : len - 64 * (n + 1);
    float cs[16];
    {
      const int k = tid & 63, sg = tid >> 6;
      float run = 0.f;
#pragma unroll
      for (int i = 0; i < 16; ++i) { run += sBC[(16 * sg + i) * 65 + k]; cs[i] = run; }
      sTot[sg * 64 + k] = run;
    }
    float qa[16];
#pragma unroll
    for (int s = 0; s < 16; ++s) qa[s] = sAT[(16 * w + r16) * 68 + 4 * s + g4];
    __syncthreads();
    {
      const int k = tid & 63, sg = tid >> 6;
      float off = 0.f;
      for (int s2 = 0; s2 < sg; ++s2) off += sTot[s2 * 64 + k];
#pragma unroll
      for (int i = 0; i < 16; ++i) sBC[(16 * sg + i) * 65 + k] = cs[i] + off;
    }
    __syncthreads();
    {
      float aq[16], rf[16];
#pragma unroll
      for (int s = 0; s < 16; ++s) {
        const int kk = 4 * s + g4;
        rf[s] = (w == 0) ? 0.f : sBC[(16 * w - 1) * 65 + kk];
        aq[s] = qa[s] * __expf(sBC[(16 * w + r16) * 65 + kk] - rf[s]);
      }
#pragma unroll
      for (int nn = 0; nn < 4; ++nn) {
        f32x4 acc = f32x4{0.f, 0.f, 0.f, 0.f};
        if (nn <= w) {
#pragma unroll
          for (int s = 0; s < 16; ++s) {
            const int kk = 4 * s + g4, sc = 16 * nn + r16;
            const float bv = sK[sc * 65 + kk] * __expf(fminf(rf[s] - sBC[sc * 65 + kk], 80.f));
            acc = MFMA4(aq[s], bv, acc);
          }
        }
#pragma unroll
        for (int r = 0; r < 4; ++r) {
          const int i = 16 * w + g4 * 4 + r, j = 16 * nn + r16;
          sAT[i * 68 + j] = (i >= j) ? acc[r] : 0.f;
        }
      }
    }
    __syncthreads();
    {
      f32x4 acc[2] = {f32x4{0.f, 0.f, 0.f, 0.f}, f32x4{0.f, 0.f, 0.f, 0.f}};
#pragma unroll
      for (int s = 0; s < 16; ++s) {
        const int kk = 4 * s + g4;
        const float a = qa[s] * __expf(sBC[(16 * w + r16) * 65 + kk]);
        acc[0] = MFMA4(sS[kk * 33 + r16], a, acc[0]);
        acc[1] = MFMA4(sS[kk * 33 + 16 + r16], a, acc[1]);
      }
#pragma unroll
      for (int s = 0; s < 16; ++s) {
        if (s < 4 * (w + 1)) {
          const float a = sAT[(16 * w + r16) * 68 + 4 * s + g4];
          acc[0] = MFMA4(sV[(4 * s + g4) * 33 + r16], a, acc[0]);
          acc[1] = MFMA4(sV[(4 * s + g4) * 33 + 16 + r16], a, acc[1]);
        }
      }
      {
        const int pp = 16 * w + r16;
        const int u = d == 0 ? pp : 63 - pp;
        u16* op = p.MIX + (size_t)(t0 + tlo + u) * 1024 + 512 + d * 256 + h * 64 + vs * 32 + g4 * 4;
        *(uint2*)(op) = pack4(acc[0]);
        *(uint2*)(op + 16) = pack4(acc[1]);
      }
    }
    __syncthreads();
    {
#pragma unroll
      for (int nn = 0; nn < 2; ++nn)
#pragma unroll
        for (int r = 0; r < 4; ++r) Sreg[nn][r] *= __expf(sBC[63 * 65 + 16 * w + g4 * 4 + r]);
      const int kA = 16 * w + r16;
      const float blA = sBC[63 * 65 + kA];
#pragma unroll
      for (int s = 0; s < 16; ++s) {
        const int srow = 4 * s + g4;
        const float a = sK[srow * 65 + kA] * __expf(blA - sBC[srow * 65 + kA]);
        Sreg[0] = MFMA4(a, sV[srow * 33 + r16], Sreg[0]);
        Sreg[1] = MFMA4(a, sV[srow * 33 + 16 + r16], Sreg[1]);
      }
    }
    __syncthreads();
#pragma unroll
    for (int nn = 0; nn < 2; ++nn)
#pragma unroll
      for (int r = 0; r < 4; ++r) sS[(16 * w + g4 * 4 + r) * 33 + nn * 16 + r16] = Sreg[nn][r];
    __syncthreads();
  }
  if (!latent) {
    float* so = p.out + OUT_SHG + ((((size_t)seq * 2 + l) * 2 + d) * 4 + h) * 4096;
#pragma unroll
    for (int nn = 0; nn < 2; ++nn)
#pragma unroll
      for (int r = 0; r < 4; ++r) so[(16 * w + g4 * 4 + r) * 64 + vs * 32 + nn * 16 + r16] = Sreg[nn][r];
  }
}

__device__ __forceinline__ void phase_c(const Params& p, int l, unsigned char* smraw, int mode = 0) {
  __shared__ int s_item;
  const int total = 1920;
  const bool paired = (gridDim.x == 512);
  const int jx = blockIdx.x >> 3;
  int my_static = -1;
  if (paired && (jx & 31) < 16) my_static = (blockIdx.x & 7) * 32 + (jx >> 5) * 16 + (jx & 15);
  for (;;) {
    __syncthreads();
    if (tid_l() == 0) {
      if (my_static >= 0) s_item = my_static;
      else s_item = (paired ? 256 : 0) + (int)atomicAdd(&p.counters[l * 64 + mode * 16], 1u);
    }
    __syncthreads();
    my_static = -1;
    const int item = s_item;
    if (item >= total) break;
    int kind, a0, a1, a2, a3;
    if (item < 256 || (item >= 1280 && item < 1792)) {
      const int i2 = item < 256 ? item : item - 1280;
      const int rest = i2 >> 1;
      kind = i2 & 1;
      a3 = rest & 1; a2 = (rest >> 1) & 1; a1 = (rest >> 2) & 3; a0 = (rest >> 4) + (item < 256 ? 16 : 0);
    } else if (item < 1280) {
      const int i2 = item - 256;
      kind = 2; a0 = 1; a1 = i2 >> 7; a2 = (i2 >> 5) & 3; a3 = i2 & 31;
    } else {
      const int i2 = item - 1792;
      kind = 2; a0 = 0; a1 = i2 >> 3; a2 = (i2 >> 1) & 3; a3 = i2 & 1;
    }
    if (mode == 1 && kind == 2) continue;
    if (mode == 2 && kind != 2) continue;
    if (kind != 2) __builtin_amdgcn_s_setprio(3);
    if (kind == 0) gdn_chain(p, l, a0, a1, a2, a3, (float*)smraw);
    else if (kind == 1) hgrn_chain(p, l, a0, a1, a2, a3, (float*)smraw);
    if (kind != 2) __builtin_amdgcn_s_setprio(0);
    else attn_item(p, a0, a1, a2, a3, smraw, mode == 2);
  }
}

__global__ void __launch_bounds__(NTHR, 2) mega(Params p) {
  __shared__ __attribute__((aligned(16))) unsigned char smem[LDS_BYTES];
  cg::grid_group grid = cg::this_grid();
  __shared__ uint4 xb_words;
  if (threadIdx.x == 0) xb_words = make_uint4(0u, 0u, 0u, 0u);
  __syncthreads();
  {
    XcdBarrier xb0 = xcd_barrier_post(p.xbar, (volatile LAS unsigned*)&xb_words);
    if (threadIdx.x == 0) ((volatile LAS unsigned*)&xb_words)[2] = xb0.x;
  }
#define GSYNC() do { XcdBarrier xb_; xb_.bar = p.xbar; xb_.st = (volatile LAS unsigned*)&xb_words; xb_.x = 0; \
    if (threadIdx.x == 0) xb_.x = ((volatile LAS unsigned*)&xb_words)[2]; xcd_barrier(xb_); } while (0)
  phase0(p, (float*)smem);
  if (p.out == nullptr) grid.sync();
  GSYNC();
  rowpass_norm(p, 0, 0);
  GSYNC();
  for (int l = 0; l < 2; ++l) {
    phase_a(p, l, (u16*)smem);
    GSYNC();
    rowpass_b0(p, l);
    GSYNC();
    phase_b1(p, l, (u16*)smem);
    GSYNC();
    rowpass_b2(p, l);
    GSYNC();
    phase_c(p, l, smem);
    GSYNC();
    rowpass_c2(p, l);
    GSYNC();
    phase_gemm_y(p.MIX, 1024, p.WoutT + (size_t)l * 1024 * 1024, 1024, 1024, p.HQ, 1024, (u16*)smem);
    GSYNC();
    rowpass_norm(p, l, 1);
    GSYNC();
    phase_e(p, l, (u16*)smem);
    GSYNC();
    phase_gemm_y(p.P, DFF, p.WfoT + (size_t)l * 1024 * DFF, DFF, 1024, p.HQ, 1024, (u16*)smem);
    GSYNC();
    rowpass_norm(p, l, 2);
    if (l == 0) GSYNC();
  }
}

extern "C" void kernel_launch(void* const* d_in, const int* in_sizes, int n_in, void* d_out, int out_size, void* d_ws,
                              size_t ws_size, hipStream_t stream) {
  static int grid_blocks = 0;
  if (!grid_blocks) {
    int dev = 0, cus = 0, per_cu = 0;
    hipGetDevice(&dev);
    hipDeviceGetAttribute(&cus, hipDeviceAttributeMultiprocessorCount, dev);
    hipOccupancyMaxActiveBlocksPerMultiprocessor(&per_cu, mega, NTHR, 0);
    if (per_cu > 2) per_cu = 2;
    if (per_cu < 1) per_cu = 1;
    grid_blocks = cus * per_cu;
  }
  Params p{};
  const float* const* in = (const float* const*)d_in;
  p.x_prompt = in[0]; p.x_sample = in[1]; p.cache_ckv = in[2]; p.cache_kr = in[3]; p.state_gdn = in[4]; p.state_hgrn = in[5];
  p.c = in[6]; p.c_ctx = in[7]; p.w_ada = in[8]; p.b_ada = in[9]; p.g_pre_mix = in[10]; p.g_post_mix = in[11];
  p.g_pre_ffn = in[12]; p.g_post_ffn = in[13]; p.w_in = in[14]; p.w_out = in[15]; p.gdn_conv_w = in[16];
  p.gdn_a_log = in[17]; p.gdn_dt_bias = in[18]; p.gdn_norm_w = in[19]; p.hgrn_lb = in[20]; p.hgrn_norm_w = in[21];
  p.mla_q_norm_w = in[22]; p.mla_w_uq = in[23]; p.mla_kv_norm_w = in[24]; p.mla_w_ukv = in[25]; p.w_ffn_in = in[26];
  p.w_ffn_out = in[27];
  p.out = (float*)d_out;
  unsigned char* ws = (unsigned char*)d_ws;
  size_t off = 0;
  auto take = [&](size_t bytes) { unsigned char* r = ws + off; off += (bytes + 255) & ~(size_t)255; return r; };
  p.counters = (unsigned*)take(1024);
  p.xbar = (unsigned*)take(16384);
  p.WinT = (u16*)take((size_t)2 * 3072 * 1024 * 2);
  p.WuqT = (u16*)take((size_t)2 * 768 * 384 * 2);
  p.WukvT = (u16*)take((size_t)2 * 1024 * 256 * 2);
  p.WoutT = (u16*)take((size_t)2 * 1024 * 1024 * 2);
  p.WfiT = (u16*)take((size_t)2 * 5632 * 1024 * 2);
  p.WfoT = (u16*)take((size_t)2 * 1024 * 2816 * 2);
  p.mod = (float*)take((size_t)2 * 9 * 6144 * 4);
  p.HQ = (u16*)take((size_t)T_ALL * 1024 * 2);
  p.P = (u16*)take((size_t)T_ALL * PW * 2);
  p.KN = (u16*)take((size_t)(T_ALL + 2048) * 512 * 2);
  p.VTL = (u16*)take((size_t)8 * 4 * 128 * 4352 * 2);
  p.VTC = (u16*)take((size_t)16 * 4 * 128 * 256 * 2);
  p.CKVC = (u16*)take((size_t)2048 * 256 * 2);
  p.KRC = (u16*)take((size_t)2048 * 64 * 2);
  p.GAB = (float*)take((size_t)T_ALL * 16 * 4);
  p.MIX = (u16*)take((size_t)T_ALL * 1024 * 2);
  if (off > ws_size) { fprintf(stderr, "workspace too small: need %zu have %zu\n", off, ws_size); return; }
  hipMemsetAsync(p.counters, 0, 1024 + 16384, stream);
  void* args[] = {&p};
  hipError_t e = hipLaunchCooperativeKernel((void*)mega, dim3(grid_blocks), dim3(NTHR), args, 0, stream);
  if (e != hipSuccess) fprintf(stderr, "cooperative launch failed: %s (grid %d)\n", hipGetErrorString(e), grid_blocks);
}
```

```cpp
#include <hip/hip_runtime.h>
#include <hip/hip_cooperative_groups.h>
#include <cstdio>
namespace cg = cooperative_groups;

typedef unsigned short u16;
using bf16x8 = __attribute__((ext_vector_type(8))) short;
using f32x4  = __attribute__((ext_vector_type(4))) float;

#define T_CTX 4096
#define T_ALL 36864
#define PW 3072
#define DFF 2816
#define LDS_BYTES 73728
#define NTHR 256

#define P_GQKV 0
#define P_GZ 768
#define P_HQ 1024
#define P_HI 1280
#define P_HF 1536
#define P_HG 2048
#define P_MCQ 2304
#define P_MCKV 2688
#define P_MKR 2944
#define P_GA 3008

struct Params {
  const float *x_prompt, *x_sample, *cache_ckv, *cache_kr, *state_gdn, *state_hgrn, *c, *c_ctx;
  const float *w_ada, *b_ada, *g_pre_mix, *g_post_mix, *g_pre_ffn, *g_post_ffn, *w_in, *w_out;
  const float *gdn_conv_w, *gdn_a_log, *gdn_dt_bias, *gdn_norm_w, *hgrn_lb, *hgrn_norm_w;
  const float *mla_q_norm_w, *mla_w_uq, *mla_kv_norm_w, *mla_w_ukv, *w_ffn_in, *w_ffn_out;
  float* out;
  u16 *WinT, *WuqT, *WukvT, *WoutT, *WfiT, *WfoT;
  float* mod;
  u16 *HQ, *P, *KN, *VTL, *VTC, *CKVC, *KRC, *MIX;
  float* GAB;
  unsigned* counters;
  unsigned* xbar;
};

#define OUT_CKV   37748736
#define OUT_KR    39845888
#define OUT_SGDN  40370176
#define OUT_SHG   41418752

__device__ __forceinline__ u16 f2bf(float f) {
  unsigned u = __float_as_uint(f);
  u += 0x7fffu + ((u >> 16) & 1u);
  return (u16)(u >> 16);
}
__device__ __forceinline__ float bf2f(u16 h) { return __uint_as_float(((unsigned)h) << 16); }
__device__ __forceinline__ float wave_sum(float v) {
#pragma unroll
  for (int o = 32; o > 0; o >>= 1) v += __shfl_xor(v, o);
  return v;
}
__device__ __forceinline__ float sigmoidf_(float x) { return __builtin_amdgcn_rcpf(1.f + __expf(-x)); }
__device__ __forceinline__ float siluf_(float x) { return x * __builtin_amdgcn_rcpf(1.f + __expf(-x)); }
__device__ __forceinline__ int tid_l() { int t = threadIdx.x; asm volatile("" : "+v"(t)); return t; }
__device__ __forceinline__ int tok_mod(int t) { return t < T_CTX ? 0 : 1 + ((t - T_CTX) >> 12); }

__device__ __forceinline__ int map_col(int kind, int j) {
  if (kind == 0) return j;
  if (kind == 1) { if (j < 1024) return j; if (j < 3008) return j + 16; if (j < 3024) return 1024 + (j - 3008); return -1; }
  int blk = j >> 6, w = j & 63;
  return w < 32 ? blk * 32 + w : DFF + blk * 32 + (w - 32);
}

__device__ __forceinline__ void cvt_tile(const float* __restrict__ src, int K, int Nsrc, u16* __restrict__ dst, int kind, int jt, int kt, float* sm) {
  const int tid = tid_l();
  const int j0 = jt * 64, k0 = kt * 64;
  __syncthreads();
  {
    int jj = tid & 63, kk0 = tid >> 6;
    int sc = map_col(kind, j0 + jj);
    for (int kk = kk0; kk < 64; kk += 4)
      sm[kk * 65 + jj] = sc >= 0 ? src[(size_t)(k0 + kk) * Nsrc + sc] : 0.f;
  }
  __syncthreads();
  {
    const int kq = tid & 15, jj0 = tid >> 4;
#pragma unroll
    for (int jj = jj0; jj < 64; jj += 16) {
      uint2 o;
      o.x = (unsigned)f2bf(sm[(4 * kq + 0) * 65 + jj]) | ((unsigned)f2bf(sm[(4 * kq + 1) * 65 + jj]) << 16);
      o.y = (unsigned)f2bf(sm[(4 * kq + 2) * 65 + jj]) | ((unsigned)f2bf(sm[(4 * kq + 3) * 65 + jj]) << 16);
      *(uint2*)(dst + (size_t)(j0 + jj) * K + k0 + 4 * kq) = o;
    }
  }
}

__device__ __forceinline__ void mod_item(const Params& p, int item, float* sm) {
  const int l = item / 96, j0 = (item % 96) * 64;
  const int tid = tid_l();
  float* sC = sm;
  float* sR = sm + 9 * 1024;
  __syncthreads();
  for (int i = tid; i < 9 * 1024; i += NTHR) {
    int m = i >> 10, k = i & 1023;
    float v = m == 0 ? p.c_ctx[k] : p.c[(m - 1) * 1024 + k];
    sC[i] = siluf_(v);
  }
  __syncthreads();
  const int col = tid & 63, ks = tid >> 6;
  float acc[9];
#pragma unroll
  for (int m = 0; m < 9; ++m) acc[m] = 0.f;
  const float* wp = p.w_ada + (size_t)l * 1024 * 6144 + j0 + col;
  for (int k = ks * 256; k < ks * 256 + 256; k += 8) {
    float wv[8];
#pragma unroll
    for (int u = 0; u < 8; ++u) wv[u] = wp[(size_t)(k + u) * 6144];
#pragma unroll
    for (int u = 0; u < 8; ++u)
#pragma unroll
      for (int m = 0; m < 9; ++m) acc[m] += sC[m * 1024 + k + u] * wv[u];
  }
#pragma unroll
  for (int m = 0; m < 9; ++m) sR[(ks * 9 + m) * 64 + col] = acc[m];
  __syncthreads();
  for (int i = tid; i < 9 * 64; i += NTHR) {
    int m = i >> 6, cc = i & 63;
    float v = sR[(0 * 9 + m) * 64 + cc] + sR[(1 * 9 + m) * 64 + cc] + sR[(2 * 9 + m) * 64 + cc] + sR[(3 * 9 + m) * 64 + cc];
    p.mod[((size_t)l * 9 + m) * 6144 + j0 + cc] = v + p.b_ada[l * 6144 + j0 + cc];
  }
}

__device__ __forceinline__ void phase0(const Params& p, float* sm) {
  const int PER_LAYER = 3272;
  const int total = 2 * PER_LAYER + 192;
  for (int item = blockIdx.x; item < total; item += gridDim.x) {
    if (item < 192) { mod_item(p, item, sm); continue; }
    int it = item - 192;
    int l = it / PER_LAYER, r = it % PER_LAYER;
    if (r < 768) { cvt_tile(p.w_in + (size_t)l * 1024 * 3024, 1024, 3024, p.WinT + (size_t)l * 3072 * 1024, 1, r / 16, r % 16, sm); continue; }
    r -= 768;
    if (r < 72) { cvt_tile(p.mla_w_uq + (size_t)l * 384 * 768, 384, 768, p.WuqT + (size_t)l * 768 * 384, 0, r / 6, r % 6, sm); continue; }
    r -= 72;
    if (r < 64) { cvt_tile(p.mla_w_ukv + (size_t)l * 256 * 1024, 256, 1024, p.WukvT + (size_t)l * 1024 * 256, 0, r / 4, r % 4, sm); continue; }
    r -= 64;
    if (r < 256) { cvt_tile(p.w_out + (size_t)l * 1024 * 1024, 1024, 1024, p.WoutT + (size_t)l * 1024 * 1024, 0, r / 16, r % 16, sm); continue; }
    r -= 256;
    if (r < 1408) { cvt_tile(p.w_ffn_in + (size_t)l * 1024 * 5632, 1024, 5632, p.WfiT + (size_t)l * 5632 * 1024, 2, r / 16, r % 16, sm); continue; }
    r -= 1408;
    cvt_tile(p.w_ffn_out + (size_t)l * 2816 * 1024, 2816, 1024, p.WfoT + (size_t)l * 1024 * 2816, 0, r / 44, r % 44, sm);
  }
}

__device__ __forceinline__ void rowpass_norm(const Params& p, int l, int stage) {
  const int tidl = tid_l();
  const int lane = tidl & 63, w = tidl >> 6;
  const int ln = stage == 0 ? 0 : (stage == 1 ? l : l + 1);
  const int sh_off = stage == 1 ? 3072 : 0;
  const float* gpre = stage == 1 ? p.g_pre_ffn + l * 1024 : p.g_pre_mix + (ln < 2 ? ln : 0) * 1024;
  u16* dst = stage == 1 ? p.MIX : p.HQ;
  for (int t = blockIdx.x * 4 + w; t < T_ALL; t += gridDim.x * 4) {
    const int m = tok_mod(t);
    float x[16];
    float* xo = p.out + (size_t)t * 1024;
    if (stage == 0) {
      const float* xi = t < T_CTX ? p.x_prompt + (size_t)t * 1024 : p.x_sample + (size_t)(t - T_CTX) * 1024;
#pragma unroll
      for (int i = 0; i < 4; ++i) {
        float4 v = *(const float4*)(xi + i * 256 + lane * 4);
        x[i * 4 + 0] = v.x; x[i * 4 + 1] = v.y; x[i * 4 + 2] = v.z; x[i * 4 + 3] = v.w;
      }
    } else {
      const u16* yp = p.HQ + (size_t)t * 1024;
      float y[16]; float ss = 0.f;
#pragma unroll
      for (int i = 0; i < 4; ++i) {
        uint2 v = *(const uint2*)(yp + i * 256 + lane * 4);
        y[i * 4 + 0] = bf2f((u16)(v.x & 0xffff)); y[i * 4 + 1] = bf2f((u16)(v.x >> 16));
        y[i * 4 + 2] = bf2f((u16)(v.y & 0xffff)); y[i * 4 + 3] = bf2f((u16)(v.y >> 16));
      }
#pragma unroll
      for (int i = 0; i < 16; ++i) ss += y[i] * y[i];
      ss = wave_sum(ss);
      const float rstd = rsqrtf(ss * (1.f / 1024.f) + 1e-6f);
      const float* gpost = (stage == 1 ? p.g_post_mix : p.g_post_ffn) + l * 1024;
      const float* gt = p.mod + ((size_t)l * 9 + m) * 6144 + (stage == 1 ? 2048 : 5120);
#pragma unroll
      for (int i = 0; i < 4; ++i) {
        float4 xv = *(const float4*)(xo + i * 256 + lane * 4);
        float4 gp = *(const float4*)(gpost + i * 256 + lane * 4);
        float4 gg = *(const float4*)(gt + i * 256 + lane * 4);
        x[i * 4 + 0] = xv.x + gg.x * y[i * 4 + 0] * rstd * gp.x;
        x[i * 4 + 1] = xv.y + gg.y * y[i * 4 + 1] * rstd * gp.y;
        x[i * 4 + 2] = xv.z + gg.z * y[i * 4 + 2] * rstd * gp.z;
        x[i * 4 + 3] = xv.w + gg.w * y[i * 4 + 3] * rstd * gp.w;
      }
    }
    __threadfence_block();
#pragma unroll
    for (int i = 0; i < 4; ++i)
      *(float4*)(xo + i * 256 + lane * 4) = make_float4(x[i * 4 + 0], x[i * 4 + 1], x[i * 4 + 2], x[i * 4 + 3]);
    if (ln >= 2) continue;
    float ss = 0.f;
#pragma unroll
    for (int i = 0; i < 16; ++i) ss += x[i] * x[i];
    ss = wave_sum(ss);
    const float rstd = rsqrtf(ss * (1.f / 1024.f) + 1e-6f);
    const float* sh = p.mod + ((size_t)ln * 9 + m) * 6144 + sh_off;
    const float* sc = sh + 1024;
    u16* hp = dst + (size_t)t * 1024;
#pragma unroll
    for (int i = 0; i < 4; ++i) {
      float4 gp = *(const float4*)(gpre + i * 256 + lane * 4);
      float4 s1 = *(const float4*)(sh + i * 256 + lane * 4);
      float4 c1 = *(const float4*)(sc + i * 256 + lane * 4);
      float h0 = x[i * 4 + 0] * rstd * gp.x * (1.f + c1.x) + s1.x;
      float h1 = x[i * 4 + 1] * rstd * gp.y * (1.f + c1.y) + s1.y;
      float h2 = x[i * 4 + 2] * rstd * gp.z * (1.f + c1.z) + s1.z;
      float h3 = x[i * 4 + 3] * rstd * gp.w * (1.f + c1.w) + s1.w;
      uint2 o;
      o.x = (unsigned)f2bf(h0) | ((unsigned)f2bf(h1) << 16);
      o.y = (unsigned)f2bf(h2) | ((unsigned)f2bf(h3) << 16);
      *(uint2*)(hp + i * 256 + lane * 4) = o;
    }
  }
}

__device__ __forceinline__ void unpack8(const uint4 v, float (&f)[8]);
__device__ __forceinline__ uint4 pack8(const float (&f)[8]);
__device__ __forceinline__ void rowpass_b0(const Params& p, int l) {
  const int tidl = tid_l();
  const int lane = tidl & 63, w = tidl >> 6;
  for (int t = blockIdx.x * 4 + w; t < T_ALL + 2048; t += gridDim.x * 4) {
    if (t >= T_ALL) {
      const int r = t - T_ALL, b = r >> 8, s = r & 255;
      if (lane < 32) {
        const float* ck = p.cache_ckv + (((size_t)b * 2 + l) * 256 + s) * 256 + lane * 8;
        const float4 x0 = *(const float4*)ck, x1 = *(const float4*)(ck + 4);
        const float f[8] = {x0.x, x0.y, x0.z, x0.w, x1.x, x1.y, x1.z, x1.w};
        *(uint4*)(p.CKVC + (size_t)r * 256 + lane * 8) = pack8(f);
      } else if (lane < 40) {
        const float* kr = p.cache_kr + (((size_t)b * 2 + l) * 256 + s) * 64 + (lane - 32) * 8;
        const float4 x0 = *(const float4*)kr, x1 = *(const float4*)(kr + 4);
        const float f[8] = {x0.x, x0.y, x0.z, x0.w, x1.x, x1.y, x1.z, x1.w};
        *(uint4*)(p.KRC + (size_t)r * 64 + (lane - 32) * 8) = pack8(f);
      }
      continue;
    }
    u16* pr = p.P + (size_t)t * PW;
    {
      float f[8]; float ss = 0.f;
      if (lane < 48) {
        unpack8(*(const uint4*)(pr + P_MCQ + lane * 8), f);
#pragma unroll
        for (int i = 0; i < 8; ++i) ss += f[i] * f[i];
      }
      ss = wave_sum(ss);
      const float rstd = rsqrtf(ss * (1.f / 384.f) + 1e-6f);
      if (lane < 48) {
        const float* wq = p.mla_q_norm_w + l * 384 + lane * 8;
        const float4 w0 = *(const float4*)wq, w1 = *(const float4*)(wq + 4);
        f[0] *= rstd * w0.x; f[1] *= rstd * w0.y; f[2] *= rstd * w0.z; f[3] *= rstd * w0.w;
        f[4] *= rstd * w1.x; f[5] *= rstd * w1.y; f[6] *= rstd * w1.z; f[7] *= rstd * w1.w;
        *(uint4*)(pr + P_MCQ + lane * 8) = pack8(f);
      }
    }
    {
      float f[8]; float ss = 0.f;
      if (lane < 32) {
        unpack8(*(const uint4*)(pr + P_MCKV + lane * 8), f);
#pragma unroll
        for (int i = 0; i < 8; ++i) ss += f[i] * f[i];
      }
      ss = wave_sum(ss);
      const float rstd = rsqrtf(ss * (1.f / 256.f) + 1e-6f);
      if (lane < 32) {
        const float* wk = p.mla_kv_norm_w + l * 256 + lane * 8;
        const float4 w0 = *(const float4*)wk, w1 = *(const float4*)(wk + 4);
        f[0] *= rstd * w0.x; f[1] *= rstd * w0.y; f[2] *= rstd * w0.z; f[3] *= rstd * w0.w;
        f[4] *= rstd * w1.x; f[5] *= rstd * w1.y; f[6] *= rstd * w1.z; f[7] *= rstd * w1.w;
        *(uint4*)(pr + P_MCKV + lane * 8) = pack8(f);
        if (t < T_CTX) {
          const int b = t >> 8, s = t & 255;
          float* op = p.out + OUT_CKV + (((size_t)b * 2 + l) * 256 + s) * 256 + lane * 8;
          *(float4*)op = make_float4(f[0], f[1], f[2], f[3]);
          *(float4*)(op + 4) = make_float4(f[4], f[5], f[6], f[7]);
        }
      }
    }
    {
      float v = bf2f(pr[P_MKR + lane]);
      if (t < T_CTX) {
        int b = t >> 8, s = t & 255;
        p.out[OUT_KR + (((size_t)b * 2 + l) * 256 + s) * 64 + lane] = v;
      } else {
        int pos = (t - T_CTX) & 4095;
        int axis = lane >> 5, half = (lane >> 4) & 1, f = lane & 15;
        float posf = axis == 0 ? (float)(pos >> 6) : (float)(pos & 63);
        float inv = exp2f(-(float)f * (13.287712379549449f / 16.f));
        float ang = posf * inv;
        float sn, cs;
        __sincosf(ang, &sn, &cs);
        float other = __shfl_xor(v, 16);
        float o = half == 0 ? v * cs - other * sn : v * cs + other * sn;
        pr[P_MKR + lane] = f2bf(o);
      }
    }
  }
}

#define P_QH 2304
#define P_KH 2560
__device__ __forceinline__ void rowpass_b2(const Params& p, int l) {
  const int tidl = tid_l();
  const int lane = tidl & 63, w = tidl >> 6;
  float cw[8][5], cv[8][5];
#pragma unroll
  for (int e = 0; e < 8; ++e)
#pragma unroll
    for (int j = 0; j < 5; ++j) {
      cw[e][j] = p.gdn_conv_w[((size_t)l * 768 + 8 * lane + e) * 5 + j];
      cv[e][j] = p.gdn_conv_w[((size_t)l * 768 + 512 + 8 * (lane & 31) + e) * 5 + j];
    }
  u16* VH = p.HQ + (size_t)T_ALL * 768;
  for (int t = blockIdx.x * 4 + w; t < T_ALL; t += gridDim.x * 4) {
    const int len = t < T_CTX ? 256 : 4096;
    const int tau = t < T_CTX ? (t & 255) : ((t - T_CTX) & 4095);
    float y[8], yv[8];
#pragma unroll
    for (int e = 0; e < 8; ++e) { y[e] = 0.f; yv[e] = 0.f; }
#pragma unroll
    for (int j = 0; j < 5; ++j) {
      const int tt = tau + j - 2;
      if (tt >= 0 && tt < len) {
        const u16* pr = p.P + (size_t)(t + j - 2) * PW;
        float f[8];
        unpack8(*(const uint4*)(pr + 8 * lane), f);
#pragma unroll
        for (int e = 0; e < 8; ++e) y[e] += cw[e][j] * f[e];
        if (lane < 32) {
          unpack8(*(const uint4*)(pr + 512 + 8 * lane), f);
#pragma unroll
          for (int e = 0; e < 8; ++e) yv[e] += cv[e][j] * f[e];
        }
      }
    }
    float ss = 0.f;
#pragma unroll
    for (int e = 0; e < 8; ++e) { y[e] = siluf_(y[e]); yv[e] = siluf_(yv[e]); ss += y[e] * y[e]; }
    ss += __shfl_xor(ss, 1); ss += __shfl_xor(ss, 2); ss += __shfl_xor(ss, 4);
    const float rn = rsqrtf(ss + 1e-6f) * (lane < 32 ? 0.125f : 1.f);
#pragma unroll
    for (int e = 0; e < 8; ++e) y[e] *= rn;
    *(uint4*)(p.P + (size_t)t * PW + P_QH + 8 * lane) = pack8(y);
    if (lane < 32) *(uint4*)(VH + (size_t)t * 256 + 8 * lane) = pack8(yv);
  }
}

__device__ __forceinline__ void unpack8(const uint4 v, float (&f)[8]) {
  f[0] = bf2f((u16)(v.x & 0xffff)); f[1] = bf2f((u16)(v.x >> 16)); f[2] = bf2f((u16)(v.y & 0xffff)); f[3] = bf2f((u16)(v.y >> 16));
  f[4] = bf2f((u16)(v.z & 0xffff)); f[5] = bf2f((u16)(v.z >> 16)); f[6] = bf2f((u16)(v.w & 0xffff)); f[7] = bf2f((u16)(v.w >> 16));
}
__device__ __forceinline__ uint4 pack8(const float (&f)[8]) {
  uint4 o;
  o.x = (unsigned)f2bf(f[0]) | ((unsigned)f2bf(f[1]) << 16); o.y = (unsigned)f2bf(f[2]) | ((unsigned)f2bf(f[3]) << 16);
  o.z = (unsigned)f2bf(f[4]) | ((unsigned)f2bf(f[5]) << 16); o.w = (unsigned)f2bf(f[6]) | ((unsigned)f2bf(f[7]) << 16);
  return o;
}
__device__ __forceinline__ void rowpass_c2(const Params& p, int l) {
  const int tidl = tid_l();
  const int lane = tidl & 63, w = tidl >> 6;
  const int hl = lane & 31, isH = lane >> 5;
  const float* nw = (isH ? p.hgrn_norm_w : p.gdn_norm_w) + l * 64 + (hl & 7) * 8;
  const float4 w0 = *(const float4*)(nw), w1 = *(const float4*)(nw + 4);
  const float wv[8] = {w0.x, w0.y, w0.z, w0.w, w1.x, w1.y, w1.z, w1.w};
  for (int t = blockIdx.x * 4 + w; t < T_ALL; t += gridDim.x * 4) {
    u16* mr = p.MIX + (size_t)t * 1024;
    const u16* pr = p.P + (size_t)t * PW;
    const u16* qr = p.HQ + (size_t)t * 768;
    const uint4 vf = *(const uint4*)(mr + isH * 512 + hl * 8);
    const uint4 vb = *(const uint4*)(mr + isH * 512 + 256 + hl * 8);
    const uint4 vg = *(const uint4*)(pr + (isH ? P_HG : P_GZ) + hl * 8);
    const int c0 = lane * 8;
    const uint4 vo = *(const uint4*)(qr + (c0 >> 7) * 192 + (c0 & 127));
    float f[8], bb[8], g[8];
    unpack8(vf, f); unpack8(vb, bb); unpack8(vg, g);
    float ss = 0.f;
#pragma unroll
    for (int i = 0; i < 8; ++i) { f[i] += bb[i]; ss += f[i] * f[i]; }
    ss += __shfl_xor(ss, 1); ss += __shfl_xor(ss, 2); ss += __shfl_xor(ss, 4);
    const float rn = rsqrtf(ss * (1.f / 64.f) + 1e-6f);
#pragma unroll
    for (int i = 0; i < 8; ++i) f[i] = f[i] * rn * wv[i] * (isH ? sigmoidf_(g[i]) : siluf_(g[i]));
    __threadfence_block();
    *(uint4*)(mr + isH * 256 + hl * 8) = pack8(f);
    *(uint4*)(mr + 512 + c0) = vo;
  }
}

__device__ __forceinline__ void gemm128(const u16* __restrict__ A, int lda, const u16* __restrict__ B, int ldb, int K,
                                        u16* lds, f32x4 (&acc)[4][4]) {
  const int tid = tid_l(), lane = tid & 63, w = tid >> 6, wm = w >> 1, wn = w & 1;
  const int r16 = lane & 15, g4 = lane >> 4;
#pragma unroll
  for (int i = 0; i < 4; ++i)
#pragma unroll
    for (int j = 0; j < 4; ++j) acc[i][j] = f32x4{0.f, 0.f, 0.f, 0.f};
  const int lrow = tid >> 3, lkc = tid & 7;
  const u16* ap = A + (size_t)lrow * lda + lkc * 8;
  const u16* bp = B + (size_t)lrow * ldb + lkc * 8;
  const size_t sa32 = (size_t)32 * lda, sb32 = (size_t)32 * ldb;
  uint4 ra0 = *(const uint4*)(ap), ra1 = *(const uint4*)(ap + sa32), ra2 = *(const uint4*)(ap + 2 * sa32), ra3 = *(const uint4*)(ap + 3 * sa32);
  uint4 rb0 = *(const uint4*)(bp), rb1 = *(const uint4*)(bp + sb32), rb2 = *(const uint4*)(bp + 2 * sb32), rb3 = *(const uint4*)(bp + 3 * sb32);
  const int woff = lrow * 64 + ((lkc ^ (lrow & 7)) * 8);
  const int sw = r16 & 7;
  const int fa0 = (wm * 64 + r16) * 64 + ((g4 ^ sw) * 8);
  const int fa1 = (wm * 64 + r16) * 64 + (((4 + g4) ^ sw) * 8);
  const int fb0 = 128 * 64 + (wn * 64 + r16) * 64 + ((g4 ^ sw) * 8);
  const int fb1 = 128 * 64 + (wn * 64 + r16) * 64 + (((4 + g4) ^ sw) * 8);
  const int nk = K >> 6;
  __syncthreads();
  {
    u16* wa = lds + woff; u16* wb = lds + 128 * 64 + woff;
    *(uint4*)(wa) = ra0; *(uint4*)(wa + 32 * 64) = ra1; *(uint4*)(wa + 64 * 64) = ra2; *(uint4*)(wa + 96 * 64) = ra3;
    *(uint4*)(wb) = rb0; *(uint4*)(wb + 32 * 64) = rb1; *(uint4*)(wb + 64 * 64) = rb2; *(uint4*)(wb + 96 * 64) = rb3;
  }
  if (nk > 1) {
    const u16* a2 = ap + 64; const u16* b2 = bp + 64;
    ra0 = *(const uint4*)(a2); ra1 = *(const uint4*)(a2 + sa32); ra2 = *(const uint4*)(a2 + 2 * sa32); ra3 = *(const uint4*)(a2 + 3 * sa32);
    rb0 = *(const uint4*)(b2); rb1 = *(const uint4*)(b2 + sb32); rb2 = *(const uint4*)(b2 + 2 * sb32); rb3 = *(const uint4*)(b2 + 3 * sb32);
  }
  __syncthreads();
  for (int kt = 0; kt < nk; ++kt) {
    const u16* cur = lds + (kt & 1) * (256 * 64);
    if (kt + 1 < nk) {
      u16* nxt = lds + ((kt + 1) & 1) * (256 * 64);
      u16* wa = nxt + woff; u16* wb = nxt + 128 * 64 + woff;
      *(uint4*)(wa) = ra0; *(uint4*)(wa + 32 * 64) = ra1; *(uint4*)(wa + 64 * 64) = ra2; *(uint4*)(wa + 96 * 64) = ra3;
      *(uint4*)(wb) = rb0; *(uint4*)(wb + 32 * 64) = rb1; *(uint4*)(wb + 64 * 64) = rb2; *(uint4*)(wb + 96 * 64) = rb3;
      if (kt + 2 < nk) {
        const u16* a2 = ap + (kt + 2) * 64; const u16* b2 = bp + (kt + 2) * 64;
        ra0 = *(const uint4*)(a2); ra1 = *(const uint4*)(a2 + sa32); ra2 = *(const uint4*)(a2 + 2 * sa32); ra3 = *(const uint4*)(a2 + 3 * sa32);
        rb0 = *(const uint4*)(b2); rb1 = *(const uint4*)(b2 + sb32); rb2 = *(const uint4*)(b2 + 2 * sb32); rb3 = *(const uint4*)(b2 + 3 * sb32);
      }
    }
    {
      const u16* pa0 = cur + fa0; const u16* pa1 = cur + fa1; const u16* pb0 = cur + fb0; const u16* pb1 = cur + fb1;
      bf16x8 a0 = *(const bf16x8*)(pa0), a1 = *(const bf16x8*)(pa0 + 16 * 64), a2 = *(const bf16x8*)(pa0 + 32 * 64), a3 = *(const bf16x8*)(pa0 + 48 * 64);
      bf16x8 b0 = *(const bf16x8*)(pb0), b1 = *(const bf16x8*)(pb0 + 16 * 64), b2 = *(const bf16x8*)(pb0 + 32 * 64), b3 = *(const bf16x8*)(pb0 + 48 * 64);
      bf16x8 c0 = *(const bf16x8*)(pa1), c1 = *(const bf16x8*)(pa1 + 16 * 64), c2 = *(const bf16x8*)(pa1 + 32 * 64), c3 = *(const bf16x8*)(pa1 + 48 * 64);
      bf16x8 d0 = *(const bf16x8*)(pb1), d1 = *(const bf16x8*)(pb1 + 16 * 64), d2 = *(const bf16x8*)(pb1 + 32 * 64), d3 = *(const bf16x8*)(pb1 + 48 * 64);
      __builtin_amdgcn_sched_barrier(0);
#define G128_MM(j, bj, x0, x1, x2, x3) do { \
        acc[0][j] = __builtin_amdgcn_mfma_f32_16x16x32_bf16(bj, x0, acc[0][j], 0, 0, 0); \
        acc[1][j] = __builtin_amdgcn_mfma_f32_16x16x32_bf16(bj, x1, acc[1][j], 0, 0, 0); \
        acc[2][j] = __builtin_amdgcn_mfma_f32_16x16x32_bf16(bj, x2, acc[2][j], 0, 0, 0); \
        acc[3][j] = __builtin_amdgcn_mfma_f32_16x16x32_bf16(bj, x3, acc[3][j], 0, 0, 0); } while (0)
      __builtin_amdgcn_s_setprio(1);
      G128_MM(0, b0, a0, a1, a2, a3); G128_MM(1, b1, a0, a1, a2, a3); G128_MM(2, b2, a0, a1, a2, a3); G128_MM(3, b3, a0, a1, a2, a3);
      G128_MM(0, d0, c0, c1, c2, c3); G128_MM(1, d1, c0, c1, c2, c3); G128_MM(2, d2, c0, c1, c2, c3); G128_MM(3, d3, c0, c1, c2, c3);
      __builtin_amdgcn_s_setprio(0);
    }
    __syncthreads();
  }
}
__device__ __forceinline__ uint2 pack4(f32x4 v) {
  uint2 o;
  o.x = (unsigned)f2bf(v[0]) | ((unsigned)f2bf(v[1]) << 16);
  o.y = (unsigned)f2bf(v[2]) | ((unsigned)f2bf(v[3]) << 16);
  return o;
}

__device__ __forceinline__ void gemm256(const u16* __restrict__ A, int lda, const u16* __restrict__ B, int ldb, int K,
                                        u16* lds, f32x4 (&acc)[8][4]) {
  const int tid = tid_l(), lane = tid & 63, w = tid >> 6, wm = w >> 1, wn = w & 1;
  const int r16 = lane & 15, g4 = lane >> 4;
#pragma unroll
  for (int i = 0; i < 8; ++i)
#pragma unroll
    for (int j = 0; j < 4; ++j) acc[i][j] = f32x4{0.f, 0.f, 0.f, 0.f};
  const int lrow = tid >> 2, lkc = tid & 3;
  const u16* ap = A + (size_t)lrow * lda + lkc * 8;
  const u16* bp = B + (size_t)lrow * ldb + lkc * 8;
  const size_t sa64 = (size_t)64 * lda, sb64 = (size_t)64 * ldb;
  const int woff = lrow * 32 + ((lkc ^ ((lrow >> 1) & 3)) * 8);
  const int fsw = (g4 ^ ((r16 >> 1) & 3)) * 8;
  const int faoff = (wm * 128 + r16) * 32 + fsw;
  const int fboff = 256 * 32 + (wn * 64 + r16) * 32 + fsw;
  const int nk = K >> 5;
  const int BUF = 384 * 32;
  uint4 xa0, xa1, xa2, xa3, xb0, xb1;
  uint4 ya0, ya1, ya2, ya3, yb0, yb1;
#define G256_LOAD(P, st) do { const u16* a2_ = ap + (st) * 32; const u16* b2_ = bp + (st) * 32; \
    P##a0 = *(const uint4*)(a2_); P##a1 = *(const uint4*)(a2_ + sa64); P##a2 = *(const uint4*)(a2_ + 2 * sa64); P##a3 = *(const uint4*)(a2_ + 3 * sa64); \
    P##b0 = *(const uint4*)(b2_); P##b1 = *(const uint4*)(b2_ + sb64); } while (0)
#define G256_STORE(P, buf) do { u16* wa_ = lds + (buf) * BUF + woff; u16* wb_ = wa_ + 256 * 32; \
    *(uint4*)(wa_) = P##a0; *(uint4*)(wa_ + 64 * 32) = P##a1; *(uint4*)(wa_ + 128 * 32) = P##a2; *(uint4*)(wa_ + 192 * 32) = P##a3; \
    *(uint4*)(wb_) = P##b0; *(uint4*)(wb_ + 64 * 32) = P##b1; } while (0)
#define G256_MM(i, af) do { \
      acc[i][0] = __builtin_amdgcn_mfma_f32_16x16x32_bf16(bf0, af, acc[i][0], 0, 0, 0); \
      acc[i][1] = __builtin_amdgcn_mfma_f32_16x16x32_bf16(bf1, af, acc[i][1], 0, 0, 0); \
      acc[i][2] = __builtin_amdgcn_mfma_f32_16x16x32_bf16(bf2, af, acc[i][2], 0, 0, 0); \
      acc[i][3] = __builtin_amdgcn_mfma_f32_16x16x32_bf16(bf3, af, acc[i][3], 0, 0, 0); } while (0)
#define G256_COMPUTE(buf) do { const u16* fa_ = lds + (buf) * BUF + faoff; const u16* fb_ = lds + (buf) * BUF + fboff; \
    bf16x8 bf0 = *(const bf16x8*)(fb_), bf1 = *(const bf16x8*)(fb_ + 16 * 32), bf2 = *(const bf16x8*)(fb_ + 32 * 32), bf3 = *(const bf16x8*)(fb_ + 48 * 32); \
    bf16x8 a0 = *(const bf16x8*)(fa_), a1 = *(const bf16x8*)(fa_ + 16 * 32), a2 = *(const bf16x8*)(fa_ + 32 * 32), a3 = *(const bf16x8*)(fa_ + 48 * 32); \
    __builtin_amdgcn_sched_barrier(0); __builtin_amdgcn_s_setprio(1); \
    G256_MM(0, a0); a0 = *(const bf16x8*)(fa_ + 64 * 32); __builtin_amdgcn_sched_barrier(0); \
    G256_MM(1, a1); a1 = *(const bf16x8*)(fa_ + 80 * 32); __builtin_amdgcn_sched_barrier(0); \
    G256_MM(2, a2); a2 = *(const bf16x8*)(fa_ + 96 * 32); __builtin_amdgcn_sched_barrier(0); \
    G256_MM(3, a3); a3 = *(const bf16x8*)(fa_ + 112 * 32); __builtin_amdgcn_sched_barrier(0); \
    G256_MM(4, a0); G256_MM(5, a1); G256_MM(6, a2); G256_MM(7, a3); __builtin_amdgcn_s_setprio(0); } while (0)
  bf16x8 bf0, bf1, bf2, bf3, a0, a1, a2, a3;
#define G3_PRELOAD(buf) do { const u16* fa_ = lds + (buf) * BUF + faoff; const u16* fb_ = lds + (buf) * BUF + fboff; \
    bf0 = *(const bf16x8*)(fb_); bf1 = *(const bf16x8*)(fb_ + 16 * 32); bf2 = *(const bf16x8*)(fb_ + 32 * 32); bf3 = *(const bf16x8*)(fb_ + 48 * 32); \
    a0 = *(const bf16x8*)(fa_); a1 = *(const bf16x8*)(fa_ + 16 * 32); a2 = *(const bf16x8*)(fa_ + 32 * 32); a3 = *(const bf16x8*)(fa_ + 48 * 32); } while (0)
#define G3_COMPUTE(buf) do { const u16* fa_ = lds + (buf) * BUF + faoff; \
    __builtin_amdgcn_sched_barrier(0); __builtin_amdgcn_s_setprio(1); \
    G256_MM(0, a0); a0 = *(const bf16x8*)(fa_ + 64 * 32); __builtin_amdgcn_sched_barrier(0); \
    G256_MM(1, a1); a1 = *(const bf16x8*)(fa_ + 80 * 32); __builtin_amdgcn_sched_barrier(0); \
    G256_MM(2, a2); a2 = *(const bf16x8*)(fa_ + 96 * 32); __builtin_amdgcn_sched_barrier(0); \
    G256_MM(3, a3); a3 = *(const bf16x8*)(fa_ + 112 * 32); __builtin_amdgcn_sched_barrier(0); \
    G256_MM(4, a0); G256_MM(5, a1); G256_MM(6, a2); G256_MM(7, a3); __builtin_amdgcn_s_setprio(0); \
    __builtin_amdgcn_sched_barrier(0); } while (0)
#define G3_STAGE(i, SET) do { \
    if (kt + (i) + 2 < nk) G256_STORE(SET, ((i) + 2) % 3); \
    if (kt + (i) + 4 < nk) G256_LOAD(SET, kt + (i) + 4); \
    if (kt + (i) < nk) G3_COMPUTE((i) % 3); \
    if (kt + (i) + 1 < nk) G3_PRELOAD(((i) + 1) % 3); \
    __syncthreads(); } while (0)
  G256_LOAD(x, 0);
  G256_LOAD(y, 1);
  __syncthreads();
  G256_STORE(x, 0);
  G256_LOAD(x, 2);
  G256_STORE(y, 1);
  G256_LOAD(y, 3);
  __syncthreads();
  G3_PRELOAD(0);
  for (int kt = 0; kt < nk; kt += 6) {
    G3_STAGE(0, x); G3_STAGE(1, y); G3_STAGE(2, x); G3_STAGE(3, y); G3_STAGE(4, x); G3_STAGE(5, y);
  }
}

__device__ __forceinline__ void gemm192(const u16* __restrict__ A, int lda, const u16* __restrict__ B, int ldb, int K,
                                        u16* lds, f32x4 (&acc)[6][4]) {
  const int tid = tid_l(), lane = tid & 63, w = tid >> 6, wm = w >> 1, wn = w & 1;
  const int r16 = lane & 15, g4 = lane >> 4;
#pragma unroll
  for (int i = 0; i < 6; ++i)
#pragma unroll
    for (int j = 0; j < 4; ++j) acc[i][j] = f32x4{0.f, 0.f, 0.f, 0.f};
  const int lrow = tid >> 2, lkc = tid & 3;
  const u16* ap = A + (size_t)lrow * lda + lkc * 8;
  const u16* bp = B + (size_t)lrow * ldb + lkc * 8;
  const size_t sa64 = (size_t)64 * lda, sb64 = (size_t)64 * ldb;
  const int woff = lrow * 32 + ((lkc ^ ((lrow >> 1) & 3)) * 8);
  const int fsw = (g4 ^ ((r16 >> 1) & 3)) * 8;
  const int faoff = (wm * 96 + r16) * 32 + fsw;
  const int fboff = 192 * 32 + (wn * 64 + r16) * 32 + fsw;
  const int nk = K >> 5;
  const int BUF = 320 * 32;
  uint4 xa0, xa1, xa2, xb0, xb1;
  uint4 ya0, ya1, ya2, yb0, yb1;
#define G192_LOAD(P, st) do { const u16* a2_ = ap + (st) * 32; const u16* b2_ = bp + (st) * 32; \
    P##a0 = *(const uint4*)(a2_); P##a1 = *(const uint4*)(a2_ + sa64); P##a2 = *(const uint4*)(a2_ + 2 * sa64); \
    P##b0 = *(const uint4*)(b2_); P##b1 = *(const uint4*)(b2_ + sb64); } while (0)
#define G192_STORE(P, buf) do { u16* wa_ = lds + (buf) * BUF + woff; u16* wb_ = wa_ + 192 * 32; \
    *(uint4*)(wa_) = P##a0; *(uint4*)(wa_ + 64 * 32) = P##a1; *(uint4*)(wa_ + 128 * 32) = P##a2; \
    *(uint4*)(wb_) = P##b0; *(uint4*)(wb_ + 64 * 32) = P##b1; } while (0)
#define G192_COMPUTE(buf) do { const u16* fa_ = lds + (buf) * BUF + faoff; const u16* fb_ = lds + (buf) * BUF + fboff; \
    bf16x8 bf0 = *(const bf16x8*)(fb_), bf1 = *(const bf16x8*)(fb_ + 16 * 32), bf2 = *(const bf16x8*)(fb_ + 32 * 32), bf3 = *(const bf16x8*)(fb_ + 48 * 32); \
    bf16x8 a0 = *(const bf16x8*)(fa_), a1 = *(const bf16x8*)(fa_ + 16 * 32), a2 = *(const bf16x8*)(fa_ + 32 * 32), a3 = *(const bf16x8*)(fa_ + 48 * 32); \
    __builtin_amdgcn_sched_barrier(0); __builtin_amdgcn_s_setprio(1); \
    G256_MM(0, a0); a0 = *(const bf16x8*)(fa_ + 64 * 32); __builtin_amdgcn_sched_barrier(0); \
    G256_MM(1, a1); a1 = *(const bf16x8*)(fa_ + 80 * 32); __builtin_amdgcn_sched_barrier(0); \
    G256_MM(2, a2); G256_MM(3, a3); G256_MM(4, a0); G256_MM(5, a1); __builtin_amdgcn_s_setprio(0); } while (0)
  G192_LOAD(x, 0);
  G192_LOAD(y, 1);
  __syncthreads();
  G192_STORE(x, 0);
  G192_LOAD(x, 2);
  __syncthreads();
  for (int kt = 0; kt < nk; kt += 2) {
    G192_STORE(y, 1);
    if (kt + 3 < nk) G192_LOAD(y, kt + 3);
    G192_COMPUTE(0);
    __syncthreads();
    if (kt + 2 < nk) {
      G192_STORE(x, 0);
      if (kt + 4 < nk) G192_LOAD(x, kt + 4);
    }
    G192_COMPUTE(1);
    __syncthreads();
  }
}
#define GEMM256_RC const int tde = tid_l(); const int rb = ((tde >> 6) >> 1) * 128 + (tde & 15), cb = ((tde >> 6) & 1) * 64 + ((tde & 63) >> 4) * 4;
#define GEMM_RC const int tde = tid_l(); const int rb = ((tde >> 6) >> 1) * 64 + (tde & 15), cb = ((tde >> 6) & 1) * 64 + ((tde & 63) >> 4) * 4;


__device__ __forceinline__ bool tile_at(int r, int Mt, int Nt, int& mt, int& nt) {
  const int x = blockIdx.x & 7, j = blockIdx.x >> 3, bpx = gridDim.x >> 3;
  const int mpx = Mt >> 3;
  const int q = r * bpx + j;
  if (q >= mpx * Nt) return false;
  const int full = (Nt >> 3) * (mpx * 8);
  int cb, rem, wcb;
  if (q < full) { cb = q / (mpx * 8); rem = q - cb * mpx * 8; wcb = 8; }
  else { cb = Nt >> 3; rem = q - full; wcb = Nt - cb * 8; }
  mt = x * mpx + rem / wcb;
  nt = cb * 8 + rem % wcb;
  return true;
}

__device__ __forceinline__ void phase_a(const Params& p, int l, u16* lds) {
  const u16* Bw = p.WinT + (size_t)l * 3072 * 1024;
  int mt, nt;
  for (int r = 0; tile_at(r, 144, 24, mt, nt); ++r) {
    const int m0 = mt * 256, n0 = nt * 128;
    f32x4 acc[8][4];
    gemm256(p.HQ + (size_t)m0 * 1024, 1024, Bw + (size_t)n0 * 1024, 1024, 1024, lds, acc);
    { GEMM256_RC
#pragma unroll
      for (int mi = 0; mi < 8; ++mi) {
        const int row = m0 + rb + mi * 16;
#pragma unroll
        for (int ni = 0; ni < 4; ++ni) {
          const int col = n0 + cb + ni * 16;
          *(uint2*)(p.P + (size_t)row * PW + col) = pack4(acc[mi][ni]);
          if (col >= P_GA && col < P_GA + 16)
            *(float4*)(p.GAB + (size_t)row * 16 + (col - P_GA)) = make_float4(acc[mi][ni][0], acc[mi][ni][1], acc[mi][ni][2], acc[mi][ni][3]);
        }
      }
    }
  }
}

__device__ __forceinline__ void phase_b1(const Params& p, int l, u16* lds) {
  int mt, nt;
  for (int pass = 0; pass < 2; ++pass) {
  for (int r = 0; tile_at(r, pass == 0 ? 288 : 304, pass == 0 ? 6 : 8, mt, nt); ++r) {
    if (pass == 0) {
      const int m0 = mt * 128, n0 = nt * 128;
      const float qscale = 0.07216878364870322f * 1.4426950408889634f;
      f32x4 acc[4][4];
      gemm128(p.P + (size_t)m0 * PW + P_MCQ, PW, p.WuqT + (size_t)l * 768 * 384 + (size_t)n0 * 384, 384, 384, lds, acc);
      { GEMM_RC
        const int g4 = (tde & 63) >> 4;
        const int cw0 = n0 + cb - g4 * 4;
        const bool ropew = ((cw0 >> 6) % 3) == 2 && m0 >= T_CTX;
#pragma unroll
        for (int mi = 0; mi < 4; ++mi) {
          const int row = m0 + rb + mi * 16;
          f32x4 v0 = acc[mi][0], v1 = acc[mi][1], v2 = acc[mi][2], v3 = acc[mi][3];
          if (ropew) {
            const int pos = (row - T_CTX) & 4095;
#pragma unroll
            for (int r = 0; r < 4; ++r) {
              const float inv = exp2f(-(float)(g4 * 4 + r) * (13.287712379549449f / 16.f));
              float s0, c0, s1, c1;
              __sincosf((float)(pos >> 6) * inv, &s0, &c0);
              __sincosf((float)(pos & 63) * inv, &s1, &c1);
              const float a0 = v0[r] * c0 - v1[r] * s0, a1 = v1[r] * c0 + v0[r] * s0;
              const float b0 = v2[r] * c1 - v3[r] * s1, b1 = v3[r] * c1 + v2[r] * s1;
              v0[r] = a0; v1[r] = a1; v2[r] = b0; v3[r] = b1;
            }
          }
          u16* qp = p.HQ + (size_t)row * 768 + n0 + cb;
          *(uint2*)(qp) = pack4(v0 * qscale); *(uint2*)(qp + 16) = pack4(v1 * qscale);
          *(uint2*)(qp + 32) = pack4(v2 * qscale); *(uint2*)(qp + 48) = pack4(v3 * qscale);
        }
      }
    } else {
      const int m0 = mt * 128, n0 = nt * 128;
      const u16* Ap; int lda;
      if (mt < 288) { Ap = p.P + (size_t)m0 * PW + P_MCKV; lda = PW; }
      else { Ap = p.CKVC + (size_t)(m0 - T_ALL) * 256; lda = 256; }
      f32x4 acc[4][4];
      gemm128(Ap, lda, p.WukvT + (size_t)l * 1024 * 256 + (size_t)n0 * 256, 256, 256, lds, acc);
      { GEMM_RC
#pragma unroll
        for (int mi = 0; mi < 4; ++mi) {
          const int row = m0 + rb + mi * 16;
          u16* vb; int vst;
          if (row < T_CTX) { int b = row >> 8, pos = row & 255; vb = p.VTC + (size_t)(b * 4) * 128 * 256 + pos; vst = 256; }
          else if (row < T_ALL) { int b = (row - T_CTX) >> 12, pos = (row - T_CTX) & 4095; vb = p.VTL + (size_t)(b * 4) * 128 * 4352 + pos; vst = 4352; }
          else { int b = (row - T_ALL) >> 8, pos = 4096 + ((row - T_ALL) & 255); vb = p.VTL + (size_t)(b * 4) * 128 * 4352 + pos; vst = 4352; }
#pragma unroll
          for (int ni = 0; ni < 4; ++ni) {
            const int col = n0 + cb + ni * 16;
            const int h = col >> 8, wi = col & 255;
            if (wi < 128) {
              *(uint2*)(p.KN + (size_t)row * 512 + h * 128 + wi) = pack4(acc[mi][ni]);
            } else {
              u16* dst = vb + (size_t)(h * 128 + (wi - 128)) * vst;
#pragma unroll
              for (int r = 0; r < 4; ++r) dst[(size_t)r * vst] = f2bf(acc[mi][ni][r]);
            }
          }
        }
      }
    }
  }
  }
}

__device__ __forceinline__ void phase_gemm_y(const u16* A, int lda, const u16* B, int K, int N, u16* Y, int ldy, u16* lds) {
  int mt, nt;
  for (int r = 0; tile_at(r, 192, N / 128, mt, nt); ++r) {
    const int m0 = mt * 192, n0 = nt * 128;
    f32x4 acc[6][4];
    gemm192(A + (size_t)m0 * lda, lda, B + (size_t)n0 * K, K, K, lds, acc);
    {
      const int tde = tid_l();
      const int rb = ((tde >> 6) >> 1) * 96 + (tde & 15), cb = ((tde >> 6) & 1) * 64 + ((tde & 63) >> 4) * 4;
#pragma unroll
      for (int mi = 0; mi < 6; ++mi)
#pragma unroll
        for (int ni = 0; ni < 4; ++ni)
          *(uint2*)(Y + (size_t)(m0 + rb + mi * 16) * ldy + n0 + cb + ni * 16) = pack4(acc[mi][ni]);
    }
  }
}

__device__ __forceinline__ void phase_e(const Params& p, int l, u16* lds) {
  const u16* Bw = p.WfiT + (size_t)l * 5632 * 1024;
  int mt, nt;
  for (int r = 0; tile_at(r, 144, 44, mt, nt); ++r) {
    const int m0 = mt * 256, n0 = nt * 128;
    f32x4 acc[8][4];
    gemm256(p.MIX + (size_t)m0 * 1024, 1024, Bw + (size_t)n0 * 1024, 1024, 1024, lds, acc);
    { GEMM256_RC
      const int g4x4 = ((tde & 63) >> 4) * 4;
      const int hc0 = ((n0 + cb - g4x4) >> 1) + g4x4;
#pragma unroll
      for (int mi = 0; mi < 8; ++mi)
#pragma unroll
        for (int ni = 0; ni < 2; ++ni) {
          f32x4 hv;
#pragma unroll
          for (int r = 0; r < 4; ++r) hv[r] = siluf_(acc[mi][ni][r]) * acc[mi][ni + 2][r];
          *(uint2*)(p.P + (size_t)(m0 + rb + mi * 16) * DFF + hc0 + ni * 16) = pack4(hv);
        }
    }
  }
}

#define KST 208
#define VST 80
#define PST 80
__device__ __forceinline__ void attn_item(const Params& p, int latent, int b, int h, int qb, unsigned char* smraw, int dummy = 0) {
  u16* sK = (u16*)smraw;
  u16* sV = sK + 64 * KST;
  u16* sP = sV + 128 * VST;
  const int tid = tid_l(), lane = tid & 63, w = tid >> 6, r16 = lane & 15, g4 = lane >> 4;
  const int nkeys = latent ? 4352 : 256;
  const int krow0 = latent ? T_CTX + b * 4096 : b * 256;
  const int tq0 = krow0 + qb * 128;
  const u16* vt = latent ? p.VTL + (size_t)((b * 4 + h) * 128) * 4352 : p.VTC + (size_t)((b * 4 + h) * 128) * 256;
  u16* sPw = sP + w * 32 * PST;
  bf16x8 q[2][6];
#pragma unroll
  for (int mi = 0; mi < 2; ++mi)
#pragma unroll
    for (int ks = 0; ks < 6; ++ks)
      q[mi][ks] = *(const bf16x8*)(p.HQ + (size_t)(tq0 + w * 32 + mi * 16 + r16) * 768 + h * 192 + ks * 32 + g4 * 8);
  f32x4 o[2][8];
  float mrow[2], lrow[2];
#pragma unroll
  for (int mi = 0; mi < 2; ++mi) {
#pragma unroll
    for (int nd = 0; nd < 8; ++nd) o[mi][nd] = f32x4{0.f, 0.f, 0.f, 0.f};
    mrow[mi] = -1e30f; lrow[mi] = 0.f;
  }
  const int lkey = tid >> 2, lpart = tid & 3;
  const int ldv = tid >> 1, lhalf = tid & 1;
  const int ntile = nkeys >> 6;
  uint4 k0, k1, k2, k3, k4, k5;
  {
    const int pos = lkey;
    const u16* srcn = p.KN + (size_t)(krow0 + pos) * 512 + h * 128 + lpart * 8;
    const u16* srcr = p.P + (size_t)(krow0 + pos) * PW + P_MKR + lpart * 8;
    k0 = *(const uint4*)(srcn); k1 = *(const uint4*)(srcn + 32); k2 = *(const uint4*)(srcn + 64); k3 = *(const uint4*)(srcn + 96);
    k4 = *(const uint4*)(srcr); k5 = *(const uint4*)(srcr + 32);
  }
  for (int kt = 0; kt < ntile; ++kt) {
    __syncthreads();
    {
      u16* dk = sK + lkey * KST + lpart * 8;
      *(uint4*)(dk) = k0; *(uint4*)(dk + 32) = k1; *(uint4*)(dk + 64) = k2; *(uint4*)(dk + 96) = k3;
      *(uint4*)(dk + 128) = k4; *(uint4*)(dk + 160) = k5;
    }
    const u16* sv = vt + (size_t)ldv * nkeys + kt * 64 + lhalf * 32;
    const uint4 v0 = *(const uint4*)(sv), v1 = *(const uint4*)(sv + 8), v2 = *(const uint4*)(sv + 16), v3 = *(const uint4*)(sv + 24);
    __syncthreads();
    f32x4 s[2][4];
#pragma unroll
    for (int mi = 0; mi < 2; ++mi)
#pragma unroll
      for (int ni = 0; ni < 4; ++ni) s[mi][ni] = f32x4{0.f, 0.f, 0.f, 0.f};
#pragma unroll
    for (int ks = 0; ks < 6; ++ks)
#pragma unroll
      for (int ni = 0; ni < 4; ++ni) {
        bf16x8 kf = *(const bf16x8*)(sK + (ni * 16 + r16) * KST + ks * 32 + g4 * 8);
        s[0][ni] = __builtin_amdgcn_mfma_f32_16x16x32_bf16(kf, q[0][ks], s[0][ni], 0, 0, 0);
        s[1][ni] = __builtin_amdgcn_mfma_f32_16x16x32_bf16(kf, q[1][ks], s[1][ni], 0, 0, 0);
      }
#pragma unroll
    for (int mi = 0; mi < 2; ++mi) {
      float mx = -1e30f;
#pragma unroll
      for (int ni = 0; ni < 4; ++ni)
#pragma unroll
        for (int r = 0; r < 4; ++r) mx = fmaxf(mx, s[mi][ni][r]);
      mx = fmaxf(mx, __shfl_xor(mx, 16)); mx = fmaxf(mx, __shfl_xor(mx, 32));
      const float mnew = fmaxf(mrow[mi], mx);
      const float alpha = __builtin_amdgcn_exp2f(mrow[mi] - mnew);
      mrow[mi] = mnew;
      float ps = 0.f;
#pragma unroll
      for (int ni = 0; ni < 4; ++ni) {
        f32x4 pv;
#pragma unroll
        for (int r = 0; r < 4; ++r) { pv[r] = __builtin_amdgcn_exp2f(s[mi][ni][r] - mnew); ps += pv[r]; }
        *(uint2*)(sPw + (mi * 16 + r16) * PST + ni * 16 + g4 * 4) = pack4(pv);
      }
      ps += __shfl_xor(ps, 16); ps += __shfl_xor(ps, 32);
      lrow[mi] = lrow[mi] * alpha + ps;
#pragma unroll
      for (int nd = 0; nd < 8; ++nd) o[mi][nd] *= alpha;
    }
    {
      u16* dvp = sV + ldv * VST + lhalf * 32;
      *(uint4*)(dvp) = v0; *(uint4*)(dvp + 8) = v1; *(uint4*)(dvp + 16) = v2; *(uint4*)(dvp + 24) = v3;
    }
    __syncthreads();
    if (kt + 1 < ntile) {
      const int pos = (kt + 1) * 64 + lkey;
      const bool own = (!latent) || pos < 4096;
      const int row = own ? krow0 + pos : T_ALL + b * 256 + (pos - 4096);
      const u16* srcn = p.KN + (size_t)row * 512 + h * 128 + lpart * 8;
      const u16* srcr = own ? p.P + (size_t)(krow0 + pos) * PW + P_MKR + lpart * 8
                            : p.KRC + (size_t)(b * 256 + pos - 4096) * 64 + lpart * 8;
      k0 = *(const uint4*)(srcn); k1 = *(const uint4*)(srcn + 32); k2 = *(const uint4*)(srcn + 64); k3 = *(const uint4*)(srcn + 96);
      k4 = *(const uint4*)(srcr); k5 = *(const uint4*)(srcr + 32);
    }
#pragma unroll
    for (int ks2 = 0; ks2 < 2; ++ks2) {
      bf16x8 pf0 = *(const bf16x8*)(sPw + (0 * 16 + r16) * PST + ks2 * 32 + g4 * 8);
      bf16x8 pf1 = *(const bf16x8*)(sPw + (1 * 16 + r16) * PST + ks2 * 32 + g4 * 8);
#pragma unroll
      for (int nd = 0; nd < 8; ++nd) {
        bf16x8 vf = *(const bf16x8*)(sV + (nd * 16 + r16) * VST + ks2 * 32 + g4 * 8);
        o[0][nd] = __builtin_amdgcn_mfma_f32_16x16x32_bf16(vf, pf0, o[0][nd], 0, 0, 0);
        o[1][nd] = __builtin_amdgcn_mfma_f32_16x16x32_bf16(vf, pf1, o[1][nd], 0, 0, 0);
      }
    }
  }
#pragma unroll
  for (int mi = 0; mi < 2; ++mi) {
    const float inv = 1.f / lrow[mi];
    const int qrow = tq0 + w * 32 + mi * 16 + r16;
    u16* op = p.HQ + (size_t)qrow * 768 + h * 192 + g4 * 4;
    if (dummy) op = p.HQ + (size_t)T_ALL * 768 + (size_t)(qrow % 9216) * 768 + h * 192 + g4 * 4;
#pragma unroll
    for (int nd = 0; nd < 8; ++nd) *(uint2*)(op + nd * 16) = pack4(o[mi][nd] * inv);
  }
}

#define XB_TMO      128
#define XB_XCNT(j)  (256  + 64 * (j))
#define XB_XSUB(j)  (1280 + 64 * (j))
#define XB_XGEN(j)  (2304 + 64 * (j))
#define XB_TOP      3328
#define XB_TOPGEN   3392
#define XCD_BAR_WORDS 3456
#define XB_SPIN_CAP (1u << 23)
#define LAS __attribute__((address_space(3)))

__device__ __forceinline__ unsigned xb_ld(unsigned* p)              { return __hip_atomic_load(p, __ATOMIC_RELAXED, __HIP_MEMORY_SCOPE_AGENT); }
__device__ __forceinline__ unsigned xb_add(unsigned* p, unsigned v) { return __hip_atomic_fetch_add(p, v, __ATOMIC_RELAXED, __HIP_MEMORY_SCOPE_AGENT); }
__device__ __forceinline__ unsigned xb_xcc_id() { return (unsigned)__builtin_amdgcn_s_getreg((3 << 11) | 20) & 0xFu; }
#define XB_SPIN(cond, bar) do { unsigned _sp = 0; while (cond) { __builtin_amdgcn_s_sleep(1); \
    if ((++_sp & 255u) == 0u) { if (xb_ld(&(bar)[XB_TMO])) break; if (_sp > XB_SPIN_CAP) { atomicAdd(&(bar)[XB_TMO], 1u); break; } } } } while (0)

struct XcdBarrier {
    unsigned* bar; unsigned x;
    volatile LAS unsigned* st;
};

__device__ __forceinline__ XcdBarrier xcd_barrier_post(unsigned* bar, volatile LAS unsigned* st) {
    XcdBarrier b; b.bar = bar; b.x = xb_xcc_id(); b.st = st;
    if (threadIdx.x == 0) (void)xb_add(&bar[XB_XCNT(b.x)], 1u);
    return b;
}
__device__ __forceinline__ void xcd_barrier_complete(unsigned* bar, unsigned x, unsigned& nloc, unsigned& nx) {
    const unsigned G = gridDim.x * gridDim.y * gridDim.z;
    unsigned sum, cnt, mine, sp = 0u;
    for (;;) {
        sum = 0u; cnt = 0u; mine = 0u;
#pragma unroll
        for (unsigned j = 0; j < 16; ++j) { const unsigned c = xb_ld(&bar[XB_XCNT(j)]); sum += c; cnt += (c > 0u) ? 1u : 0u; mine = (j == x) ? c : mine; }
        if (sum == G) break;
        __builtin_amdgcn_s_sleep(1);
        if ((++sp & 255u) == 0u) { if (xb_ld(&bar[XB_TMO])) break; if (sp > XB_SPIN_CAP) { atomicAdd(&bar[XB_TMO], 1u); break; } }
    }
    nloc = mine > 0u ? mine : 1u; nx = cnt > 0u ? cnt : 1u;
}

__device__ __forceinline__ void xcd_barrier(const XcdBarrier& b) {
    asm volatile("s_waitcnt vmcnt(0)" ::: "memory");
    __syncthreads();
    if (threadIdx.x == 0) {
        unsigned* bar = b.bar;
        __builtin_amdgcn_s_waitcnt(0);
        unsigned nloc = b.st[0], nx = b.st[1];
        if (nloc == 0u) { xcd_barrier_complete(bar, b.x, nloc, nx); b.st[0] = nloc; b.st[1] = nx; }
        const unsigned old = xb_add(&bar[XB_XSUB(b.x)], 1u);
        const unsigned gen = old / nloc;
        if (old + 1u == (gen + 1u) * nloc) {
            __builtin_amdgcn_fence(__ATOMIC_RELEASE, "agent");
            asm volatile("s_waitcnt vmcnt(0)" ::: "memory");
            const unsigned og = xb_add(&bar[XB_TOP], 1u);
            const unsigned tg = og / nx;
            if (og + 1u == (tg + 1u) * nx) xb_add(&bar[XB_TOPGEN], 1u);
            else XB_SPIN(xb_ld(&bar[XB_TOPGEN]) == tg, bar);
            __builtin_amdgcn_fence(__ATOMIC_ACQUIRE, "agent");
            xb_add(&bar[XB_XGEN(b.x)], 1u);
            asm volatile("s_waitcnt vmcnt(0)" ::: "memory");
        } else {
            XB_SPIN(xb_ld(&bar[XB_XGEN(b.x)]) == gen, bar);
            __builtin_amdgcn_fence(__ATOMIC_ACQUIRE, "agent");
            asm volatile("s_waitcnt vmcnt(0)" ::: "memory");
        }
    }
    __syncthreads();
}


__device__ __forceinline__ void gbar(unsigned* ctr, unsigned target) {
  asm volatile("s_waitcnt vmcnt(0)" ::: "memory");
  __syncthreads();
  if (tid_l() == 0) {
    __builtin_amdgcn_fence(__ATOMIC_RELEASE, "agent");
    asm volatile("s_waitcnt vmcnt(0)" ::: "memory");
    __hip_atomic_fetch_add(ctr, 1u, __ATOMIC_RELAXED, __HIP_MEMORY_SCOPE_AGENT);
    while (__hip_atomic_load(ctr, __ATOMIC_RELAXED, __HIP_MEMORY_SCOPE_AGENT) < target) __builtin_amdgcn_s_sleep(2);
    __builtin_amdgcn_fence(__ATOMIC_ACQUIRE, "agent");
    asm volatile("s_waitcnt vmcnt(0)" ::: "memory");
  }
  __syncthreads();
}
#define MFMA4(a, b, c) __builtin_amdgcn_mfma_f32_16x16x4f32((a), (b), (c), 0, 0, 0)

__device__ __forceinline__ float softplusf_(float x) { return fmaxf(x, 0.f) + log1pf(__expf(-fabsf(x))); }

__device__ __forceinline__ void gdn_chain(const Params& p, int l, int seq, int h, int d, int vs, float* sm) {
  float* sMM = sm;
  float* sK = sMM + 64 * 68;
  u16* sQb = (u16*)(sK + 64 * 65);
  u16* sKb = sQb + 64 * 80;
  float* sV = (float*)(sKb + 64 * 80);
  float* sS = sV + 64 * 33;
  float* sGc = sS + 64 * 33;
  float* sBeta = sGc + 64;
  float* sBg = sBeta + 64;
  const int tid = tid_l(), lane = tid & 63, w = tid >> 6, r16 = lane & 15, g4 = lane >> 4;
  const bool latent = seq >= 16;
  const int len = latent ? 4096 : 256;
  const int t0 = latent ? T_CTX + (seq - 16) * 4096 : seq * 256;
  const int nchunks = len >> 6;
  const float Acoef = -__expf(p.gdn_a_log[l * 8 + d * 4 + h]);
  const float dtb = p.gdn_dt_bias[l * 8 + d * 4 + h];
  f32x4 Sreg[2];
  __syncthreads();
  {
    const float* s0 = latent ? p.state_gdn + ((((size_t)(seq - 16) * 2 + l) * 2 + d) * 4 + h) * 4096 : nullptr;
#pragma unroll
    for (int n = 0; n < 2; ++n)
#pragma unroll
      for (int r = 0; r < 4; ++r) {
        const int kidx = 16 * w + g4 * 4 + r, cc = n * 16 + r16;
        float v = latent ? s0[kidx * 64 + vs * 32 + cc] : 0.f;
        Sreg[n][r] = v;
        sS[kidx * 33 + cc] = v;
      }
  }
  const u16* Pb = p.P + (size_t)t0 * PW;
  const u16* VHb = p.HQ + (size_t)T_ALL * 768 + (size_t)t0 * 256;
#define GDN_SRC(i, tl, tlo_) ({ const int e_ = (tl) + (i) * 256; const int u_ = e_ / 20, un_ = e_ % 20; \
    (un_ < 16) ? (Pb + (size_t)((tlo_) + u_) * PW + (un_ < 8 ? P_QH + h * 64 + un_ * 8 : P_KH + h * 64 + (un_ - 8) * 8)) \
               : (VHb + (size_t)((tlo_) + u_) * 256 + h * 64 + vs * 32 + (un_ - 16) * 8); })
  uint4 pf[5];
  float pga = 0.f, pgb = 0.f;
  {
    const int tlo = d == 0 ? 0 : len - 64;
#pragma unroll
    for (int i = 0; i < 5; ++i) pf[i] = *(const uint4*)GDN_SRC(i, tid, tlo);
    if (tid < 64) {
      const int u = d == 0 ? tid : 63 - tid;
      const float* gab = p.GAB + (size_t)(t0 + tlo + u) * 16;
      pga = gab[d * 4 + h]; pgb = gab[8 + d * 4 + h];
    }
  }
  for (int n = 0; n < nchunks; ++n) {
    const int tlo = d == 0 ? n * 64 : len - 64 * (n + 1);
    const int tl2 = tid_l();
#pragma unroll
    for (int i = 0; i < 5; ++i) {
      const int e = tl2 + i * 256;
      const int u = e / 20, un = e % 20;
      const int pp = d == 0 ? u : 63 - u;
      if (un < 8) { *(uint4*)(sQb + pp * 80 + un * 8) = pf[i]; }
      else {
        if (un < 16) *(uint4*)(sKb + pp * 80 + (un - 8) * 8) = pf[i];
        float* dq = un < 16 ? sK + pp * 65 + (un - 8) * 8 : sV + pp * 33 + (un - 16) * 8;
        const unsigned wv[4] = {pf[i].x, pf[i].y, pf[i].z, pf[i].w};
#pragma unroll
        for (int j = 0; j < 4; ++j) { dq[2 * j] = bf2f((u16)(wv[j] & 0xffff)); dq[2 * j + 1] = bf2f((u16)(wv[j] >> 16)); }
      }
    }
    if (tid < 64) {
      const int pp = tid;
      float g = Acoef * softplusf_(pga + dtb);
      float bt = sigmoidf_(pgb);
#pragma unroll
      for (int o = 1; o < 64; o <<= 1) { float tt = __shfl_up(g, o); if (lane >= o) g += tt; }
      sGc[pp] = g; sBeta[pp] = bt; sBg[pp] = bt * __expf(g);
    }
    if (n + 1 < nchunks) {
      const int tlo2 = d == 0 ? (n + 1) * 64 : len - 64 * (n + 2);
#pragma unroll
      for (int i = 0; i < 5; ++i) pf[i] = *(const uint4*)GDN_SRC(i, tl2, tlo2);
      if (tid < 64) {
        const int u = d == 0 ? tid : 63 - tid;
        const float* gab = p.GAB + (size_t)(t0 + tlo2 + u) * 16;
        pga = gab[d * 4 + h]; pgb = gab[8 + d * 4 + h];
      }
    }
    __syncthreads();
    float qa[16];
#pragma unroll
    for (int s = 0; s < 16; ++s) qa[s] = bf2f(sQb[(16 * w + r16) * 80 + 4 * s + g4]);
    const unsigned tcode = w == 0 ? 0x730u : (w == 1 ? 0xA51u : (w == 2 ? 0x062u : 0x0FBu));
    const int tcnt = w < 2 ? 3 : 2;
    f32x4 attacc[3];
#pragma unroll
    for (int t = 0; t < 3; ++t) {
      attacc[t] = f32x4{0.f, 0.f, 0.f, 0.f};
      if (t < tcnt) {
        const int ti = (tcode >> (4 * t)) & 3, tn = (tcode >> (4 * t + 2)) & 3;
        f32x4 accm = f32x4{0.f, 0.f, 0.f, 0.f};
        const u16* akb = sKb + (16 * ti + r16) * 80 + g4 * 8;
        const u16* aqb = sQb + (16 * ti + r16) * 80 + g4 * 8;
        const u16* bkb = sKb + (16 * tn + r16) * 80 + g4 * 8;
        const bf16x8 ak0 = *(const bf16x8*)(akb), ak1 = *(const bf16x8*)(akb + 32);
        const bf16x8 aq0 = *(const bf16x8*)(aqb), aq1 = *(const bf16x8*)(aqb + 32);
        const bf16x8 bk0 = *(const bf16x8*)(bkb), bk1 = *(const bf16x8*)(bkb + 32);
        accm = __builtin_amdgcn_mfma_f32_16x16x32_bf16(ak0, bk0, accm, 0, 0, 0);
        accm = __builtin_amdgcn_mfma_f32_16x16x32_bf16(ak1, bk1, accm, 0, 0, 0);
        attacc[t] = __builtin_amdgcn_mfma_f32_16x16x32_bf16(aq0, bk0, attacc[t], 0, 0, 0);
        attacc[t] = __builtin_amdgcn_mfma_f32_16x16x32_bf16(aq1, bk1, attacc[t], 0, 0, 0);
#pragma unroll
        for (int r = 0; r < 4; ++r) {
          const int i = 16 * ti + g4 * 4 + r, j = 16 * tn + r16;
          sMM[i * 68 + j] = (i > j) ? sBeta[i] * accm[r] * __expf(sGc[i] - sGc[j]) : 0.f;
        }
      }
    }
    __syncthreads();
    if (w == 0) {
      const int bi = tid >> 4, c = tid & 15;
      float* md = sMM + (16 * bi) * 68 + 16 * bi;
      float a[16];
#pragma unroll
      for (int r = 0; r < 16; ++r) a[r] = (r == c) ? 1.f : 0.f;
#pragma unroll
      for (int r = 1; r < 16; ++r) {
#pragma unroll
        for (int q4 = 0; q4 < (r + 3) / 4; ++q4) {
          const float4 m = *(const float4*)(md + r * 68 + 4 * q4);
          if (q4 * 4 + 0 < r) a[r] -= m.x * a[q4 * 4 + 0];
          if (q4 * 4 + 1 < r) a[r] -= m.y * a[q4 * 4 + 1];
          if (q4 * 4 + 2 < r) a[r] -= m.z * a[q4 * 4 + 2];
          if (q4 * 4 + 3 < r) a[r] -= m.w * a[q4 * 4 + 3];
        }
      }
      __builtin_amdgcn_fence(__ATOMIC_SEQ_CST, "wavefront");
#pragma unroll
      for (int r = 0; r < 16; ++r) md[r * 68 + c] = a[r];
    } else {
      for (int t = w - 1; t < 8; t += 3) {
        const int ti = t >> 1, tc = t & 1;
        const float bg = sBg[16 * ti + r16];
        const float* ak = sK + (16 * ti + r16) * 65 + g4;
        const float* bs = sS + g4 * 33 + 16 * tc + r16;
        f32x4 acc = f32x4{0.f, 0.f, 0.f, 0.f};
#pragma unroll
        for (int s = 0; s < 16; ++s) acc = MFMA4(ak[4 * s] * bg, bs[4 * s * 33], acc);
#pragma unroll
        for (int r = 0; r < 4; ++r) {
          const int i = 16 * ti + g4 * 4 + r, cc = 16 * tc + r16;
          sV[i * 33 + cc] = sV[i * 33 + cc] * sBeta[i] - acc[r];
        }
      }
    }
    __syncthreads();
    for (int ib = 0; ib < 4; ++ib) {
      if (w < 2) {
        const int ct = w;
        f32x4 acc = f32x4{0.f, 0.f, 0.f, 0.f};
        const float* am = sMM + (16 * ib + r16) * 68 + g4;
        const float* bx = sV + g4 * 33 + 16 * ct + r16;
        for (int s4 = 0; s4 < ib; ++s4) {
#pragma unroll
          for (int s = 0; s < 4; ++s) acc = MFMA4(am[16 * s4 + 4 * s], bx[(16 * s4 + 4 * s) * 33], acc);
        }
        f32x4 rm;
#pragma unroll
        for (int r = 0; r < 4; ++r) rm[r] = sV[(16 * ib + g4 * 4 + r) * 33 + 16 * ct + r16] - acc[r];
        const float* dd = sMM + (16 * ib + r16) * 68 + 16 * ib + 4 * g4;
        f32x4 xn = f32x4{0.f, 0.f, 0.f, 0.f};
#pragma unroll
        for (int s = 0; s < 4; ++s) xn = MFMA4(dd[s], rm[s], xn);
#pragma unroll
        for (int r = 0; r < 4; ++r) sV[(16 * ib + g4 * 4 + r) * 33 + 16 * ct + r16] = xn[r];
        __builtin_amdgcn_fence(__ATOMIC_SEQ_CST, "wavefront");
      }
    }
    __syncthreads();
#pragma unroll
    for (int t = 0; t < 3; ++t) {
      if (t < tcnt) {
        const int ti = (tcode >> (4 * t)) & 3, tn = (tcode >> (4 * t + 2)) & 3;
#pragma unroll
        for (int r = 0; r < 4; ++r) {
          const int i = 16 * ti + g4 * 4 + r, j = 16 * tn + r16;
          sMM[i * 68 + j] = (i >= j) ? attacc[t][r] * __expf(sGc[i] - sGc[j]) : 0.f;
        }
      }
    }
    __syncthreads();
    {
      f32x4 acc[2] = {f32x4{0.f, 0.f, 0.f, 0.f}, f32x4{0.f, 0.f, 0.f, 0.f}};
      const float eg = __expf(sGc[16 * w + r16]);
#pragma unroll
      for (int s = 0; s < 16; ++s) {
        const float a = qa[s] * eg;
        acc[0] = MFMA4(sS[(4 * s + g4) * 33 + r16], a, acc[0]);
        acc[1] = MFMA4(sS[(4 * s + g4) * 33 + 16 + r16], a, acc[1]);
      }
#pragma unroll
      for (int s = 0; s < 16; ++s) {
        if (s < 4 * (w + 1)) {
          const float a = sMM[(16 * w + r16) * 68 + 4 * s + g4];
          acc[0] = MFMA4(sV[(4 * s + g4) * 33 + r16], a, acc[0]);
          acc[1] = MFMA4(sV[(4 * s + g4) * 33 + 16 + r16], a, acc[1]);
        }
      }
      {
        const int pp = 16 * w + r16;
        const int u = d == 0 ? pp : 63 - pp;
        u16* op = p.MIX + (size_t)(t0 + tlo + u) * 1024 + d * 256 + h * 64 + vs * 32 + g4 * 4;
        *(uint2*)(op) = pack4(acc[0]);
        *(uint2*)(op + 16) = pack4(acc[1]);
      }
    }
    __syncthreads();
    {
      const float g63 = sGc[63];
      const float gl = __expf(g63);
#pragma unroll
      for (int nn = 0; nn < 2; ++nn)
#pragma unroll
        for (int r = 0; r < 4; ++r) Sreg[nn][r] *= gl;
#pragma unroll
      for (int s = 0; s < 16; ++s) {
        const int srow = 4 * s + g4;
        const float a = sK[srow * 65 + 16 * w + r16] * __expf(g63 - sGc[srow]);
        Sreg[0] = MFMA4(a, sV[srow * 33 + r16], Sreg[0]);
        Sreg[1] = MFMA4(a, sV[srow * 33 + 16 + r16], Sreg[1]);
      }
    }
    __syncthreads();
#pragma unroll
    for (int nn = 0; nn < 2; ++nn)
#pragma unroll
      for (int r = 0; r < 4; ++r) sS[(16 * w + g4 * 4 + r) * 33 + nn * 16 + r16] = Sreg[nn][r];
    __syncthreads();
  }
  if (!latent) {
    float* so = p.out + OUT_SGDN + ((((size_t)seq * 2 + l) * 2 + d) * 4 + h) * 4096;
#pragma unroll
    for (int nn = 0; nn < 2; ++nn)
#pragma unroll
      for (int r = 0; r < 4; ++r) so[(16 * w + g4 * 4 + r) * 64 + vs * 32 + nn * 16 + r16] = Sreg[nn][r];
  }
}

__device__ __forceinline__ void hgrn_chain(const Params& p, int l, int seq, int h, int d, int vs, float* sm) {
  float* sBC = sm;
  float* sK = sBC + 64 * 65;
  float* sAT = sK + 64 * 65;
  float* sV = sAT + 64 * 68;
  float* sS = sV + 64 * 33;
  float* sTot = sS + 64 * 33;
  const int tid = tid_l(), lane = tid & 63, w = tid >> 6, r16 = lane & 15, g4 = lane >> 4;
  const bool latent = seq >= 16;
  const int len = latent ? 4096 : 256;
  const int t0 = latent ? T_CTX + (seq - 16) * 4096 : seq * 256;
  const int nchunks = len >> 6;
  float lbk;
  {
    const int kch = h * 64 + (tid & 63);
    lbk = (l == 0) ? 0.f : sigmoidf_(p.hgrn_lb[256 + kch] - p.hgrn_lb[kch]);
  }
  f32x4 Sreg[2];
  __syncthreads();
  {
    const float* s0 = latent ? p.state_hgrn + ((((size_t)(seq - 16) * 2 + l) * 2 + d) * 4 + h) * 4096 : nullptr;
#pragma unroll
    for (int n = 0; n < 2; ++n)
#pragma unroll
      for (int r = 0; r < 4; ++r) {
        const int kidx = 16 * w + g4 * 4 + r, cc = n * 16 + r16;
        float v = latent ? s0[kidx * 64 + vs * 32 + cc] : 0.f;
        Sreg[n][r] = v;
        sS[kidx * 33 + cc] = v;
      }
  }
  const u16* Pb = p.P + (size_t)t0 * PW;
  float* sLb = sTot + 256;
  if (tid < 64) sLb[tid] = lbk;
  __syncthreads();
  int pgo[5];
#pragma unroll
  for (int i = 0; i < 5; ++i) {
    const int e = tid + i * 256;
    const int u = e / 20, un = e % 20;
    pgo[i] = u * PW + (un < 8 ? P_HF + d * 256 + h * 64 + un * 8 : (un < 12 ? P_HI + h * 64 + vs * 32 + (un - 8) * 8 : P_HQ + h * 64 + (un - 12) * 8));
  }
  uint4 pf[5];
  {
    const int tlo = d == 0 ? 0 : len - 64;
#pragma unroll
    for (int i = 0; i < 5; ++i) pf[i] = *(const uint4*)(Pb + (size_t)tlo * PW + pgo[i]);
  }
  for (int n = 0; n < nchunks; ++n) {
#pragma unroll
    for (int i = 0; i < 5; ++i) {
      const int e = tid + i * 256;
      const int u = e / 20, un = e % 20;
      const int pp = d == 0 ? u : 63 - u;
      const unsigned wv[4] = {pf[i].x, pf[i].y, pf[i].z, pf[i].w};
#pragma unroll
      for (int j = 0; j < 8; ++j) {
        const float x = bf2f((u16)((wv[j >> 1] >> ((j & 1) * 16)) & 0xffff));
        if (un < 8) {
          const int k = un * 8 + j;
          const float lb = sLb[k];
          const float sg_ = sigmoidf_(x);
          const float gate = lb + (1.f - lb) * sg_;
          sBC[pp * 65 + k] = __logf(fmaxf(gate, 1e-30f));
          sK[pp * 65 + k] = (1.f - lb) * (1.f - sg_);
        } else if (un < 12) {
          sV[pp * 33 + (un - 8) * 8 + j] = x;
        } else {
          sAT[pp * 68 + (un - 12) * 8 + j] = x;
        }
      }
    }
    __syncthreads();
    if (n + 1 < nchunks) {
      const int tlo2 = d == 0 ? (n + 1) * 64 : len - 64 * (n + 2);
#pragma unroll
      for (int i = 0; i < 5; ++i) pf[i] = *(const uint4*)(Pb + (size_t)tlo2 * PW + pgo[i]);
    }
    const int tlo = d == 0 ? n * 64 : len - 64 * (n + 1);
    float cs[16];
    {
      const int k = tid & 63, sg = tid >> 6;
      float run = 0.f;
#pragma unroll
      for (int i = 0; i < 16; ++i) { run += sBC[(16 * sg + i) * 65 + k]; cs[i] = run; }
      sTot[sg * 64 + k] = run;
    }
    float qa[16];
#pragma unroll
    for (int s = 0; s < 16; ++s) qa[s] = sAT[(16 * w + r16) * 68 + 4 * s + g4];
    __syncthreads();
    {
      const int k = tid & 63, sg = tid >> 6;
      float off = 0.f;
      for (int s2 = 0; s2 < sg; ++s2) off += sTot[s2 * 64 + k];
#pragma unroll
      for (int i = 0; i < 16; ++i) sBC[(16 * sg + i) * 65 + k] = cs[i] + off;
    }
    __syncthreads();
    {
      float aq[16], rf[16];
#pragma unroll
      for (int s = 0; s < 16; ++s) {
        const int kk = 4 * s + g4;
        rf[s] = (w == 0) ? 0.f : sBC[(16 * w - 1) * 65 + kk];
        aq[s] = qa[s] * __expf(sBC[(16 * w + r16) * 65 + kk] - rf[s]);
      }
#pragma unroll
      for (int nn = 0; nn < 4; ++nn) {
        f32x4 acc = f32x4{0.f, 0.f, 0.f, 0.f};
        if (nn <= w) {
#pragma unroll
          for (int s = 0; s < 16; ++s) {
            const int kk = 4 * s + g4, sc = 16 * nn + r16;
            const float bv = sK[sc * 65 + kk] * __expf(fminf(rf[s] - sBC[sc * 65 + kk], 80.f));
            acc = MFMA4(aq[s], bv, acc);
          }
        }
#pragma unroll
        for (int r = 0; r < 4; ++r) {
          const int i = 16 * w + g4 * 4 + r, j = 16 * nn + r16;
          sAT[i * 68 + j] = (i >= j) ? acc[r] : 0.f;
        }
      }
    }
    __syncthreads();
    {
      f32x4 acc[2] = {f32x4{0.f, 0.f, 0.f, 0.f}, f32x4{0.f, 0.f, 0.f, 0.f}};
#pragma unroll
      for (int s = 0; s < 16; ++s) {
        const int kk = 4 * s + g4;
        const float a = qa[s] * __expf(sBC[(16 * w + r16) * 65 + kk]);
        acc[0] = MFMA4(sS[kk * 33 + r16], a, acc[0]);
        acc[1] = MFMA4(sS[kk * 33 + 16 + r16], a, acc[1]);
      }
#pragma unroll
      for (int s = 0; s < 16; ++s) {
        if (s < 4 * (w + 1)) {
          const float a = sAT[(16 * w + r16) * 68 + 4 * s + g4];
          acc[0] = MFMA4(sV[(4 * s + g4) * 33 + r16], a, acc[0]);
          acc[1] = MFMA4(sV[(4 * s + g4) * 33 + 16 + r16], a, acc[1]);
        }
      }
      {
        const int pp = 16 * w + r16;
        const int u = d == 0 ? pp : 63 - pp;
        u16* op = p.MIX + (size_t)(t0 + tlo + u) * 1024 + 512 + d * 256 + h * 64 + vs * 32 + g4 * 4;
        *(uint2*)(op) = pack4(acc[0]);
        *(uint2*)(op + 16) = pack4(acc[1]);
      }
    }
    __syncthreads();
    {
#pragma unroll
      for (int nn = 0; nn < 2; ++nn)
#pragma unroll
        for (int r = 0; r < 4; ++r) Sreg[nn][r] *= __expf(sBC[63 * 65 + 16 * w + g4 * 4 + r]);
      const int kA = 16 * w + r16;
      const float blA = sBC[63 * 65 + kA];
#pragma unroll
      for (int s = 0; s < 16; ++s) {
        const int srow = 4 * s + g4;
        const float a = sK[srow * 65 + kA] * __expf(blA - sBC[srow * 65 + kA]);
        Sreg[0] = MFMA4(a, sV[srow * 33 + r16], Sreg[0]);
        Sreg[1] = MFMA4(a, sV[srow * 33 + 16 + r16], Sreg[1]);
      }
    }
    __syncthreads();
#pragma unroll
    for (int nn = 0; nn < 2; ++nn)
#pragma unroll
      for (int r = 0; r < 4; ++r) sS[(16 * w + g4 * 4 + r) * 33 + nn * 16 + r16] = Sreg[nn][r];
    __syncthreads();
  }
  if (!latent) {
    float* so = p.out + OUT_SHG + ((((size_t)seq * 2 + l) * 2 + d) * 4 + h) * 4096;
#pragma unroll
    for (int nn = 0; nn < 2; ++nn)
#pragma unroll
      for (int r = 0; r < 4; ++r) so[(16 * w + g4 * 4 + r) * 64 + vs * 32 + nn * 16 + r16] = Sreg[nn][r];
  }
}

__device__ __forceinline__ void phase_c(const Params& p, int l, unsigned char* smraw, int mode = 0) {
  __shared__ int s_item;
  const int total = 1920;
  const bool paired = (gridDim.x == 512);
  const int jx = blockIdx.x >> 3;
  int my_static = -1;
  if (paired && (jx & 31) < 16) my_static = (blockIdx.x & 7) * 32 + (jx & 15) * 2 + (jx >> 5);
  for (;;) {
    __syncthreads();
    if (tid_l() == 0) {
      if (my_static >= 0) s_item = my_static;
      else s_item = (paired ? 256 : 0) + (int)atomicAdd(&p.counters[l * 64 + mode * 16], 1u);
    }
    __syncthreads();
    my_static = -1;
    const int item = s_item;
    if (item >= total) break;
    int kind, a0, a1, a2, a3;
    if (item < 256 || (item >= 1280 && item < 1792)) {
      const int i2 = item < 256 ? item : item - 1280;
      const int rest = i2 >> 1;
      kind = i2 & 1;
      a3 = rest & 1; a2 = (rest >> 1) & 1; a1 = (rest >> 2) & 3; a0 = (rest >> 4) + (item < 256 ? 16 : 0);
    } else if (item < 1280) {
      const int i2 = item - 256;
      kind = 2; a0 = 1; a1 = i2 >> 7; a2 = (i2 >> 5) & 3; a3 = i2 & 31;
    } else {
      const int i2 = item - 1792;
      kind = 2; a0 = 0; a1 = i2 >> 3; a2 = (i2 >> 1) & 3; a3 = i2 & 1;
    }
    if (mode == 1 && kind == 2) continue;
    if (mode == 2 && kind != 2) continue;
    if (kind != 2) __builtin_amdgcn_s_setprio(3);
    if (kind == 0) gdn_chain(p, l, a0, a1, a2, a3, (float*)smraw);
    else if (kind == 1) hgrn_chain(p, l, a0, a1, a2, a3, (float*)smraw);
    if (kind != 2) __builtin_amdgcn_s_setprio(0);
    else attn_item(p, a0, a1, a2, a3, smraw, mode == 2);
  }
}

__global__ void __launch_bounds__(NTHR, 2) mega(Params p) {
  __shared__ __attribute__((aligned(16))) unsigned char smem[LDS_BYTES];
  cg::grid_group grid = cg::this_grid();
  __shared__ uint4 xb_words;
  if (threadIdx.x == 0) xb_words = make_uint4(0u, 0u, 0u, 0u);
  __syncthreads();
  {
    XcdBarrier xb0 = xcd_barrier_post(p.xbar, (volatile LAS unsigned*)&xb_words);
    if (threadIdx.x == 0) ((volatile LAS unsigned*)&xb_words)[2] = xb0.x;
  }
#define GSYNC() do { XcdBarrier xb_; xb_.bar = p.xbar; xb_.st = (volatile LAS unsigned*)&xb_words; xb_.x = 0; \
    if (threadIdx.x == 0) xb_.x = ((volatile LAS unsigned*)&xb_words)[2]; xcd_barrier(xb_); } while (0)
  phase0(p, (float*)smem);
  if (p.out == nullptr) grid.sync();
  GSYNC();
  rowpass_norm(p, 0, 0);
  GSYNC();
  for (int l = 0; l < 2; ++l) {
    phase_a(p, l, (u16*)smem);
    GSYNC();
    rowpass_b0(p, l);
    GSYNC();
    phase_b1(p, l, (u16*)smem);
    GSYNC();
    rowpass_b2(p, l);
    GSYNC();
    phase_c(p, l, smem);
    GSYNC();
    rowpass_c2(p, l);
    GSYNC();
    phase_gemm_y(p.MIX, 1024, p.WoutT + (size_t)l * 1024 * 1024, 1024, 1024, p.HQ, 1024, (u16*)smem);
    GSYNC();
    rowpass_norm(p, l, 1);
    GSYNC();
    phase_e(p, l, (u16*)smem);
    GSYNC();
    phase_gemm_y(p.P, DFF, p.WfoT + (size_t)l * 1024 * DFF, DFF, 1024, p.HQ, 1024, (u16*)smem);
    GSYNC();
    rowpass_norm(p, l, 2);
    if (l == 0) GSYNC();
  }
}

extern "C" void kernel_launch(void* const* d_in, const int* in_sizes, int n_in, void* d_out, int out_size, void* d_ws,
                              size_t ws_size, hipStream_t stream) {
  static int grid_blocks = 0;
  if (!grid_blocks) {
    int dev = 0, cus = 0, per_cu = 0;
    hipGetDevice(&dev);
    hipDeviceGetAttribute(&cus, hipDeviceAttributeMultiprocessorCount, dev);
    hipOccupancyMaxActiveBlocksPerMultiprocessor(&per_cu, mega, NTHR, 0);
    if (per_cu > 2) per_cu = 2;
    if (per_cu < 1) per_cu = 1;
    grid_blocks = cus * per_cu;
  }
  Params p{};
  const float* const* in = (const float* const*)d_in;
  p.x_prompt = in[0]; p.x_sample = in[1]; p.cache_ckv = in[2]; p.cache_kr = in[3]; p.state_gdn = in[4]; p.state_hgrn = in[5];
  p.c = in[6]; p.c_ctx = in[7]; p.w_ada = in[8]; p.b_ada = in[9]; p.g_pre_mix = in[10]; p.g_post_mix = in[11];
  p.g_pre_ffn = in[12]; p.g_post_ffn = in[13]; p.w_in = in[14]; p.w_out = in[15]; p.gdn_conv_w = in[16];
  p.gdn_a_log = in[17]; p.gdn_dt_bias = in[18]; p.gdn_norm_w = in[19]; p.hgrn_lb = in[20]; p.hgrn_norm_w = in[21];
  p.mla_q_norm_w = in[22]; p.mla_w_uq = in[23]; p.mla_kv_norm_w = in[24]; p.mla_w_ukv = in[25]; p.w_ffn_in = in[26];
  p.w_ffn_out = in[27];
  p.out = (float*)d_out;
  unsigned char* ws = (unsigned char*)d_ws;
  size_t off = 0;
  auto take = [&](size_t bytes) { unsigned char* r = ws + off; off += (bytes + 255) & ~(size_t)255; return r; };
  p.counters = (unsigned*)take(1024);
  p.xbar = (unsigned*)take(16384);
  p.WinT = (u16*)take((size_t)2 * 3072 * 1024 * 2);
  p.WuqT = (u16*)take((size_t)2 * 768 * 384 * 2);
  p.WukvT = (u16*)take((size_t)2 * 1024 * 256 * 2);
  p.WoutT = (u16*)take((size_t)2 * 1024 * 1024 * 2);
  p.WfiT = (u16*)take((size_t)2 * 5632 * 1024 * 2);
  p.WfoT = (u16*)take((size_t)2 * 1024 * 2816 * 2);
  p.mod = (float*)take((size_t)2 * 9 * 6144 * 4);
  p.HQ = (u16*)take((size_t)T_ALL * 1024 * 2);
  p.P = (u16*)take((size_t)T_ALL * PW * 2);
  p.KN = (u16*)take((size_t)(T_ALL + 2048) * 512 * 2);
  p.VTL = (u16*)take((size_t)8 * 4 * 128 * 4352 * 2);
  p.VTC = (u16*)take((size_t)16 * 4 * 128 * 256 * 2);
  p.CKVC = (u16*)take((size_t)2048 * 256 * 2);
  p.KRC = (u16*)take((size_t)2048 * 64 * 2);
  p.GAB = (float*)take((size_t)T_ALL * 16 * 4);
  p.MIX = (u16*)take((size_t)T_ALL * 1024 * 2);
  if (off > ws_size) { fprintf(stderr, "workspace too small: need %zu have %zu\n", off, ws_size); return; }
  hipMemsetAsync(p.counters, 0, 1024 + 16384, stream);
  void* args[] = {&p};
  hipError_t e = hipLaunchCooperativeKernel((void*)mega, dim3(grid_blocks), dim3(NTHR), args, 0, stream);
  if (e != hipSuccess) fprintf(stderr, "cooperative launch failed: %s (grid %d)\n", hipGetErrorString(e), grid_blocks);
}
```

```cpp
#include <hip/hip_runtime.h>
#include <hip/hip_cooperative_groups.h>
#include <cstdio>
namespace cg = cooperative_groups;

typedef unsigned short u16;
using bf16x8 = __attribute__((ext_vector_type(8))) short;
using f32x4  = __attribute__((ext_vector_type(4))) float;

#define T_CTX 4096
#define T_ALL 36864
#define PW 3072
#define DFF 2816
#define LDS_BYTES 77824
#define NTHR 256

#define P_GQKV 0
#define P_GZ 768
#define P_HQ 1024
#define P_HI 1280
#define P_HF 1536
#define P_HG 2048
#define P_MCQ 2304
#define P_MCKV 2688
#define P_MKR 2944
#define P_GA 3008

struct Params {
  const float *x_prompt, *x_sample, *cache_ckv, *cache_kr, *state_gdn, *state_hgrn, *c, *c_ctx;
  const float *w_ada, *b_ada, *g_pre_mix, *g_post_mix, *g_pre_ffn, *g_post_ffn, *w_in, *w_out;
  const float *gdn_conv_w, *gdn_a_log, *gdn_dt_bias, *gdn_norm_w, *hgrn_lb, *hgrn_norm_w;
  const float *mla_q_norm_w, *mla_w_uq, *mla_kv_norm_w, *mla_w_ukv, *w_ffn_in, *w_ffn_out;
  float* out;
  u16 *WinT, *WuqT, *WukvT, *WoutT, *WfiT, *WfoT;
  float* mod;
  u16 *HQ, *P, *KN, *VTL, *VTC, *CKVC, *KRC, *MIX;
  float* GAB;
  unsigned* counters;
  unsigned* xbar;
};

#define OUT_CKV   37748736
#define OUT_KR    39845888
#define OUT_SGDN  40370176
#define OUT_SHG   41418752

__device__ __forceinline__ u16 f2bf(float f) {
  unsigned u = __float_as_uint(f);
  u += 0x7fffu + ((u >> 16) & 1u);
  return (u16)(u >> 16);
}
__device__ __forceinline__ float bf2f(u16 h) { return __uint_as_float(((unsigned)h) << 16); }
__device__ __forceinline__ float wave_sum(float v) {
#pragma unroll
  for (int o = 32; o > 0; o >>= 1) v += __shfl_xor(v, o);
  return v;
}
__device__ __forceinline__ float sigmoidf_(float x) { return __builtin_amdgcn_rcpf(1.f + __expf(-x)); }
__device__ __forceinline__ float siluf_(float x) { return x * __builtin_amdgcn_rcpf(1.f + __expf(-x)); }
__device__ __forceinline__ int tid_l() { int t = threadIdx.x; asm volatile("" : "+v"(t)); return t; }
__device__ __forceinline__ int tok_mod(int t) { return t < T_CTX ? 0 : 1 + ((t - T_CTX) >> 12); }

__device__ __forceinline__ int map_col(int kind, int j) {
  if (kind == 0) return j;
  if (kind == 1) { if (j < 1024) return j; if (j < 3008) return j + 16; if (j < 3024) return 1024 + (j - 3008); return -1; }
  int blk = j >> 6, w = j & 63;
  return w < 32 ? blk * 32 + w : DFF + blk * 32 + (w - 32);
}

__device__ __forceinline__ void cvt_tile(const float* __restrict__ src, int K, int Nsrc, u16* __restrict__ dst, int kind, int jt, int kt, float* sm) {
  const int tid = tid_l();
  const int j0 = jt * 64, k0 = kt * 64;
  __syncthreads();
  {
    int jj = tid & 63, kk0 = tid >> 6;
    int sc = map_col(kind, j0 + jj);
    for (int kk = kk0; kk < 64; kk += 4)
      sm[kk * 65 + jj] = sc >= 0 ? src[(size_t)(k0 + kk) * Nsrc + sc] : 0.f;
  }
  __syncthreads();
  {
    const int kq = tid & 15, jj0 = tid >> 4;
#pragma unroll
    for (int jj = jj0; jj < 64; jj += 16) {
      uint2 o;
      o.x = (unsigned)f2bf(sm[(4 * kq + 0) * 65 + jj]) | ((unsigned)f2bf(sm[(4 * kq + 1) * 65 + jj]) << 16);
      o.y = (unsigned)f2bf(sm[(4 * kq + 2) * 65 + jj]) | ((unsigned)f2bf(sm[(4 * kq + 3) * 65 + jj]) << 16);
      *(uint2*)(dst + (size_t)(j0 + jj) * K + k0 + 4 * kq) = o;
    }
  }
}

__device__ __forceinline__ void mod_item(const Params& p, int item, float* sm) {
  const int l = item / 96, j0 = (item % 96) * 64;
  const int tid = tid_l();
  float* sC = sm;
  float* sR = sm + 9 * 1024;
  __syncthreads();
  for (int i = tid; i < 9 * 1024; i += NTHR) {
    int m = i >> 10, k = i & 1023;
    float v = m == 0 ? p.c_ctx[k] : p.c[(m - 1) * 1024 + k];
    sC[i] = siluf_(v);
  }
  __syncthreads();
  const int col = tid & 63, ks = tid >> 6;
  float acc[9];
#pragma unroll
  for (int m = 0; m < 9; ++m) acc[m] = 0.f;
  const float* wp = p.w_ada + (size_t)l * 1024 * 6144 + j0 + col;
  for (int k = ks * 256; k < ks * 256 + 256; k += 8) {
    float wv[8];
#pragma unroll
    for (int u = 0; u < 8; ++u) wv[u] = wp[(size_t)(k + u) * 6144];
#pragma unroll
    for (int u = 0; u < 8; ++u)
#pragma unroll
      for (int m = 0; m < 9; ++m) acc[m] += sC[m * 1024 + k + u] * wv[u];
  }
#pragma unroll
  for (int m = 0; m < 9; ++m) sR[(ks * 9 + m) * 64 + col] = acc[m];
  __syncthreads();
  for (int i = tid; i < 9 * 64; i += NTHR) {
    int m = i >> 6, cc = i & 63;
    float v = sR[(0 * 9 + m) * 64 + cc] + sR[(1 * 9 + m) * 64 + cc] + sR[(2 * 9 + m) * 64 + cc] + sR[(3 * 9 + m) * 64 + cc];
    p.mod[((size_t)l * 9 + m) * 6144 + j0 + cc] = v + p.b_ada[l * 6144 + j0 + cc];
  }
}

__device__ __forceinline__ void phase0(const Params& p, float* sm) {
  const int PER_LAYER = 3272;
  const int total = 2 * PER_LAYER + 192;
  for (int item = blockIdx.x; item < total; item += gridDim.x) {
    if (item < 192) { mod_item(p, item, sm); continue; }
    int it = item - 192;
    int l = it / PER_LAYER, r = it % PER_LAYER;
    if (r < 768) { cvt_tile(p.w_in + (size_t)l * 1024 * 3024, 1024, 3024, p.WinT + (size_t)l * 3072 * 1024, 1, r / 16, r % 16, sm); continue; }
    r -= 768;
    if (r < 72) { cvt_tile(p.mla_w_uq + (size_t)l * 384 * 768, 384, 768, p.WuqT + (size_t)l * 768 * 384, 0, r / 6, r % 6, sm); continue; }
    r -= 72;
    if (r < 64) { cvt_tile(p.mla_w_ukv + (size_t)l * 256 * 1024, 256, 1024, p.WukvT + (size_t)l * 1024 * 256, 0, r / 4, r % 4, sm); continue; }
    r -= 64;
    if (r < 256) { cvt_tile(p.w_out + (size_t)l * 1024 * 1024, 1024, 1024, p.WoutT + (size_t)l * 1024 * 1024, 0, r / 16, r % 16, sm); continue; }
    r -= 256;
    if (r < 1408) { cvt_tile(p.w_ffn_in + (size_t)l * 1024 * 5632, 1024, 5632, p.WfiT + (size_t)l * 5632 * 1024, 2, r / 16, r % 16, sm); continue; }
    r -= 1408;
    cvt_tile(p.w_ffn_out + (size_t)l * 2816 * 1024, 2816, 1024, p.WfoT + (size_t)l * 1024 * 2816, 0, r / 44, r % 44, sm);
  }
}

__device__ __forceinline__ void rowpass_norm(const Params& p, int l, int stage) {
  const int tidl = tid_l();
  const int lane = tidl & 63, w = tidl >> 6;
  const int ln = stage == 0 ? 0 : (stage == 1 ? l : l + 1);
  const int sh_off = stage == 1 ? 3072 : 0;
  const float* gpre = stage == 1 ? p.g_pre_ffn + l * 1024 : p.g_pre_mix + (ln < 2 ? ln : 0) * 1024;
  u16* dst = stage == 1 ? p.MIX : p.HQ;
  for (int t = blockIdx.x * 4 + w; t < T_ALL; t += gridDim.x * 4) {
    const int m = tok_mod(t);
    float x[16];
    float* xo = p.out + (size_t)t * 1024;
    if (stage == 0) {
      const float* xi = t < T_CTX ? p.x_prompt + (size_t)t * 1024 : p.x_sample + (size_t)(t - T_CTX) * 1024;
#pragma unroll
      for (int i = 0; i < 4; ++i) {
        float4 v = *(const float4*)(xi + i * 256 + lane * 4);
        x[i * 4 + 0] = v.x; x[i * 4 + 1] = v.y; x[i * 4 + 2] = v.z; x[i * 4 + 3] = v.w;
      }
    } else {
      const u16* yp = p.HQ + (size_t)t * 1024;
      float y[16]; float ss = 0.f;
#pragma unroll
      for (int i = 0; i < 4; ++i) {
        uint2 v = *(const uint2*)(yp + i * 256 + lane * 4);
        y[i * 4 + 0] = bf2f((u16)(v.x & 0xffff)); y[i * 4 + 1] = bf2f((u16)(v.x >> 16));
        y[i * 4 + 2] = bf2f((u16)(v.y & 0xffff)); y[i * 4 + 3] = bf2f((u16)(v.y >> 16));
      }
#pragma unroll
      for (int i = 0; i < 16; ++i) ss += y[i] * y[i];
      ss = wave_sum(ss);
      const float rstd = rsqrtf(ss * (1.f / 1024.f) + 1e-6f);
      const float* gpost = (stage == 1 ? p.g_post_mix : p.g_post_ffn) + l * 1024;
      const float* gt = p.mod + ((size_t)l * 9 + m) * 6144 + (stage == 1 ? 2048 : 5120);
#pragma unroll
      for (int i = 0; i < 4; ++i) {
        float4 xv = *(const float4*)(xo + i * 256 + lane * 4);
        float4 gp = *(const float4*)(gpost + i * 256 + lane * 4);
        float4 gg = *(const float4*)(gt + i * 256 + lane * 4);
        x[i * 4 + 0] = xv.x + gg.x * y[i * 4 + 0] * rstd * gp.x;
        x[i * 4 + 1] = xv.y + gg.y * y[i * 4 + 1] * rstd * gp.y;
        x[i * 4 + 2] = xv.z + gg.z * y[i * 4 + 2] * rstd * gp.z;
        x[i * 4 + 3] = xv.w + gg.w * y[i * 4 + 3] * rstd * gp.w;
      }
    }
    __threadfence_block();
#pragma unroll
    for (int i = 0; i < 4; ++i)
      *(float4*)(xo + i * 256 + lane * 4) = make_float4(x[i * 4 + 0], x[i * 4 + 1], x[i * 4 + 2], x[i * 4 + 3]);
    if (ln >= 2) continue;
    float ss = 0.f;
#pragma unroll
    for (int i = 0; i < 16; ++i) ss += x[i] * x[i];
    ss = wave_sum(ss);
    const float rstd = rsqrtf(ss * (1.f / 1024.f) + 1e-6f);
    const float* sh = p.mod + ((size_t)ln * 9 + m) * 6144 + sh_off;
    const float* sc = sh + 1024;
    u16* hp = dst + (size_t)t * 1024;
#pragma unroll
    for (int i = 0; i < 4; ++i) {
      float4 gp = *(const float4*)(gpre + i * 256 + lane * 4);
      float4 s1 = *(const float4*)(sh + i * 256 + lane * 4);
      float4 c1 = *(const float4*)(sc + i * 256 + lane * 4);
      float h0 = x[i * 4 + 0] * rstd * gp.x * (1.f + c1.x) + s1.x;
      float h1 = x[i * 4 + 1] * rstd * gp.y * (1.f + c1.y) + s1.y;
      float h2 = x[i * 4 + 2] * rstd * gp.z * (1.f + c1.z) + s1.z;
      float h3 = x[i * 4 + 3] * rstd * gp.w * (1.f + c1.w) + s1.w;
      uint2 o;
      o.x = (unsigned)f2bf(h0) | ((unsigned)f2bf(h1) << 16);
      o.y = (unsigned)f2bf(h2) | ((unsigned)f2bf(h3) << 16);
      *(uint2*)(hp + i * 256 + lane * 4) = o;
    }
  }
}

__device__ __forceinline__ void unpack8(const uint4 v, float (&f)[8]);
__device__ __forceinline__ uint4 pack8(const float (&f)[8]);
__device__ __forceinline__ void rowpass_b0(const Params& p, int l) {
  const int tidl = tid_l();
  const int lane = tidl & 63, w = tidl >> 6;
  for (int t = blockIdx.x * 4 + w; t < T_ALL + 2048; t += gridDim.x * 4) {
    if (t >= T_ALL) {
      const int r = t - T_ALL, b = r >> 8, s = r & 255;
      if (lane < 32) {
        const float* ck = p.cache_ckv + (((size_t)b * 2 + l) * 256 + s) * 256 + lane * 8;
        const float4 x0 = *(const float4*)ck, x1 = *(const float4*)(ck + 4);
        const float f[8] = {x0.x, x0.y, x0.z, x0.w, x1.x, x1.y, x1.z, x1.w};
        *(uint4*)(p.CKVC + (size_t)r * 256 + lane * 8) = pack8(f);
      } else if (lane < 40) {
        const float* kr = p.cache_kr + (((size_t)b * 2 + l) * 256 + s) * 64 + (lane - 32) * 8;
        const float4 x0 = *(const float4*)kr, x1 = *(const float4*)(kr + 4);
        const float f[8] = {x0.x, x0.y, x0.z, x0.w, x1.x, x1.y, x1.z, x1.w};
        *(uint4*)(p.KRC + (size_t)r * 64 + (lane - 32) * 8) = pack8(f);
      }
      continue;
    }
    u16* pr = p.P + (size_t)t * PW;
    {
      float f[8]; float ss = 0.f;
      if (lane < 48) {
        unpack8(*(const uint4*)(pr + P_MCQ + lane * 8), f);
#pragma unroll
        for (int i = 0; i < 8; ++i) ss += f[i] * f[i];
      }
      ss = wave_sum(ss);
      const float rstd = rsqrtf(ss * (1.f / 384.f) + 1e-6f);
      if (lane < 48) {
        const float* wq = p.mla_q_norm_w + l * 384 + lane * 8;
        const float4 w0 = *(const float4*)wq, w1 = *(const float4*)(wq + 4);
        f[0] *= rstd * w0.x; f[1] *= rstd * w0.y; f[2] *= rstd * w0.z; f[3] *= rstd * w0.w;
        f[4] *= rstd * w1.x; f[5] *= rstd * w1.y; f[6] *= rstd * w1.z; f[7] *= rstd * w1.w;
        *(uint4*)(pr + P_MCQ + lane * 8) = pack8(f);
      }
    }
    {
      float f[8]; float ss = 0.f;
      if (lane < 32) {
        unpack8(*(const uint4*)(pr + P_MCKV + lane * 8), f);
#pragma unroll
        for (int i = 0; i < 8; ++i) ss += f[i] * f[i];
      }
      ss = wave_sum(ss);
      const float rstd = rsqrtf(ss * (1.f / 256.f) + 1e-6f);
      if (lane < 32) {
        const float* wk = p.mla_kv_norm_w + l * 256 + lane * 8;
        const float4 w0 = *(const float4*)wk, w1 = *(const float4*)(wk + 4);
        f[0] *= rstd * w0.x; f[1] *= rstd * w0.y; f[2] *= rstd * w0.z; f[3] *= rstd * w0.w;
        f[4] *= rstd * w1.x; f[5] *= rstd * w1.y; f[6] *= rstd * w1.z; f[7] *= rstd * w1.w;
        *(uint4*)(pr + P_MCKV + lane * 8) = pack8(f);
        if (t < T_CTX) {
          const int b = t >> 8, s = t & 255;
          float* op = p.out + OUT_CKV + (((size_t)b * 2 + l) * 256 + s) * 256 + lane * 8;
          *(float4*)op = make_float4(f[0], f[1], f[2], f[3]);
          *(float4*)(op + 4) = make_float4(f[4], f[5], f[6], f[7]);
        }
      }
    }
    {
      float v = bf2f(pr[P_MKR + lane]);
      if (t < T_CTX) {
        int b = t >> 8, s = t & 255;
        p.out[OUT_KR + (((size_t)b * 2 + l) * 256 + s) * 64 + lane] = v;
      } else {
        int pos = (t - T_CTX) & 4095;
        int axis = lane >> 5, half = (lane >> 4) & 1, f = lane & 15;
        float posf = axis == 0 ? (float)(pos >> 6) : (float)(pos & 63);
        float inv = exp2f(-(float)f * (13.287712379549449f / 16.f));
        float ang = posf * inv;
        float sn, cs;
        __sincosf(ang, &sn, &cs);
        float other = __shfl_xor(v, 16);
        float o = half == 0 ? v * cs - other * sn : v * cs + other * sn;
        pr[P_MKR + lane] = f2bf(o);
      }
    }
  }
}

#define P_QH 2304
#define P_KH 2560
__device__ __forceinline__ void rowpass_b2(const Params& p, int l) {
  const int tidl = tid_l();
  const int lane = tidl & 63, w = tidl >> 6;
  float cw[8][5], cv[8][5];
#pragma unroll
  for (int e = 0; e < 8; ++e)
#pragma unroll
    for (int j = 0; j < 5; ++j) {
      cw[e][j] = p.gdn_conv_w[((size_t)l * 768 + 8 * lane + e) * 5 + j];
      cv[e][j] = p.gdn_conv_w[((size_t)l * 768 + 512 + 8 * (lane & 31) + e) * 5 + j];
    }
  u16* VH = p.HQ + (size_t)T_ALL * 768;
  for (int t = blockIdx.x * 4 + w; t < T_ALL; t += gridDim.x * 4) {
    const int len = t < T_CTX ? 256 : 4096;
    const int tau = t < T_CTX ? (t & 255) : ((t - T_CTX) & 4095);
    float y[8], yv[8];
#pragma unroll
    for (int e = 0; e < 8; ++e) { y[e] = 0.f; yv[e] = 0.f; }
#pragma unroll
    for (int j = 0; j < 5; ++j) {
      const int tt = tau + j - 2;
      if (tt >= 0 && tt < len) {
        const u16* pr = p.P + (size_t)(t + j - 2) * PW;
        float f[8];
        unpack8(*(const uint4*)(pr + 8 * lane), f);
#pragma unroll
        for (int e = 0; e < 8; ++e) y[e] += cw[e][j] * f[e];
        if (lane < 32) {
          unpack8(*(const uint4*)(pr + 512 + 8 * lane), f);
#pragma unroll
          for (int e = 0; e < 8; ++e) yv[e] += cv[e][j] * f[e];
        }
      }
    }
    float ss = 0.f;
#pragma unroll
    for (int e = 0; e < 8; ++e) { y[e] = siluf_(y[e]); yv[e] = siluf_(yv[e]); ss += y[e] * y[e]; }
    ss += __shfl_xor(ss, 1); ss += __shfl_xor(ss, 2); ss += __shfl_xor(ss, 4);
    const float rn = rsqrtf(ss + 1e-6f) * (lane < 32 ? 0.125f : 1.f);
#pragma unroll
    for (int e = 0; e < 8; ++e) y[e] *= rn;
    *(uint4*)(p.P + (size_t)t * PW + P_QH + 8 * lane) = pack8(y);
    if (lane < 32) *(uint4*)(VH + (size_t)t * 256 + 8 * lane) = pack8(yv);
  }
}

__device__ __forceinline__ void unpack8(const uint4 v, float (&f)[8]) {
  f[0] = bf2f((u16)(v.x & 0xffff)); f[1] = bf2f((u16)(v.x >> 16)); f[2] = bf2f((u16)(v.y & 0xffff)); f[3] = bf2f((u16)(v.y >> 16));
  f[4] = bf2f((u16)(v.z & 0xffff)); f[5] = bf2f((u16)(v.z >> 16)); f[6] = bf2f((u16)(v.w & 0xffff)); f[7] = bf2f((u16)(v.w >> 16));
}
__device__ __forceinline__ uint4 pack8(const float (&f)[8]) {
  uint4 o;
  o.x = (unsigned)f2bf(f[0]) | ((unsigned)f2bf(f[1]) << 16); o.y = (unsigned)f2bf(f[2]) | ((unsigned)f2bf(f[3]) << 16);
  o.z = (unsigned)f2bf(f[4]) | ((unsigned)f2bf(f[5]) << 16); o.w = (unsigned)f2bf(f[6]) | ((unsigned)f2bf(f[7]) << 16);
  return o;
}
__device__ __forceinline__ void rowpass_c2(const Params& p, int l) {
  const int tidl = tid_l();
  const int lane = tidl & 63, w = tidl >> 6;
  const int hl = lane & 31, isH = lane >> 5;
  const float* nw = (isH ? p.hgrn_norm_w : p.gdn_norm_w) + l * 64 + (hl & 7) * 8;
  const float4 w0 = *(const float4*)(nw), w1 = *(const float4*)(nw + 4);
  const float wv[8] = {w0.x, w0.y, w0.z, w0.w, w1.x, w1.y, w1.z, w1.w};
  for (int t = blockIdx.x * 4 + w; t < T_ALL; t += gridDim.x * 4) {
    u16* mr = p.MIX + (size_t)t * 1024;
    const u16* pr = p.P + (size_t)t * PW;
    const u16* qr = p.HQ + (size_t)t * 768;
    const uint4 vf = *(const uint4*)(mr + isH * 512 + hl * 8);
    const uint4 vb = *(const uint4*)(mr + isH * 512 + 256 + hl * 8);
    const uint4 vg = *(const uint4*)(pr + (isH ? P_HG : P_GZ) + hl * 8);
    const int c0 = lane * 8;
    const uint4 vo = *(const uint4*)(qr + (c0 >> 7) * 192 + (c0 & 127));
    float f[8], bb[8], g[8];
    unpack8(vf, f); unpack8(vb, bb); unpack8(vg, g);
    float ss = 0.f;
#pragma unroll
    for (int i = 0; i < 8; ++i) { f[i] += bb[i]; ss += f[i] * f[i]; }
    ss += __shfl_xor(ss, 1); ss += __shfl_xor(ss, 2); ss += __shfl_xor(ss, 4);
    const float rn = rsqrtf(ss * (1.f / 64.f) + 1e-6f);
#pragma unroll
    for (int i = 0; i < 8; ++i) f[i] = f[i] * rn * wv[i] * (isH ? sigmoidf_(g[i]) : siluf_(g[i]));
    __threadfence_block();
    *(uint4*)(mr + isH * 256 + hl * 8) = pack8(f);
    *(uint4*)(mr + 512 + c0) = vo;
  }
}

__device__ __forceinline__ void gemm128(const u16* __restrict__ A, int lda, const u16* __restrict__ B, int ldb, int K,
                                        u16* lds, f32x4 (&acc)[4][4]) {
  const int tid = tid_l(), lane = tid & 63, w = tid >> 6, wm = w >> 1, wn = w & 1;
  const int r16 = lane & 15, g4 = lane >> 4;
#pragma unroll
  for (int i = 0; i < 4; ++i)
#pragma unroll
    for (int j = 0; j < 4; ++j) acc[i][j] = f32x4{0.f, 0.f, 0.f, 0.f};
  const int lrow = tid >> 3, lkc = tid & 7;
  const u16* ap = A + (size_t)lrow * lda + lkc * 8;
  const u16* bp = B + (size_t)lrow * ldb + lkc * 8;
  const size_t sa32 = (size_t)32 * lda, sb32 = (size_t)32 * ldb;
  uint4 ra0 = *(const uint4*)(ap), ra1 = *(const uint4*)(ap + sa32), ra2 = *(const uint4*)(ap + 2 * sa32), ra3 = *(const uint4*)(ap + 3 * sa32);
  uint4 rb0 = *(const uint4*)(bp), rb1 = *(const uint4*)(bp + sb32), rb2 = *(const uint4*)(bp + 2 * sb32), rb3 = *(const uint4*)(bp + 3 * sb32);
  const int woff = lrow * 64 + ((lkc ^ (lrow & 7)) * 8);
  const int sw = r16 & 7;
  const int fa0 = (wm * 64 + r16) * 64 + ((g4 ^ sw) * 8);
  const int fa1 = (wm * 64 + r16) * 64 + (((4 + g4) ^ sw) * 8);
  const int fb0 = 128 * 64 + (wn * 64 + r16) * 64 + ((g4 ^ sw) * 8);
  const int fb1 = 128 * 64 + (wn * 64 + r16) * 64 + (((4 + g4) ^ sw) * 8);
  const int nk = K >> 6;
  __syncthreads();
  {
    u16* wa = lds + woff; u16* wb = lds + 128 * 64 + woff;
    *(uint4*)(wa) = ra0; *(uint4*)(wa + 32 * 64) = ra1; *(uint4*)(wa + 64 * 64) = ra2; *(uint4*)(wa + 96 * 64) = ra3;
    *(uint4*)(wb) = rb0; *(uint4*)(wb + 32 * 64) = rb1; *(uint4*)(wb + 64 * 64) = rb2; *(uint4*)(wb + 96 * 64) = rb3;
  }
  if (nk > 1) {
    const u16* a2 = ap + 64; const u16* b2 = bp + 64;
    ra0 = *(const uint4*)(a2); ra1 = *(const uint4*)(a2 + sa32); ra2 = *(const uint4*)(a2 + 2 * sa32); ra3 = *(const uint4*)(a2 + 3 * sa32);
    rb0 = *(const uint4*)(b2); rb1 = *(const uint4*)(b2 + sb32); rb2 = *(const uint4*)(b2 + 2 * sb32); rb3 = *(const uint4*)(b2 + 3 * sb32);
  }
  __syncthreads();
  for (int kt = 0; kt < nk; ++kt) {
    const u16* cur = lds + (kt & 1) * (256 * 64);
    if (kt + 1 < nk) {
      u16* nxt = lds + ((kt + 1) & 1) * (256 * 64);
      u16* wa = nxt + woff; u16* wb = nxt + 128 * 64 + woff;
      *(uint4*)(wa) = ra0; *(uint4*)(wa + 32 * 64) = ra1; *(uint4*)(wa + 64 * 64) = ra2; *(uint4*)(wa + 96 * 64) = ra3;
      *(uint4*)(wb) = rb0; *(uint4*)(wb + 32 * 64) = rb1; *(uint4*)(wb + 64 * 64) = rb2; *(uint4*)(wb + 96 * 64) = rb3;
      if (kt + 2 < nk) {
        const u16* a2 = ap + (kt + 2) * 64; const u16* b2 = bp + (kt + 2) * 64;
        ra0 = *(const uint4*)(a2); ra1 = *(const uint4*)(a2 + sa32); ra2 = *(const uint4*)(a2 + 2 * sa32); ra3 = *(const uint4*)(a2 + 3 * sa32);
        rb0 = *(const uint4*)(b2); rb1 = *(const uint4*)(b2 + sb32); rb2 = *(const uint4*)(b2 + 2 * sb32); rb3 = *(const uint4*)(b2 + 3 * sb32);
      }
    }
    {
      const u16* pa0 = cur + fa0; const u16* pa1 = cur + fa1; const u16* pb0 = cur + fb0; const u16* pb1 = cur + fb1;
      bf16x8 a0 = *(const bf16x8*)(pa0), a1 = *(const bf16x8*)(pa0 + 16 * 64), a2 = *(const bf16x8*)(pa0 + 32 * 64), a3 = *(const bf16x8*)(pa0 + 48 * 64);
      bf16x8 b0 = *(const bf16x8*)(pb0), b1 = *(const bf16x8*)(pb0 + 16 * 64), b2 = *(const bf16x8*)(pb0 + 32 * 64), b3 = *(const bf16x8*)(pb0 + 48 * 64);
      bf16x8 c0 = *(const bf16x8*)(pa1), c1 = *(const bf16x8*)(pa1 + 16 * 64), c2 = *(const bf16x8*)(pa1 + 32 * 64), c3 = *(const bf16x8*)(pa1 + 48 * 64);
      bf16x8 d0 = *(const bf16x8*)(pb1), d1 = *(const bf16x8*)(pb1 + 16 * 64), d2 = *(const bf16x8*)(pb1 + 32 * 64), d3 = *(const bf16x8*)(pb1 + 48 * 64);
      __builtin_amdgcn_sched_barrier(0);
#define G128_MM(j, bj, x0, x1, x2, x3) do { \
        acc[0][j] = __builtin_amdgcn_mfma_f32_16x16x32_bf16(bj, x0, acc[0][j], 0, 0, 0); \
        acc[1][j] = __builtin_amdgcn_mfma_f32_16x16x32_bf16(bj, x1, acc[1][j], 0, 0, 0); \
        acc[2][j] = __builtin_amdgcn_mfma_f32_16x16x32_bf16(bj, x2, acc[2][j], 0, 0, 0); \
        acc[3][j] = __builtin_amdgcn_mfma_f32_16x16x32_bf16(bj, x3, acc[3][j], 0, 0, 0); } while (0)
      __builtin_amdgcn_s_setprio(1);
      G128_MM(0, b0, a0, a1, a2, a3); G128_MM(1, b1, a0, a1, a2, a3); G128_MM(2, b2, a0, a1, a2, a3); G128_MM(3, b3, a0, a1, a2, a3);
      G128_MM(0, d0, c0, c1, c2, c3); G128_MM(1, d1, c0, c1, c2, c3); G128_MM(2, d2, c0, c1, c2, c3); G128_MM(3, d3, c0, c1, c2, c3);
      __builtin_amdgcn_s_setprio(0);
    }
    __syncthreads();
  }
}
__device__ __forceinline__ uint2 pack4(f32x4 v) {
  uint2 o;
  o.x = (unsigned)f2bf(v[0]) | ((unsigned)f2bf(v[1]) << 16);
  o.y = (unsigned)f2bf(v[2]) | ((unsigned)f2bf(v[3]) << 16);
  return o;
}

__device__ __forceinline__ void gemm256(const u16* __restrict__ A, int lda, const u16* __restrict__ B, int ldb, int K,
                                        u16* lds, f32x4 (&acc)[8][4]) {
  const int tid = tid_l(), lane = tid & 63, w = tid >> 6, wm = w >> 1, wn = w & 1;
  const int r16 = lane & 15, g4 = lane >> 4;
#pragma unroll
  for (int i = 0; i < 8; ++i)
#pragma unroll
    for (int j = 0; j < 4; ++j) acc[i][j] = f32x4{0.f, 0.f, 0.f, 0.f};
  const int lrow = tid >> 2, lkc = tid & 3;
  const u16* ap = A + (size_t)lrow * lda + lkc * 8;
  const u16* bp = B + (size_t)lrow * ldb + lkc * 8;
  const size_t sa64 = (size_t)64 * lda, sb64 = (size_t)64 * ldb;
  const int woff = lrow * 32 + ((lkc ^ ((lrow >> 1) & 3)) * 8);
  const int fsw = (g4 ^ ((r16 >> 1) & 3)) * 8;
  const int faoff = (wm * 128 + r16) * 32 + fsw;
  const int fboff = 256 * 32 + (wn * 64 + r16) * 32 + fsw;
  const int nk = K >> 5;
  const int BUF = 384 * 32;
  uint4 xa0, xa1, xa2, xa3, xb0, xb1;
  uint4 ya0, ya1, ya2, ya3, yb0, yb1;
#define G256_LOAD(P, st) do { const u16* a2_ = ap + (st) * 32; const u16* b2_ = bp + (st) * 32; \
    P##a0 = *(const uint4*)(a2_); P##a1 = *(const uint4*)(a2_ + sa64); P##a2 = *(const uint4*)(a2_ + 2 * sa64); P##a3 = *(const uint4*)(a2_ + 3 * sa64); \
    P##b0 = *(const uint4*)(b2_); P##b1 = *(const uint4*)(b2_ + sb64); } while (0)
#define G256_STORE(P, buf) do { u16* wa_ = lds + (buf) * BUF + woff; u16* wb_ = wa_ + 256 * 32; \
    *(uint4*)(wa_) = P##a0; *(uint4*)(wa_ + 64 * 32) = P##a1; *(uint4*)(wa_ + 128 * 32) = P##a2; *(uint4*)(wa_ + 192 * 32) = P##a3; \
    *(uint4*)(wb_) = P##b0; *(uint4*)(wb_ + 64 * 32) = P##b1; } while (0)
#define G256_MM(i, af) do { \
      acc[i][0] = __builtin_amdgcn_mfma_f32_16x16x32_bf16(bf0, af, acc[i][0], 0, 0, 0); \
      acc[i][1] = __builtin_amdgcn_mfma_f32_16x16x32_bf16(bf1, af, acc[i][1], 0, 0, 0); \
      acc[i][2] = __builtin_amdgcn_mfma_f32_16x16x32_bf16(bf2, af, acc[i][2], 0, 0, 0); \
      acc[i][3] = __builtin_amdgcn_mfma_f32_16x16x32_bf16(bf3, af, acc[i][3], 0, 0, 0); } while (0)
#define G256_COMPUTE(buf) do { const u16* fa_ = lds + (buf) * BUF + faoff; const u16* fb_ = lds + (buf) * BUF + fboff; \
    bf16x8 bf0 = *(const bf16x8*)(fb_), bf1 = *(const bf16x8*)(fb_ + 16 * 32), bf2 = *(const bf16x8*)(fb_ + 32 * 32), bf3 = *(const bf16x8*)(fb_ + 48 * 32); \
    bf16x8 a0 = *(const bf16x8*)(fa_), a1 = *(const bf16x8*)(fa_ + 16 * 32), a2 = *(const bf16x8*)(fa_ + 32 * 32), a3 = *(const bf16x8*)(fa_ + 48 * 32); \
    __builtin_amdgcn_sched_barrier(0); __builtin_amdgcn_s_setprio(1); \
    G256_MM(0, a0); a0 = *(const bf16x8*)(fa_ + 64 * 32); __builtin_amdgcn_sched_barrier(0); \
    G256_MM(1, a1); a1 = *(const bf16x8*)(fa_ + 80 * 32); __builtin_amdgcn_sched_barrier(0); \
    G256_MM(2, a2); a2 = *(const bf16x8*)(fa_ + 96 * 32); __builtin_amdgcn_sched_barrier(0); \
    G256_MM(3, a3); a3 = *(const bf16x8*)(fa_ + 112 * 32); __builtin_amdgcn_sched_barrier(0); \
    G256_MM(4, a0); G256_MM(5, a1); G256_MM(6, a2); G256_MM(7, a3); __builtin_amdgcn_s_setprio(0); } while (0)
  bf16x8 bf0, bf1, bf2, bf3, a0, a1, a2, a3;
#define G3_PRELOAD(buf) do { const u16* fa_ = lds + (buf) * BUF + faoff; const u16* fb_ = lds + (buf) * BUF + fboff; \
    bf0 = *(const bf16x8*)(fb_); bf1 = *(const bf16x8*)(fb_ + 16 * 32); bf2 = *(const bf16x8*)(fb_ + 32 * 32); bf3 = *(const bf16x8*)(fb_ + 48 * 32); \
    a0 = *(const bf16x8*)(fa_); a1 = *(const bf16x8*)(fa_ + 16 * 32); a2 = *(const bf16x8*)(fa_ + 32 * 32); a3 = *(const bf16x8*)(fa_ + 48 * 32); } while (0)
#define G3_COMPUTE(buf) do { const u16* fa_ = lds + (buf) * BUF + faoff; \
    __builtin_amdgcn_sched_barrier(0); __builtin_amdgcn_s_setprio(1); \
    G256_MM(0, a0); a0 = *(const bf16x8*)(fa_ + 64 * 32); __builtin_amdgcn_sched_barrier(0); \
    G256_MM(1, a1); a1 = *(const bf16x8*)(fa_ + 80 * 32); __builtin_amdgcn_sched_barrier(0); \
    G256_MM(2, a2); a2 = *(const bf16x8*)(fa_ + 96 * 32); __builtin_amdgcn_sched_barrier(0); \
    G256_MM(3, a3); a3 = *(const bf16x8*)(fa_ + 112 * 32); __builtin_amdgcn_sched_barrier(0); \
    G256_MM(4, a0); G256_MM(5, a1); G256_MM(6, a2); G256_MM(7, a3); __builtin_amdgcn_s_setprio(0); \
    __builtin_amdgcn_sched_barrier(0); } while (0)
#define G3_STAGE(i, SET) do { \
    if (kt + (i) + 2 < nk) G256_STORE(SET, ((i) + 2) % 3); \
    if (kt + (i) + 4 < nk) G256_LOAD(SET, kt + (i) + 4); \
    if (kt + (i) < nk) G3_COMPUTE((i) % 3); \
    if (kt + (i) + 1 < nk) G3_PRELOAD(((i) + 1) % 3); \
    __syncthreads(); } while (0)
  G256_LOAD(x, 0);
  G256_LOAD(y, 1);
  __syncthreads();
  G256_STORE(x, 0);
  G256_LOAD(x, 2);
  G256_STORE(y, 1);
  G256_LOAD(y, 3);
  __syncthreads();
  G3_PRELOAD(0);
  for (int kt = 0; kt < nk; kt += 6) {
    G3_STAGE(0, x); G3_STAGE(1, y); G3_STAGE(2, x); G3_STAGE(3, y); G3_STAGE(4, x); G3_STAGE(5, y);
  }
}

__device__ __forceinline__ void gemm192(const u16* __restrict__ A, int lda, const u16* __restrict__ B, int ldb, int K,
                                        u16* lds, f32x4 (&acc)[6][4]) {
  const int tid = tid_l(), lane = tid & 63, w = tid >> 6, wm = w >> 1, wn = w & 1;
  const int r16 = lane & 15, g4 = lane >> 4;
#pragma unroll
  for (int i = 0; i < 6; ++i)
#pragma unroll
    for (int j = 0; j < 4; ++j) acc[i][j] = f32x4{0.f, 0.f, 0.f, 0.f};
  const int lrow = tid >> 2, lkc = tid & 3;
  const u16* ap = A + (size_t)lrow * lda + lkc * 8;
  const u16* bp = B + (size_t)lrow * ldb + lkc * 8;
  const size_t sa64 = (size_t)64 * lda, sb64 = (size_t)64 * ldb;
  const int woff = lrow * 32 + ((lkc ^ ((lrow >> 1) & 3)) * 8);
  const int fsw = (g4 ^ ((r16 >> 1) & 3)) * 8;
  const int faoff = (wm * 96 + r16) * 32 + fsw;
  const int fboff = 192 * 32 + (wn * 64 + r16) * 32 + fsw;
  const int nk = K >> 5;
  const int BUF = 320 * 32;
  uint4 xa0, xa1, xa2, xb0, xb1;
  uint4 ya0, ya1, ya2, yb0, yb1;
#define G192_LOAD(P, st) do { const u16* a2_ = ap + (st) * 32; const u16* b2_ = bp + (st) * 32; \
    P##a0 = *(const uint4*)(a2_); P##a1 = *(const uint4*)(a2_ + sa64); P##a2 = *(const uint4*)(a2_ + 2 * sa64); \
    P##b0 = *(const uint4*)(b2_); P##b1 = *(const uint4*)(b2_ + sb64); } while (0)
#define G192_STORE(P, buf) do { u16* wa_ = lds + (buf) * BUF + woff; u16* wb_ = wa_ + 192 * 32; \
    *(uint4*)(wa_) = P##a0; *(uint4*)(wa_ + 64 * 32) = P##a1; *(uint4*)(wa_ + 128 * 32) = P##a2; \
    *(uint4*)(wb_) = P##b0; *(uint4*)(wb_ + 64 * 32) = P##b1; } while (0)
#define G192_COMPUTE(buf) do { const u16* fa_ = lds + (buf) * BUF + faoff; const u16* fb_ = lds + (buf) * BUF + fboff; \
    bf16x8 bf0 = *(const bf16x8*)(fb_), bf1 = *(const bf16x8*)(fb_ + 16 * 32), bf2 = *(const bf16x8*)(fb_ + 32 * 32), bf3 = *(const bf16x8*)(fb_ + 48 * 32); \
    bf16x8 a0 = *(const bf16x8*)(fa_), a1 = *(const bf16x8*)(fa_ + 16 * 32), a2 = *(const bf16x8*)(fa_ + 32 * 32), a3 = *(const bf16x8*)(fa_ + 48 * 32); \
    __builtin_amdgcn_sched_barrier(0); __builtin_amdgcn_s_setprio(1); \
    G256_MM(0, a0); a0 = *(const bf16x8*)(fa_ + 64 * 32); __builtin_amdgcn_sched_barrier(0); \
    G256_MM(1, a1); a1 = *(const bf16x8*)(fa_ + 80 * 32); __builtin_amdgcn_sched_barrier(0); \
    G256_MM(2, a2); G256_MM(3, a3); G256_MM(4, a0); G256_MM(5, a1); __builtin_amdgcn_s_setprio(0); } while (0)
  G192_LOAD(x, 0);
  G192_LOAD(y, 1);
  __syncthreads();
  G192_STORE(x, 0);
  G192_LOAD(x, 2);
  __syncthreads();
  for (int kt = 0; kt < nk; kt += 2) {
    G192_STORE(y, 1);
    if (kt + 3 < nk) G192_LOAD(y, kt + 3);
    G192_COMPUTE(0);
    __syncthreads();
    if (kt + 2 < nk) {
      G192_STORE(x, 0);
      if (kt + 4 < nk) G192_LOAD(x, kt + 4);
    }
    G192_COMPUTE(1);
    __syncthreads();
  }
}
#define GEMM256_RC const int tde = tid_l(); const int rb = ((tde >> 6) >> 1) * 128 + (tde & 15), cb = ((tde >> 6) & 1) * 64 + ((tde & 63) >> 4) * 4;
#define GEMM_RC const int tde = tid_l(); const int rb = ((tde >> 6) >> 1) * 64 + (tde & 15), cb = ((tde >> 6) & 1) * 64 + ((tde & 63) >> 4) * 4;


__device__ __forceinline__ bool tile_at(int r, int Mt, int Nt, int& mt, int& nt) {
  const int x = blockIdx.x & 7, j = blockIdx.x >> 3, bpx = gridDim.x >> 3;
  const int mpx = Mt >> 3;
  const int q = r * bpx + j;
  if (q >= mpx * Nt) return false;
  const int full = (Nt >> 3) * (mpx * 8);
  int cb, rem, wcb;
  if (q < full) { cb = q / (mpx * 8); rem = q - cb * mpx * 8; wcb = 8; }
  else { cb = Nt >> 3; rem = q - full; wcb = Nt - cb * 8; }
  mt = x * mpx + rem / wcb;
  nt = cb * 8 + rem % wcb;
  return true;
}

__device__ __forceinline__ void phase_a(const Params& p, int l, u16* lds) {
  const u16* Bw = p.WinT + (size_t)l * 3072 * 1024;
  int mt, nt;
  for (int r = 0; tile_at(r, 144, 24, mt, nt); ++r) {
    const int m0 = mt * 256, n0 = nt * 128;
    f32x4 acc[8][4];
    gemm256(p.HQ + (size_t)m0 * 1024, 1024, Bw + (size_t)n0 * 1024, 1024, 1024, lds, acc);
    { GEMM256_RC
#pragma unroll
      for (int mi = 0; mi < 8; ++mi) {
        const int row = m0 + rb + mi * 16;
#pragma unroll
        for (int ni = 0; ni < 4; ++ni) {
          const int col = n0 + cb + ni * 16;
          *(uint2*)(p.P + (size_t)row * PW + col) = pack4(acc[mi][ni]);
          if (col >= P_GA && col < P_GA + 16)
            *(float4*)(p.GAB + (size_t)row * 16 + (col - P_GA)) = make_float4(acc[mi][ni][0], acc[mi][ni][1], acc[mi][ni][2], acc[mi][ni][3]);
        }
      }
    }
  }
}

__device__ __forceinline__ void phase_b1(const Params& p, int l, u16* lds) {
  int mt, nt;
  for (int pass = 0; pass < 2; ++pass) {
  for (int r = 0; tile_at(r, pass == 0 ? 288 : 304, pass == 0 ? 6 : 8, mt, nt); ++r) {
    if (pass == 0) {
      const int m0 = mt * 128, n0 = nt * 128;
      const float qscale = 0.07216878364870322f * 1.4426950408889634f;
      f32x4 acc[4][4];
      gemm128(p.P + (size_t)m0 * PW + P_MCQ, PW, p.WuqT + (size_t)l * 768 * 384 + (size_t)n0 * 384, 384, 384, lds, acc);
      { GEMM_RC
        const int g4 = (tde & 63) >> 4;
        const int cw0 = n0 + cb - g4 * 4;
        const bool ropew = ((cw0 >> 6) % 3) == 2 && m0 >= T_CTX;
#pragma unroll
        for (int mi = 0; mi < 4; ++mi) {
          const int row = m0 + rb + mi * 16;
          f32x4 v0 = acc[mi][0], v1 = acc[mi][1], v2 = acc[mi][2], v3 = acc[mi][3];
          if (ropew) {
            const int pos = (row - T_CTX) & 4095;
#pragma unroll
            for (int r = 0; r < 4; ++r) {
              const float inv = exp2f(-(float)(g4 * 4 + r) * (13.287712379549449f / 16.f));
              float s0, c0, s1, c1;
              __sincosf((float)(pos >> 6) * inv, &s0, &c0);
              __sincosf((float)(pos & 63) * inv, &s1, &c1);
              const float a0 = v0[r] * c0 - v1[r] * s0, a1 = v1[r] * c0 + v0[r] * s0;
              const float b0 = v2[r] * c1 - v3[r] * s1, b1 = v3[r] * c1 + v2[r] * s1;
              v0[r] = a0; v1[r] = a1; v2[r] = b0; v3[r] = b1;
            }
          }
          u16* qp = p.HQ + (size_t)row * 768 + n0 + cb;
          *(uint2*)(qp) = pack4(v0 * qscale); *(uint2*)(qp + 16) = pack4(v1 * qscale);
          *(uint2*)(qp + 32) = pack4(v2 * qscale); *(uint2*)(qp + 48) = pack4(v3 * qscale);
        }
      }
    } else {
      const int m0 = mt * 128, n0 = nt * 128;
      const u16* Ap; int lda;
      if (mt < 288) { Ap = p.P + (size_t)m0 * PW + P_MCKV; lda = PW; }
      else { Ap = p.CKVC + (size_t)(m0 - T_ALL) * 256; lda = 256; }
      f32x4 acc[4][4];
      gemm128(Ap, lda, p.WukvT + (size_t)l * 1024 * 256 + (size_t)n0 * 256, 256, 256, lds, acc);
      { GEMM_RC
#pragma unroll
        for (int mi = 0; mi < 4; ++mi) {
          const int row = m0 + rb + mi * 16;
          u16* vb; int vst;
          if (row < T_CTX) { int b = row >> 8, pos = row & 255; vb = p.VTC + (size_t)(b * 4) * 128 * 256 + pos; vst = 256; }
          else if (row < T_ALL) { int b = (row - T_CTX) >> 12, pos = (row - T_CTX) & 4095; vb = p.VTL + (size_t)(b * 4) * 128 * 4352 + pos; vst = 4352; }
          else { int b = (row - T_ALL) >> 8, pos = 4096 + ((row - T_ALL) & 255); vb = p.VTL + (size_t)(b * 4) * 128 * 4352 + pos; vst = 4352; }
#pragma unroll
          for (int ni = 0; ni < 4; ++ni) {
            const int col = n0 + cb + ni * 16;
            const int h = col >> 8, wi = col & 255;
            if (wi < 128) {
              *(uint2*)(p.KN + (size_t)row * 512 + h * 128 + wi) = pack4(acc[mi][ni]);
            } else {
              u16* dst = vb + (size_t)(h * 128 + (wi - 128)) * vst;
#pragma unroll
              for (int r = 0; r < 4; ++r) dst[(size_t)r * vst] = f2bf(acc[mi][ni][r]);
            }
          }
        }
      }
    }
  }
  }
}

__device__ __forceinline__ void phase_gemm_y(const u16* A, int lda, const u16* B, int K, int N, u16* Y, int ldy, u16* lds) {
  int mt, nt;
  for (int r = 0; tile_at(r, 192, N / 128, mt, nt); ++r) {
    const int m0 = mt * 192, n0 = nt * 128;
    f32x4 acc[6][4];
    gemm192(A + (size_t)m0 * lda, lda, B + (size_t)n0 * K, K, K, lds, acc);
    {
      const int tde = tid_l();
      const int rb = ((tde >> 6) >> 1) * 96 + (tde & 15), cb = ((tde >> 6) & 1) * 64 + ((tde & 63) >> 4) * 4;
#pragma unroll
      for (int mi = 0; mi < 6; ++mi)
#pragma unroll
        for (int ni = 0; ni < 4; ++ni)
          *(uint2*)(Y + (size_t)(m0 + rb + mi * 16) * ldy + n0 + cb + ni * 16) = pack4(acc[mi][ni]);
    }
  }
}

__device__ __forceinline__ void phase_e(const Params& p, int l, u16* lds) {
  const u16* Bw = p.WfiT + (size_t)l * 5632 * 1024;
  int mt, nt;
  for (int r = 0; tile_at(r, 144, 44, mt, nt); ++r) {
    const int m0 = mt * 256, n0 = nt * 128;
    f32x4 acc[8][4];
    gemm256(p.MIX + (size_t)m0 * 1024, 1024, Bw + (size_t)n0 * 1024, 1024, 1024, lds, acc);
    { GEMM256_RC
      const int g4x4 = ((tde & 63) >> 4) * 4;
      const int hc0 = ((n0 + cb - g4x4) >> 1) + g4x4;
#pragma unroll
      for (int mi = 0; mi < 8; ++mi)
#pragma unroll
        for (int ni = 0; ni < 2; ++ni) {
          f32x4 hv;
#pragma unroll
          for (int r = 0; r < 4; ++r) hv[r] = siluf_(acc[mi][ni][r]) * acc[mi][ni + 2][r];
          *(uint2*)(p.P + (size_t)(m0 + rb + mi * 16) * DFF + hc0 + ni * 16) = pack4(hv);
        }
    }
  }
}

#define KST 208
#define VST 80
#define PST 80
__device__ __forceinline__ void attn_item(const Params& p, int latent, int b, int h, int qb, unsigned char* smraw, int dummy = 0) {
  u16* sK = (u16*)smraw;
  u16* sV = sK + 64 * KST;
  u16* sP = sV + 128 * VST;
  const int tid = tid_l(), lane = tid & 63, w = tid >> 6, r16 = lane & 15, g4 = lane >> 4;
  const int nkeys = latent ? 4352 : 256;
  const int krow0 = latent ? T_CTX + b * 4096 : b * 256;
  const int tq0 = krow0 + qb * 128;
  const u16* vt = latent ? p.VTL + (size_t)((b * 4 + h) * 128) * 4352 : p.VTC + (size_t)((b * 4 + h) * 128) * 256;
  u16* sPw = sP + w * 32 * PST;
  bf16x8 q[2][6];
#pragma unroll
  for (int mi = 0; mi < 2; ++mi)
#pragma unroll
    for (int ks = 0; ks < 6; ++ks)
      q[mi][ks] = *(const bf16x8*)(p.HQ + (size_t)(tq0 + w * 32 + mi * 16 + r16) * 768 + h * 192 + ks * 32 + g4 * 8);
  f32x4 o[2][8];
  float mrow[2], lrow[2];
#pragma unroll
  for (int mi = 0; mi < 2; ++mi) {
#pragma unroll
    for (int nd = 0; nd < 8; ++nd) o[mi][nd] = f32x4{0.f, 0.f, 0.f, 0.f};
    mrow[mi] = -1e30f; lrow[mi] = 0.f;
  }
  const int lkey = tid >> 2, lpart = tid & 3;
  const int ldv = tid >> 1, lhalf = tid & 1;
  const int ntile = nkeys >> 6;
  uint4 k0, k1, k2, k3, k4, k5;
  {
    const int pos = lkey;
    const u16* srcn = p.KN + (size_t)(krow0 + pos) * 512 + h * 128 + lpart * 8;
    const u16* srcr = p.P + (size_t)(krow0 + pos) * PW + P_MKR + lpart * 8;
    k0 = *(const uint4*)(srcn); k1 = *(const uint4*)(srcn + 32); k2 = *(const uint4*)(srcn + 64); k3 = *(const uint4*)(srcn + 96);
    k4 = *(const uint4*)(srcr); k5 = *(const uint4*)(srcr + 32);
  }
  for (int kt = 0; kt < ntile; ++kt) {
    __syncthreads();
    {
      u16* dk = sK + lkey * KST + lpart * 8;
      *(uint4*)(dk) = k0; *(uint4*)(dk + 32) = k1; *(uint4*)(dk + 64) = k2; *(uint4*)(dk + 96) = k3;
      *(uint4*)(dk + 128) = k4; *(uint4*)(dk + 160) = k5;
    }
    const u16* sv = vt + (size_t)ldv * nkeys + kt * 64 + lhalf * 32;
    const uint4 v0 = *(const uint4*)(sv), v1 = *(const uint4*)(sv + 8), v2 = *(const uint4*)(sv + 16), v3 = *(const uint4*)(sv + 24);
    __syncthreads();
    f32x4 s[2][4];
#pragma unroll
    for (int mi = 0; mi < 2; ++mi)
#pragma unroll
      for (int ni = 0; ni < 4; ++ni) s[mi][ni] = f32x4{0.f, 0.f, 0.f, 0.f};
#pragma unroll
    for (int ks = 0; ks < 6; ++ks)
#pragma unroll
      for (int ni = 0; ni < 4; ++ni) {
        bf16x8 kf = *(const bf16x8*)(sK + (ni * 16 + r16) * KST + ks * 32 + g4 * 8);
        s[0][ni] = __builtin_amdgcn_mfma_f32_16x16x32_bf16(kf, q[0][ks], s[0][ni], 0, 0, 0);
        s[1][ni] = __builtin_amdgcn_mfma_f32_16x16x32_bf16(kf, q[1][ks], s[1][ni], 0, 0, 0);
      }
#pragma unroll
    for (int mi = 0; mi < 2; ++mi) {
      float mx = -1e30f;
#pragma unroll
      for (int ni = 0; ni < 4; ++ni)
#pragma unroll
        for (int r = 0; r < 4; ++r) mx = fmaxf(mx, s[mi][ni][r]);
      mx = fmaxf(mx, __shfl_xor(mx, 16)); mx = fmaxf(mx, __shfl_xor(mx, 32));
      const float mnew = fmaxf(mrow[mi], mx);
      const float alpha = __builtin_amdgcn_exp2f(mrow[mi] - mnew);
      mrow[mi] = mnew;
      float ps = 0.f;
#pragma unroll
      for (int ni = 0; ni < 4; ++ni) {
        f32x4 pv;
#pragma unroll
        for (int r = 0; r < 4; ++r) { pv[r] = __builtin_amdgcn_exp2f(s[mi][ni][r] - mnew); ps += pv[r]; }
        *(uint2*)(sPw + (mi * 16 + r16) * PST + ni * 16 + g4 * 4) = pack4(pv);
      }
      ps += __shfl_xor(ps, 16); ps += __shfl_xor(ps, 32);
      lrow[mi] = lrow[mi] * alpha + ps;
#pragma unroll
      for (int nd = 0; nd < 8; ++nd) o[mi][nd] *= alpha;
    }
    {
      u16* dvp = sV + ldv * VST + lhalf * 32;
      *(uint4*)(dvp) = v0; *(uint4*)(dvp + 8) = v1; *(uint4*)(dvp + 16) = v2; *(uint4*)(dvp + 24) = v3;
    }
    __syncthreads();
    if (kt + 1 < ntile) {
      const int pos = (kt + 1) * 64 + lkey;
      const bool own = (!latent) || pos < 4096;
      const int row = own ? krow0 + pos : T_ALL + b * 256 + (pos - 4096);
      const u16* srcn = p.KN + (size_t)row * 512 + h * 128 + lpart * 8;
      const u16* srcr = own ? p.P + (size_t)(krow0 + pos) * PW + P_MKR + lpart * 8
                            : p.KRC + (size_t)(b * 256 + pos - 4096) * 64 + lpart * 8;
      k0 = *(const uint4*)(srcn); k1 = *(const uint4*)(srcn + 32); k2 = *(const uint4*)(srcn + 64); k3 = *(const uint4*)(srcn + 96);
      k4 = *(const uint4*)(srcr); k5 = *(const uint4*)(srcr + 32);
    }
#pragma unroll
    for (int ks2 = 0; ks2 < 2; ++ks2) {
      bf16x8 pf0 = *(const bf16x8*)(sPw + (0 * 16 + r16) * PST + ks2 * 32 + g4 * 8);
      bf16x8 pf1 = *(const bf16x8*)(sPw + (1 * 16 + r16) * PST + ks2 * 32 + g4 * 8);
#pragma unroll
      for (int nd = 0; nd < 8; ++nd) {
        bf16x8 vf = *(const bf16x8*)(sV + (nd * 16 + r16) * VST + ks2 * 32 + g4 * 8);
        o[0][nd] = __builtin_amdgcn_mfma_f32_16x16x32_bf16(vf, pf0, o[0][nd], 0, 0, 0);
        o[1][nd] = __builtin_amdgcn_mfma_f32_16x16x32_bf16(vf, pf1, o[1][nd], 0, 0, 0);
      }
    }
  }
#pragma unroll
  for (int mi = 0; mi < 2; ++mi) {
    const float inv = 1.f / lrow[mi];
    const int qrow = tq0 + w * 32 + mi * 16 + r16;
    u16* op = p.HQ + (size_t)qrow * 768 + h * 192 + g4 * 4;
    if (dummy) op = p.HQ + (size_t)T_ALL * 768 + (size_t)(qrow % 9216) * 768 + h * 192 + g4 * 4;
#pragma unroll
    for (int nd = 0; nd < 8; ++nd) *(uint2*)(op + nd * 16) = pack4(o[mi][nd] * inv);
  }
}

#define XB_TMO      128
#define XB_XCNT(j)  (256  + 64 * (j))
#define XB_XSUB(j)  (1280 + 64 * (j))
#define XB_XGEN(j)  (2304 + 64 * (j))
#define XB_TOP      3328
#define XB_TOPGEN   3392
#define XCD_BAR_WORDS 3456
#define XB_SPIN_CAP (1u << 23)
#define LAS __attribute__((address_space(3)))

__device__ __forceinline__ unsigned xb_ld(unsigned* p)              { return __hip_atomic_load(p, __ATOMIC_RELAXED, __HIP_MEMORY_SCOPE_AGENT); }
__device__ __forceinline__ unsigned xb_add(unsigned* p, unsigned v) { return __hip_atomic_fetch_add(p, v, __ATOMIC_RELAXED, __HIP_MEMORY_SCOPE_AGENT); }
__device__ __forceinline__ unsigned xb_xcc_id() { return (unsigned)__builtin_amdgcn_s_getreg((3 << 11) | 20) & 0xFu; }
#define XB_SPIN(cond, bar) do { unsigned _sp = 0; while (cond) { __builtin_amdgcn_s_sleep(1); \
    if ((++_sp & 255u) == 0u) { if (xb_ld(&(bar)[XB_TMO])) break; if (_sp > XB_SPIN_CAP) { atomicAdd(&(bar)[XB_TMO], 1u); break; } } } } while (0)

struct XcdBarrier {
    unsigned* bar; unsigned x;
    volatile LAS unsigned* st;
};

__device__ __forceinline__ XcdBarrier xcd_barrier_post(unsigned* bar, volatile LAS unsigned* st) {
    XcdBarrier b; b.bar = bar; b.x = xb_xcc_id(); b.st = st;
    if (threadIdx.x == 0) (void)xb_add(&bar[XB_XCNT(b.x)], 1u);
    return b;
}
__device__ __forceinline__ void xcd_barrier_complete(unsigned* bar, unsigned x, unsigned& nloc, unsigned& nx) {
    const unsigned G = gridDim.x * gridDim.y * gridDim.z;
    unsigned sum, cnt, mine, sp = 0u;
    for (;;) {
        sum = 0u; cnt = 0u; mine = 0u;
#pragma unroll
        for (unsigned j = 0; j < 16; ++j) { const unsigned c = xb_ld(&bar[XB_XCNT(j)]); sum += c; cnt += (c > 0u) ? 1u : 0u; mine = (j == x) ? c : mine; }
        if (sum == G) break;
        __builtin_amdgcn_s_sleep(1);
        if ((++sp & 255u) == 0u) { if (xb_ld(&bar[XB_TMO])) break; if (sp > XB_SPIN_CAP) { atomicAdd(&bar[XB_TMO], 1u); break; } }
    }
    nloc = mine > 0u ? mine : 1u; nx = cnt > 0u ? cnt : 1u;
}

__device__ __forceinline__ void xcd_barrier(const XcdBarrier& b) {
    asm volatile("s_waitcnt vmcnt(0)" ::: "memory");
    __syncthreads();
    if (threadIdx.x == 0) {
        unsigned* bar = b.bar;
        __builtin_amdgcn_s_waitcnt(0);
        unsigned nloc = b.st[0], nx = b.st[1];
        if (nloc == 0u) { xcd_barrier_complete(bar, b.x, nloc, nx); b.st[0] = nloc; b.st[1] = nx; }
        const unsigned old = xb_add(&bar[XB_XSUB(b.x)], 1u);
        const unsigned gen = old / nloc;
        if (old + 1u == (gen + 1u) * nloc) {
            __builtin_amdgcn_fence(__ATOMIC_RELEASE, "agent");
            asm volatile("s_waitcnt vmcnt(0)" ::: "memory");
            const unsigned og = xb_add(&bar[XB_TOP], 1u);
            const unsigned tg = og / nx;
            if (og + 1u == (tg + 1u) * nx) xb_add(&bar[XB_TOPGEN], 1u);
            else XB_SPIN(xb_ld(&bar[XB_TOPGEN]) == tg, bar);
            __builtin_amdgcn_fence(__ATOMIC_ACQUIRE, "agent");
            xb_add(&bar[XB_XGEN(b.x)], 1u);
            asm volatile("s_waitcnt vmcnt(0)" ::: "memory");
        } else {
            XB_SPIN(xb_ld(&bar[XB_XGEN(b.x)]) == gen, bar);
            __builtin_amdgcn_fence(__ATOMIC_ACQUIRE, "agent");
            asm volatile("s_waitcnt vmcnt(0)" ::: "memory");
        }
    }
    __syncthreads();
}


__device__ __forceinline__ void gbar(unsigned* ctr, unsigned target) {
  asm volatile("s_waitcnt vmcnt(0)" ::: "memory");
  __syncthreads();
  if (tid_l() == 0) {
    __builtin_amdgcn_fence(__ATOMIC_RELEASE, "agent");
    asm volatile("s_waitcnt vmcnt(0)" ::: "memory");
    __hip_atomic_fetch_add(ctr, 1u, __ATOMIC_RELAXED, __HIP_MEMORY_SCOPE_AGENT);
    while (__hip_atomic_load(ctr, __ATOMIC_RELAXED, __HIP_MEMORY_SCOPE_AGENT) < target) __builtin_amdgcn_s_sleep(2);
    __builtin_amdgcn_fence(__ATOMIC_ACQUIRE, "agent");
    asm volatile("s_waitcnt vmcnt(0)" ::: "memory");
  }
  __syncthreads();
}
#define MFMA4(a, b, c) __builtin_amdgcn_mfma_f32_16x16x4f32((a), (b), (c), 0, 0, 0)

__device__ __forceinline__ float softplusf_(float x) { return fmaxf(x, 0.f) + log1pf(__expf(-fabsf(x))); }

__device__ __forceinline__ void gdn_chain(const Params& p, int l, int seq, int h, int d, int vs, float* sm) {
  float* sMM = sm;
  float* sK = sMM + 64 * 68;
  u16* sQb = (u16*)(sK + 64 * 65);
  u16* sKb = sQb + 64 * 80;
  float* sV = (float*)(sKb + 64 * 80);
  float* sS = sV + 64 * 33;
  float* sGc = sS + 64 * 33;
  float* sBeta = sGc + 64;
  float* sBg = sBeta + 64;
  u16* sSb = (u16*)(sBg + 64);
  const int tid = tid_l(), lane = tid & 63, w = tid >> 6, r16 = lane & 15, g4 = lane >> 4;
  const bool latent = seq >= 16;
  const int len = latent ? 4096 : 256;
  const int t0 = latent ? T_CTX + (seq - 16) * 4096 : seq * 256;
  const int nchunks = len >> 6;
  const float Acoef = -__expf(p.gdn_a_log[l * 8 + d * 4 + h]);
  const float dtb = p.gdn_dt_bias[l * 8 + d * 4 + h];
  f32x4 Sreg[2];
  __syncthreads();
  {
    const float* s0 = latent ? p.state_gdn + ((((size_t)(seq - 16) * 2 + l) * 2 + d) * 4 + h) * 4096 : nullptr;
#pragma unroll
    for (int n = 0; n < 2; ++n)
#pragma unroll
      for (int r = 0; r < 4; ++r) {
        const int kidx = 16 * w + g4 * 4 + r, cc = n * 16 + r16;
        float v = latent ? s0[kidx * 64 + vs * 32 + cc] : 0.f;
        Sreg[n][r] = v;
        sS[kidx * 33 + cc] = v;
      }
#pragma unroll
    for (int n = 0; n < 2; ++n) *(uint2*)(sSb + (n * 16 + r16) * 80 + 16 * w + g4 * 4) = pack4(Sreg[n]);
  }
  const u16* Pb = p.P + (size_t)t0 * PW;
  const u16* VHb = p.HQ + (size_t)T_ALL * 768 + (size_t)t0 * 256;
#define GDN_SRC(i, tl, tlo_) ({ const int e_ = (tl) + (i) * 256; const int u_ = e_ / 20, un_ = e_ % 20; \
    (un_ < 16) ? (Pb + (size_t)((tlo_) + u_) * PW + (un_ < 8 ? P_QH + h * 64 + un_ * 8 : P_KH + h * 64 + (un_ - 8) * 8)) \
               : (VHb + (size_t)((tlo_) + u_) * 256 + h * 64 + vs * 32 + (un_ - 16) * 8); })
  uint4 pf[5];
  float pga = 0.f, pgb = 0.f;
  {
    const int tlo = d == 0 ? 0 : len - 64;
#pragma unroll
    for (int i = 0; i < 5; ++i) pf[i] = *(const uint4*)GDN_SRC(i, tid, tlo);
    if (tid < 64) {
      const int u = d == 0 ? tid : 63 - tid;
      const float* gab = p.GAB + (size_t)(t0 + tlo + u) * 16;
      pga = gab[d * 4 + h]; pgb = gab[8 + d * 4 + h];
    }
  }
  for (int n = 0; n < nchunks; ++n) {
    const int tlo = d == 0 ? n * 64 : len - 64 * (n + 1);
    const int tl2 = tid_l();
#pragma unroll
    for (int i = 0; i < 5; ++i) {
      const int e = tl2 + i * 256;
      const int u = e / 20, un = e % 20;
      const int pp = d == 0 ? u : 63 - u;
      if (un < 8) { *(uint4*)(sQb + pp * 80 + un * 8) = pf[i]; }
      else {
        if (un < 16) *(uint4*)(sKb + pp * 80 + (un - 8) * 8) = pf[i];
        float* dq = un < 16 ? sK + pp * 65 + (un - 8) * 8 : sV + pp * 33 + (un - 16) * 8;
        const unsigned wv[4] = {pf[i].x, pf[i].y, pf[i].z, pf[i].w};
#pragma unroll
        for (int j = 0; j < 4; ++j) { dq[2 * j] = bf2f((u16)(wv[j] & 0xffff)); dq[2 * j + 1] = bf2f((u16)(wv[j] >> 16)); }
      }
    }
    if (tid < 64) {
      const int pp = tid;
      float g = Acoef * softplusf_(pga + dtb);
      float bt = sigmoidf_(pgb);
#pragma unroll
      for (int o = 1; o < 64; o <<= 1) { float tt = __shfl_up(g, o); if (lane >= o) g += tt; }
      sGc[pp] = g; sBeta[pp] = bt; sBg[pp] = bt * __expf(g);
    }
    if (n + 1 < nchunks) {
      const int tlo2 = d == 0 ? (n + 1) * 64 : len - 64 * (n + 2);
#pragma unroll
      for (int i = 0; i < 5; ++i) pf[i] = *(const uint4*)GDN_SRC(i, tl2, tlo2);
      if (tid < 64) {
        const int u = d == 0 ? tid : 63 - tid;
        const float* gab = p.GAB + (size_t)(t0 + tlo2 + u) * 16;
        pga = gab[d * 4 + h]; pgb = gab[8 + d * 4 + h];
      }
    }
    __syncthreads();
    const unsigned tcode = w == 0 ? 0x730u : (w == 1 ? 0xA51u : (w == 2 ? 0x062u : 0x0FBu));
    const int tcnt = w < 2 ? 3 : 2;
    f32x4 attacc[3];
#pragma unroll
    for (int t = 0; t < 3; ++t) {
      attacc[t] = f32x4{0.f, 0.f, 0.f, 0.f};
      if (t < tcnt) {
        const int ti = (tcode >> (4 * t)) & 3, tn = (tcode >> (4 * t + 2)) & 3;
        f32x4 accm = f32x4{0.f, 0.f, 0.f, 0.f};
        const u16* akb = sKb + (16 * ti + r16) * 80 + g4 * 8;
        const u16* aqb = sQb + (16 * ti + r16) * 80 + g4 * 8;
        const u16* bkb = sKb + (16 * tn + r16) * 80 + g4 * 8;
        const bf16x8 ak0 = *(const bf16x8*)(akb), ak1 = *(const bf16x8*)(akb + 32);
        const bf16x8 aq0 = *(const bf16x8*)(aqb), aq1 = *(const bf16x8*)(aqb + 32);
        const bf16x8 bk0 = *(const bf16x8*)(bkb), bk1 = *(const bf16x8*)(bkb + 32);
        accm = __builtin_amdgcn_mfma_f32_16x16x32_bf16(ak0, bk0, accm, 0, 0, 0);
        accm = __builtin_amdgcn_mfma_f32_16x16x32_bf16(ak1, bk1, accm, 0, 0, 0);
        attacc[t] = __builtin_amdgcn_mfma_f32_16x16x32_bf16(aq0, bk0, attacc[t], 0, 0, 0);
        attacc[t] = __builtin_amdgcn_mfma_f32_16x16x32_bf16(aq1, bk1, attacc[t], 0, 0, 0);
#pragma unroll
        for (int r = 0; r < 4; ++r) {
          const int i = 16 * ti + g4 * 4 + r, j = 16 * tn + r16;
          sMM[i * 68 + j] = (i > j) ? sBeta[i] * accm[r] * __expf(sGc[i] - sGc[j]) : 0.f;
        }
      }
    }
    __syncthreads();
    if (w == 0) {
      const int bi = tid >> 4, c = tid & 15;
      float* md = sMM + (16 * bi) * 68 + 16 * bi;
      float a[16];
#pragma unroll
      for (int r = 0; r < 16; ++r) a[r] = (r == c) ? 1.f : 0.f;
#pragma unroll
      for (int r = 1; r < 16; ++r) {
#pragma unroll
        for (int q4 = 0; q4 < (r + 3) / 4; ++q4) {
          const float4 m = *(const float4*)(md + r * 68 + 4 * q4);
          if (q4 * 4 + 0 < r) a[r] -= m.x * a[q4 * 4 + 0];
          if (q4 * 4 + 1 < r) a[r] -= m.y * a[q4 * 4 + 1];
          if (q4 * 4 + 2 < r) a[r] -= m.z * a[q4 * 4 + 2];
          if (q4 * 4 + 3 < r) a[r] -= m.w * a[q4 * 4 + 3];
        }
      }
      __builtin_amdgcn_fence(__ATOMIC_SEQ_CST, "wavefront");
#pragma unroll
      for (int r = 0; r < 16; ++r) md[r * 68 + c] = a[r];
    } else {
      for (int t = w - 1; t < 8; t += 3) {
        const int ti = t >> 1, tc = t & 1;
        const u16* akb = sKb + (16 * ti + r16) * 80 + g4 * 8;
        const u16* bsb = sSb + (16 * tc + r16) * 80 + g4 * 8;
        f32x4 acc = f32x4{0.f, 0.f, 0.f, 0.f};
        acc = __builtin_amdgcn_mfma_f32_16x16x32_bf16(*(const bf16x8*)(akb), *(const bf16x8*)(bsb), acc, 0, 0, 0);
        acc = __builtin_amdgcn_mfma_f32_16x16x32_bf16(*(const bf16x8*)(akb + 32), *(const bf16x8*)(bsb + 32), acc, 0, 0, 0);
#pragma unroll
        for (int r = 0; r < 4; ++r) {
          const int i = 16 * ti + g4 * 4 + r, cc = 16 * tc + r16;
          sV[i * 33 + cc] = sV[i * 33 + cc] * sBeta[i] - sBg[i] * acc[r];
        }
      }
    }
    __syncthreads();
    for (int ib = 0; ib < 4; ++ib) {
      if (w < 2) {
        const int ct = w;
        f32x4 acc = f32x4{0.f, 0.f, 0.f, 0.f};
        const float* am = sMM + (16 * ib + r16) * 68 + g4;
        const float* bx = sV + g4 * 33 + 16 * ct + r16;
        for (int s4 = 0; s4 < ib; ++s4) {
#pragma unroll
          for (int s = 0; s < 4; ++s) acc = MFMA4(am[16 * s4 + 4 * s], bx[(16 * s4 + 4 * s) * 33], acc);
        }
        f32x4 rm;
#pragma unroll
        for (int r = 0; r < 4; ++r) rm[r] = sV[(16 * ib + g4 * 4 + r) * 33 + 16 * ct + r16] - acc[r];
        const float* dd = sMM + (16 * ib + r16) * 68 + 16 * ib + 4 * g4;
        f32x4 xn = f32x4{0.f, 0.f, 0.f, 0.f};
#pragma unroll
        for (int s = 0; s < 4; ++s) xn = MFMA4(dd[s], rm[s], xn);
#pragma unroll
        for (int r = 0; r < 4; ++r) sV[(16 * ib + g4 * 4 + r) * 33 + 16 * ct + r16] = xn[r];
        __builtin_amdgcn_fence(__ATOMIC_SEQ_CST, "wavefront");
      }
    }
    __syncthreads();
#pragma unroll
    for (int t = 0; t < 3; ++t) {
      if (t < tcnt) {
        const int ti = (tcode >> (4 * t)) & 3, tn = (tcode >> (4 * t + 2)) & 3;
#pragma unroll
        for (int r = 0; r < 4; ++r) {
          const int i = 16 * ti + g4 * 4 + r, j = 16 * tn + r16;
          sMM[i * 68 + j] = (i >= j) ? attacc[t][r] * __expf(sGc[i] - sGc[j]) : 0.f;
        }
      }
    }
    __syncthreads();
    {
      f32x4 acc[2] = {f32x4{0.f, 0.f, 0.f, 0.f}, f32x4{0.f, 0.f, 0.f, 0.f}};
      const float eg = __expf(sGc[16 * w + r16]);
      {
        const u16* qb = sQb + (16 * w + r16) * 80 + g4 * 8;
        const bf16x8 q0 = *(const bf16x8*)(qb), q1 = *(const bf16x8*)(qb + 32);
#pragma unroll
        for (int nn = 0; nn < 2; ++nn) {
          const u16* sb = sSb + (16 * nn + r16) * 80 + g4 * 8;
          acc[nn] = __builtin_amdgcn_mfma_f32_16x16x32_bf16(*(const bf16x8*)(sb), q0, acc[nn], 0, 0, 0);
          acc[nn] = __builtin_amdgcn_mfma_f32_16x16x32_bf16(*(const bf16x8*)(sb + 32), q1, acc[nn], 0, 0, 0);
          acc[nn] *= eg;
        }
      }
#pragma unroll
      for (int s = 0; s < 16; ++s) {
        if (s < 4 * (w + 1)) {
          const float a = sMM[(16 * w + r16) * 68 + 4 * s + g4];
          acc[0] = MFMA4(sV[(4 * s + g4) * 33 + r16], a, acc[0]);
          acc[1] = MFMA4(sV[(4 * s + g4) * 33 + 16 + r16], a, acc[1]);
        }
      }
      {
        const int pp = 16 * w + r16;
        const int u = d == 0 ? pp : 63 - pp;
        u16* op = p.MIX + (size_t)(t0 + tlo + u) * 1024 + d * 256 + h * 64 + vs * 32 + g4 * 4;
        *(uint2*)(op) = pack4(acc[0]);
        *(uint2*)(op + 16) = pack4(acc[1]);
      }
    }
    __syncthreads();
    {
      const float g63 = sGc[63];
      const float gl = __expf(g63);
#pragma unroll
      for (int nn = 0; nn < 2; ++nn)
#pragma unroll
        for (int r = 0; r < 4; ++r) Sreg[nn][r] *= gl;
#pragma unroll
      for (int s = 0; s < 16; ++s) {
        const int srow = 4 * s + g4;
        const float a = sK[srow * 65 + 16 * w + r16] * __expf(g63 - sGc[srow]);
        Sreg[0] = MFMA4(a, sV[srow * 33 + r16], Sreg[0]);
        Sreg[1] = MFMA4(a, sV[srow * 33 + 16 + r16], Sreg[1]);
      }
    }
    __syncthreads();
#pragma unroll
    for (int nn = 0; nn < 2; ++nn) *(uint2*)(sSb + (nn * 16 + r16) * 80 + 16 * w + g4 * 4) = pack4(Sreg[nn]);
    __syncthreads();
  }
  if (!latent) {
    float* so = p.out + OUT_SGDN + ((((size_t)seq * 2 + l) * 2 + d) * 4 + h) * 4096;
#pragma unroll
    for (int nn = 0; nn < 2; ++nn)
#pragma unroll
      for (int r = 0; r < 4; ++r) so[(16 * w + g4 * 4 + r) * 64 + vs * 32 + nn * 16 + r16] = Sreg[nn][r];
  }
}

__device__ __forceinline__ void hgrn_chain(const Params& p, int l, int seq, int h, int d, int vs, float* sm) {
  float* sBC = sm;
  float* sK = sBC + 64 * 65;
  float* sAT = sK + 64 * 65;
  float* sV = sAT + 64 * 68;
  float* sS = sV + 64 * 33;
  float* sTot = sS + 64 * 33;
  const int tid = tid_l(), lane = tid & 63, w = tid >> 6, r16 = lane & 15, g4 = lane >> 4;
  const bool latent = seq >= 16;
  const int len = latent ? 4096 : 256;
  const int t0 = latent ? T_CTX + (seq - 16) * 4096 : seq * 256;
  const int nchunks = len >> 6;
  float lbk;
  {
    const int kch = h * 64 + (tid & 63);
    lbk = (l == 0) ? 0.f : sigmoidf_(p.hgrn_lb[256 + kch] - p.hgrn_lb[kch]);
  }
  f32x4 Sreg[2];
  __syncthreads();
  {
    const float* s0 = latent ? p.state_hgrn + ((((size_t)(seq - 16) * 2 + l) * 2 + d) * 4 + h) * 4096 : nullptr;
#pragma unroll
    for (int n = 0; n < 2; ++n)
#pragma unroll
      for (int r = 0; r < 4; ++r) {
        const int kidx = 16 * w + g4 * 4 + r, cc = n * 16 + r16;
        float v = latent ? s0[kidx * 64 + vs * 32 + cc] : 0.f;
        Sreg[n][r] = v;
        sS[kidx * 33 + cc] = v;
      }
  }
  const u16* Pb = p.P + (size_t)t0 * PW;
  float* sLb = sTot + 256;
  if (tid < 64) sLb[tid] = lbk;
  __syncthreads();
  int pgo[5];
#pragma unroll
  for (int i = 0; i < 5; ++i) {
    const int e = tid + i * 256;
    const int u = e / 20, un = e % 20;
    pgo[i] = u * PW + (un < 8 ? P_HF + d * 256 + h * 64 + un * 8 : (un < 12 ? P_HI + h * 64 + vs * 32 + (un - 8) * 8 : P_HQ + h * 64 + (un - 12) * 8));
  }
  uint4 pf[5];
  {
    const int tlo = d == 0 ? 0 : len - 64;
#pragma unroll
    for (int i = 0; i < 5; ++i) pf[i] = *(const uint4*)(Pb + (size_t)tlo * PW + pgo[i]);
  }
  for (int n = 0; n < nchunks; ++n) {
#pragma unroll
    for (int i = 0; i < 5; ++i) {
      const int e = tid + i * 256;
      const int u = e / 20, un = e % 20;
      const int pp = d == 0 ? u : 63 - u;
      const unsigned wv[4] = {pf[i].x, pf[i].y, pf[i].z, pf[i].w};
#pragma unroll
      for (int j = 0; j < 8; ++j) {
        const float x = bf2f((u16)((wv[j >> 1] >> ((j & 1) * 16)) & 0xffff));
        if (un < 8) {
          const int k = un * 8 + j;
          const float lb = sLb[k];
          const float sg_ = sigmoidf_(x);
          const float gate = lb + (1.f - lb) * sg_;
          sBC[pp * 65 + k] = __logf(fmaxf(gate, 1e-30f));
          sK[pp * 65 + k] = (1.f - lb) * (1.f - sg_);
        } else if (un < 12) {
          sV[pp * 33 + (un - 8) * 8 + j] = x;
        } else {
          sAT[pp * 68 + (un - 12) * 8 + j] = x;
        }
      }
    }
    __syncthreads();
    if (n + 1 < nchunks) {
      const int tlo2 = d == 0 ? (n + 1) * 64 : len - 64 * (n + 2);
#pragma unroll
      for (int i = 0; i < 5; ++i) pf[i] = *(const uint4*)(Pb + (size_t)tlo2 * PW + pgo[i]);
    }
    const int tlo = d == 0 ? n * 64 : len - 64 * (n + 1);
    float cs[16];
    {
      const int k = tid & 63, sg = tid >> 6;
      float run = 0.f;
#pragma unroll
      for (int i = 0; i < 16; ++i) { run += sBC[(16 * sg + i) * 65 + k]; cs[i] = run; }
      sTot[sg * 64 + k] = run;
    }
    float qa[16];
#pragma unroll
    for (int s = 0; s < 16; ++s) qa[s] = sAT[(16 * w + r16) * 68 + 4 * s + g4];
    __syncthreads();
    {
      const int k = tid & 63, sg = tid >> 6;
      float off = 0.f;
      for (int s2 = 0; s2 < sg; ++s2) off += sTot[s2 * 64 + k];
#pragma unroll
      for (int i = 0; i < 16; ++i) sBC[(16 * sg + i) * 65 + k] = cs[i] + off;
    }
    __syncthreads();
    {
      float aq[16], rf[16];
#pragma unroll
      for (int s = 0; s < 16; ++s) {
        const int kk = 4 * s + g4;
        rf[s] = (w == 0) ? 0.f : sBC[(16 * w - 1) * 65 + kk];
        aq[s] = qa[s] * __expf(sBC[(16 * w + r16) * 65 + kk] - rf[s]);
      }
#pragma unroll
      for (int nn = 0; nn < 4; ++nn) {
        f32x4 acc = f32x4{0.f, 0.f, 0.f, 0.f};
        if (nn <= w) {
#pragma unroll
          for (int s = 0; s < 16; ++s) {
            const int kk = 4 * s + g4, sc = 16 * nn + r16;
            const float bv = sK[sc * 65 + kk] * __expf(fminf(rf[s] - sBC[sc * 65 + kk], 80.f));
            acc = MFMA4(aq[s], bv, acc);
          }
        }
#pragma unroll
        for (int r = 0; r < 4; ++r) {
          const int i = 16 * w + g4 * 4 + r, j = 16 * nn + r16;
          sAT[i * 68 + j] = (i >= j) ? acc[r] : 0.f;
        }
      }
    }
    __syncthreads();
    {
      f32x4 acc[2] = {f32x4{0.f, 0.f, 0.f, 0.f}, f32x4{0.f, 0.f, 0.f, 0.f}};
#pragma unroll
      for (int s = 0; s < 16; ++s) {
        const int kk = 4 * s + g4;
        const float a = qa[s] * __expf(sBC[(16 * w + r16) * 65 + kk]);
        acc[0] = MFMA4(sS[kk * 33 + r16], a, acc[0]);
        acc[1] = MFMA4(sS[kk * 33 + 16 + r16], a, acc[1]);
      }
#pragma unroll
      for (int s = 0; s < 16; ++s) {
        if (s < 4 * (w + 1)) {
          const float a = sAT[(16 * w + r16) * 68 + 4 * s + g4];
          acc[0] = MFMA4(sV[(4 * s + g4) * 33 + r16], a, acc[0]);
          acc[1] = MFMA4(sV[(4 * s + g4) * 33 + 16 + r16], a, acc[1]);
        }
      }
      {
        const int pp = 16 * w + r16;
        const int u = d == 0 ? pp : 63 - pp;
        u16* op = p.MIX + (size_t)(t0 + tlo + u) * 1024 + 512 + d * 256 + h * 64 + vs * 32 + g4 * 4;
        *(uint2*)(op) = pack4(acc[0]);
        *(uint2*)(op + 16) = pack4(acc[1]);
      }
    }
    __syncthreads();
    {
#pragma unroll
      for (int nn = 0; nn < 2; ++nn)
#pragma unroll
        for (int r = 0; r < 4; ++r) Sreg[nn][r] *= __expf(sBC[63 * 65 + 16 * w + g4 * 4 + r]);
      const int kA = 16 * w + r16;
      const float blA = sBC[63 * 65 + kA];
#pragma unroll
      for (int s = 0; s < 16; ++s) {
        const int srow = 4 * s + g4;
        const float a = sK[srow * 65 + kA] * __expf(blA - sBC[srow * 65 + kA]);
        Sreg[0] = MFMA4(a, sV[srow * 33 + r16], Sreg[0]);
        Sreg[1] = MFMA4(a, sV[srow * 33 + 16 + r16], Sreg[1]);
      }
    }
    __syncthreads();
#pragma unroll
    for (int nn = 0; nn < 2; ++nn)
#pragma unroll
      for (int r = 0; r < 4; ++r) sS[(16 * w + g4 * 4 + r) * 33 + nn * 16 + r16] = Sreg[nn][r];
    __syncthreads();
  }
  if (!latent) {
    float* so = p.out + OUT_SHG + ((((size_t)seq * 2 + l) * 2 + d) * 4 + h) * 4096;
#pragma unroll
    for (int nn = 0; nn < 2; ++nn)
#pragma unroll
      for (int r = 0; r < 4; ++r) so[(16 * w + g4 * 4 + r) * 64 + vs * 32 + nn * 16 + r16] = Sreg[nn][r];
  }
}

__device__ __forceinline__ void phase_c(const Params& p, int l, unsigned char* smraw, int mode = 0) {
  __shared__ int s_item;
  const int total = 1920;
  const bool paired = (gridDim.x == 512);
  const int jx = blockIdx.x >> 3;
  int my_static = -1;
  if (paired && (jx & 31) < 16) my_static = (blockIdx.x & 7) * 32 + (jx & 15) * 2 + (jx >> 5);
  for (;;) {
    __syncthreads();
    if (tid_l() == 0) {
      if (my_static >= 0) s_item = my_static;
      else s_item = (paired ? 256 : 0) + (int)atomicAdd(&p.counters[l * 64 + mode * 16], 1u);
    }
    __syncthreads();
    my_static = -1;
    const int item = s_item;
    if (item >= total) break;
    int kind, a0, a1, a2, a3;
    if (item < 256 || (item >= 1280 && item < 1792)) {
      const int i2 = item < 256 ? item : item - 1280;
      const int rest = i2 >> 1;
      kind = i2 & 1;
      a3 = rest & 1; a2 = (rest >> 1) & 1; a1 = (rest >> 2) & 3; a0 = (rest >> 4) + (item < 256 ? 16 : 0);
    } else if (item < 1280) {
      const int i2 = item - 256;
      kind = 2; a0 = 1; a1 = i2 >> 7; a2 = (i2 >> 5) & 3; a3 = i2 & 31;
    } else {
      const int i2 = item - 1792;
      kind = 2; a0 = 0; a1 = i2 >> 3; a2 = (i2 >> 1) & 3; a3 = i2 & 1;
    }
    if (mode == 1 && kind == 2) continue;
    if (mode == 2 && kind != 2) continue;
    if (kind != 2) __builtin_amdgcn_s_setprio(3);
    if (kind == 0) gdn_chain(p, l, a0, a1, a2, a3, (float*)smraw);
    else if (kind == 1) hgrn_chain(p, l, a0, a1, a2, a3, (float*)smraw);
    if (kind != 2) __builtin_amdgcn_s_setprio(0);
    else attn_item(p, a0, a1, a2, a3, smraw, mode == 2);
  }
}

__global__ void __launch_bounds__(NTHR, 2) mega(Params p) {
  __shared__ __attribute__((aligned(16))) unsigned char smem[LDS_BYTES];
  cg::grid_group grid = cg::this_grid();
  __shared__ uint4 xb_words;
  if (threadIdx.x == 0) xb_words = make_uint4(0u, 0u, 0u, 0u);
  __syncthreads();
  {
    XcdBarrier xb0 = xcd_barrier_post(p.xbar, (volatile LAS unsigned*)&xb_words);
    if (threadIdx.x == 0) ((volatile LAS unsigned*)&xb_words)[2] = xb0.x;
  }
#define GSYNC() do { XcdBarrier xb_; xb_.bar = p.xbar; xb_.st = (volatile LAS unsigned*)&xb_words; xb_.x = 0; \
    if (threadIdx.x == 0) xb_.x = ((volatile LAS unsigned*)&xb_words)[2]; xcd_barrier(xb_); } while (0)
  phase0(p, (float*)smem);
  if (p.out == nullptr) grid.sync();
  GSYNC();
  rowpass_norm(p, 0, 0);
  GSYNC();
  for (int l = 0; l < 2; ++l) {
    phase_a(p, l, (u16*)smem);
    GSYNC();
    rowpass_b0(p, l);
    GSYNC();
    phase_b1(p, l, (u16*)smem);
    GSYNC();
    rowpass_b2(p, l);
    GSYNC();
    phase_c(p, l, smem);
    GSYNC();
    rowpass_c2(p, l);
    GSYNC();
    phase_gemm_y(p.MIX, 1024, p.WoutT + (size_t)l * 1024 * 1024, 1024, 1024, p.HQ, 1024, (u16*)smem);
    GSYNC();
    rowpass_norm(p, l, 1);
    GSYNC();
    phase_e(p, l, (u16*)smem);
    GSYNC();
    phase_gemm_y(p.P, DFF, p.WfoT + (size_t)l * 1024 * DFF, DFF, 1024, p.HQ, 1024, (u16*)smem);
    GSYNC();
    rowpass_norm(p, l, 2);
    if (l == 0) GSYNC();
  }
}

extern "C" void kernel_launch(void* const* d_in, const int* in_sizes, int n_in, void* d_out, int out_size, void* d_ws,
                              size_t ws_size, hipStream_t stream) {
  static int grid_blocks = 0;
  if (!grid_blocks) {
    int dev = 0, cus = 0, per_cu = 0;
    hipGetDevice(&dev);
    hipDeviceGetAttribute(&cus, hipDeviceAttributeMultiprocessorCount, dev);
    hipOccupancyMaxActiveBlocksPerMultiprocessor(&per_cu, mega, NTHR, 0);
    if (per_cu > 2) per_cu = 2;
    if (per_cu < 1) per_cu = 1;
    grid_blocks = cus * per_cu;
  }
  Params p{};
  const float* const* in = (const float* const*)d_in;
  p.x_prompt = in[0]; p.x_sample = in[1]; p.cache_ckv = in[2]; p.cache_kr = in[3]; p.state_gdn = in[4]; p.state_hgrn = in[5];
  p.c = in[6]; p.c_ctx = in[7]; p.w_ada = in[8]; p.b_ada = in[9]; p.g_pre_mix = in[10]; p.g_post_mix = in[11];
  p.g_pre_ffn = in[12]; p.g_post_ffn = in[13]; p.w_in = in[14]; p.w_out = in[15]; p.gdn_conv_w = in[16];
  p.gdn_a_log = in[17]; p.gdn_dt_bias = in[18]; p.gdn_norm_w = in[19]; p.hgrn_lb = in[20]; p.hgrn_norm_w = in[21];
  p.mla_q_norm_w = in[22]; p.mla_w_uq = in[23]; p.mla_kv_norm_w = in[24]; p.mla_w_ukv = in[25]; p.w_ffn_in = in[26];
  p.w_ffn_out = in[27];
  p.out = (float*)d_out;
  unsigned char* ws = (unsigned char*)d_ws;
  size_t off = 0;
  auto take = [&](size_t bytes) { unsigned char* r = ws + off; off += (bytes + 255) & ~(size_t)255; return r; };
  p.counters = (unsigned*)take(1024);
  p.xbar = (unsigned*)take(16384);
  p.WinT = (u16*)take((size_t)2 * 3072 * 1024 * 2);
  p.WuqT = (u16*)take((size_t)2 * 768 * 384 * 2);
  p.WukvT = (u16*)take((size_t)2 * 1024 * 256 * 2);
  p.WoutT = (u16*)take((size_t)2 * 1024 * 1024 * 2);
  p.WfiT = (u16*)take((size_t)2 * 5632 * 1024 * 2);
  p.WfoT = (u16*)take((size_t)2 * 1024 * 2816 * 2);
  p.mod = (float*)take((size_t)2 * 9 * 6144 * 4);
  p.HQ = (u16*)take((size_t)T_ALL * 1024 * 2);
  p.P = (u16*)take((size_t)T_ALL * PW * 2);
  p.KN = (u16*)take((size_t)(T_ALL + 2048) * 512 * 2);
  p.VTL = (u16*)take((size_t)8 * 4 * 128 * 4352 * 2);
  p.VTC = (u16*)take((size_t)16 * 4 * 128 * 256 * 2);
  p.CKVC = (u16*)take((size_t)2048 * 256 * 2);
  p.KRC = (u16*)take((size_t)2048 * 64 * 2);
  p.GAB = (float*)take((size_t)T_ALL * 16 * 4);
  p.MIX = (u16*)take((size_t)T_ALL * 1024 * 2);
  if (off > ws_size) { fprintf(stderr, "workspace too small: need %zu have %zu\n", off, ws_size); return; }
  hipMemsetAsync(p.counters, 0, 1024 + 16384, stream);
  void* args[] = {&p};
  hipError_t e = hipLaunchCooperativeKernel((void*)mega, dim3(grid_blocks), dim3(NTHR), args, 0, stream);
  if (e != hipSuccess) fprintf(stderr, "cooperative launch failed: %s (grid %d)\n", hipGetErrorString(e), grid_blocks);
}
```

```cpp
#include <hip/hip_runtime.h>
#include <hip/hip_cooperative_groups.h>
#include <cstdio>
namespace cg = cooperative_groups;

typedef unsigned short u16;
using bf16x8 = __attribute__((ext_vector_type(8))) short;
using f32x4  = __attribute__((ext_vector_type(4))) float;

#define T_CTX 4096
#define T_ALL 36864
#define PW 3072
#define DFF 2816
#define LDS_BYTES 77824
#define NTHR 256

#define P_GQKV 0
#define P_GZ 768
#define P_HQ 1024
#define P_HI 1280
#define P_HF 1536
#define P_HG 2048
#define P_MCQ 2304
#define P_MCKV 2688
#define P_MKR 2944
#define P_GA 3008

struct Params {
  const float *x_prompt, *x_sample, *cache_ckv, *cache_kr, *state_gdn, *state_hgrn, *c, *c_ctx;
  const float *w_ada, *b_ada, *g_pre_mix, *g_post_mix, *g_pre_ffn, *g_post_ffn, *w_in, *w_out;
  const float *gdn_conv_w, *gdn_a_log, *gdn_dt_bias, *gdn_norm_w, *hgrn_lb, *hgrn_norm_w;
  const float *mla_q_norm_w, *mla_w_uq, *mla_kv_norm_w, *mla_w_ukv, *w_ffn_in, *w_ffn_out;
  float* out;
  u16 *WinT, *WuqT, *WukvT, *WoutT, *WfiT, *WfoT;
  float* mod;
  u16 *HQ, *P, *KN, *VTL, *VTC, *CKVC, *KRC, *MIX;
  float* GAB;
  unsigned* counters;
  unsigned* xbar;
};

#define OUT_CKV   37748736
#define OUT_KR    39845888
#define OUT_SGDN  40370176
#define OUT_SHG   41418752

__device__ __forceinline__ u16 f2bf(float f) {
  unsigned u = __float_as_uint(f);
  u += 0x7fffu + ((u >> 16) & 1u);
  return (u16)(u >> 16);
}
__device__ __forceinline__ float bf2f(u16 h) { return __uint_as_float(((unsigned)h) << 16); }
__device__ __forceinline__ float wave_sum(float v) {
#pragma unroll
  for (int o = 32; o > 0; o >>= 1) v += __shfl_xor(v, o);
  return v;
}
__device__ __forceinline__ float sigmoidf_(float x) { return __builtin_amdgcn_rcpf(1.f + __expf(-x)); }
__device__ __forceinline__ float siluf_(float x) { return x * __builtin_amdgcn_rcpf(1.f + __expf(-x)); }
__device__ __forceinline__ int tid_l() { int t = threadIdx.x; asm volatile("" : "+v"(t)); return t; }
__device__ __forceinline__ int tok_mod(int t) { return t < T_CTX ? 0 : 1 + ((t - T_CTX) >> 12); }

__device__ __forceinline__ int map_col(int kind, int j) {
  if (kind == 0) return j;
  if (kind == 1) { if (j < 1024) return j; if (j < 3008) return j + 16; if (j < 3024) return 1024 + (j - 3008); return -1; }
  int blk = j >> 6, w = j & 63;
  return w < 32 ? blk * 32 + w : DFF + blk * 32 + (w - 32);
}

__device__ __forceinline__ void cvt_tile(const float* __restrict__ src, int K, int Nsrc, u16* __restrict__ dst, int kind, int jt, int kt, float* sm) {
  const int tid = tid_l();
  const int j0 = jt * 64, k0 = kt * 64;
  __syncthreads();
  {
    int jj = tid & 63, kk0 = tid >> 6;
    int sc = map_col(kind, j0 + jj);
    for (int kk = kk0; kk < 64; kk += 4)
      sm[kk * 65 + jj] = sc >= 0 ? src[(size_t)(k0 + kk) * Nsrc + sc] : 0.f;
  }
  __syncthreads();
  {
    const int kq = tid & 15, jj0 = tid >> 4;
#pragma unroll
    for (int jj = jj0; jj < 64; jj += 16) {
      uint2 o;
      o.x = (unsigned)f2bf(sm[(4 * kq + 0) * 65 + jj]) | ((unsigned)f2bf(sm[(4 * kq + 1) * 65 + jj]) << 16);
      o.y = (unsigned)f2bf(sm[(4 * kq + 2) * 65 + jj]) | ((unsigned)f2bf(sm[(4 * kq + 3) * 65 + jj]) << 16);
      *(uint2*)(dst + (size_t)(j0 + jj) * K + k0 + 4 * kq) = o;
    }
  }
}

__device__ __forceinline__ void mod_item(const Params& p, int item, float* sm) {
  const int l = item / 96, j0 = (item % 96) * 64;
  const int tid = tid_l();
  float* sC = sm;
  float* sR = sm + 9 * 1024;
  __syncthreads();
  for (int i = tid; i < 9 * 1024; i += NTHR) {
    int m = i >> 10, k = i & 1023;
    float v = m == 0 ? p.c_ctx[k] : p.c[(m - 1) * 1024 + k];
    sC[i] = siluf_(v);
  }
  __syncthreads();
  const int col = tid & 63, ks = tid >> 6;
  float acc[9];
#pragma unroll
  for (int m = 0; m < 9; ++m) acc[m] = 0.f;
  const float* wp = p.w_ada + (size_t)l * 1024 * 6144 + j0 + col;
  for (int k = ks * 256; k < ks * 256 + 256; k += 8) {
    float wv[8];
#pragma unroll
    for (int u = 0; u < 8; ++u) wv[u] = wp[(size_t)(k + u) * 6144];
#pragma unroll
    for (int u = 0; u < 8; ++u)
#pragma unroll
      for (int m = 0; m < 9; ++m) acc[m] += sC[m * 1024 + k + u] * wv[u];
  }
#pragma unroll
  for (int m = 0; m < 9; ++m) sR[(ks * 9 + m) * 64 + col] = acc[m];
  __syncthreads();
  for (int i = tid; i < 9 * 64; i += NTHR) {
    int m = i >> 6, cc = i & 63;
    float v = sR[(0 * 9 + m) * 64 + cc] + sR[(1 * 9 + m) * 64 + cc] + sR[(2 * 9 + m) * 64 + cc] + sR[(3 * 9 + m) * 64 + cc];
    p.mod[((size_t)l * 9 + m) * 6144 + j0 + cc] = v + p.b_ada[l * 6144 + j0 + cc];
  }
}

__device__ __forceinline__ void phase0(const Params& p, float* sm) {
  const int PER_LAYER = 3272;
  const int total = 2 * PER_LAYER + 192;
  for (int item = blockIdx.x; item < total; item += gridDim.x) {
    if (item < 192) { mod_item(p, item, sm); continue; }
    int it = item - 192;
    int l = it / PER_LAYER, r = it % PER_LAYER;
    if (r < 768) { cvt_tile(p.w_in + (size_t)l * 1024 * 3024, 1024, 3024, p.WinT + (size_t)l * 3072 * 1024, 1, r / 16, r % 16, sm); continue; }
    r -= 768;
    if (r < 72) { cvt_tile(p.mla_w_uq + (size_t)l * 384 * 768, 384, 768, p.WuqT + (size_t)l * 768 * 384, 0, r / 6, r % 6, sm); continue; }
    r -= 72;
    if (r < 64) { cvt_tile(p.mla_w_ukv + (size_t)l * 256 * 1024, 256, 1024, p.WukvT + (size_t)l * 1024 * 256, 0, r / 4, r % 4, sm); continue; }
    r -= 64;
    if (r < 256) { cvt_tile(p.w_out + (size_t)l * 1024 * 1024, 1024, 1024, p.WoutT + (size_t)l * 1024 * 1024, 0, r / 16, r % 16, sm); continue; }
    r -= 256;
    if (r < 1408) { cvt_tile(p.w_ffn_in + (size_t)l * 1024 * 5632, 1024, 5632, p.WfiT + (size_t)l * 5632 * 1024, 2, r / 16, r % 16, sm); continue; }
    r -= 1408;
    cvt_tile(p.w_ffn_out + (size_t)l * 2816 * 1024, 2816, 1024, p.WfoT + (size_t)l * 1024 * 2816, 0, r / 44, r % 44, sm);
  }
}

__device__ __forceinline__ void rowpass_norm(const Params& p, int l, int stage) {
  const int tidl = tid_l();
  const int lane = tidl & 63, w = tidl >> 6;
  const int ln = stage == 0 ? 0 : (stage == 1 ? l : l + 1);
  const int sh_off = stage == 1 ? 3072 : 0;
  const float* gpre = stage == 1 ? p.g_pre_ffn + l * 1024 : p.g_pre_mix + (ln < 2 ? ln : 0) * 1024;
  u16* dst = stage == 1 ? p.MIX : p.HQ;
  for (int t = blockIdx.x * 4 + w; t < T_ALL; t += gridDim.x * 4) {
    const int m = tok_mod(t);
    float x[16];
    float* xo = p.out + (size_t)t * 1024;
    if (stage == 0) {
      const float* xi = t < T_CTX ? p.x_prompt + (size_t)t * 1024 : p.x_sample + (size_t)(t - T_CTX) * 1024;
#pragma unroll
      for (int i = 0; i < 4; ++i) {
        float4 v = *(const float4*)(xi + i * 256 + lane * 4);
        x[i * 4 + 0] = v.x; x[i * 4 + 1] = v.y; x[i * 4 + 2] = v.z; x[i * 4 + 3] = v.w;
      }
    } else {
      const u16* yp = p.HQ + (size_t)t * 1024;
      float y[16]; float ss = 0.f;
#pragma unroll
      for (int i = 0; i < 4; ++i) {
        uint2 v = *(const uint2*)(yp + i * 256 + lane * 4);
        y[i * 4 + 0] = bf2f((u16)(v.x & 0xffff)); y[i * 4 + 1] = bf2f((u16)(v.x >> 16));
        y[i * 4 + 2] = bf2f((u16)(v.y & 0xffff)); y[i * 4 + 3] = bf2f((u16)(v.y >> 16));
      }
#pragma unroll
      for (int i = 0; i < 16; ++i) ss += y[i] * y[i];
      ss = wave_sum(ss);
      const float rstd = rsqrtf(ss * (1.f / 1024.f) + 1e-6f);
      const float* gpost = (stage == 1 ? p.g_post_mix : p.g_post_ffn) + l * 1024;
      const float* gt = p.mod + ((size_t)l * 9 + m) * 6144 + (stage == 1 ? 2048 : 5120);
#pragma unroll
      for (int i = 0; i < 4; ++i) {
        float4 xv = *(const float4*)(xo + i * 256 + lane * 4);
        float4 gp = *(const float4*)(gpost + i * 256 + lane * 4);
        float4 gg = *(const float4*)(gt + i * 256 + lane * 4);
        x[i * 4 + 0] = xv.x + gg.x * y[i * 4 + 0] * rstd * gp.x;
        x[i * 4 + 1] = xv.y + gg.y * y[i * 4 + 1] * rstd * gp.y;
        x[i * 4 + 2] = xv.z + gg.z * y[i * 4 + 2] * rstd * gp.z;
        x[i * 4 + 3] = xv.w + gg.w * y[i * 4 + 3] * rstd * gp.w;
      }
    }
    __threadfence_block();
#pragma unroll
    for (int i = 0; i < 4; ++i)
      *(float4*)(xo + i * 256 + lane * 4) = make_float4(x[i * 4 + 0], x[i * 4 + 1], x[i * 4 + 2], x[i * 4 + 3]);
    if (ln >= 2) continue;
    float ss = 0.f;
#pragma unroll
    for (int i = 0; i < 16; ++i) ss += x[i] * x[i];
    ss = wave_sum(ss);
    const float rstd = rsqrtf(ss * (1.f / 1024.f) + 1e-6f);
    const float* sh = p.mod + ((size_t)ln * 9 + m) * 6144 + sh_off;
    const float* sc = sh + 1024;
    u16* hp = dst + (size_t)t * 1024;
#pragma unroll
    for (int i = 0; i < 4; ++i) {
      float4 gp = *(const float4*)(gpre + i * 256 + lane * 4);
      float4 s1 = *(const float4*)(sh + i * 256 + lane * 4);
      float4 c1 = *(const float4*)(sc + i * 256 + lane * 4);
      float h0 = x[i * 4 + 0] * rstd * gp.x * (1.f + c1.x) + s1.x;
      float h1 = x[i * 4 + 1] * rstd * gp.y * (1.f + c1.y) + s1.y;
      float h2 = x[i * 4 + 2] * rstd * gp.z * (1.f + c1.z) + s1.z;
      float h3 = x[i * 4 + 3] * rstd * gp.w * (1.f + c1.w) + s1.w;
      uint2 o;
      o.x = (unsigned)f2bf(h0) | ((unsigned)f2bf(h1) << 16);
      o.y = (unsigned)f2bf(h2) | ((unsigned)f2bf(h3) << 16);
      *(uint2*)(hp + i * 256 + lane * 4) = o;
    }
  }
}

__device__ __forceinline__ void unpack8(const uint4 v, float (&f)[8]);
__device__ __forceinline__ uint4 pack8(const float (&f)[8]);
__device__ __forceinline__ void rowpass_b0(const Params& p, int l) {
  const int tidl = tid_l();
  const int lane = tidl & 63, w = tidl >> 6;
  for (int t = blockIdx.x * 4 + w; t < T_ALL + 2048; t += gridDim.x * 4) {
    if (t >= T_ALL) {
      const int r = t - T_ALL, b = r >> 8, s = r & 255;
      if (lane < 32) {
        const float* ck = p.cache_ckv + (((size_t)b * 2 + l) * 256 + s) * 256 + lane * 8;
        const float4 x0 = *(const float4*)ck, x1 = *(const float4*)(ck + 4);
        const float f[8] = {x0.x, x0.y, x0.z, x0.w, x1.x, x1.y, x1.z, x1.w};
        *(uint4*)(p.CKVC + (size_t)r * 256 + lane * 8) = pack8(f);
      } else if (lane < 40) {
        const float* kr = p.cache_kr + (((size_t)b * 2 + l) * 256 + s) * 64 + (lane - 32) * 8;
        const float4 x0 = *(const float4*)kr, x1 = *(const float4*)(kr + 4);
        const float f[8] = {x0.x, x0.y, x0.z, x0.w, x1.x, x1.y, x1.z, x1.w};
        *(uint4*)(p.KRC + (size_t)r * 64 + (lane - 32) * 8) = pack8(f);
      }
      continue;
    }
    u16* pr = p.P + (size_t)t * PW;
    {
      float f[8]; float ss = 0.f;
      if (lane < 48) {
        unpack8(*(const uint4*)(pr + P_MCQ + lane * 8), f);
#pragma unroll
        for (int i = 0; i < 8; ++i) ss += f[i] * f[i];
      }
      ss = wave_sum(ss);
      const float rstd = rsqrtf(ss * (1.f / 384.f) + 1e-6f);
      if (lane < 48) {
        const float* wq = p.mla_q_norm_w + l * 384 + lane * 8;
        const float4 w0 = *(const float4*)wq, w1 = *(const float4*)(wq + 4);
        f[0] *= rstd * w0.x; f[1] *= rstd * w0.y; f[2] *= rstd * w0.z; f[3] *= rstd * w0.w;
        f[4] *= rstd * w1.x; f[5] *= rstd * w1.y; f[6] *= rstd * w1.z; f[7] *= rstd * w1.w;
        *(uint4*)(pr + P_MCQ + lane * 8) = pack8(f);
      }
    }
    {
      float f[8]; float ss = 0.f;
      if (lane < 32) {
        unpack8(*(const uint4*)(pr + P_MCKV + lane * 8), f);
#pragma unroll
        for (int i = 0; i < 8; ++i) ss += f[i] * f[i];
      }
      ss = wave_sum(ss);
      const float rstd = rsqrtf(ss * (1.f / 256.f) + 1e-6f);
      if (lane < 32) {
        const float* wk = p.mla_kv_norm_w + l * 256 + lane * 8;
        const float4 w0 = *(const float4*)wk, w1 = *(const float4*)(wk + 4);
        f[0] *= rstd * w0.x; f[1] *= rstd * w0.y; f[2] *= rstd * w0.z; f[3] *= rstd * w0.w;
        f[4] *= rstd * w1.x; f[5] *= rstd * w1.y; f[6] *= rstd * w1.z; f[7] *= rstd * w1.w;
        *(uint4*)(pr + P_MCKV + lane * 8) = pack8(f);
        if (t < T_CTX) {
          const int b = t >> 8, s = t & 255;
          float* op = p.out + OUT_CKV + (((size_t)b * 2 + l) * 256 + s) * 256 + lane * 8;
          *(float4*)op = make_float4(f[0], f[1], f[2], f[3]);
          *(float4*)(op + 4) = make_float4(f[4], f[5], f[6], f[7]);
        }
      }
    }
    {
      float v = bf2f(pr[P_MKR + lane]);
      if (t < T_CTX) {
        int b = t >> 8, s = t & 255;
        p.out[OUT_KR + (((size_t)b * 2 + l) * 256 + s) * 64 + lane] = v;
      } else {
        int pos = (t - T_CTX) & 4095;
        int axis = lane >> 5, half = (lane >> 4) & 1, f = lane & 15;
        float posf = axis == 0 ? (float)(pos >> 6) : (float)(pos & 63);
        float inv = exp2f(-(float)f * (13.287712379549449f / 16.f));
        float ang = posf * inv;
        float sn, cs;
        __sincosf(ang, &sn, &cs);
        float other = __shfl_xor(v, 16);
        float o = half == 0 ? v * cs - other * sn : v * cs + other * sn;
        pr[P_MKR + lane] = f2bf(o);
      }
    }
  }
}

#define P_QH 2304
#define P_KH 2560
__device__ __forceinline__ void rowpass_b2(const Params& p, int l) {
  const int tidl = tid_l();
  const int lane = tidl & 63, w = tidl >> 6;
  float cw[8][5], cv[8][5];
#pragma unroll
  for (int e = 0; e < 8; ++e)
#pragma unroll
    for (int j = 0; j < 5; ++j) {
      cw[e][j] = p.gdn_conv_w[((size_t)l * 768 + 8 * lane + e) * 5 + j];
      cv[e][j] = p.gdn_conv_w[((size_t)l * 768 + 512 + 8 * (lane & 31) + e) * 5 + j];
    }
  u16* VH = p.HQ + (size_t)T_ALL * 768;
  for (int t = blockIdx.x * 4 + w; t < T_ALL; t += gridDim.x * 4) {
    const int len = t < T_CTX ? 256 : 4096;
    const int tau = t < T_CTX ? (t & 255) : ((t - T_CTX) & 4095);
    float y[8], yv[8];
#pragma unroll
    for (int e = 0; e < 8; ++e) { y[e] = 0.f; yv[e] = 0.f; }
#pragma unroll
    for (int j = 0; j < 5; ++j) {
      const int tt = tau + j - 2;
      if (tt >= 0 && tt < len) {
        const u16* pr = p.P + (size_t)(t + j - 2) * PW;
        float f[8];
        unpack8(*(const uint4*)(pr + 8 * lane), f);
#pragma unroll
        for (int e = 0; e < 8; ++e) y[e] += cw[e][j] * f[e];
        if (lane < 32) {
          unpack8(*(const uint4*)(pr + 512 + 8 * lane), f);
#pragma unroll
          for (int e = 0; e < 8; ++e) yv[e] += cv[e][j] * f[e];
        }
      }
    }
    float ss = 0.f;
#pragma unroll
    for (int e = 0; e < 8; ++e) { y[e] = siluf_(y[e]); yv[e] = siluf_(yv[e]); ss += y[e] * y[e]; }
    ss += __shfl_xor(ss, 1); ss += __shfl_xor(ss, 2); ss += __shfl_xor(ss, 4);
    const float rn = rsqrtf(ss + 1e-6f) * (lane < 32 ? 0.125f : 1.f);
#pragma unroll
    for (int e = 0; e < 8; ++e) y[e] *= rn;
    *(uint4*)(p.P + (size_t)t * PW + P_QH + 8 * lane) = pack8(y);
    if (lane < 32) *(uint4*)(VH + (size_t)t * 256 + 8 * lane) = pack8(yv);
  }
}

__device__ __forceinline__ void unpack8(const uint4 v, float (&f)[8]) {
  f[0] = bf2f((u16)(v.x & 0xffff)); f[1] = bf2f((u16)(v.x >> 16)); f[2] = bf2f((u16)(v.y & 0xffff)); f[3] = bf2f((u16)(v.y >> 16));
  f[4] = bf2f((u16)(v.z & 0xffff)); f[5] = bf2f((u16)(v.z >> 16)); f[6] = bf2f((u16)(v.w & 0xffff)); f[7] = bf2f((u16)(v.w >> 16));
}
__device__ __forceinline__ uint4 pack8(const float (&f)[8]) {
  uint4 o;
  o.x = (unsigned)f2bf(f[0]) | ((unsigned)f2bf(f[1]) << 16); o.y = (unsigned)f2bf(f[2]) | ((unsigned)f2bf(f[3]) << 16);
  o.z = (unsigned)f2bf(f[4]) | ((unsigned)f2bf(f[5]) << 16); o.w = (unsigned)f2bf(f[6]) | ((unsigned)f2bf(f[7]) << 16);
  return o;
}
__device__ __forceinline__ void rowpass_c2(const Params& p, int l) {
  const int tidl = tid_l();
  const int lane = tidl & 63, w = tidl >> 6;
  const int hl = lane & 31, isH = lane >> 5;
  const float* nw = (isH ? p.hgrn_norm_w : p.gdn_norm_w) + l * 64 + (hl & 7) * 8;
  const float4 w0 = *(const float4*)(nw), w1 = *(const float4*)(nw + 4);
  const float wv[8] = {w0.x, w0.y, w0.z, w0.w, w1.x, w1.y, w1.z, w1.w};
  for (int t = blockIdx.x * 4 + w; t < T_ALL; t += gridDim.x * 4) {
    u16* mr = p.MIX + (size_t)t * 1024;
    const u16* pr = p.P + (size_t)t * PW;
    const u16* qr = p.HQ + (size_t)t * 768;
    const uint4 vf = *(const uint4*)(mr + isH * 512 + hl * 8);
    const uint4 vb = *(const uint4*)(mr + isH * 512 + 256 + hl * 8);
    const uint4 vg = *(const uint4*)(pr + (isH ? P_HG : P_GZ) + hl * 8);
    const int c0 = lane * 8;
    const uint4 vo = *(const uint4*)(qr + (c0 >> 7) * 192 + (c0 & 127));
    float f[8], bb[8], g[8];
    unpack8(vf, f); unpack8(vb, bb); unpack8(vg, g);
    float ss = 0.f;
#pragma unroll
    for (int i = 0; i < 8; ++i) { f[i] += bb[i]; ss += f[i] * f[i]; }
    ss += __shfl_xor(ss, 1); ss += __shfl_xor(ss, 2); ss += __shfl_xor(ss, 4);
    const float rn = rsqrtf(ss * (1.f / 64.f) + 1e-6f);
#pragma unroll
    for (int i = 0; i < 8; ++i) f[i] = f[i] * rn * wv[i] * (isH ? sigmoidf_(g[i]) : siluf_(g[i]));
    __threadfence_block();
    *(uint4*)(mr + isH * 256 + hl * 8) = pack8(f);
    *(uint4*)(mr + 512 + c0) = vo;
  }
}

__device__ __forceinline__ void gemm128(const u16* __restrict__ A, int lda, const u16* __restrict__ B, int ldb, int K,
                                        u16* lds, f32x4 (&acc)[4][4]) {
  const int tid = tid_l(), lane = tid & 63, w = tid >> 6, wm = w >> 1, wn = w & 1;
  const int r16 = lane & 15, g4 = lane >> 4;
#pragma unroll
  for (int i = 0; i < 4; ++i)
#pragma unroll
    for (int j = 0; j < 4; ++j) acc[i][j] = f32x4{0.f, 0.f, 0.f, 0.f};
  const int lrow = tid >> 3, lkc = tid & 7;
  const u16* ap = A + (size_t)lrow * lda + lkc * 8;
  const u16* bp = B + (size_t)lrow * ldb + lkc * 8;
  const size_t sa32 = (size_t)32 * lda, sb32 = (size_t)32 * ldb;
  uint4 ra0 = *(const uint4*)(ap), ra1 = *(const uint4*)(ap + sa32), ra2 = *(const uint4*)(ap + 2 * sa32), ra3 = *(const uint4*)(ap + 3 * sa32);
  uint4 rb0 = *(const uint4*)(bp), rb1 = *(const uint4*)(bp + sb32), rb2 = *(const uint4*)(bp + 2 * sb32), rb3 = *(const uint4*)(bp + 3 * sb32);
  const int woff = lrow * 64 + ((lkc ^ (lrow & 7)) * 8);
  const int sw = r16 & 7;
  const int fa0 = (wm * 64 + r16) * 64 + ((g4 ^ sw) * 8);
  const int fa1 = (wm * 64 + r16) * 64 + (((4 + g4) ^ sw) * 8);
  const int fb0 = 128 * 64 + (wn * 64 + r16) * 64 + ((g4 ^ sw) * 8);
  const int fb1 = 128 * 64 + (wn * 64 + r16) * 64 + (((4 + g4) ^ sw) * 8);
  const int nk = K >> 6;
  __syncthreads();
  {
    u16* wa = lds + woff; u16* wb = lds + 128 * 64 + woff;
    *(uint4*)(wa) = ra0; *(uint4*)(wa + 32 * 64) = ra1; *(uint4*)(wa + 64 * 64) = ra2; *(uint4*)(wa + 96 * 64) = ra3;
    *(uint4*)(wb) = rb0; *(uint4*)(wb + 32 * 64) = rb1; *(uint4*)(wb + 64 * 64) = rb2; *(uint4*)(wb + 96 * 64) = rb3;
  }
  if (nk > 1) {
    const u16* a2 = ap + 64; const u16* b2 = bp + 64;
    ra0 = *(const uint4*)(a2); ra1 = *(const uint4*)(a2 + sa32); ra2 = *(const uint4*)(a2 + 2 * sa32); ra3 = *(const uint4*)(a2 + 3 * sa32);
    rb0 = *(const uint4*)(b2); rb1 = *(const uint4*)(b2 + sb32); rb2 = *(const uint4*)(b2 + 2 * sb32); rb3 = *(const uint4*)(b2 + 3 * sb32);
  }
  __syncthreads();
  for (int kt = 0; kt < nk; ++kt) {
    const u16* cur = lds + (kt & 1) * (256 * 64);
    if (kt + 1 < nk) {
      u16* nxt = lds + ((kt + 1) & 1) * (256 * 64);
      u16* wa = nxt + woff; u16* wb = nxt + 128 * 64 + woff;
      *(uint4*)(wa) = ra0; *(uint4*)(wa + 32 * 64) = ra1; *(uint4*)(wa + 64 * 64) = ra2; *(uint4*)(wa + 96 * 64) = ra3;
      *(uint4*)(wb) = rb0; *(uint4*)(wb + 32 * 64) = rb1; *(uint4*)(wb + 64 * 64) = rb2; *(uint4*)(wb + 96 * 64) = rb3;
      if (kt + 2 < nk) {
        const u16* a2 = ap + (kt + 2) * 64; const u16* b2 = bp + (kt + 2) * 64;
        ra0 = *(const uint4*)(a2); ra1 = *(const uint4*)(a2 + sa32); ra2 = *(const uint4*)(a2 + 2 * sa32); ra3 = *(const uint4*)(a2 + 3 * sa32);
        rb0 = *(const uint4*)(b2); rb1 = *(const uint4*)(b2 + sb32); rb2 = *(const uint4*)(b2 + 2 * sb32); rb3 = *(const uint4*)(b2 + 3 * sb32);
      }
    }
    {
      const u16* pa0 = cur + fa0; const u16* pa1 = cur + fa1; const u16* pb0 = cur + fb0; const u16* pb1 = cur + fb1;
      bf16x8 a0 = *(const bf16x8*)(pa0), a1 = *(const bf16x8*)(pa0 + 16 * 64), a2 = *(const bf16x8*)(pa0 + 32 * 64), a3 = *(const bf16x8*)(pa0 + 48 * 64);
      bf16x8 b0 = *(const bf16x8*)(pb0), b1 = *(const bf16x8*)(pb0 + 16 * 64), b2 = *(const bf16x8*)(pb0 + 32 * 64), b3 = *(const bf16x8*)(pb0 + 48 * 64);
      bf16x8 c0 = *(const bf16x8*)(pa1), c1 = *(const bf16x8*)(pa1 + 16 * 64), c2 = *(const bf16x8*)(pa1 + 32 * 64), c3 = *(const bf16x8*)(pa1 + 48 * 64);
      bf16x8 d0 = *(const bf16x8*)(pb1), d1 = *(const bf16x8*)(pb1 + 16 * 64), d2 = *(const bf16x8*)(pb1 + 32 * 64), d3 = *(const bf16x8*)(pb1 + 48 * 64);
      __builtin_amdgcn_sched_barrier(0);
#define G128_MM(j, bj, x0, x1, x2, x3) do { \
        acc[0][j] = __builtin_amdgcn_mfma_f32_16x16x32_bf16(bj, x0, acc[0][j], 0, 0, 0); \
        acc[1][j] = __builtin_amdgcn_mfma_f32_16x16x32_bf16(bj, x1, acc[1][j], 0, 0, 0); \
        acc[2][j] = __builtin_amdgcn_mfma_f32_16x16x32_bf16(bj, x2, acc[2][j], 0, 0, 0); \
        acc[3][j] = __builtin_amdgcn_mfma_f32_16x16x32_bf16(bj, x3, acc[3][j], 0, 0, 0); } while (0)
      __builtin_amdgcn_s_setprio(1);
      G128_MM(0, b0, a0, a1, a2, a3); G128_MM(1, b1, a0, a1, a2, a3); G128_MM(2, b2, a0, a1, a2, a3); G128_MM(3, b3, a0, a1, a2, a3);
      G128_MM(0, d0, c0, c1, c2, c3); G128_MM(1, d1, c0, c1, c2, c3); G128_MM(2, d2, c0, c1, c2, c3); G128_MM(3, d3, c0, c1, c2, c3);
      __builtin_amdgcn_s_setprio(0);
    }
    __syncthreads();
  }
}
__device__ __forceinline__ uint2 pack4(f32x4 v) {
  uint2 o;
  o.x = (unsigned)f2bf(v[0]) | ((unsigned)f2bf(v[1]) << 16);
  o.y = (unsigned)f2bf(v[2]) | ((unsigned)f2bf(v[3]) << 16);
  return o;
}

__device__ __forceinline__ void gemm256(const u16* __restrict__ A, int lda, const u16* __restrict__ B, int ldb, int K,
                                        u16* lds, f32x4 (&acc)[8][4]) {
  const int tid = tid_l(), lane = tid & 63, w = tid >> 6, wm = w >> 1, wn = w & 1;
  const int r16 = lane & 15, g4 = lane >> 4;
#pragma unroll
  for (int i = 0; i < 8; ++i)
#pragma unroll
    for (int j = 0; j < 4; ++j) acc[i][j] = f32x4{0.f, 0.f, 0.f, 0.f};
  const int lrow = tid >> 2, lkc = tid & 3;
  const u16* ap = A + (size_t)lrow * lda + lkc * 8;
  const u16* bp = B + (size_t)lrow * ldb + lkc * 8;
  const size_t sa64 = (size_t)64 * lda, sb64 = (size_t)64 * ldb;
  const int woff = lrow * 32 + ((lkc ^ ((lrow >> 1) & 3)) * 8);
  const int fsw = (g4 ^ ((r16 >> 1) & 3)) * 8;
  const int faoff = (wm * 128 + r16) * 32 + fsw;
  const int fboff = 256 * 32 + (wn * 64 + r16) * 32 + fsw;
  const int nk = K >> 5;
  const int BUF = 384 * 32;
  uint4 xa0, xa1, xa2, xa3, xb0, xb1;
  uint4 ya0, ya1, ya2, ya3, yb0, yb1;
#define G256_LOAD(P, st) do { const u16* a2_ = ap + (st) * 32; const u16* b2_ = bp + (st) * 32; \
    P##a0 = *(const uint4*)(a2_); P##a1 = *(const uint4*)(a2_ + sa64); P##a2 = *(const uint4*)(a2_ + 2 * sa64); P##a3 = *(const uint4*)(a2_ + 3 * sa64); \
    P##b0 = *(const uint4*)(b2_); P##b1 = *(const uint4*)(b2_ + sb64); } while (0)
#define G256_STORE(P, buf) do { u16* wa_ = lds + (buf) * BUF + woff; u16* wb_ = wa_ + 256 * 32; \
    *(uint4*)(wa_) = P##a0; *(uint4*)(wa_ + 64 * 32) = P##a1; *(uint4*)(wa_ + 128 * 32) = P##a2; *(uint4*)(wa_ + 192 * 32) = P##a3; \
    *(uint4*)(wb_) = P##b0; *(uint4*)(wb_ + 64 * 32) = P##b1; } while (0)
#define G256_MM(i, af) do { \
      acc[i][0] = __builtin_amdgcn_mfma_f32_16x16x32_bf16(bf0, af, acc[i][0], 0, 0, 0); \
      acc[i][1] = __builtin_amdgcn_mfma_f32_16x16x32_bf16(bf1, af, acc[i][1], 0, 0, 0); \
      acc[i][2] = __builtin_amdgcn_mfma_f32_16x16x32_bf16(bf2, af, acc[i][2], 0, 0, 0); \
      acc[i][3] = __builtin_amdgcn_mfma_f32_16x16x32_bf16(bf3, af, acc[i][3], 0, 0, 0); } while (0)
#define G256_COMPUTE(buf) do { const u16* fa_ = lds + (buf) * BUF + faoff; const u16* fb_ = lds + (buf) * BUF + fboff; \
    bf16x8 bf0 = *(const bf16x8*)(fb_), bf1 = *(const bf16x8*)(fb_ + 16 * 32), bf2 = *(const bf16x8*)(fb_ + 32 * 32), bf3 = *(const bf16x8*)(fb_ + 48 * 32); \
    bf16x8 a0 = *(const bf16x8*)(fa_), a1 = *(const bf16x8*)(fa_ + 16 * 32), a2 = *(const bf16x8*)(fa_ + 32 * 32), a3 = *(const bf16x8*)(fa_ + 48 * 32); \
    __builtin_amdgcn_sched_barrier(0); __builtin_amdgcn_s_setprio(1); \
    G256_MM(0, a0); a0 = *(const bf16x8*)(fa_ + 64 * 32); __builtin_amdgcn_sched_barrier(0); \
    G256_MM(1, a1); a1 = *(const bf16x8*)(fa_ + 80 * 32); __builtin_amdgcn_sched_barrier(0); \
    G256_MM(2, a2); a2 = *(const bf16x8*)(fa_ + 96 * 32); __builtin_amdgcn_sched_barrier(0); \
    G256_MM(3, a3); a3 = *(const bf16x8*)(fa_ + 112 * 32); __builtin_amdgcn_sched_barrier(0); \
    G256_MM(4, a0); G256_MM(5, a1); G256_MM(6, a2); G256_MM(7, a3); __builtin_amdgcn_s_setprio(0); } while (0)
  bf16x8 bf0, bf1, bf2, bf3, a0, a1, a2, a3;
#define G3_PRELOAD(buf) do { const u16* fa_ = lds + (buf) * BUF + faoff; const u16* fb_ = lds + (buf) * BUF + fboff; \
    bf0 = *(const bf16x8*)(fb_); bf1 = *(const bf16x8*)(fb_ + 16 * 32); bf2 = *(const bf16x8*)(fb_ + 32 * 32); bf3 = *(const bf16x8*)(fb_ + 48 * 32); \
    a0 = *(const bf16x8*)(fa_); a1 = *(const bf16x8*)(fa_ + 16 * 32); a2 = *(const bf16x8*)(fa_ + 32 * 32); a3 = *(const bf16x8*)(fa_ + 48 * 32); } while (0)
#define G3_COMPUTE(buf) do { const u16* fa_ = lds + (buf) * BUF + faoff; \
    __builtin_amdgcn_sched_barrier(0); __builtin_amdgcn_s_setprio(1); \
    G256_MM(0, a0); a0 = *(const bf16x8*)(fa_ + 64 * 32); __builtin_amdgcn_sched_barrier(0); \
    G256_MM(1, a1); a1 = *(const bf16x8*)(fa_ + 80 * 32); __builtin_amdgcn_sched_barrier(0); \
    G256_MM(2, a2); a2 = *(const bf16x8*)(fa_ + 96 * 32); __builtin_amdgcn_sched_barrier(0); \
    G256_MM(3, a3); a3 = *(const bf16x8*)(fa_ + 112 * 32); __builtin_amdgcn_sched_barrier(0); \
    G256_MM(4, a0); G256_MM(5, a1); G256_MM(6, a2); G256_MM(7, a3); __builtin_amdgcn_s_setprio(0); \
    __builtin_amdgcn_sched_barrier(0); } while (0)
#define G3_STAGE(i, SET) do { \
    if (kt + (i) + 2 < nk) G256_STORE(SET, ((i) + 2) % 3); \
    if (kt + (i) + 4 < nk) G256_LOAD(SET, kt + (i) + 4); \
    if (kt + (i) < nk) G3_COMPUTE((i) % 3); \
    if (kt + (i) + 1 < nk) G3_PRELOAD(((i) + 1) % 3); \
    __syncthreads(); } while (0)
  G256_LOAD(x, 0);
  G256_LOAD(y, 1);
  __syncthreads();
  G256_STORE(x, 0);
  G256_LOAD(x, 2);
  G256_STORE(y, 1);
  G256_LOAD(y, 3);
  __syncthreads();
  G3_PRELOAD(0);
  for (int kt = 0; kt < nk; kt += 6) {
    G3_STAGE(0, x); G3_STAGE(1, y); G3_STAGE(2, x); G3_STAGE(3, y); G3_STAGE(4, x); G3_STAGE(5, y);
  }
}

__device__ __forceinline__ void gemm192(const u16* __restrict__ A, int lda, const u16* __restrict__ B, int ldb, int K,
                                        u16* lds, f32x4 (&acc)[6][4]) {
  const int tid = tid_l(), lane = tid & 63, w = tid >> 6, wm = w >> 1, wn = w & 1;
  const int r16 = lane & 15, g4 = lane >> 4;
#pragma unroll
  for (int i = 0; i < 6; ++i)
#pragma unroll
    for (int j = 0; j < 4; ++j) acc[i][j] = f32x4{0.f, 0.f, 0.f, 0.f};
  const int lrow = tid >> 2, lkc = tid & 3;
  const u16* ap = A + (size_t)lrow * lda + lkc * 8;
  const u16* bp = B + (size_t)lrow * ldb + lkc * 8;
  const size_t sa64 = (size_t)64 * lda, sb64 = (size_t)64 * ldb;
  const int woff = lrow * 32 + ((lkc ^ ((lrow >> 1) & 3)) * 8);
  const int fsw = (g4 ^ ((r16 >> 1) & 3)) * 8;
  const int faoff = (wm * 96 + r16) * 32 + fsw;
  const int fboff = 192 * 32 + (wn * 64 + r16) * 32 + fsw;
  const int nk = K >> 5;
  const int BUF = 320 * 32;
  uint4 xa0, xa1, xa2, xb0, xb1;
  uint4 ya0, ya1, ya2, yb0, yb1;
#define G192_LOAD(P, st) do { const u16* a2_ = ap + (st) * 32; const u16* b2_ = bp + (st) * 32; \
    P##a0 = *(const uint4*)(a2_); P##a1 = *(const uint4*)(a2_ + sa64); P##a2 = *(const uint4*)(a2_ + 2 * sa64); \
    P##b0 = *(const uint4*)(b2_); P##b1 = *(const uint4*)(b2_ + sb64); } while (0)
#define G192_STORE(P, buf) do { u16* wa_ = lds + (buf) * BUF + woff; u16* wb_ = wa_ + 192 * 32; \
    *(uint4*)(wa_) = P##a0; *(uint4*)(wa_ + 64 * 32) = P##a1; *(uint4*)(wa_ + 128 * 32) = P##a2; \
    *(uint4*)(wb_) = P##b0; *(uint4*)(wb_ + 64 * 32) = P##b1; } while (0)
#define G192_COMPUTE(buf) do { const u16* fa_ = lds + (buf) * BUF + faoff; const u16* fb_ = lds + (buf) * BUF + fboff; \
    bf16x8 bf0 = *(const bf16x8*)(fb_), bf1 = *(const bf16x8*)(fb_ + 16 * 32), bf2 = *(const bf16x8*)(fb_ + 32 * 32), bf3 = *(const bf16x8*)(fb_ + 48 * 32); \
    bf16x8 a0 = *(const bf16x8*)(fa_), a1 = *(const bf16x8*)(fa_ + 16 * 32), a2 = *(const bf16x8*)(fa_ + 32 * 32), a3 = *(const bf16x8*)(fa_ + 48 * 32); \
    __builtin_amdgcn_sched_barrier(0); __builtin_amdgcn_s_setprio(1); \
    G256_MM(0, a0); a0 = *(const bf16x8*)(fa_ + 64 * 32); __builtin_amdgcn_sched_barrier(0); \
    G256_MM(1, a1); a1 = *(const bf16x8*)(fa_ + 80 * 32); __builtin_amdgcn_sched_barrier(0); \
    G256_MM(2, a2); G256_MM(3, a3); G256_MM(4, a0); G256_MM(5, a1); __builtin_amdgcn_s_setprio(0); } while (0)
  G192_LOAD(x, 0);
  G192_LOAD(y, 1);
  __syncthreads();
  G192_STORE(x, 0);
  G192_LOAD(x, 2);
  __syncthreads();
  for (int kt = 0; kt < nk; kt += 2) {
    G192_STORE(y, 1);
    if (kt + 3 < nk) G192_LOAD(y, kt + 3);
    G192_COMPUTE(0);
    __syncthreads();
    if (kt + 2 < nk) {
      G192_STORE(x, 0);
      if (kt + 4 < nk) G192_LOAD(x, kt + 4);
    }
    G192_COMPUTE(1);
    __syncthreads();
  }
}
#define GEMM256_RC const int tde = tid_l(); const int rb = ((tde >> 6) >> 1) * 128 + (tde & 15), cb = ((tde >> 6) & 1) * 64 + ((tde & 63) >> 4) * 4;
#define GEMM_RC const int tde = tid_l(); const int rb = ((tde >> 6) >> 1) * 64 + (tde & 15), cb = ((tde >> 6) & 1) * 64 + ((tde & 63) >> 4) * 4;


__device__ __forceinline__ bool tile_at(int r, int Mt, int Nt, int& mt, int& nt) {
  const int x = blockIdx.x & 7, j = blockIdx.x >> 3, bpx = gridDim.x >> 3;
  const int mpx = Mt >> 3;
  const int q = r * bpx + j;
  if (q >= mpx * Nt) return false;
  const int full = (Nt >> 3) * (mpx * 8);
  int cb, rem, wcb;
  if (q < full) { cb = q / (mpx * 8); rem = q - cb * mpx * 8; wcb = 8; }
  else { cb = Nt >> 3; rem = q - full; wcb = Nt - cb * 8; }
  mt = x * mpx + rem / wcb;
  nt = cb * 8 + rem % wcb;
  return true;
}

__device__ __forceinline__ void phase_a(const Params& p, int l, u16* lds) {
  const u16* Bw = p.WinT + (size_t)l * 3072 * 1024;
  int mt, nt;
  for (int r = 0; tile_at(r, 144, 24, mt, nt); ++r) {
    const int m0 = mt * 256, n0 = nt * 128;
    f32x4 acc[8][4];
    gemm256(p.HQ + (size_t)m0 * 1024, 1024, Bw + (size_t)n0 * 1024, 1024, 1024, lds, acc);
    { GEMM256_RC
#pragma unroll
      for (int mi = 0; mi < 8; ++mi) {
        const int row = m0 + rb + mi * 16;
#pragma unroll
        for (int ni = 0; ni < 4; ++ni) {
          const int col = n0 + cb + ni * 16;
          *(uint2*)(p.P + (size_t)row * PW + col) = pack4(acc[mi][ni]);
          if (col >= P_GA && col < P_GA + 16)
            *(float4*)(p.GAB + (size_t)row * 16 + (col - P_GA)) = make_float4(acc[mi][ni][0], acc[mi][ni][1], acc[mi][ni][2], acc[mi][ni][3]);
        }
      }
    }
  }
}

__device__ __forceinline__ void phase_b1(const Params& p, int l, u16* lds) {
  int mt, nt;
  for (int pass = 0; pass < 2; ++pass) {
  for (int r = 0; tile_at(r, pass == 0 ? 288 : 304, pass == 0 ? 6 : 8, mt, nt); ++r) {
    if (pass == 0) {
      const int m0 = mt * 128, n0 = nt * 128;
      const float qscale = 0.07216878364870322f * 1.4426950408889634f;
      f32x4 acc[4][4];
      gemm128(p.P + (size_t)m0 * PW + P_MCQ, PW, p.WuqT + (size_t)l * 768 * 384 + (size_t)n0 * 384, 384, 384, lds, acc);
      { GEMM_RC
        const int g4 = (tde & 63) >> 4;
        const int cw0 = n0 + cb - g4 * 4;
        const bool ropew = ((cw0 >> 6) % 3) == 2 && m0 >= T_CTX;
#pragma unroll
        for (int mi = 0; mi < 4; ++mi) {
          const int row = m0 + rb + mi * 16;
          f32x4 v0 = acc[mi][0], v1 = acc[mi][1], v2 = acc[mi][2], v3 = acc[mi][3];
          if (ropew) {
            const int pos = (row - T_CTX) & 4095;
#pragma unroll
            for (int r = 0; r < 4; ++r) {
              const float inv = exp2f(-(float)(g4 * 4 + r) * (13.287712379549449f / 16.f));
              float s0, c0, s1, c1;
              __sincosf((float)(pos >> 6) * inv, &s0, &c0);
              __sincosf((float)(pos & 63) * inv, &s1, &c1);
              const float a0 = v0[r] * c0 - v1[r] * s0, a1 = v1[r] * c0 + v0[r] * s0;
              const float b0 = v2[r] * c1 - v3[r] * s1, b1 = v3[r] * c1 + v2[r] * s1;
              v0[r] = a0; v1[r] = a1; v2[r] = b0; v3[r] = b1;
            }
          }
          u16* qp = p.HQ + (size_t)row * 768 + n0 + cb;
          *(uint2*)(qp) = pack4(v0 * qscale); *(uint2*)(qp + 16) = pack4(v1 * qscale);
          *(uint2*)(qp + 32) = pack4(v2 * qscale); *(uint2*)(qp + 48) = pack4(v3 * qscale);
        }
      }
    } else {
      const int m0 = mt * 128, n0 = nt * 128;
      const u16* Ap; int lda;
      if (mt < 288) { Ap = p.P + (size_t)m0 * PW + P_MCKV; lda = PW; }
      else { Ap = p.CKVC + (size_t)(m0 - T_ALL) * 256; lda = 256; }
      f32x4 acc[4][4];
      gemm128(Ap, lda, p.WukvT + (size_t)l * 1024 * 256 + (size_t)n0 * 256, 256, 256, lds, acc);
      { GEMM_RC
#pragma unroll
        for (int mi = 0; mi < 4; ++mi) {
          const int row = m0 + rb + mi * 16;
          u16* vb; int vst;
          if (row < T_CTX) { int b = row >> 8, pos = row & 255; vb = p.VTC + (size_t)(b * 4) * 128 * 256 + pos; vst = 256; }
          else if (row < T_ALL) { int b = (row - T_CTX) >> 12, pos = (row - T_CTX) & 4095; vb = p.VTL + (size_t)(b * 4) * 128 * 4352 + pos; vst = 4352; }
          else { int b = (row - T_ALL) >> 8, pos = 4096 + ((row - T_ALL) & 255); vb = p.VTL + (size_t)(b * 4) * 128 * 4352 + pos; vst = 4352; }
#pragma unroll
          for (int ni = 0; ni < 4; ++ni) {
            const int col = n0 + cb + ni * 16;
            const int h = col >> 8, wi = col & 255;
            if (wi < 128) {
              *(uint2*)(p.KN + (size_t)row * 512 + h * 128 + wi) = pack4(acc[mi][ni]);
            } else {
              u16* dst = vb + (size_t)(h * 128 + (wi - 128)) * vst;
#pragma unroll
              for (int r = 0; r < 4; ++r) dst[(size_t)r * vst] = f2bf(acc[mi][ni][r]);
            }
          }
        }
      }
    }
  }
  }
}

__device__ __forceinline__ void phase_gemm_y(const u16* A, int lda, const u16* B, int K, int N, u16* Y, int ldy, u16* lds) {
  int mt, nt;
  for (int r = 0; tile_at(r, 192, N / 128, mt, nt); ++r) {
    const int m0 = mt * 192, n0 = nt * 128;
    f32x4 acc[6][4];
    gemm192(A + (size_t)m0 * lda, lda, B + (size_t)n0 * K, K, K, lds, acc);
    {
      const int tde = tid_l();
      const int rb = ((tde >> 6) >> 1) * 96 + (tde & 15), cb = ((tde >> 6) & 1) * 64 + ((tde & 63) >> 4) * 4;
#pragma unroll
      for (int mi = 0; mi < 6; ++mi)
#pragma unroll
        for (int ni = 0; ni < 4; ++ni)
          *(uint2*)(Y + (size_t)(m0 + rb + mi * 16) * ldy + n0 + cb + ni * 16) = pack4(acc[mi][ni]);
    }
  }
}

__device__ __forceinline__ void phase_e(const Params& p, int l, u16* lds) {
  const u16* Bw = p.WfiT + (size_t)l * 5632 * 1024;
  int mt, nt;
  for (int r = 0; tile_at(r, 144, 44, mt, nt); ++r) {
    const int m0 = mt * 256, n0 = nt * 128;
    f32x4 acc[8][4];
    gemm256(p.MIX + (size_t)m0 * 1024, 1024, Bw + (size_t)n0 * 1024, 1024, 1024, lds, acc);
    { GEMM256_RC
      const int g4x4 = ((tde & 63) >> 4) * 4;
      const int hc0 = ((n0 + cb - g4x4) >> 1) + g4x4;
#pragma unroll
      for (int mi = 0; mi < 8; ++mi)
#pragma unroll
        for (int ni = 0; ni < 2; ++ni) {
          f32x4 hv;
#pragma unroll
          for (int r = 0; r < 4; ++r) hv[r] = siluf_(acc[mi][ni][r]) * acc[mi][ni + 2][r];
          *(uint2*)(p.P + (size_t)(m0 + rb + mi * 16) * DFF + hc0 + ni * 16) = pack4(hv);
        }
    }
  }
}

#define KST 208
#define VST 80
#define PST 80
__device__ __forceinline__ void attn_item(const Params& p, int latent, int b, int h, int qb, unsigned char* smraw, int dummy = 0) {
  u16* sK = (u16*)smraw;
  u16* sV = sK + 64 * KST;
  u16* sP = sV + 128 * VST;
  const int tid = tid_l(), lane = tid & 63, w = tid >> 6, r16 = lane & 15, g4 = lane >> 4;
  const int nkeys = latent ? 4352 : 256;
  const int krow0 = latent ? T_CTX + b * 4096 : b * 256;
  const int tq0 = krow0 + qb * 128;
  const u16* vt = latent ? p.VTL + (size_t)((b * 4 + h) * 128) * 4352 : p.VTC + (size_t)((b * 4 + h) * 128) * 256;
  u16* sPw = sP + w * 32 * PST;
  bf16x8 q[2][6];
#pragma unroll
  for (int mi = 0; mi < 2; ++mi)
#pragma unroll
    for (int ks = 0; ks < 6; ++ks)
      q[mi][ks] = *(const bf16x8*)(p.HQ + (size_t)(tq0 + w * 32 + mi * 16 + r16) * 768 + h * 192 + ks * 32 + g4 * 8);
  f32x4 o[2][8];
  float mrow[2], lrow[2];
#pragma unroll
  for (int mi = 0; mi < 2; ++mi) {
#pragma unroll
    for (int nd = 0; nd < 8; ++nd) o[mi][nd] = f32x4{0.f, 0.f, 0.f, 0.f};
    mrow[mi] = -1e30f; lrow[mi] = 0.f;
  }
  const int lkey = tid >> 2, lpart = tid & 3;
  const int ldv = tid >> 1, lhalf = tid & 1;
  const int ntile = nkeys >> 6;
  uint4 k0, k1, k2, k3, k4, k5;
  {
    const int pos = lkey;
    const u16* srcn = p.KN + (size_t)(krow0 + pos) * 512 + h * 128 + lpart * 8;
    const u16* srcr = p.P + (size_t)(krow0 + pos) * PW + P_MKR + lpart * 8;
    k0 = *(const uint4*)(srcn); k1 = *(const uint4*)(srcn + 32); k2 = *(const uint4*)(srcn + 64); k3 = *(const uint4*)(srcn + 96);
    k4 = *(const uint4*)(srcr); k5 = *(const uint4*)(srcr + 32);
  }
  for (int kt = 0; kt < ntile; ++kt) {
    __syncthreads();
    {
      u16* dk = sK + lkey * KST + lpart * 8;
      *(uint4*)(dk) = k0; *(uint4*)(dk + 32) = k1; *(uint4*)(dk + 64) = k2; *(uint4*)(dk + 96) = k3;
      *(uint4*)(dk + 128) = k4; *(uint4*)(dk + 160) = k5;
    }
    const u16* sv = vt + (size_t)ldv * nkeys + kt * 64 + lhalf * 32;
    const uint4 v0 = *(const uint4*)(sv), v1 = *(const uint4*)(sv + 8), v2 = *(const uint4*)(sv + 16), v3 = *(const uint4*)(sv + 24);
    __syncthreads();
    f32x4 s[2][4];
#pragma unroll
    for (int mi = 0; mi < 2; ++mi)
#pragma unroll
      for (int ni = 0; ni < 4; ++ni) s[mi][ni] = f32x4{0.f, 0.f, 0.f, 0.f};
#pragma unroll
    for (int ks = 0; ks < 6; ++ks)
#pragma unroll
      for (int ni = 0; ni < 4; ++ni) {
        bf16x8 kf = *(const bf16x8*)(sK + (ni * 16 + r16) * KST + ks * 32 + g4 * 8);
        s[0][ni] = __builtin_amdgcn_mfma_f32_16x16x32_bf16(kf, q[0][ks], s[0][ni], 0, 0, 0);
        s[1][ni] = __builtin_amdgcn_mfma_f32_16x16x32_bf16(kf, q[1][ks], s[1][ni], 0, 0, 0);
      }
#pragma unroll
    for (int mi = 0; mi < 2; ++mi) {
      float mx = -1e30f;
#pragma unroll
      for (int ni = 0; ni < 4; ++ni)
#pragma unroll
        for (int r = 0; r < 4; ++r) mx = fmaxf(mx, s[mi][ni][r]);
      mx = fmaxf(mx, __shfl_xor(mx, 16)); mx = fmaxf(mx, __shfl_xor(mx, 32));
      const float mnew = fmaxf(mrow[mi], mx);
      const float alpha = __builtin_amdgcn_exp2f(mrow[mi] - mnew);
      mrow[mi] = mnew;
      float ps = 0.f;
#pragma unroll
      for (int ni = 0; ni < 4; ++ni) {
        f32x4 pv;
#pragma unroll
        for (int r = 0; r < 4; ++r) { pv[r] = __builtin_amdgcn_exp2f(s[mi][ni][r] - mnew); ps += pv[r]; }
        *(uint2*)(sPw + (mi * 16 + r16) * PST + ni * 16 + g4 * 4) = pack4(pv);
      }
      ps += __shfl_xor(ps, 16); ps += __shfl_xor(ps, 32);
      lrow[mi] = lrow[mi] * alpha + ps;
#pragma unroll
      for (int nd = 0; nd < 8; ++nd) o[mi][nd] *= alpha;
    }
    {
      u16* dvp = sV + ldv * VST + lhalf * 32;
      *(uint4*)(dvp) = v0; *(uint4*)(dvp + 8) = v1; *(uint4*)(dvp + 16) = v2; *(uint4*)(dvp + 24) = v3;
    }
    __syncthreads();
    if (kt + 1 < ntile) {
      const int pos = (kt + 1) * 64 + lkey;
      const bool own = (!latent) || pos < 4096;
      const int row = own ? krow0 + pos : T_ALL + b * 256 + (pos - 4096);
      const u16* srcn = p.KN + (size_t)row * 512 + h * 128 + lpart * 8;
      const u16* srcr = own ? p.P + (size_t)(krow0 + pos) * PW + P_MKR + lpart * 8
                            : p.KRC + (size_t)(b * 256 + pos - 4096) * 64 + lpart * 8;
      k0 = *(const uint4*)(srcn); k1 = *(const uint4*)(srcn + 32); k2 = *(const uint4*)(srcn + 64); k3 = *(const uint4*)(srcn + 96);
      k4 = *(const uint4*)(srcr); k5 = *(const uint4*)(srcr + 32);
    }
#pragma unroll
    for (int ks2 = 0; ks2 < 2; ++ks2) {
      bf16x8 pf0 = *(const bf16x8*)(sPw + (0 * 16 + r16) * PST + ks2 * 32 + g4 * 8);
      bf16x8 pf1 = *(const bf16x8*)(sPw + (1 * 16 + r16) * PST + ks2 * 32 + g4 * 8);
#pragma unroll
      for (int nd = 0; nd < 8; ++nd) {
        bf16x8 vf = *(const bf16x8*)(sV + (nd * 16 + r16) * VST + ks2 * 32 + g4 * 8);
        o[0][nd] = __builtin_amdgcn_mfma_f32_16x16x32_bf16(vf, pf0, o[0][nd], 0, 0, 0);
        o[1][nd] = __builtin_amdgcn_mfma_f32_16x16x32_bf16(vf, pf1, o[1][nd], 0, 0, 0);
      }
    }
  }
#pragma unroll
  for (int mi = 0; mi < 2; ++mi) {
    const float inv = 1.f / lrow[mi];
    const int qrow = tq0 + w * 32 + mi * 16 + r16;
    u16* op = p.HQ + (size_t)qrow * 768 + h * 192 + g4 * 4;
    if (dummy) op = p.HQ + (size_t)T_ALL * 768 + (size_t)(qrow % 9216) * 768 + h * 192 + g4 * 4;
#pragma unroll
    for (int nd = 0; nd < 8; ++nd) *(uint2*)(op + nd * 16) = pack4(o[mi][nd] * inv);
  }
}

#define XB_TMO      128
#define XB_XCNT(j)  (256  + 64 * (j))
#define XB_XSUB(j)  (1280 + 64 * (j))
#define XB_XGEN(j)  (2304 + 64 * (j))
#define XB_TOP      3328
#define XB_TOPGEN   3392
#define XCD_BAR_WORDS 3456
#define XB_SPIN_CAP (1u << 23)
#define LAS __attribute__((address_space(3)))

__device__ __forceinline__ unsigned xb_ld(unsigned* p)              { return __hip_atomic_load(p, __ATOMIC_RELAXED, __HIP_MEMORY_SCOPE_AGENT); }
__device__ __forceinline__ unsigned xb_add(unsigned* p, unsigned v) { return __hip_atomic_fetch_add(p, v, __ATOMIC_RELAXED, __HIP_MEMORY_SCOPE_AGENT); }
__device__ __forceinline__ unsigned xb_xcc_id() { return (unsigned)__builtin_amdgcn_s_getreg((3 << 11) | 20) & 0xFu; }
#define XB_SPIN(cond, bar) do { unsigned _sp = 0; while (cond) { __builtin_amdgcn_s_sleep(1); \
    if ((++_sp & 255u) == 0u) { if (xb_ld(&(bar)[XB_TMO])) break; if (_sp > XB_SPIN_CAP) { atomicAdd(&(bar)[XB_TMO], 1u); break; } } } } while (0)

struct XcdBarrier {
    unsigned* bar; unsigned x;
    volatile LAS unsigned* st;
};

__device__ __forceinline__ XcdBarrier xcd_barrier_post(unsigned* bar, volatile LAS unsigned* st) {
    XcdBarrier b; b.bar = bar; b.x = xb_xcc_id(); b.st = st;
    if (threadIdx.x == 0) (void)xb_add(&bar[XB_XCNT(b.x)], 1u);
    return b;
}
__device__ __forceinline__ void xcd_barrier_complete(unsigned* bar, unsigned x, unsigned& nloc, unsigned& nx) {
    const unsigned G = gridDim.x * gridDim.y * gridDim.z;
    unsigned sum, cnt, mine, sp = 0u;
    for (;;) {
        sum = 0u; cnt = 0u; mine = 0u;
#pragma unroll
        for (unsigned j = 0; j < 16; ++j) { const unsigned c = xb_ld(&bar[XB_XCNT(j)]); sum += c; cnt += (c > 0u) ? 1u : 0u; mine = (j == x) ? c : mine; }
        if (sum == G) break;
        __builtin_amdgcn_s_sleep(1);
        if ((++sp & 255u) == 0u) { if (xb_ld(&bar[XB_TMO])) break; if (sp > XB_SPIN_CAP) { atomicAdd(&bar[XB_TMO], 1u); break; } }
    }
    nloc = mine > 0u ? mine : 1u; nx = cnt > 0u ? cnt : 1u;
}

__device__ __forceinline__ void xcd_barrier(const XcdBarrier& b) {
    asm volatile("s_waitcnt vmcnt(0)" ::: "memory");
    __syncthreads();
    if (threadIdx.x == 0) {
        unsigned* bar = b.bar;
        __builtin_amdgcn_s_waitcnt(0);
        unsigned nloc = b.st[0], nx = b.st[1];
        if (nloc == 0u) { xcd_barrier_complete(bar, b.x, nloc, nx); b.st[0] = nloc; b.st[1] = nx; }
        const unsigned old = xb_add(&bar[XB_XSUB(b.x)], 1u);
        const unsigned gen = old / nloc;
        if (old + 1u == (gen + 1u) * nloc) {
            __builtin_amdgcn_fence(__ATOMIC_RELEASE, "agent");
            asm volatile("s_waitcnt vmcnt(0)" ::: "memory");
            const unsigned og = xb_add(&bar[XB_TOP], 1u);
            const unsigned tg = og / nx;
            if (og + 1u == (tg + 1u) * nx) xb_add(&bar[XB_TOPGEN], 1u);
            else XB_SPIN(xb_ld(&bar[XB_TOPGEN]) == tg, bar);
            __builtin_amdgcn_fence(__ATOMIC_ACQUIRE, "agent");
            xb_add(&bar[XB_XGEN(b.x)], 1u);
            asm volatile("s_waitcnt vmcnt(0)" ::: "memory");
        } else {
            XB_SPIN(xb_ld(&bar[XB_XGEN(b.x)]) == gen, bar);
            __builtin_amdgcn_fence(__ATOMIC_ACQUIRE, "agent");
            asm volatile("s_waitcnt vmcnt(0)" ::: "memory");
        }
    }
    __syncthreads();
}


__device__ __forceinline__ void gbar(unsigned* ctr, unsigned target) {
  asm volatile("s_waitcnt vmcnt(0)" ::: "memory");
  __syncthreads();
  if (tid_l() == 0) {
    __builtin_amdgcn_fence(__ATOMIC_RELEASE, "agent");
    asm volatile("s_waitcnt vmcnt(0)" ::: "memory");
    __hip_atomic_fetch_add(ctr, 1u, __ATOMIC_RELAXED, __HIP_MEMORY_SCOPE_AGENT);
    while (__hip_atomic_load(ctr, __ATOMIC_RELAXED, __HIP_MEMORY_SCOPE_AGENT) < target) __builtin_amdgcn_s_sleep(2);
    __builtin_amdgcn_fence(__ATOMIC_ACQUIRE, "agent");
    asm volatile("s_waitcnt vmcnt(0)" ::: "memory");
  }
  __syncthreads();
}
#define MFMA4(a, b, c) __builtin_amdgcn_mfma_f32_16x16x4f32((a), (b), (c), 0, 0, 0)

__device__ __forceinline__ float softplusf_(float x) { return fmaxf(x, 0.f) + log1pf(__expf(-fabsf(x))); }

__device__ __forceinline__ void gdn_chain(const Params& p, int l, int seq, int h, int d, int vs, float* sm) {
  float* sMM = sm;
  float* sK = sMM + 64 * 68;
  u16* sQb = (u16*)(sK + 64 * 65);
  u16* sKb = sQb + 64 * 80;
  float* sV = (float*)(sKb + 64 * 80);
  float* sS = sV + 64 * 33;
  float* sGc = sS + 64 * 33;
  float* sBeta = sGc + 64;
  float* sBg = sBeta + 64;
  u16* sSb = (u16*)(sBg + 64);
  const int tid = tid_l(), lane = tid & 63, w = tid >> 6, r16 = lane & 15, g4 = lane >> 4;
  const bool latent = seq >= 16;
  const int len = latent ? 4096 : 256;
  const int t0 = latent ? T_CTX + (seq - 16) * 4096 : seq * 256;
  const int nchunks = len >> 6;
  const float Acoef = -__expf(p.gdn_a_log[l * 8 + d * 4 + h]);
  const float dtb = p.gdn_dt_bias[l * 8 + d * 4 + h];
  f32x4 Sreg[2];
  __syncthreads();
  {
    const float* s0 = latent ? p.state_gdn + ((((size_t)(seq - 16) * 2 + l) * 2 + d) * 4 + h) * 4096 : nullptr;
#pragma unroll
    for (int n = 0; n < 2; ++n)
#pragma unroll
      for (int r = 0; r < 4; ++r) {
        const int kidx = 16 * w + g4 * 4 + r, cc = n * 16 + r16;
        float v = latent ? s0[kidx * 64 + vs * 32 + cc] : 0.f;
        Sreg[n][r] = v;
        sS[kidx * 33 + cc] = v;
      }
#pragma unroll
    for (int n = 0; n < 2; ++n) *(uint2*)(sSb + (n * 16 + r16) * 80 + 16 * w + g4 * 4) = pack4(Sreg[n]);
  }
  const u16* Pb = p.P + (size_t)t0 * PW;
  const u16* VHb = p.HQ + (size_t)T_ALL * 768 + (size_t)t0 * 256;
#define GDN_SRC(i, tl, tlo_) ({ const int e_ = (tl) + (i) * 256; const int u_ = e_ / 20, un_ = e_ % 20; \
    (un_ < 16) ? (Pb + (size_t)((tlo_) + u_) * PW + (un_ < 8 ? P_QH + h * 64 + un_ * 8 : P_KH + h * 64 + (un_ - 8) * 8)) \
               : (VHb + (size_t)((tlo_) + u_) * 256 + h * 64 + vs * 32 + (un_ - 16) * 8); })
  uint4 pf[5];
  float pga = 0.f, pgb = 0.f;
  {
    const int tlo = d == 0 ? 0 : len - 64;
#pragma unroll
    for (int i = 0; i < 5; ++i) pf[i] = *(const uint4*)GDN_SRC(i, tid, tlo);
    if (tid < 64) {
      const int u = d == 0 ? tid : 63 - tid;
      const float* gab = p.GAB + (size_t)(t0 + tlo + u) * 16;
      pga = gab[d * 4 + h]; pgb = gab[8 + d * 4 + h];
    }
  }
  for (int n = 0; n < nchunks; ++n) {
    const int tlo = d == 0 ? n * 64 : len - 64 * (n + 1);
    const int tl2 = tid_l();
#pragma unroll
    for (int i = 0; i < 5; ++i) {
      const int e = tl2 + i * 256;
      const int u = e / 20, un = e % 20;
      const int pp = d == 0 ? u : 63 - u;
      if (un < 8) { *(uint4*)(sQb + pp * 80 + un * 8) = pf[i]; }
      else {
        if (un < 16) *(uint4*)(sKb + pp * 80 + (un - 8) * 8) = pf[i];
        float* dq = un < 16 ? sK + pp * 65 + (un - 8) * 8 : sV + pp * 33 + (un - 16) * 8;
        const unsigned wv[4] = {pf[i].x, pf[i].y, pf[i].z, pf[i].w};
#pragma unroll
        for (int j = 0; j < 4; ++j) { dq[2 * j] = bf2f((u16)(wv[j] & 0xffff)); dq[2 * j + 1] = bf2f((u16)(wv[j] >> 16)); }
      }
    }
    if (tid < 64) {
      const int pp = tid;
      float g = Acoef * softplusf_(pga + dtb);
      float bt = sigmoidf_(pgb);
#pragma unroll
      for (int o = 1; o < 64; o <<= 1) { float tt = __shfl_up(g, o); if (lane >= o) g += tt; }
      sGc[pp] = g; sBeta[pp] = bt; sBg[pp] = bt * __expf(g);
    }
    if (n + 1 < nchunks) {
      const int tlo2 = d == 0 ? (n + 1) * 64 : len - 64 * (n + 2);
#pragma unroll
      for (int i = 0; i < 5; ++i) pf[i] = *(const uint4*)GDN_SRC(i, tl2, tlo2);
      if (tid < 64) {
        const int u = d == 0 ? tid : 63 - tid;
        const float* gab = p.GAB + (size_t)(t0 + tlo2 + u) * 16;
        pga = gab[d * 4 + h]; pgb = gab[8 + d * 4 + h];
      }
    }
    __syncthreads();
    const unsigned tcode = w == 0 ? 0x730u : (w == 1 ? 0xA51u : (w == 2 ? 0x062u : 0x0FBu));
    const int tcnt = w < 2 ? 3 : 2;
    f32x4 attacc[3];
#pragma unroll
    for (int t = 0; t < 3; ++t) {
      attacc[t] = f32x4{0.f, 0.f, 0.f, 0.f};
      if (t < tcnt) {
        const int ti = (tcode >> (4 * t)) & 3, tn = (tcode >> (4 * t + 2)) & 3;
        f32x4 accm = f32x4{0.f, 0.f, 0.f, 0.f};
        const u16* akb = sKb + (16 * ti + r16) * 80 + g4 * 8;
        const u16* aqb = sQb + (16 * ti + r16) * 80 + g4 * 8;
        const u16* bkb = sKb + (16 * tn + r16) * 80 + g4 * 8;
        const bf16x8 ak0 = *(const bf16x8*)(akb), ak1 = *(const bf16x8*)(akb + 32);
        const bf16x8 aq0 = *(const bf16x8*)(aqb), aq1 = *(const bf16x8*)(aqb + 32);
        const bf16x8 bk0 = *(const bf16x8*)(bkb), bk1 = *(const bf16x8*)(bkb + 32);
        accm = __builtin_amdgcn_mfma_f32_16x16x32_bf16(ak0, bk0, accm, 0, 0, 0);
        accm = __builtin_amdgcn_mfma_f32_16x16x32_bf16(ak1, bk1, accm, 0, 0, 0);
        attacc[t] = __builtin_amdgcn_mfma_f32_16x16x32_bf16(aq0, bk0, attacc[t], 0, 0, 0);
        attacc[t] = __builtin_amdgcn_mfma_f32_16x16x32_bf16(aq1, bk1, attacc[t], 0, 0, 0);
#pragma unroll
        for (int r = 0; r < 4; ++r) {
          const int i = 16 * ti + g4 * 4 + r, j = 16 * tn + r16;
          sMM[i * 68 + j] = (i > j) ? sBeta[i] * accm[r] * __expf(sGc[i] - sGc[j]) : 0.f;
        }
      }
    }
    __syncthreads();
    if (w == 0) {
      const int bi = tid >> 4, c = tid & 15;
      float* md = sMM + (16 * bi) * 68 + 16 * bi;
      float a[16];
#pragma unroll
      for (int r = 0; r < 16; ++r) a[r] = (r == c) ? 1.f : 0.f;
#pragma unroll
      for (int r = 1; r < 16; ++r) {
#pragma unroll
        for (int q4 = 0; q4 < (r + 3) / 4; ++q4) {
          const float4 m = *(const float4*)(md + r * 68 + 4 * q4);
          if (q4 * 4 + 0 < r) a[r] -= m.x * a[q4 * 4 + 0];
          if (q4 * 4 + 1 < r) a[r] -= m.y * a[q4 * 4 + 1];
          if (q4 * 4 + 2 < r) a[r] -= m.z * a[q4 * 4 + 2];
          if (q4 * 4 + 3 < r) a[r] -= m.w * a[q4 * 4 + 3];
        }
      }
      __builtin_amdgcn_fence(__ATOMIC_SEQ_CST, "wavefront");
#pragma unroll
      for (int r = 0; r < 16; ++r) md[r * 68 + c] = a[r];
    } else {
      for (int t = w - 1; t < 8; t += 3) {
        const int ti = t >> 1, tc = t & 1;
        const u16* akb = sKb + (16 * ti + r16) * 80 + g4 * 8;
        const u16* bsb = sSb + (16 * tc + r16) * 80 + g4 * 8;
        f32x4 acc = f32x4{0.f, 0.f, 0.f, 0.f};
        acc = __builtin_amdgcn_mfma_f32_16x16x32_bf16(*(const bf16x8*)(akb), *(const bf16x8*)(bsb), acc, 0, 0, 0);
        acc = __builtin_amdgcn_mfma_f32_16x16x32_bf16(*(const bf16x8*)(akb + 32), *(const bf16x8*)(bsb + 32), acc, 0, 0, 0);
#pragma unroll
        for (int r = 0; r < 4; ++r) {
          const int i = 16 * ti + g4 * 4 + r, cc = 16 * tc + r16;
          sV[i * 33 + cc] = sV[i * 33 + cc] * sBeta[i] - sBg[i] * acc[r];
        }
      }
    }
    __syncthreads();
    for (int ib = 0; ib < 4; ++ib) {
      if (w < 2) {
        const int ct = w;
        f32x4 acc = f32x4{0.f, 0.f, 0.f, 0.f};
        const float* am = sMM + (16 * ib + r16) * 68 + g4;
        const float* bx = sV + g4 * 33 + 16 * ct + r16;
        for (int s4 = 0; s4 < ib; ++s4) {
#pragma unroll
          for (int s = 0; s < 4; ++s) acc = MFMA4(am[16 * s4 + 4 * s], bx[(16 * s4 + 4 * s) * 33], acc);
        }
        f32x4 rm;
#pragma unroll
        for (int r = 0; r < 4; ++r) rm[r] = sV[(16 * ib + g4 * 4 + r) * 33 + 16 * ct + r16] - acc[r];
        const float* dd = sMM + (16 * ib + r16) * 68 + 16 * ib + 4 * g4;
        f32x4 xn = f32x4{0.f, 0.f, 0.f, 0.f};
#pragma unroll
        for (int s = 0; s < 4; ++s) xn = MFMA4(dd[s], rm[s], xn);
#pragma unroll
        for (int r = 0; r < 4; ++r) sV[(16 * ib + g4 * 4 + r) * 33 + 16 * ct + r16] = xn[r];
        __builtin_amdgcn_fence(__ATOMIC_SEQ_CST, "wavefront");
      }
    }
    __syncthreads();
#pragma unroll
    for (int t = 0; t < 3; ++t) {
      if (t < tcnt) {
        const int ti = (tcode >> (4 * t)) & 3, tn = (tcode >> (4 * t + 2)) & 3;
#pragma unroll
        for (int r = 0; r < 4; ++r) {
          const int i = 16 * ti + g4 * 4 + r, j = 16 * tn + r16;
          sMM[i * 68 + j] = (i >= j) ? attacc[t][r] * __expf(sGc[i] - sGc[j]) : 0.f;
        }
      }
    }
    __syncthreads();
    {
      f32x4 acc[2] = {f32x4{0.f, 0.f, 0.f, 0.f}, f32x4{0.f, 0.f, 0.f, 0.f}};
      const float eg = __expf(sGc[16 * w + r16]);
      {
        const u16* qb = sQb + (16 * w + r16) * 80 + g4 * 8;
        const bf16x8 q0 = *(const bf16x8*)(qb), q1 = *(const bf16x8*)(qb + 32);
#pragma unroll
        for (int nn = 0; nn < 2; ++nn) {
          const u16* sb = sSb + (16 * nn + r16) * 80 + g4 * 8;
          acc[nn] = __builtin_amdgcn_mfma_f32_16x16x32_bf16(*(const bf16x8*)(sb), q0, acc[nn], 0, 0, 0);
          acc[nn] = __builtin_amdgcn_mfma_f32_16x16x32_bf16(*(const bf16x8*)(sb + 32), q1, acc[nn], 0, 0, 0);
          acc[nn] *= eg;
        }
      }
#pragma unroll
      for (int s = 0; s < 16; ++s) {
        if (s < 4 * (w + 1)) {
          const float a = sMM[(16 * w + r16) * 68 + 4 * s + g4];
          acc[0] = MFMA4(sV[(4 * s + g4) * 33 + r16], a, acc[0]);
          acc[1] = MFMA4(sV[(4 * s + g4) * 33 + 16 + r16], a, acc[1]);
        }
      }
      {
        const int pp = 16 * w + r16;
        const int u = d == 0 ? pp : 63 - pp;
        u16* op = p.MIX + (size_t)(t0 + tlo + u) * 1024 + d * 256 + h * 64 + vs * 32 + g4 * 4;
        *(uint2*)(op) = pack4(acc[0]);
        *(uint2*)(op + 16) = pack4(acc[1]);
      }
    }
    __syncthreads();
    {
      const float g63 = sGc[63];
      const float gl = __expf(g63);
#pragma unroll
      for (int nn = 0; nn < 2; ++nn)
#pragma unroll
        for (int r = 0; r < 4; ++r) Sreg[nn][r] *= gl;
#pragma unroll
      for (int s = 0; s < 16; ++s) {
        const int srow = 4 * s + g4;
        const float a = sK[srow * 65 + 16 * w + r16] * __expf(g63 - sGc[srow]);
        Sreg[0] = MFMA4(a, sV[srow * 33 + r16], Sreg[0]);
        Sreg[1] = MFMA4(a, sV[srow * 33 + 16 + r16], Sreg[1]);
      }
    }
    __syncthreads();
#pragma unroll
    for (int nn = 0; nn < 2; ++nn) *(uint2*)(sSb + (nn * 16 + r16) * 80 + 16 * w + g4 * 4) = pack4(Sreg[nn]);
    __syncthreads();
  }
  if (!latent) {
    float* so = p.out + OUT_SGDN + ((((size_t)seq * 2 + l) * 2 + d) * 4 + h) * 4096;
#pragma unroll
    for (int nn = 0; nn < 2; ++nn)
#pragma unroll
      for (int r = 0; r < 4; ++r) so[(16 * w + g4 * 4 + r) * 64 + vs * 32 + nn * 16 + r16] = Sreg[nn][r];
  }
}

__device__ __forceinline__ void hgrn_chain(const Params& p, int l, int seq, int h, int d, int vs, float* sm) {
  float* sBC = sm;
  float* sK = sBC + 64 * 65;
  float* sAT = sK + 64 * 65;
  float* sV = sAT + 64 * 68;
  float* sS = sV + 64 * 33;
  float* sTot = sS + 64 * 33;
  u16* sSb = (u16*)(sTot + 256 + 64);
  const int tid = tid_l(), lane = tid & 63, w = tid >> 6, r16 = lane & 15, g4 = lane >> 4;
  const bool latent = seq >= 16;
  const int len = latent ? 4096 : 256;
  const int t0 = latent ? T_CTX + (seq - 16) * 4096 : seq * 256;
  const int nchunks = len >> 6;
  float lbk;
  {
    const int kch = h * 64 + (tid & 63);
    lbk = (l == 0) ? 0.f : sigmoidf_(p.hgrn_lb[256 + kch] - p.hgrn_lb[kch]);
  }
  f32x4 Sreg[2];
  __syncthreads();
  {
    const float* s0 = latent ? p.state_hgrn + ((((size_t)(seq - 16) * 2 + l) * 2 + d) * 4 + h) * 4096 : nullptr;
#pragma unroll
    for (int n = 0; n < 2; ++n)
#pragma unroll
      for (int r = 0; r < 4; ++r) {
        const int kidx = 16 * w + g4 * 4 + r, cc = n * 16 + r16;
        float v = latent ? s0[kidx * 64 + vs * 32 + cc] : 0.f;
        Sreg[n][r] = v;
        sS[kidx * 33 + cc] = v;
      }
#pragma unroll
    for (int n = 0; n < 2; ++n) *(uint2*)(sSb + (n * 16 + r16) * 80 + 16 * w + g4 * 4) = pack4(Sreg[n]);
  }
  const u16* Pb = p.P + (size_t)t0 * PW;
  float* sLb = sTot + 256;
  if (tid < 64) sLb[tid] = lbk;
  __syncthreads();
  int pgo[5];
#pragma unroll
  for (int i = 0; i < 5; ++i) {
    const int e = tid + i * 256;
    const int u = e / 20, un = e % 20;
    pgo[i] = u * PW + (un < 8 ? P_HF + d * 256 + h * 64 + un * 8 : (un < 12 ? P_HI + h * 64 + vs * 32 + (un - 8) * 8 : P_HQ + h * 64 + (un - 12) * 8));
  }
  uint4 pf[5];
  {
    const int tlo = d == 0 ? 0 : len - 64;
#pragma unroll
    for (int i = 0; i < 5; ++i) pf[i] = *(const uint4*)(Pb + (size_t)tlo * PW + pgo[i]);
  }
  for (int n = 0; n < nchunks; ++n) {
#pragma unroll
    for (int i = 0; i < 5; ++i) {
      const int e = tid + i * 256;
      const int u = e / 20, un = e % 20;
      const int pp = d == 0 ? u : 63 - u;
      const unsigned wv[4] = {pf[i].x, pf[i].y, pf[i].z, pf[i].w};
#pragma unroll
      for (int j = 0; j < 8; ++j) {
        const float x = bf2f((u16)((wv[j >> 1] >> ((j & 1) * 16)) & 0xffff));
        if (un < 8) {
          const int k = un * 8 + j;
          const float lb = sLb[k];
          const float sg_ = sigmoidf_(x);
          const float gate = lb + (1.f - lb) * sg_;
          sBC[pp * 65 + k] = __logf(fmaxf(gate, 1e-30f));
          sK[pp * 65 + k] = (1.f - lb) * (1.f - sg_);
        } else if (un < 12) {
          sV[pp * 33 + (un - 8) * 8 + j] = x;
        } else {
          sAT[pp * 68 + (un - 12) * 8 + j] = x;
        }
      }
    }
    __syncthreads();
    if (n + 1 < nchunks) {
      const int tlo2 = d == 0 ? (n + 1) * 64 : len - 64 * (n + 2);
#pragma unroll
      for (int i = 0; i < 5; ++i) pf[i] = *(const uint4*)(Pb + (size_t)tlo2 * PW + pgo[i]);
    }
    const int tlo = d == 0 ? n * 64 : len - 64 * (n + 1);
    float cs[16];
    {
      const int k = tid & 63, sg = tid >> 6;
      float run = 0.f;
#pragma unroll
      for (int i = 0; i < 16; ++i) { run += sBC[(16 * sg + i) * 65 + k]; cs[i] = run; }
      sTot[sg * 64 + k] = run;
    }
    float qa[16];
#pragma unroll
    for (int s = 0; s < 16; ++s) qa[s] = sAT[(16 * w + r16) * 68 + 4 * s + g4];
    __syncthreads();
    {
      const int k = tid & 63, sg = tid >> 6;
      float off = 0.f;
      for (int s2 = 0; s2 < sg; ++s2) off += sTot[s2 * 64 + k];
#pragma unroll
      for (int i = 0; i < 16; ++i) sBC[(16 * sg + i) * 65 + k] = cs[i] + off;
    }
    __syncthreads();
    f32x4 o1[2] = {f32x4{0.f, 0.f, 0.f, 0.f}, f32x4{0.f, 0.f, 0.f, 0.f}};
    {
      const float* qrow = sAT + (16 * w + r16) * 68 + g4 * 8;
      const float* bcrow = sBC + (16 * w + r16) * 65 + g4 * 8;
      bf16x8 af[2];
#pragma unroll
      for (int ks = 0; ks < 2; ++ks) {
        float v[8];
#pragma unroll
        for (int j = 0; j < 8; ++j) v[j] = qrow[ks * 32 + j] * __expf(bcrow[ks * 32 + j]);
        af[ks] = __builtin_bit_cast(bf16x8, pack8(v));
      }
#pragma unroll
      for (int nn = 0; nn < 2; ++nn) {
        const u16* sb = sSb + (16 * nn + r16) * 80 + g4 * 8;
        o1[nn] = __builtin_amdgcn_mfma_f32_16x16x32_bf16(*(const bf16x8*)(sb), af[0], o1[nn], 0, 0, 0);
        o1[nn] = __builtin_amdgcn_mfma_f32_16x16x32_bf16(*(const bf16x8*)(sb + 32), af[1], o1[nn], 0, 0, 0);
      }
    }
    {
      float aq[16], rf[16];
#pragma unroll
      for (int s = 0; s < 16; ++s) {
        const int kk = 4 * s + g4;
        rf[s] = (w == 0) ? 0.f : sBC[(16 * w - 1) * 65 + kk];
        aq[s] = qa[s] * __expf(sBC[(16 * w + r16) * 65 + kk] - rf[s]);
      }
#pragma unroll
      for (int nn = 0; nn < 4; ++nn) {
        f32x4 acc = f32x4{0.f, 0.f, 0.f, 0.f};
        if (nn <= w) {
#pragma unroll
          for (int s = 0; s < 16; ++s) {
            const int kk = 4 * s + g4, sc = 16 * nn + r16;
            const float bv = sK[sc * 65 + kk] * __expf(fminf(rf[s] - sBC[sc * 65 + kk], 80.f));
            acc = MFMA4(aq[s], bv, acc);
          }
        }
#pragma unroll
        for (int r = 0; r < 4; ++r) {
          const int i = 16 * w + g4 * 4 + r, j = 16 * nn + r16;
          sAT[i * 68 + j] = (i >= j) ? acc[r] : 0.f;
        }
      }
    }
    __syncthreads();
    {
      f32x4 acc[2] = {o1[0], o1[1]};
#pragma unroll
      for (int s = 0; s < 16; ++s) {
        if (s < 4 * (w + 1)) {
          const float a = sAT[(16 * w + r16) * 68 + 4 * s + g4];
          acc[0] = MFMA4(sV[(4 * s + g4) * 33 + r16], a, acc[0]);
          acc[1] = MFMA4(sV[(4 * s + g4) * 33 + 16 + r16], a, acc[1]);
        }
      }
      {
        const int pp = 16 * w + r16;
        const int u = d == 0 ? pp : 63 - pp;
        u16* op = p.MIX + (size_t)(t0 + tlo + u) * 1024 + 512 + d * 256 + h * 64 + vs * 32 + g4 * 4;
        *(uint2*)(op) = pack4(acc[0]);
        *(uint2*)(op + 16) = pack4(acc[1]);
      }
    }
    __syncthreads();
    {
#pragma unroll
      for (int nn = 0; nn < 2; ++nn)
#pragma unroll
        for (int r = 0; r < 4; ++r) Sreg[nn][r] *= __expf(sBC[63 * 65 + 16 * w + g4 * 4 + r]);
      const int kA = 16 * w + r16;
      const float blA = sBC[63 * 65 + kA];
#pragma unroll
      for (int s = 0; s < 16; ++s) {
        const int srow = 4 * s + g4;
        const float a = sK[srow * 65 + kA] * __expf(blA - sBC[srow * 65 + kA]);
        Sreg[0] = MFMA4(a, sV[srow * 33 + r16], Sreg[0]);
        Sreg[1] = MFMA4(a, sV[srow * 33 + 16 + r16], Sreg[1]);
      }
    }
    __syncthreads();
#pragma unroll
    for (int nn = 0; nn < 2; ++nn) *(uint2*)(sSb + (nn * 16 + r16) * 80 + 16 * w + g4 * 4) = pack4(Sreg[nn]);
    __syncthreads();
  }
  if (!latent) {
    float* so = p.out + OUT_SHG + ((((size_t)seq * 2 + l) * 2 + d) * 4 + h) * 4096;
#pragma unroll
    for (int nn = 0; nn < 2; ++nn)
#pragma unroll
      for (int r = 0; r < 4; ++r) so[(16 * w + g4 * 4 + r) * 64 + vs * 32 + nn * 16 + r16] = Sreg[nn][r];
  }
}

__device__ __forceinline__ void phase_c(const Params& p, int l, unsigned char* smraw, int mode = 0) {
  __shared__ int s_item;
  const int total = 1920;
  const bool paired = (gridDim.x == 512);
  const int jx = blockIdx.x >> 3;
  int my_static = -1;
  if (paired && (jx & 31) < 16) my_static = (blockIdx.x & 7) * 32 + (jx & 15) * 2 + (jx >> 5);
  for (;;) {
    __syncthreads();
    if (tid_l() == 0) {
      if (my_static >= 0) s_item = my_static;
      else s_item = (paired ? 256 : 0) + (int)atomicAdd(&p.counters[l * 64 + mode * 16], 1u);
    }
    __syncthreads();
    my_static = -1;
    const int item = s_item;
    if (item >= total) break;
    int kind, a0, a1, a2, a3;
    if (item < 256 || (item >= 1280 && item < 1792)) {
      const int i2 = item < 256 ? item : item - 1280;
      const int rest = i2 >> 1;
      kind = i2 & 1;
      a3 = rest & 1; a2 = (rest >> 1) & 1; a1 = (rest >> 2) & 3; a0 = (rest >> 4) + (item < 256 ? 16 : 0);
    } else if (item < 1280) {
      const int i2 = item - 256;
      kind = 2; a0 = 1; a1 = i2 >> 7; a2 = (i2 >> 5) & 3; a3 = i2 & 31;
    } else {
      const int i2 = item - 1792;
      kind = 2; a0 = 0; a1 = i2 >> 3; a2 = (i2 >> 1) & 3; a3 = i2 & 1;
    }
    if (mode == 1 && kind == 2) continue;
    if (mode == 2 && kind != 2) continue;
    if (kind != 2) __builtin_amdgcn_s_setprio(3);
    if (kind == 0) gdn_chain(p, l, a0, a1, a2, a3, (float*)smraw);
    else if (kind == 1) hgrn_chain(p, l, a0, a1, a2, a3, (float*)smraw);
    if (kind != 2) __builtin_amdgcn_s_setprio(0);
    else attn_item(p, a0, a1, a2, a3, smraw, mode == 2);
  }
}

__global__ void __launch_bounds__(NTHR, 2) mega(Params p) {
  __shared__ __attribute__((aligned(16))) unsigned char smem[LDS_BYTES];
  cg::grid_group grid = cg::this_grid();
  __shared__ uint4 xb_words;
  if (threadIdx.x == 0) xb_words = make_uint4(0u, 0u, 0u, 0u);
  __syncthreads();
  {
    XcdBarrier xb0 = xcd_barrier_post(p.xbar, (volatile LAS unsigned*)&xb_words);
    if (threadIdx.x == 0) ((volatile LAS unsigned*)&xb_words)[2] = xb0.x;
  }
#define GSYNC() do { XcdBarrier xb_; xb_.bar = p.xbar; xb_.st = (volatile LAS unsigned*)&xb_words; xb_.x = 0; \
    if (threadIdx.x == 0) xb_.x = ((volatile LAS unsigned*)&xb_words)[2]; xcd_barrier(xb_); } while (0)
  phase0(p, (float*)smem);
  if (p.out == nullptr) grid.sync();
  GSYNC();
  rowpass_norm(p, 0, 0);
  GSYNC();
  for (int l = 0; l < 2; ++l) {
    phase_a(p, l, (u16*)smem);
    GSYNC();
    rowpass_b0(p, l);
    GSYNC();
    phase_b1(p, l, (u16*)smem);
    GSYNC();
    rowpass_b2(p, l);
    GSYNC();
    phase_c(p, l, smem);
    GSYNC();
    rowpass_c2(p, l);
    GSYNC();
    phase_gemm_y(p.MIX, 1024, p.WoutT + (size_t)l * 1024 * 1024, 1024, 1024, p.HQ, 1024, (u16*)smem);
    GSYNC();
    rowpass_norm(p, l, 1);
    GSYNC();
    phase_e(p, l, (u16*)smem);
    GSYNC();
    phase_gemm_y(p.P, DFF, p.WfoT + (size_t)l * 1024 * DFF, DFF, 1024, p.HQ, 1024, (u16*)smem);
    GSYNC();
    rowpass_norm(p, l, 2);
    if (l == 0) GSYNC();
  }
}

extern "C" void kernel_launch(void* const* d_in, const int* in_sizes, int n_in, void* d_out, int out_size, void* d_ws,
                              size_t ws_size, hipStream_t stream) {
  static int grid_blocks = 0;
  if (!grid_blocks) {
    int dev = 0, cus = 0, per_cu = 0;
    hipGetDevice(&dev);
    hipDeviceGetAttribute(&cus, hipDeviceAttributeMultiprocessorCount, dev);
    hipOccupancyMaxActiveBlocksPerMultiprocessor(&per_cu, mega, NTHR, 0);
    if (per_cu > 2) per_cu = 2;
    if (per_cu < 1) per_cu = 1;
    grid_blocks = cus * per_cu;
  }
  Params p{};
  const float* const* in = (const float* const*)d_in;
  p.x_prompt = in[0]; p.x_sample = in[1]; p.cache_ckv = in[2]; p.cache_kr = in[3]; p.state_gdn = in[4]; p.state_hgrn = in[5];
  p.c = in[6]; p.c_ctx = in[7]; p.w_ada = in[8]; p.b_ada = in[9]; p.g_pre_mix = in[10]; p.g_post_mix = in[11];
  p.g_pre_ffn = in[12]; p.g_post_ffn = in[13]; p.w_in = in[14]; p.w_out = in[15]; p.gdn_conv_w = in[16];
  p.gdn_a_log = in[17]; p.gdn_dt_bias = in[18]; p.gdn_norm_w = in[19]; p.hgrn_lb = in[20]; p.hgrn_norm_w = in[21];
  p.mla_q_norm_w = in[22]; p.mla_w_uq = in[23]; p.mla_kv_norm_w = in[24]; p.mla_w_ukv = in[25]; p.w_ffn_in = in[26];
  p.w_ffn_out = in[27];
  p.out = (float*)d_out;
  unsigned char* ws = (unsigned char*)d_ws;
  size_t off = 0;
  auto take = [&](size_t bytes) { unsigned char* r = ws + off; off += (bytes + 255) & ~(size_t)255; return r; };
  p.counters = (unsigned*)take(1024);
  p.xbar = (unsigned*)take(16384);
  p.WinT = (u16*)take((size_t)2 * 3072 * 1024 * 2);
  p.WuqT = (u16*)take((size_t)2 * 768 * 384 * 2);
  p.WukvT = (u16*)take((size_t)2 * 1024 * 256 * 2);
  p.WoutT = (u16*)take((size_t)2 * 1024 * 1024 * 2);
  p.WfiT = (u16*)take((size_t)2 * 5632 * 1024 * 2);
  p.WfoT = (u16*)take((size_t)2 * 1024 * 2816 * 2);
  p.mod = (float*)take((size_t)2 * 9 * 6144 * 4);
  p.HQ = (u16*)take((size_t)T_ALL * 1024 * 2);
  p.P = (u16*)take((size_t)T_ALL * PW * 2);
  p.KN = (u16*)take((size_t)(T_ALL + 2048) * 512 * 2);
  p.VTL = (u16*)take((size_t)8 * 4 * 128 * 4352 * 2);
  p.VTC = (u16*)take((size_t)16 * 4 * 128 * 256 * 2);
  p.CKVC = (u16*)take((size_t)2048 * 256 * 2);
  p.KRC = (u16*)take((size_t)2048 * 64 * 2);
  p.GAB = (float*)take((size_t)T_ALL * 16 * 4);
  p.MIX = (u16*)take((size_t)T_ALL * 1024 * 2);
  if (off > ws_size) { fprintf(stderr, "workspace too small: need %zu have %zu\n", off, ws_size); return; }
  hipMemsetAsync(p.counters, 0, 1024 + 16384, stream);
  void* args[] = {&p};
  hipError_t e = hipLaunchCooperativeKernel((void*)mega, dim3(grid_blocks), dim3(NTHR), args, 0, stream);
  if (e != hipSuccess) fprintf(stderr, "cooperative launch failed: %s (grid %d)\n", hipGetErrorString(e), grid_blocks);
}
```

```cpp
#include <hip/hip_runtime.h>
#include <hip/hip_cooperative_groups.h>
#include <cstdio>
namespace cg = cooperative_groups;

typedef unsigned short u16;
using bf16x8 = __attribute__((ext_vector_type(8))) short;
using f32x4  = __attribute__((ext_vector_type(4))) float;

#define T_CTX 4096
#define T_ALL 36864
#define PW 3072
#define DFF 2816
#define LDS_BYTES 77824
#define NTHR 256

#define P_GQKV 0
#define P_GZ 768
#define P_HQ 1024
#define P_HI 1280
#define P_HF 1536
#define P_HG 2048
#define P_MCQ 2304
#define P_MCKV 2688
#define P_MKR 2944
#define P_GA 3008

struct Params {
  const float *x_prompt, *x_sample, *cache_ckv, *cache_kr, *state_gdn, *state_hgrn, *c, *c_ctx;
  const float *w_ada, *b_ada, *g_pre_mix, *g_post_mix, *g_pre_ffn, *g_post_ffn, *w_in, *w_out;
  const float *gdn_conv_w, *gdn_a_log, *gdn_dt_bias, *gdn_norm_w, *hgrn_lb, *hgrn_norm_w;
  const float *mla_q_norm_w, *mla_w_uq, *mla_kv_norm_w, *mla_w_ukv, *w_ffn_in, *w_ffn_out;
  float* out;
  u16 *WinT, *WuqT, *WukvT, *WoutT, *WfiT, *WfoT;
  float* mod;
  u16 *HQ, *P, *KN, *VTL, *VTC, *CKVC, *KRC, *MIX;
  float* GAB;
  unsigned* counters;
  unsigned* xbar;
};

#define OUT_CKV   37748736
#define OUT_KR    39845888
#define OUT_SGDN  40370176
#define OUT_SHG   41418752

__device__ __forceinline__ u16 f2bf(float f) {
  unsigned u = __float_as_uint(f);
  u += 0x7fffu + ((u >> 16) & 1u);
  return (u16)(u >> 16);
}
typedef __attribute__((ext_vector_type(2))) __bf16 bf16x2_t;
typedef __attribute__((ext_vector_type(2))) float f32x2_t;
__device__ __forceinline__ unsigned pack2bf(float x, float y) {
  return __builtin_bit_cast(unsigned, __builtin_convertvector((f32x2_t){x, y}, bf16x2_t));
}
__device__ __forceinline__ float bf2f(u16 h) { return __uint_as_float(((unsigned)h) << 16); }
__device__ __forceinline__ float wave_sum(float v) {
#pragma unroll
  for (int o = 32; o > 0; o >>= 1) v += __shfl_xor(v, o);
  return v;
}
__device__ __forceinline__ float sigmoidf_(float x) { return __builtin_amdgcn_rcpf(1.f + __expf(-x)); }
__device__ __forceinline__ float siluf_(float x) { return x * __builtin_amdgcn_rcpf(1.f + __expf(-x)); }
__device__ __forceinline__ int tid_l() { int t = threadIdx.x; asm volatile("" : "+v"(t)); return t; }
__device__ __forceinline__ int tok_mod(int t) { return t < T_CTX ? 0 : 1 + ((t - T_CTX) >> 12); }

__device__ __forceinline__ int map_col(int kind, int j) {
  if (kind == 0) return j;
  if (kind == 1) { if (j < 1024) return j; if (j < 3008) return j + 16; if (j < 3024) return 1024 + (j - 3008); return -1; }
  int blk = j >> 6, w = j & 63;
  return w < 32 ? blk * 32 + w : DFF + blk * 32 + (w - 32);
}

__device__ __forceinline__ void cvt_tile(const float* __restrict__ src, int K, int Nsrc, u16* __restrict__ dst, int kind, int jt, int kt, float* sm) {
  const int tid = tid_l();
  const int j0 = jt * 64, k0 = kt * 64;
  __syncthreads();
  {
    int jj = tid & 63, kk0 = tid >> 6;
    int sc = map_col(kind, j0 + jj);
    for (int kk = kk0; kk < 64; kk += 4)
      sm[kk * 65 + jj] = sc >= 0 ? src[(size_t)(k0 + kk) * Nsrc + sc] : 0.f;
  }
  __syncthreads();
  {
    const int kq = tid & 15, jj0 = tid >> 4;
#pragma unroll
    for (int jj = jj0; jj < 64; jj += 16) {
      uint2 o;
      o.x = pack2bf(sm[(4 * kq + 0) * 65 + jj], sm[(4 * kq + 1) * 65 + jj]);
      o.y = pack2bf(sm[(4 * kq + 2) * 65 + jj], sm[(4 * kq + 3) * 65 + jj]);
      *(uint2*)(dst + (size_t)(j0 + jj) * K + k0 + 4 * kq) = o;
    }
  }
}

__device__ __forceinline__ void mod_item(const Params& p, int item, float* sm) {
  const int l = item / 96, j0 = (item % 96) * 64;
  const int tid = tid_l();
  float* sC = sm;
  float* sR = sm + 9 * 1024;
  __syncthreads();
  for (int i = tid; i < 9 * 1024; i += NTHR) {
    int m = i >> 10, k = i & 1023;
    float v = m == 0 ? p.c_ctx[k] : p.c[(m - 1) * 1024 + k];
    sC[i] = siluf_(v);
  }
  __syncthreads();
  const int col = tid & 63, ks = tid >> 6;
  float acc[9];
#pragma unroll
  for (int m = 0; m < 9; ++m) acc[m] = 0.f;
  const float* wp = p.w_ada + (size_t)l * 1024 * 6144 + j0 + col;
  for (int k = ks * 256; k < ks * 256 + 256; k += 8) {
    float wv[8];
#pragma unroll
    for (int u = 0; u < 8; ++u) wv[u] = wp[(size_t)(k + u) * 6144];
#pragma unroll
    for (int u = 0; u < 8; ++u)
#pragma unroll
      for (int m = 0; m < 9; ++m) acc[m] += sC[m * 1024 + k + u] * wv[u];
  }
#pragma unroll
  for (int m = 0; m < 9; ++m) sR[(ks * 9 + m) * 64 + col] = acc[m];
  __syncthreads();
  for (int i = tid; i < 9 * 64; i += NTHR) {
    int m = i >> 6, cc = i & 63;
    float v = sR[(0 * 9 + m) * 64 + cc] + sR[(1 * 9 + m) * 64 + cc] + sR[(2 * 9 + m) * 64 + cc] + sR[(3 * 9 + m) * 64 + cc];
    p.mod[((size_t)l * 9 + m) * 6144 + j0 + cc] = v + p.b_ada[l * 6144 + j0 + cc];
  }
}

__device__ __forceinline__ void phase0(const Params& p, float* sm) {
  const int PER_LAYER = 3272;
  const int total = 2 * PER_LAYER + 192;
  for (int item = blockIdx.x; item < total; item += gridDim.x) {
    if (item < 192) { mod_item(p, item, sm); continue; }
    int it = item - 192;
    int l = it / PER_LAYER, r = it % PER_LAYER;
    if (r < 768) { cvt_tile(p.w_in + (size_t)l * 1024 * 3024, 1024, 3024, p.WinT + (size_t)l * 3072 * 1024, 1, r / 16, r % 16, sm); continue; }
    r -= 768;
    if (r < 72) { cvt_tile(p.mla_w_uq + (size_t)l * 384 * 768, 384, 768, p.WuqT + (size_t)l * 768 * 384, 0, r / 6, r % 6, sm); continue; }
    r -= 72;
    if (r < 64) { cvt_tile(p.mla_w_ukv + (size_t)l * 256 * 1024, 256, 1024, p.WukvT + (size_t)l * 1024 * 256, 0, r / 4, r % 4, sm); continue; }
    r -= 64;
    if (r < 256) { cvt_tile(p.w_out + (size_t)l * 1024 * 1024, 1024, 1024, p.WoutT + (size_t)l * 1024 * 1024, 0, r / 16, r % 16, sm); continue; }
    r -= 256;
    if (r < 1408) { cvt_tile(p.w_ffn_in + (size_t)l * 1024 * 5632, 1024, 5632, p.WfiT + (size_t)l * 5632 * 1024, 2, r / 16, r % 16, sm); continue; }
    r -= 1408;
    cvt_tile(p.w_ffn_out + (size_t)l * 2816 * 1024, 2816, 1024, p.WfoT + (size_t)l * 1024 * 2816, 0, r / 44, r % 44, sm);
  }
}

__device__ __forceinline__ void rowpass_norm(const Params& p, int l, int stage) {
  const int tidl = tid_l();
  const int lane = tidl & 63, w = tidl >> 6;
  const int ln = stage == 0 ? 0 : (stage == 1 ? l : l + 1);
  const int sh_off = stage == 1 ? 3072 : 0;
  const float* gpre = stage == 1 ? p.g_pre_ffn + l * 1024 : p.g_pre_mix + (ln < 2 ? ln : 0) * 1024;
  u16* dst = stage == 1 ? p.MIX : p.HQ;
  for (int t = blockIdx.x * 4 + w; t < T_ALL; t += gridDim.x * 4) {
    const int m = tok_mod(t);
    float x[16];
    float* xo = p.out + (size_t)t * 1024;
    if (stage == 0) {
      const float* xi = t < T_CTX ? p.x_prompt + (size_t)t * 1024 : p.x_sample + (size_t)(t - T_CTX) * 1024;
#pragma unroll
      for (int i = 0; i < 4; ++i) {
        float4 v = *(const float4*)(xi + i * 256 + lane * 4);
        x[i * 4 + 0] = v.x; x[i * 4 + 1] = v.y; x[i * 4 + 2] = v.z; x[i * 4 + 3] = v.w;
      }
    } else {
      const u16* yp = p.HQ + (size_t)t * 1024;
      float y[16]; float ss = 0.f;
#pragma unroll
      for (int i = 0; i < 4; ++i) {
        uint2 v = *(const uint2*)(yp + i * 256 + lane * 4);
        y[i * 4 + 0] = bf2f((u16)(v.x & 0xffff)); y[i * 4 + 1] = bf2f((u16)(v.x >> 16));
        y[i * 4 + 2] = bf2f((u16)(v.y & 0xffff)); y[i * 4 + 3] = bf2f((u16)(v.y >> 16));
      }
#pragma unroll
      for (int i = 0; i < 16; ++i) ss += y[i] * y[i];
      ss = wave_sum(ss);
      const float rstd = rsqrtf(ss * (1.f / 1024.f) + 1e-6f);
      const float* gpost = (stage == 1 ? p.g_post_mix : p.g_post_ffn) + l * 1024;
      const float* gt = p.mod + ((size_t)l * 9 + m) * 6144 + (stage == 1 ? 2048 : 5120);
#pragma unroll
      for (int i = 0; i < 4; ++i) {
        float4 xv = *(const float4*)(xo + i * 256 + lane * 4);
        float4 gp = *(const float4*)(gpost + i * 256 + lane * 4);
        float4 gg = *(const float4*)(gt + i * 256 + lane * 4);
        x[i * 4 + 0] = xv.x + gg.x * y[i * 4 + 0] * rstd * gp.x;
        x[i * 4 + 1] = xv.y + gg.y * y[i * 4 + 1] * rstd * gp.y;
        x[i * 4 + 2] = xv.z + gg.z * y[i * 4 + 2] * rstd * gp.z;
        x[i * 4 + 3] = xv.w + gg.w * y[i * 4 + 3] * rstd * gp.w;
      }
    }
    __threadfence_block();
#pragma unroll
    for (int i = 0; i < 4; ++i)
      *(float4*)(xo + i * 256 + lane * 4) = make_float4(x[i * 4 + 0], x[i * 4 + 1], x[i * 4 + 2], x[i * 4 + 3]);
    if (ln >= 2) continue;
    float ss = 0.f;
#pragma unroll
    for (int i = 0; i < 16; ++i) ss += x[i] * x[i];
    ss = wave_sum(ss);
    const float rstd = rsqrtf(ss * (1.f / 1024.f) + 1e-6f);
    const float* sh = p.mod + ((size_t)ln * 9 + m) * 6144 + sh_off;
    const float* sc = sh + 1024;
    u16* hp = dst + (size_t)t * 1024;
#pragma unroll
    for (int i = 0; i < 4; ++i) {
      float4 gp = *(const float4*)(gpre + i * 256 + lane * 4);
      float4 s1 = *(const float4*)(sh + i * 256 + lane * 4);
      float4 c1 = *(const float4*)(sc + i * 256 + lane * 4);
      float h0 = x[i * 4 + 0] * rstd * gp.x * (1.f + c1.x) + s1.x;
      float h1 = x[i * 4 + 1] * rstd * gp.y * (1.f + c1.y) + s1.y;
      float h2 = x[i * 4 + 2] * rstd * gp.z * (1.f + c1.z) + s1.z;
      float h3 = x[i * 4 + 3] * rstd * gp.w * (1.f + c1.w) + s1.w;
      uint2 o;
      o.x = pack2bf(h0, h1);
      o.y = pack2bf(h2, h3);
      *(uint2*)(hp + i * 256 + lane * 4) = o;
    }
  }
}

__device__ __forceinline__ void unpack8(const uint4 v, float (&f)[8]);
__device__ __forceinline__ uint4 pack8(const float (&f)[8]);
__device__ __forceinline__ void rowpass_b0(const Params& p, int l) {
  const int tidl = tid_l();
  const int lane = tidl & 63, w = tidl >> 6;
  for (int t = blockIdx.x * 4 + w; t < T_ALL + 2048; t += gridDim.x * 4) {
    if (t >= T_ALL) {
      const int r = t - T_ALL, b = r >> 8, s = r & 255;
      if (lane < 32) {
        const float* ck = p.cache_ckv + (((size_t)b * 2 + l) * 256 + s) * 256 + lane * 8;
        const float4 x0 = *(const float4*)ck, x1 = *(const float4*)(ck + 4);
        const float f[8] = {x0.x, x0.y, x0.z, x0.w, x1.x, x1.y, x1.z, x1.w};
        *(uint4*)(p.CKVC + (size_t)r * 256 + lane * 8) = pack8(f);
      } else if (lane < 40) {
        const float* kr = p.cache_kr + (((size_t)b * 2 + l) * 256 + s) * 64 + (lane - 32) * 8;
        const float4 x0 = *(const float4*)kr, x1 = *(const float4*)(kr + 4);
        const float f[8] = {x0.x, x0.y, x0.z, x0.w, x1.x, x1.y, x1.z, x1.w};
        *(uint4*)(p.KRC + (size_t)r * 64 + (lane - 32) * 8) = pack8(f);
      }
      continue;
    }
    u16* pr = p.P + (size_t)t * PW;
    {
      float f[8]; float ss = 0.f;
      if (lane < 48) {
        unpack8(*(const uint4*)(pr + P_MCQ + lane * 8), f);
#pragma unroll
        for (int i = 0; i < 8; ++i) ss += f[i] * f[i];
      }
      ss = wave_sum(ss);
      const float rstd = rsqrtf(ss * (1.f / 384.f) + 1e-6f);
      if (lane < 48) {
        const float* wq = p.mla_q_norm_w + l * 384 + lane * 8;
        const float4 w0 = *(const float4*)wq, w1 = *(const float4*)(wq + 4);
        f[0] *= rstd * w0.x; f[1] *= rstd * w0.y; f[2] *= rstd * w0.z; f[3] *= rstd * w0.w;
        f[4] *= rstd * w1.x; f[5] *= rstd * w1.y; f[6] *= rstd * w1.z; f[7] *= rstd * w1.w;
        *(uint4*)(pr + P_MCQ + lane * 8) = pack8(f);
      }
    }
    {
      float f[8]; float ss = 0.f;
      if (lane < 32) {
        unpack8(*(const uint4*)(pr + P_MCKV + lane * 8), f);
#pragma unroll
        for (int i = 0; i < 8; ++i) ss += f[i] * f[i];
      }
      ss = wave_sum(ss);
      const float rstd = rsqrtf(ss * (1.f / 256.f) + 1e-6f);
      if (lane < 32) {
        const float* wk = p.mla_kv_norm_w + l * 256 + lane * 8;
        const float4 w0 = *(const float4*)wk, w1 = *(const float4*)(wk + 4);
        f[0] *= rstd * w0.x; f[1] *= rstd * w0.y; f[2] *= rstd * w0.z; f[3] *= rstd * w0.w;
        f[4] *= rstd * w1.x; f[5] *= rstd * w1.y; f[6] *= rstd * w1.z; f[7] *= rstd * w1.w;
        *(uint4*)(pr + P_MCKV + lane * 8) = pack8(f);
        if (t < T_CTX) {
          const int b = t >> 8, s = t & 255;
          float* op = p.out + OUT_CKV + (((size_t)b * 2 + l) * 256 + s) * 256 + lane * 8;
          *(float4*)op = make_float4(f[0], f[1], f[2], f[3]);
          *(float4*)(op + 4) = make_float4(f[4], f[5], f[6], f[7]);
        }
      }
    }
    {
      float v = bf2f(pr[P_MKR + lane]);
      if (t < T_CTX) {
        int b = t >> 8, s = t & 255;
        p.out[OUT_KR + (((size_t)b * 2 + l) * 256 + s) * 64 + lane] = v;
      } else {
        int pos = (t - T_CTX) & 4095;
        int axis = lane >> 5, half = (lane >> 4) & 1, f = lane & 15;
        float posf = axis == 0 ? (float)(pos >> 6) : (float)(pos & 63);
        float inv = exp2f(-(float)f * (13.287712379549449f / 16.f));
        float ang = posf * inv;
        float sn, cs;
        __sincosf(ang, &sn, &cs);
        float other = __shfl_xor(v, 16);
        float o = half == 0 ? v * cs - other * sn : v * cs + other * sn;
        pr[P_MKR + lane] = f2bf(o);
      }
    }
  }
}

#define P_QH 2304
#define P_KH 2560
__device__ __forceinline__ void rowpass_b2(const Params& p, int l) {
  const int tidl = tid_l();
  const int lane = tidl & 63, w = tidl >> 6;
  float cw[8][5], cv[8][5];
#pragma unroll
  for (int e = 0; e < 8; ++e)
#pragma unroll
    for (int j = 0; j < 5; ++j) {
      cw[e][j] = p.gdn_conv_w[((size_t)l * 768 + 8 * lane + e) * 5 + j];
      cv[e][j] = p.gdn_conv_w[((size_t)l * 768 + 512 + 8 * (lane & 31) + e) * 5 + j];
    }
  u16* VH = p.HQ + (size_t)T_ALL * 768;
  for (int t = blockIdx.x * 4 + w; t < T_ALL; t += gridDim.x * 4) {
    const int len = t < T_CTX ? 256 : 4096;
    const int tau = t < T_CTX ? (t & 255) : ((t - T_CTX) & 4095);
    float y[8], yv[8];
#pragma unroll
    for (int e = 0; e < 8; ++e) { y[e] = 0.f; yv[e] = 0.f; }
#pragma unroll
    for (int j = 0; j < 5; ++j) {
      const int tt = tau + j - 2;
      if (tt >= 0 && tt < len) {
        const u16* pr = p.P + (size_t)(t + j - 2) * PW;
        float f[8];
        unpack8(*(const uint4*)(pr + 8 * lane), f);
#pragma unroll
        for (int e = 0; e < 8; ++e) y[e] += cw[e][j] * f[e];
        if (lane < 32) {
          unpack8(*(const uint4*)(pr + 512 + 8 * lane), f);
#pragma unroll
          for (int e = 0; e < 8; ++e) yv[e] += cv[e][j] * f[e];
        }
      }
    }
    float ss = 0.f;
#pragma unroll
    for (int e = 0; e < 8; ++e) { y[e] = siluf_(y[e]); yv[e] = siluf_(yv[e]); ss += y[e] * y[e]; }
    ss += __shfl_xor(ss, 1); ss += __shfl_xor(ss, 2); ss += __shfl_xor(ss, 4);
    const float rn = rsqrtf(ss + 1e-6f) * (lane < 32 ? 0.125f : 1.f);
#pragma unroll
    for (int e = 0; e < 8; ++e) y[e] *= rn;
    *(uint4*)(p.P + (size_t)t * PW + P_QH + 8 * lane) = pack8(y);
    if (lane < 32) *(uint4*)(VH + (size_t)t * 256 + 8 * lane) = pack8(yv);
  }
}

__device__ __forceinline__ void unpack8(const uint4 v, float (&f)[8]) {
  f[0] = bf2f((u16)(v.x & 0xffff)); f[1] = bf2f((u16)(v.x >> 16)); f[2] = bf2f((u16)(v.y & 0xffff)); f[3] = bf2f((u16)(v.y >> 16));
  f[4] = bf2f((u16)(v.z & 0xffff)); f[5] = bf2f((u16)(v.z >> 16)); f[6] = bf2f((u16)(v.w & 0xffff)); f[7] = bf2f((u16)(v.w >> 16));
}
__device__ __forceinline__ uint4 pack8(const float (&f)[8]) {
  uint4 o;
  o.x = pack2bf(f[0], f[1]); o.y = pack2bf(f[2], f[3]);
  o.z = pack2bf(f[4], f[5]); o.w = pack2bf(f[6], f[7]);
  return o;
}
__device__ __forceinline__ void rowpass_c2(const Params& p, int l) {
  const int tidl = tid_l();
  const int lane = tidl & 63, w = tidl >> 6;
  const int hl = lane & 31, isH = lane >> 5;
  const float* nw = (isH ? p.hgrn_norm_w : p.gdn_norm_w) + l * 64 + (hl & 7) * 8;
  const float4 w0 = *(const float4*)(nw), w1 = *(const float4*)(nw + 4);
  const float wv[8] = {w0.x, w0.y, w0.z, w0.w, w1.x, w1.y, w1.z, w1.w};
  for (int t = blockIdx.x * 4 + w; t < T_ALL; t += gridDim.x * 4) {
    u16* mr = p.MIX + (size_t)t * 1024;
    const u16* pr = p.P + (size_t)t * PW;
    const u16* qr = p.HQ + (size_t)t * 768;
    const uint4 vf = *(const uint4*)(mr + isH * 512 + hl * 8);
    const uint4 vb = *(const uint4*)(mr + isH * 512 + 256 + hl * 8);
    const uint4 vg = *(const uint4*)(pr + (isH ? P_HG : P_GZ) + hl * 8);
    const int c0 = lane * 8;
    const uint4 vo = *(const uint4*)(qr + (c0 >> 7) * 192 + (c0 & 127));
    float f[8], bb[8], g[8];
    unpack8(vf, f); unpack8(vb, bb); unpack8(vg, g);
    float ss = 0.f;
#pragma unroll
    for (int i = 0; i < 8; ++i) { f[i] += bb[i]; ss += f[i] * f[i]; }
    ss += __shfl_xor(ss, 1); ss += __shfl_xor(ss, 2); ss += __shfl_xor(ss, 4);
    const float rn = rsqrtf(ss * (1.f / 64.f) + 1e-6f);
#pragma unroll
    for (int i = 0; i < 8; ++i) f[i] = f[i] * rn * wv[i] * (isH ? sigmoidf_(g[i]) : siluf_(g[i]));
    __threadfence_block();
    *(uint4*)(mr + isH * 256 + hl * 8) = pack8(f);
    *(uint4*)(mr + 512 + c0) = vo;
  }
}

__device__ __forceinline__ void gemm128(const u16* __restrict__ A, int lda, const u16* __restrict__ B, int ldb, int K,
                                        u16* lds, f32x4 (&acc)[4][4]) {
  const int tid = tid_l(), lane = tid & 63, w = tid >> 6, wm = w >> 1, wn = w & 1;
  const int r16 = lane & 15, g4 = lane >> 4;
#pragma unroll
  for (int i = 0; i < 4; ++i)
#pragma unroll
    for (int j = 0; j < 4; ++j) acc[i][j] = f32x4{0.f, 0.f, 0.f, 0.f};
  const int lrow = tid >> 3, lkc = tid & 7;
  const u16* ap = A + (size_t)lrow * lda + lkc * 8;
  const u16* bp = B + (size_t)lrow * ldb + lkc * 8;
  const size_t sa32 = (size_t)32 * lda, sb32 = (size_t)32 * ldb;
  uint4 ra0 = *(const uint4*)(ap), ra1 = *(const uint4*)(ap + sa32), ra2 = *(const uint4*)(ap + 2 * sa32), ra3 = *(const uint4*)(ap + 3 * sa32);
  uint4 rb0 = *(const uint4*)(bp), rb1 = *(const uint4*)(bp + sb32), rb2 = *(const uint4*)(bp + 2 * sb32), rb3 = *(const uint4*)(bp + 3 * sb32);
  const int woff = lrow * 64 + ((lkc ^ (lrow & 7)) * 8);
  const int sw = r16 & 7;
  const int fa0 = (wm * 64 + r16) * 64 + ((g4 ^ sw) * 8);
  const int fa1 = (wm * 64 + r16) * 64 + (((4 + g4) ^ sw) * 8);
  const int fb0 = 128 * 64 + (wn * 64 + r16) * 64 + ((g4 ^ sw) * 8);
  const int fb1 = 128 * 64 + (wn * 64 + r16) * 64 + (((4 + g4) ^ sw) * 8);
  const int nk = K >> 6;
  __syncthreads();
  {
    u16* wa = lds + woff; u16* wb = lds + 128 * 64 + woff;
    *(uint4*)(wa) = ra0; *(uint4*)(wa + 32 * 64) = ra1; *(uint4*)(wa + 64 * 64) = ra2; *(uint4*)(wa + 96 * 64) = ra3;
    *(uint4*)(wb) = rb0; *(uint4*)(wb + 32 * 64) = rb1; *(uint4*)(wb + 64 * 64) = rb2; *(uint4*)(wb + 96 * 64) = rb3;
  }
  if (nk > 1) {
    const u16* a2 = ap + 64; const u16* b2 = bp + 64;
    ra0 = *(const uint4*)(a2); ra1 = *(const uint4*)(a2 + sa32); ra2 = *(const uint4*)(a2 + 2 * sa32); ra3 = *(const uint4*)(a2 + 3 * sa32);
    rb0 = *(const uint4*)(b2); rb1 = *(const uint4*)(b2 + sb32); rb2 = *(const uint4*)(b2 + 2 * sb32); rb3 = *(const uint4*)(b2 + 3 * sb32);
  }
  __syncthreads();
  for (int kt = 0; kt < nk; ++kt) {
    const u16* cur = lds + (kt & 1) * (256 * 64);
    if (kt + 1 < nk) {
      u16* nxt = lds + ((kt + 1) & 1) * (256 * 64);
      u16* wa = nxt + woff; u16* wb = nxt + 128 * 64 + woff;
      *(uint4*)(wa) = ra0; *(uint4*)(wa + 32 * 64) = ra1; *(uint4*)(wa + 64 * 64) = ra2; *(uint4*)(wa + 96 * 64) = ra3;
      *(uint4*)(wb) = rb0; *(uint4*)(wb + 32 * 64) = rb1; *(uint4*)(wb + 64 * 64) = rb2; *(uint4*)(wb + 96 * 64) = rb3;
      if (kt + 2 < nk) {
        const u16* a2 = ap + (kt + 2) * 64; const u16* b2 = bp + (kt + 2) * 64;
        ra0 = *(const uint4*)(a2); ra1 = *(const uint4*)(a2 + sa32); ra2 = *(const uint4*)(a2 + 2 * sa32); ra3 = *(const uint4*)(a2 + 3 * sa32);
        rb0 = *(const uint4*)(b2); rb1 = *(const uint4*)(b2 + sb32); rb2 = *(const uint4*)(b2 + 2 * sb32); rb3 = *(const uint4*)(b2 + 3 * sb32);
      }
    }
    {
      const u16* pa0 = cur + fa0; const u16* pa1 = cur + fa1; const u16* pb0 = cur + fb0; const u16* pb1 = cur + fb1;
      bf16x8 a0 = *(const bf16x8*)(pa0), a1 = *(const bf16x8*)(pa0 + 16 * 64), a2 = *(const bf16x8*)(pa0 + 32 * 64), a3 = *(const bf16x8*)(pa0 + 48 * 64);
      bf16x8 b0 = *(const bf16x8*)(pb0), b1 = *(const bf16x8*)(pb0 + 16 * 64), b2 = *(const bf16x8*)(pb0 + 32 * 64), b3 = *(const bf16x8*)(pb0 + 48 * 64);
      bf16x8 c0 = *(const bf16x8*)(pa1), c1 = *(const bf16x8*)(pa1 + 16 * 64), c2 = *(const bf16x8*)(pa1 + 32 * 64), c3 = *(const bf16x8*)(pa1 + 48 * 64);
      bf16x8 d0 = *(const bf16x8*)(pb1), d1 = *(const bf16x8*)(pb1 + 16 * 64), d2 = *(const bf16x8*)(pb1 + 32 * 64), d3 = *(const bf16x8*)(pb1 + 48 * 64);
      __builtin_amdgcn_sched_barrier(0);
#define G128_MM(j, bj, x0, x1, x2, x3) do { \
        acc[0][j] = __builtin_amdgcn_mfma_f32_16x16x32_bf16(bj, x0, acc[0][j], 0, 0, 0); \
        acc[1][j] = __builtin_amdgcn_mfma_f32_16x16x32_bf16(bj, x1, acc[1][j], 0, 0, 0); \
        acc[2][j] = __builtin_amdgcn_mfma_f32_16x16x32_bf16(bj, x2, acc[2][j], 0, 0, 0); \
        acc[3][j] = __builtin_amdgcn_mfma_f32_16x16x32_bf16(bj, x3, acc[3][j], 0, 0, 0); } while (0)
      __builtin_amdgcn_s_setprio(1);
      G128_MM(0, b0, a0, a1, a2, a3); G128_MM(1, b1, a0, a1, a2, a3); G128_MM(2, b2, a0, a1, a2, a3); G128_MM(3, b3, a0, a1, a2, a3);
      G128_MM(0, d0, c0, c1, c2, c3); G128_MM(1, d1, c0, c1, c2, c3); G128_MM(2, d2, c0, c1, c2, c3); G128_MM(3, d3, c0, c1, c2, c3);
      __builtin_amdgcn_s_setprio(0);
    }
    __syncthreads();
  }
}
__device__ __forceinline__ uint2 pack4(f32x4 v) {
  uint2 o;
  o.x = pack2bf(v[0], v[1]);
  o.y = pack2bf(v[2], v[3]);
  return o;
}

__device__ __forceinline__ void gemm256(const u16* __restrict__ A, int lda, const u16* __restrict__ B, int ldb, int K,
                                        u16* lds, f32x4 (&acc)[8][4]) {
  const int tid = tid_l(), lane = tid & 63, w = tid >> 6, wm = w >> 1, wn = w & 1;
  const int r16 = lane & 15, g4 = lane >> 4;
#pragma unroll
  for (int i = 0; i < 8; ++i)
#pragma unroll
    for (int j = 0; j < 4; ++j) acc[i][j] = f32x4{0.f, 0.f, 0.f, 0.f};
  const int lrow = tid >> 2, lkc = tid & 3;
  const u16* ap = A + (size_t)lrow * lda + lkc * 8;
  const u16* bp = B + (size_t)lrow * ldb + lkc * 8;
  const size_t sa64 = (size_t)64 * lda, sb64 = (size_t)64 * ldb;
  const int woff = lrow * 32 + ((lkc ^ ((lrow >> 1) & 3)) * 8);
  const int fsw = (g4 ^ ((r16 >> 1) & 3)) * 8;
  const int faoff = (wm * 128 + r16) * 32 + fsw;
  const int fboff = 256 * 32 + (wn * 64 + r16) * 32 + fsw;
  const int nk = K >> 5;
  const int BUF = 384 * 32;
  uint4 xa0, xa1, xa2, xa3, xb0, xb1;
  uint4 ya0, ya1, ya2, ya3, yb0, yb1;
#define G256_LOAD(P, st) do { const u16* a2_ = ap + (st) * 32; const u16* b2_ = bp + (st) * 32; \
    P##a0 = *(const uint4*)(a2_); P##a1 = *(const uint4*)(a2_ + sa64); P##a2 = *(const uint4*)(a2_ + 2 * sa64); P##a3 = *(const uint4*)(a2_ + 3 * sa64); \
    P##b0 = *(const uint4*)(b2_); P##b1 = *(const uint4*)(b2_ + sb64); } while (0)
#define G256_STORE(P, buf) do { u16* wa_ = lds + (buf) * BUF + woff; u16* wb_ = wa_ + 256 * 32; \
    *(uint4*)(wa_) = P##a0; *(uint4*)(wa_ + 64 * 32) = P##a1; *(uint4*)(wa_ + 128 * 32) = P##a2; *(uint4*)(wa_ + 192 * 32) = P##a3; \
    *(uint4*)(wb_) = P##b0; *(uint4*)(wb_ + 64 * 32) = P##b1; } while (0)
#define G256_MM(i, af) do { \
      acc[i][0] = __builtin_amdgcn_mfma_f32_16x16x32_bf16(bf0, af, acc[i][0], 0, 0, 0); \
      acc[i][1] = __builtin_amdgcn_mfma_f32_16x16x32_bf16(bf1, af, acc[i][1], 0, 0, 0); \
      acc[i][2] = __builtin_amdgcn_mfma_f32_16x16x32_bf16(bf2, af, acc[i][2], 0, 0, 0); \
      acc[i][3] = __builtin_amdgcn_mfma_f32_16x16x32_bf16(bf3, af, acc[i][3], 0, 0, 0); } while (0)
#define G256_COMPUTE(buf) do { const u16* fa_ = lds + (buf) * BUF + faoff; const u16* fb_ = lds + (buf) * BUF + fboff; \
    bf16x8 bf0 = *(const bf16x8*)(fb_), bf1 = *(const bf16x8*)(fb_ + 16 * 32), bf2 = *(const bf16x8*)(fb_ + 32 * 32), bf3 = *(const bf16x8*)(fb_ + 48 * 32); \
    bf16x8 a0 = *(const bf16x8*)(fa_), a1 = *(const bf16x8*)(fa_ + 16 * 32), a2 = *(const bf16x8*)(fa_ + 32 * 32), a3 = *(const bf16x8*)(fa_ + 48 * 32); \
    __builtin_amdgcn_sched_barrier(0); __builtin_amdgcn_s_setprio(1); \
    G256_MM(0, a0); a0 = *(const bf16x8*)(fa_ + 64 * 32); __builtin_amdgcn_sched_barrier(0); \
    G256_MM(1, a1); a1 = *(const bf16x8*)(fa_ + 80 * 32); __builtin_amdgcn_sched_barrier(0); \
    G256_MM(2, a2); a2 = *(const bf16x8*)(fa_ + 96 * 32); __builtin_amdgcn_sched_barrier(0); \
    G256_MM(3, a3); a3 = *(const bf16x8*)(fa_ + 112 * 32); __builtin_amdgcn_sched_barrier(0); \
    G256_MM(4, a0); G256_MM(5, a1); G256_MM(6, a2); G256_MM(7, a3); __builtin_amdgcn_s_setprio(0); } while (0)
  bf16x8 bf0, bf1, bf2, bf3, a0, a1, a2, a3;
#define G3_PRELOAD(buf) do { const u16* fa_ = lds + (buf) * BUF + faoff; const u16* fb_ = lds + (buf) * BUF + fboff; \
    bf0 = *(const bf16x8*)(fb_); bf1 = *(const bf16x8*)(fb_ + 16 * 32); bf2 = *(const bf16x8*)(fb_ + 32 * 32); bf3 = *(const bf16x8*)(fb_ + 48 * 32); \
    a0 = *(const bf16x8*)(fa_); a1 = *(const bf16x8*)(fa_ + 16 * 32); a2 = *(const bf16x8*)(fa_ + 32 * 32); a3 = *(const bf16x8*)(fa_ + 48 * 32); } while (0)
#define G3_COMPUTE(buf) do { const u16* fa_ = lds + (buf) * BUF + faoff; \
    __builtin_amdgcn_sched_barrier(0); __builtin_amdgcn_s_setprio(1); \
    G256_MM(0, a0); a0 = *(const bf16x8*)(fa_ + 64 * 32); __builtin_amdgcn_sched_barrier(0); \
    G256_MM(1, a1); a1 = *(const bf16x8*)(fa_ + 80 * 32); __builtin_amdgcn_sched_barrier(0); \
    G256_MM(2, a2); a2 = *(const bf16x8*)(fa_ + 96 * 32); __builtin_amdgcn_sched_barrier(0); \
    G256_MM(3, a3); a3 = *(const bf16x8*)(fa_ + 112 * 32); __builtin_amdgcn_sched_barrier(0); \
    G256_MM(4, a0); G256_MM(5, a1); G256_MM(6, a2); G256_MM(7, a3); __builtin_amdgcn_s_setprio(0); \
    __builtin_amdgcn_sched_barrier(0); } while (0)
#define G3_STAGE(i, SET) do { \
    if (kt + (i) + 2 < nk) G256_STORE(SET, ((i) + 2) % 3); \
    if (kt + (i) + 4 < nk) G256_LOAD(SET, kt + (i) + 4); \
    if (kt + (i) < nk) G3_COMPUTE((i) % 3); \
    if (kt + (i) + 1 < nk) G3_PRELOAD(((i) + 1) % 3); \
    __syncthreads(); } while (0)
  G256_LOAD(x, 0);
  G256_LOAD(y, 1);
  __syncthreads();
  G256_STORE(x, 0);
  G256_LOAD(x, 2);
  G256_STORE(y, 1);
  G256_LOAD(y, 3);
  __syncthreads();
  G3_PRELOAD(0);
  for (int kt = 0; kt < nk; kt += 6) {
    G3_STAGE(0, x); G3_STAGE(1, y); G3_STAGE(2, x); G3_STAGE(3, y); G3_STAGE(4, x); G3_STAGE(5, y);
  }
}

__device__ __forceinline__ void gemm192(const u16* __restrict__ A, int lda, const u16* __restrict__ B, int ldb, int K,
                                        u16* lds, f32x4 (&acc)[6][4]) {
  const int tid = tid_l(), lane = tid & 63, w = tid >> 6, wm = w >> 1, wn = w & 1;
  const int r16 = lane & 15, g4 = lane >> 4;
#pragma unroll
  for (int i = 0; i < 6; ++i)
#pragma unroll
    for (int j = 0; j < 4; ++j) acc[i][j] = f32x4{0.f, 0.f, 0.f, 0.f};
  const int lrow = tid >> 2, lkc = tid & 3;
  const u16* ap = A + (size_t)lrow * lda + lkc * 8;
  const u16* bp = B + (size_t)lrow * ldb + lkc * 8;
  const size_t sa64 = (size_t)64 * lda, sb64 = (size_t)64 * ldb;
  const int woff = lrow * 32 + ((lkc ^ ((lrow >> 1) & 3)) * 8);
  const int fsw = (g4 ^ ((r16 >> 1) & 3)) * 8;
  const int faoff = (wm * 96 + r16) * 32 + fsw;
  const int fboff = 192 * 32 + (wn * 64 + r16) * 32 + fsw;
  const int nk = K >> 5;
  const int BUF = 320 * 32;
  uint4 xa0, xa1, xa2, xb0, xb1;
  uint4 ya0, ya1, ya2, yb0, yb1;
#define G192_LOAD(P, st) do { const u16* a2_ = ap + (st) * 32; const u16* b2_ = bp + (st) * 32; \
    P##a0 = *(const uint4*)(a2_); P##a1 = *(const uint4*)(a2_ + sa64); P##a2 = *(const uint4*)(a2_ + 2 * sa64); \
    P##b0 = *(const uint4*)(b2_); P##b1 = *(const uint4*)(b2_ + sb64); } while (0)
#define G192_STORE(P, buf) do { u16* wa_ = lds + (buf) * BUF + woff; u16* wb_ = wa_ + 192 * 32; \
    *(uint4*)(wa_) = P##a0; *(uint4*)(wa_ + 64 * 32) = P##a1; *(uint4*)(wa_ + 128 * 32) = P##a2; \
    *(uint4*)(wb_) = P##b0; *(uint4*)(wb_ + 64 * 32) = P##b1; } while (0)
#define G192_COMPUTE(buf) do { const u16* fa_ = lds + (buf) * BUF + faoff; const u16* fb_ = lds + (buf) * BUF + fboff; \
    bf16x8 bf0 = *(const bf16x8*)(fb_), bf1 = *(const bf16x8*)(fb_ + 16 * 32), bf2 = *(const bf16x8*)(fb_ + 32 * 32), bf3 = *(const bf16x8*)(fb_ + 48 * 32); \
    bf16x8 a0 = *(const bf16x8*)(fa_), a1 = *(const bf16x8*)(fa_ + 16 * 32), a2 = *(const bf16x8*)(fa_ + 32 * 32), a3 = *(const bf16x8*)(fa_ + 48 * 32); \
    __builtin_amdgcn_sched_barrier(0); __builtin_amdgcn_s_setprio(1); \
    G256_MM(0, a0); a0 = *(const bf16x8*)(fa_ + 64 * 32); __builtin_amdgcn_sched_barrier(0); \
    G256_MM(1, a1); a1 = *(const bf16x8*)(fa_ + 80 * 32); __builtin_amdgcn_sched_barrier(0); \
    G256_MM(2, a2); G256_MM(3, a3); G256_MM(4, a0); G256_MM(5, a1); __builtin_amdgcn_s_setprio(0); } while (0)
  G192_LOAD(x, 0);
  G192_LOAD(y, 1);
  __syncthreads();
  G192_STORE(x, 0);
  G192_LOAD(x, 2);
  __syncthreads();
  for (int kt = 0; kt < nk; kt += 2) {
    G192_STORE(y, 1);
    if (kt + 3 < nk) G192_LOAD(y, kt + 3);
    G192_COMPUTE(0);
    __syncthreads();
    if (kt + 2 < nk) {
      G192_STORE(x, 0);
      if (kt + 4 < nk) G192_LOAD(x, kt + 4);
    }
    G192_COMPUTE(1);
    __syncthreads();
  }
}
#define GEMM256_RC const int tde = tid_l(); const int rb = ((tde >> 6) >> 1) * 128 + (tde & 15), cb = ((tde >> 6) & 1) * 64 + ((tde & 63) >> 4) * 4;
#define GEMM_RC const int tde = tid_l(); const int rb = ((tde >> 6) >> 1) * 64 + (tde & 15), cb = ((tde >> 6) & 1) * 64 + ((tde & 63) >> 4) * 4;


__device__ __forceinline__ bool tile_at(int r, int Mt, int Nt, int& mt, int& nt) {
  const int x = blockIdx.x & 7, j = blockIdx.x >> 3, bpx = gridDim.x >> 3;
  const int mpx = Mt >> 3;
  const int q = r * bpx + j;
  if (q >= mpx * Nt) return false;
  const int full = (Nt >> 3) * (mpx * 8);
  int cb, rem, wcb;
  if (q < full) { cb = q / (mpx * 8); rem = q - cb * mpx * 8; wcb = 8; }
  else { cb = Nt >> 3; rem = q - full; wcb = Nt - cb * 8; }
  mt = x * mpx + rem / wcb;
  nt = cb * 8 + rem % wcb;
  return true;
}

__device__ __forceinline__ void phase_a(const Params& p, int l, u16* lds) {
  const u16* Bw = p.WinT + (size_t)l * 3072 * 1024;
  int mt, nt;
  for (int r = 0; tile_at(r, 144, 24, mt, nt); ++r) {
    const int m0 = mt * 256, n0 = nt * 128;
    f32x4 acc[8][4];
    gemm256(p.HQ + (size_t)m0 * 1024, 1024, Bw + (size_t)n0 * 1024, 1024, 1024, lds, acc);
    { GEMM256_RC
#pragma unroll
      for (int mi = 0; mi < 8; ++mi) {
        const int row = m0 + rb + mi * 16;
#pragma unroll
        for (int ni = 0; ni < 4; ++ni) {
          const int col = n0 + cb + ni * 16;
          *(uint2*)(p.P + (size_t)row * PW + col) = pack4(acc[mi][ni]);
          if (col >= P_GA && col < P_GA + 16)
            *(float4*)(p.GAB + (size_t)row * 16 + (col - P_GA)) = make_float4(acc[mi][ni][0], acc[mi][ni][1], acc[mi][ni][2], acc[mi][ni][3]);
        }
      }
    }
  }
}

__device__ __forceinline__ void phase_b1(const Params& p, int l, u16* lds) {
  int mt, nt;
  for (int pass = 0; pass < 2; ++pass) {
  for (int r = 0; tile_at(r, pass == 0 ? 288 : 304, pass == 0 ? 6 : 8, mt, nt); ++r) {
    if (pass == 0) {
      const int m0 = mt * 128, n0 = nt * 128;
      const float qscale = 0.07216878364870322f * 1.4426950408889634f;
      f32x4 acc[4][4];
      gemm128(p.P + (size_t)m0 * PW + P_MCQ, PW, p.WuqT + (size_t)l * 768 * 384 + (size_t)n0 * 384, 384, 384, lds, acc);
      { GEMM_RC
        const int g4 = (tde & 63) >> 4;
        const int cw0 = n0 + cb - g4 * 4;
        const bool ropew = ((cw0 >> 6) % 3) == 2 && m0 >= T_CTX;
#pragma unroll
        for (int mi = 0; mi < 4; ++mi) {
          const int row = m0 + rb + mi * 16;
          f32x4 v0 = acc[mi][0], v1 = acc[mi][1], v2 = acc[mi][2], v3 = acc[mi][3];
          if (ropew) {
            const int pos = (row - T_CTX) & 4095;
#pragma unroll
            for (int r = 0; r < 4; ++r) {
              const float inv = exp2f(-(float)(g4 * 4 + r) * (13.287712379549449f / 16.f));
              float s0, c0, s1, c1;
              __sincosf((float)(pos >> 6) * inv, &s0, &c0);
              __sincosf((float)(pos & 63) * inv, &s1, &c1);
              const float a0 = v0[r] * c0 - v1[r] * s0, a1 = v1[r] * c0 + v0[r] * s0;
              const float b0 = v2[r] * c1 - v3[r] * s1, b1 = v3[r] * c1 + v2[r] * s1;
              v0[r] = a0; v1[r] = a1; v2[r] = b0; v3[r] = b1;
            }
          }
          u16* qp = p.HQ + (size_t)row * 768 + n0 + cb;
          *(uint2*)(qp) = pack4(v0 * qscale); *(uint2*)(qp + 16) = pack4(v1 * qscale);
          *(uint2*)(qp + 32) = pack4(v2 * qscale); *(uint2*)(qp + 48) = pack4(v3 * qscale);
        }
      }
    } else {
      const int m0 = mt * 128, n0 = nt * 128;
      const u16* Ap; int lda;
      if (mt < 288) { Ap = p.P + (size_t)m0 * PW + P_MCKV; lda = PW; }
      else { Ap = p.CKVC + (size_t)(m0 - T_ALL) * 256; lda = 256; }
      f32x4 acc[4][4];
      gemm128(Ap, lda, p.WukvT + (size_t)l * 1024 * 256 + (size_t)n0 * 256, 256, 256, lds, acc);
      { GEMM_RC
#pragma unroll
        for (int mi = 0; mi < 4; ++mi) {
          const int row = m0 + rb + mi * 16;
          u16* vb; int vst;
          if (row < T_CTX) { int b = row >> 8, pos = row & 255; vb = p.VTC + (size_t)(b * 4) * 128 * 256 + pos; vst = 256; }
          else if (row < T_ALL) { int b = (row - T_CTX) >> 12, pos = (row - T_CTX) & 4095; vb = p.VTL + (size_t)(b * 4) * 128 * 4352 + pos; vst = 4352; }
          else { int b = (row - T_ALL) >> 8, pos = 4096 + ((row - T_ALL) & 255); vb = p.VTL + (size_t)(b * 4) * 128 * 4352 + pos; vst = 4352; }
#pragma unroll
          for (int ni = 0; ni < 4; ++ni) {
            const int col = n0 + cb + ni * 16;
            const int h = col >> 8, wi = col & 255;
            if (wi < 128) {
              *(uint2*)(p.KN + (size_t)row * 512 + h * 128 + wi) = pack4(acc[mi][ni]);
            } else {
              u16* dst = vb + (size_t)(h * 128 + (wi - 128)) * vst;
#pragma unroll
              for (int r = 0; r < 4; ++r) dst[(size_t)r * vst] = f2bf(acc[mi][ni][r]);
            }
          }
        }
      }
    }
  }
  }
}

__device__ __forceinline__ void phase_gemm_y(const u16* A, int lda, const u16* B, int K, int N, u16* Y, int ldy, u16* lds) {
  int mt, nt;
  for (int r = 0; tile_at(r, 192, N / 128, mt, nt); ++r) {
    const int m0 = mt * 192, n0 = nt * 128;
    f32x4 acc[6][4];
    gemm192(A + (size_t)m0 * lda, lda, B + (size_t)n0 * K, K, K, lds, acc);
    {
      const int tde = tid_l();
      const int rb = ((tde >> 6) >> 1) * 96 + (tde & 15), cb = ((tde >> 6) & 1) * 64 + ((tde & 63) >> 4) * 4;
#pragma unroll
      for (int mi = 0; mi < 6; ++mi)
#pragma unroll
        for (int ni = 0; ni < 4; ++ni)
          *(uint2*)(Y + (size_t)(m0 + rb + mi * 16) * ldy + n0 + cb + ni * 16) = pack4(acc[mi][ni]);
    }
  }
}

__device__ __forceinline__ void phase_e(const Params& p, int l, u16* lds) {
  const u16* Bw = p.WfiT + (size_t)l * 5632 * 1024;
  int mt, nt;
  for (int r = 0; tile_at(r, 144, 44, mt, nt); ++r) {
    const int m0 = mt * 256, n0 = nt * 128;
    f32x4 acc[8][4];
    gemm256(p.MIX + (size_t)m0 * 1024, 1024, Bw + (size_t)n0 * 1024, 1024, 1024, lds, acc);
    { GEMM256_RC
      const int g4x4 = ((tde & 63) >> 4) * 4;
      const int hc0 = ((n0 + cb - g4x4) >> 1) + g4x4;
#pragma unroll
      for (int mi = 0; mi < 8; ++mi)
#pragma unroll
        for (int ni = 0; ni < 2; ++ni) {
          f32x4 hv;
#pragma unroll
          for (int r = 0; r < 4; ++r) hv[r] = siluf_(acc[mi][ni][r]) * acc[mi][ni + 2][r];
          *(uint2*)(p.P + (size_t)(m0 + rb + mi * 16) * DFF + hc0 + ni * 16) = pack4(hv);
        }
    }
  }
}

#define KST 208
#define VST 80
#define PST 80
__device__ __forceinline__ void attn_item(const Params& p, int latent, int b, int h, int qb, unsigned char* smraw, int dummy = 0) {
  u16* sK = (u16*)smraw;
  u16* sV = sK + 64 * KST;
  u16* sP = sV + 128 * VST;
  const int tid = tid_l(), lane = tid & 63, w = tid >> 6, r16 = lane & 15, g4 = lane >> 4;
  const int nkeys = latent ? 4352 : 256;
  const int krow0 = latent ? T_CTX + b * 4096 : b * 256;
  const int tq0 = krow0 + qb * 128;
  const u16* vt = latent ? p.VTL + (size_t)((b * 4 + h) * 128) * 4352 : p.VTC + (size_t)((b * 4 + h) * 128) * 256;
  u16* sPw = sP + w * 32 * PST;
  bf16x8 q[2][6];
#pragma unroll
  for (int mi = 0; mi < 2; ++mi)
#pragma unroll
    for (int ks = 0; ks < 6; ++ks)
      q[mi][ks] = *(const bf16x8*)(p.HQ + (size_t)(tq0 + w * 32 + mi * 16 + r16) * 768 + h * 192 + ks * 32 + g4 * 8);
  f32x4 o[2][8];
  float mrow[2], lrow[2];
#pragma unroll
  for (int mi = 0; mi < 2; ++mi) {
#pragma unroll
    for (int nd = 0; nd < 8; ++nd) o[mi][nd] = f32x4{0.f, 0.f, 0.f, 0.f};
    mrow[mi] = -1e30f; lrow[mi] = 0.f;
  }
  const int lkey = tid >> 2, lpart = tid & 3;
  const int ldv = tid >> 1, lhalf = tid & 1;
  const int ntile = nkeys >> 6;
  uint4 k0, k1, k2, k3, k4, k5;
  {
    const int pos = lkey;
    const u16* srcn = p.KN + (size_t)(krow0 + pos) * 512 + h * 128 + lpart * 8;
    const u16* srcr = p.P + (size_t)(krow0 + pos) * PW + P_MKR + lpart * 8;
    k0 = *(const uint4*)(srcn); k1 = *(const uint4*)(srcn + 32); k2 = *(const uint4*)(srcn + 64); k3 = *(const uint4*)(srcn + 96);
    k4 = *(const uint4*)(srcr); k5 = *(const uint4*)(srcr + 32);
  }
  for (int kt = 0; kt < ntile; ++kt) {
    __syncthreads();
    {
      u16* dk = sK + lkey * KST + lpart * 8;
      *(uint4*)(dk) = k0; *(uint4*)(dk + 32) = k1; *(uint4*)(dk + 64) = k2; *(uint4*)(dk + 96) = k3;
      *(uint4*)(dk + 128) = k4; *(uint4*)(dk + 160) = k5;
    }
    const u16* sv = vt + (size_t)ldv * nkeys + kt * 64 + lhalf * 32;
    const uint4 v0 = *(const uint4*)(sv), v1 = *(const uint4*)(sv + 8), v2 = *(const uint4*)(sv + 16), v3 = *(const uint4*)(sv + 24);
    __syncthreads();
    f32x4 s[2][4];
#pragma unroll
    for (int mi = 0; mi < 2; ++mi)
#pragma unroll
      for (int ni = 0; ni < 4; ++ni) s[mi][ni] = f32x4{0.f, 0.f, 0.f, 0.f};
#pragma unroll
    for (int ks = 0; ks < 6; ++ks)
#pragma unroll
      for (int ni = 0; ni < 4; ++ni) {
        bf16x8 kf = *(const bf16x8*)(sK + (ni * 16 + r16) * KST + ks * 32 + g4 * 8);
        s[0][ni] = __builtin_amdgcn_mfma_f32_16x16x32_bf16(kf, q[0][ks], s[0][ni], 0, 0, 0);
        s[1][ni] = __builtin_amdgcn_mfma_f32_16x16x32_bf16(kf, q[1][ks], s[1][ni], 0, 0, 0);
      }
#pragma unroll
    for (int mi = 0; mi < 2; ++mi) {
      float mx = -1e30f;
#pragma unroll
      for (int ni = 0; ni < 4; ++ni)
#pragma unroll
        for (int r = 0; r < 4; ++r) mx = fmaxf(mx, s[mi][ni][r]);
      mx = fmaxf(mx, __shfl_xor(mx, 16)); mx = fmaxf(mx, __shfl_xor(mx, 32));
      const float mnew = fmaxf(mrow[mi], mx);
      const float alpha = __builtin_amdgcn_exp2f(mrow[mi] - mnew);
      mrow[mi] = mnew;
      float ps = 0.f;
#pragma unroll
      for (int ni = 0; ni < 4; ++ni) {
        f32x4 pv;
#pragma unroll
        for (int r = 0; r < 4; ++r) { pv[r] = __builtin_amdgcn_exp2f(s[mi][ni][r] - mnew); ps += pv[r]; }
        *(uint2*)(sPw + (mi * 16 + r16) * PST + ni * 16 + g4 * 4) = pack4(pv);
      }
      ps += __shfl_xor(ps, 16); ps += __shfl_xor(ps, 32);
      lrow[mi] = lrow[mi] * alpha + ps;
#pragma unroll
      for (int nd = 0; nd < 8; ++nd) o[mi][nd] *= alpha;
    }
    {
      u16* dvp = sV + ldv * VST + lhalf * 32;
      *(uint4*)(dvp) = v0; *(uint4*)(dvp + 8) = v1; *(uint4*)(dvp + 16) = v2; *(uint4*)(dvp + 24) = v3;
    }
    __syncthreads();
    if (kt + 1 < ntile) {
      const int pos = (kt + 1) * 64 + lkey;
      const bool own = (!latent) || pos < 4096;
      const int row = own ? krow0 + pos : T_ALL + b * 256 + (pos - 4096);
      const u16* srcn = p.KN + (size_t)row * 512 + h * 128 + lpart * 8;
      const u16* srcr = own ? p.P + (size_t)(krow0 + pos) * PW + P_MKR + lpart * 8
                            : p.KRC + (size_t)(b * 256 + pos - 4096) * 64 + lpart * 8;
      k0 = *(const uint4*)(srcn); k1 = *(const uint4*)(srcn + 32); k2 = *(const uint4*)(srcn + 64); k3 = *(const uint4*)(srcn + 96);
      k4 = *(const uint4*)(srcr); k5 = *(const uint4*)(srcr + 32);
    }
#pragma unroll
    for (int ks2 = 0; ks2 < 2; ++ks2) {
      bf16x8 pf0 = *(const bf16x8*)(sPw + (0 * 16 + r16) * PST + ks2 * 32 + g4 * 8);
      bf16x8 pf1 = *(const bf16x8*)(sPw + (1 * 16 + r16) * PST + ks2 * 32 + g4 * 8);
#pragma unroll
      for (int nd = 0; nd < 8; ++nd) {
        bf16x8 vf = *(const bf16x8*)(sV + (nd * 16 + r16) * VST + ks2 * 32 + g4 * 8);
        o[0][nd] = __builtin_amdgcn_mfma_f32_16x16x32_bf16(vf, pf0, o[0][nd], 0, 0, 0);
        o[1][nd] = __builtin_amdgcn_mfma_f32_16x16x32_bf16(vf, pf1, o[1][nd], 0, 0, 0);
      }
    }
  }
#pragma unroll
  for (int mi = 0; mi < 2; ++mi) {
    const float inv = 1.f / lrow[mi];
    const int qrow = tq0 + w * 32 + mi * 16 + r16;
    u16* op = p.HQ + (size_t)qrow * 768 + h * 192 + g4 * 4;
    if (dummy) op = p.HQ + (size_t)T_ALL * 768 + (size_t)(qrow % 9216) * 768 + h * 192 + g4 * 4;
#pragma unroll
    for (int nd = 0; nd < 8; ++nd) *(uint2*)(op + nd * 16) = pack4(o[mi][nd] * inv);
  }
}

#define XB_TMO      128
#define XB_XCNT(j)  (256  + 64 * (j))
#define XB_XSUB(j)  (1280 + 64 * (j))
#define XB_XGEN(j)  (2304 + 64 * (j))
#define XB_TOP      3328
#define XB_TOPGEN   3392
#define XCD_BAR_WORDS 3456
#define XB_SPIN_CAP (1u << 23)
#define LAS __attribute__((address_space(3)))

__device__ __forceinline__ unsigned xb_ld(unsigned* p)              { return __hip_atomic_load(p, __ATOMIC_RELAXED, __HIP_MEMORY_SCOPE_AGENT); }
__device__ __forceinline__ unsigned xb_add(unsigned* p, unsigned v) { return __hip_atomic_fetch_add(p, v, __ATOMIC_RELAXED, __HIP_MEMORY_SCOPE_AGENT); }
__device__ __forceinline__ unsigned xb_xcc_id() { return (unsigned)__builtin_amdgcn_s_getreg((3 << 11) | 20) & 0xFu; }
#define XB_SPIN(cond, bar) do { unsigned _sp = 0; while (cond) { __builtin_amdgcn_s_sleep(1); \
    if ((++_sp & 255u) == 0u) { if (xb_ld(&(bar)[XB_TMO])) break; if (_sp > XB_SPIN_CAP) { atomicAdd(&(bar)[XB_TMO], 1u); break; } } } } while (0)

struct XcdBarrier {
    unsigned* bar; unsigned x;
    volatile LAS unsigned* st;
};

__device__ __forceinline__ XcdBarrier xcd_barrier_post(unsigned* bar, volatile LAS unsigned* st) {
    XcdBarrier b; b.bar = bar; b.x = xb_xcc_id(); b.st = st;
    if (threadIdx.x == 0) (void)xb_add(&bar[XB_XCNT(b.x)], 1u);
    return b;
}
__device__ __forceinline__ void xcd_barrier_complete(unsigned* bar, unsigned x, unsigned& nloc, unsigned& nx) {
    const unsigned G = gridDim.x * gridDim.y * gridDim.z;
    unsigned sum, cnt, mine, sp = 0u;
    for (;;) {
        sum = 0u; cnt = 0u; mine = 0u;
#pragma unroll
        for (unsigned j = 0; j < 16; ++j) { const unsigned c = xb_ld(&bar[XB_XCNT(j)]); sum += c; cnt += (c > 0u) ? 1u : 0u; mine = (j == x) ? c : mine; }
        if (sum == G) break;
        __builtin_amdgcn_s_sleep(1);
        if ((++sp & 255u) == 0u) { if (xb_ld(&bar[XB_TMO])) break; if (sp > XB_SPIN_CAP) { atomicAdd(&bar[XB_TMO], 1u); break; } }
    }
    nloc = mine > 0u ? mine : 1u; nx = cnt > 0u ? cnt : 1u;
}

__device__ __forceinline__ void xcd_barrier(const XcdBarrier& b) {
    asm volatile("s_waitcnt vmcnt(0)" ::: "memory");
    __syncthreads();
    if (threadIdx.x == 0) {
        unsigned* bar = b.bar;
        __builtin_amdgcn_s_waitcnt(0);
        unsigned nloc = b.st[0], nx = b.st[1];
        if (nloc == 0u) { xcd_barrier_complete(bar, b.x, nloc, nx); b.st[0] = nloc; b.st[1] = nx; }
        const unsigned old = xb_add(&bar[XB_XSUB(b.x)], 1u);
        const unsigned gen = old / nloc;
        if (old + 1u == (gen + 1u) * nloc) {
            __builtin_amdgcn_fence(__ATOMIC_RELEASE, "agent");
            asm volatile("s_waitcnt vmcnt(0)" ::: "memory");
            const unsigned og = xb_add(&bar[XB_TOP], 1u);
            const unsigned tg = og / nx;
            if (og + 1u == (tg + 1u) * nx) xb_add(&bar[XB_TOPGEN], 1u);
            else XB_SPIN(xb_ld(&bar[XB_TOPGEN]) == tg, bar);
            __builtin_amdgcn_fence(__ATOMIC_ACQUIRE, "agent");
            xb_add(&bar[XB_XGEN(b.x)], 1u);
            asm volatile("s_waitcnt vmcnt(0)" ::: "memory");
        } else {
            XB_SPIN(xb_ld(&bar[XB_XGEN(b.x)]) == gen, bar);
            __builtin_amdgcn_fence(__ATOMIC_ACQUIRE, "agent");
            asm volatile("s_waitcnt vmcnt(0)" ::: "memory");
        }
    }
    __syncthreads();
}


__device__ __forceinline__ void gbar(unsigned* ctr, unsigned target) {
  asm volatile("s_waitcnt vmcnt(0)" ::: "memory");
  __syncthreads();
  if (tid_l() == 0) {
    __builtin_amdgcn_fence(__ATOMIC_RELEASE, "agent");
    asm volatile("s_waitcnt vmcnt(0)" ::: "memory");
    __hip_atomic_fetch_add(ctr, 1u, __ATOMIC_RELAXED, __HIP_MEMORY_SCOPE_AGENT);
    while (__hip_atomic_load(ctr, __ATOMIC_RELAXED, __HIP_MEMORY_SCOPE_AGENT) < target) __builtin_amdgcn_s_sleep(2);
    __builtin_amdgcn_fence(__ATOMIC_ACQUIRE, "agent");
    asm volatile("s_waitcnt vmcnt(0)" ::: "memory");
  }
  __syncthreads();
}
#define MFMA4(a, b, c) __builtin_amdgcn_mfma_f32_16x16x4f32((a), (b), (c), 0, 0, 0)

__device__ __forceinline__ float softplusf_(float x) { return fmaxf(x, 0.f) + log1pf(__expf(-fabsf(x))); }

__device__ __forceinline__ void gdn_chain(const Params& p, int l, int seq, int h, int d, int vs, float* sm) {
  float* sMM = sm;
  float* sK = sMM + 64 * 68;
  u16* sQb = (u16*)(sK + 64 * 65);
  u16* sKb = sQb + 64 * 80;
  float* sV = (float*)(sKb + 64 * 80);
  float* sS = sV + 64 * 33;
  float* sGc = sS + 64 * 33;
  float* sBeta = sGc + 64;
  float* sBg = sBeta + 64;
  u16* sSb = (u16*)(sBg + 64);
  const int tid = tid_l(), lane = tid & 63, w = tid >> 6, r16 = lane & 15, g4 = lane >> 4;
  const bool latent = seq >= 16;
  const int len = latent ? 4096 : 256;
  const int t0 = latent ? T_CTX + (seq - 16) * 4096 : seq * 256;
  const int nchunks = len >> 6;
  const float Acoef = -__expf(p.gdn_a_log[l * 8 + d * 4 + h]);
  const float dtb = p.gdn_dt_bias[l * 8 + d * 4 + h];
  f32x4 Sreg[2];
  __syncthreads();
  {
    const float* s0 = latent ? p.state_gdn + ((((size_t)(seq - 16) * 2 + l) * 2 + d) * 4 + h) * 4096 : nullptr;
#pragma unroll
    for (int n = 0; n < 2; ++n)
#pragma unroll
      for (int r = 0; r < 4; ++r) {
        const int kidx = 16 * w + g4 * 4 + r, cc = n * 16 + r16;
        float v = latent ? s0[kidx * 64 + vs * 32 + cc] : 0.f;
        Sreg[n][r] = v;
        sS[kidx * 33 + cc] = v;
      }
#pragma unroll
    for (int n = 0; n < 2; ++n) *(uint2*)(sSb + (n * 16 + r16) * 80 + 16 * w + g4 * 4) = pack4(Sreg[n]);
  }
  const u16* Pb = p.P + (size_t)t0 * PW;
  const u16* VHb = p.HQ + (size_t)T_ALL * 768 + (size_t)t0 * 256;
#define GDN_SRC(i, tl, tlo_) ({ const int e_ = (tl) + (i) * 256; const int u_ = e_ / 20, un_ = e_ % 20; \
    (un_ < 16) ? (Pb + (size_t)((tlo_) + u_) * PW + (un_ < 8 ? P_QH + h * 64 + un_ * 8 : P_KH + h * 64 + (un_ - 8) * 8)) \
               : (VHb + (size_t)((tlo_) + u_) * 256 + h * 64 + vs * 32 + (un_ - 16) * 8); })
  uint4 pf[5];
  float pga = 0.f, pgb = 0.f;
  {
    const int tlo = d == 0 ? 0 : len - 64;
#pragma unroll
    for (int i = 0; i < 5; ++i) pf[i] = *(const uint4*)GDN_SRC(i, tid, tlo);
    if (tid < 64) {
      const int u = d == 0 ? tid : 63 - tid;
      const float* gab = p.GAB + (size_t)(t0 + tlo + u) * 16;
      pga = gab[d * 4 + h]; pgb = gab[8 + d * 4 + h];
    }
  }
  for (int n = 0; n < nchunks; ++n) {
    const int tlo = d == 0 ? n * 64 : len - 64 * (n + 1);
    const int tl2 = tid_l();
#pragma unroll
    for (int i = 0; i < 5; ++i) {
      const int e = tl2 + i * 256;
      const int u = e / 20, un = e % 20;
      const int pp = d == 0 ? u : 63 - u;
      if (un < 8) { *(uint4*)(sQb + pp * 80 + un * 8) = pf[i]; }
      else {
        if (un < 16) *(uint4*)(sKb + pp * 80 + (un - 8) * 8) = pf[i];
        float* dq = un < 16 ? sK + pp * 65 + (un - 8) * 8 : sV + pp * 33 + (un - 16) * 8;
        const unsigned wv[4] = {pf[i].x, pf[i].y, pf[i].z, pf[i].w};
#pragma unroll
        for (int j = 0; j < 4; ++j) { dq[2 * j] = bf2f((u16)(wv[j] & 0xffff)); dq[2 * j + 1] = bf2f((u16)(wv[j] >> 16)); }
      }
    }
    if (tid < 64) {
      const int pp = tid;
      float g = Acoef * softplusf_(pga + dtb);
      float bt = sigmoidf_(pgb);
#pragma unroll
      for (int o = 1; o < 64; o <<= 1) { float tt = __shfl_up(g, o); if (lane >= o) g += tt; }
      sGc[pp] = g; sBeta[pp] = bt; sBg[pp] = bt * __expf(g);
    }
    if (n + 1 < nchunks) {
      const int tlo2 = d == 0 ? (n + 1) * 64 : len - 64 * (n + 2);
#pragma unroll
      for (int i = 0; i < 5; ++i) pf[i] = *(const uint4*)GDN_SRC(i, tl2, tlo2);
      if (tid < 64) {
        const int u = d == 0 ? tid : 63 - tid;
        const float* gab = p.GAB + (size_t)(t0 + tlo2 + u) * 16;
        pga = gab[d * 4 + h]; pgb = gab[8 + d * 4 + h];
      }
    }
    __syncthreads();
    const unsigned tcode = w == 0 ? 0x730u : (w == 1 ? 0xA51u : (w == 2 ? 0x062u : 0x0FBu));
    const int tcnt = w < 2 ? 3 : 2;
    f32x4 attacc[3];
#pragma unroll
    for (int t = 0; t < 3; ++t) {
      attacc[t] = f32x4{0.f, 0.f, 0.f, 0.f};
      if (t < tcnt) {
        const int ti = (tcode >> (4 * t)) & 3, tn = (tcode >> (4 * t + 2)) & 3;
        f32x4 accm = f32x4{0.f, 0.f, 0.f, 0.f};
        const u16* akb = sKb + (16 * ti + r16) * 80 + g4 * 8;
        const u16* aqb = sQb + (16 * ti + r16) * 80 + g4 * 8;
        const u16* bkb = sKb + (16 * tn + r16) * 80 + g4 * 8;
        const bf16x8 ak0 = *(const bf16x8*)(akb), ak1 = *(const bf16x8*)(akb + 32);
        const bf16x8 aq0 = *(const bf16x8*)(aqb), aq1 = *(const bf16x8*)(aqb + 32);
        const bf16x8 bk0 = *(const bf16x8*)(bkb), bk1 = *(const bf16x8*)(bkb + 32);
        accm = __builtin_amdgcn_mfma_f32_16x16x32_bf16(ak0, bk0, accm, 0, 0, 0);
        accm = __builtin_amdgcn_mfma_f32_16x16x32_bf16(ak1, bk1, accm, 0, 0, 0);
        attacc[t] = __builtin_amdgcn_mfma_f32_16x16x32_bf16(aq0, bk0, attacc[t], 0, 0, 0);
        attacc[t] = __builtin_amdgcn_mfma_f32_16x16x32_bf16(aq1, bk1, attacc[t], 0, 0, 0);
#pragma unroll
        for (int r = 0; r < 4; ++r) {
          const int i = 16 * ti + g4 * 4 + r, j = 16 * tn + r16;
          sMM[i * 68 + j] = (i > j) ? sBeta[i] * accm[r] * __expf(sGc[i] - sGc[j]) : 0.f;
        }
      }
    }
    __syncthreads();
    if (w == 0) {
      const int bi = tid >> 4, c = tid & 15;
      float* md = sMM + (16 * bi) * 68 + 16 * bi;
      float a[16];
#pragma unroll
      for (int r = 0; r < 16; ++r) a[r] = (r == c) ? 1.f : 0.f;
#pragma unroll
      for (int r = 1; r < 16; ++r) {
#pragma unroll
        for (int q4 = 0; q4 < (r + 3) / 4; ++q4) {
          const float4 m = *(const float4*)(md + r * 68 + 4 * q4);
          if (q4 * 4 + 0 < r) a[r] -= m.x * a[q4 * 4 + 0];
          if (q4 * 4 + 1 < r) a[r] -= m.y * a[q4 * 4 + 1];
          if (q4 * 4 + 2 < r) a[r] -= m.z * a[q4 * 4 + 2];
          if (q4 * 4 + 3 < r) a[r] -= m.w * a[q4 * 4 + 3];
        }
      }
      __builtin_amdgcn_fence(__ATOMIC_SEQ_CST, "wavefront");
#pragma unroll
      for (int r = 0; r < 16; ++r) md[r * 68 + c] = a[r];
    } else {
      for (int t = w - 1; t < 8; t += 3) {
        const int ti = t >> 1, tc = t & 1;
        const u16* akb = sKb + (16 * ti + r16) * 80 + g4 * 8;
        const u16* bsb = sSb + (16 * tc + r16) * 80 + g4 * 8;
        f32x4 acc = f32x4{0.f, 0.f, 0.f, 0.f};
        acc = __builtin_amdgcn_mfma_f32_16x16x32_bf16(*(const bf16x8*)(akb), *(const bf16x8*)(bsb), acc, 0, 0, 0);
        acc = __builtin_amdgcn_mfma_f32_16x16x32_bf16(*(const bf16x8*)(akb + 32), *(const bf16x8*)(bsb + 32), acc, 0, 0, 0);
#pragma unroll
        for (int r = 0; r < 4; ++r) {
          const int i = 16 * ti + g4 * 4 + r, cc = 16 * tc + r16;
          sV[i * 33 + cc] = sV[i * 33 + cc] * sBeta[i] - sBg[i] * acc[r];
        }
      }
    }
    __syncthreads();
    for (int ib = 0; ib < 4; ++ib) {
      if (w < 2) {
        const int ct = w;
        f32x4 acc = f32x4{0.f, 0.f, 0.f, 0.f};
        const float* am = sMM + (16 * ib + r16) * 68 + g4;
        const float* bx = sV + g4 * 33 + 16 * ct + r16;
        for (int s4 = 0; s4 < ib; ++s4) {
#pragma unroll
          for (int s = 0; s < 4; ++s) acc = MFMA4(am[16 * s4 + 4 * s], bx[(16 * s4 + 4 * s) * 33], acc);
        }
        f32x4 rm;
#pragma unroll
        for (int r = 0; r < 4; ++r) rm[r] = sV[(16 * ib + g4 * 4 + r) * 33 + 16 * ct + r16] - acc[r];
        const float* dd = sMM + (16 * ib + r16) * 68 + 16 * ib + 4 * g4;
        f32x4 xn = f32x4{0.f, 0.f, 0.f, 0.f};
#pragma unroll
        for (int s = 0; s < 4; ++s) xn = MFMA4(dd[s], rm[s], xn);
#pragma unroll
        for (int r = 0; r < 4; ++r) sV[(16 * ib + g4 * 4 + r) * 33 + 16 * ct + r16] = xn[r];
        __builtin_amdgcn_fence(__ATOMIC_SEQ_CST, "wavefront");
      }
    }
    __syncthreads();
#pragma unroll
    for (int t = 0; t < 3; ++t) {
      if (t < tcnt) {
        const int ti = (tcode >> (4 * t)) & 3, tn = (tcode >> (4 * t + 2)) & 3;
#pragma unroll
        for (int r = 0; r < 4; ++r) {
          const int i = 16 * ti + g4 * 4 + r, j = 16 * tn + r16;
          sMM[i * 68 + j] = (i >= j) ? attacc[t][r] * __expf(sGc[i] - sGc[j]) : 0.f;
        }
      }
    }
    __syncthreads();
    {
      f32x4 acc[2] = {f32x4{0.f, 0.f, 0.f, 0.f}, f32x4{0.f, 0.f, 0.f, 0.f}};
      const float eg = __expf(sGc[16 * w + r16]);
      {
        const u16* qb = sQb + (16 * w + r16) * 80 + g4 * 8;
        const bf16x8 q0 = *(const bf16x8*)(qb), q1 = *(const bf16x8*)(qb + 32);
#pragma unroll
        for (int nn = 0; nn < 2; ++nn) {
          const u16* sb = sSb + (16 * nn + r16) * 80 + g4 * 8;
          acc[nn] = __builtin_amdgcn_mfma_f32_16x16x32_bf16(*(const bf16x8*)(sb), q0, acc[nn], 0, 0, 0);
          acc[nn] = __builtin_amdgcn_mfma_f32_16x16x32_bf16(*(const bf16x8*)(sb + 32), q1, acc[nn], 0, 0, 0);
          acc[nn] *= eg;
        }
      }
#pragma unroll
      for (int s = 0; s < 16; ++s) {
        if (s < 4 * (w + 1)) {
          const float a = sMM[(16 * w + r16) * 68 + 4 * s + g4];
          acc[0] = MFMA4(sV[(4 * s + g4) * 33 + r16], a, acc[0]);
          acc[1] = MFMA4(sV[(4 * s + g4) * 33 + 16 + r16], a, acc[1]);
        }
      }
      {
        const int pp = 16 * w + r16;
        const int u = d == 0 ? pp : 63 - pp;
        u16* op = p.MIX + (size_t)(t0 + tlo + u) * 1024 + d * 256 + h * 64 + vs * 32 + g4 * 4;
        *(uint2*)(op) = pack4(acc[0]);
        *(uint2*)(op + 16) = pack4(acc[1]);
      }
    }
    __syncthreads();
    {
      const float g63 = sGc[63];
      const float gl = __expf(g63);
#pragma unroll
      for (int nn = 0; nn < 2; ++nn)
#pragma unroll
        for (int r = 0; r < 4; ++r) Sreg[nn][r] *= gl;
#pragma unroll
      for (int s = 0; s < 16; ++s) {
        const int srow = 4 * s + g4;
        const float a = sK[srow * 65 + 16 * w + r16] * __expf(g63 - sGc[srow]);
        Sreg[0] = MFMA4(a, sV[srow * 33 + r16], Sreg[0]);
        Sreg[1] = MFMA4(a, sV[srow * 33 + 16 + r16], Sreg[1]);
      }
    }
    __syncthreads();
#pragma unroll
    for (int nn = 0; nn < 2; ++nn) *(uint2*)(sSb + (nn * 16 + r16) * 80 + 16 * w + g4 * 4) = pack4(Sreg[nn]);
    __syncthreads();
  }
  if (!latent) {
    float* so = p.out + OUT_SGDN + ((((size_t)seq * 2 + l) * 2 + d) * 4 + h) * 4096;
#pragma unroll
    for (int nn = 0; nn < 2; ++nn)
#pragma unroll
      for (int r = 0; r < 4; ++r) so[(16 * w + g4 * 4 + r) * 64 + vs * 32 + nn * 16 + r16] = Sreg[nn][r];
  }
}

__device__ __forceinline__ void hgrn_chain(const Params& p, int l, int seq, int h, int d, int vs, float* sm) {
  float* sBC = sm;
  float* sK = sBC + 64 * 65;
  float* sAT = sK + 64 * 65;
  float* sV = sAT + 64 * 68;
  float* sS = sV + 64 * 33;
  float* sTot = sS + 64 * 33;
  u16* sSb = (u16*)(sTot + 256 + 64);
  const int tid = tid_l(), lane = tid & 63, w = tid >> 6, r16 = lane & 15, g4 = lane >> 4;
  const bool latent = seq >= 16;
  const int len = latent ? 4096 : 256;
  const int t0 = latent ? T_CTX + (seq - 16) * 4096 : seq * 256;
  const int nchunks = len >> 6;
  float lbk;
  {
    const int kch = h * 64 + (tid & 63);
    lbk = (l == 0) ? 0.f : sigmoidf_(p.hgrn_lb[256 + kch] - p.hgrn_lb[kch]);
  }
  f32x4 Sreg[2];
  __syncthreads();
  {
    const float* s0 = latent ? p.state_hgrn + ((((size_t)(seq - 16) * 2 + l) * 2 + d) * 4 + h) * 4096 : nullptr;
#pragma unroll
    for (int n = 0; n < 2; ++n)
#pragma unroll
      for (int r = 0; r < 4; ++r) {
        const int kidx = 16 * w + g4 * 4 + r, cc = n * 16 + r16;
        float v = latent ? s0[kidx * 64 + vs * 32 + cc] : 0.f;
        Sreg[n][r] = v;
        sS[kidx * 33 + cc] = v;
      }
#pragma unroll
    for (int n = 0; n < 2; ++n) *(uint2*)(sSb + (n * 16 + r16) * 80 + 16 * w + g4 * 4) = pack4(Sreg[n]);
  }
  const u16* Pb = p.P + (size_t)t0 * PW;
  float* sLb = sTot + 256;
  if (tid < 64) sLb[tid] = lbk;
  __syncthreads();
  int pgo[5];
#pragma unroll
  for (int i = 0; i < 5; ++i) {
    const int e = tid + i * 256;
    const int u = e / 20, un = e % 20;
    pgo[i] = u * PW + (un < 8 ? P_HF + d * 256 + h * 64 + un * 8 : (un < 12 ? P_HI + h * 64 + vs * 32 + (un - 8) * 8 : P_HQ + h * 64 + (un - 12) * 8));
  }
  uint4 pf[5];
  {
    const int tlo = d == 0 ? 0 : len - 64;
#pragma unroll
    for (int i = 0; i < 5; ++i) pf[i] = *(const uint4*)(Pb + (size_t)tlo * PW + pgo[i]);
  }
  for (int n = 0; n < nchunks; ++n) {
#pragma unroll
    for (int i = 0; i < 5; ++i) {
      const int e = tid + i * 256;
      const int u = e / 20, un = e % 20;
      const int pp = d == 0 ? u : 63 - u;
      const unsigned wv[4] = {pf[i].x, pf[i].y, pf[i].z, pf[i].w};
#pragma unroll
      for (int j = 0; j < 8; ++j) {
        const float x = bf2f((u16)((wv[j >> 1] >> ((j & 1) * 16)) & 0xffff));
        if (un < 8) {
          const int k = un * 8 + j;
          const float lb = sLb[k];
          const float sg_ = sigmoidf_(x);
          const float gate = lb + (1.f - lb) * sg_;
          sBC[pp * 65 + k] = __logf(fmaxf(gate, 1e-30f));
          sK[pp * 65 + k] = (1.f - lb) * (1.f - sg_);
        } else if (un < 12) {
          sV[pp * 33 + (un - 8) * 8 + j] = x;
        } else {
          sAT[pp * 68 + (un - 12) * 8 + j] = x;
        }
      }
    }
    __syncthreads();
    if (n + 1 < nchunks) {
      const int tlo2 = d == 0 ? (n + 1) * 64 : len - 64 * (n + 2);
#pragma unroll
      for (int i = 0; i < 5; ++i) pf[i] = *(const uint4*)(Pb + (size_t)tlo2 * PW + pgo[i]);
    }
    const int tlo = d == 0 ? n * 64 : len - 64 * (n + 1);
    float cs[16];
    {
      const int k = tid & 63, sg = tid >> 6;
      float run = 0.f;
#pragma unroll
      for (int i = 0; i < 16; ++i) { run += sBC[(16 * sg + i) * 65 + k]; cs[i] = run; }
      sTot[sg * 64 + k] = run;
    }
    float qa[16];
#pragma unroll
    for (int s = 0; s < 16; ++s) qa[s] = sAT[(16 * w + r16) * 68 + 4 * s + g4];
    __syncthreads();
    {
      const int k = tid & 63, sg = tid >> 6;
      float off = 0.f;
      for (int s2 = 0; s2 < sg; ++s2) off += sTot[s2 * 64 + k];
#pragma unroll
      for (int i = 0; i < 16; ++i) sBC[(16 * sg + i) * 65 + k] = cs[i] + off;
    }
    __syncthreads();
    f32x4 o1[2] = {f32x4{0.f, 0.f, 0.f, 0.f}, f32x4{0.f, 0.f, 0.f, 0.f}};
    {
      const float* qrow = sAT + (16 * w + r16) * 68 + g4 * 8;
      const float* bcrow = sBC + (16 * w + r16) * 65 + g4 * 8;
      bf16x8 af[2];
#pragma unroll
      for (int ks = 0; ks < 2; ++ks) {
        float v[8];
#pragma unroll
        for (int j = 0; j < 8; ++j) v[j] = qrow[ks * 32 + j] * __expf(bcrow[ks * 32 + j]);
        af[ks] = __builtin_bit_cast(bf16x8, pack8(v));
      }
#pragma unroll
      for (int nn = 0; nn < 2; ++nn) {
        const u16* sb = sSb + (16 * nn + r16) * 80 + g4 * 8;
        o1[nn] = __builtin_amdgcn_mfma_f32_16x16x32_bf16(*(const bf16x8*)(sb), af[0], o1[nn], 0, 0, 0);
        o1[nn] = __builtin_amdgcn_mfma_f32_16x16x32_bf16(*(const bf16x8*)(sb + 32), af[1], o1[nn], 0, 0, 0);
      }
    }
    {
      float aq[16], rf[16];
#pragma unroll
      for (int s = 0; s < 16; ++s) {
        const int kk = 4 * s + g4;
        rf[s] = (w == 0) ? 0.f : sBC[(16 * w - 1) * 65 + kk];
        aq[s] = qa[s] * __expf(sBC[(16 * w + r16) * 65 + kk] - rf[s]);
      }
#pragma unroll
      for (int nn = 0; nn < 4; ++nn) {
        f32x4 acc = f32x4{0.f, 0.f, 0.f, 0.f};
        if (nn <= w) {
#pragma unroll
          for (int s = 0; s < 16; ++s) {
            const int kk = 4 * s + g4, sc = 16 * nn + r16;
            const float bv = sK[sc * 65 + kk] * __expf(fminf(rf[s] - sBC[sc * 65 + kk], 80.f));
            acc = MFMA4(aq[s], bv, acc);
          }
        }
#pragma unroll
        for (int r = 0; r < 4; ++r) {
          const int i = 16 * w + g4 * 4 + r, j = 16 * nn + r16;
          sAT[i * 68 + j] = (i >= j) ? acc[r] : 0.f;
        }
      }
    }
    __syncthreads();
    {
      f32x4 acc[2] = {o1[0], o1[1]};
#pragma unroll
      for (int s = 0; s < 16; ++s) {
        if (s < 4 * (w + 1)) {
          const float a = sAT[(16 * w + r16) * 68 + 4 * s + g4];
          acc[0] = MFMA4(sV[(4 * s + g4) * 33 + r16], a, acc[0]);
          acc[1] = MFMA4(sV[(4 * s + g4) * 33 + 16 + r16], a, acc[1]);
        }
      }
      {
        const int pp = 16 * w + r16;
        const int u = d == 0 ? pp : 63 - pp;
        u16* op = p.MIX + (size_t)(t0 + tlo + u) * 1024 + 512 + d * 256 + h * 64 + vs * 32 + g4 * 4;
        *(uint2*)(op) = pack4(acc[0]);
        *(uint2*)(op + 16) = pack4(acc[1]);
      }
    }
    __syncthreads();
    {
#pragma unroll
      for (int nn = 0; nn < 2; ++nn)
#pragma unroll
        for (int r = 0; r < 4; ++r) Sreg[nn][r] *= __expf(sBC[63 * 65 + 16 * w + g4 * 4 + r]);
      const int kA = 16 * w + r16;
      const float blA = sBC[63 * 65 + kA];
#pragma unroll
      for (int ks = 0; ks < 2; ++ks) {
        float va[8], v0[8], v1[8];
#pragma unroll
        for (int j = 0; j < 8; ++j) {
          const int srow = ks * 32 + g4 * 8 + j;
          va[j] = sK[srow * 65 + kA] * __expf(blA - sBC[srow * 65 + kA]);
          v0[j] = sV[srow * 33 + r16]; v1[j] = sV[srow * 33 + 16 + r16];
        }
        const bf16x8 af = __builtin_bit_cast(bf16x8, pack8(va));
        Sreg[0] = __builtin_amdgcn_mfma_f32_16x16x32_bf16(af, __builtin_bit_cast(bf16x8, pack8(v0)), Sreg[0], 0, 0, 0);
        Sreg[1] = __builtin_amdgcn_mfma_f32_16x16x32_bf16(af, __builtin_bit_cast(bf16x8, pack8(v1)), Sreg[1], 0, 0, 0);
      }
    }
    __syncthreads();
#pragma unroll
    for (int nn = 0; nn < 2; ++nn) *(uint2*)(sSb + (nn * 16 + r16) * 80 + 16 * w + g4 * 4) = pack4(Sreg[nn]);
    __syncthreads();
  }
  if (!latent) {
    float* so = p.out + OUT_SHG + ((((size_t)seq * 2 + l) * 2 + d) * 4 + h) * 4096;
#pragma unroll
    for (int nn = 0; nn < 2; ++nn)
#pragma unroll
      for (int r = 0; r < 4; ++r) so[(16 * w + g4 * 4 + r) * 64 + vs * 32 + nn * 16 + r16] = Sreg[nn][r];
  }
}

__device__ __forceinline__ void phase_c(const Params& p, int l, unsigned char* smraw, int mode = 0) {
  __shared__ int s_item;
  const int total = 1920;
  const bool paired = (gridDim.x == 512);
  const int jx = blockIdx.x >> 3;
  int my_static = -1;
  if (paired && (jx & 31) < 16) my_static = (blockIdx.x & 7) * 32 + (jx & 15) * 2 + (jx >> 5);
  for (;;) {
    __syncthreads();
    if (tid_l() == 0) {
      if (my_static >= 0) s_item = my_static;
      else s_item = (paired ? 256 : 0) + (int)atomicAdd(&p.counters[l * 64 + mode * 16], 1u);
    }
    __syncthreads();
    my_static = -1;
    const int item = s_item;
    if (item >= total) break;
    int kind, a0, a1, a2, a3;
    if (item < 256 || (item >= 1280 && item < 1792)) {
      const int i2 = item < 256 ? item : item - 1280;
      const int rest = i2 >> 1;
      kind = i2 & 1;
      a3 = rest & 1; a2 = (rest >> 1) & 1; a1 = (rest >> 2) & 3; a0 = (rest >> 4) + (item < 256 ? 16 : 0);
    } else if (item < 1280) {
      const int i2 = item - 256;
      kind = 2; a0 = 1; a1 = i2 >> 7; a2 = (i2 >> 5) & 3; a3 = i2 & 31;
    } else {
      const int i2 = item - 1792;
      kind = 2; a0 = 0; a1 = i2 >> 3; a2 = (i2 >> 1) & 3; a3 = i2 & 1;
    }
    if (mode == 1 && kind == 2) continue;
    if (mode == 2 && kind != 2) continue;
    if (kind != 2) __builtin_amdgcn_s_setprio(3);
    if (kind == 0) gdn_chain(p, l, a0, a1, a2, a3, (float*)smraw);
    else if (kind == 1) hgrn_chain(p, l, a0, a1, a2, a3, (float*)smraw);
    if (kind != 2) __builtin_amdgcn_s_setprio(0);
    else attn_item(p, a0, a1, a2, a3, smraw, mode == 2);
  }
}

__global__ void __launch_bounds__(NTHR, 2) mega(Params p) {
  __shared__ __attribute__((aligned(16))) unsigned char smem[LDS_BYTES];
  cg::grid_group grid = cg::this_grid();
  __shared__ uint4 xb_words;
  if (threadIdx.x == 0) xb_words = make_uint4(0u, 0u, 0u, 0u);
  __syncthreads();
  {
    XcdBarrier xb0 = xcd_barrier_post(p.xbar, (volatile LAS unsigned*)&xb_words);
    if (threadIdx.x == 0) ((volatile LAS unsigned*)&xb_words)[2] = xb0.x;
  }
#define GSYNC() do { XcdBarrier xb_; xb_.bar = p.xbar; xb_.st = (volatile LAS unsigned*)&xb_words; xb_.x = 0; \
    if (threadIdx.x == 0) xb_.x = ((volatile LAS unsigned*)&xb_words)[2]; xcd_barrier(xb_); } while (0)
  phase0(p, (float*)smem);
  if (p.out == nullptr) grid.sync();
  GSYNC();
  rowpass_norm(p, 0, 0);
  GSYNC();
  for (int l = 0; l < 2; ++l) {
    phase_a(p, l, (u16*)smem);
    GSYNC();
    rowpass_b0(p, l);
    GSYNC();
    phase_b1(p, l, (u16*)smem);
    GSYNC();
    rowpass_b2(p, l);
    GSYNC();
    phase_c(p, l, smem);
    GSYNC();
    rowpass_c2(p, l);
    GSYNC();
    phase_gemm_y(p.MIX, 1024, p.WoutT + (size_t)l * 1024 * 1024, 1024, 1024, p.HQ, 1024, (u16*)smem);
    GSYNC();
    rowpass_norm(p, l, 1);
    GSYNC();
    phase_e(p, l, (u16*)smem);
    GSYNC();
    phase_gemm_y(p.P, DFF, p.WfoT + (size_t)l * 1024 * DFF, DFF, 1024, p.HQ, 1024, (u16*)smem);
    GSYNC();
    rowpass_norm(p, l, 2);
    if (l == 0) GSYNC();
  }
}

extern "C" void kernel_launch(void* const* d_in, const int* in_sizes, int n_in, void* d_out, int out_size, void* d_ws,
                              size_t ws_size, hipStream_t stream) {
  static int grid_blocks = 0;
  if (!grid_blocks) {
    int dev = 0, cus = 0, per_cu = 0;
    hipGetDevice(&dev);
    hipDeviceGetAttribute(&cus, hipDeviceAttributeMultiprocessorCount, dev);
    hipOccupancyMaxActiveBlocksPerMultiprocessor(&per_cu, mega, NTHR, 0);
    if (per_cu > 2) per_cu = 2;
    if (per_cu < 1) per_cu = 1;
    grid_blocks = cus * per_cu;
  }
  Params p{};
  const float* const* in = (const float* const*)d_in;
  p.x_prompt = in[0]; p.x_sample = in[1]; p.cache_ckv = in[2]; p.cache_kr = in[3]; p.state_gdn = in[4]; p.state_hgrn = in[5];
  p.c = in[6]; p.c_ctx = in[7]; p.w_ada = in[8]; p.b_ada = in[9]; p.g_pre_mix = in[10]; p.g_post_mix = in[11];
  p.g_pre_ffn = in[12]; p.g_post_ffn = in[13]; p.w_in = in[14]; p.w_out = in[15]; p.gdn_conv_w = in[16];
  p.gdn_a_log = in[17]; p.gdn_dt_bias = in[18]; p.gdn_norm_w = in[19]; p.hgrn_lb = in[20]; p.hgrn_norm_w = in[21];
  p.mla_q_norm_w = in[22]; p.mla_w_uq = in[23]; p.mla_kv_norm_w = in[24]; p.mla_w_ukv = in[25]; p.w_ffn_in = in[26];
  p.w_ffn_out = in[27];
  p.out = (float*)d_out;
  unsigned char* ws = (unsigned char*)d_ws;
  size_t off = 0;
  auto take = [&](size_t bytes) { unsigned char* r = ws + off; off += (bytes + 255) & ~(size_t)255; return r; };
  p.counters = (unsigned*)take(1024);
  p.xbar = (unsigned*)take(16384);
  p.WinT = (u16*)take((size_t)2 * 3072 * 1024 * 2);
  p.WuqT = (u16*)take((size_t)2 * 768 * 384 * 2);
  p.WukvT = (u16*)take((size_t)2 * 1024 * 256 * 2);
  p.WoutT = (u16*)take((size_t)2 * 1024 * 1024 * 2);
  p.WfiT = (u16*)take((size_t)2 * 5632 * 1024 * 2);
  p.WfoT = (u16*)take((size_t)2 * 1024 * 2816 * 2);
  p.mod = (float*)take((size_t)2 * 9 * 6144 * 4);
  p.HQ = (u16*)take((size_t)T_ALL * 1024 * 2);
  p.P = (u16*)take((size_t)T_ALL * PW * 2);
  p.KN = (u16*)take((size_t)(T_ALL + 2048) * 512 * 2);
  p.VTL = (u16*)take((size_t)8 * 4 * 128 * 4352 * 2);
  p.VTC = (u16*)take((size_t)16 * 4 * 128 * 256 * 2);
  p.CKVC = (u16*)take((size_t)2048 * 256 * 2);
  p.KRC = (u16*)take((size_t)2048 * 64 * 2);
  p.GAB = (float*)take((size_t)T_ALL * 16 * 4);
  p.MIX = (u16*)take((size_t)T_ALL * 1024 * 2);
  if (off > ws_size) { fprintf(stderr, "workspace too small: need %zu have %zu\n", off, ws_size); return; }
  hipMemsetAsync(p.counters, 0, 1024 + 16384, stream);
  void* args[] = {&p};
  hipError_t e = hipLaunchCooperativeKernel((void*)mega, dim3(grid_blocks), dim3(NTHR), args, 0, stream);
  if (e != hipSuccess) fprintf(stderr, "cooperative launch failed: %s (grid %d)\n", hipGetErrorString(e), grid_blocks);
}
```

```cpp
#include <hip/hip_runtime.h>
#include <hip/hip_cooperative_groups.h>
#include <cstdio>
namespace cg = cooperative_groups;

typedef unsigned short u16;
using bf16x8 = __attribute__((ext_vector_type(8))) short;
using f32x4  = __attribute__((ext_vector_type(4))) float;

#define T_CTX 4096
#define T_ALL 36864
#define PW 3072
#define DFF 2816
#define LDS_BYTES 77824
#define NTHR 256

#define P_GQKV 0
#define P_GZ 768
#define P_HQ 1024
#define P_HI 1280
#define P_HF 1536
#define P_HG 2048
#define P_MCQ 2304
#define P_MCKV 2688
#define P_MKR 2944
#define P_GA 3008

struct Params {
  const float *x_prompt, *x_sample, *cache_ckv, *cache_kr, *state_gdn, *state_hgrn, *c, *c_ctx;
  const float *w_ada, *b_ada, *g_pre_mix, *g_post_mix, *g_pre_ffn, *g_post_ffn, *w_in, *w_out;
  const float *gdn_conv_w, *gdn_a_log, *gdn_dt_bias, *gdn_norm_w, *hgrn_lb, *hgrn_norm_w;
  const float *mla_q_norm_w, *mla_w_uq, *mla_kv_norm_w, *mla_w_ukv, *w_ffn_in, *w_ffn_out;
  float* out;
  u16 *WinT, *WuqT, *WukvT, *WoutT, *WfiT, *WfoT;
  float* mod;
  u16 *HQ, *P, *KN, *VTL, *VTC, *CKVC, *KRC, *MIX;
  float* GAB;
  unsigned* counters;
  unsigned* xbar;
};

#define OUT_CKV   37748736
#define OUT_KR    39845888
#define OUT_SGDN  40370176
#define OUT_SHG   41418752

__device__ __forceinline__ u16 f2bf(float f) {
  unsigned u = __float_as_uint(f);
  u += 0x7fffu + ((u >> 16) & 1u);
  return (u16)(u >> 16);
}
typedef __attribute__((ext_vector_type(2))) __bf16 bf16x2_t;
typedef __attribute__((ext_vector_type(2))) float f32x2_t;
__device__ __forceinline__ unsigned pack2bf(float x, float y) {
  return __builtin_bit_cast(unsigned, __builtin_convertvector((f32x2_t){x, y}, bf16x2_t));
}
__device__ __forceinline__ float bf2f(u16 h) { return __uint_as_float(((unsigned)h) << 16); }
__device__ __forceinline__ float wave_sum(float v) {
#pragma unroll
  for (int o = 32; o > 0; o >>= 1) v += __shfl_xor(v, o);
  return v;
}
__device__ __forceinline__ float sigmoidf_(float x) { return __builtin_amdgcn_rcpf(1.f + __expf(-x)); }
__device__ __forceinline__ float siluf_(float x) { return x * __builtin_amdgcn_rcpf(1.f + __expf(-x)); }
__device__ __forceinline__ int tid_l() { int t = threadIdx.x; asm volatile("" : "+v"(t)); return t; }
__device__ __forceinline__ int tok_mod(int t) { return t < T_CTX ? 0 : 1 + ((t - T_CTX) >> 12); }

__device__ __forceinline__ int map_col(int kind, int j) {
  if (kind == 0) return j;
  if (kind == 1) { if (j < 1024) return j; if (j < 3008) return j + 16; if (j < 3024) return 1024 + (j - 3008); return -1; }
  int blk = j >> 6, w = j & 63;
  return w < 32 ? blk * 32 + w : DFF + blk * 32 + (w - 32);
}

__device__ __forceinline__ void cvt_tile(const float* __restrict__ src, int K, int Nsrc, u16* __restrict__ dst, int kind, int jt, int kt, float* sm) {
  const int tid = tid_l();
  const int j0 = jt * 64, k0 = kt * 64;
  __syncthreads();
  {
    int jj = tid & 63, kk0 = tid >> 6;
    int sc = map_col(kind, j0 + jj);
    for (int kk = kk0; kk < 64; kk += 4)
      sm[kk * 65 + jj] = sc >= 0 ? src[(size_t)(k0 + kk) * Nsrc + sc] : 0.f;
  }
  __syncthreads();
  {
    const int kq = tid & 15, jj0 = tid >> 4;
#pragma unroll
    for (int jj = jj0; jj < 64; jj += 16) {
      uint2 o;
      o.x = pack2bf(sm[(4 * kq + 0) * 65 + jj], sm[(4 * kq + 1) * 65 + jj]);
      o.y = pack2bf(sm[(4 * kq + 2) * 65 + jj], sm[(4 * kq + 3) * 65 + jj]);
      *(uint2*)(dst + (size_t)(j0 + jj) * K + k0 + 4 * kq) = o;
    }
  }
}

__device__ __forceinline__ void mod_item(const Params& p, int item, float* sm) {
  const int l = item / 96, j0 = (item % 96) * 64;
  const int tid = tid_l();
  float* sC = sm;
  float* sR = sm + 9 * 1024;
  __syncthreads();
  for (int i = tid; i < 9 * 1024; i += NTHR) {
    int m = i >> 10, k = i & 1023;
    float v = m == 0 ? p.c_ctx[k] : p.c[(m - 1) * 1024 + k];
    sC[i] = siluf_(v);
  }
  __syncthreads();
  const int col = tid & 63, ks = tid >> 6;
  float acc[9];
#pragma unroll
  for (int m = 0; m < 9; ++m) acc[m] = 0.f;
  const float* wp = p.w_ada + (size_t)l * 1024 * 6144 + j0 + col;
  for (int k = ks * 256; k < ks * 256 + 256; k += 8) {
    float wv[8];
#pragma unroll
    for (int u = 0; u < 8; ++u) wv[u] = wp[(size_t)(k + u) * 6144];
#pragma unroll
    for (int u = 0; u < 8; ++u)
#pragma unroll
      for (int m = 0; m < 9; ++m) acc[m] += sC[m * 1024 + k + u] * wv[u];
  }
#pragma unroll
  for (int m = 0; m < 9; ++m) sR[(ks * 9 + m) * 64 + col] = acc[m];
  __syncthreads();
  for (int i = tid; i < 9 * 64; i += NTHR) {
    int m = i >> 6, cc = i & 63;
    float v = sR[(0 * 9 + m) * 64 + cc] + sR[(1 * 9 + m) * 64 + cc] + sR[(2 * 9 + m) * 64 + cc] + sR[(3 * 9 + m) * 64 + cc];
    p.mod[((size_t)l * 9 + m) * 6144 + j0 + cc] = v + p.b_ada[l * 6144 + j0 + cc];
  }
}

__device__ __forceinline__ void phase0(const Params& p, float* sm) {
  const int PER_LAYER = 3272;
  const int total = 2 * PER_LAYER + 192;
  for (int item = blockIdx.x; item < total; item += gridDim.x) {
    if (item < 192) { mod_item(p, item, sm); continue; }
    int it = item - 192;
    int l = it / PER_LAYER, r = it % PER_LAYER;
    if (r < 768) { cvt_tile(p.w_in + (size_t)l * 1024 * 3024, 1024, 3024, p.WinT + (size_t)l * 3072 * 1024, 1, r / 16, r % 16, sm); continue; }
    r -= 768;
    if (r < 72) { cvt_tile(p.mla_w_uq + (size_t)l * 384 * 768, 384, 768, p.WuqT + (size_t)l * 768 * 384, 0, r / 6, r % 6, sm); continue; }
    r -= 72;
    if (r < 64) { cvt_tile(p.mla_w_ukv + (size_t)l * 256 * 1024, 256, 1024, p.WukvT + (size_t)l * 1024 * 256, 0, r / 4, r % 4, sm); continue; }
    r -= 64;
    if (r < 256) { cvt_tile(p.w_out + (size_t)l * 1024 * 1024, 1024, 1024, p.WoutT + (size_t)l * 1024 * 1024, 0, r / 16, r % 16, sm); continue; }
    r -= 256;
    if (r < 1408) { cvt_tile(p.w_ffn_in + (size_t)l * 1024 * 5632, 1024, 5632, p.WfiT + (size_t)l * 5632 * 1024, 2, r / 16, r % 16, sm); continue; }
    r -= 1408;
    cvt_tile(p.w_ffn_out + (size_t)l * 2816 * 1024, 2816, 1024, p.WfoT + (size_t)l * 1024 * 2816, 0, r / 44, r % 44, sm);
  }
}

__device__ __forceinline__ void rowpass_norm(const Params& p, int l, int stage) {
  const int tidl = tid_l();
  const int lane = tidl & 63, w = tidl >> 6;
  const int ln = stage == 0 ? 0 : (stage == 1 ? l : l + 1);
  const int sh_off = stage == 1 ? 3072 : 0;
  const float* gpre = stage == 1 ? p.g_pre_ffn + l * 1024 : p.g_pre_mix + (ln < 2 ? ln : 0) * 1024;
  u16* dst = stage == 1 ? p.MIX : p.HQ;
  for (int t = blockIdx.x * 4 + w; t < T_ALL; t += gridDim.x * 4) {
    const int m = tok_mod(t);
    float x[16];
    float* xo = p.out + (size_t)t * 1024;
    if (stage == 0) {
      const float* xi = t < T_CTX ? p.x_prompt + (size_t)t * 1024 : p.x_sample + (size_t)(t - T_CTX) * 1024;
#pragma unroll
      for (int i = 0; i < 4; ++i) {
        float4 v = *(const float4*)(xi + i * 256 + lane * 4);
        x[i * 4 + 0] = v.x; x[i * 4 + 1] = v.y; x[i * 4 + 2] = v.z; x[i * 4 + 3] = v.w;
      }
    } else {
      const u16* yp = p.HQ + (size_t)t * 1024;
      float y[16]; float ss = 0.f;
#pragma unroll
      for (int i = 0; i < 4; ++i) {
        uint2 v = *(const uint2*)(yp + i * 256 + lane * 4);
        y[i * 4 + 0] = bf2f((u16)(v.x & 0xffff)); y[i * 4 + 1] = bf2f((u16)(v.x >> 16));
        y[i * 4 + 2] = bf2f((u16)(v.y & 0xffff)); y[i * 4 + 3] = bf2f((u16)(v.y >> 16));
      }
#pragma unroll
      for (int i = 0; i < 16; ++i) ss += y[i] * y[i];
      ss = wave_sum(ss);
      const float rstd = rsqrtf(ss * (1.f / 1024.f) + 1e-6f);
      const float* gpost = (stage == 1 ? p.g_post_mix : p.g_post_ffn) + l * 1024;
      const float* gt = p.mod + ((size_t)l * 9 + m) * 6144 + (stage == 1 ? 2048 : 5120);
#pragma unroll
      for (int i = 0; i < 4; ++i) {
        float4 xv = *(const float4*)(xo + i * 256 + lane * 4);
        float4 gp = *(const float4*)(gpost + i * 256 + lane * 4);
        float4 gg = *(const float4*)(gt + i * 256 + lane * 4);
        x[i * 4 + 0] = xv.x + gg.x * y[i * 4 + 0] * rstd * gp.x;
        x[i * 4 + 1] = xv.y + gg.y * y[i * 4 + 1] * rstd * gp.y;
        x[i * 4 + 2] = xv.z + gg.z * y[i * 4 + 2] * rstd * gp.z;
        x[i * 4 + 3] = xv.w + gg.w * y[i * 4 + 3] * rstd * gp.w;
      }
    }
    __threadfence_block();
#pragma unroll
    for (int i = 0; i < 4; ++i)
      *(float4*)(xo + i * 256 + lane * 4) = make_float4(x[i * 4 + 0], x[i * 4 + 1], x[i * 4 + 2], x[i * 4 + 3]);
    if (ln >= 2) continue;
    float ss = 0.f;
#pragma unroll
    for (int i = 0; i < 16; ++i) ss += x[i] * x[i];
    ss = wave_sum(ss);
    const float rstd = rsqrtf(ss * (1.f / 1024.f) + 1e-6f);
    const float* sh = p.mod + ((size_t)ln * 9 + m) * 6144 + sh_off;
    const float* sc = sh + 1024;
    u16* hp = dst + (size_t)t * 1024;
#pragma unroll
    for (int i = 0; i < 4; ++i) {
      float4 gp = *(const float4*)(gpre + i * 256 + lane * 4);
      float4 s1 = *(const float4*)(sh + i * 256 + lane * 4);
      float4 c1 = *(const float4*)(sc + i * 256 + lane * 4);
      float h0 = x[i * 4 + 0] * rstd * gp.x * (1.f + c1.x) + s1.x;
      float h1 = x[i * 4 + 1] * rstd * gp.y * (1.f + c1.y) + s1.y;
      float h2 = x[i * 4 + 2] * rstd * gp.z * (1.f + c1.z) + s1.z;
      float h3 = x[i * 4 + 3] * rstd * gp.w * (1.f + c1.w) + s1.w;
      uint2 o;
      o.x = pack2bf(h0, h1);
      o.y = pack2bf(h2, h3);
      *(uint2*)(hp + i * 256 + lane * 4) = o;
    }
  }
}

__device__ __forceinline__ void unpack8(const uint4 v, float (&f)[8]);
__device__ __forceinline__ uint4 pack8(const float (&f)[8]);
__device__ __forceinline__ void rowpass_b0(const Params& p, int l) {
  const int tidl = tid_l();
  const int lane = tidl & 63, w = tidl >> 6;
  for (int t = blockIdx.x * 4 + w; t < T_ALL + 2048; t += gridDim.x * 4) {
    if (t >= T_ALL) {
      const int r = t - T_ALL, b = r >> 8, s = r & 255;
      if (lane < 32) {
        const float* ck = p.cache_ckv + (((size_t)b * 2 + l) * 256 + s) * 256 + lane * 8;
        const float4 x0 = *(const float4*)ck, x1 = *(const float4*)(ck + 4);
        const float f[8] = {x0.x, x0.y, x0.z, x0.w, x1.x, x1.y, x1.z, x1.w};
        *(uint4*)(p.CKVC + (size_t)r * 256 + lane * 8) = pack8(f);
      } else if (lane < 40) {
        const float* kr = p.cache_kr + (((size_t)b * 2 + l) * 256 + s) * 64 + (lane - 32) * 8;
        const float4 x0 = *(const float4*)kr, x1 = *(const float4*)(kr + 4);
        const float f[8] = {x0.x, x0.y, x0.z, x0.w, x1.x, x1.y, x1.z, x1.w};
        *(uint4*)(p.KRC + (size_t)r * 64 + (lane - 32) * 8) = pack8(f);
      }
      continue;
    }
    u16* pr = p.P + (size_t)t * PW;
    {
      float f[8]; float ss = 0.f;
      if (lane < 48) {
        unpack8(*(const uint4*)(pr + P_MCQ + lane * 8), f);
#pragma unroll
        for (int i = 0; i < 8; ++i) ss += f[i] * f[i];
      }
      ss = wave_sum(ss);
      const float rstd = rsqrtf(ss * (1.f / 384.f) + 1e-6f);
      if (lane < 48) {
        const float* wq = p.mla_q_norm_w + l * 384 + lane * 8;
        const float4 w0 = *(const float4*)wq, w1 = *(const float4*)(wq + 4);
        f[0] *= rstd * w0.x; f[1] *= rstd * w0.y; f[2] *= rstd * w0.z; f[3] *= rstd * w0.w;
        f[4] *= rstd * w1.x; f[5] *= rstd * w1.y; f[6] *= rstd * w1.z; f[7] *= rstd * w1.w;
        *(uint4*)(pr + P_MCQ + lane * 8) = pack8(f);
      }
    }
    {
      float f[8]; float ss = 0.f;
      if (lane < 32) {
        unpack8(*(const uint4*)(pr + P_MCKV + lane * 8), f);
#pragma unroll
        for (int i = 0; i < 8; ++i) ss += f[i] * f[i];
      }
      ss = wave_sum(ss);
      const float rstd = rsqrtf(ss * (1.f / 256.f) + 1e-6f);
      if (lane < 32) {
        const float* wk = p.mla_kv_norm_w + l * 256 + lane * 8;
        const float4 w0 = *(const float4*)wk, w1 = *(const float4*)(wk + 4);
        f[0] *= rstd * w0.x; f[1] *= rstd * w0.y; f[2] *= rstd * w0.z; f[3] *= rstd * w0.w;
        f[4] *= rstd * w1.x; f[5] *= rstd * w1.y; f[6] *= rstd * w1.z; f[7] *= rstd * w1.w;
        *(uint4*)(pr + P_MCKV + lane * 8) = pack8(f);
        if (t < T_CTX) {
          const int b = t >> 8, s = t & 255;
          float* op = p.out + OUT_CKV + (((size_t)b * 2 + l) * 256 + s) * 256 + lane * 8;
          *(float4*)op = make_float4(f[0], f[1], f[2], f[3]);
          *(float4*)(op + 4) = make_float4(f[4], f[5], f[6], f[7]);
        }
      }
    }
    {
      float v = bf2f(pr[P_MKR + lane]);
      if (t < T_CTX) {
        int b = t >> 8, s = t & 255;
        p.out[OUT_KR + (((size_t)b * 2 + l) * 256 + s) * 64 + lane] = v;
      } else {
        int pos = (t - T_CTX) & 4095;
        int axis = lane >> 5, half = (lane >> 4) & 1, f = lane & 15;
        float posf = axis == 0 ? (float)(pos >> 6) : (float)(pos & 63);
        float inv = exp2f(-(float)f * (13.287712379549449f / 16.f));
        float ang = posf * inv;
        float sn, cs;
        __sincosf(ang, &sn, &cs);
        float other = __shfl_xor(v, 16);
        float o = half == 0 ? v * cs - other * sn : v * cs + other * sn;
        pr[P_MKR + lane] = f2bf(o);
      }
    }
  }
}

#define P_QH 2304
#define P_KH 2560
__device__ __forceinline__ void rowpass_b2(const Params& p, int l) {
  const int tidl = tid_l();
  const int lane = tidl & 63, w = tidl >> 6;
  float cw[8][5], cv[8][5];
#pragma unroll
  for (int e = 0; e < 8; ++e)
#pragma unroll
    for (int j = 0; j < 5; ++j) {
      cw[e][j] = p.gdn_conv_w[((size_t)l * 768 + 8 * lane + e) * 5 + j];
      cv[e][j] = p.gdn_conv_w[((size_t)l * 768 + 512 + 8 * (lane & 31) + e) * 5 + j];
    }
  u16* VH = p.HQ + (size_t)T_ALL * 768;
  for (int t = blockIdx.x * 4 + w; t < T_ALL; t += gridDim.x * 4) {
    const int len = t < T_CTX ? 256 : 4096;
    const int tau = t < T_CTX ? (t & 255) : ((t - T_CTX) & 4095);
    float y[8], yv[8];
#pragma unroll
    for (int e = 0; e < 8; ++e) { y[e] = 0.f; yv[e] = 0.f; }
#pragma unroll
    for (int j = 0; j < 5; ++j) {
      const int tt = tau + j - 2;
      if (tt >= 0 && tt < len) {
        const u16* pr = p.P + (size_t)(t + j - 2) * PW;
        float f[8];
        unpack8(*(const uint4*)(pr + 8 * lane), f);
#pragma unroll
        for (int e = 0; e < 8; ++e) y[e] += cw[e][j] * f[e];
        if (lane < 32) {
          unpack8(*(const uint4*)(pr + 512 + 8 * lane), f);
#pragma unroll
          for (int e = 0; e < 8; ++e) yv[e] += cv[e][j] * f[e];
        }
      }
    }
    float ss = 0.f;
#pragma unroll
    for (int e = 0; e < 8; ++e) { y[e] = siluf_(y[e]); yv[e] = siluf_(yv[e]); ss += y[e] * y[e]; }
    ss += __shfl_xor(ss, 1); ss += __shfl_xor(ss, 2); ss += __shfl_xor(ss, 4);
    const float rn = rsqrtf(ss + 1e-6f) * (lane < 32 ? 0.125f : 1.f);
#pragma unroll
    for (int e = 0; e < 8; ++e) y[e] *= rn;
    *(uint4*)(p.P + (size_t)t * PW + P_QH + 8 * lane) = pack8(y);
    if (lane < 32) *(uint4*)(VH + (size_t)t * 256 + 8 * lane) = pack8(yv);
  }
}

__device__ __forceinline__ void unpack8(const uint4 v, float (&f)[8]) {
  f[0] = bf2f((u16)(v.x & 0xffff)); f[1] = bf2f((u16)(v.x >> 16)); f[2] = bf2f((u16)(v.y & 0xffff)); f[3] = bf2f((u16)(v.y >> 16));
  f[4] = bf2f((u16)(v.z & 0xffff)); f[5] = bf2f((u16)(v.z >> 16)); f[6] = bf2f((u16)(v.w & 0xffff)); f[7] = bf2f((u16)(v.w >> 16));
}
__device__ __forceinline__ uint4 pack8(const float (&f)[8]) {
  uint4 o;
  o.x = pack2bf(f[0], f[1]); o.y = pack2bf(f[2], f[3]);
  o.z = pack2bf(f[4], f[5]); o.w = pack2bf(f[6], f[7]);
  return o;
}
__device__ __forceinline__ void rowpass_c2(const Params& p, int l) {
  const int tidl = tid_l();
  const int lane = tidl & 63, w = tidl >> 6;
  const int hl = lane & 31, isH = lane >> 5;
  const float* nw = (isH ? p.hgrn_norm_w : p.gdn_norm_w) + l * 64 + (hl & 7) * 8;
  const float4 w0 = *(const float4*)(nw), w1 = *(const float4*)(nw + 4);
  const float wv[8] = {w0.x, w0.y, w0.z, w0.w, w1.x, w1.y, w1.z, w1.w};
  for (int t = blockIdx.x * 4 + w; t < T_ALL; t += gridDim.x * 4) {
    u16* mr = p.MIX + (size_t)t * 1024;
    const u16* pr = p.P + (size_t)t * PW;
    const u16* qr = p.HQ + (size_t)t * 768;
    const uint4 vf = *(const uint4*)(mr + isH * 512 + hl * 8);
    const uint4 vb = *(const uint4*)(mr + isH * 512 + 256 + hl * 8);
    const uint4 vg = *(const uint4*)(pr + (isH ? P_HG : P_GZ) + hl * 8);
    const int c0 = lane * 8;
    const uint4 vo = *(const uint4*)(qr + (c0 >> 7) * 192 + (c0 & 127));
    float f[8], bb[8], g[8];
    unpack8(vf, f); unpack8(vb, bb); unpack8(vg, g);
    float ss = 0.f;
#pragma unroll
    for (int i = 0; i < 8; ++i) { f[i] += bb[i]; ss += f[i] * f[i]; }
    ss += __shfl_xor(ss, 1); ss += __shfl_xor(ss, 2); ss += __shfl_xor(ss, 4);
    const float rn = rsqrtf(ss * (1.f / 64.f) + 1e-6f);
#pragma unroll
    for (int i = 0; i < 8; ++i) f[i] = f[i] * rn * wv[i] * (isH ? sigmoidf_(g[i]) : siluf_(g[i]));
    __threadfence_block();
    *(uint4*)(mr + isH * 256 + hl * 8) = pack8(f);
    *(uint4*)(mr + 512 + c0) = vo;
  }
}

__device__ __forceinline__ void gemm128(const u16* __restrict__ A, int lda, const u16* __restrict__ B, int ldb, int K,
                                        u16* lds, f32x4 (&acc)[4][4]) {
  const int tid = tid_l(), lane = tid & 63, w = tid >> 6, wm = w >> 1, wn = w & 1;
  const int r16 = lane & 15, g4 = lane >> 4;
#pragma unroll
  for (int i = 0; i < 4; ++i)
#pragma unroll
    for (int j = 0; j < 4; ++j) acc[i][j] = f32x4{0.f, 0.f, 0.f, 0.f};
  const int lrow = tid >> 3, lkc = tid & 7;
  const u16* ap = A + (size_t)lrow * lda + lkc * 8;
  const u16* bp = B + (size_t)lrow * ldb + lkc * 8;
  const size_t sa32 = (size_t)32 * lda, sb32 = (size_t)32 * ldb;
  uint4 ra0 = *(const uint4*)(ap), ra1 = *(const uint4*)(ap + sa32), ra2 = *(const uint4*)(ap + 2 * sa32), ra3 = *(const uint4*)(ap + 3 * sa32);
  uint4 rb0 = *(const uint4*)(bp), rb1 = *(const uint4*)(bp + sb32), rb2 = *(const uint4*)(bp + 2 * sb32), rb3 = *(const uint4*)(bp + 3 * sb32);
  const int woff = lrow * 64 + ((lkc ^ (lrow & 7)) * 8);
  const int sw = r16 & 7;
  const int fa0 = (wm * 64 + r16) * 64 + ((g4 ^ sw) * 8);
  const int fa1 = (wm * 64 + r16) * 64 + (((4 + g4) ^ sw) * 8);
  const int fb0 = 128 * 64 + (wn * 64 + r16) * 64 + ((g4 ^ sw) * 8);
  const int fb1 = 128 * 64 + (wn * 64 + r16) * 64 + (((4 + g4) ^ sw) * 8);
  const int nk = K >> 6;
  __syncthreads();
  {
    u16* wa = lds + woff; u16* wb = lds + 128 * 64 + woff;
    *(uint4*)(wa) = ra0; *(uint4*)(wa + 32 * 64) = ra1; *(uint4*)(wa + 64 * 64) = ra2; *(uint4*)(wa + 96 * 64) = ra3;
    *(uint4*)(wb) = rb0; *(uint4*)(wb + 32 * 64) = rb1; *(uint4*)(wb + 64 * 64) = rb2; *(uint4*)(wb + 96 * 64) = rb3;
  }
  if (nk > 1) {
    const u16* a2 = ap + 64; const u16* b2 = bp + 64;
    ra0 = *(const uint4*)(a2); ra1 = *(const uint4*)(a2 + sa32); ra2 = *(const uint4*)(a2 + 2 * sa32); ra3 = *(const uint4*)(a2 + 3 * sa32);
    rb0 = *(const uint4*)(b2); rb1 = *(const uint4*)(b2 + sb32); rb2 = *(const uint4*)(b2 + 2 * sb32); rb3 = *(const uint4*)(b2 + 3 * sb32);
  }
  __syncthreads();
  for (int kt = 0; kt < nk; ++kt) {
    const u16* cur = lds + (kt & 1) * (256 * 64);
    if (kt + 1 < nk) {
      u16* nxt = lds + ((kt + 1) & 1) * (256 * 64);
      u16* wa = nxt + woff; u16* wb = nxt + 128 * 64 + woff;
      *(uint4*)(wa) = ra0; *(uint4*)(wa + 32 * 64) = ra1; *(uint4*)(wa + 64 * 64) = ra2; *(uint4*)(wa + 96 * 64) = ra3;
      *(uint4*)(wb) = rb0; *(uint4*)(wb + 32 * 64) = rb1; *(uint4*)(wb + 64 * 64) = rb2; *(uint4*)(wb + 96 * 64) = rb3;
      if (kt + 2 < nk) {
        const u16* a2 = ap + (kt + 2) * 64; const u16* b2 = bp + (kt + 2) * 64;
        ra0 = *(const uint4*)(a2); ra1 = *(const uint4*)(a2 + sa32); ra2 = *(const uint4*)(a2 + 2 * sa32); ra3 = *(const uint4*)(a2 + 3 * sa32);
        rb0 = *(const uint4*)(b2); rb1 = *(const uint4*)(b2 + sb32); rb2 = *(const uint4*)(b2 + 2 * sb32); rb3 = *(const uint4*)(b2 + 3 * sb32);
      }
    }
    {
      const u16* pa0 = cur + fa0; const u16* pa1 = cur + fa1; const u16* pb0 = cur + fb0; const u16* pb1 = cur + fb1;
      bf16x8 a0 = *(const bf16x8*)(pa0), a1 = *(const bf16x8*)(pa0 + 16 * 64), a2 = *(const bf16x8*)(pa0 + 32 * 64), a3 = *(const bf16x8*)(pa0 + 48 * 64);
      bf16x8 b0 = *(const bf16x8*)(pb0), b1 = *(const bf16x8*)(pb0 + 16 * 64), b2 = *(const bf16x8*)(pb0 + 32 * 64), b3 = *(const bf16x8*)(pb0 + 48 * 64);
      bf16x8 c0 = *(const bf16x8*)(pa1), c1 = *(const bf16x8*)(pa1 + 16 * 64), c2 = *(const bf16x8*)(pa1 + 32 * 64), c3 = *(const bf16x8*)(pa1 + 48 * 64);
      bf16x8 d0 = *(const bf16x8*)(pb1), d1 = *(const bf16x8*)(pb1 + 16 * 64), d2 = *(const bf16x8*)(pb1 + 32 * 64), d3 = *(const bf16x8*)(pb1 + 48 * 64);
      __builtin_amdgcn_sched_barrier(0);
#define G128_MM(j, bj, x0, x1, x2, x3) do { \
        acc[0][j] = __builtin_amdgcn_mfma_f32_16x16x32_bf16(bj, x0, acc[0][j], 0, 0, 0); \
        acc[1][j] = __builtin_amdgcn_mfma_f32_16x16x32_bf16(bj, x1, acc[1][j], 0, 0, 0); \
        acc[2][j] = __builtin_amdgcn_mfma_f32_16x16x32_bf16(bj, x2, acc[2][j], 0, 0, 0); \
        acc[3][j] = __builtin_amdgcn_mfma_f32_16x16x32_bf16(bj, x3, acc[3][j], 0, 0, 0); } while (0)
      __builtin_amdgcn_s_setprio(1);
      G128_MM(0, b0, a0, a1, a2, a3); G128_MM(1, b1, a0, a1, a2, a3); G128_MM(2, b2, a0, a1, a2, a3); G128_MM(3, b3, a0, a1, a2, a3);
      G128_MM(0, d0, c0, c1, c2, c3); G128_MM(1, d1, c0, c1, c2, c3); G128_MM(2, d2, c0, c1, c2, c3); G128_MM(3, d3, c0, c1, c2, c3);
      __builtin_amdgcn_s_setprio(0);
    }
    __syncthreads();
  }
}
__device__ __forceinline__ uint2 pack4(f32x4 v) {
  uint2 o;
  o.x = pack2bf(v[0], v[1]);
  o.y = pack2bf(v[2], v[3]);
  return o;
}

__device__ __forceinline__ void gemm256(const u16* __restrict__ A, int lda, const u16* __restrict__ B, int ldb, int K,
                                        u16* lds, f32x4 (&acc)[8][4]) {
  const int tid = tid_l(), lane = tid & 63, w = tid >> 6, wm = w >> 1, wn = w & 1;
  const int r16 = lane & 15, g4 = lane >> 4;
#pragma unroll
  for (int i = 0; i < 8; ++i)
#pragma unroll
    for (int j = 0; j < 4; ++j) acc[i][j] = f32x4{0.f, 0.f, 0.f, 0.f};
  const int lrow = tid >> 2, lkc = tid & 3;
  const u16* ap = A + (size_t)lrow * lda + lkc * 8;
  const u16* bp = B + (size_t)lrow * ldb + lkc * 8;
  const size_t sa64 = (size_t)64 * lda, sb64 = (size_t)64 * ldb;
  const int woff = lrow * 32 + ((lkc ^ ((lrow >> 1) & 3)) * 8);
  const int fsw = (g4 ^ ((r16 >> 1) & 3)) * 8;
  const int faoff = (wm * 128 + r16) * 32 + fsw;
  const int fboff = 256 * 32 + (wn * 64 + r16) * 32 + fsw;
  const int nk = K >> 5;
  const int BUF = 384 * 32;
  uint4 xa0, xa1, xa2, xa3, xb0, xb1;
  uint4 ya0, ya1, ya2, ya3, yb0, yb1;
#define G256_LOAD(P, st) do { const u16* a2_ = ap + (st) * 32; const u16* b2_ = bp + (st) * 32; \
    P##a0 = *(const uint4*)(a2_); P##a1 = *(const uint4*)(a2_ + sa64); P##a2 = *(const uint4*)(a2_ + 2 * sa64); P##a3 = *(const uint4*)(a2_ + 3 * sa64); \
    P##b0 = *(const uint4*)(b2_); P##b1 = *(const uint4*)(b2_ + sb64); } while (0)
#define G256_STORE(P, buf) do { u16* wa_ = lds + (buf) * BUF + woff; u16* wb_ = wa_ + 256 * 32; \
    *(uint4*)(wa_) = P##a0; *(uint4*)(wa_ + 64 * 32) = P##a1; *(uint4*)(wa_ + 128 * 32) = P##a2; *(uint4*)(wa_ + 192 * 32) = P##a3; \
    *(uint4*)(wb_) = P##b0; *(uint4*)(wb_ + 64 * 32) = P##b1; } while (0)
#define G256_MM(i, af) do { \
      acc[i][0] = __builtin_amdgcn_mfma_f32_16x16x32_bf16(bf0, af, acc[i][0], 0, 0, 0); \
      acc[i][1] = __builtin_amdgcn_mfma_f32_16x16x32_bf16(bf1, af, acc[i][1], 0, 0, 0); \
      acc[i][2] = __builtin_amdgcn_mfma_f32_16x16x32_bf16(bf2, af, acc[i][2], 0, 0, 0); \
      acc[i][3] = __builtin_amdgcn_mfma_f32_16x16x32_bf16(bf3, af, acc[i][3], 0, 0, 0); } while (0)
#define G256_COMPUTE(buf) do { const u16* fa_ = lds + (buf) * BUF + faoff; const u16* fb_ = lds + (buf) * BUF + fboff; \
    bf16x8 bf0 = *(const bf16x8*)(fb_), bf1 = *(const bf16x8*)(fb_ + 16 * 32), bf2 = *(const bf16x8*)(fb_ + 32 * 32), bf3 = *(const bf16x8*)(fb_ + 48 * 32); \
    bf16x8 a0 = *(const bf16x8*)(fa_), a1 = *(const bf16x8*)(fa_ + 16 * 32), a2 = *(const bf16x8*)(fa_ + 32 * 32), a3 = *(const bf16x8*)(fa_ + 48 * 32); \
    __builtin_amdgcn_sched_barrier(0); __builtin_amdgcn_s_setprio(1); \
    G256_MM(0, a0); a0 = *(const bf16x8*)(fa_ + 64 * 32); __builtin_amdgcn_sched_barrier(0); \
    G256_MM(1, a1); a1 = *(const bf16x8*)(fa_ + 80 * 32); __builtin_amdgcn_sched_barrier(0); \
    G256_MM(2, a2); a2 = *(const bf16x8*)(fa_ + 96 * 32); __builtin_amdgcn_sched_barrier(0); \
    G256_MM(3, a3); a3 = *(const bf16x8*)(fa_ + 112 * 32); __builtin_amdgcn_sched_barrier(0); \
    G256_MM(4, a0); G256_MM(5, a1); G256_MM(6, a2); G256_MM(7, a3); __builtin_amdgcn_s_setprio(0); } while (0)
  bf16x8 bf0, bf1, bf2, bf3, a0, a1, a2, a3;
#define G3_PRELOAD(buf) do { const u16* fa_ = lds + (buf) * BUF + faoff; const u16* fb_ = lds + (buf) * BUF + fboff; \
    bf0 = *(const bf16x8*)(fb_); bf1 = *(const bf16x8*)(fb_ + 16 * 32); bf2 = *(const bf16x8*)(fb_ + 32 * 32); bf3 = *(const bf16x8*)(fb_ + 48 * 32); \
    a0 = *(const bf16x8*)(fa_); a1 = *(const bf16x8*)(fa_ + 16 * 32); a2 = *(const bf16x8*)(fa_ + 32 * 32); a3 = *(const bf16x8*)(fa_ + 48 * 32); } while (0)
#define G3_COMPUTE(buf) do { const u16* fa_ = lds + (buf) * BUF + faoff; \
    __builtin_amdgcn_sched_barrier(0); __builtin_amdgcn_s_setprio(1); \
    G256_MM(0, a0); a0 = *(const bf16x8*)(fa_ + 64 * 32); __builtin_amdgcn_sched_barrier(0); \
    G256_MM(1, a1); a1 = *(const bf16x8*)(fa_ + 80 * 32); __builtin_amdgcn_sched_barrier(0); \
    G256_MM(2, a2); a2 = *(const bf16x8*)(fa_ + 96 * 32); __builtin_amdgcn_sched_barrier(0); \
    G256_MM(3, a3); a3 = *(const bf16x8*)(fa_ + 112 * 32); __builtin_amdgcn_sched_barrier(0); \
    G256_MM(4, a0); G256_MM(5, a1); G256_MM(6, a2); G256_MM(7, a3); __builtin_amdgcn_s_setprio(0); \
    __builtin_amdgcn_sched_barrier(0); } while (0)
#define G3_STAGE(i, SET) do { \
    if (kt + (i) + 2 < nk) G256_STORE(SET, ((i) + 2) % 3); \
    if (kt + (i) + 4 < nk) G256_LOAD(SET, kt + (i) + 4); \
    if (kt + (i) < nk) G3_COMPUTE((i) % 3); \
    if (kt + (i) + 1 < nk) G3_PRELOAD(((i) + 1) % 3); \
    __syncthreads(); } while (0)
  G256_LOAD(x, 0);
  G256_LOAD(y, 1);
  __syncthreads();
  G256_STORE(x, 0);
  G256_LOAD(x, 2);
  G256_STORE(y, 1);
  G256_LOAD(y, 3);
  __syncthreads();
  G3_PRELOAD(0);
  for (int kt = 0; kt < nk; kt += 6) {
    G3_STAGE(0, x); G3_STAGE(1, y); G3_STAGE(2, x); G3_STAGE(3, y); G3_STAGE(4, x); G3_STAGE(5, y);
  }
}

__device__ __forceinline__ void gemm192(const u16* __restrict__ A, int lda, const u16* __restrict__ B, int ldb, int K,
                                        u16* lds, f32x4 (&acc)[6][4]) {
  const int tid = tid_l(), lane = tid & 63, w = tid >> 6, wm = w >> 1, wn = w & 1;
  const int r16 = lane & 15, g4 = lane >> 4;
#pragma unroll
  for (int i = 0; i < 6; ++i)
#pragma unroll
    for (int j = 0; j < 4; ++j) acc[i][j] = f32x4{0.f, 0.f, 0.f, 0.f};
  const int lrow = tid >> 2, lkc = tid & 3;
  const u16* ap = A + (size_t)lrow * lda + lkc * 8;
  const u16* bp = B + (size_t)lrow * ldb + lkc * 8;
  const size_t sa64 = (size_t)64 * lda, sb64 = (size_t)64 * ldb;
  const int woff = lrow * 32 + ((lkc ^ ((lrow >> 1) & 3)) * 8);
  const int fsw = (g4 ^ ((r16 >> 1) & 3)) * 8;
  const int faoff = (wm * 96 + r16) * 32 + fsw;
  const int fboff = 192 * 32 + (wn * 64 + r16) * 32 + fsw;
  const int nk = K >> 5;
  const int BUF = 320 * 32;
  uint4 xa0, xa1, xa2, xb0, xb1;
  uint4 ya0, ya1, ya2, yb0, yb1;
#define G192_LOAD(P, st) do { const u16* a2_ = ap + (st) * 32; const u16* b2_ = bp + (st) * 32; \
    P##a0 = *(const uint4*)(a2_); P##a1 = *(const uint4*)(a2_ + sa64); P##a2 = *(const uint4*)(a2_ + 2 * sa64); \
    P##b0 = *(const uint4*)(b2_); P##b1 = *(const uint4*)(b2_ + sb64); } while (0)
#define G192_STORE(P, buf) do { u16* wa_ = lds + (buf) * BUF + woff; u16* wb_ = wa_ + 192 * 32; \
    *(uint4*)(wa_) = P##a0; *(uint4*)(wa_ + 64 * 32) = P##a1; *(uint4*)(wa_ + 128 * 32) = P##a2; \
    *(uint4*)(wb_) = P##b0; *(uint4*)(wb_ + 64 * 32) = P##b1; } while (0)
#define G192_COMPUTE(buf) do { const u16* fa_ = lds + (buf) * BUF + faoff; const u16* fb_ = lds + (buf) * BUF + fboff; \
    bf16x8 bf0 = *(const bf16x8*)(fb_), bf1 = *(const bf16x8*)(fb_ + 16 * 32), bf2 = *(const bf16x8*)(fb_ + 32 * 32), bf3 = *(const bf16x8*)(fb_ + 48 * 32); \
    bf16x8 a0 = *(const bf16x8*)(fa_), a1 = *(const bf16x8*)(fa_ + 16 * 32), a2 = *(const bf16x8*)(fa_ + 32 * 32), a3 = *(const bf16x8*)(fa_ + 48 * 32); \
    __builtin_amdgcn_sched_barrier(0); __builtin_amdgcn_s_setprio(1); \
    G256_MM(0, a0); a0 = *(const bf16x8*)(fa_ + 64 * 32); __builtin_amdgcn_sched_barrier(0); \
    G256_MM(1, a1); a1 = *(const bf16x8*)(fa_ + 80 * 32); __builtin_amdgcn_sched_barrier(0); \
    G256_MM(2, a2); G256_MM(3, a3); G256_MM(4, a0); G256_MM(5, a1); __builtin_amdgcn_s_setprio(0); } while (0)
  G192_LOAD(x, 0);
  G192_LOAD(y, 1);
  __syncthreads();
  G192_STORE(x, 0);
  G192_LOAD(x, 2);
  __syncthreads();
  for (int kt = 0; kt < nk; kt += 2) {
    G192_STORE(y, 1);
    if (kt + 3 < nk) G192_LOAD(y, kt + 3);
    G192_COMPUTE(0);
    __syncthreads();
    if (kt + 2 < nk) {
      G192_STORE(x, 0);
      if (kt + 4 < nk) G192_LOAD(x, kt + 4);
    }
    G192_COMPUTE(1);
    __syncthreads();
  }
}
#define GEMM256_RC const int tde = tid_l(); const int rb = ((tde >> 6) >> 1) * 128 + (tde & 15), cb = ((tde >> 6) & 1) * 64 + ((tde & 63) >> 4) * 4;
#define GEMM_RC const int tde = tid_l(); const int rb = ((tde >> 6) >> 1) * 64 + (tde & 15), cb = ((tde >> 6) & 1) * 64 + ((tde & 63) >> 4) * 4;


__device__ __forceinline__ bool tile_at(int r, int Mt, int Nt, int& mt, int& nt) {
  const int x = blockIdx.x & 7, j = blockIdx.x >> 3, bpx = gridDim.x >> 3;
  const int mpx = Mt >> 3;
  const int q = r * bpx + j;
  if (q >= mpx * Nt) return false;
  const int full = (Nt >> 3) * (mpx * 8);
  int cb, rem, wcb;
  if (q < full) { cb = q / (mpx * 8); rem = q - cb * mpx * 8; wcb = 8; }
  else { cb = Nt >> 3; rem = q - full; wcb = Nt - cb * 8; }
  mt = x * mpx + rem / wcb;
  nt = cb * 8 + rem % wcb;
  return true;
}

__device__ __forceinline__ void phase_a(const Params& p, int l, u16* lds) {
  const u16* Bw = p.WinT + (size_t)l * 3072 * 1024;
  int mt, nt;
  for (int r = 0; tile_at(r, 144, 24, mt, nt); ++r) {
    const int m0 = mt * 256, n0 = nt * 128;
    f32x4 acc[8][4];
    gemm256(p.HQ + (size_t)m0 * 1024, 1024, Bw + (size_t)n0 * 1024, 1024, 1024, lds, acc);
    { GEMM256_RC
#pragma unroll
      for (int mi = 0; mi < 8; ++mi) {
        const int row = m0 + rb + mi * 16;
#pragma unroll
        for (int ni = 0; ni < 4; ++ni) {
          const int col = n0 + cb + ni * 16;
          *(uint2*)(p.P + (size_t)row * PW + col) = pack4(acc[mi][ni]);
          if (col >= P_GA && col < P_GA + 16)
            *(float4*)(p.GAB + (size_t)row * 16 + (col - P_GA)) = make_float4(acc[mi][ni][0], acc[mi][ni][1], acc[mi][ni][2], acc[mi][ni][3]);
        }
      }
    }
  }
}

__device__ __forceinline__ void phase_b1(const Params& p, int l, u16* lds) {
  int mt, nt;
  for (int pass = 0; pass < 2; ++pass) {
  for (int r = 0; tile_at(r, pass == 0 ? 288 : 304, pass == 0 ? 6 : 8, mt, nt); ++r) {
    if (pass == 0) {
      const int m0 = mt * 128, n0 = nt * 128;
      const float qscale = 0.07216878364870322f * 1.4426950408889634f;
      f32x4 acc[4][4];
      gemm128(p.P + (size_t)m0 * PW + P_MCQ, PW, p.WuqT + (size_t)l * 768 * 384 + (size_t)n0 * 384, 384, 384, lds, acc);
      { GEMM_RC
        const int g4 = (tde & 63) >> 4;
        const int cw0 = n0 + cb - g4 * 4;
        const bool ropew = ((cw0 >> 6) % 3) == 2 && m0 >= T_CTX;
#pragma unroll
        for (int mi = 0; mi < 4; ++mi) {
          const int row = m0 + rb + mi * 16;
          f32x4 v0 = acc[mi][0], v1 = acc[mi][1], v2 = acc[mi][2], v3 = acc[mi][3];
          if (ropew) {
            const int pos = (row - T_CTX) & 4095;
#pragma unroll
            for (int r = 0; r < 4; ++r) {
              const float inv = exp2f(-(float)(g4 * 4 + r) * (13.287712379549449f / 16.f));
              float s0, c0, s1, c1;
              __sincosf((float)(pos >> 6) * inv, &s0, &c0);
              __sincosf((float)(pos & 63) * inv, &s1, &c1);
              const float a0 = v0[r] * c0 - v1[r] * s0, a1 = v1[r] * c0 + v0[r] * s0;
              const float b0 = v2[r] * c1 - v3[r] * s1, b1 = v3[r] * c1 + v2[r] * s1;
              v0[r] = a0; v1[r] = a1; v2[r] = b0; v3[r] = b1;
            }
          }
          u16* qp = p.HQ + (size_t)row * 768 + n0 + cb;
          *(uint2*)(qp) = pack4(v0 * qscale); *(uint2*)(qp + 16) = pack4(v1 * qscale);
          *(uint2*)(qp + 32) = pack4(v2 * qscale); *(uint2*)(qp + 48) = pack4(v3 * qscale);
        }
      }
    } else {
      const int m0 = mt * 128, n0 = nt * 128;
      const u16* Ap; int lda;
      if (mt < 288) { Ap = p.P + (size_t)m0 * PW + P_MCKV; lda = PW; }
      else { Ap = p.CKVC + (size_t)(m0 - T_ALL) * 256; lda = 256; }
      f32x4 acc[4][4];
      gemm128(Ap, lda, p.WukvT + (size_t)l * 1024 * 256 + (size_t)n0 * 256, 256, 256, lds, acc);
      { GEMM_RC
#pragma unroll
        for (int mi = 0; mi < 4; ++mi) {
          const int row = m0 + rb + mi * 16;
          u16* vb; int vst;
          if (row < T_CTX) { int b = row >> 8, pos = row & 255; vb = p.VTC + (size_t)(b * 4) * 128 * 256 + pos; vst = 256; }
          else if (row < T_ALL) { int b = (row - T_CTX) >> 12, pos = (row - T_CTX) & 4095; vb = p.VTL + (size_t)(b * 4) * 128 * 4352 + pos; vst = 4352; }
          else { int b = (row - T_ALL) >> 8, pos = 4096 + ((row - T_ALL) & 255); vb = p.VTL + (size_t)(b * 4) * 128 * 4352 + pos; vst = 4352; }
#pragma unroll
          for (int ni = 0; ni < 4; ++ni) {
            const int col = n0 + cb + ni * 16;
            const int h = col >> 8, wi = col & 255;
            if (wi < 128) {
              *(uint2*)(p.KN + (size_t)row * 512 + h * 128 + wi) = pack4(acc[mi][ni]);
            } else {
              u16* dst = vb + (size_t)(h * 128 + (wi - 128)) * vst;
#pragma unroll
              for (int r = 0; r < 4; ++r) dst[(size_t)r * vst] = f2bf(acc[mi][ni][r]);
            }
          }
        }
      }
    }
  }
  }
}

__device__ __forceinline__ void phase_gemm_y(const u16* A, int lda, const u16* B, int K, int N, u16* Y, int ldy, u16* lds) {
  int mt, nt;
  for (int r = 0; tile_at(r, 192, N / 128, mt, nt); ++r) {
    const int m0 = mt * 192, n0 = nt * 128;
    f32x4 acc[6][4];
    gemm192(A + (size_t)m0 * lda, lda, B + (size_t)n0 * K, K, K, lds, acc);
    {
      const int tde = tid_l();
      const int rb = ((tde >> 6) >> 1) * 96 + (tde & 15), cb = ((tde >> 6) & 1) * 64 + ((tde & 63) >> 4) * 4;
#pragma unroll
      for (int mi = 0; mi < 6; ++mi)
#pragma unroll
        for (int ni = 0; ni < 4; ++ni)
          *(uint2*)(Y + (size_t)(m0 + rb + mi * 16) * ldy + n0 + cb + ni * 16) = pack4(acc[mi][ni]);
    }
  }
}

__device__ __forceinline__ void phase_e(const Params& p, int l, u16* lds) {
  const u16* Bw = p.WfiT + (size_t)l * 5632 * 1024;
  int mt, nt;
  for (int r = 0; tile_at(r, 144, 44, mt, nt); ++r) {
    const int m0 = mt * 256, n0 = nt * 128;
    f32x4 acc[8][4];
    gemm256(p.MIX + (size_t)m0 * 1024, 1024, Bw + (size_t)n0 * 1024, 1024, 1024, lds, acc);
    { GEMM256_RC
      const int g4x4 = ((tde & 63) >> 4) * 4;
      const int hc0 = ((n0 + cb - g4x4) >> 1) + g4x4;
#pragma unroll
      for (int mi = 0; mi < 8; ++mi)
#pragma unroll
        for (int ni = 0; ni < 2; ++ni) {
          f32x4 hv;
#pragma unroll
          for (int r = 0; r < 4; ++r) hv[r] = siluf_(acc[mi][ni][r]) * acc[mi][ni + 2][r];
          *(uint2*)(p.P + (size_t)(m0 + rb + mi * 16) * DFF + hc0 + ni * 16) = pack4(hv);
        }
    }
  }
}

#define KST 208
#define VST 80
#define PST 80
__device__ __forceinline__ void attn_item(const Params& p, int latent, int b, int h, int qb, unsigned char* smraw, int dummy = 0) {
  u16* sK = (u16*)smraw;
  u16* sV = sK + 64 * KST;
  u16* sP = sV + 128 * VST;
  const int tid = tid_l(), lane = tid & 63, w = tid >> 6, r16 = lane & 15, g4 = lane >> 4;
  const int nkeys = latent ? 4352 : 256;
  const int krow0 = latent ? T_CTX + b * 4096 : b * 256;
  const int tq0 = krow0 + qb * 128;
  const u16* vt = latent ? p.VTL + (size_t)((b * 4 + h) * 128) * 4352 : p.VTC + (size_t)((b * 4 + h) * 128) * 256;
  u16* sPw = sP + w * 32 * PST;
  bf16x8 q[2][6];
#pragma unroll
  for (int mi = 0; mi < 2; ++mi)
#pragma unroll
    for (int ks = 0; ks < 6; ++ks)
      q[mi][ks] = *(const bf16x8*)(p.HQ + (size_t)(tq0 + w * 32 + mi * 16 + r16) * 768 + h * 192 + ks * 32 + g4 * 8);
  f32x4 o[2][8];
  float mrow[2], lrow[2];
#pragma unroll
  for (int mi = 0; mi < 2; ++mi) {
#pragma unroll
    for (int nd = 0; nd < 8; ++nd) o[mi][nd] = f32x4{0.f, 0.f, 0.f, 0.f};
    mrow[mi] = -1e30f; lrow[mi] = 0.f;
  }
  const int lkey = tid >> 2, lpart = tid & 3;
  const int ldv = tid >> 1, lhalf = tid & 1;
  const int ntile = nkeys >> 6;
  uint4 k0, k1, k2, k3, k4, k5;
  {
    const int pos = lkey;
    const u16* srcn = p.KN + (size_t)(krow0 + pos) * 512 + h * 128 + lpart * 8;
    const u16* srcr = p.P + (size_t)(krow0 + pos) * PW + P_MKR + lpart * 8;
    k0 = *(const uint4*)(srcn); k1 = *(const uint4*)(srcn + 32); k2 = *(const uint4*)(srcn + 64); k3 = *(const uint4*)(srcn + 96);
    k4 = *(const uint4*)(srcr); k5 = *(const uint4*)(srcr + 32);
  }
  for (int kt = 0; kt < ntile; ++kt) {
    __syncthreads();
    {
      u16* dk = sK + lkey * KST + lpart * 8;
      *(uint4*)(dk) = k0; *(uint4*)(dk + 32) = k1; *(uint4*)(dk + 64) = k2; *(uint4*)(dk + 96) = k3;
      *(uint4*)(dk + 128) = k4; *(uint4*)(dk + 160) = k5;
    }
    const u16* sv = vt + (size_t)ldv * nkeys + kt * 64 + lhalf * 32;
    const uint4 v0 = *(const uint4*)(sv), v1 = *(const uint4*)(sv + 8), v2 = *(const uint4*)(sv + 16), v3 = *(const uint4*)(sv + 24);
    __syncthreads();
    f32x4 s[2][4];
#pragma unroll
    for (int mi = 0; mi < 2; ++mi)
#pragma unroll
      for (int ni = 0; ni < 4; ++ni) s[mi][ni] = f32x4{0.f, 0.f, 0.f, 0.f};
#pragma unroll
    for (int ks = 0; ks < 6; ++ks)
#pragma unroll
      for (int ni = 0; ni < 4; ++ni) {
        bf16x8 kf = *(const bf16x8*)(sK + (ni * 16 + r16) * KST + ks * 32 + g4 * 8);
        s[0][ni] = __builtin_amdgcn_mfma_f32_16x16x32_bf16(kf, q[0][ks], s[0][ni], 0, 0, 0);
        s[1][ni] = __builtin_amdgcn_mfma_f32_16x16x32_bf16(kf, q[1][ks], s[1][ni], 0, 0, 0);
      }
#pragma unroll
    for (int mi = 0; mi < 2; ++mi) {
      float mx = -1e30f;
#pragma unroll
      for (int ni = 0; ni < 4; ++ni)
#pragma unroll
        for (int r = 0; r < 4; ++r) mx = fmaxf(mx, s[mi][ni][r]);
      mx = fmaxf(mx, __shfl_xor(mx, 16)); mx = fmaxf(mx, __shfl_xor(mx, 32));
      const float mnew = fmaxf(mrow[mi], mx);
      const float alpha = __builtin_amdgcn_exp2f(mrow[mi] - mnew);
      mrow[mi] = mnew;
      float ps = 0.f;
#pragma unroll
      for (int ni = 0; ni < 4; ++ni) {
        f32x4 pv;
#pragma unroll
        for (int r = 0; r < 4; ++r) { pv[r] = __builtin_amdgcn_exp2f(s[mi][ni][r] - mnew); ps += pv[r]; }
        *(uint2*)(sPw + (mi * 16 + r16) * PST + ni * 16 + g4 * 4) = pack4(pv);
      }
      ps += __shfl_xor(ps, 16); ps += __shfl_xor(ps, 32);
      lrow[mi] = lrow[mi] * alpha + ps;
#pragma unroll
      for (int nd = 0; nd < 8; ++nd) o[mi][nd] *= alpha;
    }
    {
      u16* dvp = sV + ldv * VST + lhalf * 32;
      *(uint4*)(dvp) = v0; *(uint4*)(dvp + 8) = v1; *(uint4*)(dvp + 16) = v2; *(uint4*)(dvp + 24) = v3;
    }
    __syncthreads();
    if (kt + 1 < ntile) {
      const int pos = (kt + 1) * 64 + lkey;
      const bool own = (!latent) || pos < 4096;
      const int row = own ? krow0 + pos : T_ALL + b * 256 + (pos - 4096);
      const u16* srcn = p.KN + (size_t)row * 512 + h * 128 + lpart * 8;
      const u16* srcr = own ? p.P + (size_t)(krow0 + pos) * PW + P_MKR + lpart * 8
                            : p.KRC + (size_t)(b * 256 + pos - 4096) * 64 + lpart * 8;
      k0 = *(const uint4*)(srcn); k1 = *(const uint4*)(srcn + 32); k2 = *(const uint4*)(srcn + 64); k3 = *(const uint4*)(srcn + 96);
      k4 = *(const uint4*)(srcr); k5 = *(const uint4*)(srcr + 32);
    }
#pragma unroll
    for (int ks2 = 0; ks2 < 2; ++ks2) {
      bf16x8 pf0 = *(const bf16x8*)(sPw + (0 * 16 + r16) * PST + ks2 * 32 + g4 * 8);
      bf16x8 pf1 = *(const bf16x8*)(sPw + (1 * 16 + r16) * PST + ks2 * 32 + g4 * 8);
#pragma unroll
      for (int nd = 0; nd < 8; ++nd) {
        bf16x8 vf = *(const bf16x8*)(sV + (nd * 16 + r16) * VST + ks2 * 32 + g4 * 8);
        o[0][nd] = __builtin_amdgcn_mfma_f32_16x16x32_bf16(vf, pf0, o[0][nd], 0, 0, 0);
        o[1][nd] = __builtin_amdgcn_mfma_f32_16x16x32_bf16(vf, pf1, o[1][nd], 0, 0, 0);
      }
    }
  }
#pragma unroll
  for (int mi = 0; mi < 2; ++mi) {
    const float inv = 1.f / lrow[mi];
    const int qrow = tq0 + w * 32 + mi * 16 + r16;
    u16* op = p.HQ + (size_t)qrow * 768 + h * 192 + g4 * 4;
    if (dummy) op = p.HQ + (size_t)T_ALL * 768 + (size_t)(qrow % 9216) * 768 + h * 192 + g4 * 4;
#pragma unroll
    for (int nd = 0; nd < 8; ++nd) *(uint2*)(op + nd * 16) = pack4(o[mi][nd] * inv);
  }
}

#define XB_TMO      128
#define XB_XCNT(j)  (256  + 64 * (j))
#define XB_XSUB(j)  (1280 + 64 * (j))
#define XB_XGEN(j)  (2304 + 64 * (j))
#define XB_TOP      3328
#define XB_TOPGEN   3392
#define XCD_BAR_WORDS 3456
#define XB_SPIN_CAP (1u << 23)
#define LAS __attribute__((address_space(3)))

__device__ __forceinline__ unsigned xb_ld(unsigned* p)              { return __hip_atomic_load(p, __ATOMIC_RELAXED, __HIP_MEMORY_SCOPE_AGENT); }
__device__ __forceinline__ unsigned xb_add(unsigned* p, unsigned v) { return __hip_atomic_fetch_add(p, v, __ATOMIC_RELAXED, __HIP_MEMORY_SCOPE_AGENT); }
__device__ __forceinline__ unsigned xb_xcc_id() { return (unsigned)__builtin_amdgcn_s_getreg((3 << 11) | 20) & 0xFu; }
#define XB_SPIN(cond, bar) do { unsigned _sp = 0; while (cond) { __builtin_amdgcn_s_sleep(1); \
    if ((++_sp & 255u) == 0u) { if (xb_ld(&(bar)[XB_TMO])) break; if (_sp > XB_SPIN_CAP) { atomicAdd(&(bar)[XB_TMO], 1u); break; } } } } while (0)

struct XcdBarrier {
    unsigned* bar; unsigned x;
    volatile LAS unsigned* st;
};

__device__ __forceinline__ XcdBarrier xcd_barrier_post(unsigned* bar, volatile LAS unsigned* st) {
    XcdBarrier b; b.bar = bar; b.x = xb_xcc_id(); b.st = st;
    if (threadIdx.x == 0) (void)xb_add(&bar[XB_XCNT(b.x)], 1u);
    return b;
}
__device__ __forceinline__ void xcd_barrier_complete(unsigned* bar, unsigned x, unsigned& nloc, unsigned& nx) {
    const unsigned G = gridDim.x * gridDim.y * gridDim.z;
    unsigned sum, cnt, mine, sp = 0u;
    for (;;) {
        sum = 0u; cnt = 0u; mine = 0u;
#pragma unroll
        for (unsigned j = 0; j < 16; ++j) { const unsigned c = xb_ld(&bar[XB_XCNT(j)]); sum += c; cnt += (c > 0u) ? 1u : 0u; mine = (j == x) ? c : mine; }
        if (sum == G) break;
        __builtin_amdgcn_s_sleep(1);
        if ((++sp & 255u) == 0u) { if (xb_ld(&bar[XB_TMO])) break; if (sp > XB_SPIN_CAP) { atomicAdd(&bar[XB_TMO], 1u); break; } }
    }
    nloc = mine > 0u ? mine : 1u; nx = cnt > 0u ? cnt : 1u;
}

__device__ __forceinline__ void xcd_barrier(const XcdBarrier& b) {
    asm volatile("s_waitcnt vmcnt(0)" ::: "memory");
    __syncthreads();
    if (threadIdx.x == 0) {
        unsigned* bar = b.bar;
        __builtin_amdgcn_s_waitcnt(0);
        unsigned nloc = b.st[0], nx = b.st[1];
        if (nloc == 0u) { xcd_barrier_complete(bar, b.x, nloc, nx); b.st[0] = nloc; b.st[1] = nx; }
        const unsigned old = xb_add(&bar[XB_XSUB(b.x)], 1u);
        const unsigned gen = old / nloc;
        if (old + 1u == (gen + 1u) * nloc) {
            __builtin_amdgcn_fence(__ATOMIC_RELEASE, "agent");
            asm volatile("s_waitcnt vmcnt(0)" ::: "memory");
            const unsigned og = xb_add(&bar[XB_TOP], 1u);
            const unsigned tg = og / nx;
            if (og + 1u == (tg + 1u) * nx) xb_add(&bar[XB_TOPGEN], 1u);
            else XB_SPIN(xb_ld(&bar[XB_TOPGEN]) == tg, bar);
            __builtin_amdgcn_fence(__ATOMIC_ACQUIRE, "agent");
            xb_add(&bar[XB_XGEN(b.x)], 1u);
            asm volatile("s_waitcnt vmcnt(0)" ::: "memory");
        } else {
            XB_SPIN(xb_ld(&bar[XB_XGEN(b.x)]) == gen, bar);
            __builtin_amdgcn_fence(__ATOMIC_ACQUIRE, "agent");
            asm volatile("s_waitcnt vmcnt(0)" ::: "memory");
        }
    }
    __syncthreads();
}


__device__ __forceinline__ void gbar(unsigned* ctr, unsigned target) {
  asm volatile("s_waitcnt vmcnt(0)" ::: "memory");
  __syncthreads();
  if (tid_l() == 0) {
    __builtin_amdgcn_fence(__ATOMIC_RELEASE, "agent");
    asm volatile("s_waitcnt vmcnt(0)" ::: "memory");
    __hip_atomic_fetch_add(ctr, 1u, __ATOMIC_RELAXED, __HIP_MEMORY_SCOPE_AGENT);
    while (__hip_atomic_load(ctr, __ATOMIC_RELAXED, __HIP_MEMORY_SCOPE_AGENT) < target) __builtin_amdgcn_s_sleep(2);
    __builtin_amdgcn_fence(__ATOMIC_ACQUIRE, "agent");
    asm volatile("s_waitcnt vmcnt(0)" ::: "memory");
  }
  __syncthreads();
}
#define MFMA4(a, b, c) __builtin_amdgcn_mfma_f32_16x16x4f32((a), (b), (c), 0, 0, 0)

__device__ __forceinline__ float softplusf_(float x) { return fmaxf(x, 0.f) + log1pf(__expf(-fabsf(x))); }

__device__ __forceinline__ void gdn_chain(const Params& p, int l, int seq, int h, int d, int vs, float* sm) {
  float* sMM = sm;
  float* sK = sMM + 64 * 68;
  u16* sQb = (u16*)(sK + 64 * 65);
  u16* sKb = sQb + 64 * 80;
  float* sV = (float*)(sKb + 64 * 80);
  float* sS = sV + 64 * 33;
  float* sGc = sS + 64 * 33;
  float* sBeta = sGc + 64;
  float* sBg = sBeta + 64;
  u16* sSb = (u16*)(sBg + 64);
  const int tid = tid_l(), lane = tid & 63, w = tid >> 6, r16 = lane & 15, g4 = lane >> 4;
  const bool latent = seq >= 16;
  const int len = latent ? 4096 : 256;
  const int t0 = latent ? T_CTX + (seq - 16) * 4096 : seq * 256;
  const int nchunks = len >> 6;
  const float Acoef = -__expf(p.gdn_a_log[l * 8 + d * 4 + h]);
  const float dtb = p.gdn_dt_bias[l * 8 + d * 4 + h];
  f32x4 Sreg[2];
  __syncthreads();
  {
    const float* s0 = latent ? p.state_gdn + ((((size_t)(seq - 16) * 2 + l) * 2 + d) * 4 + h) * 4096 : nullptr;
#pragma unroll
    for (int n = 0; n < 2; ++n)
#pragma unroll
      for (int r = 0; r < 4; ++r) {
        const int kidx = 16 * w + g4 * 4 + r, cc = n * 16 + r16;
        float v = latent ? s0[kidx * 64 + vs * 32 + cc] : 0.f;
        Sreg[n][r] = v;
        sS[kidx * 33 + cc] = v;
      }
#pragma unroll
    for (int n = 0; n < 2; ++n) *(uint2*)(sSb + (n * 16 + r16) * 80 + 16 * w + g4 * 4) = pack4(Sreg[n]);
  }
  const u16* Pb = p.P + (size_t)t0 * PW;
  const u16* VHb = p.HQ + (size_t)T_ALL * 768 + (size_t)t0 * 256;
#define GDN_SRC(i, tl, tlo_) ({ const int e_ = (tl) + (i) * 256; const int u_ = e_ / 20, un_ = e_ % 20; \
    (un_ < 16) ? (Pb + (size_t)((tlo_) + u_) * PW + (un_ < 8 ? P_QH + h * 64 + un_ * 8 : P_KH + h * 64 + (un_ - 8) * 8)) \
               : (VHb + (size_t)((tlo_) + u_) * 256 + h * 64 + vs * 32 + (un_ - 16) * 8); })
  uint4 pf[5];
  float pga = 0.f, pgb = 0.f;
  {
    const int tlo = d == 0 ? 0 : len - 64;
#pragma unroll
    for (int i = 0; i < 5; ++i) pf[i] = *(const uint4*)GDN_SRC(i, tid, tlo);
    if (tid < 64) {
      const int u = d == 0 ? tid : 63 - tid;
      const float* gab = p.GAB + (size_t)(t0 + tlo + u) * 16;
      pga = gab[d * 4 + h]; pgb = gab[8 + d * 4 + h];
    }
  }
  for (int n = 0; n < nchunks; ++n) {
    const int tlo = d == 0 ? n * 64 : len - 64 * (n + 1);
    const int tl2 = tid_l();
#pragma unroll
    for (int i = 0; i < 5; ++i) {
      const int e = tl2 + i * 256;
      const int u = e / 20, un = e % 20;
      const int pp = d == 0 ? u : 63 - u;
      if (un < 8) { *(uint4*)(sQb + pp * 80 + un * 8) = pf[i]; }
      else {
        if (un < 16) *(uint4*)(sKb + pp * 80 + (un - 8) * 8) = pf[i];
        float* dq = un < 16 ? sK + pp * 65 + (un - 8) * 8 : sV + pp * 33 + (un - 16) * 8;
        const unsigned wv[4] = {pf[i].x, pf[i].y, pf[i].z, pf[i].w};
#pragma unroll
        for (int j = 0; j < 4; ++j) { dq[2 * j] = bf2f((u16)(wv[j] & 0xffff)); dq[2 * j + 1] = bf2f((u16)(wv[j] >> 16)); }
      }
    }
    if (tid < 64) {
      const int pp = tid;
      float g = Acoef * softplusf_(pga + dtb);
      float bt = sigmoidf_(pgb);
#pragma unroll
      for (int o = 1; o < 64; o <<= 1) { float tt = __shfl_up(g, o); if (lane >= o) g += tt; }
      sGc[pp] = g; sBeta[pp] = bt; sBg[pp] = bt * __expf(g);
    }
    if (n + 1 < nchunks) {
      const int tlo2 = d == 0 ? (n + 1) * 64 : len - 64 * (n + 2);
#pragma unroll
      for (int i = 0; i < 5; ++i) pf[i] = *(const uint4*)GDN_SRC(i, tl2, tlo2);
      if (tid < 64) {
        const int u = d == 0 ? tid : 63 - tid;
        const float* gab = p.GAB + (size_t)(t0 + tlo2 + u) * 16;
        pga = gab[d * 4 + h]; pgb = gab[8 + d * 4 + h];
      }
    }
    __syncthreads();
    const unsigned tcode = w == 0 ? 0x730u : (w == 1 ? 0xA51u : (w == 2 ? 0x062u : 0x0FBu));
    const int tcnt = w < 2 ? 3 : 2;
    f32x4 attacc[3];
#pragma unroll
    for (int t = 0; t < 3; ++t) {
      attacc[t] = f32x4{0.f, 0.f, 0.f, 0.f};
      if (t < tcnt) {
        const int ti = (tcode >> (4 * t)) & 3, tn = (tcode >> (4 * t + 2)) & 3;
        f32x4 accm = f32x4{0.f, 0.f, 0.f, 0.f};
        const u16* akb = sKb + (16 * ti + r16) * 80 + g4 * 8;
        const u16* aqb = sQb + (16 * ti + r16) * 80 + g4 * 8;
        const u16* bkb = sKb + (16 * tn + r16) * 80 + g4 * 8;
        const bf16x8 ak0 = *(const bf16x8*)(akb), ak1 = *(const bf16x8*)(akb + 32);
        const bf16x8 aq0 = *(const bf16x8*)(aqb), aq1 = *(const bf16x8*)(aqb + 32);
        const bf16x8 bk0 = *(const bf16x8*)(bkb), bk1 = *(const bf16x8*)(bkb + 32);
        accm = __builtin_amdgcn_mfma_f32_16x16x32_bf16(ak0, bk0, accm, 0, 0, 0);
        accm = __builtin_amdgcn_mfma_f32_16x16x32_bf16(ak1, bk1, accm, 0, 0, 0);
        attacc[t] = __builtin_amdgcn_mfma_f32_16x16x32_bf16(aq0, bk0, attacc[t], 0, 0, 0);
        attacc[t] = __builtin_amdgcn_mfma_f32_16x16x32_bf16(aq1, bk1, attacc[t], 0, 0, 0);
#pragma unroll
        for (int r = 0; r < 4; ++r) {
          const int i = 16 * ti + g4 * 4 + r, j = 16 * tn + r16;
          sMM[i * 68 + j] = (i > j) ? sBeta[i] * accm[r] * __expf(sGc[i] - sGc[j]) : 0.f;
        }
      }
    }
    __syncthreads();
    if (w == 0) {
      const int bi = tid >> 4, c = tid & 15;
      float* md = sMM + (16 * bi) * 68 + 16 * bi;
      float a[16];
#pragma unroll
      for (int r = 0; r < 16; ++r) a[r] = (r == c) ? 1.f : 0.f;
#pragma unroll
      for (int r = 1; r < 16; ++r) {
#pragma unroll
        for (int q4 = 0; q4 < (r + 3) / 4; ++q4) {
          const float4 m = *(const float4*)(md + r * 68 + 4 * q4);
          if (q4 * 4 + 0 < r) a[r] -= m.x * a[q4 * 4 + 0];
          if (q4 * 4 + 1 < r) a[r] -= m.y * a[q4 * 4 + 1];
          if (q4 * 4 + 2 < r) a[r] -= m.z * a[q4 * 4 + 2];
          if (q4 * 4 + 3 < r) a[r] -= m.w * a[q4 * 4 + 3];
        }
      }
      __builtin_amdgcn_fence(__ATOMIC_SEQ_CST, "wavefront");
#pragma unroll
      for (int r = 0; r < 16; ++r) md[r * 68 + c] = a[r];
    } else {
      for (int t = w - 1; t < 8; t += 3) {
        const int ti = t >> 1, tc = t & 1;
        const u16* akb = sKb + (16 * ti + r16) * 80 + g4 * 8;
        const u16* bsb = sSb + (16 * tc + r16) * 80 + g4 * 8;
        f32x4 acc = f32x4{0.f, 0.f, 0.f, 0.f};
        acc = __builtin_amdgcn_mfma_f32_16x16x32_bf16(*(const bf16x8*)(akb), *(const bf16x8*)(bsb), acc, 0, 0, 0);
        acc = __builtin_amdgcn_mfma_f32_16x16x32_bf16(*(const bf16x8*)(akb + 32), *(const bf16x8*)(bsb + 32), acc, 0, 0, 0);
#pragma unroll
        for (int r = 0; r < 4; ++r) {
          const int i = 16 * ti + g4 * 4 + r, cc = 16 * tc + r16;
          sV[i * 33 + cc] = sV[i * 33 + cc] * sBeta[i] - sBg[i] * acc[r];
        }
      }
    }
    __syncthreads();
    for (int ib = 0; ib < 4; ++ib) {
      if (w < 2) {
        const int ct = w;
        f32x4 acc = f32x4{0.f, 0.f, 0.f, 0.f};
        const float* am = sMM + (16 * ib + r16) * 68 + g4;
        const float* bx = sV + g4 * 33 + 16 * ct + r16;
        for (int s4 = 0; s4 < ib; ++s4) {
#pragma unroll
          for (int s = 0; s < 4; ++s) acc = MFMA4(am[16 * s4 + 4 * s], bx[(16 * s4 + 4 * s) * 33], acc);
        }
        f32x4 rm;
#pragma unroll
        for (int r = 0; r < 4; ++r) rm[r] = sV[(16 * ib + g4 * 4 + r) * 33 + 16 * ct + r16] - acc[r];
        const float* dd = sMM + (16 * ib + r16) * 68 + 16 * ib + 4 * g4;
        f32x4 xn = f32x4{0.f, 0.f, 0.f, 0.f};
#pragma unroll
        for (int s = 0; s < 4; ++s) xn = MFMA4(dd[s], rm[s], xn);
#pragma unroll
        for (int r = 0; r < 4; ++r) sV[(16 * ib + g4 * 4 + r) * 33 + 16 * ct + r16] = xn[r];
        __builtin_amdgcn_fence(__ATOMIC_SEQ_CST, "wavefront");
      }
    }
    __syncthreads();
#pragma unroll
    for (int t = 0; t < 3; ++t) {
      if (t < tcnt) {
        const int ti = (tcode >> (4 * t)) & 3, tn = (tcode >> (4 * t + 2)) & 3;
#pragma unroll
        for (int r = 0; r < 4; ++r) {
          const int i = 16 * ti + g4 * 4 + r, j = 16 * tn + r16;
          sMM[i * 68 + j] = (i >= j) ? attacc[t][r] * __expf(sGc[i] - sGc[j]) : 0.f;
        }
      }
    }
    __syncthreads();
    {
      f32x4 acc[2] = {f32x4{0.f, 0.f, 0.f, 0.f}, f32x4{0.f, 0.f, 0.f, 0.f}};
      const float eg = __expf(sGc[16 * w + r16]);
      {
        const u16* qb = sQb + (16 * w + r16) * 80 + g4 * 8;
        const bf16x8 q0 = *(const bf16x8*)(qb), q1 = *(const bf16x8*)(qb + 32);
#pragma unroll
        for (int nn = 0; nn < 2; ++nn) {
          const u16* sb = sSb + (16 * nn + r16) * 80 + g4 * 8;
          acc[nn] = __builtin_amdgcn_mfma_f32_16x16x32_bf16(*(const bf16x8*)(sb), q0, acc[nn], 0, 0, 0);
          acc[nn] = __builtin_amdgcn_mfma_f32_16x16x32_bf16(*(const bf16x8*)(sb + 32), q1, acc[nn], 0, 0, 0);
          acc[nn] *= eg;
        }
      }
#pragma unroll
      for (int s = 0; s < 16; ++s) {
        if (s < 4 * (w + 1)) {
          const float a = sMM[(16 * w + r16) * 68 + 4 * s + g4];
          acc[0] = MFMA4(sV[(4 * s + g4) * 33 + r16], a, acc[0]);
          acc[1] = MFMA4(sV[(4 * s + g4) * 33 + 16 + r16], a, acc[1]);
        }
      }
      {
        const int pp = 16 * w + r16;
        const int u = d == 0 ? pp : 63 - pp;
        u16* op = p.MIX + (size_t)(t0 + tlo + u) * 1024 + d * 256 + h * 64 + vs * 32 + g4 * 4;
        *(uint2*)(op) = pack4(acc[0]);
        *(uint2*)(op + 16) = pack4(acc[1]);
      }
    }
    __syncthreads();
    {
      const float g63 = sGc[63];
      const float gl = __expf(g63);
#pragma unroll
      for (int nn = 0; nn < 2; ++nn)
#pragma unroll
        for (int r = 0; r < 4; ++r) Sreg[nn][r] *= gl;
#pragma unroll
      for (int ks = 0; ks < 2; ++ks) {
        float va[8], v0[8], v1[8];
#pragma unroll
        for (int j = 0; j < 8; ++j) {
          const int srow = ks * 32 + g4 * 8 + j;
          va[j] = sK[srow * 65 + 16 * w + r16] * __expf(g63 - sGc[srow]);
          v0[j] = sV[srow * 33 + r16]; v1[j] = sV[srow * 33 + 16 + r16];
        }
        const bf16x8 af = __builtin_bit_cast(bf16x8, pack8(va));
        Sreg[0] = __builtin_amdgcn_mfma_f32_16x16x32_bf16(af, __builtin_bit_cast(bf16x8, pack8(v0)), Sreg[0], 0, 0, 0);
        Sreg[1] = __builtin_amdgcn_mfma_f32_16x16x32_bf16(af, __builtin_bit_cast(bf16x8, pack8(v1)), Sreg[1], 0, 0, 0);
      }
    }
    __syncthreads();
#pragma unroll
    for (int nn = 0; nn < 2; ++nn) *(uint2*)(sSb + (nn * 16 + r16) * 80 + 16 * w + g4 * 4) = pack4(Sreg[nn]);
    __syncthreads();
  }
  if (!latent) {
    float* so = p.out + OUT_SGDN + ((((size_t)seq * 2 + l) * 2 + d) * 4 + h) * 4096;
#pragma unroll
    for (int nn = 0; nn < 2; ++nn)
#pragma unroll
      for (int r = 0; r < 4; ++r) so[(16 * w + g4 * 4 + r) * 64 + vs * 32 + nn * 16 + r16] = Sreg[nn][r];
  }
}

__device__ __forceinline__ void hgrn_chain(const Params& p, int l, int seq, int h, int d, int vs, float* sm) {
  float* sBC = sm;
  float* sK = sBC + 64 * 65;
  float* sAT = sK + 64 * 65;
  float* sV = sAT + 64 * 68;
  float* sS = sV + 64 * 33;
  float* sTot = sS + 64 * 33;
  u16* sSb = (u16*)(sTot + 256 + 64);
  const int tid = tid_l(), lane = tid & 63, w = tid >> 6, r16 = lane & 15, g4 = lane >> 4;
  const bool latent = seq >= 16;
  const int len = latent ? 4096 : 256;
  const int t0 = latent ? T_CTX + (seq - 16) * 4096 : seq * 256;
  const int nchunks = len >> 6;
  float lbk;
  {
    const int kch = h * 64 + (tid & 63);
    lbk = (l == 0) ? 0.f : sigmoidf_(p.hgrn_lb[256 + kch] - p.hgrn_lb[kch]);
  }
  f32x4 Sreg[2];
  __syncthreads();
  {
    const float* s0 = latent ? p.state_hgrn + ((((size_t)(seq - 16) * 2 + l) * 2 + d) * 4 + h) * 4096 : nullptr;
#pragma unroll
    for (int n = 0; n < 2; ++n)
#pragma unroll
      for (int r = 0; r < 4; ++r) {
        const int kidx = 16 * w + g4 * 4 + r, cc = n * 16 + r16;
        float v = latent ? s0[kidx * 64 + vs * 32 + cc] : 0.f;
        Sreg[n][r] = v;
        sS[kidx * 33 + cc] = v;
      }
#pragma unroll
    for (int n = 0; n < 2; ++n) *(uint2*)(sSb + (n * 16 + r16) * 80 + 16 * w + g4 * 4) = pack4(Sreg[n]);
  }
  const u16* Pb = p.P + (size_t)t0 * PW;
  float* sLb = sTot + 256;
  if (tid < 64) sLb[tid] = lbk;
  __syncthreads();
  int pgo[5];
#pragma unroll
  for (int i = 0; i < 5; ++i) {
    const int e = tid + i * 256;
    const int u = e / 20, un = e % 20;
    pgo[i] = u * PW + (un < 8 ? P_HF + d * 256 + h * 64 + un * 8 : (un < 12 ? P_HI + h * 64 + vs * 32 + (un - 8) * 8 : P_HQ + h * 64 + (un - 12) * 8));
  }
  uint4 pf[5];
  {
    const int tlo = d == 0 ? 0 : len - 64;
#pragma unroll
    for (int i = 0; i < 5; ++i) pf[i] = *(const uint4*)(Pb + (size_t)tlo * PW + pgo[i]);
  }
  for (int n = 0; n < nchunks; ++n) {
#pragma unroll
    for (int i = 0; i < 5; ++i) {
      const int e = tid + i * 256;
      const int u = e / 20, un = e % 20;
      const int pp = d == 0 ? u : 63 - u;
      const unsigned wv[4] = {pf[i].x, pf[i].y, pf[i].z, pf[i].w};
#pragma unroll
      for (int j = 0; j < 8; ++j) {
        const float x = bf2f((u16)((wv[j >> 1] >> ((j & 1) * 16)) & 0xffff));
        if (un < 8) {
          const int k = un * 8 + j;
          const float lb = sLb[k];
          const float sg_ = sigmoidf_(x);
          const float gate = lb + (1.f - lb) * sg_;
          sBC[pp * 65 + k] = __logf(fmaxf(gate, 1e-30f));
          sK[pp * 65 + k] = (1.f - lb) * (1.f - sg_);
        } else if (un < 12) {
          sV[pp * 33 + (un - 8) * 8 + j] = x;
        } else {
          sAT[pp * 68 + (un - 12) * 8 + j] = x;
        }
      }
    }
    __syncthreads();
    if (n + 1 < nchunks) {
      const int tlo2 = d == 0 ? (n + 1) * 64 : len - 64 * (n + 2);
#pragma unroll
      for (int i = 0; i < 5; ++i) pf[i] = *(const uint4*)(Pb + (size_t)tlo2 * PW + pgo[i]);
    }
    const int tlo = d == 0 ? n * 64 : len - 64 * (n + 1);
    float cs[16];
    {
      const int k = tid & 63, sg = tid >> 6;
      float run = 0.f;
#pragma unroll
      for (int i = 0; i < 16; ++i) { run += sBC[(16 * sg + i) * 65 + k]; cs[i] = run; }
      sTot[sg * 64 + k] = run;
    }
    float qa[16];
#pragma unroll
    for (int s = 0; s < 16; ++s) qa[s] = sAT[(16 * w + r16) * 68 + 4 * s + g4];
    __syncthreads();
    {
      const int k = tid & 63, sg = tid >> 6;
      float off = 0.f;
      for (int s2 = 0; s2 < sg; ++s2) off += sTot[s2 * 64 + k];
#pragma unroll
      for (int i = 0; i < 16; ++i) sBC[(16 * sg + i) * 65 + k] = cs[i] + off;
    }
    __syncthreads();
    f32x4 o1[2] = {f32x4{0.f, 0.f, 0.f, 0.f}, f32x4{0.f, 0.f, 0.f, 0.f}};
    {
      const float* qrow = sAT + (16 * w + r16) * 68 + g4 * 8;
      const float* bcrow = sBC + (16 * w + r16) * 65 + g4 * 8;
      bf16x8 af[2];
#pragma unroll
      for (int ks = 0; ks < 2; ++ks) {
        float v[8];
#pragma unroll
        for (int j = 0; j < 8; ++j) v[j] = qrow[ks * 32 + j] * __expf(bcrow[ks * 32 + j]);
        af[ks] = __builtin_bit_cast(bf16x8, pack8(v));
      }
#pragma unroll
      for (int nn = 0; nn < 2; ++nn) {
        const u16* sb = sSb + (16 * nn + r16) * 80 + g4 * 8;
        o1[nn] = __builtin_amdgcn_mfma_f32_16x16x32_bf16(*(const bf16x8*)(sb), af[0], o1[nn], 0, 0, 0);
        o1[nn] = __builtin_amdgcn_mfma_f32_16x16x32_bf16(*(const bf16x8*)(sb + 32), af[1], o1[nn], 0, 0, 0);
      }
    }
    {
      float aq[16], rf[16];
#pragma unroll
      for (int s = 0; s < 16; ++s) {
        const int kk = 4 * s + g4;
        rf[s] = (w == 0) ? 0.f : sBC[(16 * w - 1) * 65 + kk];
        aq[s] = qa[s] * __expf(sBC[(16 * w + r16) * 65 + kk] - rf[s]);
      }
#pragma unroll
      for (int nn = 0; nn < 4; ++nn) {
        f32x4 acc = f32x4{0.f, 0.f, 0.f, 0.f};
        if (nn <= w) {
#pragma unroll
          for (int s = 0; s < 16; ++s) {
            const int kk = 4 * s + g4, sc = 16 * nn + r16;
            const float bv = sK[sc * 65 + kk] * __expf(fminf(rf[s] - sBC[sc * 65 + kk], 80.f));
            acc = MFMA4(aq[s], bv, acc);
          }
        }
#pragma unroll
        for (int r = 0; r < 4; ++r) {
          const int i = 16 * w + g4 * 4 + r, j = 16 * nn + r16;
          sAT[i * 68 + j] = (i >= j) ? acc[r] : 0.f;
        }
      }
    }
    __syncthreads();
    {
      f32x4 acc[2] = {o1[0], o1[1]};
#pragma unroll
      for (int s = 0; s < 16; ++s) {
        if (s < 4 * (w + 1)) {
          const float a = sAT[(16 * w + r16) * 68 + 4 * s + g4];
          acc[0] = MFMA4(sV[(4 * s + g4) * 33 + r16], a, acc[0]);
          acc[1] = MFMA4(sV[(4 * s + g4) * 33 + 16 + r16], a, acc[1]);
        }
      }
      {
        const int pp = 16 * w + r16;
        const int u = d == 0 ? pp : 63 - pp;
        u16* op = p.MIX + (size_t)(t0 + tlo + u) * 1024 + 512 + d * 256 + h * 64 + vs * 32 + g4 * 4;
        *(uint2*)(op) = pack4(acc[0]);
        *(uint2*)(op + 16) = pack4(acc[1]);
      }
    }
    __syncthreads();
    {
#pragma unroll
      for (int nn = 0; nn < 2; ++nn)
#pragma unroll
        for (int r = 0; r < 4; ++r) Sreg[nn][r] *= __expf(sBC[63 * 65 + 16 * w + g4 * 4 + r]);
      const int kA = 16 * w + r16;
      const float blA = sBC[63 * 65 + kA];
#pragma unroll
      for (int ks = 0; ks < 2; ++ks) {
        float va[8], v0[8], v1[8];
#pragma unroll
        for (int j = 0; j < 8; ++j) {
          const int srow = ks * 32 + g4 * 8 + j;
          va[j] = sK[srow * 65 + kA] * __expf(blA - sBC[srow * 65 + kA]);
          v0[j] = sV[srow * 33 + r16]; v1[j] = sV[srow * 33 + 16 + r16];
        }
        const bf16x8 af = __builtin_bit_cast(bf16x8, pack8(va));
        Sreg[0] = __builtin_amdgcn_mfma_f32_16x16x32_bf16(af, __builtin_bit_cast(bf16x8, pack8(v0)), Sreg[0], 0, 0, 0);
        Sreg[1] = __builtin_amdgcn_mfma_f32_16x16x32_bf16(af, __builtin_bit_cast(bf16x8, pack8(v1)), Sreg[1], 0, 0, 0);
      }
    }
    __syncthreads();
#pragma unroll
    for (int nn = 0; nn < 2; ++nn) *(uint2*)(sSb + (nn * 16 + r16) * 80 + 16 * w + g4 * 4) = pack4(Sreg[nn]);
    __syncthreads();
  }
  if (!latent) {
    float* so = p.out + OUT_SHG + ((((size_t)seq * 2 + l) * 2 + d) * 4 + h) * 4096;
#pragma unroll
    for (int nn = 0; nn < 2; ++nn)
#pragma unroll
      for (int r = 0; r < 4; ++r) so[(16 * w + g4 * 4 + r) * 64 + vs * 32 + nn * 16 + r16] = Sreg[nn][r];
  }
}

__device__ __forceinline__ void phase_c(const Params& p, int l, unsigned char* smraw, int mode = 0) {
  __shared__ int s_item;
  const int total = 1920;
  const bool paired = (gridDim.x == 512);
  const int jx = blockIdx.x >> 3;
  int my_static = -1;
  if (paired && (jx & 31) < 16) my_static = (blockIdx.x & 7) * 32 + (jx & 15) * 2 + (jx >> 5);
  for (;;) {
    __syncthreads();
    if (tid_l() == 0) {
      if (my_static >= 0) s_item = my_static;
      else s_item = (paired ? 256 : 0) + (int)atomicAdd(&p.counters[l * 64 + mode * 16], 1u);
    }
    __syncthreads();
    my_static = -1;
    const int item = s_item;
    if (item >= total) break;
    int kind, a0, a1, a2, a3;
    if (item < 256 || (item >= 1280 && item < 1792)) {
      const int i2 = item < 256 ? item : item - 1280;
      const int rest = i2 >> 1;
      kind = i2 & 1;
      a3 = rest & 1; a2 = (rest >> 1) & 1; a1 = (rest >> 2) & 3; a0 = (rest >> 4) + (item < 256 ? 16 : 0);
    } else if (item < 1280) {
      const int i2 = item - 256;
      kind = 2; a0 = 1; a1 = i2 >> 7; a2 = (i2 >> 5) & 3; a3 = i2 & 31;
    } else {
      const int i2 = item - 1792;
      kind = 2; a0 = 0; a1 = i2 >> 3; a2 = (i2 >> 1) & 3; a3 = i2 & 1;
    }
    if (mode == 1 && kind == 2) continue;
    if (mode == 2 && kind != 2) continue;
    if (kind != 2) __builtin_amdgcn_s_setprio(3);
    if (kind == 0) gdn_chain(p, l, a0, a1, a2, a3, (float*)smraw);
    else if (kind == 1) hgrn_chain(p, l, a0, a1, a2, a3, (float*)smraw);
    if (kind != 2) __builtin_amdgcn_s_setprio(0);
    else attn_item(p, a0, a1, a2, a3, smraw, mode == 2);
  }
}

__global__ void __launch_bounds__(NTHR, 2) mega(Params p) {
  __shared__ __attribute__((aligned(16))) unsigned char smem[LDS_BYTES];
  cg::grid_group grid = cg::this_grid();
  __shared__ uint4 xb_words;
  if (threadIdx.x == 0) xb_words = make_uint4(0u, 0u, 0u, 0u);
  __syncthreads();
  {
    XcdBarrier xb0 = xcd_barrier_post(p.xbar, (volatile LAS unsigned*)&xb_words);
    if (threadIdx.x == 0) ((volatile LAS unsigned*)&xb_words)[2] = xb0.x;
  }
#define GSYNC() do { XcdBarrier xb_; xb_.bar = p.xbar; xb_.st = (volatile LAS unsigned*)&xb_words; xb_.x = 0; \
    if (threadIdx.x == 0) xb_.x = ((volatile LAS unsigned*)&xb_words)[2]; xcd_barrier(xb_); } while (0)
  phase0(p, (float*)smem);
  if (p.out == nullptr) grid.sync();
  GSYNC();
  rowpass_norm(p, 0, 0);
  GSYNC();
  for (int l = 0; l < 2; ++l) {
    phase_a(p, l, (u16*)smem);
    GSYNC();
    rowpass_b0(p, l);
    GSYNC();
    phase_b1(p, l, (u16*)smem);
    GSYNC();
    rowpass_b2(p, l);
    GSYNC();
    phase_c(p, l, smem);
    GSYNC();
    rowpass_c2(p, l);
    GSYNC();
    phase_gemm_y(p.MIX, 1024, p.WoutT + (size_t)l * 1024 * 1024, 1024, 1024, p.HQ, 1024, (u16*)smem);
    GSYNC();
    rowpass_norm(p, l, 1);
    GSYNC();
    phase_e(p, l, (u16*)smem);
    GSYNC();
    phase_gemm_y(p.P, DFF, p.WfoT + (size_t)l * 1024 * DFF, DFF, 1024, p.HQ, 1024, (u16*)smem);
    GSYNC();
    rowpass_norm(p, l, 2);
    if (l == 0) GSYNC();
  }
}

extern "C" void kernel_launch(void* const* d_in, const int* in_sizes, int n_in, void* d_out, int out_size, void* d_ws,
                              size_t ws_size, hipStream_t stream) {
  static int grid_blocks = 0;
  if (!grid_blocks) {
    int dev = 0, cus = 0, per_cu = 0;
    hipGetDevice(&dev);
    hipDeviceGetAttribute(&cus, hipDeviceAttributeMultiprocessorCount, dev);
    hipOccupancyMaxActiveBlocksPerMultiprocessor(&per_cu, mega, NTHR, 0);
    if (per_cu > 2) per_cu = 2;
    if (per_cu < 1) per_cu = 1;
    grid_blocks = cus * per_cu;
  }
  Params p{};
  const float* const* in = (const float* const*)d_in;
  p.x_prompt = in[0]; p.x_sample = in[1]; p.cache_ckv = in[2]; p.cache_kr = in[3]; p.state_gdn = in[4]; p.state_hgrn = in[5];
  p.c = in[6]; p.c_ctx = in[7]; p.w_ada = in[8]; p.b_ada = in[9]; p.g_pre_mix = in[10]; p.g_post_mix = in[11];
  p.g_pre_ffn = in[12]; p.g_post_ffn = in[13]; p.w_in = in[14]; p.w_out = in[15]; p.gdn_conv_w = in[16];
  p.gdn_a_log = in[17]; p.gdn_dt_bias = in[18]; p.gdn_norm_w = in[19]; p.hgrn_lb = in[20]; p.hgrn_norm_w = in[21];
  p.mla_q_norm_w = in[22]; p.mla_w_uq = in[23]; p.mla_kv_norm_w = in[24]; p.mla_w_ukv = in[25]; p.w_ffn_in = in[26];
  p.w_ffn_out = in[27];
  p.out = (float*)d_out;
  unsigned char* ws = (unsigned char*)d_ws;
  size_t off = 0;
  auto take = [&](size_t bytes) { unsigned char* r = ws + off; off += (bytes + 255) & ~(size_t)255; return r; };
  p.counters = (unsigned*)take(1024);
  p.xbar = (unsigned*)take(16384);
  p.WinT = (u16*)take((size_t)2 * 3072 * 1024 * 2);
  p.WuqT = (u16*)take((size_t)2 * 768 * 384 * 2);
  p.WukvT = (u16*)take((size_t)2 * 1024 * 256 * 2);
  p.WoutT = (u16*)take((size_t)2 * 1024 * 1024 * 2);
  p.WfiT = (u16*)take((size_t)2 * 5632 * 1024 * 2);
  p.WfoT = (u16*)take((size_t)2 * 1024 * 2816 * 2);
  p.mod = (float*)take((size_t)2 * 9 * 6144 * 4);
  p.HQ = (u16*)take((size_t)T_ALL * 1024 * 2);
  p.P = (u16*)take((size_t)T_ALL * PW * 2);
  p.KN = (u16*)take((size_t)(T_ALL + 2048) * 512 * 2);
  p.VTL = (u16*)take((size_t)8 * 4 * 128 * 4352 * 2);
  p.VTC = (u16*)take((size_t)16 * 4 * 128 * 256 * 2);
  p.CKVC = (u16*)take((size_t)2048 * 256 * 2);
  p.KRC = (u16*)take((size_t)2048 * 64 * 2);
  p.GAB = (float*)take((size_t)T_ALL * 16 * 4);
  p.MIX = (u16*)take((size_t)T_ALL * 1024 * 2);
  if (off > ws_size) { fprintf(stderr, "workspace too small: need %zu have %zu\n", off, ws_size); return; }
  hipMemsetAsync(p.counters, 0, 1024 + 16384, stream);
  void* args[] = {&p};
  hipError_t e = hipLaunchCooperativeKernel((void*)mega, dim3(grid_blocks), dim3(NTHR), args, 0, stream);
  if (e != hipSuccess) fprintf(stderr, "cooperative launch failed: %s (grid %d)\n", hipGetErrorString(e), grid_blocks);
}
```

```cpp
#include <hip/hip_runtime.h>
#include <hip/hip_cooperative_groups.h>
#include <cstdio>
namespace cg = cooperative_groups;

typedef unsigned short u16;
using bf16x8 = __attribute__((ext_vector_type(8))) short;
using f32x4  = __attribute__((ext_vector_type(4))) float;

#define T_CTX 4096
#define T_ALL 36864
#define PW 3072
#define DFF 2816
#define LDS_BYTES 77824
#define NTHR 256

#define P_GQKV 0
#define P_GZ 768
#define P_HQ 1024
#define P_HI 1280
#define P_HF 1536
#define P_HG 2048
#define P_MCQ 2304
#define P_MCKV 2688
#define P_MKR 2944
#define P_GA 3008

struct Params {
  const float *x_prompt, *x_sample, *cache_ckv, *cache_kr, *state_gdn, *state_hgrn, *c, *c_ctx;
  const float *w_ada, *b_ada, *g_pre_mix, *g_post_mix, *g_pre_ffn, *g_post_ffn, *w_in, *w_out;
  const float *gdn_conv_w, *gdn_a_log, *gdn_dt_bias, *gdn_norm_w, *hgrn_lb, *hgrn_norm_w;
  const float *mla_q_norm_w, *mla_w_uq, *mla_kv_norm_w, *mla_w_ukv, *w_ffn_in, *w_ffn_out;
  float* out;
  u16 *WinT, *WuqT, *WukvT, *WoutT, *WfiT, *WfoT;
  float* mod;
  u16 *HQ, *P, *KN, *VTL, *VTC, *CKVC, *KRC, *MIX;
  float* GAB;
  unsigned* counters;
  unsigned* xbar;
};

#define OUT_CKV   37748736
#define OUT_KR    39845888
#define OUT_SGDN  40370176
#define OUT_SHG   41418752

__device__ __forceinline__ u16 f2bf(float f) {
  unsigned u = __float_as_uint(f);
  u += 0x7fffu + ((u >> 16) & 1u);
  return (u16)(u >> 16);
}
typedef __attribute__((ext_vector_type(2))) __bf16 bf16x2_t;
typedef __attribute__((ext_vector_type(2))) float f32x2_t;
__device__ __forceinline__ unsigned pack2bf(float x, float y) {
  return __builtin_bit_cast(unsigned, __builtin_convertvector((f32x2_t){x, y}, bf16x2_t));
}
__device__ __forceinline__ float bf2f(u16 h) { return __uint_as_float(((unsigned)h) << 16); }
__device__ __forceinline__ float wave_sum(float v) {
#pragma unroll
  for (int o = 32; o > 0; o >>= 1) v += __shfl_xor(v, o);
  return v;
}
__device__ __forceinline__ float sigmoidf_(float x) { return __builtin_amdgcn_rcpf(1.f + __expf(-x)); }
__device__ __forceinline__ float siluf_(float x) { return x * __builtin_amdgcn_rcpf(1.f + __expf(-x)); }
__device__ __forceinline__ int tid_l() { int t = threadIdx.x; asm volatile("" : "+v"(t)); return t; }
__device__ __forceinline__ int tok_mod(int t) { return t < T_CTX ? 0 : 1 + ((t - T_CTX) >> 12); }

__device__ __forceinline__ int map_col(int kind, int j) {
  if (kind == 0) return j;
  if (kind == 1) { if (j < 1024) return j; if (j < 3008) return j + 16; if (j < 3024) return 1024 + (j - 3008); return -1; }
  int blk = j >> 6, w = j & 63;
  return w < 32 ? blk * 32 + w : DFF + blk * 32 + (w - 32);
}

__device__ __forceinline__ void cvt_tile(const float* __restrict__ src, int K, int Nsrc, u16* __restrict__ dst, int kind, int jt, int kt, float* sm) {
  const int tid = tid_l();
  const int j0 = jt * 64, k0 = kt * 64;
  __syncthreads();
  {
    int jj = tid & 63, kk0 = tid >> 6;
    int sc = map_col(kind, j0 + jj);
    for (int kk = kk0; kk < 64; kk += 4)
      sm[kk * 65 + jj] = sc >= 0 ? src[(size_t)(k0 + kk) * Nsrc + sc] : 0.f;
  }
  __syncthreads();
  {
    const int kq = tid & 15, jj0 = tid >> 4;
#pragma unroll
    for (int jj = jj0; jj < 64; jj += 16) {
      uint2 o;
      o.x = pack2bf(sm[(4 * kq + 0) * 65 + jj], sm[(4 * kq + 1) * 65 + jj]);
      o.y = pack2bf(sm[(4 * kq + 2) * 65 + jj], sm[(4 * kq + 3) * 65 + jj]);
      *(uint2*)(dst + (size_t)(j0 + jj) * K + k0 + 4 * kq) = o;
    }
  }
}

__device__ __forceinline__ void mod_item(const Params& p, int item, float* sm) {
  const int l = item / 96, j0 = (item % 96) * 64;
  const int tid = tid_l();
  float* sC = sm;
  float* sR = sm + 9 * 1024;
  __syncthreads();
  for (int i = tid; i < 9 * 1024; i += NTHR) {
    int m = i >> 10, k = i & 1023;
    float v = m == 0 ? p.c_ctx[k] : p.c[(m - 1) * 1024 + k];
    sC[i] = siluf_(v);
  }
  __syncthreads();
  const int col = tid & 63, ks = tid >> 6;
  float acc[9];
#pragma unroll
  for (int m = 0; m < 9; ++m) acc[m] = 0.f;
  const float* wp = p.w_ada + (size_t)l * 1024 * 6144 + j0 + col;
  for (int k = ks * 256; k < ks * 256 + 256; k += 8) {
    float wv[8];
#pragma unroll
    for (int u = 0; u < 8; ++u) wv[u] = wp[(size_t)(k + u) * 6144];
#pragma unroll
    for (int u = 0; u < 8; ++u)
#pragma unroll
      for (int m = 0; m < 9; ++m) acc[m] += sC[m * 1024 + k + u] * wv[u];
  }
#pragma unroll
  for (int m = 0; m < 9; ++m) sR[(ks * 9 + m) * 64 + col] = acc[m];
  __syncthreads();
  for (int i = tid; i < 9 * 64; i += NTHR) {
    int m = i >> 6, cc = i & 63;
    float v = sR[(0 * 9 + m) * 64 + cc] + sR[(1 * 9 + m) * 64 + cc] + sR[(2 * 9 + m) * 64 + cc] + sR[(3 * 9 + m) * 64 + cc];
    p.mod[((size_t)l * 9 + m) * 6144 + j0 + cc] = v + p.b_ada[l * 6144 + j0 + cc];
  }
}

__device__ __forceinline__ void phase0(const Params& p, float* sm) {
  const int PER_LAYER = 3272;
  const int total = 2 * PER_LAYER + 192;
  for (int item = blockIdx.x; item < total; item += gridDim.x) {
    if (item < 192) { mod_item(p, item, sm); continue; }
    int it = item - 192;
    int l = it / PER_LAYER, r = it % PER_LAYER;
    if (r < 768) { cvt_tile(p.w_in + (size_t)l * 1024 * 3024, 1024, 3024, p.WinT + (size_t)l * 3072 * 1024, 1, r / 16, r % 16, sm); continue; }
    r -= 768;
    if (r < 72) { cvt_tile(p.mla_w_uq + (size_t)l * 384 * 768, 384, 768, p.WuqT + (size_t)l * 768 * 384, 0, r / 6, r % 6, sm); continue; }
    r -= 72;
    if (r < 64) { cvt_tile(p.mla_w_ukv + (size_t)l * 256 * 1024, 256, 1024, p.WukvT + (size_t)l * 1024 * 256, 0, r / 4, r % 4, sm); continue; }
    r -= 64;
    if (r < 256) { cvt_tile(p.w_out + (size_t)l * 1024 * 1024, 1024, 1024, p.WoutT + (size_t)l * 1024 * 1024, 0, r / 16, r % 16, sm); continue; }
    r -= 256;
    if (r < 1408) { cvt_tile(p.w_ffn_in + (size_t)l * 1024 * 5632, 1024, 5632, p.WfiT + (size_t)l * 5632 * 1024, 2, r / 16, r % 16, sm); continue; }
    r -= 1408;
    cvt_tile(p.w_ffn_out + (size_t)l * 2816 * 1024, 2816, 1024, p.WfoT + (size_t)l * 1024 * 2816, 0, r / 44, r % 44, sm);
  }
}

__device__ __forceinline__ void rowpass_norm(const Params& p, int l, int stage) {
  const int tidl = tid_l();
  const int lane = tidl & 63, w = tidl >> 6;
  const int ln = stage == 0 ? 0 : (stage == 1 ? l : l + 1);
  const int sh_off = stage == 1 ? 3072 : 0;
  const float* gpre = stage == 1 ? p.g_pre_ffn + l * 1024 : p.g_pre_mix + (ln < 2 ? ln : 0) * 1024;
  u16* dst = stage == 1 ? p.MIX : p.HQ;
  for (int t = blockIdx.x * 4 + w; t < T_ALL; t += gridDim.x * 4) {
    const int m = tok_mod(t);
    float x[16];
    float* xo = p.out + (size_t)t * 1024;
    if (stage == 0) {
      const float* xi = t < T_CTX ? p.x_prompt + (size_t)t * 1024 : p.x_sample + (size_t)(t - T_CTX) * 1024;
#pragma unroll
      for (int i = 0; i < 4; ++i) {
        float4 v = *(const float4*)(xi + i * 256 + lane * 4);
        x[i * 4 + 0] = v.x; x[i * 4 + 1] = v.y; x[i * 4 + 2] = v.z; x[i * 4 + 3] = v.w;
      }
    } else {
      const u16* yp = p.HQ + (size_t)t * 1024;
      float y[16]; float ss = 0.f;
#pragma unroll
      for (int i = 0; i < 4; ++i) {
        uint2 v = *(const uint2*)(yp + i * 256 + lane * 4);
        y[i * 4 + 0] = bf2f((u16)(v.x & 0xffff)); y[i * 4 + 1] = bf2f((u16)(v.x >> 16));
        y[i * 4 + 2] = bf2f((u16)(v.y & 0xffff)); y[i * 4 + 3] = bf2f((u16)(v.y >> 16));
      }
#pragma unroll
      for (int i = 0; i < 16; ++i) ss += y[i] * y[i];
      ss = wave_sum(ss);
      const float rstd = rsqrtf(ss * (1.f / 1024.f) + 1e-6f);
      const float* gpost = (stage == 1 ? p.g_post_mix : p.g_post_ffn) + l * 1024;
      const float* gt = p.mod + ((size_t)l * 9 + m) * 6144 + (stage == 1 ? 2048 : 5120);
#pragma unroll
      for (int i = 0; i < 4; ++i) {
        float4 xv = *(const float4*)(xo + i * 256 + lane * 4);
        float4 gp = *(const float4*)(gpost + i * 256 + lane * 4);
        float4 gg = *(const float4*)(gt + i * 256 + lane * 4);
        x[i * 4 + 0] = xv.x + gg.x * y[i * 4 + 0] * rstd * gp.x;
        x[i * 4 + 1] = xv.y + gg.y * y[i * 4 + 1] * rstd * gp.y;
        x[i * 4 + 2] = xv.z + gg.z * y[i * 4 + 2] * rstd * gp.z;
        x[i * 4 + 3] = xv.w + gg.w * y[i * 4 + 3] * rstd * gp.w;
      }
    }
    __threadfence_block();
#pragma unroll
    for (int i = 0; i < 4; ++i)
      *(float4*)(xo + i * 256 + lane * 4) = make_float4(x[i * 4 + 0], x[i * 4 + 1], x[i * 4 + 2], x[i * 4 + 3]);
    if (ln >= 2) continue;
    float ss = 0.f;
#pragma unroll
    for (int i = 0; i < 16; ++i) ss += x[i] * x[i];
    ss = wave_sum(ss);
    const float rstd = rsqrtf(ss * (1.f / 1024.f) + 1e-6f);
    const float* sh = p.mod + ((size_t)ln * 9 + m) * 6144 + sh_off;
    const float* sc = sh + 1024;
    u16* hp = dst + (size_t)t * 1024;
#pragma unroll
    for (int i = 0; i < 4; ++i) {
      float4 gp = *(const float4*)(gpre + i * 256 + lane * 4);
      float4 s1 = *(const float4*)(sh + i * 256 + lane * 4);
      float4 c1 = *(const float4*)(sc + i * 256 + lane * 4);
      float h0 = x[i * 4 + 0] * rstd * gp.x * (1.f + c1.x) + s1.x;
      float h1 = x[i * 4 + 1] * rstd * gp.y * (1.f + c1.y) + s1.y;
      float h2 = x[i * 4 + 2] * rstd * gp.z * (1.f + c1.z) + s1.z;
      float h3 = x[i * 4 + 3] * rstd * gp.w * (1.f + c1.w) + s1.w;
      uint2 o;
      o.x = pack2bf(h0, h1);
      o.y = pack2bf(h2, h3);
      *(uint2*)(hp + i * 256 + lane * 4) = o;
    }
  }
}

__device__ __forceinline__ void unpack8(const uint4 v, float (&f)[8]);
__device__ __forceinline__ uint4 pack8(const float (&f)[8]);
__device__ __forceinline__ void rowpass_b0(const Params& p, int l) {
  const int tidl = tid_l();
  const int lane = tidl & 63, w = tidl >> 6;
  for (int t = blockIdx.x * 4 + w; t < T_ALL + 2048; t += gridDim.x * 4) {
    if (t >= T_ALL) {
      const int r = t - T_ALL, b = r >> 8, s = r & 255;
      if (lane < 32) {
        const float* ck = p.cache_ckv + (((size_t)b * 2 + l) * 256 + s) * 256 + lane * 8;
        const float4 x0 = *(const float4*)ck, x1 = *(const float4*)(ck + 4);
        const float f[8] = {x0.x, x0.y, x0.z, x0.w, x1.x, x1.y, x1.z, x1.w};
        *(uint4*)(p.CKVC + (size_t)r * 256 + lane * 8) = pack8(f);
      } else if (lane < 40) {
        const float* kr = p.cache_kr + (((size_t)b * 2 + l) * 256 + s) * 64 + (lane - 32) * 8;
        const float4 x0 = *(const float4*)kr, x1 = *(const float4*)(kr + 4);
        const float f[8] = {x0.x, x0.y, x0.z, x0.w, x1.x, x1.y, x1.z, x1.w};
        *(uint4*)(p.KRC + (size_t)r * 64 + (lane - 32) * 8) = pack8(f);
      }
      continue;
    }
    u16* pr = p.P + (size_t)t * PW;
    {
      float f[8]; float ss = 0.f;
      if (lane < 48) {
        unpack8(*(const uint4*)(pr + P_MCQ + lane * 8), f);
#pragma unroll
        for (int i = 0; i < 8; ++i) ss += f[i] * f[i];
      }
      ss = wave_sum(ss);
      const float rstd = rsqrtf(ss * (1.f / 384.f) + 1e-6f);
      if (lane < 48) {
        const float* wq = p.mla_q_norm_w + l * 384 + lane * 8;
        const float4 w0 = *(const float4*)wq, w1 = *(const float4*)(wq + 4);
        f[0] *= rstd * w0.x; f[1] *= rstd * w0.y; f[2] *= rstd * w0.z; f[3] *= rstd * w0.w;
        f[4] *= rstd * w1.x; f[5] *= rstd * w1.y; f[6] *= rstd * w1.z; f[7] *= rstd * w1.w;
        *(uint4*)(pr + P_MCQ + lane * 8) = pack8(f);
      }
    }
    {
      float f[8]; float ss = 0.f;
      if (lane < 32) {
        unpack8(*(const uint4*)(pr + P_MCKV + lane * 8), f);
#pragma unroll
        for (int i = 0; i < 8; ++i) ss += f[i] * f[i];
      }
      ss = wave_sum(ss);
      const float rstd = rsqrtf(ss * (1.f / 256.f) + 1e-6f);
      if (lane < 32) {
        const float* wk = p.mla_kv_norm_w + l * 256 + lane * 8;
        const float4 w0 = *(const float4*)wk, w1 = *(const float4*)(wk + 4);
        f[0] *= rstd * w0.x; f[1] *= rstd * w0.y; f[2] *= rstd * w0.z; f[3] *= rstd * w0.w;
        f[4] *= rstd * w1.x; f[5] *= rstd * w1.y; f[6] *= rstd * w1.z; f[7] *= rstd * w1.w;
        *(uint4*)(pr + P_MCKV + lane * 8) = pack8(f);
        if (t < T_CTX) {
          const int b = t >> 8, s = t & 255;
          float* op = p.out + OUT_CKV + (((size_t)b * 2 + l) * 256 + s) * 256 + lane * 8;
          *(float4*)op = make_float4(f[0], f[1], f[2], f[3]);
          *(float4*)(op + 4) = make_float4(f[4], f[5], f[6], f[7]);
        }
      }
    }
    {
      float v = bf2f(pr[P_MKR + lane]);
      if (t < T_CTX) {
        int b = t >> 8, s = t & 255;
        p.out[OUT_KR + (((size_t)b * 2 + l) * 256 + s) * 64 + lane] = v;
      } else {
        int pos = (t - T_CTX) & 4095;
        int axis = lane >> 5, half = (lane >> 4) & 1, f = lane & 15;
        float posf = axis == 0 ? (float)(pos >> 6) : (float)(pos & 63);
        float inv = exp2f(-(float)f * (13.287712379549449f / 16.f));
        float ang = posf * inv;
        float sn, cs;
        __sincosf(ang, &sn, &cs);
        float other = __shfl_xor(v, 16);
        float o = half == 0 ? v * cs - other * sn : v * cs + other * sn;
        pr[P_MKR + lane] = f2bf(o);
      }
    }
  }
}

#define P_QH 2304
#define P_KH 2560
__device__ __forceinline__ void rowpass_b2(const Params& p, int l) {
  const int tidl = tid_l();
  const int lane = tidl & 63, w = tidl >> 6;
  float cw[8][5], cv[8][5];
#pragma unroll
  for (int e = 0; e < 8; ++e)
#pragma unroll
    for (int j = 0; j < 5; ++j) {
      cw[e][j] = p.gdn_conv_w[((size_t)l * 768 + 8 * lane + e) * 5 + j];
      cv[e][j] = p.gdn_conv_w[((size_t)l * 768 + 512 + 8 * (lane & 31) + e) * 5 + j];
    }
  u16* VH = p.HQ + (size_t)T_ALL * 768;
  for (int t = blockIdx.x * 4 + w; t < T_ALL; t += gridDim.x * 4) {
    const int len = t < T_CTX ? 256 : 4096;
    const int tau = t < T_CTX ? (t & 255) : ((t - T_CTX) & 4095);
    float y[8], yv[8];
#pragma unroll
    for (int e = 0; e < 8; ++e) { y[e] = 0.f; yv[e] = 0.f; }
#pragma unroll
    for (int j = 0; j < 5; ++j) {
      const int tt = tau + j - 2;
      if (tt >= 0 && tt < len) {
        const u16* pr = p.P + (size_t)(t + j - 2) * PW;
        float f[8];
        unpack8(*(const uint4*)(pr + 8 * lane), f);
#pragma unroll
        for (int e = 0; e < 8; ++e) y[e] += cw[e][j] * f[e];
        if (lane < 32) {
          unpack8(*(const uint4*)(pr + 512 + 8 * lane), f);
#pragma unroll
          for (int e = 0; e < 8; ++e) yv[e] += cv[e][j] * f[e];
        }
      }
    }
    float ss = 0.f;
#pragma unroll
    for (int e = 0; e < 8; ++e) { y[e] = siluf_(y[e]); yv[e] = siluf_(yv[e]); ss += y[e] * y[e]; }
    ss += __shfl_xor(ss, 1); ss += __shfl_xor(ss, 2); ss += __shfl_xor(ss, 4);
    const float rn = rsqrtf(ss + 1e-6f) * (lane < 32 ? 0.125f : 1.f);
#pragma unroll
    for (int e = 0; e < 8; ++e) y[e] *= rn;
    *(uint4*)(p.P + (size_t)t * PW + P_QH + 8 * lane) = pack8(y);
    if (lane < 32) *(uint4*)(VH + (size_t)t * 256 + 8 * lane) = pack8(yv);
  }
}

__device__ __forceinline__ void unpack8(const uint4 v, float (&f)[8]) {
  f[0] = bf2f((u16)(v.x & 0xffff)); f[1] = bf2f((u16)(v.x >> 16)); f[2] = bf2f((u16)(v.y & 0xffff)); f[3] = bf2f((u16)(v.y >> 16));
  f[4] = bf2f((u16)(v.z & 0xffff)); f[5] = bf2f((u16)(v.z >> 16)); f[6] = bf2f((u16)(v.w & 0xffff)); f[7] = bf2f((u16)(v.w >> 16));
}
__device__ __forceinline__ uint4 pack8(const float (&f)[8]) {
  uint4 o;
  o.x = pack2bf(f[0], f[1]); o.y = pack2bf(f[2], f[3]);
  o.z = pack2bf(f[4], f[5]); o.w = pack2bf(f[6], f[7]);
  return o;
}
__device__ __forceinline__ void rowpass_c2(const Params& p, int l) {
  const int tidl = tid_l();
  const int lane = tidl & 63, w = tidl >> 6;
  const int hl = lane & 31, isH = lane >> 5;
  const float* nw = (isH ? p.hgrn_norm_w : p.gdn_norm_w) + l * 64 + (hl & 7) * 8;
  const float4 w0 = *(const float4*)(nw), w1 = *(const float4*)(nw + 4);
  const float wv[8] = {w0.x, w0.y, w0.z, w0.w, w1.x, w1.y, w1.z, w1.w};
  for (int t = blockIdx.x * 4 + w; t < T_ALL; t += gridDim.x * 4) {
    u16* mr = p.MIX + (size_t)t * 1024;
    const u16* pr = p.P + (size_t)t * PW;
    const u16* qr = p.HQ + (size_t)t * 768;
    const uint4 vf = *(const uint4*)(mr + isH * 512 + hl * 8);
    const uint4 vb = *(const uint4*)(mr + isH * 512 + 256 + hl * 8);
    const uint4 vg = *(const uint4*)(pr + (isH ? P_HG : P_GZ) + hl * 8);
    const int c0 = lane * 8;
    const uint4 vo = *(const uint4*)(qr + (c0 >> 7) * 192 + (c0 & 127));
    float f[8], bb[8], g[8];
    unpack8(vf, f); unpack8(vb, bb); unpack8(vg, g);
    float ss = 0.f;
#pragma unroll
    for (int i = 0; i < 8; ++i) { f[i] += bb[i]; ss += f[i] * f[i]; }
    ss += __shfl_xor(ss, 1); ss += __shfl_xor(ss, 2); ss += __shfl_xor(ss, 4);
    const float rn = rsqrtf(ss * (1.f / 64.f) + 1e-6f);
#pragma unroll
    for (int i = 0; i < 8; ++i) f[i] = f[i] * rn * wv[i] * (isH ? sigmoidf_(g[i]) : siluf_(g[i]));
    __threadfence_block();
    *(uint4*)(mr + isH * 256 + hl * 8) = pack8(f);
    *(uint4*)(mr + 512 + c0) = vo;
  }
}

__device__ __forceinline__ void gemm128(const u16* __restrict__ A, int lda, const u16* __restrict__ B, int ldb, int K,
                                        u16* lds, f32x4 (&acc)[4][4]) {
  const int tid = tid_l(), lane = tid & 63, w = tid >> 6, wm = w >> 1, wn = w & 1;
  const int r16 = lane & 15, g4 = lane >> 4;
#pragma unroll
  for (int i = 0; i < 4; ++i)
#pragma unroll
    for (int j = 0; j < 4; ++j) acc[i][j] = f32x4{0.f, 0.f, 0.f, 0.f};
  const int lrow = tid >> 3, lkc = tid & 7;
  const u16* ap = A + (size_t)lrow * lda + lkc * 8;
  const u16* bp = B + (size_t)lrow * ldb + lkc * 8;
  const size_t sa32 = (size_t)32 * lda, sb32 = (size_t)32 * ldb;
  uint4 ra0 = *(const uint4*)(ap), ra1 = *(const uint4*)(ap + sa32), ra2 = *(const uint4*)(ap + 2 * sa32), ra3 = *(const uint4*)(ap + 3 * sa32);
  uint4 rb0 = *(const uint4*)(bp), rb1 = *(const uint4*)(bp + sb32), rb2 = *(const uint4*)(bp + 2 * sb32), rb3 = *(const uint4*)(bp + 3 * sb32);
  const int woff = lrow * 64 + ((lkc ^ (lrow & 7)) * 8);
  const int sw = r16 & 7;
  const int fa0 = (wm * 64 + r16) * 64 + ((g4 ^ sw) * 8);
  const int fa1 = (wm * 64 + r16) * 64 + (((4 + g4) ^ sw) * 8);
  const int fb0 = 128 * 64 + (wn * 64 + r16) * 64 + ((g4 ^ sw) * 8);
  const int fb1 = 128 * 64 + (wn * 64 + r16) * 64 + (((4 + g4) ^ sw) * 8);
  const int nk = K >> 6;
  __syncthreads();
  {
    u16* wa = lds + woff; u16* wb = lds + 128 * 64 + woff;
    *(uint4*)(wa) = ra0; *(uint4*)(wa + 32 * 64) = ra1; *(uint4*)(wa + 64 * 64) = ra2; *(uint4*)(wa + 96 * 64) = ra3;
    *(uint4*)(wb) = rb0; *(uint4*)(wb + 32 * 64) = rb1; *(uint4*)(wb + 64 * 64) = rb2; *(uint4*)(wb + 96 * 64) = rb3;
  }
  if (nk > 1) {
    const u16* a2 = ap + 64; const u16* b2 = bp + 64;
    ra0 = *(const uint4*)(a2); ra1 = *(const uint4*)(a2 + sa32); ra2 = *(const uint4*)(a2 + 2 * sa32); ra3 = *(const uint4*)(a2 + 3 * sa32);
    rb0 = *(const uint4*)(b2); rb1 = *(const uint4*)(b2 + sb32); rb2 = *(const uint4*)(b2 + 2 * sb32); rb3 = *(const uint4*)(b2 + 3 * sb32);
  }
  __syncthreads();
  for (int kt = 0; kt < nk; ++kt) {
    const u16* cur = lds + (kt & 1) * (256 * 64);
    if (kt + 1 < nk) {
      u16* nxt = lds + ((kt + 1) & 1) * (256 * 64);
      u16* wa = nxt + woff; u16* wb = nxt + 128 * 64 + woff;
      *(uint4*)(wa) = ra0; *(uint4*)(wa + 32 * 64) = ra1; *(uint4*)(wa + 64 * 64) = ra2; *(uint4*)(wa + 96 * 64) = ra3;
      *(uint4*)(wb) = rb0; *(uint4*)(wb + 32 * 64) = rb1; *(uint4*)(wb + 64 * 64) = rb2; *(uint4*)(wb + 96 * 64) = rb3;
      if (kt + 2 < nk) {
        const u16* a2 = ap + (kt + 2) * 64; const u16* b2 = bp + (kt + 2) * 64;
        ra0 = *(const uint4*)(a2); ra1 = *(const uint4*)(a2 + sa32); ra2 = *(const uint4*)(a2 + 2 * sa32); ra3 = *(const uint4*)(a2 + 3 * sa32);
        rb0 = *(const uint4*)(b2); rb1 = *(const uint4*)(b2 + sb32); rb2 = *(const uint4*)(b2 + 2 * sb32); rb3 = *(const uint4*)(b2 + 3 * sb32);
      }
    }
    {
      const u16* pa0 = cur + fa0; const u16* pa1 = cur + fa1; const u16* pb0 = cur + fb0; const u16* pb1 = cur + fb1;
      bf16x8 a0 = *(const bf16x8*)(pa0), a1 = *(const bf16x8*)(pa0 + 16 * 64), a2 = *(const bf16x8*)(pa0 + 32 * 64), a3 = *(const bf16x8*)(pa0 + 48 * 64);
      bf16x8 b0 = *(const bf16x8*)(pb0), b1 = *(const bf16x8*)(pb0 + 16 * 64), b2 = *(const bf16x8*)(pb0 + 32 * 64), b3 = *(const bf16x8*)(pb0 + 48 * 64);
      bf16x8 c0 = *(const bf16x8*)(pa1), c1 = *(const bf16x8*)(pa1 + 16 * 64), c2 = *(const bf16x8*)(pa1 + 32 * 64), c3 = *(const bf16x8*)(pa1 + 48 * 64);
      bf16x8 d0 = *(const bf16x8*)(pb1), d1 = *(const bf16x8*)(pb1 + 16 * 64), d2 = *(const bf16x8*)(pb1 + 32 * 64), d3 = *(const bf16x8*)(pb1 + 48 * 64);
      __builtin_amdgcn_sched_barrier(0);
#define G128_MM(j, bj, x0, x1, x2, x3) do { \
        acc[0][j] = __builtin_amdgcn_mfma_f32_16x16x32_bf16(bj, x0, acc[0][j], 0, 0, 0); \
        acc[1][j] = __builtin_amdgcn_mfma_f32_16x16x32_bf16(bj, x1, acc[1][j], 0, 0, 0); \
        acc[2][j] = __builtin_amdgcn_mfma_f32_16x16x32_bf16(bj, x2, acc[2][j], 0, 0, 0); \
        acc[3][j] = __builtin_amdgcn_mfma_f32_16x16x32_bf16(bj, x3, acc[3][j], 0, 0, 0); } while (0)
      __builtin_amdgcn_s_setprio(1);
      G128_MM(0, b0, a0, a1, a2, a3); G128_MM(1, b1, a0, a1, a2, a3); G128_MM(2, b2, a0, a1, a2, a3); G128_MM(3, b3, a0, a1, a2, a3);
      G128_MM(0, d0, c0, c1, c2, c3); G128_MM(1, d1, c0, c1, c2, c3); G128_MM(2, d2, c0, c1, c2, c3); G128_MM(3, d3, c0, c1, c2, c3);
      __builtin_amdgcn_s_setprio(0);
    }
    __syncthreads();
  }
}
__device__ __forceinline__ uint2 pack4(f32x4 v) {
  uint2 o;
  o.x = pack2bf(v[0], v[1]);
  o.y = pack2bf(v[2], v[3]);
  return o;
}

__device__ __forceinline__ void gemm256(const u16* __restrict__ A, int lda, const u16* __restrict__ B, int ldb, int K,
                                        u16* lds, f32x4 (&acc)[8][4]) {
  const int tid = tid_l(), lane = tid & 63, w = tid >> 6, wm = w >> 1, wn = w & 1;
  const int r16 = lane & 15, g4 = lane >> 4;
#pragma unroll
  for (int i = 0; i < 8; ++i)
#pragma unroll
    for (int j = 0; j < 4; ++j) acc[i][j] = f32x4{0.f, 0.f, 0.f, 0.f};
  const int lrow = tid >> 2, lkc = tid & 3;
  const u16* ap = A + (size_t)lrow * lda + lkc * 8;
  const u16* bp = B + (size_t)lrow * ldb + lkc * 8;
  const size_t sa64 = (size_t)64 * lda, sb64 = (size_t)64 * ldb;
  const int woff = lrow * 32 + ((lkc ^ ((lrow >> 1) & 3)) * 8);
  const int fsw = (g4 ^ ((r16 >> 1) & 3)) * 8;
  const int faoff = (wm * 128 + r16) * 32 + fsw;
  const int fboff = 256 * 32 + (wn * 64 + r16) * 32 + fsw;
  const int nk = K >> 5;
  const int BUF = 384 * 32;
  uint4 xa0, xa1, xa2, xa3, xb0, xb1;
  uint4 ya0, ya1, ya2, ya3, yb0, yb1;
#define G256_LOAD(P, st) do { const u16* a2_ = ap + (st) * 32; const u16* b2_ = bp + (st) * 32; \
    P##a0 = *(const uint4*)(a2_); P##a1 = *(const uint4*)(a2_ + sa64); P##a2 = *(const uint4*)(a2_ + 2 * sa64); P##a3 = *(const uint4*)(a2_ + 3 * sa64); \
    P##b0 = *(const uint4*)(b2_); P##b1 = *(const uint4*)(b2_ + sb64); } while (0)
#define G256_STORE(P, buf) do { u16* wa_ = lds + (buf) * BUF + woff; u16* wb_ = wa_ + 256 * 32; \
    *(uint4*)(wa_) = P##a0; *(uint4*)(wa_ + 64 * 32) = P##a1; *(uint4*)(wa_ + 128 * 32) = P##a2; *(uint4*)(wa_ + 192 * 32) = P##a3; \
    *(uint4*)(wb_) = P##b0; *(uint4*)(wb_ + 64 * 32) = P##b1; } while (0)
#define G256_MM(i, af) do { \
      acc[i][0] = __builtin_amdgcn_mfma_f32_16x16x32_bf16(bf0, af, acc[i][0], 0, 0, 0); \
      acc[i][1] = __builtin_amdgcn_mfma_f32_16x16x32_bf16(bf1, af, acc[i][1], 0, 0, 0); \
      acc[i][2] = __builtin_amdgcn_mfma_f32_16x16x32_bf16(bf2, af, acc[i][2], 0, 0, 0); \
      acc[i][3] = __builtin_amdgcn_mfma_f32_16x16x32_bf16(bf3, af, acc[i][3], 0, 0, 0); } while (0)
#define G256_COMPUTE(buf) do { const u16* fa_ = lds + (buf) * BUF + faoff; const u16* fb_ = lds + (buf) * BUF + fboff; \
    bf16x8 bf0 = *(const bf16x8*)(fb_), bf1 = *(const bf16x8*)(fb_ + 16 * 32), bf2 = *(const bf16x8*)(fb_ + 32 * 32), bf3 = *(const bf16x8*)(fb_ + 48 * 32); \
    bf16x8 a0 = *(const bf16x8*)(fa_), a1 = *(const bf16x8*)(fa_ + 16 * 32), a2 = *(const bf16x8*)(fa_ + 32 * 32), a3 = *(const bf16x8*)(fa_ + 48 * 32); \
    __builtin_amdgcn_sched_barrier(0); __builtin_amdgcn_s_setprio(1); \
    G256_MM(0, a0); a0 = *(const bf16x8*)(fa_ + 64 * 32); __builtin_amdgcn_sched_barrier(0); \
    G256_MM(1, a1); a1 = *(const bf16x8*)(fa_ + 80 * 32); __builtin_amdgcn_sched_barrier(0); \
    G256_MM(2, a2); a2 = *(const bf16x8*)(fa_ + 96 * 32); __builtin_amdgcn_sched_barrier(0); \
    G256_MM(3, a3); a3 = *(const bf16x8*)(fa_ + 112 * 32); __builtin_amdgcn_sched_barrier(0); \
    G256_MM(4, a0); G256_MM(5, a1); G256_MM(6, a2); G256_MM(7, a3); __builtin_amdgcn_s_setprio(0); } while (0)
  bf16x8 bf0, bf1, bf2, bf3, a0, a1, a2, a3;
#define G3_PRELOAD(buf) do { const u16* fa_ = lds + (buf) * BUF + faoff; const u16* fb_ = lds + (buf) * BUF + fboff; \
    bf0 = *(const bf16x8*)(fb_); bf1 = *(const bf16x8*)(fb_ + 16 * 32); bf2 = *(const bf16x8*)(fb_ + 32 * 32); bf3 = *(const bf16x8*)(fb_ + 48 * 32); \
    a0 = *(const bf16x8*)(fa_); a1 = *(const bf16x8*)(fa_ + 16 * 32); a2 = *(const bf16x8*)(fa_ + 32 * 32); a3 = *(const bf16x8*)(fa_ + 48 * 32); } while (0)
#define G3_COMPUTE(buf) do { const u16* fa_ = lds + (buf) * BUF + faoff; \
    __builtin_amdgcn_sched_barrier(0); __builtin_amdgcn_s_setprio(1); \
    G256_MM(0, a0); a0 = *(const bf16x8*)(fa_ + 64 * 32); __builtin_amdgcn_sched_barrier(0); \
    G256_MM(1, a1); a1 = *(const bf16x8*)(fa_ + 80 * 32); __builtin_amdgcn_sched_barrier(0); \
    G256_MM(2, a2); a2 = *(const bf16x8*)(fa_ + 96 * 32); __builtin_amdgcn_sched_barrier(0); \
    G256_MM(3, a3); a3 = *(const bf16x8*)(fa_ + 112 * 32); __builtin_amdgcn_sched_barrier(0); \
    G256_MM(4, a0); G256_MM(5, a1); G256_MM(6, a2); G256_MM(7, a3); __builtin_amdgcn_s_setprio(0); \
    __builtin_amdgcn_sched_barrier(0); } while (0)
#define G3_STAGE(i, SET) do { \
    if (kt + (i) + 2 < nk) G256_STORE(SET, ((i) + 2) % 3); \
    if (kt + (i) + 4 < nk) G256_LOAD(SET, kt + (i) + 4); \
    if (kt + (i) < nk) G3_COMPUTE((i) % 3); \
    if (kt + (i) + 1 < nk) G3_PRELOAD(((i) + 1) % 3); \
    __syncthreads(); } while (0)
  G256_LOAD(x, 0);
  G256_LOAD(y, 1);
  __syncthreads();
  G256_STORE(x, 0);
  G256_LOAD(x, 2);
  G256_STORE(y, 1);
  G256_LOAD(y, 3);
  __syncthreads();
  G3_PRELOAD(0);
  for (int kt = 0; kt < nk; kt += 6) {
    G3_STAGE(0, x); G3_STAGE(1, y); G3_STAGE(2, x); G3_STAGE(3, y); G3_STAGE(4, x); G3_STAGE(5, y);
  }
}

__device__ __forceinline__ void gemm192(const u16* __restrict__ A, int lda, const u16* __restrict__ B, int ldb, int K,
                                        u16* lds, f32x4 (&acc)[6][4]) {
  const int tid = tid_l(), lane = tid & 63, w = tid >> 6, wm = w >> 1, wn = w & 1;
  const int r16 = lane & 15, g4 = lane >> 4;
#pragma unroll
  for (int i = 0; i < 6; ++i)
#pragma unroll
    for (int j = 0; j < 4; ++j) acc[i][j] = f32x4{0.f, 0.f, 0.f, 0.f};
  const int lrow = tid >> 2, lkc = tid & 3;
  const u16* ap = A + (size_t)lrow * lda + lkc * 8;
  const u16* bp = B + (size_t)lrow * ldb + lkc * 8;
  const size_t sa64 = (size_t)64 * lda, sb64 = (size_t)64 * ldb;
  const int woff = lrow * 32 + ((lkc ^ ((lrow >> 1) & 3)) * 8);
  const int fsw = (g4 ^ ((r16 >> 1) & 3)) * 8;
  const int faoff = (wm * 96 + r16) * 32 + fsw;
  const int fboff = 192 * 32 + (wn * 64 + r16) * 32 + fsw;
  const int nk = K >> 5;
  const int BUF = 320 * 32;
  uint4 xa0, xa1, xa2, xb0, xb1;
  uint4 ya0, ya1, ya2, yb0, yb1;
#define G192_LOAD(P, st) do { const u16* a2_ = ap + (st) * 32; const u16* b2_ = bp + (st) * 32; \
    P##a0 = *(const uint4*)(a2_); P##a1 = *(const uint4*)(a2_ + sa64); P##a2 = *(const uint4*)(a2_ + 2 * sa64); \
    P##b0 = *(const uint4*)(b2_); P##b1 = *(const uint4*)(b2_ + sb64); } while (0)
#define G192_STORE(P, buf) do { u16* wa_ = lds + (buf) * BUF + woff; u16* wb_ = wa_ + 192 * 32; \
    *(uint4*)(wa_) = P##a0; *(uint4*)(wa_ + 64 * 32) = P##a1; *(uint4*)(wa_ + 128 * 32) = P##a2; \
    *(uint4*)(wb_) = P##b0; *(uint4*)(wb_ + 64 * 32) = P##b1; } while (0)
#define G192_COMPUTE(buf) do { const u16* fa_ = lds + (buf) * BUF + faoff; const u16* fb_ = lds + (buf) * BUF + fboff; \
    bf16x8 bf0 = *(const bf16x8*)(fb_), bf1 = *(const bf16x8*)(fb_ + 16 * 32), bf2 = *(const bf16x8*)(fb_ + 32 * 32), bf3 = *(const bf16x8*)(fb_ + 48 * 32); \
    bf16x8 a0 = *(const bf16x8*)(fa_), a1 = *(const bf16x8*)(fa_ + 16 * 32), a2 = *(const bf16x8*)(fa_ + 32 * 32), a3 = *(const bf16x8*)(fa_ + 48 * 32); \
    __builtin_amdgcn_sched_barrier(0); __builtin_amdgcn_s_setprio(1); \
    G256_MM(0, a0); a0 = *(const bf16x8*)(fa_ + 64 * 32); __builtin_amdgcn_sched_barrier(0); \
    G256_MM(1, a1); a1 = *(const bf16x8*)(fa_ + 80 * 32); __builtin_amdgcn_sched_barrier(0); \
    G256_MM(2, a2); G256_MM(3, a3); G256_MM(4, a0); G256_MM(5, a1); __builtin_amdgcn_s_setprio(0); } while (0)
  G192_LOAD(x, 0);
  G192_LOAD(y, 1);
  __syncthreads();
  G192_STORE(x, 0);
  G192_LOAD(x, 2);
  __syncthreads();
  for (int kt = 0; kt < nk; kt += 2) {
    G192_STORE(y, 1);
    if (kt + 3 < nk) G192_LOAD(y, kt + 3);
    G192_COMPUTE(0);
    __syncthreads();
    if (kt + 2 < nk) {
      G192_STORE(x, 0);
      if (kt + 4 < nk) G192_LOAD(x, kt + 4);
    }
    G192_COMPUTE(1);
    __syncthreads();
  }
}
#define GEMM256_RC const int tde = tid_l(); const int rb = ((tde >> 6) >> 1) * 128 + (tde & 15), cb = ((tde >> 6) & 1) * 64 + ((tde & 63) >> 4) * 4;
#define GEMM_RC const int tde = tid_l(); const int rb = ((tde >> 6) >> 1) * 64 + (tde & 15), cb = ((tde >> 6) & 1) * 64 + ((tde & 63) >> 4) * 4;


__device__ __forceinline__ bool tile_at(int r, int Mt, int Nt, int& mt, int& nt) {
  const int x = blockIdx.x & 7, j = blockIdx.x >> 3, bpx = gridDim.x >> 3;
  const int mpx = Mt >> 3;
  const int q = r * bpx + j;
  if (q >= mpx * Nt) return false;
  const int full = (Nt >> 3) * (mpx * 8);
  int cb, rem, wcb;
  if (q < full) { cb = q / (mpx * 8); rem = q - cb * mpx * 8; wcb = 8; }
  else { cb = Nt >> 3; rem = q - full; wcb = Nt - cb * 8; }
  mt = x * mpx + rem / wcb;
  nt = cb * 8 + rem % wcb;
  return true;
}

__device__ __forceinline__ void phase_a(const Params& p, int l, u16* lds) {
  const u16* Bw = p.WinT + (size_t)l * 3072 * 1024;
  int mt, nt;
  for (int r = 0; tile_at(r, 144, 24, mt, nt); ++r) {
    const int m0 = mt * 256, n0 = nt * 128;
    f32x4 acc[8][4];
    gemm256(p.HQ + (size_t)m0 * 1024, 1024, Bw + (size_t)n0 * 1024, 1024, 1024, lds, acc);
    { GEMM256_RC
#pragma unroll
      for (int mi = 0; mi < 8; ++mi) {
        const int row = m0 + rb + mi * 16;
#pragma unroll
        for (int ni = 0; ni < 4; ++ni) {
          const int col = n0 + cb + ni * 16;
          *(uint2*)(p.P + (size_t)row * PW + col) = pack4(acc[mi][ni]);
          if (col >= P_GA && col < P_GA + 16)
            *(float4*)(p.GAB + (size_t)row * 16 + (col - P_GA)) = make_float4(acc[mi][ni][0], acc[mi][ni][1], acc[mi][ni][2], acc[mi][ni][3]);
        }
      }
    }
  }
}

__device__ __forceinline__ void phase_b1(const Params& p, int l, u16* lds) {
  int mt, nt;
  for (int pass = 0; pass < 2; ++pass) {
  for (int r = 0; tile_at(r, pass == 0 ? 288 : 304, pass == 0 ? 6 : 8, mt, nt); ++r) {
    if (pass == 0) {
      const int m0 = mt * 128, n0 = nt * 128;
      const float qscale = 0.07216878364870322f * 1.4426950408889634f;
      f32x4 acc[4][4];
      gemm128(p.P + (size_t)m0 * PW + P_MCQ, PW, p.WuqT + (size_t)l * 768 * 384 + (size_t)n0 * 384, 384, 384, lds, acc);
      { GEMM_RC
        const int g4 = (tde & 63) >> 4;
        const int cw0 = n0 + cb - g4 * 4;
        const bool ropew = ((cw0 >> 6) % 3) == 2 && m0 >= T_CTX;
#pragma unroll
        for (int mi = 0; mi < 4; ++mi) {
          const int row = m0 + rb + mi * 16;
          f32x4 v0 = acc[mi][0], v1 = acc[mi][1], v2 = acc[mi][2], v3 = acc[mi][3];
          if (ropew) {
            const int pos = (row - T_CTX) & 4095;
#pragma unroll
            for (int r = 0; r < 4; ++r) {
              const float inv = exp2f(-(float)(g4 * 4 + r) * (13.287712379549449f / 16.f));
              float s0, c0, s1, c1;
              __sincosf((float)(pos >> 6) * inv, &s0, &c0);
              __sincosf((float)(pos & 63) * inv, &s1, &c1);
              const float a0 = v0[r] * c0 - v1[r] * s0, a1 = v1[r] * c0 + v0[r] * s0;
              const float b0 = v2[r] * c1 - v3[r] * s1, b1 = v3[r] * c1 + v2[r] * s1;
              v0[r] = a0; v1[r] = a1; v2[r] = b0; v3[r] = b1;
            }
          }
          u16* qp = p.HQ + (size_t)row * 768 + n0 + cb;
          *(uint2*)(qp) = pack4(v0 * qscale); *(uint2*)(qp + 16) = pack4(v1 * qscale);
          *(uint2*)(qp + 32) = pack4(v2 * qscale); *(uint2*)(qp + 48) = pack4(v3 * qscale);
        }
      }
    } else {
      const int m0 = mt * 128, n0 = nt * 128;
      const u16* Ap; int lda;
      if (mt < 288) { Ap = p.P + (size_t)m0 * PW + P_MCKV; lda = PW; }
      else { Ap = p.CKVC + (size_t)(m0 - T_ALL) * 256; lda = 256; }
      f32x4 acc[4][4];
      gemm128(Ap, lda, p.WukvT + (size_t)l * 1024 * 256 + (size_t)n0 * 256, 256, 256, lds, acc);
      { GEMM_RC
#pragma unroll
        for (int mi = 0; mi < 4; ++mi) {
          const int row = m0 + rb + mi * 16;
          u16* vb; int vst;
          if (row < T_CTX) { int b = row >> 8, pos = row & 255; vb = p.VTC + (size_t)(b * 4) * 128 * 256 + pos; vst = 256; }
          else if (row < T_ALL) { int b = (row - T_CTX) >> 12, pos = (row - T_CTX) & 4095; vb = p.VTL + (size_t)(b * 4) * 128 * 4352 + pos; vst = 4352; }
          else { int b = (row - T_ALL) >> 8, pos = 4096 + ((row - T_ALL) & 255); vb = p.VTL + (size_t)(b * 4) * 128 * 4352 + pos; vst = 4352; }
#pragma unroll
          for (int ni = 0; ni < 4; ++ni) {
            const int col = n0 + cb + ni * 16;
            const int h = col >> 8, wi = col & 255;
            if (wi < 128) {
              *(uint2*)(p.KN + (size_t)row * 512 + h * 128 + wi) = pack4(acc[mi][ni]);
            } else {
              u16* dst = vb + (size_t)(h * 128 + (wi - 128)) * vst;
#pragma unroll
              for (int r = 0; r < 4; ++r) dst[(size_t)r * vst] = f2bf(acc[mi][ni][r]);
            }
          }
        }
      }
    }
  }
  }
}

__device__ __forceinline__ void phase_gemm_y(const u16* A, int lda, const u16* B, int K, int N, u16* Y, int ldy, u16* lds) {
  int mt, nt;
  for (int r = 0; tile_at(r, 192, N / 128, mt, nt); ++r) {
    const int m0 = mt * 192, n0 = nt * 128;
    f32x4 acc[6][4];
    gemm192(A + (size_t)m0 * lda, lda, B + (size_t)n0 * K, K, K, lds, acc);
    {
      const int tde = tid_l();
      const int rb = ((tde >> 6) >> 1) * 96 + (tde & 15), cb = ((tde >> 6) & 1) * 64 + ((tde & 63) >> 4) * 4;
#pragma unroll
      for (int mi = 0; mi < 6; ++mi)
#pragma unroll
        for (int ni = 0; ni < 4; ++ni)
          *(uint2*)(Y + (size_t)(m0 + rb + mi * 16) * ldy + n0 + cb + ni * 16) = pack4(acc[mi][ni]);
    }
  }
}

__device__ __forceinline__ void phase_e(const Params& p, int l, u16* lds) {
  const u16* Bw = p.WfiT + (size_t)l * 5632 * 1024;
  int mt, nt;
  for (int r = 0; tile_at(r, 144, 44, mt, nt); ++r) {
    const int m0 = mt * 256, n0 = nt * 128;
    f32x4 acc[8][4];
    gemm256(p.MIX + (size_t)m0 * 1024, 1024, Bw + (size_t)n0 * 1024, 1024, 1024, lds, acc);
    { GEMM256_RC
      const int g4x4 = ((tde & 63) >> 4) * 4;
      const int hc0 = ((n0 + cb - g4x4) >> 1) + g4x4;
#pragma unroll
      for (int mi = 0; mi < 8; ++mi)
#pragma unroll
        for (int ni = 0; ni < 2; ++ni) {
          f32x4 hv;
#pragma unroll
          for (int r = 0; r < 4; ++r) hv[r] = siluf_(acc[mi][ni][r]) * acc[mi][ni + 2][r];
          *(uint2*)(p.P + (size_t)(m0 + rb + mi * 16) * DFF + hc0 + ni * 16) = pack4(hv);
        }
    }
  }
}

#define KST 208
#define VST 80
#define PST 80
__device__ __forceinline__ void attn_item(const Params& p, int latent, int b, int h, int qb, unsigned char* smraw, int dummy = 0) {
  u16* sK = (u16*)smraw;
  u16* sV = sK + 64 * KST;
  u16* sP = sV + 128 * VST;
  const int tid = tid_l(), lane = tid & 63, w = tid >> 6, r16 = lane & 15, g4 = lane >> 4;
  const int nkeys = latent ? 4352 : 256;
  const int krow0 = latent ? T_CTX + b * 4096 : b * 256;
  const int tq0 = krow0 + qb * 128;
  const u16* vt = latent ? p.VTL + (size_t)((b * 4 + h) * 128) * 4352 : p.VTC + (size_t)((b * 4 + h) * 128) * 256;
  u16* sPw = sP + w * 32 * PST;
  bf16x8 q[2][6];
#pragma unroll
  for (int mi = 0; mi < 2; ++mi)
#pragma unroll
    for (int ks = 0; ks < 6; ++ks)
      q[mi][ks] = *(const bf16x8*)(p.HQ + (size_t)(tq0 + w * 32 + mi * 16 + r16) * 768 + h * 192 + ks * 32 + g4 * 8);
  f32x4 o[2][8];
  float mrow[2], lrow[2];
#pragma unroll
  for (int mi = 0; mi < 2; ++mi) {
#pragma unroll
    for (int nd = 0; nd < 8; ++nd) o[mi][nd] = f32x4{0.f, 0.f, 0.f, 0.f};
    mrow[mi] = -1e30f; lrow[mi] = 0.f;
  }
  const int lkey = tid >> 2, lpart = tid & 3;
  const int ldv = tid >> 1, lhalf = tid & 1;
  const int ntile = nkeys >> 6;
  uint4 k0, k1, k2, k3, k4, k5;
  {
    const int pos = lkey;
    const u16* srcn = p.KN + (size_t)(krow0 + pos) * 512 + h * 128 + lpart * 8;
    const u16* srcr = p.P + (size_t)(krow0 + pos) * PW + P_MKR + lpart * 8;
    k0 = *(const uint4*)(srcn); k1 = *(const uint4*)(srcn + 32); k2 = *(const uint4*)(srcn + 64); k3 = *(const uint4*)(srcn + 96);
    k4 = *(const uint4*)(srcr); k5 = *(const uint4*)(srcr + 32);
  }
  for (int kt = 0; kt < ntile; ++kt) {
    __syncthreads();
    {
      u16* dk = sK + lkey * KST + lpart * 8;
      *(uint4*)(dk) = k0; *(uint4*)(dk + 32) = k1; *(uint4*)(dk + 64) = k2; *(uint4*)(dk + 96) = k3;
      *(uint4*)(dk + 128) = k4; *(uint4*)(dk + 160) = k5;
    }
    const u16* sv = vt + (size_t)ldv * nkeys + kt * 64 + lhalf * 32;
    const uint4 v0 = *(const uint4*)(sv), v1 = *(const uint4*)(sv + 8), v2 = *(const uint4*)(sv + 16), v3 = *(const uint4*)(sv + 24);
    __syncthreads();
    f32x4 s[2][4];
#pragma unroll
    for (int mi = 0; mi < 2; ++mi)
#pragma unroll
      for (int ni = 0; ni < 4; ++ni) s[mi][ni] = f32x4{0.f, 0.f, 0.f, 0.f};
#pragma unroll
    for (int ks = 0; ks < 6; ++ks)
#pragma unroll
      for (int ni = 0; ni < 4; ++ni) {
        bf16x8 kf = *(const bf16x8*)(sK + (ni * 16 + r16) * KST + ks * 32 + g4 * 8);
        s[0][ni] = __builtin_amdgcn_mfma_f32_16x16x32_bf16(kf, q[0][ks], s[0][ni], 0, 0, 0);
        s[1][ni] = __builtin_amdgcn_mfma_f32_16x16x32_bf16(kf, q[1][ks], s[1][ni], 0, 0, 0);
      }
#pragma unroll
    for (int mi = 0; mi < 2; ++mi) {
      float mx = -1e30f;
#pragma unroll
      for (int ni = 0; ni < 4; ++ni)
#pragma unroll
        for (int r = 0; r < 4; ++r) mx = fmaxf(mx, s[mi][ni][r]);
      mx = fmaxf(mx, __shfl_xor(mx, 16)); mx = fmaxf(mx, __shfl_xor(mx, 32));
      const float mnew = fmaxf(mrow[mi], mx);
      const float alpha = __builtin_amdgcn_exp2f(mrow[mi] - mnew);
      mrow[mi] = mnew;
      float ps = 0.f;
#pragma unroll
      for (int ni = 0; ni < 4; ++ni) {
        f32x4 pv;
#pragma unroll
        for (int r = 0; r < 4; ++r) { pv[r] = __builtin_amdgcn_exp2f(s[mi][ni][r] - mnew); ps += pv[r]; }
        *(uint2*)(sPw + (mi * 16 + r16) * PST + ni * 16 + g4 * 4) = pack4(pv);
      }
      ps += __shfl_xor(ps, 16); ps += __shfl_xor(ps, 32);
      lrow[mi] = lrow[mi] * alpha + ps;
#pragma unroll
      for (int nd = 0; nd < 8; ++nd) o[mi][nd] *= alpha;
    }
    {
      u16* dvp = sV + ldv * VST + lhalf * 32;
      *(uint4*)(dvp) = v0; *(uint4*)(dvp + 8) = v1; *(uint4*)(dvp + 16) = v2; *(uint4*)(dvp + 24) = v3;
    }
    __syncthreads();
    if (kt + 1 < ntile) {
      const int pos = (kt + 1) * 64 + lkey;
      const bool own = (!latent) || pos < 4096;
      const int row = own ? krow0 + pos : T_ALL + b * 256 + (pos - 4096);
      const u16* srcn = p.KN + (size_t)row * 512 + h * 128 + lpart * 8;
      const u16* srcr = own ? p.P + (size_t)(krow0 + pos) * PW + P_MKR + lpart * 8
                            : p.KRC + (size_t)(b * 256 + pos - 4096) * 64 + lpart * 8;
      k0 = *(const uint4*)(srcn); k1 = *(const uint4*)(srcn + 32); k2 = *(const uint4*)(srcn + 64); k3 = *(const uint4*)(srcn + 96);
      k4 = *(const uint4*)(srcr); k5 = *(const uint4*)(srcr + 32);
    }
#pragma unroll
    for (int ks2 = 0; ks2 < 2; ++ks2) {
      bf16x8 pf0 = *(const bf16x8*)(sPw + (0 * 16 + r16) * PST + ks2 * 32 + g4 * 8);
      bf16x8 pf1 = *(const bf16x8*)(sPw + (1 * 16 + r16) * PST + ks2 * 32 + g4 * 8);
#pragma unroll
      for (int nd = 0; nd < 8; ++nd) {
        bf16x8 vf = *(const bf16x8*)(sV + (nd * 16 + r16) * VST + ks2 * 32 + g4 * 8);
        o[0][nd] = __builtin_amdgcn_mfma_f32_16x16x32_bf16(vf, pf0, o[0][nd], 0, 0, 0);
        o[1][nd] = __builtin_amdgcn_mfma_f32_16x16x32_bf16(vf, pf1, o[1][nd], 0, 0, 0);
      }
    }
  }
#pragma unroll
  for (int mi = 0; mi < 2; ++mi) {
    const float inv = 1.f / lrow[mi];
    const int qrow = tq0 + w * 32 + mi * 16 + r16;
    u16* op = p.HQ + (size_t)qrow * 768 + h * 192 + g4 * 4;
    if (dummy) op = p.HQ + (size_t)T_ALL * 768 + (size_t)(qrow % 9216) * 768 + h * 192 + g4 * 4;
#pragma unroll
    for (int nd = 0; nd < 8; ++nd) *(uint2*)(op + nd * 16) = pack4(o[mi][nd] * inv);
  }
}

#define XB_TMO      128
#define XB_XCNT(j)  (256  + 64 * (j))
#define XB_XSUB(j)  (1280 + 64 * (j))
#define XB_XGEN(j)  (2304 + 64 * (j))
#define XB_TOP      3328
#define XB_TOPGEN   3392
#define XCD_BAR_WORDS 3456
#define XB_SPIN_CAP (1u << 23)
#define LAS __attribute__((address_space(3)))

__device__ __forceinline__ unsigned xb_ld(unsigned* p)              { return __hip_atomic_load(p, __ATOMIC_RELAXED, __HIP_MEMORY_SCOPE_AGENT); }
__device__ __forceinline__ unsigned xb_add(unsigned* p, unsigned v) { return __hip_atomic_fetch_add(p, v, __ATOMIC_RELAXED, __HIP_MEMORY_SCOPE_AGENT); }
__device__ __forceinline__ unsigned xb_xcc_id() { return (unsigned)__builtin_amdgcn_s_getreg((3 << 11) | 20) & 0xFu; }
#define XB_SPIN(cond, bar) do { unsigned _sp = 0; while (cond) { __builtin_amdgcn_s_sleep(1); \
    if ((++_sp & 255u) == 0u) { if (xb_ld(&(bar)[XB_TMO])) break; if (_sp > XB_SPIN_CAP) { atomicAdd(&(bar)[XB_TMO], 1u); break; } } } } while (0)

struct XcdBarrier {
    unsigned* bar; unsigned x;
    volatile LAS unsigned* st;
};

__device__ __forceinline__ XcdBarrier xcd_barrier_post(unsigned* bar, volatile LAS unsigned* st) {
    XcdBarrier b; b.bar = bar; b.x = xb_xcc_id(); b.st = st;
    if (threadIdx.x == 0) (void)xb_add(&bar[XB_XCNT(b.x)], 1u);
    return b;
}
__device__ __forceinline__ void xcd_barrier_complete(unsigned* bar, unsigned x, unsigned& nloc, unsigned& nx) {
    const unsigned G = gridDim.x * gridDim.y * gridDim.z;
    unsigned sum, cnt, mine, sp = 0u;
    for (;;) {
        sum = 0u; cnt = 0u; mine = 0u;
#pragma unroll
        for (unsigned j = 0; j < 16; ++j) { const unsigned c = xb_ld(&bar[XB_XCNT(j)]); sum += c; cnt += (c > 0u) ? 1u : 0u; mine = (j == x) ? c : mine; }
        if (sum == G) break;
        __builtin_amdgcn_s_sleep(1);
        if ((++sp & 255u) == 0u) { if (xb_ld(&bar[XB_TMO])) break; if (sp > XB_SPIN_CAP) { atomicAdd(&bar[XB_TMO], 1u); break; } }
    }
    nloc = mine > 0u ? mine : 1u; nx = cnt > 0u ? cnt : 1u;
}

__device__ __forceinline__ void xcd_barrier(const XcdBarrier& b) {
    asm volatile("s_waitcnt vmcnt(0)" ::: "memory");
    __syncthreads();
    if (threadIdx.x == 0) {
        unsigned* bar = b.bar;
        __builtin_amdgcn_s_waitcnt(0);
        unsigned nloc = b.st[0], nx = b.st[1];
        if (nloc == 0u) { xcd_barrier_complete(bar, b.x, nloc, nx); b.st[0] = nloc; b.st[1] = nx; }
        const unsigned old = xb_add(&bar[XB_XSUB(b.x)], 1u);
        const unsigned gen = old / nloc;
        if (old + 1u == (gen + 1u) * nloc) {
            __builtin_amdgcn_fence(__ATOMIC_RELEASE, "agent");
            asm volatile("s_waitcnt vmcnt(0)" ::: "memory");
            const unsigned og = xb_add(&bar[XB_TOP], 1u);
            const unsigned tg = og / nx;
            if (og + 1u == (tg + 1u) * nx) xb_add(&bar[XB_TOPGEN], 1u);
            else XB_SPIN(xb_ld(&bar[XB_TOPGEN]) == tg, bar);
            __builtin_amdgcn_fence(__ATOMIC_ACQUIRE, "agent");
            xb_add(&bar[XB_XGEN(b.x)], 1u);
            asm volatile("s_waitcnt vmcnt(0)" ::: "memory");
        } else {
            XB_SPIN(xb_ld(&bar[XB_XGEN(b.x)]) == gen, bar);
            __builtin_amdgcn_fence(__ATOMIC_ACQUIRE, "agent");
            asm volatile("s_waitcnt vmcnt(0)" ::: "memory");
        }
    }
    __syncthreads();
}


__device__ __forceinline__ void gbar(unsigned* ctr, unsigned target) {
  asm volatile("s_waitcnt vmcnt(0)" ::: "memory");
  __syncthreads();
  if (tid_l() == 0) {
    __builtin_amdgcn_fence(__ATOMIC_RELEASE, "agent");
    asm volatile("s_waitcnt vmcnt(0)" ::: "memory");
    __hip_atomic_fetch_add(ctr, 1u, __ATOMIC_RELAXED, __HIP_MEMORY_SCOPE_AGENT);
    while (__hip_atomic_load(ctr, __ATOMIC_RELAXED, __HIP_MEMORY_SCOPE_AGENT) < target) __builtin_amdgcn_s_sleep(2);
    __builtin_amdgcn_fence(__ATOMIC_ACQUIRE, "agent");
    asm volatile("s_waitcnt vmcnt(0)" ::: "memory");
  }
  __syncthreads();
}
#define MFMA4(a, b, c) __builtin_amdgcn_mfma_f32_16x16x4f32((a), (b), (c), 0, 0, 0)

__device__ __forceinline__ float softplusf_(float x) { return fmaxf(x, 0.f) + log1pf(__expf(-fabsf(x))); }

__device__ __forceinline__ void gdn_chain(const Params& p, int l, int seq, int h, int d, int vs, float* sm) {
  float* sMM = sm;
  float* sK = sMM + 64 * 68;
  u16* sQb = (u16*)(sK + 64 * 65);
  u16* sKb = sQb + 64 * 80;
  float* sV = (float*)(sKb + 64 * 80);
  float* sS = sV + 64 * 33;
  float* sGc = sS + 64 * 33;
  float* sBeta = sGc + 64;
  float* sBg = sBeta + 64;
  u16* sSb = (u16*)(sBg + 64);
  const int tid = tid_l(), lane = tid & 63, w = tid >> 6, r16 = lane & 15, g4 = lane >> 4;
  const bool latent = seq >= 16;
  const int len = latent ? 4096 : 256;
  const int t0 = latent ? T_CTX + (seq - 16) * 4096 : seq * 256;
  const int nchunks = len >> 6;
  const float Acoef = -__expf(p.gdn_a_log[l * 8 + d * 4 + h]);
  const float dtb = p.gdn_dt_bias[l * 8 + d * 4 + h];
  f32x4 Sreg[2];
  __syncthreads();
  {
    const float* s0 = latent ? p.state_gdn + ((((size_t)(seq - 16) * 2 + l) * 2 + d) * 4 + h) * 4096 : nullptr;
#pragma unroll
    for (int n = 0; n < 2; ++n)
#pragma unroll
      for (int r = 0; r < 4; ++r) {
        const int kidx = 16 * w + g4 * 4 + r, cc = n * 16 + r16;
        float v = latent ? s0[kidx * 64 + vs * 32 + cc] : 0.f;
        Sreg[n][r] = v;
        sS[kidx * 33 + cc] = v;
      }
#pragma unroll
    for (int n = 0; n < 2; ++n) *(uint2*)(sSb + (n * 16 + r16) * 80 + 16 * w + g4 * 4) = pack4(Sreg[n]);
  }
  const u16* Pb = p.P + (size_t)t0 * PW;
  const u16* VHb = p.HQ + (size_t)T_ALL * 768 + (size_t)t0 * 256;
#define GDN_SRC(i, tl, tlo_) ({ const int e_ = (tl) + (i) * 256; const int u_ = e_ / 20, un_ = e_ % 20; \
    (un_ < 16) ? (Pb + (size_t)((tlo_) + u_) * PW + (un_ < 8 ? P_QH + h * 64 + un_ * 8 : P_KH + h * 64 + (un_ - 8) * 8)) \
               : (VHb + (size_t)((tlo_) + u_) * 256 + h * 64 + vs * 32 + (un_ - 16) * 8); })
  uint4 pf[5];
  float pga = 0.f, pgb = 0.f;
  {
    const int tlo = d == 0 ? 0 : len - 64;
#pragma unroll
    for (int i = 0; i < 5; ++i) pf[i] = *(const uint4*)GDN_SRC(i, tid, tlo);
    if (tid < 64) {
      const int u = d == 0 ? tid : 63 - tid;
      const float* gab = p.GAB + (size_t)(t0 + tlo + u) * 16;
      pga = gab[d * 4 + h]; pgb = gab[8 + d * 4 + h];
    }
  }
  for (int n = 0; n < nchunks; ++n) {
    const int tlo = d == 0 ? n * 64 : len - 64 * (n + 1);
    const int tl2 = tid_l();
#pragma unroll
    for (int i = 0; i < 5; ++i) {
      const int e = tl2 + i * 256;
      const int u = e / 20, un = e % 20;
      const int pp = d == 0 ? u : 63 - u;
      if (un < 8) { *(uint4*)(sQb + pp * 80 + un * 8) = pf[i]; }
      else {
        if (un < 16) *(uint4*)(sKb + pp * 80 + (un - 8) * 8) = pf[i];
        float* dq = un < 16 ? sK + pp * 65 + (un - 8) * 8 : sV + pp * 33 + (un - 16) * 8;
        const unsigned wv[4] = {pf[i].x, pf[i].y, pf[i].z, pf[i].w};
#pragma unroll
        for (int j = 0; j < 4; ++j) { dq[2 * j] = bf2f((u16)(wv[j] & 0xffff)); dq[2 * j + 1] = bf2f((u16)(wv[j] >> 16)); }
      }
    }
    if (tid < 64) {
      const int pp = tid;
      float g = Acoef * softplusf_(pga + dtb);
      float bt = sigmoidf_(pgb);
#pragma unroll
      for (int o = 1; o < 64; o <<= 1) { float tt = __shfl_up(g, o); if (lane >= o) g += tt; }
      sGc[pp] = g; sBeta[pp] = bt; sBg[pp] = bt * __expf(g);
    }
    if (n + 1 < nchunks) {
      const int tlo2 = d == 0 ? (n + 1) * 64 : len - 64 * (n + 2);
#pragma unroll
      for (int i = 0; i < 5; ++i) pf[i] = *(const uint4*)GDN_SRC(i, tl2, tlo2);
      if (tid < 64) {
        const int u = d == 0 ? tid : 63 - tid;
        const float* gab = p.GAB + (size_t)(t0 + tlo2 + u) * 16;
        pga = gab[d * 4 + h]; pgb = gab[8 + d * 4 + h];
      }
    }
    __syncthreads();
    const unsigned tcode = w == 0 ? 0x730u : (w == 1 ? 0xA51u : (w == 2 ? 0x062u : 0x0FBu));
    const int tcnt = w < 2 ? 3 : 2;
    f32x4 attacc[3];
#pragma unroll
    for (int t = 0; t < 3; ++t) {
      attacc[t] = f32x4{0.f, 0.f, 0.f, 0.f};
      if (t < tcnt) {
        const int ti = (tcode >> (4 * t)) & 3, tn = (tcode >> (4 * t + 2)) & 3;
        f32x4 accm = f32x4{0.f, 0.f, 0.f, 0.f};
        const u16* akb = sKb + (16 * ti + r16) * 80 + g4 * 8;
        const u16* aqb = sQb + (16 * ti + r16) * 80 + g4 * 8;
        const u16* bkb = sKb + (16 * tn + r16) * 80 + g4 * 8;
        const bf16x8 ak0 = *(const bf16x8*)(akb), ak1 = *(const bf16x8*)(akb + 32);
        const bf16x8 aq0 = *(const bf16x8*)(aqb), aq1 = *(const bf16x8*)(aqb + 32);
        const bf16x8 bk0 = *(const bf16x8*)(bkb), bk1 = *(const bf16x8*)(bkb + 32);
        accm = __builtin_amdgcn_mfma_f32_16x16x32_bf16(ak0, bk0, accm, 0, 0, 0);
        accm = __builtin_amdgcn_mfma_f32_16x16x32_bf16(ak1, bk1, accm, 0, 0, 0);
        attacc[t] = __builtin_amdgcn_mfma_f32_16x16x32_bf16(aq0, bk0, attacc[t], 0, 0, 0);
        attacc[t] = __builtin_amdgcn_mfma_f32_16x16x32_bf16(aq1, bk1, attacc[t], 0, 0, 0);
#pragma unroll
        for (int r = 0; r < 4; ++r) {
          const int i = 16 * ti + g4 * 4 + r, j = 16 * tn + r16;
          sMM[i * 68 + j] = (i > j) ? sBeta[i] * accm[r] * __expf(sGc[i] - sGc[j]) : 0.f;
        }
      }
    }
    __syncthreads();
    if (w == 0) {
      const int bi = tid >> 4, c = tid & 15;
      float* md = sMM + (16 * bi) * 68 + 16 * bi;
      float a[16];
#pragma unroll
      for (int r = 0; r < 16; ++r) a[r] = (r == c) ? 1.f : 0.f;
#pragma unroll
      for (int r = 1; r < 16; ++r) {
#pragma unroll
        for (int q4 = 0; q4 < (r + 3) / 4; ++q4) {
          const float4 m = *(const float4*)(md + r * 68 + 4 * q4);
          if (q4 * 4 + 0 < r) a[r] -= m.x * a[q4 * 4 + 0];
          if (q4 * 4 + 1 < r) a[r] -= m.y * a[q4 * 4 + 1];
          if (q4 * 4 + 2 < r) a[r] -= m.z * a[q4 * 4 + 2];
          if (q4 * 4 + 3 < r) a[r] -= m.w * a[q4 * 4 + 3];
        }
      }
      __builtin_amdgcn_fence(__ATOMIC_SEQ_CST, "wavefront");
#pragma unroll
      for (int r = 0; r < 16; ++r) md[r * 68 + c] = a[r];
    } else {
      for (int t = w - 1; t < 8; t += 3) {
        const int ti = t >> 1, tc = t & 1;
        const u16* akb = sKb + (16 * ti + r16) * 80 + g4 * 8;
        const u16* bsb = sSb + (16 * tc + r16) * 80 + g4 * 8;
        f32x4 acc = f32x4{0.f, 0.f, 0.f, 0.f};
        acc = __builtin_amdgcn_mfma_f32_16x16x32_bf16(*(const bf16x8*)(akb), *(const bf16x8*)(bsb), acc, 0, 0, 0);
        acc = __builtin_amdgcn_mfma_f32_16x16x32_bf16(*(const bf16x8*)(akb + 32), *(const bf16x8*)(bsb + 32), acc, 0, 0, 0);
#pragma unroll
        for (int r = 0; r < 4; ++r) {
          const int i = 16 * ti + g4 * 4 + r, cc = 16 * tc + r16;
          sV[i * 33 + cc] = sV[i * 33 + cc] * sBeta[i] - sBg[i] * acc[r];
        }
      }
    }
    __syncthreads();
    for (int ib = 0; ib < 4; ++ib) {
      if (w < 2) {
        const int ct = w;
        f32x4 acc = f32x4{0.f, 0.f, 0.f, 0.f};
        const float* am = sMM + (16 * ib + r16) * 68 + g4;
        const float* bx = sV + g4 * 33 + 16 * ct + r16;
        for (int s4 = 0; s4 < ib; ++s4) {
#pragma unroll
          for (int s = 0; s < 4; ++s) acc = MFMA4(am[16 * s4 + 4 * s], bx[(16 * s4 + 4 * s) * 33], acc);
        }
        f32x4 rm;
#pragma unroll
        for (int r = 0; r < 4; ++r) rm[r] = sV[(16 * ib + g4 * 4 + r) * 33 + 16 * ct + r16] - acc[r];
        const float* dd = sMM + (16 * ib + r16) * 68 + 16 * ib + 4 * g4;
        f32x4 xn = f32x4{0.f, 0.f, 0.f, 0.f};
#pragma unroll
        for (int s = 0; s < 4; ++s) xn = MFMA4(dd[s], rm[s], xn);
#pragma unroll
        for (int r = 0; r < 4; ++r) sV[(16 * ib + g4 * 4 + r) * 33 + 16 * ct + r16] = xn[r];
        __builtin_amdgcn_fence(__ATOMIC_SEQ_CST, "wavefront");
      }
    }
    __syncthreads();
#pragma unroll
    for (int t = 0; t < 3; ++t) {
      if (t < tcnt) {
        const int ti = (tcode >> (4 * t)) & 3, tn = (tcode >> (4 * t + 2)) & 3;
#pragma unroll
        for (int r = 0; r < 4; ++r) {
          const int i = 16 * ti + g4 * 4 + r, j = 16 * tn + r16;
          sMM[i * 68 + j] = (i >= j) ? attacc[t][r] * __expf(sGc[i] - sGc[j]) : 0.f;
        }
      }
    }
    __syncthreads();
    {
      f32x4 acc[2] = {f32x4{0.f, 0.f, 0.f, 0.f}, f32x4{0.f, 0.f, 0.f, 0.f}};
      const float eg = __expf(sGc[16 * w + r16]);
      {
        const u16* qb = sQb + (16 * w + r16) * 80 + g4 * 8;
        const bf16x8 q0 = *(const bf16x8*)(qb), q1 = *(const bf16x8*)(qb + 32);
#pragma unroll
        for (int nn = 0; nn < 2; ++nn) {
          const u16* sb = sSb + (16 * nn + r16) * 80 + g4 * 8;
          acc[nn] = __builtin_amdgcn_mfma_f32_16x16x32_bf16(*(const bf16x8*)(sb), q0, acc[nn], 0, 0, 0);
          acc[nn] = __builtin_amdgcn_mfma_f32_16x16x32_bf16(*(const bf16x8*)(sb + 32), q1, acc[nn], 0, 0, 0);
          acc[nn] *= eg;
        }
      }
#pragma unroll
      for (int s = 0; s < 16; ++s) {
        if (s < 4 * (w + 1)) {
          const float a = sMM[(16 * w + r16) * 68 + 4 * s + g4];
          acc[0] = MFMA4(sV[(4 * s + g4) * 33 + r16], a, acc[0]);
          acc[1] = MFMA4(sV[(4 * s + g4) * 33 + 16 + r16], a, acc[1]);
        }
      }
      {
        const int pp = 16 * w + r16;
        const int u = d == 0 ? pp : 63 - pp;
        u16* op = p.MIX + (size_t)(t0 + tlo + u) * 1024 + d * 256 + h * 64 + vs * 32 + g4 * 4;
        *(uint2*)(op) = pack4(acc[0]);
        *(uint2*)(op + 16) = pack4(acc[1]);
      }
    }
    __syncthreads();
    {
      const float g63 = sGc[63];
      const float gl = __expf(g63);
#pragma unroll
      for (int nn = 0; nn < 2; ++nn)
#pragma unroll
        for (int r = 0; r < 4; ++r) Sreg[nn][r] *= gl;
#pragma unroll
      for (int s = 0; s < 16; ++s) {
        const int srow = 4 * s + g4;
        const float a = sK[srow * 65 + 16 * w + r16] * __expf(g63 - sGc[srow]);
        Sreg[0] = MFMA4(a, sV[srow * 33 + r16], Sreg[0]);
        Sreg[1] = MFMA4(a, sV[srow * 33 + 16 + r16], Sreg[1]);
      }
    }
    __syncthreads();
#pragma unroll
    for (int nn = 0; nn < 2; ++nn) *(uint2*)(sSb + (nn * 16 + r16) * 80 + 16 * w + g4 * 4) = pack4(Sreg[nn]);
    __syncthreads();
  }
  if (!latent) {
    float* so = p.out + OUT_SGDN + ((((size_t)seq * 2 + l) * 2 + d) * 4 + h) * 4096;
#pragma unroll
    for (int nn = 0; nn < 2; ++nn)
#pragma unroll
      for (int r = 0; r < 4; ++r) so[(16 * w + g4 * 4 + r) * 64 + vs * 32 + nn * 16 + r16] = Sreg[nn][r];
  }
}

__device__ __forceinline__ void hgrn_chain(const Params& p, int l, int seq, int h, int d, int vs, float* sm) {
  float* sBC = sm;
  float* sK = sBC + 64 * 65;
  float* sAT = sK + 64 * 65;
  float* sV = sAT + 64 * 68;
  float* sS = sV + 64 * 33;
  float* sTot = sS + 64 * 33;
  u16* sSb = (u16*)(sTot + 256 + 64);
  const int tid = tid_l(), lane = tid & 63, w = tid >> 6, r16 = lane & 15, g4 = lane >> 4;
  const bool latent = seq >= 16;
  const int len = latent ? 4096 : 256;
  const int t0 = latent ? T_CTX + (seq - 16) * 4096 : seq * 256;
  const int nchunks = len >> 6;
  float lbk;
  {
    const int kch = h * 64 + (tid & 63);
    lbk = (l == 0) ? 0.f : sigmoidf_(p.hgrn_lb[256 + kch] - p.hgrn_lb[kch]);
  }
  f32x4 Sreg[2];
  __syncthreads();
  {
    const float* s0 = latent ? p.state_hgrn + ((((size_t)(seq - 16) * 2 + l) * 2 + d) * 4 + h) * 4096 : nullptr;
#pragma unroll
    for (int n = 0; n < 2; ++n)
#pragma unroll
      for (int r = 0; r < 4; ++r) {
        const int kidx = 16 * w + g4 * 4 + r, cc = n * 16 + r16;
        float v = latent ? s0[kidx * 64 + vs * 32 + cc] : 0.f;
        Sreg[n][r] = v;
        sS[kidx * 33 + cc] = v;
      }
#pragma unroll
    for (int n = 0; n < 2; ++n) *(uint2*)(sSb + (n * 16 + r16) * 80 + 16 * w + g4 * 4) = pack4(Sreg[n]);
  }
  const u16* Pb = p.P + (size_t)t0 * PW;
  float* sLb = sTot + 256;
  if (tid < 64) sLb[tid] = lbk;
  __syncthreads();
  int pgo[5];
#pragma unroll
  for (int i = 0; i < 5; ++i) {
    const int e = tid + i * 256;
    const int u = e / 20, un = e % 20;
    pgo[i] = u * PW + (un < 8 ? P_HF + d * 256 + h * 64 + un * 8 : (un < 12 ? P_HI + h * 64 + vs * 32 + (un - 8) * 8 : P_HQ + h * 64 + (un - 12) * 8));
  }
  uint4 pf[5];
  {
    const int tlo = d == 0 ? 0 : len - 64;
#pragma unroll
    for (int i = 0; i < 5; ++i) pf[i] = *(const uint4*)(Pb + (size_t)tlo * PW + pgo[i]);
  }
  for (int n = 0; n < nchunks; ++n) {
#pragma unroll
    for (int i = 0; i < 5; ++i) {
      const int e = tid + i * 256;
      const int u = e / 20, un = e % 20;
      const int pp = d == 0 ? u : 63 - u;
      const unsigned wv[4] = {pf[i].x, pf[i].y, pf[i].z, pf[i].w};
#pragma unroll
      for (int j = 0; j < 8; ++j) {
        const float x = bf2f((u16)((wv[j >> 1] >> ((j & 1) * 16)) & 0xffff));
        if (un < 8) {
          const int k = un * 8 + j;
          const float lb = sLb[k];
          const float sg_ = sigmoidf_(x);
          const float gate = lb + (1.f - lb) * sg_;
          sBC[pp * 65 + k] = __logf(fmaxf(gate, 1e-30f));
          sK[pp * 65 + k] = (1.f - lb) * (1.f - sg_);
        } else if (un < 12) {
          sV[pp * 33 + (un - 8) * 8 + j] = x;
        } else {
          sAT[pp * 68 + (un - 12) * 8 + j] = x;
        }
      }
    }
    __syncthreads();
    if (n + 1 < nchunks) {
      const int tlo2 = d == 0 ? (n + 1) * 64 : len - 64 * (n + 2);
#pragma unroll
      for (int i = 0; i < 5; ++i) pf[i] = *(const uint4*)(Pb + (size_t)tlo2 * PW + pgo[i]);
    }
    const int tlo = d == 0 ? n * 64 : len - 64 * (n + 1);
    float cs[16];
    {
      const int k = tid & 63, sg = tid >> 6;
      float run = 0.f;
#pragma unroll
      for (int i = 0; i < 16; ++i) { run += sBC[(16 * sg + i) * 65 + k]; cs[i] = run; }
      sTot[sg * 64 + k] = run;
    }
    float qa[16];
#pragma unroll
    for (int s = 0; s < 16; ++s) qa[s] = sAT[(16 * w + r16) * 68 + 4 * s + g4];
    __syncthreads();
    {
      const int k = tid & 63, sg = tid >> 6;
      float off = 0.f;
      for (int s2 = 0; s2 < sg; ++s2) off += sTot[s2 * 64 + k];
#pragma unroll
      for (int i = 0; i < 16; ++i) sBC[(16 * sg + i) * 65 + k] = cs[i] + off;
    }
    __syncthreads();
    f32x4 o1[2] = {f32x4{0.f, 0.f, 0.f, 0.f}, f32x4{0.f, 0.f, 0.f, 0.f}};
    {
      const float* qrow = sAT + (16 * w + r16) * 68 + g4 * 8;
      const float* bcrow = sBC + (16 * w + r16) * 65 + g4 * 8;
      bf16x8 af[2];
#pragma unroll
      for (int ks = 0; ks < 2; ++ks) {
        float v[8];
#pragma unroll
        for (int j = 0; j < 8; ++j) v[j] = qrow[ks * 32 + j] * __expf(bcrow[ks * 32 + j]);
        af[ks] = __builtin_bit_cast(bf16x8, pack8(v));
      }
#pragma unroll
      for (int nn = 0; nn < 2; ++nn) {
        const u16* sb = sSb + (16 * nn + r16) * 80 + g4 * 8;
        o1[nn] = __builtin_amdgcn_mfma_f32_16x16x32_bf16(*(const bf16x8*)(sb), af[0], o1[nn], 0, 0, 0);
        o1[nn] = __builtin_amdgcn_mfma_f32_16x16x32_bf16(*(const bf16x8*)(sb + 32), af[1], o1[nn], 0, 0, 0);
      }
    }
    {
      float aq[16], rf[16];
#pragma unroll
      for (int s = 0; s < 16; ++s) {
        const int kk = 4 * s + g4;
        rf[s] = (w == 0) ? 0.f : sBC[(16 * w - 1) * 65 + kk];
        aq[s] = qa[s] * __expf(sBC[(16 * w + r16) * 65 + kk] - rf[s]);
      }
#pragma unroll
      for (int nn = 0; nn < 4; ++nn) {
        f32x4 acc = f32x4{0.f, 0.f, 0.f, 0.f};
        if (nn <= w) {
#pragma unroll
          for (int s = 0; s < 16; ++s) {
            const int kk = 4 * s + g4, sc = 16 * nn + r16;
            const float bv = sK[sc * 65 + kk] * __expf(fminf(rf[s] - sBC[sc * 65 + kk], 80.f));
            acc = MFMA4(aq[s], bv, acc);
          }
        }
#pragma unroll
        for (int r = 0; r < 4; ++r) {
          const int i = 16 * w + g4 * 4 + r, j = 16 * nn + r16;
          sAT[i * 68 + j] = (i >= j) ? acc[r] : 0.f;
        }
      }
    }
    __syncthreads();
    {
      f32x4 acc[2] = {o1[0], o1[1]};
#pragma unroll
      for (int ks = 0; ks < 2; ++ks) {
        if (ks == 0 || w >= 2) {
          const float* ar = sAT + (16 * w + r16) * 68 + ks * 32 + g4 * 8;
          const float4 x0 = *(const float4*)(ar), x1 = *(const float4*)(ar + 4);
          const float va[8] = {x0.x, x0.y, x0.z, x0.w, x1.x, x1.y, x1.z, x1.w};
          const bf16x8 bfr = __builtin_bit_cast(bf16x8, pack8(va));
          float v0[8], v1[8];
#pragma unroll
          for (int j = 0; j < 8; ++j) {
            const int srow = ks * 32 + g4 * 8 + j;
            v0[j] = sV[srow * 33 + r16]; v1[j] = sV[srow * 33 + 16 + r16];
          }
          acc[0] = __builtin_amdgcn_mfma_f32_16x16x32_bf16(__builtin_bit_cast(bf16x8, pack8(v0)), bfr, acc[0], 0, 0, 0);
          acc[1] = __builtin_amdgcn_mfma_f32_16x16x32_bf16(__builtin_bit_cast(bf16x8, pack8(v1)), bfr, acc[1], 0, 0, 0);
        }
      }
      {
        const int pp = 16 * w + r16;
        const int u = d == 0 ? pp : 63 - pp;
        u16* op = p.MIX + (size_t)(t0 + tlo + u) * 1024 + 512 + d * 256 + h * 64 + vs * 32 + g4 * 4;
        *(uint2*)(op) = pack4(acc[0]);
        *(uint2*)(op + 16) = pack4(acc[1]);
      }
    }
    __syncthreads();
    {
#pragma unroll
      for (int nn = 0; nn < 2; ++nn)
#pragma unroll
        for (int r = 0; r < 4; ++r) Sreg[nn][r] *= __expf(sBC[63 * 65 + 16 * w + g4 * 4 + r]);
      const int kA = 16 * w + r16;
      const float blA = sBC[63 * 65 + kA];
#pragma unroll
      for (int ks = 0; ks < 2; ++ks) {
        float va[8], v0[8], v1[8];
#pragma unroll
        for (int j = 0; j < 8; ++j) {
          const int srow = ks * 32 + g4 * 8 + j;
          va[j] = sK[srow * 65 + kA] * __expf(blA - sBC[srow * 65 + kA]);
          v0[j] = sV[srow * 33 + r16]; v1[j] = sV[srow * 33 + 16 + r16];
        }
        const bf16x8 af = __builtin_bit_cast(bf16x8, pack8(va));
        Sreg[0] = __builtin_amdgcn_mfma_f32_16x16x32_bf16(af, __builtin_bit_cast(bf16x8, pack8(v0)), Sreg[0], 0, 0, 0);
        Sreg[1] = __builtin_amdgcn_mfma_f32_16x16x32_bf16(af, __builtin_bit_cast(bf16x8, pack8(v1)), Sreg[1], 0, 0, 0);
      }
    }
    __syncthreads();
#pragma unroll
    for (int nn = 0; nn < 2; ++nn) *(uint2*)(sSb + (nn * 16 + r16) * 80 + 16 * w + g4 * 4) = pack4(Sreg[nn]);
    __syncthreads();
  }
  if (!latent) {
    float* so = p.out + OUT_SHG + ((((size_t)seq * 2 + l) * 2 + d) * 4 + h) * 4096;
#pragma unroll
    for (int nn = 0; nn < 2; ++nn)
#pragma unroll
      for (int r = 0; r < 4; ++r) so[(16 * w + g4 * 4 + r) * 64 + vs * 32 + nn * 16 + r16] = Sreg[nn][r];
  }
}

__device__ __forceinline__ void phase_c(const Params& p, int l, unsigned char* smraw, int mode = 0) {
  __shared__ int s_item;
  const int total = 1920;
  const bool paired = (gridDim.x == 512);
  const int jx = blockIdx.x >> 3;
  int my_static = -1;
  if (paired && (jx & 31) < 16) my_static = (blockIdx.x & 7) * 32 + (jx & 15) * 2 + (jx >> 5);
  for (;;) {
    __syncthreads();
    if (tid_l() == 0) {
      if (my_static >= 0) s_item = my_static;
      else s_item = (paired ? 256 : 0) + (int)atomicAdd(&p.counters[l * 64 + mode * 16], 1u);
    }
    __syncthreads();
    my_static = -1;
    const int item = s_item;
    if (item >= total) break;
    int kind, a0, a1, a2, a3;
    if (item < 256 || (item >= 1280 && item < 1792)) {
      const int i2 = item < 256 ? item : item - 1280;
      const int rest = i2 >> 1;
      kind = i2 & 1;
      a3 = rest & 1; a2 = (rest >> 1) & 1; a1 = (rest >> 2) & 3; a0 = (rest >> 4) + (item < 256 ? 16 : 0);
    } else if (item < 1280) {
      const int i2 = item - 256;
      kind = 2; a0 = 1; a1 = i2 >> 7; a2 = (i2 >> 5) & 3; a3 = i2 & 31;
    } else {
      const int i2 = item - 1792;
      kind = 2; a0 = 0; a1 = i2 >> 3; a2 = (i2 >> 1) & 3; a3 = i2 & 1;
    }
    if (mode == 1 && kind == 2) continue;
    if (mode == 2 && kind != 2) continue;
    if (kind != 2) __builtin_amdgcn_s_setprio(3);
    if (kind == 0) gdn_chain(p, l, a0, a1, a2, a3, (float*)smraw);
    else if (kind == 1) hgrn_chain(p, l, a0, a1, a2, a3, (float*)smraw);
    if (kind != 2) __builtin_amdgcn_s_setprio(0);
    else attn_item(p, a0, a1, a2, a3, smraw, mode == 2);
  }
}

__global__ void __launch_bounds__(NTHR, 2) mega(Params p) {
  __shared__ __attribute__((aligned(16))) unsigned char smem[LDS_BYTES];
  cg::grid_group grid = cg::this_grid();
  __shared__ uint4 xb_words;
  if (threadIdx.x == 0) xb_words = make_uint4(0u, 0u, 0u, 0u);
  __syncthreads();
  {
    XcdBarrier xb0 = xcd_barrier_post(p.xbar, (volatile LAS unsigned*)&xb_words);
    if (threadIdx.x == 0) ((volatile LAS unsigned*)&xb_words)[2] = xb0.x;
  }
#define GSYNC() do { XcdBarrier xb_; xb_.bar = p.xbar; xb_.st = (volatile LAS unsigned*)&xb_words; xb_.x = 0; \
    if (threadIdx.x == 0) xb_.x = ((volatile LAS unsigned*)&xb_words)[2]; xcd_barrier(xb_); } while (0)
  phase0(p, (float*)smem);
  if (p.out == nullptr) grid.sync();
  GSYNC();
  rowpass_norm(p, 0, 0);
  GSYNC();
  for (int l = 0; l < 2; ++l) {
    phase_a(p, l, (u16*)smem);
    GSYNC();
    rowpass_b0(p, l);
    GSYNC();
    phase_b1(p, l, (u16*)smem);
    GSYNC();
    rowpass_b2(p, l);
    GSYNC();
    phase_c(p, l, smem);
    GSYNC();
    rowpass_c2(p, l);
    GSYNC();
    phase_gemm_y(p.MIX, 1024, p.WoutT + (size_t)l * 1024 * 1024, 1024, 1024, p.HQ, 1024, (u16*)smem);
    GSYNC();
    rowpass_norm(p, l, 1);
    GSYNC();
    phase_e(p, l, (u16*)smem);
    GSYNC();
    phase_gemm_y(p.P, DFF, p.WfoT + (size_t)l * 1024 * DFF, DFF, 1024, p.HQ, 1024, (u16*)smem);
    GSYNC();
    rowpass_norm(p, l, 2);
    if (l == 0) GSYNC();
  }
}

extern "C" void kernel_launch(void* const* d_in, const int* in_sizes, int n_in, void* d_out, int out_size, void* d_ws,
                              size_t ws_size, hipStream_t stream) {
  static int grid_blocks = 0;
  if (!grid_blocks) {
    int dev = 0, cus = 0, per_cu = 0;
    hipGetDevice(&dev);
    hipDeviceGetAttribute(&cus, hipDeviceAttributeMultiprocessorCount, dev);
    hipOccupancyMaxActiveBlocksPerMultiprocessor(&per_cu, mega, NTHR, 0);
    if (per_cu > 2) per_cu = 2;
    if (per_cu < 1) per_cu = 1;
    grid_blocks = cus * per_cu;
  }
  Params p{};
  const float* const* in = (const float* const*)d_in;
  p.x_prompt = in[0]; p.x_sample = in[1]; p.cache_ckv = in[2]; p.cache_kr = in[3]; p.state_gdn = in[4]; p.state_hgrn = in[5];
  p.c = in[6]; p.c_ctx = in[7]; p.w_ada = in[8]; p.b_ada = in[9]; p.g_pre_mix = in[10]; p.g_post_mix = in[11];
  p.g_pre_ffn = in[12]; p.g_post_ffn = in[13]; p.w_in = in[14]; p.w_out = in[15]; p.gdn_conv_w = in[16];
  p.gdn_a_log = in[17]; p.gdn_dt_bias = in[18]; p.gdn_norm_w = in[19]; p.hgrn_lb = in[20]; p.hgrn_norm_w = in[21];
  p.mla_q_norm_w = in[22]; p.mla_w_uq = in[23]; p.mla_kv_norm_w = in[24]; p.mla_w_ukv = in[25]; p.w_ffn_in = in[26];
  p.w_ffn_out = in[27];
  p.out = (float*)d_out;
  unsigned char* ws = (unsigned char*)d_ws;
  size_t off = 0;
  auto take = [&](size_t bytes) { unsigned char* r = ws + off; off += (bytes + 255) & ~(size_t)255; return r; };
  p.counters = (unsigned*)take(1024);
  p.xbar = (unsigned*)take(16384);
  p.WinT = (u16*)take((size_t)2 * 3072 * 1024 * 2);
  p.WuqT = (u16*)take((size_t)2 * 768 * 384 * 2);
  p.WukvT = (u16*)take((size_t)2 * 1024 * 256 * 2);
  p.WoutT = (u16*)take((size_t)2 * 1024 * 1024 * 2);
  p.WfiT = (u16*)take((size_t)2 * 5632 * 1024 * 2);
  p.WfoT = (u16*)take((size_t)2 * 1024 * 2816 * 2);
  p.mod = (float*)take((size_t)2 * 9 * 6144 * 4);
  p.HQ = (u16*)take((size_t)T_ALL * 1024 * 2);
  p.P = (u16*)take((size_t)T_ALL * PW * 2);
  p.KN = (u16*)take((size_t)(T_ALL + 2048) * 512 * 2);
  p.VTL = (u16*)take((size_t)8 * 4 * 128 * 4352 * 2);
  p.VTC = (u16*)take((size_t)16 * 4 * 128 * 256 * 2);
  p.CKVC = (u16*)take((size_t)2048 * 256 * 2);
  p.KRC = (u16*)take((size_t)2048 * 64 * 2);
  p.GAB = (float*)take((size_t)T_ALL * 16 * 4);
  p.MIX = (u16*)take((size_t)T_ALL * 1024 * 2);
  if (off > ws_size) { fprintf(stderr, "workspace too small: need %zu have %zu\n", off, ws_size); return; }
  hipMemsetAsync(p.counters, 0, 1024 + 16384, stream);
  void* args[] = {&p};
  hipError_t e = hipLaunchCooperativeKernel((void*)mega, dim3(grid_blocks), dim3(NTHR), args, 0, stream);
  if (e != hipSuccess) fprintf(stderr, "cooperative launch failed: %s (grid %d)\n", hipGetErrorString(e), grid_blocks);
}
```
